# Optimizing an MI355X kernel written in HIP

```python
import jax, jax.numpy as jnp
from jax import lax
import numpy as np

D_MODEL = 2048
BATCH = 4
SEQ = 4096
DEPTH = 4

CHUNK = 64
HG_HEADS = 8
HG_KDIM = 128
HG_VDIM = 128
HG_FDIM = HG_HEADS * HG_KDIM
HG_WIDTH = HG_HEADS * HG_VDIM
F_MIN = 1e-6
SA_HEADS = 16
SA_KV_LATENT = 256
SA_Q_RANK = 512
SA_V_DIM = 64
SA_WIDTH = SA_HEADS * SA_V_DIM
IDX_HEADS = 16
IDX_DIM = 64
TOPK_MAX = 256
Q_BLOCK = 128
MASK_VALUE = -1e30
D_FF = ((8 * D_MODEL + 3 * 256 - 1) // (3 * 256)) * 256
ALPHA = (2 * DEPTH) ** 0.25
BETA = (8 * DEPTH) ** -0.25
ADA_SCALE = 0.1
IN_SPLITS = (HG_FDIM, HG_FDIM, HG_WIDTH, HG_WIDTH, SA_Q_RANK, SA_KV_LATENT, IDX_DIM, IDX_HEADS, D_MODEL, D_MODEL)
D_IN = sum(IN_SPLITS)
HG_I_START = 2 * HG_FDIM

kernel_name = 'hybrid_hgrn2_dsa_deepnorm_encoder'


def _split_points(sizes):
    pts, acc = [], 0
    for s in sizes[:-1]:
        acc += s
        pts.append(acc)
    return pts


def layer_norm(x, g, b, eps=1e-5):
    xf = x.astype(jnp.float32)
    mu = jnp.mean(xf, -1, keepdims=True)
    var = jnp.mean(jnp.square(xf - mu), -1, keepdims=True)
    return ((xf - mu) * lax.rsqrt(var + eps)).astype(x.dtype) * g + b


def rms_norm(x, g, eps=1e-6):
    xf = x.astype(jnp.float32)
    return (xf * lax.rsqrt(jnp.mean(xf * xf, -1, keepdims=True) + eps)).astype(x.dtype) * g


def alibi_slopes(n):
    return jnp.exp2(-8.0 * (jnp.arange(n, dtype=jnp.float32) + 1.0) / n)


def hgrn_lower_bounds(lb_logits):
    p = jax.nn.softmax(lb_logits.astype(jnp.float32), axis=0)
    return jnp.cumsum(p, axis=0) - p[0:1]


def hgrn2_chunkwise(q, k, v, log_f):
    B, L, H, K = q.shape
    V = v.shape[-1]
    nc = L // CHUNK

    def to_chunks(t):
        return t.astype(jnp.float32).reshape(B, nc, CHUNK, H, t.shape[-1]).transpose(1, 0, 3, 2, 4)

    causal = jnp.tril(jnp.ones((CHUNK, CHUNK), bool))[:, :, None]

    def step(S, inp):
        qt, kt, vt, ft = inp
        b = jnp.cumsum(ft, axis=2)
        b_last = b[:, :, -1:, :]
        o_inter = jnp.einsum('bhtk,bhkv->bhtv', qt * jnp.exp(b), S)
        diff = b[:, :, :, None, :] - b[:, :, None, :, :]
        decay = jnp.where(causal, jnp.exp(jnp.where(causal, diff, 0.0)), 0.0)
        scores = jnp.einsum('bhtk,bhtsk,bhsk->bhts', qt, decay, kt)
        o_intra = jnp.einsum('bhts,bhsv->bhtv', scores, vt)
        S_new = jnp.exp(b_last[:, :, 0, :])[..., None] * S + jnp.einsum('bhsk,bhsv->bhkv', kt * jnp.exp(b_last - b), vt)
        return S_new, o_inter + o_intra

    S0 = jnp.zeros((B, H, K, V), jnp.float32)
    _, o = lax.scan(step, S0, (to_chunks(q), to_chunks(k), to_chunks(v), to_chunks(log_f)))
    return o.transpose(1, 0, 3, 2, 4).reshape(B, L, H, V)


def dsa_attention(q, c_kv, q_idx, k_idx, idx_w, slopes):
    B, L, H, C = q.shape
    n_sel = min(TOPK_MAX, L // 4)
    nblk = L // Q_BLOCK
    pos = jnp.arange(L)
    key_chunk = pos // CHUNK
    scale = C ** -0.5

    def blocks(t):
        return jnp.moveaxis(t.reshape(B, nblk, Q_BLOCK, *t.shape[2:]), 1, 0)

    def one_block(inp):
        qb, qib, wb, pb = inp
        q_chunk = pb // CHUNK
        isc = jax.nn.relu(jnp.einsum('bqhd,bsd->bqhs', qib, k_idx))
        isc = jnp.einsum('bqhs,bqh->bqs', isc, wb).astype(jnp.float32)
        admissible = key_chunk[None, :] <= q_chunk[:, None]
        isc = jnp.where(admissible[None], isc, MASK_VALUE)
        _, sel = lax.top_k(isc, n_sel)
        kv = jax.vmap(lambda t, i: t[i])(c_kv, sel)
        valid = (sel // CHUNK) <= q_chunk[None, :, None]
        dist = jnp.abs(pb[None, :, None] - sel).astype(jnp.float32)
        s = jnp.einsum('bqhc,bqkc->bqhk', qb, kv).astype(jnp.float32) * scale
        s = s - slopes[None, None, :, None] * dist[:, :, None, :]
        s = jnp.where(valid[:, :, None, :], s, MASK_VALUE)
        p = jax.nn.softmax(s, axis=-1).astype(kv.dtype)
        return jnp.einsum('bqhk,bqkc->bqhc', p, kv)

    o = lax.map(one_block, (blocks(q), blocks(q_idx), blocks(idx_w), pos.reshape(nblk, Q_BLOCK)))
    return jnp.moveaxis(o, 0, 1).reshape(B, L, H, C)


def mixer_sublayer(h, lb, slopes, w_in, g_hg, w_pa, g_cq, g_ckv, w_uq, w_iq, w_uv, w_pb, w_out):
    B, L, _ = h.shape
    proj = h @ w_in
    q_a, f_a, i_a, g_a, c_q, c_kv, k_idx, idx_w, gate_a, gate_b = jnp.split(proj, _split_points(IN_SPLITS), axis=-1)

    heads = lambda t: t.reshape(B, L, HG_HEADS, -1)
    lb_h = lb.reshape(HG_HEADS, HG_KDIM)
    f = lb_h + (1.0 - lb_h) * jax.nn.sigmoid(heads(f_a).astype(jnp.float32))
    log_f = jnp.log(jnp.clip(f, F_MIN, 1.0))
    k_a = 1.0 - f
    o_a = hgrn2_chunkwise(heads(q_a), k_a, heads(i_a), log_f).astype(h.dtype)
    y_a = (rms_norm(o_a, g_hg.reshape(HG_HEADS, HG_VDIM)) * jax.nn.silu(heads(g_a))).reshape(B, L, HG_WIDTH)

    c_q = rms_norm(c_q, g_cq)
    q_b = (c_q @ w_uq).reshape(B, L, SA_HEADS, SA_KV_LATENT)
    c_kv = rms_norm(c_kv, g_ckv)
    q_idx = (c_q @ w_iq).reshape(B, L, IDX_HEADS, IDX_DIM)
    idx_w = idx_w * (IDX_HEADS ** -0.5 * IDX_DIM ** -0.5)
    o_b = dsa_attention(q_b, c_kv, q_idx, k_idx, idx_w, slopes)
    y_b = jnp.einsum('blhc,hcv->blhv', o_b, w_uv).reshape(B, L, SA_WIDTH)

    merged = jax.nn.sigmoid(gate_a) * (y_a @ w_pa) + jax.nn.sigmoid(gate_b) * (y_b @ w_pb)
    return merged @ w_out


def swiglu(h, w_gate, w_up, w_down):
    return (jax.nn.silu(h @ w_gate) * (h @ w_up)) @ w_down


def setup_inputs(seed: int = 0) -> dict:
    key = jax.random.key(seed)
    ks = jax.random.split(key, 22)
    nrm = lambda k, shape, s: jax.random.normal(k, shape, jnp.float32) * s
    gain = lambda k, shape: 1.0 + 0.02 * jax.random.normal(k, shape, jnp.float32)
    col_scale = jnp.ones((D_IN,), jnp.float32).at[HG_I_START:HG_I_START + HG_WIDTH].set(BETA)
    return {
        'x': nrm(ks[0], (BATCH, SEQ, D_MODEL), 1.0),
        'c': nrm(ks[1], (BATCH, D_MODEL), 1.0),
        'w_ada': nrm(ks[2], (DEPTH, D_MODEL, 6 * D_MODEL), ADA_SCALE * D_MODEL ** -0.5),
        'b_ada': nrm(ks[3], (DEPTH, 6 * D_MODEL), 0.01),
        'w_in': nrm(ks[4], (DEPTH, D_MODEL, D_IN), D_MODEL ** -0.5) * col_scale,
        'lb_logits': nrm(ks[5], (DEPTH, HG_FDIM), 0.5),
        'g_hg': gain(ks[6], (DEPTH, HG_WIDTH)),
        'w_pa': nrm(ks[7], (DEPTH, HG_WIDTH, D_MODEL), HG_WIDTH ** -0.5),
        'g_cq': gain(ks[8], (DEPTH, SA_Q_RANK)),
        'g_ckv': gain(ks[9], (DEPTH, SA_KV_LATENT)),
        'w_uq': nrm(ks[10], (DEPTH, SA_Q_RANK, SA_HEADS * SA_KV_LATENT), SA_Q_RANK ** -0.5),
        'w_iq': nrm(ks[11], (DEPTH, SA_Q_RANK, IDX_HEADS * IDX_DIM), SA_Q_RANK ** -0.5),
        'w_uv': nrm(ks[12], (DEPTH, SA_HEADS, SA_KV_LATENT, SA_V_DIM), BETA * SA_KV_LATENT ** -0.5),
        'w_pb': nrm(ks[13], (DEPTH, SA_WIDTH, D_MODEL), SA_WIDTH ** -0.5),
        'w_out': nrm(ks[14], (DEPTH, D_MODEL, D_MODEL), BETA * D_MODEL ** -0.5),
        'ln1_g': gain(ks[15], (DEPTH, D_MODEL)),
        'ln1_b': nrm(ks[16], (DEPTH, D_MODEL), 0.01),
        'w_gate': nrm(ks[17], (DEPTH, D_MODEL, D_FF), D_MODEL ** -0.5),
        'w_up': nrm(ks[18], (DEPTH, D_MODEL, D_FF), BETA * D_MODEL ** -0.5),
        'w_down': nrm(ks[19], (DEPTH, D_FF, D_MODEL), BETA * D_FF ** -0.5),
        'ln2_g': gain(ks[20], (DEPTH, D_MODEL)),
        'ln2_b': nrm(ks[21], (DEPTH, D_MODEL), 0.01),
    }


def reference(x, c, w_ada, b_ada, w_in, lb_logits, g_hg, w_pa, g_cq, g_ckv, w_uq, w_iq, w_uv, w_pb, w_out, ln1_g, ln1_b, w_gate, w_up, w_down, ln2_g, ln2_b):
    lbs = hgrn_lower_bounds(lb_logits)
    slopes = alibi_slopes(SA_HEADS)
    cond = jax.nn.silu(c)
    for l in range(DEPTH):
        mod = (cond @ w_ada[l] + b_ada[l])[:, None, :]
        sh_m, sc_m, gt_m, sh_f, sc_f, gt_f = jnp.split(mod, 6, axis=-1)
        h = x * (1.0 + sc_m) + sh_m
        y = mixer_sublayer(h, lbs[l], slopes, w_in[l], g_hg[l], w_pa[l], g_cq[l], g_ckv[l], w_uq[l], w_iq[l], w_uv[l], w_pb[l], w_out[l])
        x = layer_norm(ALPHA * x + (1.0 + gt_m) * y, ln1_g[l], ln1_b[l])
        h = x * (1.0 + sc_f) + sh_f
        y = swiglu(h, w_gate[l], w_up[l], w_down[l])
        x = layer_norm(ALPHA * x + (1.0 + gt_f) * y, ln2_g[l], ln2_b[l])
    return x
```

```cpp
#include <hip/hip_runtime.h>
#include <cstdio>
#include <cstdint>

namespace pg8 {
#define PG8_LAS __attribute__((address_space(3)))
typedef unsigned short bf16_t;
typedef short bf16x8 __attribute__((ext_vector_type(8)));
typedef float f32x4 __attribute__((ext_vector_type(4)));
typedef unsigned u32x4 __attribute__((ext_vector_type(4)));
constexpr int BM = 256, BK = 64, HALF = 128, HTB = HALF * BK * 2, STAGE_BYTES = 8 * HTB, NXCD = 8, WGM = 8;

__host__ __device__ __forceinline__ int lds_byte(int r, int c) { const int st = (r >> 4) * 2 + (c >> 5), rr = r & 15, cc = c & 31, ob = rr * 64 + cc * 2; return st * 1024 + (ob ^ (((ob >> 9) & 1) << 5)); }
__host__ __device__ __forceinline__ void stage_rc(int b, int& R, int& C) { const int st = b / 1024, sb = b % 1024, swz = sb ^ (((sb >> 9) & 1) << 5); R = (st >> 1) * 16 + swz / 64; C = (st & 1) * 32 + (swz % 64) / 2; }
__host__ __device__ __forceinline__ int perm32(int rho) { const int n = rho >> 4, i = rho & 15; return 8 * (i >> 2) + 4 * n + (i & 3); }

struct Unit { int pm, pn; };
struct Gemm { const bf16_t* A; const bf16_t* Bt; int M, N, K, lda, ldb, a_pn_stride; };

struct StaticOrder {
    int nM, nN, nwg, G, c;
    __host__ __device__ void init(int M, int N, int G_, int c_) { nM = M / BM; nN = N / BM; nwg = nM * nN; G = G_; c = c_; }
    __host__ __device__ bool next(int i, Unit& u) const {
        const long L = (long)i * G + c; if (L >= nwg) return false;
        int wgid = (int)L; { const int q = nwg / NXCD, r = nwg % NXCD, xcd = wgid % NXCD, off = wgid / NXCD; wgid = (xcd < r ? xcd * (q + 1) : r * (q + 1) + (xcd - r) * q) + off; }
        const int nig = WGM * nN, gid = wgid / nig, fm = gid * WGM, gsz = (nM - fm) < WGM ? (nM - fm) : WGM;
        u.pm = fm + ((wgid % nig) % gsz); u.pn = (wgid % nig) / gsz; return true;
    }
};

typedef float f32x2_t __attribute__((ext_vector_type(2))); typedef __bf16 bf16x2_t __attribute__((ext_vector_type(2)));
__device__ __forceinline__ unsigned cvt_pk_bf16(float lo, float hi) { f32x2_t v = {lo, hi}; bf16x2_t b = __builtin_convertvector(v, bf16x2_t); return __builtin_bit_cast(unsigned, b); }

template <class Epi>
__device__ __forceinline__ void gemm_phase(PG8_LAS unsigned char* lds, const Gemm g, const StaticOrder& S, const Epi& E, const int tid) {
    const int wid = __builtin_amdgcn_readfirstlane(tid >> 6), lane = tid & 63, wr = wid >> 2, wc = wid & 3, fr = lane & 15, fq = lane >> 4;
    const int K = g.K, nt = K / BK;
    unsigned voffA[2], voffB[2];
#pragma unroll
    for (int i = 0; i < 2; ++i) { int R, C; stage_rc(tid * 16 + i * 8192, R, C); const int Rb = (R & ~31) + perm32(R & 31);
        voffA[i] = (unsigned)(R * g.lda + C) * 2u; voffB[i] = (unsigned)(Rb * g.ldb + C) * 2u; }
    const size_t kstep = (size_t)(BK * 2);
    const size_t hstepA = (size_t)HALF * g.lda * 2, hstepB = (size_t)HALF * g.ldb * 2;
    const size_t tstepA = 2 * hstepA, tstepB = 2 * hstepB;
    const unsigned ldsw = (unsigned)wid * 1024u;
    const int aoff = lds_byte(wr * 64 + fr, fq * 8), boff = lds_byte(wc * 32 + fr, fq * 8);
#define PG8_SA(b, h) (((b) * 2 + (h)) * HTB)
#define PG8_SB(b, h) ((4 + (b) * 2 + (h)) * HTB)
#define PG8_STAGE(bufoff, gbase, voff) do { _Pragma("unroll") for (int _i = 0; _i < 2; ++_i) \
        __builtin_amdgcn_global_load_lds((const unsigned*)((const char*)(gbase) + (voff)[_i]), (PG8_LAS unsigned*)(lds + (bufoff) + ldsw + _i * 8192), 16, 0, 0); } while (0)
#define PG8_LDA(dst, b, h) do { _Pragma("unroll") for (int m = 0; m < 4; ++m) _Pragma("unroll") for (int k = 0; k < 2; ++k) dst[m][k] = *(const PG8_LAS bf16x8*)(lds + PG8_SA(b, h) + aoff + m * 2048 + k * 1024); } while (0)
#define PG8_LDB(dst, b, h) do { _Pragma("unroll") for (int n = 0; n < 2; ++n) _Pragma("unroll") for (int k = 0; k < 2; ++k) dst[n][k] = *(const PG8_LAS bf16x8*)(lds + PG8_SB(b, h) + boff + n * 2048 + k * 1024); } while (0)
#define PG8_MMA(ai, bj, At, Bt) do { __builtin_amdgcn_s_setprio(1); _Pragma("unroll") for (int m = 0; m < 4; ++m) _Pragma("unroll") for (int n = 0; n < 2; ++n) _Pragma("unroll") for (int k = 0; k < 2; ++k) \
        acc[ai][bj][m][n] = __builtin_amdgcn_mfma_f32_16x16x32_bf16(Bt[n][k], At[m][k], acc[ai][bj][m][n], 0, 0, 0); __builtin_amdgcn_s_setprio(0); } while (0)
#define PG8_WAIT_V(n) asm volatile("s_waitcnt vmcnt(" #n ")" ::: "memory")
#define PG8_WAIT_L(n) asm volatile("s_waitcnt lgkmcnt(" #n ")" ::: "memory")
#define PG8_BAR __builtin_amdgcn_s_barrier()
#define PG8_SCHED __builtin_amdgcn_sched_barrier(0)
    Unit cur, nxt; int ui = 0;
    if (!S.next(0, cur)) return;
    f32x4 acc[2][2][4][2];
#pragma unroll
    for (int a = 0; a < 2; ++a)
#pragma unroll
        for (int b = 0; b < 2; ++b)
#pragma unroll
            for (int m = 0; m < 4; ++m)
#pragma unroll
                for (int n = 0; n < 2; ++n) acc[a][b][m][n] = (f32x4){0.f, 0.f, 0.f, 0.f};
    bf16x8 At[4][2], B0[2][2], B1[2][2];
    const char* cA = (const char*)g.A + (size_t)cur.pm * tstepA + (size_t)cur.pn * g.a_pn_stride * 2; const char* cB = (const char*)g.Bt + (size_t)cur.pn * tstepB;
    PG8_STAGE(PG8_SB(0, 0), cB, voffB); PG8_STAGE(PG8_SB(0, 1), cB + hstepB, voffB); PG8_STAGE(PG8_SA(0, 0), cA, voffA); PG8_STAGE(PG8_SA(0, 1), cA + hstepA, voffA);
    if (wr == 1) PG8_BAR;
    PG8_WAIT_V(2); PG8_BAR;
    PG8_STAGE(PG8_SB(1, 0), cB + kstep, voffB); PG8_STAGE(PG8_SA(1, 0), cA + kstep, voffA); PG8_STAGE(PG8_SB(1, 1), cB + hstepB + kstep, voffB);
    PG8_WAIT_V(6); PG8_BAR;
    for (;;) {
        const bool has_next = S.next(ui + 1, nxt);
        const char* nA = has_next ? (const char*)g.A + (size_t)nxt.pm * tstepA + (size_t)nxt.pn * g.a_pn_stride * 2 : cA; const char* nB = has_next ? (const char*)g.Bt + (size_t)nxt.pn * tstepB : cB;
        for (int t = 0; t < nt; t += 2) {
            const bool last = (t == nt - 2);
            const char* a1 = cA + (size_t)(t + 1) * kstep;
            const char* a2 = last ? nA : cA + (size_t)(t + 2) * kstep; const char* b2 = last ? nB : cB + (size_t)(t + 2) * kstep;
            const char* a3 = a2 + kstep; const char* b3 = b2 + kstep;
            PG8_LDB(B0, 0, 0); PG8_LDB(B1, 0, 1); PG8_SCHED; PG8_LDA(At, 0, 0); PG8_STAGE(PG8_SA(1, 1), a1 + hstepA, voffA);
            PG8_WAIT_V(8); PG8_WAIT_L(0); PG8_BAR; PG8_MMA(0, 0, At, B0); PG8_MMA(0, 1, At, B1); PG8_BAR; PG8_SCHED;
            PG8_LDA(At, 0, 1); PG8_STAGE(PG8_SB(0, 0), b2, voffB); PG8_STAGE(PG8_SB(0, 1), b2 + hstepB, voffB); PG8_STAGE(PG8_SA(0, 0), a2, voffA);
            PG8_WAIT_V(8); PG8_WAIT_L(0); PG8_BAR; PG8_MMA(1, 0, At, B0); PG8_MMA(1, 1, At, B1); PG8_BAR; PG8_SCHED;
            PG8_LDB(B0, 1, 0); PG8_LDB(B1, 1, 1); PG8_SCHED; PG8_LDA(At, 1, 0); PG8_STAGE(PG8_SA(0, 1), a2 + hstepA, voffA);
            PG8_WAIT_V(8); PG8_WAIT_L(0); PG8_BAR; PG8_MMA(0, 0, At, B0); PG8_MMA(0, 1, At, B1); PG8_BAR; PG8_SCHED;
            PG8_LDA(At, 1, 1); PG8_STAGE(PG8_SB(1, 0), b3, voffB); PG8_STAGE(PG8_SB(1, 1), b3 + hstepB, voffB); PG8_STAGE(PG8_SA(1, 0), a3, voffA);
            PG8_WAIT_V(8); PG8_WAIT_L(0); PG8_BAR; PG8_MMA(1, 0, At, B0); PG8_MMA(1, 1, At, B1); PG8_BAR; PG8_SCHED;
        }
        if (wr == 0) PG8_BAR;
        E(acc, cur, wr, wc, fr, fq);
        if (!has_next) break;
#pragma unroll
        for (int a = 0; a < 2; ++a)
#pragma unroll
            for (int b = 0; b < 2; ++b)
#pragma unroll
                for (int m = 0; m < 4; ++m)
#pragma unroll
                    for (int n = 0; n < 2; ++n) acc[a][b][m][n] = (f32x4){0.f, 0.f, 0.f, 0.f};
        cur = nxt; cA = nA; cB = nB; ++ui;
        if (wr == 1) PG8_BAR;
    }
    PG8_WAIT_V(0);
    PG8_BAR;
#undef PG8_SA
#undef PG8_SB
#undef PG8_STAGE
#undef PG8_LDA
#undef PG8_LDB
#undef PG8_MMA
#undef PG8_WAIT_V
#undef PG8_WAIT_L
#undef PG8_BAR
#undef PG8_SCHED
}
}

constexpr int NWAVES = 8, NTHR = NWAVES * 64;
constexpr int DM = 2048, NBATCH = 4, SEQ = 4096, DEPTH = 4, M = NBATCH * SEQ;
constexpr int HGW = 1024;
constexpr int SAH = 16, SAC = 256, SAR = 512;
constexpr int DFF = 5632;
constexpr int N1 = 9216, N3 = 5120, N10 = 2 * DFF;
constexpr float ALPHA = 1.6817928305074292f;
constexpr int MODW = 6 * DM;

constexpr size_t MiB = 1u << 20;
constexpr size_t WS_CTL = 0, CTL_ZERO_BYTES = 1 * MiB;
constexpr size_t WS_MOD = 1 * MiB;
constexpr size_t WS_LB = 2 * MiB;
constexpr size_t WS_MODP = 3 * MiB;
constexpr size_t WS_W1 = 9 * MiB;
constexpr size_t WS_W3 = WS_W1 + 36 * MiB;
constexpr size_t WS_W6 = WS_W3 + 5 * MiB;
constexpr size_t WS_W7 = WS_W6 + 2 * MiB;
constexpr size_t WS_W8 = WS_W7 + 8 * MiB;
constexpr size_t WS_W10 = WS_W8 + 8 * MiB;
constexpr size_t WS_W11 = WS_W10 + 44 * MiB;
constexpr size_t WS_X = WS_W11 + 22 * MiB;
constexpr size_t WS_R = WS_X + 128 * MiB;
constexpr size_t WS_H = WS_R + 128 * MiB;
constexpr size_t WS_QA = WS_H + 64 * MiB;
constexpr size_t WS_FA = WS_QA + 32 * MiB;
constexpr size_t WS_IA = WS_FA + 64 * MiB;
constexpr size_t WS_GA = WS_IA + 32 * MiB;
constexpr size_t WS_LAT = WS_GA + 32 * MiB;
constexpr size_t WS_GTA = WS_LAT + 64 * MiB;
constexpr size_t WS_GTB = WS_GTA + 64 * MiB;
constexpr size_t WS_CQN = WS_GTB + 64 * MiB;
constexpr size_t WS_CKV = WS_CQN + 16 * MiB;
constexpr size_t WS_KIDX = WS_CKV + 8 * MiB;
constexpr size_t WS_IDXW = WS_KIDX + 2 * MiB;
constexpr size_t WS_QB = WS_IDXW + 1 * MiB;
constexpr size_t WS_QIDX = WS_QB + 128 * MiB;
constexpr size_t WS_SEL = WS_QIDX + 32 * MiB;
constexpr size_t WS_YAB = WS_SEL + 8 * MiB;
constexpr size_t WS_MRG = WS_YAB + 64 * MiB;
constexpr size_t WS_BIG = WS_MRG + 64 * MiB;
constexpr size_t WS_END = WS_BIG + 256 * MiB;

constexpr int CW_BAR = 4096;

constexpr int RING_BYTES = 131072;
constexpr int LDSCTL_OFF = RING_BYTES, MISC_OFF = LDSCTL_OFF + 320, SELL_OFF = RING_BYTES + 2048;
constexpr int LDS_BYTES = 147456;

#define GAS __attribute__((address_space(1)))
#define LAS __attribute__((address_space(3)))
typedef unsigned short bf16;
typedef unsigned v4u __attribute__((ext_vector_type(4)));
typedef unsigned v2u __attribute__((ext_vector_type(2)));
typedef float f32x4 __attribute__((ext_vector_type(4)));
typedef GAS unsigned gu32;
#define LDS_WAIT() asm volatile("s_waitcnt lgkmcnt(0)" ::: "memory")
__device__ __forceinline__ unsigned f2bf(float f) { unsigned u = __builtin_bit_cast(unsigned, f); return (u + 0x7fffu + ((u >> 16) & 1u)) >> 16; }
__device__ __forceinline__ unsigned pk2(float lo, float hi) { return pg8::cvt_pk_bf16(lo, hi); }
__device__ __forceinline__ float bf2f(unsigned short b) { return __builtin_bit_cast(float, ((unsigned)b) << 16); }
__device__ __forceinline__ float bflo(unsigned w) { return __builtin_bit_cast(float, w << 16); }
__device__ __forceinline__ float bfhi(unsigned w) { return __builtin_bit_cast(float, w & 0xffff0000u); }
__device__ __forceinline__ float sigm(float x) { return __builtin_amdgcn_rcpf(1.f + __expf(-x)); }

#define XB_TMO      128
#define XB_XCNT(j)  (256  + 64 * (j))
#define XB_XSUB(j)  (1280 + 64 * (j))
#define XB_XGEN(j)  (2304 + 64 * (j))
#define XB_TOP      3328
#define XB_TOPGEN   3392
#define XCD_BAR_WORDS 3456
#define XB_SPIN_CAP (1u << 22)

__device__ __forceinline__ unsigned xb_ld(unsigned* p)              { return __hip_atomic_load(p, __ATOMIC_RELAXED, __HIP_MEMORY_SCOPE_AGENT); }
__device__ __forceinline__ unsigned xb_add(unsigned* p, unsigned v) { return __hip_atomic_fetch_add(p, v, __ATOMIC_RELAXED, __HIP_MEMORY_SCOPE_AGENT); }
__device__ __forceinline__ unsigned xb_xcc_id() { return (unsigned)__builtin_amdgcn_s_getreg((3 << 11) | 20) & 0xFu; }
#define XB_SPIN(cond, bar) do { unsigned _sp = 0; while (cond) { __builtin_amdgcn_s_sleep(1); \
    if ((++_sp & 255u) == 0u) { if (xb_ld(&(bar)[XB_TMO])) break; if (_sp > XB_SPIN_CAP) { atomicAdd(&(bar)[XB_TMO], 1u); break; } } } } while (0)

struct XcdBarrier { unsigned* bar; unsigned x; volatile LAS unsigned* st; };

__device__ __forceinline__ XcdBarrier xcd_barrier_post(unsigned* bar, volatile LAS unsigned* st) {
    XcdBarrier b; b.bar = bar; b.x = (unsigned)__builtin_amdgcn_readfirstlane((int)xb_xcc_id()); b.st = st;
    if (threadIdx.x == 0) (void)xb_add(&bar[XB_XCNT(b.x)], 1u);
    return b;
}
__device__ __forceinline__ void xcd_barrier_complete(unsigned* bar, unsigned x, unsigned& nloc, unsigned& nx) {
    const unsigned G = gridDim.x * gridDim.y * gridDim.z;
    unsigned sum, cnt, mine, sp = 0u;
    for (;;) {
        sum = 0u; cnt = 0u; mine = 0u;
#pragma unroll
        for (unsigned j = 0; j < 16; ++j) { const unsigned c = xb_ld(&bar[XB_XCNT(j)]); sum += c; cnt += (c > 0u) ? 1u : 0u; mine = (j == x) ? c : mine; }
        if (sum == G) break;
        __builtin_amdgcn_s_sleep(1);
        if ((++sp & 255u) == 0u) { if (xb_ld(&bar[XB_TMO])) break; if (sp > XB_SPIN_CAP) { atomicAdd(&bar[XB_TMO], 1u); break; } }
    }
    nloc = mine > 0u ? mine : 1u; nx = cnt > 0u ? cnt : 1u;
}
__device__ __forceinline__ void xcd_barrier(const XcdBarrier& b) {
    asm volatile("s_waitcnt vmcnt(0)" ::: "memory");
    __syncthreads();
    if (threadIdx.x == 0) {
        unsigned* bar = b.bar;
        unsigned bx = b.x; asm volatile("" : "+s"(bx));
        __builtin_amdgcn_s_waitcnt(0);
        unsigned nloc = b.st[0], nx = b.st[1];
        if (nloc == 0u) { xcd_barrier_complete(bar, bx, nloc, nx); b.st[0] = nloc; b.st[1] = nx; }
        const unsigned old = xb_add(&bar[XB_XSUB(bx)], 1u);
        const unsigned gen = old / nloc;
        if (old + 1u == (gen + 1u) * nloc) {
            __builtin_amdgcn_fence(__ATOMIC_RELEASE, "agent");
            asm volatile("s_waitcnt vmcnt(0)" ::: "memory");
            const unsigned og = xb_add(&bar[XB_TOP], 1u);
            const unsigned tg = og / nx;
            if (og + 1u == (tg + 1u) * nx) xb_add(&bar[XB_TOPGEN], 1u);
            else XB_SPIN(xb_ld(&bar[XB_TOPGEN]) == tg, bar);
            __builtin_amdgcn_fence(__ATOMIC_ACQUIRE, "agent");
            xb_add(&bar[XB_XGEN(bx)], 1u);
            asm volatile("s_waitcnt vmcnt(0)" ::: "memory");
        } else {
            XB_SPIN(xb_ld(&bar[XB_XGEN(bx)]) == gen, bar);
            __builtin_amdgcn_fence(__ATOMIC_ACQUIRE, "agent");
            asm volatile("s_waitcnt vmcnt(0)" ::: "memory");
        }
    }
    __syncthreads();
}

__device__ __forceinline__ float wave_sum(float v) {
#pragma unroll
    for (int o = 1; o < 64; o <<= 1) v += __shfl_xor(v, o);
    return v;
}
__device__ __forceinline__ float wave_max(float v) {
#pragma unroll
    for (int o = 1; o < 64; o <<= 1) v = fmaxf(v, __shfl_xor(v, o));
    return v;
}
__device__ __forceinline__ int wave_sum_i(int v) {
#pragma unroll
    for (int o = 1; o < 64; o <<= 1) v += __shfl_xor(v, o);
    return v;
}

template <class Src>
__device__ __forceinline__ void cvt_item(const Src& src, bf16* WT, int K, int k0, int n0, LAS float* scr, int lane) {
#pragma unroll 8
    for (int i = 0; i < 32; ++i) { const int kk = 2 * i + (lane >> 5); scr[kk * 33 + (lane & 31)] = src(k0 + kk, n0 + (lane & 31)); }
    LDS_WAIT(); asm volatile("" ::: "memory");
    const int c = lane & 7;
#pragma unroll
    for (int j = 0; j < 4; ++j) { const int n = (lane >> 3) + 8 * j; const LAS float* s = scr + (8 * c) * 33 + n;
        v4u o; o.x = pk2(s[0 * 33], s[1 * 33]); o.y = pk2(s[2 * 33], s[3 * 33]); o.z = pk2(s[4 * 33], s[5 * 33]); o.w = pk2(s[6 * 33], s[7 * 33]);
        *(GAS v4u*)(WT + (size_t)(n0 + n) * K + k0 + 8 * c) = o; }
    LDS_WAIT(); asm volatile("" ::: "memory");
}

struct Args { const float* in[22]; float* out; unsigned char* ws; };

using pg8::Unit; using pg8::cvt_pk_bf16;
__device__ __forceinline__ void st_bf16x8(bf16* p, f32x4 v0, f32x4 v1) {
    v4u w; w.x = cvt_pk_bf16(v0[0], v0[1]); w.y = cvt_pk_bf16(v0[2], v0[3]); w.z = cvt_pk_bf16(v1[0], v1[1]); w.w = cvt_pk_bf16(v1[2], v1[3]);
    *(v4u*)p = w;
}
__device__ __forceinline__ void st_f32x8(float* p, f32x4 v0, f32x4 v1) { *(f32x4*)p = v0; *(f32x4*)(p + 4) = v1; }
__device__ __forceinline__ f32x4 sigm4(f32x4 v) { return (f32x4){sigm(v[0]), sigm(v[1]), sigm(v[2]), sigm(v[3])}; }
__device__ __forceinline__ f32x4 silu4(f32x4 v) { return (f32x4){v[0] * sigm(v[0]), v[1] * sigm(v[1]), v[2] * sigm(v[2]), v[3] * sigm(v[3])}; }
__device__ __forceinline__ f32x4 ldbf4(const bf16* p) { const v2u w = *(const v2u*)p; return (f32x4){bflo(w.x), bfhi(w.x), bflo(w.y), bfhi(w.y)}; }

#define EPI_LOOP(...) \
    _Pragma("unroll") for (int ai = 0; ai < 2; ++ai) _Pragma("unroll") for (int m = 0; m < 4; ++m) { const int row = row0 + ai * 128 + m * 16; \
        _Pragma("unroll") for (int bj = 0; bj < 2; ++bj) { const int col = colb + bj * 128; const f32x4 v0 = acc[ai][bj][m][0], v1 = acc[ai][bj][m][1]; __VA_ARGS__ } }

struct EpiProj {
    bf16* QA; float* FA; bf16* IA; bf16* GA; float* LAT; bf16* GTA; bf16* GTB;
    __device__ __forceinline__ void operator()(const f32x4 (&acc)[2][2][4][2], const Unit& u, int wr, int wc, int fr, int fq) const {
        const int row0 = u.pm * 256 + wr * 64 + fr, pn = u.pn; const int colb = (pn & 3) * 256 + wc * 32 + 8 * fq;
        if (pn < 4)       { EPI_LOOP( st_bf16x8(QA + (size_t)row * 1024 + col, v0, v1); ) }
        else if (pn < 8)  { EPI_LOOP( st_f32x8(FA + (size_t)row * 1024 + col, v0, v1); ) }
        else if (pn < 12) { EPI_LOOP( st_bf16x8(IA + (size_t)row * 1024 + col, v0, v1); ) }
        else if (pn < 16) { EPI_LOOP( st_bf16x8(GA + (size_t)row * 1024 + col, silu4(v0), silu4(v1)); ) }
        else if (pn < 20) { EPI_LOOP( st_f32x8(LAT + (size_t)row * 1024 + col, v0, v1); ) }
        else { bf16* G = pn < 28 ? GTA : GTB; const int cb2 = ((pn - 20) & 7) * 256 + wc * 32 + 8 * fq;
            _Pragma("unroll") for (int ai = 0; ai < 2; ++ai) _Pragma("unroll") for (int m = 0; m < 4; ++m) { const int row = row0 + ai * 128 + m * 16;
                _Pragma("unroll") for (int bj = 0; bj < 2; ++bj) st_bf16x8(G + (size_t)row * 2048 + cb2 + bj * 128, sigm4(acc[ai][bj][m][0]), sigm4(acc[ai][bj][m][1])); } }
    }
};
struct EpiQ {
    bf16* QB; bf16* QIDX;
    __device__ __forceinline__ void operator()(const f32x4 (&acc)[2][2][4][2], const Unit& u, int wr, int wc, int fr, int fq) const {
        const int row0 = u.pm * 256 + wr * 64 + fr, pn = u.pn;
        if (pn < 16) { const int colb = pn * 256 + wc * 32 + 8 * fq; EPI_LOOP( st_bf16x8(QB + (size_t)row * 4096 + col, v0, v1); ) }
        else { const int colb = (pn - 16) * 256 + wc * 32 + 8 * fq; EPI_LOOP( st_bf16x8(QIDX + (size_t)row * 1024 + col, v0, v1); ) }
    }
};
struct EpiBf {
    bf16* O; int ldc; int coff;
    __device__ __forceinline__ void operator()(const f32x4 (&acc)[2][2][4][2], const Unit& u, int wr, int wc, int fr, int fq) const {
        const int row0 = u.pm * 256 + wr * 64 + fr; const int colb = coff + u.pn * 256 + wc * 32 + 8 * fq;
        EPI_LOOP( st_bf16x8(O + (size_t)row * ldc + col, v0, v1); )
    }
};
struct EpiGateA {
    float* T1; const bf16* GT;
    __device__ __forceinline__ void operator()(const f32x4 (&acc)[2][2][4][2], const Unit& u, int wr, int wc, int fr, int fq) const {
        const int row0 = u.pm * 256 + wr * 64 + fr; const int colb = u.pn * 256 + wc * 32 + 8 * fq;
        EPI_LOOP( const size_t o = (size_t)row * 2048 + col; const f32x4 g0 = ldbf4(GT + o), g1 = ldbf4(GT + o + 4); st_f32x8(T1 + o, v0 * g0, v1 * g1); )
    }
};
struct EpiGateB {
    const float* T1; const bf16* GT; bf16* MRG;
    __device__ __forceinline__ void operator()(const f32x4 (&acc)[2][2][4][2], const Unit& u, int wr, int wc, int fr, int fq) const {
        const int row0 = u.pm * 256 + wr * 64 + fr; const int colb = u.pn * 256 + wc * 32 + 8 * fq;
        EPI_LOOP( const size_t o = (size_t)row * 2048 + col; const f32x4 g0 = ldbf4(GT + o), g1 = ldbf4(GT + o + 4); const f32x4 t0 = *(const f32x4*)(T1 + o), t1 = *(const f32x4*)(T1 + o + 4);
                  st_bf16x8(MRG + o, t0 + v0 * g0, t1 + v1 * g1); )
    }
};
struct EpiRes {
    const float* X; float* R; const float* gt;
    __device__ __forceinline__ void operator()(const f32x4 (&acc)[2][2][4][2], const Unit& u, int wr, int wc, int fr, int fq) const {
        const int row0 = u.pm * 256 + wr * 64 + fr; const int colb = u.pn * 256 + wc * 32 + 8 * fq; const float* g = gt + (size_t)(u.pm >> 4) * MODW;
        EPI_LOOP( const size_t o = (size_t)row * 2048 + col; const f32x4 x0 = *(const f32x4*)(X + o), x1 = *(const f32x4*)(X + o + 4); const f32x4 g0 = *(const f32x4*)(g + col), g1 = *(const f32x4*)(g + col + 4);
                  st_f32x8(R + o, x0 * ALPHA + (g0 + 1.f) * v0, x1 * ALPHA + (g1 + 1.f) * v1); )
    }
};
struct EpiSwiglu {
    bf16* ACT;
    __device__ __forceinline__ void operator()(const f32x4 (&acc)[2][2][4][2], const Unit& u, int wr, int wc, int fr, int fq) const {
        const int row0 = u.pm * 256 + wr * 64 + fr; const int col = u.pn * 128 + wc * 32 + 8 * fq;
#pragma unroll
        for (int ai = 0; ai < 2; ++ai)
#pragma unroll
            for (int m = 0; m < 4; ++m) { const int row = row0 + ai * 128 + m * 16;
                st_bf16x8(ACT + (size_t)row * DFF + col, silu4(acc[ai][0][m][0]) * acc[ai][1][m][0], silu4(acc[ai][0][m][1]) * acc[ai][1][m][1]); }
    }
};

__global__ void __launch_bounds__(NTHR, 2) fwd_kernel(Args args) {
    extern __shared__ __attribute__((aligned(16))) unsigned char lds_raw[];
    LAS unsigned char* lds = (LAS unsigned char*)lds_raw;
    const int G = gridDim.x, blk = blockIdx.x;
    const int NGW = G * NWAVES, NT = G * NTHR;
    unsigned char* ws = args.ws;
    gu32* ctl = (gu32*)(ws + WS_CTL);
    for (int u = threadIdx.x; u < (LDS_BYTES - LDSCTL_OFF) / 4; u += NTHR) ((LAS unsigned*)(lds + LDSCTL_OFF))[u] = 0u;
    __syncthreads();
    volatile LAS unsigned* MISC = (volatile LAS unsigned*)(lds + MISC_OFF);
    XcdBarrier bar = xcd_barrier_post((unsigned*)(ctl + CW_BAR), MISC + 8);
#define GRID_BAR() xcd_barrier(bar)

#define x_in      (args.in[0])
#define c_in      (args.in[1])
#define w_ada     (args.in[2])
#define b_ada     (args.in[3])
#define w_in      (args.in[4])
#define lb_logits (args.in[5])
#define g_hg      (args.in[6])
#define w_pa      (args.in[7])
#define g_cq      (args.in[8])
#define g_ckv     (args.in[9])
#define w_uq      (args.in[10])
#define w_iq      (args.in[11])
#define w_uv      (args.in[12])
#define w_pb      (args.in[13])
#define w_out     (args.in[14])
#define ln1_g     (args.in[15])
#define ln1_b     (args.in[16])
#define w_gate    (args.in[17])
#define w_up      (args.in[18])
#define w_down    (args.in[19])
#define ln2_g     (args.in[20])
#define ln2_b     (args.in[21])
#define MOD  ((float*)(ws + WS_MOD))
#define LB   ((float*)(ws + WS_LB))
#define MODP ((float*)(ws + WS_MODP))
#define W1   ((bf16*)(ws + WS_W1))
#define W3   ((bf16*)(ws + WS_W3))
#define W6   ((bf16*)(ws + WS_W6))
#define W7   ((bf16*)(ws + WS_W7))
#define W8   ((bf16*)(ws + WS_W8))
#define W10  ((bf16*)(ws + WS_W10))
#define W11  ((bf16*)(ws + WS_W11))
#define XB   ((float*)(ws + WS_X))
#define RB   ((float*)(ws + WS_R))
#define HB   ((bf16*)(ws + WS_H))
#define QA   ((bf16*)(ws + WS_QA))
#define FA   ((float*)(ws + WS_FA))
#define IA   ((bf16*)(ws + WS_IA))
#define GA   ((bf16*)(ws + WS_GA))
#define LAT  ((float*)(ws + WS_LAT))
#define GTA  ((bf16*)(ws + WS_GTA))
#define GTB  ((bf16*)(ws + WS_GTB))
#define CQN  ((bf16*)(ws + WS_CQN))
#define CKV  ((bf16*)(ws + WS_CKV))
#define KIDX ((bf16*)(ws + WS_KIDX))
#define IDXW ((float*)(ws + WS_IDXW))
#define QB   ((bf16*)(ws + WS_QB))
#define QIDX ((bf16*)(ws + WS_QIDX))
#define SEL  ((unsigned short*)(ws + WS_SEL))
#define YAB  ((bf16*)(ws + WS_YAB))
#define MRG  ((bf16*)(ws + WS_MRG))
#define ISC  ((float*)(ws + WS_BIG))
#define OP   ((float*)(ws + WS_BIG))
#define ACT  ((bf16*)(ws + WS_BIG))
#define KK   LAT
#define PHASE_BEGIN { int tid = threadIdx.x; asm volatile("" : "+v"(tid)); const int lane = tid & 63, wave = __builtin_amdgcn_readfirstlane(tid >> 6); \
        const int gw = blk * NWAVES + wave, gtid = blk * NTHR + tid; LAS float* wscr = (LAS float*)(lds + wave * 16384); (void)lane; (void)gw; (void)gtid; (void)wscr;
#define PHASE_END }

#define CONVERT_LAYER(L) do { const int l_ = (L); \
        const float* s_in = w_in + (size_t)l_ * DM * 9040; const float* s_uq = w_uq + (size_t)l_ * SAR * 4096; const float* s_iq = w_iq + (size_t)l_ * SAR * 1024; \
        const float* s_uv = w_uv + (size_t)l_ * 16 * 256 * 64; const float* s_pa = w_pa + (size_t)l_ * 1024 * DM; const float* s_pb = w_pb + (size_t)l_ * 1024 * DM; \
        const float* s_out = w_out + (size_t)l_ * DM * DM; const float* s_g = w_gate + (size_t)l_ * DM * DFF; const float* s_u = w_up + (size_t)l_ * DM * DFF; const float* s_d = w_down + (size_t)l_ * DFF * DM; \
        constexpr int I1 = (DM / 64) * (N1 / 32), I3 = (SAR / 64) * (N3 / 32), I6 = (1024 / 64) * (1024 / 32), I7 = (DM / 64) * (DM / 32), I8 = I7, I10 = (DM / 64) * (N10 / 32), I11 = (DFF / 64) * (DM / 32); \
        constexpr int NIT = I1 + I3 + I6 + I7 + I8 + I10 + I11; \
        for (int it = gw; it < NIT; it += NGW) { int r = it; \
            if (r < I1) { const int nb = N1 / 32, k0 = (r / nb) * 64, n0 = (r % nb) * 32; \
                cvt_item([=](int k, int n) -> float { return n < 4944 ? s_in[(size_t)k * 9040 + n] : (n < 5120 ? 0.f : s_in[(size_t)k * 9040 + n - 176]); }, W1, DM, k0, n0, wscr, lane); continue; } r -= I1; \
            if (r < I3) { const int nb = N3 / 32, k0 = (r / nb) * 64, n0 = (r % nb) * 32; \
                cvt_item([=](int k, int n) -> float { return n < 4096 ? s_uq[(size_t)k * 4096 + n] * 0.0625f : s_iq[(size_t)k * 1024 + n - 4096]; }, W3, SAR, k0, n0, wscr, lane); continue; } r -= I3; \
            if (r < I6) { const int nb = 1024 / 32, k0 = (r / nb) * 64, n0 = (r % nb) * 32; \
                cvt_item([=](int k, int n) -> float { const int h = n >> 6, v = n & 63, kk = k >> 8, c = k & 255; return kk == (h & 3) ? s_uv[((size_t)h * 256 + c) * 64 + v] : 0.f; }, W6, 1024, k0, n0, wscr, lane); continue; } r -= I6; \
            if (r < I7) { const int nb = DM / 32, k0 = (r / nb) * 64, n0 = (r % nb) * 32; \
                cvt_item([=](int k, int n) -> float { return k < 1024 ? s_pa[(size_t)k * DM + n] : s_pb[(size_t)(k - 1024) * DM + n]; }, W7, DM, k0, n0, wscr, lane); continue; } r -= I7; \
            if (r < I8) { const int nb = DM / 32, k0 = (r / nb) * 64, n0 = (r % nb) * 32; \
                cvt_item([=](int k, int n) -> float { return s_out[(size_t)k * DM + n]; }, W8, DM, k0, n0, wscr, lane); continue; } r -= I8; \
            if (r < I10) { const int nb = N10 / 32, k0 = (r / nb) * 64, n0 = (r % nb) * 32; \
                cvt_item([=](int k, int n) -> float { const int pn = n >> 8, rr = n & 255; return rr < 128 ? s_g[(size_t)k * DFF + pn * 128 + rr] : s_u[(size_t)k * DFF + pn * 128 + rr - 128]; }, W10, DM, k0, n0, wscr, lane); continue; } r -= I10; \
            { const int nb = DM / 32, k0 = (r / nb) * 64, n0 = (r % nb) * 32; \
                cvt_item([=](int k, int n) -> float { return s_d[(size_t)k * DM + n]; }, W11, DFF, k0, n0, wscr, lane); } \
        } } while (0)


#ifndef DBG_CUT
#define DBG_CUT 0
#endif
#define DBG_DUMP(N, EXPR) do { if (DBG_CUT == (N)) { GRID_BAR(); for (size_t i_ = (size_t)blockIdx.x * NTHR + threadIdx.x; i_ < (size_t)M * DM; i_ += (size_t)NT) { const size_t row_ = i_ / DM, col_ = i_ % DM; (void)row_; (void)col_; args.out[i_] = (EXPR); } return; } } while (0)
    PHASE_BEGIN
    {
        LAS float* sc = (LAS float*)lds;
        for (int i = tid; i < NBATCH * DM; i += NTHR) { const float v = c_in[i]; sc[i] = v * sigm(v); }
        __syncthreads();
        for (int item = gtid; item < 8 * 12288; item += NT) {
            const int ks = item / 12288, cg = item % 12288, l = cg / 3072, n4 = (cg % 3072) * 4;
            const float* wp = w_ada + ((size_t)l * DM + ks * 256) * MODW + n4;
            f32x4 a0 = {0.f, 0.f, 0.f, 0.f}, a1 = a0, a2 = a0, a3 = a0;
#pragma unroll 8
            for (int k = 0; k < 256; ++k) { const f32x4 w = *(const f32x4*)(wp + (size_t)k * MODW); const int kk = ks * 256 + k;
                a0 += w * sc[kk]; a1 += w * sc[2048 + kk]; a2 += w * sc[4096 + kk]; a3 += w * sc[6144 + kk]; }
            float* o = MODP + ((size_t)(ks * 4 + l) * 4) * MODW + n4;
            *(f32x4*)(o) = a0; *(f32x4*)(o + MODW) = a1; *(f32x4*)(o + 2 * MODW) = a2; *(f32x4*)(o + 3 * MODW) = a3;
        }
        if (gtid < 1024) {
            const float a = lb_logits[gtid], b = lb_logits[1024 + gtid], c = lb_logits[2048 + gtid], d = lb_logits[3072 + gtid];
            const float mx = fmaxf(fmaxf(a, b), fmaxf(c, d)); const float ea = expf(a - mx), eb = expf(b - mx), ec = expf(c - mx), ed = expf(d - mx); const float inv = 1.f / (ea + eb + ec + ed);
            LB[gtid] = 0.f; LB[1024 + gtid] = eb * inv; LB[2048 + gtid] = (eb + ec) * inv; LB[3072 + gtid] = (eb + ec + ed) * inv;
        }
        __syncthreads();
        CONVERT_LAYER(0);
    }
    PHASE_END
    GRID_BAR();
    PHASE_BEGIN
    for (int i = gtid; i < DEPTH * NBATCH * MODW; i += NT) {
        const int l = i / (NBATCH * MODW), r = i % (NBATCH * MODW), b = r / MODW, n = r % MODW;
        float s = b_ada[l * MODW + n];
#pragma unroll
        for (int ks = 0; ks < 8; ++ks) s += MODP[((size_t)(ks * 4 + l) * 4 + b) * MODW + n];
        MOD[i] = s;
    }
    PHASE_END
    GRID_BAR();
    PHASE_BEGIN
    for (size_t i = gtid; i < (size_t)M * DM / 8; i += NT) {
        const size_t e = i * 8; const int row = (int)(e / DM), col = (int)(e % DM), b = row / SEQ;
        const float* md = MOD + (size_t)b * MODW;
        const f32x4 x0 = *(const f32x4*)(x_in + e), x1 = *(const f32x4*)(x_in + e + 4);
        const f32x4 s0 = *(const f32x4*)(md + 2048 + col), s1 = *(const f32x4*)(md + 2048 + col + 4), h0 = *(const f32x4*)(md + col), h1 = *(const f32x4*)(md + col + 4);
        st_bf16x8(HB + e, x0 * (s0 + 1.f) + h0, x1 * (s1 + 1.f) + h1);
    }
    PHASE_END
    GRID_BAR();

    DBG_DUMP(1, bf2f(HB[i_]) + MOD[i_ % (DEPTH * NBATCH * MODW)] + bf2f(W1[i_ % ((size_t)N1 * DM)]) + bf2f(W10[i_ % ((size_t)N10 * DM)]) + bf2f(W11[i_ % ((size_t)DM * DFF)]) + bf2f(W8[i_ % ((size_t)DM * DM)]));
    for (int l = 0; l < DEPTH; ++l) {
        const float* modl = MOD + (size_t)l * NBATCH * MODW;
        const float* xres = (l == 0) ? x_in : XB;
        PHASE_BEGIN
        { pg8::Gemm g{HB, W1, M, N1, DM, DM, DM, 0}; pg8::StaticOrder S; S.init(M, N1, G, blk);
          EpiProj E{QA, FA, IA, GA, LAT, GTA, GTB}; pg8::gemm_phase(lds, g, S, E, tid); }
        PHASE_END
        GRID_BAR();
        DBG_DUMP(2, FA[row_ * 1024 + (col_ & 1023)] + LAT[row_ * 1024 + (col_ & 1023)] + bf2f(QA[row_ * 1024 + (col_ & 1023)]) + bf2f(IA[row_ * 1024 + (col_ & 1023)]) + bf2f(GA[row_ * 1024 + (col_ & 1023)]) + bf2f(GTA[i_]) + bf2f(GTB[i_]));
        PHASE_BEGIN
        for (int row = gw; row < M; row += NGW) {
            const float* lr = LAT + (size_t)row * 1024;
            const f32x4 a0 = *(const f32x4*)(lr + 4 * lane), a1 = *(const f32x4*)(lr + 256 + 4 * lane), kv = *(const f32x4*)(lr + 512 + 4 * lane);
            const float ki = lr[768 + lane]; const float iw = lr[832 + (lane & 15)];
            float sq = a0[0] * a0[0] + a0[1] * a0[1] + a0[2] * a0[2] + a0[3] * a0[3] + a1[0] * a1[0] + a1[1] * a1[1] + a1[2] * a1[2] + a1[3] * a1[3];
            float sk = kv[0] * kv[0] + kv[1] * kv[1] + kv[2] * kv[2] + kv[3] * kv[3];
            sq = wave_sum(sq); sk = wave_sum(sk);
            const float rq = 1.0f / sqrtf(sq * (1.f / 512.f) + 1e-6f), rk = 1.0f / sqrtf(sk * (1.f / 256.f) + 1e-6f);
            const f32x4 g0 = *(const f32x4*)(g_cq + l * 512 + 4 * lane), g1 = *(const f32x4*)(g_cq + l * 512 + 256 + 4 * lane), gk = *(const f32x4*)(g_ckv + l * 256 + 4 * lane);
            v2u o; f32x4 t = a0 * rq * g0; o.x = pk2(t[0], t[1]); o.y = pk2(t[2], t[3]); *(v2u*)(CQN + (size_t)row * 512 + 4 * lane) = o;
            t = a1 * rq * g1; o.x = pk2(t[0], t[1]); o.y = pk2(t[2], t[3]); *(v2u*)(CQN + (size_t)row * 512 + 256 + 4 * lane) = o;
            t = kv * rk * gk; o.x = pk2(t[0], t[1]); o.y = pk2(t[2], t[3]); *(v2u*)(CKV + (size_t)row * 256 + 4 * lane) = o;
            KIDX[(size_t)row * 64 + lane] = (bf16)f2bf(ki);
            if (lane < 16) IDXW[(size_t)row * 16 + lane] = iw * 0.03125f;
        }
        PHASE_END
        GRID_BAR();
        PHASE_BEGIN
        for (size_t i = gtid; i < (size_t)M * HGW / 4; i += NT) {
            const size_t e = i * 4; const int ch = (int)(e & 1023);
            const f32x4 fa = *(const f32x4*)(FA + e); const f32x4 lb = *(const f32x4*)(LB + l * 1024 + ch);
            f32x4 f, k;
#pragma unroll
            for (int j = 0; j < 4; ++j) { const float s = sigm(fa[j]); f[j] = fminf(fmaxf(lb[j] + (1.f - lb[j]) * s, 1e-6f), 1.0f); k[j] = (1.f - lb[j]) * sigm(-fa[j]); }
            *(f32x4*)(FA + e) = f; *(f32x4*)(KK + e) = k;
        }
        PHASE_END
        GRID_BAR();
        PHASE_BEGIN
        if (wave == 0) {
            for (int u = blk; u < 256; u += G) {
                const int b = u >> 6, h = (u >> 3) & 7, ks = (u >> 1) & 3, vh = u & 1;
                float S[32];
#pragma unroll
                for (int j = 0; j < 32; ++j) S[j] = 0.f;
                const size_t base = (size_t)b * SEQ * 1024 + h * 128;
                const float* fp = FA + base + ks * 32; const float* kp = KK + base + ks * 32; const bf16* qp = QA + base + ks * 32;
                const bf16* vp = IA + base + vh * 64 + lane;
                float* op = OP + ((size_t)ks * M) * 1024 + base + vh * 64 + lane;
                for (int t = 0; t < SEQ; ++t) {
                    const float v = bf2f(vp[(size_t)t * 1024]);
                    float o = 0.f;
#pragma unroll
                    for (int j4 = 0; j4 < 8; ++j4) {
                        const f32x4 f = *(const f32x4*)(fp + (size_t)t * 1024 + j4 * 4), k = *(const f32x4*)(kp + (size_t)t * 1024 + j4 * 4); const v2u qw = *(const v2u*)(qp + (size_t)t * 1024 + j4 * 4);
                        const float q0 = bflo(qw.x), q1 = bfhi(qw.x), q2 = bflo(qw.y), q3 = bfhi(qw.y);
                        S[j4 * 4 + 0] = S[j4 * 4 + 0] * f[0] + k[0] * v; o += S[j4 * 4 + 0] * q0;
                        S[j4 * 4 + 1] = S[j4 * 4 + 1] * f[1] + k[1] * v; o += S[j4 * 4 + 1] * q1;
                        S[j4 * 4 + 2] = S[j4 * 4 + 2] * f[2] + k[2] * v; o += S[j4 * 4 + 2] * q2;
                        S[j4 * 4 + 3] = S[j4 * 4 + 3] * f[3] + k[3] * v; o += S[j4 * 4 + 3] * q3;
                    }
                    op[(size_t)t * 1024] = o;
                }
            }
        }
        PHASE_END
        GRID_BAR();
        PHASE_BEGIN
        for (int row = gw; row < M; row += NGW) {
            f32x4 o[4];
#pragma unroll
            for (int j = 0; j < 4; ++j) { o[j] = (f32x4){0.f, 0.f, 0.f, 0.f};
#pragma unroll
                for (int ks = 0; ks < 4; ++ks) o[j] += *(const f32x4*)(OP + ((size_t)ks * M + row) * 1024 + lane * 16 + j * 4); }
            float ss = 0.f;
#pragma unroll
            for (int j = 0; j < 4; ++j) ss += o[j][0] * o[j][0] + o[j][1] * o[j][1] + o[j][2] * o[j][2] + o[j][3] * o[j][3];
            ss += __shfl_xor(ss, 1); ss += __shfl_xor(ss, 2); ss += __shfl_xor(ss, 4);
            const float rn = 1.0f / sqrtf(ss * (1.f / 128.f) + 1e-6f);
#pragma unroll
            for (int j = 0; j < 4; ++j) { const int c = lane * 16 + j * 4; const f32x4 gg = *(const f32x4*)(g_hg + l * 1024 + c); const f32x4 ga = ldbf4(GA + (size_t)row * 1024 + c);
                const f32x4 y = o[j] * rn * gg * ga; v2u w; w.x = pk2(y[0], y[1]); w.y = pk2(y[2], y[3]); *(v2u*)(YAB + (size_t)row * 2048 + c) = w; }
        }
        PHASE_END
        GRID_BAR();
        DBG_DUMP(3, bf2f(YAB[row_ * 2048 + (col_ & 1023)]) + bf2f(CQN[row_ * 512 + (col_ & 511)]) + bf2f(CKV[row_ * 256 + (col_ & 255)]) + bf2f(KIDX[row_ * 64 + (col_ & 63)]) + IDXW[row_ * 16 + (col_ & 15)] + bf2f(GTA[i_]) + bf2f(GTB[i_]));
        PHASE_BEGIN
        { pg8::Gemm g{CQN, W3, M, N3, SAR, SAR, SAR, 0}; pg8::StaticOrder S; S.init(M, N3, G, blk);
          EpiQ E{QB, QIDX}; pg8::gemm_phase(lds, g, S, E, tid); }
        PHASE_END
        GRID_BAR();
        PHASE_BEGIN
        for (int q = gw; q < M; q += NGW) {
            const int b = q / SEQ, pos = q % SEQ, nadm = ((pos >> 6) + 1) * 64;
            {   const v4u w0 = *(const v4u*)(QIDX + (size_t)q * 1024 + lane * 16), w1 = *(const v4u*)(QIDX + (size_t)q * 1024 + lane * 16 + 8);
                LAS f32x4* d = (LAS f32x4*)(wscr + lane * 16);
                d[0] = (f32x4){bflo(w0.x), bfhi(w0.x), bflo(w0.y), bfhi(w0.y)}; d[1] = (f32x4){bflo(w0.z), bfhi(w0.z), bflo(w0.w), bfhi(w0.w)};
                d[2] = (f32x4){bflo(w1.x), bfhi(w1.x), bflo(w1.y), bfhi(w1.y)}; d[3] = (f32x4){bflo(w1.z), bfhi(w1.z), bflo(w1.w), bfhi(w1.w)};
                if (lane < 16) wscr[1024 + lane] = IDXW[(size_t)q * 16 + lane]; }
            LDS_WAIT(); asm volatile("" ::: "memory");
            for (int s0 = 0; s0 < nadm; s0 += 64) {
                const int s = s0 + lane; const bf16* kr = KIDX + ((size_t)b * SEQ + s) * 64;
                float kf[64];
#pragma unroll
                for (int j = 0; j < 8; ++j) { const v4u w = *(const v4u*)(kr + j * 8); kf[j * 8 + 0] = bflo(w.x); kf[j * 8 + 1] = bfhi(w.x); kf[j * 8 + 2] = bflo(w.y); kf[j * 8 + 3] = bfhi(w.y);
                    kf[j * 8 + 4] = bflo(w.z); kf[j * 8 + 5] = bfhi(w.z); kf[j * 8 + 6] = bflo(w.w); kf[j * 8 + 7] = bfhi(w.w); }
                float sc = 0.f;
#pragma unroll 1
                for (int h = 0; h < 16; ++h) { float d = 0.f;
#pragma unroll
                    for (int dd = 0; dd < 64; dd += 4) { const f32x4 qv = *(const LAS f32x4*)(wscr + h * 64 + dd); d += kf[dd] * qv[0] + kf[dd + 1] * qv[1] + kf[dd + 2] * qv[2] + kf[dd + 3] * qv[3]; }
                    sc += wscr[1024 + h] * fmaxf(d, 0.f); }
                ISC[(size_t)q * 4096 + s] = sc;
            }
            LDS_WAIT(); asm volatile("" ::: "memory");
        }
        PHASE_END
        GRID_BAR();
        PHASE_BEGIN
        for (int q = gw; q < M; q += NGW) {
            const int pos = q % SEQ, qc = pos >> 6, nadm = (qc + 1) * 64; unsigned short* so = SEL + (size_t)q * 256;
            if (qc < 4) { for (int j = lane; j < nadm; j += 64) so[j] = (unsigned short)j; continue; }
            unsigned key[64]; const int nblk = nadm >> 6;
#pragma unroll
            for (int i = 0; i < 64; ++i) { unsigned k = 0u; if (i < nblk) { const unsigned u = __builtin_bit_cast(unsigned, ISC[(size_t)q * 4096 + i * 64 + lane]); k = (u & 0x80000000u) ? ~u : (u | 0x80000000u); } key[i] = k; }
            unsigned T = 0u;
            for (int bit = 31; bit >= 0; --bit) { const unsigned cand = T | (1u << bit); int cnt = 0;
#pragma unroll
                for (int i = 0; i < 64; ++i) cnt += (key[i] >= cand) ? 1 : 0;
                cnt = wave_sum_i(cnt); if (cnt >= 256) T = cand; }
            int base = 0;
#pragma unroll
            for (int i = 0; i < 64; ++i) { const bool f = key[i] > T; const unsigned long long bm = __ballot(f); const int p = base + __popcll(bm & ((1ull << lane) - 1ull));
                if (f) so[p] = (unsigned short)(i * 64 + lane); base += __popcll(bm); }
#pragma unroll
            for (int i = 0; i < 64; ++i) { const bool f = key[i] == T; const unsigned long long bm = __ballot(f); const int p = base + __popcll(bm & ((1ull << lane) - 1ull));
                if (f && p < 256) so[p] = (unsigned short)(i * 64 + lane); base += __popcll(bm); }
        }
        PHASE_END
        GRID_BAR();
        DBG_DUMP(5, (float)SEL[row_ * 256 + (col_ & 255)] * ((row_ & 4095) >= 256 ? 1.f : 0.f) + bf2f(QIDX[row_ * 1024 + (col_ & 1023)]) + bf2f(QB[row_ * 4096 + col_]));
        PHASE_BEGIN
        for (int q = gw; q < M; q += NGW) {
            const int b = q / SEQ, pos = q % SEQ, qc = pos >> 6; const int nsel = qc < 4 ? (qc + 1) * 64 : 256;
            LAS unsigned short* selL = (LAS unsigned short*)(lds + SELL_OFF + wave * 512);
            int myidx[4];
#pragma unroll
            for (int j = 0; j < 4; ++j) { const int slot = j * 64 + lane; const int v = slot < nsel ? (int)SEL[(size_t)q * 256 + slot] : 0; myidx[j] = v; selL[slot] = (unsigned short)v; }
            const bf16* kvb = CKV + (size_t)b * SEQ * 256;
            bf16* qrow = QB + (size_t)q * 4096;
            for (int hp = 0; hp < 2; ++hp) {
                LAS unsigned* qL = (LAS unsigned*)wscr; LAS float* sL = wscr + 1024;
                {   const v4u w0 = *(const v4u*)(qrow + hp * 2048 + lane * 32), w1 = *(const v4u*)(qrow + hp * 2048 + lane * 32 + 8), w2 = *(const v4u*)(qrow + hp * 2048 + lane * 32 + 16), w3 = *(const v4u*)(qrow + hp * 2048 + lane * 32 + 24);
                    LAS v4u* d = (LAS v4u*)(qL + lane * 16); d[0] = w0; d[1] = w1; d[2] = w2; d[3] = w3; }
                LDS_WAIT(); asm volatile("" ::: "memory");
                float mx[8], sm[8];
#pragma unroll
                for (int h = 0; h < 8; ++h) { mx[h] = -3.0e38f; sm[h] = 0.f; }
                for (int j = 0; j < 4; ++j) {
                    const int slot = j * 64 + lane; const int idx = (j == 0) ? myidx[0] : (j == 1) ? myidx[1] : (j == 2) ? myidx[2] : myidx[3];
                    const bf16* kr = kvb + (size_t)idx * 256;
                    float s[8];
#pragma unroll
                    for (int h = 0; h < 8; ++h) s[h] = 0.f;
                    for (int dc = 0; dc < 4; ++dc) {
                        float kf[64];
#pragma unroll
                        for (int jj = 0; jj < 8; ++jj) { const v4u w = *(const v4u*)(kr + dc * 64 + jj * 8); kf[jj * 8 + 0] = bflo(w.x); kf[jj * 8 + 1] = bfhi(w.x); kf[jj * 8 + 2] = bflo(w.y); kf[jj * 8 + 3] = bfhi(w.y);
                            kf[jj * 8 + 4] = bflo(w.z); kf[jj * 8 + 5] = bfhi(w.z); kf[jj * 8 + 6] = bflo(w.w); kf[jj * 8 + 7] = bfhi(w.w); }
#pragma unroll
                        for (int h = 0; h < 8; ++h) {
#pragma unroll
                            for (int dd = 0; dd < 64; dd += 8) { const v4u qw = *(const LAS v4u*)(qL + h * 128 + dc * 32 + dd / 2);
                                s[h] += kf[dd] * bflo(qw.x) + kf[dd + 1] * bfhi(qw.x) + kf[dd + 2] * bflo(qw.y) + kf[dd + 3] * bfhi(qw.y) + kf[dd + 4] * bflo(qw.z) + kf[dd + 5] * bfhi(qw.z) + kf[dd + 6] * bflo(qw.w) + kf[dd + 7] * bfhi(qw.w); } }
                    }
                    const float dist = fabsf((float)(pos - idx)); const bool valid = slot < nsel;
#pragma unroll
                    for (int h = 0; h < 8; ++h) { const float slope = exp2f(-0.5f * (float)(hp * 8 + h + 1)); float v = valid ? s[h] - slope * dist : -1.0e30f; s[h] = v;
                        const float nm = fmaxf(mx[h], v); sm[h] = sm[h] * __expf(mx[h] - nm) + __expf(v - nm); mx[h] = nm; }
                    *(LAS f32x4*)(sL + slot * 8) = (f32x4){s[0], s[1], s[2], s[3]}; *(LAS f32x4*)(sL + slot * 8 + 4) = (f32x4){s[4], s[5], s[6], s[7]};
                }
#pragma unroll
                for (int h = 0; h < 8; ++h) { const float mt = wave_max(mx[h]); const float st = wave_sum(sm[h] * __expf(mx[h] - mt)); mx[h] = mt; sm[h] = 1.0f / st; }
                LDS_WAIT(); asm volatile("" ::: "memory");
                for (int j = 0; j < 4; ++j) { const int slot = j * 64 + lane; f32x4 a = *(LAS f32x4*)(sL + slot * 8), c = *(LAS f32x4*)(sL + slot * 8 + 4);
                    a = (f32x4){__expf(a[0] - mx[0]) * sm[0], __expf(a[1] - mx[1]) * sm[1], __expf(a[2] - mx[2]) * sm[2], __expf(a[3] - mx[3]) * sm[3]};
                    c = (f32x4){__expf(c[0] - mx[4]) * sm[4], __expf(c[1] - mx[5]) * sm[5], __expf(c[2] - mx[6]) * sm[6], __expf(c[3] - mx[7]) * sm[7]};
                    *(LAS f32x4*)(sL + slot * 8) = a; *(LAS f32x4*)(sL + slot * 8 + 4) = c; }
                LDS_WAIT(); asm volatile("" ::: "memory");
                f32x4 oacc[8];
#pragma unroll
                for (int h = 0; h < 8; ++h) oacc[h] = (f32x4){0.f, 0.f, 0.f, 0.f};
                for (int k = 0; k < nsel; ++k) {
                    const int idx = selL[k]; const f32x4 v = ldbf4(kvb + (size_t)idx * 256 + lane * 4);
                    const f32x4 p0 = *(LAS f32x4*)(sL + k * 8), p1 = *(LAS f32x4*)(sL + k * 8 + 4);
                    oacc[0] += v * p0[0]; oacc[1] += v * p0[1]; oacc[2] += v * p0[2]; oacc[3] += v * p0[3];
                    oacc[4] += v * p1[0]; oacc[5] += v * p1[1]; oacc[6] += v * p1[2]; oacc[7] += v * p1[3];
                }
#pragma unroll
                for (int h = 0; h < 8; ++h) { v2u w; w.x = pk2(oacc[h][0], oacc[h][1]); w.y = pk2(oacc[h][2], oacc[h][3]); *(v2u*)(qrow + (hp * 8 + h) * 256 + lane * 4) = w; }
                LDS_WAIT(); asm volatile("" ::: "memory");
            }
        }
        PHASE_END
        GRID_BAR();
        DBG_DUMP(6, bf2f(QB[row_ * 4096 + col_]) + bf2f(QB[row_ * 4096 + 2048 + col_]));
        PHASE_BEGIN
        { pg8::Gemm g{QB, W6, M, 1024, 1024, 4096, 1024, 1024}; pg8::StaticOrder S; S.init(M, 1024, G, blk);
          EpiBf E{YAB, 2048, 1024}; pg8::gemm_phase(lds, g, S, E, tid); }
        PHASE_END
        GRID_BAR();
        PHASE_BEGIN
        { pg8::Gemm g{YAB, W7, M, DM, 1024, 2048, 2048, 0}; pg8::StaticOrder S; S.init(M, DM, G, blk);
          EpiGateA E{RB, GTA}; pg8::gemm_phase(lds, g, S, E, tid); }
        PHASE_END
        GRID_BAR();
        PHASE_BEGIN
        { pg8::Gemm g{YAB + 1024, W7 + 1024, M, DM, 1024, 2048, 2048, 0}; pg8::StaticOrder S; S.init(M, DM, G, blk);
          EpiGateB E{RB, GTB, MRG}; pg8::gemm_phase(lds, g, S, E, tid); }
        PHASE_END
        GRID_BAR();
        PHASE_BEGIN
        { pg8::Gemm g{MRG, W8, M, DM, DM, DM, DM, 0}; pg8::StaticOrder S; S.init(M, DM, G, blk);
          EpiRes E{xres, RB, modl + 2 * DM}; pg8::gemm_phase(lds, g, S, E, tid); }
        PHASE_END
        GRID_BAR();
        PHASE_BEGIN
        for (int row = gw; row < M; row += NGW) {
            const int b = row / SEQ; const float* rr = RB + (size_t)row * DM; const float* md = modl + (size_t)b * MODW;
            f32x4 v[8]; float s = 0.f;
#pragma unroll
            for (int j = 0; j < 8; ++j) { v[j] = *(const f32x4*)(rr + j * 256 + lane * 4); s += (v[j][0] + v[j][1]) + (v[j][2] + v[j][3]); }
            const float mean = wave_sum(s) * (1.f / DM); float s2 = 0.f;
#pragma unroll
            for (int j = 0; j < 8; ++j) { v[j] = v[j] - mean; s2 += (v[j][0] * v[j][0] + v[j][1] * v[j][1]) + (v[j][2] * v[j][2] + v[j][3] * v[j][3]); }
            const float rstd = 1.0f / sqrtf(wave_sum(s2) * (1.f / DM) + 1e-5f);
#pragma unroll
            for (int j = 0; j < 8; ++j) { const int c = j * 256 + lane * 4; const f32x4 gg = *(const f32x4*)(ln1_g + l * DM + c), bb = *(const f32x4*)(ln1_b + l * DM + c);
                const f32x4 y = v[j] * rstd * gg + bb; *(f32x4*)(XB + (size_t)row * DM + c) = y;
                const f32x4 sc = *(const f32x4*)(md + 4 * DM + c), sh = *(const f32x4*)(md + 3 * DM + c); const f32x4 hh = y * (sc + 1.f) + sh;
                v2u w; w.x = pk2(hh[0], hh[1]); w.y = pk2(hh[2], hh[3]); *(v2u*)(HB + (size_t)row * DM + c) = w; }
        }
        PHASE_END
        GRID_BAR();
        DBG_DUMP(7, XB[i_] + bf2f(HB[i_]));
        PHASE_BEGIN
        { pg8::Gemm g{HB, W10, M, N10, DM, DM, DM, 0}; pg8::StaticOrder S; S.init(M, N10, G, blk);
          EpiSwiglu E{ACT}; pg8::gemm_phase(lds, g, S, E, tid); }
        PHASE_END
        GRID_BAR();
        PHASE_BEGIN
        { pg8::Gemm g{ACT, W11, M, DM, DFF, DFF, DFF, 0}; pg8::StaticOrder S; S.init(M, DM, G, blk);
          EpiRes E{XB, RB, modl + 5 * DM}; pg8::gemm_phase(lds, g, S, E, tid); }
        PHASE_END
        GRID_BAR();
        PHASE_BEGIN
        {
            float* xo = (l == DEPTH - 1) ? args.out : XB; const float* mdn = MOD + (size_t)(l + 1 < DEPTH ? l + 1 : l) * NBATCH * MODW;
            for (int row = gw; row < M; row += NGW) {
                const int b = row / SEQ; const float* rr = RB + (size_t)row * DM; const float* md = mdn + (size_t)b * MODW;
                f32x4 v[8]; float s = 0.f;
#pragma unroll
                for (int j = 0; j < 8; ++j) { v[j] = *(const f32x4*)(rr + j * 256 + lane * 4); s += (v[j][0] + v[j][1]) + (v[j][2] + v[j][3]); }
                const float mean = wave_sum(s) * (1.f / DM); float s2 = 0.f;
#pragma unroll
                for (int j = 0; j < 8; ++j) { v[j] = v[j] - mean; s2 += (v[j][0] * v[j][0] + v[j][1] * v[j][1]) + (v[j][2] * v[j][2] + v[j][3] * v[j][3]); }
                const float rstd = 1.0f / sqrtf(wave_sum(s2) * (1.f / DM) + 1e-5f);
#pragma unroll
                for (int j = 0; j < 8; ++j) { const int c = j * 256 + lane * 4; const f32x4 gg = *(const f32x4*)(ln2_g + l * DM + c), bb = *(const f32x4*)(ln2_b + l * DM + c);
                    const f32x4 y = v[j] * rstd * gg + bb; *(f32x4*)(xo + (size_t)row * DM + c) = y;
                    const f32x4 sc = *(const f32x4*)(md + DM + c), sh = *(const f32x4*)(md + c); const f32x4 hh = y * (sc + 1.f) + sh;
                    v2u w; w.x = pk2(hh[0], hh[1]); w.y = pk2(hh[2], hh[3]); *(v2u*)(HB + (size_t)row * DM + c) = w; }
            }
            if (l + 1 < DEPTH) { __syncthreads(); CONVERT_LAYER(l + 1); }
        }
        PHASE_END
        if (l + 1 < DEPTH) GRID_BAR();
    }
}

extern "C" void kernel_launch(void* const* d_in, const int* in_sizes, int n_in, void* d_out, int out_size, void* d_ws, size_t ws_size, hipStream_t stream) {
    static int grid = 0;
    if (grid == 0) {
        if (n_in != 22 || out_size != M * DM || ws_size < WS_END) { fprintf(stderr, "kernel_launch: unexpected shapes (n_in %d, out %d, ws %zu < %zu)\n", n_in, out_size, ws_size, (size_t)WS_END); grid = -1; return; }
        int dev = 0, cus = 0, per_cu = 0;
        if (hipGetDevice(&dev) != hipSuccess || hipDeviceGetAttribute(&cus, hipDeviceAttributeMultiprocessorCount, dev) != hipSuccess) { grid = -1; return; }
        if (hipFuncSetAttribute((const void*)fwd_kernel, hipFuncAttributeMaxDynamicSharedMemorySize, LDS_BYTES) != hipSuccess) { fprintf(stderr, "kernel_launch: hipFuncSetAttribute failed\n"); grid = -1; return; }
        if (hipOccupancyMaxActiveBlocksPerMultiprocessor(&per_cu, (const void*)fwd_kernel, NTHR, LDS_BYTES) != hipSuccess || per_cu < 1) { fprintf(stderr, "kernel_launch: occupancy query says %d\n", per_cu); }
        (void)hipGetLastError();
        grid = cus;
    }
    if (grid < 0) return;
    if (hipMemsetAsync((char*)d_ws + WS_CTL, 0, CTL_ZERO_BYTES, stream) != hipSuccess) return;
    Args a{};
    for (int i = 0; i < 22; ++i) a.in[i] = (const float*)d_in[i];
    a.out = (float*)d_out; a.ws = (unsigned char*)d_ws;
    hipLaunchKernelGGL(fwd_kernel, dim3(grid), dim3(NTHR), LDS_BYTES, stream, a);
}
```

```cpp
#include <hip/hip_runtime.h>
#include <cstdio>
#include <cstdint>

namespace pg8 {
#define PG8_LAS __attribute__((address_space(3)))
typedef unsigned short bf16_t;
typedef short bf16x8 __attribute__((ext_vector_type(8)));
typedef float f32x4 __attribute__((ext_vector_type(4)));
typedef unsigned u32x4 __attribute__((ext_vector_type(4)));
constexpr int BM = 256, BK = 64, HALF = 128, HTB = HALF * BK * 2, STAGE_BYTES = 8 * HTB, NXCD = 8, WGM = 8;

__host__ __device__ __forceinline__ int lds_byte(int r, int c) { const int st = (r >> 4) * 2 + (c >> 5), rr = r & 15, cc = c & 31, ob = rr * 64 + cc * 2; return st * 1024 + (ob ^ (((ob >> 9) & 1) << 5)); }
__host__ __device__ __forceinline__ void stage_rc(int b, int& R, int& C) { const int st = b / 1024, sb = b % 1024, swz = sb ^ (((sb >> 9) & 1) << 5); R = (st >> 1) * 16 + swz / 64; C = (st & 1) * 32 + (swz % 64) / 2; }
__host__ __device__ __forceinline__ int perm32(int rho) { const int n = rho >> 4, i = rho & 15; return 8 * (i >> 2) + 4 * n + (i & 3); }

struct Unit { int pm, pn; };
struct Gemm { const bf16_t* A; const bf16_t* Bt; int M, N, K, lda, ldb, a_pn_stride; };

struct StaticOrder {
    int nM, nN, nwg, G, c;
    __host__ __device__ void init(int M, int N, int G_, int c_) { nM = M / BM; nN = N / BM; nwg = nM * nN; G = G_; c = c_; }
    __host__ __device__ bool next(int i, Unit& u) const {
        const long L = (long)i * G + c; if (L >= nwg) return false;
        int wgid = (int)L; { const int q = nwg / NXCD, r = nwg % NXCD, xcd = wgid % NXCD, off = wgid / NXCD; wgid = (xcd < r ? xcd * (q + 1) : r * (q + 1) + (xcd - r) * q) + off; }
        const int nig = WGM * nN, gid = wgid / nig, fm = gid * WGM, gsz = (nM - fm) < WGM ? (nM - fm) : WGM;
        u.pm = fm + ((wgid % nig) % gsz); u.pn = (wgid % nig) / gsz; return true;
    }
};

typedef float f32x2_t __attribute__((ext_vector_type(2))); typedef __bf16 bf16x2_t __attribute__((ext_vector_type(2)));
__device__ __forceinline__ unsigned cvt_pk_bf16(float lo, float hi) { f32x2_t v = {lo, hi}; bf16x2_t b = __builtin_convertvector(v, bf16x2_t); return __builtin_bit_cast(unsigned, b); }

template <class Epi>
__device__ __forceinline__ void gemm_phase(PG8_LAS unsigned char* lds, const Gemm g, const StaticOrder& S, const Epi& E, const int tid) {
    const int wid = __builtin_amdgcn_readfirstlane(tid >> 6), lane = tid & 63, wr = wid >> 2, wc = wid & 3, fr = lane & 15, fq = lane >> 4;
    const int K = g.K, nt = K / BK;
    unsigned voffA[2], voffB[2];
#pragma unroll
    for (int i = 0; i < 2; ++i) { int R, C; stage_rc(tid * 16 + i * 8192, R, C); const int Rb = (R & ~31) + perm32(R & 31);
        voffA[i] = (unsigned)(R * g.lda + C) * 2u; voffB[i] = (unsigned)(Rb * g.ldb + C) * 2u; }
    const size_t kstep = (size_t)(BK * 2);
    const size_t hstepA = (size_t)HALF * g.lda * 2, hstepB = (size_t)HALF * g.ldb * 2;
    const size_t tstepA = 2 * hstepA, tstepB = 2 * hstepB;
    const unsigned ldsw = (unsigned)wid * 1024u;
    const int aoff = lds_byte(wr * 64 + fr, fq * 8), boff = lds_byte(wc * 32 + fr, fq * 8);
#define PG8_SA(b, h) (((b) * 2 + (h)) * HTB)
#define PG8_SB(b, h) ((4 + (b) * 2 + (h)) * HTB)
#define PG8_STAGE(bufoff, gbase, voff) do { _Pragma("unroll") for (int _i = 0; _i < 2; ++_i) \
        __builtin_amdgcn_global_load_lds((const unsigned*)((const char*)(gbase) + (voff)[_i]), (PG8_LAS unsigned*)(lds + (bufoff) + ldsw + _i * 8192), 16, 0, 0); } while (0)
#define PG8_LDA(dst, b, h) do { _Pragma("unroll") for (int m = 0; m < 4; ++m) _Pragma("unroll") for (int k = 0; k < 2; ++k) dst[m][k] = *(const PG8_LAS bf16x8*)(lds + PG8_SA(b, h) + aoff + m * 2048 + k * 1024); } while (0)
#define PG8_LDB(dst, b, h) do { _Pragma("unroll") for (int n = 0; n < 2; ++n) _Pragma("unroll") for (int k = 0; k < 2; ++k) dst[n][k] = *(const PG8_LAS bf16x8*)(lds + PG8_SB(b, h) + boff + n * 2048 + k * 1024); } while (0)
#define PG8_MMA(ai, bj, At, Bt) do { __builtin_amdgcn_s_setprio(1); _Pragma("unroll") for (int m = 0; m < 4; ++m) _Pragma("unroll") for (int n = 0; n < 2; ++n) _Pragma("unroll") for (int k = 0; k < 2; ++k) \
        acc[ai][bj][m][n] = __builtin_amdgcn_mfma_f32_16x16x32_bf16(Bt[n][k], At[m][k], acc[ai][bj][m][n], 0, 0, 0); __builtin_amdgcn_s_setprio(0); } while (0)
#define PG8_WAIT_V(n) asm volatile("s_waitcnt vmcnt(" #n ")" ::: "memory")
#define PG8_WAIT_L(n) asm volatile("s_waitcnt lgkmcnt(" #n ")" ::: "memory")
#define PG8_BAR __builtin_amdgcn_s_barrier()
#define PG8_SCHED __builtin_amdgcn_sched_barrier(0)
    Unit cur, nxt; int ui = 0;
    if (!S.next(0, cur)) return;
    f32x4 acc[2][2][4][2];
#pragma unroll
    for (int a = 0; a < 2; ++a)
#pragma unroll
        for (int b = 0; b < 2; ++b)
#pragma unroll
            for (int m = 0; m < 4; ++m)
#pragma unroll
                for (int n = 0; n < 2; ++n) acc[a][b][m][n] = (f32x4){0.f, 0.f, 0.f, 0.f};
    bf16x8 At[4][2], B0[2][2], B1[2][2];
    const char* cA = (const char*)g.A + (size_t)cur.pm * tstepA + (size_t)cur.pn * g.a_pn_stride * 2; const char* cB = (const char*)g.Bt + (size_t)cur.pn * tstepB;
    PG8_STAGE(PG8_SB(0, 0), cB, voffB); PG8_STAGE(PG8_SB(0, 1), cB + hstepB, voffB); PG8_STAGE(PG8_SA(0, 0), cA, voffA); PG8_STAGE(PG8_SA(0, 1), cA + hstepA, voffA);
    if (wr == 1) PG8_BAR;
    PG8_WAIT_V(2); PG8_BAR;
    PG8_STAGE(PG8_SB(1, 0), cB + kstep, voffB); PG8_STAGE(PG8_SA(1, 0), cA + kstep, voffA); PG8_STAGE(PG8_SB(1, 1), cB + hstepB + kstep, voffB);
    PG8_WAIT_V(6); PG8_BAR;
    for (;;) {
        const bool has_next = S.next(ui + 1, nxt);
        const char* nA = has_next ? (const char*)g.A + (size_t)nxt.pm * tstepA + (size_t)nxt.pn * g.a_pn_stride * 2 : cA; const char* nB = has_next ? (const char*)g.Bt + (size_t)nxt.pn * tstepB : cB;
        for (int t = 0; t < nt; t += 2) {
            const bool last = (t == nt - 2);
            const char* a1 = cA + (size_t)(t + 1) * kstep;
            const char* a2 = last ? nA : cA + (size_t)(t + 2) * kstep; const char* b2 = last ? nB : cB + (size_t)(t + 2) * kstep;
            const char* a3 = a2 + kstep; const char* b3 = b2 + kstep;
            PG8_LDB(B0, 0, 0); PG8_LDB(B1, 0, 1); PG8_SCHED; PG8_LDA(At, 0, 0); PG8_STAGE(PG8_SA(1, 1), a1 + hstepA, voffA);
            PG8_WAIT_V(8); PG8_WAIT_L(0); PG8_BAR; PG8_MMA(0, 0, At, B0); PG8_MMA(0, 1, At, B1); PG8_BAR; PG8_SCHED;
            PG8_LDA(At, 0, 1); PG8_STAGE(PG8_SB(0, 0), b2, voffB); PG8_STAGE(PG8_SB(0, 1), b2 + hstepB, voffB); PG8_STAGE(PG8_SA(0, 0), a2, voffA);
            PG8_WAIT_V(8); PG8_WAIT_L(0); PG8_BAR; PG8_MMA(1, 0, At, B0); PG8_MMA(1, 1, At, B1); PG8_BAR; PG8_SCHED;
            PG8_LDB(B0, 1, 0); PG8_LDB(B1, 1, 1); PG8_SCHED; PG8_LDA(At, 1, 0); PG8_STAGE(PG8_SA(0, 1), a2 + hstepA, voffA);
            PG8_WAIT_V(8); PG8_WAIT_L(0); PG8_BAR; PG8_MMA(0, 0, At, B0); PG8_MMA(0, 1, At, B1); PG8_BAR; PG8_SCHED;
            PG8_LDA(At, 1, 1); PG8_STAGE(PG8_SB(1, 0), b3, voffB); PG8_STAGE(PG8_SB(1, 1), b3 + hstepB, voffB); PG8_STAGE(PG8_SA(1, 0), a3, voffA);
            PG8_WAIT_V(8); PG8_WAIT_L(0); PG8_BAR; PG8_MMA(1, 0, At, B0); PG8_MMA(1, 1, At, B1); PG8_BAR; PG8_SCHED;
        }
        if (wr == 0) PG8_BAR;
        E(acc, cur, wr, wc, fr, fq);
        if (!has_next) break;
#pragma unroll
        for (int a = 0; a < 2; ++a)
#pragma unroll
            for (int b = 0; b < 2; ++b)
#pragma unroll
                for (int m = 0; m < 4; ++m)
#pragma unroll
                    for (int n = 0; n < 2; ++n) acc[a][b][m][n] = (f32x4){0.f, 0.f, 0.f, 0.f};
        cur = nxt; cA = nA; cB = nB; ++ui;
        if (wr == 1) PG8_BAR;
    }
    PG8_WAIT_V(0);
    PG8_BAR;
#undef PG8_SA
#undef PG8_SB
#undef PG8_STAGE
#undef PG8_LDA
#undef PG8_LDB
#undef PG8_MMA
#undef PG8_WAIT_V
#undef PG8_WAIT_L
#undef PG8_BAR
#undef PG8_SCHED
}
}

constexpr int NWAVES = 8, NTHR = NWAVES * 64;
constexpr int DM = 2048, NBATCH = 4, SEQ = 4096, DEPTH = 4, M = NBATCH * SEQ;
constexpr int HGW = 1024;
constexpr int SAH = 16, SAC = 256, SAR = 512;
constexpr int DFF = 5632;
constexpr int N1 = 9216, N3 = 5120, N10 = 2 * DFF;
constexpr float ALPHA = 1.6817928305074292f;
constexpr int MODW = 6 * DM;

constexpr size_t MiB = 1u << 20;
constexpr size_t WS_CTL = 0, CTL_ZERO_BYTES = 1 * MiB;
constexpr size_t WS_MOD = 1 * MiB;
constexpr size_t WS_LB = 2 * MiB;
constexpr size_t WS_MODP = 3 * MiB;
constexpr size_t WS_W1 = 9 * MiB;
constexpr size_t WS_W3 = WS_W1 + 36 * MiB;
constexpr size_t WS_W6 = WS_W3 + 5 * MiB;
constexpr size_t WS_W7 = WS_W6 + 2 * MiB;
constexpr size_t WS_W8 = WS_W7 + 8 * MiB;
constexpr size_t WS_W10 = WS_W8 + 8 * MiB;
constexpr size_t WS_W11 = WS_W10 + 44 * MiB;
constexpr size_t WS_X = WS_W11 + 22 * MiB;
constexpr size_t WS_R = WS_X + 128 * MiB;
constexpr size_t WS_H = WS_R + 128 * MiB;
constexpr size_t WS_QA = WS_H + 64 * MiB;
constexpr size_t WS_FA = WS_QA + 32 * MiB;
constexpr size_t WS_IA = WS_FA + 64 * MiB;
constexpr size_t WS_GA = WS_IA + 32 * MiB;
constexpr size_t WS_LAT = WS_GA + 32 * MiB;
constexpr size_t WS_GTA = WS_LAT + 64 * MiB;
constexpr size_t WS_GTB = WS_GTA + 64 * MiB;
constexpr size_t WS_CQN = WS_GTB + 64 * MiB;
constexpr size_t WS_CKV = WS_CQN + 16 * MiB;
constexpr size_t WS_KIDX = WS_CKV + 8 * MiB;
constexpr size_t WS_IDXW = WS_KIDX + 2 * MiB;
constexpr size_t WS_QB = WS_IDXW + 1 * MiB;
constexpr size_t WS_QIDX = WS_QB + 128 * MiB;
constexpr size_t WS_SEL = WS_QIDX + 32 * MiB;
constexpr size_t WS_YAB = WS_SEL + 8 * MiB;
constexpr size_t WS_MRG = WS_YAB + 64 * MiB;
constexpr size_t WS_BIG = WS_MRG + 64 * MiB;
constexpr size_t WS_END = WS_BIG + 256 * MiB;

constexpr int CW_BAR = 4096;

constexpr int RING_BYTES = 131072;
constexpr int LDS_BYTES = 163840;
constexpr int LDSCTL_OFF = LDS_BYTES - 1024, MISC_OFF = LDSCTL_OFF + 320, SELL_OFF = 147456;

#define GAS __attribute__((address_space(1)))
#define LAS __attribute__((address_space(3)))
typedef unsigned short bf16;
typedef unsigned v4u __attribute__((ext_vector_type(4)));
typedef unsigned v2u __attribute__((ext_vector_type(2)));
typedef float f32x4 __attribute__((ext_vector_type(4)));
typedef float f32x16 __attribute__((ext_vector_type(16)));
typedef short bf16x8 __attribute__((ext_vector_type(8)));
typedef short v4s __attribute__((ext_vector_type(4)));
typedef GAS unsigned gu32;
#define LDS_WAIT() asm volatile("s_waitcnt lgkmcnt(0)" ::: "memory")
__device__ __forceinline__ unsigned f2bf(float f) { unsigned u = __builtin_bit_cast(unsigned, f); return (u + 0x7fffu + ((u >> 16) & 1u)) >> 16; }
__device__ __forceinline__ unsigned pk2(float lo, float hi) { return pg8::cvt_pk_bf16(lo, hi); }
__device__ __forceinline__ float bf2f(unsigned short b) { return __builtin_bit_cast(float, ((unsigned)b) << 16); }
__device__ __forceinline__ float bflo(unsigned w) { return __builtin_bit_cast(float, w << 16); }
__device__ __forceinline__ float bfhi(unsigned w) { return __builtin_bit_cast(float, w & 0xffff0000u); }
__device__ __forceinline__ float sigm(float x) { return __builtin_amdgcn_rcpf(1.f + __expf(-x)); }

#define XB_TMO      128
#define XB_XCNT(j)  (256  + 64 * (j))
#define XB_XSUB(j)  (1280 + 64 * (j))
#define XB_XGEN(j)  (2304 + 64 * (j))
#define XB_TOP      3328
#define XB_TOPGEN   3392
#define XCD_BAR_WORDS 3456
#define XB_SPIN_CAP (1u << 22)

__device__ __forceinline__ unsigned xb_ld(unsigned* p)              { return __hip_atomic_load(p, __ATOMIC_RELAXED, __HIP_MEMORY_SCOPE_AGENT); }
__device__ __forceinline__ unsigned xb_add(unsigned* p, unsigned v) { return __hip_atomic_fetch_add(p, v, __ATOMIC_RELAXED, __HIP_MEMORY_SCOPE_AGENT); }
__device__ __forceinline__ unsigned xb_xcc_id() { return (unsigned)__builtin_amdgcn_s_getreg((3 << 11) | 20) & 0xFu; }
#define XB_SPIN(cond, bar) do { unsigned _sp = 0; while (cond) { __builtin_amdgcn_s_sleep(1); \
    if ((++_sp & 255u) == 0u) { if (xb_ld(&(bar)[XB_TMO])) break; if (_sp > XB_SPIN_CAP) { atomicAdd(&(bar)[XB_TMO], 1u); break; } } } } while (0)

struct XcdBarrier { unsigned* bar; unsigned x; volatile LAS unsigned* st; };

__device__ __forceinline__ XcdBarrier xcd_barrier_post(unsigned* bar, volatile LAS unsigned* st) {
    XcdBarrier b; b.bar = bar; b.x = (unsigned)__builtin_amdgcn_readfirstlane((int)xb_xcc_id()); b.st = st;
    if (threadIdx.x == 0) (void)xb_add(&bar[XB_XCNT(b.x)], 1u);
    return b;
}
__device__ __forceinline__ void xcd_barrier_complete(unsigned* bar, unsigned x, unsigned& nloc, unsigned& nx) {
    const unsigned G = gridDim.x * gridDim.y * gridDim.z;
    unsigned sum, cnt, mine, sp = 0u;
    for (;;) {
        sum = 0u; cnt = 0u; mine = 0u;
#pragma unroll
        for (unsigned j = 0; j < 16; ++j) { const unsigned c = xb_ld(&bar[XB_XCNT(j)]); sum += c; cnt += (c > 0u) ? 1u : 0u; mine = (j == x) ? c : mine; }
        if (sum == G) break;
        __builtin_amdgcn_s_sleep(1);
        if ((++sp & 255u) == 0u) { if (xb_ld(&bar[XB_TMO])) break; if (sp > XB_SPIN_CAP) { atomicAdd(&bar[XB_TMO], 1u); break; } }
    }
    nloc = mine > 0u ? mine : 1u; nx = cnt > 0u ? cnt : 1u;
}
__device__ __forceinline__ void xcd_barrier(const XcdBarrier& b) {
    asm volatile("s_waitcnt vmcnt(0)" ::: "memory");
    __syncthreads();
    if (threadIdx.x == 0) {
        unsigned* bar = b.bar;
        unsigned bx = b.x; asm volatile("" : "+s"(bx));
        __builtin_amdgcn_s_waitcnt(0);
        unsigned nloc = b.st[0], nx = b.st[1];
        if (nloc == 0u) { xcd_barrier_complete(bar, bx, nloc, nx); b.st[0] = nloc; b.st[1] = nx; }
        const unsigned old = xb_add(&bar[XB_XSUB(bx)], 1u);
        const unsigned gen = old / nloc;
        if (old + 1u == (gen + 1u) * nloc) {
            __builtin_amdgcn_fence(__ATOMIC_RELEASE, "agent");
            asm volatile("s_waitcnt vmcnt(0)" ::: "memory");
            const unsigned og = xb_add(&bar[XB_TOP], 1u);
            const unsigned tg = og / nx;
            if (og + 1u == (tg + 1u) * nx) xb_add(&bar[XB_TOPGEN], 1u);
            else XB_SPIN(xb_ld(&bar[XB_TOPGEN]) == tg, bar);
            __builtin_amdgcn_fence(__ATOMIC_ACQUIRE, "agent");
            xb_add(&bar[XB_XGEN(bx)], 1u);
            asm volatile("s_waitcnt vmcnt(0)" ::: "memory");
        } else {
            XB_SPIN(xb_ld(&bar[XB_XGEN(bx)]) == gen, bar);
            __builtin_amdgcn_fence(__ATOMIC_ACQUIRE, "agent");
            asm volatile("s_waitcnt vmcnt(0)" ::: "memory");
        }
    }
    __syncthreads();
}

__device__ __forceinline__ float wave_sum(float v) {
#pragma unroll
    for (int o = 1; o < 64; o <<= 1) v += __shfl_xor(v, o);
    return v;
}
__device__ __forceinline__ float wave_max(float v) {
#pragma unroll
    for (int o = 1; o < 64; o <<= 1) v = fmaxf(v, __shfl_xor(v, o));
    return v;
}
__device__ __forceinline__ int wave_sum_i(int v) {
#pragma unroll
    for (int o = 1; o < 64; o <<= 1) v += __shfl_xor(v, o);
    return v;
}

template <class Src>
__device__ __forceinline__ void cvt_item(const Src& src, bf16* WT, int K, int k0, int n0, LAS float* scr, int lane) {
#pragma unroll 8
    for (int i = 0; i < 32; ++i) { const int kk = 2 * i + (lane >> 5); scr[kk * 33 + (lane & 31)] = src(k0 + kk, n0 + (lane & 31)); }
    LDS_WAIT(); asm volatile("" ::: "memory");
    const int c = lane & 7;
#pragma unroll
    for (int j = 0; j < 4; ++j) { const int n = (lane >> 3) + 8 * j; const LAS float* s = scr + (8 * c) * 33 + n;
        v4u o; o.x = pk2(s[0 * 33], s[1 * 33]); o.y = pk2(s[2 * 33], s[3 * 33]); o.z = pk2(s[4 * 33], s[5 * 33]); o.w = pk2(s[6 * 33], s[7 * 33]);
        *(GAS v4u*)(WT + (size_t)(n0 + n) * K + k0 + 8 * c) = o; }
    LDS_WAIT(); asm volatile("" ::: "memory");
}

struct Args { const float* in[22]; float* out; unsigned char* ws; };

using pg8::Unit; using pg8::cvt_pk_bf16;
__device__ __forceinline__ void st_bf16x8(bf16* p, f32x4 v0, f32x4 v1) {
    v4u w; w.x = cvt_pk_bf16(v0[0], v0[1]); w.y = cvt_pk_bf16(v0[2], v0[3]); w.z = cvt_pk_bf16(v1[0], v1[1]); w.w = cvt_pk_bf16(v1[2], v1[3]);
    *(v4u*)p = w;
}
__device__ __forceinline__ void st_f32x8(float* p, f32x4 v0, f32x4 v1) { *(f32x4*)p = v0; *(f32x4*)(p + 4) = v1; }
__device__ __forceinline__ f32x4 sigm4(f32x4 v) { return (f32x4){sigm(v[0]), sigm(v[1]), sigm(v[2]), sigm(v[3])}; }
__device__ __forceinline__ f32x4 silu4(f32x4 v) { return (f32x4){v[0] * sigm(v[0]), v[1] * sigm(v[1]), v[2] * sigm(v[2]), v[3] * sigm(v[3])}; }
__device__ __forceinline__ f32x4 ldbf4(const bf16* p) { const v2u w = *(const v2u*)p; return (f32x4){bflo(w.x), bfhi(w.x), bflo(w.y), bfhi(w.y)}; }

#define EPI_LOOP(...) \
    _Pragma("unroll") for (int ai = 0; ai < 2; ++ai) _Pragma("unroll") for (int m = 0; m < 4; ++m) { const int row = row0 + ai * 128 + m * 16; \
        _Pragma("unroll") for (int bj = 0; bj < 2; ++bj) { const int col = colb + bj * 128; const f32x4 v0 = acc[ai][bj][m][0], v1 = acc[ai][bj][m][1]; __VA_ARGS__ } }

struct EpiProj {
    bf16* QA; float* FA; bf16* IA; bf16* GA; float* LAT; bf16* GTA; bf16* GTB;
    __device__ __forceinline__ void operator()(const f32x4 (&acc)[2][2][4][2], const Unit& u, int wr, int wc, int fr, int fq) const {
        const int row0 = u.pm * 256 + wr * 64 + fr, pn = u.pn; const int colb = (pn & 3) * 256 + wc * 32 + 8 * fq;
        if (pn < 4)       { EPI_LOOP( st_bf16x8(QA + (size_t)row * 1024 + col, v0, v1); ) }
        else if (pn < 8)  { EPI_LOOP( st_f32x8(FA + (size_t)row * 1024 + col, v0, v1); ) }
        else if (pn < 12) { EPI_LOOP( st_bf16x8(IA + (size_t)row * 1024 + col, v0, v1); ) }
        else if (pn < 16) { EPI_LOOP( st_bf16x8(GA + (size_t)row * 1024 + col, silu4(v0), silu4(v1)); ) }
        else if (pn < 20) { EPI_LOOP( st_f32x8(LAT + (size_t)row * 1024 + col, v0, v1); ) }
        else { bf16* G = pn < 28 ? GTA : GTB; const int cb2 = ((pn - 20) & 7) * 256 + wc * 32 + 8 * fq;
            _Pragma("unroll") for (int ai = 0; ai < 2; ++ai) _Pragma("unroll") for (int m = 0; m < 4; ++m) { const int row = row0 + ai * 128 + m * 16;
                _Pragma("unroll") for (int bj = 0; bj < 2; ++bj) st_bf16x8(G + (size_t)row * 2048 + cb2 + bj * 128, sigm4(acc[ai][bj][m][0]), sigm4(acc[ai][bj][m][1])); } }
    }
};
struct EpiQ {
    bf16* QB; bf16* QIDX;
    __device__ __forceinline__ void operator()(const f32x4 (&acc)[2][2][4][2], const Unit& u, int wr, int wc, int fr, int fq) const {
        const int row0 = u.pm * 256 + wr * 64 + fr, pn = u.pn;
        if (pn < 16) { const int colb = pn * 256 + wc * 32 + 8 * fq; EPI_LOOP( st_bf16x8(QB + (size_t)row * 4096 + col, v0, v1); ) }
        else { const int colb = (pn - 16) * 256 + wc * 32 + 8 * fq; EPI_LOOP( st_bf16x8(QIDX + (size_t)row * 1024 + col, v0, v1); ) }
    }
};
struct EpiBf {
    bf16* O; int ldc; int coff;
    __device__ __forceinline__ void operator()(const f32x4 (&acc)[2][2][4][2], const Unit& u, int wr, int wc, int fr, int fq) const {
        const int row0 = u.pm * 256 + wr * 64 + fr; const int colb = coff + u.pn * 256 + wc * 32 + 8 * fq;
        EPI_LOOP( st_bf16x8(O + (size_t)row * ldc + col, v0, v1); )
    }
};
struct EpiGateA {
    float* T1; const bf16* GT;
    __device__ __forceinline__ void operator()(const f32x4 (&acc)[2][2][4][2], const Unit& u, int wr, int wc, int fr, int fq) const {
        const int row0 = u.pm * 256 + wr * 64 + fr; const int colb = u.pn * 256 + wc * 32 + 8 * fq;
        EPI_LOOP( const size_t o = (size_t)row * 2048 + col; const f32x4 g0 = ldbf4(GT + o), g1 = ldbf4(GT + o + 4); st_f32x8(T1 + o, v0 * g0, v1 * g1); )
    }
};
struct EpiGateB {
    const float* T1; const bf16* GT; bf16* MRG;
    __device__ __forceinline__ void operator()(const f32x4 (&acc)[2][2][4][2], const Unit& u, int wr, int wc, int fr, int fq) const {
        const int row0 = u.pm * 256 + wr * 64 + fr; const int colb = u.pn * 256 + wc * 32 + 8 * fq;
        EPI_LOOP( const size_t o = (size_t)row * 2048 + col; const f32x4 g0 = ldbf4(GT + o), g1 = ldbf4(GT + o + 4); const f32x4 t0 = *(const f32x4*)(T1 + o), t1 = *(const f32x4*)(T1 + o + 4);
                  st_bf16x8(MRG + o, t0 + v0 * g0, t1 + v1 * g1); )
    }
};
struct EpiRes {
    const float* X; float* R; const float* gt;
    __device__ __forceinline__ void operator()(const f32x4 (&acc)[2][2][4][2], const Unit& u, int wr, int wc, int fr, int fq) const {
        const int row0 = u.pm * 256 + wr * 64 + fr; const int colb = u.pn * 256 + wc * 32 + 8 * fq; const float* g = gt + (size_t)(u.pm >> 4) * MODW;
        EPI_LOOP( const size_t o = (size_t)row * 2048 + col; const f32x4 x0 = *(const f32x4*)(X + o), x1 = *(const f32x4*)(X + o + 4); const f32x4 g0 = *(const f32x4*)(g + col), g1 = *(const f32x4*)(g + col + 4);
                  st_f32x8(R + o, x0 * ALPHA + (g0 + 1.f) * v0, x1 * ALPHA + (g1 + 1.f) * v1); )
    }
};
struct EpiSwiglu {
    bf16* ACT;
    __device__ __forceinline__ void operator()(const f32x4 (&acc)[2][2][4][2], const Unit& u, int wr, int wc, int fr, int fq) const {
        const int row0 = u.pm * 256 + wr * 64 + fr; const int col = u.pn * 128 + wc * 32 + 8 * fq;
#pragma unroll
        for (int ai = 0; ai < 2; ++ai)
#pragma unroll
            for (int m = 0; m < 4; ++m) { const int row = row0 + ai * 128 + m * 16;
                st_bf16x8(ACT + (size_t)row * DFF + col, silu4(acc[ai][0][m][0]) * acc[ai][1][m][0], silu4(acc[ai][0][m][1]) * acc[ai][1][m][1]); }
    }
};

__global__ void __launch_bounds__(NTHR, 2) fwd_kernel(Args args) {
    extern __shared__ __attribute__((aligned(16))) unsigned char lds_raw[];
    LAS unsigned char* lds = (LAS unsigned char*)lds_raw;
    const int G = gridDim.x, blk = blockIdx.x;
    const int NGW = G * NWAVES, NT = G * NTHR;
    unsigned char* ws = args.ws;
    gu32* ctl = (gu32*)(ws + WS_CTL);
    for (int u = threadIdx.x; u < (LDS_BYTES - LDSCTL_OFF) / 4; u += NTHR) ((LAS unsigned*)(lds + LDSCTL_OFF))[u] = 0u;
    __syncthreads();
    volatile LAS unsigned* MISC = (volatile LAS unsigned*)(lds + MISC_OFF);
    XcdBarrier bar = xcd_barrier_post((unsigned*)(ctl + CW_BAR), MISC + 8);
#define GRID_BAR() xcd_barrier(bar)

#define x_in      (args.in[0])
#define c_in      (args.in[1])
#define w_ada     (args.in[2])
#define b_ada     (args.in[3])
#define w_in      (args.in[4])
#define lb_logits (args.in[5])
#define g_hg      (args.in[6])
#define w_pa      (args.in[7])
#define g_cq      (args.in[8])
#define g_ckv     (args.in[9])
#define w_uq      (args.in[10])
#define w_iq      (args.in[11])
#define w_uv      (args.in[12])
#define w_pb      (args.in[13])
#define w_out     (args.in[14])
#define ln1_g     (args.in[15])
#define ln1_b     (args.in[16])
#define w_gate    (args.in[17])
#define w_up      (args.in[18])
#define w_down    (args.in[19])
#define ln2_g     (args.in[20])
#define ln2_b     (args.in[21])
#define MOD  ((float*)(ws + WS_MOD))
#define LB   ((float*)(ws + WS_LB))
#define MODP ((float*)(ws + WS_MODP))
#define W1   ((bf16*)(ws + WS_W1))
#define W3   ((bf16*)(ws + WS_W3))
#define W6   ((bf16*)(ws + WS_W6))
#define W7   ((bf16*)(ws + WS_W7))
#define W8   ((bf16*)(ws + WS_W8))
#define W10  ((bf16*)(ws + WS_W10))
#define W11  ((bf16*)(ws + WS_W11))
#define XB   ((float*)(ws + WS_X))
#define RB   ((float*)(ws + WS_R))
#define HB   ((bf16*)(ws + WS_H))
#define QA   ((bf16*)(ws + WS_QA))
#define FA   ((float*)(ws + WS_FA))
#define IA   ((bf16*)(ws + WS_IA))
#define GA   ((bf16*)(ws + WS_GA))
#define LAT  ((float*)(ws + WS_LAT))
#define GTA  ((bf16*)(ws + WS_GTA))
#define GTB  ((bf16*)(ws + WS_GTB))
#define CQN  ((bf16*)(ws + WS_CQN))
#define CKV  ((bf16*)(ws + WS_CKV))
#define KIDX ((bf16*)(ws + WS_KIDX))
#define IDXW ((float*)(ws + WS_IDXW))
#define QB   ((bf16*)(ws + WS_QB))
#define QIDX ((bf16*)(ws + WS_QIDX))
#define SEL  ((unsigned short*)(ws + WS_SEL))
#define YAB  ((bf16*)(ws + WS_YAB))
#define MRG  ((bf16*)(ws + WS_MRG))
#define ISC  ((float*)(ws + WS_BIG))
#define OP   ((float*)(ws + WS_BIG))
#define ACT  ((bf16*)(ws + WS_BIG))
#define KK   LAT
#define KSB  ((bf16*)(ws + WS_LAT))
#define KVT  ((float*)(ws + WS_BIG))
#define SPB  ((bf16*)(ws + WS_BIG + 128 * MiB))
#define DEB  ((float*)(ws + WS_BIG + 192 * MiB))
#define PHASE_BEGIN { int tid = threadIdx.x; asm volatile("" : "+v"(tid)); const int lane = tid & 63, wave = __builtin_amdgcn_readfirstlane(tid >> 6); \
        const int gw = blk * NWAVES + wave, gtid = blk * NTHR + tid; LAS float* wscr = (LAS float*)(lds + wave * 16384); (void)lane; (void)gw; (void)gtid; (void)wscr;
#define PHASE_END }

#define CONVERT_LAYER(L) do { const int l_ = (L); \
        const float* s_in = w_in + (size_t)l_ * DM * 9040; const float* s_uq = w_uq + (size_t)l_ * SAR * 4096; const float* s_iq = w_iq + (size_t)l_ * SAR * 1024; \
        const float* s_uv = w_uv + (size_t)l_ * 16 * 256 * 64; const float* s_pa = w_pa + (size_t)l_ * 1024 * DM; const float* s_pb = w_pb + (size_t)l_ * 1024 * DM; \
        const float* s_out = w_out + (size_t)l_ * DM * DM; const float* s_g = w_gate + (size_t)l_ * DM * DFF; const float* s_u = w_up + (size_t)l_ * DM * DFF; const float* s_d = w_down + (size_t)l_ * DFF * DM; \
        constexpr int I1 = (DM / 64) * (N1 / 32), I3 = (SAR / 64) * (N3 / 32), I6 = (1024 / 64) * (1024 / 32), I7 = (DM / 64) * (DM / 32), I8 = I7, I10 = (DM / 64) * (N10 / 32), I11 = (DFF / 64) * (DM / 32); \
        constexpr int NIT = I1 + I3 + I6 + I7 + I8 + I10 + I11; \
        for (int it = gw; it < NIT; it += NGW) { int r = it; \
            if (r < I1) { const int nb = N1 / 32, k0 = (r / nb) * 64, n0 = (r % nb) * 32; \
                cvt_item([=](int k, int n) -> float { return n < 4944 ? s_in[(size_t)k * 9040 + n] : (n < 5120 ? 0.f : s_in[(size_t)k * 9040 + n - 176]); }, W1, DM, k0, n0, wscr, lane); continue; } r -= I1; \
            if (r < I3) { const int nb = N3 / 32, k0 = (r / nb) * 64, n0 = (r % nb) * 32; \
                cvt_item([=](int k, int n) -> float { return n < 4096 ? s_uq[(size_t)k * 4096 + n] * 0.0625f : s_iq[(size_t)k * 1024 + n - 4096]; }, W3, SAR, k0, n0, wscr, lane); continue; } r -= I3; \
            if (r < I6) { const int nb = 1024 / 32, k0 = (r / nb) * 64, n0 = (r % nb) * 32; \
                cvt_item([=](int k, int n) -> float { const int h = n >> 6, v = n & 63, kk = k >> 8, c = k & 255; return kk == (h & 3) ? s_uv[((size_t)h * 256 + c) * 64 + v] : 0.f; }, W6, 1024, k0, n0, wscr, lane); continue; } r -= I6; \
            if (r < I7) { const int nb = DM / 32, k0 = (r / nb) * 64, n0 = (r % nb) * 32; \
                cvt_item([=](int k, int n) -> float { return k < 1024 ? s_pa[(size_t)k * DM + n] : s_pb[(size_t)(k - 1024) * DM + n]; }, W7, DM, k0, n0, wscr, lane); continue; } r -= I7; \
            if (r < I8) { const int nb = DM / 32, k0 = (r / nb) * 64, n0 = (r % nb) * 32; \
                cvt_item([=](int k, int n) -> float { return s_out[(size_t)k * DM + n]; }, W8, DM, k0, n0, wscr, lane); continue; } r -= I8; \
            if (r < I10) { const int nb = N10 / 32, k0 = (r / nb) * 64, n0 = (r % nb) * 32; \
                cvt_item([=](int k, int n) -> float { const int pn = n >> 8, rr = n & 255; return rr < 128 ? s_g[(size_t)k * DFF + pn * 128 + rr] : s_u[(size_t)k * DFF + pn * 128 + rr - 128]; }, W10, DM, k0, n0, wscr, lane); continue; } r -= I10; \
            { const int nb = DM / 32, k0 = (r / nb) * 64, n0 = (r % nb) * 32; \
                cvt_item([=](int k, int n) -> float { return s_d[(size_t)k * DM + n]; }, W11, DFF, k0, n0, wscr, lane); } \
        } } while (0)


#ifndef HGRN_NAIVE
#define HGRN_NAIVE 0
#endif
#ifndef IDX_NAIVE
#define IDX_NAIVE 0
#endif
#ifndef ATT_NAIVE
#define ATT_NAIVE 0
#endif
#ifndef DBG_CUT
#define DBG_CUT 0
#endif
#define DBG_DUMP(N, EXPR) do { if (DBG_CUT == (N)) { GRID_BAR(); for (size_t i_ = (size_t)blockIdx.x * NTHR + threadIdx.x; i_ < (size_t)M * DM; i_ += (size_t)NT) { const size_t row_ = i_ / DM, col_ = i_ % DM; (void)row_; (void)col_; args.out[i_] = (EXPR); } return; } } while (0)
    PHASE_BEGIN
    {
        LAS float* sc = (LAS float*)lds;
        for (int i = tid; i < NBATCH * DM; i += NTHR) { const float v = c_in[i]; sc[i] = v * sigm(v); }
        __syncthreads();
        for (int item = gtid; item < 8 * 12288; item += NT) {
            const int ks = item / 12288, cg = item % 12288, l = cg / 3072, n4 = (cg % 3072) * 4;
            const float* wp = w_ada + ((size_t)l * DM + ks * 256) * MODW + n4;
            f32x4 a0 = {0.f, 0.f, 0.f, 0.f}, a1 = a0, a2 = a0, a3 = a0;
#pragma unroll 8
            for (int k = 0; k < 256; ++k) { const f32x4 w = *(const f32x4*)(wp + (size_t)k * MODW); const int kk = ks * 256 + k;
                a0 += w * sc[kk]; a1 += w * sc[2048 + kk]; a2 += w * sc[4096 + kk]; a3 += w * sc[6144 + kk]; }
            float* o = MODP + ((size_t)(ks * 4 + l) * 4) * MODW + n4;
            *(f32x4*)(o) = a0; *(f32x4*)(o + MODW) = a1; *(f32x4*)(o + 2 * MODW) = a2; *(f32x4*)(o + 3 * MODW) = a3;
        }
        if (gtid < 1024) {
            const float a = lb_logits[gtid], b = lb_logits[1024 + gtid], c = lb_logits[2048 + gtid], d = lb_logits[3072 + gtid];
            const float mx = fmaxf(fmaxf(a, b), fmaxf(c, d)); const float ea = expf(a - mx), eb = expf(b - mx), ec = expf(c - mx), ed = expf(d - mx); const float inv = 1.f / (ea + eb + ec + ed);
            LB[gtid] = 0.f; LB[1024 + gtid] = eb * inv; LB[2048 + gtid] = (eb + ec) * inv; LB[3072 + gtid] = (eb + ec + ed) * inv;
        }
        __syncthreads();
        CONVERT_LAYER(0);
    }
    PHASE_END
    GRID_BAR();
    PHASE_BEGIN
    for (int i = gtid; i < DEPTH * NBATCH * MODW; i += NT) {
        const int l = i / (NBATCH * MODW), r = i % (NBATCH * MODW), b = r / MODW, n = r % MODW;
        float s = b_ada[l * MODW + n];
#pragma unroll
        for (int ks = 0; ks < 8; ++ks) s += MODP[((size_t)(ks * 4 + l) * 4 + b) * MODW + n];
        MOD[i] = s;
    }
    PHASE_END
    GRID_BAR();
    PHASE_BEGIN
    for (size_t i = gtid; i < (size_t)M * DM / 8; i += NT) {
        const size_t e = i * 8; const int row = (int)(e / DM), col = (int)(e % DM), b = row / SEQ;
        const float* md = MOD + (size_t)b * MODW;
        const f32x4 x0 = *(const f32x4*)(x_in + e), x1 = *(const f32x4*)(x_in + e + 4);
        const f32x4 s0 = *(const f32x4*)(md + 2048 + col), s1 = *(const f32x4*)(md + 2048 + col + 4), h0 = *(const f32x4*)(md + col), h1 = *(const f32x4*)(md + col + 4);
        st_bf16x8(HB + e, x0 * (s0 + 1.f) + h0, x1 * (s1 + 1.f) + h1);
    }
    PHASE_END
    GRID_BAR();

    DBG_DUMP(1, bf2f(HB[i_]) + MOD[i_ % (DEPTH * NBATCH * MODW)] + bf2f(W1[i_ % ((size_t)N1 * DM)]) + bf2f(W10[i_ % ((size_t)N10 * DM)]) + bf2f(W11[i_ % ((size_t)DM * DFF)]) + bf2f(W8[i_ % ((size_t)DM * DM)]));
    for (int l = 0; l < DEPTH; ++l) {
        const float* modl = MOD + (size_t)l * NBATCH * MODW;
        const float* xres = (l == 0) ? x_in : XB;
        PHASE_BEGIN
        { pg8::Gemm g{HB, W1, M, N1, DM, DM, DM, 0}; pg8::StaticOrder S; S.init(M, N1, G, blk);
          EpiProj E{QA, FA, IA, GA, LAT, GTA, GTB}; pg8::gemm_phase(lds, g, S, E, tid); }
        PHASE_END
        GRID_BAR();
        DBG_DUMP(2, FA[row_ * 1024 + (col_ & 1023)] + LAT[row_ * 1024 + (col_ & 1023)] + bf2f(QA[row_ * 1024 + (col_ & 1023)]) + bf2f(IA[row_ * 1024 + (col_ & 1023)]) + bf2f(GA[row_ * 1024 + (col_ & 1023)]) + bf2f(GTA[i_]) + bf2f(GTB[i_]));
        PHASE_BEGIN
        for (int row = gw; row < M; row += NGW) {
            const float* lr = LAT + (size_t)row * 1024;
            const f32x4 a0 = *(const f32x4*)(lr + 4 * lane), a1 = *(const f32x4*)(lr + 256 + 4 * lane), kv = *(const f32x4*)(lr + 512 + 4 * lane);
            const float ki = lr[768 + lane]; const float iw = lr[832 + (lane & 15)];
            float sq = a0[0] * a0[0] + a0[1] * a0[1] + a0[2] * a0[2] + a0[3] * a0[3] + a1[0] * a1[0] + a1[1] * a1[1] + a1[2] * a1[2] + a1[3] * a1[3];
            float sk = kv[0] * kv[0] + kv[1] * kv[1] + kv[2] * kv[2] + kv[3] * kv[3];
            sq = wave_sum(sq); sk = wave_sum(sk);
            const float rq = 1.0f / sqrtf(sq * (1.f / 512.f) + 1e-6f), rk = 1.0f / sqrtf(sk * (1.f / 256.f) + 1e-6f);
            const f32x4 g0 = *(const f32x4*)(g_cq + l * 512 + 4 * lane), g1 = *(const f32x4*)(g_cq + l * 512 + 256 + 4 * lane), gk = *(const f32x4*)(g_ckv + l * 256 + 4 * lane);
            v2u o; f32x4 t = a0 * rq * g0; o.x = pk2(t[0], t[1]); o.y = pk2(t[2], t[3]); *(v2u*)(CQN + (size_t)row * 512 + 4 * lane) = o;
            t = a1 * rq * g1; o.x = pk2(t[0], t[1]); o.y = pk2(t[2], t[3]); *(v2u*)(CQN + (size_t)row * 512 + 256 + 4 * lane) = o;
            t = kv * rk * gk; o.x = pk2(t[0], t[1]); o.y = pk2(t[2], t[3]); *(v2u*)(CKV + (size_t)row * 256 + 4 * lane) = o;
            KIDX[(size_t)row * 64 + lane] = (bf16)f2bf(ki);
            if (lane < 16) IDXW[(size_t)row * 16 + lane] = iw * 0.03125f;
        }
        PHASE_END
        GRID_BAR();
#if HGRN_NAIVE
        PHASE_BEGIN
        for (size_t i = gtid; i < (size_t)M * HGW / 4; i += NT) {
            const size_t e = i * 4; const int ch = (int)(e & 1023);
            const f32x4 fa = *(const f32x4*)(FA + e); const f32x4 lb = *(const f32x4*)(LB + l * 1024 + ch);
            f32x4 f, k;
#pragma unroll
            for (int j = 0; j < 4; ++j) { const float s = sigm(fa[j]); f[j] = fminf(fmaxf(lb[j] + (1.f - lb[j]) * s, 1e-6f), 1.0f); k[j] = (1.f - lb[j]) * sigm(-fa[j]); }
            *(f32x4*)(FA + e) = f; *(f32x4*)(KK + e) = k;
        }
        PHASE_END
        GRID_BAR();
        PHASE_BEGIN
        if (wave == 0) {
            for (int u = blk; u < 256; u += G) {
                const int b = u >> 6, h = (u >> 3) & 7, ks = (u >> 1) & 3, vh = u & 1;
                float S[32];
#pragma unroll
                for (int j = 0; j < 32; ++j) S[j] = 0.f;
                const size_t base = (size_t)b * SEQ * 1024 + h * 128;
                const float* fp = FA + base + ks * 32; const float* kp = KK + base + ks * 32; const bf16* qp = QA + base + ks * 32;
                const bf16* vp = IA + base + vh * 64 + lane;
                float* op = OP + ((size_t)ks * M) * 1024 + base + vh * 64 + lane;
                for (int t = 0; t < SEQ; ++t) {
                    const float v = bf2f(vp[(size_t)t * 1024]);
                    float o = 0.f;
#pragma unroll
                    for (int j4 = 0; j4 < 8; ++j4) {
                        const f32x4 f = *(const f32x4*)(fp + (size_t)t * 1024 + j4 * 4), k = *(const f32x4*)(kp + (size_t)t * 1024 + j4 * 4); const v2u qw = *(const v2u*)(qp + (size_t)t * 1024 + j4 * 4);
                        const float q0 = bflo(qw.x), q1 = bfhi(qw.x), q2 = bflo(qw.y), q3 = bfhi(qw.y);
                        S[j4 * 4 + 0] = S[j4 * 4 + 0] * f[0] + k[0] * v; o += S[j4 * 4 + 0] * q0;
                        S[j4 * 4 + 1] = S[j4 * 4 + 1] * f[1] + k[1] * v; o += S[j4 * 4 + 1] * q1;
                        S[j4 * 4 + 2] = S[j4 * 4 + 2] * f[2] + k[2] * v; o += S[j4 * 4 + 2] * q2;
                        S[j4 * 4 + 3] = S[j4 * 4 + 3] * f[3] + k[3] * v; o += S[j4 * 4 + 3] * q3;
                    }
                    op[(size_t)t * 1024] = o;
                }
            }
        }
        PHASE_END
        GRID_BAR();
        PHASE_BEGIN
        for (int row = gw; row < M; row += NGW) {
            f32x4 o[4];
#pragma unroll
            for (int j = 0; j < 4; ++j) { o[j] = (f32x4){0.f, 0.f, 0.f, 0.f};
#pragma unroll
                for (int ks = 0; ks < 4; ++ks) o[j] += *(const f32x4*)(OP + ((size_t)ks * M + row) * 1024 + lane * 16 + j * 4); }
            float ss = 0.f;
#pragma unroll
            for (int j = 0; j < 4; ++j) ss += o[j][0] * o[j][0] + o[j][1] * o[j][1] + o[j][2] * o[j][2] + o[j][3] * o[j][3];
            ss += __shfl_xor(ss, 1); ss += __shfl_xor(ss, 2); ss += __shfl_xor(ss, 4);
            const float rn = 1.0f / sqrtf(ss * (1.f / 128.f) + 1e-6f);
#pragma unroll
            for (int j = 0; j < 4; ++j) { const int c = lane * 16 + j * 4; const f32x4 gg = *(const f32x4*)(g_hg + l * 1024 + c); const f32x4 ga = ldbf4(GA + (size_t)row * 1024 + c);
                const f32x4 y = o[j] * rn * gg * ga; v2u w; w.x = pk2(y[0], y[1]); w.y = pk2(y[2], y[3]); *(v2u*)(YAB + (size_t)row * 2048 + c) = w; }
        }
        PHASE_END
        GRID_BAR();
#else
        PHASE_BEGIN
        {
            const int cp = tid & 63, sg = tid >> 6;
            LAS unsigned char* KST = lds;
            LAS unsigned char* VTL = lds + 18432;
            LAS float* SEGT = (LAS float*)(lds + 36864);
            LAS float* G63 = (LAS float*)(lds + 40960);
            for (int u = blk; u < 2048; u += G) {
                const int bh = u >> 6, c = u & 63, b = bh >> 3, h = bh & 7;
                const size_t rowb = (size_t)b * SEQ + c * 64 + sg * 8; const int col = h * 128 + 2 * cp;
                const float lb0 = LB[l * 1024 + col], lb1 = LB[l * 1024 + col + 1];
                float lf0[8], lf1[8], kk0[8], kk1[8];
#pragma unroll
                for (int i = 0; i < 8; ++i) { const float2 fa = *(const float2*)(FA + (rowb + i) * 1024 + col);
                    const float f0 = fminf(fmaxf(lb0 + (1.f - lb0) * sigm(fa.x), 1e-6f), 1.f), f1 = fminf(fmaxf(lb1 + (1.f - lb1) * sigm(fa.y), 1e-6f), 1.f);
                    lf0[i] = __logf(f0); lf1[i] = __logf(f1); kk0[i] = (1.f - lb0) * sigm(-fa.x); kk1[i] = (1.f - lb1) * sigm(-fa.y); }
#pragma unroll
                for (int i = 1; i < 8; ++i) { lf0[i] += lf0[i - 1]; lf1[i] += lf1[i - 1]; }
                SEGT[sg * 128 + 2 * cp] = lf0[7]; SEGT[sg * 128 + 2 * cp + 1] = lf1[7];
                __syncthreads();
                float pre0 = 0.f, pre1 = 0.f, r0 = 0.f, r1 = 0.f, t0 = 0.f, t1 = 0.f;
#pragma unroll
                for (int s2 = 0; s2 < 8; ++s2) { const float a0 = SEGT[s2 * 128 + 2 * cp], a1 = SEGT[s2 * 128 + 2 * cp + 1];
                    if (s2 < sg) { pre0 += a0; pre1 += a1; } if (s2 < 4) { r0 += a0; r1 += a1; } t0 += a0; t1 += a1; }
                unsigned ksw0[4], ksw1[4], vw0[4], vw1[4]; float ks0p = 0.f, ks1p = 0.f, v0p = 0.f, v1p = 0.f;
#pragma unroll
                for (int i = 0; i < 8; ++i) {
                    const float b0 = pre0 + lf0[i], b1 = pre1 + lf1[i];
                    const unsigned qw = *(const unsigned*)(QA + (rowb + i) * 1024 + col); const unsigned vw = *(const unsigned*)(IA + (rowb + i) * 1024 + col);
                    const float qs0 = bflo(qw) * __expf(b0 - r0), qs1 = bfhi(qw) * __expf(b1 - r1);
                    const float ks0 = kk0[i] * __expf(r0 - b0), ks1 = kk1[i] * __expf(r1 - b1);
                    *(unsigned*)(QA + (rowb + i) * 1024 + col) = pk2(qs0, qs1);
                    *(unsigned*)(KSB + (rowb + i) * 1024 + col) = pk2(ks0, ks1);
                    if (i & 1) { ksw0[i >> 1] = pk2(ks0p, ks0); ksw1[i >> 1] = pk2(ks1p, ks1); vw0[i >> 1] = pk2(v0p, bflo(vw)); vw1[i >> 1] = pk2(v1p, bfhi(vw)); }
                    else { ks0p = ks0; ks1p = ks1; v0p = bflo(vw); v1p = bfhi(vw); }
                }
                *(LAS v4u*)(KST + (2 * cp) * 144 + sg * 16) = (v4u){ksw0[0], ksw0[1], ksw0[2], ksw0[3]};
                *(LAS v4u*)(KST + (2 * cp + 1) * 144 + sg * 16) = (v4u){ksw1[0], ksw1[1], ksw1[2], ksw1[3]};
                *(LAS v4u*)(VTL + (2 * cp) * 144 + sg * 16) = (v4u){vw0[0], vw0[1], vw0[2], vw0[3]};
                *(LAS v4u*)(VTL + (2 * cp + 1) * 144 + sg * 16) = (v4u){vw1[0], vw1[1], vw1[2], vw1[3]};
                if (sg == 7) { float* de = DEB + (size_t)u * 256; *(float2*)(de + 2 * cp) = make_float2(__expf(r0), __expf(r1)); *(float2*)(de + 128 + 2 * cp) = make_float2(__expf(t0), __expf(t1));
                    G63[2 * cp] = __expf(t0 - r0); G63[2 * cp + 1] = __expf(t1 - r1); }
                __syncthreads();
                { const int kt = wave >> 1, vt0 = (wave & 1) * 2, lr = lane & 31, lh = lane >> 5;
                  f32x16 acc0, acc1;
#pragma unroll
                  for (int r = 0; r < 16; ++r) { acc0[r] = 0.f; acc1[r] = 0.f; }
#pragma unroll
                  for (int s4 = 0; s4 < 4; ++s4) {
                      const bf16x8 a = *(const LAS bf16x8*)(KST + (kt * 32 + lr) * 144 + (s4 * 16 + 8 * lh) * 2);
                      const bf16x8 b0 = *(const LAS bf16x8*)(VTL + (vt0 * 32 + lr) * 144 + (s4 * 16 + 8 * lh) * 2);
                      const bf16x8 b1 = *(const LAS bf16x8*)(VTL + ((vt0 + 1) * 32 + lr) * 144 + (s4 * 16 + 8 * lh) * 2);
                      acc0 = __builtin_amdgcn_mfma_f32_32x32x16_bf16(a, b0, acc0, 0, 0, 0); acc1 = __builtin_amdgcn_mfma_f32_32x32x16_bf16(a, b1, acc1, 0, 0, 0); }
                  float* kvt = KVT + (size_t)u * 16384;
#pragma unroll
                  for (int rg = 0; rg < 4; ++rg) { const int k0 = kt * 32 + 8 * rg + 4 * lh; const f32x4 g = *(const LAS f32x4*)(G63 + k0);
                      *(f32x4*)(kvt + (size_t)(vt0 * 32 + lr) * 128 + k0) = (f32x4){acc0[4 * rg] * g[0], acc0[4 * rg + 1] * g[1], acc0[4 * rg + 2] * g[2], acc0[4 * rg + 3] * g[3]};
                      *(f32x4*)(kvt + (size_t)((vt0 + 1) * 32 + lr) * 128 + k0) = (f32x4){acc1[4 * rg] * g[0], acc1[4 * rg + 1] * g[1], acc1[4 * rg + 2] * g[2], acc1[4 * rg + 3] * g[3]}; } }
                __syncthreads();
            }
        }
        PHASE_END
        GRID_BAR();
        PHASE_BEGIN
        for (int item = gtid; item < 32 * 4096; item += NT) {
            const int bh = item >> 12, v = (item >> 5) & 127, k4 = (item & 31) * 4;
            f32x4 S = {0.f, 0.f, 0.f, 0.f};
            for (int c0 = 0; c0 < 64; c0 += 8) {
                f32x4 kv[8], dd[8], ee[8];
#pragma unroll
                for (int j = 0; j < 8; ++j) { const size_t u = (size_t)bh * 64 + c0 + j; kv[j] = *(const f32x4*)(KVT + u * 16384 + v * 128 + k4); ee[j] = *(const f32x4*)(DEB + u * 256 + k4); dd[j] = *(const f32x4*)(DEB + u * 256 + 128 + k4); }
#pragma unroll
                for (int j = 0; j < 8; ++j) { const size_t u = (size_t)bh * 64 + c0 + j; const f32x4 sp = S * ee[j]; v2u w; w.x = pk2(sp[0], sp[1]); w.y = pk2(sp[2], sp[3]);
                    *(v2u*)(SPB + u * 16384 + v * 128 + k4) = w; S = S * dd[j] + kv[j]; }
            }
        }
        PHASE_END
        GRID_BAR();
        PHASE_BEGIN
        {
            LAS unsigned char* QSL = lds;
            LAS unsigned char* KSL = lds + 17408;
            LAS unsigned char* VTL = lds + 34816;
            LAS unsigned char* SPL = lds + 53248;
            LAS unsigned char* AL = lds + 88064;
            LAS float* SSQ = (LAS float*)(lds + 97280);
            const int cp = tid & 63, sg = tid >> 6, lr = lane & 31, lh = lane >> 5;
            for (int u = blk; u < 2048; u += G) {
                const int bh = u >> 6, c = u & 63, b = bh >> 3, h = bh & 7;
                const size_t row0 = (size_t)b * SEQ + c * 64; const int col0 = h * 128;
#pragma unroll
                for (int j = 0; j < 2; ++j) { const int q = tid + 512 * j, rr = q >> 4, cc = q & 15;
                    *(LAS v4u*)(QSL + rr * 272 + cc * 16) = *(const v4u*)(QA + (row0 + rr) * 1024 + col0 + cc * 8);
                    *(LAS v4u*)(KSL + rr * 272 + cc * 16) = *(const v4u*)(KSB + (row0 + rr) * 1024 + col0 + cc * 8); }
#pragma unroll
                for (int j = 0; j < 4; ++j) { const int q = tid + 512 * j, rr = q >> 4, cc = q & 15;
                    *(LAS v4u*)(SPL + rr * 272 + cc * 16) = *(const v4u*)(SPB + (size_t)u * 16384 + rr * 128 + cc * 8); }
                { unsigned vw0[4], vw1[4]; float v0p = 0.f, v1p = 0.f;
#pragma unroll
                  for (int i = 0; i < 8; ++i) { const unsigned vw = *(const unsigned*)(IA + (row0 + sg * 8 + i) * 1024 + col0 + 2 * cp);
                      if (i & 1) { vw0[i >> 1] = pk2(v0p, bflo(vw)); vw1[i >> 1] = pk2(v1p, bfhi(vw)); } else { v0p = bflo(vw); v1p = bfhi(vw); } }
                  *(LAS v4u*)(VTL + (2 * cp) * 144 + sg * 16) = (v4u){vw0[0], vw0[1], vw0[2], vw0[3]};
                  *(LAS v4u*)(VTL + (2 * cp + 1) * 144 + sg * 16) = (v4u){vw1[0], vw1[1], vw1[2], vw1[3]}; }
                __syncthreads();
                if (wave < 4) {
                    const int it = wave >> 1, jt = wave & 1;
                    f32x16 acc;
#pragma unroll
                    for (int r = 0; r < 16; ++r) acc[r] = 0.f;
                    if (!(it == 0 && jt == 1)) {
#pragma unroll
                        for (int s8 = 0; s8 < 8; ++s8) {
                            const bf16x8 a = *(const LAS bf16x8*)(QSL + (it * 32 + lr) * 272 + (s8 * 16 + 8 * lh) * 2);
                            const bf16x8 bb = *(const LAS bf16x8*)(KSL + (jt * 32 + lr) * 272 + (s8 * 16 + 8 * lh) * 2);
                            acc = __builtin_amdgcn_mfma_f32_32x32x16_bf16(a, bb, acc, 0, 0, 0); } }
                    const int jj = jt * 32 + lr;
#pragma unroll
                    for (int r = 0; r < 16; ++r) { const int ii = it * 32 + 8 * (r >> 2) + 4 * lh + (r & 3); const float x = (jj <= ii) ? acc[r] : 0.f;
                        *(LAS unsigned short*)(AL + ii * 144 + jj * 2) = (unsigned short)(pk2(x, 0.f) & 0xffffu); }
                }
                __syncthreads();
                { const int it = wave >> 2, vt = wave & 3;
                  f32x16 acc;
#pragma unroll
                  for (int r = 0; r < 16; ++r) acc[r] = 0.f;
#pragma unroll
                  for (int s4 = 0; s4 < 4; ++s4) {
                      const bf16x8 a = *(const LAS bf16x8*)(AL + (it * 32 + lr) * 144 + (s4 * 16 + 8 * lh) * 2);
                      const bf16x8 bb = *(const LAS bf16x8*)(VTL + (vt * 32 + lr) * 144 + (s4 * 16 + 8 * lh) * 2);
                      acc = __builtin_amdgcn_mfma_f32_32x32x16_bf16(a, bb, acc, 0, 0, 0); }
#pragma unroll
                  for (int s8 = 0; s8 < 8; ++s8) {
                      const bf16x8 a = *(const LAS bf16x8*)(QSL + (it * 32 + lr) * 272 + (s8 * 16 + 8 * lh) * 2);
                      const bf16x8 bb = *(const LAS bf16x8*)(SPL + (vt * 32 + lr) * 272 + (s8 * 16 + 8 * lh) * 2);
                      acc = __builtin_amdgcn_mfma_f32_32x32x16_bf16(a, bb, acc, 0, 0, 0); }
#pragma unroll
                  for (int r = 0; r < 16; ++r) { float q2 = acc[r] * acc[r];
                      q2 += __shfl_xor(q2, 1); q2 += __shfl_xor(q2, 2); q2 += __shfl_xor(q2, 4); q2 += __shfl_xor(q2, 8); q2 += __shfl_xor(q2, 16);
                      if (lr == 0) SSQ[vt * 64 + it * 32 + 8 * (r >> 2) + 4 * lh + (r & 3)] = q2; }
                  __syncthreads();
                  const int colg = col0 + vt * 32 + lr; const float gg = g_hg[l * 1024 + colg];
#pragma unroll
                  for (int r = 0; r < 16; ++r) { const int ii = it * 32 + 8 * (r >> 2) + 4 * lh + (r & 3);
                      const float ss = SSQ[ii] + SSQ[64 + ii] + SSQ[128 + ii] + SSQ[192 + ii]; const float rn = 1.0f / sqrtf(ss * (1.f / 128.f) + 1e-6f);
                      const float ga = bf2f(GA[(row0 + ii) * 1024 + colg]);
                      YAB[(row0 + ii) * 2048 + colg] = (bf16)(pk2(acc[r] * rn * gg * ga, 0.f) & 0xffffu); }
                }
                __syncthreads();
            }
        }
        PHASE_END
        GRID_BAR();
#endif
        DBG_DUMP(3, bf2f(YAB[row_ * 2048 + (col_ & 1023)]) + bf2f(CQN[row_ * 512 + (col_ & 511)]) + bf2f(CKV[row_ * 256 + (col_ & 255)]) + bf2f(KIDX[row_ * 64 + (col_ & 63)]) + IDXW[row_ * 16 + (col_ & 15)] + bf2f(GTA[i_]) + bf2f(GTB[i_]));
        PHASE_BEGIN
        { pg8::Gemm g{CQN, W3, M, N3, SAR, SAR, SAR, 0}; pg8::StaticOrder S; S.init(M, N3, G, blk);
          EpiQ E{QB, QIDX}; pg8::gemm_phase(lds, g, S, E, tid); }
        PHASE_END
        GRID_BAR();
#if IDX_NAIVE
        PHASE_BEGIN
        for (int q = gw; q < M; q += NGW) {
            const int b = q / SEQ, pos = q % SEQ, nadm = ((pos >> 6) + 1) * 64;
            {   const v4u w0 = *(const v4u*)(QIDX + (size_t)q * 1024 + lane * 16), w1 = *(const v4u*)(QIDX + (size_t)q * 1024 + lane * 16 + 8);
                LAS f32x4* d = (LAS f32x4*)(wscr + lane * 16);
                d[0] = (f32x4){bflo(w0.x), bfhi(w0.x), bflo(w0.y), bfhi(w0.y)}; d[1] = (f32x4){bflo(w0.z), bfhi(w0.z), bflo(w0.w), bfhi(w0.w)};
                d[2] = (f32x4){bflo(w1.x), bfhi(w1.x), bflo(w1.y), bfhi(w1.y)}; d[3] = (f32x4){bflo(w1.z), bfhi(w1.z), bflo(w1.w), bfhi(w1.w)};
                if (lane < 16) wscr[1024 + lane] = IDXW[(size_t)q * 16 + lane]; }
            LDS_WAIT(); asm volatile("" ::: "memory");
            for (int s0 = 0; s0 < nadm; s0 += 64) {
                const int s = s0 + lane; const bf16* kr = KIDX + ((size_t)b * SEQ + s) * 64;
                float kf[64];
#pragma unroll
                for (int j = 0; j < 8; ++j) { const v4u w = *(const v4u*)(kr + j * 8); kf[j * 8 + 0] = bflo(w.x); kf[j * 8 + 1] = bfhi(w.x); kf[j * 8 + 2] = bflo(w.y); kf[j * 8 + 3] = bfhi(w.y);
                    kf[j * 8 + 4] = bflo(w.z); kf[j * 8 + 5] = bfhi(w.z); kf[j * 8 + 6] = bflo(w.w); kf[j * 8 + 7] = bfhi(w.w); }
                float sc = 0.f;
#pragma unroll 1
                for (int h = 0; h < 16; ++h) { float d = 0.f;
#pragma unroll
                    for (int dd = 0; dd < 64; dd += 4) { const f32x4 qv = *(const LAS f32x4*)(wscr + h * 64 + dd); d += kf[dd] * qv[0] + kf[dd + 1] * qv[1] + kf[dd + 2] * qv[2] + kf[dd + 3] * qv[3]; }
                    sc += wscr[1024 + h] * fmaxf(d, 0.f); }
                ISC[(size_t)q * 4096 + s] = sc;
            }
            LDS_WAIT(); asm volatile("" ::: "memory");
        }
        PHASE_END
        GRID_BAR();
#else
        PHASE_BEGIN
        for (int unit = gw; unit < 2048; unit += NGW) {
            const int b = unit >> 9, j = unit & 511, lr = lane & 31, lh = lane >> 5;
            const int qsel = (lr >> 2) & 1, head = (lr >> 3) * 4 + (lr & 3);
            const int qlo = 4 * j, qhi = 4 * (1023 - j);
            const int nlo = ((qlo >> 6) + 1) * 64, nhi = ((qhi >> 6) + 1) * 64;
            bf16x8 A[4][4]; float W[4][16];
#pragma unroll
            for (int p = 0; p < 4; ++p) { const size_t qb = (size_t)b * SEQ + (p < 2 ? qlo + 2 * p : qhi + 2 * (p - 2));
#pragma unroll
                for (int ks = 0; ks < 4; ++ks) A[p][ks] = *(const bf16x8*)(QIDX + (qb + qsel) * 1024 + head * 64 + ks * 16 + lh * 8);
#pragma unroll
                for (int r4 = 0; r4 < 4; ++r4) { const f32x4 w = *(const f32x4*)(IDXW + (qb + lh) * 16 + r4 * 4); W[p][r4 * 4] = w[0]; W[p][r4 * 4 + 1] = w[1]; W[p][r4 * 4 + 2] = w[2]; W[p][r4 * 4 + 3] = w[3]; } }
            for (int s0 = 0; s0 < nhi; s0 += 32) {
                bf16x8 B[4];
#pragma unroll
                for (int ks = 0; ks < 4; ++ks) B[ks] = *(const bf16x8*)(KIDX + ((size_t)b * SEQ + s0 + lr) * 64 + ks * 16 + lh * 8);
#pragma unroll
                for (int p = 0; p < 4; ++p) {
                    if (p < 2 && s0 >= nlo) continue;
                    f32x16 acc;
#pragma unroll
                    for (int r = 0; r < 16; ++r) acc[r] = 0.f;
#pragma unroll
                    for (int ks = 0; ks < 4; ++ks) acc = __builtin_amdgcn_mfma_f32_32x32x16_bf16(A[p][ks], B[ks], acc, 0, 0, 0);
                    float sc = 0.f;
#pragma unroll
                    for (int r = 0; r < 16; ++r) sc += W[p][r] * fmaxf(acc[r], 0.f);
                    const size_t q = (size_t)b * SEQ + (p < 2 ? qlo + 2 * p : qhi + 2 * (p - 2)) + lh;
                    ISC[q * 4096 + s0 + lr] = sc;
                }
            }
        }
        PHASE_END
        GRID_BAR();
#endif
        PHASE_BEGIN
        for (int q = gw; q < M; q += NGW) {
            const int pos = q % SEQ, qc = pos >> 6, nadm = (qc + 1) * 64; unsigned short* so = SEL + (size_t)q * 256;
            if (qc < 4) { for (int j = lane; j < nadm; j += 64) so[j] = (unsigned short)j; continue; }
            unsigned key[64]; const int nblk = nadm >> 6;
#pragma unroll
            for (int i = 0; i < 64; ++i) { unsigned k = 0u; if (i < nblk) { const unsigned u = __builtin_bit_cast(unsigned, ISC[(size_t)q * 4096 + i * 64 + lane]); k = (u & 0x80000000u) ? ~u : (u | 0x80000000u); } key[i] = k; }
            unsigned T = 0u;
            for (int bit = 31; bit >= 0; --bit) { const unsigned cand = T | (1u << bit); int cnt = 0;
#pragma unroll
                for (int i = 0; i < 64; ++i) cnt += (key[i] >= cand) ? 1 : 0;
                cnt = wave_sum_i(cnt); if (cnt >= 256) T = cand; }
            int base = 0;
#pragma unroll
            for (int i = 0; i < 64; ++i) { const bool f = key[i] > T; const unsigned long long bm = __ballot(f); const int p = base + __popcll(bm & ((1ull << lane) - 1ull));
                if (f) so[p] = (unsigned short)(i * 64 + lane); base += __popcll(bm); }
#pragma unroll
            for (int i = 0; i < 64; ++i) { const bool f = key[i] == T; const unsigned long long bm = __ballot(f); const int p = base + __popcll(bm & ((1ull << lane) - 1ull));
                if (f && p < 256) so[p] = (unsigned short)(i * 64 + lane); base += __popcll(bm); }
        }
        PHASE_END
        GRID_BAR();
        DBG_DUMP(5, (float)SEL[row_ * 256 + (col_ & 255)] * ((row_ & 4095) >= 256 ? 1.f : 0.f) + bf2f(QIDX[row_ * 1024 + (col_ & 1023)]) + bf2f(QB[row_ * 4096 + col_]));
#if ATT_NAIVE
        PHASE_BEGIN
        for (int q = gw; q < M; q += NGW) {
            const int b = q / SEQ, pos = q % SEQ, qc = pos >> 6; const int nsel = qc < 4 ? (qc + 1) * 64 : 256;
            LAS unsigned short* selL = (LAS unsigned short*)(lds + SELL_OFF + wave * 512);
            int myidx[4];
#pragma unroll
            for (int j = 0; j < 4; ++j) { const int slot = j * 64 + lane; const int v = slot < nsel ? (int)SEL[(size_t)q * 256 + slot] : 0; myidx[j] = v; selL[slot] = (unsigned short)v; }
            const bf16* kvb = CKV + (size_t)b * SEQ * 256;
            bf16* qrow = QB + (size_t)q * 4096;
            for (int hp = 0; hp < 2; ++hp) {
                LAS unsigned* qL = (LAS unsigned*)wscr; LAS float* sL = wscr + 1024;
                {   const v4u w0 = *(const v4u*)(qrow + hp * 2048 + lane * 32), w1 = *(const v4u*)(qrow + hp * 2048 + lane * 32 + 8), w2 = *(const v4u*)(qrow + hp * 2048 + lane * 32 + 16), w3 = *(const v4u*)(qrow + hp * 2048 + lane * 32 + 24);
                    LAS v4u* d = (LAS v4u*)(qL + lane * 16); d[0] = w0; d[1] = w1; d[2] = w2; d[3] = w3; }
                LDS_WAIT(); asm volatile("" ::: "memory");
                float mx[8], sm[8];
#pragma unroll
                for (int h = 0; h < 8; ++h) { mx[h] = -3.0e38f; sm[h] = 0.f; }
                for (int j = 0; j < 4; ++j) {
                    const int slot = j * 64 + lane; const int idx = (j == 0) ? myidx[0] : (j == 1) ? myidx[1] : (j == 2) ? myidx[2] : myidx[3];
                    const bf16* kr = kvb + (size_t)idx * 256;
                    float s[8];
#pragma unroll
                    for (int h = 0; h < 8; ++h) s[h] = 0.f;
                    for (int dc = 0; dc < 4; ++dc) {
                        float kf[64];
#pragma unroll
                        for (int jj = 0; jj < 8; ++jj) { const v4u w = *(const v4u*)(kr + dc * 64 + jj * 8); kf[jj * 8 + 0] = bflo(w.x); kf[jj * 8 + 1] = bfhi(w.x); kf[jj * 8 + 2] = bflo(w.y); kf[jj * 8 + 3] = bfhi(w.y);
                            kf[jj * 8 + 4] = bflo(w.z); kf[jj * 8 + 5] = bfhi(w.z); kf[jj * 8 + 6] = bflo(w.w); kf[jj * 8 + 7] = bfhi(w.w); }
#pragma unroll
                        for (int h = 0; h < 8; ++h) {
#pragma unroll
                            for (int dd = 0; dd < 64; dd += 8) { const v4u qw = *(const LAS v4u*)(qL + h * 128 + dc * 32 + dd / 2);
                                s[h] += kf[dd] * bflo(qw.x) + kf[dd + 1] * bfhi(qw.x) + kf[dd + 2] * bflo(qw.y) + kf[dd + 3] * bfhi(qw.y) + kf[dd + 4] * bflo(qw.z) + kf[dd + 5] * bfhi(qw.z) + kf[dd + 6] * bflo(qw.w) + kf[dd + 7] * bfhi(qw.w); } }
                    }
                    const float dist = fabsf((float)(pos - idx)); const bool valid = slot < nsel;
#pragma unroll
                    for (int h = 0; h < 8; ++h) { const float slope = exp2f(-0.5f * (float)(hp * 8 + h + 1)); float v = valid ? s[h] - slope * dist : -1.0e30f; s[h] = v;
                        const float nm = fmaxf(mx[h], v); sm[h] = sm[h] * __expf(mx[h] - nm) + __expf(v - nm); mx[h] = nm; }
                    *(LAS f32x4*)(sL + slot * 8) = (f32x4){s[0], s[1], s[2], s[3]}; *(LAS f32x4*)(sL + slot * 8 + 4) = (f32x4){s[4], s[5], s[6], s[7]};
                }
#pragma unroll
                for (int h = 0; h < 8; ++h) { const float mt = wave_max(mx[h]); const float st = wave_sum(sm[h] * __expf(mx[h] - mt)); mx[h] = mt; sm[h] = 1.0f / st; }
                LDS_WAIT(); asm volatile("" ::: "memory");
                for (int j = 0; j < 4; ++j) { const int slot = j * 64 + lane; f32x4 a = *(LAS f32x4*)(sL + slot * 8), c = *(LAS f32x4*)(sL + slot * 8 + 4);
                    a = (f32x4){__expf(a[0] - mx[0]) * sm[0], __expf(a[1] - mx[1]) * sm[1], __expf(a[2] - mx[2]) * sm[2], __expf(a[3] - mx[3]) * sm[3]};
                    c = (f32x4){__expf(c[0] - mx[4]) * sm[4], __expf(c[1] - mx[5]) * sm[5], __expf(c[2] - mx[6]) * sm[6], __expf(c[3] - mx[7]) * sm[7]};
                    *(LAS f32x4*)(sL + slot * 8) = a; *(LAS f32x4*)(sL + slot * 8 + 4) = c; }
                LDS_WAIT(); asm volatile("" ::: "memory");
                f32x4 oacc[8];
#pragma unroll
                for (int h = 0; h < 8; ++h) oacc[h] = (f32x4){0.f, 0.f, 0.f, 0.f};
                for (int k = 0; k < nsel; ++k) {
                    const int idx = selL[k]; const f32x4 v = ldbf4(kvb + (size_t)idx * 256 + lane * 4);
                    const f32x4 p0 = *(LAS f32x4*)(sL + k * 8), p1 = *(LAS f32x4*)(sL + k * 8 + 4);
                    oacc[0] += v * p0[0]; oacc[1] += v * p0[1]; oacc[2] += v * p0[2]; oacc[3] += v * p0[3];
                    oacc[4] += v * p1[0]; oacc[5] += v * p1[1]; oacc[6] += v * p1[2]; oacc[7] += v * p1[3];
                }
#pragma unroll
                for (int h = 0; h < 8; ++h) { v2u w; w.x = pk2(oacc[h][0], oacc[h][1]); w.y = pk2(oacc[h][2], oacc[h][3]); *(v2u*)(qrow + (hp * 8 + h) * 256 + lane * 4) = w; }
                LDS_WAIT(); asm volatile("" ::: "memory");
            }
        }
        PHASE_END
        GRID_BAR();
#else
        PHASE_BEGIN
        {
            LAS unsigned char* VB = lds + wave * 18432;
            LAS unsigned short* SELW = (LAS unsigned short*)(VB + 17408);
            const int hd = lane & 15, g = lane >> 4, qq = hd >> 2, pp = hd & 3;
            const float slope = exp2f(-0.5f * (float)(hd + 1));
            for (int q = gw; q < M; q += NGW) {
                const int b = q / SEQ, pos = q % SEQ, qc = pos >> 6; const int nsel = qc < 4 ? (qc + 1) * 64 : 256;
                { const v2u w = *(const v2u*)(SEL + (size_t)q * 256 + 4 * lane); const bool ok = 4 * lane < nsel; v2u z; z.x = ok ? w.x : 0u; z.y = ok ? w.y : 0u; *(LAS v2u*)(SELW + 4 * lane) = z; }
                bf16* qrow = QB + (size_t)q * 4096;
                bf16x8 Bq[8];
#pragma unroll
                for (int ks = 0; ks < 8; ++ks) Bq[ks] = *(const bf16x8*)(qrow + hd * 256 + ks * 32 + g * 8);
                const bf16* kvb = CKV + (size_t)b * SEQ * 256;
                f32x4 O[16];
#pragma unroll
                for (int ct = 0; ct < 16; ++ct) O[ct] = (f32x4){0.f, 0.f, 0.f, 0.f};
                float mrun = -1.0e30f, lsum = 0.f;
                LDS_WAIT(); asm volatile("" ::: "memory");
                const int nks = nsel >> 5;
                for (int kst = 0; kst < nks; ++kst) {
                    const int i0 = SELW[32 * kst + hd], i1 = SELW[32 * kst + 16 + hd];
                    const bf16* kr0 = kvb + (size_t)i0 * 256 + g * 8; const bf16* kr1 = kvb + (size_t)i1 * 256 + g * 8;
                    bf16x8 K0[8], K1[8];
#pragma unroll
                    for (int ks = 0; ks < 8; ++ks) { K0[ks] = *(const bf16x8*)(kr0 + ks * 32); K1[ks] = *(const bf16x8*)(kr1 + ks * 32); }
                    f32x4 S0 = {0.f, 0.f, 0.f, 0.f}, S1 = {0.f, 0.f, 0.f, 0.f};
#pragma unroll
                    for (int ks = 0; ks < 8; ++ks) { S0 = __builtin_amdgcn_mfma_f32_16x16x32_bf16(K0[ks], Bq[ks], S0, 0, 0, 0); S1 = __builtin_amdgcn_mfma_f32_16x16x32_bf16(K1[ks], Bq[ks], S1, 0, 0, 0); }
                    const v2u pa = *(const LAS v2u*)(SELW + 32 * kst + 4 * g), pb = *(const LAS v2u*)(SELW + 32 * kst + 16 + 4 * g);
                    const float fp = (float)pos;
                    float s0[4], s1[4];
                    s0[0] = S0[0] - slope * fabsf(fp - (float)(pa.x & 0xffffu)); s0[1] = S0[1] - slope * fabsf(fp - (float)(pa.x >> 16));
                    s0[2] = S0[2] - slope * fabsf(fp - (float)(pa.y & 0xffffu)); s0[3] = S0[3] - slope * fabsf(fp - (float)(pa.y >> 16));
                    s1[0] = S1[0] - slope * fabsf(fp - (float)(pb.x & 0xffffu)); s1[1] = S1[1] - slope * fabsf(fp - (float)(pb.x >> 16));
                    s1[2] = S1[2] - slope * fabsf(fp - (float)(pb.y & 0xffffu)); s1[3] = S1[3] - slope * fabsf(fp - (float)(pb.y >> 16));
                    float ml = fmaxf(fmaxf(fmaxf(s0[0], s0[1]), fmaxf(s0[2], s0[3])), fmaxf(fmaxf(s1[0], s1[1]), fmaxf(s1[2], s1[3])));
                    ml = fmaxf(ml, __shfl_xor(ml, 16)); ml = fmaxf(ml, __shfl_xor(ml, 32));
                    const float mnew = fmaxf(mrun, ml), alpha = __expf(mrun - mnew); mrun = mnew;
                    float p0[4], p1[4];
#pragma unroll
                    for (int r = 0; r < 4; ++r) { p0[r] = __expf(s0[r] - mnew); p1[r] = __expf(s1[r] - mnew); }
                    lsum = lsum * alpha + ((p0[0] + p0[1]) + (p0[2] + p0[3])) + ((p1[0] + p1[1]) + (p1[2] + p1[3]));
                    v4u pw; pw.x = pk2(p0[0], p0[1]); pw.y = pk2(p0[2], p0[3]); pw.z = pk2(p1[0], p1[1]); pw.w = pk2(p1[2], p1[3]);
                    const bf16x8 Pf = __builtin_bit_cast(bf16x8, pw);
#pragma unroll
                    for (int ks = 0; ks < 8; ++ks) { *(LAS bf16x8*)(VB + hd * 544 + ks * 64 + g * 16) = K0[ks]; *(LAS bf16x8*)(VB + (16 + hd) * 544 + ks * 64 + g * 16) = K1[ks]; }
#pragma unroll
                    for (int ct = 0; ct < 16; ++ct) O[ct] = O[ct] * alpha;
                    LDS_WAIT(); asm volatile("" ::: "memory");
#pragma unroll
                    for (int ct = 0; ct < 16; ++ct) {
                        const v4s lo = __builtin_amdgcn_ds_read_tr16_b64_v4i16((LAS v4s*)(VB + (4 * g + qq) * 544 + (16 * ct + 4 * pp) * 2));
                        const v4s hi = __builtin_amdgcn_ds_read_tr16_b64_v4i16((LAS v4s*)(VB + (16 + 4 * g + qq) * 544 + (16 * ct + 4 * pp) * 2));
                        const bf16x8 Af = {lo[0], lo[1], lo[2], lo[3], hi[0], hi[1], hi[2], hi[3]};
                        O[ct] = __builtin_amdgcn_mfma_f32_16x16x32_bf16(Af, Pf, O[ct], 0, 0, 0);
                    }
                    LDS_WAIT(); asm volatile("" ::: "memory");
                }
                lsum += __shfl_xor(lsum, 16); lsum += __shfl_xor(lsum, 32);
                const float inv = 1.0f / lsum;
#pragma unroll
                for (int ct = 0; ct < 16; ++ct) { const f32x4 o = O[ct] * inv; v2u w; w.x = pk2(o[0], o[1]); w.y = pk2(o[2], o[3]); *(v2u*)(qrow + hd * 256 + 16 * ct + 4 * g) = w; }
            }
        }
        PHASE_END
        GRID_BAR();
#endif
        DBG_DUMP(6, bf2f(QB[row_ * 4096 + col_]) + bf2f(QB[row_ * 4096 + 2048 + col_]));
        PHASE_BEGIN
        { pg8::Gemm g{QB, W6, M, 1024, 1024, 4096, 1024, 1024}; pg8::StaticOrder S; S.init(M, 1024, G, blk);
          EpiBf E{YAB, 2048, 1024}; pg8::gemm_phase(lds, g, S, E, tid); }
        PHASE_END
        GRID_BAR();
        PHASE_BEGIN
        { pg8::Gemm g{YAB, W7, M, DM, 1024, 2048, 2048, 0}; pg8::StaticOrder S; S.init(M, DM, G, blk);
          EpiGateA E{RB, GTA}; pg8::gemm_phase(lds, g, S, E, tid); }
        PHASE_END
        GRID_BAR();
        PHASE_BEGIN
        { pg8::Gemm g{YAB + 1024, W7 + 1024, M, DM, 1024, 2048, 2048, 0}; pg8::StaticOrder S; S.init(M, DM, G, blk);
          EpiGateB E{RB, GTB, MRG}; pg8::gemm_phase(lds, g, S, E, tid); }
        PHASE_END
        GRID_BAR();
        PHASE_BEGIN
        { pg8::Gemm g{MRG, W8, M, DM, DM, DM, DM, 0}; pg8::StaticOrder S; S.init(M, DM, G, blk);
          EpiRes E{xres, RB, modl + 2 * DM}; pg8::gemm_phase(lds, g, S, E, tid); }
        PHASE_END
        GRID_BAR();
        PHASE_BEGIN
        for (int row = gw; row < M; row += NGW) {
            const int b = row / SEQ; const float* rr = RB + (size_t)row * DM; const float* md = modl + (size_t)b * MODW;
            f32x4 v[8]; float s = 0.f;
#pragma unroll
            for (int j = 0; j < 8; ++j) { v[j] = *(const f32x4*)(rr + j * 256 + lane * 4); s += (v[j][0] + v[j][1]) + (v[j][2] + v[j][3]); }
            const float mean = wave_sum(s) * (1.f / DM); float s2 = 0.f;
#pragma unroll
            for (int j = 0; j < 8; ++j) { v[j] = v[j] - mean; s2 += (v[j][0] * v[j][0] + v[j][1] * v[j][1]) + (v[j][2] * v[j][2] + v[j][3] * v[j][3]); }
            const float rstd = 1.0f / sqrtf(wave_sum(s2) * (1.f / DM) + 1e-5f);
#pragma unroll
            for (int j = 0; j < 8; ++j) { const int c = j * 256 + lane * 4; const f32x4 gg = *(const f32x4*)(ln1_g + l * DM + c), bb = *(const f32x4*)(ln1_b + l * DM + c);
                const f32x4 y = v[j] * rstd * gg + bb; *(f32x4*)(XB + (size_t)row * DM + c) = y;
                const f32x4 sc = *(const f32x4*)(md + 4 * DM + c), sh = *(const f32x4*)(md + 3 * DM + c); const f32x4 hh = y * (sc + 1.f) + sh;
                v2u w; w.x = pk2(hh[0], hh[1]); w.y = pk2(hh[2], hh[3]); *(v2u*)(HB + (size_t)row * DM + c) = w; }
        }
        PHASE_END
        GRID_BAR();
        DBG_DUMP(7, XB[i_] + bf2f(HB[i_]));
        PHASE_BEGIN
        { pg8::Gemm g{HB, W10, M, N10, DM, DM, DM, 0}; pg8::StaticOrder S; S.init(M, N10, G, blk);
          EpiSwiglu E{ACT}; pg8::gemm_phase(lds, g, S, E, tid); }
        PHASE_END
        GRID_BAR();
        PHASE_BEGIN
        { pg8::Gemm g{ACT, W11, M, DM, DFF, DFF, DFF, 0}; pg8::StaticOrder S; S.init(M, DM, G, blk);
          EpiRes E{XB, RB, modl + 5 * DM}; pg8::gemm_phase(lds, g, S, E, tid); }
        PHASE_END
        GRID_BAR();
        PHASE_BEGIN
        {
            float* xo = (l == DEPTH - 1) ? args.out : XB; const float* mdn = MOD + (size_t)(l + 1 < DEPTH ? l + 1 : l) * NBATCH * MODW;
            for (int row = gw; row < M; row += NGW) {
                const int b = row / SEQ; const float* rr = RB + (size_t)row * DM; const float* md = mdn + (size_t)b * MODW;
                f32x4 v[8]; float s = 0.f;
#pragma unroll
                for (int j = 0; j < 8; ++j) { v[j] = *(const f32x4*)(rr + j * 256 + lane * 4); s += (v[j][0] + v[j][1]) + (v[j][2] + v[j][3]); }
                const float mean = wave_sum(s) * (1.f / DM); float s2 = 0.f;
#pragma unroll
                for (int j = 0; j < 8; ++j) { v[j] = v[j] - mean; s2 += (v[j][0] * v[j][0] + v[j][1] * v[j][1]) + (v[j][2] * v[j][2] + v[j][3] * v[j][3]); }
                const float rstd = 1.0f / sqrtf(wave_sum(s2) * (1.f / DM) + 1e-5f);
#pragma unroll
                for (int j = 0; j < 8; ++j) { const int c = j * 256 + lane * 4; const f32x4 gg = *(const f32x4*)(ln2_g + l * DM + c), bb = *(const f32x4*)(ln2_b + l * DM + c);
                    const f32x4 y = v[j] * rstd * gg + bb; *(f32x4*)(xo + (size_t)row * DM + c) = y;
                    const f32x4 sc = *(const f32x4*)(md + DM + c), sh = *(const f32x4*)(md + c); const f32x4 hh = y * (sc + 1.f) + sh;
                    v2u w; w.x = pk2(hh[0], hh[1]); w.y = pk2(hh[2], hh[3]); *(v2u*)(HB + (size_t)row * DM + c) = w; }
            }
            if (l + 1 < DEPTH) { __syncthreads(); CONVERT_LAYER(l + 1); }
        }
        PHASE_END
        if (l + 1 < DEPTH) GRID_BAR();
    }
}

extern "C" void kernel_launch(void* const* d_in, const int* in_sizes, int n_in, void* d_out, int out_size, void* d_ws, size_t ws_size, hipStream_t stream) {
    static int grid = 0;
    if (grid == 0) {
        if (n_in != 22 || out_size != M * DM || ws_size < WS_END) { fprintf(stderr, "kernel_launch: unexpected shapes (n_in %d, out %d, ws %zu < %zu)\n", n_in, out_size, ws_size, (size_t)WS_END); grid = -1; return; }
        int dev = 0, cus = 0, per_cu = 0;
        if (hipGetDevice(&dev) != hipSuccess || hipDeviceGetAttribute(&cus, hipDeviceAttributeMultiprocessorCount, dev) != hipSuccess) { grid = -1; return; }
        if (hipFuncSetAttribute((const void*)fwd_kernel, hipFuncAttributeMaxDynamicSharedMemorySize, LDS_BYTES) != hipSuccess) { fprintf(stderr, "kernel_launch: hipFuncSetAttribute failed\n"); grid = -1; return; }
        if (hipOccupancyMaxActiveBlocksPerMultiprocessor(&per_cu, (const void*)fwd_kernel, NTHR, LDS_BYTES) != hipSuccess || per_cu < 1) { fprintf(stderr, "kernel_launch: occupancy query says %d\n", per_cu); }
        (void)hipGetLastError();
        grid = cus;
    }
    if (grid < 0) return;
    if (hipMemsetAsync((char*)d_ws + WS_CTL, 0, CTL_ZERO_BYTES, stream) != hipSuccess) return;
    Args a{};
    for (int i = 0; i < 22; ++i) a.in[i] = (const float*)d_in[i];
    a.out = (float*)d_out; a.ws = (unsigned char*)d_ws;
    hipLaunchKernelGGL(fwd_kernel, dim3(grid), dim3(NTHR), LDS_BYTES, stream, a);
}
```

```cpp
#include <hip/hip_runtime.h>
#include <cstdio>
#include <cstdint>

namespace pg8 {
#define PG8_LAS __attribute__((address_space(3)))
typedef unsigned short bf16_t;
typedef short bf16x8 __attribute__((ext_vector_type(8)));
typedef float f32x4 __attribute__((ext_vector_type(4)));
typedef unsigned u32x4 __attribute__((ext_vector_type(4)));
constexpr int BM = 256, BK = 64, HALF = 128, HTB = HALF * BK * 2, STAGE_BYTES = 8 * HTB, NXCD = 8, WGM = 8;

__host__ __device__ __forceinline__ int lds_byte(int r, int c) { const int st = (r >> 4) * 2 + (c >> 5), rr = r & 15, cc = c & 31, ob = rr * 64 + cc * 2; return st * 1024 + (ob ^ (((ob >> 9) & 1) << 5)); }
__host__ __device__ __forceinline__ void stage_rc(int b, int& R, int& C) { const int st = b / 1024, sb = b % 1024, swz = sb ^ (((sb >> 9) & 1) << 5); R = (st >> 1) * 16 + swz / 64; C = (st & 1) * 32 + (swz % 64) / 2; }
__host__ __device__ __forceinline__ int perm32(int rho) { const int n = rho >> 4, i = rho & 15; return 8 * (i >> 2) + 4 * n + (i & 3); }

struct Unit { int pm, pn; };
struct Gemm { const bf16_t* A; const bf16_t* Bt; int M, N, K, lda, ldb, a_pn_stride; };

struct StaticOrder {
    int nM, nN, nwg, G, c;
    __host__ __device__ void init(int M, int N, int G_, int c_) { nM = M / BM; nN = N / BM; nwg = nM * nN; G = G_; c = c_; }
    __host__ __device__ bool next(int i, Unit& u) const {
        const long L = (long)i * G + c; if (L >= nwg) return false;
        int wgid = (int)L; { const int q = nwg / NXCD, r = nwg % NXCD, xcd = wgid % NXCD, off = wgid / NXCD; wgid = (xcd < r ? xcd * (q + 1) : r * (q + 1) + (xcd - r) * q) + off; }
        const int nig = WGM * nN, gid = wgid / nig, fm = gid * WGM, gsz = (nM - fm) < WGM ? (nM - fm) : WGM;
        u.pm = fm + ((wgid % nig) % gsz); u.pn = (wgid % nig) / gsz; return true;
    }
};

typedef float f32x2_t __attribute__((ext_vector_type(2))); typedef __bf16 bf16x2_t __attribute__((ext_vector_type(2)));
__device__ __forceinline__ unsigned cvt_pk_bf16(float lo, float hi) { f32x2_t v = {lo, hi}; bf16x2_t b = __builtin_convertvector(v, bf16x2_t); return __builtin_bit_cast(unsigned, b); }

struct NoHook { static constexpr bool ON = false; template <class A> __device__ __forceinline__ void mid(A&, const Unit&, int, int, int, int) const {} };
template <class Epi, class Hook = NoHook>
__device__ __forceinline__ void gemm_phase(PG8_LAS unsigned char* lds, const Gemm g, const StaticOrder& S, const Epi& E, const int tid, const Hook H = Hook()) {
    const int wid = __builtin_amdgcn_readfirstlane(tid >> 6), lane = tid & 63, wr = wid >> 2, wc = wid & 3, fr = lane & 15, fq = lane >> 4;
    const int K = g.K, nt = K / BK;
    unsigned voffA[2], voffB[2];
#pragma unroll
    for (int i = 0; i < 2; ++i) { int R, C; stage_rc(tid * 16 + i * 8192, R, C); const int Rb = (R & ~31) + perm32(R & 31);
        voffA[i] = (unsigned)(R * g.lda + C) * 2u; voffB[i] = (unsigned)(Rb * g.ldb + C) * 2u; }
    const size_t kstep = (size_t)(BK * 2);
    const size_t hstepA = (size_t)HALF * g.lda * 2, hstepB = (size_t)HALF * g.ldb * 2;
    const size_t tstepA = 2 * hstepA, tstepB = 2 * hstepB;
    const unsigned ldsw = (unsigned)wid * 1024u;
    const int aoff = lds_byte(wr * 64 + fr, fq * 8), boff = lds_byte(wc * 32 + fr, fq * 8);
#define PG8_SA(b, h) (((b) * 2 + (h)) * HTB)
#define PG8_SB(b, h) ((4 + (b) * 2 + (h)) * HTB)
#define PG8_STAGE(bufoff, gbase, voff) do { _Pragma("unroll") for (int _i = 0; _i < 2; ++_i) \
        __builtin_amdgcn_global_load_lds((const unsigned*)((const char*)(gbase) + (voff)[_i]), (PG8_LAS unsigned*)(lds + (bufoff) + ldsw + _i * 8192), 16, 0, 0); } while (0)
#define PG8_LDA(dst, b, h) do { _Pragma("unroll") for (int m = 0; m < 4; ++m) _Pragma("unroll") for (int k = 0; k < 2; ++k) dst[m][k] = *(const PG8_LAS bf16x8*)(lds + PG8_SA(b, h) + aoff + m * 2048 + k * 1024); } while (0)
#define PG8_LDB(dst, b, h) do { _Pragma("unroll") for (int n = 0; n < 2; ++n) _Pragma("unroll") for (int k = 0; k < 2; ++k) dst[n][k] = *(const PG8_LAS bf16x8*)(lds + PG8_SB(b, h) + boff + n * 2048 + k * 1024); } while (0)
#define PG8_MMA(ai, bj, At, Bt) do { __builtin_amdgcn_s_setprio(1); _Pragma("unroll") for (int m = 0; m < 4; ++m) _Pragma("unroll") for (int n = 0; n < 2; ++n) _Pragma("unroll") for (int k = 0; k < 2; ++k) \
        acc[ai][bj][m][n] = __builtin_amdgcn_mfma_f32_16x16x32_bf16(Bt[n][k], At[m][k], acc[ai][bj][m][n], 0, 0, 0); __builtin_amdgcn_s_setprio(0); } while (0)
#define PG8_WAIT_V(n) asm volatile("s_waitcnt vmcnt(" #n ")" ::: "memory")
#define PG8_WAIT_L(n) asm volatile("s_waitcnt lgkmcnt(" #n ")" ::: "memory")
#define PG8_BAR __builtin_amdgcn_s_barrier()
#define PG8_SCHED __builtin_amdgcn_sched_barrier(0)
    Unit cur, nxt; int ui = 0;
    if (!S.next(0, cur)) return;
    f32x4 acc[2][2][4][2];
#pragma unroll
    for (int a = 0; a < 2; ++a)
#pragma unroll
        for (int b = 0; b < 2; ++b)
#pragma unroll
            for (int m = 0; m < 4; ++m)
#pragma unroll
                for (int n = 0; n < 2; ++n) acc[a][b][m][n] = (f32x4){0.f, 0.f, 0.f, 0.f};
    bf16x8 At[4][2], B0[2][2], B1[2][2];
    const char* cA = (const char*)g.A + (size_t)cur.pm * tstepA + (size_t)cur.pn * g.a_pn_stride * 2; const char* cB = (const char*)g.Bt + (size_t)cur.pn * tstepB;
    PG8_STAGE(PG8_SB(0, 0), cB, voffB); PG8_STAGE(PG8_SB(0, 1), cB + hstepB, voffB); PG8_STAGE(PG8_SA(0, 0), cA, voffA); PG8_STAGE(PG8_SA(0, 1), cA + hstepA, voffA);
    if (wr == 1) PG8_BAR;
    PG8_WAIT_V(2); PG8_BAR;
    PG8_STAGE(PG8_SB(1, 0), cB + kstep, voffB); PG8_STAGE(PG8_SA(1, 0), cA + kstep, voffA); PG8_STAGE(PG8_SB(1, 1), cB + hstepB + kstep, voffB);
    PG8_WAIT_V(6); PG8_BAR;
    for (;;) {
        const bool has_next = S.next(ui + 1, nxt);
        const char* nA = has_next ? (const char*)g.A + (size_t)nxt.pm * tstepA + (size_t)nxt.pn * g.a_pn_stride * 2 : cA; const char* nB = has_next ? (const char*)g.Bt + (size_t)nxt.pn * tstepB : cB;
        for (int t = 0; t < nt; t += 2) {
            const bool last = (t == nt - 2);
            const char* a1 = cA + (size_t)(t + 1) * kstep;
            const char* a2 = last ? nA : cA + (size_t)(t + 2) * kstep; const char* b2 = last ? nB : cB + (size_t)(t + 2) * kstep;
            const char* a3 = a2 + kstep; const char* b3 = b2 + kstep;
            if constexpr (Hook::ON) { if (t == (nt >> 1)) H.mid(acc, cur, wr, wc, fr, fq); }
            PG8_LDB(B0, 0, 0); PG8_LDB(B1, 0, 1); PG8_SCHED; PG8_LDA(At, 0, 0); PG8_STAGE(PG8_SA(1, 1), a1 + hstepA, voffA);
            PG8_WAIT_V(8); PG8_WAIT_L(0); PG8_BAR; PG8_MMA(0, 0, At, B0); PG8_MMA(0, 1, At, B1); PG8_BAR; PG8_SCHED;
            PG8_LDA(At, 0, 1); PG8_STAGE(PG8_SB(0, 0), b2, voffB); PG8_STAGE(PG8_SB(0, 1), b2 + hstepB, voffB); PG8_STAGE(PG8_SA(0, 0), a2, voffA);
            PG8_WAIT_V(8); PG8_WAIT_L(0); PG8_BAR; PG8_MMA(1, 0, At, B0); PG8_MMA(1, 1, At, B1); PG8_BAR; PG8_SCHED;
            PG8_LDB(B0, 1, 0); PG8_LDB(B1, 1, 1); PG8_SCHED; PG8_LDA(At, 1, 0); PG8_STAGE(PG8_SA(0, 1), a2 + hstepA, voffA);
            PG8_WAIT_V(8); PG8_WAIT_L(0); PG8_BAR; PG8_MMA(0, 0, At, B0); PG8_MMA(0, 1, At, B1); PG8_BAR; PG8_SCHED;
            PG8_LDA(At, 1, 1); PG8_STAGE(PG8_SB(1, 0), b3, voffB); PG8_STAGE(PG8_SB(1, 1), b3 + hstepB, voffB); PG8_STAGE(PG8_SA(1, 0), a3, voffA);
            PG8_WAIT_V(8); PG8_WAIT_L(0); PG8_BAR; PG8_MMA(1, 0, At, B0); PG8_MMA(1, 1, At, B1); PG8_BAR; PG8_SCHED;
        }
        if (wr == 0) PG8_BAR;
        E(acc, cur, wr, wc, fr, fq);
        if (!has_next) break;
#pragma unroll
        for (int a = 0; a < 2; ++a)
#pragma unroll
            for (int b = 0; b < 2; ++b)
#pragma unroll
                for (int m = 0; m < 4; ++m)
#pragma unroll
                    for (int n = 0; n < 2; ++n) acc[a][b][m][n] = (f32x4){0.f, 0.f, 0.f, 0.f};
        cur = nxt; cA = nA; cB = nB; ++ui;
        if (wr == 1) PG8_BAR;
    }
    PG8_WAIT_V(0);
    PG8_BAR;
#undef PG8_SA
#undef PG8_SB
#undef PG8_STAGE
#undef PG8_LDA
#undef PG8_LDB
#undef PG8_MMA
#undef PG8_WAIT_V
#undef PG8_WAIT_L
#undef PG8_BAR
#undef PG8_SCHED
}
}

constexpr int NWAVES = 8, NTHR = NWAVES * 64;
constexpr int DM = 2048, NBATCH = 4, SEQ = 4096, DEPTH = 4, M = NBATCH * SEQ;
constexpr int HGW = 1024;
constexpr int SAH = 16, SAC = 256, SAR = 512;
constexpr int DFF = 5632;
constexpr int N1 = 9216, N3 = 5120, N10 = 2 * DFF;
constexpr float ALPHA = 1.6817928305074292f;
constexpr int MODW = 6 * DM;

constexpr size_t MiB = 1u << 20;
constexpr size_t WS_CTL = 0, CTL_ZERO_BYTES = 32768;
constexpr size_t WS_MOD = 1 * MiB;
constexpr size_t WS_LB = 2 * MiB;
constexpr size_t WS_MODP = 3 * MiB;
constexpr size_t WS_W1 = 9 * MiB;
constexpr size_t WS_W3 = WS_W1 + 36 * MiB;
constexpr size_t WS_W6 = WS_W3 + 5 * MiB;
constexpr size_t WS_W7 = WS_W6 + 2 * MiB;
constexpr size_t WS_W8 = WS_W7 + 8 * MiB;
constexpr size_t WS_W10 = WS_W8 + 8 * MiB;
constexpr size_t WS_W11 = WS_W10 + 44 * MiB;
constexpr size_t WS_X = WS_W11 + 22 * MiB;
constexpr size_t WS_R = WS_X + 128 * MiB;
constexpr size_t WS_H = WS_R + 128 * MiB;
constexpr size_t WS_QA = WS_H + 64 * MiB;
constexpr size_t WS_FA = WS_QA + 32 * MiB;
constexpr size_t WS_IA = WS_FA + 64 * MiB;
constexpr size_t WS_GA = WS_IA + 32 * MiB;
constexpr size_t WS_LAT = WS_GA + 32 * MiB;
constexpr size_t WS_GTA = WS_LAT + 64 * MiB;
constexpr size_t WS_GTB = WS_GTA + 64 * MiB;
constexpr size_t WS_CQN = WS_GTB + 64 * MiB;
constexpr size_t WS_CKV = WS_CQN + 16 * MiB;
constexpr size_t WS_KIDX = WS_CKV + 8 * MiB;
constexpr size_t WS_IDXW = WS_KIDX + 2 * MiB;
constexpr size_t WS_QB = WS_IDXW + 1 * MiB;
constexpr size_t WS_QIDX = WS_QB + 128 * MiB;
constexpr size_t WS_SEL = WS_QIDX + 32 * MiB;
constexpr size_t WS_YAB = WS_SEL + 8 * MiB;
constexpr size_t WS_MRG = WS_FA;
constexpr size_t WS_OB = WS_YAB + 64 * MiB;
constexpr size_t WS_BIG = WS_OB + 128 * MiB;
constexpr size_t WS_KSB = WS_BIG + 256 * MiB;
constexpr size_t WS_DEB = WS_KSB + 32 * MiB;
constexpr size_t WS_QSB = WS_DEB + 2 * MiB;
constexpr size_t WS_END = WS_QSB + 32 * MiB;

constexpr int CW_BAR = 4096;

constexpr int RING_BYTES = 131072;
constexpr int LDS_BYTES = 163840;
constexpr int LDSCTL_OFF = LDS_BYTES - 1024, MISC_OFF = LDSCTL_OFF + 320, SELL_OFF = 147456;

#define GAS __attribute__((address_space(1)))
#define LAS __attribute__((address_space(3)))
typedef unsigned short bf16;
typedef unsigned v4u __attribute__((ext_vector_type(4)));
typedef unsigned v2u __attribute__((ext_vector_type(2)));
typedef float f32x4 __attribute__((ext_vector_type(4)));
typedef float f32x16 __attribute__((ext_vector_type(16)));
typedef short bf16x8 __attribute__((ext_vector_type(8)));
typedef short v4s __attribute__((ext_vector_type(4)));
typedef GAS unsigned gu32;
#define LDS_WAIT() asm volatile("s_waitcnt lgkmcnt(0)" ::: "memory")
__device__ __forceinline__ unsigned f2bf(float f) { unsigned u = __builtin_bit_cast(unsigned, f); return (u + 0x7fffu + ((u >> 16) & 1u)) >> 16; }
__device__ __forceinline__ unsigned pk2(float lo, float hi) { return pg8::cvt_pk_bf16(lo, hi); }
__device__ __forceinline__ float bf2f(unsigned short b) { return __builtin_bit_cast(float, ((unsigned)b) << 16); }
__device__ __forceinline__ float bflo(unsigned w) { return __builtin_bit_cast(float, w << 16); }
__device__ __forceinline__ float bfhi(unsigned w) { return __builtin_bit_cast(float, w & 0xffff0000u); }
__device__ __forceinline__ float sigm(float x) { return __builtin_amdgcn_rcpf(1.f + __expf(-x)); }

__device__ __forceinline__ int lane_id() { unsigned m = ~0u; asm volatile("" : "+s"(m)); return (int)__builtin_amdgcn_mbcnt_hi(m, __builtin_amdgcn_mbcnt_lo(m, 0u)); }
#define XB_TMO      128
#define XB_XCNT(j)  (256  + 64 * (j))
#define XB_XSUB(j)  (1280 + 64 * (j))
#define XB_XGEN(j)  (2304 + 64 * (j))
#define XB_TOP      3328
#define XB_TOPGEN   3392
#define XCD_BAR_WORDS 3456
#define XB_SPIN_CAP (1u << 22)

__device__ __forceinline__ unsigned xb_ld(unsigned* p)              { return __hip_atomic_load(p, __ATOMIC_RELAXED, __HIP_MEMORY_SCOPE_AGENT); }
__device__ __forceinline__ unsigned xb_add(unsigned* p, unsigned v) { return __hip_atomic_fetch_add(p, v, __ATOMIC_RELAXED, __HIP_MEMORY_SCOPE_AGENT); }
__device__ __forceinline__ unsigned xb_xcc_id() { return (unsigned)__builtin_amdgcn_s_getreg((3 << 11) | 20) & 0xFu; }
#define XB_SPIN(cond, bar) do { unsigned _sp = 0; while (cond) { __builtin_amdgcn_s_sleep(1); \
    if ((++_sp & 255u) == 0u) { if (xb_ld(&(bar)[XB_TMO])) break; if (_sp > XB_SPIN_CAP) { atomicAdd(&(bar)[XB_TMO], 1u); break; } } } } while (0)

struct XcdBarrier { unsigned* bar; unsigned x; volatile LAS unsigned* st; int wave; };

__device__ __forceinline__ XcdBarrier xcd_barrier_post(unsigned* bar, volatile LAS unsigned* st) {
    XcdBarrier b; b.bar = bar; b.x = (unsigned)__builtin_amdgcn_readfirstlane((int)xb_xcc_id()); b.st = st;
    if (threadIdx.x == 0) (void)xb_add(&bar[XB_XCNT(b.x)], 1u);
    return b;
}
__device__ __forceinline__ void xcd_barrier_complete(unsigned* bar, unsigned x, unsigned& nloc, unsigned& nx) {
    const unsigned G = gridDim.x * gridDim.y * gridDim.z;
    unsigned sum, cnt, mine, sp = 0u;
    for (;;) {
        sum = 0u; cnt = 0u; mine = 0u;
#pragma unroll 1
        for (unsigned j = 0; j < 16; ++j) { const unsigned c = xb_ld(&bar[XB_XCNT(j)]); sum += c; cnt += (c > 0u) ? 1u : 0u; mine = (j == x) ? c : mine; }
        if (sum == G) break;
        __builtin_amdgcn_s_sleep(1);
        if ((++sp & 255u) == 0u) { if (xb_ld(&bar[XB_TMO])) break; if (sp > XB_SPIN_CAP) { atomicAdd(&bar[XB_TMO], 1u); break; } }
    }
    nloc = mine > 0u ? mine : 1u; nx = cnt > 0u ? cnt : 1u;
}
__device__ __forceinline__ void xcd_barrier(const XcdBarrier& b) {
    asm volatile("s_waitcnt vmcnt(0)" ::: "memory");
    __syncthreads();
    if (b.wave == 0 && lane_id() == 0) {
        unsigned* bar = b.bar;
        unsigned bx = b.x; asm volatile("" : "+s"(bx));
        __builtin_amdgcn_s_waitcnt(0);
        unsigned nloc = b.st[0], nx = b.st[1];
        const unsigned old = xb_add(&bar[XB_XSUB(bx)], 1u);
        const unsigned gen = old / nloc;
        if (old + 1u == (gen + 1u) * nloc) {
            __builtin_amdgcn_fence(__ATOMIC_RELEASE, "agent");
            asm volatile("s_waitcnt vmcnt(0)" ::: "memory");
            const unsigned og = xb_add(&bar[XB_TOP], 1u);
            const unsigned tg = og / nx;
            if (og + 1u == (tg + 1u) * nx) xb_add(&bar[XB_TOPGEN], 1u);
            else XB_SPIN(xb_ld(&bar[XB_TOPGEN]) == tg, bar);
            __builtin_amdgcn_fence(__ATOMIC_ACQUIRE, "agent");
            xb_add(&bar[XB_XGEN(bx)], 1u);
            asm volatile("s_waitcnt vmcnt(0)" ::: "memory");
        } else {
            XB_SPIN(xb_ld(&bar[XB_XGEN(bx)]) == gen, bar);
            __builtin_amdgcn_fence(__ATOMIC_ACQUIRE, "agent");
            asm volatile("s_waitcnt vmcnt(0)" ::: "memory");
        }
    }
    __syncthreads();
}

__device__ __forceinline__ void xswap16(float& a, float& b) { asm volatile("s_nop 1\n\tv_permlane16_swap_b32 %0, %1\n\ts_nop 1" : "+v"(a), "+v"(b)); }
__device__ __forceinline__ void xswap32(float& a, float& b) { asm volatile("s_nop 1\n\tv_permlane32_swap_b32 %0, %1\n\ts_nop 1" : "+v"(a), "+v"(b)); }
__device__ __forceinline__ float xmax16(float x) { float a = x, b = x; xswap16(a, b); return fmaxf(a, b); }
__device__ __forceinline__ float xmax32(float x) { float a = x, b = x; xswap32(a, b); return fmaxf(a, b); }
__device__ __forceinline__ float xsum16(float x) { float a = x, b = x; xswap16(a, b); return a + b; }
__device__ __forceinline__ float xsum32(float x) { float a = x, b = x; xswap32(a, b); return a + b; }

#define DPPF(x, ctrl) __builtin_bit_cast(float, __builtin_amdgcn_update_dpp(0, __builtin_bit_cast(int, (x)), (ctrl), 0xf, 0xf, true))
__device__ __forceinline__ float wmax_f(float x) {
    x = fmaxf(x, DPPF(x, 0xB1)); x = fmaxf(x, DPPF(x, 0x4E)); x = fmaxf(x, DPPF(x, 0x124)); x = fmaxf(x, DPPF(x, 0x128));
    x = xmax16(x); return xmax32(x);
}
__device__ __forceinline__ unsigned wprefix_u(unsigned x) {
    int v = (int)x;
    v += __builtin_amdgcn_update_dpp(0, v, 0x111, 0xf, 0xf, false);
    v += __builtin_amdgcn_update_dpp(0, v, 0x112, 0xf, 0xf, false);
    v += __builtin_amdgcn_update_dpp(0, v, 0x114, 0xf, 0xf, false);
    v += __builtin_amdgcn_update_dpp(0, v, 0x118, 0xf, 0xf, false);
    v += __builtin_amdgcn_update_dpp(0, v, 0x142, 0xa, 0xf, false);
    v += __builtin_amdgcn_update_dpp(0, v, 0x143, 0xc, 0xf, false);
    return (unsigned)v;
}

__device__ __forceinline__ float rowsum16(float x) { x += DPPF(x, 0xB1); x += DPPF(x, 0x4E); x += DPPF(x, 0x124); x += DPPF(x, 0x128); return x; }
__device__ __forceinline__ float wave_sum(float x) { x = rowsum16(x); x = xsum16(x); return xsum32(x); }
__device__ __forceinline__ float wave_max(float x) { return wmax_f(x); }
__device__ __forceinline__ int wave_sum_i(int v) { float f = wave_sum((float)v); return (int)(f + 0.5f); }
template <class Src>
__device__ __forceinline__ void cvt_load(const Src& src, int k0, int n0, int lane, float (&tv)[32]) {
#pragma unroll
    for (int i = 0; i < 32; ++i) tv[i] = src(k0 + 2 * i + (lane >> 5), n0 + (lane & 31));
}
__device__ __forceinline__ void cvt_store(const float (&tv)[32], bf16* WT, int K, int k0, int n0, LAS float* scr, int lane) {
#pragma unroll
    for (int i = 0; i < 32; ++i) scr[(2 * i + (lane >> 5)) * 33 + (lane & 31)] = tv[i];
    LDS_WAIT(); asm volatile("" ::: "memory");
    const int c = lane & 7;
#pragma unroll
    for (int j = 0; j < 4; ++j) { const int n = (lane >> 3) + 8 * j; const LAS float* s = scr + (8 * c) * 33 + n;
        v4u o; o.x = pk2(s[0 * 33], s[1 * 33]); o.y = pk2(s[2 * 33], s[3 * 33]); o.z = pk2(s[4 * 33], s[5 * 33]); o.w = pk2(s[6 * 33], s[7 * 33]);
        *(GAS v4u*)(WT + (size_t)(n0 + n) * K + k0 + 8 * c) = o; }
    LDS_WAIT(); asm volatile("" ::: "memory");
}

struct Args { const float* in[22]; float* out; unsigned char* ws; };

using pg8::Unit; using pg8::cvt_pk_bf16;
__device__ __forceinline__ void st_bf16x8(bf16* p, f32x4 v0, f32x4 v1) {
    v4u w; w.x = cvt_pk_bf16(v0[0], v0[1]); w.y = cvt_pk_bf16(v0[2], v0[3]); w.z = cvt_pk_bf16(v1[0], v1[1]); w.w = cvt_pk_bf16(v1[2], v1[3]);
    *(v4u*)p = w;
}
__device__ __forceinline__ void st_f32x8(float* p, f32x4 v0, f32x4 v1) { *(f32x4*)p = v0; *(f32x4*)(p + 4) = v1; }
__device__ __forceinline__ f32x4 sigm4(f32x4 v) { return (f32x4){sigm(v[0]), sigm(v[1]), sigm(v[2]), sigm(v[3])}; }
__device__ __forceinline__ f32x4 silu4(f32x4 v) { return (f32x4){v[0] * sigm(v[0]), v[1] * sigm(v[1]), v[2] * sigm(v[2]), v[3] * sigm(v[3])}; }
__device__ __forceinline__ f32x4 ldbf4(const bf16* p) { const v2u w = *(const v2u*)p; return (f32x4){bflo(w.x), bfhi(w.x), bflo(w.y), bfhi(w.y)}; }

#define EPI_LOOP(...) \
    _Pragma("unroll") for (int ai = 0; ai < 2; ++ai) _Pragma("unroll") for (int m = 0; m < 4; ++m) { const int row = row0 + ai * 128 + m * 16; \
        _Pragma("unroll") for (int bj = 0; bj < 2; ++bj) { const int col = colb + bj * 128; const f32x4 v0 = acc[ai][bj][m][0], v1 = acc[ai][bj][m][1]; __VA_ARGS__ } }

struct EpiProj {
    bf16* QA; bf16* FA; bf16* IA; bf16* GA; bf16* LAT; bf16* GTA; bf16* GTB;
    __device__ __forceinline__ void operator()(const f32x4 (&acc)[2][2][4][2], const Unit& u, int wr, int wc, int fr, int fq) const {
        const int row0 = u.pm * 256 + wr * 64 + fr, pn = u.pn; const int colb = (pn & 3) * 256 + wc * 32 + 8 * fq;
        if (pn < 4)       { EPI_LOOP( st_bf16x8(QA + (size_t)row * 1024 + col, v0, v1); ) }
        else if (pn < 8)  { EPI_LOOP( st_bf16x8(FA + (size_t)row * 1024 + col, v0, v1); ) }
        else if (pn < 12) { EPI_LOOP( st_bf16x8(IA + (size_t)row * 1024 + col, v0, v1); ) }
        else if (pn < 16) { EPI_LOOP( st_bf16x8(GA + (size_t)row * 1024 + col, silu4(v0), silu4(v1)); ) }
        else if (pn < 20) { EPI_LOOP( st_bf16x8(LAT + (size_t)row * 1024 + col, v0, v1); ) }
        else { bf16* G = pn < 28 ? GTA : GTB; const int cb2 = ((pn - 20) & 7) * 256 + wc * 32 + 8 * fq;
            _Pragma("unroll") for (int ai = 0; ai < 2; ++ai) _Pragma("unroll") for (int m = 0; m < 4; ++m) { const int row = row0 + ai * 128 + m * 16;
                _Pragma("unroll") for (int bj = 0; bj < 2; ++bj) st_bf16x8(G + (size_t)row * 2048 + cb2 + bj * 128, sigm4(acc[ai][bj][m][0]), sigm4(acc[ai][bj][m][1])); } }
    }
};
struct EpiQ {
    bf16* QB; bf16* QIDX;
    __device__ __forceinline__ void operator()(const f32x4 (&acc)[2][2][4][2], const Unit& u, int wr, int wc, int fr, int fq) const {
        const int row0 = u.pm * 256 + wr * 64 + fr, pn = u.pn;
        if (pn < 16) { const int colb = pn * 256 + wc * 32 + 8 * fq; EPI_LOOP( st_bf16x8(QB + (size_t)row * 4096 + col, v0, v1); ) }
        else { const int colb = (pn - 16) * 256 + wc * 32 + 8 * fq; EPI_LOOP( st_bf16x8(QIDX + (size_t)row * 1024 + col, v0, v1); ) }
    }
};
struct EpiBf {
    bf16* O; int ldc; int coff;
    __device__ __forceinline__ void operator()(const f32x4 (&acc)[2][2][4][2], const Unit& u, int wr, int wc, int fr, int fq) const {
        const int row0 = u.pm * 256 + wr * 64 + fr; const int colb = coff + u.pn * 256 + wc * 32 + 8 * fq;
        EPI_LOOP( st_bf16x8(O + (size_t)row * ldc + col, v0, v1); )
    }
};
struct HookGate {
    static constexpr bool ON = true; const bf16* GA_; const bf16* GB_;
    __device__ __forceinline__ void mid(f32x4 (&acc)[2][2][4][2], const Unit& u, int wr, int wc, int fr, int fq) const {
        asm volatile("" : "+v"(fr), "+v"(fq));
        const int row0 = u.pm * 256 + wr * 64 + fr; const int colb = u.pn * 256 + wc * 32 + 8 * fq;
#pragma unroll
        for (int ai = 0; ai < 2; ++ai)
#pragma unroll
            for (int m = 0; m < 4; ++m) { const int row = row0 + ai * 128 + m * 16;
#pragma unroll
                for (int bj = 0; bj < 2; ++bj) { const size_t o = (size_t)row * 2048 + colb + bj * 128;
                    const f32x4 a0 = ldbf4(GA_ + o), a1 = ldbf4(GA_ + o + 4), b0 = ldbf4(GB_ + o), b1 = ldbf4(GB_ + o + 4);
                    f32x4 r0, r1;
#pragma unroll
                    for (int j = 0; j < 4; ++j) { r0[j] = a0[j] * __builtin_amdgcn_rcpf(b0[j]); r1[j] = a1[j] * __builtin_amdgcn_rcpf(b1[j]); }
                    acc[ai][bj][m][0] = acc[ai][bj][m][0] * r0; acc[ai][bj][m][1] = acc[ai][bj][m][1] * r1; }
                asm volatile("" : "+v"(acc[ai][0][m][0]), "+v"(acc[ai][0][m][1]), "+v"(acc[ai][1][m][0]), "+v"(acc[ai][1][m][1]));
                if (m & 1) asm volatile("" ::: "memory"); }
    }
};
struct EpiGateM {
    const bf16* GB_; bf16* MRG_;
    __device__ __forceinline__ void operator()(const f32x4 (&acc)[2][2][4][2], const Unit& u, int wr, int wc, int fr, int fq) const {
        const int row0 = u.pm * 256 + wr * 64 + fr; const int colb = u.pn * 256 + wc * 32 + 8 * fq;
        EPI_LOOP( const size_t o = (size_t)row * 2048 + col; const f32x4 g0 = ldbf4(GB_ + o), g1 = ldbf4(GB_ + o + 4); st_bf16x8(MRG_ + o, v0 * g0, v1 * g1); )
    }
};
struct EpiGateA {
    float* T1; const bf16* GT;
    __device__ __forceinline__ void operator()(const f32x4 (&acc)[2][2][4][2], const Unit& u, int wr, int wc, int fr, int fq) const {
        const int row0 = u.pm * 256 + wr * 64 + fr; const int colb = u.pn * 256 + wc * 32 + 8 * fq;
        EPI_LOOP( const size_t o = (size_t)row * 2048 + col; const f32x4 g0 = ldbf4(GT + o), g1 = ldbf4(GT + o + 4); st_f32x8(T1 + o, v0 * g0, v1 * g1); )
    }
};
struct EpiGateB {
    const float* T1; const bf16* GT; bf16* MRG;
    __device__ __forceinline__ void operator()(const f32x4 (&acc)[2][2][4][2], const Unit& u, int wr, int wc, int fr, int fq) const {
        const int row0 = u.pm * 256 + wr * 64 + fr; const int colb = u.pn * 256 + wc * 32 + 8 * fq;
        EPI_LOOP( const size_t o = (size_t)row * 2048 + col; const f32x4 g0 = ldbf4(GT + o), g1 = ldbf4(GT + o + 4); const f32x4 t0 = *(const f32x4*)(T1 + o), t1 = *(const f32x4*)(T1 + o + 4);
                  st_bf16x8(MRG + o, t0 + v0 * g0, t1 + v1 * g1); )
    }
};
struct EpiRes {
    const float* X; const bf16* Xh; bf16* R; const float* gt;
    __device__ __forceinline__ void operator()(const f32x4 (&acc)[2][2][4][2], const Unit& u, int wr, int wc, int fr, int fq) const {
        const int row0 = u.pm * 256 + wr * 64 + fr; const int colb = u.pn * 256 + wc * 32 + 8 * fq; const float* g = gt + (size_t)(u.pm >> 4) * MODW;
        if (X) { EPI_LOOP( const size_t o = (size_t)row * 2048 + col; const f32x4 x0 = *(const f32x4*)(X + o), x1 = *(const f32x4*)(X + o + 4); const f32x4 g0 = *(const f32x4*)(g + col), g1 = *(const f32x4*)(g + col + 4);
                  st_bf16x8(R + o, x0 * ALPHA + (g0 + 1.f) * v0, x1 * ALPHA + (g1 + 1.f) * v1); ) }
        else { EPI_LOOP( const size_t o = (size_t)row * 2048 + col; const f32x4 x0 = ldbf4(Xh + o), x1 = ldbf4(Xh + o + 4); const f32x4 g0 = *(const f32x4*)(g + col), g1 = *(const f32x4*)(g + col + 4);
                  st_bf16x8(R + o, x0 * ALPHA + (g0 + 1.f) * v0, x1 * ALPHA + (g1 + 1.f) * v1); ) }
    }
};
struct EpiSwiglu {
    bf16* ACT;
    __device__ __forceinline__ void operator()(const f32x4 (&acc)[2][2][4][2], const Unit& u, int wr, int wc, int fr, int fq) const {
        const int row0 = u.pm * 256 + wr * 64 + fr; const int col = u.pn * 128 + wc * 32 + 8 * fq;
#pragma unroll
        for (int ai = 0; ai < 2; ++ai)
#pragma unroll
            for (int m = 0; m < 4; ++m) { const int row = row0 + ai * 128 + m * 16;
                st_bf16x8(ACT + (size_t)row * DFF + col, silu4(acc[ai][0][m][0]) * acc[ai][1][m][0], silu4(acc[ai][0][m][1]) * acc[ai][1][m][1]); }
    }
};

__global__ void __launch_bounds__(NTHR, 2) fwd_kernel(Args args) {
    extern __shared__ __attribute__((aligned(16))) unsigned char lds_raw[];
    LAS unsigned char* lds = (LAS unsigned char*)lds_raw;
    const int G = gridDim.x, blk = blockIdx.x;
    const int NGW = G * NWAVES, NT = G * NTHR;
    unsigned char* const ws_base = args.ws;
    gu32* ctl = (gu32*)(ws_base + WS_CTL);
    for (int u = threadIdx.x; u < (LDS_BYTES - LDSCTL_OFF) / 4; u += NTHR) ((LAS unsigned*)(lds + LDSCTL_OFF))[u] = 0u;
    __syncthreads();
    volatile LAS unsigned* MISC = (volatile LAS unsigned*)(lds + MISC_OFF);
    const int wave_s = __builtin_amdgcn_readfirstlane((int)(threadIdx.x >> 6));
    XcdBarrier bar = xcd_barrier_post((unsigned*)(ctl + CW_BAR), MISC + 8); bar.wave = wave_s;
    if (threadIdx.x == 0) { unsigned nloc_ = 0u, nx_ = 0u; xcd_barrier_complete(bar.bar, bar.x, nloc_, nx_); bar.st[0] = nloc_; bar.st[1] = nx_; }
    __syncthreads();
#define GRID_BAR() xcd_barrier(bar)

#define x_in ((const float*)(const GAS float*)args.in[0 + z_])
#define c_in ((const float*)(const GAS float*)args.in[1 + z_])
#define w_ada ((const float*)(const GAS float*)args.in[2 + z_])
#define b_ada ((const float*)(const GAS float*)args.in[3 + z_])
#define w_in ((const float*)(const GAS float*)args.in[4 + z_])
#define lb_logits ((const float*)(const GAS float*)args.in[5 + z_])
#define g_hg ((const float*)(const GAS float*)args.in[6 + z_])
#define w_pa ((const float*)(const GAS float*)args.in[7 + z_])
#define g_cq ((const float*)(const GAS float*)args.in[8 + z_])
#define g_ckv ((const float*)(const GAS float*)args.in[9 + z_])
#define w_uq ((const float*)(const GAS float*)args.in[10 + z_])
#define w_iq ((const float*)(const GAS float*)args.in[11 + z_])
#define w_uv ((const float*)(const GAS float*)args.in[12 + z_])
#define w_pb ((const float*)(const GAS float*)args.in[13 + z_])
#define w_out ((const float*)(const GAS float*)args.in[14 + z_])
#define ln1_g ((const float*)(const GAS float*)args.in[15 + z_])
#define ln1_b ((const float*)(const GAS float*)args.in[16 + z_])
#define w_gate ((const float*)(const GAS float*)args.in[17 + z_])
#define w_up ((const float*)(const GAS float*)args.in[18 + z_])
#define w_down ((const float*)(const GAS float*)args.in[19 + z_])
#define ln2_g ((const float*)(const GAS float*)args.in[20 + z_])
#define ln2_b ((const float*)(const GAS float*)args.in[21 + z_])
#define MOD  ((float*)(ws + WS_MOD))
#define LB   ((float*)(ws + WS_LB))
#define MODP ((float*)(ws + WS_MODP))
#define W1   ((bf16*)(ws + WS_W1))
#define W3   ((bf16*)(ws + WS_W3))
#define W6   ((bf16*)(ws + WS_W6))
#define W7   ((bf16*)(ws + WS_W7))
#define W8   ((bf16*)(ws + WS_W8))
#define W10  ((bf16*)(ws + WS_W10))
#define W11  ((bf16*)(ws + WS_W11))
#define XB   ((bf16*)(ws + WS_X))
#define RB   ((bf16*)(ws + WS_R))
#define HB   ((bf16*)(ws + WS_H))
#define QA   ((bf16*)(ws + WS_QA))
#define FA   ((bf16*)(ws + WS_FA))
#define IA   ((bf16*)(ws + WS_IA))
#define GA   ((bf16*)(ws + WS_GA))
#define LAT  ((bf16*)(ws + WS_LAT))
#define GTA  ((bf16*)(ws + WS_GTA))
#define GTB  ((bf16*)(ws + WS_GTB))
#define CQN  ((bf16*)(ws + WS_CQN))
#define CKV  ((bf16*)(ws + WS_CKV))
#define KIDX ((bf16*)(ws + WS_KIDX))
#define IDXW ((float*)(ws + WS_IDXW))
#define QB   ((bf16*)(ws + WS_QB))
#define QIDX ((bf16*)(ws + WS_QIDX))
#define SEL  ((unsigned short*)(ws + WS_SEL))
#define YAB  ((bf16*)(ws + WS_YAB))
#define MRG  ((bf16*)(ws + WS_MRG))
#define OB   ((bf16*)(ws + WS_OB))
#define ISC  ((float*)(ws + WS_BIG))
#define OP   ((float*)(ws + WS_BIG))
#define ACT  ((bf16*)(ws + WS_BIG))
#define KK   LAT
#define modl (MOD + (size_t)l * NBATCH * MODW)
#define KSB  ((bf16*)(ws + WS_KSB))
#define QSB  ((bf16*)(ws + WS_QSB))
#define KVT  ((float*)(ws + WS_BIG))
#define SPB  ((bf16*)(ws + WS_FA))
#define DEB  ((float*)(ws + WS_DEB))
#define PHASE_BEGIN { unsigned om_ = ~0u; asm volatile("" : "+s"(om_)); int tid = wave_s * 64 + (int)__builtin_amdgcn_mbcnt_hi(om_, __builtin_amdgcn_mbcnt_lo(om_, 0u)); asm volatile("" : "+v"(tid)); int z_ = 0; asm volatile("" : "+s"(z_)); (void)z_; GAS unsigned char* wsg_ = (GAS unsigned char*)ws_base; asm volatile("" : "+s"(wsg_)); unsigned char* ws = (unsigned char*)wsg_; const int lane = tid & 63, wave = __builtin_amdgcn_readfirstlane(tid >> 6); \
        const int gw = blk * NWAVES + wave, gtid = blk * NTHR + tid; LAS float* wscr = (LAS float*)(lds + wave * 16384); (void)lane; (void)gw; (void)gtid; (void)wscr;
#define PHASE_END }

#define CVT_DECODE(IT_, MID_, K0_, N0_) do { int r_ = (IT_); \
        if (r_ < I1) { MID_ = 0; K0_ = (r_ / (N1 / 32)) * 64; N0_ = (r_ % (N1 / 32)) * 32; } else { r_ -= I1; \
        if (r_ < I3) { MID_ = 1; K0_ = (r_ / (N3 / 32)) * 64; N0_ = (r_ % (N3 / 32)) * 32; } else { r_ -= I3; \
        if (r_ < I6) { MID_ = 2; K0_ = (r_ / 32) * 64; N0_ = (r_ % 32) * 32; } else { r_ -= I6; \
        if (r_ < I7) { MID_ = 3; K0_ = (r_ / (DM / 32)) * 64; N0_ = (r_ % (DM / 32)) * 32; } else { r_ -= I7; \
        if (r_ < I8) { MID_ = 4; K0_ = (r_ / (DM / 32)) * 64; N0_ = (r_ % (DM / 32)) * 32; } else { r_ -= I8; \
        if (r_ < I10) { MID_ = 5; K0_ = (r_ / (N10 / 32)) * 64; N0_ = (r_ % (N10 / 32)) * 32; } else { r_ -= I10; \
        MID_ = 6; K0_ = (r_ / (DM / 32)) * 64; N0_ = (r_ % (DM / 32)) * 32; } } } } } } } while (0)
#define CVT_LOAD(MID_, K0_, N0_, TV_) do { \
        if (MID_ == 0) cvt_load([=](int k, int n) -> float { return n < 4944 ? s_in[(size_t)k * 9040 + n] : (n < 5120 ? 0.f : s_in[(size_t)k * 9040 + n - 176]); }, K0_, N0_, lane, TV_); \
        else if (MID_ == 1) cvt_load([=](int k, int n) -> float { return n < 4096 ? s_uq[(size_t)k * 4096 + n] * 0.0625f : s_iq[(size_t)k * 1024 + n - 4096]; }, K0_, N0_, lane, TV_); \
        else if (MID_ == 2) cvt_load([=](int k, int n) -> float { const int h = n >> 6, v = n & 63, kk = k >> 8, c = k & 255; return kk == (h & 3) ? s_uv[((size_t)h * 256 + c) * 64 + v] : 0.f; }, K0_, N0_, lane, TV_); \
        else if (MID_ == 3) cvt_load([=](int k, int n) -> float { return k < 1024 ? s_pa[(size_t)k * DM + n] : s_pb[(size_t)(k - 1024) * DM + n]; }, K0_, N0_, lane, TV_); \
        else if (MID_ == 4) cvt_load([=](int k, int n) -> float { return s_out[(size_t)k * DM + n]; }, K0_, N0_, lane, TV_); \
        else if (MID_ == 5) cvt_load([=](int k, int n) -> float { const int pn = n >> 8, rr = n & 255; return rr < 128 ? s_g[(size_t)k * DFF + pn * 128 + rr] : s_u[(size_t)k * DFF + pn * 128 + rr - 128]; }, K0_, N0_, lane, TV_); \
        else cvt_load([=](int k, int n) -> float { return s_d[(size_t)k * DM + n]; }, K0_, N0_, lane, TV_); } while (0)
#define CONVERT_LAYER(L) do { const int l_ = (L); \
        const float* s_in = w_in + (size_t)l_ * DM * 9040; const float* s_uq = w_uq + (size_t)l_ * SAR * 4096; const float* s_iq = w_iq + (size_t)l_ * SAR * 1024; \
        const float* s_uv = w_uv + (size_t)l_ * 16 * 256 * 64; const float* s_pa = w_pa + (size_t)l_ * 1024 * DM; const float* s_pb = w_pb + (size_t)l_ * 1024 * DM; \
        const float* s_out = w_out + (size_t)l_ * DM * DM; const float* s_g = w_gate + (size_t)l_ * DM * DFF; const float* s_u = w_up + (size_t)l_ * DM * DFF; const float* s_d = w_down + (size_t)l_ * DFF * DM; \
        constexpr int I1 = (DM / 64) * (N1 / 32), I3 = (SAR / 64) * (N3 / 32), I6 = (1024 / 64) * (1024 / 32), I7 = (DM / 64) * (DM / 32), I8 = I7, I10 = (DM / 64) * (N10 / 32), I11 = (DFF / 64) * (DM / 32); \
        constexpr int NIT = I1 + I3 + I6 + I7 + I8 + I10 + I11; \
        float tv_[32]; int mid_ = 0, k0_ = 0, n0_ = 0; \
        { CVT_DECODE(gw, mid_, k0_, n0_); CVT_LOAD(mid_, k0_, n0_, tv_); } \
        for (int it = gw; it < NIT; it += NGW) { \
            float tc_[32]; _Pragma("unroll") for (int i = 0; i < 32; ++i) tc_[i] = tv_[i]; \
            const int mc_ = mid_, kc_ = k0_, nc_ = n0_; \
            { const int itn_ = it + NGW < NIT ? it + NGW : it; CVT_DECODE(itn_, mid_, k0_, n0_); CVT_LOAD(mid_, k0_, n0_, tv_); }     \
            bf16* wt_ = mc_ == 0 ? W1 : mc_ == 1 ? W3 : mc_ == 2 ? W6 : mc_ == 3 ? W7 : mc_ == 4 ? W8 : mc_ == 5 ? W10 : W11; \
            const int kk_ = mc_ == 0 ? DM : mc_ == 1 ? SAR : mc_ == 2 ? 1024 : mc_ == 3 ? DM : mc_ == 4 ? DM : mc_ == 5 ? DM : DFF; \
            cvt_store(tc_, wt_, kk_, kc_, nc_, wscr, lane); \
        } } while (0)


#ifndef HGRN_NAIVE
#define HGRN_NAIVE 0
#endif
#ifndef IDX_NAIVE
#define IDX_NAIVE 0
#endif
#ifndef ATT_NAIVE
#define ATT_NAIVE 0
#endif
#ifndef TOPK_OLD
#define TOPK_OLD 0
#endif
#ifndef REP_HB
#define REP_HB 1
#endif
#ifndef REP_HC
#define REP_HC 1
#endif
#ifndef REP_P4A
#define REP_P4A 1
#endif
#ifndef REP_P5
#define REP_P5 1
#endif
#ifndef REP_P9
#define REP_P9 1
#endif
#ifndef REP_P12
#define REP_P12 1
#endif
#ifndef REP_TOPK
#define REP_TOPK 1
#endif
#ifndef REP_ATT
#define REP_ATT 1
#endif
#ifndef DRY_ATT
#define DRY_ATT 0
#endif
#ifndef REP_M1
#define REP_M1 1
#endif
#ifndef REP_M2
#define REP_M2 1
#endif
#ifndef REP_M3
#define REP_M3 1
#endif

    PHASE_BEGIN
    {
        LAS float* sc = (LAS float*)lds;
        for (int i = tid; i < NBATCH * DM; i += NTHR) { const float v = c_in[i]; sc[i] = v * sigm(v); }
        __syncthreads();
        for (int item = gtid; item < 8 * 12288; item += NT) {
            const int ks = item / 12288, cg = item % 12288, l = cg / 3072, n4 = (cg % 3072) * 4;
            const float* wp = w_ada + ((size_t)l * DM + ks * 256) * MODW + n4;
            f32x4 a0 = {0.f, 0.f, 0.f, 0.f}, a1 = a0, a2 = a0, a3 = a0;
#pragma unroll 8
            for (int k = 0; k < 256; ++k) { const f32x4 w = *(const f32x4*)(wp + (size_t)k * MODW); const int kk = ks * 256 + k;
                a0 += w * sc[kk]; a1 += w * sc[2048 + kk]; a2 += w * sc[4096 + kk]; a3 += w * sc[6144 + kk]; }
            float* o = MODP + ((size_t)(ks * 4 + l) * 4) * MODW + n4;
            *(f32x4*)(o) = a0; *(f32x4*)(o + MODW) = a1; *(f32x4*)(o + 2 * MODW) = a2; *(f32x4*)(o + 3 * MODW) = a3;
        }
        if (gtid < 1024) {
            const float a = lb_logits[gtid], b = lb_logits[1024 + gtid], c = lb_logits[2048 + gtid], d = lb_logits[3072 + gtid];
            const float mx = fmaxf(fmaxf(a, b), fmaxf(c, d)); const float ea = expf(a - mx), eb = expf(b - mx), ec = expf(c - mx), ed = expf(d - mx); const float inv = 1.f / (ea + eb + ec + ed);
            LB[gtid] = 0.f; LB[1024 + gtid] = eb * inv; LB[2048 + gtid] = (eb + ec) * inv; LB[3072 + gtid] = (eb + ec + ed) * inv;
        }
        __syncthreads();
        CONVERT_LAYER(0);
    }
    PHASE_END
    GRID_BAR();
    PHASE_BEGIN
    for (int i = gtid; i < DEPTH * NBATCH * MODW; i += NT) {
        const int l = i / (NBATCH * MODW), r = i % (NBATCH * MODW), b = r / MODW, n = r % MODW;
        float s = b_ada[l * MODW + n];
#pragma unroll
        for (int ks = 0; ks < 8; ++ks) s += MODP[((size_t)(ks * 4 + l) * 4 + b) * MODW + n];
        MOD[i] = s;
    }
    PHASE_END
    GRID_BAR();
    PHASE_BEGIN
    for (size_t i0 = gtid; i0 < (size_t)M * DM / 8; i0 += (size_t)NT * 4) {
        f32x4 xa[4], xb[4], sa[4], sb[4], ha[4], hb[4];
#pragma unroll
        for (int t = 0; t < 4; ++t) { size_t gi = i0 + (size_t)t * NT; gi = gi < (size_t)M * DM / 8 ? gi : (size_t)M * DM / 8 - 1; const size_t e = gi * 8; const int row = (int)(e / DM), col = (int)(e % DM), b = row / SEQ; const float* md = MOD + (size_t)b * MODW;
            xa[t] = *(const f32x4*)(x_in + e); xb[t] = *(const f32x4*)(x_in + e + 4); sa[t] = *(const f32x4*)(md + 2048 + col); sb[t] = *(const f32x4*)(md + 2048 + col + 4); ha[t] = *(const f32x4*)(md + col); hb[t] = *(const f32x4*)(md + col + 4); }
#pragma unroll
        for (int t = 0; t < 4; ++t) { size_t gi = i0 + (size_t)t * NT; gi = gi < (size_t)M * DM / 8 ? gi : (size_t)M * DM / 8 - 1; const size_t e = gi * 8; st_bf16x8(HB + e, xa[t] * (sa[t] + 1.f) + ha[t], xb[t] * (sb[t] + 1.f) + hb[t]); }
    }
    PHASE_END
    GRID_BAR();

    for (int l = 0; l < DEPTH; ++l) {
        PHASE_BEGIN
        { pg8::Gemm g{HB, W1, M, N1, DM, DM, DM, 0}; pg8::StaticOrder S; S.init(M, N1, G, blk);
          EpiProj E{QA, FA, IA, GA, LAT, GTA, GTB}; pg8::gemm_phase(lds, g, S, E, tid); }
        PHASE_END
        GRID_BAR();
        for (int rep_ = 0; rep_ < REP_M1; ++rep_) {
        PHASE_BEGIN
        v2u ra0, ra1, rkv; unsigned short rki, riw;
        { const bf16* lr = LAT + (size_t)gw * 1024; ra0 = *(const v2u*)(lr + 4 * lane); ra1 = *(const v2u*)(lr + 256 + 4 * lane); rkv = *(const v2u*)(lr + 512 + 4 * lane); rki = lr[768 + lane]; riw = lr[832 + (lane & 15)]; }
        for (int row = gw; row < M; row += NGW) {
            const f32x4 a0 = (f32x4){bflo(ra0.x), bfhi(ra0.x), bflo(ra0.y), bfhi(ra0.y)}, a1 = (f32x4){bflo(ra1.x), bfhi(ra1.x), bflo(ra1.y), bfhi(ra1.y)}, kv = (f32x4){bflo(rkv.x), bfhi(rkv.x), bflo(rkv.y), bfhi(rkv.y)};
            const float ki = bf2f(rki), iw = bf2f(riw);
            { const int rn = row + NGW < M ? row + NGW : row; const bf16* lr = LAT + (size_t)rn * 1024;
              ra0 = *(const v2u*)(lr + 4 * lane); ra1 = *(const v2u*)(lr + 256 + 4 * lane); rkv = *(const v2u*)(lr + 512 + 4 * lane); rki = lr[768 + lane]; riw = lr[832 + (lane & 15)]; }
            float sq = a0[0] * a0[0] + a0[1] * a0[1] + a0[2] * a0[2] + a0[3] * a0[3] + a1[0] * a1[0] + a1[1] * a1[1] + a1[2] * a1[2] + a1[3] * a1[3];
            float sk = kv[0] * kv[0] + kv[1] * kv[1] + kv[2] * kv[2] + kv[3] * kv[3];
            sq = wave_sum(sq); sk = wave_sum(sk);
            const float rq = 1.0f / sqrtf(sq * (1.f / 512.f) + 1e-6f), rk = 1.0f / sqrtf(sk * (1.f / 256.f) + 1e-6f);
            const f32x4 g0 = *(const f32x4*)(g_cq + l * 512 + 4 * lane), g1 = *(const f32x4*)(g_cq + l * 512 + 256 + 4 * lane), gk = *(const f32x4*)(g_ckv + l * 256 + 4 * lane);
            v2u o; f32x4 t = a0 * rq * g0; o.x = pk2(t[0], t[1]); o.y = pk2(t[2], t[3]); *(v2u*)(CQN + (size_t)row * 512 + 4 * lane) = o;
            t = a1 * rq * g1; o.x = pk2(t[0], t[1]); o.y = pk2(t[2], t[3]); *(v2u*)(CQN + (size_t)row * 512 + 256 + 4 * lane) = o;
            t = kv * rk * gk; o.x = pk2(t[0], t[1]); o.y = pk2(t[2], t[3]); *(v2u*)(CKV + (size_t)row * 256 + 4 * lane) = o;
            KIDX[(size_t)row * 64 + lane] = (bf16)f2bf(ki);
            if (lane < 16) IDXW[(size_t)row * 16 + lane] = iw * 0.03125f;
        }
        PHASE_END
        PHASE_BEGIN
        {
            const int cp = tid & 63, sg = tid >> 6;
            LAS unsigned char* KST = lds;
            LAS unsigned char* VTL = lds + 18432;
            LAS float* SEGT = (LAS float*)(lds + 36864);
            LAS float* G63 = (LAS float*)(lds + 40960);
            unsigned pfa[8], pq[8], pv[8];
#define HA_REQ(U_) do { int uu_ = (U_); asm volatile("" : "+s"(uu_)); const int bh_ = uu_ >> 6, c_ = uu_ & 63, b_ = bh_ >> 3, h_ = bh_ & 7; \
                const size_t rowb_ = (size_t)b_ * SEQ + c_ * 64 + sg * 8; const int col_ = h_ * 128 + 2 * cp; \
                _Pragma("unroll") for (int i = 0; i < 8; ++i) { pfa[i] = *(const unsigned*)(FA + (rowb_ + i) * 1024 + col_); pq[i] = *(const unsigned*)(QA + (rowb_ + i) * 1024 + col_); pv[i] = *(const unsigned*)(IA + (rowb_ + i) * 1024 + col_); } } while (0)
            HA_REQ(blk);
            for (int u = blk; u < 2048; u += G) {
                const int bh = u >> 6, c = u & 63, b = bh >> 3, h = bh & 7;
                const size_t rowb = (size_t)b * SEQ + c * 64 + sg * 8; const int col = h * 128 + 2 * cp;
                const float lb0 = LB[l * 1024 + col], lb1 = LB[l * 1024 + col + 1];
                float lf0[8], lf1[8], kk0[8], kk1[8]; unsigned cq[8], cv[8];
#pragma unroll
                for (int i = 0; i < 8; ++i) { cq[i] = pq[i]; cv[i] = pv[i]; }
#pragma unroll
                for (int i = 0; i < 8; ++i) { const float2 fa = make_float2(bflo(pfa[i]), bfhi(pfa[i]));
                    const float f0 = fminf(fmaxf(lb0 + (1.f - lb0) * sigm(fa.x), 1e-6f), 1.f), f1 = fminf(fmaxf(lb1 + (1.f - lb1) * sigm(fa.y), 1e-6f), 1.f);
                    lf0[i] = __logf(f0); lf1[i] = __logf(f1); kk0[i] = (1.f - lb0) * sigm(-fa.x); kk1[i] = (1.f - lb1) * sigm(-fa.y); }
#pragma unroll
                for (int i = 1; i < 8; ++i) { lf0[i] += lf0[i - 1]; lf1[i] += lf1[i - 1]; }
                SEGT[sg * 128 + 2 * cp] = lf0[7]; SEGT[sg * 128 + 2 * cp + 1] = lf1[7];
                HA_REQ(u + G < 2048 ? u + G : u);
                __syncthreads();
                float pre0 = 0.f, pre1 = 0.f, r0 = 0.f, r1 = 0.f, t0 = 0.f, t1 = 0.f;
#pragma unroll
                for (int s2 = 0; s2 < 8; ++s2) { const float a0 = SEGT[s2 * 128 + 2 * cp], a1 = SEGT[s2 * 128 + 2 * cp + 1];
                    if (s2 < sg) { pre0 += a0; pre1 += a1; } if (s2 < 4) { r0 += a0; r1 += a1; } t0 += a0; t1 += a1; }
                unsigned ksw0[4], ksw1[4], vw0[4], vw1[4]; float ks0p = 0.f, ks1p = 0.f, v0p = 0.f, v1p = 0.f;
#pragma unroll
                for (int i = 0; i < 8; ++i) {
                    const float b0 = pre0 + lf0[i], b1 = pre1 + lf1[i];
                    const unsigned qw = cq[i]; const unsigned vw = cv[i];
                    const float qs0 = bflo(qw) * __expf(b0 - r0), qs1 = bfhi(qw) * __expf(b1 - r1);
                    const float ks0 = kk0[i] * __expf(r0 - b0), ks1 = kk1[i] * __expf(r1 - b1);
                    *(unsigned*)(QSB + (rowb + i) * 1024 + col) = pk2(qs0, qs1);
                    *(unsigned*)(KSB + (rowb + i) * 1024 + col) = pk2(ks0, ks1);
                    if (i & 1) { ksw0[i >> 1] = pk2(ks0p, ks0); ksw1[i >> 1] = pk2(ks1p, ks1); vw0[i >> 1] = pk2(v0p, bflo(vw)); vw1[i >> 1] = pk2(v1p, bfhi(vw)); }
                    else { ks0p = ks0; ks1p = ks1; v0p = bflo(vw); v1p = bfhi(vw); }
                }
                *(LAS v4u*)(KST + (2 * cp) * 144 + sg * 16) = (v4u){ksw0[0], ksw0[1], ksw0[2], ksw0[3]};
                *(LAS v4u*)(KST + (2 * cp + 1) * 144 + sg * 16) = (v4u){ksw1[0], ksw1[1], ksw1[2], ksw1[3]};
                *(LAS v4u*)(VTL + (2 * cp) * 144 + sg * 16) = (v4u){vw0[0], vw0[1], vw0[2], vw0[3]};
                *(LAS v4u*)(VTL + (2 * cp + 1) * 144 + sg * 16) = (v4u){vw1[0], vw1[1], vw1[2], vw1[3]};
                if (sg == 7) { float* de = DEB + (size_t)u * 256; *(float2*)(de + 2 * cp) = make_float2(__expf(r0), __expf(r1)); *(float2*)(de + 128 + 2 * cp) = make_float2(__expf(t0), __expf(t1));
                    G63[2 * cp] = __expf(t0 - r0); G63[2 * cp + 1] = __expf(t1 - r1); }
                __syncthreads();
                { const int kt = wave >> 1, vt0 = (wave & 1) * 2, lr = lane & 31, lh = lane >> 5;
                  f32x16 acc0, acc1;
#pragma unroll
                  for (int r = 0; r < 16; ++r) { acc0[r] = 0.f; acc1[r] = 0.f; }
#pragma unroll
                  for (int s4 = 0; s4 < 4; ++s4) {
                      const bf16x8 kb = *(const LAS bf16x8*)(KST + (kt * 32 + lr) * 144 + (s4 * 16 + 8 * lh) * 2);
                      const bf16x8 a0 = *(const LAS bf16x8*)(VTL + (vt0 * 32 + lr) * 144 + (s4 * 16 + 8 * lh) * 2);
                      const bf16x8 a1 = *(const LAS bf16x8*)(VTL + ((vt0 + 1) * 32 + lr) * 144 + (s4 * 16 + 8 * lh) * 2);
                      acc0 = __builtin_amdgcn_mfma_f32_32x32x16_bf16(a0, kb, acc0, 0, 0, 0); acc1 = __builtin_amdgcn_mfma_f32_32x32x16_bf16(a1, kb, acc1, 0, 0, 0); }
                  float* kvt = KVT + (size_t)u * 16384 + kt * 32 + lr; const float g = G63[kt * 32 + lr];
#pragma unroll
                  for (int r = 0; r < 16; ++r) { const int vv = 8 * (r >> 2) + 4 * lh + (r & 3);
                      kvt[(size_t)(vt0 * 32 + vv) * 128] = acc0[r] * g; kvt[(size_t)((vt0 + 1) * 32 + vv) * 128] = acc1[r] * g; } }
                __syncthreads();
            }
        }
#undef HA_REQ
        PHASE_END
        GRID_BAR();
        }
        for (int rep_ = 0; rep_ < REP_M2; ++rep_) {
        PHASE_BEGIN
        for (int item = gtid; item < 32 * 4096; item += NT) {
            const int bh = item >> 12, v = (item >> 5) & 127, k4 = (item & 31) * 4;
            f32x4 S = {0.f, 0.f, 0.f, 0.f};
            for (int c0 = 0; c0 < 64; c0 += 8) {
                f32x4 kv[8], dd[8], ee[8];
#pragma unroll
                for (int j = 0; j < 8; ++j) { const size_t u = (size_t)bh * 64 + c0 + j; kv[j] = *(const f32x4*)(KVT + u * 16384 + v * 128 + k4); ee[j] = *(const f32x4*)(DEB + u * 256 + k4); dd[j] = *(const f32x4*)(DEB + u * 256 + 128 + k4); }
#pragma unroll
                for (int j = 0; j < 8; ++j) { const size_t u = (size_t)bh * 64 + c0 + j; const f32x4 sp = S * ee[j]; v2u w; w.x = pk2(sp[0], sp[1]); w.y = pk2(sp[2], sp[3]);
                    *(v2u*)(SPB + u * 16384 + v * 128 + k4) = w; S = S * dd[j] + kv[j]; }
            }
        }
        PHASE_END
        PHASE_BEGIN
        { pg8::Gemm g{CQN, W3, M, N3, SAR, SAR, SAR, 0}; pg8::StaticOrder S; S.init(M, N3, G, blk);
          EpiQ E{QB, QIDX}; pg8::gemm_phase(lds, g, S, E, tid); }
        PHASE_END
        GRID_BAR();
        }
        for (int rep_ = 0; rep_ < REP_M3; ++rep_) {
        PHASE_BEGIN
        {
            LAS unsigned char* QSL = lds;
            LAS unsigned char* KSL = lds + 17408;
            LAS unsigned char* VTL = lds + 34816;
            LAS unsigned char* SPL = lds + 53248;
            LAS unsigned char* AL = lds + 88064;
            LAS float* SSQ = (LAS float*)(lds + 97280);
            const int cp = tid & 63, sg = tid >> 6, lr = lane & 31, lh = lane >> 5;
            v4u rq[2], rk[2], rs[4]; unsigned rv[8]; unsigned short rg[16];
#define HC_REQ(U_) do { int uu_ = (U_); asm volatile("" : "+s"(uu_));   const int bh_ = uu_ >> 6, c_ = uu_ & 63, b_ = bh_ >> 3, h_ = bh_ & 7; const size_t row0_ = (size_t)b_ * SEQ + c_ * 64; const int col0_ = h_ * 128; \
                _Pragma("unroll") for (int j = 0; j < 2; ++j) { const int q = tid + 512 * j, rr = q >> 4, cc = q & 15; \
                    rq[j] = *(const v4u*)(QSB + (row0_ + rr) * 1024 + col0_ + cc * 8); rk[j] = *(const v4u*)(KSB + (row0_ + rr) * 1024 + col0_ + cc * 8); } \
                _Pragma("unroll") for (int j = 0; j < 4; ++j) { const int q = tid + 512 * j, rr = q >> 4, cc = q & 15; rs[j] = *(const v4u*)(SPB + (size_t)uu_ * 16384 + rr * 128 + cc * 8); } \
                _Pragma("unroll") for (int i = 0; i < 8; ++i) rv[i] = *(const unsigned*)(IA + (row0_ + sg * 8 + i) * 1024 + col0_ + 2 * cp); \
                { const int it_ = wave >> 2, vt_ = wave & 3; const int colg_ = col0_ + vt_ * 32 + lr; \
                  _Pragma("unroll") for (int r = 0; r < 16; ++r) { const int ii = it_ * 32 + 8 * (r >> 2) + 4 * lh + (r & 3); rg[r] = GA[(row0_ + ii) * 1024 + colg_]; } } } while (0)
            HC_REQ(blk);
            for (int u = blk; u < 2048; u += G) {
                const int bh = u >> 6, c = u & 63, b = bh >> 3, h = bh & 7;
                const size_t row0 = (size_t)b * SEQ + c * 64; const int col0 = h * 128;
#pragma unroll
                for (int j = 0; j < 2; ++j) { const int q = tid + 512 * j, rr = q >> 4, cc = q & 15;
                    *(LAS v4u*)(QSL + rr * 272 + cc * 16) = rq[j]; *(LAS v4u*)(KSL + rr * 272 + cc * 16) = rk[j]; }
#pragma unroll
                for (int j = 0; j < 4; ++j) { const int q = tid + 512 * j, rr = q >> 4, cc = q & 15; *(LAS v4u*)(SPL + rr * 272 + cc * 16) = rs[j]; }
                { unsigned vw0[4], vw1[4]; float v0p = 0.f, v1p = 0.f;
#pragma unroll
                  for (int i = 0; i < 8; ++i) { const unsigned vw = rv[i];
                      if (i & 1) { vw0[i >> 1] = pk2(v0p, bflo(vw)); vw1[i >> 1] = pk2(v1p, bfhi(vw)); } else { v0p = bflo(vw); v1p = bfhi(vw); } }
                  *(LAS v4u*)(VTL + (2 * cp) * 144 + sg * 16) = (v4u){vw0[0], vw0[1], vw0[2], vw0[3]};
                  *(LAS v4u*)(VTL + (2 * cp + 1) * 144 + sg * 16) = (v4u){vw1[0], vw1[1], vw1[2], vw1[3]}; }
                float gav[16];
#pragma unroll
                for (int r = 0; r < 16; ++r) gav[r] = bf2f(rg[r]);
                HC_REQ(u + G < 2048 ? u + G : u);
                __syncthreads();
                if (wave < 4) {
                    const int it = wave >> 1, jt = wave & 1;
                    f32x16 acc;
#pragma unroll
                    for (int r = 0; r < 16; ++r) acc[r] = 0.f;
                    if (!(it == 0 && jt == 1)) {
#pragma unroll
                        for (int s8 = 0; s8 < 8; ++s8) {
                            const bf16x8 a = *(const LAS bf16x8*)(QSL + (it * 32 + lr) * 272 + (s8 * 16 + 8 * lh) * 2);
                            const bf16x8 bb = *(const LAS bf16x8*)(KSL + (jt * 32 + lr) * 272 + (s8 * 16 + 8 * lh) * 2);
                            acc = __builtin_amdgcn_mfma_f32_32x32x16_bf16(a, bb, acc, 0, 0, 0); } }
                    const int jj = jt * 32 + lr;
#pragma unroll
                    for (int r = 0; r < 16; ++r) { const int ii = it * 32 + 8 * (r >> 2) + 4 * lh + (r & 3); const float x = (jj <= ii) ? acc[r] : 0.f;
                        *(LAS unsigned short*)(AL + ii * 144 + jj * 2) = (unsigned short)(pk2(x, 0.f) & 0xffffu); }
                }
                __syncthreads();
                { const int it = wave >> 2, vt = wave & 3;
                  f32x16 acc;
#pragma unroll
                  for (int r = 0; r < 16; ++r) acc[r] = 0.f;
#pragma unroll
                  for (int s4 = 0; s4 < 4; ++s4) {
                      const bf16x8 a = *(const LAS bf16x8*)(AL + (it * 32 + lr) * 144 + (s4 * 16 + 8 * lh) * 2);
                      const bf16x8 bb = *(const LAS bf16x8*)(VTL + (vt * 32 + lr) * 144 + (s4 * 16 + 8 * lh) * 2);
                      acc = __builtin_amdgcn_mfma_f32_32x32x16_bf16(a, bb, acc, 0, 0, 0); }
#pragma unroll
                  for (int s8 = 0; s8 < 8; ++s8) {
                      const bf16x8 a = *(const LAS bf16x8*)(QSL + (it * 32 + lr) * 272 + (s8 * 16 + 8 * lh) * 2);
                      const bf16x8 bb = *(const LAS bf16x8*)(SPL + (vt * 32 + lr) * 272 + (s8 * 16 + 8 * lh) * 2);
                      acc = __builtin_amdgcn_mfma_f32_32x32x16_bf16(a, bb, acc, 0, 0, 0); }
#pragma unroll
                  for (int r = 0; r < 16; ++r) { float q2 = acc[r] * acc[r];
                      q2 = xsum16(rowsum16(q2));
                      if (lr == 0) SSQ[vt * 64 + it * 32 + 8 * (r >> 2) + 4 * lh + (r & 3)] = q2; }
                  __syncthreads();
                  const int colg = col0 + vt * 32 + lr; const float gg = g_hg[l * 1024 + colg];
#pragma unroll
                  for (int r = 0; r < 16; ++r) { const int ii = it * 32 + 8 * (r >> 2) + 4 * lh + (r & 3);
                      const float ss = SSQ[ii] + SSQ[64 + ii] + SSQ[128 + ii] + SSQ[192 + ii]; const float rn = 1.0f / sqrtf(ss * (1.f / 128.f) + 1e-6f);
                      YAB[(row0 + ii) * 2048 + colg] = (bf16)(pk2(acc[r] * rn * gg * gav[r], 0.f) & 0xffffu); }
                }
                __syncthreads();
            }
        }
#undef HC_REQ
        PHASE_END
        PHASE_BEGIN
        for (int ub = blk * NWAVES; ub < 2048; ub += NGW) {
            const int unit = ub + wave;
            const int b = ub >> 9, j = unit & 511, lr = lane & 31, lh = lane >> 5;
            const int qsel = (lr >> 2) & 1, head = (lr >> 3) * 4 + (lr & 3);
            const int qlo = 4 * j, qhi = 4 * (1023 - j);
            const int nlo = ((qlo >> 6) + 1) * 64, nhi = ((qhi >> 6) + 1) * 64;
            const int nlo8 = (nlo + 511) & ~511, nhi8 = (nhi + 511) & ~511;
            const int nmax8 = (((((4 * (1023 - (ub & 511))) >> 6) + 1) * 64) + 511) & ~511;
            bf16x8 A[4][4]; float W[4][16];
#pragma unroll
            for (int p = 0; p < 4; ++p) { const size_t qb = (size_t)b * SEQ + (p < 2 ? qlo + 2 * p : qhi + 2 * (p - 2));
#pragma unroll
                for (int ks = 0; ks < 4; ++ks) A[p][ks] = *(const bf16x8*)(QIDX + (qb + qsel) * 1024 + head * 64 + ks * 16 + lh * 8);
#pragma unroll
                for (int r4 = 0; r4 < 4; ++r4) { const f32x4 w = *(const f32x4*)(IDXW + (qb + lh) * 16 + r4 * 4); W[p][r4 * 4] = w[0]; W[p][r4 * 4 + 1] = w[1]; W[p][r4 * 4 + 2] = w[2]; W[p][r4 * 4 + 3] = w[3]; } }
            const bf16* kb = KIDX + (size_t)b * SEQ * 64;
            v4u stg[4];
#pragma unroll
            for (int i = 0; i < 4; ++i) { const int pc = tid + 512 * i; stg[i] = *(const v4u*)(kb + (size_t)(pc >> 3) * 64 + (pc & 7) * 8); }
#pragma unroll
            for (int i = 0; i < 4; ++i) { const int pc = tid + 512 * i; *(LAS v4u*)(lds + (pc >> 3) * 144 + (pc & 7) * 16) = stg[i]; }
            __syncthreads();
            for (int c0 = 0; c0 < nmax8; c0 += 256) {
                const int cb = (c0 >> 8) & 1; const bool more = c0 + 256 < nmax8;
                if (more) {
#pragma unroll
                    for (int i = 0; i < 4; ++i) { const int pc = tid + 512 * i; stg[i] = *(const v4u*)(kb + (size_t)(c0 + 256 + (pc >> 3)) * 64 + (pc & 7) * 8); } }
                LAS unsigned char* kbuf = lds + cb * 36864;
#pragma unroll 1
                for (int tl = 0; tl < 8; ++tl) {
                    const int s0 = c0 + tl * 32;
                    if (s0 >= nhi8) break;
#pragma unroll
                    for (int p = 0; p < 4; ++p) { const int np = p < 2 ? nlo : nhi, np8 = p < 2 ? nlo8 : nhi8;
                        if (s0 >= np && s0 < np8) { const size_t q = (size_t)b * SEQ + (p < 2 ? qlo + 2 * p : qhi + 2 * (p - 2)) + lh; ISC[q * 4096 + s0 + lr] = -1.0e30f; } }
                    if (s0 >= nhi) continue;
                    bf16x8 B[4];
#pragma unroll
                    for (int ks = 0; ks < 4; ++ks) B[ks] = *(const LAS bf16x8*)(kbuf + (tl * 32 + lr) * 144 + ks * 32 + lh * 16);
#define IDX_FINISH(P_, ACC_) do { float sc_ = 0.f; _Pragma("unroll") for (int r = 0; r < 16; ++r) sc_ += W[P_][r] * fmaxf(ACC_[r], 0.f); \
                        const size_t q_ = (size_t)b * SEQ + ((P_) < 2 ? qlo + 2 * (P_) : qhi + 2 * ((P_) - 2)) + lh; ISC[q_ * 4096 + s0 + lr] = sc_; } while (0)
                    if (s0 < nlo) {
                        f32x16 c0_, c1_, c2_, c3_;
#pragma unroll
                        for (int r = 0; r < 16; ++r) { c0_[r] = 0.f; c1_[r] = 0.f; c2_[r] = 0.f; c3_[r] = 0.f; }
#pragma unroll
                        for (int ks = 0; ks < 4; ++ks) { c0_ = __builtin_amdgcn_mfma_f32_32x32x16_bf16(A[0][ks], B[ks], c0_, 0, 0, 0); c1_ = __builtin_amdgcn_mfma_f32_32x32x16_bf16(A[1][ks], B[ks], c1_, 0, 0, 0);
                            c2_ = __builtin_amdgcn_mfma_f32_32x32x16_bf16(A[2][ks], B[ks], c2_, 0, 0, 0); c3_ = __builtin_amdgcn_mfma_f32_32x32x16_bf16(A[3][ks], B[ks], c3_, 0, 0, 0); }
                        IDX_FINISH(0, c0_); IDX_FINISH(1, c1_); IDX_FINISH(2, c2_); IDX_FINISH(3, c3_);
                    } else {
                        f32x16 c2_, c3_;
#pragma unroll
                        for (int r = 0; r < 16; ++r) { c2_[r] = 0.f; c3_[r] = 0.f; }
#pragma unroll
                        for (int ks = 0; ks < 4; ++ks) { c2_ = __builtin_amdgcn_mfma_f32_32x32x16_bf16(A[2][ks], B[ks], c2_, 0, 0, 0); c3_ = __builtin_amdgcn_mfma_f32_32x32x16_bf16(A[3][ks], B[ks], c3_, 0, 0, 0); }
                        IDX_FINISH(2, c2_); IDX_FINISH(3, c3_);
                    }
#undef IDX_FINISH
                }
                if (more) {
#pragma unroll
                    for (int i = 0; i < 4; ++i) { const int pc = tid + 512 * i; *(LAS v4u*)(lds + (cb ^ 1) * 36864 + (pc >> 3) * 144 + (pc & 7) * 16) = stg[i]; } }
                __syncthreads();
            }
        }
        PHASE_END
        GRID_BAR();
        }
        for (int rep_ = 0; rep_ < REP_P5; ++rep_) {
        PHASE_BEGIN
        {
            LAS unsigned char* VB = lds + wave * 18432;
            LAS unsigned short* SELW = (LAS unsigned short*)(VB + 17408);
            const int hd = lane & 15, g = lane >> 4, qq = hd >> 2, pp = hd & 3;
            const float slope = exp2f(-0.5f * (float)(hd + 1));
            for (int q = gw; q < M; q += NGW) {
                const int b = q / SEQ, pos = q % SEQ, qc = pos >> 6; const int nsel = qc < 4 ? (qc + 1) * 64 : 256;
                for (int rtk_ = 0; rtk_ < REP_TOPK; ++rtk_) {
                int lane_t = lane; asm volatile("" : "+v"(lane_t));
                if (qc < 4) { const unsigned e0 = 4 * lane_t; const bool ok = 4 * lane_t < nsel; v2u z; z.x = ok ? (e0 | ((e0 + 1) << 16)) : 0u; z.y = ok ? ((e0 + 2) | ((e0 + 3) << 16)) : 0u; *(LAS v2u*)(SELW + 4 * lane_t) = z; }
                else {
                    LAS unsigned* HIST = (LAS unsigned*)VB;
                    const int nb8 = (qc + 8) >> 3;
                    float v[64];
#pragma unroll
                    for (int g8 = 0; g8 < 8; ++g8) {
                        if (g8 < nb8) {
#pragma unroll
                            for (int j = 0; j < 8; ++j) v[g8 * 8 + j] = ISC[(size_t)q * 4096 + (g8 * 8 + j) * 64 + lane_t];
                        } else {
#pragma unroll
                            for (int j = 0; j < 8; ++j) v[g8 * 8 + j] = -1.0e30f; } }
                    float vmx = v[0], vmn = fminf(fminf(fminf(v[0], v[1]), fminf(v[2], v[3])), v[4]);
#pragma unroll
                    for (int i = 1; i < 64; ++i) vmx = fmaxf(vmx, v[i]);
                    vmx = wmax_f(vmx); vmn = -wmax_f(-vmn);
                    const float rng = vmx - vmn; const float s20 = rng > 0.f ? 1048574.0f / rng : 0.f;
#define ZERO_HIST() do { *(LAS v4u*)(HIST + 16 * lane) = (v4u){0u, 0u, 0u, 0u}; *(LAS v4u*)(HIST + 16 * lane + 4) = (v4u){0u, 0u, 0u, 0u}; *(LAS v4u*)(HIST + 16 * lane + 8) = (v4u){0u, 0u, 0u, 0u}; \
                        *(LAS v4u*)(HIST + 16 * lane + 12) = (v4u){0u, 0u, 0u, 0u}; HIST[1024 + lane] = 0u; } while (0)
#define SCAN_HIST(R_, BIN_, AB_) do { unsigned hh_[16]; const int hb_ = 1008 - 16 * lane; \
                        { const v4u h0 = *(const LAS v4u*)(HIST + hb_), h1 = *(const LAS v4u*)(HIST + hb_ + 4), h2 = *(const LAS v4u*)(HIST + hb_ + 8), h3 = *(const LAS v4u*)(HIST + hb_ + 12); \
                          hh_[0] = h0.x; hh_[1] = h0.y; hh_[2] = h0.z; hh_[3] = h0.w; hh_[4] = h1.x; hh_[5] = h1.y; hh_[6] = h1.z; hh_[7] = h1.w; hh_[8] = h2.x; hh_[9] = h2.y; hh_[10] = h2.z; hh_[11] = h2.w; hh_[12] = h3.x; hh_[13] = h3.y; hh_[14] = h3.z; hh_[15] = h3.w; } \
                        unsigned tot_ = 0u; _Pragma("unroll") for (int k = 0; k < 16; ++k) tot_ += hh_[k]; \
                        unsigned run_ = wprefix_u(tot_) - tot_; int fb_ = -1; unsigned fa_ = 0u; \
                        _Pragma("unroll") for (int k = 15; k >= 0; --k) { if (run_ < (R_) && run_ + hh_[k] >= (R_)) { fb_ = hb_ + k; fa_ = run_; } run_ += hh_[k]; } \
                        const unsigned long long bm_ = __ballot(fb_ >= 0); const int L_ = (int)__builtin_ctzll(bm_); \
                        BIN_ = (unsigned)__builtin_amdgcn_readlane(fb_, L_); AB_ = (unsigned)__builtin_amdgcn_readlane((int)fa_, L_); } while (0)
                    ZERO_HIST();
#pragma unroll
                    for (int i = 0; i < 64; ++i) v[i] = __builtin_bit_cast(float, (unsigned)((v[i] - vmn) * s20));
#define cd(i_) __builtin_bit_cast(unsigned, v[i_])
#pragma unroll
                    for (int g8 = 0; g8 < 8; ++g8) { if (g8 < nb8) {
#pragma unroll
                        for (int j = 0; j < 8; ++j) __hip_atomic_fetch_add(HIST + (cd(g8 * 8 + j) >> 10), 1u, __ATOMIC_RELAXED, __HIP_MEMORY_SCOPE_WORKGROUP); } }
                    LDS_WAIT(); asm volatile("" ::: "memory");
                    unsigned tb, above; SCAN_HIST(256u, tb, above);
                    ZERO_HIST();
                    LDS_WAIT(); asm volatile("" ::: "memory");
#pragma unroll
                    for (int g8 = 0; g8 < 8; ++g8) { if (g8 < nb8) {
#pragma unroll
                        for (int j = 0; j < 8; ++j) { const unsigned c = cd(g8 * 8 + j); const unsigned a = (c >> 10) == tb ? (c & 1023u) : 1024u + lane; __hip_atomic_fetch_add(HIST + a, 1u, __ATOMIC_RELAXED, __HIP_MEMORY_SCOPE_WORKGROUP); } } }
                    LDS_WAIT(); asm volatile("" ::: "memory");
                    unsigned tb2, ab2; { const unsigned R2 = 256u - above; SCAN_HIST(R2, tb2, ab2); }
                    const unsigned T = (tb << 10) | tb2; above += ab2;
                    unsigned baseg = 0u, basee = above;
#pragma unroll
                    for (int g8 = 0; g8 < 8; ++g8) { if (g8 < nb8) {
#pragma unroll
                        for (int j = 0; j < 8; ++j) { const int i = g8 * 8 + j;
                            const bool gt = cd(i) > T; const unsigned long long bg = __ballot(gt);
                            const unsigned pgp = baseg + __builtin_amdgcn_mbcnt_hi((unsigned)(bg >> 32), __builtin_amdgcn_mbcnt_lo((unsigned)bg, 0u));
                            if (gt) SELW[pgp] = (unsigned short)(i * 64 + lane);
                            baseg += (unsigned)__popcll(bg);
                            const bool eq = cd(i) == T; const unsigned long long be = __ballot(eq);
                            if (be) { const unsigned pep = basee + __builtin_amdgcn_mbcnt_hi((unsigned)(be >> 32), __builtin_amdgcn_mbcnt_lo((unsigned)be, 0u));
                                if (eq && pep < 256u) SELW[pep] = (unsigned short)(i * 64 + lane);
                                basee += (unsigned)__popcll(be); } } } }
#undef cd
#undef ZERO_HIST
#undef SCAN_HIST
                }
                LDS_WAIT(); asm volatile("" ::: "memory");
                }
                for (int rat_ = 0; rat_ < REP_ATT; ++rat_) {
                bf16* qrow = QB + (size_t)q * 4096;
                bf16x8 Bq[8];
#pragma unroll
                for (int ks = 0; ks < 8; ++ks) Bq[ks] = *(const bf16x8*)(qrow + hd * 256 + ks * 32 + g * 8);
                const bf16* kvb = CKV + (size_t)b * SEQ * 256;
                f32x4 O[16];
#pragma unroll
                for (int ct = 0; ct < 16; ++ct) O[ct] = (f32x4){0.f, 0.f, 0.f, 0.f};
                float mrun = -1.0e30f, lsum = 0.f;
                LDS_WAIT(); asm volatile("" ::: "memory");
                const int nks = nsel >> 5;
                const int lrow = lane >> 5, lcp = lane & 31;
                v4u KR[16];
#define ATT_LOADROWS(KST_) do { _Pragma("unroll") for (int i = 0; i < 16; ++i) { const int rr_ = 2 * i + lrow; const int ix_ = SELW[32 * (KST_) + rr_]; \
                    KR[i] = *(const v4u*)(kvb + (size_t)ix_ * 256 + ((lcp ^ (rr_ & 7)) * 8)); } } while (0)
                ATT_LOADROWS(0);
                const int rlA = hd & 7;
                const int rlT = (4 * g + qq) & 7;
                const int trb = (4 * g + qq) * 512 + 8 * (pp & 1), trm = 16 * ((pp >> 1) ^ rlT);
                for (int kst = 0; kst < nks; ++kst) {
                    int rlA_ = rlA, trm_ = trm; asm volatile("" : "+v"(rlA_), "+v"(trm_));
                    if (kst + 1 < nks) {
#pragma unroll
                        for (int i = 0; i < 16; ++i) { *(LAS v4u*)(VB + i * 1024 + lane * 16) = KR[i];
                            const int rr_ = 2 * i + lrow; const int ix_ = SELW[32 * (kst + 1) + rr_]; KR[i] = *(const v4u*)(kvb + (size_t)ix_ * 256 + ((lcp ^ (rr_ & 7)) * 8)); }
                    } else {
#pragma unroll
                        for (int i = 0; i < 16; ++i) *(LAS v4u*)(VB + i * 1024 + lane * 16) = KR[i]; }
                    LDS_WAIT(); asm volatile("" ::: "memory");
                    f32x4 S0 = {0.f, 0.f, 0.f, 0.f}, S1 = {0.f, 0.f, 0.f, 0.f};
#pragma unroll
                    for (int k4 = 0; k4 < 4; ++k4) {
                        bf16x8 a0[2], a1[2];
#pragma unroll
                        for (int j = 0; j < 2; ++j) { const int ks = k4 * 2 + j; const int cpos = (4 * ks + g) ^ rlA_;
                            a0[j] = *(const LAS bf16x8*)(VB + hd * 512 + cpos * 16); a1[j] = *(const LAS bf16x8*)(VB + (16 + hd) * 512 + cpos * 16); }
#pragma unroll
                        for (int j = 0; j < 2; ++j) { const int ks = k4 * 2 + j;
                            S0 = __builtin_amdgcn_mfma_f32_16x16x32_bf16(a0[j], Bq[ks], S0, 0, 0, 0); S1 = __builtin_amdgcn_mfma_f32_16x16x32_bf16(a1[j], Bq[ks], S1, 0, 0, 0); }
                    }
                    const v2u pa = *(const LAS v2u*)(SELW + 32 * kst + 4 * g), pb = *(const LAS v2u*)(SELW + 32 * kst + 16 + 4 * g);
                    const float fp = (float)pos;
                    float s0[4], s1[4];
                    s0[0] = S0[0] - slope * fabsf(fp - (float)(pa.x & 0xffffu)); s0[1] = S0[1] - slope * fabsf(fp - (float)(pa.x >> 16));
                    s0[2] = S0[2] - slope * fabsf(fp - (float)(pa.y & 0xffffu)); s0[3] = S0[3] - slope * fabsf(fp - (float)(pa.y >> 16));
                    s1[0] = S1[0] - slope * fabsf(fp - (float)(pb.x & 0xffffu)); s1[1] = S1[1] - slope * fabsf(fp - (float)(pb.x >> 16));
                    s1[2] = S1[2] - slope * fabsf(fp - (float)(pb.y & 0xffffu)); s1[3] = S1[3] - slope * fabsf(fp - (float)(pb.y >> 16));
                    float ml = fmaxf(fmaxf(fmaxf(s0[0], s0[1]), fmaxf(s0[2], s0[3])), fmaxf(fmaxf(s1[0], s1[1]), fmaxf(s1[2], s1[3])));
                    ml = xmax16(ml); ml = xmax32(ml);
                    const float mnew = fmaxf(mrun, ml), alpha = __expf(mrun - mnew); mrun = mnew;
                    float p0[4], p1[4];
#pragma unroll
                    for (int r = 0; r < 4; ++r) { p0[r] = __expf(s0[r] - mnew); p1[r] = __expf(s1[r] - mnew); }
                    lsum = lsum * alpha + ((p0[0] + p0[1]) + (p0[2] + p0[3])) + ((p1[0] + p1[1]) + (p1[2] + p1[3]));
                    v4u pw; pw.x = pk2(p0[0], p0[1]); pw.y = pk2(p0[2], p0[3]); pw.z = pk2(p1[0], p1[1]); pw.w = pk2(p1[2], p1[3]);
                    const bf16x8 Pf = __builtin_bit_cast(bf16x8, pw);
#pragma unroll
                    for (int ct = 0; ct < 16; ++ct) O[ct] = O[ct] * alpha;
#pragma unroll
                    for (int c8 = 0; c8 < 4; ++c8) {
                        v4s lo[4], hi[4];
#pragma unroll
                        for (int j = 0; j < 4; ++j) { const int ct = c8 * 4 + j; const int off = trb + ((32 * ct) ^ trm_);
                            lo[j] = __builtin_amdgcn_ds_read_tr16_b64_v4i16((LAS v4s*)(VB + off));
                            hi[j] = __builtin_amdgcn_ds_read_tr16_b64_v4i16((LAS v4s*)(VB + 16 * 512 + off)); }
#pragma unroll
                        for (int j = 0; j < 4; ++j) { const int ct = c8 * 4 + j;
                            const bf16x8 Af = {lo[j][0], lo[j][1], lo[j][2], lo[j][3], hi[j][0], hi[j][1], hi[j][2], hi[j][3]};
                            O[ct] = __builtin_amdgcn_mfma_f32_16x16x32_bf16(Af, Pf, O[ct], 0, 0, 0); }
                    }
                    LDS_WAIT(); asm volatile("" ::: "memory");
                }
#undef ATT_LOADROWS
                lsum = xsum16(lsum); lsum = xsum32(lsum);
                const float inv = 1.0f / lsum;
#pragma unroll
                for (int ct = 0; ct < 16; ++ct) { const f32x4 o = O[ct] * inv; v2u w; w.x = pk2(o[0], o[1]); w.y = pk2(o[2], o[3]); *(v2u*)(OB + (size_t)q * 4096 + hd * 256 + 16 * ct + 4 * g) = w; }
                }
            }
        }
        PHASE_END
        GRID_BAR();
        }
        PHASE_BEGIN
        { pg8::Gemm g{OB, W6, M, 1024, 1024, 4096, 1024, 1024}; pg8::StaticOrder S; S.init(M, 1024, G, blk);
          EpiBf E{YAB, 2048, 1024}; pg8::gemm_phase(lds, g, S, E, tid); }
        PHASE_END
        GRID_BAR();
        PHASE_BEGIN
        { pg8::Gemm g{YAB, W7, M, DM, DM, DM, DM, 0}; pg8::StaticOrder S; S.init(M, DM, G, blk);
          EpiGateM E{GTB, MRG}; HookGate Hk{GTA, GTB}; pg8::gemm_phase(lds, g, S, E, tid, Hk); }
        PHASE_END
        GRID_BAR();
        PHASE_BEGIN
        { pg8::Gemm g{MRG, W8, M, DM, DM, DM, DM, 0}; pg8::StaticOrder S; S.init(M, DM, G, blk);
          EpiRes E{(l == 0) ? x_in : (const float*)nullptr, XB, RB, modl + 2 * DM}; pg8::gemm_phase(lds, g, S, E, tid); }
        PHASE_END
        GRID_BAR();
        for (int rep_ = 0; rep_ < REP_P9; ++rep_) {
        PHASE_BEGIN
        f32x4 lg[8], lb_[8]; v2u nx[8];
#pragma unroll
        for (int j = 0; j < 8; ++j) { const int c = j * 256 + lane * 4; lg[j] = *(const f32x4*)(ln1_g + l * DM + c); lb_[j] = *(const f32x4*)(ln1_b + l * DM + c); nx[j] = *(const v2u*)(RB + (size_t)gw * DM + c); }
        for (int row = gw; row < M; row += NGW) {
            const int b = row / SEQ; const float* md = modl + (size_t)b * MODW;
            f32x4 v[8]; float s = 0.f;
#pragma unroll
            for (int j = 0; j < 8; ++j) { v[j] = (f32x4){bflo(nx[j].x), bfhi(nx[j].x), bflo(nx[j].y), bfhi(nx[j].y)}; s += (v[j][0] + v[j][1]) + (v[j][2] + v[j][3]); }
            { const int rn = row + NGW < M ? row + NGW : row;
#pragma unroll
              for (int j = 0; j < 8; ++j) nx[j] = *(const v2u*)(RB + (size_t)rn * DM + j * 256 + lane * 4); }
            const float mean = wave_sum(s) * (1.f / DM); float s2 = 0.f;
#pragma unroll
            for (int j = 0; j < 8; ++j) { v[j] = v[j] - mean; s2 += (v[j][0] * v[j][0] + v[j][1] * v[j][1]) + (v[j][2] * v[j][2] + v[j][3] * v[j][3]); }
            const float rstd = 1.0f / sqrtf(wave_sum(s2) * (1.f / DM) + 1e-5f);
#pragma unroll
            for (int j = 0; j < 8; ++j) { const int c = j * 256 + lane * 4; const f32x4 gg = lg[j], bb = lb_[j];
                const f32x4 y = v[j] * rstd * gg + bb; { v2u wx; wx.x = pk2(y[0], y[1]); wx.y = pk2(y[2], y[3]); *(v2u*)(XB + (size_t)row * DM + c) = wx; }
                const f32x4 sc = *(const f32x4*)(md + 4 * DM + c), sh = *(const f32x4*)(md + 3 * DM + c); const f32x4 hh = y * (sc + 1.f) + sh;
                v2u w; w.x = pk2(hh[0], hh[1]); w.y = pk2(hh[2], hh[3]); *(v2u*)(HB + (size_t)row * DM + c) = w; }
        }
        PHASE_END
        GRID_BAR();
        }
        PHASE_BEGIN
        { pg8::Gemm g{HB, W10, M, N10, DM, DM, DM, 0}; pg8::StaticOrder S; S.init(M, N10, G, blk);
          EpiSwiglu E{ACT}; pg8::gemm_phase(lds, g, S, E, tid); }
        PHASE_END
        GRID_BAR();
        PHASE_BEGIN
        { pg8::Gemm g{ACT, W11, M, DM, DFF, DFF, DFF, 0}; pg8::StaticOrder S; S.init(M, DM, G, blk);
          EpiRes E{(const float*)nullptr, XB, RB, modl + 5 * DM}; pg8::gemm_phase(lds, g, S, E, tid); }
        PHASE_END
        GRID_BAR();
        for (int rep_ = 0; rep_ < REP_P12; ++rep_) {
        PHASE_BEGIN
        {
            const bool lastl = (l == DEPTH - 1); const float* mdn = MOD + (size_t)(l + 1 < DEPTH ? l + 1 : l) * NBATCH * MODW;
            f32x4 lg[8], lb_[8]; v2u nx[8];
#pragma unroll
            for (int j = 0; j < 8; ++j) { const int c = j * 256 + lane * 4; lg[j] = *(const f32x4*)(ln2_g + l * DM + c); lb_[j] = *(const f32x4*)(ln2_b + l * DM + c); nx[j] = *(const v2u*)(RB + (size_t)gw * DM + c); }
            for (int row = gw; row < M; row += NGW) {
                const int b = row / SEQ; const float* md = mdn + (size_t)b * MODW;
                f32x4 v[8]; float s = 0.f;
#pragma unroll
                for (int j = 0; j < 8; ++j) { v[j] = (f32x4){bflo(nx[j].x), bfhi(nx[j].x), bflo(nx[j].y), bfhi(nx[j].y)}; s += (v[j][0] + v[j][1]) + (v[j][2] + v[j][3]); }
                { const int rn = row + NGW < M ? row + NGW : row;
#pragma unroll
                  for (int j = 0; j < 8; ++j) nx[j] = *(const v2u*)(RB + (size_t)rn * DM + j * 256 + lane * 4); }
                const float mean = wave_sum(s) * (1.f / DM); float s2 = 0.f;
#pragma unroll
                for (int j = 0; j < 8; ++j) { v[j] = v[j] - mean; s2 += (v[j][0] * v[j][0] + v[j][1] * v[j][1]) + (v[j][2] * v[j][2] + v[j][3] * v[j][3]); }
                const float rstd = 1.0f / sqrtf(wave_sum(s2) * (1.f / DM) + 1e-5f);
#pragma unroll
                for (int j = 0; j < 8; ++j) { const int c = j * 256 + lane * 4; const f32x4 gg = lg[j], bb = lb_[j];
                    const f32x4 y = v[j] * rstd * gg + bb; if (lastl) *(f32x4*)(args.out + (size_t)row * DM + c) = y; else { v2u wx; wx.x = pk2(y[0], y[1]); wx.y = pk2(y[2], y[3]); *(v2u*)(XB + (size_t)row * DM + c) = wx; }
                    const f32x4 sc = *(const f32x4*)(md + DM + c), sh = *(const f32x4*)(md + c); const f32x4 hh = y * (sc + 1.f) + sh;
                    v2u w; w.x = pk2(hh[0], hh[1]); w.y = pk2(hh[2], hh[3]); *(v2u*)(HB + (size_t)row * DM + c) = w; }
            }
            if (l + 1 < DEPTH) { __syncthreads(); CONVERT_LAYER(l + 1); }
        }
        PHASE_END
        if (l + 1 < DEPTH || rep_ + 1 < REP_P12) GRID_BAR();
        }
    }
}

extern "C" void kernel_launch(void* const* d_in, const int* in_sizes, int n_in, void* d_out, int out_size, void* d_ws, size_t ws_size, hipStream_t stream) {
    static int grid = 0;
    if (grid == 0) {
        if (n_in != 22 || out_size != M * DM || ws_size < WS_END) { fprintf(stderr, "kernel_launch: unexpected shapes (n_in %d, out %d, ws %zu < %zu)\n", n_in, out_size, ws_size, (size_t)WS_END); grid = -1; return; }
        int dev = 0, cus = 0, per_cu = 0;
        if (hipGetDevice(&dev) != hipSuccess || hipDeviceGetAttribute(&cus, hipDeviceAttributeMultiprocessorCount, dev) != hipSuccess) { grid = -1; return; }
        if (hipFuncSetAttribute((const void*)fwd_kernel, hipFuncAttributeMaxDynamicSharedMemorySize, LDS_BYTES) != hipSuccess) { fprintf(stderr, "kernel_launch: hipFuncSetAttribute failed\n"); grid = -1; return; }
        if (hipOccupancyMaxActiveBlocksPerMultiprocessor(&per_cu, (const void*)fwd_kernel, NTHR, LDS_BYTES) != hipSuccess || per_cu < 1) { fprintf(stderr, "kernel_launch: occupancy query says %d\n", per_cu); }
        (void)hipGetLastError();
        grid = cus;
    }
    if (grid < 0) return;
    if (hipMemsetAsync((char*)d_ws + WS_CTL, 0, CTL_ZERO_BYTES, stream) != hipSuccess) return;
    Args a{};
    for (int i = 0; i < 22; ++i) a.in[i] = (const float*)d_in[i];
    a.out = (float*)d_out; a.ws = (unsigned char*)d_ws;
    hipLaunchKernelGGL(fwd_kernel, dim3(grid), dim3(NTHR), LDS_BYTES, stream, a);
}
```

```cpp
#include <hip/hip_runtime.h>
#include <cstdio>
#include <cstdint>

namespace pg8 {
#define PG8_LAS __attribute__((address_space(3)))
typedef unsigned short bf16_t;
typedef short bf16x8 __attribute__((ext_vector_type(8)));
typedef float f32x4 __attribute__((ext_vector_type(4)));
typedef unsigned u32x4 __attribute__((ext_vector_type(4)));
constexpr int BM = 256, BK = 64, HALF = 128, HTB = HALF * BK * 2, STAGE_BYTES = 8 * HTB, NXCD = 8, WGM = 8;

__host__ __device__ __forceinline__ int lds_byte(int r, int c) { const int st = (r >> 4) * 2 + (c >> 5), rr = r & 15, cc = c & 31, ob = rr * 64 + cc * 2; return st * 1024 + (ob ^ (((ob >> 9) & 1) << 5)); }
__host__ __device__ __forceinline__ void stage_rc(int b, int& R, int& C) { const int st = b / 1024, sb = b % 1024, swz = sb ^ (((sb >> 9) & 1) << 5); R = (st >> 1) * 16 + swz / 64; C = (st & 1) * 32 + (swz % 64) / 2; }
__host__ __device__ __forceinline__ int perm32(int rho) { const int n = rho >> 4, i = rho & 15; return 8 * (i >> 2) + 4 * n + (i & 3); }

struct Unit { int pm, pn; };
struct Gemm { const bf16_t* A; const bf16_t* Bt; int M, N, K, lda, ldb, a_pn_stride; };

struct StaticOrder {
    int nM, nN, nwg, G, c;
    __host__ __device__ void init(int M, int N, int G_, int c_) { nM = M / BM; nN = N / BM; nwg = nM * nN; G = G_; c = c_; }
    __host__ __device__ bool next(int i, Unit& u) const {
        const long L = (long)i * G + c; if (L >= nwg) return false;
        int wgid = (int)L; { const int q = nwg / NXCD, r = nwg % NXCD, xcd = wgid % NXCD, off = wgid / NXCD; wgid = (xcd < r ? xcd * (q + 1) : r * (q + 1) + (xcd - r) * q) + off; }
        const int nig = WGM * nN, gid = wgid / nig, fm = gid * WGM, gsz = (nM - fm) < WGM ? (nM - fm) : WGM;
        u.pm = fm + ((wgid % nig) % gsz); u.pn = (wgid % nig) / gsz; return true;
    }
};

typedef float f32x2_t __attribute__((ext_vector_type(2))); typedef __bf16 bf16x2_t __attribute__((ext_vector_type(2)));
__device__ __forceinline__ unsigned cvt_pk_bf16(float lo, float hi) { f32x2_t v = {lo, hi}; bf16x2_t b = __builtin_convertvector(v, bf16x2_t); return __builtin_bit_cast(unsigned, b); }

struct NoHook { static constexpr bool ON = false; template <class A> __device__ __forceinline__ void mid(A&, const Unit&, int, int, int, int) const {} };
template <class Epi, class Hook = NoHook>
__device__ __forceinline__ void gemm_phase(PG8_LAS unsigned char* lds, const Gemm g, const StaticOrder& S, const Epi& E, const int tid, const Hook H = Hook()) {
    const int wid = __builtin_amdgcn_readfirstlane(tid >> 6), lane = tid & 63, wr = wid >> 2, wc = wid & 3, fr = lane & 15, fq = lane >> 4;
    const int K = g.K, nt = K / BK;
    unsigned voffA[2], voffB[2];
#pragma unroll
    for (int i = 0; i < 2; ++i) { int R, C; stage_rc(tid * 16 + i * 8192, R, C); const int Rb = 64 * (R >> 5) + perm32(R & 31);
        voffA[i] = (unsigned)(R * g.lda + C) * 2u; voffB[i] = (unsigned)(Rb * g.ldb + C) * 2u; }
    const size_t kstep = (size_t)(BK * 2);
    const size_t hstepA = (size_t)HALF * g.lda * 2, hstepB = (size_t)32 * g.ldb * 2;
    const size_t tstepA = 2 * hstepA, tstepB = (size_t)BM * g.ldb * 2;
    const unsigned ldsw = (unsigned)wid * 1024u;
    const int aoff = lds_byte(wr * 64 + fr, fq * 8), boff = lds_byte(wc * 32 + fr, fq * 8);
#define PG8_SA(b, h) (((b) * 2 + (h)) * HTB)
#define PG8_SB(b, h) ((4 + (b) * 2 + (h)) * HTB)
#define PG8_STAGE(bufoff, gbase, voff) do { _Pragma("unroll") for (int _i = 0; _i < 2; ++_i) \
        __builtin_amdgcn_global_load_lds((const unsigned*)((const char*)(gbase) + (voff)[_i]), (PG8_LAS unsigned*)(lds + (bufoff) + ldsw + _i * 8192), 16, 0, 0); } while (0)
#define PG8_LDA(dst, b, h) do { _Pragma("unroll") for (int m = 0; m < 4; ++m) _Pragma("unroll") for (int k = 0; k < 2; ++k) dst[m][k] = *(const PG8_LAS bf16x8*)(lds + PG8_SA(b, h) + aoff + m * 2048 + k * 1024); } while (0)
#define PG8_LDB(dst, b, h) do { _Pragma("unroll") for (int n = 0; n < 2; ++n) _Pragma("unroll") for (int k = 0; k < 2; ++k) dst[n][k] = *(const PG8_LAS bf16x8*)(lds + PG8_SB(b, h) + boff + n * 2048 + k * 1024); } while (0)
#define PG8_MMA(ai, bj, At, Bt) do { __builtin_amdgcn_s_setprio(1); _Pragma("unroll") for (int m = 0; m < 4; ++m) _Pragma("unroll") for (int n = 0; n < 2; ++n) _Pragma("unroll") for (int k = 0; k < 2; ++k) \
        acc[ai][bj][m][n] = __builtin_amdgcn_mfma_f32_16x16x32_bf16(Bt[n][k], At[m][k], acc[ai][bj][m][n], 0, 0, 0); __builtin_amdgcn_s_setprio(0); } while (0)
#define PG8_WAIT_V(n) asm volatile("s_waitcnt vmcnt(" #n ")" ::: "memory")
#define PG8_WAIT_L(n) asm volatile("s_waitcnt lgkmcnt(" #n ")" ::: "memory")
#define PG8_BAR __builtin_amdgcn_s_barrier()
#define PG8_SCHED __builtin_amdgcn_sched_barrier(0)
    Unit cur, nxt; int ui = 0;
    if (!S.next(0, cur)) return;
    f32x4 acc[2][2][4][2];
#pragma unroll
    for (int a = 0; a < 2; ++a)
#pragma unroll
        for (int b = 0; b < 2; ++b)
#pragma unroll
            for (int m = 0; m < 4; ++m)
#pragma unroll
                for (int n = 0; n < 2; ++n) acc[a][b][m][n] = (f32x4){0.f, 0.f, 0.f, 0.f};
    bf16x8 At[4][2], B0[2][2], B1[2][2];
    const char* cA = (const char*)g.A + (size_t)cur.pm * tstepA + (size_t)cur.pn * g.a_pn_stride * 2; const char* cB = (const char*)g.Bt + (size_t)cur.pn * tstepB;
    PG8_STAGE(PG8_SB(0, 0), cB, voffB); PG8_STAGE(PG8_SB(0, 1), cB + hstepB, voffB); PG8_STAGE(PG8_SA(0, 0), cA, voffA); PG8_STAGE(PG8_SA(0, 1), cA + hstepA, voffA);
    if (wr == 1) PG8_BAR;
    PG8_WAIT_V(2); PG8_BAR;
    PG8_STAGE(PG8_SB(1, 0), cB + kstep, voffB); PG8_STAGE(PG8_SA(1, 0), cA + kstep, voffA); PG8_STAGE(PG8_SB(1, 1), cB + hstepB + kstep, voffB);
    PG8_WAIT_V(6); PG8_BAR;
    for (;;) {
        const bool has_next = S.next(ui + 1, nxt);
        const char* nA = has_next ? (const char*)g.A + (size_t)nxt.pm * tstepA + (size_t)nxt.pn * g.a_pn_stride * 2 : cA; const char* nB = has_next ? (const char*)g.Bt + (size_t)nxt.pn * tstepB : cB;
        for (int t = 0; t < nt; t += 2) {
            const bool last = (t == nt - 2);
            const char* a1 = cA + (size_t)(t + 1) * kstep;
            const char* a2 = last ? nA : cA + (size_t)(t + 2) * kstep; const char* b2 = last ? nB : cB + (size_t)(t + 2) * kstep;
            const char* a3 = a2 + kstep; const char* b3 = b2 + kstep;
            if constexpr (Hook::ON) { if (t == (nt >> 1)) H.mid(acc, cur, wr, wc, fr, fq); }
            PG8_LDB(B0, 0, 0); PG8_LDB(B1, 0, 1); PG8_SCHED; PG8_LDA(At, 0, 0); PG8_STAGE(PG8_SA(1, 1), a1 + hstepA, voffA);
            PG8_WAIT_V(8); PG8_WAIT_L(0); PG8_BAR; PG8_MMA(0, 0, At, B0); PG8_MMA(0, 1, At, B1); PG8_BAR; PG8_SCHED;
            PG8_LDA(At, 0, 1); PG8_STAGE(PG8_SB(0, 0), b2, voffB); PG8_STAGE(PG8_SB(0, 1), b2 + hstepB, voffB); PG8_STAGE(PG8_SA(0, 0), a2, voffA);
            PG8_WAIT_V(8); PG8_WAIT_L(0); PG8_BAR; PG8_MMA(1, 0, At, B0); PG8_MMA(1, 1, At, B1); PG8_BAR; PG8_SCHED;
            PG8_LDB(B0, 1, 0); PG8_LDB(B1, 1, 1); PG8_SCHED; PG8_LDA(At, 1, 0); PG8_STAGE(PG8_SA(0, 1), a2 + hstepA, voffA);
            PG8_WAIT_V(8); PG8_WAIT_L(0); PG8_BAR; PG8_MMA(0, 0, At, B0); PG8_MMA(0, 1, At, B1); PG8_BAR; PG8_SCHED;
            PG8_LDA(At, 1, 1); PG8_STAGE(PG8_SB(1, 0), b3, voffB); PG8_STAGE(PG8_SB(1, 1), b3 + hstepB, voffB); PG8_STAGE(PG8_SA(1, 0), a3, voffA);
            PG8_WAIT_V(8); PG8_WAIT_L(0); PG8_BAR; PG8_MMA(1, 0, At, B0); PG8_MMA(1, 1, At, B1); PG8_BAR; PG8_SCHED;
        }
        if (wr == 0) PG8_BAR;
        E(acc, cur, wr, wc, fr, fq);
        if (!has_next) break;
#pragma unroll
        for (int a = 0; a < 2; ++a)
#pragma unroll
            for (int b = 0; b < 2; ++b)
#pragma unroll
                for (int m = 0; m < 4; ++m)
#pragma unroll
                    for (int n = 0; n < 2; ++n) acc[a][b][m][n] = (f32x4){0.f, 0.f, 0.f, 0.f};
        cur = nxt; cA = nA; cB = nB; ++ui;
        if (wr == 1) PG8_BAR;
    }
    PG8_WAIT_V(0);
    PG8_BAR;
#undef PG8_SA
#undef PG8_SB
#undef PG8_STAGE
#undef PG8_LDA
#undef PG8_LDB
#undef PG8_MMA
#undef PG8_WAIT_V
#undef PG8_WAIT_L
#undef PG8_BAR
#undef PG8_SCHED
}
}

constexpr int NWAVES = 8, NTHR = NWAVES * 64;
constexpr int DM = 2048, NBATCH = 4, SEQ = 4096, DEPTH = 4, M = NBATCH * SEQ;
constexpr int HGW = 1024;
constexpr int SAH = 16, SAC = 256, SAR = 512;
constexpr int DFF = 5632;
constexpr int N1 = 9216, N3 = 5120, N10 = 2 * DFF;
constexpr float ALPHA = 1.6817928305074292f;
constexpr int MODW = 6 * DM;

constexpr size_t MiB = 1u << 20;
constexpr size_t WS_CTL = 0, CTL_ZERO_BYTES = 32768;
constexpr size_t WS_MOD = 1 * MiB;
constexpr size_t WS_LB = 2 * MiB;
constexpr size_t WS_MODP = 3 * MiB;
constexpr size_t WS_W1 = 9 * MiB;
constexpr size_t WS_W3 = WS_W1 + 36 * MiB;
constexpr size_t WS_W6 = WS_W3 + 5 * MiB;
constexpr size_t WS_W7 = WS_W6 + 2 * MiB;
constexpr size_t WS_W8 = WS_W7 + 8 * MiB;
constexpr size_t WS_W10 = WS_W8 + 8 * MiB;
constexpr size_t WS_W11 = WS_W10 + 44 * MiB;
constexpr size_t WS_X = WS_W11 + 22 * MiB;
constexpr size_t WS_R = WS_X + 128 * MiB;
constexpr size_t WS_H = WS_R + 128 * MiB;
constexpr size_t WS_QA = WS_H + 64 * MiB;
constexpr size_t WS_FA = WS_QA + 32 * MiB;
constexpr size_t WS_IA = WS_FA + 64 * MiB;
constexpr size_t WS_GA = WS_IA + 32 * MiB;
constexpr size_t WS_LAT = WS_GA + 32 * MiB;
constexpr size_t WS_GTA = WS_LAT + 64 * MiB;
constexpr size_t WS_GTB = WS_GTA + 64 * MiB;
constexpr size_t WS_CQN = WS_GTB + 64 * MiB;
constexpr size_t WS_CKV = WS_CQN + 16 * MiB;
constexpr size_t WS_KIDX = WS_CKV + 8 * MiB;
constexpr size_t WS_IDXW = WS_KIDX + 2 * MiB;
constexpr size_t WS_QB = WS_IDXW + 1 * MiB;
constexpr size_t WS_QIDX = WS_QB + 128 * MiB;
constexpr size_t WS_SEL = WS_QIDX + 32 * MiB;
constexpr size_t WS_YAB = WS_SEL + 8 * MiB;
constexpr size_t WS_MRG = WS_FA;
constexpr size_t WS_OB = WS_YAB + 64 * MiB;
constexpr size_t WS_BIG = WS_OB + 128 * MiB;
constexpr size_t WS_KSB = WS_BIG + 256 * MiB;
constexpr size_t WS_DEB = WS_KSB + 32 * MiB;
constexpr size_t WS_QSB = WS_DEB + 2 * MiB;
constexpr size_t WS_END = WS_QSB + 32 * MiB;

constexpr int CW_BAR = 4096;

constexpr int RING_BYTES = 131072;
constexpr int LDS_BYTES = 163840;
constexpr int LDSCTL_OFF = LDS_BYTES - 1024, MISC_OFF = LDSCTL_OFF + 320, SELL_OFF = 147456;

#define GAS __attribute__((address_space(1)))
#define LAS __attribute__((address_space(3)))
typedef unsigned short bf16;
typedef unsigned v4u __attribute__((ext_vector_type(4)));
typedef unsigned v2u __attribute__((ext_vector_type(2)));
typedef float f32x4 __attribute__((ext_vector_type(4)));
typedef float f32x16 __attribute__((ext_vector_type(16)));
typedef short bf16x8 __attribute__((ext_vector_type(8)));
typedef short v4s __attribute__((ext_vector_type(4)));
typedef GAS unsigned gu32;
#define LDS_WAIT() asm volatile("s_waitcnt lgkmcnt(0)" ::: "memory")
__device__ __forceinline__ unsigned f2bf(float f) { unsigned u = __builtin_bit_cast(unsigned, f); return (u + 0x7fffu + ((u >> 16) & 1u)) >> 16; }
__device__ __forceinline__ unsigned pk2(float lo, float hi) { return pg8::cvt_pk_bf16(lo, hi); }
__device__ __forceinline__ float bf2f(unsigned short b) { return __builtin_bit_cast(float, ((unsigned)b) << 16); }
__device__ __forceinline__ float bflo(unsigned w) { return __builtin_bit_cast(float, w << 16); }
__device__ __forceinline__ float bfhi(unsigned w) { return __builtin_bit_cast(float, w & 0xffff0000u); }
__device__ __forceinline__ float sigm(float x) { return __builtin_amdgcn_rcpf(1.f + __expf(-x)); }

__device__ __forceinline__ int lane_id() { unsigned m = ~0u; asm volatile("" : "+s"(m)); return (int)__builtin_amdgcn_mbcnt_hi(m, __builtin_amdgcn_mbcnt_lo(m, 0u)); }
#define XB_TMO      128
#define XB_XCNT(j)  (256  + 64 * (j))
#define XB_XSUB(j)  (1280 + 64 * (j))
#define XB_XGEN(j)  (2304 + 64 * (j))
#define XB_TOP      3328
#define XB_TOPGEN   3392
#define XCD_BAR_WORDS 3456
#define XB_SPIN_CAP (1u << 22)

__device__ __forceinline__ unsigned xb_ld(unsigned* p)              { return __hip_atomic_load(p, __ATOMIC_RELAXED, __HIP_MEMORY_SCOPE_AGENT); }
__device__ __forceinline__ unsigned xb_add(unsigned* p, unsigned v) { return __hip_atomic_fetch_add(p, v, __ATOMIC_RELAXED, __HIP_MEMORY_SCOPE_AGENT); }
__device__ __forceinline__ unsigned xb_xcc_id() { return (unsigned)__builtin_amdgcn_s_getreg((3 << 11) | 20) & 0xFu; }
#define XB_SPIN(cond, bar) do { unsigned _sp = 0; while (cond) { __builtin_amdgcn_s_sleep(1); \
    if ((++_sp & 255u) == 0u) { if (xb_ld(&(bar)[XB_TMO])) break; if (_sp > XB_SPIN_CAP) { atomicAdd(&(bar)[XB_TMO], 1u); break; } } } } while (0)

struct XcdBarrier { unsigned* bar; unsigned x; volatile LAS unsigned* st; int wave; };

__device__ __forceinline__ XcdBarrier xcd_barrier_post(unsigned* bar, volatile LAS unsigned* st) {
    XcdBarrier b; b.bar = bar; b.x = (unsigned)__builtin_amdgcn_readfirstlane((int)xb_xcc_id()); b.st = st;
    if (threadIdx.x == 0) (void)xb_add(&bar[XB_XCNT(b.x)], 1u);
    return b;
}
__device__ __forceinline__ void xcd_barrier_complete(unsigned* bar, unsigned x, unsigned& nloc, unsigned& nx) {
    const unsigned G = gridDim.x * gridDim.y * gridDim.z;
    unsigned sum, cnt, mine, sp = 0u;
    for (;;) {
        sum = 0u; cnt = 0u; mine = 0u;
#pragma unroll 1
        for (unsigned j = 0; j < 16; ++j) { const unsigned c = xb_ld(&bar[XB_XCNT(j)]); sum += c; cnt += (c > 0u) ? 1u : 0u; mine = (j == x) ? c : mine; }
        if (sum == G) break;
        __builtin_amdgcn_s_sleep(1);
        if ((++sp & 255u) == 0u) { if (xb_ld(&bar[XB_TMO])) break; if (sp > XB_SPIN_CAP) { atomicAdd(&bar[XB_TMO], 1u); break; } }
    }
    nloc = mine > 0u ? mine : 1u; nx = cnt > 0u ? cnt : 1u;
}
__device__ __forceinline__ void xcd_barrier(const XcdBarrier& b) {
    asm volatile("s_waitcnt vmcnt(0)" ::: "memory");
    __syncthreads();
    if (b.wave == 0 && lane_id() == 0) {
        unsigned* bar = b.bar;
        unsigned bx = b.x; asm volatile("" : "+s"(bx));
        __builtin_amdgcn_s_waitcnt(0);
        unsigned nloc = b.st[0], nx = b.st[1];
        const unsigned old = xb_add(&bar[XB_XSUB(bx)], 1u);
        const unsigned gen = old / nloc;
        if (old + 1u == (gen + 1u) * nloc) {
            __builtin_amdgcn_fence(__ATOMIC_RELEASE, "agent");
            asm volatile("s_waitcnt vmcnt(0)" ::: "memory");
            const unsigned og = xb_add(&bar[XB_TOP], 1u);
            const unsigned tg = og / nx;
            if (og + 1u == (tg + 1u) * nx) xb_add(&bar[XB_TOPGEN], 1u);
            else XB_SPIN(xb_ld(&bar[XB_TOPGEN]) == tg, bar);
            __builtin_amdgcn_fence(__ATOMIC_ACQUIRE, "agent");
            xb_add(&bar[XB_XGEN(bx)], 1u);
            asm volatile("s_waitcnt vmcnt(0)" ::: "memory");
        } else {
            XB_SPIN(xb_ld(&bar[XB_XGEN(bx)]) == gen, bar);
            __builtin_amdgcn_fence(__ATOMIC_ACQUIRE, "agent");
            asm volatile("s_waitcnt vmcnt(0)" ::: "memory");
        }
    }
    __syncthreads();
}

__device__ __forceinline__ void xswap16(float& a, float& b) { asm volatile("s_nop 1\n\tv_permlane16_swap_b32 %0, %1\n\ts_nop 1" : "+v"(a), "+v"(b)); }
__device__ __forceinline__ void xswap32(float& a, float& b) { asm volatile("s_nop 1\n\tv_permlane32_swap_b32 %0, %1\n\ts_nop 1" : "+v"(a), "+v"(b)); }
__device__ __forceinline__ float xmax16(float x) { float a = x, b = x; xswap16(a, b); return fmaxf(a, b); }
__device__ __forceinline__ float xmax32(float x) { float a = x, b = x; xswap32(a, b); return fmaxf(a, b); }
__device__ __forceinline__ float xsum16(float x) { float a = x, b = x; xswap16(a, b); return a + b; }
__device__ __forceinline__ float xsum32(float x) { float a = x, b = x; xswap32(a, b); return a + b; }

#define DPPF(x, ctrl) __builtin_bit_cast(float, __builtin_amdgcn_update_dpp(0, __builtin_bit_cast(int, (x)), (ctrl), 0xf, 0xf, true))
__device__ __forceinline__ float wmax_f(float x) {
    x = fmaxf(x, DPPF(x, 0xB1)); x = fmaxf(x, DPPF(x, 0x4E)); x = fmaxf(x, DPPF(x, 0x124)); x = fmaxf(x, DPPF(x, 0x128));
    x = xmax16(x); return xmax32(x);
}
__device__ __forceinline__ unsigned wprefix_u(unsigned x) {
    int v = (int)x;
    v += __builtin_amdgcn_update_dpp(0, v, 0x111, 0xf, 0xf, false);
    v += __builtin_amdgcn_update_dpp(0, v, 0x112, 0xf, 0xf, false);
    v += __builtin_amdgcn_update_dpp(0, v, 0x114, 0xf, 0xf, false);
    v += __builtin_amdgcn_update_dpp(0, v, 0x118, 0xf, 0xf, false);
    v += __builtin_amdgcn_update_dpp(0, v, 0x142, 0xa, 0xf, false);
    v += __builtin_amdgcn_update_dpp(0, v, 0x143, 0xc, 0xf, false);
    return (unsigned)v;
}

__device__ __forceinline__ float rowsum16(float x) { x += DPPF(x, 0xB1); x += DPPF(x, 0x4E); x += DPPF(x, 0x124); x += DPPF(x, 0x128); return x; }
__device__ __forceinline__ float wave_sum(float x) { x = rowsum16(x); x = xsum16(x); return xsum32(x); }
__device__ __forceinline__ float wave_max(float x) { return wmax_f(x); }
__device__ __forceinline__ int wave_sum_i(int v) { float f = wave_sum((float)v); return (int)(f + 0.5f); }
template <class Src>
__device__ __forceinline__ void cvt_load(const Src& src, int k0, int n0, int lane, float (&tv)[32]) {
#pragma unroll
    for (int i = 0; i < 32; ++i) tv[i] = src(k0 + 2 * i + (lane >> 5), n0 + (lane & 31));
}
__device__ __forceinline__ void cvt_store(const float (&tv)[32], bf16* WT, int K, int k0, int n0, LAS float* scr, int lane) {
#pragma unroll
    for (int i = 0; i < 32; ++i) scr[(2 * i + (lane >> 5)) * 33 + (lane & 31)] = tv[i];
    LDS_WAIT(); asm volatile("" ::: "memory");
    const int c = lane & 7;
#pragma unroll
    for (int j = 0; j < 4; ++j) { const int n = (lane >> 3) + 8 * j; const LAS float* s = scr + (8 * c) * 33 + n;
        v4u o; o.x = pk2(s[0 * 33], s[1 * 33]); o.y = pk2(s[2 * 33], s[3 * 33]); o.z = pk2(s[4 * 33], s[5 * 33]); o.w = pk2(s[6 * 33], s[7 * 33]);
        *(GAS v4u*)(WT + (size_t)(n0 + n) * K + k0 + 8 * c) = o; }
    LDS_WAIT(); asm volatile("" ::: "memory");
}

struct Args { const float* in[22]; float* out; unsigned char* ws; };

using pg8::Unit; using pg8::cvt_pk_bf16;
__device__ __forceinline__ void st_bf16x8(bf16* p, f32x4 v0, f32x4 v1) {
    v4u w; w.x = cvt_pk_bf16(v0[0], v0[1]); w.y = cvt_pk_bf16(v0[2], v0[3]); w.z = cvt_pk_bf16(v1[0], v1[1]); w.w = cvt_pk_bf16(v1[2], v1[3]);
    *(v4u*)p = w;
}
__device__ __forceinline__ void st_f32x8(float* p, f32x4 v0, f32x4 v1) { *(f32x4*)p = v0; *(f32x4*)(p + 4) = v1; }
__device__ __forceinline__ f32x4 sigm4(f32x4 v) { return (f32x4){sigm(v[0]), sigm(v[1]), sigm(v[2]), sigm(v[3])}; }
__device__ __forceinline__ f32x4 silu4(f32x4 v) { return (f32x4){v[0] * sigm(v[0]), v[1] * sigm(v[1]), v[2] * sigm(v[2]), v[3] * sigm(v[3])}; }
__device__ __forceinline__ f32x4 ldbf4(const bf16* p) { const v2u w = *(const v2u*)p; return (f32x4){bflo(w.x), bfhi(w.x), bflo(w.y), bfhi(w.y)}; }

#define EPI_LOOP(...) \
    _Pragma("unroll") for (int ai = 0; ai < 2; ++ai) _Pragma("unroll") for (int m = 0; m < 4; ++m) { const int row = row0 + ai * 128 + m * 16; \
        _Pragma("unroll") for (int bj = 0; bj < 2; ++bj) { const int col = colb + bj * 32; const f32x4 v0 = acc[ai][bj][m][0], v1 = acc[ai][bj][m][1]; __VA_ARGS__ } }

struct EpiProj {
    bf16* QA; bf16* FA; bf16* IA; bf16* GA; bf16* LAT; bf16* GTA; bf16* GTB;
    __device__ __forceinline__ void operator()(const f32x4 (&acc)[2][2][4][2], const Unit& u, int wr, int wc, int fr, int fq) const {
        const int row0 = u.pm * 256 + wr * 64 + fr, pn = u.pn; const int colb = (pn & 3) * 256 + wc * 64 + 8 * fq;
        if (pn < 4)       { EPI_LOOP( st_bf16x8(QA + (size_t)row * 1024 + col, v0, v1); ) }
        else if (pn < 8)  { EPI_LOOP( st_bf16x8(FA + (size_t)row * 1024 + col, v0, v1); ) }
        else if (pn < 12) { EPI_LOOP( st_bf16x8(IA + (size_t)row * 1024 + col, v0, v1); ) }
        else if (pn < 16) { EPI_LOOP( st_bf16x8(GA + (size_t)row * 1024 + col, silu4(v0), silu4(v1)); ) }
        else if (pn < 20) { EPI_LOOP( st_bf16x8(LAT + (size_t)row * 1024 + col, v0, v1); ) }
        else { bf16* G = pn < 28 ? GTA : GTB; const int cb2 = ((pn - 20) & 7) * 256 + wc * 64 + 8 * fq;
            _Pragma("unroll") for (int ai = 0; ai < 2; ++ai) _Pragma("unroll") for (int m = 0; m < 4; ++m) { const int row = row0 + ai * 128 + m * 16;
                _Pragma("unroll") for (int bj = 0; bj < 2; ++bj) st_bf16x8(G + (size_t)row * 2048 + cb2 + bj * 32, sigm4(acc[ai][bj][m][0]), sigm4(acc[ai][bj][m][1])); } }
    }
};
struct EpiQ {
    bf16* QB; bf16* QIDX;
    __device__ __forceinline__ void operator()(const f32x4 (&acc)[2][2][4][2], const Unit& u, int wr, int wc, int fr, int fq) const {
        const int row0 = u.pm * 256 + wr * 64 + fr, pn = u.pn;
        if (pn < 16) { const int colb = pn * 256 + wc * 64 + 8 * fq; EPI_LOOP( st_bf16x8(QB + (size_t)row * 4096 + col, v0, v1); ) }
        else { const int colb = (pn - 16) * 256 + wc * 64 + 8 * fq; EPI_LOOP( st_bf16x8(QIDX + (size_t)row * 1024 + col, v0, v1); ) }
    }
};
struct EpiBf {
    bf16* O; int ldc; int coff;
    __device__ __forceinline__ void operator()(const f32x4 (&acc)[2][2][4][2], const Unit& u, int wr, int wc, int fr, int fq) const {
        const int row0 = u.pm * 256 + wr * 64 + fr; const int colb = coff + u.pn * 256 + wc * 64 + 8 * fq;
        EPI_LOOP( st_bf16x8(O + (size_t)row * ldc + col, v0, v1); )
    }
};
struct HookGate {
    static constexpr bool ON = true; const bf16* GA_; const bf16* GB_;
    __device__ __forceinline__ void mid(f32x4 (&acc)[2][2][4][2], const Unit& u, int wr, int wc, int fr, int fq) const {
        asm volatile("" : "+v"(fr), "+v"(fq));
        const int row0 = u.pm * 256 + wr * 64 + fr; const int colb = u.pn * 256 + wc * 64 + 8 * fq;
#pragma unroll
        for (int ai = 0; ai < 2; ++ai)
#pragma unroll
            for (int m = 0; m < 4; ++m) { const int row = row0 + ai * 128 + m * 16;
#pragma unroll
                for (int bj = 0; bj < 2; ++bj) { const size_t o = (size_t)row * 2048 + colb + bj * 32;
                    const f32x4 a0 = ldbf4(GA_ + o), a1 = ldbf4(GA_ + o + 4), b0 = ldbf4(GB_ + o), b1 = ldbf4(GB_ + o + 4);
                    f32x4 r0, r1;
#pragma unroll
                    for (int j = 0; j < 4; ++j) { r0[j] = a0[j] * __builtin_amdgcn_rcpf(b0[j]); r1[j] = a1[j] * __builtin_amdgcn_rcpf(b1[j]); }
                    acc[ai][bj][m][0] = acc[ai][bj][m][0] * r0; acc[ai][bj][m][1] = acc[ai][bj][m][1] * r1; }
                asm volatile("" : "+v"(acc[ai][0][m][0]), "+v"(acc[ai][0][m][1]), "+v"(acc[ai][1][m][0]), "+v"(acc[ai][1][m][1]));
                if (m & 1) asm volatile("" ::: "memory"); }
    }
};
struct EpiGateM {
    const bf16* GB_; bf16* MRG_;
    __device__ __forceinline__ void operator()(const f32x4 (&acc)[2][2][4][2], const Unit& u, int wr, int wc, int fr, int fq) const {
        const int row0 = u.pm * 256 + wr * 64 + fr; const int colb = u.pn * 256 + wc * 64 + 8 * fq;
        EPI_LOOP( const size_t o = (size_t)row * 2048 + col; const f32x4 g0 = ldbf4(GB_ + o), g1 = ldbf4(GB_ + o + 4); st_bf16x8(MRG_ + o, v0 * g0, v1 * g1); )
    }
};
struct EpiGateA {
    float* T1; const bf16* GT;
    __device__ __forceinline__ void operator()(const f32x4 (&acc)[2][2][4][2], const Unit& u, int wr, int wc, int fr, int fq) const {
        const int row0 = u.pm * 256 + wr * 64 + fr; const int colb = u.pn * 256 + wc * 64 + 8 * fq;
        EPI_LOOP( const size_t o = (size_t)row * 2048 + col; const f32x4 g0 = ldbf4(GT + o), g1 = ldbf4(GT + o + 4); st_f32x8(T1 + o, v0 * g0, v1 * g1); )
    }
};
struct EpiGateB {
    const float* T1; const bf16* GT; bf16* MRG;
    __device__ __forceinline__ void operator()(const f32x4 (&acc)[2][2][4][2], const Unit& u, int wr, int wc, int fr, int fq) const {
        const int row0 = u.pm * 256 + wr * 64 + fr; const int colb = u.pn * 256 + wc * 64 + 8 * fq;
        EPI_LOOP( const size_t o = (size_t)row * 2048 + col; const f32x4 g0 = ldbf4(GT + o), g1 = ldbf4(GT + o + 4); const f32x4 t0 = *(const f32x4*)(T1 + o), t1 = *(const f32x4*)(T1 + o + 4);
                  st_bf16x8(MRG + o, t0 + v0 * g0, t1 + v1 * g1); )
    }
};
struct EpiRes {
    const float* X; const bf16* Xh; bf16* R; const float* gt;
    __device__ __forceinline__ void operator()(const f32x4 (&acc)[2][2][4][2], const Unit& u, int wr, int wc, int fr, int fq) const {
        const int row0 = u.pm * 256 + wr * 64 + fr; const int colb = u.pn * 256 + wc * 64 + 8 * fq; const float* g = gt + (size_t)(u.pm >> 4) * MODW;
        if (X) { EPI_LOOP( const size_t o = (size_t)row * 2048 + col; const f32x4 x0 = *(const f32x4*)(X + o), x1 = *(const f32x4*)(X + o + 4); const f32x4 g0 = *(const f32x4*)(g + col), g1 = *(const f32x4*)(g + col + 4);
                  st_bf16x8(R + o, x0 * ALPHA + (g0 + 1.f) * v0, x1 * ALPHA + (g1 + 1.f) * v1); ) }
        else { EPI_LOOP( const size_t o = (size_t)row * 2048 + col; const f32x4 x0 = ldbf4(Xh + o), x1 = ldbf4(Xh + o + 4); const f32x4 g0 = *(const f32x4*)(g + col), g1 = *(const f32x4*)(g + col + 4);
                  st_bf16x8(R + o, x0 * ALPHA + (g0 + 1.f) * v0, x1 * ALPHA + (g1 + 1.f) * v1); ) }
    }
};
struct EpiSwiglu {
    bf16* ACT;
    __device__ __forceinline__ void operator()(const f32x4 (&acc)[2][2][4][2], const Unit& u, int wr, int wc, int fr, int fq) const {
        const int row0 = u.pm * 256 + wr * 64 + fr; const int col = u.pn * 128 + wc * 32 + 8 * fq;
#pragma unroll
        for (int ai = 0; ai < 2; ++ai)
#pragma unroll
            for (int m = 0; m < 4; ++m) { const int row = row0 + ai * 128 + m * 16;
                st_bf16x8(ACT + (size_t)row * DFF + col, silu4(acc[ai][0][m][0]) * acc[ai][1][m][0], silu4(acc[ai][0][m][1]) * acc[ai][1][m][1]); }
    }
};

__global__ void __launch_bounds__(NTHR, 2) fwd_kernel(Args args) {
    extern __shared__ __attribute__((aligned(16))) unsigned char lds_raw[];
    LAS unsigned char* lds = (LAS unsigned char*)lds_raw;
    const int G = gridDim.x, blk = blockIdx.x;
    const int NGW = G * NWAVES, NT = G * NTHR;
    unsigned char* const ws_base = args.ws;
    gu32* ctl = (gu32*)(ws_base + WS_CTL);
    for (int u = threadIdx.x; u < (LDS_BYTES - LDSCTL_OFF) / 4; u += NTHR) ((LAS unsigned*)(lds + LDSCTL_OFF))[u] = 0u;
    __syncthreads();
    volatile LAS unsigned* MISC = (volatile LAS unsigned*)(lds + MISC_OFF);
    const int wave_s = __builtin_amdgcn_readfirstlane((int)(threadIdx.x >> 6));
    XcdBarrier bar = xcd_barrier_post((unsigned*)(ctl + CW_BAR), MISC + 8); bar.wave = wave_s;
    if (threadIdx.x == 0) { unsigned nloc_ = 0u, nx_ = 0u; xcd_barrier_complete(bar.bar, bar.x, nloc_, nx_); bar.st[0] = nloc_; bar.st[1] = nx_; }
    __syncthreads();
#define GRID_BAR() xcd_barrier(bar)

#define x_in ((const float*)(const GAS float*)args.in[0 + z_])
#define c_in ((const float*)(const GAS float*)args.in[1 + z_])
#define w_ada ((const float*)(const GAS float*)args.in[2 + z_])
#define b_ada ((const float*)(const GAS float*)args.in[3 + z_])
#define w_in ((const float*)(const GAS float*)args.in[4 + z_])
#define lb_logits ((const float*)(const GAS float*)args.in[5 + z_])
#define g_hg ((const float*)(const GAS float*)args.in[6 + z_])
#define w_pa ((const float*)(const GAS float*)args.in[7 + z_])
#define g_cq ((const float*)(const GAS float*)args.in[8 + z_])
#define g_ckv ((const float*)(const GAS float*)args.in[9 + z_])
#define w_uq ((const float*)(const GAS float*)args.in[10 + z_])
#define w_iq ((const float*)(const GAS float*)args.in[11 + z_])
#define w_uv ((const float*)(const GAS float*)args.in[12 + z_])
#define w_pb ((const float*)(const GAS float*)args.in[13 + z_])
#define w_out ((const float*)(const GAS float*)args.in[14 + z_])
#define ln1_g ((const float*)(const GAS float*)args.in[15 + z_])
#define ln1_b ((const float*)(const GAS float*)args.in[16 + z_])
#define w_gate ((const float*)(const GAS float*)args.in[17 + z_])
#define w_up ((const float*)(const GAS float*)args.in[18 + z_])
#define w_down ((const float*)(const GAS float*)args.in[19 + z_])
#define ln2_g ((const float*)(const GAS float*)args.in[20 + z_])
#define ln2_b ((const float*)(const GAS float*)args.in[21 + z_])
#define MOD  ((float*)(ws + WS_MOD))
#define LB   ((float*)(ws + WS_LB))
#define MODP ((float*)(ws + WS_MODP))
#define W1   ((bf16*)(ws + WS_W1))
#define W3   ((bf16*)(ws + WS_W3))
#define W6   ((bf16*)(ws + WS_W6))
#define W7   ((bf16*)(ws + WS_W7))
#define W8   ((bf16*)(ws + WS_W8))
#define W10  ((bf16*)(ws + WS_W10))
#define W11  ((bf16*)(ws + WS_W11))
#define XB   ((bf16*)(ws + WS_X))
#define RB   ((bf16*)(ws + WS_R))
#define HB   ((bf16*)(ws + WS_H))
#define QA   ((bf16*)(ws + WS_QA))
#define FA   ((bf16*)(ws + WS_FA))
#define IA   ((bf16*)(ws + WS_IA))
#define GA   ((bf16*)(ws + WS_GA))
#define LAT  ((bf16*)(ws + WS_LAT))
#define GTA  ((bf16*)(ws + WS_GTA))
#define GTB  ((bf16*)(ws + WS_GTB))
#define CQN  ((bf16*)(ws + WS_CQN))
#define CKV  ((bf16*)(ws + WS_CKV))
#define KIDX ((bf16*)(ws + WS_KIDX))
#define IDXW ((float*)(ws + WS_IDXW))
#define QB   ((bf16*)(ws + WS_QB))
#define QIDX ((bf16*)(ws + WS_QIDX))
#define SEL  ((unsigned short*)(ws + WS_SEL))
#define YAB  ((bf16*)(ws + WS_YAB))
#define MRG  ((bf16*)(ws + WS_MRG))
#define OB   ((bf16*)(ws + WS_OB))
#define ISC  ((float*)(ws + WS_BIG))
#define OP   ((float*)(ws + WS_BIG))
#define ACT  ((bf16*)(ws + WS_BIG))
#define KK   LAT
#define modl (MOD + (size_t)l * NBATCH * MODW)
#define KSB  ((bf16*)(ws + WS_KSB))
#define QSB  ((bf16*)(ws + WS_QSB))
#define KVT  ((float*)(ws + WS_BIG))
#define SPB  ((bf16*)(ws + WS_FA))
#define DEB  ((float*)(ws + WS_DEB))
#define PHASE_BEGIN { unsigned om_ = ~0u; asm volatile("" : "+s"(om_)); int tid = wave_s * 64 + (int)__builtin_amdgcn_mbcnt_hi(om_, __builtin_amdgcn_mbcnt_lo(om_, 0u)); asm volatile("" : "+v"(tid)); int z_ = 0; asm volatile("" : "+s"(z_)); (void)z_; GAS unsigned char* wsg_ = (GAS unsigned char*)ws_base; asm volatile("" : "+s"(wsg_)); unsigned char* ws = (unsigned char*)wsg_; const int lane = tid & 63, wave = __builtin_amdgcn_readfirstlane(tid >> 6); \
        const int gw = blk * NWAVES + wave, gtid = blk * NTHR + tid; LAS float* wscr = (LAS float*)(lds + wave * 16384); (void)lane; (void)gw; (void)gtid; (void)wscr;
#define PHASE_END }

#define CVT_DECODE(IT_, MID_, K0_, N0_) do { int r_ = (IT_); \
        if (r_ < I1) { MID_ = 0; K0_ = (r_ / (N1 / 32)) * 64; N0_ = (r_ % (N1 / 32)) * 32; } else { r_ -= I1; \
        if (r_ < I3) { MID_ = 1; K0_ = (r_ / (N3 / 32)) * 64; N0_ = (r_ % (N3 / 32)) * 32; } else { r_ -= I3; \
        if (r_ < I6) { MID_ = 2; K0_ = (r_ / 32) * 64; N0_ = (r_ % 32) * 32; } else { r_ -= I6; \
        if (r_ < I7) { MID_ = 3; K0_ = (r_ / (DM / 32)) * 64; N0_ = (r_ % (DM / 32)) * 32; } else { r_ -= I7; \
        if (r_ < I8) { MID_ = 4; K0_ = (r_ / (DM / 32)) * 64; N0_ = (r_ % (DM / 32)) * 32; } else { r_ -= I8; \
        if (r_ < I10) { MID_ = 5; K0_ = (r_ / (N10 / 32)) * 64; N0_ = (r_ % (N10 / 32)) * 32; } else { r_ -= I10; \
        MID_ = 6; K0_ = (r_ / (DM / 32)) * 64; N0_ = (r_ % (DM / 32)) * 32; } } } } } } } while (0)
#define CVT_LOAD(MID_, K0_, N0_, TV_) do { \
        if (MID_ == 0) cvt_load([=](int k, int n) -> float { return n < 4944 ? s_in[(size_t)k * 9040 + n] : (n < 5120 ? 0.f : s_in[(size_t)k * 9040 + n - 176]); }, K0_, N0_, lane, TV_); \
        else if (MID_ == 1) cvt_load([=](int k, int n) -> float { return n < 4096 ? s_uq[(size_t)k * 4096 + n] * 0.0625f : s_iq[(size_t)k * 1024 + n - 4096]; }, K0_, N0_, lane, TV_); \
        else if (MID_ == 2) cvt_load([=](int k, int n) -> float { const int h = n >> 6, v = n & 63, kk = k >> 8, c = k & 255; return kk == (h & 3) ? s_uv[((size_t)h * 256 + c) * 64 + v] : 0.f; }, K0_, N0_, lane, TV_); \
        else if (MID_ == 3) cvt_load([=](int k, int n) -> float { return k < 1024 ? s_pa[(size_t)k * DM + n] : s_pb[(size_t)(k - 1024) * DM + n]; }, K0_, N0_, lane, TV_); \
        else if (MID_ == 4) cvt_load([=](int k, int n) -> float { return s_out[(size_t)k * DM + n]; }, K0_, N0_, lane, TV_); \
        else if (MID_ == 5) cvt_load([=](int k, int n) -> float { const int pn = n >> 8, rr = n & 255, cc = pn * 128 + (rr >> 6) * 32 + (rr & 31); return (rr & 32) ? s_u[(size_t)k * DFF + cc] : s_g[(size_t)k * DFF + cc]; }, K0_, N0_, lane, TV_); \
        else cvt_load([=](int k, int n) -> float { return s_d[(size_t)k * DM + n]; }, K0_, N0_, lane, TV_); } while (0)
#define CONVERT_LAYER(L) do { const int l_ = (L); \
        const float* s_in = w_in + (size_t)l_ * DM * 9040; const float* s_uq = w_uq + (size_t)l_ * SAR * 4096; const float* s_iq = w_iq + (size_t)l_ * SAR * 1024; \
        const float* s_uv = w_uv + (size_t)l_ * 16 * 256 * 64; const float* s_pa = w_pa + (size_t)l_ * 1024 * DM; const float* s_pb = w_pb + (size_t)l_ * 1024 * DM; \
        const float* s_out = w_out + (size_t)l_ * DM * DM; const float* s_g = w_gate + (size_t)l_ * DM * DFF; const float* s_u = w_up + (size_t)l_ * DM * DFF; const float* s_d = w_down + (size_t)l_ * DFF * DM; \
        constexpr int I1 = (DM / 64) * (N1 / 32), I3 = (SAR / 64) * (N3 / 32), I6 = (1024 / 64) * (1024 / 32), I7 = (DM / 64) * (DM / 32), I8 = I7, I10 = (DM / 64) * (N10 / 32), I11 = (DFF / 64) * (DM / 32); \
        constexpr int NIT = I1 + I3 + I6 + I7 + I8 + I10 + I11; \
        float tv_[32]; int mid_ = 0, k0_ = 0, n0_ = 0; \
        { CVT_DECODE(gw, mid_, k0_, n0_); CVT_LOAD(mid_, k0_, n0_, tv_); } \
        for (int it = gw; it < NIT; it += NGW) { \
            float tc_[32]; _Pragma("unroll") for (int i = 0; i < 32; ++i) tc_[i] = tv_[i]; \
            const int mc_ = mid_, kc_ = k0_, nc_ = n0_; \
            { const int itn_ = it + NGW < NIT ? it + NGW : it; CVT_DECODE(itn_, mid_, k0_, n0_); CVT_LOAD(mid_, k0_, n0_, tv_); }     \
            bf16* wt_ = mc_ == 0 ? W1 : mc_ == 1 ? W3 : mc_ == 2 ? W6 : mc_ == 3 ? W7 : mc_ == 4 ? W8 : mc_ == 5 ? W10 : W11; \
            const int kk_ = mc_ == 0 ? DM : mc_ == 1 ? SAR : mc_ == 2 ? 1024 : mc_ == 3 ? DM : mc_ == 4 ? DM : mc_ == 5 ? DM : DFF; \
            cvt_store(tc_, wt_, kk_, kc_, nc_, wscr, lane); \
        } } while (0)


#ifndef HGRN_NAIVE
#define HGRN_NAIVE 0
#endif
#ifndef IDX_NAIVE
#define IDX_NAIVE 0
#endif
#ifndef ATT_NAIVE
#define ATT_NAIVE 0
#endif
#ifndef TOPK_OLD
#define TOPK_OLD 0
#endif
#ifndef REP_HB
#define REP_HB 1
#endif
#ifndef REP_HC
#define REP_HC 1
#endif
#ifndef REP_P4A
#define REP_P4A 1
#endif
#ifndef REP_P5
#define REP_P5 1
#endif
#ifndef REP_P9
#define REP_P9 1
#endif
#ifndef REP_P12
#define REP_P12 1
#endif
#ifndef REP_TOPK
#define REP_TOPK 1
#endif
#ifndef REP_ATT
#define REP_ATT 1
#endif
#ifndef DRY_ATT
#define DRY_ATT 0
#endif
#ifndef REP_M1
#define REP_M1 1
#endif
#ifndef REP_M2
#define REP_M2 1
#endif
#ifndef REP_M3
#define REP_M3 1
#endif

    PHASE_BEGIN
    {
        LAS float* sc = (LAS float*)lds;
        for (int i = tid; i < NBATCH * DM; i += NTHR) { const float v = c_in[i]; sc[i] = v * sigm(v); }
        __syncthreads();
        for (int item = gtid; item < 8 * 12288; item += NT) {
            const int ks = item / 12288, cg = item % 12288, l = cg / 3072, n4 = (cg % 3072) * 4;
            const float* wp = w_ada + ((size_t)l * DM + ks * 256) * MODW + n4;
            f32x4 a0 = {0.f, 0.f, 0.f, 0.f}, a1 = a0, a2 = a0, a3 = a0;
#pragma unroll 8
            for (int k = 0; k < 256; ++k) { const f32x4 w = *(const f32x4*)(wp + (size_t)k * MODW); const int kk = ks * 256 + k;
                a0 += w * sc[kk]; a1 += w * sc[2048 + kk]; a2 += w * sc[4096 + kk]; a3 += w * sc[6144 + kk]; }
            float* o = MODP + ((size_t)(ks * 4 + l) * 4) * MODW + n4;
            *(f32x4*)(o) = a0; *(f32x4*)(o + MODW) = a1; *(f32x4*)(o + 2 * MODW) = a2; *(f32x4*)(o + 3 * MODW) = a3;
        }
        if (gtid < 1024) {
            const float a = lb_logits[gtid], b = lb_logits[1024 + gtid], c = lb_logits[2048 + gtid], d = lb_logits[3072 + gtid];
            const float mx = fmaxf(fmaxf(a, b), fmaxf(c, d)); const float ea = expf(a - mx), eb = expf(b - mx), ec = expf(c - mx), ed = expf(d - mx); const float inv = 1.f / (ea + eb + ec + ed);
            LB[gtid] = 0.f; LB[1024 + gtid] = eb * inv; LB[2048 + gtid] = (eb + ec) * inv; LB[3072 + gtid] = (eb + ec + ed) * inv;
        }
        __syncthreads();
        CONVERT_LAYER(0);
    }
    PHASE_END
    GRID_BAR();
    PHASE_BEGIN
    for (int i = gtid; i < DEPTH * NBATCH * MODW; i += NT) {
        const int l = i / (NBATCH * MODW), r = i % (NBATCH * MODW), b = r / MODW, n = r % MODW;
        float s = b_ada[l * MODW + n];
#pragma unroll
        for (int ks = 0; ks < 8; ++ks) s += MODP[((size_t)(ks * 4 + l) * 4 + b) * MODW + n];
        MOD[i] = s;
    }
    PHASE_END
    GRID_BAR();
    PHASE_BEGIN
    for (size_t i0 = gtid; i0 < (size_t)M * DM / 8; i0 += (size_t)NT * 4) {
        f32x4 xa[4], xb[4], sa[4], sb[4], ha[4], hb[4];
#pragma unroll
        for (int t = 0; t < 4; ++t) { size_t gi = i0 + (size_t)t * NT; gi = gi < (size_t)M * DM / 8 ? gi : (size_t)M * DM / 8 - 1; const size_t e = gi * 8; const int row = (int)(e / DM), col = (int)(e % DM), b = row / SEQ; const float* md = MOD + (size_t)b * MODW;
            xa[t] = *(const f32x4*)(x_in + e); xb[t] = *(const f32x4*)(x_in + e + 4); sa[t] = *(const f32x4*)(md + 2048 + col); sb[t] = *(const f32x4*)(md + 2048 + col + 4); ha[t] = *(const f32x4*)(md + col); hb[t] = *(const f32x4*)(md + col + 4); }
#pragma unroll
        for (int t = 0; t < 4; ++t) { size_t gi = i0 + (size_t)t * NT; gi = gi < (size_t)M * DM / 8 ? gi : (size_t)M * DM / 8 - 1; const size_t e = gi * 8; st_bf16x8(HB + e, xa[t] * (sa[t] + 1.f) + ha[t], xb[t] * (sb[t] + 1.f) + hb[t]); }
    }
    PHASE_END
    GRID_BAR();

    for (int l = 0; l < DEPTH; ++l) {
        PHASE_BEGIN
        { pg8::Gemm g{HB, W1, M, N1, DM, DM, DM, 0}; pg8::StaticOrder S; S.init(M, N1, G, blk);
          EpiProj E{QA, FA, IA, GA, LAT, GTA, GTB}; pg8::gemm_phase(lds, g, S, E, tid); }
        PHASE_END
        GRID_BAR();
        for (int rep_ = 0; rep_ < REP_M1; ++rep_) {
        PHASE_BEGIN
        v2u ra0, ra1, rkv; unsigned short rki, riw;
        { const bf16* lr = LAT + (size_t)gw * 1024; ra0 = *(const v2u*)(lr + 4 * lane); ra1 = *(const v2u*)(lr + 256 + 4 * lane); rkv = *(const v2u*)(lr + 512 + 4 * lane); rki = lr[768 + lane]; riw = lr[832 + (lane & 15)]; }
        for (int row = gw; row < M; row += NGW) {
            const f32x4 a0 = (f32x4){bflo(ra0.x), bfhi(ra0.x), bflo(ra0.y), bfhi(ra0.y)}, a1 = (f32x4){bflo(ra1.x), bfhi(ra1.x), bflo(ra1.y), bfhi(ra1.y)}, kv = (f32x4){bflo(rkv.x), bfhi(rkv.x), bflo(rkv.y), bfhi(rkv.y)};
            const float ki = bf2f(rki), iw = bf2f(riw);
            { const int rn = row + NGW < M ? row + NGW : row; const bf16* lr = LAT + (size_t)rn * 1024;
              ra0 = *(const v2u*)(lr + 4 * lane); ra1 = *(const v2u*)(lr + 256 + 4 * lane); rkv = *(const v2u*)(lr + 512 + 4 * lane); rki = lr[768 + lane]; riw = lr[832 + (lane & 15)]; }
            float sq = a0[0] * a0[0] + a0[1] * a0[1] + a0[2] * a0[2] + a0[3] * a0[3] + a1[0] * a1[0] + a1[1] * a1[1] + a1[2] * a1[2] + a1[3] * a1[3];
            float sk = kv[0] * kv[0] + kv[1] * kv[1] + kv[2] * kv[2] + kv[3] * kv[3];
            sq = wave_sum(sq); sk = wave_sum(sk);
            const float rq = 1.0f / sqrtf(sq * (1.f / 512.f) + 1e-6f), rk = 1.0f / sqrtf(sk * (1.f / 256.f) + 1e-6f);
            const f32x4 g0 = *(const f32x4*)(g_cq + l * 512 + 4 * lane), g1 = *(const f32x4*)(g_cq + l * 512 + 256 + 4 * lane), gk = *(const f32x4*)(g_ckv + l * 256 + 4 * lane);
            v2u o; f32x4 t = a0 * rq * g0; o.x = pk2(t[0], t[1]); o.y = pk2(t[2], t[3]); *(v2u*)(CQN + (size_t)row * 512 + 4 * lane) = o;
            t = a1 * rq * g1; o.x = pk2(t[0], t[1]); o.y = pk2(t[2], t[3]); *(v2u*)(CQN + (size_t)row * 512 + 256 + 4 * lane) = o;
            t = kv * rk * gk; o.x = pk2(t[0], t[1]); o.y = pk2(t[2], t[3]); *(v2u*)(CKV + (size_t)row * 256 + 4 * lane) = o;
            KIDX[(size_t)row * 64 + lane] = (bf16)f2bf(ki);
            if (lane < 16) IDXW[(size_t)row * 16 + lane] = iw * 0.03125f;
        }
        PHASE_END
        PHASE_BEGIN
        {
            const int cp = tid & 63, sg = tid >> 6;
            LAS unsigned char* KST = lds;
            LAS unsigned char* VTL = lds + 18432;
            LAS float* SEGT = (LAS float*)(lds + 36864);
            LAS float* G63 = (LAS float*)(lds + 40960);
            unsigned pfa[8], pq[8], pv[8];
#define HA_REQ(U_) do { int uu_ = (U_); asm volatile("" : "+s"(uu_)); const int bh_ = uu_ >> 6, c_ = uu_ & 63, b_ = bh_ >> 3, h_ = bh_ & 7; \
                const size_t rowb_ = (size_t)b_ * SEQ + c_ * 64 + sg * 8; const int col_ = h_ * 128 + 2 * cp; \
                _Pragma("unroll") for (int i = 0; i < 8; ++i) { pfa[i] = *(const unsigned*)(FA + (rowb_ + i) * 1024 + col_); pq[i] = *(const unsigned*)(QA + (rowb_ + i) * 1024 + col_); pv[i] = *(const unsigned*)(IA + (rowb_ + i) * 1024 + col_); } } while (0)
            HA_REQ(blk);
            for (int u = blk; u < 2048; u += G) {
                const int bh = u >> 6, c = u & 63, b = bh >> 3, h = bh & 7;
                const size_t rowb = (size_t)b * SEQ + c * 64 + sg * 8; const int col = h * 128 + 2 * cp;
                const float lb0 = LB[l * 1024 + col], lb1 = LB[l * 1024 + col + 1];
                float lf0[8], lf1[8], kk0[8], kk1[8]; unsigned cq[8], cv[8];
#pragma unroll
                for (int i = 0; i < 8; ++i) { cq[i] = pq[i]; cv[i] = pv[i]; }
#pragma unroll
                for (int i = 0; i < 8; ++i) { const float2 fa = make_float2(bflo(pfa[i]), bfhi(pfa[i]));
                    const float f0 = fminf(fmaxf(lb0 + (1.f - lb0) * sigm(fa.x), 1e-6f), 1.f), f1 = fminf(fmaxf(lb1 + (1.f - lb1) * sigm(fa.y), 1e-6f), 1.f);
                    lf0[i] = __logf(f0); lf1[i] = __logf(f1); kk0[i] = (1.f - lb0) * sigm(-fa.x); kk1[i] = (1.f - lb1) * sigm(-fa.y); }
#pragma unroll
                for (int i = 1; i < 8; ++i) { lf0[i] += lf0[i - 1]; lf1[i] += lf1[i - 1]; }
                SEGT[sg * 128 + 2 * cp] = lf0[7]; SEGT[sg * 128 + 2 * cp + 1] = lf1[7];
                HA_REQ(u + G < 2048 ? u + G : u);
                __syncthreads();
                float pre0 = 0.f, pre1 = 0.f, r0 = 0.f, r1 = 0.f, t0 = 0.f, t1 = 0.f;
#pragma unroll
                for (int s2 = 0; s2 < 8; ++s2) { const float a0 = SEGT[s2 * 128 + 2 * cp], a1 = SEGT[s2 * 128 + 2 * cp + 1];
                    if (s2 < sg) { pre0 += a0; pre1 += a1; } if (s2 < 4) { r0 += a0; r1 += a1; } t0 += a0; t1 += a1; }
                unsigned ksw0[4], ksw1[4], vw0[4], vw1[4]; float ks0p = 0.f, ks1p = 0.f, v0p = 0.f, v1p = 0.f;
#pragma unroll
                for (int i = 0; i < 8; ++i) {
                    const float b0 = pre0 + lf0[i], b1 = pre1 + lf1[i];
                    const unsigned qw = cq[i]; const unsigned vw = cv[i];
                    const float qs0 = bflo(qw) * __expf(b0 - r0), qs1 = bfhi(qw) * __expf(b1 - r1);
                    const float ks0 = kk0[i] * __expf(r0 - b0), ks1 = kk1[i] * __expf(r1 - b1);
                    *(unsigned*)(QSB + (rowb + i) * 1024 + col) = pk2(qs0, qs1);
                    *(unsigned*)(KSB + (rowb + i) * 1024 + col) = pk2(ks0, ks1);
                    if (i & 1) { ksw0[i >> 1] = pk2(ks0p, ks0); ksw1[i >> 1] = pk2(ks1p, ks1); vw0[i >> 1] = pk2(v0p, bflo(vw)); vw1[i >> 1] = pk2(v1p, bfhi(vw)); }
                    else { ks0p = ks0; ks1p = ks1; v0p = bflo(vw); v1p = bfhi(vw); }
                }
                *(LAS v4u*)(KST + (2 * cp) * 144 + sg * 16) = (v4u){ksw0[0], ksw0[1], ksw0[2], ksw0[3]};
                *(LAS v4u*)(KST + (2 * cp + 1) * 144 + sg * 16) = (v4u){ksw1[0], ksw1[1], ksw1[2], ksw1[3]};
                *(LAS v4u*)(VTL + (2 * cp) * 144 + sg * 16) = (v4u){vw0[0], vw0[1], vw0[2], vw0[3]};
                *(LAS v4u*)(VTL + (2 * cp + 1) * 144 + sg * 16) = (v4u){vw1[0], vw1[1], vw1[2], vw1[3]};
                if (sg == 7) { float* de = DEB + (size_t)u * 256; *(float2*)(de + 2 * cp) = make_float2(__expf(r0), __expf(r1)); *(float2*)(de + 128 + 2 * cp) = make_float2(__expf(t0), __expf(t1));
                    G63[2 * cp] = __expf(t0 - r0); G63[2 * cp + 1] = __expf(t1 - r1); }
                __syncthreads();
                { const int kt = wave >> 1, vt0 = (wave & 1) * 2, lr = lane & 31, lh = lane >> 5;
                  f32x16 acc0, acc1;
#pragma unroll
                  for (int r = 0; r < 16; ++r) { acc0[r] = 0.f; acc1[r] = 0.f; }
#pragma unroll
                  for (int s4 = 0; s4 < 4; ++s4) {
                      const bf16x8 kb = *(const LAS bf16x8*)(KST + (kt * 32 + lr) * 144 + (s4 * 16 + 8 * lh) * 2);
                      const bf16x8 a0 = *(const LAS bf16x8*)(VTL + (vt0 * 32 + lr) * 144 + (s4 * 16 + 8 * lh) * 2);
                      const bf16x8 a1 = *(const LAS bf16x8*)(VTL + ((vt0 + 1) * 32 + lr) * 144 + (s4 * 16 + 8 * lh) * 2);
                      acc0 = __builtin_amdgcn_mfma_f32_32x32x16_bf16(a0, kb, acc0, 0, 0, 0); acc1 = __builtin_amdgcn_mfma_f32_32x32x16_bf16(a1, kb, acc1, 0, 0, 0); }
                  float* kvt = KVT + (size_t)u * 16384 + kt * 32 + lr; const float g = G63[kt * 32 + lr];
#pragma unroll
                  for (int r = 0; r < 16; ++r) { const int vv = 8 * (r >> 2) + 4 * lh + (r & 3);
                      kvt[(size_t)(vt0 * 32 + vv) * 128] = acc0[r] * g; kvt[(size_t)((vt0 + 1) * 32 + vv) * 128] = acc1[r] * g; } }
                __syncthreads();
            }
        }
#undef HA_REQ
        PHASE_END
        GRID_BAR();
        }
        for (int rep_ = 0; rep_ < REP_M2; ++rep_) {
        PHASE_BEGIN
        for (int item = gtid; item < 32 * 4096; item += NT) {
            const int bh = item >> 12, v = (item >> 5) & 127, k4 = (item & 31) * 4;
            f32x4 S = {0.f, 0.f, 0.f, 0.f};
            for (int c0 = 0; c0 < 64; c0 += 8) {
                f32x4 kv[8], dd[8], ee[8];
#pragma unroll
                for (int j = 0; j < 8; ++j) { const size_t u = (size_t)bh * 64 + c0 + j; kv[j] = *(const f32x4*)(KVT + u * 16384 + v * 128 + k4); ee[j] = *(const f32x4*)(DEB + u * 256 + k4); dd[j] = *(const f32x4*)(DEB + u * 256 + 128 + k4); }
#pragma unroll
                for (int j = 0; j < 8; ++j) { const size_t u = (size_t)bh * 64 + c0 + j; const f32x4 sp = S * ee[j]; v2u w; w.x = pk2(sp[0], sp[1]); w.y = pk2(sp[2], sp[3]);
                    *(v2u*)(SPB + u * 16384 + v * 128 + k4) = w; S = S * dd[j] + kv[j]; }
            }
        }
        PHASE_END
        PHASE_BEGIN
        { pg8::Gemm g{CQN, W3, M, N3, SAR, SAR, SAR, 0}; pg8::StaticOrder S; S.init(M, N3, G, blk);
          EpiQ E{QB, QIDX}; pg8::gemm_phase(lds, g, S, E, tid); }
        PHASE_END
        GRID_BAR();
        }
        for (int rep_ = 0; rep_ < REP_M3; ++rep_) {
        PHASE_BEGIN
        {
            LAS unsigned char* QSL = lds;
            LAS unsigned char* KSL = lds + 17408;
            LAS unsigned char* VTL = lds + 34816;
            LAS unsigned char* SPL = lds + 53248;
            LAS unsigned char* AL = lds + 88064;
            LAS float* SSQ = (LAS float*)(lds + 97280);
            const int cp = tid & 63, sg = tid >> 6, lr = lane & 31, lh = lane >> 5;
            v4u rq[2], rk[2], rs[4]; unsigned rv[8]; unsigned short rg[16];
#define HC_REQ(U_) do { int uu_ = (U_); asm volatile("" : "+s"(uu_));   const int bh_ = uu_ >> 6, c_ = uu_ & 63, b_ = bh_ >> 3, h_ = bh_ & 7; const size_t row0_ = (size_t)b_ * SEQ + c_ * 64; const int col0_ = h_ * 128; \
                _Pragma("unroll") for (int j = 0; j < 2; ++j) { const int q = tid + 512 * j, rr = q >> 4, cc = q & 15; \
                    rq[j] = *(const v4u*)(QSB + (row0_ + rr) * 1024 + col0_ + cc * 8); rk[j] = *(const v4u*)(KSB + (row0_ + rr) * 1024 + col0_ + cc * 8); } \
                _Pragma("unroll") for (int j = 0; j < 4; ++j) { const int q = tid + 512 * j, rr = q >> 4, cc = q & 15; rs[j] = *(const v4u*)(SPB + (size_t)uu_ * 16384 + rr * 128 + cc * 8); } \
                _Pragma("unroll") for (int i = 0; i < 8; ++i) rv[i] = *(const unsigned*)(IA + (row0_ + sg * 8 + i) * 1024 + col0_ + 2 * cp); \
                { const int it_ = wave >> 2, vt_ = wave & 3; const int colg_ = col0_ + vt_ * 32 + lr; \
                  _Pragma("unroll") for (int r = 0; r < 16; ++r) { const int ii = it_ * 32 + 8 * (r >> 2) + 4 * lh + (r & 3); rg[r] = GA[(row0_ + ii) * 1024 + colg_]; } } } while (0)
            HC_REQ(blk);
            for (int u = blk; u < 2048; u += G) {
                const int bh = u >> 6, c = u & 63, b = bh >> 3, h = bh & 7;
                const size_t row0 = (size_t)b * SEQ + c * 64; const int col0 = h * 128;
#pragma unroll
                for (int j = 0; j < 2; ++j) { const int q = tid + 512 * j, rr = q >> 4, cc = q & 15;
                    *(LAS v4u*)(QSL + rr * 272 + cc * 16) = rq[j]; *(LAS v4u*)(KSL + rr * 272 + cc * 16) = rk[j]; }
#pragma unroll
                for (int j = 0; j < 4; ++j) { const int q = tid + 512 * j, rr = q >> 4, cc = q & 15; *(LAS v4u*)(SPL + rr * 272 + cc * 16) = rs[j]; }
                { unsigned vw0[4], vw1[4]; float v0p = 0.f, v1p = 0.f;
#pragma unroll
                  for (int i = 0; i < 8; ++i) { const unsigned vw = rv[i];
                      if (i & 1) { vw0[i >> 1] = pk2(v0p, bflo(vw)); vw1[i >> 1] = pk2(v1p, bfhi(vw)); } else { v0p = bflo(vw); v1p = bfhi(vw); } }
                  *(LAS v4u*)(VTL + (2 * cp) * 144 + sg * 16) = (v4u){vw0[0], vw0[1], vw0[2], vw0[3]};
                  *(LAS v4u*)(VTL + (2 * cp + 1) * 144 + sg * 16) = (v4u){vw1[0], vw1[1], vw1[2], vw1[3]}; }
                float gav[16];
#pragma unroll
                for (int r = 0; r < 16; ++r) gav[r] = bf2f(rg[r]);
                HC_REQ(u + G < 2048 ? u + G : u);
                __syncthreads();
                if (wave < 4) {
                    const int it = wave >> 1, jt = wave & 1;
                    f32x16 acc;
#pragma unroll
                    for (int r = 0; r < 16; ++r) acc[r] = 0.f;
                    if (!(it == 0 && jt == 1)) {
#pragma unroll
                        for (int s8 = 0; s8 < 8; ++s8) {
                            const bf16x8 a = *(const LAS bf16x8*)(QSL + (it * 32 + lr) * 272 + (s8 * 16 + 8 * lh) * 2);
                            const bf16x8 bb = *(const LAS bf16x8*)(KSL + (jt * 32 + lr) * 272 + (s8 * 16 + 8 * lh) * 2);
                            acc = __builtin_amdgcn_mfma_f32_32x32x16_bf16(a, bb, acc, 0, 0, 0); } }
                    const int jj = jt * 32 + lr;
#pragma unroll
                    for (int r = 0; r < 16; ++r) { const int ii = it * 32 + 8 * (r >> 2) + 4 * lh + (r & 3); const float x = (jj <= ii) ? acc[r] : 0.f;
                        *(LAS unsigned short*)(AL + ii * 144 + jj * 2) = (unsigned short)(pk2(x, 0.f) & 0xffffu); }
                }
                __syncthreads();
                { const int it = wave >> 2, vt = wave & 3;
                  f32x16 acc;
#pragma unroll
                  for (int r = 0; r < 16; ++r) acc[r] = 0.f;
#pragma unroll
                  for (int s4 = 0; s4 < 4; ++s4) {
                      const bf16x8 a = *(const LAS bf16x8*)(AL + (it * 32 + lr) * 144 + (s4 * 16 + 8 * lh) * 2);
                      const bf16x8 bb = *(const LAS bf16x8*)(VTL + (vt * 32 + lr) * 144 + (s4 * 16 + 8 * lh) * 2);
                      acc = __builtin_amdgcn_mfma_f32_32x32x16_bf16(a, bb, acc, 0, 0, 0); }
#pragma unroll
                  for (int s8 = 0; s8 < 8; ++s8) {
                      const bf16x8 a = *(const LAS bf16x8*)(QSL + (it * 32 + lr) * 272 + (s8 * 16 + 8 * lh) * 2);
                      const bf16x8 bb = *(const LAS bf16x8*)(SPL + (vt * 32 + lr) * 272 + (s8 * 16 + 8 * lh) * 2);
                      acc = __builtin_amdgcn_mfma_f32_32x32x16_bf16(a, bb, acc, 0, 0, 0); }
#pragma unroll
                  for (int r = 0; r < 16; ++r) { float q2 = acc[r] * acc[r];
                      q2 = xsum16(rowsum16(q2));
                      if (lr == 0) SSQ[vt * 64 + it * 32 + 8 * (r >> 2) + 4 * lh + (r & 3)] = q2; }
                  __syncthreads();
                  const int colg = col0 + vt * 32 + lr; const float gg = g_hg[l * 1024 + colg];
#pragma unroll
                  for (int r = 0; r < 16; ++r) { const int ii = it * 32 + 8 * (r >> 2) + 4 * lh + (r & 3);
                      const float ss = SSQ[ii] + SSQ[64 + ii] + SSQ[128 + ii] + SSQ[192 + ii]; const float rn = 1.0f / sqrtf(ss * (1.f / 128.f) + 1e-6f);
                      YAB[(row0 + ii) * 2048 + colg] = (bf16)(pk2(acc[r] * rn * gg * gav[r], 0.f) & 0xffffu); }
                }
                __syncthreads();
            }
        }
#undef HC_REQ
        PHASE_END
        PHASE_BEGIN
        for (int ub = blk * NWAVES; ub < 2048; ub += NGW) {
            const int unit = ub + wave;
            const int b = ub >> 9, j = unit & 511, lr = lane & 31, lh = lane >> 5;
            const int qsel = (lr >> 2) & 1, head = (lr >> 3) * 4 + (lr & 3);
            const int qlo = 4 * j, qhi = 4 * (1023 - j);
            const int nlo = ((qlo >> 6) + 1) * 64, nhi = ((qhi >> 6) + 1) * 64;
            const int nlo8 = (nlo + 511) & ~511, nhi8 = (nhi + 511) & ~511;
            const int nmax8 = (((((4 * (1023 - (ub & 511))) >> 6) + 1) * 64) + 511) & ~511;
            bf16x8 A[4][4]; float W[4][16];
#pragma unroll
            for (int p = 0; p < 4; ++p) { const size_t qb = (size_t)b * SEQ + (p < 2 ? qlo + 2 * p : qhi + 2 * (p - 2));
#pragma unroll
                for (int ks = 0; ks < 4; ++ks) A[p][ks] = *(const bf16x8*)(QIDX + (qb + qsel) * 1024 + head * 64 + ks * 16 + lh * 8);
#pragma unroll
                for (int r4 = 0; r4 < 4; ++r4) { const f32x4 w = *(const f32x4*)(IDXW + (qb + lh) * 16 + r4 * 4); W[p][r4 * 4] = w[0]; W[p][r4 * 4 + 1] = w[1]; W[p][r4 * 4 + 2] = w[2]; W[p][r4 * 4 + 3] = w[3]; } }
            const bf16* kb = KIDX + (size_t)b * SEQ * 64;
            v4u stg[4];
#pragma unroll
            for (int i = 0; i < 4; ++i) { const int pc = tid + 512 * i; stg[i] = *(const v4u*)(kb + (size_t)(pc >> 3) * 64 + (pc & 7) * 8); }
#pragma unroll
            for (int i = 0; i < 4; ++i) { const int pc = tid + 512 * i; *(LAS v4u*)(lds + (pc >> 3) * 144 + (pc & 7) * 16) = stg[i]; }
            __syncthreads();
            for (int c0 = 0; c0 < nmax8; c0 += 256) {
                const int cb = (c0 >> 8) & 1; const bool more = c0 + 256 < nmax8;
                if (more) {
#pragma unroll
                    for (int i = 0; i < 4; ++i) { const int pc = tid + 512 * i; stg[i] = *(const v4u*)(kb + (size_t)(c0 + 256 + (pc >> 3)) * 64 + (pc & 7) * 8); } }
                LAS unsigned char* kbuf = lds + cb * 36864;
#pragma unroll 1
                for (int tl = 0; tl < 8; ++tl) {
                    const int s0 = c0 + tl * 32;
                    if (s0 >= nhi8) break;
#pragma unroll
                    for (int p = 0; p < 4; ++p) { const int np = p < 2 ? nlo : nhi, np8 = p < 2 ? nlo8 : nhi8;
                        if (s0 >= np && s0 < np8) { const size_t q = (size_t)b * SEQ + (p < 2 ? qlo + 2 * p : qhi + 2 * (p - 2)) + lh; ISC[q * 4096 + s0 + lr] = -1.0e30f; } }
                    if (s0 >= nhi) continue;
                    bf16x8 B[4];
#pragma unroll
                    for (int ks = 0; ks < 4; ++ks) B[ks] = *(const LAS bf16x8*)(kbuf + (tl * 32 + lr) * 144 + ks * 32 + lh * 16);
#define IDX_FINISH(P_, ACC_) do { float sc_ = 0.f; _Pragma("unroll") for (int r = 0; r < 16; ++r) sc_ += W[P_][r] * fmaxf(ACC_[r], 0.f); \
                        const size_t q_ = (size_t)b * SEQ + ((P_) < 2 ? qlo + 2 * (P_) : qhi + 2 * ((P_) - 2)) + lh; ISC[q_ * 4096 + s0 + lr] = sc_; } while (0)
                    if (s0 < nlo) {
                        f32x16 c0_, c1_, c2_, c3_;
#pragma unroll
                        for (int r = 0; r < 16; ++r) { c0_[r] = 0.f; c1_[r] = 0.f; c2_[r] = 0.f; c3_[r] = 0.f; }
#pragma unroll
                        for (int ks = 0; ks < 4; ++ks) { c0_ = __builtin_amdgcn_mfma_f32_32x32x16_bf16(A[0][ks], B[ks], c0_, 0, 0, 0); c1_ = __builtin_amdgcn_mfma_f32_32x32x16_bf16(A[1][ks], B[ks], c1_, 0, 0, 0);
                            c2_ = __builtin_amdgcn_mfma_f32_32x32x16_bf16(A[2][ks], B[ks], c2_, 0, 0, 0); c3_ = __builtin_amdgcn_mfma_f32_32x32x16_bf16(A[3][ks], B[ks], c3_, 0, 0, 0); }
                        IDX_FINISH(0, c0_); IDX_FINISH(1, c1_); IDX_FINISH(2, c2_); IDX_FINISH(3, c3_);
                    } else {
                        f32x16 c2_, c3_;
#pragma unroll
                        for (int r = 0; r < 16; ++r) { c2_[r] = 0.f; c3_[r] = 0.f; }
#pragma unroll
                        for (int ks = 0; ks < 4; ++ks) { c2_ = __builtin_amdgcn_mfma_f32_32x32x16_bf16(A[2][ks], B[ks], c2_, 0, 0, 0); c3_ = __builtin_amdgcn_mfma_f32_32x32x16_bf16(A[3][ks], B[ks], c3_, 0, 0, 0); }
                        IDX_FINISH(2, c2_); IDX_FINISH(3, c3_);
                    }
#undef IDX_FINISH
                }
                if (more) {
#pragma unroll
                    for (int i = 0; i < 4; ++i) { const int pc = tid + 512 * i; *(LAS v4u*)(lds + (cb ^ 1) * 36864 + (pc >> 3) * 144 + (pc & 7) * 16) = stg[i]; } }
                __syncthreads();
            }
        }
        PHASE_END
        GRID_BAR();
        }
        for (int rep_ = 0; rep_ < REP_P5; ++rep_) {
        PHASE_BEGIN
        {
            LAS unsigned char* VB = lds + wave * 18432;
            LAS unsigned short* SELW = (LAS unsigned short*)(VB + 17408);
            const int hd = lane & 15, g = lane >> 4, qq = hd >> 2, pp = hd & 3;
            const float slope = exp2f(-0.5f * (float)(hd + 1));
            for (int q = gw; q < M; q += NGW) {
                const int b = q / SEQ, pos = q % SEQ, qc = pos >> 6; const int nsel = qc < 4 ? (qc + 1) * 64 : 256;
                for (int rtk_ = 0; rtk_ < REP_TOPK; ++rtk_) {
                int lane_t = lane; asm volatile("" : "+v"(lane_t));
                if (qc < 4) { const unsigned e0 = 4 * lane_t; const bool ok = 4 * lane_t < nsel; v2u z; z.x = ok ? (e0 | ((e0 + 1) << 16)) : 0u; z.y = ok ? ((e0 + 2) | ((e0 + 3) << 16)) : 0u; *(LAS v2u*)(SELW + 4 * lane_t) = z; }
                else {
                    LAS unsigned* HIST = (LAS unsigned*)VB;
                    const int nb8 = (qc + 8) >> 3;
                    float v[64];
#pragma unroll
                    for (int g8 = 0; g8 < 8; ++g8) {
                        if (g8 < nb8) {
#pragma unroll
                            for (int j = 0; j < 8; ++j) v[g8 * 8 + j] = ISC[(size_t)q * 4096 + (g8 * 8 + j) * 64 + lane_t];
                        } else {
#pragma unroll
                            for (int j = 0; j < 8; ++j) v[g8 * 8 + j] = -1.0e30f; } }
                    float vmx = v[0], vmn = fminf(fminf(fminf(v[0], v[1]), fminf(v[2], v[3])), v[4]);
#pragma unroll
                    for (int i = 1; i < 64; ++i) vmx = fmaxf(vmx, v[i]);
                    vmx = wmax_f(vmx); vmn = -wmax_f(-vmn);
                    const float rng = vmx - vmn; const float s20 = rng > 0.f ? 1048574.0f / rng : 0.f;
#define ZERO_HIST() do { *(LAS v4u*)(HIST + 16 * lane) = (v4u){0u, 0u, 0u, 0u}; *(LAS v4u*)(HIST + 16 * lane + 4) = (v4u){0u, 0u, 0u, 0u}; *(LAS v4u*)(HIST + 16 * lane + 8) = (v4u){0u, 0u, 0u, 0u}; \
                        *(LAS v4u*)(HIST + 16 * lane + 12) = (v4u){0u, 0u, 0u, 0u}; HIST[1024 + lane] = 0u; } while (0)
#define SCAN_HIST(R_, BIN_, AB_) do { unsigned hh_[16]; const int hb_ = 1008 - 16 * lane; \
                        { const v4u h0 = *(const LAS v4u*)(HIST + hb_), h1 = *(const LAS v4u*)(HIST + hb_ + 4), h2 = *(const LAS v4u*)(HIST + hb_ + 8), h3 = *(const LAS v4u*)(HIST + hb_ + 12); \
                          hh_[0] = h0.x; hh_[1] = h0.y; hh_[2] = h0.z; hh_[3] = h0.w; hh_[4] = h1.x; hh_[5] = h1.y; hh_[6] = h1.z; hh_[7] = h1.w; hh_[8] = h2.x; hh_[9] = h2.y; hh_[10] = h2.z; hh_[11] = h2.w; hh_[12] = h3.x; hh_[13] = h3.y; hh_[14] = h3.z; hh_[15] = h3.w; } \
                        unsigned tot_ = 0u; _Pragma("unroll") for (int k = 0; k < 16; ++k) tot_ += hh_[k]; \
                        unsigned run_ = wprefix_u(tot_) - tot_; int fb_ = -1; unsigned fa_ = 0u; \
                        _Pragma("unroll") for (int k = 15; k >= 0; --k) { if (run_ < (R_) && run_ + hh_[k] >= (R_)) { fb_ = hb_ + k; fa_ = run_; } run_ += hh_[k]; } \
                        const unsigned long long bm_ = __ballot(fb_ >= 0); const int L_ = (int)__builtin_ctzll(bm_); \
                        BIN_ = (unsigned)__builtin_amdgcn_readlane(fb_, L_); AB_ = (unsigned)__builtin_amdgcn_readlane((int)fa_, L_); } while (0)
                    ZERO_HIST();
#pragma unroll
                    for (int i = 0; i < 64; ++i) v[i] = __builtin_bit_cast(float, (unsigned)((v[i] - vmn) * s20));
#define cd(i_) __builtin_bit_cast(unsigned, v[i_])
#pragma unroll
                    for (int g8 = 0; g8 < 8; ++g8) { if (g8 < nb8) {
#pragma unroll
                        for (int j = 0; j < 8; ++j) __hip_atomic_fetch_add(HIST + (cd(g8 * 8 + j) >> 10), 1u, __ATOMIC_RELAXED, __HIP_MEMORY_SCOPE_WORKGROUP); } }
                    LDS_WAIT(); asm volatile("" ::: "memory");
                    unsigned tb, above; SCAN_HIST(256u, tb, above);
                    ZERO_HIST();
                    LDS_WAIT(); asm volatile("" ::: "memory");
#pragma unroll
                    for (int g8 = 0; g8 < 8; ++g8) { if (g8 < nb8) {
#pragma unroll
                        for (int j = 0; j < 8; ++j) { const unsigned c = cd(g8 * 8 + j); const unsigned a = (c >> 10) == tb ? (c & 1023u) : 1024u + lane; __hip_atomic_fetch_add(HIST + a, 1u, __ATOMIC_RELAXED, __HIP_MEMORY_SCOPE_WORKGROUP); } } }
                    LDS_WAIT(); asm volatile("" ::: "memory");
                    unsigned tb2, ab2; { const unsigned R2 = 256u - above; SCAN_HIST(R2, tb2, ab2); }
                    const unsigned T = (tb << 10) | tb2; above += ab2;
                    unsigned baseg = 0u, basee = above;
#pragma unroll
                    for (int g8 = 0; g8 < 8; ++g8) { if (g8 < nb8) {
#pragma unroll
                        for (int j = 0; j < 8; ++j) { const int i = g8 * 8 + j;
                            const bool gt = cd(i) > T; const unsigned long long bg = __ballot(gt);
                            const unsigned pgp = baseg + __builtin_amdgcn_mbcnt_hi((unsigned)(bg >> 32), __builtin_amdgcn_mbcnt_lo((unsigned)bg, 0u));
                            if (gt) SELW[pgp] = (unsigned short)(i * 64 + lane);
                            baseg += (unsigned)__popcll(bg);
                            const bool eq = cd(i) == T; const unsigned long long be = __ballot(eq);
                            if (be) { const unsigned pep = basee + __builtin_amdgcn_mbcnt_hi((unsigned)(be >> 32), __builtin_amdgcn_mbcnt_lo((unsigned)be, 0u));
                                if (eq && pep < 256u) SELW[pep] = (unsigned short)(i * 64 + lane);
                                basee += (unsigned)__popcll(be); } } } }
#undef cd
#undef ZERO_HIST
#undef SCAN_HIST
                }
                LDS_WAIT(); asm volatile("" ::: "memory");
                }
                for (int rat_ = 0; rat_ < REP_ATT; ++rat_) {
                bf16* qrow = QB + (size_t)q * 4096;
                bf16x8 Bq[8];
#pragma unroll
                for (int ks = 0; ks < 8; ++ks) Bq[ks] = *(const bf16x8*)(qrow + hd * 256 + ks * 32 + g * 8);
                const bf16* kvb = CKV + (size_t)b * SEQ * 256;
                f32x4 O[16];
#pragma unroll
                for (int ct = 0; ct < 16; ++ct) O[ct] = (f32x4){0.f, 0.f, 0.f, 0.f};
                float mrun = -1.0e30f, lsum = 0.f;
                LDS_WAIT(); asm volatile("" ::: "memory");
                const int nks = nsel >> 5;
                const int lrow = lane >> 5, lcp = lane & 31;
                v4u KR[16];
#define ATT_LOADROWS(KST_) do { _Pragma("unroll") for (int i = 0; i < 16; ++i) { const int rr_ = 2 * i + lrow; const int ix_ = SELW[32 * (KST_) + rr_]; \
                    KR[i] = *(const v4u*)(kvb + (size_t)ix_ * 256 + ((lcp ^ (rr_ & 7)) * 8)); } } while (0)
                ATT_LOADROWS(0);
                const int rlA = hd & 7;
                const int rlT = (4 * g + qq) & 7;
                const int trb = (4 * g + qq) * 512 + 8 * (pp & 1), trm = 16 * ((pp >> 1) ^ rlT);
                for (int kst = 0; kst < nks; ++kst) {
                    int rlA_ = rlA, trm_ = trm; asm volatile("" : "+v"(rlA_), "+v"(trm_));
                    if (kst + 1 < nks) {
#pragma unroll
                        for (int i = 0; i < 16; ++i) { *(LAS v4u*)(VB + i * 1024 + lane * 16) = KR[i];
                            const int rr_ = 2 * i + lrow; const int ix_ = SELW[32 * (kst + 1) + rr_]; KR[i] = *(const v4u*)(kvb + (size_t)ix_ * 256 + ((lcp ^ (rr_ & 7)) * 8)); }
                    } else {
#pragma unroll
                        for (int i = 0; i < 16; ++i) *(LAS v4u*)(VB + i * 1024 + lane * 16) = KR[i]; }
                    LDS_WAIT(); asm volatile("" ::: "memory");
                    f32x4 S0 = {0.f, 0.f, 0.f, 0.f}, S1 = {0.f, 0.f, 0.f, 0.f};
#pragma unroll
                    for (int k4 = 0; k4 < 4; ++k4) {
                        bf16x8 a0[2], a1[2];
#pragma unroll
                        for (int j = 0; j < 2; ++j) { const int ks = k4 * 2 + j; const int cpos = (4 * ks + g) ^ rlA_;
                            a0[j] = *(const LAS bf16x8*)(VB + hd * 512 + cpos * 16); a1[j] = *(const LAS bf16x8*)(VB + (16 + hd) * 512 + cpos * 16); }
#pragma unroll
                        for (int j = 0; j < 2; ++j) { const int ks = k4 * 2 + j;
                            S0 = __builtin_amdgcn_mfma_f32_16x16x32_bf16(a0[j], Bq[ks], S0, 0, 0, 0); S1 = __builtin_amdgcn_mfma_f32_16x16x32_bf16(a1[j], Bq[ks], S1, 0, 0, 0); }
                    }
                    const v2u pa = *(const LAS v2u*)(SELW + 32 * kst + 4 * g), pb = *(const LAS v2u*)(SELW + 32 * kst + 16 + 4 * g);
                    const float fp = (float)pos;
                    float s0[4], s1[4];
                    s0[0] = S0[0] - slope * fabsf(fp - (float)(pa.x & 0xffffu)); s0[1] = S0[1] - slope * fabsf(fp - (float)(pa.x >> 16));
                    s0[2] = S0[2] - slope * fabsf(fp - (float)(pa.y & 0xffffu)); s0[3] = S0[3] - slope * fabsf(fp - (float)(pa.y >> 16));
                    s1[0] = S1[0] - slope * fabsf(fp - (float)(pb.x & 0xffffu)); s1[1] = S1[1] - slope * fabsf(fp - (float)(pb.x >> 16));
                    s1[2] = S1[2] - slope * fabsf(fp - (float)(pb.y & 0xffffu)); s1[3] = S1[3] - slope * fabsf(fp - (float)(pb.y >> 16));
                    float ml = fmaxf(fmaxf(fmaxf(s0[0], s0[1]), fmaxf(s0[2], s0[3])), fmaxf(fmaxf(s1[0], s1[1]), fmaxf(s1[2], s1[3])));
                    ml = xmax16(ml); ml = xmax32(ml);
                    const float mnew = fmaxf(mrun, ml), alpha = __expf(mrun - mnew); mrun = mnew;
                    float p0[4], p1[4];
#pragma unroll
                    for (int r = 0; r < 4; ++r) { p0[r] = __expf(s0[r] - mnew); p1[r] = __expf(s1[r] - mnew); }
                    lsum = lsum * alpha + ((p0[0] + p0[1]) + (p0[2] + p0[3])) + ((p1[0] + p1[1]) + (p1[2] + p1[3]));
                    v4u pw; pw.x = pk2(p0[0], p0[1]); pw.y = pk2(p0[2], p0[3]); pw.z = pk2(p1[0], p1[1]); pw.w = pk2(p1[2], p1[3]);
                    const bf16x8 Pf = __builtin_bit_cast(bf16x8, pw);
#pragma unroll
                    for (int ct = 0; ct < 16; ++ct) O[ct] = O[ct] * alpha;
#pragma unroll
                    for (int c8 = 0; c8 < 4; ++c8) {
                        v4s lo[4], hi[4];
#pragma unroll
                        for (int j = 0; j < 4; ++j) { const int ct = c8 * 4 + j; const int off = trb + ((32 * ct) ^ trm_);
                            lo[j] = __builtin_amdgcn_ds_read_tr16_b64_v4i16((LAS v4s*)(VB + off));
                            hi[j] = __builtin_amdgcn_ds_read_tr16_b64_v4i16((LAS v4s*)(VB + 16 * 512 + off)); }
#pragma unroll
                        for (int j = 0; j < 4; ++j) { const int ct = c8 * 4 + j;
                            const bf16x8 Af = {lo[j][0], lo[j][1], lo[j][2], lo[j][3], hi[j][0], hi[j][1], hi[j][2], hi[j][3]};
                            O[ct] = __builtin_amdgcn_mfma_f32_16x16x32_bf16(Af, Pf, O[ct], 0, 0, 0); }
                    }
                    LDS_WAIT(); asm volatile("" ::: "memory");
                }
#undef ATT_LOADROWS
                lsum = xsum16(lsum); lsum = xsum32(lsum);
                const float inv = 1.0f / lsum;
#pragma unroll
                for (int ct = 0; ct < 16; ++ct) { const f32x4 o = O[ct] * inv; v2u w; w.x = pk2(o[0], o[1]); w.y = pk2(o[2], o[3]); *(v2u*)(OB + (size_t)q * 4096 + hd * 256 + 16 * ct + 4 * g) = w; }
                }
            }
        }
        PHASE_END
        GRID_BAR();
        }
        PHASE_BEGIN
        { pg8::Gemm g{OB, W6, M, 1024, 1024, 4096, 1024, 1024}; pg8::StaticOrder S; S.init(M, 1024, G, blk);
          EpiBf E{YAB, 2048, 1024}; pg8::gemm_phase(lds, g, S, E, tid); }
        PHASE_END
        GRID_BAR();
        PHASE_BEGIN
        { pg8::Gemm g{YAB, W7, M, DM, DM, DM, DM, 0}; pg8::StaticOrder S; S.init(M, DM, G, blk);
          EpiGateM E{GTB, MRG}; HookGate Hk{GTA, GTB}; pg8::gemm_phase(lds, g, S, E, tid, Hk); }
        PHASE_END
        GRID_BAR();
        PHASE_BEGIN
        { pg8::Gemm g{MRG, W8, M, DM, DM, DM, DM, 0}; pg8::StaticOrder S; S.init(M, DM, G, blk);
          EpiRes E{(l == 0) ? x_in : (const float*)nullptr, XB, RB, modl + 2 * DM}; pg8::gemm_phase(lds, g, S, E, tid); }
        PHASE_END
        GRID_BAR();
        for (int rep_ = 0; rep_ < REP_P9; ++rep_) {
        PHASE_BEGIN
        f32x4 lg[8], lb_[8]; v2u nx[8];
#pragma unroll
        for (int j = 0; j < 8; ++j) { const int c = j * 256 + lane * 4; lg[j] = *(const f32x4*)(ln1_g + l * DM + c); lb_[j] = *(const f32x4*)(ln1_b + l * DM + c); nx[j] = *(const v2u*)(RB + (size_t)gw * DM + c); }
        for (int row = gw; row < M; row += NGW) {
            const int b = row / SEQ; const float* md = modl + (size_t)b * MODW;
            f32x4 v[8]; float s = 0.f;
#pragma unroll
            for (int j = 0; j < 8; ++j) { v[j] = (f32x4){bflo(nx[j].x), bfhi(nx[j].x), bflo(nx[j].y), bfhi(nx[j].y)}; s += (v[j][0] + v[j][1]) + (v[j][2] + v[j][3]); }
            { const int rn = row + NGW < M ? row + NGW : row;
#pragma unroll
              for (int j = 0; j < 8; ++j) nx[j] = *(const v2u*)(RB + (size_t)rn * DM + j * 256 + lane * 4); }
            const float mean = wave_sum(s) * (1.f / DM); float s2 = 0.f;
#pragma unroll
            for (int j = 0; j < 8; ++j) { v[j] = v[j] - mean; s2 += (v[j][0] * v[j][0] + v[j][1] * v[j][1]) + (v[j][2] * v[j][2] + v[j][3] * v[j][3]); }
            const float rstd = 1.0f / sqrtf(wave_sum(s2) * (1.f / DM) + 1e-5f);
#pragma unroll
            for (int j = 0; j < 8; ++j) { const int c = j * 256 + lane * 4; const f32x4 gg = lg[j], bb = lb_[j];
                const f32x4 y = v[j] * rstd * gg + bb; { v2u wx; wx.x = pk2(y[0], y[1]); wx.y = pk2(y[2], y[3]); *(v2u*)(XB + (size_t)row * DM + c) = wx; }
                const f32x4 sc = *(const f32x4*)(md + 4 * DM + c), sh = *(const f32x4*)(md + 3 * DM + c); const f32x4 hh = y * (sc + 1.f) + sh;
                v2u w; w.x = pk2(hh[0], hh[1]); w.y = pk2(hh[2], hh[3]); *(v2u*)(HB + (size_t)row * DM + c) = w; }
        }
        PHASE_END
        GRID_BAR();
        }
        PHASE_BEGIN
        { pg8::Gemm g{HB, W10, M, N10, DM, DM, DM, 0}; pg8::StaticOrder S; S.init(M, N10, G, blk);
          EpiSwiglu E{ACT}; pg8::gemm_phase(lds, g, S, E, tid); }
        PHASE_END
        GRID_BAR();
        PHASE_BEGIN
        { pg8::Gemm g{ACT, W11, M, DM, DFF, DFF, DFF, 0}; pg8::StaticOrder S; S.init(M, DM, G, blk);
          EpiRes E{(const float*)nullptr, XB, RB, modl + 5 * DM}; pg8::gemm_phase(lds, g, S, E, tid); }
        PHASE_END
        GRID_BAR();
        for (int rep_ = 0; rep_ < REP_P12; ++rep_) {
        PHASE_BEGIN
        {
            const bool lastl = (l == DEPTH - 1); const float* mdn = MOD + (size_t)(l + 1 < DEPTH ? l + 1 : l) * NBATCH * MODW;
            f32x4 lg[8], lb_[8]; v2u nx[8];
#pragma unroll
            for (int j = 0; j < 8; ++j) { const int c = j * 256 + lane * 4; lg[j] = *(const f32x4*)(ln2_g + l * DM + c); lb_[j] = *(const f32x4*)(ln2_b + l * DM + c); nx[j] = *(const v2u*)(RB + (size_t)gw * DM + c); }
            for (int row = gw; row < M; row += NGW) {
                const int b = row / SEQ; const float* md = mdn + (size_t)b * MODW;
                f32x4 v[8]; float s = 0.f;
#pragma unroll
                for (int j = 0; j < 8; ++j) { v[j] = (f32x4){bflo(nx[j].x), bfhi(nx[j].x), bflo(nx[j].y), bfhi(nx[j].y)}; s += (v[j][0] + v[j][1]) + (v[j][2] + v[j][3]); }
                { const int rn = row + NGW < M ? row + NGW : row;
#pragma unroll
                  for (int j = 0; j < 8; ++j) nx[j] = *(const v2u*)(RB + (size_t)rn * DM + j * 256 + lane * 4); }
                const float mean = wave_sum(s) * (1.f / DM); float s2 = 0.f;
#pragma unroll
                for (int j = 0; j < 8; ++j) { v[j] = v[j] - mean; s2 += (v[j][0] * v[j][0] + v[j][1] * v[j][1]) + (v[j][2] * v[j][2] + v[j][3] * v[j][3]); }
                const float rstd = 1.0f / sqrtf(wave_sum(s2) * (1.f / DM) + 1e-5f);
#pragma unroll
                for (int j = 0; j < 8; ++j) { const int c = j * 256 + lane * 4; const f32x4 gg = lg[j], bb = lb_[j];
                    const f32x4 y = v[j] * rstd * gg + bb; if (lastl) *(f32x4*)(args.out + (size_t)row * DM + c) = y; else { v2u wx; wx.x = pk2(y[0], y[1]); wx.y = pk2(y[2], y[3]); *(v2u*)(XB + (size_t)row * DM + c) = wx; }
                    const f32x4 sc = *(const f32x4*)(md + DM + c), sh = *(const f32x4*)(md + c); const f32x4 hh = y * (sc + 1.f) + sh;
                    v2u w; w.x = pk2(hh[0], hh[1]); w.y = pk2(hh[2], hh[3]); *(v2u*)(HB + (size_t)row * DM + c) = w; }
            }
            if (l + 1 < DEPTH) { __syncthreads(); CONVERT_LAYER(l + 1); }
        }
        PHASE_END
        if (l + 1 < DEPTH || rep_ + 1 < REP_P12) GRID_BAR();
        }
    }
}

extern "C" void kernel_launch(void* const* d_in, const int* in_sizes, int n_in, void* d_out, int out_size, void* d_ws, size_t ws_size, hipStream_t stream) {
    static int grid = 0;
    if (grid == 0) {
        if (n_in != 22 || out_size != M * DM || ws_size < WS_END) { fprintf(stderr, "kernel_launch: unexpected shapes (n_in %d, out %d, ws %zu < %zu)\n", n_in, out_size, ws_size, (size_t)WS_END); grid = -1; return; }
        int dev = 0, cus = 0, per_cu = 0;
        if (hipGetDevice(&dev) != hipSuccess || hipDeviceGetAttribute(&cus, hipDeviceAttributeMultiprocessorCount, dev) != hipSuccess) { grid = -1; return; }
        if (hipFuncSetAttribute((const void*)fwd_kernel, hipFuncAttributeMaxDynamicSharedMemorySize, LDS_BYTES) != hipSuccess) { fprintf(stderr, "kernel_launch: hipFuncSetAttribute failed\n"); grid = -1; return; }
        if (hipOccupancyMaxActiveBlocksPerMultiprocessor(&per_cu, (const void*)fwd_kernel, NTHR, LDS_BYTES) != hipSuccess || per_cu < 1) { fprintf(stderr, "kernel_launch: occupancy query says %d\n", per_cu); }
        (void)hipGetLastError();
        grid = cus;
    }
    if (grid < 0) return;
    if (hipMemsetAsync((char*)d_ws + WS_CTL, 0, CTL_ZERO_BYTES, stream) != hipSuccess) return;
    Args a{};
    for (int i = 0; i < 22; ++i) a.in[i] = (const float*)d_in[i];
    a.out = (float*)d_out; a.ws = (unsigned char*)d_ws;
    hipLaunchKernelGGL(fwd_kernel, dim3(grid), dim3(NTHR), LDS_BYTES, stream, a);
}
```

```cpp
#include <hip/hip_runtime.h>
#include <cstdio>
#include <cstdint>

namespace pg8 {
#define PG8_LAS __attribute__((address_space(3)))
typedef unsigned short bf16_t;
typedef short bf16x8 __attribute__((ext_vector_type(8)));
typedef float f32x4 __attribute__((ext_vector_type(4)));
typedef unsigned u32x4 __attribute__((ext_vector_type(4)));
constexpr int BM = 256, BK = 64, HALF = 128, HTB = HALF * BK * 2, STAGE_BYTES = 8 * HTB, NXCD = 8, WGM = 8;

__host__ __device__ __forceinline__ int lds_byte(int r, int c) { const int st = (r >> 4) * 2 + (c >> 5), rr = r & 15, cc = c & 31, ob = rr * 64 + cc * 2; return st * 1024 + (ob ^ (((ob >> 9) & 1) << 5)); }
__host__ __device__ __forceinline__ void stage_rc(int b, int& R, int& C) { const int st = b / 1024, sb = b % 1024, swz = sb ^ (((sb >> 9) & 1) << 5); R = (st >> 1) * 16 + swz / 64; C = (st & 1) * 32 + (swz % 64) / 2; }
__host__ __device__ __forceinline__ int perm32(int rho) { const int n = rho >> 4, i = rho & 15; return 8 * (i >> 2) + 4 * n + (i & 3); }

struct Unit { int pm, pn; };
struct Gemm { const bf16_t* A; const bf16_t* Bt; int M, N, K, lda, ldb, a_pn_stride; };

struct StaticOrder {
    int nM, nN, nwg, G, c;
    __host__ __device__ void init(int M, int N, int G_, int c_) { nM = M / BM; nN = N / BM; nwg = nM * nN; G = G_; c = c_; }
    __host__ __device__ bool next(int i, Unit& u) const {
        const long L = (long)i * G + c; if (L >= nwg) return false;
        int wgid = (int)L; { const int q = nwg / NXCD, r = nwg % NXCD, xcd = wgid % NXCD, off = wgid / NXCD; wgid = (xcd < r ? xcd * (q + 1) : r * (q + 1) + (xcd - r) * q) + off; }
        const int nig = WGM * nN, gid = wgid / nig, fm = gid * WGM, gsz = (nM - fm) < WGM ? (nM - fm) : WGM;
        u.pm = fm + ((wgid % nig) % gsz); u.pn = (wgid % nig) / gsz; return true;
    }
};

typedef float f32x2_t __attribute__((ext_vector_type(2))); typedef __bf16 bf16x2_t __attribute__((ext_vector_type(2)));
__device__ __forceinline__ unsigned cvt_pk_bf16(float lo, float hi) { f32x2_t v = {lo, hi}; bf16x2_t b = __builtin_convertvector(v, bf16x2_t); return __builtin_bit_cast(unsigned, b); }

struct NoHook { static constexpr bool ON = false; template <class A> __device__ __forceinline__ void mid(A&, const Unit&, int, int, int, int) const {} };
template <class Epi, class Hook = NoHook>
__device__ __forceinline__ void gemm_phase(PG8_LAS unsigned char* lds, const Gemm g, const StaticOrder& S, const Epi& E, const int tid, const Hook H = Hook()) {
    const int wid = __builtin_amdgcn_readfirstlane(tid >> 6), lane = tid & 63, wr = wid >> 2, wc = wid & 3, fr = lane & 15, fq = lane >> 4;
    const int K = g.K, nt = K / BK;
    unsigned voffA[2], voffB[2];
#pragma unroll
    for (int i = 0; i < 2; ++i) { int R, C; stage_rc(tid * 16 + i * 8192, R, C); const int Rb = 64 * (R >> 5) + perm32(R & 31);
        voffA[i] = (unsigned)(R * g.lda + C) * 2u; voffB[i] = (unsigned)(Rb * g.ldb + C) * 2u; }
    const size_t kstep = (size_t)(BK * 2);
    const size_t hstepA = (size_t)HALF * g.lda * 2, hstepB = (size_t)32 * g.ldb * 2;
    const size_t tstepA = 2 * hstepA, tstepB = (size_t)BM * g.ldb * 2;
    const unsigned ldsw = (unsigned)wid * 1024u;
    const int aoff = lds_byte(wr * 64 + fr, fq * 8), boff = lds_byte(wc * 32 + fr, fq * 8);
#define PG8_SA(b, h) (((b) * 2 + (h)) * HTB)
#define PG8_SB(b, h) ((4 + (b) * 2 + (h)) * HTB)
#define PG8_STAGE(bufoff, gbase, voff) do { _Pragma("unroll") for (int _i = 0; _i < 2; ++_i) \
        __builtin_amdgcn_global_load_lds((const unsigned*)((const char*)(gbase) + (voff)[_i]), (PG8_LAS unsigned*)(lds + (bufoff) + ldsw + _i * 8192), 16, 0, 0); } while (0)
#define PG8_LDA(dst, b, h) do { _Pragma("unroll") for (int m = 0; m < 4; ++m) _Pragma("unroll") for (int k = 0; k < 2; ++k) dst[m][k] = *(const PG8_LAS bf16x8*)(lds + PG8_SA(b, h) + aoff + m * 2048 + k * 1024); } while (0)
#define PG8_LDB(dst, b, h) do { _Pragma("unroll") for (int n = 0; n < 2; ++n) _Pragma("unroll") for (int k = 0; k < 2; ++k) dst[n][k] = *(const PG8_LAS bf16x8*)(lds + PG8_SB(b, h) + boff + n * 2048 + k * 1024); } while (0)
#define PG8_MMA(ai, bj, At, Bt) do { __builtin_amdgcn_s_setprio(1); _Pragma("unroll") for (int m = 0; m < 4; ++m) _Pragma("unroll") for (int n = 0; n < 2; ++n) _Pragma("unroll") for (int k = 0; k < 2; ++k) \
        acc[ai][bj][m][n] = __builtin_amdgcn_mfma_f32_16x16x32_bf16(Bt[n][k], At[m][k], acc[ai][bj][m][n], 0, 0, 0); __builtin_amdgcn_s_setprio(0); } while (0)
#define PG8_WAIT_V(n) asm volatile("s_waitcnt vmcnt(" #n ")" ::: "memory")
#define PG8_WAIT_L(n) asm volatile("s_waitcnt lgkmcnt(" #n ")" ::: "memory")
#define PG8_BAR __builtin_amdgcn_s_barrier()
#define PG8_SCHED __builtin_amdgcn_sched_barrier(0)
    Unit cur, nxt; int ui = 0;
    if (!S.next(0, cur)) return;
    f32x4 acc[2][2][4][2];
#pragma unroll
    for (int a = 0; a < 2; ++a)
#pragma unroll
        for (int b = 0; b < 2; ++b)
#pragma unroll
            for (int m = 0; m < 4; ++m)
#pragma unroll
                for (int n = 0; n < 2; ++n) acc[a][b][m][n] = (f32x4){0.f, 0.f, 0.f, 0.f};
    bf16x8 At[4][2], B0[2][2], B1[2][2];
    const char* cA = (const char*)g.A + (size_t)cur.pm * tstepA + (size_t)cur.pn * g.a_pn_stride * 2; const char* cB = (const char*)g.Bt + (size_t)cur.pn * tstepB;
    PG8_STAGE(PG8_SB(0, 0), cB, voffB); PG8_STAGE(PG8_SB(0, 1), cB + hstepB, voffB); PG8_STAGE(PG8_SA(0, 0), cA, voffA); PG8_STAGE(PG8_SA(0, 1), cA + hstepA, voffA);
    if (wr == 1) PG8_BAR;
    PG8_WAIT_V(2); PG8_BAR;
    PG8_STAGE(PG8_SB(1, 0), cB + kstep, voffB); PG8_STAGE(PG8_SA(1, 0), cA + kstep, voffA); PG8_STAGE(PG8_SB(1, 1), cB + hstepB + kstep, voffB);
    PG8_WAIT_V(6); PG8_BAR;
    for (;;) {
        const bool has_next = S.next(ui + 1, nxt);
        const char* nA = has_next ? (const char*)g.A + (size_t)nxt.pm * tstepA + (size_t)nxt.pn * g.a_pn_stride * 2 : cA; const char* nB = has_next ? (const char*)g.Bt + (size_t)nxt.pn * tstepB : cB;
        for (int t = 0; t < nt; t += 2) {
            const bool last = (t == nt - 2);
            const char* a1 = cA + (size_t)(t + 1) * kstep;
            const char* a2 = last ? nA : cA + (size_t)(t + 2) * kstep; const char* b2 = last ? nB : cB + (size_t)(t + 2) * kstep;
            const char* a3 = a2 + kstep; const char* b3 = b2 + kstep;
            if constexpr (Hook::ON) { if (t == (nt >> 1)) H.mid(acc, cur, wr, wc, fr, fq); }
            PG8_LDB(B0, 0, 0); PG8_LDB(B1, 0, 1); PG8_SCHED; PG8_LDA(At, 0, 0); PG8_STAGE(PG8_SA(1, 1), a1 + hstepA, voffA);
            PG8_WAIT_V(8); PG8_WAIT_L(0); PG8_BAR; PG8_MMA(0, 0, At, B0); PG8_MMA(0, 1, At, B1); PG8_BAR; PG8_SCHED;
            PG8_LDA(At, 0, 1); PG8_STAGE(PG8_SB(0, 0), b2, voffB); PG8_STAGE(PG8_SB(0, 1), b2 + hstepB, voffB); PG8_STAGE(PG8_SA(0, 0), a2, voffA);
            PG8_WAIT_V(8); PG8_WAIT_L(0); PG8_BAR; PG8_MMA(1, 0, At, B0); PG8_MMA(1, 1, At, B1); PG8_BAR; PG8_SCHED;
            PG8_LDB(B0, 1, 0); PG8_LDB(B1, 1, 1); PG8_SCHED; PG8_LDA(At, 1, 0); PG8_STAGE(PG8_SA(0, 1), a2 + hstepA, voffA);
            PG8_WAIT_V(8); PG8_WAIT_L(0); PG8_BAR; PG8_MMA(0, 0, At, B0); PG8_MMA(0, 1, At, B1); PG8_BAR; PG8_SCHED;
            PG8_LDA(At, 1, 1); PG8_STAGE(PG8_SB(1, 0), b3, voffB); PG8_STAGE(PG8_SB(1, 1), b3 + hstepB, voffB); PG8_STAGE(PG8_SA(1, 0), a3, voffA);
            PG8_WAIT_V(8); PG8_WAIT_L(0); PG8_BAR; PG8_MMA(1, 0, At, B0); PG8_MMA(1, 1, At, B1); PG8_BAR; PG8_SCHED;
        }
        if (wr == 0) PG8_BAR;
        E(acc, cur, wr, wc, fr, fq);
        if (!has_next) break;
#pragma unroll
        for (int a = 0; a < 2; ++a)
#pragma unroll
            for (int b = 0; b < 2; ++b)
#pragma unroll
                for (int m = 0; m < 4; ++m)
#pragma unroll
                    for (int n = 0; n < 2; ++n) acc[a][b][m][n] = (f32x4){0.f, 0.f, 0.f, 0.f};
        cur = nxt; cA = nA; cB = nB; ++ui;
        if (wr == 1) PG8_BAR;
    }
    PG8_WAIT_V(0);
    PG8_BAR;
#undef PG8_SA
#undef PG8_SB
#undef PG8_STAGE
#undef PG8_LDA
#undef PG8_LDB
#undef PG8_MMA
#undef PG8_WAIT_V
#undef PG8_WAIT_L
#undef PG8_BAR
#undef PG8_SCHED
}
}

constexpr int NWAVES = 8, NTHR = NWAVES * 64;
constexpr int DM = 2048, NBATCH = 4, SEQ = 4096, DEPTH = 4, M = NBATCH * SEQ;
constexpr int HGW = 1024;
constexpr int SAH = 16, SAC = 256, SAR = 512;
constexpr int DFF = 5632;
constexpr int N1 = 9216, N3 = 5120, N10 = 2 * DFF;
constexpr float ALPHA = 1.6817928305074292f;
constexpr int MODW = 6 * DM;

constexpr size_t MiB = 1u << 20;
constexpr size_t WS_CTL = 0, CTL_ZERO_BYTES = 32768;
constexpr size_t WS_MOD = 1 * MiB;
constexpr size_t WS_LB = 2 * MiB;
constexpr size_t WS_MODP = 3 * MiB;
constexpr size_t WS_W1 = 9 * MiB;
constexpr size_t WS_W3 = WS_W1 + 36 * MiB;
constexpr size_t WS_W6 = WS_W3 + 5 * MiB;
constexpr size_t WS_W7 = WS_W6 + 2 * MiB;
constexpr size_t WS_W8 = WS_W7 + 8 * MiB;
constexpr size_t WS_W10 = WS_W8 + 8 * MiB;
constexpr size_t WS_W11 = WS_W10 + 44 * MiB;
constexpr size_t WS_X = WS_W11 + 22 * MiB;
constexpr size_t WS_R = WS_X + 128 * MiB;
constexpr size_t WS_H = WS_R + 128 * MiB;
constexpr size_t WS_QA = WS_H + 64 * MiB;
constexpr size_t WS_FA = WS_QA + 32 * MiB;
constexpr size_t WS_IA = WS_FA + 64 * MiB;
constexpr size_t WS_GA = WS_IA + 32 * MiB;
constexpr size_t WS_LAT = WS_GA + 32 * MiB;
constexpr size_t WS_GTA = WS_LAT + 64 * MiB;
constexpr size_t WS_GTB = WS_GTA + 64 * MiB;
constexpr size_t WS_CQN = WS_GTB + 64 * MiB;
constexpr size_t WS_CKV = WS_CQN + 16 * MiB;
constexpr size_t WS_KIDX = WS_CKV + 8 * MiB;
constexpr size_t WS_IDXW = WS_KIDX + 2 * MiB;
constexpr size_t WS_QB = WS_IDXW + 1 * MiB;
constexpr size_t WS_QIDX = WS_QB + 128 * MiB;
constexpr size_t WS_SEL = WS_QIDX + 32 * MiB;
constexpr size_t WS_YAB = WS_SEL + 8 * MiB;
constexpr size_t WS_MRG = WS_FA;
constexpr size_t WS_OB = WS_YAB + 64 * MiB;
constexpr size_t WS_BIG = WS_OB + 128 * MiB;
constexpr size_t WS_KSB = WS_BIG + 256 * MiB;
constexpr size_t WS_DEB = WS_KSB + 32 * MiB;
constexpr size_t WS_QSB = WS_DEB + 2 * MiB;
constexpr size_t WS_END = WS_QSB + 32 * MiB;

constexpr int CW_BAR = 4096;

constexpr int RING_BYTES = 131072;
constexpr int LDS_BYTES = 163840;
constexpr int LDSCTL_OFF = LDS_BYTES - 1024, MISC_OFF = LDSCTL_OFF + 320, SELL_OFF = 147456;

#define GAS __attribute__((address_space(1)))
#define LAS __attribute__((address_space(3)))
typedef unsigned short bf16;
typedef unsigned v4u __attribute__((ext_vector_type(4)));
typedef unsigned v2u __attribute__((ext_vector_type(2)));
typedef float f32x4 __attribute__((ext_vector_type(4)));
typedef float f32x16 __attribute__((ext_vector_type(16)));
typedef short bf16x8 __attribute__((ext_vector_type(8)));
typedef short v4s __attribute__((ext_vector_type(4)));
typedef GAS unsigned gu32;
#define LDS_WAIT() asm volatile("s_waitcnt lgkmcnt(0)" ::: "memory")
__device__ __forceinline__ unsigned f2bf(float f) { unsigned u = __builtin_bit_cast(unsigned, f); return (u + 0x7fffu + ((u >> 16) & 1u)) >> 16; }
__device__ __forceinline__ unsigned pk2(float lo, float hi) { return pg8::cvt_pk_bf16(lo, hi); }
__device__ __forceinline__ float bf2f(unsigned short b) { return __builtin_bit_cast(float, ((unsigned)b) << 16); }
__device__ __forceinline__ float bflo(unsigned w) { return __builtin_bit_cast(float, w << 16); }
__device__ __forceinline__ float bfhi(unsigned w) { return __builtin_bit_cast(float, w & 0xffff0000u); }
__device__ __forceinline__ float sigm(float x) { return __builtin_amdgcn_rcpf(1.f + __expf(-x)); }

__device__ __forceinline__ int lane_id() { unsigned m = ~0u; asm volatile("" : "+s"(m)); return (int)__builtin_amdgcn_mbcnt_hi(m, __builtin_amdgcn_mbcnt_lo(m, 0u)); }
#define XB_TMO      128
#define XB_XCNT(j)  (256  + 64 * (j))
#define XB_XSUB(j)  (1280 + 64 * (j))
#define XB_XGEN(j)  (2304 + 64 * (j))
#define XB_TOP      3328
#define XB_TOPGEN   3392
#define XCD_BAR_WORDS 3456
#define XB_SPIN_CAP (1u << 22)

__device__ __forceinline__ unsigned xb_ld(unsigned* p)              { return __hip_atomic_load(p, __ATOMIC_RELAXED, __HIP_MEMORY_SCOPE_AGENT); }
__device__ __forceinline__ unsigned xb_add(unsigned* p, unsigned v) { return __hip_atomic_fetch_add(p, v, __ATOMIC_RELAXED, __HIP_MEMORY_SCOPE_AGENT); }
__device__ __forceinline__ unsigned xb_xcc_id() { return (unsigned)__builtin_amdgcn_s_getreg((3 << 11) | 20) & 0xFu; }
#define XB_SPIN(cond, bar) do { unsigned _sp = 0; while (cond) { __builtin_amdgcn_s_sleep(1); \
    if ((++_sp & 255u) == 0u) { if (xb_ld(&(bar)[XB_TMO])) break; if (_sp > XB_SPIN_CAP) { atomicAdd(&(bar)[XB_TMO], 1u); break; } } } } while (0)

struct XcdBarrier { unsigned* bar; unsigned x; volatile LAS unsigned* st; int wave; };

__device__ __forceinline__ XcdBarrier xcd_barrier_post(unsigned* bar, volatile LAS unsigned* st) {
    XcdBarrier b; b.bar = bar; b.x = (unsigned)__builtin_amdgcn_readfirstlane((int)xb_xcc_id()); b.st = st;
    if (threadIdx.x == 0) (void)xb_add(&bar[XB_XCNT(b.x)], 1u);
    return b;
}
__device__ __forceinline__ void xcd_barrier_complete(unsigned* bar, unsigned x, unsigned& nloc, unsigned& nx) {
    const unsigned G = gridDim.x * gridDim.y * gridDim.z;
    unsigned sum, cnt, mine, sp = 0u;
    for (;;) {
        sum = 0u; cnt = 0u; mine = 0u;
#pragma unroll 1
        for (unsigned j = 0; j < 16; ++j) { const unsigned c = xb_ld(&bar[XB_XCNT(j)]); sum += c; cnt += (c > 0u) ? 1u : 0u; mine = (j == x) ? c : mine; }
        if (sum == G) break;
        __builtin_amdgcn_s_sleep(1);
        if ((++sp & 255u) == 0u) { if (xb_ld(&bar[XB_TMO])) break; if (sp > XB_SPIN_CAP) { atomicAdd(&bar[XB_TMO], 1u); break; } }
    }
    nloc = mine > 0u ? mine : 1u; nx = cnt > 0u ? cnt : 1u;
}
__device__ __forceinline__ void xcd_barrier(const XcdBarrier& b) {
    asm volatile("s_waitcnt vmcnt(0)" ::: "memory");
    __syncthreads();
    if (b.wave == 0 && lane_id() == 0) {
        unsigned* bar = b.bar;
        unsigned bx = b.x; asm volatile("" : "+s"(bx));
        __builtin_amdgcn_s_waitcnt(0);
        unsigned nloc = b.st[0], nx = b.st[1];
        const unsigned old = xb_add(&bar[XB_XSUB(bx)], 1u);
        const unsigned gen = old / nloc;
        if (old + 1u == (gen + 1u) * nloc) {
            __builtin_amdgcn_fence(__ATOMIC_RELEASE, "agent");
            asm volatile("s_waitcnt vmcnt(0)" ::: "memory");
            const unsigned og = xb_add(&bar[XB_TOP], 1u);
            const unsigned tg = og / nx;
            if (og + 1u == (tg + 1u) * nx) xb_add(&bar[XB_TOPGEN], 1u);
            else XB_SPIN(xb_ld(&bar[XB_TOPGEN]) == tg, bar);
            __builtin_amdgcn_fence(__ATOMIC_ACQUIRE, "agent");
            xb_add(&bar[XB_XGEN(bx)], 1u);
            asm volatile("s_waitcnt vmcnt(0)" ::: "memory");
        } else {
            XB_SPIN(xb_ld(&bar[XB_XGEN(bx)]) == gen, bar);
            __builtin_amdgcn_fence(__ATOMIC_ACQUIRE, "agent");
            asm volatile("s_waitcnt vmcnt(0)" ::: "memory");
        }
    }
    __syncthreads();
}

__device__ __forceinline__ void xswap16(float& a, float& b) { asm volatile("s_nop 1\n\tv_permlane16_swap_b32 %0, %1\n\ts_nop 1" : "+v"(a), "+v"(b)); }
__device__ __forceinline__ void xswap32(float& a, float& b) { asm volatile("s_nop 1\n\tv_permlane32_swap_b32 %0, %1\n\ts_nop 1" : "+v"(a), "+v"(b)); }
__device__ __forceinline__ float xmax16(float x) { float a = x, b = x; xswap16(a, b); return fmaxf(a, b); }
__device__ __forceinline__ float xmax32(float x) { float a = x, b = x; xswap32(a, b); return fmaxf(a, b); }
__device__ __forceinline__ float xsum16(float x) { float a = x, b = x; xswap16(a, b); return a + b; }
__device__ __forceinline__ float xsum32(float x) { float a = x, b = x; xswap32(a, b); return a + b; }

#define DPPF(x, ctrl) __builtin_bit_cast(float, __builtin_amdgcn_update_dpp(0, __builtin_bit_cast(int, (x)), (ctrl), 0xf, 0xf, true))
__device__ __forceinline__ float wmax_f(float x) {
    x = fmaxf(x, DPPF(x, 0xB1)); x = fmaxf(x, DPPF(x, 0x4E)); x = fmaxf(x, DPPF(x, 0x124)); x = fmaxf(x, DPPF(x, 0x128));
    x = xmax16(x); return xmax32(x);
}
__device__ __forceinline__ unsigned wprefix_u(unsigned x) {
    int v = (int)x;
    v += __builtin_amdgcn_update_dpp(0, v, 0x111, 0xf, 0xf, false);
    v += __builtin_amdgcn_update_dpp(0, v, 0x112, 0xf, 0xf, false);
    v += __builtin_amdgcn_update_dpp(0, v, 0x114, 0xf, 0xf, false);
    v += __builtin_amdgcn_update_dpp(0, v, 0x118, 0xf, 0xf, false);
    v += __builtin_amdgcn_update_dpp(0, v, 0x142, 0xa, 0xf, false);
    v += __builtin_amdgcn_update_dpp(0, v, 0x143, 0xc, 0xf, false);
    return (unsigned)v;
}

__device__ __forceinline__ float rowsum16(float x) { x += DPPF(x, 0xB1); x += DPPF(x, 0x4E); x += DPPF(x, 0x124); x += DPPF(x, 0x128); return x; }
__device__ __forceinline__ float wave_sum(float x) { x = rowsum16(x); x = xsum16(x); return xsum32(x); }
__device__ __forceinline__ float wave_max(float x) { return wmax_f(x); }
__device__ __forceinline__ int wave_sum_i(int v) { float f = wave_sum((float)v); return (int)(f + 0.5f); }
template <class Src>
__device__ __forceinline__ void cvt_load(const Src& src, int k0, int n0, int lane, float (&tv)[32]) {
#pragma unroll
    for (int i = 0; i < 32; ++i) tv[i] = src(k0 + 2 * i + (lane >> 5), n0 + (lane & 31));
}
__device__ __forceinline__ void cvt_store(const float (&tv)[32], bf16* WT, int K, int k0, int n0, LAS float* scr, int lane) {
#pragma unroll
    for (int i = 0; i < 32; ++i) scr[(2 * i + (lane >> 5)) * 33 + (lane & 31)] = tv[i];
    LDS_WAIT(); asm volatile("" ::: "memory");
    const int c = lane & 7;
#pragma unroll
    for (int j = 0; j < 4; ++j) { const int n = (lane >> 3) + 8 * j; const LAS float* s = scr + (8 * c) * 33 + n;
        v4u o; o.x = pk2(s[0 * 33], s[1 * 33]); o.y = pk2(s[2 * 33], s[3 * 33]); o.z = pk2(s[4 * 33], s[5 * 33]); o.w = pk2(s[6 * 33], s[7 * 33]);
        *(GAS v4u*)(WT + (size_t)(n0 + n) * K + k0 + 8 * c) = o; }
    LDS_WAIT(); asm volatile("" ::: "memory");
}

struct Args { const float* in[22]; float* out; unsigned char* ws; };

using pg8::Unit; using pg8::cvt_pk_bf16;
__device__ __forceinline__ void st_bf16x8(bf16* p, f32x4 v0, f32x4 v1) {
    v4u w; w.x = cvt_pk_bf16(v0[0], v0[1]); w.y = cvt_pk_bf16(v0[2], v0[3]); w.z = cvt_pk_bf16(v1[0], v1[1]); w.w = cvt_pk_bf16(v1[2], v1[3]);
    *(v4u*)p = w;
}
__device__ __forceinline__ void st_f32x8(float* p, f32x4 v0, f32x4 v1) { *(f32x4*)p = v0; *(f32x4*)(p + 4) = v1; }
__device__ __forceinline__ f32x4 sigm4(f32x4 v) { return (f32x4){sigm(v[0]), sigm(v[1]), sigm(v[2]), sigm(v[3])}; }
__device__ __forceinline__ f32x4 silu4(f32x4 v) { return (f32x4){v[0] * sigm(v[0]), v[1] * sigm(v[1]), v[2] * sigm(v[2]), v[3] * sigm(v[3])}; }
__device__ __forceinline__ f32x4 ldbf4(const bf16* p) { const v2u w = *(const v2u*)p; return (f32x4){bflo(w.x), bfhi(w.x), bflo(w.y), bfhi(w.y)}; }

#define EPI_LOOP(...) \
    _Pragma("unroll") for (int ai = 0; ai < 2; ++ai) _Pragma("unroll") for (int m = 0; m < 4; ++m) { const int row = row0 + ai * 128 + m * 16; \
        _Pragma("unroll") for (int bj = 0; bj < 2; ++bj) { const int col = colb + bj * 32; const f32x4 v0 = acc[ai][bj][m][0], v1 = acc[ai][bj][m][1]; __VA_ARGS__ } }

struct EpiProj {
    bf16* QA; bf16* FA; bf16* IA; bf16* GA; bf16* LAT; bf16* GTA; bf16* GTB;
    __device__ __forceinline__ void operator()(const f32x4 (&acc)[2][2][4][2], const Unit& u, int wr, int wc, int fr, int fq) const {
        const int row0 = u.pm * 256 + wr * 64 + fr, pn = u.pn; const int colb = (pn & 3) * 256 + wc * 64 + 8 * fq;
        if (pn < 4)       { EPI_LOOP( st_bf16x8(QA + (size_t)row * 1024 + col, v0, v1); ) }
        else if (pn < 8)  { EPI_LOOP( st_bf16x8(FA + (size_t)row * 1024 + col, v0, v1); ) }
        else if (pn < 12) { EPI_LOOP( st_bf16x8(IA + (size_t)row * 1024 + col, v0, v1); ) }
        else if (pn < 16) { EPI_LOOP( st_bf16x8(GA + (size_t)row * 1024 + col, silu4(v0), silu4(v1)); ) }
        else if (pn < 20) { EPI_LOOP( st_bf16x8(LAT + (size_t)row * 1024 + col, v0, v1); ) }
        else { bf16* G = pn < 28 ? GTA : GTB; const int cb2 = ((pn - 20) & 7) * 256 + wc * 64 + 8 * fq;
            _Pragma("unroll") for (int ai = 0; ai < 2; ++ai) _Pragma("unroll") for (int m = 0; m < 4; ++m) { const int row = row0 + ai * 128 + m * 16;
                _Pragma("unroll") for (int bj = 0; bj < 2; ++bj) st_bf16x8(G + (size_t)row * 2048 + cb2 + bj * 32, sigm4(acc[ai][bj][m][0]), sigm4(acc[ai][bj][m][1])); } }
    }
};
struct EpiQ {
    bf16* QB; bf16* QIDX;
    __device__ __forceinline__ void operator()(const f32x4 (&acc)[2][2][4][2], const Unit& u, int wr, int wc, int fr, int fq) const {
        const int row0 = u.pm * 256 + wr * 64 + fr, pn = u.pn;
        if (pn < 16) { const int colb = pn * 256 + wc * 64 + 8 * fq; EPI_LOOP( st_bf16x8(QB + (size_t)row * 4096 + col, v0, v1); ) }
        else { const int colb = (pn - 16) * 256 + wc * 64 + 8 * fq; EPI_LOOP( st_bf16x8(QIDX + (size_t)row * 1024 + col, v0, v1); ) }
    }
};
struct EpiBf {
    bf16* O; int ldc; int coff;
    __device__ __forceinline__ void operator()(const f32x4 (&acc)[2][2][4][2], const Unit& u, int wr, int wc, int fr, int fq) const {
        const int row0 = u.pm * 256 + wr * 64 + fr; const int colb = coff + u.pn * 256 + wc * 64 + 8 * fq;
        EPI_LOOP( st_bf16x8(O + (size_t)row * ldc + col, v0, v1); )
    }
};
struct HookGate {
    static constexpr bool ON = true; const bf16* GA_; const bf16* GB_;
    __device__ __forceinline__ void mid(f32x4 (&acc)[2][2][4][2], const Unit& u, int wr, int wc, int fr, int fq) const {
        asm volatile("" : "+v"(fr), "+v"(fq));
        const int row0 = u.pm * 256 + wr * 64 + fr; const int colb = u.pn * 256 + wc * 64 + 8 * fq;
#pragma unroll
        for (int ai = 0; ai < 2; ++ai)
#pragma unroll
            for (int m = 0; m < 4; ++m) { const int row = row0 + ai * 128 + m * 16;
#pragma unroll
                for (int bj = 0; bj < 2; ++bj) { const size_t o = (size_t)row * 2048 + colb + bj * 32;
                    const f32x4 a0 = ldbf4(GA_ + o), a1 = ldbf4(GA_ + o + 4), b0 = ldbf4(GB_ + o), b1 = ldbf4(GB_ + o + 4);
                    f32x4 r0, r1;
#pragma unroll
                    for (int j = 0; j < 4; ++j) { r0[j] = a0[j] * __builtin_amdgcn_rcpf(b0[j]); r1[j] = a1[j] * __builtin_amdgcn_rcpf(b1[j]); }
                    acc[ai][bj][m][0] = acc[ai][bj][m][0] * r0; acc[ai][bj][m][1] = acc[ai][bj][m][1] * r1; }
                asm volatile("" : "+v"(acc[ai][0][m][0]), "+v"(acc[ai][0][m][1]), "+v"(acc[ai][1][m][0]), "+v"(acc[ai][1][m][1]));
                if (m & 1) asm volatile("" ::: "memory"); }
    }
};
struct EpiGateM {
    const bf16* GB_; bf16* MRG_;
    __device__ __forceinline__ void operator()(const f32x4 (&acc)[2][2][4][2], const Unit& u, int wr, int wc, int fr, int fq) const {
        const int row0 = u.pm * 256 + wr * 64 + fr; const int colb = u.pn * 256 + wc * 64 + 8 * fq;
        EPI_LOOP( const size_t o = (size_t)row * 2048 + col; const f32x4 g0 = ldbf4(GB_ + o), g1 = ldbf4(GB_ + o + 4); st_bf16x8(MRG_ + o, v0 * g0, v1 * g1); )
    }
};
struct EpiGateA {
    float* T1; const bf16* GT;
    __device__ __forceinline__ void operator()(const f32x4 (&acc)[2][2][4][2], const Unit& u, int wr, int wc, int fr, int fq) const {
        const int row0 = u.pm * 256 + wr * 64 + fr; const int colb = u.pn * 256 + wc * 64 + 8 * fq;
        EPI_LOOP( const size_t o = (size_t)row * 2048 + col; const f32x4 g0 = ldbf4(GT + o), g1 = ldbf4(GT + o + 4); st_f32x8(T1 + o, v0 * g0, v1 * g1); )
    }
};
struct EpiGateB {
    const float* T1; const bf16* GT; bf16* MRG;
    __device__ __forceinline__ void operator()(const f32x4 (&acc)[2][2][4][2], const Unit& u, int wr, int wc, int fr, int fq) const {
        const int row0 = u.pm * 256 + wr * 64 + fr; const int colb = u.pn * 256 + wc * 64 + 8 * fq;
        EPI_LOOP( const size_t o = (size_t)row * 2048 + col; const f32x4 g0 = ldbf4(GT + o), g1 = ldbf4(GT + o + 4); const f32x4 t0 = *(const f32x4*)(T1 + o), t1 = *(const f32x4*)(T1 + o + 4);
                  st_bf16x8(MRG + o, t0 + v0 * g0, t1 + v1 * g1); )
    }
};
struct EpiRes {
    const float* X; const bf16* Xh; bf16* R; const float* gt;
    __device__ __forceinline__ void operator()(const f32x4 (&acc)[2][2][4][2], const Unit& u, int wr, int wc, int fr, int fq) const {
        const int row0 = u.pm * 256 + wr * 64 + fr; const int colb = u.pn * 256 + wc * 64 + 8 * fq; const float* g = gt + (size_t)(u.pm >> 4) * MODW;
        if (X) { EPI_LOOP( const size_t o = (size_t)row * 2048 + col; const f32x4 x0 = *(const f32x4*)(X + o), x1 = *(const f32x4*)(X + o + 4); const f32x4 g0 = *(const f32x4*)(g + col), g1 = *(const f32x4*)(g + col + 4);
                  st_bf16x8(R + o, x0 * ALPHA + (g0 + 1.f) * v0, x1 * ALPHA + (g1 + 1.f) * v1); ) }
        else { EPI_LOOP( const size_t o = (size_t)row * 2048 + col; const f32x4 x0 = ldbf4(Xh + o), x1 = ldbf4(Xh + o + 4); const f32x4 g0 = *(const f32x4*)(g + col), g1 = *(const f32x4*)(g + col + 4);
                  st_bf16x8(R + o, x0 * ALPHA + (g0 + 1.f) * v0, x1 * ALPHA + (g1 + 1.f) * v1); ) }
    }
};
struct EpiSwiglu {
    bf16* ACT;
    __device__ __forceinline__ void operator()(const f32x4 (&acc)[2][2][4][2], const Unit& u, int wr, int wc, int fr, int fq) const {
        const int row0 = u.pm * 256 + wr * 64 + fr; const int col = u.pn * 128 + wc * 32 + 8 * fq;
#pragma unroll
        for (int ai = 0; ai < 2; ++ai)
#pragma unroll
            for (int m = 0; m < 4; ++m) { const int row = row0 + ai * 128 + m * 16;
                st_bf16x8(ACT + (size_t)row * DFF + col, silu4(acc[ai][0][m][0]) * acc[ai][1][m][0], silu4(acc[ai][0][m][1]) * acc[ai][1][m][1]); }
    }
};

__global__ void __launch_bounds__(NTHR, 2) fwd_kernel(Args args) {
    extern __shared__ __attribute__((aligned(16))) unsigned char lds_raw[];
    LAS unsigned char* lds = (LAS unsigned char*)lds_raw;
    const int G = gridDim.x, blk = blockIdx.x;
    const int NGW = G * NWAVES, NT = G * NTHR;
    unsigned char* const ws_base = args.ws;
    gu32* ctl = (gu32*)(ws_base + WS_CTL);
    for (int u = threadIdx.x; u < (LDS_BYTES - LDSCTL_OFF) / 4; u += NTHR) ((LAS unsigned*)(lds + LDSCTL_OFF))[u] = 0u;
    __syncthreads();
    volatile LAS unsigned* MISC = (volatile LAS unsigned*)(lds + MISC_OFF);
    const int wave_s = __builtin_amdgcn_readfirstlane((int)(threadIdx.x >> 6));
    XcdBarrier bar = xcd_barrier_post((unsigned*)(ctl + CW_BAR), MISC + 8); bar.wave = wave_s;
    if (threadIdx.x == 0) { unsigned nloc_ = 0u, nx_ = 0u; xcd_barrier_complete(bar.bar, bar.x, nloc_, nx_); bar.st[0] = nloc_; bar.st[1] = nx_; }
    __syncthreads();
#define GRID_BAR() xcd_barrier(bar)

#define x_in ((const float*)(const GAS float*)args.in[0 + z_])
#define c_in ((const float*)(const GAS float*)args.in[1 + z_])
#define w_ada ((const float*)(const GAS float*)args.in[2 + z_])
#define b_ada ((const float*)(const GAS float*)args.in[3 + z_])
#define w_in ((const float*)(const GAS float*)args.in[4 + z_])
#define lb_logits ((const float*)(const GAS float*)args.in[5 + z_])
#define g_hg ((const float*)(const GAS float*)args.in[6 + z_])
#define w_pa ((const float*)(const GAS float*)args.in[7 + z_])
#define g_cq ((const float*)(const GAS float*)args.in[8 + z_])
#define g_ckv ((const float*)(const GAS float*)args.in[9 + z_])
#define w_uq ((const float*)(const GAS float*)args.in[10 + z_])
#define w_iq ((const float*)(const GAS float*)args.in[11 + z_])
#define w_uv ((const float*)(const GAS float*)args.in[12 + z_])
#define w_pb ((const float*)(const GAS float*)args.in[13 + z_])
#define w_out ((const float*)(const GAS float*)args.in[14 + z_])
#define ln1_g ((const float*)(const GAS float*)args.in[15 + z_])
#define ln1_b ((const float*)(const GAS float*)args.in[16 + z_])
#define w_gate ((const float*)(const GAS float*)args.in[17 + z_])
#define w_up ((const float*)(const GAS float*)args.in[18 + z_])
#define w_down ((const float*)(const GAS float*)args.in[19 + z_])
#define ln2_g ((const float*)(const GAS float*)args.in[20 + z_])
#define ln2_b ((const float*)(const GAS float*)args.in[21 + z_])
#define MOD  ((float*)(ws + WS_MOD))
#define LB   ((float*)(ws + WS_LB))
#define MODP ((float*)(ws + WS_MODP))
#define W1   ((bf16*)(ws + WS_W1))
#define W3   ((bf16*)(ws + WS_W3))
#define W6   ((bf16*)(ws + WS_W6))
#define W7   ((bf16*)(ws + WS_W7))
#define W8   ((bf16*)(ws + WS_W8))
#define W10  ((bf16*)(ws + WS_W10))
#define W11  ((bf16*)(ws + WS_W11))
#define XB   ((bf16*)(ws + WS_X))
#define RB   ((bf16*)(ws + WS_R))
#define HB   ((bf16*)(ws + WS_H))
#define QA   ((bf16*)(ws + WS_QA))
#define FA   ((bf16*)(ws + WS_FA))
#define IA   ((bf16*)(ws + WS_IA))
#define GA   ((bf16*)(ws + WS_GA))
#define LAT  ((bf16*)(ws + WS_LAT))
#define GTA  ((bf16*)(ws + WS_GTA))
#define GTB  ((bf16*)(ws + WS_GTB))
#define CQN  ((bf16*)(ws + WS_CQN))
#define CKV  ((bf16*)(ws + WS_CKV))
#define KIDX ((bf16*)(ws + WS_KIDX))
#define IDXW ((float*)(ws + WS_IDXW))
#define QB   ((bf16*)(ws + WS_QB))
#define QIDX ((bf16*)(ws + WS_QIDX))
#define SEL  ((unsigned short*)(ws + WS_SEL))
#define YAB  ((bf16*)(ws + WS_YAB))
#define MRG  ((bf16*)(ws + WS_MRG))
#define OB   ((bf16*)(ws + WS_OB))
#define ISC  ((_Float16*)(ws + WS_BIG))
#define OP   ((float*)(ws + WS_BIG))
#define ACT  ((bf16*)(ws + WS_BIG))
#define KK   LAT
#define modl (MOD + (size_t)l * NBATCH * MODW)
#define KSB  ((bf16*)(ws + WS_KSB))
#define QSB  ((bf16*)(ws + WS_QSB))
#define KVT  ((bf16*)(ws + WS_BIG))
#define SPB  ((bf16*)(ws + WS_FA))
#define DEB  ((float*)(ws + WS_DEB))
#define PHASE_BEGIN { unsigned om_ = ~0u; asm volatile("" : "+s"(om_)); int tid = wave_s * 64 + (int)__builtin_amdgcn_mbcnt_hi(om_, __builtin_amdgcn_mbcnt_lo(om_, 0u)); asm volatile("" : "+v"(tid)); int z_ = 0; asm volatile("" : "+s"(z_)); (void)z_; GAS unsigned char* wsg_ = (GAS unsigned char*)ws_base; asm volatile("" : "+s"(wsg_)); unsigned char* ws = (unsigned char*)wsg_; const int lane = tid & 63, wave = __builtin_amdgcn_readfirstlane(tid >> 6); \
        const int gw = blk * NWAVES + wave, gtid = blk * NTHR + tid; LAS float* wscr = (LAS float*)(lds + wave * 16384); (void)lane; (void)gw; (void)gtid; (void)wscr;
#define PHASE_END }

#define CVT_DECODE(IT_, MID_, K0_, N0_) do { int r_ = (IT_); \
        if (r_ < I1) { MID_ = 0; K0_ = (r_ / (N1 / 32)) * 64; N0_ = (r_ % (N1 / 32)) * 32; } else { r_ -= I1; \
        if (r_ < I3) { MID_ = 1; K0_ = (r_ / (N3 / 32)) * 64; N0_ = (r_ % (N3 / 32)) * 32; } else { r_ -= I3; \
        if (r_ < I6) { MID_ = 2; K0_ = (r_ / 32) * 64; N0_ = (r_ % 32) * 32; } else { r_ -= I6; \
        if (r_ < I7) { MID_ = 3; K0_ = (r_ / (DM / 32)) * 64; N0_ = (r_ % (DM / 32)) * 32; } else { r_ -= I7; \
        if (r_ < I8) { MID_ = 4; K0_ = (r_ / (DM / 32)) * 64; N0_ = (r_ % (DM / 32)) * 32; } else { r_ -= I8; \
        if (r_ < I10) { MID_ = 5; K0_ = (r_ / (N10 / 32)) * 64; N0_ = (r_ % (N10 / 32)) * 32; } else { r_ -= I10; \
        MID_ = 6; K0_ = (r_ / (DM / 32)) * 64; N0_ = (r_ % (DM / 32)) * 32; } } } } } } } while (0)
#define CVT_LOAD(MID_, K0_, N0_, TV_) do { \
        if (MID_ == 0) cvt_load([=](int k, int n) -> float { return n < 4944 ? s_in[(size_t)k * 9040 + n] : (n < 5120 ? 0.f : s_in[(size_t)k * 9040 + n - 176]); }, K0_, N0_, lane, TV_); \
        else if (MID_ == 1) cvt_load([=](int k, int n) -> float { return n < 4096 ? s_uq[(size_t)k * 4096 + n] * 0.0625f : s_iq[(size_t)k * 1024 + n - 4096]; }, K0_, N0_, lane, TV_); \
        else if (MID_ == 2) cvt_load([=](int k, int n) -> float { const int h = n >> 6, v = n & 63, kk = k >> 8, c = k & 255; return kk == (h & 3) ? s_uv[((size_t)h * 256 + c) * 64 + v] : 0.f; }, K0_, N0_, lane, TV_); \
        else if (MID_ == 3) cvt_load([=](int k, int n) -> float { return k < 1024 ? s_pa[(size_t)k * DM + n] : s_pb[(size_t)(k - 1024) * DM + n]; }, K0_, N0_, lane, TV_); \
        else if (MID_ == 4) cvt_load([=](int k, int n) -> float { return s_out[(size_t)k * DM + n]; }, K0_, N0_, lane, TV_); \
        else if (MID_ == 5) cvt_load([=](int k, int n) -> float { const int pn = n >> 8, rr = n & 255, cc = pn * 128 + (rr >> 6) * 32 + (rr & 31); return (rr & 32) ? s_u[(size_t)k * DFF + cc] : s_g[(size_t)k * DFF + cc]; }, K0_, N0_, lane, TV_); \
        else cvt_load([=](int k, int n) -> float { return s_d[(size_t)k * DM + n]; }, K0_, N0_, lane, TV_); } while (0)
#define CONVERT_LAYER(L) do { const int l_ = (L); \
        const float* s_in = w_in + (size_t)l_ * DM * 9040; const float* s_uq = w_uq + (size_t)l_ * SAR * 4096; const float* s_iq = w_iq + (size_t)l_ * SAR * 1024; \
        const float* s_uv = w_uv + (size_t)l_ * 16 * 256 * 64; const float* s_pa = w_pa + (size_t)l_ * 1024 * DM; const float* s_pb = w_pb + (size_t)l_ * 1024 * DM; \
        const float* s_out = w_out + (size_t)l_ * DM * DM; const float* s_g = w_gate + (size_t)l_ * DM * DFF; const float* s_u = w_up + (size_t)l_ * DM * DFF; const float* s_d = w_down + (size_t)l_ * DFF * DM; \
        constexpr int I1 = (DM / 64) * (N1 / 32), I3 = (SAR / 64) * (N3 / 32), I6 = (1024 / 64) * (1024 / 32), I7 = (DM / 64) * (DM / 32), I8 = I7, I10 = (DM / 64) * (N10 / 32), I11 = (DFF / 64) * (DM / 32); \
        constexpr int NIT = I1 + I3 + I6 + I7 + I8 + I10 + I11; \
        float tv_[32]; int mid_ = 0, k0_ = 0, n0_ = 0; \
        { CVT_DECODE(gw, mid_, k0_, n0_); CVT_LOAD(mid_, k0_, n0_, tv_); } \
        for (int it = gw; it < NIT; it += NGW) { \
            float tc_[32]; _Pragma("unroll") for (int i = 0; i < 32; ++i) tc_[i] = tv_[i]; \
            const int mc_ = mid_, kc_ = k0_, nc_ = n0_; \
            { const int itn_ = it + NGW < NIT ? it + NGW : it; CVT_DECODE(itn_, mid_, k0_, n0_); CVT_LOAD(mid_, k0_, n0_, tv_); }     \
            bf16* wt_ = mc_ == 0 ? W1 : mc_ == 1 ? W3 : mc_ == 2 ? W6 : mc_ == 3 ? W7 : mc_ == 4 ? W8 : mc_ == 5 ? W10 : W11; \
            const int kk_ = mc_ == 0 ? DM : mc_ == 1 ? SAR : mc_ == 2 ? 1024 : mc_ == 3 ? DM : mc_ == 4 ? DM : mc_ == 5 ? DM : DFF; \
            cvt_store(tc_, wt_, kk_, kc_, nc_, wscr, lane); \
        } } while (0)


#ifndef HGRN_NAIVE
#define HGRN_NAIVE 0
#endif
#ifndef IDX_NAIVE
#define IDX_NAIVE 0
#endif
#ifndef ATT_NAIVE
#define ATT_NAIVE 0
#endif
#ifndef TOPK_OLD
#define TOPK_OLD 0
#endif
#ifndef REP_HB
#define REP_HB 1
#endif
#ifndef REP_HC
#define REP_HC 1
#endif
#ifndef REP_P4A
#define REP_P4A 1
#endif
#ifndef REP_P5
#define REP_P5 1
#endif
#ifndef REP_P9
#define REP_P9 1
#endif
#ifndef REP_P12
#define REP_P12 1
#endif
#ifndef REP_TOPK
#define REP_TOPK 1
#endif
#ifndef REP_ATT
#define REP_ATT 1
#endif
#ifndef DRY_ATT
#define DRY_ATT 0
#endif
#ifndef REP_M1
#define REP_M1 1
#endif
#ifndef REP_M2
#define REP_M2 1
#endif
#ifndef REP_M3
#define REP_M3 1
#endif

    PHASE_BEGIN
    {
        LAS float* sc = (LAS float*)lds;
        for (int i = tid; i < NBATCH * DM; i += NTHR) { const float v = c_in[i]; sc[i] = v * sigm(v); }
        __syncthreads();
        for (int item = gtid; item < 8 * 12288; item += NT) {
            const int ks = item / 12288, cg = item % 12288, l = cg / 3072, n4 = (cg % 3072) * 4;
            const float* wp = w_ada + ((size_t)l * DM + ks * 256) * MODW + n4;
            f32x4 a0 = {0.f, 0.f, 0.f, 0.f}, a1 = a0, a2 = a0, a3 = a0;
#pragma unroll 8
            for (int k = 0; k < 256; ++k) { const f32x4 w = *(const f32x4*)(wp + (size_t)k * MODW); const int kk = ks * 256 + k;
                a0 += w * sc[kk]; a1 += w * sc[2048 + kk]; a2 += w * sc[4096 + kk]; a3 += w * sc[6144 + kk]; }
            float* o = MODP + ((size_t)(ks * 4 + l) * 4) * MODW + n4;
            *(f32x4*)(o) = a0; *(f32x4*)(o + MODW) = a1; *(f32x4*)(o + 2 * MODW) = a2; *(f32x4*)(o + 3 * MODW) = a3;
        }
        if (gtid < 1024) {
            const float a = lb_logits[gtid], b = lb_logits[1024 + gtid], c = lb_logits[2048 + gtid], d = lb_logits[3072 + gtid];
            const float mx = fmaxf(fmaxf(a, b), fmaxf(c, d)); const float ea = expf(a - mx), eb = expf(b - mx), ec = expf(c - mx), ed = expf(d - mx); const float inv = 1.f / (ea + eb + ec + ed);
            LB[gtid] = 0.f; LB[1024 + gtid] = eb * inv; LB[2048 + gtid] = (eb + ec) * inv; LB[3072 + gtid] = (eb + ec + ed) * inv;
        }
        __syncthreads();
        CONVERT_LAYER(0);
    }
    PHASE_END
    GRID_BAR();
    PHASE_BEGIN
    for (int i = gtid; i < DEPTH * NBATCH * MODW; i += NT) {
        const int l = i / (NBATCH * MODW), r = i % (NBATCH * MODW), b = r / MODW, n = r % MODW;
        float s = b_ada[l * MODW + n];
#pragma unroll
        for (int ks = 0; ks < 8; ++ks) s += MODP[((size_t)(ks * 4 + l) * 4 + b) * MODW + n];
        MOD[i] = s;
    }
    PHASE_END
    GRID_BAR();
    PHASE_BEGIN
    for (size_t i0 = gtid; i0 < (size_t)M * DM / 8; i0 += (size_t)NT * 4) {
        f32x4 xa[4], xb[4], sa[4], sb[4], ha[4], hb[4];
#pragma unroll
        for (int t = 0; t < 4; ++t) { size_t gi = i0 + (size_t)t * NT; gi = gi < (size_t)M * DM / 8 ? gi : (size_t)M * DM / 8 - 1; const size_t e = gi * 8; const int row = (int)(e / DM), col = (int)(e % DM), b = row / SEQ; const float* md = MOD + (size_t)b * MODW;
            xa[t] = *(const f32x4*)(x_in + e); xb[t] = *(const f32x4*)(x_in + e + 4); sa[t] = *(const f32x4*)(md + 2048 + col); sb[t] = *(const f32x4*)(md + 2048 + col + 4); ha[t] = *(const f32x4*)(md + col); hb[t] = *(const f32x4*)(md + col + 4); }
#pragma unroll
        for (int t = 0; t < 4; ++t) { size_t gi = i0 + (size_t)t * NT; gi = gi < (size_t)M * DM / 8 ? gi : (size_t)M * DM / 8 - 1; const size_t e = gi * 8; st_bf16x8(HB + e, xa[t] * (sa[t] + 1.f) + ha[t], xb[t] * (sb[t] + 1.f) + hb[t]); }
    }
    PHASE_END
    GRID_BAR();

    for (int l = 0; l < DEPTH; ++l) {
        PHASE_BEGIN
        { pg8::Gemm g{HB, W1, M, N1, DM, DM, DM, 0}; pg8::StaticOrder S; S.init(M, N1, G, blk);
          EpiProj E{QA, FA, IA, GA, LAT, GTA, GTB}; pg8::gemm_phase(lds, g, S, E, tid); }
        PHASE_END
        GRID_BAR();
        for (int rep_ = 0; rep_ < REP_M1; ++rep_) {
        PHASE_BEGIN
        v2u ra0, ra1, rkv; unsigned short rki, riw;
        { const bf16* lr = LAT + (size_t)gw * 1024; ra0 = *(const v2u*)(lr + 4 * lane); ra1 = *(const v2u*)(lr + 256 + 4 * lane); rkv = *(const v2u*)(lr + 512 + 4 * lane); rki = lr[768 + lane]; riw = lr[832 + (lane & 15)]; }
        for (int row = gw; row < M; row += NGW) {
            const f32x4 a0 = (f32x4){bflo(ra0.x), bfhi(ra0.x), bflo(ra0.y), bfhi(ra0.y)}, a1 = (f32x4){bflo(ra1.x), bfhi(ra1.x), bflo(ra1.y), bfhi(ra1.y)}, kv = (f32x4){bflo(rkv.x), bfhi(rkv.x), bflo(rkv.y), bfhi(rkv.y)};
            const float ki = bf2f(rki), iw = bf2f(riw);
            { const int rn = row + NGW < M ? row + NGW : row; const bf16* lr = LAT + (size_t)rn * 1024;
              ra0 = *(const v2u*)(lr + 4 * lane); ra1 = *(const v2u*)(lr + 256 + 4 * lane); rkv = *(const v2u*)(lr + 512 + 4 * lane); rki = lr[768 + lane]; riw = lr[832 + (lane & 15)]; }
            float sq = a0[0] * a0[0] + a0[1] * a0[1] + a0[2] * a0[2] + a0[3] * a0[3] + a1[0] * a1[0] + a1[1] * a1[1] + a1[2] * a1[2] + a1[3] * a1[3];
            float sk = kv[0] * kv[0] + kv[1] * kv[1] + kv[2] * kv[2] + kv[3] * kv[3];
            sq = wave_sum(sq); sk = wave_sum(sk);
            const float rq = 1.0f / sqrtf(sq * (1.f / 512.f) + 1e-6f), rk = 1.0f / sqrtf(sk * (1.f / 256.f) + 1e-6f);
            const f32x4 g0 = *(const f32x4*)(g_cq + l * 512 + 4 * lane), g1 = *(const f32x4*)(g_cq + l * 512 + 256 + 4 * lane), gk = *(const f32x4*)(g_ckv + l * 256 + 4 * lane);
            v2u o; f32x4 t = a0 * rq * g0; o.x = pk2(t[0], t[1]); o.y = pk2(t[2], t[3]); *(v2u*)(CQN + (size_t)row * 512 + 4 * lane) = o;
            t = a1 * rq * g1; o.x = pk2(t[0], t[1]); o.y = pk2(t[2], t[3]); *(v2u*)(CQN + (size_t)row * 512 + 256 + 4 * lane) = o;
            t = kv * rk * gk; o.x = pk2(t[0], t[1]); o.y = pk2(t[2], t[3]); *(v2u*)(CKV + (size_t)row * 256 + 4 * lane) = o;
            KIDX[(size_t)row * 64 + lane] = (bf16)f2bf(ki);
            if (lane < 16) IDXW[(size_t)row * 16 + lane] = iw * 0.03125f;
        }
        PHASE_END
        PHASE_BEGIN
        {
            const int cp = tid & 63, sg = tid >> 6;
            LAS unsigned char* KST = lds;
            LAS unsigned char* VTL = lds + 18432;
            LAS float* SEGT = (LAS float*)(lds + 36864);
            LAS float* G63 = (LAS float*)(lds + 40960);
            unsigned pfa[8], pq[8], pv[8];
#define HA_REQ(U_) do { int uu_ = (U_); asm volatile("" : "+s"(uu_)); const int bh_ = uu_ >> 6, c_ = uu_ & 63, b_ = bh_ >> 3, h_ = bh_ & 7; \
                const size_t rowb_ = (size_t)b_ * SEQ + c_ * 64 + sg * 8; const int col_ = h_ * 128 + 2 * cp; \
                _Pragma("unroll") for (int i = 0; i < 8; ++i) { pfa[i] = *(const unsigned*)(FA + (rowb_ + i) * 1024 + col_); pq[i] = *(const unsigned*)(QA + (rowb_ + i) * 1024 + col_); pv[i] = *(const unsigned*)(IA + (rowb_ + i) * 1024 + col_); } } while (0)
            HA_REQ(blk);
            for (int u = blk; u < 2048; u += G) {
                const int bh = u >> 6, c = u & 63, b = bh >> 3, h = bh & 7;
                const size_t rowb = (size_t)b * SEQ + c * 64 + sg * 8; const int col = h * 128 + 2 * cp;
                const float lb0 = LB[l * 1024 + col], lb1 = LB[l * 1024 + col + 1];
                float lf0[8], lf1[8], kk0[8], kk1[8]; unsigned cq[8], cv[8];
#pragma unroll
                for (int i = 0; i < 8; ++i) { cq[i] = pq[i]; cv[i] = pv[i]; }
#pragma unroll
                for (int i = 0; i < 8; ++i) { const float2 fa = make_float2(bflo(pfa[i]), bfhi(pfa[i]));
                    const float f0 = fminf(fmaxf(lb0 + (1.f - lb0) * sigm(fa.x), 1e-6f), 1.f), f1 = fminf(fmaxf(lb1 + (1.f - lb1) * sigm(fa.y), 1e-6f), 1.f);
                    lf0[i] = __logf(f0); lf1[i] = __logf(f1); kk0[i] = (1.f - lb0) * sigm(-fa.x); kk1[i] = (1.f - lb1) * sigm(-fa.y); }
#pragma unroll
                for (int i = 1; i < 8; ++i) { lf0[i] += lf0[i - 1]; lf1[i] += lf1[i - 1]; }
                SEGT[sg * 128 + 2 * cp] = lf0[7]; SEGT[sg * 128 + 2 * cp + 1] = lf1[7];
                HA_REQ(u + G < 2048 ? u + G : u);
                __syncthreads();
                float pre0 = 0.f, pre1 = 0.f, r0 = 0.f, r1 = 0.f, t0 = 0.f, t1 = 0.f;
#pragma unroll
                for (int s2 = 0; s2 < 8; ++s2) { const float a0 = SEGT[s2 * 128 + 2 * cp], a1 = SEGT[s2 * 128 + 2 * cp + 1];
                    if (s2 < sg) { pre0 += a0; pre1 += a1; } if (s2 < 4) { r0 += a0; r1 += a1; } t0 += a0; t1 += a1; }
                unsigned ksw0[4], ksw1[4], vw0[4], vw1[4]; float ks0p = 0.f, ks1p = 0.f, v0p = 0.f, v1p = 0.f;
#pragma unroll
                for (int i = 0; i < 8; ++i) {
                    const float b0 = pre0 + lf0[i], b1 = pre1 + lf1[i];
                    const unsigned qw = cq[i]; const unsigned vw = cv[i];
                    const float qs0 = bflo(qw) * __expf(b0 - r0), qs1 = bfhi(qw) * __expf(b1 - r1);
                    const float ks0 = kk0[i] * __expf(r0 - b0), ks1 = kk1[i] * __expf(r1 - b1);
                    *(unsigned*)(QSB + (rowb + i) * 1024 + col) = pk2(qs0, qs1);
                    *(unsigned*)(KSB + (rowb + i) * 1024 + col) = pk2(ks0, ks1);
                    if (i & 1) { ksw0[i >> 1] = pk2(ks0p, ks0); ksw1[i >> 1] = pk2(ks1p, ks1); vw0[i >> 1] = pk2(v0p, bflo(vw)); vw1[i >> 1] = pk2(v1p, bfhi(vw)); }
                    else { ks0p = ks0; ks1p = ks1; v0p = bflo(vw); v1p = bfhi(vw); }
                }
                *(LAS v4u*)(KST + (2 * cp) * 144 + sg * 16) = (v4u){ksw0[0], ksw0[1], ksw0[2], ksw0[3]};
                *(LAS v4u*)(KST + (2 * cp + 1) * 144 + sg * 16) = (v4u){ksw1[0], ksw1[1], ksw1[2], ksw1[3]};
                *(LAS v4u*)(VTL + (2 * cp) * 144 + sg * 16) = (v4u){vw0[0], vw0[1], vw0[2], vw0[3]};
                *(LAS v4u*)(VTL + (2 * cp + 1) * 144 + sg * 16) = (v4u){vw1[0], vw1[1], vw1[2], vw1[3]};
                if (sg == 7) { float* de = DEB + (size_t)u * 256; *(float2*)(de + 2 * cp) = make_float2(__expf(r0), __expf(r1)); *(float2*)(de + 128 + 2 * cp) = make_float2(__expf(t0), __expf(t1));
                    G63[2 * cp] = __expf(t0 - r0); G63[2 * cp + 1] = __expf(t1 - r1); }
                __syncthreads();
                { const int kt = wave >> 1, vt0 = (wave & 1) * 2, lr = lane & 31, lh = lane >> 5;
                  f32x16 acc0, acc1;
#pragma unroll
                  for (int r = 0; r < 16; ++r) { acc0[r] = 0.f; acc1[r] = 0.f; }
#pragma unroll
                  for (int s4 = 0; s4 < 4; ++s4) {
                      const bf16x8 kb = *(const LAS bf16x8*)(KST + (kt * 32 + lr) * 144 + (s4 * 16 + 8 * lh) * 2);
                      const bf16x8 a0 = *(const LAS bf16x8*)(VTL + (vt0 * 32 + lr) * 144 + (s4 * 16 + 8 * lh) * 2);
                      const bf16x8 a1 = *(const LAS bf16x8*)(VTL + ((vt0 + 1) * 32 + lr) * 144 + (s4 * 16 + 8 * lh) * 2);
                      acc0 = __builtin_amdgcn_mfma_f32_32x32x16_bf16(a0, kb, acc0, 0, 0, 0); acc1 = __builtin_amdgcn_mfma_f32_32x32x16_bf16(a1, kb, acc1, 0, 0, 0); }
                  bf16* kvt = KVT + (size_t)u * 16384 + kt * 32 + lr; const float g = G63[kt * 32 + lr];
#pragma unroll
                  for (int r = 0; r < 16; ++r) { const int vv = 8 * (r >> 2) + 4 * lh + (r & 3);
                      kvt[(size_t)(vt0 * 32 + vv) * 128] = (bf16)(pk2(acc0[r] * g, 0.f) & 0xffffu); kvt[(size_t)((vt0 + 1) * 32 + vv) * 128] = (bf16)(pk2(acc1[r] * g, 0.f) & 0xffffu); } }
                __syncthreads();
            }
        }
#undef HA_REQ
        PHASE_END
        GRID_BAR();
        }
        for (int rep_ = 0; rep_ < REP_M2; ++rep_) {
        PHASE_BEGIN
        for (int item = gtid; item < 32 * 4096; item += NT) {
            const int bh = item >> 12, v = (item >> 5) & 127, k4 = (item & 31) * 4;
            f32x4 S = {0.f, 0.f, 0.f, 0.f};
            for (int c0 = 0; c0 < 64; c0 += 8) {
                f32x4 kv[8], dd[8], ee[8];
#pragma unroll
                for (int j = 0; j < 8; ++j) { const size_t u = (size_t)bh * 64 + c0 + j; kv[j] = ldbf4(KVT + u * 16384 + v * 128 + k4); ee[j] = *(const f32x4*)(DEB + u * 256 + k4); dd[j] = *(const f32x4*)(DEB + u * 256 + 128 + k4); }
#pragma unroll
                for (int j = 0; j < 8; ++j) { const size_t u = (size_t)bh * 64 + c0 + j; const f32x4 sp = S * ee[j]; v2u w; w.x = pk2(sp[0], sp[1]); w.y = pk2(sp[2], sp[3]);
                    *(v2u*)(SPB + u * 16384 + v * 128 + k4) = w; S = S * dd[j] + kv[j]; }
            }
        }
        PHASE_END
        PHASE_BEGIN
        { pg8::Gemm g{CQN, W3, M, N3, SAR, SAR, SAR, 0}; pg8::StaticOrder S; S.init(M, N3, G, blk);
          EpiQ E{QB, QIDX}; pg8::gemm_phase(lds, g, S, E, tid); }
        PHASE_END
        GRID_BAR();
        }
        for (int rep_ = 0; rep_ < REP_M3; ++rep_) {
        PHASE_BEGIN
        {
            LAS unsigned char* QSL = lds;
            LAS unsigned char* KSL = lds + 17408;
            LAS unsigned char* VTL = lds + 34816;
            LAS unsigned char* SPL = lds + 53248;
            LAS unsigned char* AL = lds + 88064;
            LAS float* SSQ = (LAS float*)(lds + 97280);
            const int cp = tid & 63, sg = tid >> 6, lr = lane & 31, lh = lane >> 5;
            v4u rq[2], rk[2], rs[4]; unsigned rv[8]; unsigned short rg[16];
#define HC_REQ(U_) do { int uu_ = (U_); asm volatile("" : "+s"(uu_));   const int bh_ = uu_ >> 6, c_ = uu_ & 63, b_ = bh_ >> 3, h_ = bh_ & 7; const size_t row0_ = (size_t)b_ * SEQ + c_ * 64; const int col0_ = h_ * 128; \
                _Pragma("unroll") for (int j = 0; j < 2; ++j) { const int q = tid + 512 * j, rr = q >> 4, cc = q & 15; \
                    rq[j] = *(const v4u*)(QSB + (row0_ + rr) * 1024 + col0_ + cc * 8); rk[j] = *(const v4u*)(KSB + (row0_ + rr) * 1024 + col0_ + cc * 8); } \
                _Pragma("unroll") for (int j = 0; j < 4; ++j) { const int q = tid + 512 * j, rr = q >> 4, cc = q & 15; rs[j] = *(const v4u*)(SPB + (size_t)uu_ * 16384 + rr * 128 + cc * 8); } \
                _Pragma("unroll") for (int i = 0; i < 8; ++i) rv[i] = *(const unsigned*)(IA + (row0_ + sg * 8 + i) * 1024 + col0_ + 2 * cp); \
                { const int it_ = wave >> 2, vt_ = wave & 3; const int colg_ = col0_ + vt_ * 32 + lr; \
                  _Pragma("unroll") for (int r = 0; r < 16; ++r) { const int ii = it_ * 32 + 8 * (r >> 2) + 4 * lh + (r & 3); rg[r] = GA[(row0_ + ii) * 1024 + colg_]; } } } while (0)
            HC_REQ(blk);
            for (int u = blk; u < 2048; u += G) {
                const int bh = u >> 6, c = u & 63, b = bh >> 3, h = bh & 7;
                const size_t row0 = (size_t)b * SEQ + c * 64; const int col0 = h * 128;
#pragma unroll
                for (int j = 0; j < 2; ++j) { const int q = tid + 512 * j, rr = q >> 4, cc = q & 15;
                    *(LAS v4u*)(QSL + rr * 272 + cc * 16) = rq[j]; *(LAS v4u*)(KSL + rr * 272 + cc * 16) = rk[j]; }
#pragma unroll
                for (int j = 0; j < 4; ++j) { const int q = tid + 512 * j, rr = q >> 4, cc = q & 15; *(LAS v4u*)(SPL + rr * 272 + cc * 16) = rs[j]; }
                { unsigned vw0[4], vw1[4]; float v0p = 0.f, v1p = 0.f;
#pragma unroll
                  for (int i = 0; i < 8; ++i) { const unsigned vw = rv[i];
                      if (i & 1) { vw0[i >> 1] = pk2(v0p, bflo(vw)); vw1[i >> 1] = pk2(v1p, bfhi(vw)); } else { v0p = bflo(vw); v1p = bfhi(vw); } }
                  *(LAS v4u*)(VTL + (2 * cp) * 144 + sg * 16) = (v4u){vw0[0], vw0[1], vw0[2], vw0[3]};
                  *(LAS v4u*)(VTL + (2 * cp + 1) * 144 + sg * 16) = (v4u){vw1[0], vw1[1], vw1[2], vw1[3]}; }
                float gav[16];
#pragma unroll
                for (int r = 0; r < 16; ++r) gav[r] = bf2f(rg[r]);
                HC_REQ(u + G < 2048 ? u + G : u);
                __syncthreads();
                if (wave < 4) {
                    const int it = wave >> 1, jt = wave & 1;
                    f32x16 acc;
#pragma unroll
                    for (int r = 0; r < 16; ++r) acc[r] = 0.f;
                    if (!(it == 0 && jt == 1)) {
#pragma unroll
                        for (int s8 = 0; s8 < 8; ++s8) {
                            const bf16x8 a = *(const LAS bf16x8*)(QSL + (it * 32 + lr) * 272 + (s8 * 16 + 8 * lh) * 2);
                            const bf16x8 bb = *(const LAS bf16x8*)(KSL + (jt * 32 + lr) * 272 + (s8 * 16 + 8 * lh) * 2);
                            acc = __builtin_amdgcn_mfma_f32_32x32x16_bf16(a, bb, acc, 0, 0, 0); } }
                    const int jj = jt * 32 + lr;
#pragma unroll
                    for (int r = 0; r < 16; ++r) { const int ii = it * 32 + 8 * (r >> 2) + 4 * lh + (r & 3); const float x = (jj <= ii) ? acc[r] : 0.f;
                        *(LAS unsigned short*)(AL + ii * 144 + jj * 2) = (unsigned short)(pk2(x, 0.f) & 0xffffu); }
                }
                __syncthreads();
                { const int it = wave >> 2, vt = wave & 3;
                  f32x16 acc;
#pragma unroll
                  for (int r = 0; r < 16; ++r) acc[r] = 0.f;
#pragma unroll
                  for (int s4 = 0; s4 < 4; ++s4) {
                      const bf16x8 a = *(const LAS bf16x8*)(AL + (it * 32 + lr) * 144 + (s4 * 16 + 8 * lh) * 2);
                      const bf16x8 bb = *(const LAS bf16x8*)(VTL + (vt * 32 + lr) * 144 + (s4 * 16 + 8 * lh) * 2);
                      acc = __builtin_amdgcn_mfma_f32_32x32x16_bf16(a, bb, acc, 0, 0, 0); }
#pragma unroll
                  for (int s8 = 0; s8 < 8; ++s8) {
                      const bf16x8 a = *(const LAS bf16x8*)(QSL + (it * 32 + lr) * 272 + (s8 * 16 + 8 * lh) * 2);
                      const bf16x8 bb = *(const LAS bf16x8*)(SPL + (vt * 32 + lr) * 272 + (s8 * 16 + 8 * lh) * 2);
                      acc = __builtin_amdgcn_mfma_f32_32x32x16_bf16(a, bb, acc, 0, 0, 0); }
#pragma unroll
                  for (int r = 0; r < 16; ++r) { float q2 = acc[r] * acc[r];
                      q2 = xsum16(rowsum16(q2));
                      if (lr == 0) SSQ[vt * 64 + it * 32 + 8 * (r >> 2) + 4 * lh + (r & 3)] = q2; }
                  __syncthreads();
                  const int colg = col0 + vt * 32 + lr; const float gg = g_hg[l * 1024 + colg];
#pragma unroll
                  for (int r = 0; r < 16; ++r) { const int ii = it * 32 + 8 * (r >> 2) + 4 * lh + (r & 3);
                      const float ss = SSQ[ii] + SSQ[64 + ii] + SSQ[128 + ii] + SSQ[192 + ii]; const float rn = 1.0f / sqrtf(ss * (1.f / 128.f) + 1e-6f);
                      YAB[(row0 + ii) * 2048 + colg] = (bf16)(pk2(acc[r] * rn * gg * gav[r], 0.f) & 0xffffu); }
                }
                __syncthreads();
            }
        }
#undef HC_REQ
        PHASE_END
        PHASE_BEGIN
        for (int ub = blk * NWAVES; ub < 2048; ub += NGW) {
            const int unit = ub + wave;
            const int b = ub >> 9, j = unit & 511, lr = lane & 31, lh = lane >> 5;
            const int qsel = (lr >> 2) & 1, head = (lr >> 3) * 4 + (lr & 3);
            const int qlo = 4 * j, qhi = 4 * (1023 - j);
            const int nlo = ((qlo >> 6) + 1) * 64, nhi = ((qhi >> 6) + 1) * 64;
            const int nlo8 = (nlo + 511) & ~511, nhi8 = (nhi + 511) & ~511;
            const int nmax8 = (((((4 * (1023 - (ub & 511))) >> 6) + 1) * 64) + 511) & ~511;
            bf16x8 A[4][4]; float W[4][16];
#pragma unroll
            for (int p = 0; p < 4; ++p) { const size_t qb = (size_t)b * SEQ + (p < 2 ? qlo + 2 * p : qhi + 2 * (p - 2));
#pragma unroll
                for (int ks = 0; ks < 4; ++ks) A[p][ks] = *(const bf16x8*)(QIDX + (qb + qsel) * 1024 + head * 64 + ks * 16 + lh * 8);
#pragma unroll
                for (int r4 = 0; r4 < 4; ++r4) { const f32x4 w = *(const f32x4*)(IDXW + (qb + lh) * 16 + r4 * 4); W[p][r4 * 4] = w[0]; W[p][r4 * 4 + 1] = w[1]; W[p][r4 * 4 + 2] = w[2]; W[p][r4 * 4 + 3] = w[3]; } }
            const bf16* kb = KIDX + (size_t)b * SEQ * 64;
            v4u stg[4];
#pragma unroll
            for (int i = 0; i < 4; ++i) { const int pc = tid + 512 * i; stg[i] = *(const v4u*)(kb + (size_t)(pc >> 3) * 64 + (pc & 7) * 8); }
#pragma unroll
            for (int i = 0; i < 4; ++i) { const int pc = tid + 512 * i; *(LAS v4u*)(lds + (pc >> 3) * 144 + (pc & 7) * 16) = stg[i]; }
            __syncthreads();
            for (int c0 = 0; c0 < nmax8; c0 += 256) {
                const int cb = (c0 >> 8) & 1; const bool more = c0 + 256 < nmax8;
                if (more) {
#pragma unroll
                    for (int i = 0; i < 4; ++i) { const int pc = tid + 512 * i; stg[i] = *(const v4u*)(kb + (size_t)(c0 + 256 + (pc >> 3)) * 64 + (pc & 7) * 8); } }
                LAS unsigned char* kbuf = lds + cb * 36864;
#pragma unroll 1
                for (int tl = 0; tl < 8; ++tl) {
                    const int s0 = c0 + tl * 32;
                    if (s0 >= nhi8) break;
#pragma unroll
                    for (int p = 0; p < 4; ++p) { const int np = p < 2 ? nlo : nhi, np8 = p < 2 ? nlo8 : nhi8;
                        if (s0 >= np && s0 < np8) { const size_t q = (size_t)b * SEQ + (p < 2 ? qlo + 2 * p : qhi + 2 * (p - 2)) + lh; ISC[q * 4096 + s0 + lr] = (_Float16)(-60000.0f); } }
                    if (s0 >= nhi) continue;
                    bf16x8 B[4];
#pragma unroll
                    for (int ks = 0; ks < 4; ++ks) B[ks] = *(const LAS bf16x8*)(kbuf + (tl * 32 + lr) * 144 + ks * 32 + lh * 16);
#define IDX_FINISH(P_, ACC_) do { float sc_ = 0.f; _Pragma("unroll") for (int r = 0; r < 16; ++r) sc_ += W[P_][r] * fmaxf(ACC_[r], 0.f); \
                        const size_t q_ = (size_t)b * SEQ + ((P_) < 2 ? qlo + 2 * (P_) : qhi + 2 * ((P_) - 2)) + lh; ISC[q_ * 4096 + s0 + lr] = (_Float16)sc_; } while (0)
                    if (s0 < nlo) {
                        f32x16 c0_, c1_, c2_, c3_;
#pragma unroll
                        for (int r = 0; r < 16; ++r) { c0_[r] = 0.f; c1_[r] = 0.f; c2_[r] = 0.f; c3_[r] = 0.f; }
#pragma unroll
                        for (int ks = 0; ks < 4; ++ks) { c0_ = __builtin_amdgcn_mfma_f32_32x32x16_bf16(A[0][ks], B[ks], c0_, 0, 0, 0); c1_ = __builtin_amdgcn_mfma_f32_32x32x16_bf16(A[1][ks], B[ks], c1_, 0, 0, 0);
                            c2_ = __builtin_amdgcn_mfma_f32_32x32x16_bf16(A[2][ks], B[ks], c2_, 0, 0, 0); c3_ = __builtin_amdgcn_mfma_f32_32x32x16_bf16(A[3][ks], B[ks], c3_, 0, 0, 0); }
                        IDX_FINISH(0, c0_); IDX_FINISH(1, c1_); IDX_FINISH(2, c2_); IDX_FINISH(3, c3_);
                    } else {
                        f32x16 c2_, c3_;
#pragma unroll
                        for (int r = 0; r < 16; ++r) { c2_[r] = 0.f; c3_[r] = 0.f; }
#pragma unroll
                        for (int ks = 0; ks < 4; ++ks) { c2_ = __builtin_amdgcn_mfma_f32_32x32x16_bf16(A[2][ks], B[ks], c2_, 0, 0, 0); c3_ = __builtin_amdgcn_mfma_f32_32x32x16_bf16(A[3][ks], B[ks], c3_, 0, 0, 0); }
                        IDX_FINISH(2, c2_); IDX_FINISH(3, c3_);
                    }
#undef IDX_FINISH
                }
                if (more) {
#pragma unroll
                    for (int i = 0; i < 4; ++i) { const int pc = tid + 512 * i; *(LAS v4u*)(lds + (cb ^ 1) * 36864 + (pc >> 3) * 144 + (pc & 7) * 16) = stg[i]; } }
                __syncthreads();
            }
        }
        PHASE_END
        GRID_BAR();
        }
        for (int rep_ = 0; rep_ < REP_P5; ++rep_) {
        PHASE_BEGIN
        {
            LAS unsigned char* VB = lds + wave * 18432;
            LAS unsigned short* SELW = (LAS unsigned short*)(VB + 17408);
            const int hd = lane & 15, g = lane >> 4, qq = hd >> 2, pp = hd & 3;
            const float slope = exp2f(-0.5f * (float)(hd + 1));
            for (int q = gw; q < M; q += NGW) {
                const int b = q / SEQ, pos = q % SEQ, qc = pos >> 6; const int nsel = qc < 4 ? (qc + 1) * 64 : 256;
                for (int rtk_ = 0; rtk_ < REP_TOPK; ++rtk_) {
                int lane_t = lane; asm volatile("" : "+v"(lane_t));
                if (qc < 4) { const unsigned e0 = 4 * lane_t; const bool ok = 4 * lane_t < nsel; v2u z; z.x = ok ? (e0 | ((e0 + 1) << 16)) : 0u; z.y = ok ? ((e0 + 2) | ((e0 + 3) << 16)) : 0u; *(LAS v2u*)(SELW + 4 * lane_t) = z; }
                else {
                    LAS unsigned* HIST = (LAS unsigned*)VB;
                    const int nb8 = (qc + 8) >> 3;
                    float v[64];
#pragma unroll
                    for (int g8 = 0; g8 < 8; ++g8) {
                        if (g8 < nb8) {
#pragma unroll
                            for (int j = 0; j < 8; ++j) v[g8 * 8 + j] = (float)ISC[(size_t)q * 4096 + (g8 * 8 + j) * 64 + lane_t];
                        } else {
#pragma unroll
                            for (int j = 0; j < 8; ++j) v[g8 * 8 + j] = -1.0e30f; } }
                    float vmx = v[0], vmn = fminf(fminf(fminf(v[0], v[1]), fminf(v[2], v[3])), v[4]);
#pragma unroll
                    for (int i = 1; i < 64; ++i) vmx = fmaxf(vmx, v[i]);
                    vmx = wmax_f(vmx); vmn = -wmax_f(-vmn);
                    const float rng = vmx - vmn; const float s20 = rng > 0.f ? 1048574.0f / rng : 0.f;
#define ZERO_HIST() do { *(LAS v4u*)(HIST + 16 * lane) = (v4u){0u, 0u, 0u, 0u}; *(LAS v4u*)(HIST + 16 * lane + 4) = (v4u){0u, 0u, 0u, 0u}; *(LAS v4u*)(HIST + 16 * lane + 8) = (v4u){0u, 0u, 0u, 0u}; \
                        *(LAS v4u*)(HIST + 16 * lane + 12) = (v4u){0u, 0u, 0u, 0u}; HIST[1024 + lane] = 0u; } while (0)
#define SCAN_HIST(R_, BIN_, AB_) do { unsigned hh_[16]; const int hb_ = 1008 - 16 * lane; \
                        { const v4u h0 = *(const LAS v4u*)(HIST + hb_), h1 = *(const LAS v4u*)(HIST + hb_ + 4), h2 = *(const LAS v4u*)(HIST + hb_ + 8), h3 = *(const LAS v4u*)(HIST + hb_ + 12); \
                          hh_[0] = h0.x; hh_[1] = h0.y; hh_[2] = h0.z; hh_[3] = h0.w; hh_[4] = h1.x; hh_[5] = h1.y; hh_[6] = h1.z; hh_[7] = h1.w; hh_[8] = h2.x; hh_[9] = h2.y; hh_[10] = h2.z; hh_[11] = h2.w; hh_[12] = h3.x; hh_[13] = h3.y; hh_[14] = h3.z; hh_[15] = h3.w; } \
                        unsigned tot_ = 0u; _Pragma("unroll") for (int k = 0; k < 16; ++k) tot_ += hh_[k]; \
                        unsigned run_ = wprefix_u(tot_) - tot_; int fb_ = -1; unsigned fa_ = 0u; \
                        _Pragma("unroll") for (int k = 15; k >= 0; --k) { if (run_ < (R_) && run_ + hh_[k] >= (R_)) { fb_ = hb_ + k; fa_ = run_; } run_ += hh_[k]; } \
                        const unsigned long long bm_ = __ballot(fb_ >= 0); const int L_ = (int)__builtin_ctzll(bm_); \
                        BIN_ = (unsigned)__builtin_amdgcn_readlane(fb_, L_); AB_ = (unsigned)__builtin_amdgcn_readlane((int)fa_, L_); } while (0)
                    ZERO_HIST();
#pragma unroll
                    for (int i = 0; i < 64; ++i) v[i] = __builtin_bit_cast(float, (unsigned)((v[i] - vmn) * s20));
#define cd(i_) __builtin_bit_cast(unsigned, v[i_])
#pragma unroll
                    for (int g8 = 0; g8 < 8; ++g8) { if (g8 < nb8) {
#pragma unroll
                        for (int j = 0; j < 8; ++j) __hip_atomic_fetch_add(HIST + (cd(g8 * 8 + j) >> 10), 1u, __ATOMIC_RELAXED, __HIP_MEMORY_SCOPE_WORKGROUP); } }
                    LDS_WAIT(); asm volatile("" ::: "memory");
                    unsigned tb, above; SCAN_HIST(256u, tb, above);
                    ZERO_HIST();
                    LDS_WAIT(); asm volatile("" ::: "memory");
#pragma unroll
                    for (int g8 = 0; g8 < 8; ++g8) { if (g8 < nb8) {
#pragma unroll
                        for (int j = 0; j < 8; ++j) { const unsigned c = cd(g8 * 8 + j); const unsigned a = (c >> 10) == tb ? (c & 1023u) : 1024u + lane; __hip_atomic_fetch_add(HIST + a, 1u, __ATOMIC_RELAXED, __HIP_MEMORY_SCOPE_WORKGROUP); } } }
                    LDS_WAIT(); asm volatile("" ::: "memory");
                    unsigned tb2, ab2; { const unsigned R2 = 256u - above; SCAN_HIST(R2, tb2, ab2); }
                    const unsigned T = (tb << 10) | tb2; above += ab2;
                    unsigned baseg = 0u, basee = above;
#pragma unroll
                    for (int g8 = 0; g8 < 8; ++g8) { if (g8 < nb8) {
#pragma unroll
                        for (int j = 0; j < 8; ++j) { const int i = g8 * 8 + j;
                            const bool gt = cd(i) > T; const unsigned long long bg = __ballot(gt);
                            const unsigned pgp = baseg + __builtin_amdgcn_mbcnt_hi((unsigned)(bg >> 32), __builtin_amdgcn_mbcnt_lo((unsigned)bg, 0u));
                            if (gt) SELW[pgp] = (unsigned short)(i * 64 + lane);
                            baseg += (unsigned)__popcll(bg);
                            const bool eq = cd(i) == T; const unsigned long long be = __ballot(eq);
                            if (be) { const unsigned pep = basee + __builtin_amdgcn_mbcnt_hi((unsigned)(be >> 32), __builtin_amdgcn_mbcnt_lo((unsigned)be, 0u));
                                if (eq && pep < 256u) SELW[pep] = (unsigned short)(i * 64 + lane);
                                basee += (unsigned)__popcll(be); } } } }
#undef cd
#undef ZERO_HIST
#undef SCAN_HIST
                }
                LDS_WAIT(); asm volatile("" ::: "memory");
                }
                for (int rat_ = 0; rat_ < REP_ATT; ++rat_) {
                bf16* qrow = QB + (size_t)q * 4096;
                bf16x8 Bq[8];
#pragma unroll
                for (int ks = 0; ks < 8; ++ks) Bq[ks] = *(const bf16x8*)(qrow + hd * 256 + ks * 32 + g * 8);
                const bf16* kvb = CKV + (size_t)b * SEQ * 256;
                f32x4 O[16];
#pragma unroll
                for (int ct = 0; ct < 16; ++ct) O[ct] = (f32x4){0.f, 0.f, 0.f, 0.f};
                float mrun = -1.0e30f, lsum = 0.f;
                LDS_WAIT(); asm volatile("" ::: "memory");
                const int nks = nsel >> 5;
                const int lrow = lane >> 5, lcp = lane & 31;
                v4u KR[16];
#define ATT_LOADROWS(KST_) do { _Pragma("unroll") for (int i = 0; i < 16; ++i) { const int rr_ = 2 * i + lrow; const int ix_ = SELW[32 * (KST_) + rr_]; \
                    KR[i] = *(const v4u*)(kvb + (size_t)ix_ * 256 + ((lcp ^ (rr_ & 7)) * 8)); } } while (0)
                ATT_LOADROWS(0);
                const int rlA = hd & 7;
                const int rlT = (4 * g + qq) & 7;
                const int trb = (4 * g + qq) * 512 + 8 * (pp & 1), trm = 16 * ((pp >> 1) ^ rlT);
                for (int kst = 0; kst < nks; ++kst) {
                    int rlA_ = rlA, trm_ = trm; asm volatile("" : "+v"(rlA_), "+v"(trm_));
                    if (kst + 1 < nks) {
#pragma unroll
                        for (int i = 0; i < 16; ++i) { *(LAS v4u*)(VB + i * 1024 + lane * 16) = KR[i];
                            const int rr_ = 2 * i + lrow; const int ix_ = SELW[32 * (kst + 1) + rr_]; KR[i] = *(const v4u*)(kvb + (size_t)ix_ * 256 + ((lcp ^ (rr_ & 7)) * 8)); }
                    } else {
#pragma unroll
                        for (int i = 0; i < 16; ++i) *(LAS v4u*)(VB + i * 1024 + lane * 16) = KR[i]; }
                    LDS_WAIT(); asm volatile("" ::: "memory");
                    f32x4 S0 = {0.f, 0.f, 0.f, 0.f}, S1 = {0.f, 0.f, 0.f, 0.f};
#pragma unroll
                    for (int k4 = 0; k4 < 4; ++k4) {
                        bf16x8 a0[2], a1[2];
#pragma unroll
                        for (int j = 0; j < 2; ++j) { const int ks = k4 * 2 + j; const int cpos = (4 * ks + g) ^ rlA_;
                            a0[j] = *(const LAS bf16x8*)(VB + hd * 512 + cpos * 16); a1[j] = *(const LAS bf16x8*)(VB + (16 + hd) * 512 + cpos * 16); }
#pragma unroll
                        for (int j = 0; j < 2; ++j) { const int ks = k4 * 2 + j;
                            S0 = __builtin_amdgcn_mfma_f32_16x16x32_bf16(a0[j], Bq[ks], S0, 0, 0, 0); S1 = __builtin_amdgcn_mfma_f32_16x16x32_bf16(a1[j], Bq[ks], S1, 0, 0, 0); }
                    }
                    const v2u pa = *(const LAS v2u*)(SELW + 32 * kst + 4 * g), pb = *(const LAS v2u*)(SELW + 32 * kst + 16 + 4 * g);
                    const float fp = (float)pos;
                    float s0[4], s1[4];
                    s0[0] = S0[0] - slope * fabsf(fp - (float)(pa.x & 0xffffu)); s0[1] = S0[1] - slope * fabsf(fp - (float)(pa.x >> 16));
                    s0[2] = S0[2] - slope * fabsf(fp - (float)(pa.y & 0xffffu)); s0[3] = S0[3] - slope * fabsf(fp - (float)(pa.y >> 16));
                    s1[0] = S1[0] - slope * fabsf(fp - (float)(pb.x & 0xffffu)); s1[1] = S1[1] - slope * fabsf(fp - (float)(pb.x >> 16));
                    s1[2] = S1[2] - slope * fabsf(fp - (float)(pb.y & 0xffffu)); s1[3] = S1[3] - slope * fabsf(fp - (float)(pb.y >> 16));
                    float ml = fmaxf(fmaxf(fmaxf(s0[0], s0[1]), fmaxf(s0[2], s0[3])), fmaxf(fmaxf(s1[0], s1[1]), fmaxf(s1[2], s1[3])));
                    ml = xmax16(ml); ml = xmax32(ml);
                    const float mnew = fmaxf(mrun, ml), alpha = __expf(mrun - mnew); mrun = mnew;
                    float p0[4], p1[4];
#pragma unroll
                    for (int r = 0; r < 4; ++r) { p0[r] = __expf(s0[r] - mnew); p1[r] = __expf(s1[r] - mnew); }
                    lsum = lsum * alpha + ((p0[0] + p0[1]) + (p0[2] + p0[3])) + ((p1[0] + p1[1]) + (p1[2] + p1[3]));
                    v4u pw; pw.x = pk2(p0[0], p0[1]); pw.y = pk2(p0[2], p0[3]); pw.z = pk2(p1[0], p1[1]); pw.w = pk2(p1[2], p1[3]);
                    const bf16x8 Pf = __builtin_bit_cast(bf16x8, pw);
#pragma unroll
                    for (int ct = 0; ct < 16; ++ct) O[ct] = O[ct] * alpha;
#pragma unroll
                    for (int c8 = 0; c8 < 4; ++c8) {
                        v4s lo[4], hi[4];
#pragma unroll
                        for (int j = 0; j < 4; ++j) { const int ct = c8 * 4 + j; const int off = trb + ((32 * ct) ^ trm_);
                            lo[j] = __builtin_amdgcn_ds_read_tr16_b64_v4i16((LAS v4s*)(VB + off));
                            hi[j] = __builtin_amdgcn_ds_read_tr16_b64_v4i16((LAS v4s*)(VB + 16 * 512 + off)); }
#pragma unroll
                        for (int j = 0; j < 4; ++j) { const int ct = c8 * 4 + j;
                            const bf16x8 Af = {lo[j][0], lo[j][1], lo[j][2], lo[j][3], hi[j][0], hi[j][1], hi[j][2], hi[j][3]};
                            O[ct] = __builtin_amdgcn_mfma_f32_16x16x32_bf16(Af, Pf, O[ct], 0, 0, 0); }
                    }
                    LDS_WAIT(); asm volatile("" ::: "memory");
                }
#undef ATT_LOADROWS
                lsum = xsum16(lsum); lsum = xsum32(lsum);
                const float inv = 1.0f / lsum;
#pragma unroll
                for (int ct = 0; ct < 16; ++ct) { const f32x4 o = O[ct] * inv; v2u w; w.x = pk2(o[0], o[1]); w.y = pk2(o[2], o[3]); *(v2u*)(OB + (size_t)q * 4096 + hd * 256 + 16 * ct + 4 * g) = w; }
                }
            }
        }
        PHASE_END
        GRID_BAR();
        }
        PHASE_BEGIN
        { pg8::Gemm g{OB, W6, M, 1024, 1024, 4096, 1024, 1024}; pg8::StaticOrder S; S.init(M, 1024, G, blk);
          EpiBf E{YAB, 2048, 1024}; pg8::gemm_phase(lds, g, S, E, tid); }
        PHASE_END
        GRID_BAR();
        PHASE_BEGIN
        { pg8::Gemm g{YAB, W7, M, DM, DM, DM, DM, 0}; pg8::StaticOrder S; S.init(M, DM, G, blk);
          EpiGateM E{GTB, MRG}; HookGate Hk{GTA, GTB}; pg8::gemm_phase(lds, g, S, E, tid, Hk); }
        PHASE_END
        GRID_BAR();
        PHASE_BEGIN
        { pg8::Gemm g{MRG, W8, M, DM, DM, DM, DM, 0}; pg8::StaticOrder S; S.init(M, DM, G, blk);
          EpiRes E{(l == 0) ? x_in : (const float*)nullptr, XB, RB, modl + 2 * DM}; pg8::gemm_phase(lds, g, S, E, tid); }
        PHASE_END
        GRID_BAR();
        for (int rep_ = 0; rep_ < REP_P9; ++rep_) {
        PHASE_BEGIN
        f32x4 lg[8], lb_[8]; v2u nx[8];
#pragma unroll
        for (int j = 0; j < 8; ++j) { const int c = j * 256 + lane * 4; lg[j] = *(const f32x4*)(ln1_g + l * DM + c); lb_[j] = *(const f32x4*)(ln1_b + l * DM + c); nx[j] = *(const v2u*)(RB + (size_t)gw * DM + c); }
        for (int row = gw; row < M; row += NGW) {
            const int b = row / SEQ; const float* md = modl + (size_t)b * MODW;
            f32x4 v[8]; float s = 0.f;
#pragma unroll
            for (int j = 0; j < 8; ++j) { v[j] = (f32x4){bflo(nx[j].x), bfhi(nx[j].x), bflo(nx[j].y), bfhi(nx[j].y)}; s += (v[j][0] + v[j][1]) + (v[j][2] + v[j][3]); }
            { const int rn = row + NGW < M ? row + NGW : row;
#pragma unroll
              for (int j = 0; j < 8; ++j) nx[j] = *(const v2u*)(RB + (size_t)rn * DM + j * 256 + lane * 4); }
            const float mean = wave_sum(s) * (1.f / DM); float s2 = 0.f;
#pragma unroll
            for (int j = 0; j < 8; ++j) { v[j] = v[j] - mean; s2 += (v[j][0] * v[j][0] + v[j][1] * v[j][1]) + (v[j][2] * v[j][2] + v[j][3] * v[j][3]); }
            const float rstd = 1.0f / sqrtf(wave_sum(s2) * (1.f / DM) + 1e-5f);
#pragma unroll
            for (int j = 0; j < 8; ++j) { const int c = j * 256 + lane * 4; const f32x4 gg = lg[j], bb = lb_[j];
                const f32x4 y = v[j] * rstd * gg + bb; { v2u wx; wx.x = pk2(y[0], y[1]); wx.y = pk2(y[2], y[3]); *(v2u*)(XB + (size_t)row * DM + c) = wx; }
                const f32x4 sc = *(const f32x4*)(md + 4 * DM + c), sh = *(const f32x4*)(md + 3 * DM + c); const f32x4 hh = y * (sc + 1.f) + sh;
                v2u w; w.x = pk2(hh[0], hh[1]); w.y = pk2(hh[2], hh[3]); *(v2u*)(HB + (size_t)row * DM + c) = w; }
        }
        PHASE_END
        GRID_BAR();
        }
        PHASE_BEGIN
        { pg8::Gemm g{HB, W10, M, N10, DM, DM, DM, 0}; pg8::StaticOrder S; S.init(M, N10, G, blk);
          EpiSwiglu E{ACT}; pg8::gemm_phase(lds, g, S, E, tid); }
        PHASE_END
        GRID_BAR();
        PHASE_BEGIN
        { pg8::Gemm g{ACT, W11, M, DM, DFF, DFF, DFF, 0}; pg8::StaticOrder S; S.init(M, DM, G, blk);
          EpiRes E{(const float*)nullptr, XB, RB, modl + 5 * DM}; pg8::gemm_phase(lds, g, S, E, tid); }
        PHASE_END
        GRID_BAR();
        for (int rep_ = 0; rep_ < REP_P12; ++rep_) {
        PHASE_BEGIN
        {
            const bool lastl = (l == DEPTH - 1); const float* mdn = MOD + (size_t)(l + 1 < DEPTH ? l + 1 : l) * NBATCH * MODW;
            f32x4 lg[8], lb_[8]; v2u nx[8];
#pragma unroll
            for (int j = 0; j < 8; ++j) { const int c = j * 256 + lane * 4; lg[j] = *(const f32x4*)(ln2_g + l * DM + c); lb_[j] = *(const f32x4*)(ln2_b + l * DM + c); nx[j] = *(const v2u*)(RB + (size_t)gw * DM + c); }
            for (int row = gw; row < M; row += NGW) {
                const int b = row / SEQ; const float* md = mdn + (size_t)b * MODW;
                f32x4 v[8]; float s = 0.f;
#pragma unroll
                for (int j = 0; j < 8; ++j) { v[j] = (f32x4){bflo(nx[j].x), bfhi(nx[j].x), bflo(nx[j].y), bfhi(nx[j].y)}; s += (v[j][0] + v[j][1]) + (v[j][2] + v[j][3]); }
                { const int rn = row + NGW < M ? row + NGW : row;
#pragma unroll
                  for (int j = 0; j < 8; ++j) nx[j] = *(const v2u*)(RB + (size_t)rn * DM + j * 256 + lane * 4); }
                const float mean = wave_sum(s) * (1.f / DM); float s2 = 0.f;
#pragma unroll
                for (int j = 0; j < 8; ++j) { v[j] = v[j] - mean; s2 += (v[j][0] * v[j][0] + v[j][1] * v[j][1]) + (v[j][2] * v[j][2] + v[j][3] * v[j][3]); }
                const float rstd = 1.0f / sqrtf(wave_sum(s2) * (1.f / DM) + 1e-5f);
#pragma unroll
                for (int j = 0; j < 8; ++j) { const int c = j * 256 + lane * 4; const f32x4 gg = lg[j], bb = lb_[j];
                    const f32x4 y = v[j] * rstd * gg + bb; if (lastl) *(f32x4*)(args.out + (size_t)row * DM + c) = y; else { v2u wx; wx.x = pk2(y[0], y[1]); wx.y = pk2(y[2], y[3]); *(v2u*)(XB + (size_t)row * DM + c) = wx; }
                    const f32x4 sc = *(const f32x4*)(md + DM + c), sh = *(const f32x4*)(md + c); const f32x4 hh = y * (sc + 1.f) + sh;
                    v2u w; w.x = pk2(hh[0], hh[1]); w.y = pk2(hh[2], hh[3]); *(v2u*)(HB + (size_t)row * DM + c) = w; }
            }
            if (l + 1 < DEPTH) { __syncthreads(); CONVERT_LAYER(l + 1); }
        }
        PHASE_END
        if (l + 1 < DEPTH || rep_ + 1 < REP_P12) GRID_BAR();
        }
    }
}

extern "C" void kernel_launch(void* const* d_in, const int* in_sizes, int n_in, void* d_out, int out_size, void* d_ws, size_t ws_size, hipStream_t stream) {
    static int grid = 0;
    if (grid == 0) {
        if (n_in != 22 || out_size != M * DM || ws_size < WS_END) { fprintf(stderr, "kernel_launch: unexpected shapes (n_in %d, out %d, ws %zu < %zu)\n", n_in, out_size, ws_size, (size_t)WS_END); grid = -1; return; }
        int dev = 0, cus = 0, per_cu = 0;
        if (hipGetDevice(&dev) != hipSuccess || hipDeviceGetAttribute(&cus, hipDeviceAttributeMultiprocessorCount, dev) != hipSuccess) { grid = -1; return; }
        if (hipFuncSetAttribute((const void*)fwd_kernel, hipFuncAttributeMaxDynamicSharedMemorySize, LDS_BYTES) != hipSuccess) { fprintf(stderr, "kernel_launch: hipFuncSetAttribute failed\n"); grid = -1; return; }
        if (hipOccupancyMaxActiveBlocksPerMultiprocessor(&per_cu, (const void*)fwd_kernel, NTHR, LDS_BYTES) != hipSuccess || per_cu < 1) { fprintf(stderr, "kernel_launch: occupancy query says %d\n", per_cu); }
        (void)hipGetLastError();
        grid = cus;
    }
    if (grid < 0) return;
    if (hipMemsetAsync((char*)d_ws + WS_CTL, 0, CTL_ZERO_BYTES, stream) != hipSuccess) return;
    Args a{};
    for (int i = 0; i < 22; ++i) a.in[i] = (const float*)d_in[i];
    a.out = (float*)d_out; a.ws = (unsigned char*)d_ws;
    hipLaunchKernelGGL(fwd_kernel, dim3(grid), dim3(NTHR), LDS_BYTES, stream, a);
}
```

```cpp
#include <hip/hip_runtime.h>
#include <cstdio>
#include <cstdint>

namespace pg8 {
#define PG8_LAS __attribute__((address_space(3)))
typedef unsigned short bf16_t;
typedef short bf16x8 __attribute__((ext_vector_type(8)));
typedef float f32x4 __attribute__((ext_vector_type(4)));
typedef unsigned u32x4 __attribute__((ext_vector_type(4)));
constexpr int BM = 256, BK = 64, HALF = 128, HTB = HALF * BK * 2, STAGE_BYTES = 8 * HTB, NXCD = 8, WGM = 8;

__host__ __device__ __forceinline__ int lds_byte(int r, int c) { const int st = (r >> 4) * 2 + (c >> 5), rr = r & 15, cc = c & 31, ob = rr * 64 + cc * 2; return st * 1024 + (ob ^ (((ob >> 9) & 1) << 5)); }
__host__ __device__ __forceinline__ void stage_rc(int b, int& R, int& C) { const int st = b / 1024, sb = b % 1024, swz = sb ^ (((sb >> 9) & 1) << 5); R = (st >> 1) * 16 + swz / 64; C = (st & 1) * 32 + (swz % 64) / 2; }
__host__ __device__ __forceinline__ int perm32(int rho) { const int n = rho >> 4, i = rho & 15; return 8 * (i >> 2) + 4 * n + (i & 3); }

struct Unit { int pm, pn; };
struct Gemm { const bf16_t* A; const bf16_t* Bt; int M, N, K, lda, ldb, a_pn_stride; };

struct StaticOrder {
    int nM, nN, nwg, G, c;
    __host__ __device__ void init(int M, int N, int G_, int c_) { nM = M / BM; nN = N / BM; nwg = nM * nN; G = G_; c = c_; }
    __host__ __device__ bool next(int i, Unit& u) const {
        const long L = (long)i * G + c; if (L >= nwg) return false;
        int wgid = (int)L; { const int q = nwg / NXCD, r = nwg % NXCD, xcd = wgid % NXCD, off = wgid / NXCD; wgid = (xcd < r ? xcd * (q + 1) : r * (q + 1) + (xcd - r) * q) + off; }
        const int nig = WGM * nN, gid = wgid / nig, fm = gid * WGM, gsz = (nM - fm) < WGM ? (nM - fm) : WGM;
        u.pm = fm + ((wgid % nig) % gsz); u.pn = (wgid % nig) / gsz; return true;
    }
};

typedef float f32x2_t __attribute__((ext_vector_type(2))); typedef __bf16 bf16x2_t __attribute__((ext_vector_type(2)));
__device__ __forceinline__ unsigned cvt_pk_bf16(float lo, float hi) { f32x2_t v = {lo, hi}; bf16x2_t b = __builtin_convertvector(v, bf16x2_t); return __builtin_bit_cast(unsigned, b); }

struct NoHook { static constexpr bool ON = false; template <class A> __device__ __forceinline__ void mid(A&, const Unit&, int, int, int, int) const {} };
template <class Epi, class Hook = NoHook>
__device__ __forceinline__ void gemm_phase(PG8_LAS unsigned char* lds, const Gemm g, const StaticOrder& S, const Epi& E, const int tid, const Hook H = Hook()) {
    const int wid = __builtin_amdgcn_readfirstlane(tid >> 6), lane = tid & 63, wr = wid >> 2, wc = wid & 3, fr = lane & 15, fq = lane >> 4;
    const int K = g.K, nt = K / BK;
    unsigned voffA[2], voffB[2];
#pragma unroll
    for (int i = 0; i < 2; ++i) { int R, C; stage_rc(tid * 16 + i * 8192, R, C); const int Rb = 64 * (R >> 5) + perm32(R & 31);
        voffA[i] = (unsigned)(R * g.lda + C) * 2u; voffB[i] = (unsigned)(Rb * g.ldb + C) * 2u; }
    const size_t kstep = (size_t)(BK * 2);
    const size_t hstepA = (size_t)HALF * g.lda * 2, hstepB = (size_t)32 * g.ldb * 2;
    const size_t tstepA = 2 * hstepA, tstepB = (size_t)BM * g.ldb * 2;
    const unsigned ldsw = (unsigned)wid * 1024u;
    const int aoff = lds_byte(wr * 64 + fr, fq * 8), boff = lds_byte(wc * 32 + fr, fq * 8);
#define PG8_SA(b, h) (((b) * 2 + (h)) * HTB)
#define PG8_SB(b, h) ((4 + (b) * 2 + (h)) * HTB)
#define PG8_STAGE(bufoff, gbase, voff) do { _Pragma("unroll") for (int _i = 0; _i < 2; ++_i) \
        __builtin_amdgcn_global_load_lds((const unsigned*)((const char*)(gbase) + (voff)[_i]), (PG8_LAS unsigned*)(lds + (bufoff) + ldsw + _i * 8192), 16, 0, 0); } while (0)
#define PG8_LDA(dst, b, h) do { _Pragma("unroll") for (int m = 0; m < 4; ++m) _Pragma("unroll") for (int k = 0; k < 2; ++k) dst[m][k] = *(const PG8_LAS bf16x8*)(lds + PG8_SA(b, h) + aoff + m * 2048 + k * 1024); } while (0)
#define PG8_LDB(dst, b, h) do { _Pragma("unroll") for (int n = 0; n < 2; ++n) _Pragma("unroll") for (int k = 0; k < 2; ++k) dst[n][k] = *(const PG8_LAS bf16x8*)(lds + PG8_SB(b, h) + boff + n * 2048 + k * 1024); } while (0)
#define PG8_MMA(ai, bj, At, Bt) do { __builtin_amdgcn_s_setprio(1); _Pragma("unroll") for (int m = 0; m < 4; ++m) _Pragma("unroll") for (int n = 0; n < 2; ++n) _Pragma("unroll") for (int k = 0; k < 2; ++k) \
        acc[ai][bj][m][n] = __builtin_amdgcn_mfma_f32_16x16x32_bf16(Bt[n][k], At[m][k], acc[ai][bj][m][n], 0, 0, 0); __builtin_amdgcn_s_setprio(0); } while (0)
#define PG8_WAIT_V(n) asm volatile("s_waitcnt vmcnt(" #n ")" ::: "memory")
#define PG8_WAIT_L(n) asm volatile("s_waitcnt lgkmcnt(" #n ")" ::: "memory")
#define PG8_BAR __builtin_amdgcn_s_barrier()
#define PG8_SCHED __builtin_amdgcn_sched_barrier(0)
    Unit cur, nxt; int ui = 0;
    if (!S.next(0, cur)) return;
    f32x4 acc[2][2][4][2];
#pragma unroll
    for (int a = 0; a < 2; ++a)
#pragma unroll
        for (int b = 0; b < 2; ++b)
#pragma unroll
            for (int m = 0; m < 4; ++m)
#pragma unroll
                for (int n = 0; n < 2; ++n) acc[a][b][m][n] = (f32x4){0.f, 0.f, 0.f, 0.f};
    bf16x8 At[4][2], B0[2][2], B1[2][2];
    const char* cA = (const char*)g.A + (size_t)cur.pm * tstepA + (size_t)cur.pn * g.a_pn_stride * 2; const char* cB = (const char*)g.Bt + (size_t)cur.pn * tstepB;
    PG8_STAGE(PG8_SB(0, 0), cB, voffB); PG8_STAGE(PG8_SB(0, 1), cB + hstepB, voffB); PG8_STAGE(PG8_SA(0, 0), cA, voffA); PG8_STAGE(PG8_SA(0, 1), cA + hstepA, voffA);
    if (wr == 1) PG8_BAR;
    PG8_WAIT_V(2); PG8_BAR;
    PG8_STAGE(PG8_SB(1, 0), cB + kstep, voffB); PG8_STAGE(PG8_SA(1, 0), cA + kstep, voffA); PG8_STAGE(PG8_SB(1, 1), cB + hstepB + kstep, voffB);
    PG8_WAIT_V(6); PG8_BAR;
    for (;;) {
        const bool has_next = S.next(ui + 1, nxt);
        const char* nA = has_next ? (const char*)g.A + (size_t)nxt.pm * tstepA + (size_t)nxt.pn * g.a_pn_stride * 2 : cA; const char* nB = has_next ? (const char*)g.Bt + (size_t)nxt.pn * tstepB : cB;
        for (int t = 0; t < nt; t += 2) {
            const bool last = (t == nt - 2);
            const char* a1 = cA + (size_t)(t + 1) * kstep;
            const char* a2 = last ? nA : cA + (size_t)(t + 2) * kstep; const char* b2 = last ? nB : cB + (size_t)(t + 2) * kstep;
            const char* a3 = a2 + kstep; const char* b3 = b2 + kstep;
            if constexpr (Hook::ON) { if (t == (nt >> 1)) H.mid(acc, cur, wr, wc, fr, fq); }
            PG8_LDB(B0, 0, 0); PG8_LDB(B1, 0, 1); PG8_SCHED; PG8_LDA(At, 0, 0); PG8_STAGE(PG8_SA(1, 1), a1 + hstepA, voffA);
            PG8_WAIT_V(8); PG8_WAIT_L(0); PG8_BAR; PG8_MMA(0, 0, At, B0); PG8_MMA(0, 1, At, B1); PG8_BAR; PG8_SCHED;
            PG8_LDA(At, 0, 1); PG8_STAGE(PG8_SB(0, 0), b2, voffB); PG8_STAGE(PG8_SB(0, 1), b2 + hstepB, voffB); PG8_STAGE(PG8_SA(0, 0), a2, voffA);
            PG8_WAIT_V(8); PG8_WAIT_L(0); PG8_BAR; PG8_MMA(1, 0, At, B0); PG8_MMA(1, 1, At, B1); PG8_BAR; PG8_SCHED;
            PG8_LDB(B0, 1, 0); PG8_LDB(B1, 1, 1); PG8_SCHED; PG8_LDA(At, 1, 0); PG8_STAGE(PG8_SA(0, 1), a2 + hstepA, voffA);
            PG8_WAIT_V(8); PG8_WAIT_L(0); PG8_BAR; PG8_MMA(0, 0, At, B0); PG8_MMA(0, 1, At, B1); PG8_BAR; PG8_SCHED;
            PG8_LDA(At, 1, 1); PG8_STAGE(PG8_SB(1, 0), b3, voffB); PG8_STAGE(PG8_SB(1, 1), b3 + hstepB, voffB); PG8_STAGE(PG8_SA(1, 0), a3, voffA);
            PG8_WAIT_V(8); PG8_WAIT_L(0); PG8_BAR; PG8_MMA(1, 0, At, B0); PG8_MMA(1, 1, At, B1); PG8_BAR; PG8_SCHED;
        }
        if (wr == 0) PG8_BAR;
        E(acc, cur, wr, wc, fr, fq);
        if (!has_next) break;
#pragma unroll
        for (int a = 0; a < 2; ++a)
#pragma unroll
            for (int b = 0; b < 2; ++b)
#pragma unroll
                for (int m = 0; m < 4; ++m)
#pragma unroll
                    for (int n = 0; n < 2; ++n) acc[a][b][m][n] = (f32x4){0.f, 0.f, 0.f, 0.f};
        cur = nxt; cA = nA; cB = nB; ++ui;
        if (wr == 1) PG8_BAR;
    }
    PG8_WAIT_V(0);
    PG8_BAR;
#undef PG8_SA
#undef PG8_SB
#undef PG8_STAGE
#undef PG8_LDA
#undef PG8_LDB
#undef PG8_MMA
#undef PG8_WAIT_V
#undef PG8_WAIT_L
#undef PG8_BAR
#undef PG8_SCHED
}
}

constexpr int NWAVES = 8, NTHR = NWAVES * 64;
constexpr int DM = 2048, NBATCH = 4, SEQ = 4096, DEPTH = 4, M = NBATCH * SEQ;
constexpr int HGW = 1024;
constexpr int SAH = 16, SAC = 256, SAR = 512;
constexpr int DFF = 5632;
constexpr int N1 = 9216, N3 = 5120, N10 = 2 * DFF;
constexpr float ALPHA = 1.6817928305074292f;
constexpr int MODW = 6 * DM;

constexpr size_t MiB = 1u << 20;
constexpr size_t WS_CTL = 0, CTL_ZERO_BYTES = 32768;
constexpr size_t WS_MOD = 1 * MiB;
constexpr size_t WS_LB = 2 * MiB;
constexpr size_t WS_MODP = 3 * MiB;
constexpr size_t WS_W1 = 9 * MiB;
constexpr size_t WS_W3 = WS_W1 + 36 * MiB;
constexpr size_t WS_W6 = WS_W3 + 5 * MiB;
constexpr size_t WS_W7 = WS_W6 + 2 * MiB;
constexpr size_t WS_W8 = WS_W7 + 8 * MiB;
constexpr size_t WS_W10 = WS_W8 + 8 * MiB;
constexpr size_t WS_W11 = WS_W10 + 44 * MiB;
constexpr size_t WS_X = WS_W11 + 22 * MiB;
constexpr size_t WS_R = WS_X + 128 * MiB;
constexpr size_t WS_H = WS_R + 128 * MiB;
constexpr size_t WS_QA = WS_H + 64 * MiB;
constexpr size_t WS_FA = WS_QA + 32 * MiB;
constexpr size_t WS_IA = WS_FA + 64 * MiB;
constexpr size_t WS_GA = WS_IA + 32 * MiB;
constexpr size_t WS_LAT = WS_GA + 32 * MiB;
constexpr size_t WS_GTA = WS_LAT + 64 * MiB;
constexpr size_t WS_GTB = WS_GTA + 64 * MiB;
constexpr size_t WS_CQN = WS_GTB + 64 * MiB;
constexpr size_t WS_CKV = WS_CQN + 16 * MiB;
constexpr size_t WS_KIDX = WS_CKV + 8 * MiB;
constexpr size_t WS_IDXW = WS_KIDX + 2 * MiB;
constexpr size_t WS_QB = WS_IDXW + 1 * MiB;
constexpr size_t WS_QIDX = WS_QB + 128 * MiB;
constexpr size_t WS_SEL = WS_QIDX + 32 * MiB;
constexpr size_t WS_YAB = WS_SEL + 8 * MiB;
constexpr size_t WS_MRG = WS_FA;
constexpr size_t WS_OB = WS_YAB + 64 * MiB;
constexpr size_t WS_BIG = WS_OB + 128 * MiB;
constexpr size_t WS_KSB = WS_BIG + 256 * MiB;
constexpr size_t WS_DEB = WS_KSB + 32 * MiB;
constexpr size_t WS_QSB = WS_DEB + 2 * MiB;
constexpr size_t WS_END = WS_QSB + 32 * MiB;

constexpr int CW_BAR = 4096;

constexpr int RING_BYTES = 131072;
constexpr int LDS_BYTES = 163840;
constexpr int LDSCTL_OFF = LDS_BYTES - 1024, MISC_OFF = LDSCTL_OFF + 320, SELL_OFF = 147456;

#define GAS __attribute__((address_space(1)))
#define LAS __attribute__((address_space(3)))
typedef unsigned short bf16;
typedef unsigned v4u __attribute__((ext_vector_type(4)));
typedef unsigned v2u __attribute__((ext_vector_type(2)));
typedef float f32x4 __attribute__((ext_vector_type(4)));
typedef float f32x16 __attribute__((ext_vector_type(16)));
typedef short bf16x8 __attribute__((ext_vector_type(8)));
typedef short v4s __attribute__((ext_vector_type(4)));
typedef GAS unsigned gu32;
#define LDS_WAIT() asm volatile("s_waitcnt lgkmcnt(0)" ::: "memory")
__device__ __forceinline__ unsigned f2bf(float f) { unsigned u = __builtin_bit_cast(unsigned, f); return (u + 0x7fffu + ((u >> 16) & 1u)) >> 16; }
__device__ __forceinline__ unsigned pk2(float lo, float hi) { return pg8::cvt_pk_bf16(lo, hi); }
__device__ __forceinline__ float bf2f(unsigned short b) { return __builtin_bit_cast(float, ((unsigned)b) << 16); }
__device__ __forceinline__ float bflo(unsigned w) { return __builtin_bit_cast(float, w << 16); }
__device__ __forceinline__ float bfhi(unsigned w) { return __builtin_bit_cast(float, w & 0xffff0000u); }
__device__ __forceinline__ float sigm(float x) { return __builtin_amdgcn_rcpf(1.f + __expf(-x)); }

__device__ __forceinline__ int lane_id() { unsigned m = ~0u; asm volatile("" : "+s"(m)); return (int)__builtin_amdgcn_mbcnt_hi(m, __builtin_amdgcn_mbcnt_lo(m, 0u)); }
#define XB_TMO      128
#define XB_XCNT(j)  (256  + 64 * (j))
#define XB_XSUB(j)  (1280 + 64 * (j))
#define XB_XGEN(j)  (2304 + 64 * (j))
#define XB_TOP      3328
#define XB_TOPGEN   3392
#define XCD_BAR_WORDS 3456
#define XB_SPIN_CAP (1u << 22)

__device__ __forceinline__ unsigned xb_ld(unsigned* p)              { return __hip_atomic_load(p, __ATOMIC_RELAXED, __HIP_MEMORY_SCOPE_AGENT); }
__device__ __forceinline__ unsigned xb_add(unsigned* p, unsigned v) { return __hip_atomic_fetch_add(p, v, __ATOMIC_RELAXED, __HIP_MEMORY_SCOPE_AGENT); }
__device__ __forceinline__ unsigned xb_xcc_id() { return (unsigned)__builtin_amdgcn_s_getreg((3 << 11) | 20) & 0xFu; }
#define XB_SPIN(cond, bar) do { unsigned _sp = 0; while (cond) { __builtin_amdgcn_s_sleep(1); \
    if ((++_sp & 255u) == 0u) { if (xb_ld(&(bar)[XB_TMO])) break; if (_sp > XB_SPIN_CAP) { atomicAdd(&(bar)[XB_TMO], 1u); break; } } } } while (0)

struct XcdBarrier { unsigned* bar; unsigned x; volatile LAS unsigned* st; int wave; };

__device__ __forceinline__ XcdBarrier xcd_barrier_post(unsigned* bar, volatile LAS unsigned* st) {
    XcdBarrier b; b.bar = bar; b.x = (unsigned)__builtin_amdgcn_readfirstlane((int)xb_xcc_id()); b.st = st;
    if (threadIdx.x == 0) (void)xb_add(&bar[XB_XCNT(b.x)], 1u);
    return b;
}
__device__ __forceinline__ void xcd_barrier_complete(unsigned* bar, unsigned x, unsigned& nloc, unsigned& nx) {
    const unsigned G = gridDim.x * gridDim.y * gridDim.z;
    unsigned sum, cnt, mine, sp = 0u;
    for (;;) {
        sum = 0u; cnt = 0u; mine = 0u;
#pragma unroll 1
        for (unsigned j = 0; j < 16; ++j) { const unsigned c = xb_ld(&bar[XB_XCNT(j)]); sum += c; cnt += (c > 0u) ? 1u : 0u; mine = (j == x) ? c : mine; }
        if (sum == G) break;
        __builtin_amdgcn_s_sleep(1);
        if ((++sp & 255u) == 0u) { if (xb_ld(&bar[XB_TMO])) break; if (sp > XB_SPIN_CAP) { atomicAdd(&bar[XB_TMO], 1u); break; } }
    }
    nloc = mine > 0u ? mine : 1u; nx = cnt > 0u ? cnt : 1u;
}
__device__ __forceinline__ void xcd_barrier(const XcdBarrier& b) {
    asm volatile("s_waitcnt vmcnt(0)" ::: "memory");
    __syncthreads();
    if (b.wave == 0 && lane_id() == 0) {
        unsigned* bar = b.bar;
        unsigned bx = b.x; asm volatile("" : "+s"(bx));
        __builtin_amdgcn_s_waitcnt(0);
        unsigned nloc = b.st[0], nx = b.st[1];
        const unsigned old = xb_add(&bar[XB_XSUB(bx)], 1u);
        const unsigned gen = old / nloc;
        if (old + 1u == (gen + 1u) * nloc) {
            __builtin_amdgcn_fence(__ATOMIC_RELEASE, "agent");
            asm volatile("s_waitcnt vmcnt(0)" ::: "memory");
            const unsigned og = xb_add(&bar[XB_TOP], 1u);
            const unsigned tg = og / nx;
            if (og + 1u == (tg + 1u) * nx) xb_add(&bar[XB_TOPGEN], 1u);
            else XB_SPIN(xb_ld(&bar[XB_TOPGEN]) == tg, bar);
            __builtin_amdgcn_fence(__ATOMIC_ACQUIRE, "agent");
            xb_add(&bar[XB_XGEN(bx)], 1u);
            asm volatile("s_waitcnt vmcnt(0)" ::: "memory");
        } else {
            XB_SPIN(xb_ld(&bar[XB_XGEN(bx)]) == gen, bar);
            __builtin_amdgcn_fence(__ATOMIC_ACQUIRE, "agent");
            asm volatile("s_waitcnt vmcnt(0)" ::: "memory");
        }
    }
    __syncthreads();
}

__device__ __forceinline__ void xswap16(float& a, float& b) { asm volatile("s_nop 1\n\tv_permlane16_swap_b32 %0, %1\n\ts_nop 1" : "+v"(a), "+v"(b)); }
__device__ __forceinline__ void xswap32(float& a, float& b) { asm volatile("s_nop 1\n\tv_permlane32_swap_b32 %0, %1\n\ts_nop 1" : "+v"(a), "+v"(b)); }
__device__ __forceinline__ float xmax16(float x) { float a = x, b = x; xswap16(a, b); return fmaxf(a, b); }
__device__ __forceinline__ float xmax32(float x) { float a = x, b = x; xswap32(a, b); return fmaxf(a, b); }
__device__ __forceinline__ float xsum16(float x) { float a = x, b = x; xswap16(a, b); return a + b; }
__device__ __forceinline__ float xsum32(float x) { float a = x, b = x; xswap32(a, b); return a + b; }

#define DPPF(x, ctrl) __builtin_bit_cast(float, __builtin_amdgcn_update_dpp(0, __builtin_bit_cast(int, (x)), (ctrl), 0xf, 0xf, true))
__device__ __forceinline__ float wmax_f(float x) {
    x = fmaxf(x, DPPF(x, 0xB1)); x = fmaxf(x, DPPF(x, 0x4E)); x = fmaxf(x, DPPF(x, 0x124)); x = fmaxf(x, DPPF(x, 0x128));
    x = xmax16(x); return xmax32(x);
}
__device__ __forceinline__ unsigned wprefix_u(unsigned x) {
    int v = (int)x;
    v += __builtin_amdgcn_update_dpp(0, v, 0x111, 0xf, 0xf, false);
    v += __builtin_amdgcn_update_dpp(0, v, 0x112, 0xf, 0xf, false);
    v += __builtin_amdgcn_update_dpp(0, v, 0x114, 0xf, 0xf, false);
    v += __builtin_amdgcn_update_dpp(0, v, 0x118, 0xf, 0xf, false);
    v += __builtin_amdgcn_update_dpp(0, v, 0x142, 0xa, 0xf, false);
    v += __builtin_amdgcn_update_dpp(0, v, 0x143, 0xc, 0xf, false);
    return (unsigned)v;
}

__device__ __forceinline__ float rowsum16(float x) { x += DPPF(x, 0xB1); x += DPPF(x, 0x4E); x += DPPF(x, 0x124); x += DPPF(x, 0x128); return x; }
__device__ __forceinline__ float wave_sum(float x) { x = rowsum16(x); x = xsum16(x); return xsum32(x); }
__device__ __forceinline__ float wave_max(float x) { return wmax_f(x); }
__device__ __forceinline__ int wave_sum_i(int v) { float f = wave_sum((float)v); return (int)(f + 0.5f); }
template <class Src>
__device__ __forceinline__ void cvt_load(const Src& src, int k0, int n0, int lane, float (&tv)[32]) {
#pragma unroll
    for (int i = 0; i < 32; ++i) tv[i] = src(k0 + 2 * i + (lane >> 5), n0 + (lane & 31));
}
__device__ __forceinline__ void cvt_store(const float (&tv)[32], bf16* WT, int K, int k0, int n0, LAS float* scr, int lane) {
#pragma unroll
    for (int i = 0; i < 32; ++i) scr[(2 * i + (lane >> 5)) * 33 + (lane & 31)] = tv[i];
    LDS_WAIT(); asm volatile("" ::: "memory");
    const int c = lane & 7;
#pragma unroll
    for (int j = 0; j < 4; ++j) { const int n = (lane >> 3) + 8 * j; const LAS float* s = scr + (8 * c) * 33 + n;
        v4u o; o.x = pk2(s[0 * 33], s[1 * 33]); o.y = pk2(s[2 * 33], s[3 * 33]); o.z = pk2(s[4 * 33], s[5 * 33]); o.w = pk2(s[6 * 33], s[7 * 33]);
        *(GAS v4u*)(WT + (size_t)(n0 + n) * K + k0 + 8 * c) = o; }
    LDS_WAIT(); asm volatile("" ::: "memory");
}

struct Args { const float* in[22]; float* out; unsigned char* ws; };

using pg8::Unit; using pg8::cvt_pk_bf16;
__device__ __forceinline__ void st_bf16x8(bf16* p, f32x4 v0, f32x4 v1) {
    v4u w; w.x = cvt_pk_bf16(v0[0], v0[1]); w.y = cvt_pk_bf16(v0[2], v0[3]); w.z = cvt_pk_bf16(v1[0], v1[1]); w.w = cvt_pk_bf16(v1[2], v1[3]);
    *(v4u*)p = w;
}
__device__ __forceinline__ void st_f32x8(float* p, f32x4 v0, f32x4 v1) { *(f32x4*)p = v0; *(f32x4*)(p + 4) = v1; }
__device__ __forceinline__ f32x4 sigm4(f32x4 v) { return (f32x4){sigm(v[0]), sigm(v[1]), sigm(v[2]), sigm(v[3])}; }
__device__ __forceinline__ f32x4 silu4(f32x4 v) { return (f32x4){v[0] * sigm(v[0]), v[1] * sigm(v[1]), v[2] * sigm(v[2]), v[3] * sigm(v[3])}; }
__device__ __forceinline__ f32x4 ldbf4(const bf16* p) { const v2u w = *(const v2u*)p; return (f32x4){bflo(w.x), bfhi(w.x), bflo(w.y), bfhi(w.y)}; }

#define EPI_LOOP(...) \
    _Pragma("unroll") for (int ai = 0; ai < 2; ++ai) _Pragma("unroll") for (int m = 0; m < 4; ++m) { const int row = row0 + ai * 128 + m * 16; \
        _Pragma("unroll") for (int bj = 0; bj < 2; ++bj) { const int col = colb + bj * 32; const f32x4 v0 = acc[ai][bj][m][0], v1 = acc[ai][bj][m][1]; __VA_ARGS__ } }

struct EpiProj {
    bf16* QA; bf16* FA; bf16* IA; bf16* GA; bf16* LAT; bf16* GTA; bf16* GTB;
    __device__ __forceinline__ void operator()(const f32x4 (&acc)[2][2][4][2], const Unit& u, int wr, int wc, int fr, int fq) const {
        const int row0 = u.pm * 256 + wr * 64 + fr, pn = u.pn; const int colb = (pn & 3) * 256 + wc * 64 + 8 * fq;
        if (pn < 4)       { EPI_LOOP( st_bf16x8(QA + (size_t)row * 1024 + col, v0, v1); ) }
        else if (pn < 8)  { EPI_LOOP( st_bf16x8(FA + (size_t)row * 1024 + col, v0, v1); ) }
        else if (pn < 12) { EPI_LOOP( st_bf16x8(IA + (size_t)row * 1024 + col, v0, v1); ) }
        else if (pn < 16) { EPI_LOOP( st_bf16x8(GA + (size_t)row * 1024 + col, silu4(v0), silu4(v1)); ) }
        else if (pn < 20) { EPI_LOOP( st_bf16x8(LAT + (size_t)row * 1024 + col, v0, v1); ) }
        else { bf16* G = pn < 28 ? GTA : GTB; const int cb2 = ((pn - 20) & 7) * 256 + wc * 64 + 8 * fq;
            _Pragma("unroll") for (int ai = 0; ai < 2; ++ai) _Pragma("unroll") for (int m = 0; m < 4; ++m) { const int row = row0 + ai * 128 + m * 16;
                _Pragma("unroll") for (int bj = 0; bj < 2; ++bj) st_bf16x8(G + (size_t)row * 2048 + cb2 + bj * 32, sigm4(acc[ai][bj][m][0]), sigm4(acc[ai][bj][m][1])); } }
    }
};
struct EpiQ {
    bf16* QB; bf16* QIDX;
    __device__ __forceinline__ void operator()(const f32x4 (&acc)[2][2][4][2], const Unit& u, int wr, int wc, int fr, int fq) const {
        const int row0 = u.pm * 256 + wr * 64 + fr, pn = u.pn;
        if (pn < 16) { const int colb = pn * 256 + wc * 64 + 8 * fq; EPI_LOOP( st_bf16x8(QB + (size_t)row * 4096 + col, v0, v1); ) }
        else { const int colb = (pn - 16) * 256 + wc * 64 + 8 * fq; EPI_LOOP( st_bf16x8(QIDX + (size_t)row * 1024 + col, v0, v1); ) }
    }
};
struct EpiBf {
    bf16* O; int ldc; int coff;
    __device__ __forceinline__ void operator()(const f32x4 (&acc)[2][2][4][2], const Unit& u, int wr, int wc, int fr, int fq) const {
        const int row0 = u.pm * 256 + wr * 64 + fr; const int colb = coff + u.pn * 256 + wc * 64 + 8 * fq;
        EPI_LOOP( st_bf16x8(O + (size_t)row * ldc + col, v0, v1); )
    }
};
struct HookGate {
    static constexpr bool ON = true; const bf16* GA_; const bf16* GB_;
    __device__ __forceinline__ void mid(f32x4 (&acc)[2][2][4][2], const Unit& u, int wr, int wc, int fr, int fq) const {
        asm volatile("" : "+v"(fr), "+v"(fq));
        const int row0 = u.pm * 256 + wr * 64 + fr; const int colb = u.pn * 256 + wc * 64 + 8 * fq;
#pragma unroll
        for (int ai = 0; ai < 2; ++ai)
#pragma unroll
            for (int m = 0; m < 4; ++m) { const int row = row0 + ai * 128 + m * 16;
#pragma unroll
                for (int bj = 0; bj < 2; ++bj) { const size_t o = (size_t)row * 2048 + colb + bj * 32;
                    const f32x4 a0 = ldbf4(GA_ + o), a1 = ldbf4(GA_ + o + 4), b0 = ldbf4(GB_ + o), b1 = ldbf4(GB_ + o + 4);
                    f32x4 r0, r1;
#pragma unroll
                    for (int j = 0; j < 4; ++j) { r0[j] = a0[j] * __builtin_amdgcn_rcpf(b0[j]); r1[j] = a1[j] * __builtin_amdgcn_rcpf(b1[j]); }
                    acc[ai][bj][m][0] = acc[ai][bj][m][0] * r0; acc[ai][bj][m][1] = acc[ai][bj][m][1] * r1; }
                asm volatile("" : "+v"(acc[ai][0][m][0]), "+v"(acc[ai][0][m][1]), "+v"(acc[ai][1][m][0]), "+v"(acc[ai][1][m][1]));
                if (m & 1) asm volatile("" ::: "memory"); }
    }
};
struct EpiGateM {
    const bf16* GB_; bf16* MRG_;
    __device__ __forceinline__ void operator()(const f32x4 (&acc)[2][2][4][2], const Unit& u, int wr, int wc, int fr, int fq) const {
        const int row0 = u.pm * 256 + wr * 64 + fr; const int colb = u.pn * 256 + wc * 64 + 8 * fq;
        EPI_LOOP( const size_t o = (size_t)row * 2048 + col; const f32x4 g0 = ldbf4(GB_ + o), g1 = ldbf4(GB_ + o + 4); st_bf16x8(MRG_ + o, v0 * g0, v1 * g1); )
    }
};
struct EpiGateA {
    float* T1; const bf16* GT;
    __device__ __forceinline__ void operator()(const f32x4 (&acc)[2][2][4][2], const Unit& u, int wr, int wc, int fr, int fq) const {
        const int row0 = u.pm * 256 + wr * 64 + fr; const int colb = u.pn * 256 + wc * 64 + 8 * fq;
        EPI_LOOP( const size_t o = (size_t)row * 2048 + col; const f32x4 g0 = ldbf4(GT + o), g1 = ldbf4(GT + o + 4); st_f32x8(T1 + o, v0 * g0, v1 * g1); )
    }
};
struct EpiGateB {
    const float* T1; const bf16* GT; bf16* MRG;
    __device__ __forceinline__ void operator()(const f32x4 (&acc)[2][2][4][2], const Unit& u, int wr, int wc, int fr, int fq) const {
        const int row0 = u.pm * 256 + wr * 64 + fr; const int colb = u.pn * 256 + wc * 64 + 8 * fq;
        EPI_LOOP( const size_t o = (size_t)row * 2048 + col; const f32x4 g0 = ldbf4(GT + o), g1 = ldbf4(GT + o + 4); const f32x4 t0 = *(const f32x4*)(T1 + o), t1 = *(const f32x4*)(T1 + o + 4);
                  st_bf16x8(MRG + o, t0 + v0 * g0, t1 + v1 * g1); )
    }
};
struct EpiRes {
    const float* X; const bf16* Xh; bf16* R; const float* gt;
    __device__ __forceinline__ void operator()(const f32x4 (&acc)[2][2][4][2], const Unit& u, int wr, int wc, int fr, int fq) const {
        const int row0 = u.pm * 256 + wr * 64 + fr; const int colb = u.pn * 256 + wc * 64 + 8 * fq; const float* g = gt + (size_t)(u.pm >> 4) * MODW;
        if (X) { EPI_LOOP( const size_t o = (size_t)row * 2048 + col; const f32x4 x0 = *(const f32x4*)(X + o), x1 = *(const f32x4*)(X + o + 4); const f32x4 g0 = *(const f32x4*)(g + col), g1 = *(const f32x4*)(g + col + 4);
                  st_bf16x8(R + o, x0 * ALPHA + (g0 + 1.f) * v0, x1 * ALPHA + (g1 + 1.f) * v1); ) }
        else { EPI_LOOP( const size_t o = (size_t)row * 2048 + col; const f32x4 x0 = ldbf4(Xh + o), x1 = ldbf4(Xh + o + 4); const f32x4 g0 = *(const f32x4*)(g + col), g1 = *(const f32x4*)(g + col + 4);
                  st_bf16x8(R + o, x0 * ALPHA + (g0 + 1.f) * v0, x1 * ALPHA + (g1 + 1.f) * v1); ) }
    }
};
struct EpiSwiglu {
    bf16* ACT;
    __device__ __forceinline__ void operator()(const f32x4 (&acc)[2][2][4][2], const Unit& u, int wr, int wc, int fr, int fq) const {
        const int row0 = u.pm * 256 + wr * 64 + fr; const int col = u.pn * 128 + wc * 32 + 8 * fq;
#pragma unroll
        for (int ai = 0; ai < 2; ++ai)
#pragma unroll
            for (int m = 0; m < 4; ++m) { const int row = row0 + ai * 128 + m * 16;
                st_bf16x8(ACT + (size_t)row * DFF + col, silu4(acc[ai][0][m][0]) * acc[ai][1][m][0], silu4(acc[ai][0][m][1]) * acc[ai][1][m][1]); }
    }
};

__global__ void __launch_bounds__(NTHR, 2) fwd_kernel(Args args) {
    extern __shared__ __attribute__((aligned(16))) unsigned char lds_raw[];
    LAS unsigned char* lds = (LAS unsigned char*)lds_raw;
    const int G = gridDim.x, blk = blockIdx.x;
    const int NGW = G * NWAVES, NT = G * NTHR;
    unsigned char* const ws_base = args.ws;
    gu32* ctl = (gu32*)(ws_base + WS_CTL);
    for (int u = threadIdx.x; u < (LDS_BYTES - LDSCTL_OFF) / 4; u += NTHR) ((LAS unsigned*)(lds + LDSCTL_OFF))[u] = 0u;
    __syncthreads();
    volatile LAS unsigned* MISC = (volatile LAS unsigned*)(lds + MISC_OFF);
    const int wave_s = __builtin_amdgcn_readfirstlane((int)(threadIdx.x >> 6));
    XcdBarrier bar = xcd_barrier_post((unsigned*)(ctl + CW_BAR), MISC + 8); bar.wave = wave_s;
    if (threadIdx.x == 0) { unsigned nloc_ = 0u, nx_ = 0u; xcd_barrier_complete(bar.bar, bar.x, nloc_, nx_); bar.st[0] = nloc_; bar.st[1] = nx_; }
    __syncthreads();
#define GRID_BAR() xcd_barrier(bar)

#define x_in ((const float*)(const GAS float*)args.in[0 + z_])
#define c_in ((const float*)(const GAS float*)args.in[1 + z_])
#define w_ada ((const float*)(const GAS float*)args.in[2 + z_])
#define b_ada ((const float*)(const GAS float*)args.in[3 + z_])
#define w_in ((const float*)(const GAS float*)args.in[4 + z_])
#define lb_logits ((const float*)(const GAS float*)args.in[5 + z_])
#define g_hg ((const float*)(const GAS float*)args.in[6 + z_])
#define w_pa ((const float*)(const GAS float*)args.in[7 + z_])
#define g_cq ((const float*)(const GAS float*)args.in[8 + z_])
#define g_ckv ((const float*)(const GAS float*)args.in[9 + z_])
#define w_uq ((const float*)(const GAS float*)args.in[10 + z_])
#define w_iq ((const float*)(const GAS float*)args.in[11 + z_])
#define w_uv ((const float*)(const GAS float*)args.in[12 + z_])
#define w_pb ((const float*)(const GAS float*)args.in[13 + z_])
#define w_out ((const float*)(const GAS float*)args.in[14 + z_])
#define ln1_g ((const float*)(const GAS float*)args.in[15 + z_])
#define ln1_b ((const float*)(const GAS float*)args.in[16 + z_])
#define w_gate ((const float*)(const GAS float*)args.in[17 + z_])
#define w_up ((const float*)(const GAS float*)args.in[18 + z_])
#define w_down ((const float*)(const GAS float*)args.in[19 + z_])
#define ln2_g ((const float*)(const GAS float*)args.in[20 + z_])
#define ln2_b ((const float*)(const GAS float*)args.in[21 + z_])
#define MOD  ((float*)(ws + WS_MOD))
#define LB   ((float*)(ws + WS_LB))
#define MODP ((float*)(ws + WS_MODP))
#define W1   ((bf16*)(ws + WS_W1))
#define W3   ((bf16*)(ws + WS_W3))
#define W6   ((bf16*)(ws + WS_W6))
#define W7   ((bf16*)(ws + WS_W7))
#define W8   ((bf16*)(ws + WS_W8))
#define W10  ((bf16*)(ws + WS_W10))
#define W11  ((bf16*)(ws + WS_W11))
#define XB   ((bf16*)(ws + WS_X))
#define RB   ((bf16*)(ws + WS_R))
#define HB   ((bf16*)(ws + WS_H))
#define QA   ((bf16*)(ws + WS_QA))
#define FA   ((bf16*)(ws + WS_FA))
#define IA   ((bf16*)(ws + WS_IA))
#define GA   ((bf16*)(ws + WS_GA))
#define LAT  ((bf16*)(ws + WS_LAT))
#define GTA  ((bf16*)(ws + WS_GTA))
#define GTB  ((bf16*)(ws + WS_GTB))
#define CQN  ((bf16*)(ws + WS_CQN))
#define CKV  ((bf16*)(ws + WS_CKV))
#define KIDX ((bf16*)(ws + WS_KIDX))
#define IDXW ((float*)(ws + WS_IDXW))
#define QB   ((bf16*)(ws + WS_QB))
#define QIDX ((bf16*)(ws + WS_QIDX))
#define SEL  ((unsigned short*)(ws + WS_SEL))
#define YAB  ((bf16*)(ws + WS_YAB))
#define MRG  ((bf16*)(ws + WS_MRG))
#define OB   ((bf16*)(ws + WS_OB))
#define ISC  ((_Float16*)(ws + WS_BIG))
#define OP   ((float*)(ws + WS_BIG))
#define ACT  ((bf16*)(ws + WS_BIG))
#define KK   LAT
#define modl (MOD + (size_t)l * NBATCH * MODW)
#define KSB  ((bf16*)(ws + WS_KSB))
#define QSB  ((bf16*)(ws + WS_QSB))
#define KVT  ((bf16*)(ws + WS_BIG))
#define SPB  ((bf16*)(ws + WS_FA))
#define DEB  ((float*)(ws + WS_DEB))
#define PHASE_BEGIN { unsigned om_ = ~0u; asm volatile("" : "+s"(om_)); int tid = wave_s * 64 + (int)__builtin_amdgcn_mbcnt_hi(om_, __builtin_amdgcn_mbcnt_lo(om_, 0u)); asm volatile("" : "+v"(tid)); int z_ = 0; asm volatile("" : "+s"(z_)); (void)z_; GAS unsigned char* wsg_ = (GAS unsigned char*)ws_base; asm volatile("" : "+s"(wsg_)); unsigned char* ws = (unsigned char*)wsg_; const int lane = tid & 63, wave = __builtin_amdgcn_readfirstlane(tid >> 6); \
        const int gw = blk * NWAVES + wave, gtid = blk * NTHR + tid; LAS float* wscr = (LAS float*)(lds + wave * 16384); (void)lane; (void)gw; (void)gtid; (void)wscr;
#define PHASE_END }

#define CVT_DECODE(IT_, MID_, K0_, N0_) do { int r_ = (IT_); \
        if (r_ < I1) { MID_ = 0; K0_ = (r_ / (N1 / 32)) * 64; N0_ = (r_ % (N1 / 32)) * 32; } else { r_ -= I1; \
        if (r_ < I3) { MID_ = 1; K0_ = (r_ / (N3 / 32)) * 64; N0_ = (r_ % (N3 / 32)) * 32; } else { r_ -= I3; \
        if (r_ < I6) { MID_ = 2; K0_ = (r_ / 32) * 64; N0_ = (r_ % 32) * 32; } else { r_ -= I6; \
        if (r_ < I7) { MID_ = 3; K0_ = (r_ / (DM / 32)) * 64; N0_ = (r_ % (DM / 32)) * 32; } else { r_ -= I7; \
        if (r_ < I8) { MID_ = 4; K0_ = (r_ / (DM / 32)) * 64; N0_ = (r_ % (DM / 32)) * 32; } else { r_ -= I8; \
        if (r_ < I10) { MID_ = 5; K0_ = (r_ / (N10 / 32)) * 64; N0_ = (r_ % (N10 / 32)) * 32; } else { r_ -= I10; \
        MID_ = 6; K0_ = (r_ / (DM / 32)) * 64; N0_ = (r_ % (DM / 32)) * 32; } } } } } } } while (0)
#define CVT_LOAD(MID_, K0_, N0_, TV_) do { \
        if (MID_ == 0) cvt_load([=](int k, int n) -> float { return n < 4944 ? s_in[(size_t)k * 9040 + n] : (n < 5120 ? 0.f : s_in[(size_t)k * 9040 + n - 176]); }, K0_, N0_, lane, TV_); \
        else if (MID_ == 1) cvt_load([=](int k, int n) -> float { return n < 4096 ? s_uq[(size_t)k * 4096 + n] * 0.0625f : s_iq[(size_t)k * 1024 + n - 4096]; }, K0_, N0_, lane, TV_); \
        else if (MID_ == 2) cvt_load([=](int k, int n) -> float { const int h = n >> 6, v = n & 63, kk = k >> 8, c = k & 255; return kk == (h & 3) ? s_uv[((size_t)h * 256 + c) * 64 + v] : 0.f; }, K0_, N0_, lane, TV_); \
        else if (MID_ == 3) cvt_load([=](int k, int n) -> float { return k < 1024 ? s_pa[(size_t)k * DM + n] : s_pb[(size_t)(k - 1024) * DM + n]; }, K0_, N0_, lane, TV_); \
        else if (MID_ == 4) cvt_load([=](int k, int n) -> float { return s_out[(size_t)k * DM + n]; }, K0_, N0_, lane, TV_); \
        else if (MID_ == 5) cvt_load([=](int k, int n) -> float { const int pn = n >> 8, rr = n & 255, cc = pn * 128 + (rr >> 6) * 32 + (rr & 31); return (rr & 32) ? s_u[(size_t)k * DFF + cc] : s_g[(size_t)k * DFF + cc]; }, K0_, N0_, lane, TV_); \
        else cvt_load([=](int k, int n) -> float { return s_d[(size_t)k * DM + n]; }, K0_, N0_, lane, TV_); } while (0)
#define CONVERT_LAYER(L) do { const int l_ = (L); \
        const float* s_in = w_in + (size_t)l_ * DM * 9040; const float* s_uq = w_uq + (size_t)l_ * SAR * 4096; const float* s_iq = w_iq + (size_t)l_ * SAR * 1024; \
        const float* s_uv = w_uv + (size_t)l_ * 16 * 256 * 64; const float* s_pa = w_pa + (size_t)l_ * 1024 * DM; const float* s_pb = w_pb + (size_t)l_ * 1024 * DM; \
        const float* s_out = w_out + (size_t)l_ * DM * DM; const float* s_g = w_gate + (size_t)l_ * DM * DFF; const float* s_u = w_up + (size_t)l_ * DM * DFF; const float* s_d = w_down + (size_t)l_ * DFF * DM; \
        constexpr int I1 = (DM / 64) * (N1 / 32), I3 = (SAR / 64) * (N3 / 32), I6 = (1024 / 64) * (1024 / 32), I7 = (DM / 64) * (DM / 32), I8 = I7, I10 = (DM / 64) * (N10 / 32), I11 = (DFF / 64) * (DM / 32); \
        constexpr int NIT = I1 + I3 + I6 + I7 + I8 + I10 + I11; \
        float tv_[32]; int mid_ = 0, k0_ = 0, n0_ = 0; \
        { CVT_DECODE(gw, mid_, k0_, n0_); CVT_LOAD(mid_, k0_, n0_, tv_); } \
        for (int it = gw; it < NIT; it += NGW) { \
            float tc_[32]; _Pragma("unroll") for (int i = 0; i < 32; ++i) tc_[i] = tv_[i]; \
            const int mc_ = mid_, kc_ = k0_, nc_ = n0_; \
            { const int itn_ = it + NGW < NIT ? it + NGW : it; CVT_DECODE(itn_, mid_, k0_, n0_); CVT_LOAD(mid_, k0_, n0_, tv_); }     \
            bf16* wt_ = mc_ == 0 ? W1 : mc_ == 1 ? W3 : mc_ == 2 ? W6 : mc_ == 3 ? W7 : mc_ == 4 ? W8 : mc_ == 5 ? W10 : W11; \
            const int kk_ = mc_ == 0 ? DM : mc_ == 1 ? SAR : mc_ == 2 ? 1024 : mc_ == 3 ? DM : mc_ == 4 ? DM : mc_ == 5 ? DM : DFF; \
            cvt_store(tc_, wt_, kk_, kc_, nc_, wscr, lane); \
        } } while (0)


#ifndef HGRN_NAIVE
#define HGRN_NAIVE 0
#endif
#ifndef IDX_NAIVE
#define IDX_NAIVE 0
#endif
#ifndef ATT_NAIVE
#define ATT_NAIVE 0
#endif
#ifndef TOPK_OLD
#define TOPK_OLD 0
#endif
#ifndef REP_HB
#define REP_HB 1
#endif
#ifndef REP_HC
#define REP_HC 1
#endif
#ifndef REP_P4A
#define REP_P4A 1
#endif
#ifndef REP_P5
#define REP_P5 1
#endif
#ifndef REP_P9
#define REP_P9 1
#endif
#ifndef REP_P12
#define REP_P12 1
#endif
#ifndef REP_TOPK
#define REP_TOPK 1
#endif
#ifndef REP_ATT
#define REP_ATT 1
#endif
#ifndef DRY_ATT
#define DRY_ATT 0
#endif
#ifndef REP_M1
#define REP_M1 1
#endif
#ifndef REP_M2
#define REP_M2 1
#endif
#ifndef REP_M3
#define REP_M3 1
#endif

    PHASE_BEGIN
    {
        LAS float* sc = (LAS float*)lds;
        for (int i = tid; i < NBATCH * DM; i += NTHR) { const float v = c_in[i]; sc[i] = v * sigm(v); }
        __syncthreads();
        for (int item = gtid; item < 8 * 12288; item += NT) {
            const int ks = item / 12288, cg = item % 12288, l = cg / 3072, n4 = (cg % 3072) * 4;
            const float* wp = w_ada + ((size_t)l * DM + ks * 256) * MODW + n4;
            f32x4 a0 = {0.f, 0.f, 0.f, 0.f}, a1 = a0, a2 = a0, a3 = a0;
#pragma unroll 8
            for (int k = 0; k < 256; ++k) { const f32x4 w = *(const f32x4*)(wp + (size_t)k * MODW); const int kk = ks * 256 + k;
                a0 += w * sc[kk]; a1 += w * sc[2048 + kk]; a2 += w * sc[4096 + kk]; a3 += w * sc[6144 + kk]; }
            float* o = MODP + ((size_t)(ks * 4 + l) * 4) * MODW + n4;
            *(f32x4*)(o) = a0; *(f32x4*)(o + MODW) = a1; *(f32x4*)(o + 2 * MODW) = a2; *(f32x4*)(o + 3 * MODW) = a3;
        }
        if (gtid < 1024) {
            const float a = lb_logits[gtid], b = lb_logits[1024 + gtid], c = lb_logits[2048 + gtid], d = lb_logits[3072 + gtid];
            const float mx = fmaxf(fmaxf(a, b), fmaxf(c, d)); const float ea = expf(a - mx), eb = expf(b - mx), ec = expf(c - mx), ed = expf(d - mx); const float inv = 1.f / (ea + eb + ec + ed);
            LB[gtid] = 0.f; LB[1024 + gtid] = eb * inv; LB[2048 + gtid] = (eb + ec) * inv; LB[3072 + gtid] = (eb + ec + ed) * inv;
        }
        __syncthreads();
        CONVERT_LAYER(0);
    }
    PHASE_END
    GRID_BAR();
    PHASE_BEGIN
    for (int i = gtid; i < DEPTH * NBATCH * MODW; i += NT) {
        const int l = i / (NBATCH * MODW), r = i % (NBATCH * MODW), b = r / MODW, n = r % MODW;
        float s = b_ada[l * MODW + n];
#pragma unroll
        for (int ks = 0; ks < 8; ++ks) s += MODP[((size_t)(ks * 4 + l) * 4 + b) * MODW + n];
        MOD[i] = s;
    }
    PHASE_END
    GRID_BAR();
    PHASE_BEGIN
    for (size_t i0 = gtid; i0 < (size_t)M * DM / 8; i0 += (size_t)NT * 4) {
        f32x4 xa[4], xb[4], sa[4], sb[4], ha[4], hb[4];
#pragma unroll
        for (int t = 0; t < 4; ++t) { size_t gi = i0 + (size_t)t * NT; gi = gi < (size_t)M * DM / 8 ? gi : (size_t)M * DM / 8 - 1; const size_t e = gi * 8; const int row = (int)(e / DM), col = (int)(e % DM), b = row / SEQ; const float* md = MOD + (size_t)b * MODW;
            xa[t] = *(const f32x4*)(x_in + e); xb[t] = *(const f32x4*)(x_in + e + 4); sa[t] = *(const f32x4*)(md + 2048 + col); sb[t] = *(const f32x4*)(md + 2048 + col + 4); ha[t] = *(const f32x4*)(md + col); hb[t] = *(const f32x4*)(md + col + 4); }
#pragma unroll
        for (int t = 0; t < 4; ++t) { size_t gi = i0 + (size_t)t * NT; gi = gi < (size_t)M * DM / 8 ? gi : (size_t)M * DM / 8 - 1; const size_t e = gi * 8; st_bf16x8(HB + e, xa[t] * (sa[t] + 1.f) + ha[t], xb[t] * (sb[t] + 1.f) + hb[t]); }
    }
    PHASE_END
    GRID_BAR();

    for (int l = 0; l < DEPTH; ++l) {
        PHASE_BEGIN
        { pg8::Gemm g{HB, W1, M, N1, DM, DM, DM, 0}; pg8::StaticOrder S; S.init(M, N1, G, blk);
          EpiProj E{QA, FA, IA, GA, LAT, GTA, GTB}; pg8::gemm_phase(lds, g, S, E, tid); }
        PHASE_END
        GRID_BAR();
        for (int rep_ = 0; rep_ < REP_M1; ++rep_) {
        PHASE_BEGIN
        v2u ra0, ra1, rkv; unsigned short rki, riw;
        { const bf16* lr = LAT + (size_t)gw * 1024; ra0 = *(const v2u*)(lr + 4 * lane); ra1 = *(const v2u*)(lr + 256 + 4 * lane); rkv = *(const v2u*)(lr + 512 + 4 * lane); rki = lr[768 + lane]; riw = lr[832 + (lane & 15)]; }
        for (int row = gw; row < M; row += NGW) {
            const f32x4 a0 = (f32x4){bflo(ra0.x), bfhi(ra0.x), bflo(ra0.y), bfhi(ra0.y)}, a1 = (f32x4){bflo(ra1.x), bfhi(ra1.x), bflo(ra1.y), bfhi(ra1.y)}, kv = (f32x4){bflo(rkv.x), bfhi(rkv.x), bflo(rkv.y), bfhi(rkv.y)};
            const float ki = bf2f(rki), iw = bf2f(riw);
            { const int rn = row + NGW < M ? row + NGW : row; const bf16* lr = LAT + (size_t)rn * 1024;
              ra0 = *(const v2u*)(lr + 4 * lane); ra1 = *(const v2u*)(lr + 256 + 4 * lane); rkv = *(const v2u*)(lr + 512 + 4 * lane); rki = lr[768 + lane]; riw = lr[832 + (lane & 15)]; }
            float sq = a0[0] * a0[0] + a0[1] * a0[1] + a0[2] * a0[2] + a0[3] * a0[3] + a1[0] * a1[0] + a1[1] * a1[1] + a1[2] * a1[2] + a1[3] * a1[3];
            float sk = kv[0] * kv[0] + kv[1] * kv[1] + kv[2] * kv[2] + kv[3] * kv[3];
            sq = wave_sum(sq); sk = wave_sum(sk);
            const float rq = 1.0f / sqrtf(sq * (1.f / 512.f) + 1e-6f), rk = 1.0f / sqrtf(sk * (1.f / 256.f) + 1e-6f);
            const f32x4 g0 = *(const f32x4*)(g_cq + l * 512 + 4 * lane), g1 = *(const f32x4*)(g_cq + l * 512 + 256 + 4 * lane), gk = *(const f32x4*)(g_ckv + l * 256 + 4 * lane);
            v2u o; f32x4 t = a0 * rq * g0; o.x = pk2(t[0], t[1]); o.y = pk2(t[2], t[3]); *(v2u*)(CQN + (size_t)row * 512 + 4 * lane) = o;
            t = a1 * rq * g1; o.x = pk2(t[0], t[1]); o.y = pk2(t[2], t[3]); *(v2u*)(CQN + (size_t)row * 512 + 256 + 4 * lane) = o;
            t = kv * rk * gk; o.x = pk2(t[0], t[1]); o.y = pk2(t[2], t[3]); *(v2u*)(CKV + (size_t)row * 256 + 4 * lane) = o;
            KIDX[(size_t)row * 64 + lane] = (bf16)f2bf(ki);
            if (lane < 16) IDXW[(size_t)row * 16 + lane] = iw * 0.03125f;
        }
        PHASE_END
        PHASE_BEGIN
        {
            const int cp = tid & 63, sg = tid >> 6;
            LAS unsigned char* KST = lds;
            LAS unsigned char* VTL = lds + 18432;
            LAS float* SEGT = (LAS float*)(lds + 36864);
            LAS float* G63 = (LAS float*)(lds + 40960);
            unsigned pfa[8], pq[8], pv[8];
#define HA_REQ(U_) do { int uu_ = (U_); asm volatile("" : "+s"(uu_)); const int bh_ = uu_ >> 6, c_ = uu_ & 63, b_ = bh_ >> 3, h_ = bh_ & 7; \
                const size_t rowb_ = (size_t)b_ * SEQ + c_ * 64 + sg * 8; const int col_ = h_ * 128 + 2 * cp; \
                _Pragma("unroll") for (int i = 0; i < 8; ++i) { pfa[i] = *(const unsigned*)(FA + (rowb_ + i) * 1024 + col_); pq[i] = *(const unsigned*)(QA + (rowb_ + i) * 1024 + col_); pv[i] = *(const unsigned*)(IA + (rowb_ + i) * 1024 + col_); } } while (0)
            HA_REQ(blk);
            for (int u = blk; u < 2048; u += G) {
                const int bh = u >> 6, c = u & 63, b = bh >> 3, h = bh & 7;
                const size_t rowb = (size_t)b * SEQ + c * 64 + sg * 8; const int col = h * 128 + 2 * cp;
                const float lb0 = LB[l * 1024 + col], lb1 = LB[l * 1024 + col + 1];
                float lf0[8], lf1[8], kk0[8], kk1[8]; unsigned cq[8], cv[8];
#pragma unroll
                for (int i = 0; i < 8; ++i) { cq[i] = pq[i]; cv[i] = pv[i]; }
#pragma unroll
                for (int i = 0; i < 8; ++i) { const float2 fa = make_float2(bflo(pfa[i]), bfhi(pfa[i]));
                    const float f0 = fminf(fmaxf(lb0 + (1.f - lb0) * sigm(fa.x), 1e-6f), 1.f), f1 = fminf(fmaxf(lb1 + (1.f - lb1) * sigm(fa.y), 1e-6f), 1.f);
                    lf0[i] = __logf(f0); lf1[i] = __logf(f1); kk0[i] = (1.f - lb0) * sigm(-fa.x); kk1[i] = (1.f - lb1) * sigm(-fa.y); }
#pragma unroll
                for (int i = 1; i < 8; ++i) { lf0[i] += lf0[i - 1]; lf1[i] += lf1[i - 1]; }
                SEGT[sg * 128 + 2 * cp] = lf0[7]; SEGT[sg * 128 + 2 * cp + 1] = lf1[7];
                HA_REQ(u + G < 2048 ? u + G : u);
                __syncthreads();
                float pre0 = 0.f, pre1 = 0.f, r0 = 0.f, r1 = 0.f, t0 = 0.f, t1 = 0.f;
#pragma unroll
                for (int s2 = 0; s2 < 8; ++s2) { const float a0 = SEGT[s2 * 128 + 2 * cp], a1 = SEGT[s2 * 128 + 2 * cp + 1];
                    if (s2 < sg) { pre0 += a0; pre1 += a1; } if (s2 < 4) { r0 += a0; r1 += a1; } t0 += a0; t1 += a1; }
                unsigned ksw0[4], ksw1[4], vw0[4], vw1[4]; float ks0p = 0.f, ks1p = 0.f, v0p = 0.f, v1p = 0.f;
#pragma unroll
                for (int i = 0; i < 8; ++i) {
                    const float b0 = pre0 + lf0[i], b1 = pre1 + lf1[i];
                    const unsigned qw = cq[i]; const unsigned vw = cv[i];
                    const float qs0 = bflo(qw) * __expf(b0 - r0), qs1 = bfhi(qw) * __expf(b1 - r1);
                    const float ks0 = kk0[i] * __expf(r0 - b0), ks1 = kk1[i] * __expf(r1 - b1);
                    *(unsigned*)(QSB + (rowb + i) * 1024 + col) = pk2(qs0, qs1);
                    *(unsigned*)(KSB + (rowb + i) * 1024 + col) = pk2(ks0, ks1);
                    if (i & 1) { ksw0[i >> 1] = pk2(ks0p, ks0); ksw1[i >> 1] = pk2(ks1p, ks1); vw0[i >> 1] = pk2(v0p, bflo(vw)); vw1[i >> 1] = pk2(v1p, bfhi(vw)); }
                    else { ks0p = ks0; ks1p = ks1; v0p = bflo(vw); v1p = bfhi(vw); }
                }
                *(LAS v4u*)(KST + (2 * cp) * 144 + sg * 16) = (v4u){ksw0[0], ksw0[1], ksw0[2], ksw0[3]};
                *(LAS v4u*)(KST + (2 * cp + 1) * 144 + sg * 16) = (v4u){ksw1[0], ksw1[1], ksw1[2], ksw1[3]};
                *(LAS v4u*)(VTL + (2 * cp) * 144 + sg * 16) = (v4u){vw0[0], vw0[1], vw0[2], vw0[3]};
                *(LAS v4u*)(VTL + (2 * cp + 1) * 144 + sg * 16) = (v4u){vw1[0], vw1[1], vw1[2], vw1[3]};
                if (sg == 7) { float* de = DEB + (size_t)u * 256; *(float2*)(de + 2 * cp) = make_float2(__expf(r0), __expf(r1)); *(float2*)(de + 128 + 2 * cp) = make_float2(__expf(t0), __expf(t1));
                    G63[2 * cp] = __expf(t0 - r0); G63[2 * cp + 1] = __expf(t1 - r1); }
                __syncthreads();
                { const int kt = wave >> 1, vt0 = (wave & 1) * 2, lr = lane & 31, lh = lane >> 5;
                  f32x16 acc0, acc1;
#pragma unroll
                  for (int r = 0; r < 16; ++r) { acc0[r] = 0.f; acc1[r] = 0.f; }
#pragma unroll
                  for (int s4 = 0; s4 < 4; ++s4) {
                      const bf16x8 kb = *(const LAS bf16x8*)(KST + (kt * 32 + lr) * 144 + (s4 * 16 + 8 * lh) * 2);
                      const bf16x8 a0 = *(const LAS bf16x8*)(VTL + (vt0 * 32 + lr) * 144 + (s4 * 16 + 8 * lh) * 2);
                      const bf16x8 a1 = *(const LAS bf16x8*)(VTL + ((vt0 + 1) * 32 + lr) * 144 + (s4 * 16 + 8 * lh) * 2);
                      acc0 = __builtin_amdgcn_mfma_f32_32x32x16_bf16(a0, kb, acc0, 0, 0, 0); acc1 = __builtin_amdgcn_mfma_f32_32x32x16_bf16(a1, kb, acc1, 0, 0, 0); }
                  bf16* kvt = KVT + (size_t)u * 16384 + kt * 32 + lr; const float g = G63[kt * 32 + lr];
#pragma unroll
                  for (int r = 0; r < 16; ++r) { const int vv = 8 * (r >> 2) + 4 * lh + (r & 3);
                      kvt[(size_t)(vt0 * 32 + vv) * 128] = (bf16)(pk2(acc0[r] * g, 0.f) & 0xffffu); kvt[(size_t)((vt0 + 1) * 32 + vv) * 128] = (bf16)(pk2(acc1[r] * g, 0.f) & 0xffffu); } }
                __syncthreads();
            }
        }
#undef HA_REQ
        PHASE_END
        GRID_BAR();
        }
        for (int rep_ = 0; rep_ < REP_M2; ++rep_) {
        PHASE_BEGIN
        for (int item = gtid; item < 32 * 4096; item += NT) {
            const int bh = item >> 12, v = (item >> 5) & 127, k4 = (item & 31) * 4;
            f32x4 S = {0.f, 0.f, 0.f, 0.f};
            for (int c0 = 0; c0 < 64; c0 += 8) {
                f32x4 kv[8], dd[8], ee[8];
#pragma unroll
                for (int j = 0; j < 8; ++j) { const size_t u = (size_t)bh * 64 + c0 + j; kv[j] = ldbf4(KVT + u * 16384 + v * 128 + k4); ee[j] = *(const f32x4*)(DEB + u * 256 + k4); dd[j] = *(const f32x4*)(DEB + u * 256 + 128 + k4); }
#pragma unroll
                for (int j = 0; j < 8; ++j) { const size_t u = (size_t)bh * 64 + c0 + j; const f32x4 sp = S * ee[j]; v2u w; w.x = pk2(sp[0], sp[1]); w.y = pk2(sp[2], sp[3]);
                    *(v2u*)(SPB + u * 16384 + v * 128 + k4) = w; S = S * dd[j] + kv[j]; }
            }
        }
        PHASE_END
        PHASE_BEGIN
        { pg8::Gemm g{CQN, W3, M, N3, SAR, SAR, SAR, 0}; pg8::StaticOrder S; S.init(M, N3, G, blk);
          EpiQ E{QB, QIDX}; pg8::gemm_phase(lds, g, S, E, tid); }
        PHASE_END
        GRID_BAR();
        }
        for (int rep_ = 0; rep_ < REP_M3; ++rep_) {
        PHASE_BEGIN
        {
            LAS unsigned char* QSL = lds;
            LAS unsigned char* KSL = lds + 17408;
            LAS unsigned char* VTL = lds + 34816;
            LAS unsigned char* SPL = lds + 53248;
            LAS unsigned char* AL = lds + 88064;
            LAS float* SSQ = (LAS float*)(lds + 97280);
            const int cp = tid & 63, sg = tid >> 6, lr = lane & 31, lh = lane >> 5;
            v4u rq[2], rk[2], rs[4]; unsigned rv[8]; unsigned short rg[16];
#define HC_REQ(U_) do { int uu_ = (U_); asm volatile("" : "+s"(uu_));   const int bh_ = uu_ >> 6, c_ = uu_ & 63, b_ = bh_ >> 3, h_ = bh_ & 7; const size_t row0_ = (size_t)b_ * SEQ + c_ * 64; const int col0_ = h_ * 128; \
                _Pragma("unroll") for (int j = 0; j < 2; ++j) { const int q = tid + 512 * j, rr = q >> 4, cc = q & 15; \
                    rq[j] = *(const v4u*)(QSB + (row0_ + rr) * 1024 + col0_ + cc * 8); rk[j] = *(const v4u*)(KSB + (row0_ + rr) * 1024 + col0_ + cc * 8); } \
                _Pragma("unroll") for (int j = 0; j < 4; ++j) { const int q = tid + 512 * j, rr = q >> 4, cc = q & 15; rs[j] = *(const v4u*)(SPB + (size_t)uu_ * 16384 + rr * 128 + cc * 8); } \
                _Pragma("unroll") for (int i = 0; i < 8; ++i) rv[i] = *(const unsigned*)(IA + (row0_ + sg * 8 + i) * 1024 + col0_ + 2 * cp); \
                { const int it_ = wave >> 2, vt_ = wave & 3; const int colg_ = col0_ + vt_ * 32 + lr; \
                  _Pragma("unroll") for (int r = 0; r < 16; ++r) { const int ii = it_ * 32 + 8 * (r >> 2) + 4 * lh + (r & 3); rg[r] = GA[(row0_ + ii) * 1024 + colg_]; } } } while (0)
            HC_REQ(blk);
            for (int u = blk; u < 2048; u += G) {
                const int bh = u >> 6, c = u & 63, b = bh >> 3, h = bh & 7;
                const size_t row0 = (size_t)b * SEQ + c * 64; const int col0 = h * 128;
#pragma unroll
                for (int j = 0; j < 2; ++j) { const int q = tid + 512 * j, rr = q >> 4, cc = q & 15;
                    *(LAS v4u*)(QSL + rr * 272 + cc * 16) = rq[j]; *(LAS v4u*)(KSL + rr * 272 + cc * 16) = rk[j]; }
#pragma unroll
                for (int j = 0; j < 4; ++j) { const int q = tid + 512 * j, rr = q >> 4, cc = q & 15; *(LAS v4u*)(SPL + rr * 272 + cc * 16) = rs[j]; }
                { unsigned vw0[4], vw1[4]; float v0p = 0.f, v1p = 0.f;
#pragma unroll
                  for (int i = 0; i < 8; ++i) { const unsigned vw = rv[i];
                      if (i & 1) { vw0[i >> 1] = pk2(v0p, bflo(vw)); vw1[i >> 1] = pk2(v1p, bfhi(vw)); } else { v0p = bflo(vw); v1p = bfhi(vw); } }
                  *(LAS v4u*)(VTL + (2 * cp) * 144 + sg * 16) = (v4u){vw0[0], vw0[1], vw0[2], vw0[3]};
                  *(LAS v4u*)(VTL + (2 * cp + 1) * 144 + sg * 16) = (v4u){vw1[0], vw1[1], vw1[2], vw1[3]}; }
                float gav[16];
#pragma unroll
                for (int r = 0; r < 16; ++r) gav[r] = bf2f(rg[r]);
                HC_REQ(u + G < 2048 ? u + G : u);
                __syncthreads();
                if (wave < 4) {
                    const int it = wave >> 1, jt = wave & 1;
                    f32x16 acc;
#pragma unroll
                    for (int r = 0; r < 16; ++r) acc[r] = 0.f;
                    if (!(it == 0 && jt == 1)) {
#pragma unroll
                        for (int s8 = 0; s8 < 8; ++s8) {
                            const bf16x8 a = *(const LAS bf16x8*)(QSL + (it * 32 + lr) * 272 + (s8 * 16 + 8 * lh) * 2);
                            const bf16x8 bb = *(const LAS bf16x8*)(KSL + (jt * 32 + lr) * 272 + (s8 * 16 + 8 * lh) * 2);
                            acc = __builtin_amdgcn_mfma_f32_32x32x16_bf16(a, bb, acc, 0, 0, 0); } }
                    const int jj = jt * 32 + lr;
#pragma unroll
                    for (int r = 0; r < 16; ++r) { const int ii = it * 32 + 8 * (r >> 2) + 4 * lh + (r & 3); const float x = (jj <= ii) ? acc[r] : 0.f;
                        *(LAS unsigned short*)(AL + ii * 144 + jj * 2) = (unsigned short)(pk2(x, 0.f) & 0xffffu); }
                }
                __syncthreads();
                { const int it = wave >> 2, vt = wave & 3;
                  f32x16 acc;
#pragma unroll
                  for (int r = 0; r < 16; ++r) acc[r] = 0.f;
#pragma unroll
                  for (int s4 = 0; s4 < 4; ++s4) {
                      const bf16x8 a = *(const LAS bf16x8*)(AL + (it * 32 + lr) * 144 + (s4 * 16 + 8 * lh) * 2);
                      const bf16x8 bb = *(const LAS bf16x8*)(VTL + (vt * 32 + lr) * 144 + (s4 * 16 + 8 * lh) * 2);
                      acc = __builtin_amdgcn_mfma_f32_32x32x16_bf16(a, bb, acc, 0, 0, 0); }
#pragma unroll
                  for (int s8 = 0; s8 < 8; ++s8) {
                      const bf16x8 a = *(const LAS bf16x8*)(QSL + (it * 32 + lr) * 272 + (s8 * 16 + 8 * lh) * 2);
                      const bf16x8 bb = *(const LAS bf16x8*)(SPL + (vt * 32 + lr) * 272 + (s8 * 16 + 8 * lh) * 2);
                      acc = __builtin_amdgcn_mfma_f32_32x32x16_bf16(a, bb, acc, 0, 0, 0); }
#pragma unroll
                  for (int r = 0; r < 16; ++r) { float q2 = acc[r] * acc[r];
                      q2 = xsum16(rowsum16(q2));
                      if (lr == 0) SSQ[vt * 64 + it * 32 + 8 * (r >> 2) + 4 * lh + (r & 3)] = q2; }
                  __syncthreads();
                  const int colg = col0 + vt * 32 + lr; const float gg = g_hg[l * 1024 + colg];
#pragma unroll
                  for (int r = 0; r < 16; ++r) { const int ii = it * 32 + 8 * (r >> 2) + 4 * lh + (r & 3);
                      const float ss = SSQ[ii] + SSQ[64 + ii] + SSQ[128 + ii] + SSQ[192 + ii]; const float rn = 1.0f / sqrtf(ss * (1.f / 128.f) + 1e-6f);
                      YAB[(row0 + ii) * 2048 + colg] = (bf16)(pk2(acc[r] * rn * gg * gav[r], 0.f) & 0xffffu); }
                }
                __syncthreads();
            }
        }
#undef HC_REQ
        PHASE_END
        PHASE_BEGIN
        for (int ub = blk * NWAVES; ub < 2048; ub += NGW) {
            const int unit = ub + wave;
            const int b = ub >> 9, j = unit & 511, lr = lane & 31, lh = lane >> 5;
            const int qsel = (lr >> 2) & 1, head = (lr >> 3) * 4 + (lr & 3);
            const int qlo = 4 * j, qhi = 4 * (1023 - j);
            const int nlo = ((qlo >> 6) + 1) * 64, nhi = ((qhi >> 6) + 1) * 64;
            const int nlo8 = (nlo + 511) & ~511, nhi8 = (nhi + 511) & ~511;
            const int nmax8 = (((((4 * (1023 - (ub & 511))) >> 6) + 1) * 64) + 511) & ~511;
            bf16x8 A[4][4]; float W[4][16]; typedef float f32x2_t __attribute__((ext_vector_type(2)));
#pragma unroll
            for (int p = 0; p < 4; ++p) { const size_t qb = (size_t)b * SEQ + (p < 2 ? qlo + 2 * p : qhi + 2 * (p - 2));
#pragma unroll
                for (int ks = 0; ks < 4; ++ks) A[p][ks] = *(const bf16x8*)(QIDX + (qb + qsel) * 1024 + head * 64 + ks * 16 + lh * 8);
#pragma unroll
                for (int r4 = 0; r4 < 4; ++r4) { const f32x4 w = *(const f32x4*)(IDXW + (qb + lh) * 16 + r4 * 4); W[p][r4 * 4] = w[0]; W[p][r4 * 4 + 1] = w[1]; W[p][r4 * 4 + 2] = w[2]; W[p][r4 * 4 + 3] = w[3]; } }
            const bf16* kb = KIDX + (size_t)b * SEQ * 64;
            const int srow = 8 * wave + (lane >> 3), spc = ((lane & 7) ^ ((srow >> 1) & 7)) * 8;
#define P4_STAGE(C0_, BUF_) do { _Pragma("unroll") for (int i = 0; i < 4; ++i) \
                __builtin_amdgcn_global_load_lds((const unsigned*)(kb + (size_t)((C0_) + 64 * i + srow) * 64 + spc), (LAS unsigned*)(lds + (BUF_) * 32768 + (i * 8 + wave) * 1024), 16, 0, 0); } while (0)
            P4_STAGE(0, 0);
            asm volatile("s_waitcnt vmcnt(0)" ::: "memory");
            __syncthreads();
            for (int c0 = 0; c0 < nmax8; c0 += 256) {
                const int cb = (c0 >> 8) & 1; const bool more = c0 + 256 < nmax8;
                if (more) P4_STAGE(c0 + 256, cb ^ 1);
                LAS unsigned char* kbuf = lds + cb * 32768;
#pragma unroll 1
                for (int tl = 0; tl < 8; ++tl) {
                    const int s0 = c0 + tl * 32;
                    if (s0 >= nhi8) break;
#pragma unroll
                    for (int p = 0; p < 4; ++p) { const int np = p < 2 ? nlo : nhi, np8 = p < 2 ? nlo8 : nhi8;
                        if (s0 >= np && s0 < np8) { const size_t q = (size_t)b * SEQ + (p < 2 ? qlo + 2 * p : qhi + 2 * (p - 2)) + lh; ISC[q * 4096 + s0 + lr] = (_Float16)(-60000.0f); } }
                    if (s0 >= nhi) continue;
                    bf16x8 B[4];
#pragma unroll
                    for (int ks = 0; ks < 4; ++ks) B[ks] = *(const LAS bf16x8*)(kbuf + (tl * 32 + lr) * 128 + (((2 * ks + lh) ^ ((lr >> 1) & 7)) * 16));
#define IDX_FINISH(P_, ACC_) do { f32x2_t s2_ = {0.f, 0.f};     \
                        _Pragma("unroll") for (int r = 0; r < 16; r += 2) { const float a0_ = ACC_[r], a1_ = ACC_[r + 1]; const int i0_ = __builtin_bit_cast(int, a0_), i1_ = __builtin_bit_cast(int, a1_); \
                            const f32x2_t rl_ = {__builtin_bit_cast(float, i0_ > 0 ? i0_ : 0), __builtin_bit_cast(float, i1_ > 0 ? i1_ : 0)}; const f32x2_t w_ = {W[P_][r], W[P_][r + 1]}; \
                            s2_ = __builtin_elementwise_fma(rl_, w_, s2_); } \
                        const float sc_ = s2_[0] + s2_[1]; \
                        const size_t q_ = (size_t)b * SEQ + ((P_) < 2 ? qlo + 2 * (P_) : qhi + 2 * ((P_) - 2)) + lh; ISC[q_ * 4096 + s0 + lr] = (_Float16)sc_; } while (0)
                    if (s0 < nlo) {
                        f32x16 c0_, c1_, c2_, c3_;
#pragma unroll
                        for (int r = 0; r < 16; ++r) { c0_[r] = 0.f; c1_[r] = 0.f; c2_[r] = 0.f; c3_[r] = 0.f; }
#pragma unroll
                        for (int ks = 0; ks < 4; ++ks) { c0_ = __builtin_amdgcn_mfma_f32_32x32x16_bf16(A[0][ks], B[ks], c0_, 0, 0, 0); c1_ = __builtin_amdgcn_mfma_f32_32x32x16_bf16(A[1][ks], B[ks], c1_, 0, 0, 0);
                            c2_ = __builtin_amdgcn_mfma_f32_32x32x16_bf16(A[2][ks], B[ks], c2_, 0, 0, 0); c3_ = __builtin_amdgcn_mfma_f32_32x32x16_bf16(A[3][ks], B[ks], c3_, 0, 0, 0); }
                        IDX_FINISH(0, c0_); IDX_FINISH(1, c1_); IDX_FINISH(2, c2_); IDX_FINISH(3, c3_);
                    } else {
                        f32x16 c2_, c3_;
#pragma unroll
                        for (int r = 0; r < 16; ++r) { c2_[r] = 0.f; c3_[r] = 0.f; }
#pragma unroll
                        for (int ks = 0; ks < 4; ++ks) { c2_ = __builtin_amdgcn_mfma_f32_32x32x16_bf16(A[2][ks], B[ks], c2_, 0, 0, 0); c3_ = __builtin_amdgcn_mfma_f32_32x32x16_bf16(A[3][ks], B[ks], c3_, 0, 0, 0); }
                        IDX_FINISH(2, c2_); IDX_FINISH(3, c3_);
                    }
#undef IDX_FINISH
                }
                asm volatile("s_waitcnt vmcnt(0)" ::: "memory");
                __syncthreads();
            }
        }
#undef P4_STAGE
        PHASE_END
        GRID_BAR();
        }
        for (int rep_ = 0; rep_ < REP_P5; ++rep_) {
        PHASE_BEGIN
        {
            LAS unsigned char* VB = lds + wave * 18432;
            LAS unsigned short* SELW = (LAS unsigned short*)(VB + 17408);
            const int hd = lane & 15, g = lane >> 4, qq = hd >> 2, pp = hd & 3;
            const float slope = exp2f(-0.5f * (float)(hd + 1));
            for (int q = gw; q < M; q += NGW) {
                const int b = q / SEQ, pos = q % SEQ, qc = pos >> 6; const int nsel = qc < 4 ? (qc + 1) * 64 : 256;
                for (int rtk_ = 0; rtk_ < REP_TOPK; ++rtk_) {
                int lane_t = lane; asm volatile("" : "+v"(lane_t));
                if (qc < 4) { const unsigned e0 = 4 * lane_t; const bool ok = 4 * lane_t < nsel; v2u z; z.x = ok ? (e0 | ((e0 + 1) << 16)) : 0u; z.y = ok ? ((e0 + 2) | ((e0 + 3) << 16)) : 0u; *(LAS v2u*)(SELW + 4 * lane_t) = z; }
                else {
                    LAS unsigned* HIST = (LAS unsigned*)VB;
                    const int nb8 = (qc + 8) >> 3;
                    float v[64];
#pragma unroll
                    for (int g8 = 0; g8 < 8; ++g8) {
                        if (g8 < nb8) {
#pragma unroll
                            for (int j = 0; j < 8; ++j) v[g8 * 8 + j] = (float)ISC[(size_t)q * 4096 + (g8 * 8 + j) * 64 + lane_t];
                        } else {
#pragma unroll
                            for (int j = 0; j < 8; ++j) v[g8 * 8 + j] = -1.0e30f; } }
                    float vmx = v[0], vmn = fminf(fminf(fminf(v[0], v[1]), fminf(v[2], v[3])), v[4]);
#pragma unroll
                    for (int i = 1; i < 64; ++i) vmx = fmaxf(vmx, v[i]);
                    vmx = wmax_f(vmx); vmn = -wmax_f(-vmn);
                    const float rng = vmx - vmn; const float s20 = rng > 0.f ? 1048574.0f / rng : 0.f;
#define ZERO_HIST() do { *(LAS v4u*)(HIST + 16 * lane) = (v4u){0u, 0u, 0u, 0u}; *(LAS v4u*)(HIST + 16 * lane + 4) = (v4u){0u, 0u, 0u, 0u}; *(LAS v4u*)(HIST + 16 * lane + 8) = (v4u){0u, 0u, 0u, 0u}; \
                        *(LAS v4u*)(HIST + 16 * lane + 12) = (v4u){0u, 0u, 0u, 0u}; HIST[1024 + lane] = 0u; } while (0)
#define SCAN_HIST(R_, BIN_, AB_) do { unsigned hh_[16]; const int hb_ = 1008 - 16 * lane; \
                        { const v4u h0 = *(const LAS v4u*)(HIST + hb_), h1 = *(const LAS v4u*)(HIST + hb_ + 4), h2 = *(const LAS v4u*)(HIST + hb_ + 8), h3 = *(const LAS v4u*)(HIST + hb_ + 12); \
                          hh_[0] = h0.x; hh_[1] = h0.y; hh_[2] = h0.z; hh_[3] = h0.w; hh_[4] = h1.x; hh_[5] = h1.y; hh_[6] = h1.z; hh_[7] = h1.w; hh_[8] = h2.x; hh_[9] = h2.y; hh_[10] = h2.z; hh_[11] = h2.w; hh_[12] = h3.x; hh_[13] = h3.y; hh_[14] = h3.z; hh_[15] = h3.w; } \
                        unsigned tot_ = 0u; _Pragma("unroll") for (int k = 0; k < 16; ++k) tot_ += hh_[k]; \
                        unsigned run_ = wprefix_u(tot_) - tot_; int fb_ = -1; unsigned fa_ = 0u; \
                        _Pragma("unroll") for (int k = 15; k >= 0; --k) { if (run_ < (R_) && run_ + hh_[k] >= (R_)) { fb_ = hb_ + k; fa_ = run_; } run_ += hh_[k]; } \
                        const unsigned long long bm_ = __ballot(fb_ >= 0); const int L_ = (int)__builtin_ctzll(bm_); \
                        BIN_ = (unsigned)__builtin_amdgcn_readlane(fb_, L_); AB_ = (unsigned)__builtin_amdgcn_readlane((int)fa_, L_); } while (0)
                    ZERO_HIST();
#pragma unroll
                    for (int i = 0; i < 64; ++i) v[i] = __builtin_bit_cast(float, (unsigned)((v[i] - vmn) * s20));
#define cd(i_) __builtin_bit_cast(unsigned, v[i_])
#pragma unroll
                    for (int g8 = 0; g8 < 8; ++g8) { if (g8 < nb8) {
#pragma unroll
                        for (int j = 0; j < 8; ++j) __hip_atomic_fetch_add(HIST + (cd(g8 * 8 + j) >> 10), 1u, __ATOMIC_RELAXED, __HIP_MEMORY_SCOPE_WORKGROUP); } }
                    LDS_WAIT(); asm volatile("" ::: "memory");
                    unsigned tb, above; SCAN_HIST(256u, tb, above);
                    ZERO_HIST();
                    LDS_WAIT(); asm volatile("" ::: "memory");
#pragma unroll
                    for (int g8 = 0; g8 < 8; ++g8) { if (g8 < nb8) {
#pragma unroll
                        for (int j = 0; j < 8; ++j) { const unsigned c = cd(g8 * 8 + j); const unsigned a = (c >> 10) == tb ? (c & 1023u) : 1024u + lane; __hip_atomic_fetch_add(HIST + a, 1u, __ATOMIC_RELAXED, __HIP_MEMORY_SCOPE_WORKGROUP); } } }
                    LDS_WAIT(); asm volatile("" ::: "memory");
                    unsigned tb2, ab2; { const unsigned R2 = 256u - above; SCAN_HIST(R2, tb2, ab2); }
                    const unsigned T = (tb << 10) | tb2; above += ab2;
                    unsigned baseg = 0u, basee = above;
#pragma unroll
                    for (int g8 = 0; g8 < 8; ++g8) { if (g8 < nb8) {
#pragma unroll
                        for (int j = 0; j < 8; ++j) { const int i = g8 * 8 + j;
                            const bool gt = cd(i) > T; const unsigned long long bg = __ballot(gt);
                            const unsigned pgp = baseg + __builtin_amdgcn_mbcnt_hi((unsigned)(bg >> 32), __builtin_amdgcn_mbcnt_lo((unsigned)bg, 0u));
                            if (gt) SELW[pgp] = (unsigned short)(i * 64 + lane);
                            baseg += (unsigned)__popcll(bg);
                            const bool eq = cd(i) == T; const unsigned long long be = __ballot(eq);
                            if (be) { const unsigned pep = basee + __builtin_amdgcn_mbcnt_hi((unsigned)(be >> 32), __builtin_amdgcn_mbcnt_lo((unsigned)be, 0u));
                                if (eq && pep < 256u) SELW[pep] = (unsigned short)(i * 64 + lane);
                                basee += (unsigned)__popcll(be); } } } }
#undef cd
#undef ZERO_HIST
#undef SCAN_HIST
                }
                LDS_WAIT(); asm volatile("" ::: "memory");
                }
                for (int rat_ = 0; rat_ < REP_ATT; ++rat_) {
                bf16* qrow = QB + (size_t)q * 4096;
                bf16x8 Bq[8];
#pragma unroll
                for (int ks = 0; ks < 8; ++ks) Bq[ks] = *(const bf16x8*)(qrow + hd * 256 + ks * 32 + g * 8);
                const bf16* kvb = CKV + (size_t)b * SEQ * 256;
                f32x4 O[16];
#pragma unroll
                for (int ct = 0; ct < 16; ++ct) O[ct] = (f32x4){0.f, 0.f, 0.f, 0.f};
                float mrun = -1.0e30f, lsum = 0.f;
                LDS_WAIT(); asm volatile("" ::: "memory");
                const int nks = nsel >> 5;
                const int lrow = lane >> 5, lcp = lane & 31;
                v4u KR[16];
#define ATT_LOADROWS(KST_) do { _Pragma("unroll") for (int i = 0; i < 16; ++i) { const int rr_ = 2 * i + lrow; const int ix_ = SELW[32 * (KST_) + rr_]; \
                    KR[i] = *(const v4u*)(kvb + (size_t)ix_ * 256 + ((lcp ^ (rr_ & 7)) * 8)); } } while (0)
                ATT_LOADROWS(0);
                const int rlA = hd & 7;
                const int rlT = (4 * g + qq) & 7;
                const int trb = (4 * g + qq) * 512 + 8 * (pp & 1), trm = 16 * ((pp >> 1) ^ rlT);
                for (int kst = 0; kst < nks; ++kst) {
                    int rlA_ = rlA, trm_ = trm; asm volatile("" : "+v"(rlA_), "+v"(trm_));
                    if (kst + 1 < nks) {
#pragma unroll
                        for (int i = 0; i < 16; ++i) { *(LAS v4u*)(VB + i * 1024 + lane * 16) = KR[i];
                            const int rr_ = 2 * i + lrow; const int ix_ = SELW[32 * (kst + 1) + rr_]; KR[i] = *(const v4u*)(kvb + (size_t)ix_ * 256 + ((lcp ^ (rr_ & 7)) * 8)); }
                    } else {
#pragma unroll
                        for (int i = 0; i < 16; ++i) *(LAS v4u*)(VB + i * 1024 + lane * 16) = KR[i]; }
                    LDS_WAIT(); asm volatile("" ::: "memory");
                    f32x4 S0 = {0.f, 0.f, 0.f, 0.f}, S1 = {0.f, 0.f, 0.f, 0.f};
#pragma unroll
                    for (int k4 = 0; k4 < 4; ++k4) {
                        bf16x8 a0[2], a1[2];
#pragma unroll
                        for (int j = 0; j < 2; ++j) { const int ks = k4 * 2 + j; const int cpos = (4 * ks + g) ^ rlA_;
                            a0[j] = *(const LAS bf16x8*)(VB + hd * 512 + cpos * 16); a1[j] = *(const LAS bf16x8*)(VB + (16 + hd) * 512 + cpos * 16); }
#pragma unroll
                        for (int j = 0; j < 2; ++j) { const int ks = k4 * 2 + j;
                            S0 = __builtin_amdgcn_mfma_f32_16x16x32_bf16(a0[j], Bq[ks], S0, 0, 0, 0); S1 = __builtin_amdgcn_mfma_f32_16x16x32_bf16(a1[j], Bq[ks], S1, 0, 0, 0); }
                    }
                    const v2u pa = *(const LAS v2u*)(SELW + 32 * kst + 4 * g), pb = *(const LAS v2u*)(SELW + 32 * kst + 16 + 4 * g);
                    const float fp = (float)pos;
                    float s0[4], s1[4];
                    s0[0] = S0[0] - slope * fabsf(fp - (float)(pa.x & 0xffffu)); s0[1] = S0[1] - slope * fabsf(fp - (float)(pa.x >> 16));
                    s0[2] = S0[2] - slope * fabsf(fp - (float)(pa.y & 0xffffu)); s0[3] = S0[3] - slope * fabsf(fp - (float)(pa.y >> 16));
                    s1[0] = S1[0] - slope * fabsf(fp - (float)(pb.x & 0xffffu)); s1[1] = S1[1] - slope * fabsf(fp - (float)(pb.x >> 16));
                    s1[2] = S1[2] - slope * fabsf(fp - (float)(pb.y & 0xffffu)); s1[3] = S1[3] - slope * fabsf(fp - (float)(pb.y >> 16));
                    float ml = fmaxf(fmaxf(fmaxf(s0[0], s0[1]), fmaxf(s0[2], s0[3])), fmaxf(fmaxf(s1[0], s1[1]), fmaxf(s1[2], s1[3])));
                    ml = xmax16(ml); ml = xmax32(ml);
                    const float mnew = fmaxf(mrun, ml), alpha = __expf(mrun - mnew); mrun = mnew;
                    float p0[4], p1[4];
#pragma unroll
                    for (int r = 0; r < 4; ++r) { p0[r] = __expf(s0[r] - mnew); p1[r] = __expf(s1[r] - mnew); }
                    lsum = lsum * alpha + ((p0[0] + p0[1]) + (p0[2] + p0[3])) + ((p1[0] + p1[1]) + (p1[2] + p1[3]));
                    v4u pw; pw.x = pk2(p0[0], p0[1]); pw.y = pk2(p0[2], p0[3]); pw.z = pk2(p1[0], p1[1]); pw.w = pk2(p1[2], p1[3]);
                    const bf16x8 Pf = __builtin_bit_cast(bf16x8, pw);
#pragma unroll
                    for (int ct = 0; ct < 16; ++ct) O[ct] = O[ct] * alpha;
#pragma unroll
                    for (int c8 = 0; c8 < 4; ++c8) {
                        v4s lo[4], hi[4];
#pragma unroll
                        for (int j = 0; j < 4; ++j) { const int ct = c8 * 4 + j; const int off = trb + ((32 * ct) ^ trm_);
                            lo[j] = __builtin_amdgcn_ds_read_tr16_b64_v4i16((LAS v4s*)(VB + off));
                            hi[j] = __builtin_amdgcn_ds_read_tr16_b64_v4i16((LAS v4s*)(VB + 16 * 512 + off)); }
#pragma unroll
                        for (int j = 0; j < 4; ++j) { const int ct = c8 * 4 + j;
                            const bf16x8 Af = {lo[j][0], lo[j][1], lo[j][2], lo[j][3], hi[j][0], hi[j][1], hi[j][2], hi[j][3]};
                            O[ct] = __builtin_amdgcn_mfma_f32_16x16x32_bf16(Af, Pf, O[ct], 0, 0, 0); }
                    }
                    LDS_WAIT(); asm volatile("" ::: "memory");
                }
#undef ATT_LOADROWS
                lsum = xsum16(lsum); lsum = xsum32(lsum);
                const float inv = 1.0f / lsum;
#pragma unroll
                for (int ct = 0; ct < 16; ++ct) { const f32x4 o = O[ct] * inv; v2u w; w.x = pk2(o[0], o[1]); w.y = pk2(o[2], o[3]); *(v2u*)(OB + (size_t)q * 4096 + hd * 256 + 16 * ct + 4 * g) = w; }
                }
            }
        }
        PHASE_END
        GRID_BAR();
        }
        PHASE_BEGIN
        { pg8::Gemm g{OB, W6, M, 1024, 1024, 4096, 1024, 1024}; pg8::StaticOrder S; S.init(M, 1024, G, blk);
          EpiBf E{YAB, 2048, 1024}; pg8::gemm_phase(lds, g, S, E, tid); }
        PHASE_END
        GRID_BAR();
        PHASE_BEGIN
        { pg8::Gemm g{YAB, W7, M, DM, DM, DM, DM, 0}; pg8::StaticOrder S; S.init(M, DM, G, blk);
          EpiGateM E{GTB, MRG}; HookGate Hk{GTA, GTB}; pg8::gemm_phase(lds, g, S, E, tid, Hk); }
        PHASE_END
        GRID_BAR();
        PHASE_BEGIN
        { pg8::Gemm g{MRG, W8, M, DM, DM, DM, DM, 0}; pg8::StaticOrder S; S.init(M, DM, G, blk);
          EpiRes E{(l == 0) ? x_in : (const float*)nullptr, XB, RB, modl + 2 * DM}; pg8::gemm_phase(lds, g, S, E, tid); }
        PHASE_END
        GRID_BAR();
        for (int rep_ = 0; rep_ < REP_P9; ++rep_) {
        PHASE_BEGIN
        f32x4 lg[8], lb_[8]; v2u nx[8];
#pragma unroll
        for (int j = 0; j < 8; ++j) { const int c = j * 256 + lane * 4; lg[j] = *(const f32x4*)(ln1_g + l * DM + c); lb_[j] = *(const f32x4*)(ln1_b + l * DM + c); nx[j] = *(const v2u*)(RB + (size_t)gw * DM + c); }
        for (int row = gw; row < M; row += NGW) {
            const int b = row / SEQ; const float* md = modl + (size_t)b * MODW;
            f32x4 v[8]; float s = 0.f;
#pragma unroll
            for (int j = 0; j < 8; ++j) { v[j] = (f32x4){bflo(nx[j].x), bfhi(nx[j].x), bflo(nx[j].y), bfhi(nx[j].y)}; s += (v[j][0] + v[j][1]) + (v[j][2] + v[j][3]); }
            { const int rn = row + NGW < M ? row + NGW : row;
#pragma unroll
              for (int j = 0; j < 8; ++j) nx[j] = *(const v2u*)(RB + (size_t)rn * DM + j * 256 + lane * 4); }
            const float mean = wave_sum(s) * (1.f / DM); float s2 = 0.f;
#pragma unroll
            for (int j = 0; j < 8; ++j) { v[j] = v[j] - mean; s2 += (v[j][0] * v[j][0] + v[j][1] * v[j][1]) + (v[j][2] * v[j][2] + v[j][3] * v[j][3]); }
            const float rstd = 1.0f / sqrtf(wave_sum(s2) * (1.f / DM) + 1e-5f);
#pragma unroll
            for (int j = 0; j < 8; ++j) { const int c = j * 256 + lane * 4; const f32x4 gg = lg[j], bb = lb_[j];
                const f32x4 y = v[j] * rstd * gg + bb; { v2u wx; wx.x = pk2(y[0], y[1]); wx.y = pk2(y[2], y[3]); *(v2u*)(XB + (size_t)row * DM + c) = wx; }
                const f32x4 sc = *(const f32x4*)(md + 4 * DM + c), sh = *(const f32x4*)(md + 3 * DM + c); const f32x4 hh = y * (sc + 1.f) + sh;
                v2u w; w.x = pk2(hh[0], hh[1]); w.y = pk2(hh[2], hh[3]); *(v2u*)(HB + (size_t)row * DM + c) = w; }
        }
        PHASE_END
        GRID_BAR();
        }
        PHASE_BEGIN
        { pg8::Gemm g{HB, W10, M, N10, DM, DM, DM, 0}; pg8::StaticOrder S; S.init(M, N10, G, blk);
          EpiSwiglu E{ACT}; pg8::gemm_phase(lds, g, S, E, tid); }
        PHASE_END
        GRID_BAR();
        PHASE_BEGIN
        { pg8::Gemm g{ACT, W11, M, DM, DFF, DFF, DFF, 0}; pg8::StaticOrder S; S.init(M, DM, G, blk);
          EpiRes E{(const float*)nullptr, XB, RB, modl + 5 * DM}; pg8::gemm_phase(lds, g, S, E, tid); }
        PHASE_END
        GRID_BAR();
        for (int rep_ = 0; rep_ < REP_P12; ++rep_) {
        PHASE_BEGIN
        {
            const bool lastl = (l == DEPTH - 1); const float* mdn = MOD + (size_t)(l + 1 < DEPTH ? l + 1 : l) * NBATCH * MODW;
            f32x4 lg[8], lb_[8]; v2u nx[8];
#pragma unroll
            for (int j = 0; j < 8; ++j) { const int c = j * 256 + lane * 4; lg[j] = *(const f32x4*)(ln2_g + l * DM + c); lb_[j] = *(const f32x4*)(ln2_b + l * DM + c); nx[j] = *(const v2u*)(RB + (size_t)gw * DM + c); }
            for (int row = gw; row < M; row += NGW) {
                const int b = row / SEQ; const float* md = mdn + (size_t)b * MODW;
                f32x4 v[8]; float s = 0.f;
#pragma unroll
                for (int j = 0; j < 8; ++j) { v[j] = (f32x4){bflo(nx[j].x), bfhi(nx[j].x), bflo(nx[j].y), bfhi(nx[j].y)}; s += (v[j][0] + v[j][1]) + (v[j][2] + v[j][3]); }
                { const int rn = row + NGW < M ? row + NGW : row;
#pragma unroll
                  for (int j = 0; j < 8; ++j) nx[j] = *(const v2u*)(RB + (size_t)rn * DM + j * 256 + lane * 4); }
                const float mean = wave_sum(s) * (1.f / DM); float s2 = 0.f;
#pragma unroll
                for (int j = 0; j < 8; ++j) { v[j] = v[j] - mean; s2 += (v[j][0] * v[j][0] + v[j][1] * v[j][1]) + (v[j][2] * v[j][2] + v[j][3] * v[j][3]); }
                const float rstd = 1.0f / sqrtf(wave_sum(s2) * (1.f / DM) + 1e-5f);
#pragma unroll
                for (int j = 0; j < 8; ++j) { const int c = j * 256 + lane * 4; const f32x4 gg = lg[j], bb = lb_[j];
                    const f32x4 y = v[j] * rstd * gg + bb; if (lastl) *(f32x4*)(args.out + (size_t)row * DM + c) = y; else { v2u wx; wx.x = pk2(y[0], y[1]); wx.y = pk2(y[2], y[3]); *(v2u*)(XB + (size_t)row * DM + c) = wx; }
                    const f32x4 sc = *(const f32x4*)(md + DM + c), sh = *(const f32x4*)(md + c); const f32x4 hh = y * (sc + 1.f) + sh;
                    v2u w; w.x = pk2(hh[0], hh[1]); w.y = pk2(hh[2], hh[3]); *(v2u*)(HB + (size_t)row * DM + c) = w; }
            }
            if (l + 1 < DEPTH) { __syncthreads(); CONVERT_LAYER(l + 1); }
        }
        PHASE_END
        if (l + 1 < DEPTH || rep_ + 1 < REP_P12) GRID_BAR();
        }
    }
}

extern "C" void kernel_launch(void* const* d_in, const int* in_sizes, int n_in, void* d_out, int out_size, void* d_ws, size_t ws_size, hipStream_t stream) {
    static int grid = 0;
    if (grid == 0) {
        if (n_in != 22 || out_size != M * DM || ws_size < WS_END) { fprintf(stderr, "kernel_launch: unexpected shapes (n_in %d, out %d, ws %zu < %zu)\n", n_in, out_size, ws_size, (size_t)WS_END); grid = -1; return; }
        int dev = 0, cus = 0, per_cu = 0;
        if (hipGetDevice(&dev) != hipSuccess || hipDeviceGetAttribute(&cus, hipDeviceAttributeMultiprocessorCount, dev) != hipSuccess) { grid = -1; return; }
        if (hipFuncSetAttribute((const void*)fwd_kernel, hipFuncAttributeMaxDynamicSharedMemorySize, LDS_BYTES) != hipSuccess) { fprintf(stderr, "kernel_launch: hipFuncSetAttribute failed\n"); grid = -1; return; }
        if (hipOccupancyMaxActiveBlocksPerMultiprocessor(&per_cu, (const void*)fwd_kernel, NTHR, LDS_BYTES) != hipSuccess || per_cu < 1) { fprintf(stderr, "kernel_launch: occupancy query says %d\n", per_cu); }
        (void)hipGetLastError();
        grid = cus;
    }
    if (grid < 0) return;
    if (hipMemsetAsync((char*)d_ws + WS_CTL, 0, CTL_ZERO_BYTES, stream) != hipSuccess) return;
    Args a{};
    for (int i = 0; i < 22; ++i) a.in[i] = (const float*)d_in[i];
    a.out = (float*)d_out; a.ws = (unsigned char*)d_ws;
    hipLaunchKernelGGL(fwd_kernel, dim3(grid), dim3(NTHR), LDS_BYTES, stream, a);
}
```

```cpp
#include <hip/hip_runtime.h>
#include <cstdio>
#include <cstdint>

namespace pg8 {
#define PG8_LAS __attribute__((address_space(3)))
typedef unsigned short bf16_t;
typedef short bf16x8 __attribute__((ext_vector_type(8)));
typedef float f32x4 __attribute__((ext_vector_type(4)));
typedef unsigned u32x4 __attribute__((ext_vector_type(4)));
constexpr int BM = 256, BK = 64, HALF = 128, HTB = HALF * BK * 2, STAGE_BYTES = 8 * HTB, NXCD = 8, WGM = 8;

__host__ __device__ __forceinline__ int lds_byte(int r, int c) { const int st = (r >> 4) * 2 + (c >> 5), rr = r & 15, cc = c & 31, ob = rr * 64 + cc * 2; return st * 1024 + (ob ^ (((ob >> 9) & 1) << 5)); }
__host__ __device__ __forceinline__ void stage_rc(int b, int& R, int& C) { const int st = b / 1024, sb = b % 1024, swz = sb ^ (((sb >> 9) & 1) << 5); R = (st >> 1) * 16 + swz / 64; C = (st & 1) * 32 + (swz % 64) / 2; }
__host__ __device__ __forceinline__ int perm32(int rho) { const int n = rho >> 4, i = rho & 15; return 8 * (i >> 2) + 4 * n + (i & 3); }

struct Unit { int pm, pn; };
struct Gemm { const bf16_t* A; const bf16_t* Bt; int M, N, K, lda, ldb, a_pn_stride; };

struct StaticOrder {
    int nM, nN, nwg, G, c;
    __host__ __device__ void init(int M, int N, int G_, int c_) { nM = M / BM; nN = N / BM; nwg = nM * nN; G = G_; c = c_; }
    __host__ __device__ bool next(int i, Unit& u) const {
        const long L = (long)i * G + c; if (L >= nwg) return false;
        int wgid = (int)L; { const int q = nwg / NXCD, r = nwg % NXCD, xcd = wgid % NXCD, off = wgid / NXCD; wgid = (xcd < r ? xcd * (q + 1) : r * (q + 1) + (xcd - r) * q) + off; }
        const int nig = WGM * nN, gid = wgid / nig, fm = gid * WGM, gsz = (nM - fm) < WGM ? (nM - fm) : WGM;
        u.pm = fm + ((wgid % nig) % gsz); u.pn = (wgid % nig) / gsz; return true;
    }
};

typedef float f32x2_t __attribute__((ext_vector_type(2))); typedef __bf16 bf16x2_t __attribute__((ext_vector_type(2)));
__device__ __forceinline__ unsigned cvt_pk_bf16(float lo, float hi) { f32x2_t v = {lo, hi}; bf16x2_t b = __builtin_convertvector(v, bf16x2_t); return __builtin_bit_cast(unsigned, b); }

struct NoHook { static constexpr bool ON = false; template <class A> __device__ __forceinline__ void mid(A&, const Unit&, int, int, int, int) const {} };
template <class Epi, class Hook = NoHook>
__device__ __forceinline__ void gemm_phase(PG8_LAS unsigned char* lds, const Gemm g, const StaticOrder& S, const Epi& E, const int tid, const Hook H = Hook()) {
    const int wid = __builtin_amdgcn_readfirstlane(tid >> 6), lane = tid & 63, wr = wid >> 2, wc = wid & 3, fr = lane & 15, fq = lane >> 4;
    const int K = g.K, nt = K / BK;
    unsigned voffA[2], voffB[2];
#pragma unroll
    for (int i = 0; i < 2; ++i) { int R, C; stage_rc(tid * 16 + i * 8192, R, C); const int Rb = 64 * (R >> 5) + perm32(R & 31);
        voffA[i] = (unsigned)(R * g.lda + C) * 2u; voffB[i] = (unsigned)(Rb * g.ldb + C) * 2u; }
    const size_t kstep = (size_t)(BK * 2);
    const size_t hstepA = (size_t)HALF * g.lda * 2, hstepB = (size_t)32 * g.ldb * 2;
    const size_t tstepA = 2 * hstepA, tstepB = (size_t)BM * g.ldb * 2;
    const unsigned ldsw = (unsigned)wid * 1024u;
    const int aoff = lds_byte(wr * 64 + fr, fq * 8), boff = lds_byte(wc * 32 + fr, fq * 8);
#define PG8_SA(b, h) (((b) * 2 + (h)) * HTB)
#define PG8_SB(b, h) ((4 + (b) * 2 + (h)) * HTB)
#define PG8_STAGE(bufoff, gbase, voff) do { _Pragma("unroll") for (int _i = 0; _i < 2; ++_i) \
        __builtin_amdgcn_global_load_lds((const unsigned*)((const char*)(gbase) + (voff)[_i]), (PG8_LAS unsigned*)(lds + (bufoff) + ldsw + _i * 8192), 16, 0, 0); } while (0)
#define PG8_LDA(dst, b, h) do { _Pragma("unroll") for (int m = 0; m < 4; ++m) _Pragma("unroll") for (int k = 0; k < 2; ++k) dst[m][k] = *(const PG8_LAS bf16x8*)(lds + PG8_SA(b, h) + aoff + m * 2048 + k * 1024); } while (0)
#define PG8_LDB(dst, b, h) do { _Pragma("unroll") for (int n = 0; n < 2; ++n) _Pragma("unroll") for (int k = 0; k < 2; ++k) dst[n][k] = *(const PG8_LAS bf16x8*)(lds + PG8_SB(b, h) + boff + n * 2048 + k * 1024); } while (0)
#define PG8_MMA(ai, bj, At, Bt) do { __builtin_amdgcn_s_setprio(1); _Pragma("unroll") for (int m = 0; m < 4; ++m) _Pragma("unroll") for (int n = 0; n < 2; ++n) _Pragma("unroll") for (int k = 0; k < 2; ++k) \
        acc[ai][bj][m][n] = __builtin_amdgcn_mfma_f32_16x16x32_bf16(Bt[n][k], At[m][k], acc[ai][bj][m][n], 0, 0, 0); __builtin_amdgcn_s_setprio(0); } while (0)
#define PG8_WAIT_V(n) asm volatile("s_waitcnt vmcnt(" #n ")" ::: "memory")
#define PG8_WAIT_L(n) asm volatile("s_waitcnt lgkmcnt(" #n ")" ::: "memory")
#define PG8_BAR __builtin_amdgcn_s_barrier()
#define PG8_SCHED __builtin_amdgcn_sched_barrier(0)
    Unit cur, nxt; int ui = 0;
    if (!S.next(0, cur)) return;
    f32x4 acc[2][2][4][2];
#pragma unroll
    for (int a = 0; a < 2; ++a)
#pragma unroll
        for (int b = 0; b < 2; ++b)
#pragma unroll
            for (int m = 0; m < 4; ++m)
#pragma unroll
                for (int n = 0; n < 2; ++n) acc[a][b][m][n] = (f32x4){0.f, 0.f, 0.f, 0.f};
    bf16x8 At[4][2], B0[2][2], B1[2][2];
    const char* cA = (const char*)g.A + (size_t)cur.pm * tstepA + (size_t)cur.pn * g.a_pn_stride * 2; const char* cB = (const char*)g.Bt + (size_t)cur.pn * tstepB;
    PG8_STAGE(PG8_SB(0, 0), cB, voffB); PG8_STAGE(PG8_SB(0, 1), cB + hstepB, voffB); PG8_STAGE(PG8_SA(0, 0), cA, voffA); PG8_STAGE(PG8_SA(0, 1), cA + hstepA, voffA);
    if (wr == 1) PG8_BAR;
    PG8_WAIT_V(2); PG8_BAR;
    PG8_STAGE(PG8_SB(1, 0), cB + kstep, voffB); PG8_STAGE(PG8_SA(1, 0), cA + kstep, voffA); PG8_STAGE(PG8_SB(1, 1), cB + hstepB + kstep, voffB);
    PG8_WAIT_V(6); PG8_BAR;
    for (;;) {
        const bool has_next = S.next(ui + 1, nxt);
        const char* nA = has_next ? (const char*)g.A + (size_t)nxt.pm * tstepA + (size_t)nxt.pn * g.a_pn_stride * 2 : cA; const char* nB = has_next ? (const char*)g.Bt + (size_t)nxt.pn * tstepB : cB;
        for (int t = 0; t < nt; t += 2) {
            const bool last = (t == nt - 2);
            const char* a1 = cA + (size_t)(t + 1) * kstep;
            const char* a2 = last ? nA : cA + (size_t)(t + 2) * kstep; const char* b2 = last ? nB : cB + (size_t)(t + 2) * kstep;
            const char* a3 = a2 + kstep; const char* b3 = b2 + kstep;
            if constexpr (Hook::ON) { if (t == (nt >> 1)) H.mid(acc, cur, wr, wc, fr, fq); }
            PG8_LDB(B0, 0, 0); PG8_LDB(B1, 0, 1); PG8_SCHED; PG8_LDA(At, 0, 0); PG8_STAGE(PG8_SA(1, 1), a1 + hstepA, voffA);
            PG8_WAIT_V(8); PG8_WAIT_L(0); PG8_BAR; PG8_MMA(0, 0, At, B0); PG8_MMA(0, 1, At, B1); PG8_BAR; PG8_SCHED;
            PG8_LDA(At, 0, 1); PG8_STAGE(PG8_SB(0, 0), b2, voffB); PG8_STAGE(PG8_SB(0, 1), b2 + hstepB, voffB); PG8_STAGE(PG8_SA(0, 0), a2, voffA);
            PG8_WAIT_V(8); PG8_WAIT_L(0); PG8_BAR; PG8_MMA(1, 0, At, B0); PG8_MMA(1, 1, At, B1); PG8_BAR; PG8_SCHED;
            PG8_LDB(B0, 1, 0); PG8_LDB(B1, 1, 1); PG8_SCHED; PG8_LDA(At, 1, 0); PG8_STAGE(PG8_SA(0, 1), a2 + hstepA, voffA);
            PG8_WAIT_V(8); PG8_WAIT_L(0); PG8_BAR; PG8_MMA(0, 0, At, B0); PG8_MMA(0, 1, At, B1); PG8_BAR; PG8_SCHED;
            PG8_LDA(At, 1, 1); PG8_STAGE(PG8_SB(1, 0), b3, voffB); PG8_STAGE(PG8_SB(1, 1), b3 + hstepB, voffB); PG8_STAGE(PG8_SA(1, 0), a3, voffA);
            PG8_WAIT_V(8); PG8_WAIT_L(0); PG8_BAR; PG8_MMA(1, 0, At, B0); PG8_MMA(1, 1, At, B1); PG8_BAR; PG8_SCHED;
        }
        if (wr == 0) PG8_BAR;
        E(acc, cur, wr, wc, fr, fq);
        if (!has_next) break;
#pragma unroll
        for (int a = 0; a < 2; ++a)
#pragma unroll
            for (int b = 0; b < 2; ++b)
#pragma unroll
                for (int m = 0; m < 4; ++m)
#pragma unroll
                    for (int n = 0; n < 2; ++n) acc[a][b][m][n] = (f32x4){0.f, 0.f, 0.f, 0.f};
        cur = nxt; cA = nA; cB = nB; ++ui;
        if (wr == 1) PG8_BAR;
    }
    PG8_WAIT_V(0);
    PG8_BAR;
#undef PG8_SA
#undef PG8_SB
#undef PG8_STAGE
#undef PG8_LDA
#undef PG8_LDB
#undef PG8_MMA
#undef PG8_WAIT_V
#undef PG8_WAIT_L
#undef PG8_BAR
#undef PG8_SCHED
}
}

constexpr int NWAVES = 8, NTHR = NWAVES * 64;
constexpr int DM = 2048, NBATCH = 4, SEQ = 4096, DEPTH = 4, M = NBATCH * SEQ;
constexpr int HGW = 1024;
constexpr int SAH = 16, SAC = 256, SAR = 512;
constexpr int DFF = 5632;
constexpr int N1 = 9216, N3 = 5120, N10 = 2 * DFF;
constexpr float ALPHA = 1.6817928305074292f;
constexpr int MODW = 6 * DM;

constexpr size_t MiB = 1u << 20;
constexpr size_t WS_CTL = 0, CTL_ZERO_BYTES = 32768;
constexpr size_t WS_MOD = 1 * MiB;
constexpr size_t WS_LB = 2 * MiB;
constexpr size_t WS_MODP = 3 * MiB;
constexpr size_t WS_W1 = 9 * MiB;
constexpr size_t WS_W3 = WS_W1 + 36 * MiB;
constexpr size_t WS_W6 = WS_W3 + 5 * MiB;
constexpr size_t WS_W7 = WS_W6 + 2 * MiB;
constexpr size_t WS_W8 = WS_W7 + 8 * MiB;
constexpr size_t WS_W10 = WS_W8 + 8 * MiB;
constexpr size_t WS_W11 = WS_W10 + 44 * MiB;
constexpr size_t WS_X = WS_W11 + 22 * MiB;
constexpr size_t WS_R = WS_X + 128 * MiB;
constexpr size_t WS_H = WS_R + 128 * MiB;
constexpr size_t WS_QA = WS_H + 64 * MiB;
constexpr size_t WS_FA = WS_QA + 32 * MiB;
constexpr size_t WS_IA = WS_FA + 64 * MiB;
constexpr size_t WS_GA = WS_IA + 32 * MiB;
constexpr size_t WS_LAT = WS_GA + 32 * MiB;
constexpr size_t WS_GTA = WS_LAT + 64 * MiB;
constexpr size_t WS_GTB = WS_GTA + 64 * MiB;
constexpr size_t WS_CQN = WS_GTB + 64 * MiB;
constexpr size_t WS_CKV = WS_CQN + 16 * MiB;
constexpr size_t WS_KIDX = WS_CKV + 8 * MiB;
constexpr size_t WS_IDXW = WS_KIDX + 2 * MiB;
constexpr size_t WS_QB = WS_IDXW + 1 * MiB;
constexpr size_t WS_QIDX = WS_QB + 128 * MiB;
constexpr size_t WS_SEL = WS_QIDX + 32 * MiB;
constexpr size_t WS_YAB = WS_SEL + 8 * MiB;
constexpr size_t WS_MRG = WS_FA;
constexpr size_t WS_OB = WS_YAB + 64 * MiB;
constexpr size_t WS_BIG = WS_OB + 128 * MiB;
constexpr size_t WS_KSB = WS_BIG + 256 * MiB;
constexpr size_t WS_DEB = WS_KSB + 32 * MiB;
constexpr size_t WS_QSB = WS_DEB + 2 * MiB;
constexpr size_t WS_END = WS_QSB + 32 * MiB;

constexpr int CW_BAR = 4096;

constexpr int RING_BYTES = 131072;
constexpr int LDS_BYTES = 163840;
constexpr int LDSCTL_OFF = LDS_BYTES - 1024, MISC_OFF = LDSCTL_OFF + 320, SELL_OFF = 147456;

#define GAS __attribute__((address_space(1)))
#define LAS __attribute__((address_space(3)))
typedef unsigned short bf16;
typedef unsigned v4u __attribute__((ext_vector_type(4)));
typedef unsigned v2u __attribute__((ext_vector_type(2)));
typedef float f32x4 __attribute__((ext_vector_type(4)));
typedef float f32x16 __attribute__((ext_vector_type(16)));
typedef short bf16x8 __attribute__((ext_vector_type(8)));
typedef short v4s __attribute__((ext_vector_type(4)));
typedef GAS unsigned gu32;
#define LDS_WAIT() asm volatile("s_waitcnt lgkmcnt(0)" ::: "memory")
__device__ __forceinline__ unsigned f2bf(float f) { unsigned u = __builtin_bit_cast(unsigned, f); return (u + 0x7fffu + ((u >> 16) & 1u)) >> 16; }
__device__ __forceinline__ unsigned pk2(float lo, float hi) { return pg8::cvt_pk_bf16(lo, hi); }
__device__ __forceinline__ float bf2f(unsigned short b) { return __builtin_bit_cast(float, ((unsigned)b) << 16); }
__device__ __forceinline__ float bflo(unsigned w) { return __builtin_bit_cast(float, w << 16); }
__device__ __forceinline__ float bfhi(unsigned w) { return __builtin_bit_cast(float, w & 0xffff0000u); }
__device__ __forceinline__ float sigm(float x) { return __builtin_amdgcn_rcpf(1.f + __expf(-x)); }

__device__ __forceinline__ int lane_id() { unsigned m = ~0u; asm volatile("" : "+s"(m)); return (int)__builtin_amdgcn_mbcnt_hi(m, __builtin_amdgcn_mbcnt_lo(m, 0u)); }
#define XB_TMO      128
#define XB_XCNT(j)  (256  + 64 * (j))
#define XB_XSUB(j)  (1280 + 64 * (j))
#define XB_XGEN(j)  (2304 + 64 * (j))
#define XB_TOP      3328
#define XB_TOPGEN   3392
#define XCD_BAR_WORDS 3456
#define XB_SPIN_CAP (1u << 22)

__device__ __forceinline__ unsigned xb_ld(unsigned* p)              { return __hip_atomic_load(p, __ATOMIC_RELAXED, __HIP_MEMORY_SCOPE_AGENT); }
__device__ __forceinline__ unsigned xb_add(unsigned* p, unsigned v) { return __hip_atomic_fetch_add(p, v, __ATOMIC_RELAXED, __HIP_MEMORY_SCOPE_AGENT); }
__device__ __forceinline__ unsigned xb_xcc_id() { return (unsigned)__builtin_amdgcn_s_getreg((3 << 11) | 20) & 0xFu; }
#define XB_SPIN(cond, bar) do { unsigned _sp = 0; while (cond) { __builtin_amdgcn_s_sleep(1); \
    if ((++_sp & 255u) == 0u) { if (xb_ld(&(bar)[XB_TMO])) break; if (_sp > XB_SPIN_CAP) { atomicAdd(&(bar)[XB_TMO], 1u); break; } } } } while (0)

struct XcdBarrier { unsigned* bar; unsigned x; volatile LAS unsigned* st; int wave; };

__device__ __forceinline__ XcdBarrier xcd_barrier_post(unsigned* bar, volatile LAS unsigned* st) {
    XcdBarrier b; b.bar = bar; b.x = (unsigned)__builtin_amdgcn_readfirstlane((int)xb_xcc_id()); b.st = st;
    if (threadIdx.x == 0) (void)xb_add(&bar[XB_XCNT(b.x)], 1u);
    return b;
}
__device__ __forceinline__ void xcd_barrier_complete(unsigned* bar, unsigned x, unsigned& nloc, unsigned& nx) {
    const unsigned G = gridDim.x * gridDim.y * gridDim.z;
    unsigned sum, cnt, mine, sp = 0u;
    for (;;) {
        sum = 0u; cnt = 0u; mine = 0u;
#pragma unroll 1
        for (unsigned j = 0; j < 16; ++j) { const unsigned c = xb_ld(&bar[XB_XCNT(j)]); sum += c; cnt += (c > 0u) ? 1u : 0u; mine = (j == x) ? c : mine; }
        if (sum == G) break;
        __builtin_amdgcn_s_sleep(1);
        if ((++sp & 255u) == 0u) { if (xb_ld(&bar[XB_TMO])) break; if (sp > XB_SPIN_CAP) { atomicAdd(&bar[XB_TMO], 1u); break; } }
    }
    nloc = mine > 0u ? mine : 1u; nx = cnt > 0u ? cnt : 1u;
}
__device__ __forceinline__ void xcd_barrier(const XcdBarrier& b) {
    asm volatile("s_waitcnt vmcnt(0)" ::: "memory");
    __syncthreads();
    if (b.wave == 0 && lane_id() == 0) {
        unsigned* bar = b.bar;
        unsigned bx = b.x; asm volatile("" : "+s"(bx));
        __builtin_amdgcn_s_waitcnt(0);
        unsigned nloc = b.st[0], nx = b.st[1];
        const unsigned old = xb_add(&bar[XB_XSUB(bx)], 1u);
        const unsigned gen = old / nloc;
        if (old + 1u == (gen + 1u) * nloc) {
            __builtin_amdgcn_fence(__ATOMIC_RELEASE, "agent");
            asm volatile("s_waitcnt vmcnt(0)" ::: "memory");
            const unsigned og = xb_add(&bar[XB_TOP], 1u);
            const unsigned tg = og / nx;
            if (og + 1u == (tg + 1u) * nx) xb_add(&bar[XB_TOPGEN], 1u);
            else XB_SPIN(xb_ld(&bar[XB_TOPGEN]) == tg, bar);
            __builtin_amdgcn_fence(__ATOMIC_ACQUIRE, "agent");
            xb_add(&bar[XB_XGEN(bx)], 1u);
            asm volatile("s_waitcnt vmcnt(0)" ::: "memory");
        } else {
            XB_SPIN(xb_ld(&bar[XB_XGEN(bx)]) == gen, bar);
            __builtin_amdgcn_fence(__ATOMIC_ACQUIRE, "agent");
            asm volatile("s_waitcnt vmcnt(0)" ::: "memory");
        }
    }
    __syncthreads();
}

__device__ __forceinline__ void xswap16(float& a, float& b) { asm volatile("s_nop 1\n\tv_permlane16_swap_b32 %0, %1\n\ts_nop 1" : "+v"(a), "+v"(b)); }
__device__ __forceinline__ void xswap32(float& a, float& b) { asm volatile("s_nop 1\n\tv_permlane32_swap_b32 %0, %1\n\ts_nop 1" : "+v"(a), "+v"(b)); }
__device__ __forceinline__ float xmax16(float x) { float a = x, b = x; xswap16(a, b); return fmaxf(a, b); }
__device__ __forceinline__ float xmax32(float x) { float a = x, b = x; xswap32(a, b); return fmaxf(a, b); }
__device__ __forceinline__ float xsum16(float x) { float a = x, b = x; xswap16(a, b); return a + b; }
__device__ __forceinline__ float xsum32(float x) { float a = x, b = x; xswap32(a, b); return a + b; }

#define DPPF(x, ctrl) __builtin_bit_cast(float, __builtin_amdgcn_update_dpp(0, __builtin_bit_cast(int, (x)), (ctrl), 0xf, 0xf, true))
__device__ __forceinline__ float wmax_f(float x) {
    x = fmaxf(x, DPPF(x, 0xB1)); x = fmaxf(x, DPPF(x, 0x4E)); x = fmaxf(x, DPPF(x, 0x124)); x = fmaxf(x, DPPF(x, 0x128));
    x = xmax16(x); return xmax32(x);
}
__device__ __forceinline__ unsigned wprefix_u(unsigned x) {
    int v = (int)x;
    v += __builtin_amdgcn_update_dpp(0, v, 0x111, 0xf, 0xf, false);
    v += __builtin_amdgcn_update_dpp(0, v, 0x112, 0xf, 0xf, false);
    v += __builtin_amdgcn_update_dpp(0, v, 0x114, 0xf, 0xf, false);
    v += __builtin_amdgcn_update_dpp(0, v, 0x118, 0xf, 0xf, false);
    v += __builtin_amdgcn_update_dpp(0, v, 0x142, 0xa, 0xf, false);
    v += __builtin_amdgcn_update_dpp(0, v, 0x143, 0xc, 0xf, false);
    return (unsigned)v;
}

__device__ __forceinline__ float rowsum16(float x) { x += DPPF(x, 0xB1); x += DPPF(x, 0x4E); x += DPPF(x, 0x124); x += DPPF(x, 0x128); return x; }
__device__ __forceinline__ float wave_sum(float x) { x = rowsum16(x); x = xsum16(x); return xsum32(x); }
__device__ __forceinline__ float wave_max(float x) { return wmax_f(x); }
__device__ __forceinline__ int wave_sum_i(int v) { float f = wave_sum((float)v); return (int)(f + 0.5f); }
template <class Src>
__device__ __forceinline__ void cvt_load(const Src& src, int k0, int n0, int lane, float (&tv)[32]) {
#pragma unroll
    for (int i = 0; i < 32; ++i) tv[i] = src(k0 + 2 * i + (lane >> 5), n0 + (lane & 31));
}
__device__ __forceinline__ void cvt_store(const float (&tv)[32], bf16* WT, int K, int k0, int n0, LAS float* scr, int lane) {
#pragma unroll
    for (int i = 0; i < 32; ++i) scr[(2 * i + (lane >> 5)) * 33 + (lane & 31)] = tv[i];
    LDS_WAIT(); asm volatile("" ::: "memory");
    const int c = lane & 7;
#pragma unroll
    for (int j = 0; j < 4; ++j) { const int n = (lane >> 3) + 8 * j; const LAS float* s = scr + (8 * c) * 33 + n;
        v4u o; o.x = pk2(s[0 * 33], s[1 * 33]); o.y = pk2(s[2 * 33], s[3 * 33]); o.z = pk2(s[4 * 33], s[5 * 33]); o.w = pk2(s[6 * 33], s[7 * 33]);
        *(GAS v4u*)(WT + (size_t)(n0 + n) * K + k0 + 8 * c) = o; }
    LDS_WAIT(); asm volatile("" ::: "memory");
}

struct Args { const float* in[22]; float* out; unsigned char* ws; };

using pg8::Unit; using pg8::cvt_pk_bf16;
__device__ __forceinline__ void st_bf16x8(bf16* p, f32x4 v0, f32x4 v1) {
    v4u w; w.x = cvt_pk_bf16(v0[0], v0[1]); w.y = cvt_pk_bf16(v0[2], v0[3]); w.z = cvt_pk_bf16(v1[0], v1[1]); w.w = cvt_pk_bf16(v1[2], v1[3]);
    *(v4u*)p = w;
}
__device__ __forceinline__ void st_f32x8(float* p, f32x4 v0, f32x4 v1) { *(f32x4*)p = v0; *(f32x4*)(p + 4) = v1; }
__device__ __forceinline__ f32x4 sigm4(f32x4 v) { return (f32x4){sigm(v[0]), sigm(v[1]), sigm(v[2]), sigm(v[3])}; }
__device__ __forceinline__ f32x4 silu4(f32x4 v) { return (f32x4){v[0] * sigm(v[0]), v[1] * sigm(v[1]), v[2] * sigm(v[2]), v[3] * sigm(v[3])}; }
__device__ __forceinline__ f32x4 ldbf4(const bf16* p) { const v2u w = *(const v2u*)p; return (f32x4){bflo(w.x), bfhi(w.x), bflo(w.y), bfhi(w.y)}; }

#define EPI_LOOP(...) \
    _Pragma("unroll") for (int ai = 0; ai < 2; ++ai) _Pragma("unroll") for (int m = 0; m < 4; ++m) { const int row = row0 + ai * 128 + m * 16; \
        _Pragma("unroll") for (int bj = 0; bj < 2; ++bj) { const int col = colb + bj * 32; const f32x4 v0 = acc[ai][bj][m][0], v1 = acc[ai][bj][m][1]; __VA_ARGS__ } }

struct EpiProj {
    bf16* QA; bf16* FA; bf16* IA; bf16* GA; bf16* LAT; bf16* GTA; bf16* GTB;
    __device__ __forceinline__ void operator()(const f32x4 (&acc)[2][2][4][2], const Unit& u, int wr, int wc, int fr, int fq) const {
        const int row0 = u.pm * 256 + wr * 64 + fr, pn = u.pn; const int colb = (pn & 3) * 256 + wc * 64 + 8 * fq;
        if (pn < 4)       { EPI_LOOP( st_bf16x8(QA + (size_t)row * 1024 + col, v0, v1); ) }
        else if (pn < 8)  { EPI_LOOP( st_bf16x8(FA + (size_t)row * 1024 + col, v0, v1); ) }
        else if (pn < 12) { EPI_LOOP( st_bf16x8(IA + (size_t)row * 1024 + col, v0, v1); ) }
        else if (pn < 16) { EPI_LOOP( st_bf16x8(GA + (size_t)row * 1024 + col, silu4(v0), silu4(v1)); ) }
        else if (pn < 20) { EPI_LOOP( st_bf16x8(LAT + (size_t)row * 1024 + col, v0, v1); ) }
        else { bf16* G = pn < 28 ? GTA : GTB; const int cb2 = ((pn - 20) & 7) * 256 + wc * 64 + 8 * fq;
            _Pragma("unroll") for (int ai = 0; ai < 2; ++ai) _Pragma("unroll") for (int m = 0; m < 4; ++m) { const int row = row0 + ai * 128 + m * 16;
                _Pragma("unroll") for (int bj = 0; bj < 2; ++bj) st_bf16x8(G + (size_t)row * 2048 + cb2 + bj * 32, sigm4(acc[ai][bj][m][0]), sigm4(acc[ai][bj][m][1])); } }
    }
};
struct EpiQ {
    bf16* QB; bf16* QIDX;
    __device__ __forceinline__ void operator()(const f32x4 (&acc)[2][2][4][2], const Unit& u, int wr, int wc, int fr, int fq) const {
        const int row0 = u.pm * 256 + wr * 64 + fr, pn = u.pn;
        if (pn < 16) { const int colb = pn * 256 + wc * 64 + 8 * fq; EPI_LOOP( st_bf16x8(QB + (size_t)row * 4096 + col, v0, v1); ) }
        else { const int colb = (pn - 16) * 256 + wc * 64 + 8 * fq; EPI_LOOP( st_bf16x8(QIDX + (size_t)row * 1024 + col, v0, v1); ) }
    }
};
struct EpiBf {
    bf16* O; int ldc; int coff;
    __device__ __forceinline__ void operator()(const f32x4 (&acc)[2][2][4][2], const Unit& u, int wr, int wc, int fr, int fq) const {
        const int row0 = u.pm * 256 + wr * 64 + fr; const int colb = coff + u.pn * 256 + wc * 64 + 8 * fq;
        EPI_LOOP( st_bf16x8(O + (size_t)row * ldc + col, v0, v1); )
    }
};
struct HookGate {
    static constexpr bool ON = true; const bf16* GA_; const bf16* GB_;
    __device__ __forceinline__ void mid(f32x4 (&acc)[2][2][4][2], const Unit& u, int wr, int wc, int fr, int fq) const {
        asm volatile("" : "+v"(fr), "+v"(fq));
        const int row0 = u.pm * 256 + wr * 64 + fr; const int colb = u.pn * 256 + wc * 64 + 8 * fq;
#pragma unroll
        for (int ai = 0; ai < 2; ++ai)
#pragma unroll
            for (int m = 0; m < 4; ++m) { const int row = row0 + ai * 128 + m * 16;
#pragma unroll
                for (int bj = 0; bj < 2; ++bj) { const size_t o = (size_t)row * 2048 + colb + bj * 32;
                    const f32x4 a0 = ldbf4(GA_ + o), a1 = ldbf4(GA_ + o + 4), b0 = ldbf4(GB_ + o), b1 = ldbf4(GB_ + o + 4);
                    f32x4 r0, r1;
#pragma unroll
                    for (int j = 0; j < 4; ++j) { r0[j] = a0[j] * __builtin_amdgcn_rcpf(b0[j]); r1[j] = a1[j] * __builtin_amdgcn_rcpf(b1[j]); }
                    acc[ai][bj][m][0] = acc[ai][bj][m][0] * r0; acc[ai][bj][m][1] = acc[ai][bj][m][1] * r1; }
                asm volatile("" : "+v"(acc[ai][0][m][0]), "+v"(acc[ai][0][m][1]), "+v"(acc[ai][1][m][0]), "+v"(acc[ai][1][m][1]));
                if (m & 1) asm volatile("" ::: "memory"); }
    }
};
struct EpiGateM {
    const bf16* GB_; bf16* MRG_;
    __device__ __forceinline__ void operator()(const f32x4 (&acc)[2][2][4][2], const Unit& u, int wr, int wc, int fr, int fq) const {
        const int row0 = u.pm * 256 + wr * 64 + fr; const int colb = u.pn * 256 + wc * 64 + 8 * fq;
        EPI_LOOP( const size_t o = (size_t)row * 2048 + col; const f32x4 g0 = ldbf4(GB_ + o), g1 = ldbf4(GB_ + o + 4); st_bf16x8(MRG_ + o, v0 * g0, v1 * g1); )
    }
};
struct EpiGateA {
    float* T1; const bf16* GT;
    __device__ __forceinline__ void operator()(const f32x4 (&acc)[2][2][4][2], const Unit& u, int wr, int wc, int fr, int fq) const {
        const int row0 = u.pm * 256 + wr * 64 + fr; const int colb = u.pn * 256 + wc * 64 + 8 * fq;
        EPI_LOOP( const size_t o = (size_t)row * 2048 + col; const f32x4 g0 = ldbf4(GT + o), g1 = ldbf4(GT + o + 4); st_f32x8(T1 + o, v0 * g0, v1 * g1); )
    }
};
struct EpiGateB {
    const float* T1; const bf16* GT; bf16* MRG;
    __device__ __forceinline__ void operator()(const f32x4 (&acc)[2][2][4][2], const Unit& u, int wr, int wc, int fr, int fq) const {
        const int row0 = u.pm * 256 + wr * 64 + fr; const int colb = u.pn * 256 + wc * 64 + 8 * fq;
        EPI_LOOP( const size_t o = (size_t)row * 2048 + col; const f32x4 g0 = ldbf4(GT + o), g1 = ldbf4(GT + o + 4); const f32x4 t0 = *(const f32x4*)(T1 + o), t1 = *(const f32x4*)(T1 + o + 4);
                  st_bf16x8(MRG + o, t0 + v0 * g0, t1 + v1 * g1); )
    }
};
struct EpiRes {
    const float* X; const bf16* Xh; bf16* R; const float* gt;
    __device__ __forceinline__ void operator()(const f32x4 (&acc)[2][2][4][2], const Unit& u, int wr, int wc, int fr, int fq) const {
        const int row0 = u.pm * 256 + wr * 64 + fr; const int colb = u.pn * 256 + wc * 64 + 8 * fq; const float* g = gt + (size_t)(u.pm >> 4) * MODW;
        if (X) { EPI_LOOP( const size_t o = (size_t)row * 2048 + col; const f32x4 x0 = *(const f32x4*)(X + o), x1 = *(const f32x4*)(X + o + 4); const f32x4 g0 = *(const f32x4*)(g + col), g1 = *(const f32x4*)(g + col + 4);
                  st_bf16x8(R + o, x0 * ALPHA + (g0 + 1.f) * v0, x1 * ALPHA + (g1 + 1.f) * v1); ) }
        else { EPI_LOOP( const size_t o = (size_t)row * 2048 + col; const f32x4 x0 = ldbf4(Xh + o), x1 = ldbf4(Xh + o + 4); const f32x4 g0 = *(const f32x4*)(g + col), g1 = *(const f32x4*)(g + col + 4);
                  st_bf16x8(R + o, x0 * ALPHA + (g0 + 1.f) * v0, x1 * ALPHA + (g1 + 1.f) * v1); ) }
    }
};
struct EpiSwiglu {
    bf16* ACT;
    __device__ __forceinline__ void operator()(const f32x4 (&acc)[2][2][4][2], const Unit& u, int wr, int wc, int fr, int fq) const {
        const int row0 = u.pm * 256 + wr * 64 + fr; const int col = u.pn * 128 + wc * 32 + 8 * fq;
#pragma unroll
        for (int ai = 0; ai < 2; ++ai)
#pragma unroll
            for (int m = 0; m < 4; ++m) { const int row = row0 + ai * 128 + m * 16;
                st_bf16x8(ACT + (size_t)row * DFF + col, silu4(acc[ai][0][m][0]) * acc[ai][1][m][0], silu4(acc[ai][0][m][1]) * acc[ai][1][m][1]); }
    }
};

__global__ void __launch_bounds__(NTHR, 2) fwd_kernel(Args args) {
    extern __shared__ __attribute__((aligned(16))) unsigned char lds_raw[];
    LAS unsigned char* lds = (LAS unsigned char*)lds_raw;
    const int G = gridDim.x, blk = blockIdx.x;
    const int NGW = G * NWAVES, NT = G * NTHR;
    unsigned char* const ws_base = args.ws;
    gu32* ctl = (gu32*)(ws_base + WS_CTL);
    for (int u = threadIdx.x; u < (LDS_BYTES - LDSCTL_OFF) / 4; u += NTHR) ((LAS unsigned*)(lds + LDSCTL_OFF))[u] = 0u;
    __syncthreads();
    volatile LAS unsigned* MISC = (volatile LAS unsigned*)(lds + MISC_OFF);
    const int wave_s = __builtin_amdgcn_readfirstlane((int)(threadIdx.x >> 6));
    XcdBarrier bar = xcd_barrier_post((unsigned*)(ctl + CW_BAR), MISC + 8); bar.wave = wave_s;
    if (threadIdx.x == 0) { unsigned nloc_ = 0u, nx_ = 0u; xcd_barrier_complete(bar.bar, bar.x, nloc_, nx_); bar.st[0] = nloc_; bar.st[1] = nx_; }
    __syncthreads();
#define GRID_BAR() xcd_barrier(bar)

#define x_in ((const float*)(const GAS float*)args.in[0 + z_])
#define c_in ((const float*)(const GAS float*)args.in[1 + z_])
#define w_ada ((const float*)(const GAS float*)args.in[2 + z_])
#define b_ada ((const float*)(const GAS float*)args.in[3 + z_])
#define w_in ((const float*)(const GAS float*)args.in[4 + z_])
#define lb_logits ((const float*)(const GAS float*)args.in[5 + z_])
#define g_hg ((const float*)(const GAS float*)args.in[6 + z_])
#define w_pa ((const float*)(const GAS float*)args.in[7 + z_])
#define g_cq ((const float*)(const GAS float*)args.in[8 + z_])
#define g_ckv ((const float*)(const GAS float*)args.in[9 + z_])
#define w_uq ((const float*)(const GAS float*)args.in[10 + z_])
#define w_iq ((const float*)(const GAS float*)args.in[11 + z_])
#define w_uv ((const float*)(const GAS float*)args.in[12 + z_])
#define w_pb ((const float*)(const GAS float*)args.in[13 + z_])
#define w_out ((const float*)(const GAS float*)args.in[14 + z_])
#define ln1_g ((const float*)(const GAS float*)args.in[15 + z_])
#define ln1_b ((const float*)(const GAS float*)args.in[16 + z_])
#define w_gate ((const float*)(const GAS float*)args.in[17 + z_])
#define w_up ((const float*)(const GAS float*)args.in[18 + z_])
#define w_down ((const float*)(const GAS float*)args.in[19 + z_])
#define ln2_g ((const float*)(const GAS float*)args.in[20 + z_])
#define ln2_b ((const float*)(const GAS float*)args.in[21 + z_])
#define MOD  ((float*)(ws + WS_MOD))
#define LB   ((float*)(ws + WS_LB))
#define MODP ((float*)(ws + WS_MODP))
#define W1   ((bf16*)(ws + WS_W1))
#define W3   ((bf16*)(ws + WS_W3))
#define W6   ((bf16*)(ws + WS_W6))
#define W7   ((bf16*)(ws + WS_W7))
#define W8   ((bf16*)(ws + WS_W8))
#define W10  ((bf16*)(ws + WS_W10))
#define W11  ((bf16*)(ws + WS_W11))
#define XB   ((bf16*)(ws + WS_X))
#define RB   ((bf16*)(ws + WS_R))
#define HB   ((bf16*)(ws + WS_H))
#define QA   ((bf16*)(ws + WS_QA))
#define FA   ((bf16*)(ws + WS_FA))
#define IA   ((bf16*)(ws + WS_IA))
#define GA   ((bf16*)(ws + WS_GA))
#define LAT  ((bf16*)(ws + WS_LAT))
#define GTA  ((bf16*)(ws + WS_GTA))
#define GTB  ((bf16*)(ws + WS_GTB))
#define CQN  ((bf16*)(ws + WS_CQN))
#define CKV  ((bf16*)(ws + WS_CKV))
#define KIDX ((bf16*)(ws + WS_KIDX))
#define IDXW ((float*)(ws + WS_IDXW))
#define QB   ((bf16*)(ws + WS_QB))
#define QIDX ((bf16*)(ws + WS_QIDX))
#define SEL  ((unsigned short*)(ws + WS_SEL))
#define YAB  ((bf16*)(ws + WS_YAB))
#define MRG  ((bf16*)(ws + WS_MRG))
#define OB   ((bf16*)(ws + WS_OB))
#define ISC  ((_Float16*)(ws + WS_BIG))
#define OP   ((float*)(ws + WS_BIG))
#define ACT  ((bf16*)(ws + WS_BIG))
#define KK   LAT
#define modl (MOD + (size_t)l * NBATCH * MODW)
#define KSB  ((bf16*)(ws + WS_KSB))
#define QSB  ((bf16*)(ws + WS_QSB))
#define KVT  ((bf16*)(ws + WS_BIG))
#define SPB  ((bf16*)(ws + WS_FA))
#define DEB  ((float*)(ws + WS_DEB))
#define PHASE_BEGIN { unsigned om_ = ~0u; asm volatile("" : "+s"(om_)); int tid = wave_s * 64 + (int)__builtin_amdgcn_mbcnt_hi(om_, __builtin_amdgcn_mbcnt_lo(om_, 0u)); asm volatile("" : "+v"(tid)); int z_ = 0; asm volatile("" : "+s"(z_)); (void)z_; GAS unsigned char* wsg_ = (GAS unsigned char*)ws_base; asm volatile("" : "+s"(wsg_)); unsigned char* ws = (unsigned char*)wsg_; const int lane = tid & 63, wave = __builtin_amdgcn_readfirstlane(tid >> 6); \
        const int gw = blk * NWAVES + wave, gtid = blk * NTHR + tid; LAS float* wscr = (LAS float*)(lds + wave * 16384); (void)lane; (void)gw; (void)gtid; (void)wscr;
#define PHASE_END }

#define CVT_DECODE(IT_, MID_, K0_, N0_) do { int r_ = (IT_); \
        if (r_ < I1) { MID_ = 0; K0_ = (r_ / (N1 / 32)) * 64; N0_ = (r_ % (N1 / 32)) * 32; } else { r_ -= I1; \
        if (r_ < I3) { MID_ = 1; K0_ = (r_ / (N3 / 32)) * 64; N0_ = (r_ % (N3 / 32)) * 32; } else { r_ -= I3; \
        if (r_ < I6) { MID_ = 2; K0_ = (r_ / 32) * 64; N0_ = (r_ % 32) * 32; } else { r_ -= I6; \
        if (r_ < I7) { MID_ = 3; K0_ = (r_ / (DM / 32)) * 64; N0_ = (r_ % (DM / 32)) * 32; } else { r_ -= I7; \
        if (r_ < I8) { MID_ = 4; K0_ = (r_ / (DM / 32)) * 64; N0_ = (r_ % (DM / 32)) * 32; } else { r_ -= I8; \
        if (r_ < I10) { MID_ = 5; K0_ = (r_ / (N10 / 32)) * 64; N0_ = (r_ % (N10 / 32)) * 32; } else { r_ -= I10; \
        MID_ = 6; K0_ = (r_ / (DM / 32)) * 64; N0_ = (r_ % (DM / 32)) * 32; } } } } } } } while (0)
#define CVT_LOAD(MID_, K0_, N0_, TV_) do { \
        if (MID_ == 0) cvt_load([=](int k, int n) -> float { return n < 4944 ? s_in[(size_t)k * 9040 + n] : (n < 5120 ? 0.f : s_in[(size_t)k * 9040 + n - 176]); }, K0_, N0_, lane, TV_); \
        else if (MID_ == 1) cvt_load([=](int k, int n) -> float { return n < 4096 ? s_uq[(size_t)k * 4096 + n] * 0.0625f : s_iq[(size_t)k * 1024 + n - 4096]; }, K0_, N0_, lane, TV_); \
        else if (MID_ == 2) cvt_load([=](int k, int n) -> float { const int h = n >> 6, v = n & 63, kk = k >> 8, c = k & 255; return kk == (h & 3) ? s_uv[((size_t)h * 256 + c) * 64 + v] : 0.f; }, K0_, N0_, lane, TV_); \
        else if (MID_ == 3) cvt_load([=](int k, int n) -> float { return k < 1024 ? s_pa[(size_t)k * DM + n] : s_pb[(size_t)(k - 1024) * DM + n]; }, K0_, N0_, lane, TV_); \
        else if (MID_ == 4) cvt_load([=](int k, int n) -> float { return s_out[(size_t)k * DM + n]; }, K0_, N0_, lane, TV_); \
        else if (MID_ == 5) cvt_load([=](int k, int n) -> float { const int pn = n >> 8, rr = n & 255, cc = pn * 128 + (rr >> 6) * 32 + (rr & 31); return (rr & 32) ? s_u[(size_t)k * DFF + cc] : s_g[(size_t)k * DFF + cc]; }, K0_, N0_, lane, TV_); \
        else cvt_load([=](int k, int n) -> float { return s_d[(size_t)k * DM + n]; }, K0_, N0_, lane, TV_); } while (0)
#define CONVERT_LAYER(L) do { const int l_ = (L); \
        const float* s_in = w_in + (size_t)l_ * DM * 9040; const float* s_uq = w_uq + (size_t)l_ * SAR * 4096; const float* s_iq = w_iq + (size_t)l_ * SAR * 1024; \
        const float* s_uv = w_uv + (size_t)l_ * 16 * 256 * 64; const float* s_pa = w_pa + (size_t)l_ * 1024 * DM; const float* s_pb = w_pb + (size_t)l_ * 1024 * DM; \
        const float* s_out = w_out + (size_t)l_ * DM * DM; const float* s_g = w_gate + (size_t)l_ * DM * DFF; const float* s_u = w_up + (size_t)l_ * DM * DFF; const float* s_d = w_down + (size_t)l_ * DFF * DM; \
        constexpr int I1 = (DM / 64) * (N1 / 32), I3 = (SAR / 64) * (N3 / 32), I6 = (1024 / 64) * (1024 / 32), I7 = (DM / 64) * (DM / 32), I8 = I7, I10 = (DM / 64) * (N10 / 32), I11 = (DFF / 64) * (DM / 32); \
        constexpr int NIT = I1 + I3 + I6 + I7 + I8 + I10 + I11; \
        float tv_[32]; int mid_ = 0, k0_ = 0, n0_ = 0; \
        { CVT_DECODE(gw, mid_, k0_, n0_); CVT_LOAD(mid_, k0_, n0_, tv_); } \
        for (int it = gw; it < NIT; it += NGW) { \
            float tc_[32]; _Pragma("unroll") for (int i = 0; i < 32; ++i) tc_[i] = tv_[i]; \
            const int mc_ = mid_, kc_ = k0_, nc_ = n0_; \
            { const int itn_ = it + NGW < NIT ? it + NGW : it; CVT_DECODE(itn_, mid_, k0_, n0_); CVT_LOAD(mid_, k0_, n0_, tv_); }     \
            bf16* wt_ = mc_ == 0 ? W1 : mc_ == 1 ? W3 : mc_ == 2 ? W6 : mc_ == 3 ? W7 : mc_ == 4 ? W8 : mc_ == 5 ? W10 : W11; \
            const int kk_ = mc_ == 0 ? DM : mc_ == 1 ? SAR : mc_ == 2 ? 1024 : mc_ == 3 ? DM : mc_ == 4 ? DM : mc_ == 5 ? DM : DFF; \
            cvt_store(tc_, wt_, kk_, kc_, nc_, wscr, lane); \
        } } while (0)


#ifndef HGRN_NAIVE
#define HGRN_NAIVE 0
#endif
#ifndef IDX_NAIVE
#define IDX_NAIVE 0
#endif
#ifndef ATT_NAIVE
#define ATT_NAIVE 0
#endif
#ifndef TOPK_OLD
#define TOPK_OLD 0
#endif
#ifndef REP_HB
#define REP_HB 1
#endif
#ifndef REP_HC
#define REP_HC 1
#endif
#ifndef REP_P4A
#define REP_P4A 1
#endif
#ifndef REP_P5
#define REP_P5 1
#endif
#ifndef REP_P9
#define REP_P9 1
#endif
#ifndef REP_P12
#define REP_P12 1
#endif
#ifndef REP_TOPK
#define REP_TOPK 1
#endif
#ifndef REP_ATT
#define REP_ATT 1
#endif
#ifndef DRY_ATT
#define DRY_ATT 0
#endif
#ifndef REP_M1
#define REP_M1 1
#endif
#ifndef REP_M2
#define REP_M2 1
#endif
#ifndef REP_M3
#define REP_M3 1
#endif

    PHASE_BEGIN
    {
        LAS float* sc = (LAS float*)lds;
        for (int i = tid; i < NBATCH * DM; i += NTHR) { const float v = c_in[i]; sc[i] = v * sigm(v); }
        __syncthreads();
        for (int item = gtid; item < 8 * 12288; item += NT) {
            const int ks = item / 12288, cg = item % 12288, l = cg / 3072, n4 = (cg % 3072) * 4;
            const float* wp = w_ada + ((size_t)l * DM + ks * 256) * MODW + n4;
            f32x4 a0 = {0.f, 0.f, 0.f, 0.f}, a1 = a0, a2 = a0, a3 = a0;
#pragma unroll 8
            for (int k = 0; k < 256; ++k) { const f32x4 w = *(const f32x4*)(wp + (size_t)k * MODW); const int kk = ks * 256 + k;
                a0 += w * sc[kk]; a1 += w * sc[2048 + kk]; a2 += w * sc[4096 + kk]; a3 += w * sc[6144 + kk]; }
            float* o = MODP + ((size_t)(ks * 4 + l) * 4) * MODW + n4;
            *(f32x4*)(o) = a0; *(f32x4*)(o + MODW) = a1; *(f32x4*)(o + 2 * MODW) = a2; *(f32x4*)(o + 3 * MODW) = a3;
        }
        if (gtid < 1024) {
            const float a = lb_logits[gtid], b = lb_logits[1024 + gtid], c = lb_logits[2048 + gtid], d = lb_logits[3072 + gtid];
            const float mx = fmaxf(fmaxf(a, b), fmaxf(c, d)); const float ea = expf(a - mx), eb = expf(b - mx), ec = expf(c - mx), ed = expf(d - mx); const float inv = 1.f / (ea + eb + ec + ed);
            LB[gtid] = 0.f; LB[1024 + gtid] = eb * inv; LB[2048 + gtid] = (eb + ec) * inv; LB[3072 + gtid] = (eb + ec + ed) * inv;
        }
        __syncthreads();
        CONVERT_LAYER(0);
    }
    PHASE_END
    GRID_BAR();
    PHASE_BEGIN
    for (int i = gtid; i < DEPTH * NBATCH * MODW; i += NT) {
        const int l = i / (NBATCH * MODW), r = i % (NBATCH * MODW), b = r / MODW, n = r % MODW;
        float s = b_ada[l * MODW + n];
#pragma unroll
        for (int ks = 0; ks < 8; ++ks) s += MODP[((size_t)(ks * 4 + l) * 4 + b) * MODW + n];
        MOD[i] = s;
    }
    PHASE_END
    GRID_BAR();
    PHASE_BEGIN
    for (size_t i0 = gtid; i0 < (size_t)M * DM / 8; i0 += (size_t)NT * 4) {
        f32x4 xa[4], xb[4], sa[4], sb[4], ha[4], hb[4];
#pragma unroll
        for (int t = 0; t < 4; ++t) { size_t gi = i0 + (size_t)t * NT; gi = gi < (size_t)M * DM / 8 ? gi : (size_t)M * DM / 8 - 1; const size_t e = gi * 8; const int row = (int)(e / DM), col = (int)(e % DM), b = row / SEQ; const float* md = MOD + (size_t)b * MODW;
            xa[t] = *(const f32x4*)(x_in + e); xb[t] = *(const f32x4*)(x_in + e + 4); sa[t] = *(const f32x4*)(md + 2048 + col); sb[t] = *(const f32x4*)(md + 2048 + col + 4); ha[t] = *(const f32x4*)(md + col); hb[t] = *(const f32x4*)(md + col + 4); }
#pragma unroll
        for (int t = 0; t < 4; ++t) { size_t gi = i0 + (size_t)t * NT; gi = gi < (size_t)M * DM / 8 ? gi : (size_t)M * DM / 8 - 1; const size_t e = gi * 8; st_bf16x8(HB + e, xa[t] * (sa[t] + 1.f) + ha[t], xb[t] * (sb[t] + 1.f) + hb[t]); }
    }
    PHASE_END
    GRID_BAR();

    for (int l = 0; l < DEPTH; ++l) {
        PHASE_BEGIN
        { pg8::Gemm g{HB, W1, M, N1, DM, DM, DM, 0}; pg8::StaticOrder S; S.init(M, N1, G, blk);
          EpiProj E{QA, FA, IA, GA, LAT, GTA, GTB}; pg8::gemm_phase(lds, g, S, E, tid); }
        PHASE_END
        GRID_BAR();
        for (int rep_ = 0; rep_ < REP_M1; ++rep_) {
        PHASE_BEGIN
        v2u ra0, ra1, rkv; unsigned short rki, riw;
        { const bf16* lr = LAT + (size_t)gw * 1024; ra0 = *(const v2u*)(lr + 4 * lane); ra1 = *(const v2u*)(lr + 256 + 4 * lane); rkv = *(const v2u*)(lr + 512 + 4 * lane); rki = lr[768 + lane]; riw = lr[832 + (lane & 15)]; }
        for (int row = gw; row < M; row += NGW) {
            const f32x4 a0 = (f32x4){bflo(ra0.x), bfhi(ra0.x), bflo(ra0.y), bfhi(ra0.y)}, a1 = (f32x4){bflo(ra1.x), bfhi(ra1.x), bflo(ra1.y), bfhi(ra1.y)}, kv = (f32x4){bflo(rkv.x), bfhi(rkv.x), bflo(rkv.y), bfhi(rkv.y)};
            const float ki = bf2f(rki), iw = bf2f(riw);
            { const int rn = row + NGW < M ? row + NGW : row; const bf16* lr = LAT + (size_t)rn * 1024;
              ra0 = *(const v2u*)(lr + 4 * lane); ra1 = *(const v2u*)(lr + 256 + 4 * lane); rkv = *(const v2u*)(lr + 512 + 4 * lane); rki = lr[768 + lane]; riw = lr[832 + (lane & 15)]; }
            float sq = a0[0] * a0[0] + a0[1] * a0[1] + a0[2] * a0[2] + a0[3] * a0[3] + a1[0] * a1[0] + a1[1] * a1[1] + a1[2] * a1[2] + a1[3] * a1[3];
            float sk = kv[0] * kv[0] + kv[1] * kv[1] + kv[2] * kv[2] + kv[3] * kv[3];
            sq = wave_sum(sq); sk = wave_sum(sk);
            const float rq = 1.0f / sqrtf(sq * (1.f / 512.f) + 1e-6f), rk = 1.0f / sqrtf(sk * (1.f / 256.f) + 1e-6f);
            const f32x4 g0 = *(const f32x4*)(g_cq + l * 512 + 4 * lane), g1 = *(const f32x4*)(g_cq + l * 512 + 256 + 4 * lane), gk = *(const f32x4*)(g_ckv + l * 256 + 4 * lane);
            v2u o; f32x4 t = a0 * rq * g0; o.x = pk2(t[0], t[1]); o.y = pk2(t[2], t[3]); *(v2u*)(CQN + (size_t)row * 512 + 4 * lane) = o;
            t = a1 * rq * g1; o.x = pk2(t[0], t[1]); o.y = pk2(t[2], t[3]); *(v2u*)(CQN + (size_t)row * 512 + 256 + 4 * lane) = o;
            t = kv * rk * gk; o.x = pk2(t[0], t[1]); o.y = pk2(t[2], t[3]); *(v2u*)(CKV + (size_t)row * 256 + 4 * lane) = o;
            KIDX[(size_t)row * 64 + lane] = (bf16)f2bf(ki);
            if (lane < 16) IDXW[(size_t)row * 16 + lane] = iw * 0.03125f;
        }
        PHASE_END
        PHASE_BEGIN
        {
            const int cp = tid & 63, sg = tid >> 6;
            LAS unsigned char* KST = lds;
            LAS unsigned char* VTL = lds + 18432;
            LAS float* SEGT = (LAS float*)(lds + 36864);
            LAS float* G63 = (LAS float*)(lds + 40960);
            unsigned pfa[8], pq[8], pv[8];
#define HA_REQ(U_) do { int uu_ = (U_); asm volatile("" : "+s"(uu_)); const int bh_ = uu_ >> 6, c_ = uu_ & 63, b_ = bh_ >> 3, h_ = bh_ & 7; \
                const size_t rowb_ = (size_t)b_ * SEQ + c_ * 64 + sg * 8; const int col_ = h_ * 128 + 2 * cp; \
                _Pragma("unroll") for (int i = 0; i < 8; ++i) { pfa[i] = *(const unsigned*)(FA + (rowb_ + i) * 1024 + col_); pq[i] = *(const unsigned*)(QA + (rowb_ + i) * 1024 + col_); pv[i] = *(const unsigned*)(IA + (rowb_ + i) * 1024 + col_); } } while (0)
            HA_REQ(blk);
            for (int u = blk; u < 2048; u += G) {
                const int bh = u >> 6, c = u & 63, b = bh >> 3, h = bh & 7;
                const size_t rowb = (size_t)b * SEQ + c * 64 + sg * 8; const int col = h * 128 + 2 * cp;
                const float lb0 = LB[l * 1024 + col], lb1 = LB[l * 1024 + col + 1];
                float lf0[8], lf1[8], kk0[8], kk1[8]; unsigned cq[8], cv[8];
#pragma unroll
                for (int i = 0; i < 8; ++i) { cq[i] = pq[i]; cv[i] = pv[i]; }
#pragma unroll
                for (int i = 0; i < 8; ++i) { const float2 fa = make_float2(bflo(pfa[i]), bfhi(pfa[i]));
                    const float f0 = fminf(fmaxf(lb0 + (1.f - lb0) * sigm(fa.x), 1e-6f), 1.f), f1 = fminf(fmaxf(lb1 + (1.f - lb1) * sigm(fa.y), 1e-6f), 1.f);
                    lf0[i] = __logf(f0); lf1[i] = __logf(f1); kk0[i] = (1.f - lb0) * sigm(-fa.x); kk1[i] = (1.f - lb1) * sigm(-fa.y); }
#pragma unroll
                for (int i = 1; i < 8; ++i) { lf0[i] += lf0[i - 1]; lf1[i] += lf1[i - 1]; }
                SEGT[sg * 128 + 2 * cp] = lf0[7]; SEGT[sg * 128 + 2 * cp + 1] = lf1[7];
                HA_REQ(u + G < 2048 ? u + G : u);
                __syncthreads();
                float pre0 = 0.f, pre1 = 0.f, r0 = 0.f, r1 = 0.f, t0 = 0.f, t1 = 0.f;
#pragma unroll
                for (int s2 = 0; s2 < 8; ++s2) { const float a0 = SEGT[s2 * 128 + 2 * cp], a1 = SEGT[s2 * 128 + 2 * cp + 1];
                    if (s2 < sg) { pre0 += a0; pre1 += a1; } if (s2 < 4) { r0 += a0; r1 += a1; } t0 += a0; t1 += a1; }
                unsigned ksw0[4], ksw1[4], vw0[4], vw1[4]; float ks0p = 0.f, ks1p = 0.f, v0p = 0.f, v1p = 0.f;
#pragma unroll
                for (int i = 0; i < 8; ++i) {
                    const float b0 = pre0 + lf0[i], b1 = pre1 + lf1[i];
                    const unsigned qw = cq[i]; const unsigned vw = cv[i];
                    const float qs0 = bflo(qw) * __expf(b0 - r0), qs1 = bfhi(qw) * __expf(b1 - r1);
                    const float ks0 = kk0[i] * __expf(r0 - b0), ks1 = kk1[i] * __expf(r1 - b1);
                    *(unsigned*)(QSB + (rowb + i) * 1024 + col) = pk2(qs0, qs1);
                    *(unsigned*)(KSB + (rowb + i) * 1024 + col) = pk2(ks0, ks1);
                    if (i & 1) { ksw0[i >> 1] = pk2(ks0p, ks0); ksw1[i >> 1] = pk2(ks1p, ks1); vw0[i >> 1] = pk2(v0p, bflo(vw)); vw1[i >> 1] = pk2(v1p, bfhi(vw)); }
                    else { ks0p = ks0; ks1p = ks1; v0p = bflo(vw); v1p = bfhi(vw); }
                }
                *(LAS v4u*)(KST + (2 * cp) * 144 + sg * 16) = (v4u){ksw0[0], ksw0[1], ksw0[2], ksw0[3]};
                *(LAS v4u*)(KST + (2 * cp + 1) * 144 + sg * 16) = (v4u){ksw1[0], ksw1[1], ksw1[2], ksw1[3]};
                *(LAS v4u*)(VTL + (2 * cp) * 144 + sg * 16) = (v4u){vw0[0], vw0[1], vw0[2], vw0[3]};
                *(LAS v4u*)(VTL + (2 * cp + 1) * 144 + sg * 16) = (v4u){vw1[0], vw1[1], vw1[2], vw1[3]};
                if (sg == 7) { float* de = DEB + (size_t)u * 256; *(float2*)(de + 2 * cp) = make_float2(__expf(r0), __expf(r1)); *(float2*)(de + 128 + 2 * cp) = make_float2(__expf(t0), __expf(t1));
                    G63[2 * cp] = __expf(t0 - r0); G63[2 * cp + 1] = __expf(t1 - r1); }
                __syncthreads();
                { const int kt = wave >> 1, vt0 = (wave & 1) * 2, lr = lane & 31, lh = lane >> 5;
                  f32x16 acc0, acc1;
#pragma unroll
                  for (int r = 0; r < 16; ++r) { acc0[r] = 0.f; acc1[r] = 0.f; }
#pragma unroll
                  for (int s4 = 0; s4 < 4; ++s4) {
                      const bf16x8 kb = *(const LAS bf16x8*)(KST + (kt * 32 + lr) * 144 + (s4 * 16 + 8 * lh) * 2);
                      const bf16x8 a0 = *(const LAS bf16x8*)(VTL + (vt0 * 32 + lr) * 144 + (s4 * 16 + 8 * lh) * 2);
                      const bf16x8 a1 = *(const LAS bf16x8*)(VTL + ((vt0 + 1) * 32 + lr) * 144 + (s4 * 16 + 8 * lh) * 2);
                      acc0 = __builtin_amdgcn_mfma_f32_32x32x16_bf16(a0, kb, acc0, 0, 0, 0); acc1 = __builtin_amdgcn_mfma_f32_32x32x16_bf16(a1, kb, acc1, 0, 0, 0); }
                  bf16* kvt = KVT + (size_t)u * 16384 + kt * 32 + lr; const float g = G63[kt * 32 + lr];
#pragma unroll
                  for (int r = 0; r < 16; ++r) { const int vv = 8 * (r >> 2) + 4 * lh + (r & 3);
                      kvt[(size_t)(vt0 * 32 + vv) * 128] = (bf16)(pk2(acc0[r] * g, 0.f) & 0xffffu); kvt[(size_t)((vt0 + 1) * 32 + vv) * 128] = (bf16)(pk2(acc1[r] * g, 0.f) & 0xffffu); } }
                __syncthreads();
            }
        }
#undef HA_REQ
        PHASE_END
        GRID_BAR();
        }
        for (int rep_ = 0; rep_ < REP_M2; ++rep_) {
        PHASE_BEGIN
        for (int item = gtid; item < 32 * 4096; item += NT) {
            const int bh = item >> 12, v = (item >> 5) & 127, k4 = (item & 31) * 4;
            f32x4 S = {0.f, 0.f, 0.f, 0.f};
            for (int c0 = 0; c0 < 64; c0 += 8) {
                f32x4 kv[8], dd[8], ee[8];
#pragma unroll
                for (int j = 0; j < 8; ++j) { const size_t u = (size_t)bh * 64 + c0 + j; kv[j] = ldbf4(KVT + u * 16384 + v * 128 + k4); ee[j] = *(const f32x4*)(DEB + u * 256 + k4); dd[j] = *(const f32x4*)(DEB + u * 256 + 128 + k4); }
#pragma unroll
                for (int j = 0; j < 8; ++j) { const size_t u = (size_t)bh * 64 + c0 + j; const f32x4 sp = S * ee[j]; v2u w; w.x = pk2(sp[0], sp[1]); w.y = pk2(sp[2], sp[3]);
                    *(v2u*)(SPB + u * 16384 + v * 128 + k4) = w; S = S * dd[j] + kv[j]; }
            }
        }
        PHASE_END
        PHASE_BEGIN
        { pg8::Gemm g{CQN, W3, M, N3, SAR, SAR, SAR, 0}; pg8::StaticOrder S; S.init(M, N3, G, blk);
          EpiQ E{QB, QIDX}; pg8::gemm_phase(lds, g, S, E, tid); }
        PHASE_END
        GRID_BAR();
        }
        for (int rep_ = 0; rep_ < REP_M3; ++rep_) {
        PHASE_BEGIN
        {
            LAS unsigned char* QSL = lds;
            LAS unsigned char* KSL = lds + 17408;
            LAS unsigned char* VTL = lds + 34816;
            LAS unsigned char* SPL = lds + 53248;
            LAS unsigned char* AL = lds + 88064;
            LAS float* SSQ = (LAS float*)(lds + 97280);
            const int cp = tid & 63, sg = tid >> 6, lr = lane & 31, lh = lane >> 5;
            v4u rq[2], rk[2], rs[4]; unsigned rv[8]; unsigned short rg[16];
#define HC_REQ(U_) do { int uu_ = (U_); asm volatile("" : "+s"(uu_));   const int bh_ = uu_ >> 6, c_ = uu_ & 63, b_ = bh_ >> 3, h_ = bh_ & 7; const size_t row0_ = (size_t)b_ * SEQ + c_ * 64; const int col0_ = h_ * 128; \
                _Pragma("unroll") for (int j = 0; j < 2; ++j) { const int q = tid + 512 * j, rr = q >> 4, cc = q & 15; \
                    rq[j] = *(const v4u*)(QSB + (row0_ + rr) * 1024 + col0_ + cc * 8); rk[j] = *(const v4u*)(KSB + (row0_ + rr) * 1024 + col0_ + cc * 8); } \
                _Pragma("unroll") for (int j = 0; j < 4; ++j) { const int q = tid + 512 * j, rr = q >> 4, cc = q & 15; rs[j] = *(const v4u*)(SPB + (size_t)uu_ * 16384 + rr * 128 + cc * 8); } \
                _Pragma("unroll") for (int i = 0; i < 8; ++i) rv[i] = *(const unsigned*)(IA + (row0_ + sg * 8 + i) * 1024 + col0_ + 2 * cp); \
                { const int it_ = wave >> 2, vt_ = wave & 3; const int colg_ = col0_ + vt_ * 32 + lr; \
                  _Pragma("unroll") for (int r = 0; r < 16; ++r) { const int ii = it_ * 32 + 8 * (r >> 2) + 4 * lh + (r & 3); rg[r] = GA[(row0_ + ii) * 1024 + colg_]; } } } while (0)
            HC_REQ(blk);
            for (int u = blk; u < 2048; u += G) {
                const int bh = u >> 6, c = u & 63, b = bh >> 3, h = bh & 7;
                const size_t row0 = (size_t)b * SEQ + c * 64; const int col0 = h * 128;
#pragma unroll
                for (int j = 0; j < 2; ++j) { const int q = tid + 512 * j, rr = q >> 4, cc = q & 15;
                    *(LAS v4u*)(QSL + rr * 272 + cc * 16) = rq[j]; *(LAS v4u*)(KSL + rr * 272 + cc * 16) = rk[j]; }
#pragma unroll
                for (int j = 0; j < 4; ++j) { const int q = tid + 512 * j, rr = q >> 4, cc = q & 15; *(LAS v4u*)(SPL + rr * 272 + cc * 16) = rs[j]; }
                { unsigned vw0[4], vw1[4]; float v0p = 0.f, v1p = 0.f;
#pragma unroll
                  for (int i = 0; i < 8; ++i) { const unsigned vw = rv[i];
                      if (i & 1) { vw0[i >> 1] = pk2(v0p, bflo(vw)); vw1[i >> 1] = pk2(v1p, bfhi(vw)); } else { v0p = bflo(vw); v1p = bfhi(vw); } }
                  *(LAS v4u*)(VTL + (2 * cp) * 144 + sg * 16) = (v4u){vw0[0], vw0[1], vw0[2], vw0[3]};
                  *(LAS v4u*)(VTL + (2 * cp + 1) * 144 + sg * 16) = (v4u){vw1[0], vw1[1], vw1[2], vw1[3]}; }
                float gav[16];
#pragma unroll
                for (int r = 0; r < 16; ++r) gav[r] = bf2f(rg[r]);
                HC_REQ(u + G < 2048 ? u + G : u);
                __syncthreads();
                if (wave < 4) {
                    const int it = wave >> 1, jt = wave & 1;
                    f32x16 acc;
#pragma unroll
                    for (int r = 0; r < 16; ++r) acc[r] = 0.f;
                    if (!(it == 0 && jt == 1)) {
#pragma unroll
                        for (int s8 = 0; s8 < 8; ++s8) {
                            const bf16x8 a = *(const LAS bf16x8*)(QSL + (it * 32 + lr) * 272 + (s8 * 16 + 8 * lh) * 2);
                            const bf16x8 bb = *(const LAS bf16x8*)(KSL + (jt * 32 + lr) * 272 + (s8 * 16 + 8 * lh) * 2);
                            acc = __builtin_amdgcn_mfma_f32_32x32x16_bf16(a, bb, acc, 0, 0, 0); } }
                    const int jj = jt * 32 + lr;
#pragma unroll
                    for (int r = 0; r < 16; ++r) { const int ii = it * 32 + 8 * (r >> 2) + 4 * lh + (r & 3); const float x = (jj <= ii) ? acc[r] : 0.f;
                        *(LAS unsigned short*)(AL + ii * 144 + jj * 2) = (unsigned short)(pk2(x, 0.f) & 0xffffu); }
                }
                __syncthreads();
                { const int it = wave >> 2, vt = wave & 3;
                  f32x16 acc;
#pragma unroll
                  for (int r = 0; r < 16; ++r) acc[r] = 0.f;
#pragma unroll
                  for (int s4 = 0; s4 < 4; ++s4) {
                      const bf16x8 a = *(const LAS bf16x8*)(AL + (it * 32 + lr) * 144 + (s4 * 16 + 8 * lh) * 2);
                      const bf16x8 bb = *(const LAS bf16x8*)(VTL + (vt * 32 + lr) * 144 + (s4 * 16 + 8 * lh) * 2);
                      acc = __builtin_amdgcn_mfma_f32_32x32x16_bf16(a, bb, acc, 0, 0, 0); }
#pragma unroll
                  for (int s8 = 0; s8 < 8; ++s8) {
                      const bf16x8 a = *(const LAS bf16x8*)(QSL + (it * 32 + lr) * 272 + (s8 * 16 + 8 * lh) * 2);
                      const bf16x8 bb = *(const LAS bf16x8*)(SPL + (vt * 32 + lr) * 272 + (s8 * 16 + 8 * lh) * 2);
                      acc = __builtin_amdgcn_mfma_f32_32x32x16_bf16(a, bb, acc, 0, 0, 0); }
#pragma unroll
                  for (int r = 0; r < 16; ++r) { float q2 = acc[r] * acc[r];
                      q2 = xsum16(rowsum16(q2));
                      if (lr == 0) SSQ[vt * 64 + it * 32 + 8 * (r >> 2) + 4 * lh + (r & 3)] = q2; }
                  __syncthreads();
                  const int colg = col0 + vt * 32 + lr; const float gg = g_hg[l * 1024 + colg];
#pragma unroll
                  for (int r = 0; r < 16; ++r) { const int ii = it * 32 + 8 * (r >> 2) + 4 * lh + (r & 3);
                      const float ss = SSQ[ii] + SSQ[64 + ii] + SSQ[128 + ii] + SSQ[192 + ii]; const float rn = 1.0f / sqrtf(ss * (1.f / 128.f) + 1e-6f);
                      YAB[(row0 + ii) * 2048 + colg] = (bf16)(pk2(acc[r] * rn * gg * gav[r], 0.f) & 0xffffu); }
                }
                __syncthreads();
            }
        }
#undef HC_REQ
        PHASE_END
        PHASE_BEGIN
        for (int ub = blk * NWAVES; ub < 2048; ub += NGW) {
            const int unit = ub + wave;
            const int b = ub >> 9, j = unit & 511, lr = lane & 31, lh = lane >> 5;
            const int qsel = (lr >> 2) & 1, head = (lr >> 3) * 4 + (lr & 3);
            const int qlo = 4 * j, qhi = 4 * (1023 - j);
            const int nlo = ((qlo >> 6) + 1) * 64, nhi = ((qhi >> 6) + 1) * 64;
            const int nlo8 = (nlo + 511) & ~511, nhi8 = (nhi + 511) & ~511;
            const int nmax8 = (((((4 * (1023 - (ub & 511))) >> 6) + 1) * 64) + 511) & ~511;
            bf16x8 A[4][4]; float W[4][16]; typedef float f32x2_t __attribute__((ext_vector_type(2)));
#pragma unroll
            for (int p = 0; p < 4; ++p) { const size_t qb = (size_t)b * SEQ + (p < 2 ? qlo + 2 * p : qhi + 2 * (p - 2));
#pragma unroll
                for (int ks = 0; ks < 4; ++ks) A[p][ks] = *(const bf16x8*)(QIDX + (qb + qsel) * 1024 + head * 64 + ks * 16 + lh * 8);
#pragma unroll
                for (int r4 = 0; r4 < 4; ++r4) { const f32x4 w = *(const f32x4*)(IDXW + (qb + lh) * 16 + r4 * 4); W[p][r4 * 4] = w[0]; W[p][r4 * 4 + 1] = w[1]; W[p][r4 * 4 + 2] = w[2]; W[p][r4 * 4 + 3] = w[3]; } }
            const bf16* kb = KIDX + (size_t)b * SEQ * 64;
            const int srow = 8 * wave + (lane >> 3), spc = ((lane & 7) ^ ((srow >> 1) & 7)) * 8;
#define P4_STAGE(C0_, BUF_) do { _Pragma("unroll") for (int i = 0; i < 4; ++i) \
                __builtin_amdgcn_global_load_lds((const unsigned*)(kb + (size_t)((C0_) + 64 * i + srow) * 64 + spc), (LAS unsigned*)(lds + (BUF_) * 32768 + (i * 8 + wave) * 1024), 16, 0, 0); } while (0)
            P4_STAGE(0, 0);
            asm volatile("s_waitcnt vmcnt(0)" ::: "memory");
            __syncthreads();
            for (int c0 = 0; c0 < nmax8; c0 += 256) {
                const int cb = (c0 >> 8) & 1; const bool more = c0 + 256 < nmax8;
                if (more) P4_STAGE(c0 + 256, cb ^ 1);
                LAS unsigned char* kbuf = lds + cb * 32768;
#pragma unroll 1
                for (int tl = 0; tl < 8; ++tl) {
                    const int s0 = c0 + tl * 32;
                    if (s0 >= nhi8) break;
#pragma unroll
                    for (int p = 0; p < 4; ++p) { const int np = p < 2 ? nlo : nhi, np8 = p < 2 ? nlo8 : nhi8;
                        if (s0 >= np && s0 < np8) { const size_t q = (size_t)b * SEQ + (p < 2 ? qlo + 2 * p : qhi + 2 * (p - 2)) + lh; ISC[q * 4096 + s0 + lr] = (_Float16)(-60000.0f); } }
                    if (s0 >= nhi) continue;
                    bf16x8 B[4];
#pragma unroll
                    for (int ks = 0; ks < 4; ++ks) B[ks] = *(const LAS bf16x8*)(kbuf + (tl * 32 + lr) * 128 + (((2 * ks + lh) ^ ((lr >> 1) & 7)) * 16));
#define IDX_FINISH(P_, ACC_) do { f32x2_t s2_ = {0.f, 0.f};     \
                        _Pragma("unroll") for (int r = 0; r < 16; r += 2) { const float a0_ = ACC_[r], a1_ = ACC_[r + 1]; const int i0_ = __builtin_bit_cast(int, a0_), i1_ = __builtin_bit_cast(int, a1_); \
                            const f32x2_t rl_ = {__builtin_bit_cast(float, i0_ > 0 ? i0_ : 0), __builtin_bit_cast(float, i1_ > 0 ? i1_ : 0)}; const f32x2_t w_ = {W[P_][r], W[P_][r + 1]}; \
                            s2_ = __builtin_elementwise_fma(rl_, w_, s2_); } \
                        const float sc_ = s2_[0] + s2_[1]; \
                        const size_t q_ = (size_t)b * SEQ + ((P_) < 2 ? qlo + 2 * (P_) : qhi + 2 * ((P_) - 2)) + lh; ISC[q_ * 4096 + s0 + lr] = (_Float16)sc_; } while (0)
                    if (s0 < nlo) {
                        f32x16 c0_, c1_, c2_, c3_;
#pragma unroll
                        for (int r = 0; r < 16; ++r) { c0_[r] = 0.f; c1_[r] = 0.f; c2_[r] = 0.f; c3_[r] = 0.f; }
#pragma unroll
                        for (int ks = 0; ks < 4; ++ks) { c0_ = __builtin_amdgcn_mfma_f32_32x32x16_bf16(A[0][ks], B[ks], c0_, 0, 0, 0); c1_ = __builtin_amdgcn_mfma_f32_32x32x16_bf16(A[1][ks], B[ks], c1_, 0, 0, 0);
                            c2_ = __builtin_amdgcn_mfma_f32_32x32x16_bf16(A[2][ks], B[ks], c2_, 0, 0, 0); c3_ = __builtin_amdgcn_mfma_f32_32x32x16_bf16(A[3][ks], B[ks], c3_, 0, 0, 0); }
                        IDX_FINISH(0, c0_); IDX_FINISH(1, c1_); IDX_FINISH(2, c2_); IDX_FINISH(3, c3_);
                    } else {
                        f32x16 c2_, c3_;
#pragma unroll
                        for (int r = 0; r < 16; ++r) { c2_[r] = 0.f; c3_[r] = 0.f; }
#pragma unroll
                        for (int ks = 0; ks < 4; ++ks) { c2_ = __builtin_amdgcn_mfma_f32_32x32x16_bf16(A[2][ks], B[ks], c2_, 0, 0, 0); c3_ = __builtin_amdgcn_mfma_f32_32x32x16_bf16(A[3][ks], B[ks], c3_, 0, 0, 0); }
                        IDX_FINISH(2, c2_); IDX_FINISH(3, c3_);
                    }
#undef IDX_FINISH
                }
                asm volatile("s_waitcnt vmcnt(0)" ::: "memory");
                __syncthreads();
            }
        }
#undef P4_STAGE
        PHASE_END
        GRID_BAR();
        }
        for (int rep_ = 0; rep_ < REP_P5; ++rep_) {
        PHASE_BEGIN
        {
            LAS unsigned char* VB = lds + wave * 18432;
            LAS unsigned short* SELW = (LAS unsigned short*)(VB + 17408);
            const int hd = lane & 15, g = lane >> 4, qq = hd >> 2, pp = hd & 3;
            const float slope = exp2f(-0.5f * (float)(hd + 1));
            for (int q = gw; q < M; q += NGW) {
                const int b = q / SEQ, pos = q % SEQ, qc = pos >> 6; const int nsel = qc < 4 ? (qc + 1) * 64 : 256;
                for (int rtk_ = 0; rtk_ < REP_TOPK; ++rtk_) {
                int lane_t = lane; asm volatile("" : "+v"(lane_t));
                if (qc < 4) { const unsigned e0 = 4 * lane_t; const bool ok = 4 * lane_t < nsel; v2u z; z.x = ok ? (e0 | ((e0 + 1) << 16)) : 0u; z.y = ok ? ((e0 + 2) | ((e0 + 3) << 16)) : 0u; *(LAS v2u*)(SELW + 4 * lane_t) = z; }
                else {
                    LAS unsigned* HIST = (LAS unsigned*)VB;
                    const int nb8 = (qc + 8) >> 3;
                    float v[64];
                    { unsigned pk[32]; const int i2max = 4 * nb8 - 1; const _Float16* irow = ISC + (size_t)q * 4096 + 2 * lane_t; typedef _Float16 h2_t __attribute__((ext_vector_type(2)));
#pragma unroll
                      for (int i2 = 0; i2 < 32; ++i2) { const int ic = i2 < i2max ? i2 : i2max; pk[i2] = *(const unsigned*)(irow + ic * 128); }
#pragma unroll
                      for (int i2 = 0; i2 < 32; ++i2) { const float lim = (i2 >> 2) < nb8 ? 3.0e38f : -1.0e30f; const h2_t h = __builtin_bit_cast(h2_t, pk[i2]);
                          const float f0 = (float)h[0], f1 = (float)h[1]; v[2 * i2] = fminf(f0, lim); v[2 * i2 + 1] = fminf(f1, lim); } }
                    float vmx = v[0], vmn = fminf(fminf(v[0], v[1]), fminf(v[2], v[3]));
#pragma unroll
                    for (int i = 1; i < 64; ++i) vmx = fmaxf(vmx, v[i]);
                    vmx = wmax_f(vmx); vmn = -wmax_f(-vmn);
                    const float rng = vmx - vmn; const float s20 = rng > 0.f ? 1048574.0f / rng : 0.f;
#define ZERO_HIST() do { *(LAS v4u*)(HIST + 16 * lane) = (v4u){0u, 0u, 0u, 0u}; *(LAS v4u*)(HIST + 16 * lane + 4) = (v4u){0u, 0u, 0u, 0u}; *(LAS v4u*)(HIST + 16 * lane + 8) = (v4u){0u, 0u, 0u, 0u}; \
                        *(LAS v4u*)(HIST + 16 * lane + 12) = (v4u){0u, 0u, 0u, 0u}; HIST[1024 + lane] = 0u; } while (0)
#define SCAN_HIST(R_, BIN_, AB_) do { unsigned hh_[16]; const int hb_ = 1008 - 16 * lane; \
                        { const v4u h0 = *(const LAS v4u*)(HIST + hb_), h1 = *(const LAS v4u*)(HIST + hb_ + 4), h2 = *(const LAS v4u*)(HIST + hb_ + 8), h3 = *(const LAS v4u*)(HIST + hb_ + 12); \
                          hh_[0] = h0.x; hh_[1] = h0.y; hh_[2] = h0.z; hh_[3] = h0.w; hh_[4] = h1.x; hh_[5] = h1.y; hh_[6] = h1.z; hh_[7] = h1.w; hh_[8] = h2.x; hh_[9] = h2.y; hh_[10] = h2.z; hh_[11] = h2.w; hh_[12] = h3.x; hh_[13] = h3.y; hh_[14] = h3.z; hh_[15] = h3.w; } \
                        unsigned tot_ = 0u; _Pragma("unroll") for (int k = 0; k < 16; ++k) tot_ += hh_[k]; \
                        unsigned run_ = wprefix_u(tot_) - tot_; int fb_ = -1; unsigned fa_ = 0u; \
                        _Pragma("unroll") for (int k = 15; k >= 0; --k) { if (run_ < (R_) && run_ + hh_[k] >= (R_)) { fb_ = hb_ + k; fa_ = run_; } run_ += hh_[k]; } \
                        const unsigned long long bm_ = __ballot(fb_ >= 0); const int L_ = (int)__builtin_ctzll(bm_); \
                        BIN_ = (unsigned)__builtin_amdgcn_readlane(fb_, L_); AB_ = (unsigned)__builtin_amdgcn_readlane((int)fa_, L_); } while (0)
                    ZERO_HIST();
#pragma unroll
                    for (int i = 0; i < 64; ++i) v[i] = __builtin_bit_cast(float, (unsigned)((v[i] - vmn) * s20));
#define cd(i_) __builtin_bit_cast(unsigned, v[i_])
#pragma unroll
                    for (int g8 = 0; g8 < 8; ++g8) { if (g8 < nb8) {
#pragma unroll
                        for (int j = 0; j < 8; ++j) __hip_atomic_fetch_add(HIST + (cd(g8 * 8 + j) >> 10), 1u, __ATOMIC_RELAXED, __HIP_MEMORY_SCOPE_WORKGROUP); } }
                    LDS_WAIT(); asm volatile("" ::: "memory");
                    unsigned tb, above; SCAN_HIST(256u, tb, above);
                    ZERO_HIST();
                    LDS_WAIT(); asm volatile("" ::: "memory");
#pragma unroll
                    for (int g8 = 0; g8 < 8; ++g8) { if (g8 < nb8) {
#pragma unroll
                        for (int j = 0; j < 8; ++j) { const unsigned c = cd(g8 * 8 + j); const unsigned a = (c >> 10) == tb ? (c & 1023u) : 1024u + lane; __hip_atomic_fetch_add(HIST + a, 1u, __ATOMIC_RELAXED, __HIP_MEMORY_SCOPE_WORKGROUP); } } }
                    LDS_WAIT(); asm volatile("" ::: "memory");
                    unsigned tb2, ab2; { const unsigned R2 = 256u - above; SCAN_HIST(R2, tb2, ab2); }
                    const unsigned T = (tb << 10) | tb2; above += ab2;
                    unsigned baseg = 0u, basee = above;
#pragma unroll
                    for (int g8 = 0; g8 < 8; ++g8) { if (g8 < nb8) {
#pragma unroll
                        for (int j = 0; j < 8; ++j) { const int i = g8 * 8 + j;
                            const bool gt = cd(i) > T; const unsigned long long bg = __ballot(gt);
                            const unsigned pgp = baseg + __builtin_amdgcn_mbcnt_hi((unsigned)(bg >> 32), __builtin_amdgcn_mbcnt_lo((unsigned)bg, 0u));
                            if (gt) SELW[pgp] = (unsigned short)((i >> 1) * 128 + (i & 1) + 2 * lane);
                            baseg += (unsigned)__popcll(bg);
                            const bool eq = cd(i) == T; const unsigned long long be = __ballot(eq);
                            if (be) { const unsigned pep = basee + __builtin_amdgcn_mbcnt_hi((unsigned)(be >> 32), __builtin_amdgcn_mbcnt_lo((unsigned)be, 0u));
                                if (eq && pep < 256u) SELW[pep] = (unsigned short)((i >> 1) * 128 + (i & 1) + 2 * lane);
                                basee += (unsigned)__popcll(be); } } } }
#undef cd
#undef ZERO_HIST
#undef SCAN_HIST
                }
                LDS_WAIT(); asm volatile("" ::: "memory");
                }
                for (int rat_ = 0; rat_ < REP_ATT; ++rat_) {
                bf16* qrow = QB + (size_t)q * 4096;
                bf16x8 Bq[8];
#pragma unroll
                for (int ks = 0; ks < 8; ++ks) Bq[ks] = *(const bf16x8*)(qrow + hd * 256 + ks * 32 + g * 8);
                const bf16* kvb = CKV + (size_t)b * SEQ * 256;
                f32x4 O[16];
#pragma unroll
                for (int ct = 0; ct < 16; ++ct) O[ct] = (f32x4){0.f, 0.f, 0.f, 0.f};
                float mrun = -1.0e30f, lsum = 0.f;
                LDS_WAIT(); asm volatile("" ::: "memory");
                const int nks = nsel >> 5;
                const int lrow = lane >> 5, lcp = lane & 31;
                v4u KR[16];
#define ATT_LOADROWS(KST_) do { _Pragma("unroll") for (int i = 0; i < 16; ++i) { const int rr_ = 2 * i + lrow; const int ix_ = SELW[32 * (KST_) + rr_]; \
                    KR[i] = *(const v4u*)(kvb + (size_t)ix_ * 256 + ((lcp ^ (rr_ & 7)) * 8)); } } while (0)
                ATT_LOADROWS(0);
                const int rlA = hd & 7;
                const int rlT = (4 * g + qq) & 7;
                const int trb = (4 * g + qq) * 512 + 8 * (pp & 1), trm = 16 * ((pp >> 1) ^ rlT);
                for (int kst = 0; kst < nks; ++kst) {
                    int rlA_ = rlA, trm_ = trm; asm volatile("" : "+v"(rlA_), "+v"(trm_));
                    if (kst + 1 < nks) {
#pragma unroll
                        for (int i = 0; i < 16; ++i) { *(LAS v4u*)(VB + i * 1024 + lane * 16) = KR[i];
                            const int rr_ = 2 * i + lrow; const int ix_ = SELW[32 * (kst + 1) + rr_]; KR[i] = *(const v4u*)(kvb + (size_t)ix_ * 256 + ((lcp ^ (rr_ & 7)) * 8)); }
                    } else {
#pragma unroll
                        for (int i = 0; i < 16; ++i) *(LAS v4u*)(VB + i * 1024 + lane * 16) = KR[i]; }
                    LDS_WAIT(); asm volatile("" ::: "memory");
                    f32x4 S0 = {0.f, 0.f, 0.f, 0.f}, S1 = {0.f, 0.f, 0.f, 0.f};
#pragma unroll
                    for (int k4 = 0; k4 < 4; ++k4) {
                        bf16x8 a0[2], a1[2];
#pragma unroll
                        for (int j = 0; j < 2; ++j) { const int ks = k4 * 2 + j; const int cpos = (4 * ks + g) ^ rlA_;
                            a0[j] = *(const LAS bf16x8*)(VB + hd * 512 + cpos * 16); a1[j] = *(const LAS bf16x8*)(VB + (16 + hd) * 512 + cpos * 16); }
#pragma unroll
                        for (int j = 0; j < 2; ++j) { const int ks = k4 * 2 + j;
                            S0 = __builtin_amdgcn_mfma_f32_16x16x32_bf16(a0[j], Bq[ks], S0, 0, 0, 0); S1 = __builtin_amdgcn_mfma_f32_16x16x32_bf16(a1[j], Bq[ks], S1, 0, 0, 0); }
                    }
                    const v2u pa = *(const LAS v2u*)(SELW + 32 * kst + 4 * g), pb = *(const LAS v2u*)(SELW + 32 * kst + 16 + 4 * g);
                    const float fp = (float)pos;
                    float s0[4], s1[4];
                    s0[0] = S0[0] - slope * fabsf(fp - (float)(pa.x & 0xffffu)); s0[1] = S0[1] - slope * fabsf(fp - (float)(pa.x >> 16));
                    s0[2] = S0[2] - slope * fabsf(fp - (float)(pa.y & 0xffffu)); s0[3] = S0[3] - slope * fabsf(fp - (float)(pa.y >> 16));
                    s1[0] = S1[0] - slope * fabsf(fp - (float)(pb.x & 0xffffu)); s1[1] = S1[1] - slope * fabsf(fp - (float)(pb.x >> 16));
                    s1[2] = S1[2] - slope * fabsf(fp - (float)(pb.y & 0xffffu)); s1[3] = S1[3] - slope * fabsf(fp - (float)(pb.y >> 16));
                    float ml = fmaxf(fmaxf(fmaxf(s0[0], s0[1]), fmaxf(s0[2], s0[3])), fmaxf(fmaxf(s1[0], s1[1]), fmaxf(s1[2], s1[3])));
                    ml = xmax16(ml); ml = xmax32(ml);
                    const float mnew = fmaxf(mrun, ml), alpha = __expf(mrun - mnew); mrun = mnew;
                    float p0[4], p1[4];
#pragma unroll
                    for (int r = 0; r < 4; ++r) { p0[r] = __expf(s0[r] - mnew); p1[r] = __expf(s1[r] - mnew); }
                    lsum = lsum * alpha + ((p0[0] + p0[1]) + (p0[2] + p0[3])) + ((p1[0] + p1[1]) + (p1[2] + p1[3]));
                    v4u pw; pw.x = pk2(p0[0], p0[1]); pw.y = pk2(p0[2], p0[3]); pw.z = pk2(p1[0], p1[1]); pw.w = pk2(p1[2], p1[3]);
                    const bf16x8 Pf = __builtin_bit_cast(bf16x8, pw);
#pragma unroll
                    for (int ct = 0; ct < 16; ++ct) O[ct] = O[ct] * alpha;
#pragma unroll
                    for (int c8 = 0; c8 < 4; ++c8) {
                        v4s lo[4], hi[4];
#pragma unroll
                        for (int j = 0; j < 4; ++j) { const int ct = c8 * 4 + j; const int off = trb + ((32 * ct) ^ trm_);
                            lo[j] = __builtin_amdgcn_ds_read_tr16_b64_v4i16((LAS v4s*)(VB + off));
                            hi[j] = __builtin_amdgcn_ds_read_tr16_b64_v4i16((LAS v4s*)(VB + 16 * 512 + off)); }
#pragma unroll
                        for (int j = 0; j < 4; ++j) { const int ct = c8 * 4 + j;
                            const bf16x8 Af = {lo[j][0], lo[j][1], lo[j][2], lo[j][3], hi[j][0], hi[j][1], hi[j][2], hi[j][3]};
                            O[ct] = __builtin_amdgcn_mfma_f32_16x16x32_bf16(Af, Pf, O[ct], 0, 0, 0); }
                    }
                    LDS_WAIT(); asm volatile("" ::: "memory");
                }
#undef ATT_LOADROWS
                lsum = xsum16(lsum); lsum = xsum32(lsum);
                const float inv = 1.0f / lsum;
#pragma unroll
                for (int ct = 0; ct < 16; ++ct) { const f32x4 o = O[ct] * inv; v2u w; w.x = pk2(o[0], o[1]); w.y = pk2(o[2], o[3]); *(v2u*)(OB + (size_t)q * 4096 + hd * 256 + 16 * ct + 4 * g) = w; }
                }
            }
        }
        PHASE_END
        GRID_BAR();
        }
        PHASE_BEGIN
        { pg8::Gemm g{OB, W6, M, 1024, 1024, 4096, 1024, 1024}; pg8::StaticOrder S; S.init(M, 1024, G, blk);
          EpiBf E{YAB, 2048, 1024}; pg8::gemm_phase(lds, g, S, E, tid); }
        PHASE_END
        GRID_BAR();
        PHASE_BEGIN
        { pg8::Gemm g{YAB, W7, M, DM, DM, DM, DM, 0}; pg8::StaticOrder S; S.init(M, DM, G, blk);
          EpiGateM E{GTB, MRG}; HookGate Hk{GTA, GTB}; pg8::gemm_phase(lds, g, S, E, tid, Hk); }
        PHASE_END
        GRID_BAR();
        PHASE_BEGIN
        { pg8::Gemm g{MRG, W8, M, DM, DM, DM, DM, 0}; pg8::StaticOrder S; S.init(M, DM, G, blk);
          EpiRes E{(l == 0) ? x_in : (const float*)nullptr, XB, RB, modl + 2 * DM}; pg8::gemm_phase(lds, g, S, E, tid); }
        PHASE_END
        GRID_BAR();
        for (int rep_ = 0; rep_ < REP_P9; ++rep_) {
        PHASE_BEGIN
        f32x4 lg[8], lb_[8]; v2u nx[8];
#pragma unroll
        for (int j = 0; j < 8; ++j) { const int c = j * 256 + lane * 4; lg[j] = *(const f32x4*)(ln1_g + l * DM + c); lb_[j] = *(const f32x4*)(ln1_b + l * DM + c); nx[j] = *(const v2u*)(RB + (size_t)gw * DM + c); }
        for (int row = gw; row < M; row += NGW) {
            const int b = row / SEQ; const float* md = modl + (size_t)b * MODW;
            f32x4 v[8]; float s = 0.f;
#pragma unroll
            for (int j = 0; j < 8; ++j) { v[j] = (f32x4){bflo(nx[j].x), bfhi(nx[j].x), bflo(nx[j].y), bfhi(nx[j].y)}; s += (v[j][0] + v[j][1]) + (v[j][2] + v[j][3]); }
            { const int rn = row + NGW < M ? row + NGW : row;
#pragma unroll
              for (int j = 0; j < 8; ++j) nx[j] = *(const v2u*)(RB + (size_t)rn * DM + j * 256 + lane * 4); }
            const float mean = wave_sum(s) * (1.f / DM); float s2 = 0.f;
#pragma unroll
            for (int j = 0; j < 8; ++j) { v[j] = v[j] - mean; s2 += (v[j][0] * v[j][0] + v[j][1] * v[j][1]) + (v[j][2] * v[j][2] + v[j][3] * v[j][3]); }
            const float rstd = 1.0f / sqrtf(wave_sum(s2) * (1.f / DM) + 1e-5f);
#pragma unroll
            for (int j = 0; j < 8; ++j) { const int c = j * 256 + lane * 4; const f32x4 gg = lg[j], bb = lb_[j];
                const f32x4 y = v[j] * rstd * gg + bb; { v2u wx; wx.x = pk2(y[0], y[1]); wx.y = pk2(y[2], y[3]); *(v2u*)(XB + (size_t)row * DM + c) = wx; }
                const f32x4 sc = *(const f32x4*)(md + 4 * DM + c), sh = *(const f32x4*)(md + 3 * DM + c); const f32x4 hh = y * (sc + 1.f) + sh;
                v2u w; w.x = pk2(hh[0], hh[1]); w.y = pk2(hh[2], hh[3]); *(v2u*)(HB + (size_t)row * DM + c) = w; }
        }
        PHASE_END
        GRID_BAR();
        }
        PHASE_BEGIN
        { pg8::Gemm g{HB, W10, M, N10, DM, DM, DM, 0}; pg8::StaticOrder S; S.init(M, N10, G, blk);
          EpiSwiglu E{ACT}; pg8::gemm_phase(lds, g, S, E, tid); }
        PHASE_END
        GRID_BAR();
        PHASE_BEGIN
        { pg8::Gemm g{ACT, W11, M, DM, DFF, DFF, DFF, 0}; pg8::StaticOrder S; S.init(M, DM, G, blk);
          EpiRes E{(const float*)nullptr, XB, RB, modl + 5 * DM}; pg8::gemm_phase(lds, g, S, E, tid); }
        PHASE_END
        GRID_BAR();
        for (int rep_ = 0; rep_ < REP_P12; ++rep_) {
        PHASE_BEGIN
        {
            const bool lastl = (l == DEPTH - 1); const float* mdn = MOD + (size_t)(l + 1 < DEPTH ? l + 1 : l) * NBATCH * MODW;
            f32x4 lg[8], lb_[8]; v2u nx[8];
#pragma unroll
            for (int j = 0; j < 8; ++j) { const int c = j * 256 + lane * 4; lg[j] = *(const f32x4*)(ln2_g + l * DM + c); lb_[j] = *(const f32x4*)(ln2_b + l * DM + c); nx[j] = *(const v2u*)(RB + (size_t)gw * DM + c); }
            for (int row = gw; row < M; row += NGW) {
                const int b = row / SEQ; const float* md = mdn + (size_t)b * MODW;
                f32x4 v[8]; float s = 0.f;
#pragma unroll
                for (int j = 0; j < 8; ++j) { v[j] = (f32x4){bflo(nx[j].x), bfhi(nx[j].x), bflo(nx[j].y), bfhi(nx[j].y)}; s += (v[j][0] + v[j][1]) + (v[j][2] + v[j][3]); }
                { const int rn = row + NGW < M ? row + NGW : row;
#pragma unroll
                  for (int j = 0; j < 8; ++j) nx[j] = *(const v2u*)(RB + (size_t)rn * DM + j * 256 + lane * 4); }
                const float mean = wave_sum(s) * (1.f / DM); float s2 = 0.f;
#pragma unroll
                for (int j = 0; j < 8; ++j) { v[j] = v[j] - mean; s2 += (v[j][0] * v[j][0] + v[j][1] * v[j][1]) + (v[j][2] * v[j][2] + v[j][3] * v[j][3]); }
                const float rstd = 1.0f / sqrtf(wave_sum(s2) * (1.f / DM) + 1e-5f);
#pragma unroll
                for (int j = 0; j < 8; ++j) { const int c = j * 256 + lane * 4; const f32x4 gg = lg[j], bb = lb_[j];
                    const f32x4 y = v[j] * rstd * gg + bb; if (lastl) *(f32x4*)(args.out + (size_t)row * DM + c) = y; else { v2u wx; wx.x = pk2(y[0], y[1]); wx.y = pk2(y[2], y[3]); *(v2u*)(XB + (size_t)row * DM + c) = wx; }
                    const f32x4 sc = *(const f32x4*)(md + DM + c), sh = *(const f32x4*)(md + c); const f32x4 hh = y * (sc + 1.f) + sh;
                    v2u w; w.x = pk2(hh[0], hh[1]); w.y = pk2(hh[2], hh[3]); *(v2u*)(HB + (size_t)row * DM + c) = w; }
            }
            if (l + 1 < DEPTH) { __syncthreads(); CONVERT_LAYER(l + 1); }
        }
        PHASE_END
        if (l + 1 < DEPTH || rep_ + 1 < REP_P12) GRID_BAR();
        }
    }
}

extern "C" void kernel_launch(void* const* d_in, const int* in_sizes, int n_in, void* d_out, int out_size, void* d_ws, size_t ws_size, hipStream_t stream) {
    static int grid = 0;
    if (grid == 0) {
        if (n_in != 22 || out_size != M * DM || ws_size < WS_END) { fprintf(stderr, "kernel_launch: unexpected shapes (n_in %d, out %d, ws %zu < %zu)\n", n_in, out_size, ws_size, (size_t)WS_END); grid = -1; return; }
        int dev = 0, cus = 0, per_cu = 0;
        if (hipGetDevice(&dev) != hipSuccess || hipDeviceGetAttribute(&cus, hipDeviceAttributeMultiprocessorCount, dev) != hipSuccess) { grid = -1; return; }
        if (hipFuncSetAttribute((const void*)fwd_kernel, hipFuncAttributeMaxDynamicSharedMemorySize, LDS_BYTES) != hipSuccess) { fprintf(stderr, "kernel_launch: hipFuncSetAttribute failed\n"); grid = -1; return; }
        if (hipOccupancyMaxActiveBlocksPerMultiprocessor(&per_cu, (const void*)fwd_kernel, NTHR, LDS_BYTES) != hipSuccess || per_cu < 1) { fprintf(stderr, "kernel_launch: occupancy query says %d\n", per_cu); }
        (void)hipGetLastError();
        grid = cus;
    }
    if (grid < 0) return;
    if (hipMemsetAsync((char*)d_ws + WS_CTL, 0, CTL_ZERO_BYTES, stream) != hipSuccess) return;
    Args a{};
    for (int i = 0; i < 22; ++i) a.in[i] = (const float*)d_in[i];
    a.out = (float*)d_out; a.ws = (unsigned char*)d_ws;
    hipLaunchKernelGGL(fwd_kernel, dim3(grid), dim3(NTHR), LDS_BYTES, stream, a);
}
```

```cpp
#include <hip/hip_runtime.h>
#include <cstdio>
#include <cstdint>

namespace pg8 {
#define PG8_LAS __attribute__((address_space(3)))
typedef unsigned short bf16_t;
typedef short bf16x8 __attribute__((ext_vector_type(8)));
typedef float f32x4 __attribute__((ext_vector_type(4)));
typedef unsigned u32x4 __attribute__((ext_vector_type(4)));
constexpr int BM = 256, BK = 64, HALF = 128, HTB = HALF * BK * 2, STAGE_BYTES = 8 * HTB, NXCD = 8, WGM = 8;

__host__ __device__ __forceinline__ int lds_byte(int r, int c) { const int st = (r >> 4) * 2 + (c >> 5), rr = r & 15, cc = c & 31, ob = rr * 64 + cc * 2; return st * 1024 + (ob ^ (((ob >> 9) & 1) << 5)); }
__host__ __device__ __forceinline__ void stage_rc(int b, int& R, int& C) { const int st = b / 1024, sb = b % 1024, swz = sb ^ (((sb >> 9) & 1) << 5); R = (st >> 1) * 16 + swz / 64; C = (st & 1) * 32 + (swz % 64) / 2; }
__host__ __device__ __forceinline__ int perm32(int rho) { const int n = rho >> 4, i = rho & 15; return 8 * (i >> 2) + 4 * n + (i & 3); }

struct Unit { int pm, pn; };
struct Gemm { const bf16_t* A; const bf16_t* Bt; int M, N, K, lda, ldb, a_pn_stride; };

struct StaticOrder {
    int nM, nN, nwg, G, c;
    __host__ __device__ void init(int M, int N, int G_, int c_) { nM = M / BM; nN = N / BM; nwg = nM * nN; G = G_; c = c_; }
    __host__ __device__ bool next(int i, Unit& u) const {
        const long L = (long)i * G + c; if (L >= nwg) return false;
        int wgid = (int)L; { const int q = nwg / NXCD, r = nwg % NXCD, xcd = wgid % NXCD, off = wgid / NXCD; wgid = (xcd < r ? xcd * (q + 1) : r * (q + 1) + (xcd - r) * q) + off; }
        const int nig = WGM * nN, gid = wgid / nig, fm = gid * WGM, gsz = (nM - fm) < WGM ? (nM - fm) : WGM;
        u.pm = fm + ((wgid % nig) % gsz); u.pn = (wgid % nig) / gsz; return true;
    }
};

typedef float f32x2_t __attribute__((ext_vector_type(2))); typedef __bf16 bf16x2_t __attribute__((ext_vector_type(2)));
__device__ __forceinline__ unsigned cvt_pk_bf16(float lo, float hi) { f32x2_t v = {lo, hi}; bf16x2_t b = __builtin_convertvector(v, bf16x2_t); return __builtin_bit_cast(unsigned, b); }

struct NoHook { static constexpr bool ON = false; template <class A> __device__ __forceinline__ void mid(A&, const Unit&, int, int, int, int) const {} };
template <class Epi, class Hook = NoHook>
__device__ __forceinline__ void gemm_phase(PG8_LAS unsigned char* lds, const Gemm g, const StaticOrder& S, const Epi& E, const int tid, const Hook H = Hook()) {
    const int wid = __builtin_amdgcn_readfirstlane(tid >> 6), lane = tid & 63, wr = wid >> 2, wc = wid & 3, fr = lane & 15, fq = lane >> 4;
    const int K = g.K, nt = K / BK;
    unsigned voffA[2], voffB[2];
#pragma unroll
    for (int i = 0; i < 2; ++i) { int R, C; stage_rc(tid * 16 + i * 8192, R, C); const int Rb = 64 * (R >> 5) + perm32(R & 31);
        voffA[i] = (unsigned)(R * g.lda + C) * 2u; voffB[i] = (unsigned)(Rb * g.ldb + C) * 2u; }
    const size_t kstep = (size_t)(BK * 2);
    const size_t hstepA = (size_t)HALF * g.lda * 2, hstepB = (size_t)32 * g.ldb * 2;
    const size_t tstepA = 2 * hstepA, tstepB = (size_t)BM * g.ldb * 2;
    const unsigned ldsw = (unsigned)wid * 1024u;
    const int aoff = lds_byte(wr * 64 + fr, fq * 8), boff = lds_byte(wc * 32 + fr, fq * 8);
#define PG8_SA(b, h) (((b) * 2 + (h)) * HTB)
#define PG8_SB(b, h) ((4 + (b) * 2 + (h)) * HTB)
#define PG8_STAGE(bufoff, gbase, voff) do { _Pragma("unroll") for (int _i = 0; _i < 2; ++_i) \
        __builtin_amdgcn_global_load_lds((const unsigned*)((const char*)(gbase) + (voff)[_i]), (PG8_LAS unsigned*)(lds + (bufoff) + ldsw + _i * 8192), 16, 0, 0); } while (0)
#define PG8_LDA(dst, b, h) do { _Pragma("unroll") for (int m = 0; m < 4; ++m) _Pragma("unroll") for (int k = 0; k < 2; ++k) dst[m][k] = *(const PG8_LAS bf16x8*)(lds + PG8_SA(b, h) + aoff + m * 2048 + k * 1024); } while (0)
#define PG8_LDB(dst, b, h) do { _Pragma("unroll") for (int n = 0; n < 2; ++n) _Pragma("unroll") for (int k = 0; k < 2; ++k) dst[n][k] = *(const PG8_LAS bf16x8*)(lds + PG8_SB(b, h) + boff + n * 2048 + k * 1024); } while (0)
#define PG8_MMA(ai, bj, At, Bt) do { __builtin_amdgcn_s_setprio(1); _Pragma("unroll") for (int m = 0; m < 4; ++m) _Pragma("unroll") for (int n = 0; n < 2; ++n) _Pragma("unroll") for (int k = 0; k < 2; ++k) \
        acc[ai][bj][m][n] = __builtin_amdgcn_mfma_f32_16x16x32_bf16(Bt[n][k], At[m][k], acc[ai][bj][m][n], 0, 0, 0); __builtin_amdgcn_s_setprio(0); } while (0)
#define PG8_WAIT_V(n) asm volatile("s_waitcnt vmcnt(" #n ")" ::: "memory")
#define PG8_WAIT_L(n) asm volatile("s_waitcnt lgkmcnt(" #n ")" ::: "memory")
#define PG8_BAR __builtin_amdgcn_s_barrier()
#define PG8_SCHED __builtin_amdgcn_sched_barrier(0)
    Unit cur, nxt; int ui = 0;
    if (!S.next(0, cur)) return;
    f32x4 acc[2][2][4][2];
#pragma unroll
    for (int a = 0; a < 2; ++a)
#pragma unroll
        for (int b = 0; b < 2; ++b)
#pragma unroll
            for (int m = 0; m < 4; ++m)
#pragma unroll
                for (int n = 0; n < 2; ++n) acc[a][b][m][n] = (f32x4){0.f, 0.f, 0.f, 0.f};
    bf16x8 At[4][2], B0[2][2], B1[2][2];
    const char* cA = (const char*)g.A + (size_t)cur.pm * tstepA + (size_t)cur.pn * g.a_pn_stride * 2; const char* cB = (const char*)g.Bt + (size_t)cur.pn * tstepB;
    PG8_STAGE(PG8_SB(0, 0), cB, voffB); PG8_STAGE(PG8_SB(0, 1), cB + hstepB, voffB); PG8_STAGE(PG8_SA(0, 0), cA, voffA); PG8_STAGE(PG8_SA(0, 1), cA + hstepA, voffA);
    if (wr == 1) PG8_BAR;
    PG8_WAIT_V(2); PG8_BAR;
    PG8_STAGE(PG8_SB(1, 0), cB + kstep, voffB); PG8_STAGE(PG8_SA(1, 0), cA + kstep, voffA); PG8_STAGE(PG8_SB(1, 1), cB + hstepB + kstep, voffB);
    PG8_WAIT_V(6); PG8_BAR;
    for (;;) {
        const bool has_next = S.next(ui + 1, nxt);
        const char* nA = has_next ? (const char*)g.A + (size_t)nxt.pm * tstepA + (size_t)nxt.pn * g.a_pn_stride * 2 : cA; const char* nB = has_next ? (const char*)g.Bt + (size_t)nxt.pn * tstepB : cB;
        for (int t = 0; t < nt; t += 2) {
            const bool last = (t == nt - 2);
            const char* a1 = cA + (size_t)(t + 1) * kstep;
            const char* a2 = last ? nA : cA + (size_t)(t + 2) * kstep; const char* b2 = last ? nB : cB + (size_t)(t + 2) * kstep;
            const char* a3 = a2 + kstep; const char* b3 = b2 + kstep;
            if constexpr (Hook::ON) { if (t == (nt >> 1)) H.mid(acc, cur, wr, wc, fr, fq); }
            PG8_LDB(B0, 0, 0); PG8_LDB(B1, 0, 1); PG8_SCHED; PG8_LDA(At, 0, 0); PG8_STAGE(PG8_SA(1, 1), a1 + hstepA, voffA);
            PG8_WAIT_V(8); PG8_WAIT_L(0); PG8_BAR; PG8_MMA(0, 0, At, B0); PG8_MMA(0, 1, At, B1); PG8_BAR; PG8_SCHED;
            PG8_LDA(At, 0, 1); PG8_STAGE(PG8_SB(0, 0), b2, voffB); PG8_STAGE(PG8_SB(0, 1), b2 + hstepB, voffB); PG8_STAGE(PG8_SA(0, 0), a2, voffA);
            PG8_WAIT_V(8); PG8_WAIT_L(0); PG8_BAR; PG8_MMA(1, 0, At, B0); PG8_MMA(1, 1, At, B1); PG8_BAR; PG8_SCHED;
            PG8_LDB(B0, 1, 0); PG8_LDB(B1, 1, 1); PG8_SCHED; PG8_LDA(At, 1, 0); PG8_STAGE(PG8_SA(0, 1), a2 + hstepA, voffA);
            PG8_WAIT_V(8); PG8_WAIT_L(0); PG8_BAR; PG8_MMA(0, 0, At, B0); PG8_MMA(0, 1, At, B1); PG8_BAR; PG8_SCHED;
            PG8_LDA(At, 1, 1); PG8_STAGE(PG8_SB(1, 0), b3, voffB); PG8_STAGE(PG8_SB(1, 1), b3 + hstepB, voffB); PG8_STAGE(PG8_SA(1, 0), a3, voffA);
            PG8_WAIT_V(8); PG8_WAIT_L(0); PG8_BAR; PG8_MMA(1, 0, At, B0); PG8_MMA(1, 1, At, B1); PG8_BAR; PG8_SCHED;
        }
        if (wr == 0) PG8_BAR;
        E(acc, cur, wr, wc, fr, fq);
        if (!has_next) break;
#pragma unroll
        for (int a = 0; a < 2; ++a)
#pragma unroll
            for (int b = 0; b < 2; ++b)
#pragma unroll
                for (int m = 0; m < 4; ++m)
#pragma unroll
                    for (int n = 0; n < 2; ++n) acc[a][b][m][n] = (f32x4){0.f, 0.f, 0.f, 0.f};
        cur = nxt; cA = nA; cB = nB; ++ui;
        if (wr == 1) PG8_BAR;
    }
    PG8_WAIT_V(0);
    PG8_BAR;
#undef PG8_SA
#undef PG8_SB
#undef PG8_STAGE
#undef PG8_LDA
#undef PG8_LDB
#undef PG8_MMA
#undef PG8_WAIT_V
#undef PG8_WAIT_L
#undef PG8_BAR
#undef PG8_SCHED
}
}

constexpr int NWAVES = 8, NTHR = NWAVES * 64;
constexpr int DM = 2048, NBATCH = 4, SEQ = 4096, DEPTH = 4, M = NBATCH * SEQ;
constexpr int HGW = 1024;
constexpr int SAH = 16, SAC = 256, SAR = 512;
constexpr int DFF = 5632;
constexpr int N1 = 9216, N3 = 5120, N10 = 2 * DFF;
constexpr float ALPHA = 1.6817928305074292f;
constexpr int MODW = 6 * DM;

constexpr size_t MiB = 1u << 20;
constexpr size_t WS_CTL = 0, CTL_ZERO_BYTES = 32768;
constexpr size_t WS_MOD = 1 * MiB;
constexpr size_t WS_LB = 2 * MiB;
constexpr size_t WS_MODP = 3 * MiB;
constexpr size_t WS_W1 = 9 * MiB;
constexpr size_t WS_W3 = WS_W1 + 36 * MiB;
constexpr size_t WS_W6 = WS_W3 + 5 * MiB;
constexpr size_t WS_W7 = WS_W6 + 2 * MiB;
constexpr size_t WS_W8 = WS_W7 + 8 * MiB;
constexpr size_t WS_W10 = WS_W8 + 8 * MiB;
constexpr size_t WS_W11 = WS_W10 + 44 * MiB;
constexpr size_t WS_X = WS_W11 + 22 * MiB;
constexpr size_t WS_R = WS_X + 128 * MiB;
constexpr size_t WS_H = WS_R + 128 * MiB;
constexpr size_t WS_QA = WS_H + 64 * MiB;
constexpr size_t WS_FA = WS_QA + 32 * MiB;
constexpr size_t WS_IA = WS_FA + 64 * MiB;
constexpr size_t WS_GA = WS_IA + 32 * MiB;
constexpr size_t WS_LAT = WS_GA + 32 * MiB;
constexpr size_t WS_GTA = WS_LAT + 64 * MiB;
constexpr size_t WS_GTB = WS_GTA + 64 * MiB;
constexpr size_t WS_CQN = WS_GTB + 64 * MiB;
constexpr size_t WS_CKV = WS_CQN + 16 * MiB;
constexpr size_t WS_KIDX = WS_CKV + 8 * MiB;
constexpr size_t WS_IDXW = WS_KIDX + 2 * MiB;
constexpr size_t WS_QB = WS_IDXW + 1 * MiB;
constexpr size_t WS_QIDX = WS_QB + 128 * MiB;
constexpr size_t WS_SEL = WS_QIDX + 32 * MiB;
constexpr size_t WS_YAB = WS_SEL + 8 * MiB;
constexpr size_t WS_MRG = WS_FA;
constexpr size_t WS_OB = WS_YAB + 64 * MiB;
constexpr size_t WS_BIG = WS_OB + 128 * MiB;
constexpr size_t WS_KSB = WS_BIG + 256 * MiB;
constexpr size_t WS_DEB = WS_KSB + 32 * MiB;
constexpr size_t WS_QSB = WS_DEB + 2 * MiB;
constexpr size_t WS_END = WS_QSB + 32 * MiB;

constexpr int CW_BAR = 4096;

constexpr int RING_BYTES = 131072;
constexpr int LDS_BYTES = 163840;
constexpr int LDSCTL_OFF = LDS_BYTES - 1024, MISC_OFF = LDSCTL_OFF + 320, SELL_OFF = 147456;

#define GAS __attribute__((address_space(1)))
#define LAS __attribute__((address_space(3)))
typedef unsigned short bf16;
typedef unsigned v4u __attribute__((ext_vector_type(4)));
typedef unsigned v2u __attribute__((ext_vector_type(2)));
typedef float f32x4 __attribute__((ext_vector_type(4)));
typedef float f32x16 __attribute__((ext_vector_type(16)));
typedef short bf16x8 __attribute__((ext_vector_type(8)));
typedef short v4s __attribute__((ext_vector_type(4)));
typedef GAS unsigned gu32;
#define LDS_WAIT() asm volatile("s_waitcnt lgkmcnt(0)" ::: "memory")
__device__ __forceinline__ unsigned f2bf(float f) { unsigned u = __builtin_bit_cast(unsigned, f); return (u + 0x7fffu + ((u >> 16) & 1u)) >> 16; }
__device__ __forceinline__ unsigned pk2(float lo, float hi) { return pg8::cvt_pk_bf16(lo, hi); }
__device__ __forceinline__ float bf2f(unsigned short b) { return __builtin_bit_cast(float, ((unsigned)b) << 16); }
__device__ __forceinline__ float bflo(unsigned w) { return __builtin_bit_cast(float, w << 16); }
__device__ __forceinline__ float bfhi(unsigned w) { return __builtin_bit_cast(float, w & 0xffff0000u); }
__device__ __forceinline__ float sigm(float x) { return __builtin_amdgcn_rcpf(1.f + __expf(-x)); }

__device__ __forceinline__ int lane_id() { unsigned m = ~0u; asm volatile("" : "+s"(m)); return (int)__builtin_amdgcn_mbcnt_hi(m, __builtin_amdgcn_mbcnt_lo(m, 0u)); }
#define XB_TMO      128
#define XB_XCNT(j)  (256  + 64 * (j))
#define XB_XSUB(j)  (1280 + 64 * (j))
#define XB_XGEN(j)  (2304 + 64 * (j))
#define XB_TOP      3328
#define XB_TOPGEN   3392
#define XCD_BAR_WORDS 3456
#define XB_SPIN_CAP (1u << 22)

__device__ __forceinline__ unsigned xb_ld(unsigned* p)              { return __hip_atomic_load(p, __ATOMIC_RELAXED, __HIP_MEMORY_SCOPE_AGENT); }
__device__ __forceinline__ unsigned xb_add(unsigned* p, unsigned v) { return __hip_atomic_fetch_add(p, v, __ATOMIC_RELAXED, __HIP_MEMORY_SCOPE_AGENT); }
__device__ __forceinline__ unsigned xb_xcc_id() { return (unsigned)__builtin_amdgcn_s_getreg((3 << 11) | 20) & 0xFu; }
#define XB_SPIN(cond, bar) do { unsigned _sp = 0; while (cond) { __builtin_amdgcn_s_sleep(1); \
    if ((++_sp & 255u) == 0u) { if (xb_ld(&(bar)[XB_TMO])) break; if (_sp > XB_SPIN_CAP) { atomicAdd(&(bar)[XB_TMO], 1u); break; } } } } while (0)

struct XcdBarrier { unsigned* bar; unsigned x; volatile LAS unsigned* st; int wave; };

__device__ __forceinline__ XcdBarrier xcd_barrier_post(unsigned* bar, volatile LAS unsigned* st) {
    XcdBarrier b; b.bar = bar; b.x = (unsigned)__builtin_amdgcn_readfirstlane((int)xb_xcc_id()); b.st = st;
    if (threadIdx.x == 0) (void)xb_add(&bar[XB_XCNT(b.x)], 1u);
    return b;
}
__device__ __forceinline__ void xcd_barrier_complete(unsigned* bar, unsigned x, unsigned& nloc, unsigned& nx) {
    const unsigned G = gridDim.x * gridDim.y * gridDim.z;
    unsigned sum, cnt, mine, sp = 0u;
    for (;;) {
        sum = 0u; cnt = 0u; mine = 0u;
#pragma unroll 1
        for (unsigned j = 0; j < 16; ++j) { const unsigned c = xb_ld(&bar[XB_XCNT(j)]); sum += c; cnt += (c > 0u) ? 1u : 0u; mine = (j == x) ? c : mine; }
        if (sum == G) break;
        __builtin_amdgcn_s_sleep(1);
        if ((++sp & 255u) == 0u) { if (xb_ld(&bar[XB_TMO])) break; if (sp > XB_SPIN_CAP) { atomicAdd(&bar[XB_TMO], 1u); break; } }
    }
    nloc = mine > 0u ? mine : 1u; nx = cnt > 0u ? cnt : 1u;
}
__device__ __forceinline__ void xcd_barrier(const XcdBarrier& b) {
    asm volatile("s_waitcnt vmcnt(0)" ::: "memory");
    __syncthreads();
    if (b.wave == 0 && lane_id() == 0) {
        unsigned* bar = b.bar;
        unsigned bx = b.x; asm volatile("" : "+s"(bx));
        __builtin_amdgcn_s_waitcnt(0);
        unsigned nloc = b.st[0], nx = b.st[1];
        const unsigned old = xb_add(&bar[XB_XSUB(bx)], 1u);
        const unsigned gen = old / nloc;
        if (old + 1u == (gen + 1u) * nloc) {
            __builtin_amdgcn_fence(__ATOMIC_RELEASE, "agent");
            asm volatile("s_waitcnt vmcnt(0)" ::: "memory");
            const unsigned og = xb_add(&bar[XB_TOP], 1u);
            const unsigned tg = og / nx;
            if (og + 1u == (tg + 1u) * nx) xb_add(&bar[XB_TOPGEN], 1u);
            else XB_SPIN(xb_ld(&bar[XB_TOPGEN]) == tg, bar);
            __builtin_amdgcn_fence(__ATOMIC_ACQUIRE, "agent");
            xb_add(&bar[XB_XGEN(bx)], 1u);
            asm volatile("s_waitcnt vmcnt(0)" ::: "memory");
        } else {
            XB_SPIN(xb_ld(&bar[XB_XGEN(bx)]) == gen, bar);
            __builtin_amdgcn_fence(__ATOMIC_ACQUIRE, "agent");
            asm volatile("s_waitcnt vmcnt(0)" ::: "memory");
        }
    }
    __syncthreads();
}

__device__ __forceinline__ void xswap16(float& a, float& b) { asm volatile("s_nop 1\n\tv_permlane16_swap_b32 %0, %1\n\ts_nop 1" : "+v"(a), "+v"(b)); }
__device__ __forceinline__ void xswap32(float& a, float& b) { asm volatile("s_nop 1\n\tv_permlane32_swap_b32 %0, %1\n\ts_nop 1" : "+v"(a), "+v"(b)); }
__device__ __forceinline__ float xmax16(float x) { float a = x, b = x; xswap16(a, b); return fmaxf(a, b); }
__device__ __forceinline__ float xmax32(float x) { float a = x, b = x; xswap32(a, b); return fmaxf(a, b); }
__device__ __forceinline__ float xsum16(float x) { float a = x, b = x; xswap16(a, b); return a + b; }
__device__ __forceinline__ float xsum32(float x) { float a = x, b = x; xswap32(a, b); return a + b; }

#define DPPF(x, ctrl) __builtin_bit_cast(float, __builtin_amdgcn_update_dpp(0, __builtin_bit_cast(int, (x)), (ctrl), 0xf, 0xf, true))
__device__ __forceinline__ float wmax_f(float x) {
    x = fmaxf(x, DPPF(x, 0xB1)); x = fmaxf(x, DPPF(x, 0x4E)); x = fmaxf(x, DPPF(x, 0x124)); x = fmaxf(x, DPPF(x, 0x128));
    x = xmax16(x); return xmax32(x);
}
__device__ __forceinline__ unsigned wprefix_u(unsigned x) {
    int v = (int)x;
    v += __builtin_amdgcn_update_dpp(0, v, 0x111, 0xf, 0xf, false);
    v += __builtin_amdgcn_update_dpp(0, v, 0x112, 0xf, 0xf, false);
    v += __builtin_amdgcn_update_dpp(0, v, 0x114, 0xf, 0xf, false);
    v += __builtin_amdgcn_update_dpp(0, v, 0x118, 0xf, 0xf, false);
    v += __builtin_amdgcn_update_dpp(0, v, 0x142, 0xa, 0xf, false);
    v += __builtin_amdgcn_update_dpp(0, v, 0x143, 0xc, 0xf, false);
    return (unsigned)v;
}

__device__ __forceinline__ float rowsum16(float x) { x += DPPF(x, 0xB1); x += DPPF(x, 0x4E); x += DPPF(x, 0x124); x += DPPF(x, 0x128); return x; }
__device__ __forceinline__ float wave_sum(float x) { x = rowsum16(x); x = xsum16(x); return xsum32(x); }
__device__ __forceinline__ float wave_max(float x) { return wmax_f(x); }
__device__ __forceinline__ int wave_sum_i(int v) { float f = wave_sum((float)v); return (int)(f + 0.5f); }
template <class Src>
__device__ __forceinline__ void cvt_load(const Src& src, int k0, int n0, int lane, float (&tv)[32]) {
#pragma unroll
    for (int i = 0; i < 32; ++i) tv[i] = src(k0 + 2 * i + (lane >> 5), n0 + (lane & 31));
}
__device__ __forceinline__ void cvt_store(const float (&tv)[32], bf16* WT, int K, int k0, int n0, LAS float* scr, int lane) {
#pragma unroll
    for (int i = 0; i < 32; ++i) scr[(2 * i + (lane >> 5)) * 33 + (lane & 31)] = tv[i];
    LDS_WAIT(); asm volatile("" ::: "memory");
    const int c = lane & 7;
#pragma unroll
    for (int j = 0; j < 4; ++j) { const int n = (lane >> 3) + 8 * j; const LAS float* s = scr + (8 * c) * 33 + n;
        v4u o; o.x = pk2(s[0 * 33], s[1 * 33]); o.y = pk2(s[2 * 33], s[3 * 33]); o.z = pk2(s[4 * 33], s[5 * 33]); o.w = pk2(s[6 * 33], s[7 * 33]);
        *(GAS v4u*)(WT + (size_t)(n0 + n) * K + k0 + 8 * c) = o; }
    LDS_WAIT(); asm volatile("" ::: "memory");
}

struct Args { const float* in[22]; float* out; unsigned char* ws; };

using pg8::Unit; using pg8::cvt_pk_bf16;
__device__ __forceinline__ void st_bf16x8(bf16* p, f32x4 v0, f32x4 v1) {
    v4u w; w.x = cvt_pk_bf16(v0[0], v0[1]); w.y = cvt_pk_bf16(v0[2], v0[3]); w.z = cvt_pk_bf16(v1[0], v1[1]); w.w = cvt_pk_bf16(v1[2], v1[3]);
    *(v4u*)p = w;
}
__device__ __forceinline__ void st_f32x8(float* p, f32x4 v0, f32x4 v1) { *(f32x4*)p = v0; *(f32x4*)(p + 4) = v1; }
__device__ __forceinline__ f32x4 sigm4(f32x4 v) { return (f32x4){sigm(v[0]), sigm(v[1]), sigm(v[2]), sigm(v[3])}; }
__device__ __forceinline__ f32x4 silu4(f32x4 v) { return (f32x4){v[0] * sigm(v[0]), v[1] * sigm(v[1]), v[2] * sigm(v[2]), v[3] * sigm(v[3])}; }
__device__ __forceinline__ f32x4 ldbf4(const bf16* p) { const v2u w = *(const v2u*)p; return (f32x4){bflo(w.x), bfhi(w.x), bflo(w.y), bfhi(w.y)}; }

#define EPI_LOOP(...) \
    _Pragma("unroll") for (int ai = 0; ai < 2; ++ai) _Pragma("unroll") for (int m = 0; m < 4; ++m) { const int row = row0 + ai * 128 + m * 16; \
        _Pragma("unroll") for (int bj = 0; bj < 2; ++bj) { const int col = colb + bj * 32; const f32x4 v0 = acc[ai][bj][m][0], v1 = acc[ai][bj][m][1]; __VA_ARGS__ } }

struct EpiProj {
    bf16* QA; bf16* FA; bf16* IA; bf16* GA; bf16* LAT; bf16* GTA; bf16* GTB;
    __device__ __forceinline__ void operator()(const f32x4 (&acc)[2][2][4][2], const Unit& u, int wr, int wc, int fr, int fq) const {
        const int row0 = u.pm * 256 + wr * 64 + fr, pn = u.pn; const int colb = (pn & 3) * 256 + wc * 64 + 8 * fq;
        if (pn < 4)       { EPI_LOOP( st_bf16x8(QA + (size_t)row * 1024 + col, v0, v1); ) }
        else if (pn < 8)  { EPI_LOOP( st_bf16x8(FA + (size_t)row * 1024 + col, v0, v1); ) }
        else if (pn < 12) { EPI_LOOP( st_bf16x8(IA + (size_t)row * 1024 + col, v0, v1); ) }
        else if (pn < 16) { EPI_LOOP( st_bf16x8(GA + (size_t)row * 1024 + col, silu4(v0), silu4(v1)); ) }
        else if (pn < 20) { EPI_LOOP( st_bf16x8(LAT + (size_t)row * 1024 + col, v0, v1); ) }
        else { bf16* G = pn < 28 ? GTA : GTB; const int cb2 = ((pn - 20) & 7) * 256 + wc * 64 + 8 * fq;
            _Pragma("unroll") for (int ai = 0; ai < 2; ++ai) _Pragma("unroll") for (int m = 0; m < 4; ++m) { const int row = row0 + ai * 128 + m * 16;
                _Pragma("unroll") for (int bj = 0; bj < 2; ++bj) st_bf16x8(G + (size_t)row * 2048 + cb2 + bj * 32, sigm4(acc[ai][bj][m][0]), sigm4(acc[ai][bj][m][1])); } }
    }
};
struct EpiQ {
    bf16* QB; bf16* QIDX;
    __device__ __forceinline__ void operator()(const f32x4 (&acc)[2][2][4][2], const Unit& u, int wr, int wc, int fr, int fq) const {
        const int row0 = u.pm * 256 + wr * 64 + fr, pn = u.pn;
        if (pn < 16) { const int colb = pn * 256 + wc * 64 + 8 * fq; EPI_LOOP( st_bf16x8(QB + (size_t)row * 4096 + col, v0, v1); ) }
        else { const int colb = (pn - 16) * 256 + wc * 64 + 8 * fq; EPI_LOOP( st_bf16x8(QIDX + (size_t)row * 1024 + col, v0, v1); ) }
    }
};
struct EpiBf {
    bf16* O; int ldc; int coff;
    __device__ __forceinline__ void operator()(const f32x4 (&acc)[2][2][4][2], const Unit& u, int wr, int wc, int fr, int fq) const {
        const int row0 = u.pm * 256 + wr * 64 + fr; const int colb = coff + u.pn * 256 + wc * 64 + 8 * fq;
        EPI_LOOP( st_bf16x8(O + (size_t)row * ldc + col, v0, v1); )
    }
};
struct HookGate {
    static constexpr bool ON = true; const bf16* GA_; const bf16* GB_;
    __device__ __forceinline__ void mid(f32x4 (&acc)[2][2][4][2], const Unit& u, int wr, int wc, int fr, int fq) const {
        asm volatile("" : "+v"(fr), "+v"(fq));
        const int row0 = u.pm * 256 + wr * 64 + fr; const int colb = u.pn * 256 + wc * 64 + 8 * fq;
#pragma unroll
        for (int ai = 0; ai < 2; ++ai)
#pragma unroll
            for (int m = 0; m < 4; ++m) { const int row = row0 + ai * 128 + m * 16;
#pragma unroll
                for (int bj = 0; bj < 2; ++bj) { const size_t o = (size_t)row * 2048 + colb + bj * 32;
                    const f32x4 a0 = ldbf4(GA_ + o), a1 = ldbf4(GA_ + o + 4), b0 = ldbf4(GB_ + o), b1 = ldbf4(GB_ + o + 4);
                    f32x4 r0, r1;
#pragma unroll
                    for (int j = 0; j < 4; ++j) { r0[j] = a0[j] * __builtin_amdgcn_rcpf(b0[j]); r1[j] = a1[j] * __builtin_amdgcn_rcpf(b1[j]); }
                    acc[ai][bj][m][0] = acc[ai][bj][m][0] * r0; acc[ai][bj][m][1] = acc[ai][bj][m][1] * r1; }
                asm volatile("" : "+v"(acc[ai][0][m][0]), "+v"(acc[ai][0][m][1]), "+v"(acc[ai][1][m][0]), "+v"(acc[ai][1][m][1]));
                if (m & 1) asm volatile("" ::: "memory"); }
    }
};
__device__ __forceinline__ f32x4 cvbf4(v2u w) { return (f32x4){bflo(w.x), bfhi(w.x), bflo(w.y), bfhi(w.y)}; }
struct EpiGateM {
    const bf16* GB_; bf16* MRG_;
    __device__ __forceinline__ void operator()(const f32x4 (&acc)[2][2][4][2], const Unit& u, int wr, int wc, int fr, int fq) const {
        const int row0 = u.pm * 256 + wr * 64 + fr; const int colb = u.pn * 256 + wc * 64 + 8 * fq;
#pragma unroll
        for (int ai = 0; ai < 2; ++ai) { v2u gr[4][2][2];
#pragma unroll
            for (int m = 0; m < 4; ++m)
#pragma unroll
                for (int bj = 0; bj < 2; ++bj) { const size_t o = (size_t)(row0 + ai * 128 + m * 16) * 2048 + colb + bj * 32; gr[m][bj][0] = *(const v2u*)(GB_ + o); gr[m][bj][1] = *(const v2u*)(GB_ + o + 4); }
#pragma unroll
            for (int m = 0; m < 4; ++m)
#pragma unroll
                for (int bj = 0; bj < 2; ++bj) { const size_t o = (size_t)(row0 + ai * 128 + m * 16) * 2048 + colb + bj * 32;
                    st_bf16x8(MRG_ + o, acc[ai][bj][m][0] * cvbf4(gr[m][bj][0]), acc[ai][bj][m][1] * cvbf4(gr[m][bj][1])); } }
    }
};
struct EpiGateA {
    float* T1; const bf16* GT;
    __device__ __forceinline__ void operator()(const f32x4 (&acc)[2][2][4][2], const Unit& u, int wr, int wc, int fr, int fq) const {
        const int row0 = u.pm * 256 + wr * 64 + fr; const int colb = u.pn * 256 + wc * 64 + 8 * fq;
        EPI_LOOP( const size_t o = (size_t)row * 2048 + col; const f32x4 g0 = ldbf4(GT + o), g1 = ldbf4(GT + o + 4); st_f32x8(T1 + o, v0 * g0, v1 * g1); )
    }
};
struct EpiGateB {
    const float* T1; const bf16* GT; bf16* MRG;
    __device__ __forceinline__ void operator()(const f32x4 (&acc)[2][2][4][2], const Unit& u, int wr, int wc, int fr, int fq) const {
        const int row0 = u.pm * 256 + wr * 64 + fr; const int colb = u.pn * 256 + wc * 64 + 8 * fq;
        EPI_LOOP( const size_t o = (size_t)row * 2048 + col; const f32x4 g0 = ldbf4(GT + o), g1 = ldbf4(GT + o + 4); const f32x4 t0 = *(const f32x4*)(T1 + o), t1 = *(const f32x4*)(T1 + o + 4);
                  st_bf16x8(MRG + o, t0 + v0 * g0, t1 + v1 * g1); )
    }
};
struct EpiRes {
    const float* X; const bf16* Xh; bf16* R; const float* gt;
    __device__ __forceinline__ void operator()(const f32x4 (&acc)[2][2][4][2], const Unit& u, int wr, int wc, int fr, int fq) const {
        const int row0 = u.pm * 256 + wr * 64 + fr; const int colb = u.pn * 256 + wc * 64 + 8 * fq; const float* g = gt + (size_t)(u.pm >> 4) * MODW;
        f32x4 gg[2][2];
#pragma unroll
        for (int bj = 0; bj < 2; ++bj) { gg[bj][0] = *(const f32x4*)(g + colb + bj * 32) + 1.f; gg[bj][1] = *(const f32x4*)(g + colb + bj * 32 + 4) + 1.f; }
        if (X) {
#pragma unroll
            for (int ai = 0; ai < 2; ++ai)
#pragma unroll
                for (int mh = 0; mh < 2; ++mh) { f32x4 xr[2][2][2];
#pragma unroll
                    for (int mm = 0; mm < 2; ++mm)
#pragma unroll
                        for (int bj = 0; bj < 2; ++bj) { const size_t o = (size_t)(row0 + ai * 128 + (2 * mh + mm) * 16) * 2048 + colb + bj * 32; xr[mm][bj][0] = *(const f32x4*)(X + o); xr[mm][bj][1] = *(const f32x4*)(X + o + 4); }
#pragma unroll
                    for (int mm = 0; mm < 2; ++mm)
#pragma unroll
                        for (int bj = 0; bj < 2; ++bj) { const int m = 2 * mh + mm; const size_t o = (size_t)(row0 + ai * 128 + m * 16) * 2048 + colb + bj * 32;
                            st_bf16x8(R + o, xr[mm][bj][0] * ALPHA + gg[bj][0] * acc[ai][bj][m][0], xr[mm][bj][1] * ALPHA + gg[bj][1] * acc[ai][bj][m][1]); } }
        } else {
#pragma unroll
            for (int ai = 0; ai < 2; ++ai) { v2u xr[4][2][2];
#pragma unroll
                for (int m = 0; m < 4; ++m)
#pragma unroll
                    for (int bj = 0; bj < 2; ++bj) { const size_t o = (size_t)(row0 + ai * 128 + m * 16) * 2048 + colb + bj * 32; xr[m][bj][0] = *(const v2u*)(Xh + o); xr[m][bj][1] = *(const v2u*)(Xh + o + 4); }
#pragma unroll
                for (int m = 0; m < 4; ++m)
#pragma unroll
                    for (int bj = 0; bj < 2; ++bj) { const size_t o = (size_t)(row0 + ai * 128 + m * 16) * 2048 + colb + bj * 32;
                        st_bf16x8(R + o, cvbf4(xr[m][bj][0]) * ALPHA + gg[bj][0] * acc[ai][bj][m][0], cvbf4(xr[m][bj][1]) * ALPHA + gg[bj][1] * acc[ai][bj][m][1]); } }
        }
    }
};
struct EpiSwiglu {
    bf16* ACT;
    __device__ __forceinline__ void operator()(const f32x4 (&acc)[2][2][4][2], const Unit& u, int wr, int wc, int fr, int fq) const {
        const int row0 = u.pm * 256 + wr * 64 + fr; const int col = u.pn * 128 + wc * 32 + 8 * fq;
#pragma unroll
        for (int ai = 0; ai < 2; ++ai)
#pragma unroll
            for (int m = 0; m < 4; ++m) { const int row = row0 + ai * 128 + m * 16;
                st_bf16x8(ACT + (size_t)row * DFF + col, silu4(acc[ai][0][m][0]) * acc[ai][1][m][0], silu4(acc[ai][0][m][1]) * acc[ai][1][m][1]); }
    }
};

__global__ void __launch_bounds__(NTHR, 2) fwd_kernel(Args args) {
    extern __shared__ __attribute__((aligned(16))) unsigned char lds_raw[];
    LAS unsigned char* lds = (LAS unsigned char*)lds_raw;
    const int G = gridDim.x, blk = blockIdx.x;
    const int NGW = G * NWAVES, NT = G * NTHR;
    unsigned char* const ws_base = args.ws;
    gu32* ctl = (gu32*)(ws_base + WS_CTL);
    for (int u = threadIdx.x; u < (LDS_BYTES - LDSCTL_OFF) / 4; u += NTHR) ((LAS unsigned*)(lds + LDSCTL_OFF))[u] = 0u;
    __syncthreads();
    volatile LAS unsigned* MISC = (volatile LAS unsigned*)(lds + MISC_OFF);
    const int wave_s = __builtin_amdgcn_readfirstlane((int)(threadIdx.x >> 6));
    XcdBarrier bar = xcd_barrier_post((unsigned*)(ctl + CW_BAR), MISC + 8); bar.wave = wave_s;
    if (threadIdx.x == 0) { unsigned nloc_ = 0u, nx_ = 0u; xcd_barrier_complete(bar.bar, bar.x, nloc_, nx_); bar.st[0] = nloc_; bar.st[1] = nx_; }
    __syncthreads();
#define GRID_BAR() xcd_barrier(bar)

#define x_in ((const float*)(const GAS float*)args.in[0 + z_])
#define c_in ((const float*)(const GAS float*)args.in[1 + z_])
#define w_ada ((const float*)(const GAS float*)args.in[2 + z_])
#define b_ada ((const float*)(const GAS float*)args.in[3 + z_])
#define w_in ((const float*)(const GAS float*)args.in[4 + z_])
#define lb_logits ((const float*)(const GAS float*)args.in[5 + z_])
#define g_hg ((const float*)(const GAS float*)args.in[6 + z_])
#define w_pa ((const float*)(const GAS float*)args.in[7 + z_])
#define g_cq ((const float*)(const GAS float*)args.in[8 + z_])
#define g_ckv ((const float*)(const GAS float*)args.in[9 + z_])
#define w_uq ((const float*)(const GAS float*)args.in[10 + z_])
#define w_iq ((const float*)(const GAS float*)args.in[11 + z_])
#define w_uv ((const float*)(const GAS float*)args.in[12 + z_])
#define w_pb ((const float*)(const GAS float*)args.in[13 + z_])
#define w_out ((const float*)(const GAS float*)args.in[14 + z_])
#define ln1_g ((const float*)(const GAS float*)args.in[15 + z_])
#define ln1_b ((const float*)(const GAS float*)args.in[16 + z_])
#define w_gate ((const float*)(const GAS float*)args.in[17 + z_])
#define w_up ((const float*)(const GAS float*)args.in[18 + z_])
#define w_down ((const float*)(const GAS float*)args.in[19 + z_])
#define ln2_g ((const float*)(const GAS float*)args.in[20 + z_])
#define ln2_b ((const float*)(const GAS float*)args.in[21 + z_])
#define MOD  ((float*)(ws + WS_MOD))
#define LB   ((float*)(ws + WS_LB))
#define MODP ((float*)(ws + WS_MODP))
#define W1   ((bf16*)(ws + WS_W1))
#define W3   ((bf16*)(ws + WS_W3))
#define W6   ((bf16*)(ws + WS_W6))
#define W7   ((bf16*)(ws + WS_W7))
#define W8   ((bf16*)(ws + WS_W8))
#define W10  ((bf16*)(ws + WS_W10))
#define W11  ((bf16*)(ws + WS_W11))
#define XB   ((bf16*)(ws + WS_X))
#define RB   ((bf16*)(ws + WS_R))
#define HB   ((bf16*)(ws + WS_H))
#define QA   ((bf16*)(ws + WS_QA))
#define FA   ((bf16*)(ws + WS_FA))
#define IA   ((bf16*)(ws + WS_IA))
#define GA   ((bf16*)(ws + WS_GA))
#define LAT  ((bf16*)(ws + WS_LAT))
#define GTA  ((bf16*)(ws + WS_GTA))
#define GTB  ((bf16*)(ws + WS_GTB))
#define CQN  ((bf16*)(ws + WS_CQN))
#define CKV  ((bf16*)(ws + WS_CKV))
#define KIDX ((bf16*)(ws + WS_KIDX))
#define IDXW ((float*)(ws + WS_IDXW))
#define QB   ((bf16*)(ws + WS_QB))
#define QIDX ((bf16*)(ws + WS_QIDX))
#define SEL  ((unsigned short*)(ws + WS_SEL))
#define YAB  ((bf16*)(ws + WS_YAB))
#define MRG  ((bf16*)(ws + WS_MRG))
#define OB   ((bf16*)(ws + WS_OB))
#define ISC  ((_Float16*)(ws + WS_BIG))
#define OP   ((float*)(ws + WS_BIG))
#define ACT  ((bf16*)(ws + WS_BIG))
#define KK   LAT
#define modl (MOD + (size_t)l * NBATCH * MODW)
#define KSB  ((bf16*)(ws + WS_KSB))
#define QSB  ((bf16*)(ws + WS_QSB))
#define KVT  ((bf16*)(ws + WS_BIG))
#define SPB  ((bf16*)(ws + WS_FA))
#define DEB  ((float*)(ws + WS_DEB))
#define PHASE_BEGIN { unsigned om_ = ~0u; asm volatile("" : "+s"(om_)); int tid = wave_s * 64 + (int)__builtin_amdgcn_mbcnt_hi(om_, __builtin_amdgcn_mbcnt_lo(om_, 0u)); asm volatile("" : "+v"(tid)); int z_ = 0; asm volatile("" : "+s"(z_)); (void)z_; GAS unsigned char* wsg_ = (GAS unsigned char*)ws_base; asm volatile("" : "+s"(wsg_)); unsigned char* ws = (unsigned char*)wsg_; const int lane = tid & 63, wave = __builtin_amdgcn_readfirstlane(tid >> 6); \
        const int gw = blk * NWAVES + wave, gtid = blk * NTHR + tid; LAS float* wscr = (LAS float*)(lds + wave * 16384); (void)lane; (void)gw; (void)gtid; (void)wscr;
#define PHASE_END }

#define CVT_DECODE(IT_, MID_, K0_, N0_) do { int r_ = (IT_); \
        if (r_ < I1) { MID_ = 0; K0_ = (r_ / (N1 / 32)) * 64; N0_ = (r_ % (N1 / 32)) * 32; } else { r_ -= I1; \
        if (r_ < I3) { MID_ = 1; K0_ = (r_ / (N3 / 32)) * 64; N0_ = (r_ % (N3 / 32)) * 32; } else { r_ -= I3; \
        if (r_ < I6) { MID_ = 2; K0_ = (r_ / 32) * 64; N0_ = (r_ % 32) * 32; } else { r_ -= I6; \
        if (r_ < I7) { MID_ = 3; K0_ = (r_ / (DM / 32)) * 64; N0_ = (r_ % (DM / 32)) * 32; } else { r_ -= I7; \
        if (r_ < I8) { MID_ = 4; K0_ = (r_ / (DM / 32)) * 64; N0_ = (r_ % (DM / 32)) * 32; } else { r_ -= I8; \
        if (r_ < I10) { MID_ = 5; K0_ = (r_ / (N10 / 32)) * 64; N0_ = (r_ % (N10 / 32)) * 32; } else { r_ -= I10; \
        MID_ = 6; K0_ = (r_ / (DM / 32)) * 64; N0_ = (r_ % (DM / 32)) * 32; } } } } } } } while (0)
#define CVT_LOAD(MID_, K0_, N0_, TV_) do { \
        if (MID_ == 0) cvt_load([=](int k, int n) -> float { return n < 4944 ? s_in[(size_t)k * 9040 + n] : (n < 5120 ? 0.f : s_in[(size_t)k * 9040 + n - 176]); }, K0_, N0_, lane, TV_); \
        else if (MID_ == 1) cvt_load([=](int k, int n) -> float { return n < 4096 ? s_uq[(size_t)k * 4096 + n] * 0.0625f : s_iq[(size_t)k * 1024 + n - 4096]; }, K0_, N0_, lane, TV_); \
        else if (MID_ == 2) cvt_load([=](int k, int n) -> float { const int h = n >> 6, v = n & 63, kk = k >> 8, c = k & 255; return kk == (h & 3) ? s_uv[((size_t)h * 256 + c) * 64 + v] : 0.f; }, K0_, N0_, lane, TV_); \
        else if (MID_ == 3) cvt_load([=](int k, int n) -> float { return k < 1024 ? s_pa[(size_t)k * DM + n] : s_pb[(size_t)(k - 1024) * DM + n]; }, K0_, N0_, lane, TV_); \
        else if (MID_ == 4) cvt_load([=](int k, int n) -> float { return s_out[(size_t)k * DM + n]; }, K0_, N0_, lane, TV_); \
        else if (MID_ == 5) cvt_load([=](int k, int n) -> float { const int pn = n >> 8, rr = n & 255, cc = pn * 128 + (rr >> 6) * 32 + (rr & 31); return (rr & 32) ? s_u[(size_t)k * DFF + cc] : s_g[(size_t)k * DFF + cc]; }, K0_, N0_, lane, TV_); \
        else cvt_load([=](int k, int n) -> float { return s_d[(size_t)k * DM + n]; }, K0_, N0_, lane, TV_); } while (0)
#define CONVERT_LAYER(L) do { const int l_ = (L); \
        const float* s_in = w_in + (size_t)l_ * DM * 9040; const float* s_uq = w_uq + (size_t)l_ * SAR * 4096; const float* s_iq = w_iq + (size_t)l_ * SAR * 1024; \
        const float* s_uv = w_uv + (size_t)l_ * 16 * 256 * 64; const float* s_pa = w_pa + (size_t)l_ * 1024 * DM; const float* s_pb = w_pb + (size_t)l_ * 1024 * DM; \
        const float* s_out = w_out + (size_t)l_ * DM * DM; const float* s_g = w_gate + (size_t)l_ * DM * DFF; const float* s_u = w_up + (size_t)l_ * DM * DFF; const float* s_d = w_down + (size_t)l_ * DFF * DM; \
        constexpr int I1 = (DM / 64) * (N1 / 32), I3 = (SAR / 64) * (N3 / 32), I6 = (1024 / 64) * (1024 / 32), I7 = (DM / 64) * (DM / 32), I8 = I7, I10 = (DM / 64) * (N10 / 32), I11 = (DFF / 64) * (DM / 32); \
        constexpr int NIT = I1 + I3 + I6 + I7 + I8 + I10 + I11; \
        float tv_[32]; int mid_ = 0, k0_ = 0, n0_ = 0; \
        { CVT_DECODE(gw, mid_, k0_, n0_); CVT_LOAD(mid_, k0_, n0_, tv_); } \
        for (int it = gw; it < NIT; it += NGW) { \
            float tc_[32]; _Pragma("unroll") for (int i = 0; i < 32; ++i) tc_[i] = tv_[i]; \
            const int mc_ = mid_, kc_ = k0_, nc_ = n0_; \
            { const int itn_ = it + NGW < NIT ? it + NGW : it; CVT_DECODE(itn_, mid_, k0_, n0_); CVT_LOAD(mid_, k0_, n0_, tv_); }     \
            bf16* wt_ = mc_ == 0 ? W1 : mc_ == 1 ? W3 : mc_ == 2 ? W6 : mc_ == 3 ? W7 : mc_ == 4 ? W8 : mc_ == 5 ? W10 : W11; \
            const int kk_ = mc_ == 0 ? DM : mc_ == 1 ? SAR : mc_ == 2 ? 1024 : mc_ == 3 ? DM : mc_ == 4 ? DM : mc_ == 5 ? DM : DFF; \
            cvt_store(tc_, wt_, kk_, kc_, nc_, wscr, lane); \
        } } while (0)


#ifndef HGRN_NAIVE
#define HGRN_NAIVE 0
#endif
#ifndef IDX_NAIVE
#define IDX_NAIVE 0
#endif
#ifndef ATT_NAIVE
#define ATT_NAIVE 0
#endif
#ifndef TOPK_OLD
#define TOPK_OLD 0
#endif
#ifndef REP_HB
#define REP_HB 1
#endif
#ifndef REP_HC
#define REP_HC 1
#endif
#ifndef REP_P4A
#define REP_P4A 1
#endif
#ifndef REP_P5
#define REP_P5 1
#endif
#ifndef REP_P9
#define REP_P9 1
#endif
#ifndef REP_P12
#define REP_P12 1
#endif
#ifndef REP_TOPK
#define REP_TOPK 1
#endif
#ifndef REP_ATT
#define REP_ATT 1
#endif
#ifndef DRY_ATT
#define DRY_ATT 0
#endif
#ifndef REP_M1
#define REP_M1 1
#endif
#ifndef REP_M2
#define REP_M2 1
#endif
#ifndef REP_M3
#define REP_M3 1
#endif

    PHASE_BEGIN
    {
        LAS float* sc = (LAS float*)lds;
        for (int i = tid; i < NBATCH * DM; i += NTHR) { const float v = c_in[i]; sc[i] = v * sigm(v); }
        __syncthreads();
        for (int item = gtid; item < 8 * 12288; item += NT) {
            const int ks = item / 12288, cg = item % 12288, l = cg / 3072, n4 = (cg % 3072) * 4;
            const float* wp = w_ada + ((size_t)l * DM + ks * 256) * MODW + n4;
            f32x4 a0 = {0.f, 0.f, 0.f, 0.f}, a1 = a0, a2 = a0, a3 = a0;
#pragma unroll 8
            for (int k = 0; k < 256; ++k) { const f32x4 w = *(const f32x4*)(wp + (size_t)k * MODW); const int kk = ks * 256 + k;
                a0 += w * sc[kk]; a1 += w * sc[2048 + kk]; a2 += w * sc[4096 + kk]; a3 += w * sc[6144 + kk]; }
            float* o = MODP + ((size_t)(ks * 4 + l) * 4) * MODW + n4;
            *(f32x4*)(o) = a0; *(f32x4*)(o + MODW) = a1; *(f32x4*)(o + 2 * MODW) = a2; *(f32x4*)(o + 3 * MODW) = a3;
        }
        if (gtid < 1024) {
            const float a = lb_logits[gtid], b = lb_logits[1024 + gtid], c = lb_logits[2048 + gtid], d = lb_logits[3072 + gtid];
            const float mx = fmaxf(fmaxf(a, b), fmaxf(c, d)); const float ea = expf(a - mx), eb = expf(b - mx), ec = expf(c - mx), ed = expf(d - mx); const float inv = 1.f / (ea + eb + ec + ed);
            LB[gtid] = 0.f; LB[1024 + gtid] = eb * inv; LB[2048 + gtid] = (eb + ec) * inv; LB[3072 + gtid] = (eb + ec + ed) * inv;
        }
        __syncthreads();
        CONVERT_LAYER(0);
    }
    PHASE_END
    GRID_BAR();
    PHASE_BEGIN
    for (int i = gtid; i < DEPTH * NBATCH * MODW; i += NT) {
        const int l = i / (NBATCH * MODW), r = i % (NBATCH * MODW), b = r / MODW, n = r % MODW;
        float s = b_ada[l * MODW + n];
#pragma unroll
        for (int ks = 0; ks < 8; ++ks) s += MODP[((size_t)(ks * 4 + l) * 4 + b) * MODW + n];
        MOD[i] = s;
    }
    PHASE_END
    GRID_BAR();
    PHASE_BEGIN
    for (size_t i0 = gtid; i0 < (size_t)M * DM / 8; i0 += (size_t)NT * 4) {
        f32x4 xa[4], xb[4], sa[4], sb[4], ha[4], hb[4];
#pragma unroll
        for (int t = 0; t < 4; ++t) { size_t gi = i0 + (size_t)t * NT; gi = gi < (size_t)M * DM / 8 ? gi : (size_t)M * DM / 8 - 1; const size_t e = gi * 8; const int row = (int)(e / DM), col = (int)(e % DM), b = row / SEQ; const float* md = MOD + (size_t)b * MODW;
            xa[t] = *(const f32x4*)(x_in + e); xb[t] = *(const f32x4*)(x_in + e + 4); sa[t] = *(const f32x4*)(md + 2048 + col); sb[t] = *(const f32x4*)(md + 2048 + col + 4); ha[t] = *(const f32x4*)(md + col); hb[t] = *(const f32x4*)(md + col + 4); }
#pragma unroll
        for (int t = 0; t < 4; ++t) { size_t gi = i0 + (size_t)t * NT; gi = gi < (size_t)M * DM / 8 ? gi : (size_t)M * DM / 8 - 1; const size_t e = gi * 8; st_bf16x8(HB + e, xa[t] * (sa[t] + 1.f) + ha[t], xb[t] * (sb[t] + 1.f) + hb[t]); }
    }
    PHASE_END
    GRID_BAR();

    for (int l = 0; l < DEPTH; ++l) {
        PHASE_BEGIN
        { pg8::Gemm g{HB, W1, M, N1, DM, DM, DM, 0}; pg8::StaticOrder S; S.init(M, N1, G, blk);
          EpiProj E{QA, FA, IA, GA, LAT, GTA, GTB}; pg8::gemm_phase(lds, g, S, E, tid); }
        PHASE_END
        GRID_BAR();
        for (int rep_ = 0; rep_ < REP_M1; ++rep_) {
        PHASE_BEGIN
        v2u ra0, ra1, rkv; unsigned short rki, riw;
        const f32x4 g0 = *(const f32x4*)(g_cq + l * 512 + 4 * lane), g1 = *(const f32x4*)(g_cq + l * 512 + 256 + 4 * lane), gk = *(const f32x4*)(g_ckv + l * 256 + 4 * lane);
        { const bf16* lr = LAT + (size_t)gw * 1024; ra0 = *(const v2u*)(lr + 4 * lane); ra1 = *(const v2u*)(lr + 256 + 4 * lane); rkv = *(const v2u*)(lr + 512 + 4 * lane); rki = lr[768 + lane]; riw = lr[832 + (lane & 15)]; }
        for (int row = gw; row < M; row += NGW) {
            const f32x4 a0 = (f32x4){bflo(ra0.x), bfhi(ra0.x), bflo(ra0.y), bfhi(ra0.y)}, a1 = (f32x4){bflo(ra1.x), bfhi(ra1.x), bflo(ra1.y), bfhi(ra1.y)}, kv = (f32x4){bflo(rkv.x), bfhi(rkv.x), bflo(rkv.y), bfhi(rkv.y)};
            const float ki = bf2f(rki), iw = bf2f(riw);
            { const int rn = row + NGW < M ? row + NGW : row; const bf16* lr = LAT + (size_t)rn * 1024;
              ra0 = *(const v2u*)(lr + 4 * lane); ra1 = *(const v2u*)(lr + 256 + 4 * lane); rkv = *(const v2u*)(lr + 512 + 4 * lane); rki = lr[768 + lane]; riw = lr[832 + (lane & 15)]; }
            float sq = a0[0] * a0[0] + a0[1] * a0[1] + a0[2] * a0[2] + a0[3] * a0[3] + a1[0] * a1[0] + a1[1] * a1[1] + a1[2] * a1[2] + a1[3] * a1[3];
            float sk = kv[0] * kv[0] + kv[1] * kv[1] + kv[2] * kv[2] + kv[3] * kv[3];
            sq = wave_sum(sq); sk = wave_sum(sk);
            const float rq = 1.0f / sqrtf(sq * (1.f / 512.f) + 1e-6f), rk = 1.0f / sqrtf(sk * (1.f / 256.f) + 1e-6f);
            v2u o; f32x4 t = a0 * rq * g0; o.x = pk2(t[0], t[1]); o.y = pk2(t[2], t[3]); *(v2u*)(CQN + (size_t)row * 512 + 4 * lane) = o;
            t = a1 * rq * g1; o.x = pk2(t[0], t[1]); o.y = pk2(t[2], t[3]); *(v2u*)(CQN + (size_t)row * 512 + 256 + 4 * lane) = o;
            t = kv * rk * gk; o.x = pk2(t[0], t[1]); o.y = pk2(t[2], t[3]); *(v2u*)(CKV + (size_t)row * 256 + 4 * lane) = o;
            KIDX[(size_t)row * 64 + lane] = (bf16)f2bf(ki);
            if (lane < 16) IDXW[(size_t)row * 16 + lane] = iw * 0.03125f;
        }
        PHASE_END
        PHASE_BEGIN
        {
            const int cp = tid & 63, sg = tid >> 6;
            LAS unsigned char* KST = lds;
            LAS unsigned char* VTL = lds + 18432;
            LAS float* SEGT = (LAS float*)(lds + 36864);
            LAS float* G63 = (LAS float*)(lds + 40960);
            unsigned pfa[8], pq[8], pv[8]; float plb0, plb1;
#define HA_REQ(U_) do { int uu_ = (U_); asm volatile("" : "+s"(uu_)); const int bh_ = uu_ >> 6, c_ = uu_ & 63, b_ = bh_ >> 3, h_ = bh_ & 7; \
                const size_t rowb_ = (size_t)b_ * SEQ + c_ * 64 + sg * 8; const int col_ = h_ * 128 + 2 * cp; \
                _Pragma("unroll") for (int i = 0; i < 8; ++i) { pfa[i] = *(const unsigned*)(FA + (rowb_ + i) * 1024 + col_); pq[i] = *(const unsigned*)(QA + (rowb_ + i) * 1024 + col_); pv[i] = *(const unsigned*)(IA + (rowb_ + i) * 1024 + col_); } plb0 = LB[l * 1024 + col_]; plb1 = LB[l * 1024 + col_ + 1]; } while (0)
            HA_REQ(blk);
            for (int u = blk; u < 2048; u += G) {
                const int bh = u >> 6, c = u & 63, b = bh >> 3, h = bh & 7;
                const size_t rowb = (size_t)b * SEQ + c * 64 + sg * 8; const int col = h * 128 + 2 * cp;
                const float lb0 = plb0, lb1 = plb1;
                float lf0[8], lf1[8], kk0[8], kk1[8]; unsigned cq[8], cv[8];
#pragma unroll
                for (int i = 0; i < 8; ++i) { cq[i] = pq[i]; cv[i] = pv[i]; }
#pragma unroll
                for (int i = 0; i < 8; ++i) { const float2 fa = make_float2(bflo(pfa[i]), bfhi(pfa[i]));
                    const float f0 = fminf(fmaxf(lb0 + (1.f - lb0) * sigm(fa.x), 1e-6f), 1.f), f1 = fminf(fmaxf(lb1 + (1.f - lb1) * sigm(fa.y), 1e-6f), 1.f);
                    lf0[i] = __logf(f0); lf1[i] = __logf(f1); kk0[i] = (1.f - lb0) * sigm(-fa.x); kk1[i] = (1.f - lb1) * sigm(-fa.y); }
#pragma unroll
                for (int i = 1; i < 8; ++i) { lf0[i] += lf0[i - 1]; lf1[i] += lf1[i - 1]; }
                SEGT[sg * 128 + 2 * cp] = lf0[7]; SEGT[sg * 128 + 2 * cp + 1] = lf1[7];
                HA_REQ(u + G < 2048 ? u + G : u);
                __syncthreads();
                float pre0 = 0.f, pre1 = 0.f, r0 = 0.f, r1 = 0.f, t0 = 0.f, t1 = 0.f;
#pragma unroll
                for (int s2 = 0; s2 < 8; ++s2) { const float a0 = SEGT[s2 * 128 + 2 * cp], a1 = SEGT[s2 * 128 + 2 * cp + 1];
                    if (s2 < sg) { pre0 += a0; pre1 += a1; } if (s2 < 4) { r0 += a0; r1 += a1; } t0 += a0; t1 += a1; }
                unsigned ksw0[4], ksw1[4], vw0[4], vw1[4]; float ks0p = 0.f, ks1p = 0.f, v0p = 0.f, v1p = 0.f;
#pragma unroll
                for (int i = 0; i < 8; ++i) {
                    const float b0 = pre0 + lf0[i], b1 = pre1 + lf1[i];
                    const unsigned qw = cq[i]; const unsigned vw = cv[i];
                    const float qs0 = bflo(qw) * __expf(b0 - r0), qs1 = bfhi(qw) * __expf(b1 - r1);
                    const float ks0 = kk0[i] * __expf(r0 - b0), ks1 = kk1[i] * __expf(r1 - b1);
                    *(unsigned*)(QSB + (rowb + i) * 1024 + col) = pk2(qs0, qs1);
                    *(unsigned*)(KSB + (rowb + i) * 1024 + col) = pk2(ks0, ks1);
                    if (i & 1) { ksw0[i >> 1] = pk2(ks0p, ks0); ksw1[i >> 1] = pk2(ks1p, ks1); vw0[i >> 1] = pk2(v0p, bflo(vw)); vw1[i >> 1] = pk2(v1p, bfhi(vw)); }
                    else { ks0p = ks0; ks1p = ks1; v0p = bflo(vw); v1p = bfhi(vw); }
                }
                *(LAS v4u*)(KST + (2 * cp) * 144 + sg * 16) = (v4u){ksw0[0], ksw0[1], ksw0[2], ksw0[3]};
                *(LAS v4u*)(KST + (2 * cp + 1) * 144 + sg * 16) = (v4u){ksw1[0], ksw1[1], ksw1[2], ksw1[3]};
                *(LAS v4u*)(VTL + (2 * cp) * 144 + sg * 16) = (v4u){vw0[0], vw0[1], vw0[2], vw0[3]};
                *(LAS v4u*)(VTL + (2 * cp + 1) * 144 + sg * 16) = (v4u){vw1[0], vw1[1], vw1[2], vw1[3]};
                if (sg == 7) { float* de = DEB + (size_t)u * 256; *(float2*)(de + 2 * cp) = make_float2(__expf(r0), __expf(r1)); *(float2*)(de + 128 + 2 * cp) = make_float2(__expf(t0), __expf(t1));
                    G63[2 * cp] = __expf(t0 - r0); G63[2 * cp + 1] = __expf(t1 - r1); }
                __syncthreads();
                { const int kt = wave >> 1, vt0 = (wave & 1) * 2, lr = lane & 31, lh = lane >> 5;
                  f32x16 acc0, acc1;
#pragma unroll
                  for (int r = 0; r < 16; ++r) { acc0[r] = 0.f; acc1[r] = 0.f; }
#pragma unroll
                  for (int s4 = 0; s4 < 4; ++s4) {
                      const bf16x8 kb = *(const LAS bf16x8*)(KST + (kt * 32 + lr) * 144 + (s4 * 16 + 8 * lh) * 2);
                      const bf16x8 a0 = *(const LAS bf16x8*)(VTL + (vt0 * 32 + lr) * 144 + (s4 * 16 + 8 * lh) * 2);
                      const bf16x8 a1 = *(const LAS bf16x8*)(VTL + ((vt0 + 1) * 32 + lr) * 144 + (s4 * 16 + 8 * lh) * 2);
                      acc0 = __builtin_amdgcn_mfma_f32_32x32x16_bf16(a0, kb, acc0, 0, 0, 0); acc1 = __builtin_amdgcn_mfma_f32_32x32x16_bf16(a1, kb, acc1, 0, 0, 0); }
                  bf16* kvt = KVT + (size_t)u * 16384 + kt * 32 + lr; const float g = G63[kt * 32 + lr];
#pragma unroll
                  for (int r = 0; r < 16; ++r) { const int vv = 8 * (r >> 2) + 4 * lh + (r & 3);
                      kvt[(size_t)(vt0 * 32 + vv) * 128] = (bf16)(pk2(acc0[r] * g, 0.f) & 0xffffu); kvt[(size_t)((vt0 + 1) * 32 + vv) * 128] = (bf16)(pk2(acc1[r] * g, 0.f) & 0xffffu); } }
                __syncthreads();
            }
        }
#undef HA_REQ
        PHASE_END
        GRID_BAR();
        }
        for (int rep_ = 0; rep_ < REP_M2; ++rep_) {
        PHASE_BEGIN
        for (int item = gtid; item < 32 * 4096; item += NT) {
            const int bh = item >> 12, v = (item >> 5) & 127, k4 = (item & 31) * 4;
            f32x4 S = {0.f, 0.f, 0.f, 0.f};
            for (int c0 = 0; c0 < 64; c0 += 8) {
                f32x4 kv[8], dd[8], ee[8];
#pragma unroll
                for (int j = 0; j < 8; ++j) { const size_t u = (size_t)bh * 64 + c0 + j; kv[j] = ldbf4(KVT + u * 16384 + v * 128 + k4); ee[j] = *(const f32x4*)(DEB + u * 256 + k4); dd[j] = *(const f32x4*)(DEB + u * 256 + 128 + k4); }
#pragma unroll
                for (int j = 0; j < 8; ++j) { const size_t u = (size_t)bh * 64 + c0 + j; const f32x4 sp = S * ee[j]; v2u w; w.x = pk2(sp[0], sp[1]); w.y = pk2(sp[2], sp[3]);
                    *(v2u*)(SPB + u * 16384 + v * 128 + k4) = w; S = S * dd[j] + kv[j]; }
            }
        }
        PHASE_END
        PHASE_BEGIN
        { pg8::Gemm g{CQN, W3, M, N3, SAR, SAR, SAR, 0}; pg8::StaticOrder S; S.init(M, N3, G, blk);
          EpiQ E{QB, QIDX}; pg8::gemm_phase(lds, g, S, E, tid); }
        PHASE_END
        GRID_BAR();
        }
        for (int rep_ = 0; rep_ < REP_M3; ++rep_) {
        PHASE_BEGIN
        {
            LAS unsigned char* QSL = lds;
            LAS unsigned char* KSL = lds + 17408;
            LAS unsigned char* VTL = lds + 34816;
            LAS unsigned char* SPL = lds + 53248;
            LAS unsigned char* AL = lds + 88064;
            LAS float* SSQ = (LAS float*)(lds + 97280);
            const int cp = tid & 63, sg = tid >> 6, lr = lane & 31, lh = lane >> 5;
            v4u rq[2], rk[2], rs[4]; unsigned rv[8]; unsigned short rg[16];
#define HC_REQ(U_) do { int uu_ = (U_); asm volatile("" : "+s"(uu_));   const int bh_ = uu_ >> 6, c_ = uu_ & 63, b_ = bh_ >> 3, h_ = bh_ & 7; const size_t row0_ = (size_t)b_ * SEQ + c_ * 64; const int col0_ = h_ * 128; \
                _Pragma("unroll") for (int j = 0; j < 2; ++j) { const int q = tid + 512 * j, rr = q >> 4, cc = q & 15; \
                    rq[j] = *(const v4u*)(QSB + (row0_ + rr) * 1024 + col0_ + cc * 8); rk[j] = *(const v4u*)(KSB + (row0_ + rr) * 1024 + col0_ + cc * 8); } \
                _Pragma("unroll") for (int j = 0; j < 4; ++j) { const int q = tid + 512 * j, rr = q >> 4, cc = q & 15; rs[j] = *(const v4u*)(SPB + (size_t)uu_ * 16384 + rr * 128 + cc * 8); } \
                _Pragma("unroll") for (int i = 0; i < 8; ++i) rv[i] = *(const unsigned*)(IA + (row0_ + sg * 8 + i) * 1024 + col0_ + 2 * cp); \
                { const int it_ = wave >> 2, vt_ = wave & 3; const int colg_ = col0_ + vt_ * 32 + lr; \
                  _Pragma("unroll") for (int r = 0; r < 16; ++r) { const int ii = it_ * 32 + 8 * (r >> 2) + 4 * lh + (r & 3); rg[r] = GA[(row0_ + ii) * 1024 + colg_]; } } } while (0)
            HC_REQ(blk);
            for (int u = blk; u < 2048; u += G) {
                const int bh = u >> 6, c = u & 63, b = bh >> 3, h = bh & 7;
                const size_t row0 = (size_t)b * SEQ + c * 64; const int col0 = h * 128;
#pragma unroll
                for (int j = 0; j < 2; ++j) { const int q = tid + 512 * j, rr = q >> 4, cc = q & 15;
                    *(LAS v4u*)(QSL + rr * 272 + cc * 16) = rq[j]; *(LAS v4u*)(KSL + rr * 272 + cc * 16) = rk[j]; }
#pragma unroll
                for (int j = 0; j < 4; ++j) { const int q = tid + 512 * j, rr = q >> 4, cc = q & 15; *(LAS v4u*)(SPL + rr * 272 + cc * 16) = rs[j]; }
                { unsigned vw0[4], vw1[4]; float v0p = 0.f, v1p = 0.f;
#pragma unroll
                  for (int i = 0; i < 8; ++i) { const unsigned vw = rv[i];
                      if (i & 1) { vw0[i >> 1] = pk2(v0p, bflo(vw)); vw1[i >> 1] = pk2(v1p, bfhi(vw)); } else { v0p = bflo(vw); v1p = bfhi(vw); } }
                  *(LAS v4u*)(VTL + (2 * cp) * 144 + sg * 16) = (v4u){vw0[0], vw0[1], vw0[2], vw0[3]};
                  *(LAS v4u*)(VTL + (2 * cp + 1) * 144 + sg * 16) = (v4u){vw1[0], vw1[1], vw1[2], vw1[3]}; }
                float gav[16];
#pragma unroll
                for (int r = 0; r < 16; ++r) gav[r] = bf2f(rg[r]);
                const float gg = g_hg[l * 1024 + col0 + (wave & 3) * 32 + lr];
                HC_REQ(u + G < 2048 ? u + G : u);
                __syncthreads();
                if (wave < 4) {
                    const int it = wave >> 1, jt = wave & 1;
                    f32x16 acc;
#pragma unroll
                    for (int r = 0; r < 16; ++r) acc[r] = 0.f;
                    if (!(it == 0 && jt == 1)) {
#pragma unroll
                        for (int s8 = 0; s8 < 8; ++s8) {
                            const bf16x8 a = *(const LAS bf16x8*)(QSL + (it * 32 + lr) * 272 + (s8 * 16 + 8 * lh) * 2);
                            const bf16x8 bb = *(const LAS bf16x8*)(KSL + (jt * 32 + lr) * 272 + (s8 * 16 + 8 * lh) * 2);
                            acc = __builtin_amdgcn_mfma_f32_32x32x16_bf16(a, bb, acc, 0, 0, 0); } }
                    const int jj = jt * 32 + lr;
#pragma unroll
                    for (int r = 0; r < 16; ++r) { const int ii = it * 32 + 8 * (r >> 2) + 4 * lh + (r & 3); const float x = (jj <= ii) ? acc[r] : 0.f;
                        *(LAS unsigned short*)(AL + ii * 144 + jj * 2) = (unsigned short)(pk2(x, 0.f) & 0xffffu); }
                }
                __syncthreads();
                { const int it = wave >> 2, vt = wave & 3;
                  f32x16 acc;
#pragma unroll
                  for (int r = 0; r < 16; ++r) acc[r] = 0.f;
#pragma unroll
                  for (int s4 = 0; s4 < 4; ++s4) {
                      const bf16x8 a = *(const LAS bf16x8*)(AL + (it * 32 + lr) * 144 + (s4 * 16 + 8 * lh) * 2);
                      const bf16x8 bb = *(const LAS bf16x8*)(VTL + (vt * 32 + lr) * 144 + (s4 * 16 + 8 * lh) * 2);
                      acc = __builtin_amdgcn_mfma_f32_32x32x16_bf16(a, bb, acc, 0, 0, 0); }
#pragma unroll
                  for (int s8 = 0; s8 < 8; ++s8) {
                      const bf16x8 a = *(const LAS bf16x8*)(QSL + (it * 32 + lr) * 272 + (s8 * 16 + 8 * lh) * 2);
                      const bf16x8 bb = *(const LAS bf16x8*)(SPL + (vt * 32 + lr) * 272 + (s8 * 16 + 8 * lh) * 2);
                      acc = __builtin_amdgcn_mfma_f32_32x32x16_bf16(a, bb, acc, 0, 0, 0); }
#pragma unroll
                  for (int r = 0; r < 16; ++r) { float q2 = acc[r] * acc[r];
                      q2 = xsum16(rowsum16(q2));
                      if (lr == 0) SSQ[vt * 64 + it * 32 + 8 * (r >> 2) + 4 * lh + (r & 3)] = q2; }
                  __syncthreads();
                  const int colg = col0 + vt * 32 + lr;
#pragma unroll
                  for (int r = 0; r < 16; ++r) { const int ii = it * 32 + 8 * (r >> 2) + 4 * lh + (r & 3);
                      const float ss = SSQ[ii] + SSQ[64 + ii] + SSQ[128 + ii] + SSQ[192 + ii]; const float rn = 1.0f / sqrtf(ss * (1.f / 128.f) + 1e-6f);
                      YAB[(row0 + ii) * 2048 + colg] = (bf16)(pk2(acc[r] * rn * gg * gav[r], 0.f) & 0xffffu); }
                }
                __syncthreads();
            }
        }
#undef HC_REQ
        PHASE_END
        PHASE_BEGIN
        for (int ub = blk * NWAVES; ub < 2048; ub += NGW) {
            const int unit = ub + wave;
            const int b = ub >> 9, j = unit & 511, lr = lane & 31, lh = lane >> 5;
            const int qsel = (lr >> 2) & 1, head = (lr >> 3) * 4 + (lr & 3);
            const int qlo = 4 * j, qhi = 4 * (1023 - j);
            const int nlo = ((qlo >> 6) + 1) * 64, nhi = ((qhi >> 6) + 1) * 64;
            const int nlo8 = (nlo + 511) & ~511, nhi8 = (nhi + 511) & ~511;
            const int nmax8 = (((((4 * (1023 - (ub & 511))) >> 6) + 1) * 64) + 511) & ~511;
            bf16x8 A[4][4]; float W[4][16]; typedef float f32x2_t __attribute__((ext_vector_type(2)));
#pragma unroll
            for (int p = 0; p < 4; ++p) { const size_t qb = (size_t)b * SEQ + (p < 2 ? qlo + 2 * p : qhi + 2 * (p - 2));
#pragma unroll
                for (int ks = 0; ks < 4; ++ks) A[p][ks] = *(const bf16x8*)(QIDX + (qb + qsel) * 1024 + head * 64 + ks * 16 + lh * 8);
#pragma unroll
                for (int r4 = 0; r4 < 4; ++r4) { const f32x4 w = *(const f32x4*)(IDXW + (qb + lh) * 16 + r4 * 4); W[p][r4 * 4] = w[0]; W[p][r4 * 4 + 1] = w[1]; W[p][r4 * 4 + 2] = w[2]; W[p][r4 * 4 + 3] = w[3]; } }
            const bf16* kb = KIDX + (size_t)b * SEQ * 64;
            const int srow = 8 * wave + (lane >> 3), spc = ((lane & 7) ^ ((srow >> 1) & 7)) * 8;
#define P4_STAGE(C0_, BUF_) do { _Pragma("unroll") for (int i = 0; i < 4; ++i) \
                __builtin_amdgcn_global_load_lds((const unsigned*)(kb + (size_t)((C0_) + 64 * i + srow) * 64 + spc), (LAS unsigned*)(lds + (BUF_) * 32768 + (i * 8 + wave) * 1024), 16, 0, 0); } while (0)
            P4_STAGE(0, 0);
            asm volatile("s_waitcnt vmcnt(0)" ::: "memory");
            __syncthreads();
            for (int c0 = 0; c0 < nmax8; c0 += 256) {
                const int cb = (c0 >> 8) & 1; const bool more = c0 + 256 < nmax8;
                if (more) P4_STAGE(c0 + 256, cb ^ 1);
                LAS unsigned char* kbuf = lds + cb * 32768;
#pragma unroll 1
                for (int tl = 0; tl < 8; ++tl) {
                    const int s0 = c0 + tl * 32;
                    if (s0 >= nhi8) break;
#pragma unroll
                    for (int p = 0; p < 4; ++p) { const int np = p < 2 ? nlo : nhi, np8 = p < 2 ? nlo8 : nhi8;
                        if (s0 >= np && s0 < np8) { const size_t q = (size_t)b * SEQ + (p < 2 ? qlo + 2 * p : qhi + 2 * (p - 2)) + lh; ISC[q * 4096 + s0 + lr] = (_Float16)(-60000.0f); } }
                    if (s0 >= nhi) continue;
                    bf16x8 B[4];
#pragma unroll
                    for (int ks = 0; ks < 4; ++ks) B[ks] = *(const LAS bf16x8*)(kbuf + (tl * 32 + lr) * 128 + (((2 * ks + lh) ^ ((lr >> 1) & 7)) * 16));
#define IDX_FINISH(P_, ACC_) do { f32x2_t s2_ = {0.f, 0.f};     \
                        _Pragma("unroll") for (int r = 0; r < 16; r += 2) { const float a0_ = ACC_[r], a1_ = ACC_[r + 1]; const int i0_ = __builtin_bit_cast(int, a0_), i1_ = __builtin_bit_cast(int, a1_); \
                            const f32x2_t rl_ = {__builtin_bit_cast(float, i0_ > 0 ? i0_ : 0), __builtin_bit_cast(float, i1_ > 0 ? i1_ : 0)}; const f32x2_t w_ = {W[P_][r], W[P_][r + 1]}; \
                            s2_ = __builtin_elementwise_fma(rl_, w_, s2_); } \
                        const float sc_ = s2_[0] + s2_[1]; \
                        const size_t q_ = (size_t)b * SEQ + ((P_) < 2 ? qlo + 2 * (P_) : qhi + 2 * ((P_) - 2)) + lh; ISC[q_ * 4096 + s0 + lr] = (_Float16)sc_; } while (0)
                    if (s0 < nlo) {
                        f32x16 c0_, c1_, c2_, c3_;
#pragma unroll
                        for (int r = 0; r < 16; ++r) { c0_[r] = 0.f; c1_[r] = 0.f; c2_[r] = 0.f; c3_[r] = 0.f; }
#pragma unroll
                        for (int ks = 0; ks < 4; ++ks) { c0_ = __builtin_amdgcn_mfma_f32_32x32x16_bf16(A[0][ks], B[ks], c0_, 0, 0, 0); c1_ = __builtin_amdgcn_mfma_f32_32x32x16_bf16(A[1][ks], B[ks], c1_, 0, 0, 0);
                            c2_ = __builtin_amdgcn_mfma_f32_32x32x16_bf16(A[2][ks], B[ks], c2_, 0, 0, 0); c3_ = __builtin_amdgcn_mfma_f32_32x32x16_bf16(A[3][ks], B[ks], c3_, 0, 0, 0); }
                        IDX_FINISH(0, c0_); IDX_FINISH(1, c1_); IDX_FINISH(2, c2_); IDX_FINISH(3, c3_);
                    } else {
                        f32x16 c2_, c3_;
#pragma unroll
                        for (int r = 0; r < 16; ++r) { c2_[r] = 0.f; c3_[r] = 0.f; }
#pragma unroll
                        for (int ks = 0; ks < 4; ++ks) { c2_ = __builtin_amdgcn_mfma_f32_32x32x16_bf16(A[2][ks], B[ks], c2_, 0, 0, 0); c3_ = __builtin_amdgcn_mfma_f32_32x32x16_bf16(A[3][ks], B[ks], c3_, 0, 0, 0); }
                        IDX_FINISH(2, c2_); IDX_FINISH(3, c3_);
                    }
#undef IDX_FINISH
                }
                asm volatile("s_waitcnt vmcnt(0)" ::: "memory");
                __syncthreads();
            }
        }
#undef P4_STAGE
        PHASE_END
        GRID_BAR();
        }
        for (int rep_ = 0; rep_ < REP_P5; ++rep_) {
        PHASE_BEGIN
        {
            LAS unsigned char* VB = lds + wave * 18432;
            LAS unsigned short* SELW = (LAS unsigned short*)(VB + 17408);
            const int hd = lane & 15, g = lane >> 4, qq = hd >> 2, pp = hd & 3;
            const float slope = exp2f(-0.5f * (float)(hd + 1));
            for (int q = gw; q < M; q += NGW) {
                const int b = q / SEQ, pos = q % SEQ, qc = pos >> 6; const int nsel = qc < 4 ? (qc + 1) * 64 : 256;
                for (int rtk_ = 0; rtk_ < REP_TOPK; ++rtk_) {
                int lane_t = lane; asm volatile("" : "+v"(lane_t));
                if (qc < 4) { const unsigned e0 = 4 * lane_t; const bool ok = 4 * lane_t < nsel; v2u z; z.x = ok ? (e0 | ((e0 + 1) << 16)) : 0u; z.y = ok ? ((e0 + 2) | ((e0 + 3) << 16)) : 0u; *(LAS v2u*)(SELW + 4 * lane_t) = z; }
                else {
                    LAS unsigned* HIST = (LAS unsigned*)VB;
                    const int nb8 = (qc + 8) >> 3;
                    float v[64];
                    { unsigned pk[32]; const int i2max = 4 * nb8 - 1; const _Float16* irow = ISC + (size_t)q * 4096 + 2 * lane_t; typedef _Float16 h2_t __attribute__((ext_vector_type(2)));
#pragma unroll
                      for (int i2 = 0; i2 < 32; ++i2) { const int ic = i2 < i2max ? i2 : i2max; pk[i2] = *(const unsigned*)(irow + ic * 128); }
#pragma unroll
                      for (int i2 = 0; i2 < 32; ++i2) { const float lim = (i2 >> 2) < nb8 ? 3.0e38f : -1.0e30f; const h2_t h = __builtin_bit_cast(h2_t, pk[i2]);
                          const float f0 = (float)h[0], f1 = (float)h[1]; v[2 * i2] = fminf(f0, lim); v[2 * i2 + 1] = fminf(f1, lim); } }
                    float vmx = v[0], vmn = fminf(fminf(v[0], v[1]), fminf(v[2], v[3]));
#pragma unroll
                    for (int i = 1; i < 64; ++i) vmx = fmaxf(vmx, v[i]);
                    vmx = wmax_f(vmx); vmn = -wmax_f(-vmn);
                    const float rng = vmx - vmn; const float s20 = rng > 0.f ? 1048574.0f / rng : 0.f;
#define ZERO_HIST() do { *(LAS v4u*)(HIST + 16 * lane) = (v4u){0u, 0u, 0u, 0u}; *(LAS v4u*)(HIST + 16 * lane + 4) = (v4u){0u, 0u, 0u, 0u}; *(LAS v4u*)(HIST + 16 * lane + 8) = (v4u){0u, 0u, 0u, 0u}; \
                        *(LAS v4u*)(HIST + 16 * lane + 12) = (v4u){0u, 0u, 0u, 0u}; HIST[1024 + lane] = 0u; } while (0)
#define SCAN_HIST(R_, BIN_, AB_) do { unsigned hh_[16]; const int hb_ = 1008 - 16 * lane; \
                        { const v4u h0 = *(const LAS v4u*)(HIST + hb_), h1 = *(const LAS v4u*)(HIST + hb_ + 4), h2 = *(const LAS v4u*)(HIST + hb_ + 8), h3 = *(const LAS v4u*)(HIST + hb_ + 12); \
                          hh_[0] = h0.x; hh_[1] = h0.y; hh_[2] = h0.z; hh_[3] = h0.w; hh_[4] = h1.x; hh_[5] = h1.y; hh_[6] = h1.z; hh_[7] = h1.w; hh_[8] = h2.x; hh_[9] = h2.y; hh_[10] = h2.z; hh_[11] = h2.w; hh_[12] = h3.x; hh_[13] = h3.y; hh_[14] = h3.z; hh_[15] = h3.w; } \
                        unsigned tot_ = 0u; _Pragma("unroll") for (int k = 0; k < 16; ++k) tot_ += hh_[k]; \
                        unsigned run_ = wprefix_u(tot_) - tot_; int fb_ = -1; unsigned fa_ = 0u; \
                        _Pragma("unroll") for (int k = 15; k >= 0; --k) { if (run_ < (R_) && run_ + hh_[k] >= (R_)) { fb_ = hb_ + k; fa_ = run_; } run_ += hh_[k]; } \
                        const unsigned long long bm_ = __ballot(fb_ >= 0); const int L_ = (int)__builtin_ctzll(bm_); \
                        BIN_ = (unsigned)__builtin_amdgcn_readlane(fb_, L_); AB_ = (unsigned)__builtin_amdgcn_readlane((int)fa_, L_); } while (0)
                    ZERO_HIST();
#pragma unroll
                    for (int i = 0; i < 64; ++i) v[i] = __builtin_bit_cast(float, (unsigned)((v[i] - vmn) * s20));
#define cd(i_) __builtin_bit_cast(unsigned, v[i_])
#pragma unroll
                    for (int g8 = 0; g8 < 8; ++g8) { if (g8 < nb8) {
#pragma unroll
                        for (int j = 0; j < 8; ++j) __hip_atomic_fetch_add(HIST + (cd(g8 * 8 + j) >> 10), 1u, __ATOMIC_RELAXED, __HIP_MEMORY_SCOPE_WORKGROUP); } }
                    LDS_WAIT(); asm volatile("" ::: "memory");
                    unsigned tb, above; SCAN_HIST(256u, tb, above);
                    ZERO_HIST();
                    LDS_WAIT(); asm volatile("" ::: "memory");
#pragma unroll
                    for (int g8 = 0; g8 < 8; ++g8) { if (g8 < nb8) {
#pragma unroll
                        for (int j = 0; j < 8; ++j) { const unsigned c = cd(g8 * 8 + j); const unsigned a = (c >> 10) == tb ? (c & 1023u) : 1024u + lane; __hip_atomic_fetch_add(HIST + a, 1u, __ATOMIC_RELAXED, __HIP_MEMORY_SCOPE_WORKGROUP); } } }
                    LDS_WAIT(); asm volatile("" ::: "memory");
                    unsigned tb2, ab2; { const unsigned R2 = 256u - above; SCAN_HIST(R2, tb2, ab2); }
                    const unsigned T = (tb << 10) | tb2; above += ab2;
                    unsigned baseg = 0u, basee = above;
#pragma unroll
                    for (int g8 = 0; g8 < 8; ++g8) { if (g8 < nb8) {
#pragma unroll
                        for (int j = 0; j < 8; ++j) { const int i = g8 * 8 + j;
                            const bool gt = cd(i) > T; const unsigned long long bg = __ballot(gt);
                            const unsigned pgp = baseg + __builtin_amdgcn_mbcnt_hi((unsigned)(bg >> 32), __builtin_amdgcn_mbcnt_lo((unsigned)bg, 0u));
                            if (gt) SELW[pgp] = (unsigned short)((i >> 1) * 128 + (i & 1) + 2 * lane);
                            baseg += (unsigned)__popcll(bg);
                            const bool eq = cd(i) == T; const unsigned long long be = __ballot(eq);
                            if (be) { const unsigned pep = basee + __builtin_amdgcn_mbcnt_hi((unsigned)(be >> 32), __builtin_amdgcn_mbcnt_lo((unsigned)be, 0u));
                                if (eq && pep < 256u) SELW[pep] = (unsigned short)((i >> 1) * 128 + (i & 1) + 2 * lane);
                                basee += (unsigned)__popcll(be); } } } }
#undef cd
#undef ZERO_HIST
#undef SCAN_HIST
                }
                LDS_WAIT(); asm volatile("" ::: "memory");
                }
                for (int rat_ = 0; rat_ < REP_ATT; ++rat_) {
                bf16* qrow = QB + (size_t)q * 4096;
                bf16x8 Bq[8];
#pragma unroll
                for (int ks = 0; ks < 8; ++ks) Bq[ks] = *(const bf16x8*)(qrow + hd * 256 + ks * 32 + g * 8);
                const bf16* kvb = CKV + (size_t)b * SEQ * 256;
                f32x4 O[16];
#pragma unroll
                for (int ct = 0; ct < 16; ++ct) O[ct] = (f32x4){0.f, 0.f, 0.f, 0.f};
                float mrun = -1.0e30f, lsum = 0.f;
                LDS_WAIT(); asm volatile("" ::: "memory");
                const int nks = nsel >> 5;
                const int lrow = lane >> 5, lcp = lane & 31;
                v4u KR[16];
#define ATT_LOADROWS(KST_) do { _Pragma("unroll") for (int i = 0; i < 16; ++i) { const int rr_ = 2 * i + lrow; const int ix_ = SELW[32 * (KST_) + rr_]; \
                    KR[i] = *(const v4u*)(kvb + (size_t)ix_ * 256 + ((lcp ^ (rr_ & 7)) * 8)); } } while (0)
                ATT_LOADROWS(0);
                const int rlA = hd & 7;
                const int rlT = (4 * g + qq) & 7;
                const int trb = (4 * g + qq) * 512 + 8 * (pp & 1), trm = 16 * ((pp >> 1) ^ rlT);
                for (int kst = 0; kst < nks; ++kst) {
                    int rlA_ = rlA, trm_ = trm; asm volatile("" : "+v"(rlA_), "+v"(trm_));
                    if (kst + 1 < nks) {
#pragma unroll
                        for (int i = 0; i < 16; ++i) { *(LAS v4u*)(VB + i * 1024 + lane * 16) = KR[i];
                            const int rr_ = 2 * i + lrow; const int ix_ = SELW[32 * (kst + 1) + rr_]; KR[i] = *(const v4u*)(kvb + (size_t)ix_ * 256 + ((lcp ^ (rr_ & 7)) * 8)); }
                    } else {
#pragma unroll
                        for (int i = 0; i < 16; ++i) *(LAS v4u*)(VB + i * 1024 + lane * 16) = KR[i]; }
                    LDS_WAIT(); asm volatile("" ::: "memory");
                    f32x4 S0 = {0.f, 0.f, 0.f, 0.f}, S1 = {0.f, 0.f, 0.f, 0.f};
#pragma unroll
                    for (int k4 = 0; k4 < 4; ++k4) {
                        bf16x8 a0[2], a1[2];
#pragma unroll
                        for (int j = 0; j < 2; ++j) { const int ks = k4 * 2 + j; const int cpos = (4 * ks + g) ^ rlA_;
                            a0[j] = *(const LAS bf16x8*)(VB + hd * 512 + cpos * 16); a1[j] = *(const LAS bf16x8*)(VB + (16 + hd) * 512 + cpos * 16); }
#pragma unroll
                        for (int j = 0; j < 2; ++j) { const int ks = k4 * 2 + j;
                            S0 = __builtin_amdgcn_mfma_f32_16x16x32_bf16(a0[j], Bq[ks], S0, 0, 0, 0); S1 = __builtin_amdgcn_mfma_f32_16x16x32_bf16(a1[j], Bq[ks], S1, 0, 0, 0); }
                    }
                    const v2u pa = *(const LAS v2u*)(SELW + 32 * kst + 4 * g), pb = *(const LAS v2u*)(SELW + 32 * kst + 16 + 4 * g);
                    const float fp = (float)pos;
                    float s0[4], s1[4];
                    s0[0] = S0[0] - slope * fabsf(fp - (float)(pa.x & 0xffffu)); s0[1] = S0[1] - slope * fabsf(fp - (float)(pa.x >> 16));
                    s0[2] = S0[2] - slope * fabsf(fp - (float)(pa.y & 0xffffu)); s0[3] = S0[3] - slope * fabsf(fp - (float)(pa.y >> 16));
                    s1[0] = S1[0] - slope * fabsf(fp - (float)(pb.x & 0xffffu)); s1[1] = S1[1] - slope * fabsf(fp - (float)(pb.x >> 16));
                    s1[2] = S1[2] - slope * fabsf(fp - (float)(pb.y & 0xffffu)); s1[3] = S1[3] - slope * fabsf(fp - (float)(pb.y >> 16));
                    float ml = fmaxf(fmaxf(fmaxf(s0[0], s0[1]), fmaxf(s0[2], s0[3])), fmaxf(fmaxf(s1[0], s1[1]), fmaxf(s1[2], s1[3])));
                    ml = xmax16(ml); ml = xmax32(ml);
                    const float mnew = fmaxf(mrun, ml), alpha = __expf(mrun - mnew); mrun = mnew;
                    float p0[4], p1[4];
#pragma unroll
                    for (int r = 0; r < 4; ++r) { p0[r] = __expf(s0[r] - mnew); p1[r] = __expf(s1[r] - mnew); }
                    lsum = lsum * alpha + ((p0[0] + p0[1]) + (p0[2] + p0[3])) + ((p1[0] + p1[1]) + (p1[2] + p1[3]));
                    v4u pw; pw.x = pk2(p0[0], p0[1]); pw.y = pk2(p0[2], p0[3]); pw.z = pk2(p1[0], p1[1]); pw.w = pk2(p1[2], p1[3]);
                    const bf16x8 Pf = __builtin_bit_cast(bf16x8, pw);
#pragma unroll
                    for (int ct = 0; ct < 16; ++ct) O[ct] = O[ct] * alpha;
#pragma unroll
                    for (int c8 = 0; c8 < 4; ++c8) {
                        v4s lo[4], hi[4];
#pragma unroll
                        for (int j = 0; j < 4; ++j) { const int ct = c8 * 4 + j; const int off = trb + ((32 * ct) ^ trm_);
                            lo[j] = __builtin_amdgcn_ds_read_tr16_b64_v4i16((LAS v4s*)(VB + off));
                            hi[j] = __builtin_amdgcn_ds_read_tr16_b64_v4i16((LAS v4s*)(VB + 16 * 512 + off)); }
#pragma unroll
                        for (int j = 0; j < 4; ++j) { const int ct = c8 * 4 + j;
                            const bf16x8 Af = {lo[j][0], lo[j][1], lo[j][2], lo[j][3], hi[j][0], hi[j][1], hi[j][2], hi[j][3]};
                            O[ct] = __builtin_amdgcn_mfma_f32_16x16x32_bf16(Af, Pf, O[ct], 0, 0, 0); }
                    }
                    LDS_WAIT(); asm volatile("" ::: "memory");
                }
#undef ATT_LOADROWS
                lsum = xsum16(lsum); lsum = xsum32(lsum);
                const float inv = 1.0f / lsum;
#pragma unroll
                for (int ct = 0; ct < 16; ++ct) { const f32x4 o = O[ct] * inv; v2u w; w.x = pk2(o[0], o[1]); w.y = pk2(o[2], o[3]); *(v2u*)(OB + (size_t)q * 4096 + hd * 256 + 16 * ct + 4 * g) = w; }
                }
            }
        }
        PHASE_END
        GRID_BAR();
        }
        PHASE_BEGIN
        { pg8::Gemm g{OB, W6, M, 1024, 1024, 4096, 1024, 1024}; pg8::StaticOrder S; S.init(M, 1024, G, blk);
          EpiBf E{YAB, 2048, 1024}; pg8::gemm_phase(lds, g, S, E, tid); }
        PHASE_END
        GRID_BAR();
        PHASE_BEGIN
        { pg8::Gemm g{YAB, W7, M, DM, DM, DM, DM, 0}; pg8::StaticOrder S; S.init(M, DM, G, blk);
          EpiGateM E{GTB, MRG}; HookGate Hk{GTA, GTB}; pg8::gemm_phase(lds, g, S, E, tid, Hk); }
        PHASE_END
        GRID_BAR();
        PHASE_BEGIN
        { pg8::Gemm g{MRG, W8, M, DM, DM, DM, DM, 0}; pg8::StaticOrder S; S.init(M, DM, G, blk);
          EpiRes E{(l == 0) ? x_in : (const float*)nullptr, XB, RB, modl + 2 * DM}; pg8::gemm_phase(lds, g, S, E, tid); }
        PHASE_END
        GRID_BAR();
        for (int rep_ = 0; rep_ < REP_P9; ++rep_) {
        PHASE_BEGIN
        f32x4 lg[8], lb_[8]; v2u nx[8];
#pragma unroll
        for (int j = 0; j < 8; ++j) { const int c = j * 256 + lane * 4; lg[j] = *(const f32x4*)(ln1_g + l * DM + c); lb_[j] = *(const f32x4*)(ln1_b + l * DM + c); nx[j] = *(const v2u*)(RB + (size_t)gw * DM + c); }
        for (int row = gw; row < M; row += NGW) {
            const int b = row / SEQ; const float* md = modl + (size_t)b * MODW;
            f32x4 v[8]; float s = 0.f;
#pragma unroll
            for (int j = 0; j < 8; ++j) { v[j] = (f32x4){bflo(nx[j].x), bfhi(nx[j].x), bflo(nx[j].y), bfhi(nx[j].y)}; s += (v[j][0] + v[j][1]) + (v[j][2] + v[j][3]); }
            { const int rn = row + NGW < M ? row + NGW : row;
#pragma unroll
              for (int j = 0; j < 8; ++j) nx[j] = *(const v2u*)(RB + (size_t)rn * DM + j * 256 + lane * 4); }
            f32x4 msc[8], msh[8];
#pragma unroll
            for (int j = 0; j < 8; ++j) { const int c = j * 256 + lane * 4; msc[j] = *(const f32x4*)(md + 4 * DM + c); msh[j] = *(const f32x4*)(md + 3 * DM + c); }
            const float mean = wave_sum(s) * (1.f / DM); float s2 = 0.f;
#pragma unroll
            for (int j = 0; j < 8; ++j) { v[j] = v[j] - mean; s2 += (v[j][0] * v[j][0] + v[j][1] * v[j][1]) + (v[j][2] * v[j][2] + v[j][3] * v[j][3]); }
            const float rstd = 1.0f / sqrtf(wave_sum(s2) * (1.f / DM) + 1e-5f);
#pragma unroll
            for (int j = 0; j < 8; ++j) { const int c = j * 256 + lane * 4; const f32x4 gg = lg[j], bb = lb_[j];
                const f32x4 y = v[j] * rstd * gg + bb; { v2u wx; wx.x = pk2(y[0], y[1]); wx.y = pk2(y[2], y[3]); *(v2u*)(XB + (size_t)row * DM + c) = wx; }
                const f32x4 sc = msc[j], sh = msh[j]; const f32x4 hh = y * (sc + 1.f) + sh;
                v2u w; w.x = pk2(hh[0], hh[1]); w.y = pk2(hh[2], hh[3]); *(v2u*)(HB + (size_t)row * DM + c) = w; }
        }
        PHASE_END
        GRID_BAR();
        }
        PHASE_BEGIN
        { pg8::Gemm g{HB, W10, M, N10, DM, DM, DM, 0}; pg8::StaticOrder S; S.init(M, N10, G, blk);
          EpiSwiglu E{ACT}; pg8::gemm_phase(lds, g, S, E, tid); }
        PHASE_END
        GRID_BAR();
        PHASE_BEGIN
        { pg8::Gemm g{ACT, W11, M, DM, DFF, DFF, DFF, 0}; pg8::StaticOrder S; S.init(M, DM, G, blk);
          EpiRes E{(const float*)nullptr, XB, RB, modl + 5 * DM}; pg8::gemm_phase(lds, g, S, E, tid); }
        PHASE_END
        GRID_BAR();
        for (int rep_ = 0; rep_ < REP_P12; ++rep_) {
        PHASE_BEGIN
        {
            const bool lastl = (l == DEPTH - 1); const float* mdn = MOD + (size_t)(l + 1 < DEPTH ? l + 1 : l) * NBATCH * MODW;
            f32x4 lg[8], lb_[8]; v2u nx[8];
#pragma unroll
            for (int j = 0; j < 8; ++j) { const int c = j * 256 + lane * 4; lg[j] = *(const f32x4*)(ln2_g + l * DM + c); lb_[j] = *(const f32x4*)(ln2_b + l * DM + c); nx[j] = *(const v2u*)(RB + (size_t)gw * DM + c); }
            for (int row = gw; row < M; row += NGW) {
                const int b = row / SEQ; const float* md = mdn + (size_t)b * MODW;
                f32x4 v[8]; float s = 0.f;
#pragma unroll
                for (int j = 0; j < 8; ++j) { v[j] = (f32x4){bflo(nx[j].x), bfhi(nx[j].x), bflo(nx[j].y), bfhi(nx[j].y)}; s += (v[j][0] + v[j][1]) + (v[j][2] + v[j][3]); }
                { const int rn = row + NGW < M ? row + NGW : row;
#pragma unroll
                  for (int j = 0; j < 8; ++j) nx[j] = *(const v2u*)(RB + (size_t)rn * DM + j * 256 + lane * 4); }
                f32x4 msc[8], msh[8];
#pragma unroll
                for (int j = 0; j < 8; ++j) { const int c = j * 256 + lane * 4; msc[j] = *(const f32x4*)(md + DM + c); msh[j] = *(const f32x4*)(md + c); }
                const float mean = wave_sum(s) * (1.f / DM); float s2 = 0.f;
#pragma unroll
                for (int j = 0; j < 8; ++j) { v[j] = v[j] - mean; s2 += (v[j][0] * v[j][0] + v[j][1] * v[j][1]) + (v[j][2] * v[j][2] + v[j][3] * v[j][3]); }
                const float rstd = 1.0f / sqrtf(wave_sum(s2) * (1.f / DM) + 1e-5f);
#pragma unroll
                for (int j = 0; j < 8; ++j) { const int c = j * 256 + lane * 4; const f32x4 gg = lg[j], bb = lb_[j];
                    const f32x4 y = v[j] * rstd * gg + bb; if (lastl) *(f32x4*)(args.out + (size_t)row * DM + c) = y; else { v2u wx; wx.x = pk2(y[0], y[1]); wx.y = pk2(y[2], y[3]); *(v2u*)(XB + (size_t)row * DM + c) = wx; }
                    const f32x4 sc = msc[j], sh = msh[j]; const f32x4 hh = y * (sc + 1.f) + sh;
                    v2u w; w.x = pk2(hh[0], hh[1]); w.y = pk2(hh[2], hh[3]); *(v2u*)(HB + (size_t)row * DM + c) = w; }
            }
            if (l + 1 < DEPTH) { __syncthreads(); CONVERT_LAYER(l + 1); }
        }
        PHASE_END
        if (l + 1 < DEPTH || rep_ + 1 < REP_P12) GRID_BAR();
        }
    }
}

extern "C" void kernel_launch(void* const* d_in, const int* in_sizes, int n_in, void* d_out, int out_size, void* d_ws, size_t ws_size, hipStream_t stream) {
    static int grid = 0;
    if (grid == 0) {
        if (n_in != 22 || out_size != M * DM || ws_size < WS_END) { fprintf(stderr, "kernel_launch: unexpected shapes (n_in %d, out %d, ws %zu < %zu)\n", n_in, out_size, ws_size, (size_t)WS_END); grid = -1; return; }
        int dev = 0, cus = 0, per_cu = 0;
        if (hipGetDevice(&dev) != hipSuccess || hipDeviceGetAttribute(&cus, hipDeviceAttributeMultiprocessorCount, dev) != hipSuccess) { grid = -1; return; }
        if (hipFuncSetAttribute((const void*)fwd_kernel, hipFuncAttributeMaxDynamicSharedMemorySize, LDS_BYTES) != hipSuccess) { fprintf(stderr, "kernel_launch: hipFuncSetAttribute failed\n"); grid = -1; return; }
        if (hipOccupancyMaxActiveBlocksPerMultiprocessor(&per_cu, (const void*)fwd_kernel, NTHR, LDS_BYTES) != hipSuccess || per_cu < 1) { fprintf(stderr, "kernel_launch: occupancy query says %d\n", per_cu); }
        (void)hipGetLastError();
        grid = cus;
    }
    if (grid < 0) return;
    if (hipMemsetAsync((char*)d_ws + WS_CTL, 0, CTL_ZERO_BYTES, stream) != hipSuccess) return;
    Args a{};
    for (int i = 0; i < 22; ++i) a.in[i] = (const float*)d_in[i];
    a.out = (float*)d_out; a.ws = (unsigned char*)d_ws;
    hipLaunchKernelGGL(fwd_kernel, dim3(grid), dim3(NTHR), LDS_BYTES, stream, a);
}
```

```cpp
#include <hip/hip_runtime.h>
#include <cstdio>
#include <cstdint>

namespace pg8 {
#define PG8_LAS __attribute__((address_space(3)))
typedef unsigned short bf16_t;
typedef short bf16x8 __attribute__((ext_vector_type(8)));
typedef float f32x4 __attribute__((ext_vector_type(4)));
typedef unsigned u32x4 __attribute__((ext_vector_type(4)));
constexpr int BM = 256, BK = 64, HALF = 128, HTB = HALF * BK * 2, STAGE_BYTES = 8 * HTB, NXCD = 8, WGM = 8;

__host__ __device__ __forceinline__ int lds_byte(int r, int c) { const int st = (r >> 4) * 2 + (c >> 5), rr = r & 15, cc = c & 31, ob = rr * 64 + cc * 2; return st * 1024 + (ob ^ (((ob >> 9) & 1) << 5)); }
__host__ __device__ __forceinline__ void stage_rc(int b, int& R, int& C) { const int st = b / 1024, sb = b % 1024, swz = sb ^ (((sb >> 9) & 1) << 5); R = (st >> 1) * 16 + swz / 64; C = (st & 1) * 32 + (swz % 64) / 2; }
__host__ __device__ __forceinline__ int perm32(int rho) { const int n = rho >> 4, i = rho & 15; return 8 * (i >> 2) + 4 * n + (i & 3); }

struct Unit { int pm, pn; };
struct Gemm { const bf16_t* A; const bf16_t* Bt; int M, N, K, lda, ldb, a_pn_stride; };

struct StaticOrder {
    int nM, nN, nwg, G, c;
    __host__ __device__ void init(int M, int N, int G_, int c_) { nM = M / BM; nN = N / BM; nwg = nM * nN; G = G_; c = c_; }
    __host__ __device__ bool next(int i, Unit& u) const {
        const long L = (long)i * G + c; if (L >= nwg) return false;
        int wgid = (int)L; { const int q = nwg / NXCD, r = nwg % NXCD, xcd = wgid % NXCD, off = wgid / NXCD; wgid = (xcd < r ? xcd * (q + 1) : r * (q + 1) + (xcd - r) * q) + off; }
        const int nig = WGM * nN, gid = wgid / nig, fm = gid * WGM, gsz = (nM - fm) < WGM ? (nM - fm) : WGM;
        u.pm = fm + ((wgid % nig) % gsz); u.pn = (wgid % nig) / gsz; return true;
    }
};

typedef float f32x2_t __attribute__((ext_vector_type(2))); typedef __bf16 bf16x2_t __attribute__((ext_vector_type(2)));
__device__ __forceinline__ unsigned cvt_pk_bf16(float lo, float hi) { f32x2_t v = {lo, hi}; bf16x2_t b = __builtin_convertvector(v, bf16x2_t); return __builtin_bit_cast(unsigned, b); }

struct NoHook { static constexpr bool ON = false; template <class A> __device__ __forceinline__ void mid(A&, const Unit&, int, int, int, int) const {} };
template <class Epi, class Hook = NoHook>
__device__ __forceinline__ void gemm_phase(PG8_LAS unsigned char* lds, const Gemm g, const StaticOrder& S, const Epi& E, const int tid, const Hook H = Hook()) {
    const int wid = __builtin_amdgcn_readfirstlane(tid >> 6), lane = tid & 63, wr = wid >> 2, wc = wid & 3, fr = lane & 15, fq = lane >> 4;
    const int K = g.K, nt = K / BK;
    unsigned voffA[2], voffB[2];
#pragma unroll
    for (int i = 0; i < 2; ++i) { int R, C; stage_rc(tid * 16 + i * 8192, R, C); const int Rb = 64 * (R >> 5) + perm32(R & 31);
        voffA[i] = (unsigned)(R * g.lda + C) * 2u; voffB[i] = (unsigned)(Rb * g.ldb + C) * 2u; }
    const size_t kstep = (size_t)(BK * 2);
    const size_t hstepA = (size_t)HALF * g.lda * 2, hstepB = (size_t)32 * g.ldb * 2;
    const size_t tstepA = 2 * hstepA, tstepB = (size_t)BM * g.ldb * 2;
    const unsigned ldsw = (unsigned)wid * 1024u;
    const int aoff = lds_byte(wr * 64 + fr, fq * 8), boff = lds_byte(wc * 32 + fr, fq * 8);
#define PG8_SA(b, h) (((b) * 2 + (h)) * HTB)
#define PG8_SB(b, h) ((4 + (b) * 2 + (h)) * HTB)
#define PG8_STAGE(bufoff, gbase, voff) do { _Pragma("unroll") for (int _i = 0; _i < 2; ++_i) \
        __builtin_amdgcn_global_load_lds((const unsigned*)((const char*)(gbase) + (voff)[_i]), (PG8_LAS unsigned*)(lds + (bufoff) + ldsw + _i * 8192), 16, 0, 0); } while (0)
#define PG8_LDA(dst, b, h) do { _Pragma("unroll") for (int m = 0; m < 4; ++m) _Pragma("unroll") for (int k = 0; k < 2; ++k) dst[m][k] = *(const PG8_LAS bf16x8*)(lds + PG8_SA(b, h) + aoff + m * 2048 + k * 1024); } while (0)
#define PG8_LDB(dst, b, h) do { _Pragma("unroll") for (int n = 0; n < 2; ++n) _Pragma("unroll") for (int k = 0; k < 2; ++k) dst[n][k] = *(const PG8_LAS bf16x8*)(lds + PG8_SB(b, h) + boff + n * 2048 + k * 1024); } while (0)
#define PG8_MMA(ai, bj, At, Bt) do { __builtin_amdgcn_s_setprio(1); _Pragma("unroll") for (int m = 0; m < 4; ++m) _Pragma("unroll") for (int n = 0; n < 2; ++n) _Pragma("unroll") for (int k = 0; k < 2; ++k) \
        acc[ai][bj][m][n] = __builtin_amdgcn_mfma_f32_16x16x32_bf16(Bt[n][k], At[m][k], acc[ai][bj][m][n], 0, 0, 0); __builtin_amdgcn_s_setprio(0); } while (0)
#define PG8_WAIT_V(n) asm volatile("s_waitcnt vmcnt(" #n ")" ::: "memory")
#define PG8_WAIT_L(n) asm volatile("s_waitcnt lgkmcnt(" #n ")" ::: "memory")
#define PG8_BAR __builtin_amdgcn_s_barrier()
#define PG8_SCHED __builtin_amdgcn_sched_barrier(0)
    Unit cur, nxt; int ui = 0;
    if (!S.next(0, cur)) return;
    f32x4 acc[2][2][4][2];
#pragma unroll
    for (int a = 0; a < 2; ++a)
#pragma unroll
        for (int b = 0; b < 2; ++b)
#pragma unroll
            for (int m = 0; m < 4; ++m)
#pragma unroll
                for (int n = 0; n < 2; ++n) acc[a][b][m][n] = (f32x4){0.f, 0.f, 0.f, 0.f};
    bf16x8 At[4][2], B0[2][2], B1[2][2];
    const char* cA = (const char*)g.A + (size_t)cur.pm * tstepA + (size_t)cur.pn * g.a_pn_stride * 2; const char* cB = (const char*)g.Bt + (size_t)cur.pn * tstepB;
    PG8_STAGE(PG8_SB(0, 0), cB, voffB); PG8_STAGE(PG8_SB(0, 1), cB + hstepB, voffB); PG8_STAGE(PG8_SA(0, 0), cA, voffA); PG8_STAGE(PG8_SA(0, 1), cA + hstepA, voffA);
    if (wr == 1) PG8_BAR;
    PG8_WAIT_V(2); PG8_BAR;
    PG8_STAGE(PG8_SB(1, 0), cB + kstep, voffB); PG8_STAGE(PG8_SA(1, 0), cA + kstep, voffA); PG8_STAGE(PG8_SB(1, 1), cB + hstepB + kstep, voffB);
    PG8_WAIT_V(6); PG8_BAR;
    for (;;) {
        const bool has_next = S.next(ui + 1, nxt);
        const char* nA = has_next ? (const char*)g.A + (size_t)nxt.pm * tstepA + (size_t)nxt.pn * g.a_pn_stride * 2 : cA; const char* nB = has_next ? (const char*)g.Bt + (size_t)nxt.pn * tstepB : cB;
        for (int t = 0; t < nt; t += 2) {
            const bool last = (t == nt - 2);
            const char* a1 = cA + (size_t)(t + 1) * kstep;
            const char* a2 = last ? nA : cA + (size_t)(t + 2) * kstep; const char* b2 = last ? nB : cB + (size_t)(t + 2) * kstep;
            const char* a3 = a2 + kstep; const char* b3 = b2 + kstep;
            if constexpr (Hook::ON) { if (t == (nt >> 1)) H.mid(acc, cur, wr, wc, fr, fq); }
            PG8_LDB(B0, 0, 0); PG8_LDB(B1, 0, 1); PG8_SCHED; PG8_LDA(At, 0, 0); PG8_STAGE(PG8_SA(1, 1), a1 + hstepA, voffA);
            PG8_WAIT_V(8); PG8_WAIT_L(0); PG8_BAR; PG8_MMA(0, 0, At, B0); PG8_MMA(0, 1, At, B1); PG8_BAR; PG8_SCHED;
            PG8_LDA(At, 0, 1); PG8_STAGE(PG8_SB(0, 0), b2, voffB); PG8_STAGE(PG8_SB(0, 1), b2 + hstepB, voffB); PG8_STAGE(PG8_SA(0, 0), a2, voffA);
            PG8_WAIT_V(8); PG8_WAIT_L(0); PG8_BAR; PG8_MMA(1, 0, At, B0); PG8_MMA(1, 1, At, B1); PG8_BAR; PG8_SCHED;
            PG8_LDB(B0, 1, 0); PG8_LDB(B1, 1, 1); PG8_SCHED; PG8_LDA(At, 1, 0); PG8_STAGE(PG8_SA(0, 1), a2 + hstepA, voffA);
            PG8_WAIT_V(8); PG8_WAIT_L(0); PG8_BAR; PG8_MMA(0, 0, At, B0); PG8_MMA(0, 1, At, B1); PG8_BAR; PG8_SCHED;
            PG8_LDA(At, 1, 1); PG8_STAGE(PG8_SB(1, 0), b3, voffB); PG8_STAGE(PG8_SB(1, 1), b3 + hstepB, voffB); PG8_STAGE(PG8_SA(1, 0), a3, voffA);
            PG8_WAIT_V(8); PG8_WAIT_L(0); PG8_BAR; PG8_MMA(1, 0, At, B0); PG8_MMA(1, 1, At, B1); PG8_BAR; PG8_SCHED;
        }
        if (wr == 0) PG8_BAR;
        E(acc, cur, wr, wc, fr, fq);
        if (!has_next) break;
#pragma unroll
        for (int a = 0; a < 2; ++a)
#pragma unroll
            for (int b = 0; b < 2; ++b)
#pragma unroll
                for (int m = 0; m < 4; ++m)
#pragma unroll
                    for (int n = 0; n < 2; ++n) acc[a][b][m][n] = (f32x4){0.f, 0.f, 0.f, 0.f};
        cur = nxt; cA = nA; cB = nB; ++ui;
        if (wr == 1) PG8_BAR;
    }
    PG8_WAIT_V(0);
    PG8_BAR;
#undef PG8_SA
#undef PG8_SB
#undef PG8_STAGE
#undef PG8_LDA
#undef PG8_LDB
#undef PG8_MMA
#undef PG8_WAIT_V
#undef PG8_WAIT_L
#undef PG8_BAR
#undef PG8_SCHED
}
}

constexpr int NWAVES = 8, NTHR = NWAVES * 64;
constexpr int DM = 2048, NBATCH = 4, SEQ = 4096, DEPTH = 4, M = NBATCH * SEQ;
constexpr int HGW = 1024;
constexpr int SAH = 16, SAC = 256, SAR = 512;
constexpr int DFF = 5632;
constexpr int N1 = 9216, N3 = 5120, N10 = 2 * DFF;
constexpr float ALPHA = 1.6817928305074292f;
constexpr int MODW = 6 * DM;

constexpr size_t MiB = 1u << 20;
constexpr size_t WS_CTL = 0, CTL_ZERO_BYTES = 32768;
constexpr size_t WS_MOD = 1 * MiB;
constexpr size_t WS_LB = 2 * MiB;
constexpr size_t WS_MODP = 3 * MiB;
constexpr size_t WS_W1 = 9 * MiB;
constexpr size_t WS_W3 = WS_W1 + 36 * MiB;
constexpr size_t WS_W6 = WS_W3 + 5 * MiB;
constexpr size_t WS_W7 = WS_W6 + 2 * MiB;
constexpr size_t WS_W8 = WS_W7 + 8 * MiB;
constexpr size_t WS_W10 = WS_W8 + 8 * MiB;
constexpr size_t WS_W11 = WS_W10 + 44 * MiB;
constexpr size_t WS_X = WS_W11 + 22 * MiB;
constexpr size_t WS_R = WS_X + 128 * MiB;
constexpr size_t WS_H = WS_R + 128 * MiB;
constexpr size_t WS_QA = WS_H + 64 * MiB;
constexpr size_t WS_FA = WS_QA + 32 * MiB;
constexpr size_t WS_IA = WS_FA + 64 * MiB;
constexpr size_t WS_GA = WS_IA + 32 * MiB;
constexpr size_t WS_LAT = WS_GA + 32 * MiB;
constexpr size_t WS_GTA = WS_LAT + 64 * MiB;
constexpr size_t WS_GTB = WS_GTA + 64 * MiB;
constexpr size_t WS_CQN = WS_GTB + 64 * MiB;
constexpr size_t WS_CKV = WS_CQN + 16 * MiB;
constexpr size_t WS_KIDX = WS_CKV + 8 * MiB;
constexpr size_t WS_IDXW = WS_KIDX + 2 * MiB;
constexpr size_t WS_QB = WS_IDXW + 1 * MiB;
constexpr size_t WS_QIDX = WS_QB + 128 * MiB;
constexpr size_t WS_SEL = WS_QIDX + 32 * MiB;
constexpr size_t WS_YAB = WS_SEL + 8 * MiB;
constexpr size_t WS_MRG = WS_FA;
constexpr size_t WS_OB = WS_YAB + 64 * MiB;
constexpr size_t WS_BIG = WS_OB + 128 * MiB;
constexpr size_t WS_KSB = WS_BIG + 256 * MiB;
constexpr size_t WS_DEB = WS_KSB + 32 * MiB;
constexpr size_t WS_QSB = WS_DEB + 2 * MiB;
constexpr size_t WS_END = WS_QSB + 32 * MiB;

constexpr int CW_BAR = 4096;

constexpr int RING_BYTES = 131072;
constexpr int LDS_BYTES = 163840;
constexpr int LDSCTL_OFF = LDS_BYTES - 1024, MISC_OFF = LDSCTL_OFF + 320, SELL_OFF = 147456;

#define GAS __attribute__((address_space(1)))
#define LAS __attribute__((address_space(3)))
typedef unsigned short bf16;
typedef unsigned v4u __attribute__((ext_vector_type(4)));
typedef unsigned v2u __attribute__((ext_vector_type(2)));
typedef float f32x4 __attribute__((ext_vector_type(4)));
typedef float f32x16 __attribute__((ext_vector_type(16)));
typedef short bf16x8 __attribute__((ext_vector_type(8)));
typedef short v4s __attribute__((ext_vector_type(4)));
typedef GAS unsigned gu32;
#define LDS_WAIT() asm volatile("s_waitcnt lgkmcnt(0)" ::: "memory")
__device__ __forceinline__ unsigned f2bf(float f) { unsigned u = __builtin_bit_cast(unsigned, f); return (u + 0x7fffu + ((u >> 16) & 1u)) >> 16; }
__device__ __forceinline__ unsigned pk2(float lo, float hi) { return pg8::cvt_pk_bf16(lo, hi); }
__device__ __forceinline__ float bf2f(unsigned short b) { return __builtin_bit_cast(float, ((unsigned)b) << 16); }
__device__ __forceinline__ float bflo(unsigned w) { return __builtin_bit_cast(float, w << 16); }
__device__ __forceinline__ float bfhi(unsigned w) { return __builtin_bit_cast(float, w & 0xffff0000u); }
__device__ __forceinline__ float sigm(float x) { return __builtin_amdgcn_rcpf(1.f + __expf(-x)); }

__device__ __forceinline__ int lane_id() { unsigned m = ~0u; asm volatile("" : "+s"(m)); return (int)__builtin_amdgcn_mbcnt_hi(m, __builtin_amdgcn_mbcnt_lo(m, 0u)); }
#define XB_TMO      128
#define XB_XCNT(j)  (256  + 64 * (j))
#define XB_XSUB(j)  (1280 + 64 * (j))
#define XB_XGEN(j)  (2304 + 64 * (j))
#define XB_TOP      3328
#define XB_TOPGEN   3392
#define XCD_BAR_WORDS 3456
#define XB_SPIN_CAP (1u << 22)

__device__ __forceinline__ unsigned xb_ld(unsigned* p)              { return __hip_atomic_load(p, __ATOMIC_RELAXED, __HIP_MEMORY_SCOPE_AGENT); }
__device__ __forceinline__ unsigned xb_add(unsigned* p, unsigned v) { return __hip_atomic_fetch_add(p, v, __ATOMIC_RELAXED, __HIP_MEMORY_SCOPE_AGENT); }
__device__ __forceinline__ unsigned xb_xcc_id() { return (unsigned)__builtin_amdgcn_s_getreg((3 << 11) | 20) & 0xFu; }
#define XB_SPIN(cond, bar) do { unsigned _sp = 0; while (cond) { __builtin_amdgcn_s_sleep(1); \
    if ((++_sp & 255u) == 0u) { if (xb_ld(&(bar)[XB_TMO])) break; if (_sp > XB_SPIN_CAP) { atomicAdd(&(bar)[XB_TMO], 1u); break; } } } } while (0)

struct XcdBarrier { unsigned* bar; unsigned x; volatile LAS unsigned* st; int wave; };

__device__ __forceinline__ XcdBarrier xcd_barrier_post(unsigned* bar, volatile LAS unsigned* st) {
    XcdBarrier b; b.bar = bar; b.x = (unsigned)__builtin_amdgcn_readfirstlane((int)xb_xcc_id()); b.st = st;
    if (threadIdx.x == 0) (void)xb_add(&bar[XB_XCNT(b.x)], 1u);
    return b;
}
__device__ __forceinline__ void xcd_barrier_complete(unsigned* bar, unsigned x, unsigned& nloc, unsigned& nx) {
    const unsigned G = gridDim.x * gridDim.y * gridDim.z;
    unsigned sum, cnt, mine, sp = 0u;
    for (;;) {
        sum = 0u; cnt = 0u; mine = 0u;
#pragma unroll 1
        for (unsigned j = 0; j < 16; ++j) { const unsigned c = xb_ld(&bar[XB_XCNT(j)]); sum += c; cnt += (c > 0u) ? 1u : 0u; mine = (j == x) ? c : mine; }
        if (sum == G) break;
        __builtin_amdgcn_s_sleep(1);
        if ((++sp & 255u) == 0u) { if (xb_ld(&bar[XB_TMO])) break; if (sp > XB_SPIN_CAP) { atomicAdd(&bar[XB_TMO], 1u); break; } }
    }
    nloc = mine > 0u ? mine : 1u; nx = cnt > 0u ? cnt : 1u;
}
__device__ __forceinline__ void xcd_barrier(const XcdBarrier& b) {
    asm volatile("s_waitcnt vmcnt(0)" ::: "memory");
    __syncthreads();
    if (b.wave == 0 && lane_id() == 0) {
        unsigned* bar = b.bar;
        unsigned bx = b.x; asm volatile("" : "+s"(bx));
        __builtin_amdgcn_s_waitcnt(0);
        unsigned nloc = b.st[0], nx = b.st[1];
        const unsigned old = xb_add(&bar[XB_XSUB(bx)], 1u);
        const unsigned gen = old / nloc;
        if (old + 1u == (gen + 1u) * nloc) {
            __builtin_amdgcn_fence(__ATOMIC_RELEASE, "agent");
            asm volatile("s_waitcnt vmcnt(0)" ::: "memory");
            const unsigned og = xb_add(&bar[XB_TOP], 1u);
            const unsigned tg = og / nx;
            if (og + 1u == (tg + 1u) * nx) xb_add(&bar[XB_TOPGEN], 1u);
            else XB_SPIN(xb_ld(&bar[XB_TOPGEN]) == tg, bar);
            __builtin_amdgcn_fence(__ATOMIC_ACQUIRE, "agent");
            xb_add(&bar[XB_XGEN(bx)], 1u);
            asm volatile("s_waitcnt vmcnt(0)" ::: "memory");
        } else {
            XB_SPIN(xb_ld(&bar[XB_XGEN(bx)]) == gen, bar);
            __builtin_amdgcn_fence(__ATOMIC_ACQUIRE, "agent");
            asm volatile("s_waitcnt vmcnt(0)" ::: "memory");
        }
    }
    __syncthreads();
}

__device__ __forceinline__ void xswap16(float& a, float& b) { asm volatile("s_nop 1\n\tv_permlane16_swap_b32 %0, %1\n\ts_nop 1" : "+v"(a), "+v"(b)); }
__device__ __forceinline__ void xswap32(float& a, float& b) { asm volatile("s_nop 1\n\tv_permlane32_swap_b32 %0, %1\n\ts_nop 1" : "+v"(a), "+v"(b)); }
__device__ __forceinline__ float xmax16(float x) { float a = x, b = x; xswap16(a, b); return fmaxf(a, b); }
__device__ __forceinline__ float xmax32(float x) { float a = x, b = x; xswap32(a, b); return fmaxf(a, b); }
__device__ __forceinline__ float xsum16(float x) { float a = x, b = x; xswap16(a, b); return a + b; }
__device__ __forceinline__ float xsum32(float x) { float a = x, b = x; xswap32(a, b); return a + b; }

#define DPPF(x, ctrl) __builtin_bit_cast(float, __builtin_amdgcn_update_dpp(0, __builtin_bit_cast(int, (x)), (ctrl), 0xf, 0xf, true))
__device__ __forceinline__ float wmax_f(float x) {
    x = fmaxf(x, DPPF(x, 0xB1)); x = fmaxf(x, DPPF(x, 0x4E)); x = fmaxf(x, DPPF(x, 0x124)); x = fmaxf(x, DPPF(x, 0x128));
    x = xmax16(x); return xmax32(x);
}
__device__ __forceinline__ unsigned wprefix_u(unsigned x) {
    int v = (int)x;
    v += __builtin_amdgcn_update_dpp(0, v, 0x111, 0xf, 0xf, false);
    v += __builtin_amdgcn_update_dpp(0, v, 0x112, 0xf, 0xf, false);
    v += __builtin_amdgcn_update_dpp(0, v, 0x114, 0xf, 0xf, false);
    v += __builtin_amdgcn_update_dpp(0, v, 0x118, 0xf, 0xf, false);
    v += __builtin_amdgcn_update_dpp(0, v, 0x142, 0xa, 0xf, false);
    v += __builtin_amdgcn_update_dpp(0, v, 0x143, 0xc, 0xf, false);
    return (unsigned)v;
}

__device__ __forceinline__ float rowsum16(float x) { x += DPPF(x, 0xB1); x += DPPF(x, 0x4E); x += DPPF(x, 0x124); x += DPPF(x, 0x128); return x; }
__device__ __forceinline__ float wave_sum(float x) { x = rowsum16(x); x = xsum16(x); return xsum32(x); }
__device__ __forceinline__ float wave_max(float x) { return wmax_f(x); }
__device__ __forceinline__ int wave_sum_i(int v) { float f = wave_sum((float)v); return (int)(f + 0.5f); }
template <class Src>
__device__ __forceinline__ void cvt_load(const Src& src, int k0, int n0, int lane, float (&tv)[32]) {
#pragma unroll
    for (int i = 0; i < 32; ++i) tv[i] = src(k0 + 2 * i + (lane >> 5), n0 + (lane & 31));
}
__device__ __forceinline__ void cvt_store(const float (&tv)[32], bf16* WT, int K, int k0, int n0, LAS float* scr, int lane) {
#pragma unroll
    for (int i = 0; i < 32; ++i) scr[(2 * i + (lane >> 5)) * 33 + (lane & 31)] = tv[i];
    LDS_WAIT(); asm volatile("" ::: "memory");
    const int c = lane & 7;
#pragma unroll
    for (int j = 0; j < 4; ++j) { const int n = (lane >> 3) + 8 * j; const LAS float* s = scr + (8 * c) * 33 + n;
        v4u o; o.x = pk2(s[0 * 33], s[1 * 33]); o.y = pk2(s[2 * 33], s[3 * 33]); o.z = pk2(s[4 * 33], s[5 * 33]); o.w = pk2(s[6 * 33], s[7 * 33]);
        *(GAS v4u*)(WT + (size_t)(n0 + n) * K + k0 + 8 * c) = o; }
    LDS_WAIT(); asm volatile("" ::: "memory");
}

struct Args { const float* in[22]; float* out; unsigned char* ws; };

using pg8::Unit; using pg8::cvt_pk_bf16;
__device__ __forceinline__ void st_bf16x8(bf16* p, f32x4 v0, f32x4 v1) {
    v4u w; w.x = cvt_pk_bf16(v0[0], v0[1]); w.y = cvt_pk_bf16(v0[2], v0[3]); w.z = cvt_pk_bf16(v1[0], v1[1]); w.w = cvt_pk_bf16(v1[2], v1[3]);
    *(v4u*)p = w;
}
__device__ __forceinline__ void st_f32x8(float* p, f32x4 v0, f32x4 v1) { *(f32x4*)p = v0; *(f32x4*)(p + 4) = v1; }
__device__ __forceinline__ f32x4 sigm4(f32x4 v) { return (f32x4){sigm(v[0]), sigm(v[1]), sigm(v[2]), sigm(v[3])}; }
__device__ __forceinline__ f32x4 silu4(f32x4 v) { return (f32x4){v[0] * sigm(v[0]), v[1] * sigm(v[1]), v[2] * sigm(v[2]), v[3] * sigm(v[3])}; }
__device__ __forceinline__ f32x4 ldbf4(const bf16* p) { const v2u w = *(const v2u*)p; return (f32x4){bflo(w.x), bfhi(w.x), bflo(w.y), bfhi(w.y)}; }

#define EPI_LOOP(...) \
    _Pragma("unroll") for (int ai = 0; ai < 2; ++ai) _Pragma("unroll") for (int m = 0; m < 4; ++m) { const int row = row0 + ai * 128 + m * 16; \
        _Pragma("unroll") for (int bj = 0; bj < 2; ++bj) { const int col = colb + bj * 32; const f32x4 v0 = acc[ai][bj][m][0], v1 = acc[ai][bj][m][1]; __VA_ARGS__ } }

struct EpiProj {
    bf16* QA; bf16* FA; bf16* IA; bf16* GA; bf16* LAT; bf16* GTA; bf16* GTB;
    __device__ __forceinline__ void operator()(const f32x4 (&acc)[2][2][4][2], const Unit& u, int wr, int wc, int fr, int fq) const {
        const int row0 = u.pm * 256 + wr * 64 + fr, pn = u.pn; const int colb = (pn & 3) * 256 + wc * 64 + 8 * fq;
        if (pn < 4)       { EPI_LOOP( st_bf16x8(QA + (size_t)row * 1024 + col, v0, v1); ) }
        else if (pn < 8)  { EPI_LOOP( st_bf16x8(FA + (size_t)row * 1024 + col, v0, v1); ) }
        else if (pn < 12) { EPI_LOOP( st_bf16x8(IA + (size_t)row * 1024 + col, v0, v1); ) }
        else if (pn < 16) { EPI_LOOP( st_bf16x8(GA + (size_t)row * 1024 + col, silu4(v0), silu4(v1)); ) }
        else if (pn < 20) { EPI_LOOP( st_bf16x8(LAT + (size_t)row * 1024 + col, v0, v1); ) }
        else { bf16* G = pn < 28 ? GTA : GTB; const int cb2 = ((pn - 20) & 7) * 256 + wc * 64 + 8 * fq;
            _Pragma("unroll") for (int ai = 0; ai < 2; ++ai) _Pragma("unroll") for (int m = 0; m < 4; ++m) { const int row = row0 + ai * 128 + m * 16;
                _Pragma("unroll") for (int bj = 0; bj < 2; ++bj) st_bf16x8(G + (size_t)row * 2048 + cb2 + bj * 32, sigm4(acc[ai][bj][m][0]), sigm4(acc[ai][bj][m][1])); } }
    }
};
struct EpiQ {
    bf16* QB; bf16* QIDX;
    __device__ __forceinline__ void operator()(const f32x4 (&acc)[2][2][4][2], const Unit& u, int wr, int wc, int fr, int fq) const {
        const int row0 = u.pm * 256 + wr * 64 + fr, pn = u.pn;
        if (pn < 16) { const int colb = pn * 256 + wc * 64 + 8 * fq; EPI_LOOP( st_bf16x8(QB + (size_t)row * 4096 + col, v0, v1); ) }
        else { const int colb = (pn - 16) * 256 + wc * 64 + 8 * fq; EPI_LOOP( st_bf16x8(QIDX + (size_t)row * 1024 + col, v0, v1); ) }
    }
};
struct EpiBf {
    bf16* O; int ldc; int coff;
    __device__ __forceinline__ void operator()(const f32x4 (&acc)[2][2][4][2], const Unit& u, int wr, int wc, int fr, int fq) const {
        const int row0 = u.pm * 256 + wr * 64 + fr; const int colb = coff + u.pn * 256 + wc * 64 + 8 * fq;
        EPI_LOOP( st_bf16x8(O + (size_t)row * ldc + col, v0, v1); )
    }
};
struct HookGate {
    static constexpr bool ON = true; const bf16* GA_; const bf16* GB_;
    __device__ __forceinline__ void mid(f32x4 (&acc)[2][2][4][2], const Unit& u, int wr, int wc, int fr, int fq) const {
        asm volatile("" : "+v"(fr), "+v"(fq));
        const int row0 = u.pm * 256 + wr * 64 + fr; const int colb = u.pn * 256 + wc * 64 + 8 * fq;
#pragma unroll
        for (int ai = 0; ai < 2; ++ai)
#pragma unroll
            for (int m = 0; m < 4; ++m) { const int row = row0 + ai * 128 + m * 16;
#pragma unroll
                for (int bj = 0; bj < 2; ++bj) { const size_t o = (size_t)row * 2048 + colb + bj * 32;
                    const f32x4 a0 = ldbf4(GA_ + o), a1 = ldbf4(GA_ + o + 4), b0 = ldbf4(GB_ + o), b1 = ldbf4(GB_ + o + 4);
                    f32x4 r0, r1;
#pragma unroll
                    for (int j = 0; j < 4; ++j) { r0[j] = a0[j] * __builtin_amdgcn_rcpf(b0[j]); r1[j] = a1[j] * __builtin_amdgcn_rcpf(b1[j]); }
                    acc[ai][bj][m][0] = acc[ai][bj][m][0] * r0; acc[ai][bj][m][1] = acc[ai][bj][m][1] * r1; }
                asm volatile("" : "+v"(acc[ai][0][m][0]), "+v"(acc[ai][0][m][1]), "+v"(acc[ai][1][m][0]), "+v"(acc[ai][1][m][1]));
                if (m & 1) asm volatile("" ::: "memory"); }
    }
};
__device__ __forceinline__ f32x4 cvbf4(v2u w) { return (f32x4){bflo(w.x), bfhi(w.x), bflo(w.y), bfhi(w.y)}; }
struct EpiGateM {
    const bf16* GB_; bf16* MRG_;
    __device__ __forceinline__ void operator()(const f32x4 (&acc)[2][2][4][2], const Unit& u, int wr, int wc, int fr, int fq) const {
        const int row0 = u.pm * 256 + wr * 64 + fr; const int colb = u.pn * 256 + wc * 64 + 8 * fq;
#pragma unroll
        for (int ai = 0; ai < 2; ++ai) { v2u gr[4][2][2];
#pragma unroll
            for (int m = 0; m < 4; ++m)
#pragma unroll
                for (int bj = 0; bj < 2; ++bj) { const size_t o = (size_t)(row0 + ai * 128 + m * 16) * 2048 + colb + bj * 32; gr[m][bj][0] = *(const v2u*)(GB_ + o); gr[m][bj][1] = *(const v2u*)(GB_ + o + 4); }
#pragma unroll
            for (int m = 0; m < 4; ++m)
#pragma unroll
                for (int bj = 0; bj < 2; ++bj) { const size_t o = (size_t)(row0 + ai * 128 + m * 16) * 2048 + colb + bj * 32;
                    st_bf16x8(MRG_ + o, acc[ai][bj][m][0] * cvbf4(gr[m][bj][0]), acc[ai][bj][m][1] * cvbf4(gr[m][bj][1])); } }
    }
};
struct EpiGateA {
    float* T1; const bf16* GT;
    __device__ __forceinline__ void operator()(const f32x4 (&acc)[2][2][4][2], const Unit& u, int wr, int wc, int fr, int fq) const {
        const int row0 = u.pm * 256 + wr * 64 + fr; const int colb = u.pn * 256 + wc * 64 + 8 * fq;
        EPI_LOOP( const size_t o = (size_t)row * 2048 + col; const f32x4 g0 = ldbf4(GT + o), g1 = ldbf4(GT + o + 4); st_f32x8(T1 + o, v0 * g0, v1 * g1); )
    }
};
struct EpiGateB {
    const float* T1; const bf16* GT; bf16* MRG;
    __device__ __forceinline__ void operator()(const f32x4 (&acc)[2][2][4][2], const Unit& u, int wr, int wc, int fr, int fq) const {
        const int row0 = u.pm * 256 + wr * 64 + fr; const int colb = u.pn * 256 + wc * 64 + 8 * fq;
        EPI_LOOP( const size_t o = (size_t)row * 2048 + col; const f32x4 g0 = ldbf4(GT + o), g1 = ldbf4(GT + o + 4); const f32x4 t0 = *(const f32x4*)(T1 + o), t1 = *(const f32x4*)(T1 + o + 4);
                  st_bf16x8(MRG + o, t0 + v0 * g0, t1 + v1 * g1); )
    }
};
struct EpiRes {
    const float* X; const bf16* Xh; bf16* R; const float* gt;
    __device__ __forceinline__ void operator()(const f32x4 (&acc)[2][2][4][2], const Unit& u, int wr, int wc, int fr, int fq) const {
        const int row0 = u.pm * 256 + wr * 64 + fr; const int colb = u.pn * 256 + wc * 64 + 8 * fq; const float* g = gt + (size_t)(u.pm >> 4) * MODW;
        f32x4 gg[2][2];
#pragma unroll
        for (int bj = 0; bj < 2; ++bj) { gg[bj][0] = *(const f32x4*)(g + colb + bj * 32) + 1.f; gg[bj][1] = *(const f32x4*)(g + colb + bj * 32 + 4) + 1.f; }
        if (X) {
#pragma unroll
            for (int ai = 0; ai < 2; ++ai)
#pragma unroll
                for (int mh = 0; mh < 2; ++mh) { f32x4 xr[2][2][2];
#pragma unroll
                    for (int mm = 0; mm < 2; ++mm)
#pragma unroll
                        for (int bj = 0; bj < 2; ++bj) { const size_t o = (size_t)(row0 + ai * 128 + (2 * mh + mm) * 16) * 2048 + colb + bj * 32; xr[mm][bj][0] = *(const f32x4*)(X + o); xr[mm][bj][1] = *(const f32x4*)(X + o + 4); }
#pragma unroll
                    for (int mm = 0; mm < 2; ++mm)
#pragma unroll
                        for (int bj = 0; bj < 2; ++bj) { const int m = 2 * mh + mm; const size_t o = (size_t)(row0 + ai * 128 + m * 16) * 2048 + colb + bj * 32;
                            st_bf16x8(R + o, xr[mm][bj][0] * ALPHA + gg[bj][0] * acc[ai][bj][m][0], xr[mm][bj][1] * ALPHA + gg[bj][1] * acc[ai][bj][m][1]); } }
        } else {
#pragma unroll
            for (int ai = 0; ai < 2; ++ai) { v2u xr[4][2][2];
#pragma unroll
                for (int m = 0; m < 4; ++m)
#pragma unroll
                    for (int bj = 0; bj < 2; ++bj) { const size_t o = (size_t)(row0 + ai * 128 + m * 16) * 2048 + colb + bj * 32; xr[m][bj][0] = *(const v2u*)(Xh + o); xr[m][bj][1] = *(const v2u*)(Xh + o + 4); }
#pragma unroll
                for (int m = 0; m < 4; ++m)
#pragma unroll
                    for (int bj = 0; bj < 2; ++bj) { const size_t o = (size_t)(row0 + ai * 128 + m * 16) * 2048 + colb + bj * 32;
                        st_bf16x8(R + o, cvbf4(xr[m][bj][0]) * ALPHA + gg[bj][0] * acc[ai][bj][m][0], cvbf4(xr[m][bj][1]) * ALPHA + gg[bj][1] * acc[ai][bj][m][1]); } }
        }
    }
};
struct EpiSwiglu {
    bf16* ACT;
    __device__ __forceinline__ void operator()(const f32x4 (&acc)[2][2][4][2], const Unit& u, int wr, int wc, int fr, int fq) const {
        const int row0 = u.pm * 256 + wr * 64 + fr; const int col = u.pn * 128 + wc * 32 + 8 * fq;
#pragma unroll
        for (int ai = 0; ai < 2; ++ai)
#pragma unroll
            for (int m = 0; m < 4; ++m) { const int row = row0 + ai * 128 + m * 16;
                st_bf16x8(ACT + (size_t)row * DFF + col, silu4(acc[ai][0][m][0]) * acc[ai][1][m][0], silu4(acc[ai][0][m][1]) * acc[ai][1][m][1]); }
    }
};

__global__ void __launch_bounds__(NTHR, 2) fwd_kernel(Args args) {
    extern __shared__ __attribute__((aligned(16))) unsigned char lds_raw[];
    LAS unsigned char* lds = (LAS unsigned char*)lds_raw;
    const int G = gridDim.x, blk = blockIdx.x;
    const int NGW = G * NWAVES, NT = G * NTHR;
    unsigned char* const ws_base = args.ws;
    gu32* ctl = (gu32*)(ws_base + WS_CTL);
    for (int u = threadIdx.x; u < (LDS_BYTES - LDSCTL_OFF) / 4; u += NTHR) ((LAS unsigned*)(lds + LDSCTL_OFF))[u] = 0u;
    __syncthreads();
    volatile LAS unsigned* MISC = (volatile LAS unsigned*)(lds + MISC_OFF);
    const int wave_s = __builtin_amdgcn_readfirstlane((int)(threadIdx.x >> 6));
    XcdBarrier bar = xcd_barrier_post((unsigned*)(ctl + CW_BAR), MISC + 8); bar.wave = wave_s;
    if (threadIdx.x == 0) { unsigned nloc_ = 0u, nx_ = 0u; xcd_barrier_complete(bar.bar, bar.x, nloc_, nx_); bar.st[0] = nloc_; bar.st[1] = nx_; }
    __syncthreads();
#define GRID_BAR() xcd_barrier(bar)

#define x_in ((const float*)(const GAS float*)args.in[0 + z_])
#define c_in ((const float*)(const GAS float*)args.in[1 + z_])
#define w_ada ((const float*)(const GAS float*)args.in[2 + z_])
#define b_ada ((const float*)(const GAS float*)args.in[3 + z_])
#define w_in ((const float*)(const GAS float*)args.in[4 + z_])
#define lb_logits ((const float*)(const GAS float*)args.in[5 + z_])
#define g_hg ((const float*)(const GAS float*)args.in[6 + z_])
#define w_pa ((const float*)(const GAS float*)args.in[7 + z_])
#define g_cq ((const float*)(const GAS float*)args.in[8 + z_])
#define g_ckv ((const float*)(const GAS float*)args.in[9 + z_])
#define w_uq ((const float*)(const GAS float*)args.in[10 + z_])
#define w_iq ((const float*)(const GAS float*)args.in[11 + z_])
#define w_uv ((const float*)(const GAS float*)args.in[12 + z_])
#define w_pb ((const float*)(const GAS float*)args.in[13 + z_])
#define w_out ((const float*)(const GAS float*)args.in[14 + z_])
#define ln1_g ((const float*)(const GAS float*)args.in[15 + z_])
#define ln1_b ((const float*)(const GAS float*)args.in[16 + z_])
#define w_gate ((const float*)(const GAS float*)args.in[17 + z_])
#define w_up ((const float*)(const GAS float*)args.in[18 + z_])
#define w_down ((const float*)(const GAS float*)args.in[19 + z_])
#define ln2_g ((const float*)(const GAS float*)args.in[20 + z_])
#define ln2_b ((const float*)(const GAS float*)args.in[21 + z_])
#define MOD  ((float*)(ws + WS_MOD))
#define LB   ((float*)(ws + WS_LB))
#define MODP ((float*)(ws + WS_MODP))
#define W1   ((bf16*)(ws + WS_W1))
#define W3   ((bf16*)(ws + WS_W3))
#define W6   ((bf16*)(ws + WS_W6))
#define W7   ((bf16*)(ws + WS_W7))
#define W8   ((bf16*)(ws + WS_W8))
#define W10  ((bf16*)(ws + WS_W10))
#define W11  ((bf16*)(ws + WS_W11))
#define XB   ((bf16*)(ws + WS_X))
#define RB   ((bf16*)(ws + WS_R))
#define HB   ((bf16*)(ws + WS_H))
#define QA   ((bf16*)(ws + WS_QA))
#define FA   ((bf16*)(ws + WS_FA))
#define IA   ((bf16*)(ws + WS_IA))
#define GA   ((bf16*)(ws + WS_GA))
#define LAT  ((bf16*)(ws + WS_LAT))
#define GTA  ((bf16*)(ws + WS_GTA))
#define GTB  ((bf16*)(ws + WS_GTB))
#define CQN  ((bf16*)(ws + WS_CQN))
#define CKV  ((bf16*)(ws + WS_CKV))
#define KIDX ((bf16*)(ws + WS_KIDX))
#define IDXW ((float*)(ws + WS_IDXW))
#define QB   ((bf16*)(ws + WS_QB))
#define QIDX ((bf16*)(ws + WS_QIDX))
#define SEL  ((unsigned short*)(ws + WS_SEL))
#define YAB  ((bf16*)(ws + WS_YAB))
#define MRG  ((bf16*)(ws + WS_MRG))
#define OB   ((bf16*)(ws + WS_OB))
#define ISC  ((_Float16*)(ws + WS_BIG))
#define OP   ((float*)(ws + WS_BIG))
#define ACT  ((bf16*)(ws + WS_BIG))
#define KK   LAT
#define modl (MOD + (size_t)l * NBATCH * MODW)
#define KSB  ((bf16*)(ws + WS_KSB))
#define QSB  ((bf16*)(ws + WS_QSB))
#define KVT  ((bf16*)(ws + WS_BIG))
#define SPB  ((bf16*)(ws + WS_FA))
#define DEB  ((float*)(ws + WS_DEB))
#define PHASE_BEGIN { unsigned om_ = ~0u; asm volatile("" : "+s"(om_)); int tid = wave_s * 64 + (int)__builtin_amdgcn_mbcnt_hi(om_, __builtin_amdgcn_mbcnt_lo(om_, 0u)); asm volatile("" : "+v"(tid)); int z_ = 0; asm volatile("" : "+s"(z_)); (void)z_; GAS unsigned char* wsg_ = (GAS unsigned char*)ws_base; asm volatile("" : "+s"(wsg_)); unsigned char* ws = (unsigned char*)wsg_; const int lane = tid & 63, wave = __builtin_amdgcn_readfirstlane(tid >> 6); \
        const int gw = blk * NWAVES + wave, gtid = blk * NTHR + tid; LAS float* wscr = (LAS float*)(lds + wave * 16384); (void)lane; (void)gw; (void)gtid; (void)wscr;
#define PHASE_END }

#define CVT_DECODE(IT_, MID_, K0_, N0_) do { int r_ = (IT_); \
        if (r_ < I1) { MID_ = 0; K0_ = (r_ / (N1 / 32)) * 64; N0_ = (r_ % (N1 / 32)) * 32; } else { r_ -= I1; \
        if (r_ < I3) { MID_ = 1; K0_ = (r_ / (N3 / 32)) * 64; N0_ = (r_ % (N3 / 32)) * 32; } else { r_ -= I3; \
        if (r_ < I6) { MID_ = 2; K0_ = (r_ / 32) * 64; N0_ = (r_ % 32) * 32; } else { r_ -= I6; \
        if (r_ < I7) { MID_ = 3; K0_ = (r_ / (DM / 32)) * 64; N0_ = (r_ % (DM / 32)) * 32; } else { r_ -= I7; \
        if (r_ < I8) { MID_ = 4; K0_ = (r_ / (DM / 32)) * 64; N0_ = (r_ % (DM / 32)) * 32; } else { r_ -= I8; \
        if (r_ < I10) { MID_ = 5; K0_ = (r_ / (N10 / 32)) * 64; N0_ = (r_ % (N10 / 32)) * 32; } else { r_ -= I10; \
        MID_ = 6; K0_ = (r_ / (DM / 32)) * 64; N0_ = (r_ % (DM / 32)) * 32; } } } } } } } while (0)
#define CVT_LOAD(MID_, K0_, N0_, TV_) do { \
        if (MID_ == 0) cvt_load([=](int k, int n) -> float { return n < 4944 ? s_in[(size_t)k * 9040 + n] : (n < 5120 ? 0.f : s_in[(size_t)k * 9040 + n - 176]); }, K0_, N0_, lane, TV_); \
        else if (MID_ == 1) cvt_load([=](int k, int n) -> float { return n < 4096 ? s_uq[(size_t)k * 4096 + n] * 0.0625f : s_iq[(size_t)k * 1024 + n - 4096]; }, K0_, N0_, lane, TV_); \
        else if (MID_ == 2) cvt_load([=](int k, int n) -> float { const int h = n >> 6, v = n & 63, kk = k >> 8, c = k & 255; return kk == (h & 3) ? s_uv[((size_t)h * 256 + c) * 64 + v] : 0.f; }, K0_, N0_, lane, TV_); \
        else if (MID_ == 3) cvt_load([=](int k, int n) -> float { return k < 1024 ? s_pa[(size_t)k * DM + n] : s_pb[(size_t)(k - 1024) * DM + n]; }, K0_, N0_, lane, TV_); \
        else if (MID_ == 4) cvt_load([=](int k, int n) -> float { return s_out[(size_t)k * DM + n]; }, K0_, N0_, lane, TV_); \
        else if (MID_ == 5) cvt_load([=](int k, int n) -> float { const int pn = n >> 8, rr = n & 255, cc = pn * 128 + (rr >> 6) * 32 + (rr & 31); return (rr & 32) ? s_u[(size_t)k * DFF + cc] : s_g[(size_t)k * DFF + cc]; }, K0_, N0_, lane, TV_); \
        else cvt_load([=](int k, int n) -> float { return s_d[(size_t)k * DM + n]; }, K0_, N0_, lane, TV_); } while (0)
#define CONVERT_LAYER(L) do { const int l_ = (L); \
        const float* s_in = w_in + (size_t)l_ * DM * 9040; const float* s_uq = w_uq + (size_t)l_ * SAR * 4096; const float* s_iq = w_iq + (size_t)l_ * SAR * 1024; \
        const float* s_uv = w_uv + (size_t)l_ * 16 * 256 * 64; const float* s_pa = w_pa + (size_t)l_ * 1024 * DM; const float* s_pb = w_pb + (size_t)l_ * 1024 * DM; \
        const float* s_out = w_out + (size_t)l_ * DM * DM; const float* s_g = w_gate + (size_t)l_ * DM * DFF; const float* s_u = w_up + (size_t)l_ * DM * DFF; const float* s_d = w_down + (size_t)l_ * DFF * DM; \
        constexpr int I1 = (DM / 64) * (N1 / 32), I3 = (SAR / 64) * (N3 / 32), I6 = (1024 / 64) * (1024 / 32), I7 = (DM / 64) * (DM / 32), I8 = I7, I10 = (DM / 64) * (N10 / 32), I11 = (DFF / 64) * (DM / 32); \
        constexpr int NIT = I1 + I3 + I6 + I7 + I8 + I10 + I11; \
        float tv_[32]; int mid_ = 0, k0_ = 0, n0_ = 0; \
        { CVT_DECODE(gw, mid_, k0_, n0_); CVT_LOAD(mid_, k0_, n0_, tv_); } \
        for (int it = gw; it < NIT; it += NGW) { \
            float tc_[32]; _Pragma("unroll") for (int i = 0; i < 32; ++i) tc_[i] = tv_[i]; \
            const int mc_ = mid_, kc_ = k0_, nc_ = n0_; \
            { const int itn_ = it + NGW < NIT ? it + NGW : it; CVT_DECODE(itn_, mid_, k0_, n0_); CVT_LOAD(mid_, k0_, n0_, tv_); }     \
            bf16* wt_ = mc_ == 0 ? W1 : mc_ == 1 ? W3 : mc_ == 2 ? W6 : mc_ == 3 ? W7 : mc_ == 4 ? W8 : mc_ == 5 ? W10 : W11; \
            const int kk_ = mc_ == 0 ? DM : mc_ == 1 ? SAR : mc_ == 2 ? 1024 : mc_ == 3 ? DM : mc_ == 4 ? DM : mc_ == 5 ? DM : DFF; \
            cvt_store(tc_, wt_, kk_, kc_, nc_, wscr, lane); \
        } } while (0)


#ifndef HGRN_NAIVE
#define HGRN_NAIVE 0
#endif
#ifndef IDX_NAIVE
#define IDX_NAIVE 0
#endif
#ifndef ATT_NAIVE
#define ATT_NAIVE 0
#endif
#ifndef TOPK_OLD
#define TOPK_OLD 0
#endif
#ifndef REP_HB
#define REP_HB 1
#endif
#ifndef REP_HC
#define REP_HC 1
#endif
#ifndef REP_P4A
#define REP_P4A 1
#endif
#ifndef REP_P5
#define REP_P5 1
#endif
#ifndef REP_P9
#define REP_P9 1
#endif
#ifndef REP_P12
#define REP_P12 1
#endif
#ifndef REP_TOPK
#define REP_TOPK 1
#endif
#ifndef REP_ATT
#define REP_ATT 1
#endif
#ifndef DRY_ATT
#define DRY_ATT 0
#endif
#ifndef REP_M1
#define REP_M1 1
#endif
#ifndef REP_M2
#define REP_M2 1
#endif
#ifndef REP_M3
#define REP_M3 1
#endif

    PHASE_BEGIN
    {
        LAS float* sc = (LAS float*)lds;
        for (int i = tid; i < NBATCH * DM; i += NTHR) { const float v = c_in[i]; sc[i] = v * sigm(v); }
        __syncthreads();
        for (int item = gtid; item < 8 * 12288; item += NT) {
            const int ks = item / 12288, cg = item % 12288, l = cg / 3072, n4 = (cg % 3072) * 4;
            const float* wp = w_ada + ((size_t)l * DM + ks * 256) * MODW + n4;
            f32x4 a0 = {0.f, 0.f, 0.f, 0.f}, a1 = a0, a2 = a0, a3 = a0;
#pragma unroll 8
            for (int k = 0; k < 256; ++k) { const f32x4 w = *(const f32x4*)(wp + (size_t)k * MODW); const int kk = ks * 256 + k;
                a0 += w * sc[kk]; a1 += w * sc[2048 + kk]; a2 += w * sc[4096 + kk]; a3 += w * sc[6144 + kk]; }
            float* o = MODP + ((size_t)(ks * 4 + l) * 4) * MODW + n4;
            *(f32x4*)(o) = a0; *(f32x4*)(o + MODW) = a1; *(f32x4*)(o + 2 * MODW) = a2; *(f32x4*)(o + 3 * MODW) = a3;
        }
        if (gtid < 1024) {
            const float a = lb_logits[gtid], b = lb_logits[1024 + gtid], c = lb_logits[2048 + gtid], d = lb_logits[3072 + gtid];
            const float mx = fmaxf(fmaxf(a, b), fmaxf(c, d)); const float ea = expf(a - mx), eb = expf(b - mx), ec = expf(c - mx), ed = expf(d - mx); const float inv = 1.f / (ea + eb + ec + ed);
            LB[gtid] = 0.f; LB[1024 + gtid] = eb * inv; LB[2048 + gtid] = (eb + ec) * inv; LB[3072 + gtid] = (eb + ec + ed) * inv;
        }
        __syncthreads();
        CONVERT_LAYER(0);
    }
    PHASE_END
    GRID_BAR();
    PHASE_BEGIN
    for (int i = gtid; i < DEPTH * NBATCH * MODW; i += NT) {
        const int l = i / (NBATCH * MODW), r = i % (NBATCH * MODW), b = r / MODW, n = r % MODW;
        float s = b_ada[l * MODW + n];
#pragma unroll
        for (int ks = 0; ks < 8; ++ks) s += MODP[((size_t)(ks * 4 + l) * 4 + b) * MODW + n];
        MOD[i] = s;
    }
    PHASE_END
    GRID_BAR();
    PHASE_BEGIN
    for (size_t i0 = gtid; i0 < (size_t)M * DM / 8; i0 += (size_t)NT * 4) {
        f32x4 xa[4], xb[4], sa[4], sb[4], ha[4], hb[4];
#pragma unroll
        for (int t = 0; t < 4; ++t) { size_t gi = i0 + (size_t)t * NT; gi = gi < (size_t)M * DM / 8 ? gi : (size_t)M * DM / 8 - 1; const size_t e = gi * 8; const int row = (int)(e / DM), col = (int)(e % DM), b = row / SEQ; const float* md = MOD + (size_t)b * MODW;
            xa[t] = *(const f32x4*)(x_in + e); xb[t] = *(const f32x4*)(x_in + e + 4); sa[t] = *(const f32x4*)(md + 2048 + col); sb[t] = *(const f32x4*)(md + 2048 + col + 4); ha[t] = *(const f32x4*)(md + col); hb[t] = *(const f32x4*)(md + col + 4); }
#pragma unroll
        for (int t = 0; t < 4; ++t) { size_t gi = i0 + (size_t)t * NT; gi = gi < (size_t)M * DM / 8 ? gi : (size_t)M * DM / 8 - 1; const size_t e = gi * 8; st_bf16x8(HB + e, xa[t] * (sa[t] + 1.f) + ha[t], xb[t] * (sb[t] + 1.f) + hb[t]); }
    }
    PHASE_END
    GRID_BAR();

    for (int l = 0; l < DEPTH; ++l) {
        PHASE_BEGIN
        { pg8::Gemm g{HB, W1, M, N1, DM, DM, DM, 0}; pg8::StaticOrder S; S.init(M, N1, G, blk);
          EpiProj E{QA, FA, IA, GA, LAT, GTA, GTB}; pg8::gemm_phase(lds, g, S, E, tid); }
        PHASE_END
        GRID_BAR();
        for (int rep_ = 0; rep_ < REP_M1; ++rep_) {
        PHASE_BEGIN
        v2u ra0, ra1, rkv; unsigned short rki, riw;
        const f32x4 g0 = *(const f32x4*)(g_cq + l * 512 + 4 * lane), g1 = *(const f32x4*)(g_cq + l * 512 + 256 + 4 * lane), gk = *(const f32x4*)(g_ckv + l * 256 + 4 * lane);
        { const bf16* lr = LAT + (size_t)gw * 1024; ra0 = *(const v2u*)(lr + 4 * lane); ra1 = *(const v2u*)(lr + 256 + 4 * lane); rkv = *(const v2u*)(lr + 512 + 4 * lane); rki = lr[768 + lane]; riw = lr[832 + (lane & 15)]; }
        for (int row = gw; row < M; row += NGW) {
            const f32x4 a0 = (f32x4){bflo(ra0.x), bfhi(ra0.x), bflo(ra0.y), bfhi(ra0.y)}, a1 = (f32x4){bflo(ra1.x), bfhi(ra1.x), bflo(ra1.y), bfhi(ra1.y)}, kv = (f32x4){bflo(rkv.x), bfhi(rkv.x), bflo(rkv.y), bfhi(rkv.y)};
            const float ki = bf2f(rki), iw = bf2f(riw);
            { const int rn = row + NGW < M ? row + NGW : row; const bf16* lr = LAT + (size_t)rn * 1024;
              ra0 = *(const v2u*)(lr + 4 * lane); ra1 = *(const v2u*)(lr + 256 + 4 * lane); rkv = *(const v2u*)(lr + 512 + 4 * lane); rki = lr[768 + lane]; riw = lr[832 + (lane & 15)]; }
            float sq = a0[0] * a0[0] + a0[1] * a0[1] + a0[2] * a0[2] + a0[3] * a0[3] + a1[0] * a1[0] + a1[1] * a1[1] + a1[2] * a1[2] + a1[3] * a1[3];
            float sk = kv[0] * kv[0] + kv[1] * kv[1] + kv[2] * kv[2] + kv[3] * kv[3];
            sq = wave_sum(sq); sk = wave_sum(sk);
            const float rq = 1.0f / sqrtf(sq * (1.f / 512.f) + 1e-6f), rk = 1.0f / sqrtf(sk * (1.f / 256.f) + 1e-6f);
            v2u o; f32x4 t = a0 * rq * g0; o.x = pk2(t[0], t[1]); o.y = pk2(t[2], t[3]); *(v2u*)(CQN + (size_t)row * 512 + 4 * lane) = o;
            t = a1 * rq * g1; o.x = pk2(t[0], t[1]); o.y = pk2(t[2], t[3]); *(v2u*)(CQN + (size_t)row * 512 + 256 + 4 * lane) = o;
            t = kv * rk * gk; o.x = pk2(t[0], t[1]); o.y = pk2(t[2], t[3]); *(v2u*)(CKV + (size_t)row * 256 + 4 * lane) = o;
            KIDX[(size_t)row * 64 + lane] = (bf16)f2bf(ki);
            if (lane < 16) IDXW[(size_t)row * 16 + lane] = iw * 0.03125f;
        }
        PHASE_END
        PHASE_BEGIN
        {
            const int cp = tid & 63, sg = tid >> 6;
            LAS unsigned char* KST = lds;
            LAS unsigned char* VTL = lds + 18432;
            LAS float* SEGT = (LAS float*)(lds + 36864);
            LAS float* G63 = (LAS float*)(lds + 40960);
            unsigned pfa[8], pq[8], pv[8]; float plb0, plb1;
#define HA_REQ(U_) do { int uu_ = (U_); asm volatile("" : "+s"(uu_)); const int bh_ = uu_ >> 6, c_ = uu_ & 63, b_ = bh_ >> 3, h_ = bh_ & 7; \
                const size_t rowb_ = (size_t)b_ * SEQ + c_ * 64 + sg * 8; const int col_ = h_ * 128 + 2 * cp; \
                _Pragma("unroll") for (int i = 0; i < 8; ++i) { pfa[i] = *(const unsigned*)(FA + (rowb_ + i) * 1024 + col_); pq[i] = *(const unsigned*)(QA + (rowb_ + i) * 1024 + col_); pv[i] = *(const unsigned*)(IA + (rowb_ + i) * 1024 + col_); } plb0 = LB[l * 1024 + col_]; plb1 = LB[l * 1024 + col_ + 1]; } while (0)
            HA_REQ(blk);
            for (int u = blk; u < 2048; u += G) {
                const int bh = u >> 6, c = u & 63, b = bh >> 3, h = bh & 7;
                const size_t rowb = (size_t)b * SEQ + c * 64 + sg * 8; const int col = h * 128 + 2 * cp;
                const float lb0 = plb0, lb1 = plb1;
                float lf0[8], lf1[8], kk0[8], kk1[8]; unsigned cq[8], cv[8];
#pragma unroll
                for (int i = 0; i < 8; ++i) { cq[i] = pq[i]; cv[i] = pv[i]; }
#pragma unroll
                for (int i = 0; i < 8; ++i) { const float2 fa = make_float2(bflo(pfa[i]), bfhi(pfa[i]));
                    const float f0 = fminf(fmaxf(lb0 + (1.f - lb0) * sigm(fa.x), 1e-6f), 1.f), f1 = fminf(fmaxf(lb1 + (1.f - lb1) * sigm(fa.y), 1e-6f), 1.f);
                    lf0[i] = __logf(f0); lf1[i] = __logf(f1); kk0[i] = (1.f - lb0) * sigm(-fa.x); kk1[i] = (1.f - lb1) * sigm(-fa.y); }
#pragma unroll
                for (int i = 1; i < 8; ++i) { lf0[i] += lf0[i - 1]; lf1[i] += lf1[i - 1]; }
                SEGT[sg * 128 + 2 * cp] = lf0[7]; SEGT[sg * 128 + 2 * cp + 1] = lf1[7];
                HA_REQ(u + G < 2048 ? u + G : u);
                __syncthreads();
                float pre0 = 0.f, pre1 = 0.f, r0 = 0.f, r1 = 0.f, t0 = 0.f, t1 = 0.f;
#pragma unroll
                for (int s2 = 0; s2 < 8; ++s2) { const float a0 = SEGT[s2 * 128 + 2 * cp], a1 = SEGT[s2 * 128 + 2 * cp + 1];
                    if (s2 < sg) { pre0 += a0; pre1 += a1; } if (s2 < 4) { r0 += a0; r1 += a1; } t0 += a0; t1 += a1; }
                unsigned ksw0[4], ksw1[4], vw0[4], vw1[4]; float ks0p = 0.f, ks1p = 0.f, v0p = 0.f, v1p = 0.f;
#pragma unroll
                for (int i = 0; i < 8; ++i) {
                    const float b0 = pre0 + lf0[i], b1 = pre1 + lf1[i];
                    const unsigned qw = cq[i]; const unsigned vw = cv[i];
                    const float qs0 = bflo(qw) * __expf(b0 - r0), qs1 = bfhi(qw) * __expf(b1 - r1);
                    const float ks0 = kk0[i] * __expf(r0 - b0), ks1 = kk1[i] * __expf(r1 - b1);
                    *(unsigned*)(QSB + (rowb + i) * 1024 + col) = pk2(qs0, qs1);
                    *(unsigned*)(KSB + (rowb + i) * 1024 + col) = pk2(ks0, ks1);
                    if (i & 1) { ksw0[i >> 1] = pk2(ks0p, ks0); ksw1[i >> 1] = pk2(ks1p, ks1); vw0[i >> 1] = pk2(v0p, bflo(vw)); vw1[i >> 1] = pk2(v1p, bfhi(vw)); }
                    else { ks0p = ks0; ks1p = ks1; v0p = bflo(vw); v1p = bfhi(vw); }
                }
                *(LAS v4u*)(KST + (2 * cp) * 144 + sg * 16) = (v4u){ksw0[0], ksw0[1], ksw0[2], ksw0[3]};
                *(LAS v4u*)(KST + (2 * cp + 1) * 144 + sg * 16) = (v4u){ksw1[0], ksw1[1], ksw1[2], ksw1[3]};
                *(LAS v4u*)(VTL + (2 * cp) * 144 + sg * 16) = (v4u){vw0[0], vw0[1], vw0[2], vw0[3]};
                *(LAS v4u*)(VTL + (2 * cp + 1) * 144 + sg * 16) = (v4u){vw1[0], vw1[1], vw1[2], vw1[3]};
                if (sg == 7) { float* de = DEB + (size_t)u * 256; *(float2*)(de + 2 * cp) = make_float2(__expf(r0), __expf(r1)); *(float2*)(de + 128 + 2 * cp) = make_float2(__expf(t0), __expf(t1));
                    G63[2 * cp] = __expf(t0 - r0); G63[2 * cp + 1] = __expf(t1 - r1); }
                __syncthreads();
                { const int kt = wave >> 1, vt0 = (wave & 1) * 2, lr = lane & 31, lh = lane >> 5;
                  f32x16 acc0, acc1;
#pragma unroll
                  for (int r = 0; r < 16; ++r) { acc0[r] = 0.f; acc1[r] = 0.f; }
#pragma unroll
                  for (int s4 = 0; s4 < 4; ++s4) {
                      const bf16x8 kb = *(const LAS bf16x8*)(KST + (kt * 32 + lr) * 144 + (s4 * 16 + 8 * lh) * 2);
                      const bf16x8 a0 = *(const LAS bf16x8*)(VTL + (vt0 * 32 + lr) * 144 + (s4 * 16 + 8 * lh) * 2);
                      const bf16x8 a1 = *(const LAS bf16x8*)(VTL + ((vt0 + 1) * 32 + lr) * 144 + (s4 * 16 + 8 * lh) * 2);
                      acc0 = __builtin_amdgcn_mfma_f32_32x32x16_bf16(a0, kb, acc0, 0, 0, 0); acc1 = __builtin_amdgcn_mfma_f32_32x32x16_bf16(a1, kb, acc1, 0, 0, 0); }
                  bf16* kvt = KVT + (size_t)u * 16384 + kt * 32 + lr; const float g = G63[kt * 32 + lr];
#pragma unroll
                  for (int r = 0; r < 16; ++r) { const int vv = 8 * (r >> 2) + 4 * lh + (r & 3);
                      kvt[(size_t)(vt0 * 32 + vv) * 128] = (bf16)(pk2(acc0[r] * g, 0.f) & 0xffffu); kvt[(size_t)((vt0 + 1) * 32 + vv) * 128] = (bf16)(pk2(acc1[r] * g, 0.f) & 0xffffu); } }
                __syncthreads();
            }
        }
#undef HA_REQ
        PHASE_END
        GRID_BAR();
        }
        for (int rep_ = 0; rep_ < REP_M2; ++rep_) {
        PHASE_BEGIN
        for (int item = gtid; item < 32 * 4096; item += NT) {
            const int bh = item >> 12, v = (item >> 5) & 127, k4 = (item & 31) * 4;
            f32x4 S = {0.f, 0.f, 0.f, 0.f};
            for (int c0 = 0; c0 < 64; c0 += 8) {
                f32x4 kv[8], dd[8], ee[8];
#pragma unroll
                for (int j = 0; j < 8; ++j) { const size_t u = (size_t)bh * 64 + c0 + j; kv[j] = ldbf4(KVT + u * 16384 + v * 128 + k4); ee[j] = *(const f32x4*)(DEB + u * 256 + k4); dd[j] = *(const f32x4*)(DEB + u * 256 + 128 + k4); }
#pragma unroll
                for (int j = 0; j < 8; ++j) { const size_t u = (size_t)bh * 64 + c0 + j; const f32x4 sp = S * ee[j]; v2u w; w.x = pk2(sp[0], sp[1]); w.y = pk2(sp[2], sp[3]);
                    *(v2u*)(SPB + u * 16384 + v * 128 + k4) = w; S = S * dd[j] + kv[j]; }
            }
        }
        PHASE_END
        PHASE_BEGIN
        { pg8::Gemm g{CQN, W3, M, N3, SAR, SAR, SAR, 0}; pg8::StaticOrder S; S.init(M, N3, G, blk);
          EpiQ E{QB, QIDX}; pg8::gemm_phase(lds, g, S, E, tid); }
        PHASE_END
        GRID_BAR();
        }
        for (int rep_ = 0; rep_ < REP_M3; ++rep_) {
        PHASE_BEGIN
        {
            LAS unsigned char* QSL = lds;
            LAS unsigned char* KSL = lds + 17408;
            LAS unsigned char* VTL = lds + 34816;
            LAS unsigned char* SPL = lds + 53248;
            LAS unsigned char* AL = lds + 88064;
            LAS float* SSQ = (LAS float*)(lds + 97280);
            const int cp = tid & 63, sg = tid >> 6, lr = lane & 31, lh = lane >> 5;
            v4u rq[2], rk[2], rs[4]; unsigned rv[8]; unsigned short rg[16];
#define HC_REQ(U_) do { int uu_ = (U_); asm volatile("" : "+s"(uu_));   const int bh_ = uu_ >> 6, c_ = uu_ & 63, b_ = bh_ >> 3, h_ = bh_ & 7; const size_t row0_ = (size_t)b_ * SEQ + c_ * 64; const int col0_ = h_ * 128; \
                _Pragma("unroll") for (int j = 0; j < 2; ++j) { const int q = tid + 512 * j, rr = q >> 4, cc = q & 15; \
                    rq[j] = *(const v4u*)(QSB + (row0_ + rr) * 1024 + col0_ + cc * 8); rk[j] = *(const v4u*)(KSB + (row0_ + rr) * 1024 + col0_ + cc * 8); } \
                _Pragma("unroll") for (int j = 0; j < 4; ++j) { const int q = tid + 512 * j, rr = q >> 4, cc = q & 15; rs[j] = *(const v4u*)(SPB + (size_t)uu_ * 16384 + rr * 128 + cc * 8); } \
                _Pragma("unroll") for (int i = 0; i < 8; ++i) rv[i] = *(const unsigned*)(IA + (row0_ + sg * 8 + i) * 1024 + col0_ + 2 * cp); \
                { const int it_ = wave >> 2, vt_ = wave & 3; const int colg_ = col0_ + vt_ * 32 + lr; \
                  _Pragma("unroll") for (int r = 0; r < 16; ++r) { const int ii = it_ * 32 + 8 * (r >> 2) + 4 * lh + (r & 3); rg[r] = GA[(row0_ + ii) * 1024 + colg_]; } } } while (0)
            HC_REQ(blk);
            for (int u = blk; u < 2048; u += G) {
                const int bh = u >> 6, c = u & 63, b = bh >> 3, h = bh & 7;
                const size_t row0 = (size_t)b * SEQ + c * 64; const int col0 = h * 128;
#pragma unroll
                for (int j = 0; j < 2; ++j) { const int q = tid + 512 * j, rr = q >> 4, cc = q & 15;
                    *(LAS v4u*)(QSL + rr * 272 + cc * 16) = rq[j]; *(LAS v4u*)(KSL + rr * 272 + cc * 16) = rk[j]; }
#pragma unroll
                for (int j = 0; j < 4; ++j) { const int q = tid + 512 * j, rr = q >> 4, cc = q & 15; *(LAS v4u*)(SPL + rr * 272 + cc * 16) = rs[j]; }
                { unsigned vw0[4], vw1[4]; float v0p = 0.f, v1p = 0.f;
#pragma unroll
                  for (int i = 0; i < 8; ++i) { const unsigned vw = rv[i];
                      if (i & 1) { vw0[i >> 1] = pk2(v0p, bflo(vw)); vw1[i >> 1] = pk2(v1p, bfhi(vw)); } else { v0p = bflo(vw); v1p = bfhi(vw); } }
                  *(LAS v4u*)(VTL + (2 * cp) * 144 + sg * 16) = (v4u){vw0[0], vw0[1], vw0[2], vw0[3]};
                  *(LAS v4u*)(VTL + (2 * cp + 1) * 144 + sg * 16) = (v4u){vw1[0], vw1[1], vw1[2], vw1[3]}; }
                float gav[16];
#pragma unroll
                for (int r = 0; r < 16; ++r) gav[r] = bf2f(rg[r]);
                const float gg = g_hg[l * 1024 + col0 + (wave & 3) * 32 + lr];
                HC_REQ(u + G < 2048 ? u + G : u);
                __syncthreads();
                if (wave < 4) {
                    const int it = wave >> 1, jt = wave & 1;
                    f32x16 acc;
#pragma unroll
                    for (int r = 0; r < 16; ++r) acc[r] = 0.f;
                    if (!(it == 0 && jt == 1)) {
#pragma unroll
                        for (int s8 = 0; s8 < 8; ++s8) {
                            const bf16x8 a = *(const LAS bf16x8*)(QSL + (it * 32 + lr) * 272 + (s8 * 16 + 8 * lh) * 2);
                            const bf16x8 bb = *(const LAS bf16x8*)(KSL + (jt * 32 + lr) * 272 + (s8 * 16 + 8 * lh) * 2);
                            acc = __builtin_amdgcn_mfma_f32_32x32x16_bf16(a, bb, acc, 0, 0, 0); } }
                    const int jj = jt * 32 + lr;
#pragma unroll
                    for (int r = 0; r < 16; ++r) { const int ii = it * 32 + 8 * (r >> 2) + 4 * lh + (r & 3); const float x = (jj <= ii) ? acc[r] : 0.f;
                        *(LAS unsigned short*)(AL + ii * 144 + jj * 2) = (unsigned short)(pk2(x, 0.f) & 0xffffu); }
                }
                __syncthreads();
                { const int it = wave >> 2, vt = wave & 3;
                  f32x16 acc;
#pragma unroll
                  for (int r = 0; r < 16; ++r) acc[r] = 0.f;
#pragma unroll
                  for (int s4 = 0; s4 < 4; ++s4) {
                      const bf16x8 a = *(const LAS bf16x8*)(AL + (it * 32 + lr) * 144 + (s4 * 16 + 8 * lh) * 2);
                      const bf16x8 bb = *(const LAS bf16x8*)(VTL + (vt * 32 + lr) * 144 + (s4 * 16 + 8 * lh) * 2);
                      acc = __builtin_amdgcn_mfma_f32_32x32x16_bf16(a, bb, acc, 0, 0, 0); }
#pragma unroll
                  for (int s8 = 0; s8 < 8; ++s8) {
                      const bf16x8 a = *(const LAS bf16x8*)(QSL + (it * 32 + lr) * 272 + (s8 * 16 + 8 * lh) * 2);
                      const bf16x8 bb = *(const LAS bf16x8*)(SPL + (vt * 32 + lr) * 272 + (s8 * 16 + 8 * lh) * 2);
                      acc = __builtin_amdgcn_mfma_f32_32x32x16_bf16(a, bb, acc, 0, 0, 0); }
#pragma unroll
                  for (int r = 0; r < 16; ++r) { float q2 = acc[r] * acc[r];
                      q2 = xsum16(rowsum16(q2));
                      if (lr == 0) SSQ[vt * 64 + it * 32 + 8 * (r >> 2) + 4 * lh + (r & 3)] = q2; }
                  __syncthreads();
                  const int colg = col0 + vt * 32 + lr;
#pragma unroll
                  for (int r = 0; r < 16; ++r) { const int ii = it * 32 + 8 * (r >> 2) + 4 * lh + (r & 3);
                      const float ss = SSQ[ii] + SSQ[64 + ii] + SSQ[128 + ii] + SSQ[192 + ii]; const float rn = 1.0f / sqrtf(ss * (1.f / 128.f) + 1e-6f);
                      YAB[(row0 + ii) * 2048 + colg] = (bf16)(pk2(acc[r] * rn * gg * gav[r], 0.f) & 0xffffu); }
                }
                __syncthreads();
            }
        }
#undef HC_REQ
        PHASE_END
        PHASE_BEGIN
        for (int ub = blk * NWAVES; ub < 2048; ub += NGW) {
            const int unit = ub + wave;
            const int b = ub >> 9, j = unit & 511, lr = lane & 31, lh = lane >> 5;
            const int qsel = (lr >> 2) & 1, head = (lr >> 3) * 4 + (lr & 3);
            const int qlo = 4 * j, qhi = 4 * (1023 - j);
            const int nlo = ((qlo >> 6) + 1) * 64, nhi = ((qhi >> 6) + 1) * 64;
            const int nlo8 = (nlo + 511) & ~511, nhi8 = (nhi + 511) & ~511;
            const int nmax8 = (((((4 * (1023 - (ub & 511))) >> 6) + 1) * 64) + 511) & ~511;
            bf16x8 A[4][4]; float W[4][16]; typedef float f32x2_t __attribute__((ext_vector_type(2)));
#pragma unroll
            for (int p = 0; p < 4; ++p) { const size_t qb = (size_t)b * SEQ + (p < 2 ? qlo + 2 * p : qhi + 2 * (p - 2));
#pragma unroll
                for (int ks = 0; ks < 4; ++ks) A[p][ks] = *(const bf16x8*)(QIDX + (qb + qsel) * 1024 + head * 64 + ks * 16 + lh * 8);
#pragma unroll
                for (int r4 = 0; r4 < 4; ++r4) { const f32x4 w = *(const f32x4*)(IDXW + (qb + lh) * 16 + r4 * 4); W[p][r4 * 4] = w[0]; W[p][r4 * 4 + 1] = w[1]; W[p][r4 * 4 + 2] = w[2]; W[p][r4 * 4 + 3] = w[3]; } }
            const bf16* kb = KIDX + (size_t)b * SEQ * 64;
            const int srow = 8 * wave + (lane >> 3), spc = ((lane & 7) ^ ((srow >> 1) & 7)) * 8;
#define P4_STAGE(C0_, BUF_) do { _Pragma("unroll") for (int i = 0; i < 4; ++i) \
                __builtin_amdgcn_global_load_lds((const unsigned*)(kb + (size_t)((C0_) + 64 * i + srow) * 64 + spc), (LAS unsigned*)(lds + (BUF_) * 32768 + (i * 8 + wave) * 1024), 16, 0, 0); } while (0)
            P4_STAGE(0, 0);
            asm volatile("s_waitcnt vmcnt(0)" ::: "memory");
            __syncthreads();
            for (int c0 = 0; c0 < nmax8; c0 += 256) {
                const int cb = (c0 >> 8) & 1; const bool more = c0 + 256 < nmax8;
                if (more) P4_STAGE(c0 + 256, cb ^ 1);
                LAS unsigned char* kbuf = lds + cb * 32768;
#pragma unroll 1
                for (int tl = 0; tl < 8; ++tl) {
                    const int s0 = c0 + tl * 32;
                    if (s0 >= nhi8) break;
#pragma unroll
                    for (int p = 0; p < 4; ++p) { const int np = p < 2 ? nlo : nhi, np8 = p < 2 ? nlo8 : nhi8;
                        if (s0 >= np && s0 < np8) { const size_t q = (size_t)b * SEQ + (p < 2 ? qlo + 2 * p : qhi + 2 * (p - 2)) + lh; ISC[q * 4096 + s0 + lr] = (_Float16)(-60000.0f); } }
                    if (s0 >= nhi) continue;
                    bf16x8 B[4];
#pragma unroll
                    for (int ks = 0; ks < 4; ++ks) B[ks] = *(const LAS bf16x8*)(kbuf + (tl * 32 + lr) * 128 + (((2 * ks + lh) ^ ((lr >> 1) & 7)) * 16));
#define IDX_FINISH(P_, ACC_) do { f32x2_t s2_ = {0.f, 0.f};     \
                        _Pragma("unroll") for (int r = 0; r < 16; r += 2) { const float a0_ = ACC_[r], a1_ = ACC_[r + 1]; const int i0_ = __builtin_bit_cast(int, a0_), i1_ = __builtin_bit_cast(int, a1_); \
                            const f32x2_t rl_ = {__builtin_bit_cast(float, i0_ > 0 ? i0_ : 0), __builtin_bit_cast(float, i1_ > 0 ? i1_ : 0)}; const f32x2_t w_ = {W[P_][r], W[P_][r + 1]}; \
                            s2_ = __builtin_elementwise_fma(rl_, w_, s2_); } \
                        const float sc_ = s2_[0] + s2_[1]; \
                        const size_t q_ = (size_t)b * SEQ + ((P_) < 2 ? qlo + 2 * (P_) : qhi + 2 * ((P_) - 2)) + lh; ISC[q_ * 4096 + s0 + lr] = (_Float16)sc_; } while (0)
                    if (s0 < nlo) {
                        f32x16 c0_, c1_, c2_, c3_;
#pragma unroll
                        for (int r = 0; r < 16; ++r) { c0_[r] = 0.f; c1_[r] = 0.f; c2_[r] = 0.f; c3_[r] = 0.f; }
#pragma unroll
                        for (int ks = 0; ks < 4; ++ks) { c0_ = __builtin_amdgcn_mfma_f32_32x32x16_bf16(A[0][ks], B[ks], c0_, 0, 0, 0); c1_ = __builtin_amdgcn_mfma_f32_32x32x16_bf16(A[1][ks], B[ks], c1_, 0, 0, 0);
                            c2_ = __builtin_amdgcn_mfma_f32_32x32x16_bf16(A[2][ks], B[ks], c2_, 0, 0, 0); c3_ = __builtin_amdgcn_mfma_f32_32x32x16_bf16(A[3][ks], B[ks], c3_, 0, 0, 0); }
                        IDX_FINISH(0, c0_); IDX_FINISH(1, c1_); IDX_FINISH(2, c2_); IDX_FINISH(3, c3_);
                    } else {
                        f32x16 c2_, c3_;
#pragma unroll
                        for (int r = 0; r < 16; ++r) { c2_[r] = 0.f; c3_[r] = 0.f; }
#pragma unroll
                        for (int ks = 0; ks < 4; ++ks) { c2_ = __builtin_amdgcn_mfma_f32_32x32x16_bf16(A[2][ks], B[ks], c2_, 0, 0, 0); c3_ = __builtin_amdgcn_mfma_f32_32x32x16_bf16(A[3][ks], B[ks], c3_, 0, 0, 0); }
                        IDX_FINISH(2, c2_); IDX_FINISH(3, c3_);
                    }
#undef IDX_FINISH
                }
                asm volatile("s_waitcnt vmcnt(0)" ::: "memory");
                __syncthreads();
            }
        }
#undef P4_STAGE
        PHASE_END
        GRID_BAR();
        }
        for (int rep_ = 0; rep_ < REP_P5; ++rep_) {
        PHASE_BEGIN
        {
            LAS unsigned char* VB = lds + wave * 18432;
            LAS unsigned short* SELW = (LAS unsigned short*)(VB + 17408);
            const int hd = lane & 15, g = lane >> 4, qq = hd >> 2, pp = hd & 3;
            const float slope = exp2f(-0.5f * (float)(hd + 1));
            for (int q = gw; q < M; q += NGW) {
                const int b = q / SEQ, pos = q % SEQ, qc = pos >> 6; const int nsel = qc < 4 ? (qc + 1) * 64 : 256;
                for (int rtk_ = 0; rtk_ < REP_TOPK; ++rtk_) {
                int lane_t = lane; asm volatile("" : "+v"(lane_t));
                if (qc < 4) { const unsigned e0 = 4 * lane_t; const bool ok = 4 * lane_t < nsel; v2u z; z.x = ok ? (e0 | ((e0 + 1) << 16)) : 0u; z.y = ok ? ((e0 + 2) | ((e0 + 3) << 16)) : 0u; *(LAS v2u*)(SELW + 4 * lane_t) = z; }
                else {
                    LAS unsigned* HIST = (LAS unsigned*)VB;
                    const int nb8 = (qc + 8) >> 3;
                    float v[64];
                    { unsigned pk[32]; const int i2max = 4 * nb8 - 1; const _Float16* irow = ISC + (size_t)q * 4096 + 2 * lane_t; typedef _Float16 h2_t __attribute__((ext_vector_type(2)));
#pragma unroll
                      for (int i2 = 0; i2 < 32; ++i2) { const int ic = i2 < i2max ? i2 : i2max; pk[i2] = *(const unsigned*)(irow + ic * 128); }
#pragma unroll
                      for (int i2 = 0; i2 < 32; ++i2) { const float lim = (i2 >> 2) < nb8 ? 3.0e38f : -1.0e30f; const h2_t h = __builtin_bit_cast(h2_t, pk[i2]);
                          const float f0 = (float)h[0], f1 = (float)h[1]; v[2 * i2] = fminf(f0, lim); v[2 * i2 + 1] = fminf(f1, lim); } }
                    float vmx = v[0], vmn = fminf(fminf(v[0], v[1]), fminf(v[2], v[3]));
#pragma unroll
                    for (int i = 1; i < 64; ++i) vmx = fmaxf(vmx, v[i]);
                    vmx = wmax_f(vmx); vmn = -wmax_f(-vmn);
                    const float rng = vmx - vmn; const float s20 = rng > 0.f ? 1048574.0f / rng : 0.f;
#define ZERO_HIST() do { *(LAS v4u*)(HIST + 16 * lane) = (v4u){0u, 0u, 0u, 0u}; *(LAS v4u*)(HIST + 16 * lane + 4) = (v4u){0u, 0u, 0u, 0u}; *(LAS v4u*)(HIST + 16 * lane + 8) = (v4u){0u, 0u, 0u, 0u}; \
                        *(LAS v4u*)(HIST + 16 * lane + 12) = (v4u){0u, 0u, 0u, 0u}; HIST[1024 + lane] = 0u; } while (0)
#define SCAN_HIST(R_, BIN_, AB_) do { unsigned hh_[16]; const int hb_ = 1008 - 16 * lane; \
                        { const v4u h0 = *(const LAS v4u*)(HIST + hb_), h1 = *(const LAS v4u*)(HIST + hb_ + 4), h2 = *(const LAS v4u*)(HIST + hb_ + 8), h3 = *(const LAS v4u*)(HIST + hb_ + 12); \
                          hh_[0] = h0.x; hh_[1] = h0.y; hh_[2] = h0.z; hh_[3] = h0.w; hh_[4] = h1.x; hh_[5] = h1.y; hh_[6] = h1.z; hh_[7] = h1.w; hh_[8] = h2.x; hh_[9] = h2.y; hh_[10] = h2.z; hh_[11] = h2.w; hh_[12] = h3.x; hh_[13] = h3.y; hh_[14] = h3.z; hh_[15] = h3.w; } \
                        unsigned tot_ = 0u; _Pragma("unroll") for (int k = 0; k < 16; ++k) tot_ += hh_[k]; \
                        unsigned run_ = wprefix_u(tot_) - tot_; int fb_ = -1; unsigned fa_ = 0u; \
                        _Pragma("unroll") for (int k = 15; k >= 0; --k) { if (run_ < (R_) && run_ + hh_[k] >= (R_)) { fb_ = hb_ + k; fa_ = run_; } run_ += hh_[k]; } \
                        const unsigned long long bm_ = __ballot(fb_ >= 0); const int L_ = (int)__builtin_ctzll(bm_); \
                        BIN_ = (unsigned)__builtin_amdgcn_readlane(fb_, L_); AB_ = (unsigned)__builtin_amdgcn_readlane((int)fa_, L_); } while (0)
                    ZERO_HIST();
#pragma unroll
                    for (int i = 0; i < 64; ++i) v[i] = __builtin_bit_cast(float, (unsigned)((v[i] - vmn) * s20));
#define cd(i_) __builtin_bit_cast(unsigned, v[i_])
#pragma unroll
                    for (int g8 = 0; g8 < 8; ++g8) { if (g8 < nb8) {
#pragma unroll
                        for (int j = 0; j < 8; ++j) __hip_atomic_fetch_add(HIST + (cd(g8 * 8 + j) >> 10), 1u, __ATOMIC_RELAXED, __HIP_MEMORY_SCOPE_WORKGROUP); } }
                    LDS_WAIT(); asm volatile("" ::: "memory");
                    unsigned tb, above; SCAN_HIST(256u, tb, above);
                    ZERO_HIST();
                    LDS_WAIT(); asm volatile("" ::: "memory");
#pragma unroll
                    for (int g8 = 0; g8 < 8; ++g8) { if (g8 < nb8) {
#pragma unroll
                        for (int j = 0; j < 8; ++j) { const unsigned c = cd(g8 * 8 + j); const unsigned a = (c >> 10) == tb ? (c & 1023u) : 1024u + lane; __hip_atomic_fetch_add(HIST + a, 1u, __ATOMIC_RELAXED, __HIP_MEMORY_SCOPE_WORKGROUP); } } }
                    LDS_WAIT(); asm volatile("" ::: "memory");
                    unsigned tb2, ab2; { const unsigned R2 = 256u - above; SCAN_HIST(R2, tb2, ab2); }
                    const unsigned T = (tb << 10) | tb2; above += ab2;
                    unsigned baseg = 0u, basee = above;
#pragma unroll
                    for (int g8 = 0; g8 < 8; ++g8) { if (g8 < nb8) {
#pragma unroll
                        for (int j = 0; j < 8; ++j) { const int i = g8 * 8 + j;
                            const bool gt = cd(i) > T; const unsigned long long bg = __ballot(gt);
                            const unsigned pgp = baseg + __builtin_amdgcn_mbcnt_hi((unsigned)(bg >> 32), __builtin_amdgcn_mbcnt_lo((unsigned)bg, 0u));
                            if (gt) SELW[pgp] = (unsigned short)((i >> 1) * 128 + (i & 1) + 2 * lane);
                            baseg += (unsigned)__popcll(bg);
                            const bool eq = cd(i) == T; const unsigned long long be = __ballot(eq);
                            if (be) { const unsigned pep = basee + __builtin_amdgcn_mbcnt_hi((unsigned)(be >> 32), __builtin_amdgcn_mbcnt_lo((unsigned)be, 0u));
                                if (eq && pep < 256u) SELW[pep] = (unsigned short)((i >> 1) * 128 + (i & 1) + 2 * lane);
                                basee += (unsigned)__popcll(be); } } } }
#undef cd
#undef ZERO_HIST
#undef SCAN_HIST
                }
                LDS_WAIT(); asm volatile("" ::: "memory");
                }
                for (int rat_ = 0; rat_ < REP_ATT; ++rat_) {
                bf16* qrow = QB + (size_t)q * 4096;
                bf16x8 Bq[8];
#pragma unroll
                for (int ks = 0; ks < 8; ++ks) Bq[ks] = *(const bf16x8*)(qrow + hd * 256 + ks * 32 + g * 8);
                const bf16* kvb = CKV + (size_t)b * SEQ * 256;
                f32x4 O[16];
#pragma unroll
                for (int ct = 0; ct < 16; ++ct) O[ct] = (f32x4){0.f, 0.f, 0.f, 0.f};
                float mrun = -1.0e30f, lsum = 0.f;
                LDS_WAIT(); asm volatile("" ::: "memory");
                const int nks = nsel >> 5;
                const int lrow = lane >> 5, lcp = lane & 31, lsh = 16 * lrow;
                v4u KR[16];
#define ATT_IDX(KST_) v4u iw_[4]; _Pragma("unroll") for (int c = 0; c < 4; ++c) iw_[c] = *(const LAS v4u*)(SELW + 32 * (KST_) + 8 * c)
#define ATT_LOADROWS(KST_) do { ATT_IDX(KST_); _Pragma("unroll") for (int i = 0; i < 16; ++i) { const int rr_ = 2 * i + lrow; const unsigned w_ = iw_[i >> 2][i & 3]; const int ix_ = (int)((w_ >> lsh) & 0xffffu); \
                    KR[i] = *(const v4u*)(kvb + (size_t)ix_ * 256 + ((lcp ^ (rr_ & 7)) * 8)); } } while (0)
                ATT_LOADROWS(0);
                const int rlA = hd & 7;
                const int rlT = (4 * g + qq) & 7;
                const int trb = (4 * g + qq) * 512 + 8 * (pp & 1), trm = 16 * ((pp >> 1) ^ rlT);
                for (int kst = 0; kst < nks; ++kst) {
                    int rlA_ = rlA, trm_ = trm; asm volatile("" : "+v"(rlA_), "+v"(trm_));
                    if (kst + 1 < nks) {
                        ATT_IDX(kst + 1);
#pragma unroll
                        for (int i = 0; i < 16; ++i) { *(LAS v4u*)(VB + i * 1024 + lane * 16) = KR[i];
                            const int rr_ = 2 * i + lrow; const unsigned w_ = iw_[i >> 2][i & 3]; const int ix_ = (int)((w_ >> lsh) & 0xffffu); KR[i] = *(const v4u*)(kvb + (size_t)ix_ * 256 + ((lcp ^ (rr_ & 7)) * 8)); }
                    } else {
#pragma unroll
                        for (int i = 0; i < 16; ++i) *(LAS v4u*)(VB + i * 1024 + lane * 16) = KR[i]; }
                    LDS_WAIT(); asm volatile("" ::: "memory");
                    f32x4 S0 = {0.f, 0.f, 0.f, 0.f}, S1 = {0.f, 0.f, 0.f, 0.f};
#pragma unroll
                    for (int k4 = 0; k4 < 4; ++k4) {
                        bf16x8 a0[2], a1[2];
#pragma unroll
                        for (int j = 0; j < 2; ++j) { const int ks = k4 * 2 + j; const int cpos = (4 * ks + g) ^ rlA_;
                            a0[j] = *(const LAS bf16x8*)(VB + hd * 512 + cpos * 16); a1[j] = *(const LAS bf16x8*)(VB + (16 + hd) * 512 + cpos * 16); }
#pragma unroll
                        for (int j = 0; j < 2; ++j) { const int ks = k4 * 2 + j;
                            S0 = __builtin_amdgcn_mfma_f32_16x16x32_bf16(a0[j], Bq[ks], S0, 0, 0, 0); S1 = __builtin_amdgcn_mfma_f32_16x16x32_bf16(a1[j], Bq[ks], S1, 0, 0, 0); }
                    }
                    const v2u pa = *(const LAS v2u*)(SELW + 32 * kst + 4 * g), pb = *(const LAS v2u*)(SELW + 32 * kst + 16 + 4 * g);
                    const float fp = (float)pos;
                    float s0[4], s1[4];
                    s0[0] = S0[0] - slope * fabsf(fp - (float)(pa.x & 0xffffu)); s0[1] = S0[1] - slope * fabsf(fp - (float)(pa.x >> 16));
                    s0[2] = S0[2] - slope * fabsf(fp - (float)(pa.y & 0xffffu)); s0[3] = S0[3] - slope * fabsf(fp - (float)(pa.y >> 16));
                    s1[0] = S1[0] - slope * fabsf(fp - (float)(pb.x & 0xffffu)); s1[1] = S1[1] - slope * fabsf(fp - (float)(pb.x >> 16));
                    s1[2] = S1[2] - slope * fabsf(fp - (float)(pb.y & 0xffffu)); s1[3] = S1[3] - slope * fabsf(fp - (float)(pb.y >> 16));
                    float ml = fmaxf(fmaxf(fmaxf(s0[0], s0[1]), fmaxf(s0[2], s0[3])), fmaxf(fmaxf(s1[0], s1[1]), fmaxf(s1[2], s1[3])));
                    ml = xmax16(ml); ml = xmax32(ml);
                    const float mnew = fmaxf(mrun, ml), alpha = __expf(mrun - mnew); mrun = mnew;
                    float p0[4], p1[4];
#pragma unroll
                    for (int r = 0; r < 4; ++r) { p0[r] = __expf(s0[r] - mnew); p1[r] = __expf(s1[r] - mnew); }
                    lsum = lsum * alpha + ((p0[0] + p0[1]) + (p0[2] + p0[3])) + ((p1[0] + p1[1]) + (p1[2] + p1[3]));
                    v4u pw; pw.x = pk2(p0[0], p0[1]); pw.y = pk2(p0[2], p0[3]); pw.z = pk2(p1[0], p1[1]); pw.w = pk2(p1[2], p1[3]);
                    const bf16x8 Pf = __builtin_bit_cast(bf16x8, pw);
#pragma unroll
                    for (int ct = 0; ct < 16; ++ct) O[ct] = O[ct] * alpha;
#pragma unroll
                    for (int c8 = 0; c8 < 4; ++c8) {
                        v4s lo[4], hi[4];
#pragma unroll
                        for (int j = 0; j < 4; ++j) { const int ct = c8 * 4 + j; const int off = trb + ((32 * ct) ^ trm_);
                            lo[j] = __builtin_amdgcn_ds_read_tr16_b64_v4i16((LAS v4s*)(VB + off));
                            hi[j] = __builtin_amdgcn_ds_read_tr16_b64_v4i16((LAS v4s*)(VB + 16 * 512 + off)); }
#pragma unroll
                        for (int j = 0; j < 4; ++j) { const int ct = c8 * 4 + j;
                            const bf16x8 Af = {lo[j][0], lo[j][1], lo[j][2], lo[j][3], hi[j][0], hi[j][1], hi[j][2], hi[j][3]};
                            O[ct] = __builtin_amdgcn_mfma_f32_16x16x32_bf16(Af, Pf, O[ct], 0, 0, 0); }
                    }
                    LDS_WAIT(); asm volatile("" ::: "memory");
                }
#undef ATT_LOADROWS
#undef ATT_IDX
                lsum = xsum16(lsum); lsum = xsum32(lsum);
                const float inv = 1.0f / lsum;
#pragma unroll
                for (int ct = 0; ct < 16; ++ct) { const f32x4 o = O[ct] * inv; v2u w; w.x = pk2(o[0], o[1]); w.y = pk2(o[2], o[3]); *(v2u*)(OB + (size_t)q * 4096 + hd * 256 + 16 * ct + 4 * g) = w; }
                }
            }
        }
        PHASE_END
        GRID_BAR();
        }
        PHASE_BEGIN
        { pg8::Gemm g{OB, W6, M, 1024, 1024, 4096, 1024, 1024}; pg8::StaticOrder S; S.init(M, 1024, G, blk);
          EpiBf E{YAB, 2048, 1024}; pg8::gemm_phase(lds, g, S, E, tid); }
        PHASE_END
        GRID_BAR();
        PHASE_BEGIN
        { pg8::Gemm g{YAB, W7, M, DM, DM, DM, DM, 0}; pg8::StaticOrder S; S.init(M, DM, G, blk);
          EpiGateM E{GTB, MRG}; HookGate Hk{GTA, GTB}; pg8::gemm_phase(lds, g, S, E, tid, Hk); }
        PHASE_END
        GRID_BAR();
        PHASE_BEGIN
        { pg8::Gemm g{MRG, W8, M, DM, DM, DM, DM, 0}; pg8::StaticOrder S; S.init(M, DM, G, blk);
          EpiRes E{(l == 0) ? x_in : (const float*)nullptr, XB, RB, modl + 2 * DM}; pg8::gemm_phase(lds, g, S, E, tid); }
        PHASE_END
        GRID_BAR();
        for (int rep_ = 0; rep_ < REP_P9; ++rep_) {
        PHASE_BEGIN
        f32x4 lg[8], lb_[8]; v2u nx[8];
#pragma unroll
        for (int j = 0; j < 8; ++j) { const int c = j * 256 + lane * 4; lg[j] = *(const f32x4*)(ln1_g + l * DM + c); lb_[j] = *(const f32x4*)(ln1_b + l * DM + c); nx[j] = *(const v2u*)(RB + (size_t)gw * DM + c); }
        for (int row = gw; row < M; row += NGW) {
            const int b = row / SEQ; const float* md = modl + (size_t)b * MODW;
            f32x4 v[8]; float s = 0.f;
#pragma unroll
            for (int j = 0; j < 8; ++j) { v[j] = (f32x4){bflo(nx[j].x), bfhi(nx[j].x), bflo(nx[j].y), bfhi(nx[j].y)}; s += (v[j][0] + v[j][1]) + (v[j][2] + v[j][3]); }
            { const int rn = row + NGW < M ? row + NGW : row;
#pragma unroll
              for (int j = 0; j < 8; ++j) nx[j] = *(const v2u*)(RB + (size_t)rn * DM + j * 256 + lane * 4); }
            f32x4 msc[8], msh[8];
#pragma unroll
            for (int j = 0; j < 8; ++j) { const int c = j * 256 + lane * 4; msc[j] = *(const f32x4*)(md + 4 * DM + c); msh[j] = *(const f32x4*)(md + 3 * DM + c); }
            const float mean = wave_sum(s) * (1.f / DM); float s2 = 0.f;
#pragma unroll
            for (int j = 0; j < 8; ++j) { v[j] = v[j] - mean; s2 += (v[j][0] * v[j][0] + v[j][1] * v[j][1]) + (v[j][2] * v[j][2] + v[j][3] * v[j][3]); }
            const float rstd = 1.0f / sqrtf(wave_sum(s2) * (1.f / DM) + 1e-5f);
#pragma unroll
            for (int j = 0; j < 8; ++j) { const int c = j * 256 + lane * 4; const f32x4 gg = lg[j], bb = lb_[j];
                const f32x4 y = v[j] * rstd * gg + bb; { v2u wx; wx.x = pk2(y[0], y[1]); wx.y = pk2(y[2], y[3]); *(v2u*)(XB + (size_t)row * DM + c) = wx; }
                const f32x4 sc = msc[j], sh = msh[j]; const f32x4 hh = y * (sc + 1.f) + sh;
                v2u w; w.x = pk2(hh[0], hh[1]); w.y = pk2(hh[2], hh[3]); *(v2u*)(HB + (size_t)row * DM + c) = w; }
        }
        PHASE_END
        GRID_BAR();
        }
        PHASE_BEGIN
        { pg8::Gemm g{HB, W10, M, N10, DM, DM, DM, 0}; pg8::StaticOrder S; S.init(M, N10, G, blk);
          EpiSwiglu E{ACT}; pg8::gemm_phase(lds, g, S, E, tid); }
        PHASE_END
        GRID_BAR();
        PHASE_BEGIN
        { pg8::Gemm g{ACT, W11, M, DM, DFF, DFF, DFF, 0}; pg8::StaticOrder S; S.init(M, DM, G, blk);
          EpiRes E{(const float*)nullptr, XB, RB, modl + 5 * DM}; pg8::gemm_phase(lds, g, S, E, tid); }
        PHASE_END
        GRID_BAR();
        for (int rep_ = 0; rep_ < REP_P12; ++rep_) {
        PHASE_BEGIN
        {
            const bool lastl = (l == DEPTH - 1); const float* mdn = MOD + (size_t)(l + 1 < DEPTH ? l + 1 : l) * NBATCH * MODW;
            f32x4 lg[8], lb_[8]; v2u nx[8];
#pragma unroll
            for (int j = 0; j < 8; ++j) { const int c = j * 256 + lane * 4; lg[j] = *(const f32x4*)(ln2_g + l * DM + c); lb_[j] = *(const f32x4*)(ln2_b + l * DM + c); nx[j] = *(const v2u*)(RB + (size_t)gw * DM + c); }
            for (int row = gw; row < M; row += NGW) {
                const int b = row / SEQ; const float* md = mdn + (size_t)b * MODW;
                f32x4 v[8]; float s = 0.f;
#pragma unroll
                for (int j = 0; j < 8; ++j) { v[j] = (f32x4){bflo(nx[j].x), bfhi(nx[j].x), bflo(nx[j].y), bfhi(nx[j].y)}; s += (v[j][0] + v[j][1]) + (v[j][2] + v[j][3]); }
                { const int rn = row + NGW < M ? row + NGW : row;
#pragma unroll
                  for (int j = 0; j < 8; ++j) nx[j] = *(const v2u*)(RB + (size_t)rn * DM + j * 256 + lane * 4); }
                f32x4 msc[8], msh[8];
#pragma unroll
                for (int j = 0; j < 8; ++j) { const int c = j * 256 + lane * 4; msc[j] = *(const f32x4*)(md + DM + c); msh[j] = *(const f32x4*)(md + c); }
                const float mean = wave_sum(s) * (1.f / DM); float s2 = 0.f;
#pragma unroll
                for (int j = 0; j < 8; ++j) { v[j] = v[j] - mean; s2 += (v[j][0] * v[j][0] + v[j][1] * v[j][1]) + (v[j][2] * v[j][2] + v[j][3] * v[j][3]); }
                const float rstd = 1.0f / sqrtf(wave_sum(s2) * (1.f / DM) + 1e-5f);
#pragma unroll
                for (int j = 0; j < 8; ++j) { const int c = j * 256 + lane * 4; const f32x4 gg = lg[j], bb = lb_[j];
                    const f32x4 y = v[j] * rstd * gg + bb; if (lastl) *(f32x4*)(args.out + (size_t)row * DM + c) = y; else { v2u wx; wx.x = pk2(y[0], y[1]); wx.y = pk2(y[2], y[3]); *(v2u*)(XB + (size_t)row * DM + c) = wx; }
                    const f32x4 sc = msc[j], sh = msh[j]; const f32x4 hh = y * (sc + 1.f) + sh;
                    v2u w; w.x = pk2(hh[0], hh[1]); w.y = pk2(hh[2], hh[3]); *(v2u*)(HB + (size_t)row * DM + c) = w; }
            }
            if (l + 1 < DEPTH) { __syncthreads(); CONVERT_LAYER(l + 1); }
        }
        PHASE_END
        if (l + 1 < DEPTH || rep_ + 1 < REP_P12) GRID_BAR();
        }
    }
}

extern "C" void kernel_launch(void* const* d_in, const int* in_sizes, int n_in, void* d_out, int out_size, void* d_ws, size_t ws_size, hipStream_t stream) {
    static int grid = 0;
    if (grid == 0) {
        if (n_in != 22 || out_size != M * DM || ws_size < WS_END) { fprintf(stderr, "kernel_launch: unexpected shapes (n_in %d, out %d, ws %zu < %zu)\n", n_in, out_size, ws_size, (size_t)WS_END); grid = -1; return; }
        int dev = 0, cus = 0, per_cu = 0;
        if (hipGetDevice(&dev) != hipSuccess || hipDeviceGetAttribute(&cus, hipDeviceAttributeMultiprocessorCount, dev) != hipSuccess) { grid = -1; return; }
        if (hipFuncSetAttribute((const void*)fwd_kernel, hipFuncAttributeMaxDynamicSharedMemorySize, LDS_BYTES) != hipSuccess) { fprintf(stderr, "kernel_launch: hipFuncSetAttribute failed\n"); grid = -1; return; }
        if (hipOccupancyMaxActiveBlocksPerMultiprocessor(&per_cu, (const void*)fwd_kernel, NTHR, LDS_BYTES) != hipSuccess || per_cu < 1) { fprintf(stderr, "kernel_launch: occupancy query says %d\n", per_cu); }
        (void)hipGetLastError();
        grid = cus;
    }
    if (grid < 0) return;
    if (hipMemsetAsync((char*)d_ws + WS_CTL, 0, CTL_ZERO_BYTES, stream) != hipSuccess) return;
    Args a{};
    for (int i = 0; i < 22; ++i) a.in[i] = (const float*)d_in[i];
    a.out = (float*)d_out; a.ws = (unsigned char*)d_ws;
    hipLaunchKernelGGL(fwd_kernel, dim3(grid), dim3(NTHR), LDS_BYTES, stream, a);
}
```

```cpp
#include <hip/hip_runtime.h>
#include <cstdio>
#include <cstdint>

namespace pg8 {
#define PG8_LAS __attribute__((address_space(3)))
typedef unsigned short bf16_t;
typedef short bf16x8 __attribute__((ext_vector_type(8)));
typedef float f32x4 __attribute__((ext_vector_type(4)));
typedef unsigned u32x4 __attribute__((ext_vector_type(4)));
constexpr int BM = 256, BK = 64, HALF = 128, HTB = HALF * BK * 2, STAGE_BYTES = 8 * HTB, NXCD = 8, WGM = 8;

__host__ __device__ __forceinline__ int lds_byte(int r, int c) { const int st = (r >> 4) * 2 + (c >> 5), rr = r & 15, cc = c & 31, ob = rr * 64 + cc * 2; return st * 1024 + (ob ^ (((ob >> 9) & 1) << 5)); }
__host__ __device__ __forceinline__ void stage_rc(int b, int& R, int& C) { const int st = b / 1024, sb = b % 1024, swz = sb ^ (((sb >> 9) & 1) << 5); R = (st >> 1) * 16 + swz / 64; C = (st & 1) * 32 + (swz % 64) / 2; }
__host__ __device__ __forceinline__ int perm32(int rho) { const int n = rho >> 4, i = rho & 15; return 8 * (i >> 2) + 4 * n + (i & 3); }

struct Unit { int pm, pn; };
struct Gemm { const bf16_t* A; const bf16_t* Bt; int M, N, K, lda, ldb, a_pn_stride; };

struct StaticOrder {
    int nM, nN, nwg, G, c;
    __host__ __device__ void init(int M, int N, int G_, int c_) { nM = M / BM; nN = N / BM; nwg = nM * nN; G = G_; c = c_; }
    __host__ __device__ bool next(int i, Unit& u) const {
        const long L = (long)i * G + c; if (L >= nwg) return false;
        int wgid = (int)L; { const int q = nwg / NXCD, r = nwg % NXCD, xcd = wgid % NXCD, off = wgid / NXCD; wgid = (xcd < r ? xcd * (q + 1) : r * (q + 1) + (xcd - r) * q) + off; }
        const int nig = WGM * nN, gid = wgid / nig, fm = gid * WGM, gsz = (nM - fm) < WGM ? (nM - fm) : WGM;
        u.pm = fm + ((wgid % nig) % gsz); u.pn = (wgid % nig) / gsz; return true;
    }
};

typedef float f32x2_t __attribute__((ext_vector_type(2))); typedef __bf16 bf16x2_t __attribute__((ext_vector_type(2)));
__device__ __forceinline__ unsigned cvt_pk_bf16(float lo, float hi) { f32x2_t v = {lo, hi}; bf16x2_t b = __builtin_convertvector(v, bf16x2_t); return __builtin_bit_cast(unsigned, b); }

struct NoHook { static constexpr bool ON = false; template <class A> __device__ __forceinline__ void mid(A&, const Unit&, int, int, int, int) const {} };
template <class Epi, class Hook = NoHook>
__device__ __forceinline__ void gemm_phase(PG8_LAS unsigned char* lds, const Gemm g, const StaticOrder& S, const Epi& E, const int tid, const Hook H = Hook()) {
    const int wid = __builtin_amdgcn_readfirstlane(tid >> 6), lane = tid & 63, wr = wid >> 2, wc = wid & 3, fr = lane & 15, fq = lane >> 4;
    const int K = g.K, nt = K / BK;
    unsigned voffA[2], voffB[2];
#pragma unroll
    for (int i = 0; i < 2; ++i) { int R, C; stage_rc(tid * 16 + i * 8192, R, C); const int Rb = 64 * (R >> 5) + perm32(R & 31);
        voffA[i] = (unsigned)(R * g.lda + C) * 2u; voffB[i] = (unsigned)(Rb * g.ldb + C) * 2u; }
    const size_t kstep = (size_t)(BK * 2);
    const size_t hstepA = (size_t)HALF * g.lda * 2, hstepB = (size_t)32 * g.ldb * 2;
    const size_t tstepA = 2 * hstepA, tstepB = (size_t)BM * g.ldb * 2;
    const unsigned ldsw = (unsigned)wid * 1024u;
    const int aoff = lds_byte(wr * 64 + fr, fq * 8), boff = lds_byte(wc * 32 + fr, fq * 8);
#define PG8_SA(b, h) (((b) * 2 + (h)) * HTB)
#define PG8_SB(b, h) ((4 + (b) * 2 + (h)) * HTB)
#define PG8_STAGE(bufoff, gbase, voff) do { _Pragma("unroll") for (int _i = 0; _i < 2; ++_i) \
        __builtin_amdgcn_global_load_lds((const unsigned*)((const char*)(gbase) + (voff)[_i]), (PG8_LAS unsigned*)(lds + (bufoff) + ldsw + _i * 8192), 16, 0, 0); } while (0)
#define PG8_LDA(dst, b, h) do { _Pragma("unroll") for (int m = 0; m < 4; ++m) _Pragma("unroll") for (int k = 0; k < 2; ++k) dst[m][k] = *(const PG8_LAS bf16x8*)(lds + PG8_SA(b, h) + aoff + m * 2048 + k * 1024); } while (0)
#define PG8_LDB(dst, b, h) do { _Pragma("unroll") for (int n = 0; n < 2; ++n) _Pragma("unroll") for (int k = 0; k < 2; ++k) dst[n][k] = *(const PG8_LAS bf16x8*)(lds + PG8_SB(b, h) + boff + n * 2048 + k * 1024); } while (0)
#define PG8_MMA(ai, bj, At, Bt) do { __builtin_amdgcn_s_setprio(1); _Pragma("unroll") for (int m = 0; m < 4; ++m) _Pragma("unroll") for (int n = 0; n < 2; ++n) _Pragma("unroll") for (int k = 0; k < 2; ++k) \
        acc[ai][bj][m][n] = __builtin_amdgcn_mfma_f32_16x16x32_bf16(Bt[n][k], At[m][k], acc[ai][bj][m][n], 0, 0, 0); __builtin_amdgcn_s_setprio(0); } while (0)
#define PG8_WAIT_V(n) asm volatile("s_waitcnt vmcnt(" #n ")" ::: "memory")
#define PG8_WAIT_L(n) asm volatile("s_waitcnt lgkmcnt(" #n ")" ::: "memory")
#define PG8_BAR __builtin_amdgcn_s_barrier()
#define PG8_SCHED __builtin_amdgcn_sched_barrier(0)
    Unit cur, nxt; int ui = 0;
    if (!S.next(0, cur)) return;
    f32x4 acc[2][2][4][2];
#pragma unroll
    for (int a = 0; a < 2; ++a)
#pragma unroll
        for (int b = 0; b < 2; ++b)
#pragma unroll
            for (int m = 0; m < 4; ++m)
#pragma unroll
                for (int n = 0; n < 2; ++n) acc[a][b][m][n] = (f32x4){0.f, 0.f, 0.f, 0.f};
    bf16x8 At[4][2], B0[2][2], B1[2][2];
    const char* cA = (const char*)g.A + (size_t)cur.pm * tstepA + (size_t)cur.pn * g.a_pn_stride * 2; const char* cB = (const char*)g.Bt + (size_t)cur.pn * tstepB;
    PG8_STAGE(PG8_SB(0, 0), cB, voffB); PG8_STAGE(PG8_SB(0, 1), cB + hstepB, voffB); PG8_STAGE(PG8_SA(0, 0), cA, voffA); PG8_STAGE(PG8_SA(0, 1), cA + hstepA, voffA);
    if (wr == 1) PG8_BAR;
    PG8_WAIT_V(2); PG8_BAR;
    PG8_STAGE(PG8_SB(1, 0), cB + kstep, voffB); PG8_STAGE(PG8_SA(1, 0), cA + kstep, voffA); PG8_STAGE(PG8_SB(1, 1), cB + hstepB + kstep, voffB);
    PG8_WAIT_V(6); PG8_BAR;
    for (;;) {
        const bool has_next = S.next(ui + 1, nxt);
        const char* nA = has_next ? (const char*)g.A + (size_t)nxt.pm * tstepA + (size_t)nxt.pn * g.a_pn_stride * 2 : cA; const char* nB = has_next ? (const char*)g.Bt + (size_t)nxt.pn * tstepB : cB;
        for (int t = 0; t < nt; t += 2) {
            const bool last = (t == nt - 2);
            const char* a1 = cA + (size_t)(t + 1) * kstep;
            const char* a2 = last ? nA : cA + (size_t)(t + 2) * kstep; const char* b2 = last ? nB : cB + (size_t)(t + 2) * kstep;
            const char* a3 = a2 + kstep; const char* b3 = b2 + kstep;
            if constexpr (Hook::ON) { if (t == (nt >> 1)) H.mid(acc, cur, wr, wc, fr, fq); }
            PG8_LDB(B0, 0, 0); PG8_LDB(B1, 0, 1); PG8_SCHED; PG8_LDA(At, 0, 0); PG8_STAGE(PG8_SA(1, 1), a1 + hstepA, voffA);
            PG8_WAIT_V(8); PG8_WAIT_L(0); PG8_BAR; PG8_MMA(0, 0, At, B0); PG8_MMA(0, 1, At, B1); PG8_BAR; PG8_SCHED;
            PG8_LDA(At, 0, 1); PG8_STAGE(PG8_SB(0, 0), b2, voffB); PG8_STAGE(PG8_SB(0, 1), b2 + hstepB, voffB); PG8_STAGE(PG8_SA(0, 0), a2, voffA);
            PG8_WAIT_V(8); PG8_WAIT_L(0); PG8_BAR; PG8_MMA(1, 0, At, B0); PG8_MMA(1, 1, At, B1); PG8_BAR; PG8_SCHED;
            PG8_LDB(B0, 1, 0); PG8_LDB(B1, 1, 1); PG8_SCHED; PG8_LDA(At, 1, 0); PG8_STAGE(PG8_SA(0, 1), a2 + hstepA, voffA);
            PG8_WAIT_V(8); PG8_WAIT_L(0); PG8_BAR; PG8_MMA(0, 0, At, B0); PG8_MMA(0, 1, At, B1); PG8_BAR; PG8_SCHED;
            PG8_LDA(At, 1, 1); PG8_STAGE(PG8_SB(1, 0), b3, voffB); PG8_STAGE(PG8_SB(1, 1), b3 + hstepB, voffB); PG8_STAGE(PG8_SA(1, 0), a3, voffA);
            PG8_WAIT_V(8); PG8_WAIT_L(0); PG8_BAR; PG8_MMA(1, 0, At, B0); PG8_MMA(1, 1, At, B1); PG8_BAR; PG8_SCHED;
        }
        if (wr == 0) PG8_BAR;
        E(acc, cur, wr, wc, fr, fq);
        if (!has_next) break;
#pragma unroll
        for (int a = 0; a < 2; ++a)
#pragma unroll
            for (int b = 0; b < 2; ++b)
#pragma unroll
                for (int m = 0; m < 4; ++m)
#pragma unroll
                    for (int n = 0; n < 2; ++n) acc[a][b][m][n] = (f32x4){0.f, 0.f, 0.f, 0.f};
        cur = nxt; cA = nA; cB = nB; ++ui;
        if (wr == 1) PG8_BAR;
    }
    PG8_WAIT_V(0);
    PG8_BAR;
#undef PG8_SA
#undef PG8_SB
#undef PG8_STAGE
#undef PG8_LDA
#undef PG8_LDB
#undef PG8_MMA
#undef PG8_WAIT_V
#undef PG8_WAIT_L
#undef PG8_BAR
#undef PG8_SCHED
}
}

constexpr int NWAVES = 8, NTHR = NWAVES * 64;
constexpr int DM = 2048, NBATCH = 4, SEQ = 4096, DEPTH = 4, M = NBATCH * SEQ;
constexpr int HGW = 1024;
constexpr int SAH = 16, SAC = 256, SAR = 512;
constexpr int DFF = 5632;
constexpr int N1 = 9216, N3 = 5120, N10 = 2 * DFF;
constexpr float ALPHA = 1.6817928305074292f;
constexpr int MODW = 6 * DM;

constexpr size_t MiB = 1u << 20;
constexpr size_t WS_CTL = 0, CTL_ZERO_BYTES = 32768;
constexpr size_t WS_MOD = 1 * MiB;
constexpr size_t WS_LB = 2 * MiB;
constexpr size_t WS_MODP = 3 * MiB;
constexpr size_t WS_W1 = 9 * MiB;
constexpr size_t WS_W3 = WS_W1 + 36 * MiB;
constexpr size_t WS_W6 = WS_W3 + 5 * MiB;
constexpr size_t WS_W7 = WS_W6 + 2 * MiB;
constexpr size_t WS_W8 = WS_W7 + 8 * MiB;
constexpr size_t WS_W10 = WS_W8 + 8 * MiB;
constexpr size_t WS_W11 = WS_W10 + 44 * MiB;
constexpr size_t WS_X = WS_W11 + 22 * MiB;
constexpr size_t WS_R = WS_X + 128 * MiB;
constexpr size_t WS_H = WS_R + 128 * MiB;
constexpr size_t WS_QA = WS_H + 64 * MiB;
constexpr size_t WS_FA = WS_QA + 32 * MiB;
constexpr size_t WS_IA = WS_FA + 64 * MiB;
constexpr size_t WS_GA = WS_IA + 32 * MiB;
constexpr size_t WS_LAT = WS_GA + 32 * MiB;
constexpr size_t WS_GTA = WS_LAT + 64 * MiB;
constexpr size_t WS_GTB = WS_GTA + 64 * MiB;
constexpr size_t WS_CQN = WS_GTB + 64 * MiB;
constexpr size_t WS_CKV = WS_CQN + 16 * MiB;
constexpr size_t WS_KIDX = WS_CKV + 8 * MiB;
constexpr size_t WS_IDXW = WS_KIDX + 2 * MiB;
constexpr size_t WS_QB = WS_IDXW + 1 * MiB;
constexpr size_t WS_QIDX = WS_QB + 128 * MiB;
constexpr size_t WS_SEL = WS_QIDX + 32 * MiB;
constexpr size_t WS_YAB = WS_SEL + 8 * MiB;
constexpr size_t WS_MRG = WS_FA;
constexpr size_t WS_OB = WS_YAB + 64 * MiB;
constexpr size_t WS_BIG = WS_OB + 128 * MiB;
constexpr size_t WS_KSB = WS_BIG + 256 * MiB;
constexpr size_t WS_DEB = WS_KSB + 32 * MiB;
constexpr size_t WS_QSB = WS_DEB + 2 * MiB;
constexpr size_t WS_END = WS_QSB + 32 * MiB;

constexpr int CW_BAR = 4096;

constexpr int RING_BYTES = 131072;
constexpr int LDS_BYTES = 163840;
constexpr int LDSCTL_OFF = LDS_BYTES - 1024, MISC_OFF = LDSCTL_OFF + 320, SELL_OFF = 147456;

#define GAS __attribute__((address_space(1)))
#define LAS __attribute__((address_space(3)))
typedef unsigned short bf16;
typedef unsigned v4u __attribute__((ext_vector_type(4)));
typedef unsigned v2u __attribute__((ext_vector_type(2)));
typedef float f32x4 __attribute__((ext_vector_type(4)));
typedef float f32x16 __attribute__((ext_vector_type(16)));
typedef short bf16x8 __attribute__((ext_vector_type(8)));
typedef short v4s __attribute__((ext_vector_type(4)));
typedef GAS unsigned gu32;
#define LDS_WAIT() asm volatile("s_waitcnt lgkmcnt(0)" ::: "memory")
__device__ __forceinline__ unsigned f2bf(float f) { unsigned u = __builtin_bit_cast(unsigned, f); return (u + 0x7fffu + ((u >> 16) & 1u)) >> 16; }
__device__ __forceinline__ unsigned pk2(float lo, float hi) { return pg8::cvt_pk_bf16(lo, hi); }
__device__ __forceinline__ float bf2f(unsigned short b) { return __builtin_bit_cast(float, ((unsigned)b) << 16); }
__device__ __forceinline__ float bflo(unsigned w) { return __builtin_bit_cast(float, w << 16); }
__device__ __forceinline__ float bfhi(unsigned w) { return __builtin_bit_cast(float, w & 0xffff0000u); }
__device__ __forceinline__ float sigm(float x) { return __builtin_amdgcn_rcpf(1.f + __expf(-x)); }

__device__ __forceinline__ int lane_id() { unsigned m = ~0u; asm volatile("" : "+s"(m)); return (int)__builtin_amdgcn_mbcnt_hi(m, __builtin_amdgcn_mbcnt_lo(m, 0u)); }
#define XB_TMO      128
#define XB_XCNT(j)  (256  + 64 * (j))
#define XB_XSUB(j)  (1280 + 64 * (j))
#define XB_XGEN(j)  (2304 + 64 * (j))
#define XB_TOP      3328
#define XB_TOPGEN   3392
#define XCD_BAR_WORDS 3456
#define XB_SPIN_CAP (1u << 22)

__device__ __forceinline__ unsigned xb_ld(unsigned* p)              { return __hip_atomic_load(p, __ATOMIC_RELAXED, __HIP_MEMORY_SCOPE_AGENT); }
__device__ __forceinline__ unsigned xb_add(unsigned* p, unsigned v) { return __hip_atomic_fetch_add(p, v, __ATOMIC_RELAXED, __HIP_MEMORY_SCOPE_AGENT); }
__device__ __forceinline__ unsigned xb_xcc_id() { return (unsigned)__builtin_amdgcn_s_getreg((3 << 11) | 20) & 0xFu; }
#define XB_SPIN(cond, bar) do { unsigned _sp = 0; while (cond) { __builtin_amdgcn_s_sleep(1); \
    if ((++_sp & 255u) == 0u) { if (xb_ld(&(bar)[XB_TMO])) break; if (_sp > XB_SPIN_CAP) { atomicAdd(&(bar)[XB_TMO], 1u); break; } } } } while (0)

struct XcdBarrier { unsigned* bar; unsigned x; volatile LAS unsigned* st; int wave; };

__device__ __forceinline__ XcdBarrier xcd_barrier_post(unsigned* bar, volatile LAS unsigned* st) {
    XcdBarrier b; b.bar = bar; b.x = (unsigned)__builtin_amdgcn_readfirstlane((int)xb_xcc_id()); b.st = st;
    if (threadIdx.x == 0) (void)xb_add(&bar[XB_XCNT(b.x)], 1u);
    return b;
}
__device__ __forceinline__ void xcd_barrier_complete(unsigned* bar, unsigned x, unsigned& nloc, unsigned& nx) {
    const unsigned G = gridDim.x * gridDim.y * gridDim.z;
    unsigned sum, cnt, mine, sp = 0u;
    for (;;) {
        sum = 0u; cnt = 0u; mine = 0u;
#pragma unroll 1
        for (unsigned j = 0; j < 16; ++j) { const unsigned c = xb_ld(&bar[XB_XCNT(j)]); sum += c; cnt += (c > 0u) ? 1u : 0u; mine = (j == x) ? c : mine; }
        if (sum == G) break;
        __builtin_amdgcn_s_sleep(1);
        if ((++sp & 255u) == 0u) { if (xb_ld(&bar[XB_TMO])) break; if (sp > XB_SPIN_CAP) { atomicAdd(&bar[XB_TMO], 1u); break; } }
    }
    nloc = mine > 0u ? mine : 1u; nx = cnt > 0u ? cnt : 1u;
}
__device__ __forceinline__ void xcd_barrier(const XcdBarrier& b) {
    asm volatile("s_waitcnt vmcnt(0)" ::: "memory");
    __syncthreads();
    if (b.wave == 0 && lane_id() == 0) {
        unsigned* bar = b.bar;
        unsigned bx = b.x; asm volatile("" : "+s"(bx));
        __builtin_amdgcn_s_waitcnt(0);
        unsigned nloc = b.st[0], nx = b.st[1];
        const unsigned old = xb_add(&bar[XB_XSUB(bx)], 1u);
        const unsigned gen = old / nloc;
        if (old + 1u == (gen + 1u) * nloc) {
            __builtin_amdgcn_fence(__ATOMIC_RELEASE, "agent");
            asm volatile("s_waitcnt vmcnt(0)" ::: "memory");
            const unsigned og = xb_add(&bar[XB_TOP], 1u);
            const unsigned tg = og / nx;
            if (og + 1u == (tg + 1u) * nx) xb_add(&bar[XB_TOPGEN], 1u);
            else XB_SPIN(xb_ld(&bar[XB_TOPGEN]) == tg, bar);
            __builtin_amdgcn_fence(__ATOMIC_ACQUIRE, "agent");
            xb_add(&bar[XB_XGEN(bx)], 1u);
            asm volatile("s_waitcnt vmcnt(0)" ::: "memory");
        } else {
            XB_SPIN(xb_ld(&bar[XB_XGEN(bx)]) == gen, bar);
            __builtin_amdgcn_fence(__ATOMIC_ACQUIRE, "agent");
            asm volatile("s_waitcnt vmcnt(0)" ::: "memory");
        }
    }
    __syncthreads();
}

__device__ __forceinline__ void xswap16(float& a, float& b) { asm volatile("s_nop 1\n\tv_permlane16_swap_b32 %0, %1\n\ts_nop 1" : "+v"(a), "+v"(b)); }
__device__ __forceinline__ void xswap32(float& a, float& b) { asm volatile("s_nop 1\n\tv_permlane32_swap_b32 %0, %1\n\ts_nop 1" : "+v"(a), "+v"(b)); }
__device__ __forceinline__ float xmax16(float x) { float a = x, b = x; xswap16(a, b); return fmaxf(a, b); }
__device__ __forceinline__ float xmax32(float x) { float a = x, b = x; xswap32(a, b); return fmaxf(a, b); }
__device__ __forceinline__ float xsum16(float x) { float a = x, b = x; xswap16(a, b); return a + b; }
__device__ __forceinline__ float xsum32(float x) { float a = x, b = x; xswap32(a, b); return a + b; }

#define DPPF(x, ctrl) __builtin_bit_cast(float, __builtin_amdgcn_update_dpp(0, __builtin_bit_cast(int, (x)), (ctrl), 0xf, 0xf, true))
__device__ __forceinline__ float wmax_f(float x) {
    x = fmaxf(x, DPPF(x, 0xB1)); x = fmaxf(x, DPPF(x, 0x4E)); x = fmaxf(x, DPPF(x, 0x124)); x = fmaxf(x, DPPF(x, 0x128));
    x = xmax16(x); return xmax32(x);
}
__device__ __forceinline__ unsigned wprefix_u(unsigned x) {
    int v = (int)x;
    v += __builtin_amdgcn_update_dpp(0, v, 0x111, 0xf, 0xf, false);
    v += __builtin_amdgcn_update_dpp(0, v, 0x112, 0xf, 0xf, false);
    v += __builtin_amdgcn_update_dpp(0, v, 0x114, 0xf, 0xf, false);
    v += __builtin_amdgcn_update_dpp(0, v, 0x118, 0xf, 0xf, false);
    v += __builtin_amdgcn_update_dpp(0, v, 0x142, 0xa, 0xf, false);
    v += __builtin_amdgcn_update_dpp(0, v, 0x143, 0xc, 0xf, false);
    return (unsigned)v;
}

__device__ __forceinline__ float rowsum16(float x) { x += DPPF(x, 0xB1); x += DPPF(x, 0x4E); x += DPPF(x, 0x124); x += DPPF(x, 0x128); return x; }
__device__ __forceinline__ float wave_sum(float x) { x = rowsum16(x); x = xsum16(x); return xsum32(x); }
__device__ __forceinline__ float wave_max(float x) { return wmax_f(x); }
__device__ __forceinline__ int wave_sum_i(int v) { float f = wave_sum((float)v); return (int)(f + 0.5f); }
template <class Src>
__device__ __forceinline__ void cvt_load(const Src& src, int k0, int n0, int lane, float (&tv)[32]) {
#pragma unroll
    for (int i = 0; i < 32; ++i) tv[i] = src(k0 + 2 * i + (lane >> 5), n0 + (lane & 31));
}
__device__ __forceinline__ void cvt_store(const float (&tv)[32], bf16* WT, int K, int k0, int n0, LAS float* scr, int lane) {
#pragma unroll
    for (int i = 0; i < 32; ++i) scr[(2 * i + (lane >> 5)) * 33 + (lane & 31)] = tv[i];
    LDS_WAIT(); asm volatile("" ::: "memory");
    const int c = lane & 7;
#pragma unroll
    for (int j = 0; j < 4; ++j) { const int n = (lane >> 3) + 8 * j; const LAS float* s = scr + (8 * c) * 33 + n;
        v4u o; o.x = pk2(s[0 * 33], s[1 * 33]); o.y = pk2(s[2 * 33], s[3 * 33]); o.z = pk2(s[4 * 33], s[5 * 33]); o.w = pk2(s[6 * 33], s[7 * 33]);
        *(GAS v4u*)(WT + (size_t)(n0 + n) * K + k0 + 8 * c) = o; }
    LDS_WAIT(); asm volatile("" ::: "memory");
}

struct Args { const float* in[22]; float* out; unsigned char* ws; };

using pg8::Unit; using pg8::cvt_pk_bf16;
__device__ __forceinline__ void st_bf16x8(bf16* p, f32x4 v0, f32x4 v1) {
    v4u w; w.x = cvt_pk_bf16(v0[0], v0[1]); w.y = cvt_pk_bf16(v0[2], v0[3]); w.z = cvt_pk_bf16(v1[0], v1[1]); w.w = cvt_pk_bf16(v1[2], v1[3]);
    *(v4u*)p = w;
}
__device__ __forceinline__ void st_f32x8(float* p, f32x4 v0, f32x4 v1) { *(f32x4*)p = v0; *(f32x4*)(p + 4) = v1; }
__device__ __forceinline__ f32x4 sigm4(f32x4 v) { return (f32x4){sigm(v[0]), sigm(v[1]), sigm(v[2]), sigm(v[3])}; }
__device__ __forceinline__ f32x4 silu4(f32x4 v) { return (f32x4){v[0] * sigm(v[0]), v[1] * sigm(v[1]), v[2] * sigm(v[2]), v[3] * sigm(v[3])}; }
__device__ __forceinline__ f32x4 ldbf4(const bf16* p) { const v2u w = *(const v2u*)p; return (f32x4){bflo(w.x), bfhi(w.x), bflo(w.y), bfhi(w.y)}; }

#define EPI_LOOP(...) \
    _Pragma("unroll") for (int ai = 0; ai < 2; ++ai) _Pragma("unroll") for (int m = 0; m < 4; ++m) { const int row = row0 + ai * 128 + m * 16; \
        _Pragma("unroll") for (int bj = 0; bj < 2; ++bj) { const int col = colb + bj * 32; const f32x4 v0 = acc[ai][bj][m][0], v1 = acc[ai][bj][m][1]; __VA_ARGS__ } }

struct EpiProj {
    bf16* QA; bf16* FA; bf16* IA; bf16* GA; bf16* LAT; bf16* GTA; bf16* GTB;
    __device__ __forceinline__ void operator()(const f32x4 (&acc)[2][2][4][2], const Unit& u, int wr, int wc, int fr, int fq) const {
        const int row0 = u.pm * 256 + wr * 64 + fr, pn = u.pn; const int colb = (pn & 3) * 256 + wc * 64 + 8 * fq;
        if (pn < 4)       { EPI_LOOP( st_bf16x8(QA + (size_t)row * 1024 + col, v0, v1); ) }
        else if (pn < 8)  { EPI_LOOP( st_bf16x8(FA + (size_t)row * 1024 + col, v0, v1); ) }
        else if (pn < 12) { EPI_LOOP( st_bf16x8(IA + (size_t)row * 1024 + col, v0, v1); ) }
        else if (pn < 16) { EPI_LOOP( st_bf16x8(GA + (size_t)row * 1024 + col, silu4(v0), silu4(v1)); ) }
        else if (pn < 20) { EPI_LOOP( st_bf16x8(LAT + (size_t)row * 1024 + col, v0, v1); ) }
        else { bf16* G = pn < 28 ? GTA : GTB; const int cb2 = ((pn - 20) & 7) * 256 + wc * 64 + 8 * fq;
            _Pragma("unroll") for (int ai = 0; ai < 2; ++ai) _Pragma("unroll") for (int m = 0; m < 4; ++m) { const int row = row0 + ai * 128 + m * 16;
                _Pragma("unroll") for (int bj = 0; bj < 2; ++bj) st_bf16x8(G + (size_t)row * 2048 + cb2 + bj * 32, sigm4(acc[ai][bj][m][0]), sigm4(acc[ai][bj][m][1])); } }
    }
};
struct EpiQ {
    bf16* QB; bf16* QIDX;
    __device__ __forceinline__ void operator()(const f32x4 (&acc)[2][2][4][2], const Unit& u, int wr, int wc, int fr, int fq) const {
        const int row0 = u.pm * 256 + wr * 64 + fr, pn = u.pn;
        if (pn < 16) { const int colb = pn * 256 + wc * 64 + 8 * fq; EPI_LOOP( st_bf16x8(QB + (size_t)row * 4096 + col, v0, v1); ) }
        else { const int colb = (pn - 16) * 256 + wc * 64 + 8 * fq; EPI_LOOP( st_bf16x8(QIDX + (size_t)row * 1024 + col, v0, v1); ) }
    }
};
struct EpiBf {
    bf16* O; int ldc; int coff;
    __device__ __forceinline__ void operator()(const f32x4 (&acc)[2][2][4][2], const Unit& u, int wr, int wc, int fr, int fq) const {
        const int row0 = u.pm * 256 + wr * 64 + fr; const int colb = coff + u.pn * 256 + wc * 64 + 8 * fq;
        EPI_LOOP( st_bf16x8(O + (size_t)row * ldc + col, v0, v1); )
    }
};
struct HookGate {
    static constexpr bool ON = true; const bf16* GA_; const bf16* GB_;
    __device__ __forceinline__ void mid(f32x4 (&acc)[2][2][4][2], const Unit& u, int wr, int wc, int fr, int fq) const {
        asm volatile("" : "+v"(fr), "+v"(fq));
        const int row0 = u.pm * 256 + wr * 64 + fr; const int colb = u.pn * 256 + wc * 64 + 8 * fq;
#pragma unroll
        for (int ai = 0; ai < 2; ++ai)
#pragma unroll
            for (int m = 0; m < 4; ++m) { const int row = row0 + ai * 128 + m * 16;
#pragma unroll
                for (int bj = 0; bj < 2; ++bj) { const size_t o = (size_t)row * 2048 + colb + bj * 32;
                    const f32x4 a0 = ldbf4(GA_ + o), a1 = ldbf4(GA_ + o + 4), b0 = ldbf4(GB_ + o), b1 = ldbf4(GB_ + o + 4);
                    f32x4 r0, r1;
#pragma unroll
                    for (int j = 0; j < 4; ++j) { r0[j] = a0[j] * __builtin_amdgcn_rcpf(b0[j]); r1[j] = a1[j] * __builtin_amdgcn_rcpf(b1[j]); }
                    acc[ai][bj][m][0] = acc[ai][bj][m][0] * r0; acc[ai][bj][m][1] = acc[ai][bj][m][1] * r1; }
                asm volatile("" : "+v"(acc[ai][0][m][0]), "+v"(acc[ai][0][m][1]), "+v"(acc[ai][1][m][0]), "+v"(acc[ai][1][m][1]));
                if (m & 1) asm volatile("" ::: "memory"); }
    }
};
__device__ __forceinline__ f32x4 cvbf4(v2u w) { return (f32x4){bflo(w.x), bfhi(w.x), bflo(w.y), bfhi(w.y)}; }
struct EpiGateM {
    const bf16* GB_; bf16* MRG_;
    __device__ __forceinline__ void operator()(const f32x4 (&acc)[2][2][4][2], const Unit& u, int wr, int wc, int fr, int fq) const {
        const int row0 = u.pm * 256 + wr * 64 + fr; const int colb = u.pn * 256 + wc * 64 + 8 * fq;
#pragma unroll
        for (int ai = 0; ai < 2; ++ai) { v2u gr[4][2][2];
#pragma unroll
            for (int m = 0; m < 4; ++m)
#pragma unroll
                for (int bj = 0; bj < 2; ++bj) { const size_t o = (size_t)(row0 + ai * 128 + m * 16) * 2048 + colb + bj * 32; gr[m][bj][0] = *(const v2u*)(GB_ + o); gr[m][bj][1] = *(const v2u*)(GB_ + o + 4); }
#pragma unroll
            for (int m = 0; m < 4; ++m)
#pragma unroll
                for (int bj = 0; bj < 2; ++bj) { const size_t o = (size_t)(row0 + ai * 128 + m * 16) * 2048 + colb + bj * 32;
                    st_bf16x8(MRG_ + o, acc[ai][bj][m][0] * cvbf4(gr[m][bj][0]), acc[ai][bj][m][1] * cvbf4(gr[m][bj][1])); } }
    }
};
struct EpiGateA {
    float* T1; const bf16* GT;
    __device__ __forceinline__ void operator()(const f32x4 (&acc)[2][2][4][2], const Unit& u, int wr, int wc, int fr, int fq) const {
        const int row0 = u.pm * 256 + wr * 64 + fr; const int colb = u.pn * 256 + wc * 64 + 8 * fq;
        EPI_LOOP( const size_t o = (size_t)row * 2048 + col; const f32x4 g0 = ldbf4(GT + o), g1 = ldbf4(GT + o + 4); st_f32x8(T1 + o, v0 * g0, v1 * g1); )
    }
};
struct EpiGateB {
    const float* T1; const bf16* GT; bf16* MRG;
    __device__ __forceinline__ void operator()(const f32x4 (&acc)[2][2][4][2], const Unit& u, int wr, int wc, int fr, int fq) const {
        const int row0 = u.pm * 256 + wr * 64 + fr; const int colb = u.pn * 256 + wc * 64 + 8 * fq;
        EPI_LOOP( const size_t o = (size_t)row * 2048 + col; const f32x4 g0 = ldbf4(GT + o), g1 = ldbf4(GT + o + 4); const f32x4 t0 = *(const f32x4*)(T1 + o), t1 = *(const f32x4*)(T1 + o + 4);
                  st_bf16x8(MRG + o, t0 + v0 * g0, t1 + v1 * g1); )
    }
};
struct EpiRes {
    const float* X; const bf16* Hh; bf16* R; const float* md; int osh, osc, ogt;
    __device__ __forceinline__ void operator()(const f32x4 (&acc)[2][2][4][2], const Unit& u, int wr, int wc, int fr, int fq) const {
        const int row0 = u.pm * 256 + wr * 64 + fr; const int colb = u.pn * 256 + wc * 64 + 8 * fq; const float* g = md + (size_t)(u.pm >> 4) * MODW;
        f32x4 gg[2][2];
#pragma unroll
        for (int bj = 0; bj < 2; ++bj) { gg[bj][0] = *(const f32x4*)(g + ogt + colb + bj * 32) + 1.f; gg[bj][1] = *(const f32x4*)(g + ogt + colb + bj * 32 + 4) + 1.f; }
        if (X) {
#pragma unroll
            for (int ai = 0; ai < 2; ++ai)
#pragma unroll
                for (int mh = 0; mh < 2; ++mh) { f32x4 xr[2][2][2];
#pragma unroll
                    for (int mm = 0; mm < 2; ++mm)
#pragma unroll
                        for (int bj = 0; bj < 2; ++bj) { const size_t o = (size_t)(row0 + ai * 128 + (2 * mh + mm) * 16) * 2048 + colb + bj * 32; xr[mm][bj][0] = *(const f32x4*)(X + o); xr[mm][bj][1] = *(const f32x4*)(X + o + 4); }
#pragma unroll
                    for (int mm = 0; mm < 2; ++mm)
#pragma unroll
                        for (int bj = 0; bj < 2; ++bj) { const int m = 2 * mh + mm; const size_t o = (size_t)(row0 + ai * 128 + m * 16) * 2048 + colb + bj * 32;
                            st_bf16x8(R + o, xr[mm][bj][0] * ALPHA + gg[bj][0] * acc[ai][bj][m][0], xr[mm][bj][1] * ALPHA + gg[bj][1] * acc[ai][bj][m][1]); } }
        } else {
            f32x4 ia[2][2], sb[2][2];
#pragma unroll
            for (int bj = 0; bj < 2; ++bj)
#pragma unroll
                for (int hh = 0; hh < 2; ++hh) { const f32x4 sc = *(const f32x4*)(g + osc + colb + bj * 32 + 4 * hh), sh = *(const f32x4*)(g + osh + colb + bj * 32 + 4 * hh);
#pragma unroll
                    for (int e = 0; e < 4; ++e) { ia[bj][hh][e] = ALPHA / (1.f + sc[e]); sb[bj][hh][e] = sh[e] * ia[bj][hh][e]; } }
#pragma unroll
            for (int ai = 0; ai < 2; ++ai) { v2u xr[4][2][2];
#pragma unroll
                for (int m = 0; m < 4; ++m)
#pragma unroll
                    for (int bj = 0; bj < 2; ++bj) { const size_t o = (size_t)(row0 + ai * 128 + m * 16) * 2048 + colb + bj * 32; xr[m][bj][0] = *(const v2u*)(Hh + o); xr[m][bj][1] = *(const v2u*)(Hh + o + 4); }
#pragma unroll
                for (int m = 0; m < 4; ++m)
#pragma unroll
                    for (int bj = 0; bj < 2; ++bj) { const size_t o = (size_t)(row0 + ai * 128 + m * 16) * 2048 + colb + bj * 32;
                        st_bf16x8(R + o, cvbf4(xr[m][bj][0]) * ia[bj][0] - sb[bj][0] + gg[bj][0] * acc[ai][bj][m][0], cvbf4(xr[m][bj][1]) * ia[bj][1] - sb[bj][1] + gg[bj][1] * acc[ai][bj][m][1]); } }
        }
    }
};
struct EpiSwiglu {
    bf16* ACT;
    __device__ __forceinline__ void operator()(const f32x4 (&acc)[2][2][4][2], const Unit& u, int wr, int wc, int fr, int fq) const {
        const int row0 = u.pm * 256 + wr * 64 + fr; const int col = u.pn * 128 + wc * 32 + 8 * fq;
#pragma unroll
        for (int ai = 0; ai < 2; ++ai)
#pragma unroll
            for (int m = 0; m < 4; ++m) { const int row = row0 + ai * 128 + m * 16;
                st_bf16x8(ACT + (size_t)row * DFF + col, silu4(acc[ai][0][m][0]) * acc[ai][1][m][0], silu4(acc[ai][0][m][1]) * acc[ai][1][m][1]); }
    }
};

__global__ void __launch_bounds__(NTHR, 2) fwd_kernel(Args args) {
    extern __shared__ __attribute__((aligned(16))) unsigned char lds_raw[];
    LAS unsigned char* lds = (LAS unsigned char*)lds_raw;
    const int G = gridDim.x, blk = blockIdx.x;
    const int NGW = G * NWAVES, NT = G * NTHR;
    unsigned char* const ws_base = args.ws;
    gu32* ctl = (gu32*)(ws_base + WS_CTL);
    for (int u = threadIdx.x; u < (LDS_BYTES - LDSCTL_OFF) / 4; u += NTHR) ((LAS unsigned*)(lds + LDSCTL_OFF))[u] = 0u;
    __syncthreads();
    volatile LAS unsigned* MISC = (volatile LAS unsigned*)(lds + MISC_OFF);
    const int wave_s = __builtin_amdgcn_readfirstlane((int)(threadIdx.x >> 6));
    XcdBarrier bar = xcd_barrier_post((unsigned*)(ctl + CW_BAR), MISC + 8); bar.wave = wave_s;
    if (threadIdx.x == 0) { unsigned nloc_ = 0u, nx_ = 0u; xcd_barrier_complete(bar.bar, bar.x, nloc_, nx_); bar.st[0] = nloc_; bar.st[1] = nx_; }
    __syncthreads();
#define GRID_BAR() xcd_barrier(bar)

#define x_in ((const float*)(const GAS float*)args.in[0 + z_])
#define c_in ((const float*)(const GAS float*)args.in[1 + z_])
#define w_ada ((const float*)(const GAS float*)args.in[2 + z_])
#define b_ada ((const float*)(const GAS float*)args.in[3 + z_])
#define w_in ((const float*)(const GAS float*)args.in[4 + z_])
#define lb_logits ((const float*)(const GAS float*)args.in[5 + z_])
#define g_hg ((const float*)(const GAS float*)args.in[6 + z_])
#define w_pa ((const float*)(const GAS float*)args.in[7 + z_])
#define g_cq ((const float*)(const GAS float*)args.in[8 + z_])
#define g_ckv ((const float*)(const GAS float*)args.in[9 + z_])
#define w_uq ((const float*)(const GAS float*)args.in[10 + z_])
#define w_iq ((const float*)(const GAS float*)args.in[11 + z_])
#define w_uv ((const float*)(const GAS float*)args.in[12 + z_])
#define w_pb ((const float*)(const GAS float*)args.in[13 + z_])
#define w_out ((const float*)(const GAS float*)args.in[14 + z_])
#define ln1_g ((const float*)(const GAS float*)args.in[15 + z_])
#define ln1_b ((const float*)(const GAS float*)args.in[16 + z_])
#define w_gate ((const float*)(const GAS float*)args.in[17 + z_])
#define w_up ((const float*)(const GAS float*)args.in[18 + z_])
#define w_down ((const float*)(const GAS float*)args.in[19 + z_])
#define ln2_g ((const float*)(const GAS float*)args.in[20 + z_])
#define ln2_b ((const float*)(const GAS float*)args.in[21 + z_])
#define MOD  ((float*)(ws + WS_MOD))
#define LB   ((float*)(ws + WS_LB))
#define MODP ((float*)(ws + WS_MODP))
#define W1   ((bf16*)(ws + WS_W1))
#define W3   ((bf16*)(ws + WS_W3))
#define W6   ((bf16*)(ws + WS_W6))
#define W7   ((bf16*)(ws + WS_W7))
#define W8   ((bf16*)(ws + WS_W8))
#define W10  ((bf16*)(ws + WS_W10))
#define W11  ((bf16*)(ws + WS_W11))
#define XB   ((bf16*)(ws + WS_X))
#define RB   ((bf16*)(ws + WS_R))
#define HB   ((bf16*)(ws + WS_H))
#define QA   ((bf16*)(ws + WS_QA))
#define FA   ((bf16*)(ws + WS_FA))
#define IA   ((bf16*)(ws + WS_IA))
#define GA   ((bf16*)(ws + WS_GA))
#define LAT  ((bf16*)(ws + WS_LAT))
#define GTA  ((bf16*)(ws + WS_GTA))
#define GTB  ((bf16*)(ws + WS_GTB))
#define CQN  ((bf16*)(ws + WS_CQN))
#define CKV  ((bf16*)(ws + WS_CKV))
#define KIDX ((bf16*)(ws + WS_KIDX))
#define IDXW ((float*)(ws + WS_IDXW))
#define QB   ((bf16*)(ws + WS_QB))
#define QIDX ((bf16*)(ws + WS_QIDX))
#define SEL  ((unsigned short*)(ws + WS_SEL))
#define YAB  ((bf16*)(ws + WS_YAB))
#define MRG  ((bf16*)(ws + WS_MRG))
#define OB   ((bf16*)(ws + WS_OB))
#define ISC  ((_Float16*)(ws + WS_BIG))
#define OP   ((float*)(ws + WS_BIG))
#define ACT  ((bf16*)(ws + WS_BIG))
#define KK   LAT
#define modl (MOD + (size_t)l * NBATCH * MODW)
#define KSB  ((bf16*)(ws + WS_KSB))
#define QSB  ((bf16*)(ws + WS_QSB))
#define KVT  ((bf16*)(ws + WS_BIG))
#define SPB  ((bf16*)(ws + WS_FA))
#define DEB  ((float*)(ws + WS_DEB))
#define PHASE_BEGIN { unsigned om_ = ~0u; asm volatile("" : "+s"(om_)); int tid = wave_s * 64 + (int)__builtin_amdgcn_mbcnt_hi(om_, __builtin_amdgcn_mbcnt_lo(om_, 0u)); asm volatile("" : "+v"(tid)); int z_ = 0; asm volatile("" : "+s"(z_)); (void)z_; GAS unsigned char* wsg_ = (GAS unsigned char*)ws_base; asm volatile("" : "+s"(wsg_)); unsigned char* ws = (unsigned char*)wsg_; const int lane = tid & 63, wave = __builtin_amdgcn_readfirstlane(tid >> 6); \
        const int gw = blk * NWAVES + wave, gtid = blk * NTHR + tid; LAS float* wscr = (LAS float*)(lds + wave * 16384); (void)lane; (void)gw; (void)gtid; (void)wscr;
#define PHASE_END }

#define CVT_DECODE(IT_, MID_, K0_, N0_) do { int r_ = (IT_); \
        if (r_ < I1) { MID_ = 0; K0_ = (r_ / (N1 / 32)) * 64; N0_ = (r_ % (N1 / 32)) * 32; } else { r_ -= I1; \
        if (r_ < I3) { MID_ = 1; K0_ = (r_ / (N3 / 32)) * 64; N0_ = (r_ % (N3 / 32)) * 32; } else { r_ -= I3; \
        if (r_ < I6) { MID_ = 2; K0_ = (r_ / 32) * 64; N0_ = (r_ % 32) * 32; } else { r_ -= I6; \
        if (r_ < I7) { MID_ = 3; K0_ = (r_ / (DM / 32)) * 64; N0_ = (r_ % (DM / 32)) * 32; } else { r_ -= I7; \
        if (r_ < I8) { MID_ = 4; K0_ = (r_ / (DM / 32)) * 64; N0_ = (r_ % (DM / 32)) * 32; } else { r_ -= I8; \
        if (r_ < I10) { MID_ = 5; K0_ = (r_ / (N10 / 32)) * 64; N0_ = (r_ % (N10 / 32)) * 32; } else { r_ -= I10; \
        MID_ = 6; K0_ = (r_ / (DM / 32)) * 64; N0_ = (r_ % (DM / 32)) * 32; } } } } } } } while (0)
#define CVT_LOAD(MID_, K0_, N0_, TV_) do { \
        if (MID_ == 0) cvt_load([=](int k, int n) -> float { return n < 4944 ? s_in[(size_t)k * 9040 + n] : (n < 5120 ? 0.f : s_in[(size_t)k * 9040 + n - 176]); }, K0_, N0_, lane, TV_); \
        else if (MID_ == 1) cvt_load([=](int k, int n) -> float { return n < 4096 ? s_uq[(size_t)k * 4096 + n] * 0.0625f : s_iq[(size_t)k * 1024 + n - 4096]; }, K0_, N0_, lane, TV_); \
        else if (MID_ == 2) cvt_load([=](int k, int n) -> float { const int h = n >> 6, v = n & 63, kk = k >> 8, c = k & 255; return kk == (h & 3) ? s_uv[((size_t)h * 256 + c) * 64 + v] : 0.f; }, K0_, N0_, lane, TV_); \
        else if (MID_ == 3) cvt_load([=](int k, int n) -> float { return k < 1024 ? s_pa[(size_t)k * DM + n] : s_pb[(size_t)(k - 1024) * DM + n]; }, K0_, N0_, lane, TV_); \
        else if (MID_ == 4) cvt_load([=](int k, int n) -> float { return s_out[(size_t)k * DM + n]; }, K0_, N0_, lane, TV_); \
        else if (MID_ == 5) cvt_load([=](int k, int n) -> float { const int pn = n >> 8, rr = n & 255, cc = pn * 128 + (rr >> 6) * 32 + (rr & 31); return (rr & 32) ? s_u[(size_t)k * DFF + cc] : s_g[(size_t)k * DFF + cc]; }, K0_, N0_, lane, TV_); \
        else cvt_load([=](int k, int n) -> float { return s_d[(size_t)k * DM + n]; }, K0_, N0_, lane, TV_); } while (0)
#define CONVERT_LAYER(L) do { const int l_ = (L); \
        const float* s_in = w_in + (size_t)l_ * DM * 9040; const float* s_uq = w_uq + (size_t)l_ * SAR * 4096; const float* s_iq = w_iq + (size_t)l_ * SAR * 1024; \
        const float* s_uv = w_uv + (size_t)l_ * 16 * 256 * 64; const float* s_pa = w_pa + (size_t)l_ * 1024 * DM; const float* s_pb = w_pb + (size_t)l_ * 1024 * DM; \
        const float* s_out = w_out + (size_t)l_ * DM * DM; const float* s_g = w_gate + (size_t)l_ * DM * DFF; const float* s_u = w_up + (size_t)l_ * DM * DFF; const float* s_d = w_down + (size_t)l_ * DFF * DM; \
        constexpr int I1 = (DM / 64) * (N1 / 32), I3 = (SAR / 64) * (N3 / 32), I6 = (1024 / 64) * (1024 / 32), I7 = (DM / 64) * (DM / 32), I8 = I7, I10 = (DM / 64) * (N10 / 32), I11 = (DFF / 64) * (DM / 32); \
        constexpr int NIT = I1 + I3 + I6 + I7 + I8 + I10 + I11; \
        float tv_[32]; int mid_ = 0, k0_ = 0, n0_ = 0; \
        { CVT_DECODE(gw, mid_, k0_, n0_); CVT_LOAD(mid_, k0_, n0_, tv_); } \
        for (int it = gw; it < NIT; it += NGW) { \
            float tc_[32]; _Pragma("unroll") for (int i = 0; i < 32; ++i) tc_[i] = tv_[i]; \
            const int mc_ = mid_, kc_ = k0_, nc_ = n0_; \
            { const int itn_ = it + NGW < NIT ? it + NGW : it; CVT_DECODE(itn_, mid_, k0_, n0_); CVT_LOAD(mid_, k0_, n0_, tv_); }     \
            bf16* wt_ = mc_ == 0 ? W1 : mc_ == 1 ? W3 : mc_ == 2 ? W6 : mc_ == 3 ? W7 : mc_ == 4 ? W8 : mc_ == 5 ? W10 : W11; \
            const int kk_ = mc_ == 0 ? DM : mc_ == 1 ? SAR : mc_ == 2 ? 1024 : mc_ == 3 ? DM : mc_ == 4 ? DM : mc_ == 5 ? DM : DFF; \
            cvt_store(tc_, wt_, kk_, kc_, nc_, wscr, lane); \
        } } while (0)


#ifndef HGRN_NAIVE
#define HGRN_NAIVE 0
#endif
#ifndef IDX_NAIVE
#define IDX_NAIVE 0
#endif
#ifndef ATT_NAIVE
#define ATT_NAIVE 0
#endif
#ifndef TOPK_OLD
#define TOPK_OLD 0
#endif
#ifndef REP_HB
#define REP_HB 1
#endif
#ifndef REP_HC
#define REP_HC 1
#endif
#ifndef REP_P4A
#define REP_P4A 1
#endif
#ifndef REP_P5
#define REP_P5 1
#endif
#ifndef REP_P9
#define REP_P9 1
#endif
#ifndef REP_P12
#define REP_P12 1
#endif
#ifndef REP_TOPK
#define REP_TOPK 1
#endif
#ifndef REP_ATT
#define REP_ATT 1
#endif
#ifndef DRY_ATT
#define DRY_ATT 0
#endif
#ifndef REP_M1
#define REP_M1 1
#endif
#ifndef REP_M2
#define REP_M2 1
#endif
#ifndef REP_M3
#define REP_M3 1
#endif

    PHASE_BEGIN
    {
        LAS float* sc = (LAS float*)lds;
        for (int i = tid; i < NBATCH * DM; i += NTHR) { const float v = c_in[i]; sc[i] = v * sigm(v); }
        __syncthreads();
        for (int item = gtid; item < 8 * 12288; item += NT) {
            const int ks = item / 12288, cg = item % 12288, l = cg / 3072, n4 = (cg % 3072) * 4;
            const float* wp = w_ada + ((size_t)l * DM + ks * 256) * MODW + n4;
            f32x4 a0 = {0.f, 0.f, 0.f, 0.f}, a1 = a0, a2 = a0, a3 = a0;
#pragma unroll 8
            for (int k = 0; k < 256; ++k) { const f32x4 w = *(const f32x4*)(wp + (size_t)k * MODW); const int kk = ks * 256 + k;
                a0 += w * sc[kk]; a1 += w * sc[2048 + kk]; a2 += w * sc[4096 + kk]; a3 += w * sc[6144 + kk]; }
            float* o = MODP + ((size_t)(ks * 4 + l) * 4) * MODW + n4;
            *(f32x4*)(o) = a0; *(f32x4*)(o + MODW) = a1; *(f32x4*)(o + 2 * MODW) = a2; *(f32x4*)(o + 3 * MODW) = a3;
        }
        if (gtid < 1024) {
            const float a = lb_logits[gtid], b = lb_logits[1024 + gtid], c = lb_logits[2048 + gtid], d = lb_logits[3072 + gtid];
            const float mx = fmaxf(fmaxf(a, b), fmaxf(c, d)); const float ea = expf(a - mx), eb = expf(b - mx), ec = expf(c - mx), ed = expf(d - mx); const float inv = 1.f / (ea + eb + ec + ed);
            LB[gtid] = 0.f; LB[1024 + gtid] = eb * inv; LB[2048 + gtid] = (eb + ec) * inv; LB[3072 + gtid] = (eb + ec + ed) * inv;
        }
        __syncthreads();
        CONVERT_LAYER(0);
    }
    PHASE_END
    GRID_BAR();
    PHASE_BEGIN
    for (int i = gtid; i < DEPTH * NBATCH * MODW; i += NT) {
        const int l = i / (NBATCH * MODW), r = i % (NBATCH * MODW), b = r / MODW, n = r % MODW;
        float s = b_ada[l * MODW + n];
#pragma unroll
        for (int ks = 0; ks < 8; ++ks) s += MODP[((size_t)(ks * 4 + l) * 4 + b) * MODW + n];
        MOD[i] = s;
    }
    PHASE_END
    GRID_BAR();
    PHASE_BEGIN
    for (size_t i0 = gtid; i0 < (size_t)M * DM / 8; i0 += (size_t)NT * 4) {
        f32x4 xa[4], xb[4], sa[4], sb[4], ha[4], hb[4];
#pragma unroll
        for (int t = 0; t < 4; ++t) { size_t gi = i0 + (size_t)t * NT; gi = gi < (size_t)M * DM / 8 ? gi : (size_t)M * DM / 8 - 1; const size_t e = gi * 8; const int row = (int)(e / DM), col = (int)(e % DM), b = row / SEQ; const float* md = MOD + (size_t)b * MODW;
            xa[t] = *(const f32x4*)(x_in + e); xb[t] = *(const f32x4*)(x_in + e + 4); sa[t] = *(const f32x4*)(md + 2048 + col); sb[t] = *(const f32x4*)(md + 2048 + col + 4); ha[t] = *(const f32x4*)(md + col); hb[t] = *(const f32x4*)(md + col + 4); }
#pragma unroll
        for (int t = 0; t < 4; ++t) { size_t gi = i0 + (size_t)t * NT; gi = gi < (size_t)M * DM / 8 ? gi : (size_t)M * DM / 8 - 1; const size_t e = gi * 8; st_bf16x8(HB + e, xa[t] * (sa[t] + 1.f) + ha[t], xb[t] * (sb[t] + 1.f) + hb[t]); }
    }
    PHASE_END
    GRID_BAR();

    for (int l = 0; l < DEPTH; ++l) {
        PHASE_BEGIN
        { pg8::Gemm g{HB, W1, M, N1, DM, DM, DM, 0}; pg8::StaticOrder S; S.init(M, N1, G, blk);
          EpiProj E{QA, FA, IA, GA, LAT, GTA, GTB}; pg8::gemm_phase(lds, g, S, E, tid); }
        PHASE_END
        GRID_BAR();
        for (int rep_ = 0; rep_ < REP_M1; ++rep_) {
        PHASE_BEGIN
        v2u ra0, ra1, rkv; unsigned short rki, riw;
        const f32x4 g0 = *(const f32x4*)(g_cq + l * 512 + 4 * lane), g1 = *(const f32x4*)(g_cq + l * 512 + 256 + 4 * lane), gk = *(const f32x4*)(g_ckv + l * 256 + 4 * lane);
        { const bf16* lr = LAT + (size_t)gw * 1024; ra0 = *(const v2u*)(lr + 4 * lane); ra1 = *(const v2u*)(lr + 256 + 4 * lane); rkv = *(const v2u*)(lr + 512 + 4 * lane); rki = lr[768 + lane]; riw = lr[832 + (lane & 15)]; }
        for (int row = gw; row < M; row += NGW) {
            const f32x4 a0 = (f32x4){bflo(ra0.x), bfhi(ra0.x), bflo(ra0.y), bfhi(ra0.y)}, a1 = (f32x4){bflo(ra1.x), bfhi(ra1.x), bflo(ra1.y), bfhi(ra1.y)}, kv = (f32x4){bflo(rkv.x), bfhi(rkv.x), bflo(rkv.y), bfhi(rkv.y)};
            const float ki = bf2f(rki), iw = bf2f(riw);
            { const int rn = row + NGW < M ? row + NGW : row; const bf16* lr = LAT + (size_t)rn * 1024;
              ra0 = *(const v2u*)(lr + 4 * lane); ra1 = *(const v2u*)(lr + 256 + 4 * lane); rkv = *(const v2u*)(lr + 512 + 4 * lane); rki = lr[768 + lane]; riw = lr[832 + (lane & 15)]; }
            float sq = a0[0] * a0[0] + a0[1] * a0[1] + a0[2] * a0[2] + a0[3] * a0[3] + a1[0] * a1[0] + a1[1] * a1[1] + a1[2] * a1[2] + a1[3] * a1[3];
            float sk = kv[0] * kv[0] + kv[1] * kv[1] + kv[2] * kv[2] + kv[3] * kv[3];
            sq = wave_sum(sq); sk = wave_sum(sk);
            const float rq = 1.0f / sqrtf(sq * (1.f / 512.f) + 1e-6f), rk = 1.0f / sqrtf(sk * (1.f / 256.f) + 1e-6f);
            v2u o; f32x4 t = a0 * rq * g0; o.x = pk2(t[0], t[1]); o.y = pk2(t[2], t[3]); *(v2u*)(CQN + (size_t)row * 512 + 4 * lane) = o;
            t = a1 * rq * g1; o.x = pk2(t[0], t[1]); o.y = pk2(t[2], t[3]); *(v2u*)(CQN + (size_t)row * 512 + 256 + 4 * lane) = o;
            t = kv * rk * gk; o.x = pk2(t[0], t[1]); o.y = pk2(t[2], t[3]); *(v2u*)(CKV + (size_t)row * 256 + 4 * lane) = o;
            KIDX[(size_t)row * 64 + lane] = (bf16)f2bf(ki);
            if (lane < 16) IDXW[(size_t)row * 16 + lane] = iw * 0.03125f;
        }
        PHASE_END
        PHASE_BEGIN
        {
            const int cp = tid & 63, sg = tid >> 6;
            LAS unsigned char* KST = lds;
            LAS unsigned char* VTL = lds + 18432;
            LAS float* SEGT = (LAS float*)(lds + 36864);
            LAS float* G63 = (LAS float*)(lds + 40960);
            unsigned pfa[8], pq[8], pv[8]; float plb0, plb1;
#define HA_REQ(U_) do { int uu_ = (U_); asm volatile("" : "+s"(uu_)); const int bh_ = uu_ >> 6, c_ = uu_ & 63, b_ = bh_ >> 3, h_ = bh_ & 7; \
                const size_t rowb_ = (size_t)b_ * SEQ + c_ * 64 + sg * 8; const int col_ = h_ * 128 + 2 * cp; \
                _Pragma("unroll") for (int i = 0; i < 8; ++i) { pfa[i] = *(const unsigned*)(FA + (rowb_ + i) * 1024 + col_); pq[i] = *(const unsigned*)(QA + (rowb_ + i) * 1024 + col_); pv[i] = *(const unsigned*)(IA + (rowb_ + i) * 1024 + col_); } plb0 = LB[l * 1024 + col_]; plb1 = LB[l * 1024 + col_ + 1]; } while (0)
            HA_REQ(blk);
            for (int u = blk; u < 2048; u += G) {
                const int bh = u >> 6, c = u & 63, b = bh >> 3, h = bh & 7;
                const size_t rowb = (size_t)b * SEQ + c * 64 + sg * 8; const int col = h * 128 + 2 * cp;
                const float lb0 = plb0, lb1 = plb1;
                float lf0[8], lf1[8], kk0[8], kk1[8]; unsigned cq[8], cv[8];
#pragma unroll
                for (int i = 0; i < 8; ++i) { cq[i] = pq[i]; cv[i] = pv[i]; }
#pragma unroll
                for (int i = 0; i < 8; ++i) { const float2 fa = make_float2(bflo(pfa[i]), bfhi(pfa[i]));
                    const float f0 = fminf(fmaxf(lb0 + (1.f - lb0) * sigm(fa.x), 1e-6f), 1.f), f1 = fminf(fmaxf(lb1 + (1.f - lb1) * sigm(fa.y), 1e-6f), 1.f);
                    lf0[i] = __logf(f0); lf1[i] = __logf(f1); kk0[i] = (1.f - lb0) * sigm(-fa.x); kk1[i] = (1.f - lb1) * sigm(-fa.y); }
#pragma unroll
                for (int i = 1; i < 8; ++i) { lf0[i] += lf0[i - 1]; lf1[i] += lf1[i - 1]; }
                SEGT[sg * 128 + 2 * cp] = lf0[7]; SEGT[sg * 128 + 2 * cp + 1] = lf1[7];
                HA_REQ(u + G < 2048 ? u + G : u);
                __syncthreads();
                float pre0 = 0.f, pre1 = 0.f, r0 = 0.f, r1 = 0.f, t0 = 0.f, t1 = 0.f;
#pragma unroll
                for (int s2 = 0; s2 < 8; ++s2) { const float a0 = SEGT[s2 * 128 + 2 * cp], a1 = SEGT[s2 * 128 + 2 * cp + 1];
                    if (s2 < sg) { pre0 += a0; pre1 += a1; } if (s2 < 4) { r0 += a0; r1 += a1; } t0 += a0; t1 += a1; }
                unsigned ksw0[4], ksw1[4], vw0[4], vw1[4]; float ks0p = 0.f, ks1p = 0.f, v0p = 0.f, v1p = 0.f;
#pragma unroll
                for (int i = 0; i < 8; ++i) {
                    const float b0 = pre0 + lf0[i], b1 = pre1 + lf1[i];
                    const unsigned qw = cq[i]; const unsigned vw = cv[i];
                    const float qs0 = bflo(qw) * __expf(b0 - r0), qs1 = bfhi(qw) * __expf(b1 - r1);
                    const float ks0 = kk0[i] * __expf(r0 - b0), ks1 = kk1[i] * __expf(r1 - b1);
                    *(unsigned*)(QSB + (rowb + i) * 1024 + col) = pk2(qs0, qs1);
                    *(unsigned*)(KSB + (rowb + i) * 1024 + col) = pk2(ks0, ks1);
                    if (i & 1) { ksw0[i >> 1] = pk2(ks0p, ks0); ksw1[i >> 1] = pk2(ks1p, ks1); vw0[i >> 1] = pk2(v0p, bflo(vw)); vw1[i >> 1] = pk2(v1p, bfhi(vw)); }
                    else { ks0p = ks0; ks1p = ks1; v0p = bflo(vw); v1p = bfhi(vw); }
                }
                *(LAS v4u*)(KST + (2 * cp) * 144 + sg * 16) = (v4u){ksw0[0], ksw0[1], ksw0[2], ksw0[3]};
                *(LAS v4u*)(KST + (2 * cp + 1) * 144 + sg * 16) = (v4u){ksw1[0], ksw1[1], ksw1[2], ksw1[3]};
                *(LAS v4u*)(VTL + (2 * cp) * 144 + sg * 16) = (v4u){vw0[0], vw0[1], vw0[2], vw0[3]};
                *(LAS v4u*)(VTL + (2 * cp + 1) * 144 + sg * 16) = (v4u){vw1[0], vw1[1], vw1[2], vw1[3]};
                if (sg == 7) { float* de = DEB + (size_t)u * 256; *(float2*)(de + 2 * cp) = make_float2(__expf(r0), __expf(r1)); *(float2*)(de + 128 + 2 * cp) = make_float2(__expf(t0), __expf(t1));
                    G63[2 * cp] = __expf(t0 - r0); G63[2 * cp + 1] = __expf(t1 - r1); }
                __syncthreads();
                { const int kt = wave >> 1, vt0 = (wave & 1) * 2, lr = lane & 31, lh = lane >> 5;
                  f32x16 acc0, acc1;
#pragma unroll
                  for (int r = 0; r < 16; ++r) { acc0[r] = 0.f; acc1[r] = 0.f; }
#pragma unroll
                  for (int s4 = 0; s4 < 4; ++s4) {
                      const bf16x8 kb = *(const LAS bf16x8*)(KST + (kt * 32 + lr) * 144 + (s4 * 16 + 8 * lh) * 2);
                      const bf16x8 a0 = *(const LAS bf16x8*)(VTL + (vt0 * 32 + lr) * 144 + (s4 * 16 + 8 * lh) * 2);
                      const bf16x8 a1 = *(const LAS bf16x8*)(VTL + ((vt0 + 1) * 32 + lr) * 144 + (s4 * 16 + 8 * lh) * 2);
                      acc0 = __builtin_amdgcn_mfma_f32_32x32x16_bf16(a0, kb, acc0, 0, 0, 0); acc1 = __builtin_amdgcn_mfma_f32_32x32x16_bf16(a1, kb, acc1, 0, 0, 0); }
                  bf16* kvt = KVT + (size_t)u * 16384 + kt * 32 + lr; const float g = G63[kt * 32 + lr];
#pragma unroll
                  for (int r = 0; r < 16; ++r) { const int vv = 8 * (r >> 2) + 4 * lh + (r & 3);
                      kvt[(size_t)(vt0 * 32 + vv) * 128] = (bf16)(pk2(acc0[r] * g, 0.f) & 0xffffu); kvt[(size_t)((vt0 + 1) * 32 + vv) * 128] = (bf16)(pk2(acc1[r] * g, 0.f) & 0xffffu); } }
                __syncthreads();
            }
        }
#undef HA_REQ
        PHASE_END
        GRID_BAR();
        }
        for (int rep_ = 0; rep_ < REP_M2; ++rep_) {
        PHASE_BEGIN
        for (int item = gtid; item < 32 * 4096; item += NT) {
            const int bh = item >> 12, v = (item >> 5) & 127, k4 = (item & 31) * 4;
            f32x4 S = {0.f, 0.f, 0.f, 0.f};
            for (int c0 = 0; c0 < 64; c0 += 8) {
                f32x4 kv[8], dd[8], ee[8];
#pragma unroll
                for (int j = 0; j < 8; ++j) { const size_t u = (size_t)bh * 64 + c0 + j; kv[j] = ldbf4(KVT + u * 16384 + v * 128 + k4); ee[j] = *(const f32x4*)(DEB + u * 256 + k4); dd[j] = *(const f32x4*)(DEB + u * 256 + 128 + k4); }
#pragma unroll
                for (int j = 0; j < 8; ++j) { const size_t u = (size_t)bh * 64 + c0 + j; const f32x4 sp = S * ee[j]; v2u w; w.x = pk2(sp[0], sp[1]); w.y = pk2(sp[2], sp[3]);
                    *(v2u*)(SPB + u * 16384 + v * 128 + k4) = w; S = S * dd[j] + kv[j]; }
            }
        }
        PHASE_END
        PHASE_BEGIN
        { pg8::Gemm g{CQN, W3, M, N3, SAR, SAR, SAR, 0}; pg8::StaticOrder S; S.init(M, N3, G, blk);
          EpiQ E{QB, QIDX}; pg8::gemm_phase(lds, g, S, E, tid); }
        PHASE_END
        GRID_BAR();
        }
        for (int rep_ = 0; rep_ < REP_M3; ++rep_) {
        PHASE_BEGIN
        {
            LAS unsigned char* QSL = lds;
            LAS unsigned char* KSL = lds + 17408;
            LAS unsigned char* VTL = lds + 34816;
            LAS unsigned char* SPL = lds + 53248;
            LAS unsigned char* AL = lds + 88064;
            LAS float* SSQ = (LAS float*)(lds + 97280);
            const int cp = tid & 63, sg = tid >> 6, lr = lane & 31, lh = lane >> 5;
            v4u rq[2], rk[2], rs[4]; unsigned rv[8]; unsigned short rg[16];
#define HC_REQ(U_) do { int uu_ = (U_); asm volatile("" : "+s"(uu_));   const int bh_ = uu_ >> 6, c_ = uu_ & 63, b_ = bh_ >> 3, h_ = bh_ & 7; const size_t row0_ = (size_t)b_ * SEQ + c_ * 64; const int col0_ = h_ * 128; \
                _Pragma("unroll") for (int j = 0; j < 2; ++j) { const int q = tid + 512 * j, rr = q >> 4, cc = q & 15; \
                    rq[j] = *(const v4u*)(QSB + (row0_ + rr) * 1024 + col0_ + cc * 8); rk[j] = *(const v4u*)(KSB + (row0_ + rr) * 1024 + col0_ + cc * 8); } \
                _Pragma("unroll") for (int j = 0; j < 4; ++j) { const int q = tid + 512 * j, rr = q >> 4, cc = q & 15; rs[j] = *(const v4u*)(SPB + (size_t)uu_ * 16384 + rr * 128 + cc * 8); } \
                _Pragma("unroll") for (int i = 0; i < 8; ++i) rv[i] = *(const unsigned*)(IA + (row0_ + sg * 8 + i) * 1024 + col0_ + 2 * cp); \
                { const int it_ = wave >> 2, vt_ = wave & 3; const int colg_ = col0_ + vt_ * 32 + lr; \
                  _Pragma("unroll") for (int r = 0; r < 16; ++r) { const int ii = it_ * 32 + 8 * (r >> 2) + 4 * lh + (r & 3); rg[r] = GA[(row0_ + ii) * 1024 + colg_]; } } } while (0)
            HC_REQ(blk);
            for (int u = blk; u < 2048; u += G) {
                const int bh = u >> 6, c = u & 63, b = bh >> 3, h = bh & 7;
                const size_t row0 = (size_t)b * SEQ + c * 64; const int col0 = h * 128;
#pragma unroll
                for (int j = 0; j < 2; ++j) { const int q = tid + 512 * j, rr = q >> 4, cc = q & 15;
                    *(LAS v4u*)(QSL + rr * 272 + cc * 16) = rq[j]; *(LAS v4u*)(KSL + rr * 272 + cc * 16) = rk[j]; }
#pragma unroll
                for (int j = 0; j < 4; ++j) { const int q = tid + 512 * j, rr = q >> 4, cc = q & 15; *(LAS v4u*)(SPL + rr * 272 + cc * 16) = rs[j]; }
                { unsigned vw0[4], vw1[4]; float v0p = 0.f, v1p = 0.f;
#pragma unroll
                  for (int i = 0; i < 8; ++i) { const unsigned vw = rv[i];
                      if (i & 1) { vw0[i >> 1] = pk2(v0p, bflo(vw)); vw1[i >> 1] = pk2(v1p, bfhi(vw)); } else { v0p = bflo(vw); v1p = bfhi(vw); } }
                  *(LAS v4u*)(VTL + (2 * cp) * 144 + sg * 16) = (v4u){vw0[0], vw0[1], vw0[2], vw0[3]};
                  *(LAS v4u*)(VTL + (2 * cp + 1) * 144 + sg * 16) = (v4u){vw1[0], vw1[1], vw1[2], vw1[3]}; }
                float gav[16];
#pragma unroll
                for (int r = 0; r < 16; ++r) gav[r] = bf2f(rg[r]);
                const float gg = g_hg[l * 1024 + col0 + (wave & 3) * 32 + lr];
                HC_REQ(u + G < 2048 ? u + G : u);
                __syncthreads();
                if (wave < 4) {
                    const int it = wave >> 1, jt = wave & 1;
                    f32x16 acc;
#pragma unroll
                    for (int r = 0; r < 16; ++r) acc[r] = 0.f;
                    if (!(it == 0 && jt == 1)) {
#pragma unroll
                        for (int s8 = 0; s8 < 8; ++s8) {
                            const bf16x8 a = *(const LAS bf16x8*)(QSL + (it * 32 + lr) * 272 + (s8 * 16 + 8 * lh) * 2);
                            const bf16x8 bb = *(const LAS bf16x8*)(KSL + (jt * 32 + lr) * 272 + (s8 * 16 + 8 * lh) * 2);
                            acc = __builtin_amdgcn_mfma_f32_32x32x16_bf16(a, bb, acc, 0, 0, 0); } }
                    const int jj = jt * 32 + lr;
#pragma unroll
                    for (int r = 0; r < 16; ++r) { const int ii = it * 32 + 8 * (r >> 2) + 4 * lh + (r & 3); const float x = (jj <= ii) ? acc[r] : 0.f;
                        *(LAS unsigned short*)(AL + ii * 144 + jj * 2) = (unsigned short)(pk2(x, 0.f) & 0xffffu); }
                }
                __syncthreads();
                { const int it = wave >> 2, vt = wave & 3;
                  f32x16 acc;
#pragma unroll
                  for (int r = 0; r < 16; ++r) acc[r] = 0.f;
#pragma unroll
                  for (int s4 = 0; s4 < 4; ++s4) {
                      const bf16x8 a = *(const LAS bf16x8*)(AL + (it * 32 + lr) * 144 + (s4 * 16 + 8 * lh) * 2);
                      const bf16x8 bb = *(const LAS bf16x8*)(VTL + (vt * 32 + lr) * 144 + (s4 * 16 + 8 * lh) * 2);
                      acc = __builtin_amdgcn_mfma_f32_32x32x16_bf16(a, bb, acc, 0, 0, 0); }
#pragma unroll
                  for (int s8 = 0; s8 < 8; ++s8) {
                      const bf16x8 a = *(const LAS bf16x8*)(QSL + (it * 32 + lr) * 272 + (s8 * 16 + 8 * lh) * 2);
                      const bf16x8 bb = *(const LAS bf16x8*)(SPL + (vt * 32 + lr) * 272 + (s8 * 16 + 8 * lh) * 2);
                      acc = __builtin_amdgcn_mfma_f32_32x32x16_bf16(a, bb, acc, 0, 0, 0); }
#pragma unroll
                  for (int r = 0; r < 16; ++r) { float q2 = acc[r] * acc[r];
                      q2 = xsum16(rowsum16(q2));
                      if (lr == 0) SSQ[vt * 64 + it * 32 + 8 * (r >> 2) + 4 * lh + (r & 3)] = q2; }
                  __syncthreads();
                  const int colg = col0 + vt * 32 + lr;
#pragma unroll
                  for (int r = 0; r < 16; ++r) { const int ii = it * 32 + 8 * (r >> 2) + 4 * lh + (r & 3);
                      const float ss = SSQ[ii] + SSQ[64 + ii] + SSQ[128 + ii] + SSQ[192 + ii]; const float rn = 1.0f / sqrtf(ss * (1.f / 128.f) + 1e-6f);
                      YAB[(row0 + ii) * 2048 + colg] = (bf16)(pk2(acc[r] * rn * gg * gav[r], 0.f) & 0xffffu); }
                }
                __syncthreads();
            }
        }
#undef HC_REQ
        PHASE_END
        PHASE_BEGIN
        for (int ub = blk * NWAVES; ub < 2048; ub += NGW) {
            const int unit = ub + wave;
            const int b = ub >> 9, j = unit & 511, lr = lane & 31, lh = lane >> 5;
            const int qsel = (lr >> 2) & 1, head = (lr >> 3) * 4 + (lr & 3);
            const int qlo = 4 * j, qhi = 4 * (1023 - j);
            const int nlo = ((qlo >> 6) + 1) * 64, nhi = ((qhi >> 6) + 1) * 64;
            const int nlo8 = (nlo + 511) & ~511, nhi8 = (nhi + 511) & ~511;
            const int nmax8 = (((((4 * (1023 - (ub & 511))) >> 6) + 1) * 64) + 511) & ~511;
            bf16x8 A[4][4]; float W[4][16]; typedef float f32x2_t __attribute__((ext_vector_type(2)));
#pragma unroll
            for (int p = 0; p < 4; ++p) { const size_t qb = (size_t)b * SEQ + (p < 2 ? qlo + 2 * p : qhi + 2 * (p - 2));
#pragma unroll
                for (int ks = 0; ks < 4; ++ks) A[p][ks] = *(const bf16x8*)(QIDX + (qb + qsel) * 1024 + head * 64 + ks * 16 + lh * 8);
#pragma unroll
                for (int r4 = 0; r4 < 4; ++r4) { const f32x4 w = *(const f32x4*)(IDXW + (qb + lh) * 16 + r4 * 4); W[p][r4 * 4] = w[0]; W[p][r4 * 4 + 1] = w[1]; W[p][r4 * 4 + 2] = w[2]; W[p][r4 * 4 + 3] = w[3]; } }
            const bf16* kb = KIDX + (size_t)b * SEQ * 64;
            const int srow = 8 * wave + (lane >> 3), spc = ((lane & 7) ^ ((srow >> 1) & 7)) * 8;
#define P4_STAGE(C0_, BUF_) do { _Pragma("unroll") for (int i = 0; i < 4; ++i) \
                __builtin_amdgcn_global_load_lds((const unsigned*)(kb + (size_t)((C0_) + 64 * i + srow) * 64 + spc), (LAS unsigned*)(lds + (BUF_) * 32768 + (i * 8 + wave) * 1024), 16, 0, 0); } while (0)
            P4_STAGE(0, 0);
            asm volatile("s_waitcnt vmcnt(0)" ::: "memory");
            __syncthreads();
            for (int c0 = 0; c0 < nmax8; c0 += 256) {
                const int cb = (c0 >> 8) & 1; const bool more = c0 + 256 < nmax8;
                if (more) P4_STAGE(c0 + 256, cb ^ 1);
                LAS unsigned char* kbuf = lds + cb * 32768;
#pragma unroll 1
                for (int tl = 0; tl < 8; ++tl) {
                    const int s0 = c0 + tl * 32;
                    if (s0 >= nhi8) break;
#pragma unroll
                    for (int p = 0; p < 4; ++p) { const int np = p < 2 ? nlo : nhi, np8 = p < 2 ? nlo8 : nhi8;
                        if (s0 >= np && s0 < np8) { const size_t q = (size_t)b * SEQ + (p < 2 ? qlo + 2 * p : qhi + 2 * (p - 2)) + lh; ISC[q * 4096 + s0 + lr] = (_Float16)(-60000.0f); } }
                    if (s0 >= nhi) continue;
                    bf16x8 B[4];
#pragma unroll
                    for (int ks = 0; ks < 4; ++ks) B[ks] = *(const LAS bf16x8*)(kbuf + (tl * 32 + lr) * 128 + (((2 * ks + lh) ^ ((lr >> 1) & 7)) * 16));
#define IDX_FINISH(P_, ACC_) do { f32x2_t s2_ = {0.f, 0.f};     \
                        _Pragma("unroll") for (int r = 0; r < 16; r += 2) { const float a0_ = ACC_[r], a1_ = ACC_[r + 1]; const int i0_ = __builtin_bit_cast(int, a0_), i1_ = __builtin_bit_cast(int, a1_); \
                            const f32x2_t rl_ = {__builtin_bit_cast(float, i0_ > 0 ? i0_ : 0), __builtin_bit_cast(float, i1_ > 0 ? i1_ : 0)}; const f32x2_t w_ = {W[P_][r], W[P_][r + 1]}; \
                            s2_ = __builtin_elementwise_fma(rl_, w_, s2_); } \
                        const float sc_ = s2_[0] + s2_[1]; \
                        const size_t q_ = (size_t)b * SEQ + ((P_) < 2 ? qlo + 2 * (P_) : qhi + 2 * ((P_) - 2)) + lh; ISC[q_ * 4096 + s0 + lr] = (_Float16)sc_; } while (0)
                    if (s0 < nlo) {
                        f32x16 c0_, c1_, c2_, c3_;
#pragma unroll
                        for (int r = 0; r < 16; ++r) { c0_[r] = 0.f; c1_[r] = 0.f; c2_[r] = 0.f; c3_[r] = 0.f; }
#pragma unroll
                        for (int ks = 0; ks < 4; ++ks) { c0_ = __builtin_amdgcn_mfma_f32_32x32x16_bf16(A[0][ks], B[ks], c0_, 0, 0, 0); c1_ = __builtin_amdgcn_mfma_f32_32x32x16_bf16(A[1][ks], B[ks], c1_, 0, 0, 0);
                            c2_ = __builtin_amdgcn_mfma_f32_32x32x16_bf16(A[2][ks], B[ks], c2_, 0, 0, 0); c3_ = __builtin_amdgcn_mfma_f32_32x32x16_bf16(A[3][ks], B[ks], c3_, 0, 0, 0); }
                        IDX_FINISH(0, c0_); IDX_FINISH(1, c1_); IDX_FINISH(2, c2_); IDX_FINISH(3, c3_);
                    } else {
                        f32x16 c2_, c3_;
#pragma unroll
                        for (int r = 0; r < 16; ++r) { c2_[r] = 0.f; c3_[r] = 0.f; }
#pragma unroll
                        for (int ks = 0; ks < 4; ++ks) { c2_ = __builtin_amdgcn_mfma_f32_32x32x16_bf16(A[2][ks], B[ks], c2_, 0, 0, 0); c3_ = __builtin_amdgcn_mfma_f32_32x32x16_bf16(A[3][ks], B[ks], c3_, 0, 0, 0); }
                        IDX_FINISH(2, c2_); IDX_FINISH(3, c3_);
                    }
#undef IDX_FINISH
                }
                asm volatile("s_waitcnt vmcnt(0)" ::: "memory");
                __syncthreads();
            }
        }
#undef P4_STAGE
        PHASE_END
        GRID_BAR();
        }
        for (int rep_ = 0; rep_ < REP_P5; ++rep_) {
        PHASE_BEGIN
        {
            LAS unsigned char* VB = lds + wave * 18432;
            LAS unsigned short* SELW = (LAS unsigned short*)(VB + 17408);
            const int hd = lane & 15, g = lane >> 4, qq = hd >> 2, pp = hd & 3;
            const float slope = exp2f(-0.5f * (float)(hd + 1));
            for (int q = gw; q < M; q += NGW) {
                const int b = q / SEQ, pos = q % SEQ, qc = pos >> 6; const int nsel = qc < 4 ? (qc + 1) * 64 : 256;
                for (int rtk_ = 0; rtk_ < REP_TOPK; ++rtk_) {
                int lane_t = lane; asm volatile("" : "+v"(lane_t));
                if (qc < 4) { const unsigned e0 = 4 * lane_t; const bool ok = 4 * lane_t < nsel; v2u z; z.x = ok ? (e0 | ((e0 + 1) << 16)) : 0u; z.y = ok ? ((e0 + 2) | ((e0 + 3) << 16)) : 0u; *(LAS v2u*)(SELW + 4 * lane_t) = z; }
                else {
                    LAS unsigned* HIST = (LAS unsigned*)VB;
                    const int nb8 = (qc + 8) >> 3;
                    float v[64];
                    { unsigned pk[32]; const int i2max = 4 * nb8 - 1; const _Float16* irow = ISC + (size_t)q * 4096 + 2 * lane_t; typedef _Float16 h2_t __attribute__((ext_vector_type(2)));
#pragma unroll
                      for (int i2 = 0; i2 < 32; ++i2) { const int ic = i2 < i2max ? i2 : i2max; pk[i2] = *(const unsigned*)(irow + ic * 128); }
#pragma unroll
                      for (int i2 = 0; i2 < 32; ++i2) { const float lim = (i2 >> 2) < nb8 ? 3.0e38f : -1.0e30f; const h2_t h = __builtin_bit_cast(h2_t, pk[i2]);
                          const float f0 = (float)h[0], f1 = (float)h[1]; v[2 * i2] = fminf(f0, lim); v[2 * i2 + 1] = fminf(f1, lim); } }
                    float vmx = v[0], vmn = fminf(fminf(v[0], v[1]), fminf(v[2], v[3]));
#pragma unroll
                    for (int i = 1; i < 64; ++i) vmx = fmaxf(vmx, v[i]);
                    vmx = wmax_f(vmx); vmn = -wmax_f(-vmn);
                    const float rng = vmx - vmn; const float s20 = rng > 0.f ? 1048574.0f / rng : 0.f;
#define ZERO_HIST() do { *(LAS v4u*)(HIST + 16 * lane) = (v4u){0u, 0u, 0u, 0u}; *(LAS v4u*)(HIST + 16 * lane + 4) = (v4u){0u, 0u, 0u, 0u}; *(LAS v4u*)(HIST + 16 * lane + 8) = (v4u){0u, 0u, 0u, 0u}; \
                        *(LAS v4u*)(HIST + 16 * lane + 12) = (v4u){0u, 0u, 0u, 0u}; HIST[1024 + lane] = 0u; } while (0)
#define SCAN_HIST(R_, BIN_, AB_) do { unsigned hh_[16]; const int hb_ = 1008 - 16 * lane; \
                        { const v4u h0 = *(const LAS v4u*)(HIST + hb_), h1 = *(const LAS v4u*)(HIST + hb_ + 4), h2 = *(const LAS v4u*)(HIST + hb_ + 8), h3 = *(const LAS v4u*)(HIST + hb_ + 12); \
                          hh_[0] = h0.x; hh_[1] = h0.y; hh_[2] = h0.z; hh_[3] = h0.w; hh_[4] = h1.x; hh_[5] = h1.y; hh_[6] = h1.z; hh_[7] = h1.w; hh_[8] = h2.x; hh_[9] = h2.y; hh_[10] = h2.z; hh_[11] = h2.w; hh_[12] = h3.x; hh_[13] = h3.y; hh_[14] = h3.z; hh_[15] = h3.w; } \
                        unsigned tot_ = 0u; _Pragma("unroll") for (int k = 0; k < 16; ++k) tot_ += hh_[k]; \
                        unsigned run_ = wprefix_u(tot_) - tot_; int fb_ = -1; unsigned fa_ = 0u; \
                        _Pragma("unroll") for (int k = 15; k >= 0; --k) { if (run_ < (R_) && run_ + hh_[k] >= (R_)) { fb_ = hb_ + k; fa_ = run_; } run_ += hh_[k]; } \
                        const unsigned long long bm_ = __ballot(fb_ >= 0); const int L_ = (int)__builtin_ctzll(bm_); \
                        BIN_ = (unsigned)__builtin_amdgcn_readlane(fb_, L_); AB_ = (unsigned)__builtin_amdgcn_readlane((int)fa_, L_); } while (0)
                    ZERO_HIST();
#pragma unroll
                    for (int i = 0; i < 64; ++i) v[i] = __builtin_bit_cast(float, (unsigned)((v[i] - vmn) * s20));
#define cd(i_) __builtin_bit_cast(unsigned, v[i_])
#pragma unroll
                    for (int g8 = 0; g8 < 8; ++g8) { if (g8 < nb8) {
#pragma unroll
                        for (int j = 0; j < 8; ++j) __hip_atomic_fetch_add(HIST + (cd(g8 * 8 + j) >> 10), 1u, __ATOMIC_RELAXED, __HIP_MEMORY_SCOPE_WORKGROUP); } }
                    LDS_WAIT(); asm volatile("" ::: "memory");
                    unsigned tb, above; SCAN_HIST(256u, tb, above);
                    ZERO_HIST();
                    LDS_WAIT(); asm volatile("" ::: "memory");
#pragma unroll
                    for (int g8 = 0; g8 < 8; ++g8) { if (g8 < nb8) {
#pragma unroll
                        for (int j = 0; j < 8; ++j) { const unsigned c = cd(g8 * 8 + j); const unsigned a = (c >> 10) == tb ? (c & 1023u) : 1024u + lane; __hip_atomic_fetch_add(HIST + a, 1u, __ATOMIC_RELAXED, __HIP_MEMORY_SCOPE_WORKGROUP); } } }
                    LDS_WAIT(); asm volatile("" ::: "memory");
                    unsigned tb2, ab2; { const unsigned R2 = 256u - above; SCAN_HIST(R2, tb2, ab2); }
                    const unsigned T = (tb << 10) | tb2; above += ab2;
                    unsigned baseg = 0u, basee = above;
#pragma unroll
                    for (int g8 = 0; g8 < 8; ++g8) { if (g8 < nb8) {
#pragma unroll
                        for (int j = 0; j < 8; ++j) { const int i = g8 * 8 + j;
                            const bool gt = cd(i) > T; const unsigned long long bg = __ballot(gt);
                            const unsigned pgp = baseg + __builtin_amdgcn_mbcnt_hi((unsigned)(bg >> 32), __builtin_amdgcn_mbcnt_lo((unsigned)bg, 0u));
                            if (gt) SELW[pgp] = (unsigned short)((i >> 1) * 128 + (i & 1) + 2 * lane);
                            baseg += (unsigned)__popcll(bg);
                            const bool eq = cd(i) == T; const unsigned long long be = __ballot(eq);
                            if (be) { const unsigned pep = basee + __builtin_amdgcn_mbcnt_hi((unsigned)(be >> 32), __builtin_amdgcn_mbcnt_lo((unsigned)be, 0u));
                                if (eq && pep < 256u) SELW[pep] = (unsigned short)((i >> 1) * 128 + (i & 1) + 2 * lane);
                                basee += (unsigned)__popcll(be); } } } }
#undef cd
#undef ZERO_HIST
#undef SCAN_HIST
                }
                LDS_WAIT(); asm volatile("" ::: "memory");
                }
                for (int rat_ = 0; rat_ < REP_ATT; ++rat_) {
                bf16* qrow = QB + (size_t)q * 4096;
                bf16x8 Bq[8];
#pragma unroll
                for (int ks = 0; ks < 8; ++ks) Bq[ks] = *(const bf16x8*)(qrow + hd * 256 + ks * 32 + g * 8);
                const bf16* kvb = CKV + (size_t)b * SEQ * 256;
                f32x4 O[16];
#pragma unroll
                for (int ct = 0; ct < 16; ++ct) O[ct] = (f32x4){0.f, 0.f, 0.f, 0.f};
                float mrun = -1.0e30f, lsum = 0.f;
                LDS_WAIT(); asm volatile("" ::: "memory");
                const int nks = nsel >> 5;
                const int lrow = lane >> 5, lcp = lane & 31, lsh = 16 * lrow;
                v4u KR[16];
#define ATT_IDX(KST_) v4u iw_[4]; _Pragma("unroll") for (int c = 0; c < 4; ++c) iw_[c] = *(const LAS v4u*)(SELW + 32 * (KST_) + 8 * c)
#define ATT_LOADROWS(KST_) do { ATT_IDX(KST_); _Pragma("unroll") for (int i = 0; i < 16; ++i) { const int rr_ = 2 * i + lrow; const unsigned w_ = iw_[i >> 2][i & 3]; const int ix_ = (int)((w_ >> lsh) & 0xffffu); \
                    KR[i] = *(const v4u*)(kvb + (size_t)ix_ * 256 + ((lcp ^ (rr_ & 7)) * 8)); } } while (0)
                ATT_LOADROWS(0);
                const int rlA = hd & 7;
                const int rlT = (4 * g + qq) & 7;
                const int trb = (4 * g + qq) * 512 + 8 * (pp & 1), trm = 16 * ((pp >> 1) ^ rlT);
                for (int kst = 0; kst < nks; ++kst) {
                    int rlA_ = rlA, trm_ = trm; asm volatile("" : "+v"(rlA_), "+v"(trm_));
                    if (kst + 1 < nks) {
                        ATT_IDX(kst + 1);
#pragma unroll
                        for (int i = 0; i < 16; ++i) { *(LAS v4u*)(VB + i * 1024 + lane * 16) = KR[i];
                            const int rr_ = 2 * i + lrow; const unsigned w_ = iw_[i >> 2][i & 3]; const int ix_ = (int)((w_ >> lsh) & 0xffffu); KR[i] = *(const v4u*)(kvb + (size_t)ix_ * 256 + ((lcp ^ (rr_ & 7)) * 8)); }
                    } else {
#pragma unroll
                        for (int i = 0; i < 16; ++i) *(LAS v4u*)(VB + i * 1024 + lane * 16) = KR[i]; }
                    LDS_WAIT(); asm volatile("" ::: "memory");
                    f32x4 S0 = {0.f, 0.f, 0.f, 0.f}, S1 = {0.f, 0.f, 0.f, 0.f};
#pragma unroll
                    for (int k4 = 0; k4 < 4; ++k4) {
                        bf16x8 a0[2], a1[2];
#pragma unroll
                        for (int j = 0; j < 2; ++j) { const int ks = k4 * 2 + j; const int cpos = (4 * ks + g) ^ rlA_;
                            a0[j] = *(const LAS bf16x8*)(VB + hd * 512 + cpos * 16); a1[j] = *(const LAS bf16x8*)(VB + (16 + hd) * 512 + cpos * 16); }
#pragma unroll
                        for (int j = 0; j < 2; ++j) { const int ks = k4 * 2 + j;
                            S0 = __builtin_amdgcn_mfma_f32_16x16x32_bf16(a0[j], Bq[ks], S0, 0, 0, 0); S1 = __builtin_amdgcn_mfma_f32_16x16x32_bf16(a1[j], Bq[ks], S1, 0, 0, 0); }
                    }
                    const v2u pa = *(const LAS v2u*)(SELW + 32 * kst + 4 * g), pb = *(const LAS v2u*)(SELW + 32 * kst + 16 + 4 * g);
                    const float fp = (float)pos;
                    float s0[4], s1[4];
                    s0[0] = S0[0] - slope * fabsf(fp - (float)(pa.x & 0xffffu)); s0[1] = S0[1] - slope * fabsf(fp - (float)(pa.x >> 16));
                    s0[2] = S0[2] - slope * fabsf(fp - (float)(pa.y & 0xffffu)); s0[3] = S0[3] - slope * fabsf(fp - (float)(pa.y >> 16));
                    s1[0] = S1[0] - slope * fabsf(fp - (float)(pb.x & 0xffffu)); s1[1] = S1[1] - slope * fabsf(fp - (float)(pb.x >> 16));
                    s1[2] = S1[2] - slope * fabsf(fp - (float)(pb.y & 0xffffu)); s1[3] = S1[3] - slope * fabsf(fp - (float)(pb.y >> 16));
                    float ml = fmaxf(fmaxf(fmaxf(s0[0], s0[1]), fmaxf(s0[2], s0[3])), fmaxf(fmaxf(s1[0], s1[1]), fmaxf(s1[2], s1[3])));
                    ml = xmax16(ml); ml = xmax32(ml);
                    const float mnew = fmaxf(mrun, ml), alpha = __expf(mrun - mnew); mrun = mnew;
                    float p0[4], p1[4];
#pragma unroll
                    for (int r = 0; r < 4; ++r) { p0[r] = __expf(s0[r] - mnew); p1[r] = __expf(s1[r] - mnew); }
                    lsum = lsum * alpha + ((p0[0] + p0[1]) + (p0[2] + p0[3])) + ((p1[0] + p1[1]) + (p1[2] + p1[3]));
                    v4u pw; pw.x = pk2(p0[0], p0[1]); pw.y = pk2(p0[2], p0[3]); pw.z = pk2(p1[0], p1[1]); pw.w = pk2(p1[2], p1[3]);
                    const bf16x8 Pf = __builtin_bit_cast(bf16x8, pw);
#pragma unroll
                    for (int ct = 0; ct < 16; ++ct) O[ct] = O[ct] * alpha;
#pragma unroll
                    for (int c8 = 0; c8 < 4; ++c8) {
                        v4s lo[4], hi[4];
#pragma unroll
                        for (int j = 0; j < 4; ++j) { const int ct = c8 * 4 + j; const int off = trb + ((32 * ct) ^ trm_);
                            lo[j] = __builtin_amdgcn_ds_read_tr16_b64_v4i16((LAS v4s*)(VB + off));
                            hi[j] = __builtin_amdgcn_ds_read_tr16_b64_v4i16((LAS v4s*)(VB + 16 * 512 + off)); }
#pragma unroll
                        for (int j = 0; j < 4; ++j) { const int ct = c8 * 4 + j;
                            const bf16x8 Af = {lo[j][0], lo[j][1], lo[j][2], lo[j][3], hi[j][0], hi[j][1], hi[j][2], hi[j][3]};
                            O[ct] = __builtin_amdgcn_mfma_f32_16x16x32_bf16(Af, Pf, O[ct], 0, 0, 0); }
                    }
                    LDS_WAIT(); asm volatile("" ::: "memory");
                }
#undef ATT_LOADROWS
#undef ATT_IDX
                lsum = xsum16(lsum); lsum = xsum32(lsum);
                const float inv = 1.0f / lsum;
#pragma unroll
                for (int ct = 0; ct < 16; ++ct) { const f32x4 o = O[ct] * inv; v2u w; w.x = pk2(o[0], o[1]); w.y = pk2(o[2], o[3]); *(v2u*)(OB + (size_t)q * 4096 + hd * 256 + 16 * ct + 4 * g) = w; }
                }
            }
        }
        PHASE_END
        GRID_BAR();
        }
        PHASE_BEGIN
        { pg8::Gemm g{OB, W6, M, 1024, 1024, 4096, 1024, 1024}; pg8::StaticOrder S; S.init(M, 1024, G, blk);
          EpiBf E{YAB, 2048, 1024}; pg8::gemm_phase(lds, g, S, E, tid); }
        PHASE_END
        GRID_BAR();
        PHASE_BEGIN
        { pg8::Gemm g{YAB, W7, M, DM, DM, DM, DM, 0}; pg8::StaticOrder S; S.init(M, DM, G, blk);
          EpiGateM E{GTB, MRG}; HookGate Hk{GTA, GTB}; pg8::gemm_phase(lds, g, S, E, tid, Hk); }
        PHASE_END
        GRID_BAR();
        PHASE_BEGIN
        { pg8::Gemm g{MRG, W8, M, DM, DM, DM, DM, 0}; pg8::StaticOrder S; S.init(M, DM, G, blk);
          EpiRes E{(l == 0) ? x_in : (const float*)nullptr, HB, RB, modl, 0, DM, 2 * DM}; pg8::gemm_phase(lds, g, S, E, tid); }
        PHASE_END
        GRID_BAR();
        for (int rep_ = 0; rep_ < REP_P9; ++rep_) {
        PHASE_BEGIN
        f32x4 lg[8], lb_[8]; v2u nx[8];
#pragma unroll
        for (int j = 0; j < 8; ++j) { const int c = j * 256 + lane * 4; lg[j] = *(const f32x4*)(ln1_g + l * DM + c); lb_[j] = *(const f32x4*)(ln1_b + l * DM + c); nx[j] = *(const v2u*)(RB + (size_t)gw * DM + c); }
        for (int row = gw; row < M; row += NGW) {
            const int b = row / SEQ; const float* md = modl + (size_t)b * MODW;
            f32x4 v[8]; float s = 0.f;
#pragma unroll
            for (int j = 0; j < 8; ++j) { v[j] = (f32x4){bflo(nx[j].x), bfhi(nx[j].x), bflo(nx[j].y), bfhi(nx[j].y)}; s += (v[j][0] + v[j][1]) + (v[j][2] + v[j][3]); }
            { const int rn = row + NGW < M ? row + NGW : row;
#pragma unroll
              for (int j = 0; j < 8; ++j) nx[j] = *(const v2u*)(RB + (size_t)rn * DM + j * 256 + lane * 4); }
            f32x4 msc[8], msh[8];
#pragma unroll
            for (int j = 0; j < 8; ++j) { const int c = j * 256 + lane * 4; msc[j] = *(const f32x4*)(md + 4 * DM + c); msh[j] = *(const f32x4*)(md + 3 * DM + c); }
            const float mean = wave_sum(s) * (1.f / DM); float s2 = 0.f;
#pragma unroll
            for (int j = 0; j < 8; ++j) { v[j] = v[j] - mean; s2 += (v[j][0] * v[j][0] + v[j][1] * v[j][1]) + (v[j][2] * v[j][2] + v[j][3] * v[j][3]); }
            const float rstd = 1.0f / sqrtf(wave_sum(s2) * (1.f / DM) + 1e-5f);
#pragma unroll
            for (int j = 0; j < 8; ++j) { const int c = j * 256 + lane * 4; const f32x4 gg = lg[j], bb = lb_[j];
                const f32x4 y = v[j] * rstd * gg + bb;
                const f32x4 sc = msc[j], sh = msh[j]; const f32x4 hh = y * (sc + 1.f) + sh;
                v2u w; w.x = pk2(hh[0], hh[1]); w.y = pk2(hh[2], hh[3]); *(v2u*)(HB + (size_t)row * DM + c) = w; }
        }
        PHASE_END
        GRID_BAR();
        }
        PHASE_BEGIN
        { pg8::Gemm g{HB, W10, M, N10, DM, DM, DM, 0}; pg8::StaticOrder S; S.init(M, N10, G, blk);
          EpiSwiglu E{ACT}; pg8::gemm_phase(lds, g, S, E, tid); }
        PHASE_END
        GRID_BAR();
        PHASE_BEGIN
        { pg8::Gemm g{ACT, W11, M, DM, DFF, DFF, DFF, 0}; pg8::StaticOrder S; S.init(M, DM, G, blk);
          EpiRes E{(const float*)nullptr, HB, RB, modl, 3 * DM, 4 * DM, 5 * DM}; pg8::gemm_phase(lds, g, S, E, tid); }
        PHASE_END
        GRID_BAR();
        for (int rep_ = 0; rep_ < REP_P12; ++rep_) {
        PHASE_BEGIN
        {
            const bool lastl = (l == DEPTH - 1); const float* mdn = MOD + (size_t)(l + 1 < DEPTH ? l + 1 : l) * NBATCH * MODW;
            f32x4 lg[8], lb_[8]; v2u nx[8];
#pragma unroll
            for (int j = 0; j < 8; ++j) { const int c = j * 256 + lane * 4; lg[j] = *(const f32x4*)(ln2_g + l * DM + c); lb_[j] = *(const f32x4*)(ln2_b + l * DM + c); nx[j] = *(const v2u*)(RB + (size_t)gw * DM + c); }
            for (int row = gw; row < M; row += NGW) {
                const int b = row / SEQ; const float* md = mdn + (size_t)b * MODW;
                f32x4 v[8]; float s = 0.f;
#pragma unroll
                for (int j = 0; j < 8; ++j) { v[j] = (f32x4){bflo(nx[j].x), bfhi(nx[j].x), bflo(nx[j].y), bfhi(nx[j].y)}; s += (v[j][0] + v[j][1]) + (v[j][2] + v[j][3]); }
                { const int rn = row + NGW < M ? row + NGW : row;
#pragma unroll
                  for (int j = 0; j < 8; ++j) nx[j] = *(const v2u*)(RB + (size_t)rn * DM + j * 256 + lane * 4); }
                f32x4 msc[8], msh[8];
#pragma unroll
                for (int j = 0; j < 8; ++j) { const int c = j * 256 + lane * 4; msc[j] = *(const f32x4*)(md + DM + c); msh[j] = *(const f32x4*)(md + c); }
                const float mean = wave_sum(s) * (1.f / DM); float s2 = 0.f;
#pragma unroll
                for (int j = 0; j < 8; ++j) { v[j] = v[j] - mean; s2 += (v[j][0] * v[j][0] + v[j][1] * v[j][1]) + (v[j][2] * v[j][2] + v[j][3] * v[j][3]); }
                const float rstd = 1.0f / sqrtf(wave_sum(s2) * (1.f / DM) + 1e-5f);
#pragma unroll
                for (int j = 0; j < 8; ++j) { const int c = j * 256 + lane * 4; const f32x4 gg = lg[j], bb = lb_[j];
                    const f32x4 y = v[j] * rstd * gg + bb;
                    if (lastl) *(f32x4*)(args.out + (size_t)row * DM + c) = y;
                    else { const f32x4 sc = msc[j], sh = msh[j]; const f32x4 hh = y * (sc + 1.f) + sh;
                        v2u w; w.x = pk2(hh[0], hh[1]); w.y = pk2(hh[2], hh[3]); *(v2u*)(HB + (size_t)row * DM + c) = w; } }
            }
            if (l + 1 < DEPTH) { __syncthreads(); CONVERT_LAYER(l + 1); }
        }
        PHASE_END
        if (l + 1 < DEPTH || rep_ + 1 < REP_P12) GRID_BAR();
        }
    }
}

extern "C" void kernel_launch(void* const* d_in, const int* in_sizes, int n_in, void* d_out, int out_size, void* d_ws, size_t ws_size, hipStream_t stream) {
    static int grid = 0;
    if (grid == 0) {
        if (n_in != 22 || out_size != M * DM || ws_size < WS_END) { fprintf(stderr, "kernel_launch: unexpected shapes (n_in %d, out %d, ws %zu < %zu)\n", n_in, out_size, ws_size, (size_t)WS_END); grid = -1; return; }
        int dev = 0, cus = 0, per_cu = 0;
        if (hipGetDevice(&dev) != hipSuccess || hipDeviceGetAttribute(&cus, hipDeviceAttributeMultiprocessorCount, dev) != hipSuccess) { grid = -1; return; }
        if (hipFuncSetAttribute((const void*)fwd_kernel, hipFuncAttributeMaxDynamicSharedMemorySize, LDS_BYTES) != hipSuccess) { fprintf(stderr, "kernel_launch: hipFuncSetAttribute failed\n"); grid = -1; return; }
        if (hipOccupancyMaxActiveBlocksPerMultiprocessor(&per_cu, (const void*)fwd_kernel, NTHR, LDS_BYTES) != hipSuccess || per_cu < 1) { fprintf(stderr, "kernel_launch: occupancy query says %d\n", per_cu); }
        (void)hipGetLastError();
        grid = cus;
    }
    if (grid < 0) return;
    if (hipMemsetAsync((char*)d_ws + WS_CTL, 0, CTL_ZERO_BYTES, stream) != hipSuccess) return;
    Args a{};
    for (int i = 0; i < 22; ++i) a.in[i] = (const float*)d_in[i];
    a.out = (float*)d_out; a.ws = (unsigned char*)d_ws;
    hipLaunchKernelGGL(fwd_kernel, dim3(grid), dim3(NTHR), LDS_BYTES, stream, a);
}
```

```cpp
#include <hip/hip_runtime.h>
#include <cstdio>
#include <cstdint>

namespace pg8 {
#define PG8_LAS __attribute__((address_space(3)))
typedef unsigned short bf16_t;
typedef short bf16x8 __attribute__((ext_vector_type(8)));
typedef float f32x4 __attribute__((ext_vector_type(4)));
typedef unsigned u32x4 __attribute__((ext_vector_type(4)));
constexpr int BM = 256, BK = 64, HALF = 128, HTB = HALF * BK * 2, STAGE_BYTES = 8 * HTB, NXCD = 8, WGM = 8;

__host__ __device__ __forceinline__ int lds_byte(int r, int c) { const int st = (r >> 4) * 2 + (c >> 5), rr = r & 15, cc = c & 31, ob = rr * 64 + cc * 2; return st * 1024 + (ob ^ (((ob >> 9) & 1) << 5)); }
__host__ __device__ __forceinline__ void stage_rc(int b, int& R, int& C) { const int st = b / 1024, sb = b % 1024, swz = sb ^ (((sb >> 9) & 1) << 5); R = (st >> 1) * 16 + swz / 64; C = (st & 1) * 32 + (swz % 64) / 2; }
__host__ __device__ __forceinline__ int perm32(int rho) { const int n = rho >> 4, i = rho & 15; return 8 * (i >> 2) + 4 * n + (i & 3); }

struct Unit { int pm, pn; };
struct Gemm { const bf16_t* A; const bf16_t* Bt; int M, N, K, lda, ldb, a_pn_stride; };

struct StaticOrder {
    int nM, nN, nwg, G, c;
    __host__ __device__ void init(int M, int N, int G_, int c_) { nM = M / BM; nN = N / BM; nwg = nM * nN; G = G_; c = c_; }
    __host__ __device__ bool next(int i, Unit& u) const {
        const long L = (long)i * G + c; if (L >= nwg) return false;
        int wgid = (int)L; { const int q = nwg / NXCD, r = nwg % NXCD, xcd = wgid % NXCD, off = wgid / NXCD; wgid = (xcd < r ? xcd * (q + 1) : r * (q + 1) + (xcd - r) * q) + off; }
        const int nig = WGM * nN, gid = wgid / nig, fm = gid * WGM, gsz = (nM - fm) < WGM ? (nM - fm) : WGM;
        u.pm = fm + ((wgid % nig) % gsz); u.pn = (wgid % nig) / gsz; return true;
    }
};

typedef float f32x2_t __attribute__((ext_vector_type(2))); typedef __bf16 bf16x2_t __attribute__((ext_vector_type(2)));
__device__ __forceinline__ unsigned cvt_pk_bf16(float lo, float hi) { f32x2_t v = {lo, hi}; bf16x2_t b = __builtin_convertvector(v, bf16x2_t); return __builtin_bit_cast(unsigned, b); }

struct NoHook { static constexpr bool ON = false; template <class A> __device__ __forceinline__ void mid(A&, const Unit&, int, int, int, int) const {} };
template <class Epi, class Hook = NoHook>
__device__ __forceinline__ void gemm_phase(PG8_LAS unsigned char* lds, const Gemm g, const StaticOrder& S, const Epi& E, const int tid, const Hook H = Hook()) {
    const int wid = __builtin_amdgcn_readfirstlane(tid >> 6), lane = tid & 63, wr = wid >> 2, wc = wid & 3, fr = lane & 15, fq = lane >> 4;
    const int K = g.K, nt = K / BK;
    unsigned voffA[2], voffB[2];
#pragma unroll
    for (int i = 0; i < 2; ++i) { int R, C; stage_rc(tid * 16 + i * 8192, R, C); const int Rb = 64 * (R >> 5) + perm32(R & 31);
        voffA[i] = (unsigned)(R * g.lda + C) * 2u; voffB[i] = (unsigned)(Rb * g.ldb + C) * 2u; }
    const size_t kstep = (size_t)(BK * 2);
    const size_t hstepA = (size_t)HALF * g.lda * 2, hstepB = (size_t)32 * g.ldb * 2;
    const size_t tstepA = 2 * hstepA, tstepB = (size_t)BM * g.ldb * 2;
    const unsigned ldsw = (unsigned)wid * 1024u;
    const int aoff = lds_byte(wr * 64 + fr, fq * 8), boff = lds_byte(wc * 32 + fr, fq * 8);
#define PG8_SA(b, h) (((b) * 2 + (h)) * HTB)
#define PG8_SB(b, h) ((4 + (b) * 2 + (h)) * HTB)
#define PG8_STAGE(bufoff, gbase, voff) do { _Pragma("unroll") for (int _i = 0; _i < 2; ++_i) \
        __builtin_amdgcn_global_load_lds((const unsigned*)((const char*)(gbase) + (voff)[_i]), (PG8_LAS unsigned*)(lds + (bufoff) + ldsw + _i * 8192), 16, 0, 0); } while (0)
#define PG8_LDA(dst, b, h) do { _Pragma("unroll") for (int m = 0; m < 4; ++m) _Pragma("unroll") for (int k = 0; k < 2; ++k) dst[m][k] = *(const PG8_LAS bf16x8*)(lds + PG8_SA(b, h) + aoff + m * 2048 + k * 1024); } while (0)
#define PG8_LDB(dst, b, h) do { _Pragma("unroll") for (int n = 0; n < 2; ++n) _Pragma("unroll") for (int k = 0; k < 2; ++k) dst[n][k] = *(const PG8_LAS bf16x8*)(lds + PG8_SB(b, h) + boff + n * 2048 + k * 1024); } while (0)
#define PG8_MMA(ai, bj, At, Bt) do { __builtin_amdgcn_s_setprio(1); _Pragma("unroll") for (int m = 0; m < 4; ++m) _Pragma("unroll") for (int n = 0; n < 2; ++n) _Pragma("unroll") for (int k = 0; k < 2; ++k) \
        acc[ai][bj][m][n] = __builtin_amdgcn_mfma_f32_16x16x32_bf16(Bt[n][k], At[m][k], acc[ai][bj][m][n], 0, 0, 0); __builtin_amdgcn_s_setprio(0); } while (0)
#define PG8_WAIT_V(n) asm volatile("s_waitcnt vmcnt(" #n ")" ::: "memory")
#define PG8_WAIT_L(n) asm volatile("s_waitcnt lgkmcnt(" #n ")" ::: "memory")
#define PG8_BAR __builtin_amdgcn_s_barrier()
#define PG8_SCHED __builtin_amdgcn_sched_barrier(0)
    Unit cur, nxt; int ui = 0;
    if (!S.next(0, cur)) return;
    f32x4 acc[2][2][4][2];
#pragma unroll
    for (int a = 0; a < 2; ++a)
#pragma unroll
        for (int b = 0; b < 2; ++b)
#pragma unroll
            for (int m = 0; m < 4; ++m)
#pragma unroll
                for (int n = 0; n < 2; ++n) acc[a][b][m][n] = (f32x4){0.f, 0.f, 0.f, 0.f};
    bf16x8 At[4][2], B0[2][2], B1[2][2];
    const char* cA = (const char*)g.A + (size_t)cur.pm * tstepA + (size_t)cur.pn * g.a_pn_stride * 2; const char* cB = (const char*)g.Bt + (size_t)cur.pn * tstepB;
    PG8_STAGE(PG8_SB(0, 0), cB, voffB); PG8_STAGE(PG8_SB(0, 1), cB + hstepB, voffB); PG8_STAGE(PG8_SA(0, 0), cA, voffA); PG8_STAGE(PG8_SA(0, 1), cA + hstepA, voffA);
    if (wr == 1) PG8_BAR;
    PG8_WAIT_V(2); PG8_BAR;
    PG8_STAGE(PG8_SB(1, 0), cB + kstep, voffB); PG8_STAGE(PG8_SA(1, 0), cA + kstep, voffA); PG8_STAGE(PG8_SB(1, 1), cB + hstepB + kstep, voffB);
    PG8_WAIT_V(6); PG8_BAR;
    for (;;) {
        const bool has_next = S.next(ui + 1, nxt);
        const char* nA = has_next ? (const char*)g.A + (size_t)nxt.pm * tstepA + (size_t)nxt.pn * g.a_pn_stride * 2 : cA; const char* nB = has_next ? (const char*)g.Bt + (size_t)nxt.pn * tstepB : cB;
        for (int t = 0; t < nt; t += 2) {
            const bool last = (t == nt - 2);
            const char* a1 = cA + (size_t)(t + 1) * kstep;
            const char* a2 = last ? nA : cA + (size_t)(t + 2) * kstep; const char* b2 = last ? nB : cB + (size_t)(t + 2) * kstep;
            const char* a3 = a2 + kstep; const char* b3 = b2 + kstep;
            if constexpr (Hook::ON) { if (t == (nt >> 1)) H.mid(acc, cur, wr, wc, fr, fq); }
            PG8_LDB(B0, 0, 0); PG8_LDB(B1, 0, 1); PG8_SCHED; PG8_LDA(At, 0, 0); PG8_STAGE(PG8_SA(1, 1), a1 + hstepA, voffA);
            PG8_WAIT_V(8); PG8_WAIT_L(0); PG8_BAR; PG8_MMA(0, 0, At, B0); PG8_MMA(0, 1, At, B1); PG8_BAR; PG8_SCHED;
            PG8_LDA(At, 0, 1); PG8_STAGE(PG8_SB(0, 0), b2, voffB); PG8_STAGE(PG8_SB(0, 1), b2 + hstepB, voffB); PG8_STAGE(PG8_SA(0, 0), a2, voffA);
            PG8_WAIT_V(8); PG8_WAIT_L(0); PG8_BAR; PG8_MMA(1, 0, At, B0); PG8_MMA(1, 1, At, B1); PG8_BAR; PG8_SCHED;
            PG8_LDB(B0, 1, 0); PG8_LDB(B1, 1, 1); PG8_SCHED; PG8_LDA(At, 1, 0); PG8_STAGE(PG8_SA(0, 1), a2 + hstepA, voffA);
            PG8_WAIT_V(8); PG8_WAIT_L(0); PG8_BAR; PG8_MMA(0, 0, At, B0); PG8_MMA(0, 1, At, B1); PG8_BAR; PG8_SCHED;
            PG8_LDA(At, 1, 1); PG8_STAGE(PG8_SB(1, 0), b3, voffB); PG8_STAGE(PG8_SB(1, 1), b3 + hstepB, voffB); PG8_STAGE(PG8_SA(1, 0), a3, voffA);
            PG8_WAIT_V(8); PG8_WAIT_L(0); PG8_BAR; PG8_MMA(1, 0, At, B0); PG8_MMA(1, 1, At, B1); PG8_BAR; PG8_SCHED;
        }
        if (wr == 0) PG8_BAR;
        E(acc, cur, wr, wc, fr, fq);
        if (!has_next) break;
#pragma unroll
        for (int a = 0; a < 2; ++a)
#pragma unroll
            for (int b = 0; b < 2; ++b)
#pragma unroll
                for (int m = 0; m < 4; ++m)
#pragma unroll
                    for (int n = 0; n < 2; ++n) acc[a][b][m][n] = (f32x4){0.f, 0.f, 0.f, 0.f};
        cur = nxt; cA = nA; cB = nB; ++ui;
        if (wr == 1) PG8_BAR;
    }
    PG8_WAIT_V(0);
    PG8_BAR;
#undef PG8_SA
#undef PG8_SB
#undef PG8_STAGE
#undef PG8_LDA
#undef PG8_LDB
#undef PG8_MMA
#undef PG8_WAIT_V
#undef PG8_WAIT_L
#undef PG8_BAR
#undef PG8_SCHED
}
}

constexpr int NWAVES = 8, NTHR = NWAVES * 64;
constexpr int DM = 2048, NBATCH = 4, SEQ = 4096, DEPTH = 4, M = NBATCH * SEQ;
constexpr int HGW = 1024;
constexpr int SAH = 16, SAC = 256, SAR = 512;
constexpr int DFF = 5632;
constexpr int N1 = 9216, N3 = 5120, N10 = 2 * DFF;
constexpr float ALPHA = 1.6817928305074292f;
constexpr int MODW = 6 * DM;

constexpr size_t MiB = 1u << 20;
constexpr size_t WS_CTL = 0, CTL_ZERO_BYTES = 32768;
constexpr size_t WS_MOD = 1 * MiB;
constexpr size_t WS_LB = 2 * MiB;
constexpr size_t WS_MODP = 3 * MiB;
constexpr size_t WS_W1 = 9 * MiB;
constexpr size_t WS_W3 = WS_W1 + 36 * MiB;
constexpr size_t WS_W6 = WS_W3 + 5 * MiB;
constexpr size_t WS_W7 = WS_W6 + 2 * MiB;
constexpr size_t WS_W8 = WS_W7 + 8 * MiB;
constexpr size_t WS_W10 = WS_W8 + 8 * MiB;
constexpr size_t WS_W11 = WS_W10 + 44 * MiB;
constexpr size_t WS_X = WS_W11 + 22 * MiB;
constexpr size_t WS_R = WS_X + 128 * MiB;
constexpr size_t WS_H = WS_R + 128 * MiB;
constexpr size_t WS_QA = WS_H + 64 * MiB;
constexpr size_t WS_FA = WS_QA + 32 * MiB;
constexpr size_t WS_IA = WS_FA + 64 * MiB;
constexpr size_t WS_GA = WS_IA + 32 * MiB;
constexpr size_t WS_LAT = WS_GA + 32 * MiB;
constexpr size_t WS_GTA = WS_LAT + 64 * MiB;
constexpr size_t WS_GTB = WS_GTA + 64 * MiB;
constexpr size_t WS_CQN = WS_GTB + 64 * MiB;
constexpr size_t WS_CKV = WS_CQN + 16 * MiB;
constexpr size_t WS_KIDX = WS_CKV + 8 * MiB;
constexpr size_t WS_IDXW = WS_KIDX + 2 * MiB;
constexpr size_t WS_QB = WS_IDXW + 1 * MiB;
constexpr size_t WS_QIDX = WS_QB + 128 * MiB;
constexpr size_t WS_SEL = WS_QIDX + 32 * MiB;
constexpr size_t WS_YAB = WS_SEL + 8 * MiB;
constexpr size_t WS_MRG = WS_FA;
constexpr size_t WS_OB = WS_YAB + 64 * MiB;
constexpr size_t WS_BIG = WS_OB + 128 * MiB;
constexpr size_t WS_KSB = WS_BIG + 256 * MiB;
constexpr size_t WS_DEB = WS_KSB + 32 * MiB;
constexpr size_t WS_QSB = WS_DEB + 2 * MiB;
constexpr size_t WS_END = WS_QSB + 32 * MiB;

constexpr int CW_BAR = 4096;

constexpr int RING_BYTES = 131072;
constexpr int LDS_BYTES = 163840;
constexpr int LDSCTL_OFF = LDS_BYTES - 1024, MISC_OFF = LDSCTL_OFF + 320, SELL_OFF = 147456;

#define GAS __attribute__((address_space(1)))
#define LAS __attribute__((address_space(3)))
typedef unsigned short bf16;
typedef unsigned v4u __attribute__((ext_vector_type(4)));
typedef unsigned v2u __attribute__((ext_vector_type(2)));
typedef float f32x4 __attribute__((ext_vector_type(4)));
typedef float f32x16 __attribute__((ext_vector_type(16)));
typedef short bf16x8 __attribute__((ext_vector_type(8)));
typedef short v4s __attribute__((ext_vector_type(4)));
typedef GAS unsigned gu32;
#define LDS_WAIT() asm volatile("s_waitcnt lgkmcnt(0)" ::: "memory")
__device__ __forceinline__ unsigned f2bf(float f) { unsigned u = __builtin_bit_cast(unsigned, f); return (u + 0x7fffu + ((u >> 16) & 1u)) >> 16; }
__device__ __forceinline__ unsigned pk2(float lo, float hi) { return pg8::cvt_pk_bf16(lo, hi); }
__device__ __forceinline__ float bf2f(unsigned short b) { return __builtin_bit_cast(float, ((unsigned)b) << 16); }
__device__ __forceinline__ float bflo(unsigned w) { return __builtin_bit_cast(float, w << 16); }
__device__ __forceinline__ float bfhi(unsigned w) { return __builtin_bit_cast(float, w & 0xffff0000u); }
__device__ __forceinline__ float sigm(float x) { return __builtin_amdgcn_rcpf(1.f + __expf(-x)); }

__device__ __forceinline__ int lane_id() { unsigned m = ~0u; asm volatile("" : "+s"(m)); return (int)__builtin_amdgcn_mbcnt_hi(m, __builtin_amdgcn_mbcnt_lo(m, 0u)); }
#define XB_TMO      128
#define XB_XCNT(j)  (256  + 64 * (j))
#define XB_XSUB(j)  (1280 + 64 * (j))
#define XB_XGEN(j)  (2304 + 64 * (j))
#define XB_TOP      3328
#define XB_TOPGEN   3392
#define XCD_BAR_WORDS 3456
#define XB_SPIN_CAP (1u << 22)

__device__ __forceinline__ unsigned xb_ld(unsigned* p)              { return __hip_atomic_load(p, __ATOMIC_RELAXED, __HIP_MEMORY_SCOPE_AGENT); }
__device__ __forceinline__ unsigned xb_add(unsigned* p, unsigned v) { return __hip_atomic_fetch_add(p, v, __ATOMIC_RELAXED, __HIP_MEMORY_SCOPE_AGENT); }
__device__ __forceinline__ unsigned xb_xcc_id() { return (unsigned)__builtin_amdgcn_s_getreg((3 << 11) | 20) & 0xFu; }
#define XB_SPIN(cond, bar) do { unsigned _sp = 0; while (cond) { __builtin_amdgcn_s_sleep(1); \
    if ((++_sp & 255u) == 0u) { if (xb_ld(&(bar)[XB_TMO])) break; if (_sp > XB_SPIN_CAP) { atomicAdd(&(bar)[XB_TMO], 1u); break; } } } } while (0)

struct XcdBarrier { unsigned* bar; unsigned x; volatile LAS unsigned* st; int wave; };

__device__ __forceinline__ XcdBarrier xcd_barrier_post(unsigned* bar, volatile LAS unsigned* st) {
    XcdBarrier b; b.bar = bar; b.x = (unsigned)__builtin_amdgcn_readfirstlane((int)xb_xcc_id()); b.st = st;
    if (threadIdx.x == 0) (void)xb_add(&bar[XB_XCNT(b.x)], 1u);
    return b;
}
__device__ __forceinline__ void xcd_barrier_complete(unsigned* bar, unsigned x, unsigned& nloc, unsigned& nx) {
    const unsigned G = gridDim.x * gridDim.y * gridDim.z;
    unsigned sum, cnt, mine, sp = 0u;
    for (;;) {
        sum = 0u; cnt = 0u; mine = 0u;
#pragma unroll 1
        for (unsigned j = 0; j < 16; ++j) { const unsigned c = xb_ld(&bar[XB_XCNT(j)]); sum += c; cnt += (c > 0u) ? 1u : 0u; mine = (j == x) ? c : mine; }
        if (sum == G) break;
        __builtin_amdgcn_s_sleep(1);
        if ((++sp & 255u) == 0u) { if (xb_ld(&bar[XB_TMO])) break; if (sp > XB_SPIN_CAP) { atomicAdd(&bar[XB_TMO], 1u); break; } }
    }
    nloc = mine > 0u ? mine : 1u; nx = cnt > 0u ? cnt : 1u;
}
__device__ __forceinline__ void xcd_barrier(const XcdBarrier& b) {
    asm volatile("s_waitcnt vmcnt(0)" ::: "memory");
    __syncthreads();
    if (b.wave == 0 && lane_id() == 0) {
        unsigned* bar = b.bar;
        unsigned bx = b.x; asm volatile("" : "+s"(bx));
        __builtin_amdgcn_s_waitcnt(0);
        unsigned nloc = b.st[0], nx = b.st[1];
        const unsigned old = xb_add(&bar[XB_XSUB(bx)], 1u);
        const unsigned gen = old / nloc;
        if (old + 1u == (gen + 1u) * nloc) {
            __builtin_amdgcn_fence(__ATOMIC_RELEASE, "agent");
            asm volatile("s_waitcnt vmcnt(0)" ::: "memory");
            const unsigned og = xb_add(&bar[XB_TOP], 1u);
            const unsigned tg = og / nx;
            if (og + 1u == (tg + 1u) * nx) xb_add(&bar[XB_TOPGEN], 1u);
            else XB_SPIN(xb_ld(&bar[XB_TOPGEN]) == tg, bar);
            __builtin_amdgcn_fence(__ATOMIC_ACQUIRE, "agent");
            xb_add(&bar[XB_XGEN(bx)], 1u);
            asm volatile("s_waitcnt vmcnt(0)" ::: "memory");
        } else {
            XB_SPIN(xb_ld(&bar[XB_XGEN(bx)]) == gen, bar);
            __builtin_amdgcn_fence(__ATOMIC_ACQUIRE, "agent");
            asm volatile("s_waitcnt vmcnt(0)" ::: "memory");
        }
    }
    __syncthreads();
}

__device__ __forceinline__ void xswap16(float& a, float& b) { asm volatile("s_nop 1\n\tv_permlane16_swap_b32 %0, %1\n\ts_nop 1" : "+v"(a), "+v"(b)); }
__device__ __forceinline__ void xswap32(float& a, float& b) { asm volatile("s_nop 1\n\tv_permlane32_swap_b32 %0, %1\n\ts_nop 1" : "+v"(a), "+v"(b)); }
__device__ __forceinline__ float xmax16(float x) { float a = x, b = x; xswap16(a, b); return fmaxf(a, b); }
__device__ __forceinline__ float xmax32(float x) { float a = x, b = x; xswap32(a, b); return fmaxf(a, b); }
__device__ __forceinline__ float xsum16(float x) { float a = x, b = x; xswap16(a, b); return a + b; }
__device__ __forceinline__ float xsum32(float x) { float a = x, b = x; xswap32(a, b); return a + b; }

#define DPPF(x, ctrl) __builtin_bit_cast(float, __builtin_amdgcn_update_dpp(0, __builtin_bit_cast(int, (x)), (ctrl), 0xf, 0xf, true))
__device__ __forceinline__ float wmax_f(float x) {
    x = fmaxf(x, DPPF(x, 0xB1)); x = fmaxf(x, DPPF(x, 0x4E)); x = fmaxf(x, DPPF(x, 0x124)); x = fmaxf(x, DPPF(x, 0x128));
    x = xmax16(x); return xmax32(x);
}
__device__ __forceinline__ unsigned wprefix_u(unsigned x) {
    int v = (int)x;
    v += __builtin_amdgcn_update_dpp(0, v, 0x111, 0xf, 0xf, false);
    v += __builtin_amdgcn_update_dpp(0, v, 0x112, 0xf, 0xf, false);
    v += __builtin_amdgcn_update_dpp(0, v, 0x114, 0xf, 0xf, false);
    v += __builtin_amdgcn_update_dpp(0, v, 0x118, 0xf, 0xf, false);
    v += __builtin_amdgcn_update_dpp(0, v, 0x142, 0xa, 0xf, false);
    v += __builtin_amdgcn_update_dpp(0, v, 0x143, 0xc, 0xf, false);
    return (unsigned)v;
}

__device__ __forceinline__ float rowsum16(float x) { x += DPPF(x, 0xB1); x += DPPF(x, 0x4E); x += DPPF(x, 0x124); x += DPPF(x, 0x128); return x; }
__device__ __forceinline__ float wave_sum(float x) { x = rowsum16(x); x = xsum16(x); return xsum32(x); }
__device__ __forceinline__ float wave_max(float x) { return wmax_f(x); }
__device__ __forceinline__ int wave_sum_i(int v) { float f = wave_sum((float)v); return (int)(f + 0.5f); }
template <class Src>
__device__ __forceinline__ void cvt_load(const Src& src, int k0, int n0, int lane, float (&tv)[32]) {
#pragma unroll
    for (int i = 0; i < 32; ++i) tv[i] = src(k0 + 2 * i + (lane >> 5), n0 + (lane & 31));
}
__device__ __forceinline__ void cvt_store(const float (&tv)[32], bf16* WT, int K, int k0, int n0, LAS float* scr, int lane) {
#pragma unroll
    for (int i = 0; i < 32; ++i) scr[(2 * i + (lane >> 5)) * 33 + (lane & 31)] = tv[i];
    LDS_WAIT(); asm volatile("" ::: "memory");
    const int c = lane & 7;
#pragma unroll
    for (int j = 0; j < 4; ++j) { const int n = (lane >> 3) + 8 * j; const LAS float* s = scr + (8 * c) * 33 + n;
        v4u o; o.x = pk2(s[0 * 33], s[1 * 33]); o.y = pk2(s[2 * 33], s[3 * 33]); o.z = pk2(s[4 * 33], s[5 * 33]); o.w = pk2(s[6 * 33], s[7 * 33]);
        *(GAS v4u*)(WT + (size_t)(n0 + n) * K + k0 + 8 * c) = o; }
    LDS_WAIT(); asm volatile("" ::: "memory");
}

struct Args { const float* in[22]; float* out; unsigned char* ws; };

using pg8::Unit; using pg8::cvt_pk_bf16;
__device__ __forceinline__ void st_bf16x8(bf16* p, f32x4 v0, f32x4 v1) {
    v4u w; w.x = cvt_pk_bf16(v0[0], v0[1]); w.y = cvt_pk_bf16(v0[2], v0[3]); w.z = cvt_pk_bf16(v1[0], v1[1]); w.w = cvt_pk_bf16(v1[2], v1[3]);
    *(v4u*)p = w;
}
__device__ __forceinline__ void st_f32x8(float* p, f32x4 v0, f32x4 v1) { *(f32x4*)p = v0; *(f32x4*)(p + 4) = v1; }
__device__ __forceinline__ f32x4 sigm4(f32x4 v) { return (f32x4){sigm(v[0]), sigm(v[1]), sigm(v[2]), sigm(v[3])}; }
__device__ __forceinline__ f32x4 silu4(f32x4 v) { return (f32x4){v[0] * sigm(v[0]), v[1] * sigm(v[1]), v[2] * sigm(v[2]), v[3] * sigm(v[3])}; }
__device__ __forceinline__ f32x4 ldbf4(const bf16* p) { const v2u w = *(const v2u*)p; return (f32x4){bflo(w.x), bfhi(w.x), bflo(w.y), bfhi(w.y)}; }

#define EPI_LOOP(...) \
    _Pragma("unroll") for (int ai = 0; ai < 2; ++ai) _Pragma("unroll") for (int m = 0; m < 4; ++m) { const int row = row0 + ai * 128 + m * 16; \
        _Pragma("unroll") for (int bj = 0; bj < 2; ++bj) { const int col = colb + bj * 32; const f32x4 v0 = acc[ai][bj][m][0], v1 = acc[ai][bj][m][1]; __VA_ARGS__ } }

__device__ __forceinline__ unsigned q8x4(f32x4 g) { unsigned w = 0u;
#pragma unroll
    for (int e = 0; e < 4; ++e) { const float t = fmaxf(__builtin_fmaf(g[e], 255.f, 0.5f), 1.f); w |= ((unsigned)t) << (8 * e); } return w; }
__device__ __forceinline__ f32x4 ub4(unsigned w) { return (f32x4){(float)(w & 0xffu), (float)((w >> 8) & 0xffu), (float)((w >> 16) & 0xffu), (float)(w >> 24)}; }
struct EpiProj {
    bf16* QA; bf16* FA; bf16* IA; bf16* GA; bf16* LAT; bf16* GTA; bf16* GTB;
    __device__ __forceinline__ void operator()(const f32x4 (&acc)[2][2][4][2], const Unit& u, int wr, int wc, int fr, int fq) const {
        const int row0 = u.pm * 256 + wr * 64 + fr, pn = u.pn; const int colb = (pn & 3) * 256 + wc * 64 + 8 * fq;
        if (pn < 4)       { EPI_LOOP( st_bf16x8(QA + (size_t)row * 1024 + col, v0, v1); ) }
        else if (pn < 8)  { EPI_LOOP( st_bf16x8(FA + (size_t)row * 1024 + col, v0, v1); ) }
        else if (pn < 12) { EPI_LOOP( st_bf16x8(IA + (size_t)row * 1024 + col, v0, v1); ) }
        else if (pn < 16) { EPI_LOOP( st_bf16x8(GA + (size_t)row * 1024 + col, silu4(v0), silu4(v1)); ) }
        else if (pn < 20) { EPI_LOOP( st_bf16x8(LAT + (size_t)row * 1024 + col, v0, v1); ) }
        else { unsigned char* G8 = (unsigned char*)(pn < 28 ? GTA : GTB) + ((size_t)(u.pm * 8 + ((pn - 20) & 7)) * 8 + (wr * 4 + wc)) * 8192 + (fq * 16 + fr) * 16;
            _Pragma("unroll") for (int ai = 0; ai < 2; ++ai) _Pragma("unroll") for (int bj = 0; bj < 2; ++bj) _Pragma("unroll") for (int mp = 0; mp < 2; ++mp) { v4u w;
                w.x = q8x4(sigm4(acc[ai][bj][2 * mp][0])); w.y = q8x4(sigm4(acc[ai][bj][2 * mp][1])); w.z = q8x4(sigm4(acc[ai][bj][2 * mp + 1][0])); w.w = q8x4(sigm4(acc[ai][bj][2 * mp + 1][1]));
                *(v4u*)(G8 + (ai * 4 + bj * 2 + mp) * 1024) = w; } }
    }
};
struct EpiQ {
    bf16* QB; bf16* QIDX;
    __device__ __forceinline__ void operator()(const f32x4 (&acc)[2][2][4][2], const Unit& u, int wr, int wc, int fr, int fq) const {
        const int row0 = u.pm * 256 + wr * 64 + fr, pn = u.pn;
        if (pn < 16) { const int colb = pn * 256 + wc * 64 + 8 * fq; EPI_LOOP( st_bf16x8(QB + (size_t)row * 4096 + col, v0, v1); ) }
        else { const int colb = (pn - 16) * 256 + wc * 64 + 8 * fq; EPI_LOOP( st_bf16x8(QIDX + (size_t)row * 1024 + col, v0, v1); ) }
    }
};
struct EpiBf {
    bf16* O; int ldc; int coff;
    __device__ __forceinline__ void operator()(const f32x4 (&acc)[2][2][4][2], const Unit& u, int wr, int wc, int fr, int fq) const {
        const int row0 = u.pm * 256 + wr * 64 + fr; const int colb = coff + u.pn * 256 + wc * 64 + 8 * fq;
        EPI_LOOP( st_bf16x8(O + (size_t)row * ldc + col, v0, v1); )
    }
};
struct HookGate {
    static constexpr bool ON = true; const bf16* GA_; const bf16* GB_;
    __device__ __forceinline__ void mid(f32x4 (&acc)[2][2][4][2], const Unit& u, int wr, int wc, int fr, int fq) const {
        asm volatile("" : "+v"(fr), "+v"(fq));
        const size_t off = ((size_t)(u.pm * 8 + u.pn) * 8 + (wr * 4 + wc)) * 8192 + (fq * 16 + fr) * 16;
        const unsigned char* A8 = (const unsigned char*)GA_ + off; const unsigned char* B8 = (const unsigned char*)GB_ + off;
#pragma unroll
        for (int ai = 0; ai < 2; ++ai)
#pragma unroll
            for (int mp = 0; mp < 2; ++mp) {
#pragma unroll
                for (int bj = 0; bj < 2; ++bj) { const v4u a = *(const v4u*)(A8 + (ai * 4 + bj * 2 + mp) * 1024), b = *(const v4u*)(B8 + (ai * 4 + bj * 2 + mp) * 1024);
#pragma unroll
                    for (int mm = 0; mm < 2; ++mm)
#pragma unroll
                        for (int n = 0; n < 2; ++n) { const unsigned aw = a[mm * 2 + n], bw = b[mm * 2 + n]; const f32x4 fa = ub4(aw), fb = ub4(bw); f32x4 r;
#pragma unroll
                            for (int j = 0; j < 4; ++j) r[j] = fa[j] * __builtin_amdgcn_rcpf(fb[j]);
                            acc[ai][bj][2 * mp + mm][n] = acc[ai][bj][2 * mp + mm][n] * r; } }
                asm volatile("" : "+v"(acc[ai][0][2 * mp][0]), "+v"(acc[ai][0][2 * mp][1]), "+v"(acc[ai][1][2 * mp][0]), "+v"(acc[ai][1][2 * mp][1]));
                asm volatile("" : "+v"(acc[ai][0][2 * mp + 1][0]), "+v"(acc[ai][0][2 * mp + 1][1]), "+v"(acc[ai][1][2 * mp + 1][0]), "+v"(acc[ai][1][2 * mp + 1][1]));
                asm volatile("" ::: "memory"); }
    }
};
__device__ __forceinline__ f32x4 cvbf4(v2u w) { return (f32x4){bflo(w.x), bfhi(w.x), bflo(w.y), bfhi(w.y)}; }
struct EpiGateM {
    const bf16* GB_; bf16* MRG_;
    __device__ __forceinline__ void operator()(const f32x4 (&acc)[2][2][4][2], const Unit& u, int wr, int wc, int fr, int fq) const {
        const int row0 = u.pm * 256 + wr * 64 + fr; const int colb = u.pn * 256 + wc * 64 + 8 * fq;
        const unsigned char* B8 = (const unsigned char*)GB_ + ((size_t)(u.pm * 8 + u.pn) * 8 + (wr * 4 + wc)) * 8192 + (fq * 16 + fr) * 16;
#pragma unroll
        for (int ai = 0; ai < 2; ++ai) { v4u gr[2][2];
#pragma unroll
            for (int bj = 0; bj < 2; ++bj)
#pragma unroll
                for (int mp = 0; mp < 2; ++mp) gr[bj][mp] = *(const v4u*)(B8 + (ai * 4 + bj * 2 + mp) * 1024);
#pragma unroll
            for (int m = 0; m < 4; ++m)
#pragma unroll
                for (int bj = 0; bj < 2; ++bj) { const size_t o = (size_t)(row0 + ai * 128 + m * 16) * 2048 + colb + bj * 32;
                    const unsigned w0 = gr[bj][m >> 1][(m & 1) * 2], w1 = gr[bj][m >> 1][(m & 1) * 2 + 1];
                    st_bf16x8(MRG_ + o, acc[ai][bj][m][0] * (ub4(w0) * (1.f / 255.f)), acc[ai][bj][m][1] * (ub4(w1) * (1.f / 255.f))); } }
    }
};
struct EpiGateA {
    float* T1; const bf16* GT;
    __device__ __forceinline__ void operator()(const f32x4 (&acc)[2][2][4][2], const Unit& u, int wr, int wc, int fr, int fq) const {
        const int row0 = u.pm * 256 + wr * 64 + fr; const int colb = u.pn * 256 + wc * 64 + 8 * fq;
        EPI_LOOP( const size_t o = (size_t)row * 2048 + col; const f32x4 g0 = ldbf4(GT + o), g1 = ldbf4(GT + o + 4); st_f32x8(T1 + o, v0 * g0, v1 * g1); )
    }
};
struct EpiGateB {
    const float* T1; const bf16* GT; bf16* MRG;
    __device__ __forceinline__ void operator()(const f32x4 (&acc)[2][2][4][2], const Unit& u, int wr, int wc, int fr, int fq) const {
        const int row0 = u.pm * 256 + wr * 64 + fr; const int colb = u.pn * 256 + wc * 64 + 8 * fq;
        EPI_LOOP( const size_t o = (size_t)row * 2048 + col; const f32x4 g0 = ldbf4(GT + o), g1 = ldbf4(GT + o + 4); const f32x4 t0 = *(const f32x4*)(T1 + o), t1 = *(const f32x4*)(T1 + o + 4);
                  st_bf16x8(MRG + o, t0 + v0 * g0, t1 + v1 * g1); )
    }
};
struct EpiRes {
    const float* X; const bf16* Hh; bf16* R; const float* md; int osh, osc, ogt;
    __device__ __forceinline__ void operator()(const f32x4 (&acc)[2][2][4][2], const Unit& u, int wr, int wc, int fr, int fq) const {
        const int row0 = u.pm * 256 + wr * 64 + fr; const int colb = u.pn * 256 + wc * 64 + 8 * fq; const float* g = md + (size_t)(u.pm >> 4) * MODW;
        f32x4 gg[2][2];
#pragma unroll
        for (int bj = 0; bj < 2; ++bj) { gg[bj][0] = *(const f32x4*)(g + ogt + colb + bj * 32) + 1.f; gg[bj][1] = *(const f32x4*)(g + ogt + colb + bj * 32 + 4) + 1.f; }
        if (X) {
#pragma unroll
            for (int ai = 0; ai < 2; ++ai)
#pragma unroll
                for (int mh = 0; mh < 2; ++mh) { f32x4 xr[2][2][2];
#pragma unroll
                    for (int mm = 0; mm < 2; ++mm)
#pragma unroll
                        for (int bj = 0; bj < 2; ++bj) { const size_t o = (size_t)(row0 + ai * 128 + (2 * mh + mm) * 16) * 2048 + colb + bj * 32; xr[mm][bj][0] = *(const f32x4*)(X + o); xr[mm][bj][1] = *(const f32x4*)(X + o + 4); }
#pragma unroll
                    for (int mm = 0; mm < 2; ++mm)
#pragma unroll
                        for (int bj = 0; bj < 2; ++bj) { const int m = 2 * mh + mm; const size_t o = (size_t)(row0 + ai * 128 + m * 16) * 2048 + colb + bj * 32;
                            st_bf16x8(R + o, xr[mm][bj][0] * ALPHA + gg[bj][0] * acc[ai][bj][m][0], xr[mm][bj][1] * ALPHA + gg[bj][1] * acc[ai][bj][m][1]); } }
        } else {
            f32x4 ia[2][2], sb[2][2];
#pragma unroll
            for (int bj = 0; bj < 2; ++bj)
#pragma unroll
                for (int hh = 0; hh < 2; ++hh) { const f32x4 sc = *(const f32x4*)(g + osc + colb + bj * 32 + 4 * hh), sh = *(const f32x4*)(g + osh + colb + bj * 32 + 4 * hh);
#pragma unroll
                    for (int e = 0; e < 4; ++e) { ia[bj][hh][e] = ALPHA / (1.f + sc[e]); sb[bj][hh][e] = sh[e] * ia[bj][hh][e]; } }
#pragma unroll
            for (int ai = 0; ai < 2; ++ai) { v2u xr[4][2][2];
#pragma unroll
                for (int m = 0; m < 4; ++m)
#pragma unroll
                    for (int bj = 0; bj < 2; ++bj) { const size_t o = (size_t)(row0 + ai * 128 + m * 16) * 2048 + colb + bj * 32; xr[m][bj][0] = *(const v2u*)(Hh + o); xr[m][bj][1] = *(const v2u*)(Hh + o + 4); }
#pragma unroll
                for (int m = 0; m < 4; ++m)
#pragma unroll
                    for (int bj = 0; bj < 2; ++bj) { const size_t o = (size_t)(row0 + ai * 128 + m * 16) * 2048 + colb + bj * 32;
                        st_bf16x8(R + o, cvbf4(xr[m][bj][0]) * ia[bj][0] - sb[bj][0] + gg[bj][0] * acc[ai][bj][m][0], cvbf4(xr[m][bj][1]) * ia[bj][1] - sb[bj][1] + gg[bj][1] * acc[ai][bj][m][1]); } }
        }
    }
};
struct EpiSwiglu {
    bf16* ACT;
    __device__ __forceinline__ void operator()(const f32x4 (&acc)[2][2][4][2], const Unit& u, int wr, int wc, int fr, int fq) const {
        const int row0 = u.pm * 256 + wr * 64 + fr; const int col = u.pn * 128 + wc * 32 + 8 * fq;
#pragma unroll
        for (int ai = 0; ai < 2; ++ai)
#pragma unroll
            for (int m = 0; m < 4; ++m) { const int row = row0 + ai * 128 + m * 16;
                st_bf16x8(ACT + (size_t)row * DFF + col, silu4(acc[ai][0][m][0]) * acc[ai][1][m][0], silu4(acc[ai][0][m][1]) * acc[ai][1][m][1]); }
    }
};

__global__ void __launch_bounds__(NTHR, 2) fwd_kernel(Args args) {
    extern __shared__ __attribute__((aligned(16))) unsigned char lds_raw[];
    LAS unsigned char* lds = (LAS unsigned char*)lds_raw;
    const int G = gridDim.x, blk = blockIdx.x;
    const int NGW = G * NWAVES, NT = G * NTHR;
    unsigned char* const ws_base = args.ws;
    gu32* ctl = (gu32*)(ws_base + WS_CTL);
    for (int u = threadIdx.x; u < (LDS_BYTES - LDSCTL_OFF) / 4; u += NTHR) ((LAS unsigned*)(lds + LDSCTL_OFF))[u] = 0u;
    __syncthreads();
    volatile LAS unsigned* MISC = (volatile LAS unsigned*)(lds + MISC_OFF);
    const int wave_s = __builtin_amdgcn_readfirstlane((int)(threadIdx.x >> 6));
    XcdBarrier bar = xcd_barrier_post((unsigned*)(ctl + CW_BAR), MISC + 8); bar.wave = wave_s;
    if (threadIdx.x == 0) { unsigned nloc_ = 0u, nx_ = 0u; xcd_barrier_complete(bar.bar, bar.x, nloc_, nx_); bar.st[0] = nloc_; bar.st[1] = nx_; }
    __syncthreads();
#define GRID_BAR() xcd_barrier(bar)

#define x_in ((const float*)(const GAS float*)args.in[0 + z_])
#define c_in ((const float*)(const GAS float*)args.in[1 + z_])
#define w_ada ((const float*)(const GAS float*)args.in[2 + z_])
#define b_ada ((const float*)(const GAS float*)args.in[3 + z_])
#define w_in ((const float*)(const GAS float*)args.in[4 + z_])
#define lb_logits ((const float*)(const GAS float*)args.in[5 + z_])
#define g_hg ((const float*)(const GAS float*)args.in[6 + z_])
#define w_pa ((const float*)(const GAS float*)args.in[7 + z_])
#define g_cq ((const float*)(const GAS float*)args.in[8 + z_])
#define g_ckv ((const float*)(const GAS float*)args.in[9 + z_])
#define w_uq ((const float*)(const GAS float*)args.in[10 + z_])
#define w_iq ((const float*)(const GAS float*)args.in[11 + z_])
#define w_uv ((const float*)(const GAS float*)args.in[12 + z_])
#define w_pb ((const float*)(const GAS float*)args.in[13 + z_])
#define w_out ((const float*)(const GAS float*)args.in[14 + z_])
#define ln1_g ((const float*)(const GAS float*)args.in[15 + z_])
#define ln1_b ((const float*)(const GAS float*)args.in[16 + z_])
#define w_gate ((const float*)(const GAS float*)args.in[17 + z_])
#define w_up ((const float*)(const GAS float*)args.in[18 + z_])
#define w_down ((const float*)(const GAS float*)args.in[19 + z_])
#define ln2_g ((const float*)(const GAS float*)args.in[20 + z_])
#define ln2_b ((const float*)(const GAS float*)args.in[21 + z_])
#define MOD  ((float*)(ws + WS_MOD))
#define LB   ((float*)(ws + WS_LB))
#define MODP ((float*)(ws + WS_MODP))
#define W1   ((bf16*)(ws + WS_W1))
#define W3   ((bf16*)(ws + WS_W3))
#define W6   ((bf16*)(ws + WS_W6))
#define W7   ((bf16*)(ws + WS_W7))
#define W8   ((bf16*)(ws + WS_W8))
#define W10  ((bf16*)(ws + WS_W10))
#define W11  ((bf16*)(ws + WS_W11))
#define XB   ((bf16*)(ws + WS_X))
#define RB   ((bf16*)(ws + WS_R))
#define HB   ((bf16*)(ws + WS_H))
#define QA   ((bf16*)(ws + WS_QA))
#define FA   ((bf16*)(ws + WS_FA))
#define IA   ((bf16*)(ws + WS_IA))
#define GA   ((bf16*)(ws + WS_GA))
#define LAT  ((bf16*)(ws + WS_LAT))
#define GTA  ((bf16*)(ws + WS_GTA))
#define GTB  ((bf16*)(ws + WS_GTB))
#define CQN  ((bf16*)(ws + WS_CQN))
#define CKV  ((bf16*)(ws + WS_CKV))
#define KIDX ((bf16*)(ws + WS_KIDX))
#define IDXW ((float*)(ws + WS_IDXW))
#define QB   ((bf16*)(ws + WS_QB))
#define QIDX ((bf16*)(ws + WS_QIDX))
#define SEL  ((unsigned short*)(ws + WS_SEL))
#define YAB  ((bf16*)(ws + WS_YAB))
#define MRG  ((bf16*)(ws + WS_MRG))
#define OB   ((bf16*)(ws + WS_OB))
#define ISC  ((_Float16*)(ws + WS_BIG))
#define OP   ((float*)(ws + WS_BIG))
#define ACT  ((bf16*)(ws + WS_BIG))
#define KK   LAT
#define modl (MOD + (size_t)l * NBATCH * MODW)
#define KSB  ((bf16*)(ws + WS_KSB))
#define QSB  ((bf16*)(ws + WS_QSB))
#define KVT  ((bf16*)(ws + WS_BIG))
#define SPB  ((bf16*)(ws + WS_FA))
#define DEB  ((float*)(ws + WS_DEB))
#define PHASE_BEGIN { unsigned om_ = ~0u; asm volatile("" : "+s"(om_)); int tid = wave_s * 64 + (int)__builtin_amdgcn_mbcnt_hi(om_, __builtin_amdgcn_mbcnt_lo(om_, 0u)); asm volatile("" : "+v"(tid)); int z_ = 0; asm volatile("" : "+s"(z_)); (void)z_; GAS unsigned char* wsg_ = (GAS unsigned char*)ws_base; asm volatile("" : "+s"(wsg_)); unsigned char* ws = (unsigned char*)wsg_; const int lane = tid & 63, wave = __builtin_amdgcn_readfirstlane(tid >> 6); \
        const int gw = blk * NWAVES + wave, gtid = blk * NTHR + tid; LAS float* wscr = (LAS float*)(lds + wave * 16384); (void)lane; (void)gw; (void)gtid; (void)wscr;
#define PHASE_END }

#define CVT_DECODE(IT_, MID_, K0_, N0_) do { int r_ = (IT_); \
        if (r_ < I1) { MID_ = 0; K0_ = (r_ / (N1 / 32)) * 64; N0_ = (r_ % (N1 / 32)) * 32; } else { r_ -= I1; \
        if (r_ < I3) { MID_ = 1; K0_ = (r_ / (N3 / 32)) * 64; N0_ = (r_ % (N3 / 32)) * 32; } else { r_ -= I3; \
        if (r_ < I6) { MID_ = 2; K0_ = (r_ / 32) * 64; N0_ = (r_ % 32) * 32; } else { r_ -= I6; \
        if (r_ < I7) { MID_ = 3; K0_ = (r_ / (DM / 32)) * 64; N0_ = (r_ % (DM / 32)) * 32; } else { r_ -= I7; \
        if (r_ < I8) { MID_ = 4; K0_ = (r_ / (DM / 32)) * 64; N0_ = (r_ % (DM / 32)) * 32; } else { r_ -= I8; \
        if (r_ < I10) { MID_ = 5; K0_ = (r_ / (N10 / 32)) * 64; N0_ = (r_ % (N10 / 32)) * 32; } else { r_ -= I10; \
        MID_ = 6; K0_ = (r_ / (DM / 32)) * 64; N0_ = (r_ % (DM / 32)) * 32; } } } } } } } while (0)
#define CVT_LOAD(MID_, K0_, N0_, TV_) do { \
        if (MID_ == 0) cvt_load([=](int k, int n) -> float { return n < 4944 ? s_in[(size_t)k * 9040 + n] : (n < 5120 ? 0.f : s_in[(size_t)k * 9040 + n - 176]); }, K0_, N0_, lane, TV_); \
        else if (MID_ == 1) cvt_load([=](int k, int n) -> float { return n < 4096 ? s_uq[(size_t)k * 4096 + n] * 0.0625f : s_iq[(size_t)k * 1024 + n - 4096]; }, K0_, N0_, lane, TV_); \
        else if (MID_ == 2) cvt_load([=](int k, int n) -> float { const int h = n >> 6, v = n & 63, kk = k >> 8, c = k & 255; return kk == (h & 3) ? s_uv[((size_t)h * 256 + c) * 64 + v] : 0.f; }, K0_, N0_, lane, TV_); \
        else if (MID_ == 3) cvt_load([=](int k, int n) -> float { return k < 1024 ? s_pa[(size_t)k * DM + n] : s_pb[(size_t)(k - 1024) * DM + n]; }, K0_, N0_, lane, TV_); \
        else if (MID_ == 4) cvt_load([=](int k, int n) -> float { return s_out[(size_t)k * DM + n]; }, K0_, N0_, lane, TV_); \
        else if (MID_ == 5) cvt_load([=](int k, int n) -> float { const int pn = n >> 8, rr = n & 255, cc = pn * 128 + (rr >> 6) * 32 + (rr & 31); return (rr & 32) ? s_u[(size_t)k * DFF + cc] : s_g[(size_t)k * DFF + cc]; }, K0_, N0_, lane, TV_); \
        else cvt_load([=](int k, int n) -> float { return s_d[(size_t)k * DM + n]; }, K0_, N0_, lane, TV_); } while (0)
#define CONVERT_LAYER(L) do { const int l_ = (L); \
        const float* s_in = w_in + (size_t)l_ * DM * 9040; const float* s_uq = w_uq + (size_t)l_ * SAR * 4096; const float* s_iq = w_iq + (size_t)l_ * SAR * 1024; \
        const float* s_uv = w_uv + (size_t)l_ * 16 * 256 * 64; const float* s_pa = w_pa + (size_t)l_ * 1024 * DM; const float* s_pb = w_pb + (size_t)l_ * 1024 * DM; \
        const float* s_out = w_out + (size_t)l_ * DM * DM; const float* s_g = w_gate + (size_t)l_ * DM * DFF; const float* s_u = w_up + (size_t)l_ * DM * DFF; const float* s_d = w_down + (size_t)l_ * DFF * DM; \
        constexpr int I1 = (DM / 64) * (N1 / 32), I3 = (SAR / 64) * (N3 / 32), I6 = (1024 / 64) * (1024 / 32), I7 = (DM / 64) * (DM / 32), I8 = I7, I10 = (DM / 64) * (N10 / 32), I11 = (DFF / 64) * (DM / 32); \
        constexpr int NIT = I1 + I3 + I6 + I7 + I8 + I10 + I11; \
        float tv_[32]; int mid_ = 0, k0_ = 0, n0_ = 0; \
        { CVT_DECODE(gw, mid_, k0_, n0_); CVT_LOAD(mid_, k0_, n0_, tv_); } \
        for (int it = gw; it < NIT; it += NGW) { \
            float tc_[32]; _Pragma("unroll") for (int i = 0; i < 32; ++i) tc_[i] = tv_[i]; \
            const int mc_ = mid_, kc_ = k0_, nc_ = n0_; \
            { const int itn_ = it + NGW < NIT ? it + NGW : it; CVT_DECODE(itn_, mid_, k0_, n0_); CVT_LOAD(mid_, k0_, n0_, tv_); }     \
            bf16* wt_ = mc_ == 0 ? W1 : mc_ == 1 ? W3 : mc_ == 2 ? W6 : mc_ == 3 ? W7 : mc_ == 4 ? W8 : mc_ == 5 ? W10 : W11; \
            const int kk_ = mc_ == 0 ? DM : mc_ == 1 ? SAR : mc_ == 2 ? 1024 : mc_ == 3 ? DM : mc_ == 4 ? DM : mc_ == 5 ? DM : DFF; \
            cvt_store(tc_, wt_, kk_, kc_, nc_, wscr, lane); \
        } } while (0)


#ifndef HGRN_NAIVE
#define HGRN_NAIVE 0
#endif
#ifndef IDX_NAIVE
#define IDX_NAIVE 0
#endif
#ifndef ATT_NAIVE
#define ATT_NAIVE 0
#endif
#ifndef TOPK_OLD
#define TOPK_OLD 0
#endif
#ifndef REP_HB
#define REP_HB 1
#endif
#ifndef REP_HC
#define REP_HC 1
#endif
#ifndef REP_P4A
#define REP_P4A 1
#endif
#ifndef REP_P5
#define REP_P5 1
#endif
#ifndef REP_P9
#define REP_P9 1
#endif
#ifndef REP_P12
#define REP_P12 1
#endif
#ifndef REP_TOPK
#define REP_TOPK 1
#endif
#ifndef REP_ATT
#define REP_ATT 1
#endif
#ifndef DRY_ATT
#define DRY_ATT 0
#endif
#ifndef REP_M1
#define REP_M1 1
#endif
#ifndef REP_M2
#define REP_M2 1
#endif
#ifndef REP_M3
#define REP_M3 1
#endif

    PHASE_BEGIN
    {
        LAS float* sc = (LAS float*)lds;
        for (int i = tid; i < NBATCH * DM; i += NTHR) { const float v = c_in[i]; sc[i] = v * sigm(v); }
        __syncthreads();
        for (int item = gtid; item < 8 * 12288; item += NT) {
            const int ks = item / 12288, cg = item % 12288, l = cg / 3072, n4 = (cg % 3072) * 4;
            const float* wp = w_ada + ((size_t)l * DM + ks * 256) * MODW + n4;
            f32x4 a0 = {0.f, 0.f, 0.f, 0.f}, a1 = a0, a2 = a0, a3 = a0;
#pragma unroll 8
            for (int k = 0; k < 256; ++k) { const f32x4 w = *(const f32x4*)(wp + (size_t)k * MODW); const int kk = ks * 256 + k;
                a0 += w * sc[kk]; a1 += w * sc[2048 + kk]; a2 += w * sc[4096 + kk]; a3 += w * sc[6144 + kk]; }
            float* o = MODP + ((size_t)(ks * 4 + l) * 4) * MODW + n4;
            *(f32x4*)(o) = a0; *(f32x4*)(o + MODW) = a1; *(f32x4*)(o + 2 * MODW) = a2; *(f32x4*)(o + 3 * MODW) = a3;
        }
        if (gtid < 1024) {
            const float a = lb_logits[gtid], b = lb_logits[1024 + gtid], c = lb_logits[2048 + gtid], d = lb_logits[3072 + gtid];
            const float mx = fmaxf(fmaxf(a, b), fmaxf(c, d)); const float ea = expf(a - mx), eb = expf(b - mx), ec = expf(c - mx), ed = expf(d - mx); const float inv = 1.f / (ea + eb + ec + ed);
            LB[gtid] = 0.f; LB[1024 + gtid] = eb * inv; LB[2048 + gtid] = (eb + ec) * inv; LB[3072 + gtid] = (eb + ec + ed) * inv;
        }
        __syncthreads();
        CONVERT_LAYER(0);
    }
    PHASE_END
    GRID_BAR();
    PHASE_BEGIN
    for (int i = gtid; i < DEPTH * NBATCH * MODW; i += NT) {
        const int l = i / (NBATCH * MODW), r = i % (NBATCH * MODW), b = r / MODW, n = r % MODW;
        float s = b_ada[l * MODW + n];
#pragma unroll
        for (int ks = 0; ks < 8; ++ks) s += MODP[((size_t)(ks * 4 + l) * 4 + b) * MODW + n];
        MOD[i] = s;
    }
    PHASE_END
    GRID_BAR();
    PHASE_BEGIN
    for (size_t i0 = gtid; i0 < (size_t)M * DM / 8; i0 += (size_t)NT * 4) {
        f32x4 xa[4], xb[4], sa[4], sb[4], ha[4], hb[4];
#pragma unroll
        for (int t = 0; t < 4; ++t) { size_t gi = i0 + (size_t)t * NT; gi = gi < (size_t)M * DM / 8 ? gi : (size_t)M * DM / 8 - 1; const size_t e = gi * 8; const int row = (int)(e / DM), col = (int)(e % DM), b = row / SEQ; const float* md = MOD + (size_t)b * MODW;
            xa[t] = *(const f32x4*)(x_in + e); xb[t] = *(const f32x4*)(x_in + e + 4); sa[t] = *(const f32x4*)(md + 2048 + col); sb[t] = *(const f32x4*)(md + 2048 + col + 4); ha[t] = *(const f32x4*)(md + col); hb[t] = *(const f32x4*)(md + col + 4); }
#pragma unroll
        for (int t = 0; t < 4; ++t) { size_t gi = i0 + (size_t)t * NT; gi = gi < (size_t)M * DM / 8 ? gi : (size_t)M * DM / 8 - 1; const size_t e = gi * 8; st_bf16x8(HB + e, xa[t] * (sa[t] + 1.f) + ha[t], xb[t] * (sb[t] + 1.f) + hb[t]); }
    }
    PHASE_END
    GRID_BAR();

    for (int l = 0; l < DEPTH; ++l) {
        PHASE_BEGIN
        { pg8::Gemm g{HB, W1, M, N1, DM, DM, DM, 0}; pg8::StaticOrder S; S.init(M, N1, G, blk);
          EpiProj E{QA, FA, IA, GA, LAT, GTA, GTB}; pg8::gemm_phase(lds, g, S, E, tid); }
        PHASE_END
        GRID_BAR();
        for (int rep_ = 0; rep_ < REP_M1; ++rep_) {
        PHASE_BEGIN
        v2u ra0, ra1, rkv; unsigned short rki, riw;
        const f32x4 g0 = *(const f32x4*)(g_cq + l * 512 + 4 * lane), g1 = *(const f32x4*)(g_cq + l * 512 + 256 + 4 * lane), gk = *(const f32x4*)(g_ckv + l * 256 + 4 * lane);
        { const bf16* lr = LAT + (size_t)gw * 1024; ra0 = *(const v2u*)(lr + 4 * lane); ra1 = *(const v2u*)(lr + 256 + 4 * lane); rkv = *(const v2u*)(lr + 512 + 4 * lane); rki = lr[768 + lane]; riw = lr[832 + (lane & 15)]; }
        for (int row = gw; row < M; row += NGW) {
            const f32x4 a0 = (f32x4){bflo(ra0.x), bfhi(ra0.x), bflo(ra0.y), bfhi(ra0.y)}, a1 = (f32x4){bflo(ra1.x), bfhi(ra1.x), bflo(ra1.y), bfhi(ra1.y)}, kv = (f32x4){bflo(rkv.x), bfhi(rkv.x), bflo(rkv.y), bfhi(rkv.y)};
            const float ki = bf2f(rki), iw = bf2f(riw);
            { const int rn = row + NGW < M ? row + NGW : row; const bf16* lr = LAT + (size_t)rn * 1024;
              ra0 = *(const v2u*)(lr + 4 * lane); ra1 = *(const v2u*)(lr + 256 + 4 * lane); rkv = *(const v2u*)(lr + 512 + 4 * lane); rki = lr[768 + lane]; riw = lr[832 + (lane & 15)]; }
            float sq = a0[0] * a0[0] + a0[1] * a0[1] + a0[2] * a0[2] + a0[3] * a0[3] + a1[0] * a1[0] + a1[1] * a1[1] + a1[2] * a1[2] + a1[3] * a1[3];
            float sk = kv[0] * kv[0] + kv[1] * kv[1] + kv[2] * kv[2] + kv[3] * kv[3];
            sq = wave_sum(sq); sk = wave_sum(sk);
            const float rq = 1.0f / sqrtf(sq * (1.f / 512.f) + 1e-6f), rk = 1.0f / sqrtf(sk * (1.f / 256.f) + 1e-6f);
            v2u o; f32x4 t = a0 * rq * g0; o.x = pk2(t[0], t[1]); o.y = pk2(t[2], t[3]); *(v2u*)(CQN + (size_t)row * 512 + 4 * lane) = o;
            t = a1 * rq * g1; o.x = pk2(t[0], t[1]); o.y = pk2(t[2], t[3]); *(v2u*)(CQN + (size_t)row * 512 + 256 + 4 * lane) = o;
            t = kv * rk * gk; o.x = pk2(t[0], t[1]); o.y = pk2(t[2], t[3]); *(v2u*)(CKV + (size_t)row * 256 + 4 * lane) = o;
            KIDX[(size_t)row * 64 + lane] = (bf16)f2bf(ki);
            if (lane < 16) IDXW[(size_t)row * 16 + lane] = iw * 0.03125f;
        }
        PHASE_END
        PHASE_BEGIN
        {
            const int cp = tid & 63, sg = tid >> 6;
            LAS unsigned char* KST = lds;
            LAS unsigned char* VTL = lds + 18432;
            LAS float* SEGT = (LAS float*)(lds + 36864);
            LAS float* G63 = (LAS float*)(lds + 40960);
            unsigned pfa[8], pq[8], pv[8]; float plb0, plb1;
#define HA_REQ(U_) do { int uu_ = (U_); asm volatile("" : "+s"(uu_)); const int bh_ = uu_ >> 6, c_ = uu_ & 63, b_ = bh_ >> 3, h_ = bh_ & 7; \
                const size_t rowb_ = (size_t)b_ * SEQ + c_ * 64 + sg * 8; const int col_ = h_ * 128 + 2 * cp; \
                _Pragma("unroll") for (int i = 0; i < 8; ++i) { pfa[i] = *(const unsigned*)(FA + (rowb_ + i) * 1024 + col_); pq[i] = *(const unsigned*)(QA + (rowb_ + i) * 1024 + col_); pv[i] = *(const unsigned*)(IA + (rowb_ + i) * 1024 + col_); } plb0 = LB[l * 1024 + col_]; plb1 = LB[l * 1024 + col_ + 1]; } while (0)
            HA_REQ(blk);
            for (int u = blk; u < 2048; u += G) {
                const int bh = u >> 6, c = u & 63, b = bh >> 3, h = bh & 7;
                const size_t rowb = (size_t)b * SEQ + c * 64 + sg * 8; const int col = h * 128 + 2 * cp;
                const float lb0 = plb0, lb1 = plb1;
                float lf0[8], lf1[8], kk0[8], kk1[8]; unsigned cq[8], cv[8];
#pragma unroll
                for (int i = 0; i < 8; ++i) { cq[i] = pq[i]; cv[i] = pv[i]; }
#pragma unroll
                for (int i = 0; i < 8; ++i) { const float2 fa = make_float2(bflo(pfa[i]), bfhi(pfa[i]));
                    const float f0 = fminf(fmaxf(lb0 + (1.f - lb0) * sigm(fa.x), 1e-6f), 1.f), f1 = fminf(fmaxf(lb1 + (1.f - lb1) * sigm(fa.y), 1e-6f), 1.f);
                    lf0[i] = __logf(f0); lf1[i] = __logf(f1); kk0[i] = (1.f - lb0) * sigm(-fa.x); kk1[i] = (1.f - lb1) * sigm(-fa.y); }
#pragma unroll
                for (int i = 1; i < 8; ++i) { lf0[i] += lf0[i - 1]; lf1[i] += lf1[i - 1]; }
                SEGT[sg * 128 + 2 * cp] = lf0[7]; SEGT[sg * 128 + 2 * cp + 1] = lf1[7];
                HA_REQ(u + G < 2048 ? u + G : u);
                __syncthreads();
                float pre0 = 0.f, pre1 = 0.f, r0 = 0.f, r1 = 0.f, t0 = 0.f, t1 = 0.f;
#pragma unroll
                for (int s2 = 0; s2 < 8; ++s2) { const float a0 = SEGT[s2 * 128 + 2 * cp], a1 = SEGT[s2 * 128 + 2 * cp + 1];
                    if (s2 < sg) { pre0 += a0; pre1 += a1; } if (s2 < 4) { r0 += a0; r1 += a1; } t0 += a0; t1 += a1; }
                unsigned ksw0[4], ksw1[4], vw0[4], vw1[4]; float ks0p = 0.f, ks1p = 0.f, v0p = 0.f, v1p = 0.f;
#pragma unroll
                for (int i = 0; i < 8; ++i) {
                    const float b0 = pre0 + lf0[i], b1 = pre1 + lf1[i];
                    const unsigned qw = cq[i]; const unsigned vw = cv[i];
                    const float qs0 = bflo(qw) * __expf(b0 - r0), qs1 = bfhi(qw) * __expf(b1 - r1);
                    const float ks0 = kk0[i] * __expf(r0 - b0), ks1 = kk1[i] * __expf(r1 - b1);
                    *(unsigned*)(QSB + (rowb + i) * 1024 + col) = pk2(qs0, qs1);
                    *(unsigned*)(KSB + (rowb + i) * 1024 + col) = pk2(ks0, ks1);
                    if (i & 1) { ksw0[i >> 1] = pk2(ks0p, ks0); ksw1[i >> 1] = pk2(ks1p, ks1); vw0[i >> 1] = pk2(v0p, bflo(vw)); vw1[i >> 1] = pk2(v1p, bfhi(vw)); }
                    else { ks0p = ks0; ks1p = ks1; v0p = bflo(vw); v1p = bfhi(vw); }
                }
                *(LAS v4u*)(KST + (2 * cp) * 144 + sg * 16) = (v4u){ksw0[0], ksw0[1], ksw0[2], ksw0[3]};
                *(LAS v4u*)(KST + (2 * cp + 1) * 144 + sg * 16) = (v4u){ksw1[0], ksw1[1], ksw1[2], ksw1[3]};
                *(LAS v4u*)(VTL + (2 * cp) * 144 + sg * 16) = (v4u){vw0[0], vw0[1], vw0[2], vw0[3]};
                *(LAS v4u*)(VTL + (2 * cp + 1) * 144 + sg * 16) = (v4u){vw1[0], vw1[1], vw1[2], vw1[3]};
                if (sg == 7) { float* de = DEB + (size_t)u * 256; *(float2*)(de + 2 * cp) = make_float2(__expf(r0), __expf(r1)); *(float2*)(de + 128 + 2 * cp) = make_float2(__expf(t0), __expf(t1));
                    G63[2 * cp] = __expf(t0 - r0); G63[2 * cp + 1] = __expf(t1 - r1); }
                __syncthreads();
                { const int kt = wave >> 1, vt0 = (wave & 1) * 2, lr = lane & 31, lh = lane >> 5;
                  f32x16 acc0, acc1;
#pragma unroll
                  for (int r = 0; r < 16; ++r) { acc0[r] = 0.f; acc1[r] = 0.f; }
#pragma unroll
                  for (int s4 = 0; s4 < 4; ++s4) {
                      const bf16x8 kb = *(const LAS bf16x8*)(KST + (kt * 32 + lr) * 144 + (s4 * 16 + 8 * lh) * 2);
                      const bf16x8 a0 = *(const LAS bf16x8*)(VTL + (vt0 * 32 + lr) * 144 + (s4 * 16 + 8 * lh) * 2);
                      const bf16x8 a1 = *(const LAS bf16x8*)(VTL + ((vt0 + 1) * 32 + lr) * 144 + (s4 * 16 + 8 * lh) * 2);
                      acc0 = __builtin_amdgcn_mfma_f32_32x32x16_bf16(a0, kb, acc0, 0, 0, 0); acc1 = __builtin_amdgcn_mfma_f32_32x32x16_bf16(a1, kb, acc1, 0, 0, 0); }
                  bf16* kvt = KVT + (size_t)u * 16384 + kt * 32 + lr; const float g = G63[kt * 32 + lr];
#pragma unroll
                  for (int r = 0; r < 16; ++r) { const int vv = 8 * (r >> 2) + 4 * lh + (r & 3);
                      kvt[(size_t)(vt0 * 32 + vv) * 128] = (bf16)(pk2(acc0[r] * g, 0.f) & 0xffffu); kvt[(size_t)((vt0 + 1) * 32 + vv) * 128] = (bf16)(pk2(acc1[r] * g, 0.f) & 0xffffu); } }
                __syncthreads();
            }
        }
#undef HA_REQ
        PHASE_END
        GRID_BAR();
        }
        for (int rep_ = 0; rep_ < REP_M2; ++rep_) {
        PHASE_BEGIN
        for (int item = gtid; item < 32 * 4096; item += NT) {
            const int bh = item >> 12, v = (item >> 5) & 127, k4 = (item & 31) * 4;
            f32x4 S = {0.f, 0.f, 0.f, 0.f};
            for (int c0 = 0; c0 < 64; c0 += 8) {
                f32x4 kv[8], dd[8], ee[8];
#pragma unroll
                for (int j = 0; j < 8; ++j) { const size_t u = (size_t)bh * 64 + c0 + j; kv[j] = ldbf4(KVT + u * 16384 + v * 128 + k4); ee[j] = *(const f32x4*)(DEB + u * 256 + k4); dd[j] = *(const f32x4*)(DEB + u * 256 + 128 + k4); }
#pragma unroll
                for (int j = 0; j < 8; ++j) { const size_t u = (size_t)bh * 64 + c0 + j; const f32x4 sp = S * ee[j]; v2u w; w.x = pk2(sp[0], sp[1]); w.y = pk2(sp[2], sp[3]);
                    *(v2u*)(SPB + u * 16384 + v * 128 + k4) = w; S = S * dd[j] + kv[j]; }
            }
        }
        PHASE_END
        PHASE_BEGIN
        { pg8::Gemm g{CQN, W3, M, N3, SAR, SAR, SAR, 0}; pg8::StaticOrder S; S.init(M, N3, G, blk);
          EpiQ E{QB, QIDX}; pg8::gemm_phase(lds, g, S, E, tid); }
        PHASE_END
        GRID_BAR();
        }
        for (int rep_ = 0; rep_ < REP_M3; ++rep_) {
        PHASE_BEGIN
        {
            LAS unsigned char* QSL = lds;
            LAS unsigned char* KSL = lds + 17408;
            LAS unsigned char* VTL = lds + 34816;
            LAS unsigned char* SPL = lds + 53248;
            LAS unsigned char* AL = lds + 88064;
            LAS float* SSQ = (LAS float*)(lds + 97280);
            const int cp = tid & 63, sg = tid >> 6, lr = lane & 31, lh = lane >> 5;
            v4u rq[2], rk[2], rs[4]; unsigned rv[8]; unsigned short rg[16];
#define HC_REQ(U_) do { int uu_ = (U_); asm volatile("" : "+s"(uu_));   const int bh_ = uu_ >> 6, c_ = uu_ & 63, b_ = bh_ >> 3, h_ = bh_ & 7; const size_t row0_ = (size_t)b_ * SEQ + c_ * 64; const int col0_ = h_ * 128; \
                _Pragma("unroll") for (int j = 0; j < 2; ++j) { const int q = tid + 512 * j, rr = q >> 4, cc = q & 15; \
                    rq[j] = *(const v4u*)(QSB + (row0_ + rr) * 1024 + col0_ + cc * 8); rk[j] = *(const v4u*)(KSB + (row0_ + rr) * 1024 + col0_ + cc * 8); } \
                _Pragma("unroll") for (int j = 0; j < 4; ++j) { const int q = tid + 512 * j, rr = q >> 4, cc = q & 15; rs[j] = *(const v4u*)(SPB + (size_t)uu_ * 16384 + rr * 128 + cc * 8); } \
                _Pragma("unroll") for (int i = 0; i < 8; ++i) rv[i] = *(const unsigned*)(IA + (row0_ + sg * 8 + i) * 1024 + col0_ + 2 * cp); \
                { const int it_ = wave >> 2, vt_ = wave & 3; const int colg_ = col0_ + vt_ * 32 + lr; \
                  _Pragma("unroll") for (int r = 0; r < 16; ++r) { const int ii = it_ * 32 + 8 * (r >> 2) + 4 * lh + (r & 3); rg[r] = GA[(row0_ + ii) * 1024 + colg_]; } } } while (0)
            HC_REQ(blk);
            for (int u = blk; u < 2048; u += G) {
                const int bh = u >> 6, c = u & 63, b = bh >> 3, h = bh & 7;
                const size_t row0 = (size_t)b * SEQ + c * 64; const int col0 = h * 128;
#pragma unroll
                for (int j = 0; j < 2; ++j) { const int q = tid + 512 * j, rr = q >> 4, cc = q & 15;
                    *(LAS v4u*)(QSL + rr * 272 + cc * 16) = rq[j]; *(LAS v4u*)(KSL + rr * 272 + cc * 16) = rk[j]; }
#pragma unroll
                for (int j = 0; j < 4; ++j) { const int q = tid + 512 * j, rr = q >> 4, cc = q & 15; *(LAS v4u*)(SPL + rr * 272 + cc * 16) = rs[j]; }
                { unsigned vw0[4], vw1[4]; float v0p = 0.f, v1p = 0.f;
#pragma unroll
                  for (int i = 0; i < 8; ++i) { const unsigned vw = rv[i];
                      if (i & 1) { vw0[i >> 1] = pk2(v0p, bflo(vw)); vw1[i >> 1] = pk2(v1p, bfhi(vw)); } else { v0p = bflo(vw); v1p = bfhi(vw); } }
                  *(LAS v4u*)(VTL + (2 * cp) * 144 + sg * 16) = (v4u){vw0[0], vw0[1], vw0[2], vw0[3]};
                  *(LAS v4u*)(VTL + (2 * cp + 1) * 144 + sg * 16) = (v4u){vw1[0], vw1[1], vw1[2], vw1[3]}; }
                float gav[16];
#pragma unroll
                for (int r = 0; r < 16; ++r) gav[r] = bf2f(rg[r]);
                const float gg = g_hg[l * 1024 + col0 + (wave & 3) * 32 + lr];
                HC_REQ(u + G < 2048 ? u + G : u);
                __syncthreads();
                if (wave < 4) {
                    const int it = wave >> 1, jt = wave & 1;
                    f32x16 acc;
#pragma unroll
                    for (int r = 0; r < 16; ++r) acc[r] = 0.f;
                    if (!(it == 0 && jt == 1)) {
#pragma unroll
                        for (int s8 = 0; s8 < 8; ++s8) {
                            const bf16x8 a = *(const LAS bf16x8*)(QSL + (it * 32 + lr) * 272 + (s8 * 16 + 8 * lh) * 2);
                            const bf16x8 bb = *(const LAS bf16x8*)(KSL + (jt * 32 + lr) * 272 + (s8 * 16 + 8 * lh) * 2);
                            acc = __builtin_amdgcn_mfma_f32_32x32x16_bf16(a, bb, acc, 0, 0, 0); } }
                    const int jj = jt * 32 + lr;
#pragma unroll
                    for (int r = 0; r < 16; ++r) { const int ii = it * 32 + 8 * (r >> 2) + 4 * lh + (r & 3); const float x = (jj <= ii) ? acc[r] : 0.f;
                        *(LAS unsigned short*)(AL + ii * 144 + jj * 2) = (unsigned short)(pk2(x, 0.f) & 0xffffu); }
                }
                __syncthreads();
                { const int it = wave >> 2, vt = wave & 3;
                  f32x16 acc;
#pragma unroll
                  for (int r = 0; r < 16; ++r) acc[r] = 0.f;
#pragma unroll
                  for (int s4 = 0; s4 < 4; ++s4) {
                      const bf16x8 a = *(const LAS bf16x8*)(AL + (it * 32 + lr) * 144 + (s4 * 16 + 8 * lh) * 2);
                      const bf16x8 bb = *(const LAS bf16x8*)(VTL + (vt * 32 + lr) * 144 + (s4 * 16 + 8 * lh) * 2);
                      acc = __builtin_amdgcn_mfma_f32_32x32x16_bf16(a, bb, acc, 0, 0, 0); }
#pragma unroll
                  for (int s8 = 0; s8 < 8; ++s8) {
                      const bf16x8 a = *(const LAS bf16x8*)(QSL + (it * 32 + lr) * 272 + (s8 * 16 + 8 * lh) * 2);
                      const bf16x8 bb = *(const LAS bf16x8*)(SPL + (vt * 32 + lr) * 272 + (s8 * 16 + 8 * lh) * 2);
                      acc = __builtin_amdgcn_mfma_f32_32x32x16_bf16(a, bb, acc, 0, 0, 0); }
#pragma unroll
                  for (int r = 0; r < 16; ++r) { float q2 = acc[r] * acc[r];
                      q2 = xsum16(rowsum16(q2));
                      if (lr == 0) SSQ[vt * 64 + it * 32 + 8 * (r >> 2) + 4 * lh + (r & 3)] = q2; }
                  __syncthreads();
                  const int colg = col0 + vt * 32 + lr;
#pragma unroll
                  for (int r = 0; r < 16; ++r) { const int ii = it * 32 + 8 * (r >> 2) + 4 * lh + (r & 3);
                      const float ss = SSQ[ii] + SSQ[64 + ii] + SSQ[128 + ii] + SSQ[192 + ii]; const float rn = 1.0f / sqrtf(ss * (1.f / 128.f) + 1e-6f);
                      YAB[(row0 + ii) * 2048 + colg] = (bf16)(pk2(acc[r] * rn * gg * gav[r], 0.f) & 0xffffu); }
                }
                __syncthreads();
            }
        }
#undef HC_REQ
        PHASE_END
        PHASE_BEGIN
        for (int ub = blk * NWAVES; ub < 2048; ub += NGW) {
            const int unit = ub + wave;
            const int b = ub >> 9, j = unit & 511, lr = lane & 31, lh = lane >> 5;
            const int qsel = (lr >> 2) & 1, head = (lr >> 3) * 4 + (lr & 3);
            const int qlo = 4 * j, qhi = 4 * (1023 - j);
            const int nlo = ((qlo >> 6) + 1) * 64, nhi = ((qhi >> 6) + 1) * 64;
            const int nlo8 = (nlo + 511) & ~511, nhi8 = (nhi + 511) & ~511;
            const int nmax8 = (((((4 * (1023 - (ub & 511))) >> 6) + 1) * 64) + 511) & ~511;
            bf16x8 A[4][4]; float W[4][16]; typedef float f32x2_t __attribute__((ext_vector_type(2)));
#pragma unroll
            for (int p = 0; p < 4; ++p) { const size_t qb = (size_t)b * SEQ + (p < 2 ? qlo + 2 * p : qhi + 2 * (p - 2));
#pragma unroll
                for (int ks = 0; ks < 4; ++ks) A[p][ks] = *(const bf16x8*)(QIDX + (qb + qsel) * 1024 + head * 64 + ks * 16 + lh * 8);
#pragma unroll
                for (int r4 = 0; r4 < 4; ++r4) { const f32x4 w = *(const f32x4*)(IDXW + (qb + lh) * 16 + r4 * 4); W[p][r4 * 4] = w[0]; W[p][r4 * 4 + 1] = w[1]; W[p][r4 * 4 + 2] = w[2]; W[p][r4 * 4 + 3] = w[3]; } }
            const bf16* kb = KIDX + (size_t)b * SEQ * 64;
            const int srow = 8 * wave + (lane >> 3), spc = ((lane & 7) ^ ((srow >> 1) & 7)) * 8;
#define P4_STAGE(C0_, BUF_) do { _Pragma("unroll") for (int i = 0; i < 4; ++i) \
                __builtin_amdgcn_global_load_lds((const unsigned*)(kb + (size_t)((C0_) + 64 * i + srow) * 64 + spc), (LAS unsigned*)(lds + (BUF_) * 32768 + (i * 8 + wave) * 1024), 16, 0, 0); } while (0)
            P4_STAGE(0, 0);
            asm volatile("s_waitcnt vmcnt(0)" ::: "memory");
            __syncthreads();
            for (int c0 = 0; c0 < nmax8; c0 += 256) {
                const int cb = (c0 >> 8) & 1; const bool more = c0 + 256 < nmax8;
                if (more) P4_STAGE(c0 + 256, cb ^ 1);
                LAS unsigned char* kbuf = lds + cb * 32768;
#pragma unroll 1
                for (int tl = 0; tl < 8; ++tl) {
                    const int s0 = c0 + tl * 32;
                    if (s0 >= nhi8) break;
#pragma unroll
                    for (int p = 0; p < 4; ++p) { const int np = p < 2 ? nlo : nhi, np8 = p < 2 ? nlo8 : nhi8;
                        if (s0 >= np && s0 < np8) { const size_t q = (size_t)b * SEQ + (p < 2 ? qlo + 2 * p : qhi + 2 * (p - 2)) + lh; ISC[q * 4096 + s0 + lr] = (_Float16)(-60000.0f); } }
                    if (s0 >= nhi) continue;
                    bf16x8 B[4];
#pragma unroll
                    for (int ks = 0; ks < 4; ++ks) B[ks] = *(const LAS bf16x8*)(kbuf + (tl * 32 + lr) * 128 + (((2 * ks + lh) ^ ((lr >> 1) & 7)) * 16));
#define IDX_FINISH(P_, ACC_) do { f32x2_t s2_ = {0.f, 0.f};     \
                        _Pragma("unroll") for (int r = 0; r < 16; r += 2) { const float a0_ = ACC_[r], a1_ = ACC_[r + 1]; const int i0_ = __builtin_bit_cast(int, a0_), i1_ = __builtin_bit_cast(int, a1_); \
                            const f32x2_t rl_ = {__builtin_bit_cast(float, i0_ > 0 ? i0_ : 0), __builtin_bit_cast(float, i1_ > 0 ? i1_ : 0)}; const f32x2_t w_ = {W[P_][r], W[P_][r + 1]}; \
                            s2_ = __builtin_elementwise_fma(rl_, w_, s2_); } \
                        const float sc_ = s2_[0] + s2_[1]; \
                        const size_t q_ = (size_t)b * SEQ + ((P_) < 2 ? qlo + 2 * (P_) : qhi + 2 * ((P_) - 2)) + lh; ISC[q_ * 4096 + s0 + lr] = (_Float16)sc_; } while (0)
                    if (s0 < nlo) {
                        f32x16 c0_, c1_, c2_, c3_;
#pragma unroll
                        for (int r = 0; r < 16; ++r) { c0_[r] = 0.f; c1_[r] = 0.f; c2_[r] = 0.f; c3_[r] = 0.f; }
#pragma unroll
                        for (int ks = 0; ks < 4; ++ks) { c0_ = __builtin_amdgcn_mfma_f32_32x32x16_bf16(A[0][ks], B[ks], c0_, 0, 0, 0); c1_ = __builtin_amdgcn_mfma_f32_32x32x16_bf16(A[1][ks], B[ks], c1_, 0, 0, 0);
                            c2_ = __builtin_amdgcn_mfma_f32_32x32x16_bf16(A[2][ks], B[ks], c2_, 0, 0, 0); c3_ = __builtin_amdgcn_mfma_f32_32x32x16_bf16(A[3][ks], B[ks], c3_, 0, 0, 0); }
                        IDX_FINISH(0, c0_); IDX_FINISH(1, c1_); IDX_FINISH(2, c2_); IDX_FINISH(3, c3_);
                    } else {
                        f32x16 c2_, c3_;
#pragma unroll
                        for (int r = 0; r < 16; ++r) { c2_[r] = 0.f; c3_[r] = 0.f; }
#pragma unroll
                        for (int ks = 0; ks < 4; ++ks) { c2_ = __builtin_amdgcn_mfma_f32_32x32x16_bf16(A[2][ks], B[ks], c2_, 0, 0, 0); c3_ = __builtin_amdgcn_mfma_f32_32x32x16_bf16(A[3][ks], B[ks], c3_, 0, 0, 0); }
                        IDX_FINISH(2, c2_); IDX_FINISH(3, c3_);
                    }
#undef IDX_FINISH
                }
                asm volatile("s_waitcnt vmcnt(0)" ::: "memory");
                __syncthreads();
            }
        }
#undef P4_STAGE
        PHASE_END
        GRID_BAR();
        }
        for (int rep_ = 0; rep_ < REP_P5; ++rep_) {
        PHASE_BEGIN
        {
            LAS unsigned char* VB = lds + wave * 18432;
            LAS unsigned short* SELW = (LAS unsigned short*)(VB + 17408);
            const int hd = lane & 15, g = lane >> 4, qq = hd >> 2, pp = hd & 3;
            const float slope = exp2f(-0.5f * (float)(hd + 1));
            for (int q = gw; q < M; q += NGW) {
                const int b = q / SEQ, pos = q % SEQ, qc = pos >> 6; const int nsel = qc < 4 ? (qc + 1) * 64 : 256;
                for (int rtk_ = 0; rtk_ < REP_TOPK; ++rtk_) {
                int lane_t = lane; asm volatile("" : "+v"(lane_t));
                if (qc < 4) { const unsigned e0 = 4 * lane_t; const bool ok = 4 * lane_t < nsel; v2u z; z.x = ok ? (e0 | ((e0 + 1) << 16)) : 0u; z.y = ok ? ((e0 + 2) | ((e0 + 3) << 16)) : 0u; *(LAS v2u*)(SELW + 4 * lane_t) = z; }
                else {
                    LAS unsigned* HIST = (LAS unsigned*)VB;
                    const int nb8 = (qc + 8) >> 3;
                    float v[64];
                    { unsigned pk[32]; const int i2max = 4 * nb8 - 1; const _Float16* irow = ISC + (size_t)q * 4096 + 2 * lane_t; typedef _Float16 h2_t __attribute__((ext_vector_type(2)));
#pragma unroll
                      for (int i2 = 0; i2 < 32; ++i2) { const int ic = i2 < i2max ? i2 : i2max; pk[i2] = *(const unsigned*)(irow + ic * 128); }
#pragma unroll
                      for (int i2 = 0; i2 < 32; ++i2) { const float lim = (i2 >> 2) < nb8 ? 3.0e38f : -1.0e30f; const h2_t h = __builtin_bit_cast(h2_t, pk[i2]);
                          const float f0 = (float)h[0], f1 = (float)h[1]; v[2 * i2] = fminf(f0, lim); v[2 * i2 + 1] = fminf(f1, lim); } }
                    float vmx = v[0], vmn = fminf(fminf(v[0], v[1]), fminf(v[2], v[3]));
#pragma unroll
                    for (int i = 1; i < 64; ++i) vmx = fmaxf(vmx, v[i]);
                    vmx = wmax_f(vmx); vmn = -wmax_f(-vmn);
                    const float rng = vmx - vmn; const float s20 = rng > 0.f ? 1048574.0f / rng : 0.f;
#define ZERO_HIST() do { *(LAS v4u*)(HIST + 16 * lane) = (v4u){0u, 0u, 0u, 0u}; *(LAS v4u*)(HIST + 16 * lane + 4) = (v4u){0u, 0u, 0u, 0u}; *(LAS v4u*)(HIST + 16 * lane + 8) = (v4u){0u, 0u, 0u, 0u}; \
                        *(LAS v4u*)(HIST + 16 * lane + 12) = (v4u){0u, 0u, 0u, 0u}; HIST[1024 + lane] = 0u; } while (0)
#define SCAN_HIST(R_, BIN_, AB_) do { unsigned hh_[16]; const int hb_ = 1008 - 16 * lane; \
                        { const v4u h0 = *(const LAS v4u*)(HIST + hb_), h1 = *(const LAS v4u*)(HIST + hb_ + 4), h2 = *(const LAS v4u*)(HIST + hb_ + 8), h3 = *(const LAS v4u*)(HIST + hb_ + 12); \
                          hh_[0] = h0.x; hh_[1] = h0.y; hh_[2] = h0.z; hh_[3] = h0.w; hh_[4] = h1.x; hh_[5] = h1.y; hh_[6] = h1.z; hh_[7] = h1.w; hh_[8] = h2.x; hh_[9] = h2.y; hh_[10] = h2.z; hh_[11] = h2.w; hh_[12] = h3.x; hh_[13] = h3.y; hh_[14] = h3.z; hh_[15] = h3.w; } \
                        unsigned tot_ = 0u; _Pragma("unroll") for (int k = 0; k < 16; ++k) tot_ += hh_[k]; \
                        unsigned run_ = wprefix_u(tot_) - tot_; int fb_ = -1; unsigned fa_ = 0u; \
                        _Pragma("unroll") for (int k = 15; k >= 0; --k) { if (run_ < (R_) && run_ + hh_[k] >= (R_)) { fb_ = hb_ + k; fa_ = run_; } run_ += hh_[k]; } \
                        const unsigned long long bm_ = __ballot(fb_ >= 0); const int L_ = (int)__builtin_ctzll(bm_); \
                        BIN_ = (unsigned)__builtin_amdgcn_readlane(fb_, L_); AB_ = (unsigned)__builtin_amdgcn_readlane((int)fa_, L_); } while (0)
                    ZERO_HIST();
#pragma unroll
                    for (int i = 0; i < 64; ++i) v[i] = __builtin_bit_cast(float, (unsigned)((v[i] - vmn) * s20));
#define cd(i_) __builtin_bit_cast(unsigned, v[i_])
#pragma unroll
                    for (int g8 = 0; g8 < 8; ++g8) { if (g8 < nb8) {
#pragma unroll
                        for (int j = 0; j < 8; ++j) __hip_atomic_fetch_add(HIST + (cd(g8 * 8 + j) >> 10), 1u, __ATOMIC_RELAXED, __HIP_MEMORY_SCOPE_WORKGROUP); } }
                    LDS_WAIT(); asm volatile("" ::: "memory");
                    unsigned tb, above; SCAN_HIST(256u, tb, above);
                    ZERO_HIST();
                    LDS_WAIT(); asm volatile("" ::: "memory");
#pragma unroll
                    for (int g8 = 0; g8 < 8; ++g8) { if (g8 < nb8) {
#pragma unroll
                        for (int j = 0; j < 8; ++j) { const unsigned c = cd(g8 * 8 + j); const unsigned a = (c >> 10) == tb ? (c & 1023u) : 1024u + lane; __hip_atomic_fetch_add(HIST + a, 1u, __ATOMIC_RELAXED, __HIP_MEMORY_SCOPE_WORKGROUP); } } }
                    LDS_WAIT(); asm volatile("" ::: "memory");
                    unsigned tb2, ab2; { const unsigned R2 = 256u - above; SCAN_HIST(R2, tb2, ab2); }
                    const unsigned T = (tb << 10) | tb2; above += ab2;
                    unsigned baseg = 0u, basee = above;
#pragma unroll
                    for (int g8 = 0; g8 < 8; ++g8) { if (g8 < nb8) {
#pragma unroll
                        for (int j = 0; j < 8; ++j) { const int i = g8 * 8 + j;
                            const bool gt = cd(i) > T; const unsigned long long bg = __ballot(gt);
                            const unsigned pgp = baseg + __builtin_amdgcn_mbcnt_hi((unsigned)(bg >> 32), __builtin_amdgcn_mbcnt_lo((unsigned)bg, 0u));
                            if (gt) SELW[pgp] = (unsigned short)((i >> 1) * 128 + (i & 1) + 2 * lane);
                            baseg += (unsigned)__popcll(bg);
                            const bool eq = cd(i) == T; const unsigned long long be = __ballot(eq);
                            if (be) { const unsigned pep = basee + __builtin_amdgcn_mbcnt_hi((unsigned)(be >> 32), __builtin_amdgcn_mbcnt_lo((unsigned)be, 0u));
                                if (eq && pep < 256u) SELW[pep] = (unsigned short)((i >> 1) * 128 + (i & 1) + 2 * lane);
                                basee += (unsigned)__popcll(be); } } } }
#undef cd
#undef ZERO_HIST
#undef SCAN_HIST
                }
                LDS_WAIT(); asm volatile("" ::: "memory");
                }
                for (int rat_ = 0; rat_ < REP_ATT; ++rat_) {
                bf16* qrow = QB + (size_t)q * 4096;
                bf16x8 Bq[8];
#pragma unroll
                for (int ks = 0; ks < 8; ++ks) Bq[ks] = *(const bf16x8*)(qrow + hd * 256 + ks * 32 + g * 8);
                const bf16* kvb = CKV + (size_t)b * SEQ * 256;
                f32x4 O[16];
#pragma unroll
                for (int ct = 0; ct < 16; ++ct) O[ct] = (f32x4){0.f, 0.f, 0.f, 0.f};
                float mrun = -1.0e30f, lsum = 0.f;
                LDS_WAIT(); asm volatile("" ::: "memory");
                const int nks = nsel >> 5;
                const int lrow = lane >> 5, lcp = lane & 31, lsh = 16 * lrow;
                v4u KR[16];
#define ATT_IDX(KST_) v4u iw_[4]; _Pragma("unroll") for (int c = 0; c < 4; ++c) iw_[c] = *(const LAS v4u*)(SELW + 32 * (KST_) + 8 * c)
#define ATT_LOADROWS(KST_) do { ATT_IDX(KST_); _Pragma("unroll") for (int i = 0; i < 16; ++i) { const int rr_ = 2 * i + lrow; const unsigned w_ = iw_[i >> 2][i & 3]; const int ix_ = (int)((w_ >> lsh) & 0xffffu); \
                    KR[i] = *(const v4u*)(kvb + (size_t)ix_ * 256 + ((lcp ^ (rr_ & 7)) * 8)); } } while (0)
                ATT_LOADROWS(0);
                const int rlA = hd & 7;
                const int rlT = (4 * g + qq) & 7;
                const int trb = (4 * g + qq) * 512 + 8 * (pp & 1), trm = 16 * ((pp >> 1) ^ rlT);
                for (int kst = 0; kst < nks; ++kst) {
                    int rlA_ = rlA, trm_ = trm; asm volatile("" : "+v"(rlA_), "+v"(trm_));
                    if (kst + 1 < nks) {
                        ATT_IDX(kst + 1);
#pragma unroll
                        for (int i = 0; i < 16; ++i) { *(LAS v4u*)(VB + i * 1024 + lane * 16) = KR[i];
                            const int rr_ = 2 * i + lrow; const unsigned w_ = iw_[i >> 2][i & 3]; const int ix_ = (int)((w_ >> lsh) & 0xffffu); KR[i] = *(const v4u*)(kvb + (size_t)ix_ * 256 + ((lcp ^ (rr_ & 7)) * 8)); }
                    } else {
#pragma unroll
                        for (int i = 0; i < 16; ++i) *(LAS v4u*)(VB + i * 1024 + lane * 16) = KR[i]; }
                    LDS_WAIT(); asm volatile("" ::: "memory");
                    f32x4 S0 = {0.f, 0.f, 0.f, 0.f}, S1 = {0.f, 0.f, 0.f, 0.f};
#pragma unroll
                    for (int k4 = 0; k4 < 4; ++k4) {
                        bf16x8 a0[2], a1[2];
#pragma unroll
                        for (int j = 0; j < 2; ++j) { const int ks = k4 * 2 + j; const int cpos = (4 * ks + g) ^ rlA_;
                            a0[j] = *(const LAS bf16x8*)(VB + hd * 512 + cpos * 16); a1[j] = *(const LAS bf16x8*)(VB + (16 + hd) * 512 + cpos * 16); }
#pragma unroll
                        for (int j = 0; j < 2; ++j) { const int ks = k4 * 2 + j;
                            S0 = __builtin_amdgcn_mfma_f32_16x16x32_bf16(a0[j], Bq[ks], S0, 0, 0, 0); S1 = __builtin_amdgcn_mfma_f32_16x16x32_bf16(a1[j], Bq[ks], S1, 0, 0, 0); }
                    }
                    const v2u pa = *(const LAS v2u*)(SELW + 32 * kst + 4 * g), pb = *(const LAS v2u*)(SELW + 32 * kst + 16 + 4 * g);
                    const float fp = (float)pos;
                    float s0[4], s1[4];
                    s0[0] = S0[0] - slope * fabsf(fp - (float)(pa.x & 0xffffu)); s0[1] = S0[1] - slope * fabsf(fp - (float)(pa.x >> 16));
                    s0[2] = S0[2] - slope * fabsf(fp - (float)(pa.y & 0xffffu)); s0[3] = S0[3] - slope * fabsf(fp - (float)(pa.y >> 16));
                    s1[0] = S1[0] - slope * fabsf(fp - (float)(pb.x & 0xffffu)); s1[1] = S1[1] - slope * fabsf(fp - (float)(pb.x >> 16));
                    s1[2] = S1[2] - slope * fabsf(fp - (float)(pb.y & 0xffffu)); s1[3] = S1[3] - slope * fabsf(fp - (float)(pb.y >> 16));
                    float ml = fmaxf(fmaxf(fmaxf(s0[0], s0[1]), fmaxf(s0[2], s0[3])), fmaxf(fmaxf(s1[0], s1[1]), fmaxf(s1[2], s1[3])));
                    ml = xmax16(ml); ml = xmax32(ml);
                    const float mnew = fmaxf(mrun, ml), alpha = __expf(mrun - mnew); mrun = mnew;
                    float p0[4], p1[4];
#pragma unroll
                    for (int r = 0; r < 4; ++r) { p0[r] = __expf(s0[r] - mnew); p1[r] = __expf(s1[r] - mnew); }
                    lsum = lsum * alpha + ((p0[0] + p0[1]) + (p0[2] + p0[3])) + ((p1[0] + p1[1]) + (p1[2] + p1[3]));
                    v4u pw; pw.x = pk2(p0[0], p0[1]); pw.y = pk2(p0[2], p0[3]); pw.z = pk2(p1[0], p1[1]); pw.w = pk2(p1[2], p1[3]);
                    const bf16x8 Pf = __builtin_bit_cast(bf16x8, pw);
#pragma unroll
                    for (int ct = 0; ct < 16; ++ct) O[ct] = O[ct] * alpha;
#pragma unroll
                    for (int c8 = 0; c8 < 4; ++c8) {
                        v4s lo[4], hi[4];
#pragma unroll
                        for (int j = 0; j < 4; ++j) { const int ct = c8 * 4 + j; const int off = trb + ((32 * ct) ^ trm_);
                            lo[j] = __builtin_amdgcn_ds_read_tr16_b64_v4i16((LAS v4s*)(VB + off));
                            hi[j] = __builtin_amdgcn_ds_read_tr16_b64_v4i16((LAS v4s*)(VB + 16 * 512 + off)); }
#pragma unroll
                        for (int j = 0; j < 4; ++j) { const int ct = c8 * 4 + j;
                            const bf16x8 Af = {lo[j][0], lo[j][1], lo[j][2], lo[j][3], hi[j][0], hi[j][1], hi[j][2], hi[j][3]};
                            O[ct] = __builtin_amdgcn_mfma_f32_16x16x32_bf16(Af, Pf, O[ct], 0, 0, 0); }
                    }
                    LDS_WAIT(); asm volatile("" ::: "memory");
                }
#undef ATT_LOADROWS
#undef ATT_IDX
                lsum = xsum16(lsum); lsum = xsum32(lsum);
                const float inv = 1.0f / lsum;
#pragma unroll
                for (int ct = 0; ct < 16; ++ct) { const f32x4 o = O[ct] * inv; v2u w; w.x = pk2(o[0], o[1]); w.y = pk2(o[2], o[3]); *(v2u*)(OB + (size_t)q * 4096 + hd * 256 + 16 * ct + 4 * g) = w; }
                }
            }
        }
        PHASE_END
        GRID_BAR();
        }
        PHASE_BEGIN
        { pg8::Gemm g{OB, W6, M, 1024, 1024, 4096, 1024, 1024}; pg8::StaticOrder S; S.init(M, 1024, G, blk);
          EpiBf E{YAB, 2048, 1024}; pg8::gemm_phase(lds, g, S, E, tid); }
        PHASE_END
        GRID_BAR();
        PHASE_BEGIN
        { pg8::Gemm g{YAB, W7, M, DM, DM, DM, DM, 0}; pg8::StaticOrder S; S.init(M, DM, G, blk);
          EpiGateM E{GTB, MRG}; HookGate Hk{GTA, GTB}; pg8::gemm_phase(lds, g, S, E, tid, Hk); }
        PHASE_END
        GRID_BAR();
        PHASE_BEGIN
        { pg8::Gemm g{MRG, W8, M, DM, DM, DM, DM, 0}; pg8::StaticOrder S; S.init(M, DM, G, blk);
          EpiRes E{(l == 0) ? x_in : (const float*)nullptr, HB, RB, modl, 0, DM, 2 * DM}; pg8::gemm_phase(lds, g, S, E, tid); }
        PHASE_END
        GRID_BAR();
        for (int rep_ = 0; rep_ < REP_P9; ++rep_) {
        PHASE_BEGIN
        f32x4 lg[8], lb_[8]; v2u nx[8];
#pragma unroll
        for (int j = 0; j < 8; ++j) { const int c = j * 256 + lane * 4; lg[j] = *(const f32x4*)(ln1_g + l * DM + c); lb_[j] = *(const f32x4*)(ln1_b + l * DM + c); nx[j] = *(const v2u*)(RB + (size_t)gw * DM + c); }
        for (int row = gw; row < M; row += NGW) {
            const int b = row / SEQ; const float* md = modl + (size_t)b * MODW;
            f32x4 v[8]; float s = 0.f;
#pragma unroll
            for (int j = 0; j < 8; ++j) { v[j] = (f32x4){bflo(nx[j].x), bfhi(nx[j].x), bflo(nx[j].y), bfhi(nx[j].y)}; s += (v[j][0] + v[j][1]) + (v[j][2] + v[j][3]); }
            { const int rn = row + NGW < M ? row + NGW : row;
#pragma unroll
              for (int j = 0; j < 8; ++j) nx[j] = *(const v2u*)(RB + (size_t)rn * DM + j * 256 + lane * 4); }
            f32x4 msc[8], msh[8];
#pragma unroll
            for (int j = 0; j < 8; ++j) { const int c = j * 256 + lane * 4; msc[j] = *(const f32x4*)(md + 4 * DM + c); msh[j] = *(const f32x4*)(md + 3 * DM + c); }
            const float mean = wave_sum(s) * (1.f / DM); float s2 = 0.f;
#pragma unroll
            for (int j = 0; j < 8; ++j) { v[j] = v[j] - mean; s2 += (v[j][0] * v[j][0] + v[j][1] * v[j][1]) + (v[j][2] * v[j][2] + v[j][3] * v[j][3]); }
            const float rstd = 1.0f / sqrtf(wave_sum(s2) * (1.f / DM) + 1e-5f);
#pragma unroll
            for (int j = 0; j < 8; ++j) { const int c = j * 256 + lane * 4; const f32x4 gg = lg[j], bb = lb_[j];
                const f32x4 y = v[j] * rstd * gg + bb;
                const f32x4 sc = msc[j], sh = msh[j]; const f32x4 hh = y * (sc + 1.f) + sh;
                v2u w; w.x = pk2(hh[0], hh[1]); w.y = pk2(hh[2], hh[3]); *(v2u*)(HB + (size_t)row * DM + c) = w; }
        }
        PHASE_END
        GRID_BAR();
        }
        PHASE_BEGIN
        { pg8::Gemm g{HB, W10, M, N10, DM, DM, DM, 0}; pg8::StaticOrder S; S.init(M, N10, G, blk);
          EpiSwiglu E{ACT}; pg8::gemm_phase(lds, g, S, E, tid); }
        PHASE_END
        GRID_BAR();
        PHASE_BEGIN
        { pg8::Gemm g{ACT, W11, M, DM, DFF, DFF, DFF, 0}; pg8::StaticOrder S; S.init(M, DM, G, blk);
          EpiRes E{(const float*)nullptr, HB, RB, modl, 3 * DM, 4 * DM, 5 * DM}; pg8::gemm_phase(lds, g, S, E, tid); }
        PHASE_END
        GRID_BAR();
        for (int rep_ = 0; rep_ < REP_P12; ++rep_) {
        PHASE_BEGIN
        {
            const bool lastl = (l == DEPTH - 1); const float* mdn = MOD + (size_t)(l + 1 < DEPTH ? l + 1 : l) * NBATCH * MODW;
            f32x4 lg[8], lb_[8]; v2u nx[8];
#pragma unroll
            for (int j = 0; j < 8; ++j) { const int c = j * 256 + lane * 4; lg[j] = *(const f32x4*)(ln2_g + l * DM + c); lb_[j] = *(const f32x4*)(ln2_b + l * DM + c); nx[j] = *(const v2u*)(RB + (size_t)gw * DM + c); }
            for (int row = gw; row < M; row += NGW) {
                const int b = row / SEQ; const float* md = mdn + (size_t)b * MODW;
                f32x4 v[8]; float s = 0.f;
#pragma unroll
                for (int j = 0; j < 8; ++j) { v[j] = (f32x4){bflo(nx[j].x), bfhi(nx[j].x), bflo(nx[j].y), bfhi(nx[j].y)}; s += (v[j][0] + v[j][1]) + (v[j][2] + v[j][3]); }
                { const int rn = row + NGW < M ? row + NGW : row;
#pragma unroll
                  for (int j = 0; j < 8; ++j) nx[j] = *(const v2u*)(RB + (size_t)rn * DM + j * 256 + lane * 4); }
                f32x4 msc[8], msh[8];
#pragma unroll
                for (int j = 0; j < 8; ++j) { const int c = j * 256 + lane * 4; msc[j] = *(const f32x4*)(md + DM + c); msh[j] = *(const f32x4*)(md + c); }
                const float mean = wave_sum(s) * (1.f / DM); float s2 = 0.f;
#pragma unroll
                for (int j = 0; j < 8; ++j) { v[j] = v[j] - mean; s2 += (v[j][0] * v[j][0] + v[j][1] * v[j][1]) + (v[j][2] * v[j][2] + v[j][3] * v[j][3]); }
                const float rstd = 1.0f / sqrtf(wave_sum(s2) * (1.f / DM) + 1e-5f);
#pragma unroll
                for (int j = 0; j < 8; ++j) { const int c = j * 256 + lane * 4; const f32x4 gg = lg[j], bb = lb_[j];
                    const f32x4 y = v[j] * rstd * gg + bb;
                    if (lastl) *(f32x4*)(args.out + (size_t)row * DM + c) = y;
                    else { const f32x4 sc = msc[j], sh = msh[j]; const f32x4 hh = y * (sc + 1.f) + sh;
                        v2u w; w.x = pk2(hh[0], hh[1]); w.y = pk2(hh[2], hh[3]); *(v2u*)(HB + (size_t)row * DM + c) = w; } }
            }
            if (l + 1 < DEPTH) { __syncthreads(); CONVERT_LAYER(l + 1); }
        }
        PHASE_END
        if (l + 1 < DEPTH || rep_ + 1 < REP_P12) GRID_BAR();
        }
    }
}

extern "C" void kernel_launch(void* const* d_in, const int* in_sizes, int n_in, void* d_out, int out_size, void* d_ws, size_t ws_size, hipStream_t stream) {
    static int grid = 0;
    if (grid == 0) {
        if (n_in != 22 || out_size != M * DM || ws_size < WS_END) { fprintf(stderr, "kernel_launch: unexpected shapes (n_in %d, out %d, ws %zu < %zu)\n", n_in, out_size, ws_size, (size_t)WS_END); grid = -1; return; }
        int dev = 0, cus = 0, per_cu = 0;
        if (hipGetDevice(&dev) != hipSuccess || hipDeviceGetAttribute(&cus, hipDeviceAttributeMultiprocessorCount, dev) != hipSuccess) { grid = -1; return; }
        if (hipFuncSetAttribute((const void*)fwd_kernel, hipFuncAttributeMaxDynamicSharedMemorySize, LDS_BYTES) != hipSuccess) { fprintf(stderr, "kernel_launch: hipFuncSetAttribute failed\n"); grid = -1; return; }
        if (hipOccupancyMaxActiveBlocksPerMultiprocessor(&per_cu, (const void*)fwd_kernel, NTHR, LDS_BYTES) != hipSuccess || per_cu < 1) { fprintf(stderr, "kernel_launch: occupancy query says %d\n", per_cu); }
        (void)hipGetLastError();
        grid = cus;
    }
    if (grid < 0) return;
    if (hipMemsetAsync((char*)d_ws + WS_CTL, 0, CTL_ZERO_BYTES, stream) != hipSuccess) return;
    Args a{};
    for (int i = 0; i < 22; ++i) a.in[i] = (const float*)d_in[i];
    a.out = (float*)d_out; a.ws = (unsigned char*)d_ws;
    hipLaunchKernelGGL(fwd_kernel, dim3(grid), dim3(NTHR), LDS_BYTES, stream, a);
}
```

```cpp
#include <hip/hip_runtime.h>
#include <cstdio>
#include <cstdint>

namespace pg8 {
#define PG8_LAS __attribute__((address_space(3)))
typedef unsigned short bf16_t;
typedef short bf16x8 __attribute__((ext_vector_type(8)));
typedef float f32x4 __attribute__((ext_vector_type(4)));
typedef unsigned u32x4 __attribute__((ext_vector_type(4)));
constexpr int BM = 256, BK = 64, HALF = 128, HTB = HALF * BK * 2, STAGE_BYTES = 8 * HTB, NXCD = 8, WGM = 8;

__host__ __device__ __forceinline__ int lds_byte(int r, int c) { const int st = (r >> 4) * 2 + (c >> 5), rr = r & 15, cc = c & 31, ob = rr * 64 + cc * 2; return st * 1024 + (ob ^ (((ob >> 9) & 1) << 5)); }
__host__ __device__ __forceinline__ void stage_rc(int b, int& R, int& C) { const int st = b / 1024, sb = b % 1024, swz = sb ^ (((sb >> 9) & 1) << 5); R = (st >> 1) * 16 + swz / 64; C = (st & 1) * 32 + (swz % 64) / 2; }
__host__ __device__ __forceinline__ int perm32(int rho) { const int n = rho >> 4, i = rho & 15; return 8 * (i >> 2) + 4 * n + (i & 3); }

struct Unit { int pm, pn; };
struct Gemm { const bf16_t* A; const bf16_t* Bt; int M, N, K, lda, ldb, a_pn_stride; };

struct StaticOrder {
    int nM, nN, nwg, G, c, mode;
    __host__ __device__ void init(int M, int N, int G_, int c_) { nM = M / BM; nN = N / BM; nwg = nM * nN; G = G_; c = c_; mode = 0; }
    __host__ __device__ bool next(int i, Unit& u) const {
        if (mode == 1) {
            const int PR = G >> 3, x = c & 7, j = c >> 3, pm = i * PR + (PR >> 3) * x + (j >> 3); if (pm >= nM) return false; u.pm = pm; u.pn = j & 7; return true; }
        const long L = (long)i * G + c; if (L >= nwg) return false;
        int wgid = (int)L; { const int q = nwg / NXCD, r = nwg % NXCD, xcd = wgid % NXCD, off = wgid / NXCD; wgid = (xcd < r ? xcd * (q + 1) : r * (q + 1) + (xcd - r) * q) + off; }
        const int nig = WGM * nN, gid = wgid / nig, fm = gid * WGM, gsz = (nM - fm) < WGM ? (nM - fm) : WGM;
        u.pm = fm + ((wgid % nig) % gsz); u.pn = (wgid % nig) / gsz; return true;
    }
};

typedef float f32x2_t __attribute__((ext_vector_type(2))); typedef __bf16 bf16x2_t __attribute__((ext_vector_type(2)));
__device__ __forceinline__ unsigned cvt_pk_bf16(float lo, float hi) { f32x2_t v = {lo, hi}; bf16x2_t b = __builtin_convertvector(v, bf16x2_t); return __builtin_bit_cast(unsigned, b); }

struct NoHook { static constexpr bool ON = false; template <class A> __device__ __forceinline__ void mid(A&, const Unit&, int, int, int, int) const {} };
template <class Epi, class Hook = NoHook>
__device__ __forceinline__ void gemm_phase(PG8_LAS unsigned char* lds, const Gemm g, const StaticOrder& S, const Epi& E, const int tid, const Hook H = Hook()) {
    const int wid = __builtin_amdgcn_readfirstlane(tid >> 6), lane = tid & 63, wr = wid >> 2, wc = wid & 3, fr = lane & 15, fq = lane >> 4;
    const int K = g.K, nt = K / BK;
    unsigned voffA[2], voffB[2];
#pragma unroll
    for (int i = 0; i < 2; ++i) { int R, C; stage_rc(tid * 16 + i * 8192, R, C); const int Rb = 64 * (R >> 5) + perm32(R & 31);
        voffA[i] = (unsigned)(R * g.lda + C) * 2u; voffB[i] = (unsigned)(Rb * g.ldb + C) * 2u; }
    const size_t kstep = (size_t)(BK * 2);
    const size_t hstepA = (size_t)HALF * g.lda * 2, hstepB = (size_t)32 * g.ldb * 2;
    const size_t tstepA = 2 * hstepA, tstepB = (size_t)BM * g.ldb * 2;
    const unsigned ldsw = (unsigned)wid * 1024u;
    const int aoff = lds_byte(wr * 64 + fr, fq * 8), boff = lds_byte(wc * 32 + fr, fq * 8);
#define PG8_SA(b, h) (((b) * 2 + (h)) * HTB)
#define PG8_SB(b, h) ((4 + (b) * 2 + (h)) * HTB)
#define PG8_STAGE(bufoff, gbase, voff) do { _Pragma("unroll") for (int _i = 0; _i < 2; ++_i) \
        __builtin_amdgcn_global_load_lds((const unsigned*)((const char*)(gbase) + (voff)[_i]), (PG8_LAS unsigned*)(lds + (bufoff) + ldsw + _i * 8192), 16, 0, 0); } while (0)
#define PG8_LDA(dst, b, h) do { _Pragma("unroll") for (int m = 0; m < 4; ++m) _Pragma("unroll") for (int k = 0; k < 2; ++k) dst[m][k] = *(const PG8_LAS bf16x8*)(lds + PG8_SA(b, h) + aoff + m * 2048 + k * 1024); } while (0)
#define PG8_LDB(dst, b, h) do { _Pragma("unroll") for (int n = 0; n < 2; ++n) _Pragma("unroll") for (int k = 0; k < 2; ++k) dst[n][k] = *(const PG8_LAS bf16x8*)(lds + PG8_SB(b, h) + boff + n * 2048 + k * 1024); } while (0)
#define PG8_MMA(ai, bj, At, Bt) do { __builtin_amdgcn_s_setprio(1); _Pragma("unroll") for (int m = 0; m < 4; ++m) _Pragma("unroll") for (int n = 0; n < 2; ++n) _Pragma("unroll") for (int k = 0; k < 2; ++k) \
        acc[ai][bj][m][n] = __builtin_amdgcn_mfma_f32_16x16x32_bf16(Bt[n][k], At[m][k], acc[ai][bj][m][n], 0, 0, 0); __builtin_amdgcn_s_setprio(0); } while (0)
#define PG8_WAIT_V(n) asm volatile("s_waitcnt vmcnt(" #n ")" ::: "memory")
#define PG8_WAIT_L(n) asm volatile("s_waitcnt lgkmcnt(" #n ")" ::: "memory")
#define PG8_BAR __builtin_amdgcn_s_barrier()
#define PG8_SCHED __builtin_amdgcn_sched_barrier(0)
    Unit cur, nxt; int ui = 0;
    if (!S.next(0, cur)) return;
    f32x4 acc[2][2][4][2];
#pragma unroll
    for (int a = 0; a < 2; ++a)
#pragma unroll
        for (int b = 0; b < 2; ++b)
#pragma unroll
            for (int m = 0; m < 4; ++m)
#pragma unroll
                for (int n = 0; n < 2; ++n) acc[a][b][m][n] = (f32x4){0.f, 0.f, 0.f, 0.f};
    bf16x8 At[4][2], B0[2][2], B1[2][2];
    const char* cA = (const char*)g.A + (size_t)cur.pm * tstepA + (size_t)cur.pn * g.a_pn_stride * 2; const char* cB = (const char*)g.Bt + (size_t)cur.pn * tstepB;
    PG8_STAGE(PG8_SB(0, 0), cB, voffB); PG8_STAGE(PG8_SB(0, 1), cB + hstepB, voffB); PG8_STAGE(PG8_SA(0, 0), cA, voffA); PG8_STAGE(PG8_SA(0, 1), cA + hstepA, voffA);
    if (wr == 1) PG8_BAR;
    PG8_WAIT_V(2); PG8_BAR;
    PG8_STAGE(PG8_SB(1, 0), cB + kstep, voffB); PG8_STAGE(PG8_SA(1, 0), cA + kstep, voffA); PG8_STAGE(PG8_SB(1, 1), cB + hstepB + kstep, voffB);
    PG8_WAIT_V(6); PG8_BAR;
    for (;;) {
        const bool has_next = S.next(ui + 1, nxt);
        const char* nA = has_next ? (const char*)g.A + (size_t)nxt.pm * tstepA + (size_t)nxt.pn * g.a_pn_stride * 2 : cA; const char* nB = has_next ? (const char*)g.Bt + (size_t)nxt.pn * tstepB : cB;
        for (int t = 0; t < nt; t += 2) {
            const bool last = (t == nt - 2);
            const char* a1 = cA + (size_t)(t + 1) * kstep;
            const char* a2 = last ? nA : cA + (size_t)(t + 2) * kstep; const char* b2 = last ? nB : cB + (size_t)(t + 2) * kstep;
            const char* a3 = a2 + kstep; const char* b3 = b2 + kstep;
            if constexpr (Hook::ON) { if (t == (nt >> 1)) H.mid(acc, cur, wr, wc, fr, fq); }
            PG8_LDB(B0, 0, 0); PG8_LDB(B1, 0, 1); PG8_SCHED; PG8_LDA(At, 0, 0); PG8_STAGE(PG8_SA(1, 1), a1 + hstepA, voffA);
            PG8_WAIT_V(8); PG8_WAIT_L(0); PG8_BAR; PG8_MMA(0, 0, At, B0); PG8_MMA(0, 1, At, B1); PG8_BAR; PG8_SCHED;
            PG8_LDA(At, 0, 1); PG8_STAGE(PG8_SB(0, 0), b2, voffB); PG8_STAGE(PG8_SB(0, 1), b2 + hstepB, voffB); PG8_STAGE(PG8_SA(0, 0), a2, voffA);
            PG8_WAIT_V(8); PG8_WAIT_L(0); PG8_BAR; PG8_MMA(1, 0, At, B0); PG8_MMA(1, 1, At, B1); PG8_BAR; PG8_SCHED;
            PG8_LDB(B0, 1, 0); PG8_LDB(B1, 1, 1); PG8_SCHED; PG8_LDA(At, 1, 0); PG8_STAGE(PG8_SA(0, 1), a2 + hstepA, voffA);
            PG8_WAIT_V(8); PG8_WAIT_L(0); PG8_BAR; PG8_MMA(0, 0, At, B0); PG8_MMA(0, 1, At, B1); PG8_BAR; PG8_SCHED;
            PG8_LDA(At, 1, 1); PG8_STAGE(PG8_SB(1, 0), b3, voffB); PG8_STAGE(PG8_SB(1, 1), b3 + hstepB, voffB); PG8_STAGE(PG8_SA(1, 0), a3, voffA);
            PG8_WAIT_V(8); PG8_WAIT_L(0); PG8_BAR; PG8_MMA(1, 0, At, B0); PG8_MMA(1, 1, At, B1); PG8_BAR; PG8_SCHED;
        }
        if (wr == 0) PG8_BAR;
        E(acc, cur, wr, wc, fr, fq);
        if (!has_next) break;
#pragma unroll
        for (int a = 0; a < 2; ++a)
#pragma unroll
            for (int b = 0; b < 2; ++b)
#pragma unroll
                for (int m = 0; m < 4; ++m)
#pragma unroll
                    for (int n = 0; n < 2; ++n) acc[a][b][m][n] = (f32x4){0.f, 0.f, 0.f, 0.f};
        cur = nxt; cA = nA; cB = nB; ++ui;
        if (wr == 1) PG8_BAR;
    }
    PG8_WAIT_V(0);
    PG8_BAR;
#undef PG8_SA
#undef PG8_SB
#undef PG8_STAGE
#undef PG8_LDA
#undef PG8_LDB
#undef PG8_MMA
#undef PG8_WAIT_V
#undef PG8_WAIT_L
#undef PG8_BAR
#undef PG8_SCHED
}
}

constexpr int NWAVES = 8, NTHR = NWAVES * 64;
constexpr int DM = 2048, NBATCH = 4, SEQ = 4096, DEPTH = 4, M = NBATCH * SEQ;
constexpr int HGW = 1024;
constexpr int SAH = 16, SAC = 256, SAR = 512;
constexpr int DFF = 5632;
constexpr int N1 = 9216, N3 = 5120, N10 = 2 * DFF;
constexpr float ALPHA = 1.6817928305074292f;
constexpr int MODW = 6 * DM;

constexpr size_t MiB = 1u << 20;
constexpr size_t WS_CTL = 0, CTL_ZERO_BYTES = 32768;
constexpr size_t WS_MOD = 1 * MiB;
constexpr size_t WS_LB = 2 * MiB;
constexpr size_t WS_MODP = 3 * MiB;
constexpr size_t WS_W1 = 9 * MiB;
constexpr size_t WS_W3 = WS_W1 + 36 * MiB;
constexpr size_t WS_W6 = WS_W3 + 5 * MiB;
constexpr size_t WS_W7 = WS_W6 + 2 * MiB;
constexpr size_t WS_W8 = WS_W7 + 8 * MiB;
constexpr size_t WS_W10 = WS_W8 + 8 * MiB;
constexpr size_t WS_W11 = WS_W10 + 44 * MiB;
constexpr size_t WS_X = WS_W11 + 22 * MiB;
constexpr size_t WS_R = WS_X + 128 * MiB;
constexpr size_t WS_H = WS_R + 128 * MiB;
constexpr size_t WS_QA = WS_H + 64 * MiB;
constexpr size_t WS_FA = WS_QA + 32 * MiB;
constexpr size_t WS_IA = WS_FA + 64 * MiB;
constexpr size_t WS_GA = WS_IA + 32 * MiB;
constexpr size_t WS_LAT = WS_GA + 32 * MiB;
constexpr size_t WS_GTA = WS_LAT + 64 * MiB;
constexpr size_t WS_GTB = WS_GTA + 64 * MiB;
constexpr size_t WS_CQN = WS_GTB + 64 * MiB;
constexpr size_t WS_CKV = WS_CQN + 16 * MiB;
constexpr size_t WS_KIDX = WS_CKV + 8 * MiB;
constexpr size_t WS_IDXW = WS_KIDX + 2 * MiB;
constexpr size_t WS_QB = WS_IDXW + 1 * MiB;
constexpr size_t WS_QIDX = WS_QB + 128 * MiB;
constexpr size_t WS_SEL = WS_QIDX + 32 * MiB;
constexpr size_t WS_YAB = WS_SEL + 8 * MiB;
constexpr size_t WS_MRG = WS_FA;
constexpr size_t WS_OB = WS_YAB + 64 * MiB;
constexpr size_t WS_BIG = WS_OB + 128 * MiB;
constexpr size_t WS_KSB = WS_BIG + 256 * MiB;
constexpr size_t WS_DEB = WS_KSB + 32 * MiB;
constexpr size_t WS_QSB = WS_DEB + 2 * MiB;
constexpr size_t WS_END = WS_QSB + 32 * MiB;

constexpr int CW_BAR = 4096;

constexpr int RING_BYTES = 131072;
constexpr int LDS_BYTES = 163840;
constexpr int LDSCTL_OFF = LDS_BYTES - 1024, MISC_OFF = LDSCTL_OFF + 320, SELL_OFF = 147456;

#define GAS __attribute__((address_space(1)))
#define LAS __attribute__((address_space(3)))
typedef unsigned short bf16;
typedef unsigned v4u __attribute__((ext_vector_type(4)));
typedef unsigned v2u __attribute__((ext_vector_type(2)));
typedef float f32x4 __attribute__((ext_vector_type(4)));
typedef float f32x16 __attribute__((ext_vector_type(16)));
typedef short bf16x8 __attribute__((ext_vector_type(8)));
typedef short v4s __attribute__((ext_vector_type(4)));
typedef GAS unsigned gu32;
#define LDS_WAIT() asm volatile("s_waitcnt lgkmcnt(0)" ::: "memory")
__device__ __forceinline__ unsigned f2bf(float f) { unsigned u = __builtin_bit_cast(unsigned, f); return (u + 0x7fffu + ((u >> 16) & 1u)) >> 16; }
__device__ __forceinline__ unsigned pk2(float lo, float hi) { return pg8::cvt_pk_bf16(lo, hi); }
__device__ __forceinline__ float bf2f(unsigned short b) { return __builtin_bit_cast(float, ((unsigned)b) << 16); }
__device__ __forceinline__ float bflo(unsigned w) { return __builtin_bit_cast(float, w << 16); }
__device__ __forceinline__ float bfhi(unsigned w) { return __builtin_bit_cast(float, w & 0xffff0000u); }
__device__ __forceinline__ float sigm(float x) { return __builtin_amdgcn_rcpf(1.f + __expf(-x)); }

__device__ __forceinline__ int lane_id() { unsigned m = ~0u; asm volatile("" : "+s"(m)); return (int)__builtin_amdgcn_mbcnt_hi(m, __builtin_amdgcn_mbcnt_lo(m, 0u)); }
#define XB_TMO      128
#define XB_XCNT(j)  (256  + 64 * (j))
#define XB_XSUB(j)  (1280 + 64 * (j))
#define XB_XGEN(j)  (2304 + 64 * (j))
#define XB_TOP      3328
#define XB_TOPGEN   3392
#define XCD_BAR_WORDS 3456
#define XB_SPIN_CAP (1u << 22)

__device__ __forceinline__ unsigned xb_ld(unsigned* p)              { return __hip_atomic_load(p, __ATOMIC_RELAXED, __HIP_MEMORY_SCOPE_AGENT); }
__device__ __forceinline__ unsigned xb_add(unsigned* p, unsigned v) { return __hip_atomic_fetch_add(p, v, __ATOMIC_RELAXED, __HIP_MEMORY_SCOPE_AGENT); }
__device__ __forceinline__ unsigned xb_xcc_id() { return (unsigned)__builtin_amdgcn_s_getreg((3 << 11) | 20) & 0xFu; }
#define XB_SPIN(cond, bar) do { unsigned _sp = 0; while (cond) { __builtin_amdgcn_s_sleep(1); \
    if ((++_sp & 255u) == 0u) { if (xb_ld(&(bar)[XB_TMO])) break; if (_sp > XB_SPIN_CAP) { atomicAdd(&(bar)[XB_TMO], 1u); break; } } } } while (0)

struct XcdBarrier { unsigned* bar; unsigned x; volatile LAS unsigned* st; int wave; };

__device__ __forceinline__ XcdBarrier xcd_barrier_post(unsigned* bar, volatile LAS unsigned* st) {
    XcdBarrier b; b.bar = bar; b.x = (unsigned)__builtin_amdgcn_readfirstlane((int)xb_xcc_id()); b.st = st;
    if (threadIdx.x == 0) (void)xb_add(&bar[XB_XCNT(b.x)], 1u);
    return b;
}
__device__ __forceinline__ void xcd_barrier_complete(unsigned* bar, unsigned x, unsigned& nloc, unsigned& nx) {
    const unsigned G = gridDim.x * gridDim.y * gridDim.z;
    unsigned sum, cnt, mine, sp = 0u;
    for (;;) {
        sum = 0u; cnt = 0u; mine = 0u;
#pragma unroll 1
        for (unsigned j = 0; j < 16; ++j) { const unsigned c = xb_ld(&bar[XB_XCNT(j)]); sum += c; cnt += (c > 0u) ? 1u : 0u; mine = (j == x) ? c : mine; }
        if (sum == G) break;
        __builtin_amdgcn_s_sleep(1);
        if ((++sp & 255u) == 0u) { if (xb_ld(&bar[XB_TMO])) break; if (sp > XB_SPIN_CAP) { atomicAdd(&bar[XB_TMO], 1u); break; } }
    }
    nloc = mine > 0u ? mine : 1u; nx = cnt > 0u ? cnt : 1u;
}
__device__ __forceinline__ void xcd_barrier(const XcdBarrier& b) {
    asm volatile("s_waitcnt vmcnt(0)" ::: "memory");
    __syncthreads();
    if (b.wave == 0 && lane_id() == 0) {
        unsigned* bar = b.bar;
        unsigned bx = b.x; asm volatile("" : "+s"(bx));
        __builtin_amdgcn_s_waitcnt(0);
        unsigned nloc = b.st[0], nx = b.st[1];
        const unsigned old = xb_add(&bar[XB_XSUB(bx)], 1u);
        const unsigned gen = old / nloc;
        if (old + 1u == (gen + 1u) * nloc) {
            __builtin_amdgcn_fence(__ATOMIC_RELEASE, "agent");
            asm volatile("s_waitcnt vmcnt(0)" ::: "memory");
            const unsigned og = xb_add(&bar[XB_TOP], 1u);
            const unsigned tg = og / nx;
            if (og + 1u == (tg + 1u) * nx) xb_add(&bar[XB_TOPGEN], 1u);
            else XB_SPIN(xb_ld(&bar[XB_TOPGEN]) == tg, bar);
            __builtin_amdgcn_fence(__ATOMIC_ACQUIRE, "agent");
            xb_add(&bar[XB_XGEN(bx)], 1u);
            asm volatile("s_waitcnt vmcnt(0)" ::: "memory");
        } else {
            XB_SPIN(xb_ld(&bar[XB_XGEN(bx)]) == gen, bar);
            __builtin_amdgcn_fence(__ATOMIC_ACQUIRE, "agent");
            asm volatile("s_waitcnt vmcnt(0)" ::: "memory");
        }
    }
    __syncthreads();
}

__device__ __forceinline__ void xswap16(float& a, float& b) { asm volatile("s_nop 1\n\tv_permlane16_swap_b32 %0, %1\n\ts_nop 1" : "+v"(a), "+v"(b)); }
__device__ __forceinline__ void xswap32(float& a, float& b) { asm volatile("s_nop 1\n\tv_permlane32_swap_b32 %0, %1\n\ts_nop 1" : "+v"(a), "+v"(b)); }
__device__ __forceinline__ float xmax16(float x) { float a = x, b = x; xswap16(a, b); return fmaxf(a, b); }
__device__ __forceinline__ float xmax32(float x) { float a = x, b = x; xswap32(a, b); return fmaxf(a, b); }
__device__ __forceinline__ float xsum16(float x) { float a = x, b = x; xswap16(a, b); return a + b; }
__device__ __forceinline__ float xsum32(float x) { float a = x, b = x; xswap32(a, b); return a + b; }

#define DPPF(x, ctrl) __builtin_bit_cast(float, __builtin_amdgcn_update_dpp(0, __builtin_bit_cast(int, (x)), (ctrl), 0xf, 0xf, true))
__device__ __forceinline__ float wmax_f(float x) {
    x = fmaxf(x, DPPF(x, 0xB1)); x = fmaxf(x, DPPF(x, 0x4E)); x = fmaxf(x, DPPF(x, 0x124)); x = fmaxf(x, DPPF(x, 0x128));
    x = xmax16(x); return xmax32(x);
}
__device__ __forceinline__ unsigned wprefix_u(unsigned x) {
    int v = (int)x;
    v += __builtin_amdgcn_update_dpp(0, v, 0x111, 0xf, 0xf, false);
    v += __builtin_amdgcn_update_dpp(0, v, 0x112, 0xf, 0xf, false);
    v += __builtin_amdgcn_update_dpp(0, v, 0x114, 0xf, 0xf, false);
    v += __builtin_amdgcn_update_dpp(0, v, 0x118, 0xf, 0xf, false);
    v += __builtin_amdgcn_update_dpp(0, v, 0x142, 0xa, 0xf, false);
    v += __builtin_amdgcn_update_dpp(0, v, 0x143, 0xc, 0xf, false);
    return (unsigned)v;
}

__device__ __forceinline__ float rowsum16(float x) { x += DPPF(x, 0xB1); x += DPPF(x, 0x4E); x += DPPF(x, 0x124); x += DPPF(x, 0x128); return x; }
__device__ __forceinline__ float wave_sum(float x) { x = rowsum16(x); x = xsum16(x); return xsum32(x); }
__device__ __forceinline__ float wave_max(float x) { return wmax_f(x); }
__device__ __forceinline__ int wave_sum_i(int v) { float f = wave_sum((float)v); return (int)(f + 0.5f); }
template <class Src>
__device__ __forceinline__ void cvt_load(const Src& src, int k0, int n0, int lane, float (&tv)[32]) {
#pragma unroll
    for (int i = 0; i < 32; ++i) tv[i] = src(k0 + 2 * i + (lane >> 5), n0 + (lane & 31));
}
__device__ __forceinline__ void cvt_store(const float (&tv)[32], bf16* WT, int K, int k0, int n0, LAS float* scr, int lane) {
#pragma unroll
    for (int i = 0; i < 32; ++i) scr[(2 * i + (lane >> 5)) * 33 + (lane & 31)] = tv[i];
    LDS_WAIT(); asm volatile("" ::: "memory");
    const int c = lane & 7;
#pragma unroll
    for (int j = 0; j < 4; ++j) { const int n = (lane >> 3) + 8 * j; const LAS float* s = scr + (8 * c) * 33 + n;
        v4u o; o.x = pk2(s[0 * 33], s[1 * 33]); o.y = pk2(s[2 * 33], s[3 * 33]); o.z = pk2(s[4 * 33], s[5 * 33]); o.w = pk2(s[6 * 33], s[7 * 33]);
        *(GAS v4u*)(WT + (size_t)(n0 + n) * K + k0 + 8 * c) = o; }
    LDS_WAIT(); asm volatile("" ::: "memory");
}

struct Args { const float* in[22]; float* out; unsigned char* ws; };

using pg8::Unit; using pg8::cvt_pk_bf16;
__device__ __forceinline__ void st_bf16x8(bf16* p, f32x4 v0, f32x4 v1) {
    v4u w; w.x = cvt_pk_bf16(v0[0], v0[1]); w.y = cvt_pk_bf16(v0[2], v0[3]); w.z = cvt_pk_bf16(v1[0], v1[1]); w.w = cvt_pk_bf16(v1[2], v1[3]);
    *(v4u*)p = w;
}
__device__ __forceinline__ void st_f32x8(float* p, f32x4 v0, f32x4 v1) { *(f32x4*)p = v0; *(f32x4*)(p + 4) = v1; }
__device__ __forceinline__ f32x4 sigm4(f32x4 v) { return (f32x4){sigm(v[0]), sigm(v[1]), sigm(v[2]), sigm(v[3])}; }
__device__ __forceinline__ f32x4 silu4(f32x4 v) { return (f32x4){v[0] * sigm(v[0]), v[1] * sigm(v[1]), v[2] * sigm(v[2]), v[3] * sigm(v[3])}; }
__device__ __forceinline__ f32x4 ldbf4(const bf16* p) { const v2u w = *(const v2u*)p; return (f32x4){bflo(w.x), bfhi(w.x), bflo(w.y), bfhi(w.y)}; }

#define EPI_LOOP(...) \
    _Pragma("unroll") for (int ai = 0; ai < 2; ++ai) _Pragma("unroll") for (int m = 0; m < 4; ++m) { const int row = row0 + ai * 128 + m * 16; \
        _Pragma("unroll") for (int bj = 0; bj < 2; ++bj) { const int col = colb + bj * 32; const f32x4 v0 = acc[ai][bj][m][0], v1 = acc[ai][bj][m][1]; __VA_ARGS__ } }

__device__ __forceinline__ unsigned q8x4(f32x4 g) { unsigned w = 0u;
#pragma unroll
    for (int e = 0; e < 4; ++e) { const float t = fmaxf(__builtin_fmaf(g[e], 255.f, 0.5f), 1.f); w |= ((unsigned)t) << (8 * e); } return w; }
__device__ __forceinline__ f32x4 ub4(unsigned w) { return (f32x4){(float)(w & 0xffu), (float)((w >> 8) & 0xffu), (float)((w >> 16) & 0xffu), (float)(w >> 24)}; }
struct EpiProj {
    bf16* QA; bf16* FA; bf16* IA; bf16* GA; bf16* LAT; bf16* GTA; bf16* GTB;
    __device__ __forceinline__ void operator()(const f32x4 (&acc)[2][2][4][2], const Unit& u, int wr, int wc, int fr, int fq) const {
        const int row0 = u.pm * 256 + wr * 64 + fr, pn = u.pn; const int colb = (pn & 3) * 256 + wc * 64 + 8 * fq;
        if (pn < 4)       { EPI_LOOP( st_bf16x8(QA + (size_t)row * 1024 + col, v0, v1); ) }
        else if (pn < 8)  { EPI_LOOP( st_bf16x8(FA + (size_t)row * 1024 + col, v0, v1); ) }
        else if (pn < 12) { EPI_LOOP( st_bf16x8(IA + (size_t)row * 1024 + col, v0, v1); ) }
        else if (pn < 16) { EPI_LOOP( st_bf16x8(GA + (size_t)row * 1024 + col, silu4(v0), silu4(v1)); ) }
        else if (pn < 20) { EPI_LOOP( st_bf16x8(LAT + (size_t)row * 1024 + col, v0, v1); ) }
        else { unsigned char* G8 = (unsigned char*)(pn < 28 ? GTA : GTB) + ((size_t)(u.pm * 8 + ((pn - 20) & 7)) * 8 + (wr * 4 + wc)) * 8192 + (fq * 16 + fr) * 16;
            _Pragma("unroll") for (int ai = 0; ai < 2; ++ai) _Pragma("unroll") for (int bj = 0; bj < 2; ++bj) _Pragma("unroll") for (int mp = 0; mp < 2; ++mp) { v4u w;
                w.x = q8x4(sigm4(acc[ai][bj][2 * mp][0])); w.y = q8x4(sigm4(acc[ai][bj][2 * mp][1])); w.z = q8x4(sigm4(acc[ai][bj][2 * mp + 1][0])); w.w = q8x4(sigm4(acc[ai][bj][2 * mp + 1][1]));
                *(v4u*)(G8 + (ai * 4 + bj * 2 + mp) * 1024) = w; } }
    }
};
struct EpiQ {
    bf16* QB; bf16* QIDX;
    __device__ __forceinline__ void operator()(const f32x4 (&acc)[2][2][4][2], const Unit& u, int wr, int wc, int fr, int fq) const {
        const int row0 = u.pm * 256 + wr * 64 + fr, pn = u.pn;
        if (pn < 16) { const int colb = pn * 256 + wc * 64 + 8 * fq; EPI_LOOP( st_bf16x8(QB + (size_t)row * 4096 + col, v0, v1); ) }
        else { const int colb = (pn - 16) * 256 + wc * 64 + 8 * fq; EPI_LOOP( st_bf16x8(QIDX + (size_t)row * 1024 + col, v0, v1); ) }
    }
};
struct EpiBf {
    bf16* O; int ldc; int coff;
    __device__ __forceinline__ void operator()(const f32x4 (&acc)[2][2][4][2], const Unit& u, int wr, int wc, int fr, int fq) const {
        const int row0 = u.pm * 256 + wr * 64 + fr; const int colb = coff + u.pn * 256 + wc * 64 + 8 * fq;
        EPI_LOOP( st_bf16x8(O + (size_t)row * ldc + col, v0, v1); )
    }
};
struct HookGate {
    static constexpr bool ON = true; const bf16* GA_; const bf16* GB_;
    __device__ __forceinline__ void mid(f32x4 (&acc)[2][2][4][2], const Unit& u, int wr, int wc, int fr, int fq) const {
        asm volatile("" : "+v"(fr), "+v"(fq));
        const size_t off = ((size_t)(u.pm * 8 + u.pn) * 8 + (wr * 4 + wc)) * 8192 + (fq * 16 + fr) * 16;
        const unsigned char* A8 = (const unsigned char*)GA_ + off; const unsigned char* B8 = (const unsigned char*)GB_ + off;
#pragma unroll
        for (int ai = 0; ai < 2; ++ai)
#pragma unroll
            for (int mp = 0; mp < 2; ++mp) {
#pragma unroll
                for (int bj = 0; bj < 2; ++bj) { const v4u a = *(const v4u*)(A8 + (ai * 4 + bj * 2 + mp) * 1024), b = *(const v4u*)(B8 + (ai * 4 + bj * 2 + mp) * 1024);
#pragma unroll
                    for (int mm = 0; mm < 2; ++mm)
#pragma unroll
                        for (int n = 0; n < 2; ++n) { const unsigned aw = a[mm * 2 + n], bw = b[mm * 2 + n]; const f32x4 fa = ub4(aw), fb = ub4(bw); f32x4 r;
#pragma unroll
                            for (int j = 0; j < 4; ++j) r[j] = fa[j] * __builtin_amdgcn_rcpf(fb[j]);
                            acc[ai][bj][2 * mp + mm][n] = acc[ai][bj][2 * mp + mm][n] * r; } }
                asm volatile("" : "+v"(acc[ai][0][2 * mp][0]), "+v"(acc[ai][0][2 * mp][1]), "+v"(acc[ai][1][2 * mp][0]), "+v"(acc[ai][1][2 * mp][1]));
                asm volatile("" : "+v"(acc[ai][0][2 * mp + 1][0]), "+v"(acc[ai][0][2 * mp + 1][1]), "+v"(acc[ai][1][2 * mp + 1][0]), "+v"(acc[ai][1][2 * mp + 1][1]));
                asm volatile("" ::: "memory"); }
    }
};
__device__ __forceinline__ f32x4 cvbf4(v2u w) { return (f32x4){bflo(w.x), bfhi(w.x), bflo(w.y), bfhi(w.y)}; }
struct EpiGateM {
    const bf16* GB_; bf16* MRG_;
    __device__ __forceinline__ void operator()(const f32x4 (&acc)[2][2][4][2], const Unit& u, int wr, int wc, int fr, int fq) const {
        const int row0 = u.pm * 256 + wr * 64 + fr; const int colb = u.pn * 256 + wc * 64 + 8 * fq;
        const unsigned char* B8 = (const unsigned char*)GB_ + ((size_t)(u.pm * 8 + u.pn) * 8 + (wr * 4 + wc)) * 8192 + (fq * 16 + fr) * 16;
#pragma unroll
        for (int ai = 0; ai < 2; ++ai) { v4u gr[2][2];
#pragma unroll
            for (int bj = 0; bj < 2; ++bj)
#pragma unroll
                for (int mp = 0; mp < 2; ++mp) gr[bj][mp] = *(const v4u*)(B8 + (ai * 4 + bj * 2 + mp) * 1024);
#pragma unroll
            for (int m = 0; m < 4; ++m)
#pragma unroll
                for (int bj = 0; bj < 2; ++bj) { const size_t o = (size_t)(row0 + ai * 128 + m * 16) * 2048 + colb + bj * 32;
                    const unsigned w0 = gr[bj][m >> 1][(m & 1) * 2], w1 = gr[bj][m >> 1][(m & 1) * 2 + 1];
                    st_bf16x8(MRG_ + o, acc[ai][bj][m][0] * (ub4(w0) * (1.f / 255.f)), acc[ai][bj][m][1] * (ub4(w1) * (1.f / 255.f))); } }
    }
};
struct EpiGateA {
    float* T1; const bf16* GT;
    __device__ __forceinline__ void operator()(const f32x4 (&acc)[2][2][4][2], const Unit& u, int wr, int wc, int fr, int fq) const {
        const int row0 = u.pm * 256 + wr * 64 + fr; const int colb = u.pn * 256 + wc * 64 + 8 * fq;
        EPI_LOOP( const size_t o = (size_t)row * 2048 + col; const f32x4 g0 = ldbf4(GT + o), g1 = ldbf4(GT + o + 4); st_f32x8(T1 + o, v0 * g0, v1 * g1); )
    }
};
struct EpiGateB {
    const float* T1; const bf16* GT; bf16* MRG;
    __device__ __forceinline__ void operator()(const f32x4 (&acc)[2][2][4][2], const Unit& u, int wr, int wc, int fr, int fq) const {
        const int row0 = u.pm * 256 + wr * 64 + fr; const int colb = u.pn * 256 + wc * 64 + 8 * fq;
        EPI_LOOP( const size_t o = (size_t)row * 2048 + col; const f32x4 g0 = ldbf4(GT + o), g1 = ldbf4(GT + o + 4); const f32x4 t0 = *(const f32x4*)(T1 + o), t1 = *(const f32x4*)(T1 + o + 4);
                  st_bf16x8(MRG + o, t0 + v0 * g0, t1 + v1 * g1); )
    }
};
struct EpiRes {
    const float* X; const bf16* Hh; bf16* R; const float* md; int osh, osc, ogt;
    __device__ __forceinline__ void operator()(const f32x4 (&acc)[2][2][4][2], const Unit& u, int wr, int wc, int fr, int fq) const {
        const int row0 = u.pm * 256 + wr * 64 + fr; const int colb = u.pn * 256 + wc * 64 + 8 * fq; const float* g = md + (size_t)(u.pm >> 4) * MODW;
        f32x4 gg[2][2];
#pragma unroll
        for (int bj = 0; bj < 2; ++bj) { gg[bj][0] = *(const f32x4*)(g + ogt + colb + bj * 32) + 1.f; gg[bj][1] = *(const f32x4*)(g + ogt + colb + bj * 32 + 4) + 1.f; }
        if (X) {
#pragma unroll
            for (int ai = 0; ai < 2; ++ai)
#pragma unroll
                for (int mh = 0; mh < 2; ++mh) { f32x4 xr[2][2][2];
#pragma unroll
                    for (int mm = 0; mm < 2; ++mm)
#pragma unroll
                        for (int bj = 0; bj < 2; ++bj) { const size_t o = (size_t)(row0 + ai * 128 + (2 * mh + mm) * 16) * 2048 + colb + bj * 32; xr[mm][bj][0] = *(const f32x4*)(X + o); xr[mm][bj][1] = *(const f32x4*)(X + o + 4); }
#pragma unroll
                    for (int mm = 0; mm < 2; ++mm)
#pragma unroll
                        for (int bj = 0; bj < 2; ++bj) { const int m = 2 * mh + mm; const size_t o = (size_t)(row0 + ai * 128 + m * 16) * 2048 + colb + bj * 32;
                            st_bf16x8(R + o, xr[mm][bj][0] * ALPHA + gg[bj][0] * acc[ai][bj][m][0], xr[mm][bj][1] * ALPHA + gg[bj][1] * acc[ai][bj][m][1]); } }
        } else {
            f32x4 ia[2][2], sb[2][2];
#pragma unroll
            for (int bj = 0; bj < 2; ++bj)
#pragma unroll
                for (int hh = 0; hh < 2; ++hh) { const f32x4 sc = *(const f32x4*)(g + osc + colb + bj * 32 + 4 * hh), sh = *(const f32x4*)(g + osh + colb + bj * 32 + 4 * hh);
#pragma unroll
                    for (int e = 0; e < 4; ++e) { ia[bj][hh][e] = ALPHA / (1.f + sc[e]); sb[bj][hh][e] = sh[e] * ia[bj][hh][e]; } }
#pragma unroll
            for (int ai = 0; ai < 2; ++ai) { v2u xr[4][2][2];
#pragma unroll
                for (int m = 0; m < 4; ++m)
#pragma unroll
                    for (int bj = 0; bj < 2; ++bj) { const size_t o = (size_t)(row0 + ai * 128 + m * 16) * 2048 + colb + bj * 32; xr[m][bj][0] = *(const v2u*)(Hh + o); xr[m][bj][1] = *(const v2u*)(Hh + o + 4); }
#pragma unroll
                for (int m = 0; m < 4; ++m)
#pragma unroll
                    for (int bj = 0; bj < 2; ++bj) { const size_t o = (size_t)(row0 + ai * 128 + m * 16) * 2048 + colb + bj * 32;
                        st_bf16x8(R + o, cvbf4(xr[m][bj][0]) * ia[bj][0] - sb[bj][0] + gg[bj][0] * acc[ai][bj][m][0], cvbf4(xr[m][bj][1]) * ia[bj][1] - sb[bj][1] + gg[bj][1] * acc[ai][bj][m][1]); } }
        }
    }
};
template <int which, bool FINAL>
struct EpiLn {
    unsigned char* ws; const float* X; float* Fo; const float* lng; const float* lnb; LAS unsigned char* lds; int l;
    __device__ __forceinline__ void operator()(f32x4 (&acc)[2][2][4][2], const Unit& u, int wr, int wc, int fr, int fq) const {
        { const int ln_ = lane_id(); fr = ln_ & 15; fq = ln_ >> 4; }
        int upm = u.pm, upn = u.pn; asm volatile("" : "+s"(upm), "+s"(upn));
        const float* MODb = (const float*)(ws + WS_MOD); bf16* Hh = (bf16*)(ws + WS_H);
        const float* g = MODb + ((size_t)l * NBATCH + (upm >> 4)) * MODW + (which ? 3 * DM : 0);
        const float* go = which ? MODb + ((size_t)(l + 1 < DEPTH ? l + 1 : l) * NBATCH + (upm >> 4)) * MODW : g + 3 * DM;
        LAS float* sl = (LAS float*)(lds + RING_BYTES);
        const int row0 = upm * 256 + wr * 64 + fr; const int colb = upn * 256 + wc * 64 + 8 * fq;
#pragma unroll
        for (int bj = 0; bj < 2; ++bj) { const int c0 = colb + bj * 32;
            const f32x4 gg0 = *(const f32x4*)(g + 2 * DM + c0) + 1.f, gg1 = *(const f32x4*)(g + 2 * DM + c0 + 4) + 1.f;
            if (which == 0 && X) {
#pragma unroll
                for (int ai = 0; ai < 2; ++ai) { f32x4 xr[4][2];
#pragma unroll
                    for (int m = 0; m < 4; ++m) { const size_t o = (size_t)(row0 + ai * 128 + m * 16) * 2048 + c0; xr[m][0] = *(const f32x4*)(X + o); xr[m][1] = *(const f32x4*)(X + o + 4); }
#pragma unroll
                    for (int m = 0; m < 4; ++m) { acc[ai][bj][m][0] = xr[m][0] * ALPHA + gg0 * acc[ai][bj][m][0]; acc[ai][bj][m][1] = xr[m][1] * ALPHA + gg1 * acc[ai][bj][m][1]; } }
            } else {
                f32x4 ia0, ia1, sb0, sb1;
                { const f32x4 sc0 = *(const f32x4*)(g + DM + c0), sc1 = *(const f32x4*)(g + DM + c0 + 4), sh0 = *(const f32x4*)(g + c0), sh1 = *(const f32x4*)(g + c0 + 4);
#pragma unroll
                  for (int e = 0; e < 4; ++e) { ia0[e] = ALPHA * __builtin_amdgcn_rcpf(1.f + sc0[e]); ia1[e] = ALPHA * __builtin_amdgcn_rcpf(1.f + sc1[e]); sb0[e] = sh0[e] * ia0[e]; sb1[e] = sh1[e] * ia1[e]; } }
#pragma unroll
                for (int ai = 0; ai < 2; ++ai) { v2u xr[4][2];
#pragma unroll
                    for (int m = 0; m < 4; ++m) { const size_t o = (size_t)(row0 + ai * 128 + m * 16) * 2048 + c0; xr[m][0] = *(const v2u*)(Hh + o); xr[m][1] = *(const v2u*)(Hh + o + 4); }
#pragma unroll
                    for (int m = 0; m < 4; ++m) { acc[ai][bj][m][0] = cvbf4(xr[m][0]) * ia0 - sb0 + gg0 * acc[ai][bj][m][0]; acc[ai][bj][m][1] = cvbf4(xr[m][1]) * ia1 - sb1 + gg1 * acc[ai][bj][m][1]; }
                    asm volatile("" ::: "memory"); }
            }
            asm volatile("" ::: "memory"); }
        { const int ln_ = lane_id(); fr = ln_ & 15; fq = ln_ >> 4; }
#pragma unroll
        for (int ai = 0; ai < 2; ++ai)
#pragma unroll
            for (int m = 0; m < 4; ++m) { float s1 = 0.f, s2 = 0.f;
#pragma unroll
                for (int bj = 0; bj < 2; ++bj)
#pragma unroll
                    for (int hh = 0; hh < 2; ++hh) { const f32x4 v = acc[ai][bj][m][hh]; s1 += (v[0] + v[1]) + (v[2] + v[3]); s2 += (v[0] * v[0] + v[1] * v[1]) + (v[2] * v[2] + v[3] * v[3]); }
                s1 = xsum32(xsum16(s1)); s2 = xsum32(xsum16(s2));
                if (fq == 0) { const int rt = ai * 128 + wr * 64 + m * 16 + fr; sl[(wc * 256 + rt) * 2] = s1; sl[(wc * 256 + rt) * 2 + 1] = s2; } }
        __syncthreads();
        const int tid = (wr * 4 + wc) * 64 + lane_id();
        float* ex = (float*)(ws + WS_SEL) + (size_t)upm * 8 * 512;
        if (tid < 256) { const float S1 = (sl[tid * 2] + sl[(256 + tid) * 2]) + (sl[(512 + tid) * 2] + sl[(768 + tid) * 2]), S2 = (sl[tid * 2 + 1] + sl[(256 + tid) * 2 + 1]) + (sl[(512 + tid) * 2 + 1] + sl[(768 + tid) * 2 + 1]);
            __hip_atomic_store((unsigned*)(ex + (upn * 256 + tid) * 2), __builtin_bit_cast(unsigned, S1), __ATOMIC_RELAXED, __HIP_MEMORY_SCOPE_AGENT);
            __hip_atomic_store((unsigned*)(ex + (upn * 256 + tid) * 2 + 1), __builtin_bit_cast(unsigned, S2), __ATOMIC_RELAXED, __HIP_MEMORY_SCOPE_AGENT); }
        asm volatile("s_waitcnt vmcnt(0)" ::: "memory");
        __syncthreads();
        if (tid == 0) { unsigned* cp = (unsigned*)(ws + WS_CTL) + 256 + (l * 2 + which) * 64 + upm;
            __builtin_amdgcn_fence(__ATOMIC_RELEASE, "agent"); asm volatile("s_waitcnt vmcnt(0)" ::: "memory");
            (void)xb_add(cp, 1u);
            for (unsigned sp = 0u; xb_ld(cp) < 8u && sp < 400000u; ++sp) __builtin_amdgcn_s_sleep(1);
            __builtin_amdgcn_fence(__ATOMIC_ACQUIRE, "agent"); asm volatile("s_waitcnt vmcnt(0)" ::: "memory"); }
        __syncthreads();
        if (tid < 256) { float S1 = 0.f, S2 = 0.f;
#pragma unroll
            for (int p = 0; p < 8; ++p) { S1 += __builtin_bit_cast(float, __hip_atomic_load((unsigned*)(ex + (p * 256 + tid) * 2), __ATOMIC_RELAXED, __HIP_MEMORY_SCOPE_AGENT));
                S2 += __builtin_bit_cast(float, __hip_atomic_load((unsigned*)(ex + (p * 256 + tid) * 2 + 1), __ATOMIC_RELAXED, __HIP_MEMORY_SCOPE_AGENT)); }
            const float mean = S1 * (1.f / DM); const float var = fmaxf(S2 * (1.f / DM) - mean * mean, 0.f);
            sl[2048 + tid * 2] = mean; sl[2048 + tid * 2 + 1] = 1.0f / sqrtf(var + 1e-5f); }
        __syncthreads();
        { const int ln_ = lane_id(); fr = ln_ & 15; fq = ln_ >> 4; }
        const int row1 = upm * 256 + wr * 64 + fr; const int colc = upn * 256 + wc * 64 + 8 * fq;
#pragma unroll
        for (int bj = 0; bj < 2; ++bj) { const int c0 = colc + bj * 32;
            const f32x4 lg0 = *(const f32x4*)(lng + c0), lg1 = *(const f32x4*)(lng + c0 + 4), lb0 = *(const f32x4*)(lnb + c0), lb1 = *(const f32x4*)(lnb + c0 + 4);
            const f32x4 q0 = *(const f32x4*)(go + DM + c0) + 1.f, q1 = *(const f32x4*)(go + DM + c0 + 4) + 1.f, h0 = *(const f32x4*)(go + c0), h1 = *(const f32x4*)(go + c0 + 4);
#pragma unroll
            for (int ai = 0; ai < 2; ++ai)
#pragma unroll
                for (int m = 0; m < 4; ++m) { const int rt = ai * 128 + wr * 64 + m * 16 + fr; const float mean = sl[2048 + rt * 2], rstd = sl[2048 + rt * 2 + 1];
                    const size_t o = (size_t)(row1 + ai * 128 + m * 16) * 2048 + c0;
                    const f32x4 y0 = (acc[ai][bj][m][0] - mean) * rstd * lg0 + lb0, y1 = (acc[ai][bj][m][1] - mean) * rstd * lg1 + lb1;
                    if constexpr (FINAL) { *(f32x4*)(Fo + o) = y0; *(f32x4*)(Fo + o + 4) = y1; }
                    else st_bf16x8(Hh + o, y0 * q0 + h0, y1 * q1 + h1); }
            asm volatile("" ::: "memory"); }
    }
};
struct EpiSwiglu {
    bf16* ACT;
    __device__ __forceinline__ void operator()(const f32x4 (&acc)[2][2][4][2], const Unit& u, int wr, int wc, int fr, int fq) const {
        const int row0 = u.pm * 256 + wr * 64 + fr; const int col = u.pn * 128 + wc * 32 + 8 * fq;
#pragma unroll
        for (int ai = 0; ai < 2; ++ai)
#pragma unroll
            for (int m = 0; m < 4; ++m) { const int row = row0 + ai * 128 + m * 16;
                st_bf16x8(ACT + (size_t)row * DFF + col, silu4(acc[ai][0][m][0]) * acc[ai][1][m][0], silu4(acc[ai][0][m][1]) * acc[ai][1][m][1]); }
    }
};

__global__ void __launch_bounds__(NTHR, 2) fwd_kernel(Args args) {
    extern __shared__ __attribute__((aligned(16))) unsigned char lds_raw[];
    LAS unsigned char* lds = (LAS unsigned char*)lds_raw;
    const int G = gridDim.x, blk = blockIdx.x;
    const int NGW = G * NWAVES, NT = G * NTHR;
    unsigned char* const ws_base = args.ws;
    gu32* ctl = (gu32*)(ws_base + WS_CTL);
    for (int u = threadIdx.x; u < (LDS_BYTES - LDSCTL_OFF) / 4; u += NTHR) ((LAS unsigned*)(lds + LDSCTL_OFF))[u] = 0u;
    __syncthreads();
    volatile LAS unsigned* MISC = (volatile LAS unsigned*)(lds + MISC_OFF);
    const int wave_s = __builtin_amdgcn_readfirstlane((int)(threadIdx.x >> 6));
    XcdBarrier bar = xcd_barrier_post((unsigned*)(ctl + CW_BAR), MISC + 8); bar.wave = wave_s;
    if (threadIdx.x == 0) { unsigned nloc_ = 0u, nx_ = 0u; xcd_barrier_complete(bar.bar, bar.x, nloc_, nx_); bar.st[0] = nloc_; bar.st[1] = nx_; }
    __syncthreads();
#define GRID_BAR() xcd_barrier(bar)

#define x_in ((const float*)(const GAS float*)args.in[0 + z_])
#define c_in ((const float*)(const GAS float*)args.in[1 + z_])
#define w_ada ((const float*)(const GAS float*)args.in[2 + z_])
#define b_ada ((const float*)(const GAS float*)args.in[3 + z_])
#define w_in ((const float*)(const GAS float*)args.in[4 + z_])
#define lb_logits ((const float*)(const GAS float*)args.in[5 + z_])
#define g_hg ((const float*)(const GAS float*)args.in[6 + z_])
#define w_pa ((const float*)(const GAS float*)args.in[7 + z_])
#define g_cq ((const float*)(const GAS float*)args.in[8 + z_])
#define g_ckv ((const float*)(const GAS float*)args.in[9 + z_])
#define w_uq ((const float*)(const GAS float*)args.in[10 + z_])
#define w_iq ((const float*)(const GAS float*)args.in[11 + z_])
#define w_uv ((const float*)(const GAS float*)args.in[12 + z_])
#define w_pb ((const float*)(const GAS float*)args.in[13 + z_])
#define w_out ((const float*)(const GAS float*)args.in[14 + z_])
#define ln1_g ((const float*)(const GAS float*)args.in[15 + z_])
#define ln1_b ((const float*)(const GAS float*)args.in[16 + z_])
#define w_gate ((const float*)(const GAS float*)args.in[17 + z_])
#define w_up ((const float*)(const GAS float*)args.in[18 + z_])
#define w_down ((const float*)(const GAS float*)args.in[19 + z_])
#define ln2_g ((const float*)(const GAS float*)args.in[20 + z_])
#define ln2_b ((const float*)(const GAS float*)args.in[21 + z_])
#define MOD  ((float*)(ws + WS_MOD))
#define LB   ((float*)(ws + WS_LB))
#define MODP ((float*)(ws + WS_MODP))
#define W1   ((bf16*)(ws + WS_W1))
#define W3   ((bf16*)(ws + WS_W3))
#define W6   ((bf16*)(ws + WS_W6))
#define W7   ((bf16*)(ws + WS_W7))
#define W8   ((bf16*)(ws + WS_W8))
#define W10  ((bf16*)(ws + WS_W10))
#define W11  ((bf16*)(ws + WS_W11))
#define XB   ((bf16*)(ws + WS_X))
#define RB   ((bf16*)(ws + WS_R))
#define HB   ((bf16*)(ws + WS_H))
#define QA   ((bf16*)(ws + WS_QA))
#define FA   ((bf16*)(ws + WS_FA))
#define IA   ((bf16*)(ws + WS_IA))
#define GA   ((bf16*)(ws + WS_GA))
#define LAT  ((bf16*)(ws + WS_LAT))
#define GTA  ((bf16*)(ws + WS_GTA))
#define GTB  ((bf16*)(ws + WS_GTB))
#define CQN  ((bf16*)(ws + WS_CQN))
#define CKV  ((bf16*)(ws + WS_CKV))
#define KIDX ((bf16*)(ws + WS_KIDX))
#define IDXW ((float*)(ws + WS_IDXW))
#define QB   ((bf16*)(ws + WS_QB))
#define QIDX ((bf16*)(ws + WS_QIDX))
#define SEL  ((unsigned short*)(ws + WS_SEL))
#define YAB  ((bf16*)(ws + WS_YAB))
#define MRG  ((bf16*)(ws + WS_MRG))
#define OB   ((bf16*)(ws + WS_OB))
#define ISC  ((_Float16*)(ws + WS_BIG))
#define OP   ((float*)(ws + WS_BIG))
#define ACT  ((bf16*)(ws + WS_BIG))
#define KK   LAT
#define modl (MOD + (size_t)l * NBATCH * MODW)
#define KSB  ((bf16*)(ws + WS_KSB))
#define QSB  ((bf16*)(ws + WS_QSB))
#define KVT  ((bf16*)(ws + WS_BIG))
#define SPB  ((bf16*)(ws + WS_FA))
#define DEB  ((float*)(ws + WS_DEB))
#define PHASE_BEGIN { unsigned om_ = ~0u; asm volatile("" : "+s"(om_)); int tid = wave_s * 64 + (int)__builtin_amdgcn_mbcnt_hi(om_, __builtin_amdgcn_mbcnt_lo(om_, 0u)); asm volatile("" : "+v"(tid)); int z_ = 0; asm volatile("" : "+s"(z_)); (void)z_; GAS unsigned char* wsg_ = (GAS unsigned char*)ws_base; asm volatile("" : "+s"(wsg_)); unsigned char* ws = (unsigned char*)wsg_; const int lane = tid & 63, wave = __builtin_amdgcn_readfirstlane(tid >> 6); \
        const int gw = blk * NWAVES + wave, gtid = blk * NTHR + tid; LAS float* wscr = (LAS float*)(lds + wave * 16384); (void)lane; (void)gw; (void)gtid; (void)wscr;
#define PHASE_END }

#define CVT_DECODE(IT_, MID_, K0_, N0_) do { int r_ = (IT_); \
        if (r_ < I1) { MID_ = 0; K0_ = (r_ / (N1 / 32)) * 64; N0_ = (r_ % (N1 / 32)) * 32; } else { r_ -= I1; \
        if (r_ < I3) { MID_ = 1; K0_ = (r_ / (N3 / 32)) * 64; N0_ = (r_ % (N3 / 32)) * 32; } else { r_ -= I3; \
        if (r_ < I6) { MID_ = 2; K0_ = (r_ / 32) * 64; N0_ = (r_ % 32) * 32; } else { r_ -= I6; \
        if (r_ < I7) { MID_ = 3; K0_ = (r_ / (DM / 32)) * 64; N0_ = (r_ % (DM / 32)) * 32; } else { r_ -= I7; \
        if (r_ < I8) { MID_ = 4; K0_ = (r_ / (DM / 32)) * 64; N0_ = (r_ % (DM / 32)) * 32; } else { r_ -= I8; \
        if (r_ < I10) { MID_ = 5; K0_ = (r_ / (N10 / 32)) * 64; N0_ = (r_ % (N10 / 32)) * 32; } else { r_ -= I10; \
        MID_ = 6; K0_ = (r_ / (DM / 32)) * 64; N0_ = (r_ % (DM / 32)) * 32; } } } } } } } while (0)
#define CVT_LOAD(MID_, K0_, N0_, TV_) do { \
        if (MID_ == 0) cvt_load([=](int k, int n) -> float { return n < 4944 ? s_in[(size_t)k * 9040 + n] : (n < 5120 ? 0.f : s_in[(size_t)k * 9040 + n - 176]); }, K0_, N0_, lane, TV_); \
        else if (MID_ == 1) cvt_load([=](int k, int n) -> float { return n < 4096 ? s_uq[(size_t)k * 4096 + n] * 0.0625f : s_iq[(size_t)k * 1024 + n - 4096]; }, K0_, N0_, lane, TV_); \
        else if (MID_ == 2) cvt_load([=](int k, int n) -> float { const int h = n >> 6, v = n & 63, kk = k >> 8, c = k & 255; return kk == (h & 3) ? s_uv[((size_t)h * 256 + c) * 64 + v] : 0.f; }, K0_, N0_, lane, TV_); \
        else if (MID_ == 3) cvt_load([=](int k, int n) -> float { return k < 1024 ? s_pa[(size_t)k * DM + n] : s_pb[(size_t)(k - 1024) * DM + n]; }, K0_, N0_, lane, TV_); \
        else if (MID_ == 4) cvt_load([=](int k, int n) -> float { return s_out[(size_t)k * DM + n]; }, K0_, N0_, lane, TV_); \
        else if (MID_ == 5) cvt_load([=](int k, int n) -> float { const int pn = n >> 8, rr = n & 255, cc = pn * 128 + (rr >> 6) * 32 + (rr & 31); return (rr & 32) ? s_u[(size_t)k * DFF + cc] : s_g[(size_t)k * DFF + cc]; }, K0_, N0_, lane, TV_); \
        else cvt_load([=](int k, int n) -> float { return s_d[(size_t)k * DM + n]; }, K0_, N0_, lane, TV_); } while (0)
#define CONVERT_LAYER(L) do { const int l_ = (L); \
        const float* s_in = w_in + (size_t)l_ * DM * 9040; const float* s_uq = w_uq + (size_t)l_ * SAR * 4096; const float* s_iq = w_iq + (size_t)l_ * SAR * 1024; \
        const float* s_uv = w_uv + (size_t)l_ * 16 * 256 * 64; const float* s_pa = w_pa + (size_t)l_ * 1024 * DM; const float* s_pb = w_pb + (size_t)l_ * 1024 * DM; \
        const float* s_out = w_out + (size_t)l_ * DM * DM; const float* s_g = w_gate + (size_t)l_ * DM * DFF; const float* s_u = w_up + (size_t)l_ * DM * DFF; const float* s_d = w_down + (size_t)l_ * DFF * DM; \
        constexpr int I1 = (DM / 64) * (N1 / 32), I3 = (SAR / 64) * (N3 / 32), I6 = (1024 / 64) * (1024 / 32), I7 = (DM / 64) * (DM / 32), I8 = I7, I10 = (DM / 64) * (N10 / 32), I11 = (DFF / 64) * (DM / 32); \
        constexpr int NIT = I1 + I3 + I6 + I7 + I8 + I10 + I11; \
        float tv_[32]; int mid_ = 0, k0_ = 0, n0_ = 0; \
        { CVT_DECODE(gw, mid_, k0_, n0_); CVT_LOAD(mid_, k0_, n0_, tv_); } \
        for (int it = gw; it < NIT; it += NGW) { \
            float tc_[32]; _Pragma("unroll") for (int i = 0; i < 32; ++i) tc_[i] = tv_[i]; \
            const int mc_ = mid_, kc_ = k0_, nc_ = n0_; \
            { const int itn_ = it + NGW < NIT ? it + NGW : it; CVT_DECODE(itn_, mid_, k0_, n0_); CVT_LOAD(mid_, k0_, n0_, tv_); }     \
            bf16* wt_ = mc_ == 0 ? W1 : mc_ == 1 ? W3 : mc_ == 2 ? W6 : mc_ == 3 ? W7 : mc_ == 4 ? W8 : mc_ == 5 ? W10 : W11; \
            const int kk_ = mc_ == 0 ? DM : mc_ == 1 ? SAR : mc_ == 2 ? 1024 : mc_ == 3 ? DM : mc_ == 4 ? DM : mc_ == 5 ? DM : DFF; \
            cvt_store(tc_, wt_, kk_, kc_, nc_, wscr, lane); \
        } } while (0)


#ifndef HGRN_NAIVE
#define HGRN_NAIVE 0
#endif
#ifndef IDX_NAIVE
#define IDX_NAIVE 0
#endif
#ifndef ATT_NAIVE
#define ATT_NAIVE 0
#endif
#ifndef TOPK_OLD
#define TOPK_OLD 0
#endif
#ifndef REP_HB
#define REP_HB 1
#endif
#ifndef REP_HC
#define REP_HC 1
#endif
#ifndef REP_P4A
#define REP_P4A 1
#endif
#ifndef REP_P5
#define REP_P5 1
#endif
#ifndef REP_P9
#define REP_P9 1
#endif
#ifndef REP_P12
#define REP_P12 1
#endif
#ifndef REP_TOPK
#define REP_TOPK 1
#endif
#ifndef REP_ATT
#define REP_ATT 1
#endif
#ifndef DRY_ATT
#define DRY_ATT 0
#endif
#ifndef REP_M1
#define REP_M1 1
#endif
#ifndef REP_M2
#define REP_M2 1
#endif
#ifndef REP_M3
#define REP_M3 1
#endif

    PHASE_BEGIN
    {
        LAS float* sc = (LAS float*)lds;
        for (int i = tid; i < NBATCH * DM; i += NTHR) { const float v = c_in[i]; sc[i] = v * sigm(v); }
        __syncthreads();
        for (int item = gtid; item < 8 * 12288; item += NT) {
            const int ks = item / 12288, cg = item % 12288, l = cg / 3072, n4 = (cg % 3072) * 4;
            const float* wp = w_ada + ((size_t)l * DM + ks * 256) * MODW + n4;
            f32x4 a0 = {0.f, 0.f, 0.f, 0.f}, a1 = a0, a2 = a0, a3 = a0;
#pragma unroll 8
            for (int k = 0; k < 256; ++k) { const f32x4 w = *(const f32x4*)(wp + (size_t)k * MODW); const int kk = ks * 256 + k;
                a0 += w * sc[kk]; a1 += w * sc[2048 + kk]; a2 += w * sc[4096 + kk]; a3 += w * sc[6144 + kk]; }
            float* o = MODP + ((size_t)(ks * 4 + l) * 4) * MODW + n4;
            *(f32x4*)(o) = a0; *(f32x4*)(o + MODW) = a1; *(f32x4*)(o + 2 * MODW) = a2; *(f32x4*)(o + 3 * MODW) = a3;
        }
        if (gtid < 1024) {
            const float a = lb_logits[gtid], b = lb_logits[1024 + gtid], c = lb_logits[2048 + gtid], d = lb_logits[3072 + gtid];
            const float mx = fmaxf(fmaxf(a, b), fmaxf(c, d)); const float ea = expf(a - mx), eb = expf(b - mx), ec = expf(c - mx), ed = expf(d - mx); const float inv = 1.f / (ea + eb + ec + ed);
            LB[gtid] = 0.f; LB[1024 + gtid] = eb * inv; LB[2048 + gtid] = (eb + ec) * inv; LB[3072 + gtid] = (eb + ec + ed) * inv;
        }
        __syncthreads();
        CONVERT_LAYER(0);
    }
    PHASE_END
    GRID_BAR();
    PHASE_BEGIN
    for (int i = gtid; i < DEPTH * NBATCH * MODW; i += NT) {
        const int l = i / (NBATCH * MODW), r = i % (NBATCH * MODW), b = r / MODW, n = r % MODW;
        float s = b_ada[l * MODW + n];
#pragma unroll
        for (int ks = 0; ks < 8; ++ks) s += MODP[((size_t)(ks * 4 + l) * 4 + b) * MODW + n];
        MOD[i] = s;
    }
    PHASE_END
    GRID_BAR();
    PHASE_BEGIN
    for (size_t i0 = gtid; i0 < (size_t)M * DM / 8; i0 += (size_t)NT * 4) {
        f32x4 xa[4], xb[4], sa[4], sb[4], ha[4], hb[4];
#pragma unroll
        for (int t = 0; t < 4; ++t) { size_t gi = i0 + (size_t)t * NT; gi = gi < (size_t)M * DM / 8 ? gi : (size_t)M * DM / 8 - 1; const size_t e = gi * 8; const int row = (int)(e / DM), col = (int)(e % DM), b = row / SEQ; const float* md = MOD + (size_t)b * MODW;
            xa[t] = *(const f32x4*)(x_in + e); xb[t] = *(const f32x4*)(x_in + e + 4); sa[t] = *(const f32x4*)(md + 2048 + col); sb[t] = *(const f32x4*)(md + 2048 + col + 4); ha[t] = *(const f32x4*)(md + col); hb[t] = *(const f32x4*)(md + col + 4); }
#pragma unroll
        for (int t = 0; t < 4; ++t) { size_t gi = i0 + (size_t)t * NT; gi = gi < (size_t)M * DM / 8 ? gi : (size_t)M * DM / 8 - 1; const size_t e = gi * 8; st_bf16x8(HB + e, xa[t] * (sa[t] + 1.f) + ha[t], xb[t] * (sb[t] + 1.f) + hb[t]); }
    }
    PHASE_END
    GRID_BAR();

    for (int l = 0; l < DEPTH; ++l) {
        PHASE_BEGIN
        { pg8::Gemm g{HB, W1, M, N1, DM, DM, DM, 0}; pg8::StaticOrder S; S.init(M, N1, G, blk);
          EpiProj E{QA, FA, IA, GA, LAT, GTA, GTB}; pg8::gemm_phase(lds, g, S, E, tid); }
        PHASE_END
        GRID_BAR();
        for (int rep_ = 0; rep_ < REP_M1; ++rep_) {
        PHASE_BEGIN
        v2u ra0, ra1, rkv; unsigned short rki, riw;
        const f32x4 g0 = *(const f32x4*)(g_cq + l * 512 + 4 * lane), g1 = *(const f32x4*)(g_cq + l * 512 + 256 + 4 * lane), gk = *(const f32x4*)(g_ckv + l * 256 + 4 * lane);
        { const bf16* lr = LAT + (size_t)gw * 1024; ra0 = *(const v2u*)(lr + 4 * lane); ra1 = *(const v2u*)(lr + 256 + 4 * lane); rkv = *(const v2u*)(lr + 512 + 4 * lane); rki = lr[768 + lane]; riw = lr[832 + (lane & 15)]; }
        for (int row = gw; row < M; row += NGW) {
            const f32x4 a0 = (f32x4){bflo(ra0.x), bfhi(ra0.x), bflo(ra0.y), bfhi(ra0.y)}, a1 = (f32x4){bflo(ra1.x), bfhi(ra1.x), bflo(ra1.y), bfhi(ra1.y)}, kv = (f32x4){bflo(rkv.x), bfhi(rkv.x), bflo(rkv.y), bfhi(rkv.y)};
            const float ki = bf2f(rki), iw = bf2f(riw);
            { const int rn = row + NGW < M ? row + NGW : row; const bf16* lr = LAT + (size_t)rn * 1024;
              ra0 = *(const v2u*)(lr + 4 * lane); ra1 = *(const v2u*)(lr + 256 + 4 * lane); rkv = *(const v2u*)(lr + 512 + 4 * lane); rki = lr[768 + lane]; riw = lr[832 + (lane & 15)]; }
            float sq = a0[0] * a0[0] + a0[1] * a0[1] + a0[2] * a0[2] + a0[3] * a0[3] + a1[0] * a1[0] + a1[1] * a1[1] + a1[2] * a1[2] + a1[3] * a1[3];
            float sk = kv[0] * kv[0] + kv[1] * kv[1] + kv[2] * kv[2] + kv[3] * kv[3];
            sq = wave_sum(sq); sk = wave_sum(sk);
            const float rq = 1.0f / sqrtf(sq * (1.f / 512.f) + 1e-6f), rk = 1.0f / sqrtf(sk * (1.f / 256.f) + 1e-6f);
            v2u o; f32x4 t = a0 * rq * g0; o.x = pk2(t[0], t[1]); o.y = pk2(t[2], t[3]); *(v2u*)(CQN + (size_t)row * 512 + 4 * lane) = o;
            t = a1 * rq * g1; o.x = pk2(t[0], t[1]); o.y = pk2(t[2], t[3]); *(v2u*)(CQN + (size_t)row * 512 + 256 + 4 * lane) = o;
            t = kv * rk * gk; o.x = pk2(t[0], t[1]); o.y = pk2(t[2], t[3]); *(v2u*)(CKV + (size_t)row * 256 + 4 * lane) = o;
            KIDX[(size_t)row * 64 + lane] = (bf16)f2bf(ki);
            if (lane < 16) IDXW[(size_t)row * 16 + lane] = iw * 0.03125f;
        }
        PHASE_END
        PHASE_BEGIN
        {
            const int cp = tid & 63, sg = tid >> 6;
            LAS unsigned char* KST = lds;
            LAS unsigned char* VTL = lds + 18432;
            LAS float* SEGT = (LAS float*)(lds + 36864);
            LAS float* G63 = (LAS float*)(lds + 40960);
            unsigned pfa[8], pq[8], pv[8]; float plb0, plb1;
#define HA_REQ(U_) do { int uu_ = (U_); asm volatile("" : "+s"(uu_)); const int bh_ = uu_ >> 6, c_ = uu_ & 63, b_ = bh_ >> 3, h_ = bh_ & 7; \
                const size_t rowb_ = (size_t)b_ * SEQ + c_ * 64 + sg * 8; const int col_ = h_ * 128 + 2 * cp; \
                _Pragma("unroll") for (int i = 0; i < 8; ++i) { pfa[i] = *(const unsigned*)(FA + (rowb_ + i) * 1024 + col_); pq[i] = *(const unsigned*)(QA + (rowb_ + i) * 1024 + col_); pv[i] = *(const unsigned*)(IA + (rowb_ + i) * 1024 + col_); } plb0 = LB[l * 1024 + col_]; plb1 = LB[l * 1024 + col_ + 1]; } while (0)
            HA_REQ(blk);
            for (int u = blk; u < 2048; u += G) {
                const int bh = u >> 6, c = u & 63, b = bh >> 3, h = bh & 7;
                const size_t rowb = (size_t)b * SEQ + c * 64 + sg * 8; const int col = h * 128 + 2 * cp;
                const float lb0 = plb0, lb1 = plb1;
                float lf0[8], lf1[8], kk0[8], kk1[8]; unsigned cq[8], cv[8];
#pragma unroll
                for (int i = 0; i < 8; ++i) { cq[i] = pq[i]; cv[i] = pv[i]; }
#pragma unroll
                for (int i = 0; i < 8; ++i) { const float2 fa = make_float2(bflo(pfa[i]), bfhi(pfa[i]));
                    const float f0 = fminf(fmaxf(lb0 + (1.f - lb0) * sigm(fa.x), 1e-6f), 1.f), f1 = fminf(fmaxf(lb1 + (1.f - lb1) * sigm(fa.y), 1e-6f), 1.f);
                    lf0[i] = __logf(f0); lf1[i] = __logf(f1); kk0[i] = (1.f - lb0) * sigm(-fa.x); kk1[i] = (1.f - lb1) * sigm(-fa.y); }
#pragma unroll
                for (int i = 1; i < 8; ++i) { lf0[i] += lf0[i - 1]; lf1[i] += lf1[i - 1]; }
                SEGT[sg * 128 + 2 * cp] = lf0[7]; SEGT[sg * 128 + 2 * cp + 1] = lf1[7];
                HA_REQ(u + G < 2048 ? u + G : u);
                __syncthreads();
                float pre0 = 0.f, pre1 = 0.f, r0 = 0.f, r1 = 0.f, t0 = 0.f, t1 = 0.f;
#pragma unroll
                for (int s2 = 0; s2 < 8; ++s2) { const float a0 = SEGT[s2 * 128 + 2 * cp], a1 = SEGT[s2 * 128 + 2 * cp + 1];
                    if (s2 < sg) { pre0 += a0; pre1 += a1; } if (s2 < 4) { r0 += a0; r1 += a1; } t0 += a0; t1 += a1; }
                unsigned ksw0[4], ksw1[4], vw0[4], vw1[4]; float ks0p = 0.f, ks1p = 0.f, v0p = 0.f, v1p = 0.f;
#pragma unroll
                for (int i = 0; i < 8; ++i) {
                    const float b0 = pre0 + lf0[i], b1 = pre1 + lf1[i];
                    const unsigned qw = cq[i]; const unsigned vw = cv[i];
                    const float qs0 = bflo(qw) * __expf(b0 - r0), qs1 = bfhi(qw) * __expf(b1 - r1);
                    const float ks0 = kk0[i] * __expf(r0 - b0), ks1 = kk1[i] * __expf(r1 - b1);
                    *(unsigned*)(QSB + (rowb + i) * 1024 + col) = pk2(qs0, qs1);
                    *(unsigned*)(KSB + (rowb + i) * 1024 + col) = pk2(ks0, ks1);
                    if (i & 1) { ksw0[i >> 1] = pk2(ks0p, ks0); ksw1[i >> 1] = pk2(ks1p, ks1); vw0[i >> 1] = pk2(v0p, bflo(vw)); vw1[i >> 1] = pk2(v1p, bfhi(vw)); }
                    else { ks0p = ks0; ks1p = ks1; v0p = bflo(vw); v1p = bfhi(vw); }
                }
                *(LAS v4u*)(KST + (2 * cp) * 144 + sg * 16) = (v4u){ksw0[0], ksw0[1], ksw0[2], ksw0[3]};
                *(LAS v4u*)(KST + (2 * cp + 1) * 144 + sg * 16) = (v4u){ksw1[0], ksw1[1], ksw1[2], ksw1[3]};
                *(LAS v4u*)(VTL + (2 * cp) * 144 + sg * 16) = (v4u){vw0[0], vw0[1], vw0[2], vw0[3]};
                *(LAS v4u*)(VTL + (2 * cp + 1) * 144 + sg * 16) = (v4u){vw1[0], vw1[1], vw1[2], vw1[3]};
                if (sg == 7) { float* de = DEB + (size_t)u * 256; *(float2*)(de + 2 * cp) = make_float2(__expf(r0), __expf(r1)); *(float2*)(de + 128 + 2 * cp) = make_float2(__expf(t0), __expf(t1));
                    G63[2 * cp] = __expf(t0 - r0); G63[2 * cp + 1] = __expf(t1 - r1); }
                __syncthreads();
                { const int kt = wave >> 1, vt0 = (wave & 1) * 2, lr = lane & 31, lh = lane >> 5;
                  f32x16 acc0, acc1;
#pragma unroll
                  for (int r = 0; r < 16; ++r) { acc0[r] = 0.f; acc1[r] = 0.f; }
#pragma unroll
                  for (int s4 = 0; s4 < 4; ++s4) {
                      const bf16x8 kb = *(const LAS bf16x8*)(KST + (kt * 32 + lr) * 144 + (s4 * 16 + 8 * lh) * 2);
                      const bf16x8 a0 = *(const LAS bf16x8*)(VTL + (vt0 * 32 + lr) * 144 + (s4 * 16 + 8 * lh) * 2);
                      const bf16x8 a1 = *(const LAS bf16x8*)(VTL + ((vt0 + 1) * 32 + lr) * 144 + (s4 * 16 + 8 * lh) * 2);
                      acc0 = __builtin_amdgcn_mfma_f32_32x32x16_bf16(a0, kb, acc0, 0, 0, 0); acc1 = __builtin_amdgcn_mfma_f32_32x32x16_bf16(a1, kb, acc1, 0, 0, 0); }
                  bf16* kvt = KVT + (size_t)u * 16384 + kt * 32 + lr; const float g = G63[kt * 32 + lr];
#pragma unroll
                  for (int r = 0; r < 16; ++r) { const int vv = 8 * (r >> 2) + 4 * lh + (r & 3);
                      kvt[(size_t)(vt0 * 32 + vv) * 128] = (bf16)(pk2(acc0[r] * g, 0.f) & 0xffffu); kvt[(size_t)((vt0 + 1) * 32 + vv) * 128] = (bf16)(pk2(acc1[r] * g, 0.f) & 0xffffu); } }
                __syncthreads();
            }
        }
#undef HA_REQ
        PHASE_END
        GRID_BAR();
        }
        for (int rep_ = 0; rep_ < REP_M2; ++rep_) {
        PHASE_BEGIN
        for (int item = gtid; item < 32 * 4096; item += NT) {
            const int bh = item >> 12, v = (item >> 5) & 127, k4 = (item & 31) * 4;
            f32x4 S = {0.f, 0.f, 0.f, 0.f};
            for (int c0 = 0; c0 < 64; c0 += 8) {
                f32x4 kv[8], dd[8], ee[8];
#pragma unroll
                for (int j = 0; j < 8; ++j) { const size_t u = (size_t)bh * 64 + c0 + j; kv[j] = ldbf4(KVT + u * 16384 + v * 128 + k4); ee[j] = *(const f32x4*)(DEB + u * 256 + k4); dd[j] = *(const f32x4*)(DEB + u * 256 + 128 + k4); }
#pragma unroll
                for (int j = 0; j < 8; ++j) { const size_t u = (size_t)bh * 64 + c0 + j; const f32x4 sp = S * ee[j]; v2u w; w.x = pk2(sp[0], sp[1]); w.y = pk2(sp[2], sp[3]);
                    *(v2u*)(SPB + u * 16384 + v * 128 + k4) = w; S = S * dd[j] + kv[j]; }
            }
        }
        PHASE_END
        PHASE_BEGIN
        { pg8::Gemm g{CQN, W3, M, N3, SAR, SAR, SAR, 0}; pg8::StaticOrder S; S.init(M, N3, G, blk);
          EpiQ E{QB, QIDX}; pg8::gemm_phase(lds, g, S, E, tid); }
        PHASE_END
        GRID_BAR();
        }
        for (int rep_ = 0; rep_ < REP_M3; ++rep_) {
        PHASE_BEGIN
        {
            LAS unsigned char* QSL = lds;
            LAS unsigned char* KSL = lds + 17408;
            LAS unsigned char* VTL = lds + 34816;
            LAS unsigned char* SPL = lds + 53248;
            LAS unsigned char* AL = lds + 88064;
            LAS float* SSQ = (LAS float*)(lds + 97280);
            const int cp = tid & 63, sg = tid >> 6, lr = lane & 31, lh = lane >> 5;
            v4u rq[2], rk[2], rs[4]; unsigned rv[8]; unsigned short rg[16];
#define HC_REQ(U_) do { int uu_ = (U_); asm volatile("" : "+s"(uu_));   const int bh_ = uu_ >> 6, c_ = uu_ & 63, b_ = bh_ >> 3, h_ = bh_ & 7; const size_t row0_ = (size_t)b_ * SEQ + c_ * 64; const int col0_ = h_ * 128; \
                _Pragma("unroll") for (int j = 0; j < 2; ++j) { const int q = tid + 512 * j, rr = q >> 4, cc = q & 15; \
                    rq[j] = *(const v4u*)(QSB + (row0_ + rr) * 1024 + col0_ + cc * 8); rk[j] = *(const v4u*)(KSB + (row0_ + rr) * 1024 + col0_ + cc * 8); } \
                _Pragma("unroll") for (int j = 0; j < 4; ++j) { const int q = tid + 512 * j, rr = q >> 4, cc = q & 15; rs[j] = *(const v4u*)(SPB + (size_t)uu_ * 16384 + rr * 128 + cc * 8); } \
                _Pragma("unroll") for (int i = 0; i < 8; ++i) rv[i] = *(const unsigned*)(IA + (row0_ + sg * 8 + i) * 1024 + col0_ + 2 * cp); \
                { const int it_ = wave >> 2, vt_ = wave & 3; const int colg_ = col0_ + vt_ * 32 + lr; \
                  _Pragma("unroll") for (int r = 0; r < 16; ++r) { const int ii = it_ * 32 + 8 * (r >> 2) + 4 * lh + (r & 3); rg[r] = GA[(row0_ + ii) * 1024 + colg_]; } } } while (0)
            HC_REQ(blk);
            for (int u = blk; u < 2048; u += G) {
                const int bh = u >> 6, c = u & 63, b = bh >> 3, h = bh & 7;
                const size_t row0 = (size_t)b * SEQ + c * 64; const int col0 = h * 128;
#pragma unroll
                for (int j = 0; j < 2; ++j) { const int q = tid + 512 * j, rr = q >> 4, cc = q & 15;
                    *(LAS v4u*)(QSL + rr * 272 + cc * 16) = rq[j]; *(LAS v4u*)(KSL + rr * 272 + cc * 16) = rk[j]; }
#pragma unroll
                for (int j = 0; j < 4; ++j) { const int q = tid + 512 * j, rr = q >> 4, cc = q & 15; *(LAS v4u*)(SPL + rr * 272 + cc * 16) = rs[j]; }
                { unsigned vw0[4], vw1[4]; float v0p = 0.f, v1p = 0.f;
#pragma unroll
                  for (int i = 0; i < 8; ++i) { const unsigned vw = rv[i];
                      if (i & 1) { vw0[i >> 1] = pk2(v0p, bflo(vw)); vw1[i >> 1] = pk2(v1p, bfhi(vw)); } else { v0p = bflo(vw); v1p = bfhi(vw); } }
                  *(LAS v4u*)(VTL + (2 * cp) * 144 + sg * 16) = (v4u){vw0[0], vw0[1], vw0[2], vw0[3]};
                  *(LAS v4u*)(VTL + (2 * cp + 1) * 144 + sg * 16) = (v4u){vw1[0], vw1[1], vw1[2], vw1[3]}; }
                float gav[16];
#pragma unroll
                for (int r = 0; r < 16; ++r) gav[r] = bf2f(rg[r]);
                const float gg = g_hg[l * 1024 + col0 + (wave & 3) * 32 + lr];
                HC_REQ(u + G < 2048 ? u + G : u);
                __syncthreads();
                if (wave < 4) {
                    const int it = wave >> 1, jt = wave & 1;
                    f32x16 acc;
#pragma unroll
                    for (int r = 0; r < 16; ++r) acc[r] = 0.f;
                    if (!(it == 0 && jt == 1)) {
#pragma unroll
                        for (int s8 = 0; s8 < 8; ++s8) {
                            const bf16x8 a = *(const LAS bf16x8*)(QSL + (it * 32 + lr) * 272 + (s8 * 16 + 8 * lh) * 2);
                            const bf16x8 bb = *(const LAS bf16x8*)(KSL + (jt * 32 + lr) * 272 + (s8 * 16 + 8 * lh) * 2);
                            acc = __builtin_amdgcn_mfma_f32_32x32x16_bf16(a, bb, acc, 0, 0, 0); } }
                    const int jj = jt * 32 + lr;
#pragma unroll
                    for (int r = 0; r < 16; ++r) { const int ii = it * 32 + 8 * (r >> 2) + 4 * lh + (r & 3); const float x = (jj <= ii) ? acc[r] : 0.f;
                        *(LAS unsigned short*)(AL + ii * 144 + jj * 2) = (unsigned short)(pk2(x, 0.f) & 0xffffu); }
                }
                __syncthreads();
                { const int it = wave >> 2, vt = wave & 3;
                  f32x16 acc;
#pragma unroll
                  for (int r = 0; r < 16; ++r) acc[r] = 0.f;
#pragma unroll
                  for (int s4 = 0; s4 < 4; ++s4) {
                      const bf16x8 a = *(const LAS bf16x8*)(AL + (it * 32 + lr) * 144 + (s4 * 16 + 8 * lh) * 2);
                      const bf16x8 bb = *(const LAS bf16x8*)(VTL + (vt * 32 + lr) * 144 + (s4 * 16 + 8 * lh) * 2);
                      acc = __builtin_amdgcn_mfma_f32_32x32x16_bf16(a, bb, acc, 0, 0, 0); }
#pragma unroll
                  for (int s8 = 0; s8 < 8; ++s8) {
                      const bf16x8 a = *(const LAS bf16x8*)(QSL + (it * 32 + lr) * 272 + (s8 * 16 + 8 * lh) * 2);
                      const bf16x8 bb = *(const LAS bf16x8*)(SPL + (vt * 32 + lr) * 272 + (s8 * 16 + 8 * lh) * 2);
                      acc = __builtin_amdgcn_mfma_f32_32x32x16_bf16(a, bb, acc, 0, 0, 0); }
#pragma unroll
                  for (int r = 0; r < 16; ++r) { float q2 = acc[r] * acc[r];
                      q2 = xsum16(rowsum16(q2));
                      if (lr == 0) SSQ[vt * 64 + it * 32 + 8 * (r >> 2) + 4 * lh + (r & 3)] = q2; }
                  __syncthreads();
                  const int colg = col0 + vt * 32 + lr;
#pragma unroll
                  for (int r = 0; r < 16; ++r) { const int ii = it * 32 + 8 * (r >> 2) + 4 * lh + (r & 3);
                      const float ss = SSQ[ii] + SSQ[64 + ii] + SSQ[128 + ii] + SSQ[192 + ii]; const float rn = 1.0f / sqrtf(ss * (1.f / 128.f) + 1e-6f);
                      YAB[(row0 + ii) * 2048 + colg] = (bf16)(pk2(acc[r] * rn * gg * gav[r], 0.f) & 0xffffu); }
                }
                __syncthreads();
            }
        }
#undef HC_REQ
        PHASE_END
        PHASE_BEGIN
        for (int ub = blk * NWAVES; ub < 2048; ub += NGW) {
            const int unit = ub + wave;
            const int b = ub >> 9, j = unit & 511, lr = lane & 31, lh = lane >> 5;
            const int qsel = (lr >> 2) & 1, head = (lr >> 3) * 4 + (lr & 3);
            const int qlo = 4 * j, qhi = 4 * (1023 - j);
            const int nlo = ((qlo >> 6) + 1) * 64, nhi = ((qhi >> 6) + 1) * 64;
            const int nlo8 = (nlo + 511) & ~511, nhi8 = (nhi + 511) & ~511;
            const int nmax8 = (((((4 * (1023 - (ub & 511))) >> 6) + 1) * 64) + 511) & ~511;
            bf16x8 A[4][4]; float W[4][16]; typedef float f32x2_t __attribute__((ext_vector_type(2)));
#pragma unroll
            for (int p = 0; p < 4; ++p) { const size_t qb = (size_t)b * SEQ + (p < 2 ? qlo + 2 * p : qhi + 2 * (p - 2));
#pragma unroll
                for (int ks = 0; ks < 4; ++ks) A[p][ks] = *(const bf16x8*)(QIDX + (qb + qsel) * 1024 + head * 64 + ks * 16 + lh * 8);
#pragma unroll
                for (int r4 = 0; r4 < 4; ++r4) { const f32x4 w = *(const f32x4*)(IDXW + (qb + lh) * 16 + r4 * 4); W[p][r4 * 4] = w[0]; W[p][r4 * 4 + 1] = w[1]; W[p][r4 * 4 + 2] = w[2]; W[p][r4 * 4 + 3] = w[3]; } }
            const bf16* kb = KIDX + (size_t)b * SEQ * 64;
            const int srow = 8 * wave + (lane >> 3), spc = ((lane & 7) ^ ((srow >> 1) & 7)) * 8;
#define P4_STAGE(C0_, BUF_) do { _Pragma("unroll") for (int i = 0; i < 4; ++i) \
                __builtin_amdgcn_global_load_lds((const unsigned*)(kb + (size_t)((C0_) + 64 * i + srow) * 64 + spc), (LAS unsigned*)(lds + (BUF_) * 32768 + (i * 8 + wave) * 1024), 16, 0, 0); } while (0)
            P4_STAGE(0, 0);
            asm volatile("s_waitcnt vmcnt(0)" ::: "memory");
            __syncthreads();
            for (int c0 = 0; c0 < nmax8; c0 += 256) {
                const int cb = (c0 >> 8) & 1; const bool more = c0 + 256 < nmax8;
                if (more) P4_STAGE(c0 + 256, cb ^ 1);
                LAS unsigned char* kbuf = lds + cb * 32768;
#pragma unroll 1
                for (int tl = 0; tl < 8; ++tl) {
                    const int s0 = c0 + tl * 32;
                    if (s0 >= nhi8) break;
#pragma unroll
                    for (int p = 0; p < 4; ++p) { const int np = p < 2 ? nlo : nhi, np8 = p < 2 ? nlo8 : nhi8;
                        if (s0 >= np && s0 < np8) { const size_t q = (size_t)b * SEQ + (p < 2 ? qlo + 2 * p : qhi + 2 * (p - 2)) + lh; ISC[q * 4096 + s0 + lr] = (_Float16)(-60000.0f); } }
                    if (s0 >= nhi) continue;
                    bf16x8 B[4];
#pragma unroll
                    for (int ks = 0; ks < 4; ++ks) B[ks] = *(const LAS bf16x8*)(kbuf + (tl * 32 + lr) * 128 + (((2 * ks + lh) ^ ((lr >> 1) & 7)) * 16));
#define IDX_FINISH(P_, ACC_) do { f32x2_t s2_ = {0.f, 0.f};     \
                        _Pragma("unroll") for (int r = 0; r < 16; r += 2) { const float a0_ = ACC_[r], a1_ = ACC_[r + 1]; const int i0_ = __builtin_bit_cast(int, a0_), i1_ = __builtin_bit_cast(int, a1_); \
                            const f32x2_t rl_ = {__builtin_bit_cast(float, i0_ > 0 ? i0_ : 0), __builtin_bit_cast(float, i1_ > 0 ? i1_ : 0)}; const f32x2_t w_ = {W[P_][r], W[P_][r + 1]}; \
                            s2_ = __builtin_elementwise_fma(rl_, w_, s2_); } \
                        const float sc_ = s2_[0] + s2_[1]; \
                        const size_t q_ = (size_t)b * SEQ + ((P_) < 2 ? qlo + 2 * (P_) : qhi + 2 * ((P_) - 2)) + lh; ISC[q_ * 4096 + s0 + lr] = (_Float16)sc_; } while (0)
                    if (s0 < nlo) {
                        f32x16 c0_, c1_, c2_, c3_;
#pragma unroll
                        for (int r = 0; r < 16; ++r) { c0_[r] = 0.f; c1_[r] = 0.f; c2_[r] = 0.f; c3_[r] = 0.f; }
#pragma unroll
                        for (int ks = 0; ks < 4; ++ks) { c0_ = __builtin_amdgcn_mfma_f32_32x32x16_bf16(A[0][ks], B[ks], c0_, 0, 0, 0); c1_ = __builtin_amdgcn_mfma_f32_32x32x16_bf16(A[1][ks], B[ks], c1_, 0, 0, 0);
                            c2_ = __builtin_amdgcn_mfma_f32_32x32x16_bf16(A[2][ks], B[ks], c2_, 0, 0, 0); c3_ = __builtin_amdgcn_mfma_f32_32x32x16_bf16(A[3][ks], B[ks], c3_, 0, 0, 0); }
                        IDX_FINISH(0, c0_); IDX_FINISH(1, c1_); IDX_FINISH(2, c2_); IDX_FINISH(3, c3_);
                    } else {
                        f32x16 c2_, c3_;
#pragma unroll
                        for (int r = 0; r < 16; ++r) { c2_[r] = 0.f; c3_[r] = 0.f; }
#pragma unroll
                        for (int ks = 0; ks < 4; ++ks) { c2_ = __builtin_amdgcn_mfma_f32_32x32x16_bf16(A[2][ks], B[ks], c2_, 0, 0, 0); c3_ = __builtin_amdgcn_mfma_f32_32x32x16_bf16(A[3][ks], B[ks], c3_, 0, 0, 0); }
                        IDX_FINISH(2, c2_); IDX_FINISH(3, c3_);
                    }
#undef IDX_FINISH
                }
                asm volatile("s_waitcnt vmcnt(0)" ::: "memory");
                __syncthreads();
            }
        }
#undef P4_STAGE
        PHASE_END
        GRID_BAR();
        }
        for (int rep_ = 0; rep_ < REP_P5; ++rep_) {
        PHASE_BEGIN
        {
            LAS unsigned char* VB = lds + wave * 18432;
            LAS unsigned short* SELW = (LAS unsigned short*)(VB + 17408);
            const int hd = lane & 15, g = lane >> 4, qq = hd >> 2, pp = hd & 3;
            const float slope = exp2f(-0.5f * (float)(hd + 1));
            for (int q = gw; q < M; q += NGW) {
                const int b = q / SEQ, pos = q % SEQ, qc = pos >> 6; const int nsel = qc < 4 ? (qc + 1) * 64 : 256;
                for (int rtk_ = 0; rtk_ < REP_TOPK; ++rtk_) {
                int lane_t = lane; asm volatile("" : "+v"(lane_t));
                if (qc < 4) { const unsigned e0 = 4 * lane_t; const bool ok = 4 * lane_t < nsel; v2u z; z.x = ok ? (e0 | ((e0 + 1) << 16)) : 0u; z.y = ok ? ((e0 + 2) | ((e0 + 3) << 16)) : 0u; *(LAS v2u*)(SELW + 4 * lane_t) = z; }
                else {
                    LAS unsigned* HIST = (LAS unsigned*)VB;
                    const int nb8 = (qc + 8) >> 3;
                    float v[64];
                    { unsigned pk[32]; const int i2max = 4 * nb8 - 1; const _Float16* irow = ISC + (size_t)q * 4096 + 2 * lane_t; typedef _Float16 h2_t __attribute__((ext_vector_type(2)));
#pragma unroll
                      for (int i2 = 0; i2 < 32; ++i2) { const int ic = i2 < i2max ? i2 : i2max; pk[i2] = *(const unsigned*)(irow + ic * 128); }
#pragma unroll
                      for (int i2 = 0; i2 < 32; ++i2) { const float lim = (i2 >> 2) < nb8 ? 3.0e38f : -1.0e30f; const h2_t h = __builtin_bit_cast(h2_t, pk[i2]);
                          const float f0 = (float)h[0], f1 = (float)h[1]; v[2 * i2] = fminf(f0, lim); v[2 * i2 + 1] = fminf(f1, lim); } }
                    float vmx = v[0], vmn = fminf(fminf(v[0], v[1]), fminf(v[2], v[3]));
#pragma unroll
                    for (int i = 1; i < 64; ++i) vmx = fmaxf(vmx, v[i]);
                    vmx = wmax_f(vmx); vmn = -wmax_f(-vmn);
                    const float rng = vmx - vmn; const float s20 = rng > 0.f ? 1048574.0f / rng : 0.f;
#define ZERO_HIST() do { *(LAS v4u*)(HIST + 16 * lane) = (v4u){0u, 0u, 0u, 0u}; *(LAS v4u*)(HIST + 16 * lane + 4) = (v4u){0u, 0u, 0u, 0u}; *(LAS v4u*)(HIST + 16 * lane + 8) = (v4u){0u, 0u, 0u, 0u}; \
                        *(LAS v4u*)(HIST + 16 * lane + 12) = (v4u){0u, 0u, 0u, 0u}; HIST[1024 + lane] = 0u; } while (0)
#define SCAN_HIST(R_, BIN_, AB_) do { unsigned hh_[16]; const int hb_ = 1008 - 16 * lane; \
                        { const v4u h0 = *(const LAS v4u*)(HIST + hb_), h1 = *(const LAS v4u*)(HIST + hb_ + 4), h2 = *(const LAS v4u*)(HIST + hb_ + 8), h3 = *(const LAS v4u*)(HIST + hb_ + 12); \
                          hh_[0] = h0.x; hh_[1] = h0.y; hh_[2] = h0.z; hh_[3] = h0.w; hh_[4] = h1.x; hh_[5] = h1.y; hh_[6] = h1.z; hh_[7] = h1.w; hh_[8] = h2.x; hh_[9] = h2.y; hh_[10] = h2.z; hh_[11] = h2.w; hh_[12] = h3.x; hh_[13] = h3.y; hh_[14] = h3.z; hh_[15] = h3.w; } \
                        unsigned tot_ = 0u; _Pragma("unroll") for (int k = 0; k < 16; ++k) tot_ += hh_[k]; \
                        unsigned run_ = wprefix_u(tot_) - tot_; int fb_ = -1; unsigned fa_ = 0u; \
                        _Pragma("unroll") for (int k = 15; k >= 0; --k) { if (run_ < (R_) && run_ + hh_[k] >= (R_)) { fb_ = hb_ + k; fa_ = run_; } run_ += hh_[k]; } \
                        const unsigned long long bm_ = __ballot(fb_ >= 0); const int L_ = (int)__builtin_ctzll(bm_); \
                        BIN_ = (unsigned)__builtin_amdgcn_readlane(fb_, L_); AB_ = (unsigned)__builtin_amdgcn_readlane((int)fa_, L_); } while (0)
                    ZERO_HIST();
#pragma unroll
                    for (int i = 0; i < 64; ++i) v[i] = __builtin_bit_cast(float, (unsigned)((v[i] - vmn) * s20));
#define cd(i_) __builtin_bit_cast(unsigned, v[i_])
#pragma unroll
                    for (int g8 = 0; g8 < 8; ++g8) { if (g8 < nb8) {
#pragma unroll
                        for (int j = 0; j < 8; ++j) __hip_atomic_fetch_add(HIST + (cd(g8 * 8 + j) >> 10), 1u, __ATOMIC_RELAXED, __HIP_MEMORY_SCOPE_WORKGROUP); } }
                    LDS_WAIT(); asm volatile("" ::: "memory");
                    unsigned tb, above; SCAN_HIST(256u, tb, above);
                    ZERO_HIST();
                    LDS_WAIT(); asm volatile("" ::: "memory");
#pragma unroll
                    for (int g8 = 0; g8 < 8; ++g8) { if (g8 < nb8) {
#pragma unroll
                        for (int j = 0; j < 8; ++j) { const unsigned c = cd(g8 * 8 + j); const unsigned a = (c >> 10) == tb ? (c & 1023u) : 1024u + lane; __hip_atomic_fetch_add(HIST + a, 1u, __ATOMIC_RELAXED, __HIP_MEMORY_SCOPE_WORKGROUP); } } }
                    LDS_WAIT(); asm volatile("" ::: "memory");
                    unsigned tb2, ab2; { const unsigned R2 = 256u - above; SCAN_HIST(R2, tb2, ab2); }
                    const unsigned T = (tb << 10) | tb2; above += ab2;
                    unsigned baseg = 0u, basee = above;
#pragma unroll
                    for (int g8 = 0; g8 < 8; ++g8) { if (g8 < nb8) {
#pragma unroll
                        for (int j = 0; j < 8; ++j) { const int i = g8 * 8 + j;
                            const bool gt = cd(i) > T; const unsigned long long bg = __ballot(gt);
                            const unsigned pgp = baseg + __builtin_amdgcn_mbcnt_hi((unsigned)(bg >> 32), __builtin_amdgcn_mbcnt_lo((unsigned)bg, 0u));
                            if (gt) SELW[pgp] = (unsigned short)((i >> 1) * 128 + (i & 1) + 2 * lane);
                            baseg += (unsigned)__popcll(bg);
                            const bool eq = cd(i) == T; const unsigned long long be = __ballot(eq);
                            if (be) { const unsigned pep = basee + __builtin_amdgcn_mbcnt_hi((unsigned)(be >> 32), __builtin_amdgcn_mbcnt_lo((unsigned)be, 0u));
                                if (eq && pep < 256u) SELW[pep] = (unsigned short)((i >> 1) * 128 + (i & 1) + 2 * lane);
                                basee += (unsigned)__popcll(be); } } } }
#undef cd
#undef ZERO_HIST
#undef SCAN_HIST
                }
                LDS_WAIT(); asm volatile("" ::: "memory");
                }
                for (int rat_ = 0; rat_ < REP_ATT; ++rat_) {
                bf16* qrow = QB + (size_t)q * 4096;
                bf16x8 Bq[8];
#pragma unroll
                for (int ks = 0; ks < 8; ++ks) Bq[ks] = *(const bf16x8*)(qrow + hd * 256 + ks * 32 + g * 8);
                const bf16* kvb = CKV + (size_t)b * SEQ * 256;
                f32x4 O[16];
#pragma unroll
                for (int ct = 0; ct < 16; ++ct) O[ct] = (f32x4){0.f, 0.f, 0.f, 0.f};
                float mrun = -1.0e30f, lsum = 0.f;
                LDS_WAIT(); asm volatile("" ::: "memory");
                const int nks = nsel >> 5;
                const int lrow = lane >> 5, lcp = lane & 31, lsh = 16 * lrow;
                v4u KR[16];
#define ATT_IDX(KST_) v4u iw_[4]; _Pragma("unroll") for (int c = 0; c < 4; ++c) iw_[c] = *(const LAS v4u*)(SELW + 32 * (KST_) + 8 * c)
#define ATT_LOADROWS(KST_) do { ATT_IDX(KST_); _Pragma("unroll") for (int i = 0; i < 16; ++i) { const int rr_ = 2 * i + lrow; const unsigned w_ = iw_[i >> 2][i & 3]; const int ix_ = (int)((w_ >> lsh) & 0xffffu); \
                    KR[i] = *(const v4u*)(kvb + (size_t)ix_ * 256 + ((lcp ^ (rr_ & 7)) * 8)); } } while (0)
                ATT_LOADROWS(0);
                const int rlA = hd & 7;
                const int rlT = (4 * g + qq) & 7;
                const int trb = (4 * g + qq) * 512 + 8 * (pp & 1), trm = 16 * ((pp >> 1) ^ rlT);
                for (int kst = 0; kst < nks; ++kst) {
                    int rlA_ = rlA, trm_ = trm; asm volatile("" : "+v"(rlA_), "+v"(trm_));
                    if (kst + 1 < nks) {
                        ATT_IDX(kst + 1);
#pragma unroll
                        for (int i = 0; i < 16; ++i) { *(LAS v4u*)(VB + i * 1024 + lane * 16) = KR[i];
                            const int rr_ = 2 * i + lrow; const unsigned w_ = iw_[i >> 2][i & 3]; const int ix_ = (int)((w_ >> lsh) & 0xffffu); KR[i] = *(const v4u*)(kvb + (size_t)ix_ * 256 + ((lcp ^ (rr_ & 7)) * 8)); }
                    } else {
#pragma unroll
                        for (int i = 0; i < 16; ++i) *(LAS v4u*)(VB + i * 1024 + lane * 16) = KR[i]; }
                    LDS_WAIT(); asm volatile("" ::: "memory");
                    f32x4 S0 = {0.f, 0.f, 0.f, 0.f}, S1 = {0.f, 0.f, 0.f, 0.f};
#pragma unroll
                    for (int k4 = 0; k4 < 4; ++k4) {
                        bf16x8 a0[2], a1[2];
#pragma unroll
                        for (int j = 0; j < 2; ++j) { const int ks = k4 * 2 + j; const int cpos = (4 * ks + g) ^ rlA_;
                            a0[j] = *(const LAS bf16x8*)(VB + hd * 512 + cpos * 16); a1[j] = *(const LAS bf16x8*)(VB + (16 + hd) * 512 + cpos * 16); }
#pragma unroll
                        for (int j = 0; j < 2; ++j) { const int ks = k4 * 2 + j;
                            S0 = __builtin_amdgcn_mfma_f32_16x16x32_bf16(a0[j], Bq[ks], S0, 0, 0, 0); S1 = __builtin_amdgcn_mfma_f32_16x16x32_bf16(a1[j], Bq[ks], S1, 0, 0, 0); }
                    }
                    const v2u pa = *(const LAS v2u*)(SELW + 32 * kst + 4 * g), pb = *(const LAS v2u*)(SELW + 32 * kst + 16 + 4 * g);
                    const float fp = (float)pos;
                    float s0[4], s1[4];
                    s0[0] = S0[0] - slope * fabsf(fp - (float)(pa.x & 0xffffu)); s0[1] = S0[1] - slope * fabsf(fp - (float)(pa.x >> 16));
                    s0[2] = S0[2] - slope * fabsf(fp - (float)(pa.y & 0xffffu)); s0[3] = S0[3] - slope * fabsf(fp - (float)(pa.y >> 16));
                    s1[0] = S1[0] - slope * fabsf(fp - (float)(pb.x & 0xffffu)); s1[1] = S1[1] - slope * fabsf(fp - (float)(pb.x >> 16));
                    s1[2] = S1[2] - slope * fabsf(fp - (float)(pb.y & 0xffffu)); s1[3] = S1[3] - slope * fabsf(fp - (float)(pb.y >> 16));
                    float ml = fmaxf(fmaxf(fmaxf(s0[0], s0[1]), fmaxf(s0[2], s0[3])), fmaxf(fmaxf(s1[0], s1[1]), fmaxf(s1[2], s1[3])));
                    ml = xmax16(ml); ml = xmax32(ml);
                    const float mnew = fmaxf(mrun, ml), alpha = __expf(mrun - mnew); mrun = mnew;
                    float p0[4], p1[4];
#pragma unroll
                    for (int r = 0; r < 4; ++r) { p0[r] = __expf(s0[r] - mnew); p1[r] = __expf(s1[r] - mnew); }
                    lsum = lsum * alpha + ((p0[0] + p0[1]) + (p0[2] + p0[3])) + ((p1[0] + p1[1]) + (p1[2] + p1[3]));
                    v4u pw; pw.x = pk2(p0[0], p0[1]); pw.y = pk2(p0[2], p0[3]); pw.z = pk2(p1[0], p1[1]); pw.w = pk2(p1[2], p1[3]);
                    const bf16x8 Pf = __builtin_bit_cast(bf16x8, pw);
#pragma unroll
                    for (int ct = 0; ct < 16; ++ct) O[ct] = O[ct] * alpha;
#pragma unroll
                    for (int c8 = 0; c8 < 4; ++c8) {
                        v4s lo[4], hi[4];
#pragma unroll
                        for (int j = 0; j < 4; ++j) { const int ct = c8 * 4 + j; const int off = trb + ((32 * ct) ^ trm_);
                            lo[j] = __builtin_amdgcn_ds_read_tr16_b64_v4i16((LAS v4s*)(VB + off));
                            hi[j] = __builtin_amdgcn_ds_read_tr16_b64_v4i16((LAS v4s*)(VB + 16 * 512 + off)); }
#pragma unroll
                        for (int j = 0; j < 4; ++j) { const int ct = c8 * 4 + j;
                            const bf16x8 Af = {lo[j][0], lo[j][1], lo[j][2], lo[j][3], hi[j][0], hi[j][1], hi[j][2], hi[j][3]};
                            O[ct] = __builtin_amdgcn_mfma_f32_16x16x32_bf16(Af, Pf, O[ct], 0, 0, 0); }
                    }
                    LDS_WAIT(); asm volatile("" ::: "memory");
                }
#undef ATT_LOADROWS
#undef ATT_IDX
                lsum = xsum16(lsum); lsum = xsum32(lsum);
                const float inv = 1.0f / lsum;
#pragma unroll
                for (int ct = 0; ct < 16; ++ct) { const f32x4 o = O[ct] * inv; v2u w; w.x = pk2(o[0], o[1]); w.y = pk2(o[2], o[3]); *(v2u*)(OB + (size_t)q * 4096 + hd * 256 + 16 * ct + 4 * g) = w; }
                }
            }
        }
        PHASE_END
        GRID_BAR();
        }
        PHASE_BEGIN
        { pg8::Gemm g{OB, W6, M, 1024, 1024, 4096, 1024, 1024}; pg8::StaticOrder S; S.init(M, 1024, G, blk);
          EpiBf E{YAB, 2048, 1024}; pg8::gemm_phase(lds, g, S, E, tid); }
        PHASE_END
        GRID_BAR();
        PHASE_BEGIN
        { pg8::Gemm g{YAB, W7, M, DM, DM, DM, DM, 0}; pg8::StaticOrder S; S.init(M, DM, G, blk);
          EpiGateM E{GTB, MRG}; HookGate Hk{GTA, GTB}; pg8::gemm_phase(lds, g, S, E, tid, Hk); }
        PHASE_END
        GRID_BAR();
        PHASE_BEGIN
        { pg8::Gemm g{MRG, W8, M, DM, DM, DM, DM, 0}; pg8::StaticOrder S; S.init(M, DM, G, blk);
          S.mode = 1;
          EpiLn<0, false> E{ws, (l == 0) ? x_in : (const float*)nullptr, (float*)nullptr, ln1_g + l * DM, ln1_b + l * DM, lds, l};
          pg8::gemm_phase(lds, g, S, E, tid); }
        PHASE_END
        GRID_BAR();
        PHASE_BEGIN
        { pg8::Gemm g{HB, W10, M, N10, DM, DM, DM, 0}; pg8::StaticOrder S; S.init(M, N10, G, blk);
          EpiSwiglu E{ACT}; pg8::gemm_phase(lds, g, S, E, tid); }
        PHASE_END
        GRID_BAR();
        if (l == DEPTH - 1) {
        PHASE_BEGIN
        { pg8::Gemm g{ACT, W11, M, DM, DFF, DFF, DFF, 0}; pg8::StaticOrder S; S.init(M, DM, G, blk); S.mode = 1;
          EpiLn<1, true> E{ws, (const float*)nullptr, args.out, ln2_g + l * DM, ln2_b + l * DM, lds, l}; pg8::gemm_phase(lds, g, S, E, tid); }
        PHASE_END
        } else {
        PHASE_BEGIN
        { pg8::Gemm g{ACT, W11, M, DM, DFF, DFF, DFF, 0}; pg8::StaticOrder S; S.init(M, DM, G, blk); S.mode = 1;
          EpiLn<1, false> E{ws, (const float*)nullptr, (float*)nullptr, ln2_g + l * DM, ln2_b + l * DM, lds, l}; pg8::gemm_phase(lds, g, S, E, tid); }
        PHASE_END
        }
        if (l + 1 < DEPTH) {
            GRID_BAR();
            PHASE_BEGIN
            { CONVERT_LAYER(l + 1); }
            PHASE_END
            GRID_BAR();
        }
    }
}

extern "C" void kernel_launch(void* const* d_in, const int* in_sizes, int n_in, void* d_out, int out_size, void* d_ws, size_t ws_size, hipStream_t stream) {
    static int grid = 0;
    if (grid == 0) {
        if (n_in != 22 || out_size != M * DM || ws_size < WS_END) { fprintf(stderr, "kernel_launch: unexpected shapes (n_in %d, out %d, ws %zu < %zu)\n", n_in, out_size, ws_size, (size_t)WS_END); grid = -1; return; }
        int dev = 0, cus = 0, per_cu = 0;
        if (hipGetDevice(&dev) != hipSuccess || hipDeviceGetAttribute(&cus, hipDeviceAttributeMultiprocessorCount, dev) != hipSuccess) { grid = -1; return; }
        if (hipFuncSetAttribute((const void*)fwd_kernel, hipFuncAttributeMaxDynamicSharedMemorySize, LDS_BYTES) != hipSuccess) { fprintf(stderr, "kernel_launch: hipFuncSetAttribute failed\n"); grid = -1; return; }
        if (hipOccupancyMaxActiveBlocksPerMultiprocessor(&per_cu, (const void*)fwd_kernel, NTHR, LDS_BYTES) != hipSuccess || per_cu < 1) { fprintf(stderr, "kernel_launch: occupancy query says %d\n", per_cu); }
        (void)hipGetLastError();
        if (cus % 64 != 0) { fprintf(stderr, "kernel_launch: %d CUs: the fused-LayerNorm unit order needs a multiple of 64 workgroups\n", cus); grid = -1; return; }
        grid = cus;
    }
    if (grid < 0) return;
    if (hipMemsetAsync((char*)d_ws + WS_CTL, 0, CTL_ZERO_BYTES, stream) != hipSuccess) return;
    Args a{};
    for (int i = 0; i < 22; ++i) a.in[i] = (const float*)d_in[i];
    a.out = (float*)d_out; a.ws = (unsigned char*)d_ws;
    hipLaunchKernelGGL(fwd_kernel, dim3(grid), dim3(NTHR), LDS_BYTES, stream, a);
}
```

```cpp
#include <hip/hip_runtime.h>
#include <cstdio>
#include <cstdint>

namespace pg8 {
#define PG8_LAS __attribute__((address_space(3)))
typedef unsigned short bf16_t;
typedef short bf16x8 __attribute__((ext_vector_type(8)));
typedef float f32x4 __attribute__((ext_vector_type(4)));
typedef unsigned u32x4 __attribute__((ext_vector_type(4)));
constexpr int BM = 256, BK = 64, HALF = 128, HTB = HALF * BK * 2, STAGE_BYTES = 8 * HTB, NXCD = 8, WGM = 8;

__host__ __device__ __forceinline__ int lds_byte(int r, int c) { const int st = (r >> 4) * 2 + (c >> 5), rr = r & 15, cc = c & 31, ob = rr * 64 + cc * 2; return st * 1024 + (ob ^ (((ob >> 9) & 1) << 5)); }
__host__ __device__ __forceinline__ void stage_rc(int b, int& R, int& C) { const int st = b / 1024, sb = b % 1024, swz = sb ^ (((sb >> 9) & 1) << 5); R = (st >> 1) * 16 + swz / 64; C = (st & 1) * 32 + (swz % 64) / 2; }
__host__ __device__ __forceinline__ int perm32(int rho) { const int n = rho >> 4, i = rho & 15; return 8 * (i >> 2) + 4 * n + (i & 3); }

struct Unit { int pm, pn; };
struct Gemm { const bf16_t* A; const bf16_t* Bt; int M, N, K, lda, ldb, a_pn_stride; };

struct StaticOrder {
    int nM, nN, nwg, G, c, mode;
    __host__ __device__ void init(int M, int N, int G_, int c_) { nM = M / BM; nN = N / BM; nwg = nM * nN; G = G_; c = c_; mode = 0; }
    __host__ __device__ bool next(int i, Unit& u) const {
        if (mode == 1) {
            const int PR = G >> 3, x = c & 7, j = c >> 3, pm = i * PR + (PR >> 3) * x + (j >> 3); if (pm >= nM) return false; u.pm = pm; u.pn = j & 7; return true; }
        const long L = (long)i * G + c; if (L >= nwg) return false;
        int wgid = (int)L; { const int q = nwg / NXCD, r = nwg % NXCD, xcd = wgid % NXCD, off = wgid / NXCD; wgid = (xcd < r ? xcd * (q + 1) : r * (q + 1) + (xcd - r) * q) + off; }
        const int nig = WGM * nN, gid = wgid / nig, fm = gid * WGM, gsz = (nM - fm) < WGM ? (nM - fm) : WGM;
        u.pm = fm + ((wgid % nig) % gsz); u.pn = (wgid % nig) / gsz; return true;
    }
};

typedef float f32x2_t __attribute__((ext_vector_type(2))); typedef __bf16 bf16x2_t __attribute__((ext_vector_type(2)));
__device__ __forceinline__ unsigned cvt_pk_bf16(float lo, float hi) { f32x2_t v = {lo, hi}; bf16x2_t b = __builtin_convertvector(v, bf16x2_t); return __builtin_bit_cast(unsigned, b); }

struct NoHook { static constexpr bool ON = false; template <class A> __device__ __forceinline__ void mid(A&, const Unit&, int, int, int, int) const {} };
template <class Epi, class Hook = NoHook>
__device__ __forceinline__ void gemm_phase(PG8_LAS unsigned char* lds, const Gemm g, const StaticOrder& S, const Epi& E, const int tid, const Hook H = Hook()) {
    const int wid = __builtin_amdgcn_readfirstlane(tid >> 6), lane = tid & 63, wr = wid >> 2, wc = wid & 3, fr = lane & 15, fq = lane >> 4;
    const int K = g.K, nt = K / BK;
    unsigned voffA[2], voffB[2];
#pragma unroll
    for (int i = 0; i < 2; ++i) { int R, C; stage_rc(tid * 16 + i * 8192, R, C); const int Rb = 64 * (R >> 5) + perm32(R & 31);
        voffA[i] = (unsigned)(R * g.lda + C) * 2u; voffB[i] = (unsigned)(Rb * g.ldb + C) * 2u; }
    const size_t kstep = (size_t)(BK * 2);
    const size_t hstepA = (size_t)HALF * g.lda * 2, hstepB = (size_t)32 * g.ldb * 2;
    const size_t tstepA = 2 * hstepA, tstepB = (size_t)BM * g.ldb * 2;
    const unsigned ldsw = (unsigned)wid * 1024u;
    const int aoff = lds_byte(wr * 64 + fr, fq * 8), boff = lds_byte(wc * 32 + fr, fq * 8);
#define PG8_SA(b, h) (((b) * 2 + (h)) * HTB)
#define PG8_SB(b, h) ((4 + (b) * 2 + (h)) * HTB)
#define PG8_STAGE(bufoff, gbase, voff) do { _Pragma("unroll") for (int _i = 0; _i < 2; ++_i) \
        __builtin_amdgcn_global_load_lds((const unsigned*)((const char*)(gbase) + (voff)[_i]), (PG8_LAS unsigned*)(lds + (bufoff) + ldsw + _i * 8192), 16, 0, 0); } while (0)
#define PG8_LDA(dst, b, h) do { _Pragma("unroll") for (int m = 0; m < 4; ++m) _Pragma("unroll") for (int k = 0; k < 2; ++k) dst[m][k] = *(const PG8_LAS bf16x8*)(lds + PG8_SA(b, h) + aoff + m * 2048 + k * 1024); } while (0)
#define PG8_LDB(dst, b, h) do { _Pragma("unroll") for (int n = 0; n < 2; ++n) _Pragma("unroll") for (int k = 0; k < 2; ++k) dst[n][k] = *(const PG8_LAS bf16x8*)(lds + PG8_SB(b, h) + boff + n * 2048 + k * 1024); } while (0)
#define PG8_MMA(ai, bj, At, Bt) do { __builtin_amdgcn_s_setprio(1); _Pragma("unroll") for (int m = 0; m < 4; ++m) _Pragma("unroll") for (int n = 0; n < 2; ++n) _Pragma("unroll") for (int k = 0; k < 2; ++k) \
        acc[ai][bj][m][n] = __builtin_amdgcn_mfma_f32_16x16x32_bf16(Bt[n][k], At[m][k], acc[ai][bj][m][n], 0, 0, 0); __builtin_amdgcn_s_setprio(0); } while (0)
#define PG8_WAIT_V(n) asm volatile("s_waitcnt vmcnt(" #n ")" ::: "memory")
#define PG8_WAIT_L(n) asm volatile("s_waitcnt lgkmcnt(" #n ")" ::: "memory")
#define PG8_BAR __builtin_amdgcn_s_barrier()
#define PG8_SCHED __builtin_amdgcn_sched_barrier(0)
    Unit cur, nxt; int ui = 0;
    if (!S.next(0, cur)) return;
    f32x4 acc[2][2][4][2];
#pragma unroll
    for (int a = 0; a < 2; ++a)
#pragma unroll
        for (int b = 0; b < 2; ++b)
#pragma unroll
            for (int m = 0; m < 4; ++m)
#pragma unroll
                for (int n = 0; n < 2; ++n) acc[a][b][m][n] = (f32x4){0.f, 0.f, 0.f, 0.f};
    bf16x8 At[4][2], B0[2][2], B1[2][2];
    const char* cA = (const char*)g.A + (size_t)cur.pm * tstepA + (size_t)cur.pn * g.a_pn_stride * 2; const char* cB = (const char*)g.Bt + (size_t)cur.pn * tstepB;
    PG8_STAGE(PG8_SB(0, 0), cB, voffB); PG8_STAGE(PG8_SB(0, 1), cB + hstepB, voffB); PG8_STAGE(PG8_SA(0, 0), cA, voffA); PG8_STAGE(PG8_SA(0, 1), cA + hstepA, voffA);
    if (wr == 1) PG8_BAR;
    PG8_WAIT_V(2); PG8_BAR;
    PG8_STAGE(PG8_SB(1, 0), cB + kstep, voffB); PG8_STAGE(PG8_SA(1, 0), cA + kstep, voffA); PG8_STAGE(PG8_SB(1, 1), cB + hstepB + kstep, voffB);
    PG8_WAIT_V(6); PG8_BAR;
    for (;;) {
        const bool has_next = S.next(ui + 1, nxt);
        const char* nA = has_next ? (const char*)g.A + (size_t)nxt.pm * tstepA + (size_t)nxt.pn * g.a_pn_stride * 2 : cA; const char* nB = has_next ? (const char*)g.Bt + (size_t)nxt.pn * tstepB : cB;
        for (int t = 0; t < nt; t += 2) {
            const bool last = (t == nt - 2);
            const char* a1 = cA + (size_t)(t + 1) * kstep;
            const char* a2 = last ? nA : cA + (size_t)(t + 2) * kstep; const char* b2 = last ? nB : cB + (size_t)(t + 2) * kstep;
            const char* a3 = a2 + kstep; const char* b3 = b2 + kstep;
            if constexpr (Hook::ON) { if (t == (nt >> 1)) H.mid(acc, cur, wr, wc, fr, fq); }
            PG8_LDB(B0, 0, 0); PG8_LDB(B1, 0, 1); PG8_SCHED; PG8_LDA(At, 0, 0); PG8_STAGE(PG8_SA(1, 1), a1 + hstepA, voffA);
            PG8_WAIT_V(8); PG8_WAIT_L(0); PG8_BAR; PG8_MMA(0, 0, At, B0); PG8_MMA(0, 1, At, B1); PG8_BAR; PG8_SCHED;
            PG8_LDA(At, 0, 1); PG8_STAGE(PG8_SB(0, 0), b2, voffB); PG8_STAGE(PG8_SB(0, 1), b2 + hstepB, voffB); PG8_STAGE(PG8_SA(0, 0), a2, voffA);
            PG8_WAIT_V(8); PG8_WAIT_L(0); PG8_BAR; PG8_MMA(1, 0, At, B0); PG8_MMA(1, 1, At, B1); PG8_BAR; PG8_SCHED;
            PG8_LDB(B0, 1, 0); PG8_LDB(B1, 1, 1); PG8_SCHED; PG8_LDA(At, 1, 0); PG8_STAGE(PG8_SA(0, 1), a2 + hstepA, voffA);
            PG8_WAIT_V(8); PG8_WAIT_L(0); PG8_BAR; PG8_MMA(0, 0, At, B0); PG8_MMA(0, 1, At, B1); PG8_BAR; PG8_SCHED;
            PG8_LDA(At, 1, 1); PG8_STAGE(PG8_SB(1, 0), b3, voffB); PG8_STAGE(PG8_SB(1, 1), b3 + hstepB, voffB); PG8_STAGE(PG8_SA(1, 0), a3, voffA);
            PG8_WAIT_V(8); PG8_WAIT_L(0); PG8_BAR; PG8_MMA(1, 0, At, B0); PG8_MMA(1, 1, At, B1); PG8_BAR; PG8_SCHED;
        }
        if (wr == 0) PG8_BAR;
        E(acc, cur, wr, wc, fr, fq);
        if (!has_next) break;
#pragma unroll
        for (int a = 0; a < 2; ++a)
#pragma unroll
            for (int b = 0; b < 2; ++b)
#pragma unroll
                for (int m = 0; m < 4; ++m)
#pragma unroll
                    for (int n = 0; n < 2; ++n) acc[a][b][m][n] = (f32x4){0.f, 0.f, 0.f, 0.f};
        cur = nxt; cA = nA; cB = nB; ++ui;
        if (wr == 1) PG8_BAR;
    }
    PG8_WAIT_V(0);
    PG8_BAR;
#undef PG8_SA
#undef PG8_SB
#undef PG8_STAGE
#undef PG8_LDA
#undef PG8_LDB
#undef PG8_MMA
#undef PG8_WAIT_V
#undef PG8_WAIT_L
#undef PG8_BAR
#undef PG8_SCHED
}
}

constexpr int NWAVES = 8, NTHR = NWAVES * 64;
constexpr int DM = 2048, NBATCH = 4, SEQ = 4096, DEPTH = 4, M = NBATCH * SEQ;
constexpr int HGW = 1024;
constexpr int SAH = 16, SAC = 256, SAR = 512;
constexpr int DFF = 5632;
constexpr int N1 = 9216, N3 = 5120, N10 = 2 * DFF;
constexpr float ALPHA = 1.6817928305074292f;
constexpr int MODW = 6 * DM;

constexpr size_t MiB = 1u << 20;
constexpr size_t WS_CTL = 0, CTL_ZERO_BYTES = 32768;
constexpr size_t WS_MOD = 1 * MiB;
constexpr size_t WS_LB = 2 * MiB;
constexpr size_t WS_MODP = 3 * MiB;
constexpr size_t WS_W1 = 9 * MiB;
constexpr size_t WS_W3 = WS_W1 + 36 * MiB;
constexpr size_t WS_W6 = WS_W3 + 5 * MiB;
constexpr size_t WS_W7 = WS_W6 + 2 * MiB;
constexpr size_t WS_W8 = WS_W7 + 8 * MiB;
constexpr size_t WS_W10 = WS_W8 + 8 * MiB;
constexpr size_t WS_W11 = WS_W10 + 44 * MiB;
constexpr size_t WS_X = WS_W11 + 22 * MiB;
constexpr size_t WS_R = WS_X + 128 * MiB;
constexpr size_t WS_H = WS_R + 128 * MiB;
constexpr size_t WS_QA = WS_H + 64 * MiB;
constexpr size_t WS_FA = WS_QA + 32 * MiB;
constexpr size_t WS_IA = WS_FA + 64 * MiB;
constexpr size_t WS_GA = WS_IA + 32 * MiB;
constexpr size_t WS_LAT = WS_GA + 32 * MiB;
constexpr size_t WS_GTA = WS_LAT + 64 * MiB;
constexpr size_t WS_GTB = WS_GTA + 64 * MiB;
constexpr size_t WS_CQN = WS_GTB + 64 * MiB;
constexpr size_t WS_CKV = WS_CQN + 16 * MiB;
constexpr size_t WS_KIDX = WS_CKV + 8 * MiB;
constexpr size_t WS_IDXW = WS_KIDX + 2 * MiB;
constexpr size_t WS_QB = WS_IDXW + 1 * MiB;
constexpr size_t WS_QIDX = WS_QB + 128 * MiB;
constexpr size_t WS_SEL = WS_QIDX + 32 * MiB;
constexpr size_t WS_YAB = WS_SEL + 8 * MiB;
constexpr size_t WS_MRG = WS_FA;
constexpr size_t WS_OB = WS_YAB + 64 * MiB;
constexpr size_t WS_BIG = WS_OB + 128 * MiB;
constexpr size_t WS_KSB = WS_BIG + 256 * MiB;
constexpr size_t WS_DEB = WS_KSB + 32 * MiB;
constexpr size_t WS_QSB = WS_DEB + 2 * MiB;
constexpr size_t WS_END = WS_QSB + 32 * MiB;

constexpr int CW_BAR = 4096;

constexpr int RING_BYTES = 131072;
constexpr int LDS_BYTES = 163840;
constexpr int LDSCTL_OFF = LDS_BYTES - 1024, MISC_OFF = LDSCTL_OFF + 320, SELL_OFF = 147456;

#define GAS __attribute__((address_space(1)))
#define LAS __attribute__((address_space(3)))
typedef unsigned short bf16;
typedef unsigned v4u __attribute__((ext_vector_type(4)));
typedef unsigned v2u __attribute__((ext_vector_type(2)));
typedef float f32x4 __attribute__((ext_vector_type(4)));
typedef float f32x16 __attribute__((ext_vector_type(16)));
typedef short bf16x8 __attribute__((ext_vector_type(8)));
typedef short v4s __attribute__((ext_vector_type(4)));
typedef GAS unsigned gu32;
#define LDS_WAIT() asm volatile("s_waitcnt lgkmcnt(0)" ::: "memory")
__device__ __forceinline__ unsigned f2bf(float f) { unsigned u = __builtin_bit_cast(unsigned, f); return (u + 0x7fffu + ((u >> 16) & 1u)) >> 16; }
__device__ __forceinline__ unsigned pk2(float lo, float hi) { return pg8::cvt_pk_bf16(lo, hi); }
__device__ __forceinline__ float bf2f(unsigned short b) { return __builtin_bit_cast(float, ((unsigned)b) << 16); }
__device__ __forceinline__ float bflo(unsigned w) { return __builtin_bit_cast(float, w << 16); }
__device__ __forceinline__ float bfhi(unsigned w) { return __builtin_bit_cast(float, w & 0xffff0000u); }
__device__ __forceinline__ float sigm(float x) { return __builtin_amdgcn_rcpf(1.f + __expf(-x)); }

__device__ __forceinline__ int lane_id() { unsigned m = ~0u; asm volatile("" : "+s"(m)); return (int)__builtin_amdgcn_mbcnt_hi(m, __builtin_amdgcn_mbcnt_lo(m, 0u)); }
#define XB_TMO      128
#define XB_XCNT(j)  (256  + 64 * (j))
#define XB_XSUB(j)  (1280 + 64 * (j))
#define XB_XGEN(j)  (2304 + 64 * (j))
#define XB_TOP      3328
#define XB_TOPGEN   3392
#define XCD_BAR_WORDS 3456
#define XB_SPIN_CAP (1u << 22)

__device__ __forceinline__ unsigned xb_ld(unsigned* p)              { return __hip_atomic_load(p, __ATOMIC_RELAXED, __HIP_MEMORY_SCOPE_AGENT); }
__device__ __forceinline__ unsigned xb_add(unsigned* p, unsigned v) { return __hip_atomic_fetch_add(p, v, __ATOMIC_RELAXED, __HIP_MEMORY_SCOPE_AGENT); }
__device__ __forceinline__ unsigned xb_xcc_id() { return (unsigned)__builtin_amdgcn_s_getreg((3 << 11) | 20) & 0xFu; }
#define XB_SPIN(cond, bar) do { unsigned _sp = 0; while (cond) { __builtin_amdgcn_s_sleep(1); \
    if ((++_sp & 255u) == 0u) { if (xb_ld(&(bar)[XB_TMO])) break; if (_sp > XB_SPIN_CAP) { atomicAdd(&(bar)[XB_TMO], 1u); break; } } } } while (0)

struct XcdBarrier { unsigned* bar; unsigned x; volatile LAS unsigned* st; int wave; };

__device__ __forceinline__ XcdBarrier xcd_barrier_post(unsigned* bar, volatile LAS unsigned* st) {
    XcdBarrier b; b.bar = bar; b.x = (unsigned)__builtin_amdgcn_readfirstlane((int)xb_xcc_id()); b.st = st;
    if (threadIdx.x == 0) (void)xb_add(&bar[XB_XCNT(b.x)], 1u);
    return b;
}
__device__ __forceinline__ void xcd_barrier_complete(unsigned* bar, unsigned x, unsigned& nloc, unsigned& nx) {
    const unsigned G = gridDim.x * gridDim.y * gridDim.z;
    unsigned sum, cnt, mine, sp = 0u;
    for (;;) {
        sum = 0u; cnt = 0u; mine = 0u;
#pragma unroll 1
        for (unsigned j = 0; j < 16; ++j) { const unsigned c = xb_ld(&bar[XB_XCNT(j)]); sum += c; cnt += (c > 0u) ? 1u : 0u; mine = (j == x) ? c : mine; }
        if (sum == G) break;
        __builtin_amdgcn_s_sleep(1);
        if ((++sp & 255u) == 0u) { if (xb_ld(&bar[XB_TMO])) break; if (sp > XB_SPIN_CAP) { atomicAdd(&bar[XB_TMO], 1u); break; } }
    }
    nloc = mine > 0u ? mine : 1u; nx = cnt > 0u ? cnt : 1u;
}
__device__ __forceinline__ void xcd_barrier(const XcdBarrier& b) {
    asm volatile("s_waitcnt vmcnt(0)" ::: "memory");
    __syncthreads();
    if (b.wave == 0 && lane_id() == 0) {
        unsigned* bar = b.bar;
        unsigned bx = b.x; asm volatile("" : "+s"(bx));
        __builtin_amdgcn_s_waitcnt(0);
        unsigned nloc = b.st[0], nx = b.st[1];
        const unsigned old = xb_add(&bar[XB_XSUB(bx)], 1u);
        const unsigned gen = old / nloc;
        if (old + 1u == (gen + 1u) * nloc) {
            __builtin_amdgcn_fence(__ATOMIC_RELEASE, "agent");
            asm volatile("s_waitcnt vmcnt(0)" ::: "memory");
            const unsigned og = xb_add(&bar[XB_TOP], 1u);
            const unsigned tg = og / nx;
            if (og + 1u == (tg + 1u) * nx) xb_add(&bar[XB_TOPGEN], 1u);
            else XB_SPIN(xb_ld(&bar[XB_TOPGEN]) == tg, bar);
            __builtin_amdgcn_fence(__ATOMIC_ACQUIRE, "agent");
            xb_add(&bar[XB_XGEN(bx)], 1u);
            asm volatile("s_waitcnt vmcnt(0)" ::: "memory");
        } else {
            XB_SPIN(xb_ld(&bar[XB_XGEN(bx)]) == gen, bar);
            __builtin_amdgcn_fence(__ATOMIC_ACQUIRE, "agent");
            asm volatile("s_waitcnt vmcnt(0)" ::: "memory");
        }
    }
    __syncthreads();
}

__device__ __forceinline__ void xswap16(float& a, float& b) { asm volatile("s_nop 1\n\tv_permlane16_swap_b32 %0, %1\n\ts_nop 1" : "+v"(a), "+v"(b)); }
__device__ __forceinline__ void xswap32(float& a, float& b) { asm volatile("s_nop 1\n\tv_permlane32_swap_b32 %0, %1\n\ts_nop 1" : "+v"(a), "+v"(b)); }
__device__ __forceinline__ float xmax16(float x) { float a = x, b = x; xswap16(a, b); return fmaxf(a, b); }
__device__ __forceinline__ float xmax32(float x) { float a = x, b = x; xswap32(a, b); return fmaxf(a, b); }
__device__ __forceinline__ float xsum16(float x) { float a = x, b = x; xswap16(a, b); return a + b; }
__device__ __forceinline__ float xsum32(float x) { float a = x, b = x; xswap32(a, b); return a + b; }

#define DPPF(x, ctrl) __builtin_bit_cast(float, __builtin_amdgcn_update_dpp(0, __builtin_bit_cast(int, (x)), (ctrl), 0xf, 0xf, true))
__device__ __forceinline__ float wmax_f(float x) {
    x = fmaxf(x, DPPF(x, 0xB1)); x = fmaxf(x, DPPF(x, 0x4E)); x = fmaxf(x, DPPF(x, 0x124)); x = fmaxf(x, DPPF(x, 0x128));
    x = xmax16(x); return xmax32(x);
}
__device__ __forceinline__ unsigned wprefix_u(unsigned x) {
    int v = (int)x;
    v += __builtin_amdgcn_update_dpp(0, v, 0x111, 0xf, 0xf, false);
    v += __builtin_amdgcn_update_dpp(0, v, 0x112, 0xf, 0xf, false);
    v += __builtin_amdgcn_update_dpp(0, v, 0x114, 0xf, 0xf, false);
    v += __builtin_amdgcn_update_dpp(0, v, 0x118, 0xf, 0xf, false);
    v += __builtin_amdgcn_update_dpp(0, v, 0x142, 0xa, 0xf, false);
    v += __builtin_amdgcn_update_dpp(0, v, 0x143, 0xc, 0xf, false);
    return (unsigned)v;
}

__device__ __forceinline__ float rowsum16(float x) { x += DPPF(x, 0xB1); x += DPPF(x, 0x4E); x += DPPF(x, 0x124); x += DPPF(x, 0x128); return x; }
__device__ __forceinline__ float wave_sum(float x) { x = rowsum16(x); x = xsum16(x); return xsum32(x); }
__device__ __forceinline__ float wave_max(float x) { return wmax_f(x); }
__device__ __forceinline__ int wave_sum_i(int v) { float f = wave_sum((float)v); return (int)(f + 0.5f); }
template <class Src>
__device__ __forceinline__ void cvt_load(const Src& src, int k0, int n0, int lane, float (&tv)[32]) {
#pragma unroll
    for (int j = 0; j < 8; ++j) { const f32x4 v = src(k0 + 8 * j + (lane >> 3), n0 + 4 * (lane & 7)); tv[4 * j] = v[0]; tv[4 * j + 1] = v[1]; tv[4 * j + 2] = v[2]; tv[4 * j + 3] = v[3]; }
}
__device__ __forceinline__ void cvt_store(const float (&tv)[32], bf16* WT, int K, int k0, int n0, LAS float* scr, int lane) {
#pragma unroll
    for (int j = 0; j < 8; ++j)
#pragma unroll
        for (int e = 0; e < 4; ++e) scr[(8 * j + (lane >> 3)) * 33 + 4 * (lane & 7) + e] = tv[4 * j + e];
    LDS_WAIT(); asm volatile("" ::: "memory");
    const int c = lane & 7;
#pragma unroll
    for (int j = 0; j < 4; ++j) { const int n = (lane >> 3) + 8 * j; const LAS float* s = scr + (8 * c) * 33 + n;
        v4u o; o.x = pk2(s[0 * 33], s[1 * 33]); o.y = pk2(s[2 * 33], s[3 * 33]); o.z = pk2(s[4 * 33], s[5 * 33]); o.w = pk2(s[6 * 33], s[7 * 33]);
        *(GAS v4u*)(WT + (size_t)(n0 + n) * K + k0 + 8 * c) = o; }
    LDS_WAIT(); asm volatile("" ::: "memory");
}

struct Args { const float* in[22]; float* out; unsigned char* ws; };

using pg8::Unit; using pg8::cvt_pk_bf16;
__device__ __forceinline__ void st_bf16x8(bf16* p, f32x4 v0, f32x4 v1) {
    v4u w; w.x = cvt_pk_bf16(v0[0], v0[1]); w.y = cvt_pk_bf16(v0[2], v0[3]); w.z = cvt_pk_bf16(v1[0], v1[1]); w.w = cvt_pk_bf16(v1[2], v1[3]);
    *(v4u*)p = w;
}
__device__ __forceinline__ void st_f32x8(float* p, f32x4 v0, f32x4 v1) { *(f32x4*)p = v0; *(f32x4*)(p + 4) = v1; }
__device__ __forceinline__ f32x4 sigm4(f32x4 v) { return (f32x4){sigm(v[0]), sigm(v[1]), sigm(v[2]), sigm(v[3])}; }
__device__ __forceinline__ f32x4 silu4(f32x4 v) { return (f32x4){v[0] * sigm(v[0]), v[1] * sigm(v[1]), v[2] * sigm(v[2]), v[3] * sigm(v[3])}; }
__device__ __forceinline__ f32x4 ldbf4(const bf16* p) { const v2u w = *(const v2u*)p; return (f32x4){bflo(w.x), bfhi(w.x), bflo(w.y), bfhi(w.y)}; }

#define EPI_LOOP(...) \
    _Pragma("unroll") for (int ai = 0; ai < 2; ++ai) _Pragma("unroll") for (int m = 0; m < 4; ++m) { const int row = row0 + ai * 128 + m * 16; \
        _Pragma("unroll") for (int bj = 0; bj < 2; ++bj) { const int col = colb + bj * 32; const f32x4 v0 = acc[ai][bj][m][0], v1 = acc[ai][bj][m][1]; __VA_ARGS__ } }

__device__ __forceinline__ unsigned q8x4(f32x4 g) { unsigned w = 0u;
#pragma unroll
    for (int e = 0; e < 4; ++e) { const float t = fmaxf(__builtin_fmaf(g[e], 255.f, 0.5f), 1.f); w |= ((unsigned)t) << (8 * e); } return w; }
__device__ __forceinline__ f32x4 ub4(unsigned w) { return (f32x4){(float)(w & 0xffu), (float)((w >> 8) & 0xffu), (float)((w >> 16) & 0xffu), (float)(w >> 24)}; }
struct EpiProj {
    bf16* QA; bf16* FA; bf16* IA; bf16* GA; bf16* LAT; bf16* GTA; bf16* GTB;
    __device__ __forceinline__ void operator()(const f32x4 (&acc)[2][2][4][2], const Unit& u, int wr, int wc, int fr, int fq) const {
        const int row0 = u.pm * 256 + wr * 64 + fr, pn = u.pn; const int colb = (pn & 3) * 256 + wc * 64 + 8 * fq;
        if (pn < 4)       { EPI_LOOP( st_bf16x8(QA + (size_t)row * 1024 + col, v0, v1); ) }
        else if (pn < 8)  { EPI_LOOP( st_bf16x8(FA + (size_t)row * 1024 + col, v0, v1); ) }
        else if (pn < 12) { EPI_LOOP( st_bf16x8(IA + (size_t)row * 1024 + col, v0, v1); ) }
        else if (pn < 16) { EPI_LOOP( st_bf16x8(GA + (size_t)row * 1024 + col, silu4(v0), silu4(v1)); ) }
        else if (pn < 20) { EPI_LOOP( st_bf16x8(LAT + (size_t)row * 1024 + col, v0, v1); ) }
        else { unsigned char* G8 = (unsigned char*)(pn < 28 ? GTA : GTB) + ((size_t)(u.pm * 8 + ((pn - 20) & 7)) * 8 + (wr * 4 + wc)) * 8192 + (fq * 16 + fr) * 16;
            _Pragma("unroll") for (int ai = 0; ai < 2; ++ai) _Pragma("unroll") for (int bj = 0; bj < 2; ++bj) _Pragma("unroll") for (int mp = 0; mp < 2; ++mp) { v4u w;
                w.x = q8x4(sigm4(acc[ai][bj][2 * mp][0])); w.y = q8x4(sigm4(acc[ai][bj][2 * mp][1])); w.z = q8x4(sigm4(acc[ai][bj][2 * mp + 1][0])); w.w = q8x4(sigm4(acc[ai][bj][2 * mp + 1][1]));
                *(v4u*)(G8 + (ai * 4 + bj * 2 + mp) * 1024) = w; } }
    }
};
struct EpiQ {
    bf16* QB; bf16* QIDX;
    __device__ __forceinline__ void operator()(const f32x4 (&acc)[2][2][4][2], const Unit& u, int wr, int wc, int fr, int fq) const {
        const int row0 = u.pm * 256 + wr * 64 + fr, pn = u.pn;
        if (pn < 16) { const int colb = pn * 256 + wc * 64 + 8 * fq; EPI_LOOP( st_bf16x8(QB + (size_t)row * 4096 + col, v0, v1); ) }
        else { const int colb = (pn - 16) * 256 + wc * 64 + 8 * fq; EPI_LOOP( st_bf16x8(QIDX + (size_t)row * 1024 + col, v0, v1); ) }
    }
};
struct EpiBf {
    bf16* O; int ldc; int coff;
    __device__ __forceinline__ void operator()(const f32x4 (&acc)[2][2][4][2], const Unit& u, int wr, int wc, int fr, int fq) const {
        const int row0 = u.pm * 256 + wr * 64 + fr; const int colb = coff + u.pn * 256 + wc * 64 + 8 * fq;
        EPI_LOOP( st_bf16x8(O + (size_t)row * ldc + col, v0, v1); )
    }
};
struct HookGate {
    static constexpr bool ON = true; const bf16* GA_; const bf16* GB_;
    __device__ __forceinline__ void mid(f32x4 (&acc)[2][2][4][2], const Unit& u, int wr, int wc, int fr, int fq) const {
        asm volatile("" : "+v"(fr), "+v"(fq));
        const size_t off = ((size_t)(u.pm * 8 + u.pn) * 8 + (wr * 4 + wc)) * 8192 + (fq * 16 + fr) * 16;
        const unsigned char* A8 = (const unsigned char*)GA_ + off; const unsigned char* B8 = (const unsigned char*)GB_ + off;
#pragma unroll
        for (int ai = 0; ai < 2; ++ai)
#pragma unroll
            for (int mp = 0; mp < 2; ++mp) {
#pragma unroll
                for (int bj = 0; bj < 2; ++bj) { const v4u a = *(const v4u*)(A8 + (ai * 4 + bj * 2 + mp) * 1024), b = *(const v4u*)(B8 + (ai * 4 + bj * 2 + mp) * 1024);
#pragma unroll
                    for (int mm = 0; mm < 2; ++mm)
#pragma unroll
                        for (int n = 0; n < 2; ++n) { const unsigned aw = a[mm * 2 + n], bw = b[mm * 2 + n]; const f32x4 fa = ub4(aw), fb = ub4(bw); f32x4 r;
#pragma unroll
                            for (int j = 0; j < 4; ++j) r[j] = fa[j] * __builtin_amdgcn_rcpf(fb[j]);
                            acc[ai][bj][2 * mp + mm][n] = acc[ai][bj][2 * mp + mm][n] * r; } }
                asm volatile("" : "+v"(acc[ai][0][2 * mp][0]), "+v"(acc[ai][0][2 * mp][1]), "+v"(acc[ai][1][2 * mp][0]), "+v"(acc[ai][1][2 * mp][1]));
                asm volatile("" : "+v"(acc[ai][0][2 * mp + 1][0]), "+v"(acc[ai][0][2 * mp + 1][1]), "+v"(acc[ai][1][2 * mp + 1][0]), "+v"(acc[ai][1][2 * mp + 1][1]));
                asm volatile("" ::: "memory"); }
    }
};
__device__ __forceinline__ f32x4 cvbf4(v2u w) { return (f32x4){bflo(w.x), bfhi(w.x), bflo(w.y), bfhi(w.y)}; }
struct EpiGateM {
    const bf16* GB_; bf16* MRG_;
    __device__ __forceinline__ void operator()(const f32x4 (&acc)[2][2][4][2], const Unit& u, int wr, int wc, int fr, int fq) const {
        const int row0 = u.pm * 256 + wr * 64 + fr; const int colb = u.pn * 256 + wc * 64 + 8 * fq;
        const unsigned char* B8 = (const unsigned char*)GB_ + ((size_t)(u.pm * 8 + u.pn) * 8 + (wr * 4 + wc)) * 8192 + (fq * 16 + fr) * 16;
#pragma unroll
        for (int ai = 0; ai < 2; ++ai) { v4u gr[2][2];
#pragma unroll
            for (int bj = 0; bj < 2; ++bj)
#pragma unroll
                for (int mp = 0; mp < 2; ++mp) gr[bj][mp] = *(const v4u*)(B8 + (ai * 4 + bj * 2 + mp) * 1024);
#pragma unroll
            for (int m = 0; m < 4; ++m)
#pragma unroll
                for (int bj = 0; bj < 2; ++bj) { const size_t o = (size_t)(row0 + ai * 128 + m * 16) * 2048 + colb + bj * 32;
                    const unsigned w0 = gr[bj][m >> 1][(m & 1) * 2], w1 = gr[bj][m >> 1][(m & 1) * 2 + 1];
                    st_bf16x8(MRG_ + o, acc[ai][bj][m][0] * (ub4(w0) * (1.f / 255.f)), acc[ai][bj][m][1] * (ub4(w1) * (1.f / 255.f))); } }
    }
};
struct EpiGateA {
    float* T1; const bf16* GT;
    __device__ __forceinline__ void operator()(const f32x4 (&acc)[2][2][4][2], const Unit& u, int wr, int wc, int fr, int fq) const {
        const int row0 = u.pm * 256 + wr * 64 + fr; const int colb = u.pn * 256 + wc * 64 + 8 * fq;
        EPI_LOOP( const size_t o = (size_t)row * 2048 + col; const f32x4 g0 = ldbf4(GT + o), g1 = ldbf4(GT + o + 4); st_f32x8(T1 + o, v0 * g0, v1 * g1); )
    }
};
struct EpiGateB {
    const float* T1; const bf16* GT; bf16* MRG;
    __device__ __forceinline__ void operator()(const f32x4 (&acc)[2][2][4][2], const Unit& u, int wr, int wc, int fr, int fq) const {
        const int row0 = u.pm * 256 + wr * 64 + fr; const int colb = u.pn * 256 + wc * 64 + 8 * fq;
        EPI_LOOP( const size_t o = (size_t)row * 2048 + col; const f32x4 g0 = ldbf4(GT + o), g1 = ldbf4(GT + o + 4); const f32x4 t0 = *(const f32x4*)(T1 + o), t1 = *(const f32x4*)(T1 + o + 4);
                  st_bf16x8(MRG + o, t0 + v0 * g0, t1 + v1 * g1); )
    }
};
struct EpiRes {
    const float* X; const bf16* Hh; bf16* R; const float* md; int osh, osc, ogt;
    __device__ __forceinline__ void operator()(const f32x4 (&acc)[2][2][4][2], const Unit& u, int wr, int wc, int fr, int fq) const {
        const int row0 = u.pm * 256 + wr * 64 + fr; const int colb = u.pn * 256 + wc * 64 + 8 * fq; const float* g = md + (size_t)(u.pm >> 4) * MODW;
        f32x4 gg[2][2];
#pragma unroll
        for (int bj = 0; bj < 2; ++bj) { gg[bj][0] = *(const f32x4*)(g + ogt + colb + bj * 32) + 1.f; gg[bj][1] = *(const f32x4*)(g + ogt + colb + bj * 32 + 4) + 1.f; }
        if (X) {
#pragma unroll
            for (int ai = 0; ai < 2; ++ai)
#pragma unroll
                for (int mh = 0; mh < 2; ++mh) { f32x4 xr[2][2][2];
#pragma unroll
                    for (int mm = 0; mm < 2; ++mm)
#pragma unroll
                        for (int bj = 0; bj < 2; ++bj) { const size_t o = (size_t)(row0 + ai * 128 + (2 * mh + mm) * 16) * 2048 + colb + bj * 32; xr[mm][bj][0] = *(const f32x4*)(X + o); xr[mm][bj][1] = *(const f32x4*)(X + o + 4); }
#pragma unroll
                    for (int mm = 0; mm < 2; ++mm)
#pragma unroll
                        for (int bj = 0; bj < 2; ++bj) { const int m = 2 * mh + mm; const size_t o = (size_t)(row0 + ai * 128 + m * 16) * 2048 + colb + bj * 32;
                            st_bf16x8(R + o, xr[mm][bj][0] * ALPHA + gg[bj][0] * acc[ai][bj][m][0], xr[mm][bj][1] * ALPHA + gg[bj][1] * acc[ai][bj][m][1]); } }
        } else {
            f32x4 ia[2][2], sb[2][2];
#pragma unroll
            for (int bj = 0; bj < 2; ++bj)
#pragma unroll
                for (int hh = 0; hh < 2; ++hh) { const f32x4 sc = *(const f32x4*)(g + osc + colb + bj * 32 + 4 * hh), sh = *(const f32x4*)(g + osh + colb + bj * 32 + 4 * hh);
#pragma unroll
                    for (int e = 0; e < 4; ++e) { ia[bj][hh][e] = ALPHA / (1.f + sc[e]); sb[bj][hh][e] = sh[e] * ia[bj][hh][e]; } }
#pragma unroll
            for (int ai = 0; ai < 2; ++ai) { v2u xr[4][2][2];
#pragma unroll
                for (int m = 0; m < 4; ++m)
#pragma unroll
                    for (int bj = 0; bj < 2; ++bj) { const size_t o = (size_t)(row0 + ai * 128 + m * 16) * 2048 + colb + bj * 32; xr[m][bj][0] = *(const v2u*)(Hh + o); xr[m][bj][1] = *(const v2u*)(Hh + o + 4); }
#pragma unroll
                for (int m = 0; m < 4; ++m)
#pragma unroll
                    for (int bj = 0; bj < 2; ++bj) { const size_t o = (size_t)(row0 + ai * 128 + m * 16) * 2048 + colb + bj * 32;
                        st_bf16x8(R + o, cvbf4(xr[m][bj][0]) * ia[bj][0] - sb[bj][0] + gg[bj][0] * acc[ai][bj][m][0], cvbf4(xr[m][bj][1]) * ia[bj][1] - sb[bj][1] + gg[bj][1] * acc[ai][bj][m][1]); } }
        }
    }
};
template <int which, bool FINAL>
struct EpiLn {
    unsigned char* ws; const float* X; float* Fo; const float* lng; const float* lnb; LAS unsigned char* lds; int l;
    __device__ __forceinline__ void operator()(f32x4 (&acc)[2][2][4][2], const Unit& u, int wr, int wc, int fr, int fq) const {
        { const int ln_ = lane_id(); fr = ln_ & 15; fq = ln_ >> 4; }
        int upm = u.pm, upn = u.pn; asm volatile("" : "+s"(upm), "+s"(upn));
        const float* MODb = (const float*)(ws + WS_MOD); bf16* Hh = (bf16*)(ws + WS_H);
        const float* g = MODb + ((size_t)l * NBATCH + (upm >> 4)) * MODW + (which ? 3 * DM : 0);
        const float* go = which ? MODb + ((size_t)(l + 1 < DEPTH ? l + 1 : l) * NBATCH + (upm >> 4)) * MODW : g + 3 * DM;
        LAS float* sl = (LAS float*)(lds + RING_BYTES);
        const int row0 = upm * 256 + wr * 64 + fr; const int colb = upn * 256 + wc * 64 + 8 * fq;
#pragma unroll
        for (int bj = 0; bj < 2; ++bj) { const int c0 = colb + bj * 32;
            const f32x4 gg0 = *(const f32x4*)(g + 2 * DM + c0) + 1.f, gg1 = *(const f32x4*)(g + 2 * DM + c0 + 4) + 1.f;
            if (which == 0 && X) {
#pragma unroll
                for (int ai = 0; ai < 2; ++ai) { f32x4 xr[4][2];
#pragma unroll
                    for (int m = 0; m < 4; ++m) { const size_t o = (size_t)(row0 + ai * 128 + m * 16) * 2048 + c0; xr[m][0] = *(const f32x4*)(X + o); xr[m][1] = *(const f32x4*)(X + o + 4); }
#pragma unroll
                    for (int m = 0; m < 4; ++m) { acc[ai][bj][m][0] = xr[m][0] * ALPHA + gg0 * acc[ai][bj][m][0]; acc[ai][bj][m][1] = xr[m][1] * ALPHA + gg1 * acc[ai][bj][m][1]; } }
            } else {
                f32x4 ia0, ia1, sb0, sb1;
                { const f32x4 sc0 = *(const f32x4*)(g + DM + c0), sc1 = *(const f32x4*)(g + DM + c0 + 4), sh0 = *(const f32x4*)(g + c0), sh1 = *(const f32x4*)(g + c0 + 4);
#pragma unroll
                  for (int e = 0; e < 4; ++e) { ia0[e] = ALPHA * __builtin_amdgcn_rcpf(1.f + sc0[e]); ia1[e] = ALPHA * __builtin_amdgcn_rcpf(1.f + sc1[e]); sb0[e] = sh0[e] * ia0[e]; sb1[e] = sh1[e] * ia1[e]; } }
#pragma unroll
                for (int ai = 0; ai < 2; ++ai) { v2u xr[4][2];
#pragma unroll
                    for (int m = 0; m < 4; ++m) { const size_t o = (size_t)(row0 + ai * 128 + m * 16) * 2048 + c0; xr[m][0] = *(const v2u*)(Hh + o); xr[m][1] = *(const v2u*)(Hh + o + 4); }
#pragma unroll
                    for (int m = 0; m < 4; ++m) { acc[ai][bj][m][0] = cvbf4(xr[m][0]) * ia0 - sb0 + gg0 * acc[ai][bj][m][0]; acc[ai][bj][m][1] = cvbf4(xr[m][1]) * ia1 - sb1 + gg1 * acc[ai][bj][m][1]; }
                    asm volatile("" ::: "memory"); }
            }
            asm volatile("" ::: "memory"); }
        { const int ln_ = lane_id(); fr = ln_ & 15; fq = ln_ >> 4; }
#pragma unroll
        for (int ai = 0; ai < 2; ++ai)
#pragma unroll
            for (int m = 0; m < 4; ++m) { float s1 = 0.f, s2 = 0.f;
#pragma unroll
                for (int bj = 0; bj < 2; ++bj)
#pragma unroll
                    for (int hh = 0; hh < 2; ++hh) { const f32x4 v = acc[ai][bj][m][hh]; s1 += (v[0] + v[1]) + (v[2] + v[3]); s2 += (v[0] * v[0] + v[1] * v[1]) + (v[2] * v[2] + v[3] * v[3]); }
                s1 = xsum32(xsum16(s1)); s2 = xsum32(xsum16(s2));
                if (fq == 0) { const int rt = ai * 128 + wr * 64 + m * 16 + fr; sl[(wc * 256 + rt) * 2] = s1; sl[(wc * 256 + rt) * 2 + 1] = s2; } }
        __syncthreads();
        const int tid = (wr * 4 + wc) * 64 + lane_id();
        float* ex = (float*)(ws + WS_SEL) + (size_t)upm * 8 * 512;
        if (tid < 256) { const float S1 = (sl[tid * 2] + sl[(256 + tid) * 2]) + (sl[(512 + tid) * 2] + sl[(768 + tid) * 2]), S2 = (sl[tid * 2 + 1] + sl[(256 + tid) * 2 + 1]) + (sl[(512 + tid) * 2 + 1] + sl[(768 + tid) * 2 + 1]);
            __hip_atomic_store((unsigned*)(ex + (upn * 256 + tid) * 2), __builtin_bit_cast(unsigned, S1), __ATOMIC_RELAXED, __HIP_MEMORY_SCOPE_AGENT);
            __hip_atomic_store((unsigned*)(ex + (upn * 256 + tid) * 2 + 1), __builtin_bit_cast(unsigned, S2), __ATOMIC_RELAXED, __HIP_MEMORY_SCOPE_AGENT); }
        asm volatile("s_waitcnt vmcnt(0)" ::: "memory");
        __syncthreads();
        if (tid == 0) { unsigned* cp = (unsigned*)(ws + WS_CTL) + 256 + (l * 2 + which) * 64 + upm;
            __builtin_amdgcn_fence(__ATOMIC_RELEASE, "agent"); asm volatile("s_waitcnt vmcnt(0)" ::: "memory");
            (void)xb_add(cp, 1u);
            for (unsigned sp = 0u; xb_ld(cp) < 8u && sp < 400000u; ++sp) __builtin_amdgcn_s_sleep(1);
            __builtin_amdgcn_fence(__ATOMIC_ACQUIRE, "agent"); asm volatile("s_waitcnt vmcnt(0)" ::: "memory"); }
        __syncthreads();
        if (tid < 256) { float S1 = 0.f, S2 = 0.f;
#pragma unroll
            for (int p = 0; p < 8; ++p) { S1 += __builtin_bit_cast(float, __hip_atomic_load((unsigned*)(ex + (p * 256 + tid) * 2), __ATOMIC_RELAXED, __HIP_MEMORY_SCOPE_AGENT));
                S2 += __builtin_bit_cast(float, __hip_atomic_load((unsigned*)(ex + (p * 256 + tid) * 2 + 1), __ATOMIC_RELAXED, __HIP_MEMORY_SCOPE_AGENT)); }
            const float mean = S1 * (1.f / DM); const float var = fmaxf(S2 * (1.f / DM) - mean * mean, 0.f);
            sl[2048 + tid * 2] = mean; sl[2048 + tid * 2 + 1] = 1.0f / sqrtf(var + 1e-5f); }
        __syncthreads();
        { const int ln_ = lane_id(); fr = ln_ & 15; fq = ln_ >> 4; }
        const int row1 = upm * 256 + wr * 64 + fr; const int colc = upn * 256 + wc * 64 + 8 * fq;
#pragma unroll
        for (int bj = 0; bj < 2; ++bj) { const int c0 = colc + bj * 32;
            const f32x4 lg0 = *(const f32x4*)(lng + c0), lg1 = *(const f32x4*)(lng + c0 + 4), lb0 = *(const f32x4*)(lnb + c0), lb1 = *(const f32x4*)(lnb + c0 + 4);
            const f32x4 q0 = *(const f32x4*)(go + DM + c0) + 1.f, q1 = *(const f32x4*)(go + DM + c0 + 4) + 1.f, h0 = *(const f32x4*)(go + c0), h1 = *(const f32x4*)(go + c0 + 4);
#pragma unroll
            for (int ai = 0; ai < 2; ++ai)
#pragma unroll
                for (int m = 0; m < 4; ++m) { const int rt = ai * 128 + wr * 64 + m * 16 + fr; const float mean = sl[2048 + rt * 2], rstd = sl[2048 + rt * 2 + 1];
                    const size_t o = (size_t)(row1 + ai * 128 + m * 16) * 2048 + c0;
                    const f32x4 y0 = (acc[ai][bj][m][0] - mean) * rstd * lg0 + lb0, y1 = (acc[ai][bj][m][1] - mean) * rstd * lg1 + lb1;
                    if constexpr (FINAL) { *(f32x4*)(Fo + o) = y0; *(f32x4*)(Fo + o + 4) = y1; }
                    else st_bf16x8(Hh + o, y0 * q0 + h0, y1 * q1 + h1); }
            asm volatile("" ::: "memory"); }
    }
};
struct EpiSwiglu {
    bf16* ACT;
    __device__ __forceinline__ void operator()(const f32x4 (&acc)[2][2][4][2], const Unit& u, int wr, int wc, int fr, int fq) const {
        const int row0 = u.pm * 256 + wr * 64 + fr; const int col = u.pn * 128 + wc * 32 + 8 * fq;
#pragma unroll
        for (int ai = 0; ai < 2; ++ai)
#pragma unroll
            for (int m = 0; m < 4; ++m) { const int row = row0 + ai * 128 + m * 16;
                st_bf16x8(ACT + (size_t)row * DFF + col, silu4(acc[ai][0][m][0]) * acc[ai][1][m][0], silu4(acc[ai][0][m][1]) * acc[ai][1][m][1]); }
    }
};

__global__ void __launch_bounds__(NTHR, 2) fwd_kernel(Args args) {
    extern __shared__ __attribute__((aligned(16))) unsigned char lds_raw[];
    LAS unsigned char* lds = (LAS unsigned char*)lds_raw;
    const int G = gridDim.x, blk = blockIdx.x;
    const int NGW = G * NWAVES, NT = G * NTHR;
    unsigned char* const ws_base = args.ws;
    gu32* ctl = (gu32*)(ws_base + WS_CTL);
    for (int u = threadIdx.x; u < (LDS_BYTES - LDSCTL_OFF) / 4; u += NTHR) ((LAS unsigned*)(lds + LDSCTL_OFF))[u] = 0u;
    __syncthreads();
    volatile LAS unsigned* MISC = (volatile LAS unsigned*)(lds + MISC_OFF);
    const int wave_s = __builtin_amdgcn_readfirstlane((int)(threadIdx.x >> 6));
    XcdBarrier bar = xcd_barrier_post((unsigned*)(ctl + CW_BAR), MISC + 8); bar.wave = wave_s;
    if (threadIdx.x == 0) { unsigned nloc_ = 0u, nx_ = 0u; xcd_barrier_complete(bar.bar, bar.x, nloc_, nx_); bar.st[0] = nloc_; bar.st[1] = nx_; }
    __syncthreads();
#define GRID_BAR() xcd_barrier(bar)

#define x_in ((const float*)(const GAS float*)args.in[0 + z_])
#define c_in ((const float*)(const GAS float*)args.in[1 + z_])
#define w_ada ((const float*)(const GAS float*)args.in[2 + z_])
#define b_ada ((const float*)(const GAS float*)args.in[3 + z_])
#define w_in ((const float*)(const GAS float*)args.in[4 + z_])
#define lb_logits ((const float*)(const GAS float*)args.in[5 + z_])
#define g_hg ((const float*)(const GAS float*)args.in[6 + z_])
#define w_pa ((const float*)(const GAS float*)args.in[7 + z_])
#define g_cq ((const float*)(const GAS float*)args.in[8 + z_])
#define g_ckv ((const float*)(const GAS float*)args.in[9 + z_])
#define w_uq ((const float*)(const GAS float*)args.in[10 + z_])
#define w_iq ((const float*)(const GAS float*)args.in[11 + z_])
#define w_uv ((const float*)(const GAS float*)args.in[12 + z_])
#define w_pb ((const float*)(const GAS float*)args.in[13 + z_])
#define w_out ((const float*)(const GAS float*)args.in[14 + z_])
#define ln1_g ((const float*)(const GAS float*)args.in[15 + z_])
#define ln1_b ((const float*)(const GAS float*)args.in[16 + z_])
#define w_gate ((const float*)(const GAS float*)args.in[17 + z_])
#define w_up ((const float*)(const GAS float*)args.in[18 + z_])
#define w_down ((const float*)(const GAS float*)args.in[19 + z_])
#define ln2_g ((const float*)(const GAS float*)args.in[20 + z_])
#define ln2_b ((const float*)(const GAS float*)args.in[21 + z_])
#define MOD  ((float*)(ws + WS_MOD))
#define LB   ((float*)(ws + WS_LB))
#define MODP ((float*)(ws + WS_MODP))
#define W1   ((bf16*)(ws + WS_W1))
#define W3   ((bf16*)(ws + WS_W3))
#define W6   ((bf16*)(ws + WS_W6))
#define W7   ((bf16*)(ws + WS_W7))
#define W8   ((bf16*)(ws + WS_W8))
#define W10  ((bf16*)(ws + WS_W10))
#define W11  ((bf16*)(ws + WS_W11))
#define XB   ((bf16*)(ws + WS_X))
#define RB   ((bf16*)(ws + WS_R))
#define HB   ((bf16*)(ws + WS_H))
#define QA   ((bf16*)(ws + WS_QA))
#define FA   ((bf16*)(ws + WS_FA))
#define IA   ((bf16*)(ws + WS_IA))
#define GA   ((bf16*)(ws + WS_GA))
#define LAT  ((bf16*)(ws + WS_LAT))
#define GTA  ((bf16*)(ws + WS_GTA))
#define GTB  ((bf16*)(ws + WS_GTB))
#define CQN  ((bf16*)(ws + WS_CQN))
#define CKV  ((bf16*)(ws + WS_CKV))
#define KIDX ((bf16*)(ws + WS_KIDX))
#define IDXW ((float*)(ws + WS_IDXW))
#define QB   ((bf16*)(ws + WS_QB))
#define QIDX ((bf16*)(ws + WS_QIDX))
#define SEL  ((unsigned short*)(ws + WS_SEL))
#define YAB  ((bf16*)(ws + WS_YAB))
#define MRG  ((bf16*)(ws + WS_MRG))
#define OB   ((bf16*)(ws + WS_OB))
#define ISC  ((_Float16*)(ws + WS_BIG))
#define OP   ((float*)(ws + WS_BIG))
#define ACT  ((bf16*)(ws + WS_BIG))
#define KK   LAT
#define modl (MOD + (size_t)l * NBATCH * MODW)
#define KSB  ((bf16*)(ws + WS_KSB))
#define QSB  ((bf16*)(ws + WS_QSB))
#define KVT  ((bf16*)(ws + WS_BIG))
#define SPB  ((bf16*)(ws + WS_FA))
#define DEB  ((float*)(ws + WS_DEB))
#define PHASE_BEGIN { unsigned om_ = ~0u; asm volatile("" : "+s"(om_)); int tid = wave_s * 64 + (int)__builtin_amdgcn_mbcnt_hi(om_, __builtin_amdgcn_mbcnt_lo(om_, 0u)); asm volatile("" : "+v"(tid)); int z_ = 0; asm volatile("" : "+s"(z_)); (void)z_; GAS unsigned char* wsg_ = (GAS unsigned char*)ws_base; asm volatile("" : "+s"(wsg_)); unsigned char* ws = (unsigned char*)wsg_; const int lane = tid & 63, wave = __builtin_amdgcn_readfirstlane(tid >> 6); \
        const int gw = blk * NWAVES + wave, gtid = blk * NTHR + tid; LAS float* wscr = (LAS float*)(lds + wave * 16384); (void)lane; (void)gw; (void)gtid; (void)wscr;
#define PHASE_END }

#define CVT_DECODE(IT_, MID_, K0_, N0_) do { int r_ = (IT_); \
        if (r_ < I1) { MID_ = 0; K0_ = (r_ / (N1 / 32)) * 64; N0_ = (r_ % (N1 / 32)) * 32; } else { r_ -= I1; \
        if (r_ < I3) { MID_ = 1; K0_ = (r_ / (N3 / 32)) * 64; N0_ = (r_ % (N3 / 32)) * 32; } else { r_ -= I3; \
        if (r_ < I6) { MID_ = 2; K0_ = (r_ / 32) * 64; N0_ = (r_ % 32) * 32; } else { r_ -= I6; \
        if (r_ < I7) { MID_ = 3; K0_ = (r_ / (DM / 32)) * 64; N0_ = (r_ % (DM / 32)) * 32; } else { r_ -= I7; \
        if (r_ < I8) { MID_ = 4; K0_ = (r_ / (DM / 32)) * 64; N0_ = (r_ % (DM / 32)) * 32; } else { r_ -= I8; \
        if (r_ < I10) { MID_ = 5; K0_ = (r_ / (N10 / 32)) * 64; N0_ = (r_ % (N10 / 32)) * 32; } else { r_ -= I10; \
        MID_ = 6; K0_ = (r_ / (DM / 32)) * 64; N0_ = (r_ % (DM / 32)) * 32; } } } } } } } while (0)
#define CVT_LOAD(MID_, K0_, N0_, TV_) do { \
        if (MID_ == 0) cvt_load([=](int k, int n) -> f32x4 { const f32x4 v = *(const f32x4*)(s_in + (size_t)k * 9040 + (n < 4944 ? n : n - 176)); return (n >= 4944 && n < 5120) ? (f32x4){0.f, 0.f, 0.f, 0.f} : v; }, K0_, N0_, lane, TV_); \
        else if (MID_ == 1) cvt_load([=](int k, int n) -> f32x4 { const float* p = n < 4096 ? s_uq + (size_t)k * 4096 + n : s_iq + (size_t)k * 1024 + (n - 4096); return *(const f32x4*)p * (n < 4096 ? 0.0625f : 1.f); }, K0_, N0_, lane, TV_); \
        else if (MID_ == 2) cvt_load([=](int k, int n) -> f32x4 { const int h = n >> 6, v = n & 63, kk = k >> 8, c = k & 255; const f32x4 w = *(const f32x4*)(s_uv + ((size_t)h * 256 + c) * 64 + v); return kk == (h & 3) ? w : (f32x4){0.f, 0.f, 0.f, 0.f}; }, K0_, N0_, lane, TV_); \
        else if (MID_ == 3) cvt_load([=](int k, int n) -> f32x4 { const float* p = k < 1024 ? s_pa + (size_t)k * DM + n : s_pb + (size_t)(k - 1024) * DM + n; return *(const f32x4*)p; }, K0_, N0_, lane, TV_); \
        else if (MID_ == 4) cvt_load([=](int k, int n) -> f32x4 { return *(const f32x4*)(s_out + (size_t)k * DM + n); }, K0_, N0_, lane, TV_); \
        else if (MID_ == 5) cvt_load([=](int k, int n) -> f32x4 { const int pn = n >> 8, rr = n & 255, cc = pn * 128 + (rr >> 6) * 32 + (rr & 31); const float* p = ((rr & 32) ? s_u : s_g) + (size_t)k * DFF + cc; return *(const f32x4*)p; }, K0_, N0_, lane, TV_); \
        else cvt_load([=](int k, int n) -> f32x4 { return *(const f32x4*)(s_d + (size_t)k * DM + n); }, K0_, N0_, lane, TV_); } while (0)
#define CONVERT_LAYER(L) do { const int l_ = (L); \
        const float* s_in = w_in + (size_t)l_ * DM * 9040; const float* s_uq = w_uq + (size_t)l_ * SAR * 4096; const float* s_iq = w_iq + (size_t)l_ * SAR * 1024; \
        const float* s_uv = w_uv + (size_t)l_ * 16 * 256 * 64; const float* s_pa = w_pa + (size_t)l_ * 1024 * DM; const float* s_pb = w_pb + (size_t)l_ * 1024 * DM; \
        const float* s_out = w_out + (size_t)l_ * DM * DM; const float* s_g = w_gate + (size_t)l_ * DM * DFF; const float* s_u = w_up + (size_t)l_ * DM * DFF; const float* s_d = w_down + (size_t)l_ * DFF * DM; \
        constexpr int I1 = (DM / 64) * (N1 / 32), I3 = (SAR / 64) * (N3 / 32), I6 = (1024 / 64) * (1024 / 32), I7 = (DM / 64) * (DM / 32), I8 = I7, I10 = (DM / 64) * (N10 / 32), I11 = (DFF / 64) * (DM / 32); \
        constexpr int NIT = I1 + I3 + I6 + I7 + I8 + I10 + I11; \
        float tv_[32]; int mid_ = 0, k0_ = 0, n0_ = 0; \
        { CVT_DECODE(gw, mid_, k0_, n0_); CVT_LOAD(mid_, k0_, n0_, tv_); } \
        for (int it = gw; it < NIT; it += NGW) { \
            float tc_[32]; _Pragma("unroll") for (int i = 0; i < 32; ++i) tc_[i] = tv_[i]; \
            const int mc_ = mid_, kc_ = k0_, nc_ = n0_; \
            { const int itn_ = it + NGW < NIT ? it + NGW : it; CVT_DECODE(itn_, mid_, k0_, n0_); CVT_LOAD(mid_, k0_, n0_, tv_); }     \
            bf16* wt_ = mc_ == 0 ? W1 : mc_ == 1 ? W3 : mc_ == 2 ? W6 : mc_ == 3 ? W7 : mc_ == 4 ? W8 : mc_ == 5 ? W10 : W11; \
            const int kk_ = mc_ == 0 ? DM : mc_ == 1 ? SAR : mc_ == 2 ? 1024 : mc_ == 3 ? DM : mc_ == 4 ? DM : mc_ == 5 ? DM : DFF; \
            cvt_store(tc_, wt_, kk_, kc_, nc_, wscr, lane); \
        } } while (0)


#ifndef HGRN_NAIVE
#define HGRN_NAIVE 0
#endif
#ifndef IDX_NAIVE
#define IDX_NAIVE 0
#endif
#ifndef ATT_NAIVE
#define ATT_NAIVE 0
#endif
#ifndef TOPK_OLD
#define TOPK_OLD 0
#endif
#ifndef REP_HB
#define REP_HB 1
#endif
#ifndef REP_HC
#define REP_HC 1
#endif
#ifndef REP_P4A
#define REP_P4A 1
#endif
#ifndef REP_P5
#define REP_P5 1
#endif
#ifndef REP_P9
#define REP_P9 1
#endif
#ifndef REP_P12
#define REP_P12 1
#endif
#ifndef REP_TOPK
#define REP_TOPK 1
#endif
#ifndef REP_ATT
#define REP_ATT 1
#endif
#ifndef DRY_ATT
#define DRY_ATT 0
#endif
#ifndef REP_M1
#define REP_M1 1
#endif
#ifndef REP_M2
#define REP_M2 1
#endif
#ifndef REP_M3
#define REP_M3 1
#endif

    PHASE_BEGIN
    {
        LAS float* sc = (LAS float*)lds;
        for (int i = tid; i < NBATCH * DM; i += NTHR) { const float v = c_in[i]; sc[i] = v * sigm(v); }
        __syncthreads();
        for (int item = gtid; item < 8 * 12288; item += NT) {
            const int ks = item / 12288, cg = item % 12288, l = cg / 3072, n4 = (cg % 3072) * 4;
            const float* wp = w_ada + ((size_t)l * DM + ks * 256) * MODW + n4;
            f32x4 a0 = {0.f, 0.f, 0.f, 0.f}, a1 = a0, a2 = a0, a3 = a0;
#pragma unroll 8
            for (int k = 0; k < 256; ++k) { const f32x4 w = *(const f32x4*)(wp + (size_t)k * MODW); const int kk = ks * 256 + k;
                a0 += w * sc[kk]; a1 += w * sc[2048 + kk]; a2 += w * sc[4096 + kk]; a3 += w * sc[6144 + kk]; }
            float* o = MODP + ((size_t)(ks * 4 + l) * 4) * MODW + n4;
            *(f32x4*)(o) = a0; *(f32x4*)(o + MODW) = a1; *(f32x4*)(o + 2 * MODW) = a2; *(f32x4*)(o + 3 * MODW) = a3;
        }
        if (gtid < 1024) {
            const float a = lb_logits[gtid], b = lb_logits[1024 + gtid], c = lb_logits[2048 + gtid], d = lb_logits[3072 + gtid];
            const float mx = fmaxf(fmaxf(a, b), fmaxf(c, d)); const float ea = expf(a - mx), eb = expf(b - mx), ec = expf(c - mx), ed = expf(d - mx); const float inv = 1.f / (ea + eb + ec + ed);
            LB[gtid] = 0.f; LB[1024 + gtid] = eb * inv; LB[2048 + gtid] = (eb + ec) * inv; LB[3072 + gtid] = (eb + ec + ed) * inv;
        }
        __syncthreads();
        CONVERT_LAYER(0);
    }
    PHASE_END
    GRID_BAR();
    PHASE_BEGIN
    for (int i = gtid; i < DEPTH * NBATCH * MODW; i += NT) {
        const int l = i / (NBATCH * MODW), r = i % (NBATCH * MODW), b = r / MODW, n = r % MODW;
        float s = b_ada[l * MODW + n];
#pragma unroll
        for (int ks = 0; ks < 8; ++ks) s += MODP[((size_t)(ks * 4 + l) * 4 + b) * MODW + n];
        MOD[i] = s;
    }
    PHASE_END
    GRID_BAR();
    PHASE_BEGIN
    for (size_t i0 = gtid; i0 < (size_t)M * DM / 8; i0 += (size_t)NT * 4) {
        f32x4 xa[4], xb[4], sa[4], sb[4], ha[4], hb[4];
#pragma unroll
        for (int t = 0; t < 4; ++t) { size_t gi = i0 + (size_t)t * NT; gi = gi < (size_t)M * DM / 8 ? gi : (size_t)M * DM / 8 - 1; const size_t e = gi * 8; const int row = (int)(e / DM), col = (int)(e % DM), b = row / SEQ; const float* md = MOD + (size_t)b * MODW;
            xa[t] = *(const f32x4*)(x_in + e); xb[t] = *(const f32x4*)(x_in + e + 4); sa[t] = *(const f32x4*)(md + 2048 + col); sb[t] = *(const f32x4*)(md + 2048 + col + 4); ha[t] = *(const f32x4*)(md + col); hb[t] = *(const f32x4*)(md + col + 4); }
#pragma unroll
        for (int t = 0; t < 4; ++t) { size_t gi = i0 + (size_t)t * NT; gi = gi < (size_t)M * DM / 8 ? gi : (size_t)M * DM / 8 - 1; const size_t e = gi * 8; st_bf16x8(HB + e, xa[t] * (sa[t] + 1.f) + ha[t], xb[t] * (sb[t] + 1.f) + hb[t]); }
    }
    PHASE_END
    GRID_BAR();

    for (int l = 0; l < DEPTH; ++l) {
        PHASE_BEGIN
        { pg8::Gemm g{HB, W1, M, N1, DM, DM, DM, 0}; pg8::StaticOrder S; S.init(M, N1, G, blk);
          EpiProj E{QA, FA, IA, GA, LAT, GTA, GTB}; pg8::gemm_phase(lds, g, S, E, tid); }
        PHASE_END
        GRID_BAR();
        for (int rep_ = 0; rep_ < REP_M1; ++rep_) {
        PHASE_BEGIN
        v2u ra0, ra1, rkv; unsigned short rki, riw;
        const f32x4 g0 = *(const f32x4*)(g_cq + l * 512 + 4 * lane), g1 = *(const f32x4*)(g_cq + l * 512 + 256 + 4 * lane), gk = *(const f32x4*)(g_ckv + l * 256 + 4 * lane);
        { const bf16* lr = LAT + (size_t)gw * 1024; ra0 = *(const v2u*)(lr + 4 * lane); ra1 = *(const v2u*)(lr + 256 + 4 * lane); rkv = *(const v2u*)(lr + 512 + 4 * lane); rki = lr[768 + lane]; riw = lr[832 + (lane & 15)]; }
        for (int row = gw; row < M; row += NGW) {
            const f32x4 a0 = (f32x4){bflo(ra0.x), bfhi(ra0.x), bflo(ra0.y), bfhi(ra0.y)}, a1 = (f32x4){bflo(ra1.x), bfhi(ra1.x), bflo(ra1.y), bfhi(ra1.y)}, kv = (f32x4){bflo(rkv.x), bfhi(rkv.x), bflo(rkv.y), bfhi(rkv.y)};
            const float ki = bf2f(rki), iw = bf2f(riw);
            { const int rn = row + NGW < M ? row + NGW : row; const bf16* lr = LAT + (size_t)rn * 1024;
              ra0 = *(const v2u*)(lr + 4 * lane); ra1 = *(const v2u*)(lr + 256 + 4 * lane); rkv = *(const v2u*)(lr + 512 + 4 * lane); rki = lr[768 + lane]; riw = lr[832 + (lane & 15)]; }
            float sq = a0[0] * a0[0] + a0[1] * a0[1] + a0[2] * a0[2] + a0[3] * a0[3] + a1[0] * a1[0] + a1[1] * a1[1] + a1[2] * a1[2] + a1[3] * a1[3];
            float sk = kv[0] * kv[0] + kv[1] * kv[1] + kv[2] * kv[2] + kv[3] * kv[3];
            sq = wave_sum(sq); sk = wave_sum(sk);
            const float rq = 1.0f / sqrtf(sq * (1.f / 512.f) + 1e-6f), rk = 1.0f / sqrtf(sk * (1.f / 256.f) + 1e-6f);
            v2u o; f32x4 t = a0 * rq * g0; o.x = pk2(t[0], t[1]); o.y = pk2(t[2], t[3]); *(v2u*)(CQN + (size_t)row * 512 + 4 * lane) = o;
            t = a1 * rq * g1; o.x = pk2(t[0], t[1]); o.y = pk2(t[2], t[3]); *(v2u*)(CQN + (size_t)row * 512 + 256 + 4 * lane) = o;
            t = kv * rk * gk; o.x = pk2(t[0], t[1]); o.y = pk2(t[2], t[3]); *(v2u*)(CKV + (size_t)row * 256 + 4 * lane) = o;
            KIDX[(size_t)row * 64 + lane] = (bf16)f2bf(ki);
            if (lane < 16) IDXW[(size_t)row * 16 + lane] = iw * 0.03125f;
        }
        PHASE_END
        PHASE_BEGIN
        {
            const int cp = tid & 63, sg = tid >> 6;
            LAS unsigned char* KST = lds;
            LAS unsigned char* VTL = lds + 18432;
            LAS float* SEGT = (LAS float*)(lds + 36864);
            LAS float* G63 = (LAS float*)(lds + 40960);
            unsigned pfa[8], pq[8], pv[8]; float plb0, plb1;
#define HA_REQ(U_) do { int uu_ = (U_); asm volatile("" : "+s"(uu_)); const int bh_ = uu_ >> 6, c_ = uu_ & 63, b_ = bh_ >> 3, h_ = bh_ & 7; \
                const size_t rowb_ = (size_t)b_ * SEQ + c_ * 64 + sg * 8; const int col_ = h_ * 128 + 2 * cp; \
                _Pragma("unroll") for (int i = 0; i < 8; ++i) { pfa[i] = *(const unsigned*)(FA + (rowb_ + i) * 1024 + col_); pq[i] = *(const unsigned*)(QA + (rowb_ + i) * 1024 + col_); pv[i] = *(const unsigned*)(IA + (rowb_ + i) * 1024 + col_); } plb0 = LB[l * 1024 + col_]; plb1 = LB[l * 1024 + col_ + 1]; } while (0)
            HA_REQ(blk);
            for (int u = blk; u < 2048; u += G) {
                const int bh = u >> 6, c = u & 63, b = bh >> 3, h = bh & 7;
                const size_t rowb = (size_t)b * SEQ + c * 64 + sg * 8; const int col = h * 128 + 2 * cp;
                const float lb0 = plb0, lb1 = plb1;
                float lf0[8], lf1[8], kk0[8], kk1[8]; unsigned cq[8], cv[8];
#pragma unroll
                for (int i = 0; i < 8; ++i) { cq[i] = pq[i]; cv[i] = pv[i]; }
#pragma unroll
                for (int i = 0; i < 8; ++i) { const float2 fa = make_float2(bflo(pfa[i]), bfhi(pfa[i]));
                    const float f0 = fminf(fmaxf(lb0 + (1.f - lb0) * sigm(fa.x), 1e-6f), 1.f), f1 = fminf(fmaxf(lb1 + (1.f - lb1) * sigm(fa.y), 1e-6f), 1.f);
                    lf0[i] = __logf(f0); lf1[i] = __logf(f1); kk0[i] = (1.f - lb0) * sigm(-fa.x); kk1[i] = (1.f - lb1) * sigm(-fa.y); }
#pragma unroll
                for (int i = 1; i < 8; ++i) { lf0[i] += lf0[i - 1]; lf1[i] += lf1[i - 1]; }
                SEGT[sg * 128 + 2 * cp] = lf0[7]; SEGT[sg * 128 + 2 * cp + 1] = lf1[7];
                HA_REQ(u + G < 2048 ? u + G : u);
                __syncthreads();
                float pre0 = 0.f, pre1 = 0.f, r0 = 0.f, r1 = 0.f, t0 = 0.f, t1 = 0.f;
#pragma unroll
                for (int s2 = 0; s2 < 8; ++s2) { const float a0 = SEGT[s2 * 128 + 2 * cp], a1 = SEGT[s2 * 128 + 2 * cp + 1];
                    if (s2 < sg) { pre0 += a0; pre1 += a1; } if (s2 < 4) { r0 += a0; r1 += a1; } t0 += a0; t1 += a1; }
                unsigned ksw0[4], ksw1[4], vw0[4], vw1[4]; float ks0p = 0.f, ks1p = 0.f, v0p = 0.f, v1p = 0.f;
#pragma unroll
                for (int i = 0; i < 8; ++i) {
                    const float b0 = pre0 + lf0[i], b1 = pre1 + lf1[i];
                    const unsigned qw = cq[i]; const unsigned vw = cv[i];
                    const float qs0 = bflo(qw) * __expf(b0 - r0), qs1 = bfhi(qw) * __expf(b1 - r1);
                    const float ks0 = kk0[i] * __expf(r0 - b0), ks1 = kk1[i] * __expf(r1 - b1);
                    *(unsigned*)(QSB + (rowb + i) * 1024 + col) = pk2(qs0, qs1);
                    *(unsigned*)(KSB + (rowb + i) * 1024 + col) = pk2(ks0, ks1);
                    if (i & 1) { ksw0[i >> 1] = pk2(ks0p, ks0); ksw1[i >> 1] = pk2(ks1p, ks1); vw0[i >> 1] = pk2(v0p, bflo(vw)); vw1[i >> 1] = pk2(v1p, bfhi(vw)); }
                    else { ks0p = ks0; ks1p = ks1; v0p = bflo(vw); v1p = bfhi(vw); }
                }
                *(LAS v4u*)(KST + (2 * cp) * 144 + sg * 16) = (v4u){ksw0[0], ksw0[1], ksw0[2], ksw0[3]};
                *(LAS v4u*)(KST + (2 * cp + 1) * 144 + sg * 16) = (v4u){ksw1[0], ksw1[1], ksw1[2], ksw1[3]};
                *(LAS v4u*)(VTL + (2 * cp) * 144 + sg * 16) = (v4u){vw0[0], vw0[1], vw0[2], vw0[3]};
                *(LAS v4u*)(VTL + (2 * cp + 1) * 144 + sg * 16) = (v4u){vw1[0], vw1[1], vw1[2], vw1[3]};
                if (sg == 7) { float* de = DEB + (size_t)u * 256; *(float2*)(de + 2 * cp) = make_float2(__expf(r0), __expf(r1)); *(float2*)(de + 128 + 2 * cp) = make_float2(__expf(t0), __expf(t1));
                    G63[2 * cp] = __expf(t0 - r0); G63[2 * cp + 1] = __expf(t1 - r1); }
                __syncthreads();
                { const int kt = wave >> 1, vt0 = (wave & 1) * 2, lr = lane & 31, lh = lane >> 5;
                  f32x16 acc0, acc1;
#pragma unroll
                  for (int r = 0; r < 16; ++r) { acc0[r] = 0.f; acc1[r] = 0.f; }
#pragma unroll
                  for (int s4 = 0; s4 < 4; ++s4) {
                      const bf16x8 kb = *(const LAS bf16x8*)(KST + (kt * 32 + lr) * 144 + (s4 * 16 + 8 * lh) * 2);
                      const bf16x8 a0 = *(const LAS bf16x8*)(VTL + (vt0 * 32 + lr) * 144 + (s4 * 16 + 8 * lh) * 2);
                      const bf16x8 a1 = *(const LAS bf16x8*)(VTL + ((vt0 + 1) * 32 + lr) * 144 + (s4 * 16 + 8 * lh) * 2);
                      acc0 = __builtin_amdgcn_mfma_f32_32x32x16_bf16(a0, kb, acc0, 0, 0, 0); acc1 = __builtin_amdgcn_mfma_f32_32x32x16_bf16(a1, kb, acc1, 0, 0, 0); }
                  bf16* kvt = KVT + (size_t)u * 16384 + kt * 32 + lr; const float g = G63[kt * 32 + lr];
#pragma unroll
                  for (int r = 0; r < 16; ++r) { const int vv = 8 * (r >> 2) + 4 * lh + (r & 3);
                      kvt[(size_t)(vt0 * 32 + vv) * 128] = (bf16)(pk2(acc0[r] * g, 0.f) & 0xffffu); kvt[(size_t)((vt0 + 1) * 32 + vv) * 128] = (bf16)(pk2(acc1[r] * g, 0.f) & 0xffffu); } }
                __syncthreads();
            }
        }
#undef HA_REQ
        PHASE_END
        GRID_BAR();
        }
        for (int rep_ = 0; rep_ < REP_M2; ++rep_) {
        PHASE_BEGIN
        for (int item = gtid; item < 32 * 4096; item += NT) {
            const int bh = item >> 12, v = (item >> 5) & 127, k4 = (item & 31) * 4;
            f32x4 S = {0.f, 0.f, 0.f, 0.f};
            for (int c0 = 0; c0 < 64; c0 += 8) {
                f32x4 kv[8], dd[8], ee[8];
#pragma unroll
                for (int j = 0; j < 8; ++j) { const size_t u = (size_t)bh * 64 + c0 + j; kv[j] = ldbf4(KVT + u * 16384 + v * 128 + k4); ee[j] = *(const f32x4*)(DEB + u * 256 + k4); dd[j] = *(const f32x4*)(DEB + u * 256 + 128 + k4); }
#pragma unroll
                for (int j = 0; j < 8; ++j) { const size_t u = (size_t)bh * 64 + c0 + j; const f32x4 sp = S * ee[j]; v2u w; w.x = pk2(sp[0], sp[1]); w.y = pk2(sp[2], sp[3]);
                    *(v2u*)(SPB + u * 16384 + v * 128 + k4) = w; S = S * dd[j] + kv[j]; }
            }
        }
        PHASE_END
        PHASE_BEGIN
        { pg8::Gemm g{CQN, W3, M, N3, SAR, SAR, SAR, 0}; pg8::StaticOrder S; S.init(M, N3, G, blk);
          EpiQ E{QB, QIDX}; pg8::gemm_phase(lds, g, S, E, tid); }
        PHASE_END
        GRID_BAR();
        }
        for (int rep_ = 0; rep_ < REP_M3; ++rep_) {
        PHASE_BEGIN
        {
            LAS unsigned char* QSL = lds;
            LAS unsigned char* KSL = lds + 17408;
            LAS unsigned char* VTL = lds + 34816;
            LAS unsigned char* SPL = lds + 53248;
            LAS unsigned char* AL = lds + 88064;
            LAS float* SSQ = (LAS float*)(lds + 97280);
            const int cp = tid & 63, sg = tid >> 6, lr = lane & 31, lh = lane >> 5;
            v4u rq[2], rk[2], rs[4]; unsigned rv[8]; unsigned short rg[16];
#define HC_REQ(U_) do { int uu_ = (U_); asm volatile("" : "+s"(uu_));   const int bh_ = uu_ >> 6, c_ = uu_ & 63, b_ = bh_ >> 3, h_ = bh_ & 7; const size_t row0_ = (size_t)b_ * SEQ + c_ * 64; const int col0_ = h_ * 128; \
                _Pragma("unroll") for (int j = 0; j < 2; ++j) { const int q = tid + 512 * j, rr = q >> 4, cc = q & 15; \
                    rq[j] = *(const v4u*)(QSB + (row0_ + rr) * 1024 + col0_ + cc * 8); rk[j] = *(const v4u*)(KSB + (row0_ + rr) * 1024 + col0_ + cc * 8); } \
                _Pragma("unroll") for (int j = 0; j < 4; ++j) { const int q = tid + 512 * j, rr = q >> 4, cc = q & 15; rs[j] = *(const v4u*)(SPB + (size_t)uu_ * 16384 + rr * 128 + cc * 8); } \
                _Pragma("unroll") for (int i = 0; i < 8; ++i) rv[i] = *(const unsigned*)(IA + (row0_ + sg * 8 + i) * 1024 + col0_ + 2 * cp); \
                { const int it_ = wave >> 2, vt_ = wave & 3; const int colg_ = col0_ + vt_ * 32 + lr; \
                  _Pragma("unroll") for (int r = 0; r < 16; ++r) { const int ii = it_ * 32 + 8 * (r >> 2) + 4 * lh + (r & 3); rg[r] = GA[(row0_ + ii) * 1024 + colg_]; } } } while (0)
            HC_REQ(blk);
            for (int u = blk; u < 2048; u += G) {
                const int bh = u >> 6, c = u & 63, b = bh >> 3, h = bh & 7;
                const size_t row0 = (size_t)b * SEQ + c * 64; const int col0 = h * 128;
#pragma unroll
                for (int j = 0; j < 2; ++j) { const int q = tid + 512 * j, rr = q >> 4, cc = q & 15;
                    *(LAS v4u*)(QSL + rr * 272 + cc * 16) = rq[j]; *(LAS v4u*)(KSL + rr * 272 + cc * 16) = rk[j]; }
#pragma unroll
                for (int j = 0; j < 4; ++j) { const int q = tid + 512 * j, rr = q >> 4, cc = q & 15; *(LAS v4u*)(SPL + rr * 272 + cc * 16) = rs[j]; }
                { unsigned vw0[4], vw1[4]; float v0p = 0.f, v1p = 0.f;
#pragma unroll
                  for (int i = 0; i < 8; ++i) { const unsigned vw = rv[i];
                      if (i & 1) { vw0[i >> 1] = pk2(v0p, bflo(vw)); vw1[i >> 1] = pk2(v1p, bfhi(vw)); } else { v0p = bflo(vw); v1p = bfhi(vw); } }
                  *(LAS v4u*)(VTL + (2 * cp) * 144 + sg * 16) = (v4u){vw0[0], vw0[1], vw0[2], vw0[3]};
                  *(LAS v4u*)(VTL + (2 * cp + 1) * 144 + sg * 16) = (v4u){vw1[0], vw1[1], vw1[2], vw1[3]}; }
                float gav[16];
#pragma unroll
                for (int r = 0; r < 16; ++r) gav[r] = bf2f(rg[r]);
                const float gg = g_hg[l * 1024 + col0 + (wave & 3) * 32 + lr];
                HC_REQ(u + G < 2048 ? u + G : u);
                __syncthreads();
                if (wave < 4) {
                    const int it = wave >> 1, jt = wave & 1;
                    f32x16 acc;
#pragma unroll
                    for (int r = 0; r < 16; ++r) acc[r] = 0.f;
                    if (!(it == 0 && jt == 1)) {
#pragma unroll
                        for (int s8 = 0; s8 < 8; ++s8) {
                            const bf16x8 a = *(const LAS bf16x8*)(QSL + (it * 32 + lr) * 272 + (s8 * 16 + 8 * lh) * 2);
                            const bf16x8 bb = *(const LAS bf16x8*)(KSL + (jt * 32 + lr) * 272 + (s8 * 16 + 8 * lh) * 2);
                            acc = __builtin_amdgcn_mfma_f32_32x32x16_bf16(a, bb, acc, 0, 0, 0); } }
                    const int jj = jt * 32 + lr;
#pragma unroll
                    for (int r = 0; r < 16; ++r) { const int ii = it * 32 + 8 * (r >> 2) + 4 * lh + (r & 3); const float x = (jj <= ii) ? acc[r] : 0.f;
                        *(LAS unsigned short*)(AL + ii * 144 + jj * 2) = (unsigned short)(pk2(x, 0.f) & 0xffffu); }
                }
                __syncthreads();
                { const int it = wave >> 2, vt = wave & 3;
                  f32x16 acc;
#pragma unroll
                  for (int r = 0; r < 16; ++r) acc[r] = 0.f;
#pragma unroll
                  for (int s4 = 0; s4 < 4; ++s4) {
                      const bf16x8 a = *(const LAS bf16x8*)(AL + (it * 32 + lr) * 144 + (s4 * 16 + 8 * lh) * 2);
                      const bf16x8 bb = *(const LAS bf16x8*)(VTL + (vt * 32 + lr) * 144 + (s4 * 16 + 8 * lh) * 2);
                      acc = __builtin_amdgcn_mfma_f32_32x32x16_bf16(a, bb, acc, 0, 0, 0); }
#pragma unroll
                  for (int s8 = 0; s8 < 8; ++s8) {
                      const bf16x8 a = *(const LAS bf16x8*)(QSL + (it * 32 + lr) * 272 + (s8 * 16 + 8 * lh) * 2);
                      const bf16x8 bb = *(const LAS bf16x8*)(SPL + (vt * 32 + lr) * 272 + (s8 * 16 + 8 * lh) * 2);
                      acc = __builtin_amdgcn_mfma_f32_32x32x16_bf16(a, bb, acc, 0, 0, 0); }
#pragma unroll
                  for (int r = 0; r < 16; ++r) { float q2 = acc[r] * acc[r];
                      q2 = xsum16(rowsum16(q2));
                      if (lr == 0) SSQ[vt * 64 + it * 32 + 8 * (r >> 2) + 4 * lh + (r & 3)] = q2; }
                  __syncthreads();
                  const int colg = col0 + vt * 32 + lr;
#pragma unroll
                  for (int r = 0; r < 16; ++r) { const int ii = it * 32 + 8 * (r >> 2) + 4 * lh + (r & 3);
                      const float ss = SSQ[ii] + SSQ[64 + ii] + SSQ[128 + ii] + SSQ[192 + ii]; const float rn = 1.0f / sqrtf(ss * (1.f / 128.f) + 1e-6f);
                      YAB[(row0 + ii) * 2048 + colg] = (bf16)(pk2(acc[r] * rn * gg * gav[r], 0.f) & 0xffffu); }
                }
                __syncthreads();
            }
        }
#undef HC_REQ
        PHASE_END
        PHASE_BEGIN
        for (int ub = blk * NWAVES; ub < 2048; ub += NGW) {
            const int unit = ub + wave;
            const int b = ub >> 9, j = unit & 511, lr = lane & 31, lh = lane >> 5;
            const int qsel = (lr >> 2) & 1, head = (lr >> 3) * 4 + (lr & 3);
            const int qlo = 4 * j, qhi = 4 * (1023 - j);
            const int nlo = ((qlo >> 6) + 1) * 64, nhi = ((qhi >> 6) + 1) * 64;
            const int nlo8 = (nlo + 511) & ~511, nhi8 = (nhi + 511) & ~511;
            const int nmax8 = (((((4 * (1023 - (ub & 511))) >> 6) + 1) * 64) + 511) & ~511;
            bf16x8 A[4][4]; float W[4][16]; typedef float f32x2_t __attribute__((ext_vector_type(2)));
#pragma unroll
            for (int p = 0; p < 4; ++p) { const size_t qb = (size_t)b * SEQ + (p < 2 ? qlo + 2 * p : qhi + 2 * (p - 2));
#pragma unroll
                for (int ks = 0; ks < 4; ++ks) A[p][ks] = *(const bf16x8*)(QIDX + (qb + qsel) * 1024 + head * 64 + ks * 16 + lh * 8);
#pragma unroll
                for (int r4 = 0; r4 < 4; ++r4) { const f32x4 w = *(const f32x4*)(IDXW + (qb + lh) * 16 + r4 * 4); W[p][r4 * 4] = w[0]; W[p][r4 * 4 + 1] = w[1]; W[p][r4 * 4 + 2] = w[2]; W[p][r4 * 4 + 3] = w[3]; } }
            const bf16* kb = KIDX + (size_t)b * SEQ * 64;
            const int srow = 8 * wave + (lane >> 3), spc = ((lane & 7) ^ ((srow >> 1) & 7)) * 8;
#define P4_STAGE(C0_, BUF_) do { _Pragma("unroll") for (int i = 0; i < 4; ++i) \
                __builtin_amdgcn_global_load_lds((const unsigned*)(kb + (size_t)((C0_) + 64 * i + srow) * 64 + spc), (LAS unsigned*)(lds + (BUF_) * 32768 + (i * 8 + wave) * 1024), 16, 0, 0); } while (0)
            P4_STAGE(0, 0);
            asm volatile("s_waitcnt vmcnt(0)" ::: "memory");
            __syncthreads();
            for (int c0 = 0; c0 < nmax8; c0 += 256) {
                const int cb = (c0 >> 8) & 1; const bool more = c0 + 256 < nmax8;
                if (more) P4_STAGE(c0 + 256, cb ^ 1);
                LAS unsigned char* kbuf = lds + cb * 32768;
#pragma unroll 1
                for (int tl = 0; tl < 8; ++tl) {
                    const int s0 = c0 + tl * 32;
                    if (s0 >= nhi8) break;
#pragma unroll
                    for (int p = 0; p < 4; ++p) { const int np = p < 2 ? nlo : nhi, np8 = p < 2 ? nlo8 : nhi8;
                        if (s0 >= np && s0 < np8) { const size_t q = (size_t)b * SEQ + (p < 2 ? qlo + 2 * p : qhi + 2 * (p - 2)) + lh; ISC[q * 4096 + s0 + lr] = (_Float16)(-60000.0f); } }
                    if (s0 >= nhi) continue;
                    bf16x8 B[4];
#pragma unroll
                    for (int ks = 0; ks < 4; ++ks) B[ks] = *(const LAS bf16x8*)(kbuf + (tl * 32 + lr) * 128 + (((2 * ks + lh) ^ ((lr >> 1) & 7)) * 16));
#define IDX_FINISH(P_, ACC_) do { f32x2_t s2_ = {0.f, 0.f};     \
                        _Pragma("unroll") for (int r = 0; r < 16; r += 2) { const float a0_ = ACC_[r], a1_ = ACC_[r + 1]; const int i0_ = __builtin_bit_cast(int, a0_), i1_ = __builtin_bit_cast(int, a1_); \
                            const f32x2_t rl_ = {__builtin_bit_cast(float, i0_ > 0 ? i0_ : 0), __builtin_bit_cast(float, i1_ > 0 ? i1_ : 0)}; const f32x2_t w_ = {W[P_][r], W[P_][r + 1]}; \
                            s2_ = __builtin_elementwise_fma(rl_, w_, s2_); } \
                        const float sc_ = s2_[0] + s2_[1]; \
                        const size_t q_ = (size_t)b * SEQ + ((P_) < 2 ? qlo + 2 * (P_) : qhi + 2 * ((P_) - 2)) + lh; ISC[q_ * 4096 + s0 + lr] = (_Float16)sc_; } while (0)
                    if (s0 < nlo) {
                        f32x16 c0_, c1_, c2_, c3_;
#pragma unroll
                        for (int r = 0; r < 16; ++r) { c0_[r] = 0.f; c1_[r] = 0.f; c2_[r] = 0.f; c3_[r] = 0.f; }
#pragma unroll
                        for (int ks = 0; ks < 4; ++ks) { c0_ = __builtin_amdgcn_mfma_f32_32x32x16_bf16(A[0][ks], B[ks], c0_, 0, 0, 0); c1_ = __builtin_amdgcn_mfma_f32_32x32x16_bf16(A[1][ks], B[ks], c1_, 0, 0, 0);
                            c2_ = __builtin_amdgcn_mfma_f32_32x32x16_bf16(A[2][ks], B[ks], c2_, 0, 0, 0); c3_ = __builtin_amdgcn_mfma_f32_32x32x16_bf16(A[3][ks], B[ks], c3_, 0, 0, 0); }
                        IDX_FINISH(0, c0_); IDX_FINISH(1, c1_); IDX_FINISH(2, c2_); IDX_FINISH(3, c3_);
                    } else {
                        f32x16 c2_, c3_;
#pragma unroll
                        for (int r = 0; r < 16; ++r) { c2_[r] = 0.f; c3_[r] = 0.f; }
#pragma unroll
                        for (int ks = 0; ks < 4; ++ks) { c2_ = __builtin_amdgcn_mfma_f32_32x32x16_bf16(A[2][ks], B[ks], c2_, 0, 0, 0); c3_ = __builtin_amdgcn_mfma_f32_32x32x16_bf16(A[3][ks], B[ks], c3_, 0, 0, 0); }
                        IDX_FINISH(2, c2_); IDX_FINISH(3, c3_);
                    }
#undef IDX_FINISH
                }
                asm volatile("s_waitcnt vmcnt(0)" ::: "memory");
                __syncthreads();
            }
        }
#undef P4_STAGE
        PHASE_END
        GRID_BAR();
        }
        for (int rep_ = 0; rep_ < REP_P5; ++rep_) {
        PHASE_BEGIN
        {
            LAS unsigned char* VB = lds + wave * 18432;
            LAS unsigned short* SELW = (LAS unsigned short*)(VB + 17408);
            const int hd = lane & 15, g = lane >> 4, qq = hd >> 2, pp = hd & 3;
            const float slope = exp2f(-0.5f * (float)(hd + 1));
            for (int q = gw; q < M; q += NGW) {
                const int b = q / SEQ, pos = q % SEQ, qc = pos >> 6; const int nsel = qc < 4 ? (qc + 1) * 64 : 256;
                for (int rtk_ = 0; rtk_ < REP_TOPK; ++rtk_) {
                int lane_t = lane; asm volatile("" : "+v"(lane_t));
                if (qc < 4) { const unsigned e0 = 4 * lane_t; const bool ok = 4 * lane_t < nsel; v2u z; z.x = ok ? (e0 | ((e0 + 1) << 16)) : 0u; z.y = ok ? ((e0 + 2) | ((e0 + 3) << 16)) : 0u; *(LAS v2u*)(SELW + 4 * lane_t) = z; }
                else {
                    LAS unsigned* HIST = (LAS unsigned*)VB;
                    const int nb8 = (qc + 8) >> 3;
                    float v[64];
                    { unsigned pk[32]; const int i2max = 4 * nb8 - 1; const _Float16* irow = ISC + (size_t)q * 4096 + 2 * lane_t; typedef _Float16 h2_t __attribute__((ext_vector_type(2)));
#pragma unroll
                      for (int i2 = 0; i2 < 32; ++i2) { const int ic = i2 < i2max ? i2 : i2max; pk[i2] = *(const unsigned*)(irow + ic * 128); }
#pragma unroll
                      for (int i2 = 0; i2 < 32; ++i2) { const float lim = (i2 >> 2) < nb8 ? 3.0e38f : -1.0e30f; const h2_t h = __builtin_bit_cast(h2_t, pk[i2]);
                          const float f0 = (float)h[0], f1 = (float)h[1]; v[2 * i2] = fminf(f0, lim); v[2 * i2 + 1] = fminf(f1, lim); } }
                    float vmx = v[0], vmn = fminf(fminf(v[0], v[1]), fminf(v[2], v[3]));
#pragma unroll
                    for (int i = 1; i < 64; ++i) vmx = fmaxf(vmx, v[i]);
                    vmx = wmax_f(vmx); vmn = -wmax_f(-vmn);
                    const float rng = vmx - vmn; const float s20 = rng > 0.f ? 1048574.0f / rng : 0.f;
#define ZERO_HIST() do { *(LAS v4u*)(HIST + 16 * lane) = (v4u){0u, 0u, 0u, 0u}; *(LAS v4u*)(HIST + 16 * lane + 4) = (v4u){0u, 0u, 0u, 0u}; *(LAS v4u*)(HIST + 16 * lane + 8) = (v4u){0u, 0u, 0u, 0u}; \
                        *(LAS v4u*)(HIST + 16 * lane + 12) = (v4u){0u, 0u, 0u, 0u}; HIST[1024 + lane] = 0u; } while (0)
#define SCAN_HIST(R_, BIN_, AB_) do { unsigned hh_[16]; const int hb_ = 1008 - 16 * lane; \
                        { const v4u h0 = *(const LAS v4u*)(HIST + hb_), h1 = *(const LAS v4u*)(HIST + hb_ + 4), h2 = *(const LAS v4u*)(HIST + hb_ + 8), h3 = *(const LAS v4u*)(HIST + hb_ + 12); \
                          hh_[0] = h0.x; hh_[1] = h0.y; hh_[2] = h0.z; hh_[3] = h0.w; hh_[4] = h1.x; hh_[5] = h1.y; hh_[6] = h1.z; hh_[7] = h1.w; hh_[8] = h2.x; hh_[9] = h2.y; hh_[10] = h2.z; hh_[11] = h2.w; hh_[12] = h3.x; hh_[13] = h3.y; hh_[14] = h3.z; hh_[15] = h3.w; } \
                        unsigned tot_ = 0u; _Pragma("unroll") for (int k = 0; k < 16; ++k) tot_ += hh_[k]; \
                        unsigned run_ = wprefix_u(tot_) - tot_; int fb_ = -1; unsigned fa_ = 0u; \
                        _Pragma("unroll") for (int k = 15; k >= 0; --k) { if (run_ < (R_) && run_ + hh_[k] >= (R_)) { fb_ = hb_ + k; fa_ = run_; } run_ += hh_[k]; } \
                        const unsigned long long bm_ = __ballot(fb_ >= 0); const int L_ = (int)__builtin_ctzll(bm_); \
                        BIN_ = (unsigned)__builtin_amdgcn_readlane(fb_, L_); AB_ = (unsigned)__builtin_amdgcn_readlane((int)fa_, L_); } while (0)
                    ZERO_HIST();
#pragma unroll
                    for (int i = 0; i < 64; ++i) v[i] = __builtin_bit_cast(float, (unsigned)((v[i] - vmn) * s20));
#define cd(i_) __builtin_bit_cast(unsigned, v[i_])
#pragma unroll
                    for (int g8 = 0; g8 < 8; ++g8) { if (g8 < nb8) {
#pragma unroll
                        for (int j = 0; j < 8; ++j) __hip_atomic_fetch_add(HIST + (cd(g8 * 8 + j) >> 10), 1u, __ATOMIC_RELAXED, __HIP_MEMORY_SCOPE_WORKGROUP); } }
                    LDS_WAIT(); asm volatile("" ::: "memory");
                    unsigned tb, above; SCAN_HIST(256u, tb, above);
                    ZERO_HIST();
                    LDS_WAIT(); asm volatile("" ::: "memory");
#pragma unroll
                    for (int g8 = 0; g8 < 8; ++g8) { if (g8 < nb8) {
#pragma unroll
                        for (int j = 0; j < 8; ++j) { const unsigned c = cd(g8 * 8 + j); const unsigned a = (c >> 10) == tb ? (c & 1023u) : 1024u + lane; __hip_atomic_fetch_add(HIST + a, 1u, __ATOMIC_RELAXED, __HIP_MEMORY_SCOPE_WORKGROUP); } } }
                    LDS_WAIT(); asm volatile("" ::: "memory");
                    unsigned tb2, ab2; { const unsigned R2 = 256u - above; SCAN_HIST(R2, tb2, ab2); }
                    const unsigned T = (tb << 10) | tb2; above += ab2;
                    unsigned baseg = 0u, basee = above;
#pragma unroll
                    for (int g8 = 0; g8 < 8; ++g8) { if (g8 < nb8) {
#pragma unroll
                        for (int j = 0; j < 8; ++j) { const int i = g8 * 8 + j;
                            const bool gt = cd(i) > T; const unsigned long long bg = __ballot(gt);
                            const unsigned pgp = baseg + __builtin_amdgcn_mbcnt_hi((unsigned)(bg >> 32), __builtin_amdgcn_mbcnt_lo((unsigned)bg, 0u));
                            if (gt) SELW[pgp] = (unsigned short)((i >> 1) * 128 + (i & 1) + 2 * lane);
                            baseg += (unsigned)__popcll(bg);
                            const bool eq = cd(i) == T; const unsigned long long be = __ballot(eq);
                            if (be) { const unsigned pep = basee + __builtin_amdgcn_mbcnt_hi((unsigned)(be >> 32), __builtin_amdgcn_mbcnt_lo((unsigned)be, 0u));
                                if (eq && pep < 256u) SELW[pep] = (unsigned short)((i >> 1) * 128 + (i & 1) + 2 * lane);
                                basee += (unsigned)__popcll(be); } } } }
#undef cd
#undef ZERO_HIST
#undef SCAN_HIST
                }
                LDS_WAIT(); asm volatile("" ::: "memory");
                }
                for (int rat_ = 0; rat_ < REP_ATT; ++rat_) {
                bf16* qrow = QB + (size_t)q * 4096;
                bf16x8 Bq[8];
#pragma unroll
                for (int ks = 0; ks < 8; ++ks) Bq[ks] = *(const bf16x8*)(qrow + hd * 256 + ks * 32 + g * 8);
                const bf16* kvb = CKV + (size_t)b * SEQ * 256;
                f32x4 O[16];
#pragma unroll
                for (int ct = 0; ct < 16; ++ct) O[ct] = (f32x4){0.f, 0.f, 0.f, 0.f};
                float mrun = -1.0e30f, lsum = 0.f;
                LDS_WAIT(); asm volatile("" ::: "memory");
                const int nks = nsel >> 5;
                const int lrow = lane >> 5, lcp = lane & 31, lsh = 16 * lrow;
                v4u KR[16];
#define ATT_IDX(KST_) v4u iw_[4]; _Pragma("unroll") for (int c = 0; c < 4; ++c) iw_[c] = *(const LAS v4u*)(SELW + 32 * (KST_) + 8 * c)
#define ATT_LOADROWS(KST_) do { ATT_IDX(KST_); _Pragma("unroll") for (int i = 0; i < 16; ++i) { const int rr_ = 2 * i + lrow; const unsigned w_ = iw_[i >> 2][i & 3]; const int ix_ = (int)((w_ >> lsh) & 0xffffu); \
                    KR[i] = *(const v4u*)(kvb + (size_t)ix_ * 256 + ((lcp ^ (rr_ & 7)) * 8)); } } while (0)
                ATT_LOADROWS(0);
                const int rlA = hd & 7;
                const int rlT = (4 * g + qq) & 7;
                const int trb = (4 * g + qq) * 512 + 8 * (pp & 1), trm = 16 * ((pp >> 1) ^ rlT);
                for (int kst = 0; kst < nks; ++kst) {
                    int rlA_ = rlA, trm_ = trm; asm volatile("" : "+v"(rlA_), "+v"(trm_));
                    if (kst + 1 < nks) {
                        ATT_IDX(kst + 1);
#pragma unroll
                        for (int i = 0; i < 16; ++i) { *(LAS v4u*)(VB + i * 1024 + lane * 16) = KR[i];
                            const int rr_ = 2 * i + lrow; const unsigned w_ = iw_[i >> 2][i & 3]; const int ix_ = (int)((w_ >> lsh) & 0xffffu); KR[i] = *(const v4u*)(kvb + (size_t)ix_ * 256 + ((lcp ^ (rr_ & 7)) * 8)); }
                    } else {
#pragma unroll
                        for (int i = 0; i < 16; ++i) *(LAS v4u*)(VB + i * 1024 + lane * 16) = KR[i]; }
                    LDS_WAIT(); asm volatile("" ::: "memory");
                    f32x4 S0 = {0.f, 0.f, 0.f, 0.f}, S1 = {0.f, 0.f, 0.f, 0.f};
#pragma unroll
                    for (int k4 = 0; k4 < 4; ++k4) {
                        bf16x8 a0[2], a1[2];
#pragma unroll
                        for (int j = 0; j < 2; ++j) { const int ks = k4 * 2 + j; const int cpos = (4 * ks + g) ^ rlA_;
                            a0[j] = *(const LAS bf16x8*)(VB + hd * 512 + cpos * 16); a1[j] = *(const LAS bf16x8*)(VB + (16 + hd) * 512 + cpos * 16); }
#pragma unroll
                        for (int j = 0; j < 2; ++j) { const int ks = k4 * 2 + j;
                            S0 = __builtin_amdgcn_mfma_f32_16x16x32_bf16(a0[j], Bq[ks], S0, 0, 0, 0); S1 = __builtin_amdgcn_mfma_f32_16x16x32_bf16(a1[j], Bq[ks], S1, 0, 0, 0); }
                    }
                    const v2u pa = *(const LAS v2u*)(SELW + 32 * kst + 4 * g), pb = *(const LAS v2u*)(SELW + 32 * kst + 16 + 4 * g);
                    const float fp = (float)pos;
                    float s0[4], s1[4];
                    s0[0] = S0[0] - slope * fabsf(fp - (float)(pa.x & 0xffffu)); s0[1] = S0[1] - slope * fabsf(fp - (float)(pa.x >> 16));
                    s0[2] = S0[2] - slope * fabsf(fp - (float)(pa.y & 0xffffu)); s0[3] = S0[3] - slope * fabsf(fp - (float)(pa.y >> 16));
                    s1[0] = S1[0] - slope * fabsf(fp - (float)(pb.x & 0xffffu)); s1[1] = S1[1] - slope * fabsf(fp - (float)(pb.x >> 16));
                    s1[2] = S1[2] - slope * fabsf(fp - (float)(pb.y & 0xffffu)); s1[3] = S1[3] - slope * fabsf(fp - (float)(pb.y >> 16));
                    float ml = fmaxf(fmaxf(fmaxf(s0[0], s0[1]), fmaxf(s0[2], s0[3])), fmaxf(fmaxf(s1[0], s1[1]), fmaxf(s1[2], s1[3])));
                    ml = xmax16(ml); ml = xmax32(ml);
                    const float mnew = fmaxf(mrun, ml), alpha = __expf(mrun - mnew); mrun = mnew;
                    float p0[4], p1[4];
#pragma unroll
                    for (int r = 0; r < 4; ++r) { p0[r] = __expf(s0[r] - mnew); p1[r] = __expf(s1[r] - mnew); }
                    lsum = lsum * alpha + ((p0[0] + p0[1]) + (p0[2] + p0[3])) + ((p1[0] + p1[1]) + (p1[2] + p1[3]));
                    v4u pw; pw.x = pk2(p0[0], p0[1]); pw.y = pk2(p0[2], p0[3]); pw.z = pk2(p1[0], p1[1]); pw.w = pk2(p1[2], p1[3]);
                    const bf16x8 Pf = __builtin_bit_cast(bf16x8, pw);
#pragma unroll
                    for (int ct = 0; ct < 16; ++ct) O[ct] = O[ct] * alpha;
#pragma unroll
                    for (int c8 = 0; c8 < 4; ++c8) {
                        v4s lo[4], hi[4];
#pragma unroll
                        for (int j = 0; j < 4; ++j) { const int ct = c8 * 4 + j; const int off = trb + ((32 * ct) ^ trm_);
                            lo[j] = __builtin_amdgcn_ds_read_tr16_b64_v4i16((LAS v4s*)(VB + off));
                            hi[j] = __builtin_amdgcn_ds_read_tr16_b64_v4i16((LAS v4s*)(VB + 16 * 512 + off)); }
#pragma unroll
                        for (int j = 0; j < 4; ++j) { const int ct = c8 * 4 + j;
                            const bf16x8 Af = {lo[j][0], lo[j][1], lo[j][2], lo[j][3], hi[j][0], hi[j][1], hi[j][2], hi[j][3]};
                            O[ct] = __builtin_amdgcn_mfma_f32_16x16x32_bf16(Af, Pf, O[ct], 0, 0, 0); }
                    }
                    LDS_WAIT(); asm volatile("" ::: "memory");
                }
#undef ATT_LOADROWS
#undef ATT_IDX
                lsum = xsum16(lsum); lsum = xsum32(lsum);
                const float inv = 1.0f / lsum;
#pragma unroll
                for (int ct = 0; ct < 16; ++ct) { const f32x4 o = O[ct] * inv; v2u w; w.x = pk2(o[0], o[1]); w.y = pk2(o[2], o[3]); *(v2u*)(OB + (size_t)q * 4096 + hd * 256 + 16 * ct + 4 * g) = w; }
                }
            }
        }
        PHASE_END
        GRID_BAR();
        }
        PHASE_BEGIN
        { pg8::Gemm g{OB, W6, M, 1024, 1024, 4096, 1024, 1024}; pg8::StaticOrder S; S.init(M, 1024, G, blk);
          EpiBf E{YAB, 2048, 1024}; pg8::gemm_phase(lds, g, S, E, tid); }
        PHASE_END
        GRID_BAR();
        PHASE_BEGIN
        { pg8::Gemm g{YAB, W7, M, DM, DM, DM, DM, 0}; pg8::StaticOrder S; S.init(M, DM, G, blk);
          EpiGateM E{GTB, MRG}; HookGate Hk{GTA, GTB}; pg8::gemm_phase(lds, g, S, E, tid, Hk); }
        PHASE_END
        GRID_BAR();
        PHASE_BEGIN
        { pg8::Gemm g{MRG, W8, M, DM, DM, DM, DM, 0}; pg8::StaticOrder S; S.init(M, DM, G, blk);
          S.mode = 1;
          EpiLn<0, false> E{ws, (l == 0) ? x_in : (const float*)nullptr, (float*)nullptr, ln1_g + l * DM, ln1_b + l * DM, lds, l};
          pg8::gemm_phase(lds, g, S, E, tid); }
        PHASE_END
        GRID_BAR();
        PHASE_BEGIN
        { pg8::Gemm g{HB, W10, M, N10, DM, DM, DM, 0}; pg8::StaticOrder S; S.init(M, N10, G, blk);
          EpiSwiglu E{ACT}; pg8::gemm_phase(lds, g, S, E, tid); }
        PHASE_END
        GRID_BAR();
        if (l == DEPTH - 1) {
        PHASE_BEGIN
        { pg8::Gemm g{ACT, W11, M, DM, DFF, DFF, DFF, 0}; pg8::StaticOrder S; S.init(M, DM, G, blk); S.mode = 1;
          EpiLn<1, true> E{ws, (const float*)nullptr, args.out, ln2_g + l * DM, ln2_b + l * DM, lds, l}; pg8::gemm_phase(lds, g, S, E, tid); }
        PHASE_END
        } else {
        PHASE_BEGIN
        { pg8::Gemm g{ACT, W11, M, DM, DFF, DFF, DFF, 0}; pg8::StaticOrder S; S.init(M, DM, G, blk); S.mode = 1;
          EpiLn<1, false> E{ws, (const float*)nullptr, (float*)nullptr, ln2_g + l * DM, ln2_b + l * DM, lds, l}; pg8::gemm_phase(lds, g, S, E, tid); }
        PHASE_END
        }
        if (l + 1 < DEPTH) {
            GRID_BAR();
            PHASE_BEGIN
            { CONVERT_LAYER(l + 1); }
            PHASE_END
            GRID_BAR();
        }
    }
}

extern "C" void kernel_launch(void* const* d_in, const int* in_sizes, int n_in, void* d_out, int out_size, void* d_ws, size_t ws_size, hipStream_t stream) {
    static int grid = 0;
    if (grid == 0) {
        if (n_in != 22 || out_size != M * DM || ws_size < WS_END) { fprintf(stderr, "kernel_launch: unexpected shapes (n_in %d, out %d, ws %zu < %zu)\n", n_in, out_size, ws_size, (size_t)WS_END); grid = -1; return; }
        int dev = 0, cus = 0, per_cu = 0;
        if (hipGetDevice(&dev) != hipSuccess || hipDeviceGetAttribute(&cus, hipDeviceAttributeMultiprocessorCount, dev) != hipSuccess) { grid = -1; return; }
        if (hipFuncSetAttribute((const void*)fwd_kernel, hipFuncAttributeMaxDynamicSharedMemorySize, LDS_BYTES) != hipSuccess) { fprintf(stderr, "kernel_launch: hipFuncSetAttribute failed\n"); grid = -1; return; }
        if (hipOccupancyMaxActiveBlocksPerMultiprocessor(&per_cu, (const void*)fwd_kernel, NTHR, LDS_BYTES) != hipSuccess || per_cu < 1) { fprintf(stderr, "kernel_launch: occupancy query says %d\n", per_cu); }
        (void)hipGetLastError();
        if (cus % 64 != 0) { fprintf(stderr, "kernel_launch: %d CUs: the fused-LayerNorm unit order needs a multiple of 64 workgroups\n", cus); grid = -1; return; }
        grid = cus;
    }
    if (grid < 0) return;
    if (hipMemsetAsync((char*)d_ws + WS_CTL, 0, CTL_ZERO_BYTES, stream) != hipSuccess) return;
    Args a{};
    for (int i = 0; i < 22; ++i) a.in[i] = (const float*)d_in[i];
    a.out = (float*)d_out; a.ws = (unsigned char*)d_ws;
    hipLaunchKernelGGL(fwd_kernel, dim3(grid), dim3(NTHR), LDS_BYTES, stream, a);
}
```

```cpp
#include <hip/hip_runtime.h>
#include <cstdio>
#include <cstdint>

namespace pg8 {
#define PG8_LAS __attribute__((address_space(3)))
typedef unsigned short bf16_t;
typedef short bf16x8 __attribute__((ext_vector_type(8)));
typedef float f32x4 __attribute__((ext_vector_type(4)));
typedef unsigned u32x4 __attribute__((ext_vector_type(4)));
constexpr int BM = 256, BK = 64, HALF = 128, HTB = HALF * BK * 2, STAGE_BYTES = 8 * HTB, NXCD = 8, WGM = 8;

__host__ __device__ __forceinline__ int lds_byte(int r, int c) { const int st = (r >> 4) * 2 + (c >> 5), rr = r & 15, cc = c & 31, ob = rr * 64 + cc * 2; return st * 1024 + (ob ^ (((ob >> 9) & 1) << 5)); }
__host__ __device__ __forceinline__ void stage_rc(int b, int& R, int& C) { const int st = b / 1024, sb = b % 1024, swz = sb ^ (((sb >> 9) & 1) << 5); R = (st >> 1) * 16 + swz / 64; C = (st & 1) * 32 + (swz % 64) / 2; }
__host__ __device__ __forceinline__ int perm32(int rho) { const int n = rho >> 4, i = rho & 15; return 8 * (i >> 2) + 4 * n + (i & 3); }

struct Unit { int pm, pn; };
struct Gemm { const bf16_t* A; const bf16_t* Bt; int M, N, K, lda, ldb, a_pn_stride; };

struct StaticOrder {
    int nM, nN, nwg, G, c, mode;
    __host__ __device__ void init(int M, int N, int G_, int c_) { nM = M / BM; nN = N / BM; nwg = nM * nN; G = G_; c = c_; mode = 0; }
    __host__ __device__ bool next(int i, Unit& u) const {
        if (mode == 1) {
            const int PR = G >> 3, x = c & 7, j = c >> 3, pm = i * PR + (PR >> 3) * x + (j >> 3); if (pm >= nM) return false; u.pm = pm; u.pn = j & 7; return true; }
        const long L = (long)i * G + c; if (L >= nwg) return false;
        int wgid = (int)L; { const int q = nwg / NXCD, r = nwg % NXCD, xcd = wgid % NXCD, off = wgid / NXCD; wgid = (xcd < r ? xcd * (q + 1) : r * (q + 1) + (xcd - r) * q) + off; }
        const int nig = WGM * nN, gid = wgid / nig, fm = gid * WGM, gsz = (nM - fm) < WGM ? (nM - fm) : WGM;
        u.pm = fm + ((wgid % nig) % gsz); u.pn = (wgid % nig) / gsz; return true;
    }
};

typedef float f32x2_t __attribute__((ext_vector_type(2))); typedef __bf16 bf16x2_t __attribute__((ext_vector_type(2)));
__device__ __forceinline__ unsigned cvt_pk_bf16(float lo, float hi) { f32x2_t v = {lo, hi}; bf16x2_t b = __builtin_convertvector(v, bf16x2_t); return __builtin_bit_cast(unsigned, b); }

struct NoHook { static constexpr bool ON = false; template <class A> __device__ __forceinline__ void mid(A&, const Unit&, int, int, int, int) const {} };
template <class Epi, class Hook = NoHook>
__device__ __forceinline__ void gemm_phase(PG8_LAS unsigned char* lds, const Gemm g, const StaticOrder& S, const Epi& E, const int tid, const Hook H = Hook()) {
    const int wid = __builtin_amdgcn_readfirstlane(tid >> 6), lane = tid & 63, wr = wid >> 2, wc = wid & 3, fr = lane & 15, fq = lane >> 4;
    const int K = g.K, nt = K / BK;
    unsigned voffA[2], voffB[2];
#pragma unroll
    for (int i = 0; i < 2; ++i) { int R, C; stage_rc(tid * 16 + i * 8192, R, C); const int Rb = 64 * (R >> 5) + perm32(R & 31);
        voffA[i] = (unsigned)(R * g.lda + C) * 2u; voffB[i] = (unsigned)(Rb * g.ldb + C) * 2u; }
    const size_t kstep = (size_t)(BK * 2);
    const size_t hstepA = (size_t)HALF * g.lda * 2, hstepB = (size_t)32 * g.ldb * 2;
    const size_t tstepA = 2 * hstepA, tstepB = (size_t)BM * g.ldb * 2;
    const unsigned ldsw = (unsigned)wid * 1024u;
    const int aoff = lds_byte(wr * 64 + fr, fq * 8), boff = lds_byte(wc * 32 + fr, fq * 8);
#define PG8_SA(b, h) (((b) * 2 + (h)) * HTB)
#define PG8_SB(b, h) ((4 + (b) * 2 + (h)) * HTB)
#define PG8_STAGE(bufoff, gbase, voff) do { _Pragma("unroll") for (int _i = 0; _i < 2; ++_i) \
        __builtin_amdgcn_global_load_lds((const unsigned*)((const char*)(gbase) + (voff)[_i]), (PG8_LAS unsigned*)(lds + (bufoff) + ldsw + _i * 8192), 16, 0, 0); } while (0)
#define PG8_LDA(dst, b, h) do { _Pragma("unroll") for (int m = 0; m < 4; ++m) _Pragma("unroll") for (int k = 0; k < 2; ++k) dst[m][k] = *(const PG8_LAS bf16x8*)(lds + PG8_SA(b, h) + aoff + m * 2048 + k * 1024); } while (0)
#define PG8_LDB(dst, b, h) do { _Pragma("unroll") for (int n = 0; n < 2; ++n) _Pragma("unroll") for (int k = 0; k < 2; ++k) dst[n][k] = *(const PG8_LAS bf16x8*)(lds + PG8_SB(b, h) + boff + n * 2048 + k * 1024); } while (0)
#define PG8_MMA(ai, bj, At, Bt) do { __builtin_amdgcn_s_setprio(1); _Pragma("unroll") for (int m = 0; m < 4; ++m) _Pragma("unroll") for (int n = 0; n < 2; ++n) _Pragma("unroll") for (int k = 0; k < 2; ++k) \
        acc[ai][bj][m][n] = __builtin_amdgcn_mfma_f32_16x16x32_bf16(Bt[n][k], At[m][k], acc[ai][bj][m][n], 0, 0, 0); __builtin_amdgcn_s_setprio(0); } while (0)
#define PG8_WAIT_V(n) asm volatile("s_waitcnt vmcnt(" #n ")" ::: "memory")
#define PG8_WAIT_L(n) asm volatile("s_waitcnt lgkmcnt(" #n ")" ::: "memory")
#define PG8_BAR __builtin_amdgcn_s_barrier()
#define PG8_SCHED __builtin_amdgcn_sched_barrier(0)
    Unit cur, nxt; int ui = 0;
    if (!S.next(0, cur)) return;
    f32x4 acc[2][2][4][2];
#pragma unroll
    for (int a = 0; a < 2; ++a)
#pragma unroll
        for (int b = 0; b < 2; ++b)
#pragma unroll
            for (int m = 0; m < 4; ++m)
#pragma unroll
                for (int n = 0; n < 2; ++n) acc[a][b][m][n] = (f32x4){0.f, 0.f, 0.f, 0.f};
    bf16x8 At[4][2], B0[2][2], B1[2][2];
    const char* cA = (const char*)g.A + (size_t)cur.pm * tstepA + (size_t)cur.pn * g.a_pn_stride * 2; const char* cB = (const char*)g.Bt + (size_t)cur.pn * tstepB;
    PG8_STAGE(PG8_SB(0, 0), cB, voffB); PG8_STAGE(PG8_SB(0, 1), cB + hstepB, voffB); PG8_STAGE(PG8_SA(0, 0), cA, voffA); PG8_STAGE(PG8_SA(0, 1), cA + hstepA, voffA);
    if (wr == 1) PG8_BAR;
    PG8_WAIT_V(2); PG8_BAR;
    PG8_STAGE(PG8_SB(1, 0), cB + kstep, voffB); PG8_STAGE(PG8_SA(1, 0), cA + kstep, voffA); PG8_STAGE(PG8_SB(1, 1), cB + hstepB + kstep, voffB);
    PG8_WAIT_V(6); PG8_BAR;
    for (;;) {
        const bool has_next = S.next(ui + 1, nxt);
        const char* nA = has_next ? (const char*)g.A + (size_t)nxt.pm * tstepA + (size_t)nxt.pn * g.a_pn_stride * 2 : cA; const char* nB = has_next ? (const char*)g.Bt + (size_t)nxt.pn * tstepB : cB;
        for (int t = 0; t < nt; t += 2) {
            const bool last = (t == nt - 2);
            const char* a1 = cA + (size_t)(t + 1) * kstep;
            const char* a2 = last ? nA : cA + (size_t)(t + 2) * kstep; const char* b2 = last ? nB : cB + (size_t)(t + 2) * kstep;
            const char* a3 = a2 + kstep; const char* b3 = b2 + kstep;
            if constexpr (Hook::ON) { if (t == (nt >> 1)) H.mid(acc, cur, wr, wc, fr, fq); }
            PG8_LDB(B0, 0, 0); PG8_LDB(B1, 0, 1); PG8_SCHED; PG8_LDA(At, 0, 0); PG8_STAGE(PG8_SA(1, 1), a1 + hstepA, voffA);
            PG8_WAIT_V(8); PG8_WAIT_L(0); PG8_BAR; PG8_MMA(0, 0, At, B0); PG8_MMA(0, 1, At, B1); PG8_BAR; PG8_SCHED;
            PG8_LDA(At, 0, 1); PG8_STAGE(PG8_SB(0, 0), b2, voffB); PG8_STAGE(PG8_SB(0, 1), b2 + hstepB, voffB); PG8_STAGE(PG8_SA(0, 0), a2, voffA);
            PG8_WAIT_V(8); PG8_WAIT_L(0); PG8_BAR; PG8_MMA(1, 0, At, B0); PG8_MMA(1, 1, At, B1); PG8_BAR; PG8_SCHED;
            PG8_LDB(B0, 1, 0); PG8_LDB(B1, 1, 1); PG8_SCHED; PG8_LDA(At, 1, 0); PG8_STAGE(PG8_SA(0, 1), a2 + hstepA, voffA);
            PG8_WAIT_V(8); PG8_WAIT_L(0); PG8_BAR; PG8_MMA(0, 0, At, B0); PG8_MMA(0, 1, At, B1); PG8_BAR; PG8_SCHED;
            PG8_LDA(At, 1, 1); PG8_STAGE(PG8_SB(1, 0), b3, voffB); PG8_STAGE(PG8_SB(1, 1), b3 + hstepB, voffB); PG8_STAGE(PG8_SA(1, 0), a3, voffA);
            PG8_WAIT_V(8); PG8_WAIT_L(0); PG8_BAR; PG8_MMA(1, 0, At, B0); PG8_MMA(1, 1, At, B1); PG8_BAR; PG8_SCHED;
        }
        if (wr == 0) PG8_BAR;
        E(acc, cur, wr, wc, fr, fq);
        if (!has_next) break;
#pragma unroll
        for (int a = 0; a < 2; ++a)
#pragma unroll
            for (int b = 0; b < 2; ++b)
#pragma unroll
                for (int m = 0; m < 4; ++m)
#pragma unroll
                    for (int n = 0; n < 2; ++n) acc[a][b][m][n] = (f32x4){0.f, 0.f, 0.f, 0.f};
        cur = nxt; cA = nA; cB = nB; ++ui;
        if (wr == 1) PG8_BAR;
    }
    PG8_WAIT_V(0);
    PG8_BAR;
#undef PG8_SA
#undef PG8_SB
#undef PG8_STAGE
#undef PG8_LDA
#undef PG8_LDB
#undef PG8_MMA
#undef PG8_WAIT_V
#undef PG8_WAIT_L
#undef PG8_BAR
#undef PG8_SCHED
}
}

constexpr int NWAVES = 8, NTHR = NWAVES * 64;
constexpr int DM = 2048, NBATCH = 4, SEQ = 4096, DEPTH = 4, M = NBATCH * SEQ;
constexpr int HGW = 1024;
constexpr int SAH = 16, SAC = 256, SAR = 512;
constexpr int DFF = 5632;
constexpr int N1 = 9216, N3 = 5120, N10 = 2 * DFF;
constexpr float ALPHA = 1.6817928305074292f;
constexpr int MODW = 6 * DM;

constexpr size_t MiB = 1u << 20;
constexpr size_t WS_CTL = 0, CTL_ZERO_BYTES = 32768;
constexpr size_t WS_MOD = 1 * MiB;
constexpr size_t WS_LB = 2 * MiB;
constexpr size_t WS_MODP = 3 * MiB;
constexpr size_t WS_W1 = 9 * MiB;
constexpr size_t WS_W3 = WS_W1 + 36 * MiB;
constexpr size_t WS_W6 = WS_W3 + 5 * MiB;
constexpr size_t WS_W7 = WS_W6 + 2 * MiB;
constexpr size_t WS_W8 = WS_W7 + 8 * MiB;
constexpr size_t WS_W10 = WS_W8 + 8 * MiB;
constexpr size_t WS_W11 = WS_W10 + 44 * MiB;
constexpr size_t WS_X = WS_W11 + 22 * MiB;
constexpr size_t WS_R = WS_X + 128 * MiB;
constexpr size_t WS_H = WS_R + 128 * MiB;
constexpr size_t WS_QA = WS_H + 64 * MiB;
constexpr size_t WS_FA = WS_QA + 32 * MiB;
constexpr size_t WS_IA = WS_FA + 64 * MiB;
constexpr size_t WS_GA = WS_IA + 32 * MiB;
constexpr size_t WS_LAT = WS_GA + 32 * MiB;
constexpr size_t WS_GTA = WS_LAT + 64 * MiB;
constexpr size_t WS_GTB = WS_GTA + 64 * MiB;
constexpr size_t WS_CQN = WS_GTB + 64 * MiB;
constexpr size_t WS_CKV = WS_CQN + 16 * MiB;
constexpr size_t WS_KIDX = WS_CKV + 8 * MiB;
constexpr size_t WS_IDXW = WS_KIDX + 2 * MiB;
constexpr size_t WS_QB = WS_IDXW + 1 * MiB;
constexpr size_t WS_QIDX = WS_QB + 128 * MiB;
constexpr size_t WS_SEL = WS_QIDX + 32 * MiB;
constexpr size_t WS_YAB = WS_SEL + 8 * MiB;
constexpr size_t WS_MRG = WS_FA;
constexpr size_t WS_OB = WS_YAB + 64 * MiB;
constexpr size_t WS_BIG = WS_OB + 128 * MiB;
constexpr size_t WS_KSB = WS_BIG + 256 * MiB;
constexpr size_t WS_DEB = WS_KSB + 32 * MiB;
constexpr size_t WS_QSB = WS_DEB + 2 * MiB;
constexpr size_t WS_END = WS_QSB + 32 * MiB;

constexpr int CW_BAR = 4096;

constexpr int RING_BYTES = 131072;
constexpr int LDS_BYTES = 163840;
constexpr int LDSCTL_OFF = LDS_BYTES - 1024, MISC_OFF = LDSCTL_OFF + 320, SELL_OFF = 147456;

#define GAS __attribute__((address_space(1)))
#define LAS __attribute__((address_space(3)))
typedef unsigned short bf16;
typedef unsigned v4u __attribute__((ext_vector_type(4)));
typedef unsigned v2u __attribute__((ext_vector_type(2)));
typedef float f32x4 __attribute__((ext_vector_type(4)));
typedef float f32x16 __attribute__((ext_vector_type(16)));
typedef short bf16x8 __attribute__((ext_vector_type(8)));
typedef short v4s __attribute__((ext_vector_type(4)));
typedef GAS unsigned gu32;
#define LDS_WAIT() asm volatile("s_waitcnt lgkmcnt(0)" ::: "memory")
__device__ __forceinline__ unsigned f2bf(float f) { unsigned u = __builtin_bit_cast(unsigned, f); return (u + 0x7fffu + ((u >> 16) & 1u)) >> 16; }
__device__ __forceinline__ unsigned pk2(float lo, float hi) { return pg8::cvt_pk_bf16(lo, hi); }
__device__ __forceinline__ float bf2f(unsigned short b) { return __builtin_bit_cast(float, ((unsigned)b) << 16); }
__device__ __forceinline__ float bflo(unsigned w) { return __builtin_bit_cast(float, w << 16); }
__device__ __forceinline__ float bfhi(unsigned w) { return __builtin_bit_cast(float, w & 0xffff0000u); }
__device__ __forceinline__ float sigm(float x) { return __builtin_amdgcn_rcpf(1.f + __expf(-x)); }

__device__ __forceinline__ int lane_id() { unsigned m = ~0u; asm volatile("" : "+s"(m)); return (int)__builtin_amdgcn_mbcnt_hi(m, __builtin_amdgcn_mbcnt_lo(m, 0u)); }
#define XB_TMO      128
#define XB_XCNT(j)  (256  + 64 * (j))
#define XB_XSUB(j)  (1280 + 64 * (j))
#define XB_XGEN(j)  (2304 + 64 * (j))
#define XB_TOP      3328
#define XB_TOPGEN   3392
#define XCD_BAR_WORDS 3456
#define XB_SPIN_CAP (1u << 22)

__device__ __forceinline__ unsigned xb_ld(unsigned* p)              { return __hip_atomic_load(p, __ATOMIC_RELAXED, __HIP_MEMORY_SCOPE_AGENT); }
__device__ __forceinline__ unsigned xb_add(unsigned* p, unsigned v) { return __hip_atomic_fetch_add(p, v, __ATOMIC_RELAXED, __HIP_MEMORY_SCOPE_AGENT); }
__device__ __forceinline__ unsigned xb_xcc_id() { return (unsigned)__builtin_amdgcn_s_getreg((3 << 11) | 20) & 0xFu; }
#define XB_SPIN(cond, bar) do { unsigned _sp = 0; while (cond) { __builtin_amdgcn_s_sleep(1); \
    if ((++_sp & 255u) == 0u) { if (xb_ld(&(bar)[XB_TMO])) break; if (_sp > XB_SPIN_CAP) { atomicAdd(&(bar)[XB_TMO], 1u); break; } } } } while (0)

struct XcdBarrier { unsigned* bar; unsigned x; volatile LAS unsigned* st; int wave; };

__device__ __forceinline__ XcdBarrier xcd_barrier_post(unsigned* bar, volatile LAS unsigned* st) {
    XcdBarrier b; b.bar = bar; b.x = (unsigned)__builtin_amdgcn_readfirstlane((int)xb_xcc_id()); b.st = st;
    if (threadIdx.x == 0) (void)xb_add(&bar[XB_XCNT(b.x)], 1u);
    return b;
}
__device__ __forceinline__ void xcd_barrier_complete(unsigned* bar, unsigned x, unsigned& nloc, unsigned& nx) {
    const unsigned G = gridDim.x * gridDim.y * gridDim.z;
    unsigned sum, cnt, mine, sp = 0u;
    for (;;) {
        sum = 0u; cnt = 0u; mine = 0u;
#pragma unroll 1
        for (unsigned j = 0; j < 16; ++j) { const unsigned c = xb_ld(&bar[XB_XCNT(j)]); sum += c; cnt += (c > 0u) ? 1u : 0u; mine = (j == x) ? c : mine; }
        if (sum == G) break;
        __builtin_amdgcn_s_sleep(1);
        if ((++sp & 255u) == 0u) { if (xb_ld(&bar[XB_TMO])) break; if (sp > XB_SPIN_CAP) { atomicAdd(&bar[XB_TMO], 1u); break; } }
    }
    nloc = mine > 0u ? mine : 1u; nx = cnt > 0u ? cnt : 1u;
}
__device__ __forceinline__ void xcd_barrier(const XcdBarrier& b) {
    asm volatile("s_waitcnt vmcnt(0)" ::: "memory");
    __syncthreads();
    if (b.wave == 0 && lane_id() == 0) {
        unsigned* bar = b.bar;
        unsigned bx = b.x; asm volatile("" : "+s"(bx));
        __builtin_amdgcn_s_waitcnt(0);
        unsigned nloc = b.st[0], nx = b.st[1];
        const unsigned old = xb_add(&bar[XB_XSUB(bx)], 1u);
        const unsigned gen = old / nloc;
        if (old + 1u == (gen + 1u) * nloc) {
            __builtin_amdgcn_fence(__ATOMIC_RELEASE, "agent");
            asm volatile("s_waitcnt vmcnt(0)" ::: "memory");
            const unsigned og = xb_add(&bar[XB_TOP], 1u);
            const unsigned tg = og / nx;
            if (og + 1u == (tg + 1u) * nx) xb_add(&bar[XB_TOPGEN], 1u);
            else XB_SPIN(xb_ld(&bar[XB_TOPGEN]) == tg, bar);
            __builtin_amdgcn_fence(__ATOMIC_ACQUIRE, "agent");
            xb_add(&bar[XB_XGEN(bx)], 1u);
            asm volatile("s_waitcnt vmcnt(0)" ::: "memory");
        } else {
            XB_SPIN(xb_ld(&bar[XB_XGEN(bx)]) == gen, bar);
            __builtin_amdgcn_fence(__ATOMIC_ACQUIRE, "agent");
            asm volatile("s_waitcnt vmcnt(0)" ::: "memory");
        }
    }
    __syncthreads();
}

__device__ __forceinline__ void xswap16(float& a, float& b) { asm volatile("s_nop 1\n\tv_permlane16_swap_b32 %0, %1\n\ts_nop 1" : "+v"(a), "+v"(b)); }
__device__ __forceinline__ void xswap32(float& a, float& b) { asm volatile("s_nop 1\n\tv_permlane32_swap_b32 %0, %1\n\ts_nop 1" : "+v"(a), "+v"(b)); }
__device__ __forceinline__ float xmax16(float x) { float a = x, b = x; xswap16(a, b); return fmaxf(a, b); }
__device__ __forceinline__ float xmax32(float x) { float a = x, b = x; xswap32(a, b); return fmaxf(a, b); }
__device__ __forceinline__ float xsum16(float x) { float a = x, b = x; xswap16(a, b); return a + b; }
__device__ __forceinline__ float xsum32(float x) { float a = x, b = x; xswap32(a, b); return a + b; }

#define DPPF(x, ctrl) __builtin_bit_cast(float, __builtin_amdgcn_update_dpp(0, __builtin_bit_cast(int, (x)), (ctrl), 0xf, 0xf, true))
__device__ __forceinline__ float wmax_f(float x) {
    x = fmaxf(x, DPPF(x, 0xB1)); x = fmaxf(x, DPPF(x, 0x4E)); x = fmaxf(x, DPPF(x, 0x124)); x = fmaxf(x, DPPF(x, 0x128));
    x = xmax16(x); return xmax32(x);
}
__device__ __forceinline__ unsigned wprefix_u(unsigned x) {
    int v = (int)x;
    v += __builtin_amdgcn_update_dpp(0, v, 0x111, 0xf, 0xf, false);
    v += __builtin_amdgcn_update_dpp(0, v, 0x112, 0xf, 0xf, false);
    v += __builtin_amdgcn_update_dpp(0, v, 0x114, 0xf, 0xf, false);
    v += __builtin_amdgcn_update_dpp(0, v, 0x118, 0xf, 0xf, false);
    v += __builtin_amdgcn_update_dpp(0, v, 0x142, 0xa, 0xf, false);
    v += __builtin_amdgcn_update_dpp(0, v, 0x143, 0xc, 0xf, false);
    return (unsigned)v;
}

__device__ __forceinline__ float rowsum16(float x) { x += DPPF(x, 0xB1); x += DPPF(x, 0x4E); x += DPPF(x, 0x124); x += DPPF(x, 0x128); return x; }
__device__ __forceinline__ float wave_sum(float x) { x = rowsum16(x); x = xsum16(x); return xsum32(x); }
__device__ __forceinline__ float wave_max(float x) { return wmax_f(x); }
__device__ __forceinline__ int wave_sum_i(int v) { float f = wave_sum((float)v); return (int)(f + 0.5f); }
template <class Src>
__device__ __forceinline__ void cvt_load(const Src& src, int k0, int n0, int lane, float (&tv)[32]) {
#pragma unroll
    for (int j = 0; j < 8; ++j) { const f32x4 v = src(k0 + 8 * j + (lane >> 3), n0 + 4 * (lane & 7)); tv[4 * j] = v[0]; tv[4 * j + 1] = v[1]; tv[4 * j + 2] = v[2]; tv[4 * j + 3] = v[3]; }
}
__device__ __forceinline__ void cvt_store(const float (&tv)[32], bf16* WT, int K, int k0, int n0, LAS float* scr, int lane) {
#pragma unroll
    for (int j = 0; j < 8; ++j)
#pragma unroll
        for (int e = 0; e < 4; ++e) scr[(8 * j + (lane >> 3)) * 33 + 4 * (lane & 7) + e] = tv[4 * j + e];
    LDS_WAIT(); asm volatile("" ::: "memory");
    const int c = lane & 7;
#pragma unroll
    for (int j = 0; j < 4; ++j) { const int n = (lane >> 3) + 8 * j; const LAS float* s = scr + (8 * c) * 33 + n;
        v4u o; o.x = pk2(s[0 * 33], s[1 * 33]); o.y = pk2(s[2 * 33], s[3 * 33]); o.z = pk2(s[4 * 33], s[5 * 33]); o.w = pk2(s[6 * 33], s[7 * 33]);
        *(GAS v4u*)(WT + (size_t)(n0 + n) * K + k0 + 8 * c) = o; }
    LDS_WAIT(); asm volatile("" ::: "memory");
}

struct Args { const float* in[22]; float* out; unsigned char* ws; };

using pg8::Unit; using pg8::cvt_pk_bf16;
__device__ __forceinline__ void st_bf16x8(bf16* p, f32x4 v0, f32x4 v1) {
    v4u w; w.x = cvt_pk_bf16(v0[0], v0[1]); w.y = cvt_pk_bf16(v0[2], v0[3]); w.z = cvt_pk_bf16(v1[0], v1[1]); w.w = cvt_pk_bf16(v1[2], v1[3]);
    *(v4u*)p = w;
}
__device__ __forceinline__ void st_f32x8(float* p, f32x4 v0, f32x4 v1) { *(f32x4*)p = v0; *(f32x4*)(p + 4) = v1; }
__device__ __forceinline__ f32x4 sigm4(f32x4 v) { return (f32x4){sigm(v[0]), sigm(v[1]), sigm(v[2]), sigm(v[3])}; }
__device__ __forceinline__ f32x4 silu4(f32x4 v) { return (f32x4){v[0] * sigm(v[0]), v[1] * sigm(v[1]), v[2] * sigm(v[2]), v[3] * sigm(v[3])}; }
__device__ __forceinline__ f32x4 ldbf4(const bf16* p) { const v2u w = *(const v2u*)p; return (f32x4){bflo(w.x), bfhi(w.x), bflo(w.y), bfhi(w.y)}; }

#define EPI_LOOP(...) \
    _Pragma("unroll") for (int ai = 0; ai < 2; ++ai) _Pragma("unroll") for (int m = 0; m < 4; ++m) { const int row = row0 + ai * 128 + m * 16; \
        _Pragma("unroll") for (int bj = 0; bj < 2; ++bj) { const int col = colb + bj * 32; const f32x4 v0 = acc[ai][bj][m][0], v1 = acc[ai][bj][m][1]; __VA_ARGS__ } }

__device__ __forceinline__ unsigned q8x4(f32x4 g) { unsigned w = 0u;
#pragma unroll
    for (int e = 0; e < 4; ++e) { const float t = fmaxf(__builtin_fmaf(g[e], 255.f, 0.5f), 1.f); w |= ((unsigned)t) << (8 * e); } return w; }
__device__ __forceinline__ f32x4 ub4(unsigned w) { return (f32x4){(float)(w & 0xffu), (float)((w >> 8) & 0xffu), (float)((w >> 16) & 0xffu), (float)(w >> 24)}; }
struct EpiProj {
    bf16* QA; bf16* FA; bf16* IA; bf16* GA; bf16* LAT; bf16* GTA; bf16* GTB;
    __device__ __forceinline__ void operator()(const f32x4 (&acc)[2][2][4][2], const Unit& u, int wr, int wc, int fr, int fq) const {
        const int row0 = u.pm * 256 + wr * 64 + fr, pn = u.pn; const int colb = (pn & 3) * 256 + wc * 64 + 8 * fq;
        if (pn < 4)       { EPI_LOOP( st_bf16x8(QA + (size_t)row * 1024 + col, v0, v1); ) }
        else if (pn < 8)  { EPI_LOOP( st_bf16x8(FA + (size_t)row * 1024 + col, v0, v1); ) }
        else if (pn < 12) { EPI_LOOP( st_bf16x8(IA + (size_t)row * 1024 + col, v0, v1); ) }
        else if (pn < 16) { EPI_LOOP( st_bf16x8(GA + (size_t)row * 1024 + col, silu4(v0), silu4(v1)); ) }
        else if (pn < 20) { EPI_LOOP( st_bf16x8(LAT + (size_t)row * 1024 + col, v0, v1); ) }
        else { unsigned char* G8 = (unsigned char*)(pn < 28 ? GTA : GTB) + ((size_t)(u.pm * 8 + ((pn - 20) & 7)) * 8 + (wr * 4 + wc)) * 8192 + (fq * 16 + fr) * 16;
            _Pragma("unroll") for (int ai = 0; ai < 2; ++ai) _Pragma("unroll") for (int bj = 0; bj < 2; ++bj) _Pragma("unroll") for (int mp = 0; mp < 2; ++mp) { v4u w;
                w.x = q8x4(sigm4(acc[ai][bj][2 * mp][0])); w.y = q8x4(sigm4(acc[ai][bj][2 * mp][1])); w.z = q8x4(sigm4(acc[ai][bj][2 * mp + 1][0])); w.w = q8x4(sigm4(acc[ai][bj][2 * mp + 1][1]));
                *(v4u*)(G8 + (ai * 4 + bj * 2 + mp) * 1024) = w; } }
    }
};
struct EpiQ {
    bf16* QB; bf16* QIDX;
    __device__ __forceinline__ void operator()(const f32x4 (&acc)[2][2][4][2], const Unit& u, int wr, int wc, int fr, int fq) const {
        const int row0 = u.pm * 256 + wr * 64 + fr, pn = u.pn;
        if (pn < 16) { const int colb = pn * 256 + wc * 64 + 8 * fq; EPI_LOOP( st_bf16x8(QB + (size_t)row * 4096 + col, v0, v1); ) }
        else { const int colb = (pn - 16) * 256 + wc * 64 + 8 * fq; EPI_LOOP( st_bf16x8(QIDX + (size_t)row * 1024 + col, v0, v1); ) }
    }
};
struct EpiBf {
    bf16* O; int ldc; int coff;
    __device__ __forceinline__ void operator()(const f32x4 (&acc)[2][2][4][2], const Unit& u, int wr, int wc, int fr, int fq) const {
        const int row0 = u.pm * 256 + wr * 64 + fr; const int colb = coff + u.pn * 256 + wc * 64 + 8 * fq;
        EPI_LOOP( st_bf16x8(O + (size_t)row * ldc + col, v0, v1); )
    }
};
struct HookGate {
    static constexpr bool ON = true; const bf16* GA_; const bf16* GB_;
    __device__ __forceinline__ void mid(f32x4 (&acc)[2][2][4][2], const Unit& u, int wr, int wc, int fr, int fq) const {
        asm volatile("" : "+v"(fr), "+v"(fq));
        const size_t off = ((size_t)(u.pm * 8 + u.pn) * 8 + (wr * 4 + wc)) * 8192 + (fq * 16 + fr) * 16;
        const unsigned char* A8 = (const unsigned char*)GA_ + off; const unsigned char* B8 = (const unsigned char*)GB_ + off;
#pragma unroll
        for (int ai = 0; ai < 2; ++ai)
#pragma unroll
            for (int mp = 0; mp < 2; ++mp) {
#pragma unroll
                for (int bj = 0; bj < 2; ++bj) { const v4u a = *(const v4u*)(A8 + (ai * 4 + bj * 2 + mp) * 1024), b = *(const v4u*)(B8 + (ai * 4 + bj * 2 + mp) * 1024);
#pragma unroll
                    for (int mm = 0; mm < 2; ++mm)
#pragma unroll
                        for (int n = 0; n < 2; ++n) { const unsigned aw = a[mm * 2 + n], bw = b[mm * 2 + n]; const f32x4 fa = ub4(aw), fb = ub4(bw); f32x4 r;
#pragma unroll
                            for (int j = 0; j < 4; ++j) r[j] = fa[j] * __builtin_amdgcn_rcpf(fb[j]);
                            acc[ai][bj][2 * mp + mm][n] = acc[ai][bj][2 * mp + mm][n] * r; } }
                asm volatile("" : "+v"(acc[ai][0][2 * mp][0]), "+v"(acc[ai][0][2 * mp][1]), "+v"(acc[ai][1][2 * mp][0]), "+v"(acc[ai][1][2 * mp][1]));
                asm volatile("" : "+v"(acc[ai][0][2 * mp + 1][0]), "+v"(acc[ai][0][2 * mp + 1][1]), "+v"(acc[ai][1][2 * mp + 1][0]), "+v"(acc[ai][1][2 * mp + 1][1]));
                asm volatile("" ::: "memory"); }
    }
};
__device__ __forceinline__ f32x4 cvbf4(v2u w) { return (f32x4){bflo(w.x), bfhi(w.x), bflo(w.y), bfhi(w.y)}; }
struct EpiGateM {
    const bf16* GB_; bf16* MRG_;
    __device__ __forceinline__ void operator()(const f32x4 (&acc)[2][2][4][2], const Unit& u, int wr, int wc, int fr, int fq) const {
        const int row0 = u.pm * 256 + wr * 64 + fr; const int colb = u.pn * 256 + wc * 64 + 8 * fq;
        const unsigned char* B8 = (const unsigned char*)GB_ + ((size_t)(u.pm * 8 + u.pn) * 8 + (wr * 4 + wc)) * 8192 + (fq * 16 + fr) * 16;
#pragma unroll
        for (int ai = 0; ai < 2; ++ai) { v4u gr[2][2];
#pragma unroll
            for (int bj = 0; bj < 2; ++bj)
#pragma unroll
                for (int mp = 0; mp < 2; ++mp) gr[bj][mp] = *(const v4u*)(B8 + (ai * 4 + bj * 2 + mp) * 1024);
#pragma unroll
            for (int m = 0; m < 4; ++m)
#pragma unroll
                for (int bj = 0; bj < 2; ++bj) { const size_t o = (size_t)(row0 + ai * 128 + m * 16) * 2048 + colb + bj * 32;
                    const unsigned w0 = gr[bj][m >> 1][(m & 1) * 2], w1 = gr[bj][m >> 1][(m & 1) * 2 + 1];
                    st_bf16x8(MRG_ + o, acc[ai][bj][m][0] * (ub4(w0) * (1.f / 255.f)), acc[ai][bj][m][1] * (ub4(w1) * (1.f / 255.f))); } }
    }
};
struct EpiGateA {
    float* T1; const bf16* GT;
    __device__ __forceinline__ void operator()(const f32x4 (&acc)[2][2][4][2], const Unit& u, int wr, int wc, int fr, int fq) const {
        const int row0 = u.pm * 256 + wr * 64 + fr; const int colb = u.pn * 256 + wc * 64 + 8 * fq;
        EPI_LOOP( const size_t o = (size_t)row * 2048 + col; const f32x4 g0 = ldbf4(GT + o), g1 = ldbf4(GT + o + 4); st_f32x8(T1 + o, v0 * g0, v1 * g1); )
    }
};
struct EpiGateB {
    const float* T1; const bf16* GT; bf16* MRG;
    __device__ __forceinline__ void operator()(const f32x4 (&acc)[2][2][4][2], const Unit& u, int wr, int wc, int fr, int fq) const {
        const int row0 = u.pm * 256 + wr * 64 + fr; const int colb = u.pn * 256 + wc * 64 + 8 * fq;
        EPI_LOOP( const size_t o = (size_t)row * 2048 + col; const f32x4 g0 = ldbf4(GT + o), g1 = ldbf4(GT + o + 4); const f32x4 t0 = *(const f32x4*)(T1 + o), t1 = *(const f32x4*)(T1 + o + 4);
                  st_bf16x8(MRG + o, t0 + v0 * g0, t1 + v1 * g1); )
    }
};
struct EpiRes {
    const float* X; const bf16* Hh; bf16* R; const float* md; int osh, osc, ogt;
    __device__ __forceinline__ void operator()(const f32x4 (&acc)[2][2][4][2], const Unit& u, int wr, int wc, int fr, int fq) const {
        const int row0 = u.pm * 256 + wr * 64 + fr; const int colb = u.pn * 256 + wc * 64 + 8 * fq; const float* g = md + (size_t)(u.pm >> 4) * MODW;
        f32x4 gg[2][2];
#pragma unroll
        for (int bj = 0; bj < 2; ++bj) { gg[bj][0] = *(const f32x4*)(g + ogt + colb + bj * 32) + 1.f; gg[bj][1] = *(const f32x4*)(g + ogt + colb + bj * 32 + 4) + 1.f; }
        if (X) {
#pragma unroll
            for (int ai = 0; ai < 2; ++ai)
#pragma unroll
                for (int mh = 0; mh < 2; ++mh) { f32x4 xr[2][2][2];
#pragma unroll
                    for (int mm = 0; mm < 2; ++mm)
#pragma unroll
                        for (int bj = 0; bj < 2; ++bj) { const size_t o = (size_t)(row0 + ai * 128 + (2 * mh + mm) * 16) * 2048 + colb + bj * 32; xr[mm][bj][0] = *(const f32x4*)(X + o); xr[mm][bj][1] = *(const f32x4*)(X + o + 4); }
#pragma unroll
                    for (int mm = 0; mm < 2; ++mm)
#pragma unroll
                        for (int bj = 0; bj < 2; ++bj) { const int m = 2 * mh + mm; const size_t o = (size_t)(row0 + ai * 128 + m * 16) * 2048 + colb + bj * 32;
                            st_bf16x8(R + o, xr[mm][bj][0] * ALPHA + gg[bj][0] * acc[ai][bj][m][0], xr[mm][bj][1] * ALPHA + gg[bj][1] * acc[ai][bj][m][1]); } }
        } else {
            f32x4 ia[2][2], sb[2][2];
#pragma unroll
            for (int bj = 0; bj < 2; ++bj)
#pragma unroll
                for (int hh = 0; hh < 2; ++hh) { const f32x4 sc = *(const f32x4*)(g + osc + colb + bj * 32 + 4 * hh), sh = *(const f32x4*)(g + osh + colb + bj * 32 + 4 * hh);
#pragma unroll
                    for (int e = 0; e < 4; ++e) { ia[bj][hh][e] = ALPHA / (1.f + sc[e]); sb[bj][hh][e] = sh[e] * ia[bj][hh][e]; } }
#pragma unroll
            for (int ai = 0; ai < 2; ++ai) { v2u xr[4][2][2];
#pragma unroll
                for (int m = 0; m < 4; ++m)
#pragma unroll
                    for (int bj = 0; bj < 2; ++bj) { const size_t o = (size_t)(row0 + ai * 128 + m * 16) * 2048 + colb + bj * 32; xr[m][bj][0] = *(const v2u*)(Hh + o); xr[m][bj][1] = *(const v2u*)(Hh + o + 4); }
#pragma unroll
                for (int m = 0; m < 4; ++m)
#pragma unroll
                    for (int bj = 0; bj < 2; ++bj) { const size_t o = (size_t)(row0 + ai * 128 + m * 16) * 2048 + colb + bj * 32;
                        st_bf16x8(R + o, cvbf4(xr[m][bj][0]) * ia[bj][0] - sb[bj][0] + gg[bj][0] * acc[ai][bj][m][0], cvbf4(xr[m][bj][1]) * ia[bj][1] - sb[bj][1] + gg[bj][1] * acc[ai][bj][m][1]); } }
        }
    }
};
template <int which, bool FINAL>
struct EpiLn {
    unsigned char* ws; const float* X; float* Fo; const float* lng; const float* lnb; LAS unsigned char* lds; int l;
    __device__ __forceinline__ void operator()(f32x4 (&acc)[2][2][4][2], const Unit& u, int wr, int wc, int fr, int fq) const {
        { const int ln_ = lane_id(); fr = ln_ & 15; fq = ln_ >> 4; }
        int upm = u.pm, upn = u.pn; asm volatile("" : "+s"(upm), "+s"(upn));
        const float* MODb = (const float*)(ws + WS_MOD); bf16* Hh = (bf16*)(ws + WS_H);
        const float* g = MODb + ((size_t)l * NBATCH + (upm >> 4)) * MODW + (which ? 3 * DM : 0);
        const float* go = which ? MODb + ((size_t)(l + 1 < DEPTH ? l + 1 : l) * NBATCH + (upm >> 4)) * MODW : g + 3 * DM;
        LAS float* sl = (LAS float*)(lds + RING_BYTES);
        const int row0 = upm * 256 + wr * 64 + fr; const int colb = upn * 256 + wc * 64 + 8 * fq;
#pragma unroll
        for (int bj = 0; bj < 2; ++bj) { const int c0 = colb + bj * 32;
            const f32x4 gg0 = *(const f32x4*)(g + 2 * DM + c0) + 1.f, gg1 = *(const f32x4*)(g + 2 * DM + c0 + 4) + 1.f;
            if (which == 0 && X) {
#pragma unroll
                for (int ai = 0; ai < 2; ++ai) { f32x4 xr[4][2];
#pragma unroll
                    for (int m = 0; m < 4; ++m) { const size_t o = (size_t)(row0 + ai * 128 + m * 16) * 2048 + c0; xr[m][0] = *(const f32x4*)(X + o); xr[m][1] = *(const f32x4*)(X + o + 4); }
#pragma unroll
                    for (int m = 0; m < 4; ++m) { acc[ai][bj][m][0] = xr[m][0] * ALPHA + gg0 * acc[ai][bj][m][0]; acc[ai][bj][m][1] = xr[m][1] * ALPHA + gg1 * acc[ai][bj][m][1]; } }
            } else {
                f32x4 ia0, ia1, sb0, sb1;
                { const f32x4 sc0 = *(const f32x4*)(g + DM + c0), sc1 = *(const f32x4*)(g + DM + c0 + 4), sh0 = *(const f32x4*)(g + c0), sh1 = *(const f32x4*)(g + c0 + 4);
#pragma unroll
                  for (int e = 0; e < 4; ++e) { ia0[e] = ALPHA * __builtin_amdgcn_rcpf(1.f + sc0[e]); ia1[e] = ALPHA * __builtin_amdgcn_rcpf(1.f + sc1[e]); sb0[e] = sh0[e] * ia0[e]; sb1[e] = sh1[e] * ia1[e]; } }
#pragma unroll
                for (int ai = 0; ai < 2; ++ai) { v2u xr[4][2]; size_t o = (size_t)(row0 + ai * 128) * 2048 + c0;
#pragma unroll
                    for (int m = 0; m < 4; ++m) { xr[m][0] = *(const v2u*)(Hh + o); xr[m][1] = *(const v2u*)(Hh + o + 4); size_t st_ = 16 * 2048; asm volatile("" : "+s"(st_)); o += st_; }
#pragma unroll
                    for (int m = 0; m < 4; ++m) { acc[ai][bj][m][0] = cvbf4(xr[m][0]) * ia0 - sb0 + gg0 * acc[ai][bj][m][0]; acc[ai][bj][m][1] = cvbf4(xr[m][1]) * ia1 - sb1 + gg1 * acc[ai][bj][m][1]; }
                    asm volatile("" ::: "memory"); }
            }
            asm volatile("" ::: "memory"); }
        { const int ln_ = lane_id(); fr = ln_ & 15; fq = ln_ >> 4; }
#pragma unroll
        for (int ai = 0; ai < 2; ++ai)
#pragma unroll
            for (int m = 0; m < 4; ++m) { float s1 = 0.f, s2 = 0.f;
#pragma unroll
                for (int bj = 0; bj < 2; ++bj)
#pragma unroll
                    for (int hh = 0; hh < 2; ++hh) { const f32x4 v = acc[ai][bj][m][hh]; s1 += (v[0] + v[1]) + (v[2] + v[3]); s2 += (v[0] * v[0] + v[1] * v[1]) + (v[2] * v[2] + v[3] * v[3]); }
                s1 = xsum32(xsum16(s1)); s2 = xsum32(xsum16(s2));
                if (fq == 0) { const int rt = ai * 128 + wr * 64 + m * 16 + fr; sl[(wc * 256 + rt) * 2] = s1; sl[(wc * 256 + rt) * 2 + 1] = s2; } }
        __syncthreads();
        const int tid = (wr * 4 + wc) * 64 + lane_id();
        float* ex = (float*)(ws + WS_SEL) + (size_t)upm * 8 * 512;
        if (tid < 256) { const float S1 = (sl[tid * 2] + sl[(256 + tid) * 2]) + (sl[(512 + tid) * 2] + sl[(768 + tid) * 2]), S2 = (sl[tid * 2 + 1] + sl[(256 + tid) * 2 + 1]) + (sl[(512 + tid) * 2 + 1] + sl[(768 + tid) * 2 + 1]);
            __hip_atomic_store((unsigned*)(ex + (upn * 256 + tid) * 2), __builtin_bit_cast(unsigned, S1), __ATOMIC_RELAXED, __HIP_MEMORY_SCOPE_AGENT);
            __hip_atomic_store((unsigned*)(ex + (upn * 256 + tid) * 2 + 1), __builtin_bit_cast(unsigned, S2), __ATOMIC_RELAXED, __HIP_MEMORY_SCOPE_AGENT); }
        asm volatile("s_waitcnt vmcnt(0)" ::: "memory");
        __syncthreads();
        if (tid == 0) { unsigned* cp = (unsigned*)(ws + WS_CTL) + 256 + (l * 2 + which) * 64 + upm;
            __builtin_amdgcn_fence(__ATOMIC_RELEASE, "agent"); asm volatile("s_waitcnt vmcnt(0)" ::: "memory");
            (void)xb_add(cp, 1u);
            for (unsigned sp = 0u; xb_ld(cp) < 8u && sp < 400000u; ++sp) __builtin_amdgcn_s_sleep(1);
            __builtin_amdgcn_fence(__ATOMIC_ACQUIRE, "agent"); asm volatile("s_waitcnt vmcnt(0)" ::: "memory"); }
        __syncthreads();
        if (tid < 256) { float S1 = 0.f, S2 = 0.f;
#pragma unroll
            for (int p = 0; p < 8; ++p) { S1 += __builtin_bit_cast(float, __hip_atomic_load((unsigned*)(ex + (p * 256 + tid) * 2), __ATOMIC_RELAXED, __HIP_MEMORY_SCOPE_AGENT));
                S2 += __builtin_bit_cast(float, __hip_atomic_load((unsigned*)(ex + (p * 256 + tid) * 2 + 1), __ATOMIC_RELAXED, __HIP_MEMORY_SCOPE_AGENT)); }
            const float mean = S1 * (1.f / DM); const float var = fmaxf(S2 * (1.f / DM) - mean * mean, 0.f);
            sl[2048 + tid * 2] = mean; sl[2048 + tid * 2 + 1] = 1.0f / sqrtf(var + 1e-5f); }
        __syncthreads();
        { const int ln_ = lane_id(); fr = ln_ & 15; fq = ln_ >> 4; }
        const int row1 = upm * 256 + wr * 64 + fr; const int colc = upn * 256 + wc * 64 + 8 * fq;
#pragma unroll
        for (int bj = 0; bj < 2; ++bj) { const int c0 = colc + bj * 32;
            const f32x4 lg0 = *(const f32x4*)(lng + c0), lg1 = *(const f32x4*)(lng + c0 + 4), lb0 = *(const f32x4*)(lnb + c0), lb1 = *(const f32x4*)(lnb + c0 + 4);
            const f32x4 q0 = *(const f32x4*)(go + DM + c0) + 1.f, q1 = *(const f32x4*)(go + DM + c0 + 4) + 1.f, h0 = *(const f32x4*)(go + c0), h1 = *(const f32x4*)(go + c0 + 4);
#pragma unroll
            for (int ai = 0; ai < 2; ++ai) { size_t on = (size_t)(row1 + ai * 128) * 2048 + c0;
#pragma unroll
                for (int m = 0; m < 4; ++m) { const int rt = ai * 128 + wr * 64 + m * 16 + fr; const float mean = sl[2048 + rt * 2], rstd = sl[2048 + rt * 2 + 1];
                    const size_t o = on; { size_t st_ = 16 * 2048; asm volatile("" : "+s"(st_)); on += st_; }
                    const f32x4 y0 = (acc[ai][bj][m][0] - mean) * rstd * lg0 + lb0, y1 = (acc[ai][bj][m][1] - mean) * rstd * lg1 + lb1;
                    if constexpr (FINAL) { *(f32x4*)(Fo + o) = y0; *(f32x4*)(Fo + o + 4) = y1; }
                    else st_bf16x8(Hh + o, y0 * q0 + h0, y1 * q1 + h1); } }
            asm volatile("" ::: "memory"); }
    }
};
struct EpiSwiglu {
    bf16* ACT;
    __device__ __forceinline__ void operator()(const f32x4 (&acc)[2][2][4][2], const Unit& u, int wr, int wc, int fr, int fq) const {
        const int row0 = u.pm * 256 + wr * 64 + fr; const int col = u.pn * 128 + wc * 32 + 8 * fq;
#pragma unroll
        for (int ai = 0; ai < 2; ++ai)
#pragma unroll
            for (int m = 0; m < 4; ++m) { const int row = row0 + ai * 128 + m * 16;
                st_bf16x8(ACT + (size_t)row * DFF + col, silu4(acc[ai][0][m][0]) * acc[ai][1][m][0], silu4(acc[ai][0][m][1]) * acc[ai][1][m][1]); }
    }
};

__global__ void __launch_bounds__(NTHR, 2) fwd_kernel(Args args) {
    extern __shared__ __attribute__((aligned(16))) unsigned char lds_raw[];
    LAS unsigned char* lds = (LAS unsigned char*)lds_raw;
    const int G = gridDim.x, blk = blockIdx.x;
    const int NGW = G * NWAVES, NT = G * NTHR;
    unsigned char* const ws_base = args.ws;
    gu32* ctl = (gu32*)(ws_base + WS_CTL);
    for (int u = threadIdx.x; u < (LDS_BYTES - LDSCTL_OFF) / 4; u += NTHR) ((LAS unsigned*)(lds + LDSCTL_OFF))[u] = 0u;
    __syncthreads();
    volatile LAS unsigned* MISC = (volatile LAS unsigned*)(lds + MISC_OFF);
    const int wave_s = __builtin_amdgcn_readfirstlane((int)(threadIdx.x >> 6));
    XcdBarrier bar = xcd_barrier_post((unsigned*)(ctl + CW_BAR), MISC + 8); bar.wave = wave_s;
    if (threadIdx.x == 0) { unsigned nloc_ = 0u, nx_ = 0u; xcd_barrier_complete(bar.bar, bar.x, nloc_, nx_); bar.st[0] = nloc_; bar.st[1] = nx_; }
    __syncthreads();
#define GRID_BAR() xcd_barrier(bar)

#define x_in ((const float*)(const GAS float*)args.in[0 + z_])
#define c_in ((const float*)(const GAS float*)args.in[1 + z_])
#define w_ada ((const float*)(const GAS float*)args.in[2 + z_])
#define b_ada ((const float*)(const GAS float*)args.in[3 + z_])
#define w_in ((const float*)(const GAS float*)args.in[4 + z_])
#define lb_logits ((const float*)(const GAS float*)args.in[5 + z_])
#define g_hg ((const float*)(const GAS float*)args.in[6 + z_])
#define w_pa ((const float*)(const GAS float*)args.in[7 + z_])
#define g_cq ((const float*)(const GAS float*)args.in[8 + z_])
#define g_ckv ((const float*)(const GAS float*)args.in[9 + z_])
#define w_uq ((const float*)(const GAS float*)args.in[10 + z_])
#define w_iq ((const float*)(const GAS float*)args.in[11 + z_])
#define w_uv ((const float*)(const GAS float*)args.in[12 + z_])
#define w_pb ((const float*)(const GAS float*)args.in[13 + z_])
#define w_out ((const float*)(const GAS float*)args.in[14 + z_])
#define ln1_g ((const float*)(const GAS float*)args.in[15 + z_])
#define ln1_b ((const float*)(const GAS float*)args.in[16 + z_])
#define w_gate ((const float*)(const GAS float*)args.in[17 + z_])
#define w_up ((const float*)(const GAS float*)args.in[18 + z_])
#define w_down ((const float*)(const GAS float*)args.in[19 + z_])
#define ln2_g ((const float*)(const GAS float*)args.in[20 + z_])
#define ln2_b ((const float*)(const GAS float*)args.in[21 + z_])
#define MOD  ((float*)(ws + WS_MOD))
#define LB   ((float*)(ws + WS_LB))
#define MODP ((float*)(ws + WS_MODP))
#define W1   ((bf16*)(ws + WS_W1))
#define W3   ((bf16*)(ws + WS_W3))
#define W6   ((bf16*)(ws + WS_W6))
#define W7   ((bf16*)(ws + WS_W7))
#define W8   ((bf16*)(ws + WS_W8))
#define W10  ((bf16*)(ws + WS_W10))
#define W11  ((bf16*)(ws + WS_W11))
#define XB   ((bf16*)(ws + WS_X))
#define RB   ((bf16*)(ws + WS_R))
#define HB   ((bf16*)(ws + WS_H))
#define QA   ((bf16*)(ws + WS_QA))
#define FA   ((bf16*)(ws + WS_FA))
#define IA   ((bf16*)(ws + WS_IA))
#define GA   ((bf16*)(ws + WS_GA))
#define LAT  ((bf16*)(ws + WS_LAT))
#define GTA  ((bf16*)(ws + WS_GTA))
#define GTB  ((bf16*)(ws + WS_GTB))
#define CQN  ((bf16*)(ws + WS_CQN))
#define CKV  ((bf16*)(ws + WS_CKV))
#define KIDX ((bf16*)(ws + WS_KIDX))
#define IDXW ((float*)(ws + WS_IDXW))
#define QB   ((bf16*)(ws + WS_QB))
#define QIDX ((bf16*)(ws + WS_QIDX))
#define SEL  ((unsigned short*)(ws + WS_SEL))
#define YAB  ((bf16*)(ws + WS_YAB))
#define MRG  ((bf16*)(ws + WS_MRG))
#define OB   ((bf16*)(ws + WS_OB))
#define ISC  ((_Float16*)(ws + WS_BIG))
#define OP   ((float*)(ws + WS_BIG))
#define ACT  ((bf16*)(ws + WS_BIG))
#define KK   LAT
#define modl (MOD + (size_t)l * NBATCH * MODW)
#define KSB  ((bf16*)(ws + WS_KSB))
#define QSB  ((bf16*)(ws + WS_QSB))
#define KVT  ((bf16*)(ws + WS_BIG))
#define SPB  ((bf16*)(ws + WS_FA))
#define DEB  ((float*)(ws + WS_DEB))
#define PHASE_BEGIN { unsigned om_ = ~0u; asm volatile("" : "+s"(om_)); int tid = wave_s * 64 + (int)__builtin_amdgcn_mbcnt_hi(om_, __builtin_amdgcn_mbcnt_lo(om_, 0u)); asm volatile("" : "+v"(tid)); int z_ = 0; asm volatile("" : "+s"(z_)); (void)z_; GAS unsigned char* wsg_ = (GAS unsigned char*)ws_base; asm volatile("" : "+s"(wsg_)); unsigned char* ws = (unsigned char*)wsg_; const int lane = tid & 63, wave = __builtin_amdgcn_readfirstlane(tid >> 6); \
        const int gw = blk * NWAVES + wave, gtid = blk * NTHR + tid; LAS float* wscr = (LAS float*)(lds + wave * 16384); (void)lane; (void)gw; (void)gtid; (void)wscr;
#define PHASE_END }

#define CVT_DECODE(IT_, MID_, K0_, N0_) do { int r_ = (IT_); \
        if (r_ < I1) { MID_ = 0; K0_ = (r_ / (N1 / 32)) * 64; N0_ = (r_ % (N1 / 32)) * 32; } else { r_ -= I1; \
        if (r_ < I3) { MID_ = 1; K0_ = (r_ / (N3 / 32)) * 64; N0_ = (r_ % (N3 / 32)) * 32; } else { r_ -= I3; \
        if (r_ < I6) { MID_ = 2; K0_ = (r_ / 32) * 64; N0_ = (r_ % 32) * 32; } else { r_ -= I6; \
        if (r_ < I7) { MID_ = 3; K0_ = (r_ / (DM / 32)) * 64; N0_ = (r_ % (DM / 32)) * 32; } else { r_ -= I7; \
        if (r_ < I8) { MID_ = 4; K0_ = (r_ / (DM / 32)) * 64; N0_ = (r_ % (DM / 32)) * 32; } else { r_ -= I8; \
        if (r_ < I10) { MID_ = 5; K0_ = (r_ / (N10 / 32)) * 64; N0_ = (r_ % (N10 / 32)) * 32; } else { r_ -= I10; \
        MID_ = 6; K0_ = (r_ / (DM / 32)) * 64; N0_ = (r_ % (DM / 32)) * 32; } } } } } } } while (0)
#define CVT_LOAD(MID_, K0_, N0_, TV_) do { \
        if (MID_ == 0) cvt_load([=](int k, int n) -> f32x4 { const f32x4 v = *(const f32x4*)(s_in + (size_t)k * 9040 + (n < 4944 ? n : n - 176)); return (n >= 4944 && n < 5120) ? (f32x4){0.f, 0.f, 0.f, 0.f} : v; }, K0_, N0_, lane, TV_); \
        else if (MID_ == 1) cvt_load([=](int k, int n) -> f32x4 { const float* p = n < 4096 ? s_uq + (size_t)k * 4096 + n : s_iq + (size_t)k * 1024 + (n - 4096); return *(const f32x4*)p * (n < 4096 ? 0.0625f : 1.f); }, K0_, N0_, lane, TV_); \
        else if (MID_ == 2) cvt_load([=](int k, int n) -> f32x4 { const int h = n >> 6, v = n & 63, kk = k >> 8, c = k & 255; const f32x4 w = *(const f32x4*)(s_uv + ((size_t)h * 256 + c) * 64 + v); return kk == (h & 3) ? w : (f32x4){0.f, 0.f, 0.f, 0.f}; }, K0_, N0_, lane, TV_); \
        else if (MID_ == 3) cvt_load([=](int k, int n) -> f32x4 { const float* p = k < 1024 ? s_pa + (size_t)k * DM + n : s_pb + (size_t)(k - 1024) * DM + n; return *(const f32x4*)p; }, K0_, N0_, lane, TV_); \
        else if (MID_ == 4) cvt_load([=](int k, int n) -> f32x4 { return *(const f32x4*)(s_out + (size_t)k * DM + n); }, K0_, N0_, lane, TV_); \
        else if (MID_ == 5) cvt_load([=](int k, int n) -> f32x4 { const int pn = n >> 8, rr = n & 255, cc = pn * 128 + (rr >> 6) * 32 + (rr & 31); const float* p = ((rr & 32) ? s_u : s_g) + (size_t)k * DFF + cc; return *(const f32x4*)p; }, K0_, N0_, lane, TV_); \
        else cvt_load([=](int k, int n) -> f32x4 { return *(const f32x4*)(s_d + (size_t)k * DM + n); }, K0_, N0_, lane, TV_); } while (0)
#define CONVERT_LAYER(L) do { const int l_ = (L); \
        const float* s_in = w_in + (size_t)l_ * DM * 9040; const float* s_uq = w_uq + (size_t)l_ * SAR * 4096; const float* s_iq = w_iq + (size_t)l_ * SAR * 1024; \
        const float* s_uv = w_uv + (size_t)l_ * 16 * 256 * 64; const float* s_pa = w_pa + (size_t)l_ * 1024 * DM; const float* s_pb = w_pb + (size_t)l_ * 1024 * DM; \
        const float* s_out = w_out + (size_t)l_ * DM * DM; const float* s_g = w_gate + (size_t)l_ * DM * DFF; const float* s_u = w_up + (size_t)l_ * DM * DFF; const float* s_d = w_down + (size_t)l_ * DFF * DM; \
        constexpr int I1 = (DM / 64) * (N1 / 32), I3 = (SAR / 64) * (N3 / 32), I6 = (1024 / 64) * (1024 / 32), I7 = (DM / 64) * (DM / 32), I8 = I7, I10 = (DM / 64) * (N10 / 32), I11 = (DFF / 64) * (DM / 32); \
        constexpr int NIT = I1 + I3 + I6 + I7 + I8 + I10 + I11; \
        float tv_[32]; int mid_ = 0, k0_ = 0, n0_ = 0; \
        { CVT_DECODE(gw, mid_, k0_, n0_); CVT_LOAD(mid_, k0_, n0_, tv_); } \
        for (int it = gw; it < NIT; it += NGW) { \
            float tc_[32]; _Pragma("unroll") for (int i = 0; i < 32; ++i) tc_[i] = tv_[i]; \
            const int mc_ = mid_, kc_ = k0_, nc_ = n0_; \
            { const int itn_ = it + NGW < NIT ? it + NGW : it; CVT_DECODE(itn_, mid_, k0_, n0_); CVT_LOAD(mid_, k0_, n0_, tv_); }     \
            bf16* wt_ = mc_ == 0 ? W1 : mc_ == 1 ? W3 : mc_ == 2 ? W6 : mc_ == 3 ? W7 : mc_ == 4 ? W8 : mc_ == 5 ? W10 : W11; \
            const int kk_ = mc_ == 0 ? DM : mc_ == 1 ? SAR : mc_ == 2 ? 1024 : mc_ == 3 ? DM : mc_ == 4 ? DM : mc_ == 5 ? DM : DFF; \
            cvt_store(tc_, wt_, kk_, kc_, nc_, wscr, lane); \
        } } while (0)


#ifndef HGRN_NAIVE
#define HGRN_NAIVE 0
#endif
#ifndef IDX_NAIVE
#define IDX_NAIVE 0
#endif
#ifndef ATT_NAIVE
#define ATT_NAIVE 0
#endif
#ifndef TOPK_OLD
#define TOPK_OLD 0
#endif
#ifndef REP_HB
#define REP_HB 1
#endif
#ifndef REP_HC
#define REP_HC 1
#endif
#ifndef REP_P4A
#define REP_P4A 1
#endif
#ifndef REP_P5
#define REP_P5 1
#endif
#ifndef REP_P9
#define REP_P9 1
#endif
#ifndef REP_P12
#define REP_P12 1
#endif
#ifndef REP_TOPK
#define REP_TOPK 1
#endif
#ifndef REP_ATT
#define REP_ATT 1
#endif
#ifndef DRY_ATT
#define DRY_ATT 0
#endif
#ifndef REP_M1
#define REP_M1 1
#endif
#ifndef REP_M2
#define REP_M2 1
#endif
#ifndef REP_M3
#define REP_M3 1
#endif

    PHASE_BEGIN
    {
        LAS float* sc = (LAS float*)lds;
        for (int i = tid; i < NBATCH * DM; i += NTHR) { const float v = c_in[i]; sc[i] = v * sigm(v); }
        __syncthreads();
        for (int item = gtid; item < 8 * 12288; item += NT) {
            const int ks = item / 12288, cg = item % 12288, l = cg / 3072, n4 = (cg % 3072) * 4;
            const float* wp = w_ada + ((size_t)l * DM + ks * 256) * MODW + n4;
            f32x4 a0 = {0.f, 0.f, 0.f, 0.f}, a1 = a0, a2 = a0, a3 = a0;
#pragma unroll 8
            for (int k = 0; k < 256; ++k) { const f32x4 w = *(const f32x4*)(wp + (size_t)k * MODW); const int kk = ks * 256 + k;
                a0 += w * sc[kk]; a1 += w * sc[2048 + kk]; a2 += w * sc[4096 + kk]; a3 += w * sc[6144 + kk]; }
            float* o = MODP + ((size_t)(ks * 4 + l) * 4) * MODW + n4;
            *(f32x4*)(o) = a0; *(f32x4*)(o + MODW) = a1; *(f32x4*)(o + 2 * MODW) = a2; *(f32x4*)(o + 3 * MODW) = a3;
        }
        if (gtid < 1024) {
            const float a = lb_logits[gtid], b = lb_logits[1024 + gtid], c = lb_logits[2048 + gtid], d = lb_logits[3072 + gtid];
            const float mx = fmaxf(fmaxf(a, b), fmaxf(c, d)); const float ea = expf(a - mx), eb = expf(b - mx), ec = expf(c - mx), ed = expf(d - mx); const float inv = 1.f / (ea + eb + ec + ed);
            LB[gtid] = 0.f; LB[1024 + gtid] = eb * inv; LB[2048 + gtid] = (eb + ec) * inv; LB[3072 + gtid] = (eb + ec + ed) * inv;
        }
        __syncthreads();
        CONVERT_LAYER(0);
    }
    PHASE_END
    GRID_BAR();
    PHASE_BEGIN
    for (int i = gtid; i < DEPTH * NBATCH * MODW; i += NT) {
        const int l = i / (NBATCH * MODW), r = i % (NBATCH * MODW), b = r / MODW, n = r % MODW;
        float s = b_ada[l * MODW + n];
#pragma unroll
        for (int ks = 0; ks < 8; ++ks) s += MODP[((size_t)(ks * 4 + l) * 4 + b) * MODW + n];
        MOD[i] = s;
    }
    PHASE_END
    GRID_BAR();
    PHASE_BEGIN
    for (size_t i0 = gtid; i0 < (size_t)M * DM / 8; i0 += (size_t)NT * 4) {
        f32x4 xa[4], xb[4], sa[4], sb[4], ha[4], hb[4];
#pragma unroll
        for (int t = 0; t < 4; ++t) { size_t gi = i0 + (size_t)t * NT; gi = gi < (size_t)M * DM / 8 ? gi : (size_t)M * DM / 8 - 1; const size_t e = gi * 8; const int row = (int)(e / DM), col = (int)(e % DM), b = row / SEQ; const float* md = MOD + (size_t)b * MODW;
            xa[t] = *(const f32x4*)(x_in + e); xb[t] = *(const f32x4*)(x_in + e + 4); sa[t] = *(const f32x4*)(md + 2048 + col); sb[t] = *(const f32x4*)(md + 2048 + col + 4); ha[t] = *(const f32x4*)(md + col); hb[t] = *(const f32x4*)(md + col + 4); }
#pragma unroll
        for (int t = 0; t < 4; ++t) { size_t gi = i0 + (size_t)t * NT; gi = gi < (size_t)M * DM / 8 ? gi : (size_t)M * DM / 8 - 1; const size_t e = gi * 8; st_bf16x8(HB + e, xa[t] * (sa[t] + 1.f) + ha[t], xb[t] * (sb[t] + 1.f) + hb[t]); }
    }
    PHASE_END
    GRID_BAR();

    for (int l = 0; l < DEPTH; ++l) {
        PHASE_BEGIN
        { pg8::Gemm g{HB, W1, M, N1, DM, DM, DM, 0}; pg8::StaticOrder S; S.init(M, N1, G, blk);
          EpiProj E{QA, FA, IA, GA, LAT, GTA, GTB}; pg8::gemm_phase(lds, g, S, E, tid); }
        PHASE_END
        GRID_BAR();
        for (int rep_ = 0; rep_ < REP_M1; ++rep_) {
        PHASE_BEGIN
        v2u ra0, ra1, rkv; unsigned short rki, riw;
        const f32x4 g0 = *(const f32x4*)(g_cq + l * 512 + 4 * lane), g1 = *(const f32x4*)(g_cq + l * 512 + 256 + 4 * lane), gk = *(const f32x4*)(g_ckv + l * 256 + 4 * lane);
        { const bf16* lr = LAT + (size_t)gw * 1024; ra0 = *(const v2u*)(lr + 4 * lane); ra1 = *(const v2u*)(lr + 256 + 4 * lane); rkv = *(const v2u*)(lr + 512 + 4 * lane); rki = lr[768 + lane]; riw = lr[832 + (lane & 15)]; }
        for (int row = gw; row < M; row += NGW) {
            const f32x4 a0 = (f32x4){bflo(ra0.x), bfhi(ra0.x), bflo(ra0.y), bfhi(ra0.y)}, a1 = (f32x4){bflo(ra1.x), bfhi(ra1.x), bflo(ra1.y), bfhi(ra1.y)}, kv = (f32x4){bflo(rkv.x), bfhi(rkv.x), bflo(rkv.y), bfhi(rkv.y)};
            const float ki = bf2f(rki), iw = bf2f(riw);
            { const int rn = row + NGW < M ? row + NGW : row; const bf16* lr = LAT + (size_t)rn * 1024;
              ra0 = *(const v2u*)(lr + 4 * lane); ra1 = *(const v2u*)(lr + 256 + 4 * lane); rkv = *(const v2u*)(lr + 512 + 4 * lane); rki = lr[768 + lane]; riw = lr[832 + (lane & 15)]; }
            float sq = a0[0] * a0[0] + a0[1] * a0[1] + a0[2] * a0[2] + a0[3] * a0[3] + a1[0] * a1[0] + a1[1] * a1[1] + a1[2] * a1[2] + a1[3] * a1[3];
            float sk = kv[0] * kv[0] + kv[1] * kv[1] + kv[2] * kv[2] + kv[3] * kv[3];
            sq = wave_sum(sq); sk = wave_sum(sk);
            const float rq = 1.0f / sqrtf(sq * (1.f / 512.f) + 1e-6f), rk = 1.0f / sqrtf(sk * (1.f / 256.f) + 1e-6f);
            v2u o; f32x4 t = a0 * rq * g0; o.x = pk2(t[0], t[1]); o.y = pk2(t[2], t[3]); *(v2u*)(CQN + (size_t)row * 512 + 4 * lane) = o;
            t = a1 * rq * g1; o.x = pk2(t[0], t[1]); o.y = pk2(t[2], t[3]); *(v2u*)(CQN + (size_t)row * 512 + 256 + 4 * lane) = o;
            t = kv * rk * gk; o.x = pk2(t[0], t[1]); o.y = pk2(t[2], t[3]); *(v2u*)(CKV + (size_t)row * 256 + 4 * lane) = o;
            KIDX[(size_t)row * 64 + lane] = (bf16)f2bf(ki);
            if (lane < 16) IDXW[(size_t)row * 16 + lane] = iw * 0.03125f;
        }
        PHASE_END
        PHASE_BEGIN
        {
            const int cp = tid & 63, sg = tid >> 6;
            LAS unsigned char* KST = lds;
            LAS unsigned char* VTL = lds + 18432;
            LAS float* SEGT = (LAS float*)(lds + 36864);
            LAS float* G63 = (LAS float*)(lds + 40960);
            unsigned pfa[8], pq[8], pv[8]; float plb0, plb1;
#define HA_REQ(U_) do { int uu_ = (U_); asm volatile("" : "+s"(uu_)); const int bh_ = uu_ >> 6, c_ = uu_ & 63, b_ = bh_ >> 3, h_ = bh_ & 7; \
                const size_t rowb_ = (size_t)b_ * SEQ + c_ * 64 + sg * 8; const int col_ = h_ * 128 + 2 * cp; \
                _Pragma("unroll") for (int i = 0; i < 8; ++i) { pfa[i] = *(const unsigned*)(FA + (rowb_ + i) * 1024 + col_); pq[i] = *(const unsigned*)(QA + (rowb_ + i) * 1024 + col_); pv[i] = *(const unsigned*)(IA + (rowb_ + i) * 1024 + col_); } plb0 = LB[l * 1024 + col_]; plb1 = LB[l * 1024 + col_ + 1]; } while (0)
            HA_REQ(blk);
            for (int u = blk; u < 2048; u += G) {
                const int bh = u >> 6, c = u & 63, b = bh >> 3, h = bh & 7;
                const size_t rowb = (size_t)b * SEQ + c * 64 + sg * 8; const int col = h * 128 + 2 * cp;
                const float lb0 = plb0, lb1 = plb1;
                float lf0[8], lf1[8], kk0[8], kk1[8]; unsigned cq[8], cv[8];
#pragma unroll
                for (int i = 0; i < 8; ++i) { cq[i] = pq[i]; cv[i] = pv[i]; }
#pragma unroll
                for (int i = 0; i < 8; ++i) { const float2 fa = make_float2(bflo(pfa[i]), bfhi(pfa[i]));
                    const float f0 = fminf(fmaxf(lb0 + (1.f - lb0) * sigm(fa.x), 1e-6f), 1.f), f1 = fminf(fmaxf(lb1 + (1.f - lb1) * sigm(fa.y), 1e-6f), 1.f);
                    lf0[i] = __logf(f0); lf1[i] = __logf(f1); kk0[i] = (1.f - lb0) * sigm(-fa.x); kk1[i] = (1.f - lb1) * sigm(-fa.y); }
#pragma unroll
                for (int i = 1; i < 8; ++i) { lf0[i] += lf0[i - 1]; lf1[i] += lf1[i - 1]; }
                SEGT[sg * 128 + 2 * cp] = lf0[7]; SEGT[sg * 128 + 2 * cp + 1] = lf1[7];
                HA_REQ(u + G < 2048 ? u + G : u);
                __syncthreads();
                float pre0 = 0.f, pre1 = 0.f, r0 = 0.f, r1 = 0.f, t0 = 0.f, t1 = 0.f;
#pragma unroll
                for (int s2 = 0; s2 < 8; ++s2) { const float a0 = SEGT[s2 * 128 + 2 * cp], a1 = SEGT[s2 * 128 + 2 * cp + 1];
                    if (s2 < sg) { pre0 += a0; pre1 += a1; } if (s2 < 4) { r0 += a0; r1 += a1; } t0 += a0; t1 += a1; }
                unsigned ksw0[4], ksw1[4], vw0[4], vw1[4]; float ks0p = 0.f, ks1p = 0.f, v0p = 0.f, v1p = 0.f;
#pragma unroll
                for (int i = 0; i < 8; ++i) {
                    const float b0 = pre0 + lf0[i], b1 = pre1 + lf1[i];
                    const unsigned qw = cq[i]; const unsigned vw = cv[i];
                    const float qs0 = bflo(qw) * __expf(b0 - r0), qs1 = bfhi(qw) * __expf(b1 - r1);
                    const float ks0 = kk0[i] * __expf(r0 - b0), ks1 = kk1[i] * __expf(r1 - b1);
                    *(unsigned*)(QSB + (rowb + i) * 1024 + col) = pk2(qs0, qs1);
                    *(unsigned*)(KSB + (rowb + i) * 1024 + col) = pk2(ks0, ks1);
                    if (i & 1) { ksw0[i >> 1] = pk2(ks0p, ks0); ksw1[i >> 1] = pk2(ks1p, ks1); vw0[i >> 1] = pk2(v0p, bflo(vw)); vw1[i >> 1] = pk2(v1p, bfhi(vw)); }
                    else { ks0p = ks0; ks1p = ks1; v0p = bflo(vw); v1p = bfhi(vw); }
                }
                *(LAS v4u*)(KST + (2 * cp) * 144 + sg * 16) = (v4u){ksw0[0], ksw0[1], ksw0[2], ksw0[3]};
                *(LAS v4u*)(KST + (2 * cp + 1) * 144 + sg * 16) = (v4u){ksw1[0], ksw1[1], ksw1[2], ksw1[3]};
                *(LAS v4u*)(VTL + (2 * cp) * 144 + sg * 16) = (v4u){vw0[0], vw0[1], vw0[2], vw0[3]};
                *(LAS v4u*)(VTL + (2 * cp + 1) * 144 + sg * 16) = (v4u){vw1[0], vw1[1], vw1[2], vw1[3]};
                if (sg == 7) { float* de = DEB + (size_t)u * 256; *(float2*)(de + 2 * cp) = make_float2(__expf(r0), __expf(r1)); *(float2*)(de + 128 + 2 * cp) = make_float2(__expf(t0), __expf(t1));
                    G63[2 * cp] = __expf(t0 - r0); G63[2 * cp + 1] = __expf(t1 - r1); }
                __syncthreads();
                { const int kt = wave >> 1, vt0 = (wave & 1) * 2, lr = lane & 31, lh = lane >> 5;
                  f32x16 acc0, acc1;
#pragma unroll
                  for (int r = 0; r < 16; ++r) { acc0[r] = 0.f; acc1[r] = 0.f; }
#pragma unroll
                  for (int s4 = 0; s4 < 4; ++s4) {
                      const bf16x8 kb = *(const LAS bf16x8*)(KST + (kt * 32 + lr) * 144 + (s4 * 16 + 8 * lh) * 2);
                      const bf16x8 a0 = *(const LAS bf16x8*)(VTL + (vt0 * 32 + lr) * 144 + (s4 * 16 + 8 * lh) * 2);
                      const bf16x8 a1 = *(const LAS bf16x8*)(VTL + ((vt0 + 1) * 32 + lr) * 144 + (s4 * 16 + 8 * lh) * 2);
                      acc0 = __builtin_amdgcn_mfma_f32_32x32x16_bf16(a0, kb, acc0, 0, 0, 0); acc1 = __builtin_amdgcn_mfma_f32_32x32x16_bf16(a1, kb, acc1, 0, 0, 0); }
                  bf16* kvt = KVT + (size_t)u * 16384 + kt * 32 + lr; const float g = G63[kt * 32 + lr];
#pragma unroll
                  for (int r = 0; r < 16; ++r) { const int vv = 8 * (r >> 2) + 4 * lh + (r & 3);
                      kvt[(size_t)(vt0 * 32 + vv) * 128] = (bf16)(pk2(acc0[r] * g, 0.f) & 0xffffu); kvt[(size_t)((vt0 + 1) * 32 + vv) * 128] = (bf16)(pk2(acc1[r] * g, 0.f) & 0xffffu); } }
                __syncthreads();
            }
        }
#undef HA_REQ
        PHASE_END
        GRID_BAR();
        }
        for (int rep_ = 0; rep_ < REP_M2; ++rep_) {
        PHASE_BEGIN
        for (int item = gtid; item < 32 * 4096; item += NT) {
            const int bh = item >> 12, v = (item >> 5) & 127, k4 = (item & 31) * 4;
            f32x4 S = {0.f, 0.f, 0.f, 0.f};
            for (int c0 = 0; c0 < 64; c0 += 8) {
                f32x4 kv[8], dd[8], ee[8];
#pragma unroll
                for (int j = 0; j < 8; ++j) { const size_t u = (size_t)bh * 64 + c0 + j; kv[j] = ldbf4(KVT + u * 16384 + v * 128 + k4); ee[j] = *(const f32x4*)(DEB + u * 256 + k4); dd[j] = *(const f32x4*)(DEB + u * 256 + 128 + k4); }
#pragma unroll
                for (int j = 0; j < 8; ++j) { const size_t u = (size_t)bh * 64 + c0 + j; const f32x4 sp = S * ee[j]; v2u w; w.x = pk2(sp[0], sp[1]); w.y = pk2(sp[2], sp[3]);
                    *(v2u*)(SPB + u * 16384 + v * 128 + k4) = w; S = S * dd[j] + kv[j]; }
            }
        }
        PHASE_END
        PHASE_BEGIN
        { pg8::Gemm g{CQN, W3, M, N3, SAR, SAR, SAR, 0}; pg8::StaticOrder S; S.init(M, N3, G, blk);
          EpiQ E{QB, QIDX}; pg8::gemm_phase(lds, g, S, E, tid); }
        PHASE_END
        GRID_BAR();
        }
        for (int st_ = 0; st_ < 2; ++st_) {
        if ((st_ == 0) == (((blk >> 3) & 1) == 0)) {
        PHASE_BEGIN
        {
            LAS unsigned char* QSL = lds;
            LAS unsigned char* KSL = lds + 17408;
            LAS unsigned char* VTL = lds + 34816;
            LAS unsigned char* SPL = lds + 53248;
            LAS unsigned char* AL = lds + 88064;
            LAS float* SSQ = (LAS float*)(lds + 97280);
            const int cp = tid & 63, sg = tid >> 6, lr = lane & 31, lh = lane >> 5;
            v4u rq[2], rk[2], rs[4]; unsigned rv[8]; unsigned short rg[16];
#define HC_REQ(U_) do { int uu_ = (U_); asm volatile("" : "+s"(uu_));   const int bh_ = uu_ >> 6, c_ = uu_ & 63, b_ = bh_ >> 3, h_ = bh_ & 7; const size_t row0_ = (size_t)b_ * SEQ + c_ * 64; const int col0_ = h_ * 128; \
                _Pragma("unroll") for (int j = 0; j < 2; ++j) { const int q = tid + 512 * j, rr = q >> 4, cc = q & 15; \
                    rq[j] = *(const v4u*)(QSB + (row0_ + rr) * 1024 + col0_ + cc * 8); rk[j] = *(const v4u*)(KSB + (row0_ + rr) * 1024 + col0_ + cc * 8); } \
                _Pragma("unroll") for (int j = 0; j < 4; ++j) { const int q = tid + 512 * j, rr = q >> 4, cc = q & 15; rs[j] = *(const v4u*)(SPB + (size_t)uu_ * 16384 + rr * 128 + cc * 8); } \
                _Pragma("unroll") for (int i = 0; i < 8; ++i) rv[i] = *(const unsigned*)(IA + (row0_ + sg * 8 + i) * 1024 + col0_ + 2 * cp); \
                { const int it_ = wave >> 2, vt_ = wave & 3; const int colg_ = col0_ + vt_ * 32 + lr; \
                  _Pragma("unroll") for (int r = 0; r < 16; ++r) { const int ii = it_ * 32 + 8 * (r >> 2) + 4 * lh + (r & 3); rg[r] = GA[(row0_ + ii) * 1024 + colg_]; } } } while (0)
            HC_REQ(blk);
            for (int u = blk; u < 2048; u += G) {
                const int bh = u >> 6, c = u & 63, b = bh >> 3, h = bh & 7;
                const size_t row0 = (size_t)b * SEQ + c * 64; const int col0 = h * 128;
#pragma unroll
                for (int j = 0; j < 2; ++j) { const int q = tid + 512 * j, rr = q >> 4, cc = q & 15;
                    *(LAS v4u*)(QSL + rr * 272 + cc * 16) = rq[j]; *(LAS v4u*)(KSL + rr * 272 + cc * 16) = rk[j]; }
#pragma unroll
                for (int j = 0; j < 4; ++j) { const int q = tid + 512 * j, rr = q >> 4, cc = q & 15; *(LAS v4u*)(SPL + rr * 272 + cc * 16) = rs[j]; }
                { unsigned vw0[4], vw1[4]; float v0p = 0.f, v1p = 0.f;
#pragma unroll
                  for (int i = 0; i < 8; ++i) { const unsigned vw = rv[i];
                      if (i & 1) { vw0[i >> 1] = pk2(v0p, bflo(vw)); vw1[i >> 1] = pk2(v1p, bfhi(vw)); } else { v0p = bflo(vw); v1p = bfhi(vw); } }
                  *(LAS v4u*)(VTL + (2 * cp) * 144 + sg * 16) = (v4u){vw0[0], vw0[1], vw0[2], vw0[3]};
                  *(LAS v4u*)(VTL + (2 * cp + 1) * 144 + sg * 16) = (v4u){vw1[0], vw1[1], vw1[2], vw1[3]}; }
                float gav[16];
#pragma unroll
                for (int r = 0; r < 16; ++r) gav[r] = bf2f(rg[r]);
                const float gg = g_hg[l * 1024 + col0 + (wave & 3) * 32 + lr];
                HC_REQ(u + G < 2048 ? u + G : u);
                __syncthreads();
                if (wave < 4) {
                    const int it = wave >> 1, jt = wave & 1;
                    f32x16 acc;
#pragma unroll
                    for (int r = 0; r < 16; ++r) acc[r] = 0.f;
                    if (!(it == 0 && jt == 1)) {
#pragma unroll
                        for (int s8 = 0; s8 < 8; ++s8) {
                            const bf16x8 a = *(const LAS bf16x8*)(QSL + (it * 32 + lr) * 272 + (s8 * 16 + 8 * lh) * 2);
                            const bf16x8 bb = *(const LAS bf16x8*)(KSL + (jt * 32 + lr) * 272 + (s8 * 16 + 8 * lh) * 2);
                            acc = __builtin_amdgcn_mfma_f32_32x32x16_bf16(a, bb, acc, 0, 0, 0); } }
                    const int jj = jt * 32 + lr;
#pragma unroll
                    for (int r = 0; r < 16; ++r) { const int ii = it * 32 + 8 * (r >> 2) + 4 * lh + (r & 3); const float x = (jj <= ii) ? acc[r] : 0.f;
                        *(LAS unsigned short*)(AL + ii * 144 + jj * 2) = (unsigned short)(pk2(x, 0.f) & 0xffffu); }
                }
                __syncthreads();
                { const int it = wave >> 2, vt = wave & 3;
                  f32x16 acc;
#pragma unroll
                  for (int r = 0; r < 16; ++r) acc[r] = 0.f;
#pragma unroll
                  for (int s4 = 0; s4 < 4; ++s4) {
                      const bf16x8 a = *(const LAS bf16x8*)(AL + (it * 32 + lr) * 144 + (s4 * 16 + 8 * lh) * 2);
                      const bf16x8 bb = *(const LAS bf16x8*)(VTL + (vt * 32 + lr) * 144 + (s4 * 16 + 8 * lh) * 2);
                      acc = __builtin_amdgcn_mfma_f32_32x32x16_bf16(a, bb, acc, 0, 0, 0); }
#pragma unroll
                  for (int s8 = 0; s8 < 8; ++s8) {
                      const bf16x8 a = *(const LAS bf16x8*)(QSL + (it * 32 + lr) * 272 + (s8 * 16 + 8 * lh) * 2);
                      const bf16x8 bb = *(const LAS bf16x8*)(SPL + (vt * 32 + lr) * 272 + (s8 * 16 + 8 * lh) * 2);
                      acc = __builtin_amdgcn_mfma_f32_32x32x16_bf16(a, bb, acc, 0, 0, 0); }
#pragma unroll
                  for (int r = 0; r < 16; ++r) { float q2 = acc[r] * acc[r];
                      q2 = xsum16(rowsum16(q2));
                      if (lr == 0) SSQ[vt * 64 + it * 32 + 8 * (r >> 2) + 4 * lh + (r & 3)] = q2; }
                  __syncthreads();
                  const int colg = col0 + vt * 32 + lr;
#pragma unroll
                  for (int r = 0; r < 16; ++r) { const int ii = it * 32 + 8 * (r >> 2) + 4 * lh + (r & 3);
                      const float ss = SSQ[ii] + SSQ[64 + ii] + SSQ[128 + ii] + SSQ[192 + ii]; const float rn = 1.0f / sqrtf(ss * (1.f / 128.f) + 1e-6f);
                      YAB[(row0 + ii) * 2048 + colg] = (bf16)(pk2(acc[r] * rn * gg * gav[r], 0.f) & 0xffffu); }
                }
                __syncthreads();
            }
        }
#undef HC_REQ
        PHASE_END
        } else {
        PHASE_BEGIN
        for (int ub = blk * NWAVES; ub < 2048; ub += NGW) {
            const int unit = ub + wave;
            const int b = ub >> 9, j = unit & 511, lr = lane & 31, lh = lane >> 5;
            const int qsel = (lr >> 2) & 1, head = (lr >> 3) * 4 + (lr & 3);
            const int qlo = 4 * j, qhi = 4 * (1023 - j);
            const int nlo = ((qlo >> 6) + 1) * 64, nhi = ((qhi >> 6) + 1) * 64;
            const int nlo8 = (nlo + 511) & ~511, nhi8 = (nhi + 511) & ~511;
            const int nmax8 = (((((4 * (1023 - (ub & 511))) >> 6) + 1) * 64) + 511) & ~511;
            bf16x8 A[4][4]; float W[4][16]; typedef float f32x2_t __attribute__((ext_vector_type(2)));
#pragma unroll
            for (int p = 0; p < 4; ++p) { const size_t qb = (size_t)b * SEQ + (p < 2 ? qlo + 2 * p : qhi + 2 * (p - 2));
#pragma unroll
                for (int ks = 0; ks < 4; ++ks) A[p][ks] = *(const bf16x8*)(QIDX + (qb + qsel) * 1024 + head * 64 + ks * 16 + lh * 8);
#pragma unroll
                for (int r4 = 0; r4 < 4; ++r4) { const f32x4 w = *(const f32x4*)(IDXW + (qb + lh) * 16 + r4 * 4); W[p][r4 * 4] = w[0]; W[p][r4 * 4 + 1] = w[1]; W[p][r4 * 4 + 2] = w[2]; W[p][r4 * 4 + 3] = w[3]; } }
            const bf16* kb = KIDX + (size_t)b * SEQ * 64;
            const int srow = 8 * wave + (lane >> 3), spc = ((lane & 7) ^ ((srow >> 1) & 7)) * 8;
#define P4_STAGE(C0_, BUF_) do { _Pragma("unroll") for (int i = 0; i < 4; ++i) \
                __builtin_amdgcn_global_load_lds((const unsigned*)(kb + (size_t)((C0_) + 64 * i + srow) * 64 + spc), (LAS unsigned*)(lds + (BUF_) * 32768 + (i * 8 + wave) * 1024), 16, 0, 0); } while (0)
            P4_STAGE(0, 0);
            asm volatile("s_waitcnt vmcnt(0)" ::: "memory");
            __syncthreads();
            for (int c0 = 0; c0 < nmax8; c0 += 256) {
                const int cb = (c0 >> 8) & 1; const bool more = c0 + 256 < nmax8;
                if (more) P4_STAGE(c0 + 256, cb ^ 1);
                LAS unsigned char* kbuf = lds + cb * 32768;
#pragma unroll 1
                for (int tl = 0; tl < 8; ++tl) {
                    const int s0 = c0 + tl * 32;
                    if (s0 >= nhi8) break;
#pragma unroll
                    for (int p = 0; p < 4; ++p) { const int np = p < 2 ? nlo : nhi, np8 = p < 2 ? nlo8 : nhi8;
                        if (s0 >= np && s0 < np8) { const size_t q = (size_t)b * SEQ + (p < 2 ? qlo + 2 * p : qhi + 2 * (p - 2)) + lh; ISC[q * 4096 + s0 + lr] = (_Float16)(-60000.0f); } }
                    if (s0 >= nhi) continue;
                    bf16x8 B[4];
#pragma unroll
                    for (int ks = 0; ks < 4; ++ks) B[ks] = *(const LAS bf16x8*)(kbuf + (tl * 32 + lr) * 128 + (((2 * ks + lh) ^ ((lr >> 1) & 7)) * 16));
#define IDX_FINISH(P_, ACC_) do { f32x2_t s2_ = {0.f, 0.f};     \
                        _Pragma("unroll") for (int r = 0; r < 16; r += 2) { const float a0_ = ACC_[r], a1_ = ACC_[r + 1]; const int i0_ = __builtin_bit_cast(int, a0_), i1_ = __builtin_bit_cast(int, a1_); \
                            const f32x2_t rl_ = {__builtin_bit_cast(float, i0_ > 0 ? i0_ : 0), __builtin_bit_cast(float, i1_ > 0 ? i1_ : 0)}; const f32x2_t w_ = {W[P_][r], W[P_][r + 1]}; \
                            s2_ = __builtin_elementwise_fma(rl_, w_, s2_); } \
                        const float sc_ = s2_[0] + s2_[1]; \
                        const size_t q_ = (size_t)b * SEQ + ((P_) < 2 ? qlo + 2 * (P_) : qhi + 2 * ((P_) - 2)) + lh; ISC[q_ * 4096 + s0 + lr] = (_Float16)sc_; } while (0)
                    if (s0 < nlo) {
                        f32x16 c0_, c1_, c2_, c3_;
#pragma unroll
                        for (int r = 0; r < 16; ++r) { c0_[r] = 0.f; c1_[r] = 0.f; c2_[r] = 0.f; c3_[r] = 0.f; }
#pragma unroll
                        for (int ks = 0; ks < 4; ++ks) { c0_ = __builtin_amdgcn_mfma_f32_32x32x16_bf16(A[0][ks], B[ks], c0_, 0, 0, 0); c1_ = __builtin_amdgcn_mfma_f32_32x32x16_bf16(A[1][ks], B[ks], c1_, 0, 0, 0);
                            c2_ = __builtin_amdgcn_mfma_f32_32x32x16_bf16(A[2][ks], B[ks], c2_, 0, 0, 0); c3_ = __builtin_amdgcn_mfma_f32_32x32x16_bf16(A[3][ks], B[ks], c3_, 0, 0, 0); }
                        IDX_FINISH(0, c0_); IDX_FINISH(1, c1_); IDX_FINISH(2, c2_); IDX_FINISH(3, c3_);
                    } else {
                        f32x16 c2_, c3_;
#pragma unroll
                        for (int r = 0; r < 16; ++r) { c2_[r] = 0.f; c3_[r] = 0.f; }
#pragma unroll
                        for (int ks = 0; ks < 4; ++ks) { c2_ = __builtin_amdgcn_mfma_f32_32x32x16_bf16(A[2][ks], B[ks], c2_, 0, 0, 0); c3_ = __builtin_amdgcn_mfma_f32_32x32x16_bf16(A[3][ks], B[ks], c3_, 0, 0, 0); }
                        IDX_FINISH(2, c2_); IDX_FINISH(3, c3_);
                    }
#undef IDX_FINISH
                }
                asm volatile("s_waitcnt vmcnt(0)" ::: "memory");
                __syncthreads();
            }
        }
#undef P4_STAGE
        PHASE_END
        }
        __syncthreads();
        }
        GRID_BAR();
        for (int rep_ = 0; rep_ < REP_P5; ++rep_) {
        PHASE_BEGIN
        {
            LAS unsigned char* VB = lds + wave * 18432;
            LAS unsigned short* SELW = (LAS unsigned short*)(VB + 17408);
            const int hd = lane & 15, g = lane >> 4, qq = hd >> 2, pp = hd & 3;
            const float slope = exp2f(-0.5f * (float)(hd + 1));
            for (int q = gw; q < M; q += NGW) {
                const int b = q / SEQ, pos = q % SEQ, qc = pos >> 6; const int nsel = qc < 4 ? (qc + 1) * 64 : 256;
                for (int rtk_ = 0; rtk_ < REP_TOPK; ++rtk_) {
                int lane_t = lane; asm volatile("" : "+v"(lane_t));
                if (qc < 4) { const unsigned e0 = 4 * lane_t; const bool ok = 4 * lane_t < nsel; v2u z; z.x = ok ? (e0 | ((e0 + 1) << 16)) : 0u; z.y = ok ? ((e0 + 2) | ((e0 + 3) << 16)) : 0u; *(LAS v2u*)(SELW + 4 * lane_t) = z; }
                else {
                    LAS unsigned* HIST = (LAS unsigned*)VB;
                    const int nb8 = (qc + 8) >> 3;
                    float v[64];
                    { unsigned pk[32]; const int i2max = 4 * nb8 - 1; const _Float16* irow = ISC + (size_t)q * 4096 + 2 * lane_t; typedef _Float16 h2_t __attribute__((ext_vector_type(2)));
#pragma unroll
                      for (int i2 = 0; i2 < 32; ++i2) { const int ic = i2 < i2max ? i2 : i2max; pk[i2] = *(const unsigned*)(irow + ic * 128); }
#pragma unroll
                      for (int i2 = 0; i2 < 32; ++i2) { const float lim = (i2 >> 2) < nb8 ? 3.0e38f : -1.0e30f; const h2_t h = __builtin_bit_cast(h2_t, pk[i2]);
                          const float f0 = (float)h[0], f1 = (float)h[1]; v[2 * i2] = fminf(f0, lim); v[2 * i2 + 1] = fminf(f1, lim); } }
                    float vmx = v[0], vmn = fminf(fminf(v[0], v[1]), fminf(v[2], v[3]));
#pragma unroll
                    for (int i = 1; i < 64; ++i) vmx = fmaxf(vmx, v[i]);
                    vmx = wmax_f(vmx); vmn = -wmax_f(-vmn);
                    const float rng = vmx - vmn; const float s20 = rng > 0.f ? 1048574.0f / rng : 0.f;
#define ZERO_HIST() do { *(LAS v4u*)(HIST + 16 * lane) = (v4u){0u, 0u, 0u, 0u}; *(LAS v4u*)(HIST + 16 * lane + 4) = (v4u){0u, 0u, 0u, 0u}; *(LAS v4u*)(HIST + 16 * lane + 8) = (v4u){0u, 0u, 0u, 0u}; \
                        *(LAS v4u*)(HIST + 16 * lane + 12) = (v4u){0u, 0u, 0u, 0u}; HIST[1024 + lane] = 0u; } while (0)
#define SCAN_HIST(R_, BIN_, AB_) do { unsigned hh_[16]; const int hb_ = 1008 - 16 * lane; \
                        { const v4u h0 = *(const LAS v4u*)(HIST + hb_), h1 = *(const LAS v4u*)(HIST + hb_ + 4), h2 = *(const LAS v4u*)(HIST + hb_ + 8), h3 = *(const LAS v4u*)(HIST + hb_ + 12); \
                          hh_[0] = h0.x; hh_[1] = h0.y; hh_[2] = h0.z; hh_[3] = h0.w; hh_[4] = h1.x; hh_[5] = h1.y; hh_[6] = h1.z; hh_[7] = h1.w; hh_[8] = h2.x; hh_[9] = h2.y; hh_[10] = h2.z; hh_[11] = h2.w; hh_[12] = h3.x; hh_[13] = h3.y; hh_[14] = h3.z; hh_[15] = h3.w; } \
                        unsigned tot_ = 0u; _Pragma("unroll") for (int k = 0; k < 16; ++k) tot_ += hh_[k]; \
                        unsigned run_ = wprefix_u(tot_) - tot_; int fb_ = -1; unsigned fa_ = 0u; \
                        _Pragma("unroll") for (int k = 15; k >= 0; --k) { if (run_ < (R_) && run_ + hh_[k] >= (R_)) { fb_ = hb_ + k; fa_ = run_; } run_ += hh_[k]; } \
                        const unsigned long long bm_ = __ballot(fb_ >= 0); const int L_ = (int)__builtin_ctzll(bm_); \
                        BIN_ = (unsigned)__builtin_amdgcn_readlane(fb_, L_); AB_ = (unsigned)__builtin_amdgcn_readlane((int)fa_, L_); } while (0)
                    ZERO_HIST();
#pragma unroll
                    for (int i = 0; i < 64; ++i) v[i] = __builtin_bit_cast(float, (unsigned)((v[i] - vmn) * s20));
#define cd(i_) __builtin_bit_cast(unsigned, v[i_])
#pragma unroll
                    for (int g8 = 0; g8 < 8; ++g8) { if (g8 < nb8) {
#pragma unroll
                        for (int j = 0; j < 8; ++j) __hip_atomic_fetch_add(HIST + (cd(g8 * 8 + j) >> 10), 1u, __ATOMIC_RELAXED, __HIP_MEMORY_SCOPE_WORKGROUP); } }
                    LDS_WAIT(); asm volatile("" ::: "memory");
                    unsigned tb, above; SCAN_HIST(256u, tb, above);
                    ZERO_HIST();
                    LDS_WAIT(); asm volatile("" ::: "memory");
#pragma unroll
                    for (int g8 = 0; g8 < 8; ++g8) { if (g8 < nb8) {
#pragma unroll
                        for (int j = 0; j < 8; ++j) { const unsigned c = cd(g8 * 8 + j); const unsigned a = (c >> 10) == tb ? (c & 1023u) : 1024u + lane; __hip_atomic_fetch_add(HIST + a, 1u, __ATOMIC_RELAXED, __HIP_MEMORY_SCOPE_WORKGROUP); } } }
                    LDS_WAIT(); asm volatile("" ::: "memory");
                    unsigned tb2, ab2; { const unsigned R2 = 256u - above; SCAN_HIST(R2, tb2, ab2); }
                    const unsigned T = (tb << 10) | tb2; above += ab2;
                    unsigned baseg = 0u, basee = above;
#pragma unroll
                    for (int g8 = 0; g8 < 8; ++g8) { if (g8 < nb8) {
#pragma unroll
                        for (int j = 0; j < 8; ++j) { const int i = g8 * 8 + j;
                            const bool gt = cd(i) > T; const unsigned long long bg = __ballot(gt);
                            const unsigned pgp = baseg + __builtin_amdgcn_mbcnt_hi((unsigned)(bg >> 32), __builtin_amdgcn_mbcnt_lo((unsigned)bg, 0u));
                            if (gt) SELW[pgp] = (unsigned short)((i >> 1) * 128 + (i & 1) + 2 * lane);
                            baseg += (unsigned)__popcll(bg);
                            const bool eq = cd(i) == T; const unsigned long long be = __ballot(eq);
                            if (be) { const unsigned pep = basee + __builtin_amdgcn_mbcnt_hi((unsigned)(be >> 32), __builtin_amdgcn_mbcnt_lo((unsigned)be, 0u));
                                if (eq && pep < 256u) SELW[pep] = (unsigned short)((i >> 1) * 128 + (i & 1) + 2 * lane);
                                basee += (unsigned)__popcll(be); } } } }
#undef cd
#undef ZERO_HIST
#undef SCAN_HIST
                }
                LDS_WAIT(); asm volatile("" ::: "memory");
                }
                for (int rat_ = 0; rat_ < REP_ATT; ++rat_) {
                bf16* qrow = QB + (size_t)q * 4096;
                bf16x8 Bq[8];
#pragma unroll
                for (int ks = 0; ks < 8; ++ks) Bq[ks] = *(const bf16x8*)(qrow + hd * 256 + ks * 32 + g * 8);
                const bf16* kvb = CKV + (size_t)b * SEQ * 256;
                f32x4 O[16];
#pragma unroll
                for (int ct = 0; ct < 16; ++ct) O[ct] = (f32x4){0.f, 0.f, 0.f, 0.f};
                float mrun = -1.0e30f, lsum = 0.f;
                LDS_WAIT(); asm volatile("" ::: "memory");
                const int nks = nsel >> 5;
                const int lrow = lane >> 5, lcp = lane & 31, lsh = 16 * lrow;
                v4u KR[16];
#define ATT_IDX(KST_) v4u iw_[4]; _Pragma("unroll") for (int c = 0; c < 4; ++c) iw_[c] = *(const LAS v4u*)(SELW + 32 * (KST_) + 8 * c)
#define ATT_LOADROWS(KST_) do { ATT_IDX(KST_); _Pragma("unroll") for (int i = 0; i < 16; ++i) { const int rr_ = 2 * i + lrow; const unsigned w_ = iw_[i >> 2][i & 3]; const int ix_ = (int)((w_ >> lsh) & 0xffffu); \
                    KR[i] = *(const v4u*)(kvb + (size_t)ix_ * 256 + ((lcp ^ (rr_ & 7)) * 8)); } } while (0)
                ATT_LOADROWS(0);
                const int rlA = hd & 7;
                const int rlT = (4 * g + qq) & 7;
                const int trb = (4 * g + qq) * 512 + 8 * (pp & 1), trm = 16 * ((pp >> 1) ^ rlT);
                for (int kst = 0; kst < nks; ++kst) {
                    int rlA_ = rlA, trm_ = trm; asm volatile("" : "+v"(rlA_), "+v"(trm_));
                    if (kst + 1 < nks) {
                        ATT_IDX(kst + 1);
#pragma unroll
                        for (int i = 0; i < 16; ++i) { *(LAS v4u*)(VB + i * 1024 + lane * 16) = KR[i];
                            const int rr_ = 2 * i + lrow; const unsigned w_ = iw_[i >> 2][i & 3]; const int ix_ = (int)((w_ >> lsh) & 0xffffu); KR[i] = *(const v4u*)(kvb + (size_t)ix_ * 256 + ((lcp ^ (rr_ & 7)) * 8)); }
                    } else {
#pragma unroll
                        for (int i = 0; i < 16; ++i) *(LAS v4u*)(VB + i * 1024 + lane * 16) = KR[i]; }
                    LDS_WAIT(); asm volatile("" ::: "memory");
                    f32x4 S0 = {0.f, 0.f, 0.f, 0.f}, S1 = {0.f, 0.f, 0.f, 0.f};
#pragma unroll
                    for (int k4 = 0; k4 < 4; ++k4) {
                        bf16x8 a0[2], a1[2];
#pragma unroll
                        for (int j = 0; j < 2; ++j) { const int ks = k4 * 2 + j; const int cpos = (4 * ks + g) ^ rlA_;
                            a0[j] = *(const LAS bf16x8*)(VB + hd * 512 + cpos * 16); a1[j] = *(const LAS bf16x8*)(VB + (16 + hd) * 512 + cpos * 16); }
#pragma unroll
                        for (int j = 0; j < 2; ++j) { const int ks = k4 * 2 + j;
                            S0 = __builtin_amdgcn_mfma_f32_16x16x32_bf16(a0[j], Bq[ks], S0, 0, 0, 0); S1 = __builtin_amdgcn_mfma_f32_16x16x32_bf16(a1[j], Bq[ks], S1, 0, 0, 0); }
                    }
                    const v2u pa = *(const LAS v2u*)(SELW + 32 * kst + 4 * g), pb = *(const LAS v2u*)(SELW + 32 * kst + 16 + 4 * g);
                    const float fp = (float)pos;
                    float s0[4], s1[4];
                    s0[0] = S0[0] - slope * fabsf(fp - (float)(pa.x & 0xffffu)); s0[1] = S0[1] - slope * fabsf(fp - (float)(pa.x >> 16));
                    s0[2] = S0[2] - slope * fabsf(fp - (float)(pa.y & 0xffffu)); s0[3] = S0[3] - slope * fabsf(fp - (float)(pa.y >> 16));
                    s1[0] = S1[0] - slope * fabsf(fp - (float)(pb.x & 0xffffu)); s1[1] = S1[1] - slope * fabsf(fp - (float)(pb.x >> 16));
                    s1[2] = S1[2] - slope * fabsf(fp - (float)(pb.y & 0xffffu)); s1[3] = S1[3] - slope * fabsf(fp - (float)(pb.y >> 16));
                    float ml = fmaxf(fmaxf(fmaxf(s0[0], s0[1]), fmaxf(s0[2], s0[3])), fmaxf(fmaxf(s1[0], s1[1]), fmaxf(s1[2], s1[3])));
                    ml = xmax16(ml); ml = xmax32(ml);
                    const float mnew = fmaxf(mrun, ml), alpha = __expf(mrun - mnew); mrun = mnew;
                    float p0[4], p1[4];
#pragma unroll
                    for (int r = 0; r < 4; ++r) { p0[r] = __expf(s0[r] - mnew); p1[r] = __expf(s1[r] - mnew); }
                    lsum = lsum * alpha + ((p0[0] + p0[1]) + (p0[2] + p0[3])) + ((p1[0] + p1[1]) + (p1[2] + p1[3]));
                    v4u pw; pw.x = pk2(p0[0], p0[1]); pw.y = pk2(p0[2], p0[3]); pw.z = pk2(p1[0], p1[1]); pw.w = pk2(p1[2], p1[3]);
                    const bf16x8 Pf = __builtin_bit_cast(bf16x8, pw);
#pragma unroll
                    for (int ct = 0; ct < 16; ++ct) O[ct] = O[ct] * alpha;
#pragma unroll
                    for (int c8 = 0; c8 < 4; ++c8) {
                        v4s lo[4], hi[4];
#pragma unroll
                        for (int j = 0; j < 4; ++j) { const int ct = c8 * 4 + j; const int off = trb + ((32 * ct) ^ trm_);
                            lo[j] = __builtin_amdgcn_ds_read_tr16_b64_v4i16((LAS v4s*)(VB + off));
                            hi[j] = __builtin_amdgcn_ds_read_tr16_b64_v4i16((LAS v4s*)(VB + 16 * 512 + off)); }
#pragma unroll
                        for (int j = 0; j < 4; ++j) { const int ct = c8 * 4 + j;
                            const bf16x8 Af = {lo[j][0], lo[j][1], lo[j][2], lo[j][3], hi[j][0], hi[j][1], hi[j][2], hi[j][3]};
                            O[ct] = __builtin_amdgcn_mfma_f32_16x16x32_bf16(Af, Pf, O[ct], 0, 0, 0); }
                    }
                    LDS_WAIT(); asm volatile("" ::: "memory");
                }
#undef ATT_LOADROWS
#undef ATT_IDX
                lsum = xsum16(lsum); lsum = xsum32(lsum);
                const float inv = 1.0f / lsum;
#pragma unroll
                for (int ct = 0; ct < 16; ++ct) { const f32x4 o = O[ct] * inv; v2u w; w.x = pk2(o[0], o[1]); w.y = pk2(o[2], o[3]); *(v2u*)(OB + (size_t)q * 4096 + hd * 256 + 16 * ct + 4 * g) = w; }
                }
            }
        }
        PHASE_END
        GRID_BAR();
        }
        PHASE_BEGIN
        { pg8::Gemm g{OB, W6, M, 1024, 1024, 4096, 1024, 1024}; pg8::StaticOrder S; S.init(M, 1024, G, blk);
          EpiBf E{YAB, 2048, 1024}; pg8::gemm_phase(lds, g, S, E, tid); }
        PHASE_END
        GRID_BAR();
        PHASE_BEGIN
        { pg8::Gemm g{YAB, W7, M, DM, DM, DM, DM, 0}; pg8::StaticOrder S; S.init(M, DM, G, blk);
          EpiGateM E{GTB, MRG}; HookGate Hk{GTA, GTB}; pg8::gemm_phase(lds, g, S, E, tid, Hk); }
        PHASE_END
        GRID_BAR();
        PHASE_BEGIN
        { pg8::Gemm g{MRG, W8, M, DM, DM, DM, DM, 0}; pg8::StaticOrder S; S.init(M, DM, G, blk);
          S.mode = 1;
          EpiLn<0, false> E{ws, (l == 0) ? x_in : (const float*)nullptr, (float*)nullptr, ln1_g + l * DM, ln1_b + l * DM, lds, l};
          pg8::gemm_phase(lds, g, S, E, tid); }
        PHASE_END
        GRID_BAR();
        PHASE_BEGIN
        { pg8::Gemm g{HB, W10, M, N10, DM, DM, DM, 0}; pg8::StaticOrder S; S.init(M, N10, G, blk);
          EpiSwiglu E{ACT}; pg8::gemm_phase(lds, g, S, E, tid); }
        PHASE_END
        GRID_BAR();
        if (l == DEPTH - 1) {
        PHASE_BEGIN
        { pg8::Gemm g{ACT, W11, M, DM, DFF, DFF, DFF, 0}; pg8::StaticOrder S; S.init(M, DM, G, blk); S.mode = 1;
          EpiLn<1, true> E{ws, (const float*)nullptr, args.out, ln2_g + l * DM, ln2_b + l * DM, lds, l}; pg8::gemm_phase(lds, g, S, E, tid); }
        PHASE_END
        } else {
        PHASE_BEGIN
        { pg8::Gemm g{ACT, W11, M, DM, DFF, DFF, DFF, 0}; pg8::StaticOrder S; S.init(M, DM, G, blk); S.mode = 1;
          EpiLn<1, false> E{ws, (const float*)nullptr, (float*)nullptr, ln2_g + l * DM, ln2_b + l * DM, lds, l}; pg8::gemm_phase(lds, g, S, E, tid); }
        PHASE_END
        }
        if (l + 1 < DEPTH) {
            GRID_BAR();
            PHASE_BEGIN
            { CONVERT_LAYER(l + 1); }
            PHASE_END
            GRID_BAR();
        }
    }
}

extern "C" void kernel_launch(void* const* d_in, const int* in_sizes, int n_in, void* d_out, int out_size, void* d_ws, size_t ws_size, hipStream_t stream) {
    static int grid = 0;
    if (grid == 0) {
        if (n_in != 22 || out_size != M * DM || ws_size < WS_END) { fprintf(stderr, "kernel_launch: unexpected shapes (n_in %d, out %d, ws %zu < %zu)\n", n_in, out_size, ws_size, (size_t)WS_END); grid = -1; return; }
        int dev = 0, cus = 0, per_cu = 0;
        if (hipGetDevice(&dev) != hipSuccess || hipDeviceGetAttribute(&cus, hipDeviceAttributeMultiprocessorCount, dev) != hipSuccess) { grid = -1; return; }
        if (hipFuncSetAttribute((const void*)fwd_kernel, hipFuncAttributeMaxDynamicSharedMemorySize, LDS_BYTES) != hipSuccess) { fprintf(stderr, "kernel_launch: hipFuncSetAttribute failed\n"); grid = -1; return; }
        if (hipOccupancyMaxActiveBlocksPerMultiprocessor(&per_cu, (const void*)fwd_kernel, NTHR, LDS_BYTES) != hipSuccess || per_cu < 1) { fprintf(stderr, "kernel_launch: occupancy query says %d\n", per_cu); }
        (void)hipGetLastError();
        if (cus % 64 != 0) { fprintf(stderr, "kernel_launch: %d CUs: the fused-LayerNorm unit order needs a multiple of 64 workgroups\n", cus); grid = -1; return; }
        grid = cus;
    }
    if (grid < 0) return;
    if (hipMemsetAsync((char*)d_ws + WS_CTL, 0, CTL_ZERO_BYTES, stream) != hipSuccess) return;
    Args a{};
    for (int i = 0; i < 22; ++i) a.in[i] = (const float*)d_in[i];
    a.out = (float*)d_out; a.ws = (unsigned char*)d_ws;
    hipLaunchKernelGGL(fwd_kernel, dim3(grid), dim3(NTHR), LDS_BYTES, stream, a);
}
```

```cpp
#include <hip/hip_runtime.h>
#include <cstdio>
#include <cstdint>

namespace pg8 {
#define PG8_LAS __attribute__((address_space(3)))
typedef unsigned short bf16_t;
typedef short bf16x8 __attribute__((ext_vector_type(8)));
typedef float f32x4 __attribute__((ext_vector_type(4)));
typedef unsigned u32x4 __attribute__((ext_vector_type(4)));
constexpr int BM = 256, BK = 64, HALF = 128, HTB = HALF * BK * 2, STAGE_BYTES = 8 * HTB, NXCD = 8, WGM = 8;

__host__ __device__ __forceinline__ int lds_byte(int r, int c) { const int st = (r >> 4) * 2 + (c >> 5), rr = r & 15, cc = c & 31, ob = rr * 64 + cc * 2; return st * 1024 + (ob ^ (((ob >> 9) & 1) << 5)); }
__host__ __device__ __forceinline__ void stage_rc(int b, int& R, int& C) { const int st = b / 1024, sb = b % 1024, swz = sb ^ (((sb >> 9) & 1) << 5); R = (st >> 1) * 16 + swz / 64; C = (st & 1) * 32 + (swz % 64) / 2; }
__host__ __device__ __forceinline__ int perm32(int rho) { const int n = rho >> 4, i = rho & 15; return 8 * (i >> 2) + 4 * n + (i & 3); }

struct Unit { int pm, pn; };
struct Gemm { const bf16_t* A; const bf16_t* Bt; int M, N, K, lda, ldb, a_pn_stride; int krev = 0; };

struct StaticOrder {
    int nM, nN, nwg, G, c, mode;
    __host__ __device__ void init(int M, int N, int G_, int c_) { nM = M / BM; nN = N / BM; nwg = nM * nN; G = G_; c = c_; mode = 0; }
    __host__ __device__ bool next(int i, Unit& u) const {
        if (mode == 1) {
            const int PR = G >> 3, x = c & 7, j = c >> 3, pq = PR >> 3, nx = nM >> 3; if (i * pq + (j >> 3) >= nx) return false; u.pm = x * nx + i * pq + (j >> 3); u.pn = j & 7; return true; }
        const long L = (long)i * G + c; if (L >= nwg) return false;
        int wgid = (int)L; { const int q = nwg / NXCD, r = nwg % NXCD, xcd = wgid % NXCD, off = wgid / NXCD; wgid = (xcd < r ? xcd * (q + 1) : r * (q + 1) + (xcd - r) * q) + off; }
        const int nig = WGM * nN, gid = wgid / nig, fm = gid * WGM, gsz = (nM - fm) < WGM ? (nM - fm) : WGM;
        u.pm = fm + ((wgid % nig) % gsz); u.pn = (wgid % nig) / gsz; return true;
    }
};

typedef float f32x2_t __attribute__((ext_vector_type(2))); typedef __bf16 bf16x2_t __attribute__((ext_vector_type(2)));
__device__ __forceinline__ unsigned cvt_pk_bf16(float lo, float hi) { f32x2_t v = {lo, hi}; bf16x2_t b = __builtin_convertvector(v, bf16x2_t); return __builtin_bit_cast(unsigned, b); }

struct NoHook { static constexpr bool ON = false; template <class A> __device__ __forceinline__ void mid(A&, const Unit&, int, int, int, int) const {} };
template <class Epi, class Hook = NoHook>
__device__ __forceinline__ void gemm_phase(PG8_LAS unsigned char* lds, const Gemm g, const StaticOrder& S, const Epi& E, const int tid, const Hook H = Hook()) {
    const int wid = __builtin_amdgcn_readfirstlane(tid >> 6), lane = tid & 63, wr = wid >> 2, wc = wid & 3, fr = lane & 15, fq = lane >> 4;
    const int K = g.K, nt = K / BK;
    unsigned voffA[2], voffB[2];
#pragma unroll
    for (int i = 0; i < 2; ++i) { int R, C; stage_rc(tid * 16 + i * 8192, R, C); const int Rb = 64 * (R >> 5) + perm32(R & 31);
        voffA[i] = (unsigned)(R * g.lda + C) * 2u; voffB[i] = (unsigned)(Rb * g.ldb + C) * 2u; }
    const long kstep = g.krev ? -(long)(BK * 2) : (long)(BK * 2); const size_t kbase = g.krev ? (size_t)(nt - 1) * (BK * 2) : 0;
    const size_t hstepA = (size_t)HALF * g.lda * 2, hstepB = (size_t)32 * g.ldb * 2;
    const size_t tstepA = 2 * hstepA, tstepB = (size_t)BM * g.ldb * 2;
    const unsigned ldsw = (unsigned)wid * 1024u;
    const int aoff = lds_byte(wr * 64 + fr, fq * 8), boff = lds_byte(wc * 32 + fr, fq * 8);
#define PG8_SA(b, h) (((b) * 2 + (h)) * HTB)
#define PG8_SB(b, h) ((4 + (b) * 2 + (h)) * HTB)
#define PG8_STAGE(bufoff, gbase, voff) do { _Pragma("unroll") for (int _i = 0; _i < 2; ++_i) \
        __builtin_amdgcn_global_load_lds((const unsigned*)((const char*)(gbase) + (voff)[_i]), (PG8_LAS unsigned*)(lds + (bufoff) + ldsw + _i * 8192), 16, 0, 0); } while (0)
#define PG8_LDA(dst, b, h) do { _Pragma("unroll") for (int m = 0; m < 4; ++m) _Pragma("unroll") for (int k = 0; k < 2; ++k) dst[m][k] = *(const PG8_LAS bf16x8*)(lds + PG8_SA(b, h) + aoff + m * 2048 + k * 1024); } while (0)
#define PG8_LDB(dst, b, h) do { _Pragma("unroll") for (int n = 0; n < 2; ++n) _Pragma("unroll") for (int k = 0; k < 2; ++k) dst[n][k] = *(const PG8_LAS bf16x8*)(lds + PG8_SB(b, h) + boff + n * 2048 + k * 1024); } while (0)
#define PG8_MMA(ai, bj, At, Bt) do { __builtin_amdgcn_s_setprio(1); _Pragma("unroll") for (int m = 0; m < 4; ++m) _Pragma("unroll") for (int n = 0; n < 2; ++n) _Pragma("unroll") for (int k = 0; k < 2; ++k) \
        acc[ai][bj][m][n] = __builtin_amdgcn_mfma_f32_16x16x32_bf16(Bt[n][k], At[m][k], acc[ai][bj][m][n], 0, 0, 0); __builtin_amdgcn_s_setprio(0); } while (0)
#define PG8_WAIT_V(n) asm volatile("s_waitcnt vmcnt(" #n ")" ::: "memory")
#define PG8_WAIT_L(n) asm volatile("s_waitcnt lgkmcnt(" #n ")" ::: "memory")
#define PG8_BAR __builtin_amdgcn_s_barrier()
#define PG8_SCHED __builtin_amdgcn_sched_barrier(0)
    Unit cur, nxt; int ui = 0;
    if (!S.next(0, cur)) return;
    f32x4 acc[2][2][4][2];
#pragma unroll
    for (int a = 0; a < 2; ++a)
#pragma unroll
        for (int b = 0; b < 2; ++b)
#pragma unroll
            for (int m = 0; m < 4; ++m)
#pragma unroll
                for (int n = 0; n < 2; ++n) acc[a][b][m][n] = (f32x4){0.f, 0.f, 0.f, 0.f};
    bf16x8 At[4][2], B0[2][2], B1[2][2];
    const char* cA = (const char*)g.A + (size_t)cur.pm * tstepA + (size_t)cur.pn * g.a_pn_stride * 2 + kbase; const char* cB = (const char*)g.Bt + (size_t)cur.pn * tstepB + kbase;
    PG8_STAGE(PG8_SB(0, 0), cB, voffB); PG8_STAGE(PG8_SB(0, 1), cB + hstepB, voffB); PG8_STAGE(PG8_SA(0, 0), cA, voffA); PG8_STAGE(PG8_SA(0, 1), cA + hstepA, voffA);
    if (wr == 1) PG8_BAR;
    PG8_WAIT_V(2); PG8_BAR;
    PG8_STAGE(PG8_SB(1, 0), cB + kstep, voffB); PG8_STAGE(PG8_SA(1, 0), cA + kstep, voffA); PG8_STAGE(PG8_SB(1, 1), cB + hstepB + kstep, voffB);
    PG8_WAIT_V(6); PG8_BAR;
    for (;;) {
        const bool has_next = S.next(ui + 1, nxt);
        const char* nA = has_next ? (const char*)g.A + (size_t)nxt.pm * tstepA + (size_t)nxt.pn * g.a_pn_stride * 2 + kbase : cA; const char* nB = has_next ? (const char*)g.Bt + (size_t)nxt.pn * tstepB + kbase : cB;
        for (int t = 0; t < nt; t += 2) {
            const bool last = (t == nt - 2);
            const char* a1 = cA + (long)(t + 1) * kstep;
            const char* a2 = last ? nA : cA + (long)(t + 2) * kstep; const char* b2 = last ? nB : cB + (long)(t + 2) * kstep;
            const char* a3 = a2 + kstep; const char* b3 = b2 + kstep;
            if constexpr (Hook::ON) { if (t == (nt >> 1)) H.mid(acc, cur, wr, wc, fr, fq); }
            PG8_LDB(B0, 0, 0); PG8_LDB(B1, 0, 1); PG8_SCHED; PG8_LDA(At, 0, 0); PG8_STAGE(PG8_SA(1, 1), a1 + hstepA, voffA);
            PG8_WAIT_V(8); PG8_WAIT_L(0); PG8_BAR; PG8_MMA(0, 0, At, B0); PG8_MMA(0, 1, At, B1); PG8_BAR; PG8_SCHED;
            PG8_LDA(At, 0, 1); PG8_STAGE(PG8_SB(0, 0), b2, voffB); PG8_STAGE(PG8_SB(0, 1), b2 + hstepB, voffB); PG8_STAGE(PG8_SA(0, 0), a2, voffA);
            PG8_WAIT_V(8); PG8_WAIT_L(0); PG8_BAR; PG8_MMA(1, 0, At, B0); PG8_MMA(1, 1, At, B1); PG8_BAR; PG8_SCHED;
            PG8_LDB(B0, 1, 0); PG8_LDB(B1, 1, 1); PG8_SCHED; PG8_LDA(At, 1, 0); PG8_STAGE(PG8_SA(0, 1), a2 + hstepA, voffA);
            PG8_WAIT_V(8); PG8_WAIT_L(0); PG8_BAR; PG8_MMA(0, 0, At, B0); PG8_MMA(0, 1, At, B1); PG8_BAR; PG8_SCHED;
            PG8_LDA(At, 1, 1); PG8_STAGE(PG8_SB(1, 0), b3, voffB); PG8_STAGE(PG8_SB(1, 1), b3 + hstepB, voffB); PG8_STAGE(PG8_SA(1, 0), a3, voffA);
            PG8_WAIT_V(8); PG8_WAIT_L(0); PG8_BAR; PG8_MMA(1, 0, At, B0); PG8_MMA(1, 1, At, B1); PG8_BAR; PG8_SCHED;
        }
        if (wr == 0) PG8_BAR;
        E(acc, cur, wr, wc, fr, fq);
        if (!has_next) break;
#pragma unroll
        for (int a = 0; a < 2; ++a)
#pragma unroll
            for (int b = 0; b < 2; ++b)
#pragma unroll
                for (int m = 0; m < 4; ++m)
#pragma unroll
                    for (int n = 0; n < 2; ++n) acc[a][b][m][n] = (f32x4){0.f, 0.f, 0.f, 0.f};
        cur = nxt; cA = nA; cB = nB; ++ui;
        if (wr == 1) PG8_BAR;
    }
    PG8_WAIT_V(0);
    PG8_BAR;
#undef PG8_SA
#undef PG8_SB
#undef PG8_STAGE
#undef PG8_LDA
#undef PG8_LDB
#undef PG8_MMA
#undef PG8_WAIT_V
#undef PG8_WAIT_L
#undef PG8_BAR
#undef PG8_SCHED
}
}

constexpr int NWAVES = 8, NTHR = NWAVES * 64;
constexpr int DM = 2048, NBATCH = 4, SEQ = 4096, DEPTH = 4, M = NBATCH * SEQ;
constexpr int HGW = 1024;
constexpr int SAH = 16, SAC = 256, SAR = 512;
constexpr int DFF = 5632;
constexpr int N1 = 9216, N3 = 5120, N10 = 2 * DFF;
constexpr float ALPHA = 1.6817928305074292f;
constexpr int MODW = 6 * DM;

constexpr size_t MiB = 1u << 20;
constexpr size_t WS_CTL = 0, CTL_ZERO_BYTES = 32768;
constexpr size_t WS_MOD = 1 * MiB;
constexpr size_t WS_LB = 2 * MiB;
constexpr size_t WS_MODP = 3 * MiB;
constexpr size_t WS_W1 = 9 * MiB;
constexpr size_t WS_W3 = WS_W1 + 36 * MiB;
constexpr size_t WS_W6 = WS_W3 + 5 * MiB;
constexpr size_t WS_W7 = WS_W6 + 2 * MiB;
constexpr size_t WS_W8 = WS_W7 + 8 * MiB;
constexpr size_t WS_W10 = WS_W8 + 8 * MiB;
constexpr size_t WS_W11 = WS_W10 + 44 * MiB;
constexpr size_t WS_X = WS_W11 + 22 * MiB;
constexpr size_t WS_R = WS_X + 128 * MiB;
constexpr size_t WS_H = WS_R + 128 * MiB;
constexpr size_t WS_QA = WS_H + 64 * MiB;
constexpr size_t WS_FA = WS_QA + 32 * MiB;
constexpr size_t WS_IA = WS_FA + 64 * MiB;
constexpr size_t WS_GA = WS_IA + 32 * MiB;
constexpr size_t WS_LAT = WS_GA + 32 * MiB;
constexpr size_t WS_GTA = WS_LAT + 64 * MiB;
constexpr size_t WS_GTB = WS_GTA + 64 * MiB;
constexpr size_t WS_CQN = WS_GTB + 64 * MiB;
constexpr size_t WS_CKV = WS_CQN + 16 * MiB;
constexpr size_t WS_KIDX = WS_CKV + 8 * MiB;
constexpr size_t WS_IDXW = WS_KIDX + 2 * MiB;
constexpr size_t WS_QB = WS_IDXW + 1 * MiB;
constexpr size_t WS_QIDX = WS_QB + 128 * MiB;
constexpr size_t WS_SEL = WS_QIDX + 32 * MiB;
constexpr size_t WS_YAB = WS_SEL + 8 * MiB;
constexpr size_t WS_MRG = WS_FA;
constexpr size_t WS_OB = WS_YAB + 64 * MiB;
constexpr size_t WS_BIG = WS_OB + 128 * MiB;
constexpr size_t WS_KSB = WS_BIG + 256 * MiB;
constexpr size_t WS_DEB = WS_KSB + 32 * MiB;
constexpr size_t WS_QSB = WS_DEB + 2 * MiB;
constexpr size_t WS_END = WS_QSB + 32 * MiB;

constexpr int CW_BAR = 4096;

constexpr int RING_BYTES = 131072;
constexpr int LDS_BYTES = 163840;
constexpr int LDSCTL_OFF = LDS_BYTES - 1024, MISC_OFF = LDSCTL_OFF + 320, SELL_OFF = 147456;

#define GAS __attribute__((address_space(1)))
#define LAS __attribute__((address_space(3)))
typedef unsigned short bf16;
typedef unsigned v4u __attribute__((ext_vector_type(4)));
typedef unsigned v2u __attribute__((ext_vector_type(2)));
typedef float f32x4 __attribute__((ext_vector_type(4)));
typedef float f32x16 __attribute__((ext_vector_type(16)));
typedef short bf16x8 __attribute__((ext_vector_type(8)));
typedef short v4s __attribute__((ext_vector_type(4)));
typedef GAS unsigned gu32;
#define LDS_WAIT() asm volatile("s_waitcnt lgkmcnt(0)" ::: "memory")
__device__ __forceinline__ unsigned f2bf(float f) { unsigned u = __builtin_bit_cast(unsigned, f); return (u + 0x7fffu + ((u >> 16) & 1u)) >> 16; }
__device__ __forceinline__ unsigned pk2(float lo, float hi) { return pg8::cvt_pk_bf16(lo, hi); }
__device__ __forceinline__ float bf2f(unsigned short b) { return __builtin_bit_cast(float, ((unsigned)b) << 16); }
__device__ __forceinline__ float bflo(unsigned w) { return __builtin_bit_cast(float, w << 16); }
__device__ __forceinline__ float bfhi(unsigned w) { return __builtin_bit_cast(float, w & 0xffff0000u); }
__device__ __forceinline__ float sigm(float x) { return __builtin_amdgcn_rcpf(1.f + __expf(-x)); }

__device__ __forceinline__ int lane_id() { unsigned m = ~0u; asm volatile("" : "+s"(m)); return (int)__builtin_amdgcn_mbcnt_hi(m, __builtin_amdgcn_mbcnt_lo(m, 0u)); }
#define XB_TMO      128
#define XB_XCNT(j)  (256  + 64 * (j))
#define XB_XSUB(j)  (1280 + 64 * (j))
#define XB_XGEN(j)  (2304 + 64 * (j))
#define XB_TOP      3328
#define XB_TOPGEN   3392
#define XCD_BAR_WORDS 3456
#define XB_SPIN_CAP (1u << 22)

__device__ __forceinline__ unsigned xb_ld(unsigned* p)              { return __hip_atomic_load(p, __ATOMIC_RELAXED, __HIP_MEMORY_SCOPE_AGENT); }
__device__ __forceinline__ unsigned xb_add(unsigned* p, unsigned v) { return __hip_atomic_fetch_add(p, v, __ATOMIC_RELAXED, __HIP_MEMORY_SCOPE_AGENT); }
__device__ __forceinline__ unsigned xb_xcc_id() { return (unsigned)__builtin_amdgcn_s_getreg((3 << 11) | 20) & 0xFu; }
#define XB_SPIN(cond, bar) do { unsigned _sp = 0; while (cond) { __builtin_amdgcn_s_sleep(1); \
    if ((++_sp & 255u) == 0u) { if (xb_ld(&(bar)[XB_TMO])) break; if (_sp > XB_SPIN_CAP) { atomicAdd(&(bar)[XB_TMO], 1u); break; } } } } while (0)

struct XcdBarrier { unsigned* bar; unsigned x; volatile LAS unsigned* st; int wave; };

__device__ __forceinline__ XcdBarrier xcd_barrier_post(unsigned* bar, volatile LAS unsigned* st) {
    XcdBarrier b; b.bar = bar; b.x = (unsigned)__builtin_amdgcn_readfirstlane((int)xb_xcc_id()); b.st = st;
    if (threadIdx.x == 0) (void)xb_add(&bar[XB_XCNT(b.x)], 1u);
    return b;
}
__device__ __forceinline__ void xcd_barrier_complete(unsigned* bar, unsigned x, unsigned& nloc, unsigned& nx) {
    const unsigned G = gridDim.x * gridDim.y * gridDim.z;
    unsigned sum, cnt, mine, sp = 0u;
    for (;;) {
        sum = 0u; cnt = 0u; mine = 0u;
#pragma unroll 1
        for (unsigned j = 0; j < 16; ++j) { const unsigned c = xb_ld(&bar[XB_XCNT(j)]); sum += c; cnt += (c > 0u) ? 1u : 0u; mine = (j == x) ? c : mine; }
        if (sum == G) break;
        __builtin_amdgcn_s_sleep(1);
        if ((++sp & 255u) == 0u) { if (xb_ld(&bar[XB_TMO])) break; if (sp > XB_SPIN_CAP) { atomicAdd(&bar[XB_TMO], 1u); break; } }
    }
    nloc = mine > 0u ? mine : 1u; nx = cnt > 0u ? cnt : 1u;
}
__device__ __forceinline__ void xcd_barrier(const XcdBarrier& b) {
    asm volatile("s_waitcnt vmcnt(0)" ::: "memory");
    __syncthreads();
    if (b.wave == 0 && lane_id() == 0) {
        unsigned* bar = b.bar;
        unsigned bx = b.x; asm volatile("" : "+s"(bx));
        __builtin_amdgcn_s_waitcnt(0);
        unsigned nloc = b.st[0], nx = b.st[1];
        const unsigned old = xb_add(&bar[XB_XSUB(bx)], 1u);
        const unsigned gen = old / nloc;
        if (old + 1u == (gen + 1u) * nloc) {
            __builtin_amdgcn_fence(__ATOMIC_RELEASE, "agent");
            asm volatile("s_waitcnt vmcnt(0)" ::: "memory");
            const unsigned og = xb_add(&bar[XB_TOP], 1u);
            const unsigned tg = og / nx;
            if (og + 1u == (tg + 1u) * nx) xb_add(&bar[XB_TOPGEN], 1u);
            else XB_SPIN(xb_ld(&bar[XB_TOPGEN]) == tg, bar);
            __builtin_amdgcn_fence(__ATOMIC_ACQUIRE, "agent");
            xb_add(&bar[XB_XGEN(bx)], 1u);
            asm volatile("s_waitcnt vmcnt(0)" ::: "memory");
        } else {
            XB_SPIN(xb_ld(&bar[XB_XGEN(bx)]) == gen, bar);
            __builtin_amdgcn_fence(__ATOMIC_ACQUIRE, "agent");
            asm volatile("s_waitcnt vmcnt(0)" ::: "memory");
        }
    }
    __syncthreads();
}

__device__ __forceinline__ void xswap16(float& a, float& b) { asm volatile("s_nop 1\n\tv_permlane16_swap_b32 %0, %1\n\ts_nop 1" : "+v"(a), "+v"(b)); }
__device__ __forceinline__ void xswap32(float& a, float& b) { asm volatile("s_nop 1\n\tv_permlane32_swap_b32 %0, %1\n\ts_nop 1" : "+v"(a), "+v"(b)); }
__device__ __forceinline__ float xmax16(float x) { float a = x, b = x; xswap16(a, b); return fmaxf(a, b); }
__device__ __forceinline__ float xmax32(float x) { float a = x, b = x; xswap32(a, b); return fmaxf(a, b); }
__device__ __forceinline__ float xsum16(float x) { float a = x, b = x; xswap16(a, b); return a + b; }
__device__ __forceinline__ float xsum32(float x) { float a = x, b = x; xswap32(a, b); return a + b; }

#define DPPF(x, ctrl) __builtin_bit_cast(float, __builtin_amdgcn_update_dpp(0, __builtin_bit_cast(int, (x)), (ctrl), 0xf, 0xf, true))
__device__ __forceinline__ float wmax_f(float x) {
    x = fmaxf(x, DPPF(x, 0xB1)); x = fmaxf(x, DPPF(x, 0x4E)); x = fmaxf(x, DPPF(x, 0x124)); x = fmaxf(x, DPPF(x, 0x128));
    x = xmax16(x); return xmax32(x);
}
__device__ __forceinline__ unsigned wprefix_u(unsigned x) {
    int v = (int)x;
    v += __builtin_amdgcn_update_dpp(0, v, 0x111, 0xf, 0xf, false);
    v += __builtin_amdgcn_update_dpp(0, v, 0x112, 0xf, 0xf, false);
    v += __builtin_amdgcn_update_dpp(0, v, 0x114, 0xf, 0xf, false);
    v += __builtin_amdgcn_update_dpp(0, v, 0x118, 0xf, 0xf, false);
    v += __builtin_amdgcn_update_dpp(0, v, 0x142, 0xa, 0xf, false);
    v += __builtin_amdgcn_update_dpp(0, v, 0x143, 0xc, 0xf, false);
    return (unsigned)v;
}

__device__ __forceinline__ float rowsum16(float x) { x += DPPF(x, 0xB1); x += DPPF(x, 0x4E); x += DPPF(x, 0x124); x += DPPF(x, 0x128); return x; }
__device__ __forceinline__ float wave_sum(float x) { x = rowsum16(x); x = xsum16(x); return xsum32(x); }
__device__ __forceinline__ float wave_max(float x) { return wmax_f(x); }
__device__ __forceinline__ int wave_sum_i(int v) { float f = wave_sum((float)v); return (int)(f + 0.5f); }
template <class Src>
__device__ __forceinline__ void cvt_load(const Src& src, int k0, int n0, int lane, float (&tv)[32]) {
#pragma unroll
    for (int j = 0; j < 8; ++j) { const f32x4 v = src(k0 + 8 * j + (lane >> 3), n0 + 4 * (lane & 7)); tv[4 * j] = v[0]; tv[4 * j + 1] = v[1]; tv[4 * j + 2] = v[2]; tv[4 * j + 3] = v[3]; }
}
__device__ __forceinline__ void cvt_store(const float (&tv)[32], bf16* WT, int K, int k0, int n0, LAS float* scr, int lane) {
#pragma unroll
    for (int j = 0; j < 8; ++j)
#pragma unroll
        for (int e = 0; e < 4; ++e) scr[(8 * j + (lane >> 3)) * 33 + 4 * (lane & 7) + e] = tv[4 * j + e];
    LDS_WAIT(); asm volatile("" ::: "memory");
    const int c = lane & 7;
#pragma unroll
    for (int j = 0; j < 4; ++j) { const int n = (lane >> 3) + 8 * j; const LAS float* s = scr + (8 * c) * 33 + n;
        v4u o; o.x = pk2(s[0 * 33], s[1 * 33]); o.y = pk2(s[2 * 33], s[3 * 33]); o.z = pk2(s[4 * 33], s[5 * 33]); o.w = pk2(s[6 * 33], s[7 * 33]);
        *(GAS v4u*)(WT + (size_t)(n0 + n) * K + k0 + 8 * c) = o; }
    LDS_WAIT(); asm volatile("" ::: "memory");
}

struct Args { const float* in[22]; float* out; unsigned char* ws; };

using pg8::Unit; using pg8::cvt_pk_bf16;
__device__ __forceinline__ void st_bf16x8(bf16* p, f32x4 v0, f32x4 v1) {
    v4u w; w.x = cvt_pk_bf16(v0[0], v0[1]); w.y = cvt_pk_bf16(v0[2], v0[3]); w.z = cvt_pk_bf16(v1[0], v1[1]); w.w = cvt_pk_bf16(v1[2], v1[3]);
    *(v4u*)p = w;
}
__device__ __forceinline__ void st_f32x8(float* p, f32x4 v0, f32x4 v1) { *(f32x4*)p = v0; *(f32x4*)(p + 4) = v1; }
__device__ __forceinline__ f32x4 sigm4(f32x4 v) { return (f32x4){sigm(v[0]), sigm(v[1]), sigm(v[2]), sigm(v[3])}; }
__device__ __forceinline__ f32x4 silu4(f32x4 v) { return (f32x4){v[0] * sigm(v[0]), v[1] * sigm(v[1]), v[2] * sigm(v[2]), v[3] * sigm(v[3])}; }
__device__ __forceinline__ f32x4 ldbf4(const bf16* p) { const v2u w = *(const v2u*)p; return (f32x4){bflo(w.x), bfhi(w.x), bflo(w.y), bfhi(w.y)}; }

#define EPI_LOOP(...) \
    _Pragma("unroll") for (int ai = 0; ai < 2; ++ai) _Pragma("unroll") for (int m = 0; m < 4; ++m) { const int row = row0 + ai * 128 + m * 16; \
        _Pragma("unroll") for (int bj = 0; bj < 2; ++bj) { const int col = colb + bj * 32; const f32x4 v0 = acc[ai][bj][m][0], v1 = acc[ai][bj][m][1]; __VA_ARGS__ } }

__device__ __forceinline__ unsigned q8x4(f32x4 g) { unsigned w = 0u;
#pragma unroll
    for (int e = 0; e < 4; ++e) { const float t = fmaxf(__builtin_fmaf(g[e], 255.f, 0.5f), 1.f); w |= ((unsigned)t) << (8 * e); } return w; }
__device__ __forceinline__ f32x4 ub4(unsigned w) { return (f32x4){(float)(w & 0xffu), (float)((w >> 8) & 0xffu), (float)((w >> 16) & 0xffu), (float)(w >> 24)}; }
struct EpiProj {
    bf16* QA; bf16* FA; bf16* IA; bf16* GA; bf16* LAT; bf16* GTA; bf16* GTB;
    __device__ __forceinline__ void operator()(const f32x4 (&acc)[2][2][4][2], const Unit& u, int wr, int wc, int fr, int fq) const {
        const int row0 = u.pm * 256 + wr * 64 + fr, pn = u.pn; const int colb = (pn & 3) * 256 + wc * 64 + 8 * fq;
        if (pn < 4)       { EPI_LOOP( st_bf16x8(QA + (size_t)row * 1024 + col, v0, v1); ) }
        else if (pn < 8)  { EPI_LOOP( st_bf16x8(FA + (size_t)row * 1024 + col, v0, v1); ) }
        else if (pn < 12) { EPI_LOOP( st_bf16x8(IA + (size_t)row * 1024 + col, v0, v1); ) }
        else if (pn < 16) { EPI_LOOP( st_bf16x8(GA + (size_t)row * 1024 + col, silu4(v0), silu4(v1)); ) }
        else if (pn < 20) { EPI_LOOP( st_bf16x8(LAT + (size_t)row * 1024 + col, v0, v1); ) }
        else { unsigned char* G8 = (unsigned char*)(pn < 28 ? GTA : GTB) + ((size_t)(u.pm * 8 + ((pn - 20) & 7)) * 8 + (wr * 4 + wc)) * 8192 + (fq * 16 + fr) * 16;
            _Pragma("unroll") for (int ai = 0; ai < 2; ++ai) _Pragma("unroll") for (int bj = 0; bj < 2; ++bj) _Pragma("unroll") for (int mp = 0; mp < 2; ++mp) { v4u w;
                w.x = q8x4(sigm4(acc[ai][bj][2 * mp][0])); w.y = q8x4(sigm4(acc[ai][bj][2 * mp][1])); w.z = q8x4(sigm4(acc[ai][bj][2 * mp + 1][0])); w.w = q8x4(sigm4(acc[ai][bj][2 * mp + 1][1]));
                *(v4u*)(G8 + (ai * 4 + bj * 2 + mp) * 1024) = w; } }
    }
};
struct EpiQ {
    bf16* QB; bf16* QIDX;
    __device__ __forceinline__ void operator()(const f32x4 (&acc)[2][2][4][2], const Unit& u, int wr, int wc, int fr, int fq) const {
        const int row0 = u.pm * 256 + wr * 64 + fr, pn = u.pn;
        if (pn < 16) { const int colb = pn * 256 + wc * 64 + 8 * fq; EPI_LOOP( st_bf16x8(QB + (size_t)row * 4096 + col, v0, v1); ) }
        else { const int colb = (pn - 16) * 256 + wc * 64 + 8 * fq; EPI_LOOP( st_bf16x8(QIDX + (size_t)row * 1024 + col, v0, v1); ) }
    }
};
struct EpiBf {
    bf16* O; int ldc; int coff;
    __device__ __forceinline__ void operator()(const f32x4 (&acc)[2][2][4][2], const Unit& u, int wr, int wc, int fr, int fq) const {
        const int row0 = u.pm * 256 + wr * 64 + fr; const int colb = coff + u.pn * 256 + wc * 64 + 8 * fq;
        EPI_LOOP( st_bf16x8(O + (size_t)row * ldc + col, v0, v1); )
    }
};
struct HookGate {
    static constexpr bool ON = true; const bf16* GA_; const bf16* GB_;
    __device__ __forceinline__ void mid(f32x4 (&acc)[2][2][4][2], const Unit& u, int wr, int wc, int fr, int fq) const {
        asm volatile("" : "+v"(fr), "+v"(fq));
        const size_t off = ((size_t)(u.pm * 8 + u.pn) * 8 + (wr * 4 + wc)) * 8192 + (fq * 16 + fr) * 16;
        const unsigned char* A8 = (const unsigned char*)GA_ + off; const unsigned char* B8 = (const unsigned char*)GB_ + off;
#pragma unroll
        for (int ai = 0; ai < 2; ++ai)
#pragma unroll
            for (int mp = 0; mp < 2; ++mp) {
#pragma unroll
                for (int bj = 0; bj < 2; ++bj) { const v4u a = *(const v4u*)(A8 + (ai * 4 + bj * 2 + mp) * 1024), b = *(const v4u*)(B8 + (ai * 4 + bj * 2 + mp) * 1024);
#pragma unroll
                    for (int mm = 0; mm < 2; ++mm)
#pragma unroll
                        for (int n = 0; n < 2; ++n) { const unsigned aw = a[mm * 2 + n], bw = b[mm * 2 + n]; const f32x4 fa = ub4(aw), fb = ub4(bw); f32x4 r;
#pragma unroll
                            for (int j = 0; j < 4; ++j) r[j] = fa[j] * __builtin_amdgcn_rcpf(fb[j]);
                            acc[ai][bj][2 * mp + mm][n] = acc[ai][bj][2 * mp + mm][n] * r; } }
                asm volatile("" : "+v"(acc[ai][0][2 * mp][0]), "+v"(acc[ai][0][2 * mp][1]), "+v"(acc[ai][1][2 * mp][0]), "+v"(acc[ai][1][2 * mp][1]));
                asm volatile("" : "+v"(acc[ai][0][2 * mp + 1][0]), "+v"(acc[ai][0][2 * mp + 1][1]), "+v"(acc[ai][1][2 * mp + 1][0]), "+v"(acc[ai][1][2 * mp + 1][1]));
                asm volatile("" ::: "memory"); }
    }
};
__device__ __forceinline__ f32x4 cvbf4(v2u w) { return (f32x4){bflo(w.x), bfhi(w.x), bflo(w.y), bfhi(w.y)}; }
struct EpiGateM {
    const bf16* GB_; bf16* MRG_;
    __device__ __forceinline__ void operator()(const f32x4 (&acc)[2][2][4][2], const Unit& u, int wr, int wc, int fr, int fq) const {
        const int row0 = u.pm * 256 + wr * 64 + fr; const int colb = u.pn * 256 + wc * 64 + 8 * fq;
        const unsigned char* B8 = (const unsigned char*)GB_ + ((size_t)(u.pm * 8 + u.pn) * 8 + (wr * 4 + wc)) * 8192 + (fq * 16 + fr) * 16;
#pragma unroll
        for (int ai = 0; ai < 2; ++ai) { v4u gr[2][2];
#pragma unroll
            for (int bj = 0; bj < 2; ++bj)
#pragma unroll
                for (int mp = 0; mp < 2; ++mp) gr[bj][mp] = *(const v4u*)(B8 + (ai * 4 + bj * 2 + mp) * 1024);
#pragma unroll
            for (int m = 0; m < 4; ++m)
#pragma unroll
                for (int bj = 0; bj < 2; ++bj) { const size_t o = (size_t)(row0 + ai * 128 + m * 16) * 2048 + colb + bj * 32;
                    const unsigned w0 = gr[bj][m >> 1][(m & 1) * 2], w1 = gr[bj][m >> 1][(m & 1) * 2 + 1];
                    st_bf16x8(MRG_ + o, acc[ai][bj][m][0] * (ub4(w0) * (1.f / 255.f)), acc[ai][bj][m][1] * (ub4(w1) * (1.f / 255.f))); } }
    }
};
struct EpiGateA {
    float* T1; const bf16* GT;
    __device__ __forceinline__ void operator()(const f32x4 (&acc)[2][2][4][2], const Unit& u, int wr, int wc, int fr, int fq) const {
        const int row0 = u.pm * 256 + wr * 64 + fr; const int colb = u.pn * 256 + wc * 64 + 8 * fq;
        EPI_LOOP( const size_t o = (size_t)row * 2048 + col; const f32x4 g0 = ldbf4(GT + o), g1 = ldbf4(GT + o + 4); st_f32x8(T1 + o, v0 * g0, v1 * g1); )
    }
};
struct EpiGateB {
    const float* T1; const bf16* GT; bf16* MRG;
    __device__ __forceinline__ void operator()(const f32x4 (&acc)[2][2][4][2], const Unit& u, int wr, int wc, int fr, int fq) const {
        const int row0 = u.pm * 256 + wr * 64 + fr; const int colb = u.pn * 256 + wc * 64 + 8 * fq;
        EPI_LOOP( const size_t o = (size_t)row * 2048 + col; const f32x4 g0 = ldbf4(GT + o), g1 = ldbf4(GT + o + 4); const f32x4 t0 = *(const f32x4*)(T1 + o), t1 = *(const f32x4*)(T1 + o + 4);
                  st_bf16x8(MRG + o, t0 + v0 * g0, t1 + v1 * g1); )
    }
};
struct EpiRes {
    const float* X; const bf16* Hh; bf16* R; const float* md; int osh, osc, ogt;
    __device__ __forceinline__ void operator()(const f32x4 (&acc)[2][2][4][2], const Unit& u, int wr, int wc, int fr, int fq) const {
        const int row0 = u.pm * 256 + wr * 64 + fr; const int colb = u.pn * 256 + wc * 64 + 8 * fq; const float* g = md + (size_t)(u.pm >> 4) * MODW;
        f32x4 gg[2][2];
#pragma unroll
        for (int bj = 0; bj < 2; ++bj) { gg[bj][0] = *(const f32x4*)(g + ogt + colb + bj * 32) + 1.f; gg[bj][1] = *(const f32x4*)(g + ogt + colb + bj * 32 + 4) + 1.f; }
        if (X) {
#pragma unroll
            for (int ai = 0; ai < 2; ++ai)
#pragma unroll
                for (int mh = 0; mh < 2; ++mh) { f32x4 xr[2][2][2];
#pragma unroll
                    for (int mm = 0; mm < 2; ++mm)
#pragma unroll
                        for (int bj = 0; bj < 2; ++bj) { const size_t o = (size_t)(row0 + ai * 128 + (2 * mh + mm) * 16) * 2048 + colb + bj * 32; xr[mm][bj][0] = *(const f32x4*)(X + o); xr[mm][bj][1] = *(const f32x4*)(X + o + 4); }
#pragma unroll
                    for (int mm = 0; mm < 2; ++mm)
#pragma unroll
                        for (int bj = 0; bj < 2; ++bj) { const int m = 2 * mh + mm; const size_t o = (size_t)(row0 + ai * 128 + m * 16) * 2048 + colb + bj * 32;
                            st_bf16x8(R + o, xr[mm][bj][0] * ALPHA + gg[bj][0] * acc[ai][bj][m][0], xr[mm][bj][1] * ALPHA + gg[bj][1] * acc[ai][bj][m][1]); } }
        } else {
            f32x4 ia[2][2], sb[2][2];
#pragma unroll
            for (int bj = 0; bj < 2; ++bj)
#pragma unroll
                for (int hh = 0; hh < 2; ++hh) { const f32x4 sc = *(const f32x4*)(g + osc + colb + bj * 32 + 4 * hh), sh = *(const f32x4*)(g + osh + colb + bj * 32 + 4 * hh);
#pragma unroll
                    for (int e = 0; e < 4; ++e) { ia[bj][hh][e] = ALPHA / (1.f + sc[e]); sb[bj][hh][e] = sh[e] * ia[bj][hh][e]; } }
#pragma unroll
            for (int ai = 0; ai < 2; ++ai) { v2u xr[4][2][2];
#pragma unroll
                for (int m = 0; m < 4; ++m)
#pragma unroll
                    for (int bj = 0; bj < 2; ++bj) { const size_t o = (size_t)(row0 + ai * 128 + m * 16) * 2048 + colb + bj * 32; xr[m][bj][0] = *(const v2u*)(Hh + o); xr[m][bj][1] = *(const v2u*)(Hh + o + 4); }
#pragma unroll
                for (int m = 0; m < 4; ++m)
#pragma unroll
                    for (int bj = 0; bj < 2; ++bj) { const size_t o = (size_t)(row0 + ai * 128 + m * 16) * 2048 + colb + bj * 32;
                        st_bf16x8(R + o, cvbf4(xr[m][bj][0]) * ia[bj][0] - sb[bj][0] + gg[bj][0] * acc[ai][bj][m][0], cvbf4(xr[m][bj][1]) * ia[bj][1] - sb[bj][1] + gg[bj][1] * acc[ai][bj][m][1]); } }
        }
    }
};
template <int which, bool FINAL>
struct EpiLn {
    unsigned char* ws; const float* X; float* Fo; const float* lng; const float* lnb; LAS unsigned char* lds; int l;
    __device__ __forceinline__ void operator()(f32x4 (&acc)[2][2][4][2], const Unit& u, int wr, int wc, int fr, int fq) const {
        { const int ln_ = lane_id(); fr = ln_ & 15; fq = ln_ >> 4; }
        int upm = u.pm, upn = u.pn; asm volatile("" : "+s"(upm), "+s"(upn));
        const float* MODb = (const float*)(ws + WS_MOD); bf16* Hh = (bf16*)(ws + WS_H);
        const float* g = MODb + ((size_t)l * NBATCH + (upm >> 4)) * MODW + (which ? 3 * DM : 0);
        const float* go = which ? MODb + ((size_t)(l + 1 < DEPTH ? l + 1 : l) * NBATCH + (upm >> 4)) * MODW : g + 3 * DM;
        LAS float* sl = (LAS float*)(lds + RING_BYTES);
        const int row0 = upm * 256 + wr * 64 + fr; const int colb = upn * 256 + wc * 64 + 8 * fq;
#pragma unroll
        for (int bj = 0; bj < 2; ++bj) { const int c0 = colb + bj * 32;
            const f32x4 gg0 = *(const f32x4*)(g + 2 * DM + c0) + 1.f, gg1 = *(const f32x4*)(g + 2 * DM + c0 + 4) + 1.f;
            if (which == 0 && X) {
#pragma unroll
                for (int ai = 0; ai < 2; ++ai) { f32x4 xr[4][2];
#pragma unroll
                    for (int m = 0; m < 4; ++m) { const size_t o = (size_t)(row0 + ai * 128 + m * 16) * 2048 + c0; xr[m][0] = *(const f32x4*)(X + o); xr[m][1] = *(const f32x4*)(X + o + 4); }
#pragma unroll
                    for (int m = 0; m < 4; ++m) { acc[ai][bj][m][0] = xr[m][0] * ALPHA + gg0 * acc[ai][bj][m][0]; acc[ai][bj][m][1] = xr[m][1] * ALPHA + gg1 * acc[ai][bj][m][1]; } }
            } else {
                f32x4 ia0, ia1, sb0, sb1;
                { const f32x4 sc0 = *(const f32x4*)(g + DM + c0), sc1 = *(const f32x4*)(g + DM + c0 + 4), sh0 = *(const f32x4*)(g + c0), sh1 = *(const f32x4*)(g + c0 + 4);
#pragma unroll
                  for (int e = 0; e < 4; ++e) { ia0[e] = ALPHA * __builtin_amdgcn_rcpf(1.f + sc0[e]); ia1[e] = ALPHA * __builtin_amdgcn_rcpf(1.f + sc1[e]); sb0[e] = sh0[e] * ia0[e]; sb1[e] = sh1[e] * ia1[e]; } }
#pragma unroll
                for (int ai = 0; ai < 2; ++ai) { v2u xr[4][2]; size_t o = (size_t)(row0 + ai * 128) * 2048 + c0;
#pragma unroll
                    for (int m = 0; m < 4; ++m) { xr[m][0] = *(const v2u*)(Hh + o); xr[m][1] = *(const v2u*)(Hh + o + 4); size_t st_ = 16 * 2048; asm volatile("" : "+s"(st_)); o += st_; }
#pragma unroll
                    for (int m = 0; m < 4; ++m) { acc[ai][bj][m][0] = cvbf4(xr[m][0]) * ia0 - sb0 + gg0 * acc[ai][bj][m][0]; acc[ai][bj][m][1] = cvbf4(xr[m][1]) * ia1 - sb1 + gg1 * acc[ai][bj][m][1]; }
                    asm volatile("" ::: "memory"); }
            }
            asm volatile("" ::: "memory"); }
        { const int ln_ = lane_id(); fr = ln_ & 15; fq = ln_ >> 4; }
#pragma unroll
        for (int ai = 0; ai < 2; ++ai)
#pragma unroll
            for (int m = 0; m < 4; ++m) { float s1 = 0.f, s2 = 0.f;
#pragma unroll
                for (int bj = 0; bj < 2; ++bj)
#pragma unroll
                    for (int hh = 0; hh < 2; ++hh) { const f32x4 v = acc[ai][bj][m][hh]; s1 += (v[0] + v[1]) + (v[2] + v[3]); s2 += (v[0] * v[0] + v[1] * v[1]) + (v[2] * v[2] + v[3] * v[3]); }
                s1 = xsum32(xsum16(s1)); s2 = xsum32(xsum16(s2));
                if (fq == 0) { const int rt = ai * 128 + wr * 64 + m * 16 + fr; sl[(wc * 256 + rt) * 2] = s1; sl[(wc * 256 + rt) * 2 + 1] = s2; } }
        __syncthreads();
        const int tid = (wr * 4 + wc) * 64 + lane_id();
        float* ex = (float*)(ws + WS_SEL) + (size_t)upm * 8 * 512;
        if (tid < 256) { const float S1 = (sl[tid * 2] + sl[(256 + tid) * 2]) + (sl[(512 + tid) * 2] + sl[(768 + tid) * 2]), S2 = (sl[tid * 2 + 1] + sl[(256 + tid) * 2 + 1]) + (sl[(512 + tid) * 2 + 1] + sl[(768 + tid) * 2 + 1]);
            __hip_atomic_store((unsigned*)(ex + (upn * 256 + tid) * 2), __builtin_bit_cast(unsigned, S1), __ATOMIC_RELAXED, __HIP_MEMORY_SCOPE_AGENT);
            __hip_atomic_store((unsigned*)(ex + (upn * 256 + tid) * 2 + 1), __builtin_bit_cast(unsigned, S2), __ATOMIC_RELAXED, __HIP_MEMORY_SCOPE_AGENT); }
        asm volatile("s_waitcnt vmcnt(0)" ::: "memory");
        __syncthreads();
        if (tid == 0) { unsigned* cp = (unsigned*)(ws + WS_CTL) + 256 + (l * 2 + which) * 64 + upm;
            __builtin_amdgcn_fence(__ATOMIC_RELEASE, "agent"); asm volatile("s_waitcnt vmcnt(0)" ::: "memory");
            (void)xb_add(cp, 1u);
            for (unsigned sp = 0u; xb_ld(cp) < 8u && sp < 400000u; ++sp) __builtin_amdgcn_s_sleep(1);
            __builtin_amdgcn_fence(__ATOMIC_ACQUIRE, "agent"); asm volatile("s_waitcnt vmcnt(0)" ::: "memory"); }
        __syncthreads();
        if (tid < 256) { float S1 = 0.f, S2 = 0.f;
#pragma unroll
            for (int p = 0; p < 8; ++p) { S1 += __builtin_bit_cast(float, __hip_atomic_load((unsigned*)(ex + (p * 256 + tid) * 2), __ATOMIC_RELAXED, __HIP_MEMORY_SCOPE_AGENT));
                S2 += __builtin_bit_cast(float, __hip_atomic_load((unsigned*)(ex + (p * 256 + tid) * 2 + 1), __ATOMIC_RELAXED, __HIP_MEMORY_SCOPE_AGENT)); }
            const float mean = S1 * (1.f / DM); const float var = fmaxf(S2 * (1.f / DM) - mean * mean, 0.f);
            sl[2048 + tid * 2] = mean; sl[2048 + tid * 2 + 1] = 1.0f / sqrtf(var + 1e-5f); }
        __syncthreads();
        { const int ln_ = lane_id(); fr = ln_ & 15; fq = ln_ >> 4; }
        const int row1 = upm * 256 + wr * 64 + fr; const int colc = upn * 256 + wc * 64 + 8 * fq;
#pragma unroll
        for (int bj = 0; bj < 2; ++bj) { const int c0 = colc + bj * 32;
            const f32x4 lg0 = *(const f32x4*)(lng + c0), lg1 = *(const f32x4*)(lng + c0 + 4), lb0 = *(const f32x4*)(lnb + c0), lb1 = *(const f32x4*)(lnb + c0 + 4);
            const f32x4 q0 = *(const f32x4*)(go + DM + c0) + 1.f, q1 = *(const f32x4*)(go + DM + c0 + 4) + 1.f, h0 = *(const f32x4*)(go + c0), h1 = *(const f32x4*)(go + c0 + 4);
#pragma unroll
            for (int ai = 0; ai < 2; ++ai) { size_t on = (size_t)(row1 + ai * 128) * 2048 + c0;
#pragma unroll
                for (int m = 0; m < 4; ++m) { const int rt = ai * 128 + wr * 64 + m * 16 + fr; const float mean = sl[2048 + rt * 2], rstd = sl[2048 + rt * 2 + 1];
                    const size_t o = on; { size_t st_ = 16 * 2048; asm volatile("" : "+s"(st_)); on += st_; }
                    const f32x4 y0 = (acc[ai][bj][m][0] - mean) * rstd * lg0 + lb0, y1 = (acc[ai][bj][m][1] - mean) * rstd * lg1 + lb1;
                    if constexpr (FINAL) { *(f32x4*)(Fo + o) = y0; *(f32x4*)(Fo + o + 4) = y1; }
                    else st_bf16x8(Hh + o, y0 * q0 + h0, y1 * q1 + h1); } }
            asm volatile("" ::: "memory"); }
    }
};
struct EpiSwiglu {
    bf16* ACT;
    __device__ __forceinline__ void operator()(const f32x4 (&acc)[2][2][4][2], const Unit& u, int wr, int wc, int fr, int fq) const {
        const int row0 = u.pm * 256 + wr * 64 + fr; const int col = u.pn * 128 + wc * 32 + 8 * fq;
#pragma unroll
        for (int ai = 0; ai < 2; ++ai)
#pragma unroll
            for (int m = 0; m < 4; ++m) { const int row = row0 + ai * 128 + m * 16;
                st_bf16x8(ACT + (size_t)row * DFF + col, silu4(acc[ai][0][m][0]) * acc[ai][1][m][0], silu4(acc[ai][0][m][1]) * acc[ai][1][m][1]); }
    }
};

__global__ void __launch_bounds__(NTHR, 2) fwd_kernel(Args args) {
    extern __shared__ __attribute__((aligned(16))) unsigned char lds_raw[];
    LAS unsigned char* lds = (LAS unsigned char*)lds_raw;
    const int G = gridDim.x, blk = blockIdx.x;
    const int NGW = G * NWAVES, NT = G * NTHR;
    unsigned char* const ws_base = args.ws;
    gu32* ctl = (gu32*)(ws_base + WS_CTL);
    for (int u = threadIdx.x; u < (LDS_BYTES - LDSCTL_OFF) / 4; u += NTHR) ((LAS unsigned*)(lds + LDSCTL_OFF))[u] = 0u;
    __syncthreads();
    volatile LAS unsigned* MISC = (volatile LAS unsigned*)(lds + MISC_OFF);
    const int wave_s = __builtin_amdgcn_readfirstlane((int)(threadIdx.x >> 6));
    XcdBarrier bar = xcd_barrier_post((unsigned*)(ctl + CW_BAR), MISC + 8); bar.wave = wave_s;
    if (threadIdx.x == 0) { unsigned nloc_ = 0u, nx_ = 0u; xcd_barrier_complete(bar.bar, bar.x, nloc_, nx_); bar.st[0] = nloc_; bar.st[1] = nx_; }
    __syncthreads();
#define GRID_BAR() xcd_barrier(bar)

#define x_in ((const float*)(const GAS float*)args.in[0 + z_])
#define c_in ((const float*)(const GAS float*)args.in[1 + z_])
#define w_ada ((const float*)(const GAS float*)args.in[2 + z_])
#define b_ada ((const float*)(const GAS float*)args.in[3 + z_])
#define w_in ((const float*)(const GAS float*)args.in[4 + z_])
#define lb_logits ((const float*)(const GAS float*)args.in[5 + z_])
#define g_hg ((const float*)(const GAS float*)args.in[6 + z_])
#define w_pa ((const float*)(const GAS float*)args.in[7 + z_])
#define g_cq ((const float*)(const GAS float*)args.in[8 + z_])
#define g_ckv ((const float*)(const GAS float*)args.in[9 + z_])
#define w_uq ((const float*)(const GAS float*)args.in[10 + z_])
#define w_iq ((const float*)(const GAS float*)args.in[11 + z_])
#define w_uv ((const float*)(const GAS float*)args.in[12 + z_])
#define w_pb ((const float*)(const GAS float*)args.in[13 + z_])
#define w_out ((const float*)(const GAS float*)args.in[14 + z_])
#define ln1_g ((const float*)(const GAS float*)args.in[15 + z_])
#define ln1_b ((const float*)(const GAS float*)args.in[16 + z_])
#define w_gate ((const float*)(const GAS float*)args.in[17 + z_])
#define w_up ((const float*)(const GAS float*)args.in[18 + z_])
#define w_down ((const float*)(const GAS float*)args.in[19 + z_])
#define ln2_g ((const float*)(const GAS float*)args.in[20 + z_])
#define ln2_b ((const float*)(const GAS float*)args.in[21 + z_])
#define MOD  ((float*)(ws + WS_MOD))
#define LB   ((float*)(ws + WS_LB))
#define MODP ((float*)(ws + WS_MODP))
#define W1   ((bf16*)(ws + WS_W1))
#define W3   ((bf16*)(ws + WS_W3))
#define W6   ((bf16*)(ws + WS_W6))
#define W7   ((bf16*)(ws + WS_W7))
#define W8   ((bf16*)(ws + WS_W8))
#define W10  ((bf16*)(ws + WS_W10))
#define W11  ((bf16*)(ws + WS_W11))
#define XB   ((bf16*)(ws + WS_X))
#define RB   ((bf16*)(ws + WS_R))
#define HB   ((bf16*)(ws + WS_H))
#define QA   ((bf16*)(ws + WS_QA))
#define FA   ((bf16*)(ws + WS_FA))
#define IA   ((bf16*)(ws + WS_IA))
#define GA   ((bf16*)(ws + WS_GA))
#define LAT  ((bf16*)(ws + WS_LAT))
#define GTA  ((bf16*)(ws + WS_GTA))
#define GTB  ((bf16*)(ws + WS_GTB))
#define CQN  ((bf16*)(ws + WS_CQN))
#define CKV  ((bf16*)(ws + WS_CKV))
#define KIDX ((bf16*)(ws + WS_KIDX))
#define IDXW ((float*)(ws + WS_IDXW))
#define QB   ((bf16*)(ws + WS_QB))
#define QIDX ((bf16*)(ws + WS_QIDX))
#define SEL  ((unsigned short*)(ws + WS_SEL))
#define YAB  ((bf16*)(ws + WS_YAB))
#define MRG  ((bf16*)(ws + WS_MRG))
#define OB   ((bf16*)(ws + WS_OB))
#define ISC  ((_Float16*)(ws + WS_BIG))
#define OP   ((float*)(ws + WS_BIG))
#define ACT  ((bf16*)(ws + WS_BIG))
#define KK   LAT
#define modl (MOD + (size_t)l * NBATCH * MODW)
#define KSB  ((bf16*)(ws + WS_KSB))
#define QSB  ((bf16*)(ws + WS_QSB))
#define KVT  ((bf16*)(ws + WS_BIG))
#define SPB  ((bf16*)(ws + WS_FA))
#define DEB  ((float*)(ws + WS_DEB))
#define PHASE_BEGIN { unsigned om_ = ~0u; asm volatile("" : "+s"(om_)); int tid = wave_s * 64 + (int)__builtin_amdgcn_mbcnt_hi(om_, __builtin_amdgcn_mbcnt_lo(om_, 0u)); asm volatile("" : "+v"(tid)); int z_ = 0; asm volatile("" : "+s"(z_)); (void)z_; GAS unsigned char* wsg_ = (GAS unsigned char*)ws_base; asm volatile("" : "+s"(wsg_)); unsigned char* ws = (unsigned char*)wsg_; const int lane = tid & 63, wave = __builtin_amdgcn_readfirstlane(tid >> 6); \
        const int gw = blk * NWAVES + wave, gtid = blk * NTHR + tid; LAS float* wscr = (LAS float*)(lds + wave * 16384); (void)lane; (void)gw; (void)gtid; (void)wscr;
#define PHASE_END }

#define CVT_DECODE(IT_, MID_, K0_, N0_) do { int r_ = (IT_); \
        if (r_ < I1) { MID_ = 0; K0_ = (r_ / (N1 / 32)) * 64; N0_ = (r_ % (N1 / 32)) * 32; } else { r_ -= I1; \
        if (r_ < I3) { MID_ = 1; K0_ = (r_ / (N3 / 32)) * 64; N0_ = (r_ % (N3 / 32)) * 32; } else { r_ -= I3; \
        if (r_ < I6) { MID_ = 2; K0_ = (r_ / 32) * 64; N0_ = (r_ % 32) * 32; } else { r_ -= I6; \
        if (r_ < I7) { MID_ = 3; K0_ = (r_ / (DM / 32)) * 64; N0_ = (r_ % (DM / 32)) * 32; } else { r_ -= I7; \
        if (r_ < I8) { MID_ = 4; K0_ = (r_ / (DM / 32)) * 64; N0_ = (r_ % (DM / 32)) * 32; } else { r_ -= I8; \
        if (r_ < I10) { MID_ = 5; K0_ = (r_ / (N10 / 32)) * 64; N0_ = (r_ % (N10 / 32)) * 32; } else { r_ -= I10; \
        MID_ = 6; K0_ = (r_ / (DM / 32)) * 64; N0_ = (r_ % (DM / 32)) * 32; } } } } } } } while (0)
#define CVT_LOAD(MID_, K0_, N0_, TV_) do { \
        if (MID_ == 0) cvt_load([=](int k, int n) -> f32x4 { const f32x4 v = *(const f32x4*)(s_in + (size_t)k * 9040 + (n < 4944 ? n : n - 176)); return (n >= 4944 && n < 5120) ? (f32x4){0.f, 0.f, 0.f, 0.f} : v; }, K0_, N0_, lane, TV_); \
        else if (MID_ == 1) cvt_load([=](int k, int n) -> f32x4 { const float* p = n < 4096 ? s_uq + (size_t)k * 4096 + n : s_iq + (size_t)k * 1024 + (n - 4096); return *(const f32x4*)p * (n < 4096 ? 0.0625f : 1.f); }, K0_, N0_, lane, TV_); \
        else if (MID_ == 2) cvt_load([=](int k, int n) -> f32x4 { const int h = n >> 6, v = n & 63, kk = k >> 8, c = k & 255; const f32x4 w = *(const f32x4*)(s_uv + ((size_t)h * 256 + c) * 64 + v); return kk == (h & 3) ? w : (f32x4){0.f, 0.f, 0.f, 0.f}; }, K0_, N0_, lane, TV_); \
        else if (MID_ == 3) cvt_load([=](int k, int n) -> f32x4 { const float* p = k < 1024 ? s_pa + (size_t)k * DM + n : s_pb + (size_t)(k - 1024) * DM + n; return *(const f32x4*)p; }, K0_, N0_, lane, TV_); \
        else if (MID_ == 4) cvt_load([=](int k, int n) -> f32x4 { return *(const f32x4*)(s_out + (size_t)k * DM + n); }, K0_, N0_, lane, TV_); \
        else if (MID_ == 5) cvt_load([=](int k, int n) -> f32x4 { const int pn = n >> 8, rr = n & 255, cc = pn * 128 + (rr >> 6) * 32 + (rr & 31); const float* p = ((rr & 32) ? s_u : s_g) + (size_t)k * DFF + cc; return *(const f32x4*)p; }, K0_, N0_, lane, TV_); \
        else cvt_load([=](int k, int n) -> f32x4 { return *(const f32x4*)(s_d + (size_t)k * DM + n); }, K0_, N0_, lane, TV_); } while (0)
#define CONVERT_LAYER(L) do { const int l_ = (L); \
        const float* s_in = w_in + (size_t)l_ * DM * 9040; const float* s_uq = w_uq + (size_t)l_ * SAR * 4096; const float* s_iq = w_iq + (size_t)l_ * SAR * 1024; \
        const float* s_uv = w_uv + (size_t)l_ * 16 * 256 * 64; const float* s_pa = w_pa + (size_t)l_ * 1024 * DM; const float* s_pb = w_pb + (size_t)l_ * 1024 * DM; \
        const float* s_out = w_out + (size_t)l_ * DM * DM; const float* s_g = w_gate + (size_t)l_ * DM * DFF; const float* s_u = w_up + (size_t)l_ * DM * DFF; const float* s_d = w_down + (size_t)l_ * DFF * DM; \
        constexpr int I1 = (DM / 64) * (N1 / 32), I3 = (SAR / 64) * (N3 / 32), I6 = (1024 / 64) * (1024 / 32), I7 = (DM / 64) * (DM / 32), I8 = I7, I10 = (DM / 64) * (N10 / 32), I11 = (DFF / 64) * (DM / 32); \
        constexpr int NIT = I1 + I3 + I6 + I7 + I8 + I10 + I11; \
        float tv_[32]; int mid_ = 0, k0_ = 0, n0_ = 0; \
        { CVT_DECODE(gw, mid_, k0_, n0_); CVT_LOAD(mid_, k0_, n0_, tv_); } \
        for (int it = gw; it < NIT; it += NGW) { \
            float tc_[32]; _Pragma("unroll") for (int i = 0; i < 32; ++i) tc_[i] = tv_[i]; \
            const int mc_ = mid_, kc_ = k0_, nc_ = n0_; \
            { const int itn_ = it + NGW < NIT ? it + NGW : it; CVT_DECODE(itn_, mid_, k0_, n0_); CVT_LOAD(mid_, k0_, n0_, tv_); }     \
            bf16* wt_ = mc_ == 0 ? W1 : mc_ == 1 ? W3 : mc_ == 2 ? W6 : mc_ == 3 ? W7 : mc_ == 4 ? W8 : mc_ == 5 ? W10 : W11; \
            const int kk_ = mc_ == 0 ? DM : mc_ == 1 ? SAR : mc_ == 2 ? 1024 : mc_ == 3 ? DM : mc_ == 4 ? DM : mc_ == 5 ? DM : DFF; \
            cvt_store(tc_, wt_, kk_, kc_, nc_, wscr, lane); \
        } } while (0)


#ifndef HGRN_NAIVE
#define HGRN_NAIVE 0
#endif
#ifndef IDX_NAIVE
#define IDX_NAIVE 0
#endif
#ifndef ATT_NAIVE
#define ATT_NAIVE 0
#endif
#ifndef TOPK_OLD
#define TOPK_OLD 0
#endif
#ifndef REP_HB
#define REP_HB 1
#endif
#ifndef REP_HC
#define REP_HC 1
#endif
#ifndef REP_P4A
#define REP_P4A 1
#endif
#ifndef REP_P5
#define REP_P5 1
#endif
#ifndef REP_P9
#define REP_P9 1
#endif
#ifndef REP_P12
#define REP_P12 1
#endif
#ifndef REP_TOPK
#define REP_TOPK 1
#endif
#ifndef REP_ATT
#define REP_ATT 1
#endif
#ifndef DRY_ATT
#define DRY_ATT 0
#endif
#ifndef REP_M1
#define REP_M1 1
#endif
#ifndef REP_M2
#define REP_M2 1
#endif
#ifndef REP_M3
#define REP_M3 1
#endif

    PHASE_BEGIN
    {
        LAS float* sc = (LAS float*)lds;
        for (int i = tid; i < NBATCH * DM; i += NTHR) { const float v = c_in[i]; sc[i] = v * sigm(v); }
        __syncthreads();
        for (int item = gtid; item < 8 * 12288; item += NT) {
            const int ks = item / 12288, cg = item % 12288, l = cg / 3072, n4 = (cg % 3072) * 4;
            const float* wp = w_ada + ((size_t)l * DM + ks * 256) * MODW + n4;
            f32x4 a0 = {0.f, 0.f, 0.f, 0.f}, a1 = a0, a2 = a0, a3 = a0;
#pragma unroll 8
            for (int k = 0; k < 256; ++k) { const f32x4 w = *(const f32x4*)(wp + (size_t)k * MODW); const int kk = ks * 256 + k;
                a0 += w * sc[kk]; a1 += w * sc[2048 + kk]; a2 += w * sc[4096 + kk]; a3 += w * sc[6144 + kk]; }
            float* o = MODP + ((size_t)(ks * 4 + l) * 4) * MODW + n4;
            *(f32x4*)(o) = a0; *(f32x4*)(o + MODW) = a1; *(f32x4*)(o + 2 * MODW) = a2; *(f32x4*)(o + 3 * MODW) = a3;
        }
        if (gtid < 1024) {
            const float a = lb_logits[gtid], b = lb_logits[1024 + gtid], c = lb_logits[2048 + gtid], d = lb_logits[3072 + gtid];
            const float mx = fmaxf(fmaxf(a, b), fmaxf(c, d)); const float ea = expf(a - mx), eb = expf(b - mx), ec = expf(c - mx), ed = expf(d - mx); const float inv = 1.f / (ea + eb + ec + ed);
            LB[gtid] = 0.f; LB[1024 + gtid] = eb * inv; LB[2048 + gtid] = (eb + ec) * inv; LB[3072 + gtid] = (eb + ec + ed) * inv;
        }
        __syncthreads();
        CONVERT_LAYER(0);
    }
    PHASE_END
    GRID_BAR();
    PHASE_BEGIN
    for (int i = gtid; i < DEPTH * NBATCH * MODW; i += NT) {
        const int l = i / (NBATCH * MODW), r = i % (NBATCH * MODW), b = r / MODW, n = r % MODW;
        float s = b_ada[l * MODW + n];
#pragma unroll
        for (int ks = 0; ks < 8; ++ks) s += MODP[((size_t)(ks * 4 + l) * 4 + b) * MODW + n];
        MOD[i] = s;
    }
    PHASE_END
    GRID_BAR();
    PHASE_BEGIN
    for (size_t i0 = gtid; i0 < (size_t)M * DM / 8; i0 += (size_t)NT * 4) {
        f32x4 xa[4], xb[4], sa[4], sb[4], ha[4], hb[4];
#pragma unroll
        for (int t = 0; t < 4; ++t) { size_t gi = i0 + (size_t)t * NT; gi = gi < (size_t)M * DM / 8 ? gi : (size_t)M * DM / 8 - 1; const size_t e = gi * 8; const int row = (int)(e / DM), col = (int)(e % DM), b = row / SEQ; const float* md = MOD + (size_t)b * MODW;
            xa[t] = *(const f32x4*)(x_in + e); xb[t] = *(const f32x4*)(x_in + e + 4); sa[t] = *(const f32x4*)(md + 2048 + col); sb[t] = *(const f32x4*)(md + 2048 + col + 4); ha[t] = *(const f32x4*)(md + col); hb[t] = *(const f32x4*)(md + col + 4); }
#pragma unroll
        for (int t = 0; t < 4; ++t) { size_t gi = i0 + (size_t)t * NT; gi = gi < (size_t)M * DM / 8 ? gi : (size_t)M * DM / 8 - 1; const size_t e = gi * 8; st_bf16x8(HB + e, xa[t] * (sa[t] + 1.f) + ha[t], xb[t] * (sb[t] + 1.f) + hb[t]); }
    }
    PHASE_END
    GRID_BAR();

    for (int l = 0; l < DEPTH; ++l) {
        PHASE_BEGIN
        { pg8::Gemm g{HB, W1, M, N1, DM, DM, DM, 0}; pg8::StaticOrder S; S.init(M, N1, G, blk);
          EpiProj E{QA, FA, IA, GA, LAT, GTA, GTB}; pg8::gemm_phase(lds, g, S, E, tid); }
        PHASE_END
        GRID_BAR();
        for (int rep_ = 0; rep_ < REP_M1; ++rep_) {
        PHASE_BEGIN
        v2u ra0, ra1, rkv; unsigned short rki, riw;
        const f32x4 g0 = *(const f32x4*)(g_cq + l * 512 + 4 * lane), g1 = *(const f32x4*)(g_cq + l * 512 + 256 + 4 * lane), gk = *(const f32x4*)(g_ckv + l * 256 + 4 * lane);
        { const bf16* lr = LAT + (size_t)gw * 1024; ra0 = *(const v2u*)(lr + 4 * lane); ra1 = *(const v2u*)(lr + 256 + 4 * lane); rkv = *(const v2u*)(lr + 512 + 4 * lane); rki = lr[768 + lane]; riw = lr[832 + (lane & 15)]; }
        for (int row = gw; row < M; row += NGW) {
            const f32x4 a0 = (f32x4){bflo(ra0.x), bfhi(ra0.x), bflo(ra0.y), bfhi(ra0.y)}, a1 = (f32x4){bflo(ra1.x), bfhi(ra1.x), bflo(ra1.y), bfhi(ra1.y)}, kv = (f32x4){bflo(rkv.x), bfhi(rkv.x), bflo(rkv.y), bfhi(rkv.y)};
            const float ki = bf2f(rki), iw = bf2f(riw);
            { const int rn = row + NGW < M ? row + NGW : row; const bf16* lr = LAT + (size_t)rn * 1024;
              ra0 = *(const v2u*)(lr + 4 * lane); ra1 = *(const v2u*)(lr + 256 + 4 * lane); rkv = *(const v2u*)(lr + 512 + 4 * lane); rki = lr[768 + lane]; riw = lr[832 + (lane & 15)]; }
            float sq = a0[0] * a0[0] + a0[1] * a0[1] + a0[2] * a0[2] + a0[3] * a0[3] + a1[0] * a1[0] + a1[1] * a1[1] + a1[2] * a1[2] + a1[3] * a1[3];
            float sk = kv[0] * kv[0] + kv[1] * kv[1] + kv[2] * kv[2] + kv[3] * kv[3];
            sq = wave_sum(sq); sk = wave_sum(sk);
            const float rq = 1.0f / sqrtf(sq * (1.f / 512.f) + 1e-6f), rk = 1.0f / sqrtf(sk * (1.f / 256.f) + 1e-6f);
            v2u o; f32x4 t = a0 * rq * g0; o.x = pk2(t[0], t[1]); o.y = pk2(t[2], t[3]); *(v2u*)(CQN + (size_t)row * 512 + 4 * lane) = o;
            t = a1 * rq * g1; o.x = pk2(t[0], t[1]); o.y = pk2(t[2], t[3]); *(v2u*)(CQN + (size_t)row * 512 + 256 + 4 * lane) = o;
            t = kv * rk * gk; o.x = pk2(t[0], t[1]); o.y = pk2(t[2], t[3]); *(v2u*)(CKV + (size_t)row * 256 + 4 * lane) = o;
            KIDX[(size_t)row * 64 + lane] = (bf16)f2bf(ki);
            if (lane < 16) IDXW[(size_t)row * 16 + lane] = iw * 0.03125f;
        }
        PHASE_END
        PHASE_BEGIN
        {
            const int cp = tid & 63, sg = tid >> 6;
            LAS unsigned char* KST = lds;
            LAS unsigned char* VTL = lds + 18432;
            LAS float* SEGT = (LAS float*)(lds + 36864);
            LAS float* G63 = (LAS float*)(lds + 40960);
            unsigned pfa[8], pq[8], pv[8]; float plb0, plb1;
#define HA_REQ(U_) do { int uu_ = (U_); asm volatile("" : "+s"(uu_)); const int bh_ = uu_ >> 6, c_ = uu_ & 63, b_ = bh_ >> 3, h_ = bh_ & 7; \
                const size_t rowb_ = (size_t)b_ * SEQ + c_ * 64 + sg * 8; const int col_ = h_ * 128 + 2 * cp; \
                _Pragma("unroll") for (int i = 0; i < 8; ++i) { pfa[i] = *(const unsigned*)(FA + (rowb_ + i) * 1024 + col_); pq[i] = *(const unsigned*)(QA + (rowb_ + i) * 1024 + col_); pv[i] = *(const unsigned*)(IA + (rowb_ + i) * 1024 + col_); } plb0 = LB[l * 1024 + col_]; plb1 = LB[l * 1024 + col_ + 1]; } while (0)
            HA_REQ(blk);
            for (int u = blk; u < 2048; u += G) {
                const int bh = u >> 6, c = u & 63, b = bh >> 3, h = bh & 7;
                const size_t rowb = (size_t)b * SEQ + c * 64 + sg * 8; const int col = h * 128 + 2 * cp;
                const float lb0 = plb0, lb1 = plb1;
                float lf0[8], lf1[8], kk0[8], kk1[8]; unsigned cq[8], cv[8];
#pragma unroll
                for (int i = 0; i < 8; ++i) { cq[i] = pq[i]; cv[i] = pv[i]; }
#pragma unroll
                for (int i = 0; i < 8; ++i) { const float2 fa = make_float2(bflo(pfa[i]), bfhi(pfa[i]));
                    const float f0 = fminf(fmaxf(lb0 + (1.f - lb0) * sigm(fa.x), 1e-6f), 1.f), f1 = fminf(fmaxf(lb1 + (1.f - lb1) * sigm(fa.y), 1e-6f), 1.f);
                    lf0[i] = __logf(f0); lf1[i] = __logf(f1); kk0[i] = (1.f - lb0) * sigm(-fa.x); kk1[i] = (1.f - lb1) * sigm(-fa.y); }
#pragma unroll
                for (int i = 1; i < 8; ++i) { lf0[i] += lf0[i - 1]; lf1[i] += lf1[i - 1]; }
                SEGT[sg * 128 + 2 * cp] = lf0[7]; SEGT[sg * 128 + 2 * cp + 1] = lf1[7];
                HA_REQ(u + G < 2048 ? u + G : u);
                __syncthreads();
                float pre0 = 0.f, pre1 = 0.f, r0 = 0.f, r1 = 0.f, t0 = 0.f, t1 = 0.f;
#pragma unroll
                for (int s2 = 0; s2 < 8; ++s2) { const float a0 = SEGT[s2 * 128 + 2 * cp], a1 = SEGT[s2 * 128 + 2 * cp + 1];
                    if (s2 < sg) { pre0 += a0; pre1 += a1; } if (s2 < 4) { r0 += a0; r1 += a1; } t0 += a0; t1 += a1; }
                unsigned ksw0[4], ksw1[4], vw0[4], vw1[4]; float ks0p = 0.f, ks1p = 0.f, v0p = 0.f, v1p = 0.f;
#pragma unroll
                for (int i = 0; i < 8; ++i) {
                    const float b0 = pre0 + lf0[i], b1 = pre1 + lf1[i];
                    const unsigned qw = cq[i]; const unsigned vw = cv[i];
                    const float qs0 = bflo(qw) * __expf(b0 - r0), qs1 = bfhi(qw) * __expf(b1 - r1);
                    const float ks0 = kk0[i] * __expf(r0 - b0), ks1 = kk1[i] * __expf(r1 - b1);
                    *(unsigned*)(QSB + (rowb + i) * 1024 + col) = pk2(qs0, qs1);
                    *(unsigned*)(KSB + (rowb + i) * 1024 + col) = pk2(ks0, ks1);
                    if (i & 1) { ksw0[i >> 1] = pk2(ks0p, ks0); ksw1[i >> 1] = pk2(ks1p, ks1); vw0[i >> 1] = pk2(v0p, bflo(vw)); vw1[i >> 1] = pk2(v1p, bfhi(vw)); }
                    else { ks0p = ks0; ks1p = ks1; v0p = bflo(vw); v1p = bfhi(vw); }
                }
                *(LAS v4u*)(KST + (2 * cp) * 144 + sg * 16) = (v4u){ksw0[0], ksw0[1], ksw0[2], ksw0[3]};
                *(LAS v4u*)(KST + (2 * cp + 1) * 144 + sg * 16) = (v4u){ksw1[0], ksw1[1], ksw1[2], ksw1[3]};
                *(LAS v4u*)(VTL + (2 * cp) * 144 + sg * 16) = (v4u){vw0[0], vw0[1], vw0[2], vw0[3]};
                *(LAS v4u*)(VTL + (2 * cp + 1) * 144 + sg * 16) = (v4u){vw1[0], vw1[1], vw1[2], vw1[3]};
                if (sg == 7) { float* de = DEB + (size_t)u * 256; *(float2*)(de + 2 * cp) = make_float2(__expf(r0), __expf(r1)); *(float2*)(de + 128 + 2 * cp) = make_float2(__expf(t0), __expf(t1));
                    G63[2 * cp] = __expf(t0 - r0); G63[2 * cp + 1] = __expf(t1 - r1); }
                __syncthreads();
                { const int kt = wave >> 1, vt0 = (wave & 1) * 2, lr = lane & 31, lh = lane >> 5;
                  f32x16 acc0, acc1;
#pragma unroll
                  for (int r = 0; r < 16; ++r) { acc0[r] = 0.f; acc1[r] = 0.f; }
#pragma unroll
                  for (int s4 = 0; s4 < 4; ++s4) {
                      const bf16x8 kb = *(const LAS bf16x8*)(KST + (kt * 32 + lr) * 144 + (s4 * 16 + 8 * lh) * 2);
                      const bf16x8 a0 = *(const LAS bf16x8*)(VTL + (vt0 * 32 + lr) * 144 + (s4 * 16 + 8 * lh) * 2);
                      const bf16x8 a1 = *(const LAS bf16x8*)(VTL + ((vt0 + 1) * 32 + lr) * 144 + (s4 * 16 + 8 * lh) * 2);
                      acc0 = __builtin_amdgcn_mfma_f32_32x32x16_bf16(a0, kb, acc0, 0, 0, 0); acc1 = __builtin_amdgcn_mfma_f32_32x32x16_bf16(a1, kb, acc1, 0, 0, 0); }
                  bf16* kvt = KVT + (size_t)u * 16384 + kt * 32 + lr; const float g = G63[kt * 32 + lr];
#pragma unroll
                  for (int r = 0; r < 16; ++r) { const int vv = 8 * (r >> 2) + 4 * lh + (r & 3);
                      kvt[(size_t)(vt0 * 32 + vv) * 128] = (bf16)(pk2(acc0[r] * g, 0.f) & 0xffffu); kvt[(size_t)((vt0 + 1) * 32 + vv) * 128] = (bf16)(pk2(acc1[r] * g, 0.f) & 0xffffu); } }
                __syncthreads();
            }
        }
#undef HA_REQ
        PHASE_END
        GRID_BAR();
        }
        for (int rep_ = 0; rep_ < REP_M2; ++rep_) {
        PHASE_BEGIN
        for (int item = gtid; item < 32 * 4096; item += NT) {
            const int bh = item >> 12, v = (item >> 5) & 127, k4 = (item & 31) * 4;
            f32x4 S = {0.f, 0.f, 0.f, 0.f};
            for (int c0 = 0; c0 < 64; c0 += 8) {
                f32x4 kv[8], dd[8], ee[8];
#pragma unroll
                for (int j = 0; j < 8; ++j) { const size_t u = (size_t)bh * 64 + c0 + j; kv[j] = ldbf4(KVT + u * 16384 + v * 128 + k4); ee[j] = *(const f32x4*)(DEB + u * 256 + k4); dd[j] = *(const f32x4*)(DEB + u * 256 + 128 + k4); }
#pragma unroll
                for (int j = 0; j < 8; ++j) { const size_t u = (size_t)bh * 64 + c0 + j; const f32x4 sp = S * ee[j]; v2u w; w.x = pk2(sp[0], sp[1]); w.y = pk2(sp[2], sp[3]);
                    *(v2u*)(SPB + u * 16384 + v * 128 + k4) = w; S = S * dd[j] + kv[j]; }
            }
        }
        PHASE_END
        PHASE_BEGIN
        { pg8::Gemm g{CQN, W3, M, N3, SAR, SAR, SAR, 0}; pg8::StaticOrder S; S.init(M, N3, G, blk);
          EpiQ E{QB, QIDX}; pg8::gemm_phase(lds, g, S, E, tid); }
        PHASE_END
        GRID_BAR();
        }
        for (int st_ = 0; st_ < 2; ++st_) {
        if ((st_ == 0) == (((blk >> 3) & 1) == 0)) {
        PHASE_BEGIN
        {
            LAS unsigned char* QSL = lds;
            LAS unsigned char* KSL = lds + 17408;
            LAS unsigned char* VTL = lds + 34816;
            LAS unsigned char* SPL = lds + 53248;
            LAS unsigned char* AL = lds + 88064;
            LAS float* SSQ = (LAS float*)(lds + 97280);
            const int cp = tid & 63, sg = tid >> 6, lr = lane & 31, lh = lane >> 5;
            v4u rq[2], rk[2], rs[4]; unsigned rv[8]; unsigned short rg[16];
#define HC_REQ(U_) do { int uu_ = (U_); asm volatile("" : "+s"(uu_));   const int bh_ = uu_ >> 6, c_ = uu_ & 63, b_ = bh_ >> 3, h_ = bh_ & 7; const size_t row0_ = (size_t)b_ * SEQ + c_ * 64; const int col0_ = h_ * 128; \
                _Pragma("unroll") for (int j = 0; j < 2; ++j) { const int q = tid + 512 * j, rr = q >> 4, cc = q & 15; \
                    rq[j] = *(const v4u*)(QSB + (row0_ + rr) * 1024 + col0_ + cc * 8); rk[j] = *(const v4u*)(KSB + (row0_ + rr) * 1024 + col0_ + cc * 8); } \
                _Pragma("unroll") for (int j = 0; j < 4; ++j) { const int q = tid + 512 * j, rr = q >> 4, cc = q & 15; rs[j] = *(const v4u*)(SPB + (size_t)uu_ * 16384 + rr * 128 + cc * 8); } \
                _Pragma("unroll") for (int i = 0; i < 8; ++i) rv[i] = *(const unsigned*)(IA + (row0_ + sg * 8 + i) * 1024 + col0_ + 2 * cp); \
                { const int it_ = wave >> 2, vt_ = wave & 3; const int colg_ = col0_ + vt_ * 32 + lr; \
                  _Pragma("unroll") for (int r = 0; r < 16; ++r) { const int ii = it_ * 32 + 8 * (r >> 2) + 4 * lh + (r & 3); rg[r] = GA[(row0_ + ii) * 1024 + colg_]; } } } while (0)
            HC_REQ(blk);
            for (int u = blk; u < 2048; u += G) {
                const int bh = u >> 6, c = u & 63, b = bh >> 3, h = bh & 7;
                const size_t row0 = (size_t)b * SEQ + c * 64; const int col0 = h * 128;
#pragma unroll
                for (int j = 0; j < 2; ++j) { const int q = tid + 512 * j, rr = q >> 4, cc = q & 15;
                    *(LAS v4u*)(QSL + rr * 272 + cc * 16) = rq[j]; *(LAS v4u*)(KSL + rr * 272 + cc * 16) = rk[j]; }
#pragma unroll
                for (int j = 0; j < 4; ++j) { const int q = tid + 512 * j, rr = q >> 4, cc = q & 15; *(LAS v4u*)(SPL + rr * 272 + cc * 16) = rs[j]; }
                { unsigned vw0[4], vw1[4]; float v0p = 0.f, v1p = 0.f;
#pragma unroll
                  for (int i = 0; i < 8; ++i) { const unsigned vw = rv[i];
                      if (i & 1) { vw0[i >> 1] = pk2(v0p, bflo(vw)); vw1[i >> 1] = pk2(v1p, bfhi(vw)); } else { v0p = bflo(vw); v1p = bfhi(vw); } }
                  *(LAS v4u*)(VTL + (2 * cp) * 144 + sg * 16) = (v4u){vw0[0], vw0[1], vw0[2], vw0[3]};
                  *(LAS v4u*)(VTL + (2 * cp + 1) * 144 + sg * 16) = (v4u){vw1[0], vw1[1], vw1[2], vw1[3]}; }
                float gav[16];
#pragma unroll
                for (int r = 0; r < 16; ++r) gav[r] = bf2f(rg[r]);
                const float gg = g_hg[l * 1024 + col0 + (wave & 3) * 32 + lr];
                HC_REQ(u + G < 2048 ? u + G : u);
                __syncthreads();
                if (wave < 4) {
                    const int it = wave >> 1, jt = wave & 1;
                    f32x16 acc;
#pragma unroll
                    for (int r = 0; r < 16; ++r) acc[r] = 0.f;
                    if (!(it == 0 && jt == 1)) {
#pragma unroll
                        for (int s8 = 0; s8 < 8; ++s8) {
                            const bf16x8 a = *(const LAS bf16x8*)(QSL + (it * 32 + lr) * 272 + (s8 * 16 + 8 * lh) * 2);
                            const bf16x8 bb = *(const LAS bf16x8*)(KSL + (jt * 32 + lr) * 272 + (s8 * 16 + 8 * lh) * 2);
                            acc = __builtin_amdgcn_mfma_f32_32x32x16_bf16(a, bb, acc, 0, 0, 0); } }
                    const int jj = jt * 32 + lr;
#pragma unroll
                    for (int r = 0; r < 16; ++r) { const int ii = it * 32 + 8 * (r >> 2) + 4 * lh + (r & 3); const float x = (jj <= ii) ? acc[r] : 0.f;
                        *(LAS unsigned short*)(AL + ii * 144 + jj * 2) = (unsigned short)(pk2(x, 0.f) & 0xffffu); }
                }
                __syncthreads();
                { const int it = wave >> 2, vt = wave & 3;
                  f32x16 acc;
#pragma unroll
                  for (int r = 0; r < 16; ++r) acc[r] = 0.f;
#pragma unroll
                  for (int s4 = 0; s4 < 4; ++s4) {
                      const bf16x8 a = *(const LAS bf16x8*)(AL + (it * 32 + lr) * 144 + (s4 * 16 + 8 * lh) * 2);
                      const bf16x8 bb = *(const LAS bf16x8*)(VTL + (vt * 32 + lr) * 144 + (s4 * 16 + 8 * lh) * 2);
                      acc = __builtin_amdgcn_mfma_f32_32x32x16_bf16(a, bb, acc, 0, 0, 0); }
#pragma unroll
                  for (int s8 = 0; s8 < 8; ++s8) {
                      const bf16x8 a = *(const LAS bf16x8*)(QSL + (it * 32 + lr) * 272 + (s8 * 16 + 8 * lh) * 2);
                      const bf16x8 bb = *(const LAS bf16x8*)(SPL + (vt * 32 + lr) * 272 + (s8 * 16 + 8 * lh) * 2);
                      acc = __builtin_amdgcn_mfma_f32_32x32x16_bf16(a, bb, acc, 0, 0, 0); }
#pragma unroll
                  for (int r = 0; r < 16; ++r) { float q2 = acc[r] * acc[r];
                      q2 = xsum16(rowsum16(q2));
                      if (lr == 0) SSQ[vt * 64 + it * 32 + 8 * (r >> 2) + 4 * lh + (r & 3)] = q2; }
                  __syncthreads();
                  const int colg = col0 + vt * 32 + lr;
#pragma unroll
                  for (int r = 0; r < 16; ++r) { const int ii = it * 32 + 8 * (r >> 2) + 4 * lh + (r & 3);
                      const float ss = SSQ[ii] + SSQ[64 + ii] + SSQ[128 + ii] + SSQ[192 + ii]; const float rn = 1.0f / sqrtf(ss * (1.f / 128.f) + 1e-6f);
                      YAB[(row0 + ii) * 2048 + colg] = (bf16)(pk2(acc[r] * rn * gg * gav[r], 0.f) & 0xffffu); }
                }
                __syncthreads();
            }
        }
#undef HC_REQ
        PHASE_END
        } else {
        PHASE_BEGIN
        for (int ub = blk * NWAVES; ub < 2048; ub += NGW) {
            const int unit = ub + wave;
            const int b = ub >> 9, j = unit & 511, lr = lane & 31, lh = lane >> 5;
            const int qsel = (lr >> 2) & 1, head = (lr >> 3) * 4 + (lr & 3);
            const int qlo = 4 * j, qhi = 4 * (1023 - j);
            const int nlo = ((qlo >> 6) + 1) * 64, nhi = ((qhi >> 6) + 1) * 64;
            const int nlo8 = (nlo + 511) & ~511, nhi8 = (nhi + 511) & ~511;
            const int nmax8 = (((((4 * (1023 - (ub & 511))) >> 6) + 1) * 64) + 511) & ~511;
            bf16x8 A[4][4]; float W[4][16]; typedef float f32x2_t __attribute__((ext_vector_type(2)));
#pragma unroll
            for (int p = 0; p < 4; ++p) { const size_t qb = (size_t)b * SEQ + (p < 2 ? qlo + 2 * p : qhi + 2 * (p - 2));
#pragma unroll
                for (int ks = 0; ks < 4; ++ks) A[p][ks] = *(const bf16x8*)(QIDX + (qb + qsel) * 1024 + head * 64 + ks * 16 + lh * 8);
#pragma unroll
                for (int r4 = 0; r4 < 4; ++r4) { const f32x4 w = *(const f32x4*)(IDXW + (qb + lh) * 16 + r4 * 4); W[p][r4 * 4] = w[0]; W[p][r4 * 4 + 1] = w[1]; W[p][r4 * 4 + 2] = w[2]; W[p][r4 * 4 + 3] = w[3]; } }
            const bf16* kb = KIDX + (size_t)b * SEQ * 64;
            const int srow = 8 * wave + (lane >> 3), spc = ((lane & 7) ^ ((srow >> 1) & 7)) * 8;
#define P4_STAGE(C0_, BUF_) do { _Pragma("unroll") for (int i = 0; i < 4; ++i) \
                __builtin_amdgcn_global_load_lds((const unsigned*)(kb + (size_t)((C0_) + 64 * i + srow) * 64 + spc), (LAS unsigned*)(lds + (BUF_) * 32768 + (i * 8 + wave) * 1024), 16, 0, 0); } while (0)
            P4_STAGE(0, 0);
            asm volatile("s_waitcnt vmcnt(0)" ::: "memory");
            __syncthreads();
            for (int c0 = 0; c0 < nmax8; c0 += 256) {
                const int cb = (c0 >> 8) & 1; const bool more = c0 + 256 < nmax8;
                if (more) P4_STAGE(c0 + 256, cb ^ 1);
                LAS unsigned char* kbuf = lds + cb * 32768;
#pragma unroll 1
                for (int tl = 0; tl < 8; ++tl) {
                    const int s0 = c0 + tl * 32;
                    if (s0 >= nhi8) break;
#pragma unroll
                    for (int p = 0; p < 4; ++p) { const int np = p < 2 ? nlo : nhi, np8 = p < 2 ? nlo8 : nhi8;
                        if (s0 >= np && s0 < np8) { const size_t q = (size_t)b * SEQ + (p < 2 ? qlo + 2 * p : qhi + 2 * (p - 2)) + lh; ISC[q * 4096 + s0 + lr] = (_Float16)(-60000.0f); } }
                    if (s0 >= nhi) continue;
                    bf16x8 B[4];
#pragma unroll
                    for (int ks = 0; ks < 4; ++ks) B[ks] = *(const LAS bf16x8*)(kbuf + (tl * 32 + lr) * 128 + (((2 * ks + lh) ^ ((lr >> 1) & 7)) * 16));
#define IDX_FINISH(P_, ACC_) do { f32x2_t s2_ = {0.f, 0.f};     \
                        _Pragma("unroll") for (int r = 0; r < 16; r += 2) { const float a0_ = ACC_[r], a1_ = ACC_[r + 1]; const int i0_ = __builtin_bit_cast(int, a0_), i1_ = __builtin_bit_cast(int, a1_); \
                            const f32x2_t rl_ = {__builtin_bit_cast(float, i0_ > 0 ? i0_ : 0), __builtin_bit_cast(float, i1_ > 0 ? i1_ : 0)}; const f32x2_t w_ = {W[P_][r], W[P_][r + 1]}; \
                            s2_ = __builtin_elementwise_fma(rl_, w_, s2_); } \
                        const float sc_ = s2_[0] + s2_[1]; \
                        const size_t q_ = (size_t)b * SEQ + ((P_) < 2 ? qlo + 2 * (P_) : qhi + 2 * ((P_) - 2)) + lh; ISC[q_ * 4096 + s0 + lr] = (_Float16)sc_; } while (0)
                    if (s0 < nlo) {
                        f32x16 c0_, c1_, c2_, c3_;
#pragma unroll
                        for (int r = 0; r < 16; ++r) { c0_[r] = 0.f; c1_[r] = 0.f; c2_[r] = 0.f; c3_[r] = 0.f; }
#pragma unroll
                        for (int ks = 0; ks < 4; ++ks) { c0_ = __builtin_amdgcn_mfma_f32_32x32x16_bf16(A[0][ks], B[ks], c0_, 0, 0, 0); c1_ = __builtin_amdgcn_mfma_f32_32x32x16_bf16(A[1][ks], B[ks], c1_, 0, 0, 0);
                            c2_ = __builtin_amdgcn_mfma_f32_32x32x16_bf16(A[2][ks], B[ks], c2_, 0, 0, 0); c3_ = __builtin_amdgcn_mfma_f32_32x32x16_bf16(A[3][ks], B[ks], c3_, 0, 0, 0); }
                        IDX_FINISH(0, c0_); IDX_FINISH(1, c1_); IDX_FINISH(2, c2_); IDX_FINISH(3, c3_);
                    } else {
                        f32x16 c2_, c3_;
#pragma unroll
                        for (int r = 0; r < 16; ++r) { c2_[r] = 0.f; c3_[r] = 0.f; }
#pragma unroll
                        for (int ks = 0; ks < 4; ++ks) { c2_ = __builtin_amdgcn_mfma_f32_32x32x16_bf16(A[2][ks], B[ks], c2_, 0, 0, 0); c3_ = __builtin_amdgcn_mfma_f32_32x32x16_bf16(A[3][ks], B[ks], c3_, 0, 0, 0); }
                        IDX_FINISH(2, c2_); IDX_FINISH(3, c3_);
                    }
#undef IDX_FINISH
                }
                asm volatile("s_waitcnt vmcnt(0)" ::: "memory");
                __syncthreads();
            }
        }
#undef P4_STAGE
        PHASE_END
        }
        __syncthreads();
        }
        GRID_BAR();
        for (int rep_ = 0; rep_ < REP_P5; ++rep_) {
        PHASE_BEGIN
        {
            LAS unsigned char* VB = lds + wave * 18432;
            LAS unsigned short* SELW = (LAS unsigned short*)(VB + 17408);
            const int hd = lane & 15, g = lane >> 4, qq = hd >> 2, pp = hd & 3;
            const float slope = exp2f(-0.5f * (float)(hd + 1));
            for (int q = gw; q < M; q += NGW) {
                const int b = q / SEQ, pos = q % SEQ, qc = pos >> 6; const int nsel = qc < 4 ? (qc + 1) * 64 : 256;
                for (int rtk_ = 0; rtk_ < REP_TOPK; ++rtk_) {
                int lane_t = lane; asm volatile("" : "+v"(lane_t));
                if (qc < 4) { const unsigned e0 = 4 * lane_t; const bool ok = 4 * lane_t < nsel; v2u z; z.x = ok ? (e0 | ((e0 + 1) << 16)) : 0u; z.y = ok ? ((e0 + 2) | ((e0 + 3) << 16)) : 0u; *(LAS v2u*)(SELW + 4 * lane_t) = z; }
                else {
                    LAS unsigned* HIST = (LAS unsigned*)VB;
                    const int nb8 = (qc + 8) >> 3;
                    float v[64];
                    { unsigned pk[32]; const int i2max = 4 * nb8 - 1; const _Float16* irow = ISC + (size_t)q * 4096 + 2 * lane_t; typedef _Float16 h2_t __attribute__((ext_vector_type(2)));
#pragma unroll
                      for (int i2 = 0; i2 < 32; ++i2) { const int ic = i2 < i2max ? i2 : i2max; pk[i2] = *(const unsigned*)(irow + ic * 128); }
#pragma unroll
                      for (int i2 = 0; i2 < 32; ++i2) { const float lim = (i2 >> 2) < nb8 ? 3.0e38f : -1.0e30f; const h2_t h = __builtin_bit_cast(h2_t, pk[i2]);
                          const float f0 = (float)h[0], f1 = (float)h[1]; v[2 * i2] = fminf(f0, lim); v[2 * i2 + 1] = fminf(f1, lim); } }
                    float vmx = v[0], vmn = fminf(fminf(v[0], v[1]), fminf(v[2], v[3]));
#pragma unroll
                    for (int i = 1; i < 64; ++i) vmx = fmaxf(vmx, v[i]);
                    vmx = wmax_f(vmx); vmn = -wmax_f(-vmn);
                    const float rng = vmx - vmn; const float s20 = rng > 0.f ? 1048574.0f / rng : 0.f;
#define ZERO_HIST() do { *(LAS v4u*)(HIST + 16 * lane) = (v4u){0u, 0u, 0u, 0u}; *(LAS v4u*)(HIST + 16 * lane + 4) = (v4u){0u, 0u, 0u, 0u}; *(LAS v4u*)(HIST + 16 * lane + 8) = (v4u){0u, 0u, 0u, 0u}; \
                        *(LAS v4u*)(HIST + 16 * lane + 12) = (v4u){0u, 0u, 0u, 0u}; HIST[1024 + lane] = 0u; } while (0)
#define SCAN_HIST(R_, BIN_, AB_) do { unsigned hh_[16]; const int hb_ = 1008 - 16 * lane; \
                        { const v4u h0 = *(const LAS v4u*)(HIST + hb_), h1 = *(const LAS v4u*)(HIST + hb_ + 4), h2 = *(const LAS v4u*)(HIST + hb_ + 8), h3 = *(const LAS v4u*)(HIST + hb_ + 12); \
                          hh_[0] = h0.x; hh_[1] = h0.y; hh_[2] = h0.z; hh_[3] = h0.w; hh_[4] = h1.x; hh_[5] = h1.y; hh_[6] = h1.z; hh_[7] = h1.w; hh_[8] = h2.x; hh_[9] = h2.y; hh_[10] = h2.z; hh_[11] = h2.w; hh_[12] = h3.x; hh_[13] = h3.y; hh_[14] = h3.z; hh_[15] = h3.w; } \
                        unsigned tot_ = 0u; _Pragma("unroll") for (int k = 0; k < 16; ++k) tot_ += hh_[k]; \
                        unsigned run_ = wprefix_u(tot_) - tot_; int fb_ = -1; unsigned fa_ = 0u; \
                        _Pragma("unroll") for (int k = 15; k >= 0; --k) { if (run_ < (R_) && run_ + hh_[k] >= (R_)) { fb_ = hb_ + k; fa_ = run_; } run_ += hh_[k]; } \
                        const unsigned long long bm_ = __ballot(fb_ >= 0); const int L_ = (int)__builtin_ctzll(bm_); \
                        BIN_ = (unsigned)__builtin_amdgcn_readlane(fb_, L_); AB_ = (unsigned)__builtin_amdgcn_readlane((int)fa_, L_); } while (0)
                    ZERO_HIST();
#pragma unroll
                    for (int i = 0; i < 64; ++i) v[i] = __builtin_bit_cast(float, (unsigned)((v[i] - vmn) * s20));
#define cd(i_) __builtin_bit_cast(unsigned, v[i_])
#pragma unroll
                    for (int g8 = 0; g8 < 8; ++g8) { if (g8 < nb8) {
#pragma unroll
                        for (int j = 0; j < 8; ++j) __hip_atomic_fetch_add(HIST + (cd(g8 * 8 + j) >> 10), 1u, __ATOMIC_RELAXED, __HIP_MEMORY_SCOPE_WORKGROUP); } }
                    LDS_WAIT(); asm volatile("" ::: "memory");
                    unsigned tb, above; SCAN_HIST(256u, tb, above);
                    ZERO_HIST();
                    LDS_WAIT(); asm volatile("" ::: "memory");
#pragma unroll
                    for (int g8 = 0; g8 < 8; ++g8) { if (g8 < nb8) {
#pragma unroll
                        for (int j = 0; j < 8; ++j) { const unsigned c = cd(g8 * 8 + j); const unsigned a = (c >> 10) == tb ? (c & 1023u) : 1024u + lane; __hip_atomic_fetch_add(HIST + a, 1u, __ATOMIC_RELAXED, __HIP_MEMORY_SCOPE_WORKGROUP); } } }
                    LDS_WAIT(); asm volatile("" ::: "memory");
                    unsigned tb2, ab2; { const unsigned R2 = 256u - above; SCAN_HIST(R2, tb2, ab2); }
                    const unsigned T = (tb << 10) | tb2; above += ab2;
                    unsigned baseg = 0u, basee = above;
#pragma unroll
                    for (int g8 = 0; g8 < 8; ++g8) { if (g8 < nb8) {
#pragma unroll
                        for (int j = 0; j < 8; ++j) { const int i = g8 * 8 + j;
                            const bool gt = cd(i) > T; const unsigned long long bg = __ballot(gt);
                            const unsigned pgp = baseg + __builtin_amdgcn_mbcnt_hi((unsigned)(bg >> 32), __builtin_amdgcn_mbcnt_lo((unsigned)bg, 0u));
                            if (gt) SELW[pgp] = (unsigned short)((i >> 1) * 128 + (i & 1) + 2 * lane);
                            baseg += (unsigned)__popcll(bg);
                            const bool eq = cd(i) == T; const unsigned long long be = __ballot(eq);
                            if (be) { const unsigned pep = basee + __builtin_amdgcn_mbcnt_hi((unsigned)(be >> 32), __builtin_amdgcn_mbcnt_lo((unsigned)be, 0u));
                                if (eq && pep < 256u) SELW[pep] = (unsigned short)((i >> 1) * 128 + (i & 1) + 2 * lane);
                                basee += (unsigned)__popcll(be); } } } }
#undef cd
#undef ZERO_HIST
#undef SCAN_HIST
                }
                LDS_WAIT(); asm volatile("" ::: "memory");
                }
                for (int rat_ = 0; rat_ < REP_ATT; ++rat_) {
                bf16* qrow = QB + (size_t)q * 4096;
                bf16x8 Bq[8];
#pragma unroll
                for (int ks = 0; ks < 8; ++ks) Bq[ks] = *(const bf16x8*)(qrow + hd * 256 + ks * 32 + g * 8);
                const bf16* kvb = CKV + (size_t)b * SEQ * 256;
                f32x4 O[16];
#pragma unroll
                for (int ct = 0; ct < 16; ++ct) O[ct] = (f32x4){0.f, 0.f, 0.f, 0.f};
                float mrun = -1.0e30f, lsum = 0.f;
                LDS_WAIT(); asm volatile("" ::: "memory");
                const int nks = nsel >> 5;
                const int lrow = lane >> 5, lcp = lane & 31, lsh = 16 * lrow;
                v4u KR[16];
#define ATT_IDX(KST_) v4u iw_[4]; _Pragma("unroll") for (int c = 0; c < 4; ++c) iw_[c] = *(const LAS v4u*)(SELW + 32 * (KST_) + 8 * c)
#define ATT_LOADROWS(KST_) do { ATT_IDX(KST_); _Pragma("unroll") for (int i = 0; i < 16; ++i) { const int rr_ = 2 * i + lrow; const unsigned w_ = iw_[i >> 2][i & 3]; const int ix_ = (int)((w_ >> lsh) & 0xffffu); \
                    KR[i] = *(const v4u*)(kvb + (size_t)ix_ * 256 + ((lcp ^ (rr_ & 7)) * 8)); } } while (0)
                ATT_LOADROWS(0);
                const int rlA = hd & 7;
                const int rlT = (4 * g + qq) & 7;
                const int trb = (4 * g + qq) * 512 + 8 * (pp & 1), trm = 16 * ((pp >> 1) ^ rlT);
                for (int kst = 0; kst < nks; ++kst) {
                    int rlA_ = rlA, trm_ = trm; asm volatile("" : "+v"(rlA_), "+v"(trm_));
                    if (kst + 1 < nks) {
                        ATT_IDX(kst + 1);
#pragma unroll
                        for (int i = 0; i < 16; ++i) { *(LAS v4u*)(VB + i * 1024 + lane * 16) = KR[i];
                            const int rr_ = 2 * i + lrow; const unsigned w_ = iw_[i >> 2][i & 3]; const int ix_ = (int)((w_ >> lsh) & 0xffffu); KR[i] = *(const v4u*)(kvb + (size_t)ix_ * 256 + ((lcp ^ (rr_ & 7)) * 8)); }
                    } else {
#pragma unroll
                        for (int i = 0; i < 16; ++i) *(LAS v4u*)(VB + i * 1024 + lane * 16) = KR[i]; }
                    LDS_WAIT(); asm volatile("" ::: "memory");
                    f32x4 S0 = {0.f, 0.f, 0.f, 0.f}, S1 = {0.f, 0.f, 0.f, 0.f};
#pragma unroll
                    for (int k4 = 0; k4 < 4; ++k4) {
                        bf16x8 a0[2], a1[2];
#pragma unroll
                        for (int j = 0; j < 2; ++j) { const int ks = k4 * 2 + j; const int cpos = (4 * ks + g) ^ rlA_;
                            a0[j] = *(const LAS bf16x8*)(VB + hd * 512 + cpos * 16); a1[j] = *(const LAS bf16x8*)(VB + (16 + hd) * 512 + cpos * 16); }
#pragma unroll
                        for (int j = 0; j < 2; ++j) { const int ks = k4 * 2 + j;
                            S0 = __builtin_amdgcn_mfma_f32_16x16x32_bf16(a0[j], Bq[ks], S0, 0, 0, 0); S1 = __builtin_amdgcn_mfma_f32_16x16x32_bf16(a1[j], Bq[ks], S1, 0, 0, 0); }
                    }
                    const v2u pa = *(const LAS v2u*)(SELW + 32 * kst + 4 * g), pb = *(const LAS v2u*)(SELW + 32 * kst + 16 + 4 * g);
                    const float fp = (float)pos;
                    float s0[4], s1[4];
                    s0[0] = S0[0] - slope * fabsf(fp - (float)(pa.x & 0xffffu)); s0[1] = S0[1] - slope * fabsf(fp - (float)(pa.x >> 16));
                    s0[2] = S0[2] - slope * fabsf(fp - (float)(pa.y & 0xffffu)); s0[3] = S0[3] - slope * fabsf(fp - (float)(pa.y >> 16));
                    s1[0] = S1[0] - slope * fabsf(fp - (float)(pb.x & 0xffffu)); s1[1] = S1[1] - slope * fabsf(fp - (float)(pb.x >> 16));
                    s1[2] = S1[2] - slope * fabsf(fp - (float)(pb.y & 0xffffu)); s1[3] = S1[3] - slope * fabsf(fp - (float)(pb.y >> 16));
                    float ml = fmaxf(fmaxf(fmaxf(s0[0], s0[1]), fmaxf(s0[2], s0[3])), fmaxf(fmaxf(s1[0], s1[1]), fmaxf(s1[2], s1[3])));
                    ml = xmax16(ml); ml = xmax32(ml);
                    const float mnew = fmaxf(mrun, ml), alpha = __expf(mrun - mnew); mrun = mnew;
                    float p0[4], p1[4];
#pragma unroll
                    for (int r = 0; r < 4; ++r) { p0[r] = __expf(s0[r] - mnew); p1[r] = __expf(s1[r] - mnew); }
                    lsum = lsum * alpha + ((p0[0] + p0[1]) + (p0[2] + p0[3])) + ((p1[0] + p1[1]) + (p1[2] + p1[3]));
                    v4u pw; pw.x = pk2(p0[0], p0[1]); pw.y = pk2(p0[2], p0[3]); pw.z = pk2(p1[0], p1[1]); pw.w = pk2(p1[2], p1[3]);
                    const bf16x8 Pf = __builtin_bit_cast(bf16x8, pw);
#pragma unroll
                    for (int ct = 0; ct < 16; ++ct) O[ct] = O[ct] * alpha;
#pragma unroll
                    for (int c8 = 0; c8 < 4; ++c8) {
                        v4s lo[4], hi[4];
#pragma unroll
                        for (int j = 0; j < 4; ++j) { const int ct = c8 * 4 + j; const int off = trb + ((32 * ct) ^ trm_);
                            lo[j] = __builtin_amdgcn_ds_read_tr16_b64_v4i16((LAS v4s*)(VB + off));
                            hi[j] = __builtin_amdgcn_ds_read_tr16_b64_v4i16((LAS v4s*)(VB + 16 * 512 + off)); }
#pragma unroll
                        for (int j = 0; j < 4; ++j) { const int ct = c8 * 4 + j;
                            const bf16x8 Af = {lo[j][0], lo[j][1], lo[j][2], lo[j][3], hi[j][0], hi[j][1], hi[j][2], hi[j][3]};
                            O[ct] = __builtin_amdgcn_mfma_f32_16x16x32_bf16(Af, Pf, O[ct], 0, 0, 0); }
                    }
                    LDS_WAIT(); asm volatile("" ::: "memory");
                }
#undef ATT_LOADROWS
#undef ATT_IDX
                lsum = xsum16(lsum); lsum = xsum32(lsum);
                const float inv = 1.0f / lsum;
#pragma unroll
                for (int ct = 0; ct < 16; ++ct) { const f32x4 o = O[ct] * inv; v2u w; w.x = pk2(o[0], o[1]); w.y = pk2(o[2], o[3]); *(v2u*)(OB + (size_t)q * 4096 + hd * 256 + 16 * ct + 4 * g) = w; }
                }
            }
        }
        PHASE_END
        GRID_BAR();
        }
        PHASE_BEGIN
        { pg8::Gemm g{OB, W6, M, 1024, 1024, 4096, 1024, 1024}; pg8::StaticOrder S; S.init(M, 1024, G, blk);
          EpiBf E{YAB, 2048, 1024}; pg8::gemm_phase(lds, g, S, E, tid); }
        PHASE_END
        GRID_BAR();
        PHASE_BEGIN
        { pg8::Gemm g{YAB, W7, M, DM, DM, DM, DM, 0, 1}; pg8::StaticOrder S; S.init(M, DM, G, blk);
          EpiGateM E{GTA, MRG}; HookGate Hk{GTB, GTA}; pg8::gemm_phase(lds, g, S, E, tid, Hk); }
        PHASE_END
        GRID_BAR();
        PHASE_BEGIN
        { pg8::Gemm g{MRG, W8, M, DM, DM, DM, DM, 0, 1}; pg8::StaticOrder S; S.init(M, DM, G, blk);
          S.mode = 1;
          EpiLn<0, false> E{ws, (l == 0) ? x_in : (const float*)nullptr, (float*)nullptr, ln1_g + l * DM, ln1_b + l * DM, lds, l};
          pg8::gemm_phase(lds, g, S, E, tid); }
        PHASE_END
        GRID_BAR();
        PHASE_BEGIN
        { pg8::Gemm g{HB, W10, M, N10, DM, DM, DM, 0}; pg8::StaticOrder S; S.init(M, N10, G, blk);
          EpiSwiglu E{ACT}; pg8::gemm_phase(lds, g, S, E, tid); }
        PHASE_END
        GRID_BAR();
        if (l == DEPTH - 1) {
        PHASE_BEGIN
        { pg8::Gemm g{ACT, W11, M, DM, DFF, DFF, DFF, 0, 1}; pg8::StaticOrder S; S.init(M, DM, G, blk); S.mode = 1;
          EpiLn<1, true> E{ws, (const float*)nullptr, args.out, ln2_g + l * DM, ln2_b + l * DM, lds, l}; pg8::gemm_phase(lds, g, S, E, tid); }
        PHASE_END
        } else {
        PHASE_BEGIN
        { pg8::Gemm g{ACT, W11, M, DM, DFF, DFF, DFF, 0, 1}; pg8::StaticOrder S; S.init(M, DM, G, blk); S.mode = 1;
          EpiLn<1, false> E{ws, (const float*)nullptr, (float*)nullptr, ln2_g + l * DM, ln2_b + l * DM, lds, l}; pg8::gemm_phase(lds, g, S, E, tid); }
        PHASE_END
        }
        if (l + 1 < DEPTH) {
            GRID_BAR();
            PHASE_BEGIN
            { CONVERT_LAYER(l + 1); }
            PHASE_END
            GRID_BAR();
        }
    }
}

extern "C" void kernel_launch(void* const* d_in, const int* in_sizes, int n_in, void* d_out, int out_size, void* d_ws, size_t ws_size, hipStream_t stream) {
    static int grid = 0;
    if (grid == 0) {
        if (n_in != 22 || out_size != M * DM || ws_size < WS_END) { fprintf(stderr, "kernel_launch: unexpected shapes (n_in %d, out %d, ws %zu < %zu)\n", n_in, out_size, ws_size, (size_t)WS_END); grid = -1; return; }
        int dev = 0, cus = 0, per_cu = 0;
        if (hipGetDevice(&dev) != hipSuccess || hipDeviceGetAttribute(&cus, hipDeviceAttributeMultiprocessorCount, dev) != hipSuccess) { grid = -1; return; }
        if (hipFuncSetAttribute((const void*)fwd_kernel, hipFuncAttributeMaxDynamicSharedMemorySize, LDS_BYTES) != hipSuccess) { fprintf(stderr, "kernel_launch: hipFuncSetAttribute failed\n"); grid = -1; return; }
        if (hipOccupancyMaxActiveBlocksPerMultiprocessor(&per_cu, (const void*)fwd_kernel, NTHR, LDS_BYTES) != hipSuccess || per_cu < 1) { fprintf(stderr, "kernel_launch: occupancy query says %d\n", per_cu); }
        (void)hipGetLastError();
        if (cus % 64 != 0) { fprintf(stderr, "kernel_launch: %d CUs: the fused-LayerNorm unit order needs a multiple of 64 workgroups\n", cus); grid = -1; return; }
        grid = cus;
    }
    if (grid < 0) return;
    if (hipMemsetAsync((char*)d_ws + WS_CTL, 0, CTL_ZERO_BYTES, stream) != hipSuccess) return;
    Args a{};
    for (int i = 0; i < 22; ++i) a.in[i] = (const float*)d_in[i];
    a.out = (float*)d_out; a.ws = (unsigned char*)d_ws;
    hipLaunchKernelGGL(fwd_kernel, dim3(grid), dim3(NTHR), LDS_BYTES, stream, a);
}
```

```cpp
#include <hip/hip_runtime.h>
#include <cstdio>
#include <cstdint>

namespace pg8 {
#define PG8_LAS __attribute__((address_space(3)))
typedef unsigned short bf16_t;
typedef short bf16x8 __attribute__((ext_vector_type(8)));
typedef float f32x4 __attribute__((ext_vector_type(4)));
typedef unsigned u32x4 __attribute__((ext_vector_type(4)));
constexpr int BM = 256, BK = 64, HALF = 128, HTB = HALF * BK * 2, STAGE_BYTES = 8 * HTB, NXCD = 8, WGM = 8;

__host__ __device__ __forceinline__ int lds_byte(int r, int c) { const int st = (r >> 4) * 2 + (c >> 5), rr = r & 15, cc = c & 31, ob = rr * 64 + cc * 2; return st * 1024 + (ob ^ (((ob >> 9) & 1) << 5)); }
__host__ __device__ __forceinline__ void stage_rc(int b, int& R, int& C) { const int st = b / 1024, sb = b % 1024, swz = sb ^ (((sb >> 9) & 1) << 5); R = (st >> 1) * 16 + swz / 64; C = (st & 1) * 32 + (swz % 64) / 2; }
__host__ __device__ __forceinline__ int perm32(int rho) { const int n = rho >> 4, i = rho & 15; return 8 * (i >> 2) + 4 * n + (i & 3); }

struct Unit { int pm, pn; };
struct Gemm { const bf16_t* A; const bf16_t* Bt; int M, N, K, lda, ldb, a_pn_stride; int krev = 0; };

struct StaticOrder {
    int nM, nN, nwg, G, c, mode;
    __host__ __device__ void init(int M, int N, int G_, int c_) { nM = M / BM; nN = N / BM; nwg = nM * nN; G = G_; c = c_; mode = 0; }
    __host__ __device__ bool next(int i, Unit& u) const {
        if (mode == 1) {
            const int PR = G >> 3, x = c & 7, j = c >> 3, pq = PR >> 3, nx = nM >> 3; if (i * pq + (j >> 3) >= nx) return false; u.pm = x * nx + i * pq + (j >> 3); u.pn = j & 7; return true; }
        const long L = (long)i * G + c; if (L >= nwg) return false;
        int wgid = (int)L; { const int q = nwg / NXCD, r = nwg % NXCD, xcd = wgid % NXCD, off = wgid / NXCD; wgid = (xcd < r ? xcd * (q + 1) : r * (q + 1) + (xcd - r) * q) + off; }
        const int nig = WGM * nN, gid = wgid / nig, fm = gid * WGM, gsz = (nM - fm) < WGM ? (nM - fm) : WGM;
        u.pm = fm + ((wgid % nig) % gsz); u.pn = (wgid % nig) / gsz; return true;
    }
};

typedef float f32x2_t __attribute__((ext_vector_type(2))); typedef __bf16 bf16x2_t __attribute__((ext_vector_type(2)));
__device__ __forceinline__ unsigned cvt_pk_bf16(float lo, float hi) { f32x2_t v = {lo, hi}; bf16x2_t b = __builtin_convertvector(v, bf16x2_t); return __builtin_bit_cast(unsigned, b); }

struct NoHook { static constexpr bool ON = false; template <class A> __device__ __forceinline__ void mid(A&, const Unit&, int, int, int, int) const {} };
template <class Epi, class Hook = NoHook>
__device__ __forceinline__ void gemm_phase(PG8_LAS unsigned char* lds, const Gemm g, const StaticOrder& S, const Epi& E, const int tid, const Hook H = Hook()) {
    const int wid = __builtin_amdgcn_readfirstlane(tid >> 6), lane = tid & 63, wr = wid >> 2, wc = wid & 3, fr = lane & 15, fq = lane >> 4;
    const int K = g.K, nt = K / BK;
    unsigned voffA[2], voffB[2];
#pragma unroll
    for (int i = 0; i < 2; ++i) { int R, C; stage_rc(tid * 16 + i * 8192, R, C); const int Rb = 64 * (R >> 5) + perm32(R & 31);
        voffA[i] = (unsigned)(R * g.lda + C) * 2u; voffB[i] = (unsigned)(Rb * g.ldb + C) * 2u; }
    const long kstep = g.krev ? -(long)(BK * 2) : (long)(BK * 2); const size_t kbase = g.krev ? (size_t)(nt - 1) * (BK * 2) : 0;
    const size_t hstepA = (size_t)HALF * g.lda * 2, hstepB = (size_t)32 * g.ldb * 2;
    const size_t tstepA = 2 * hstepA, tstepB = (size_t)BM * g.ldb * 2;
    const unsigned ldsw = (unsigned)wid * 1024u;
    const int aoff = lds_byte(wr * 64 + fr, fq * 8), boff = lds_byte(wc * 32 + fr, fq * 8);
#define PG8_SA(b, h) (((b) * 2 + (h)) * HTB)
#define PG8_SB(b, h) ((4 + (b) * 2 + (h)) * HTB)
#define PG8_STAGE(bufoff, gbase, voff) do { _Pragma("unroll") for (int _i = 0; _i < 2; ++_i) \
        __builtin_amdgcn_global_load_lds((const unsigned*)((const char*)(gbase) + (voff)[_i]), (PG8_LAS unsigned*)(lds + (bufoff) + ldsw + _i * 8192), 16, 0, 0); } while (0)
#define PG8_LDA(dst, b, h) do { _Pragma("unroll") for (int m = 0; m < 4; ++m) _Pragma("unroll") for (int k = 0; k < 2; ++k) dst[m][k] = *(const PG8_LAS bf16x8*)(lds + PG8_SA(b, h) + aoff + m * 2048 + k * 1024); } while (0)
#define PG8_LDB(dst, b, h) do { _Pragma("unroll") for (int n = 0; n < 2; ++n) _Pragma("unroll") for (int k = 0; k < 2; ++k) dst[n][k] = *(const PG8_LAS bf16x8*)(lds + PG8_SB(b, h) + boff + n * 2048 + k * 1024); } while (0)
#define PG8_MMA(ai, bj, At, Bt) do { __builtin_amdgcn_s_setprio(1); _Pragma("unroll") for (int m = 0; m < 4; ++m) _Pragma("unroll") for (int n = 0; n < 2; ++n) _Pragma("unroll") for (int k = 0; k < 2; ++k) \
        acc[ai][bj][m][n] = __builtin_amdgcn_mfma_f32_16x16x32_bf16(Bt[n][k], At[m][k], acc[ai][bj][m][n], 0, 0, 0); __builtin_amdgcn_s_setprio(0); } while (0)
#define PG8_WAIT_V(n) asm volatile("s_waitcnt vmcnt(" #n ")" ::: "memory")
#define PG8_WAIT_L(n) asm volatile("s_waitcnt lgkmcnt(" #n ")" ::: "memory")
#define PG8_BAR __builtin_amdgcn_s_barrier()
#define PG8_SCHED __builtin_amdgcn_sched_barrier(0)
    Unit cur, nxt; int ui = 0;
    if (!S.next(0, cur)) return;
    f32x4 acc[2][2][4][2];
#pragma unroll
    for (int a = 0; a < 2; ++a)
#pragma unroll
        for (int b = 0; b < 2; ++b)
#pragma unroll
            for (int m = 0; m < 4; ++m)
#pragma unroll
                for (int n = 0; n < 2; ++n) acc[a][b][m][n] = (f32x4){0.f, 0.f, 0.f, 0.f};
    bf16x8 At[4][2], B0[2][2], B1[2][2];
    const char* cA = (const char*)g.A + (size_t)cur.pm * tstepA + (size_t)cur.pn * g.a_pn_stride * 2 + kbase; const char* cB = (const char*)g.Bt + (size_t)cur.pn * tstepB + kbase;
    PG8_STAGE(PG8_SB(0, 0), cB, voffB); PG8_STAGE(PG8_SB(0, 1), cB + hstepB, voffB); PG8_STAGE(PG8_SA(0, 0), cA, voffA); PG8_STAGE(PG8_SA(0, 1), cA + hstepA, voffA);
    if (wr == 1) PG8_BAR;
    PG8_WAIT_V(2); PG8_BAR;
    PG8_STAGE(PG8_SB(1, 0), cB + kstep, voffB); PG8_STAGE(PG8_SA(1, 0), cA + kstep, voffA); PG8_STAGE(PG8_SB(1, 1), cB + hstepB + kstep, voffB);
    PG8_WAIT_V(6); PG8_BAR;
    for (;;) {
        const bool has_next = S.next(ui + 1, nxt);
        const char* nA = has_next ? (const char*)g.A + (size_t)nxt.pm * tstepA + (size_t)nxt.pn * g.a_pn_stride * 2 + kbase : cA; const char* nB = has_next ? (const char*)g.Bt + (size_t)nxt.pn * tstepB + kbase : cB;
        for (int t = 0; t < nt; t += 2) {
            const bool last = (t == nt - 2);
            const char* a1 = cA + (long)(t + 1) * kstep;
            const char* a2 = last ? nA : cA + (long)(t + 2) * kstep; const char* b2 = last ? nB : cB + (long)(t + 2) * kstep;
            const char* a3 = a2 + kstep; const char* b3 = b2 + kstep;
            if constexpr (Hook::ON) { if (t == (nt >> 1)) H.mid(acc, cur, wr, wc, fr, fq); }
            PG8_LDB(B0, 0, 0); PG8_LDB(B1, 0, 1); PG8_SCHED; PG8_LDA(At, 0, 0); PG8_STAGE(PG8_SA(1, 1), a1 + hstepA, voffA);
            PG8_WAIT_V(8); PG8_WAIT_L(0); PG8_BAR; PG8_MMA(0, 0, At, B0); PG8_MMA(0, 1, At, B1); PG8_BAR; PG8_SCHED;
            PG8_LDA(At, 0, 1); PG8_STAGE(PG8_SB(0, 0), b2, voffB); PG8_STAGE(PG8_SB(0, 1), b2 + hstepB, voffB); PG8_STAGE(PG8_SA(0, 0), a2, voffA);
            PG8_WAIT_V(8); PG8_WAIT_L(0); PG8_BAR; PG8_MMA(1, 0, At, B0); PG8_MMA(1, 1, At, B1); PG8_BAR; PG8_SCHED;
            PG8_LDB(B0, 1, 0); PG8_LDB(B1, 1, 1); PG8_SCHED; PG8_LDA(At, 1, 0); PG8_STAGE(PG8_SA(0, 1), a2 + hstepA, voffA);
            PG8_WAIT_V(8); PG8_WAIT_L(0); PG8_BAR; PG8_MMA(0, 0, At, B0); PG8_MMA(0, 1, At, B1); PG8_BAR; PG8_SCHED;
            PG8_LDA(At, 1, 1); PG8_STAGE(PG8_SB(1, 0), b3, voffB); PG8_STAGE(PG8_SB(1, 1), b3 + hstepB, voffB); PG8_STAGE(PG8_SA(1, 0), a3, voffA);
            PG8_WAIT_V(8); PG8_WAIT_L(0); PG8_BAR; PG8_MMA(1, 0, At, B0); PG8_MMA(1, 1, At, B1); PG8_BAR; PG8_SCHED;
        }
        if (wr == 0) PG8_BAR;
        E(acc, cur, wr, wc, fr, fq);
        if (!has_next) break;
#pragma unroll
        for (int a = 0; a < 2; ++a)
#pragma unroll
            for (int b = 0; b < 2; ++b)
#pragma unroll
                for (int m = 0; m < 4; ++m)
#pragma unroll
                    for (int n = 0; n < 2; ++n) acc[a][b][m][n] = (f32x4){0.f, 0.f, 0.f, 0.f};
        cur = nxt; cA = nA; cB = nB; ++ui;
        if (wr == 1) PG8_BAR;
    }
    PG8_WAIT_V(0);
    PG8_BAR;
#undef PG8_SA
#undef PG8_SB
#undef PG8_STAGE
#undef PG8_LDA
#undef PG8_LDB
#undef PG8_MMA
#undef PG8_WAIT_V
#undef PG8_WAIT_L
#undef PG8_BAR
#undef PG8_SCHED
}
}

constexpr int NWAVES = 8, NTHR = NWAVES * 64;
constexpr int DM = 2048, NBATCH = 4, SEQ = 4096, DEPTH = 4, M = NBATCH * SEQ;
constexpr int HGW = 1024;
constexpr int SAH = 16, SAC = 256, SAR = 512;
constexpr int DFF = 5632;
constexpr int N1 = 9216, N3 = 5120, N10 = 2 * DFF;
constexpr float ALPHA = 1.6817928305074292f;
constexpr int MODW = 6 * DM;

constexpr size_t MiB = 1u << 20;
constexpr size_t WS_CTL = 0, CTL_ZERO_BYTES = 32768;
constexpr size_t WS_MOD = 1 * MiB;
constexpr size_t WS_LB = 2 * MiB;
constexpr size_t WS_MODP = 3 * MiB;
constexpr size_t WS_W1 = 9 * MiB;
constexpr size_t WS_W3 = WS_W1 + 36 * MiB;
constexpr size_t WS_W6 = WS_W3 + 5 * MiB;
constexpr size_t WS_W7 = WS_W6 + 2 * MiB;
constexpr size_t WS_W8 = WS_W7 + 8 * MiB;
constexpr size_t WS_W10 = WS_W8 + 8 * MiB;
constexpr size_t WS_W11 = WS_W10 + 44 * MiB;
constexpr size_t WS_X = WS_W11 + 22 * MiB;
constexpr size_t WS_R = WS_X + 128 * MiB;
constexpr size_t WS_H = WS_R + 128 * MiB;
constexpr size_t WS_QA = WS_H + 64 * MiB;
constexpr size_t WS_FA = WS_QA + 32 * MiB;
constexpr size_t WS_IA = WS_FA + 64 * MiB;
constexpr size_t WS_GA = WS_IA + 32 * MiB;
constexpr size_t WS_LAT = WS_GA + 32 * MiB;
constexpr size_t WS_GTA = WS_LAT + 64 * MiB;
constexpr size_t WS_GTB = WS_GTA + 64 * MiB;
constexpr size_t WS_CQN = WS_GTB + 64 * MiB;
constexpr size_t WS_CKV = WS_CQN + 16 * MiB;
constexpr size_t WS_KIDX = WS_CKV + 8 * MiB;
constexpr size_t WS_IDXW = WS_KIDX + 2 * MiB;
constexpr size_t WS_QB = WS_IDXW + 1 * MiB;
constexpr size_t WS_QIDX = WS_QB + 128 * MiB;
constexpr size_t WS_SEL = WS_QIDX + 32 * MiB;
constexpr size_t WS_YAB = WS_SEL + 8 * MiB;
constexpr size_t WS_MRG = WS_FA;
constexpr size_t WS_OB = WS_YAB + 64 * MiB;
constexpr size_t WS_BIG = WS_OB + 128 * MiB;
constexpr size_t WS_KSB = WS_BIG + 256 * MiB;
constexpr size_t WS_DEB = WS_KSB + 32 * MiB;
constexpr size_t WS_QSB = WS_DEB + 2 * MiB;
constexpr size_t WS_END = WS_QSB + 32 * MiB;

constexpr int CW_BAR = 4096;

constexpr int RING_BYTES = 131072;
constexpr int LDS_BYTES = 163840;
constexpr int LDSCTL_OFF = LDS_BYTES - 1024, MISC_OFF = LDSCTL_OFF + 320, SELL_OFF = 147456;

#define GAS __attribute__((address_space(1)))
#define LAS __attribute__((address_space(3)))
typedef unsigned short bf16;
typedef unsigned v4u __attribute__((ext_vector_type(4)));
typedef unsigned v2u __attribute__((ext_vector_type(2)));
typedef float f32x4 __attribute__((ext_vector_type(4)));
typedef float f32x16 __attribute__((ext_vector_type(16)));
typedef short bf16x8 __attribute__((ext_vector_type(8)));
typedef short v4s __attribute__((ext_vector_type(4)));
typedef GAS unsigned gu32;
#define LDS_WAIT() asm volatile("s_waitcnt lgkmcnt(0)" ::: "memory")
__device__ __forceinline__ unsigned f2bf(float f) { unsigned u = __builtin_bit_cast(unsigned, f); return (u + 0x7fffu + ((u >> 16) & 1u)) >> 16; }
__device__ __forceinline__ unsigned pk2(float lo, float hi) { return pg8::cvt_pk_bf16(lo, hi); }
__device__ __forceinline__ float bf2f(unsigned short b) { return __builtin_bit_cast(float, ((unsigned)b) << 16); }
__device__ __forceinline__ float bflo(unsigned w) { return __builtin_bit_cast(float, w << 16); }
__device__ __forceinline__ float bfhi(unsigned w) { return __builtin_bit_cast(float, w & 0xffff0000u); }
__device__ __forceinline__ float sigm(float x) { return __builtin_amdgcn_rcpf(1.f + __expf(-x)); }

__device__ __forceinline__ int lane_id() { unsigned m = ~0u; asm volatile("" : "+s"(m)); return (int)__builtin_amdgcn_mbcnt_hi(m, __builtin_amdgcn_mbcnt_lo(m, 0u)); }
#define XB_TMO      128
#define XB_XCNT(j)  (256  + 64 * (j))
#define XB_XSUB(j)  (1280 + 64 * (j))
#define XB_XGEN(j)  (2304 + 64 * (j))
#define XB_TOP      3328
#define XB_TOPGEN   3392
#define XCD_BAR_WORDS 3456
#define XB_SPIN_CAP (1u << 22)

__device__ __forceinline__ unsigned xb_ld(unsigned* p)              { return __hip_atomic_load(p, __ATOMIC_RELAXED, __HIP_MEMORY_SCOPE_AGENT); }
__device__ __forceinline__ unsigned xb_add(unsigned* p, unsigned v) { return __hip_atomic_fetch_add(p, v, __ATOMIC_RELAXED, __HIP_MEMORY_SCOPE_AGENT); }
__device__ __forceinline__ unsigned xb_xcc_id() { return (unsigned)__builtin_amdgcn_s_getreg((3 << 11) | 20) & 0xFu; }
#define XB_SPIN(cond, bar) do { unsigned _sp = 0; while (cond) { __builtin_amdgcn_s_sleep(1); \
    if ((++_sp & 255u) == 0u) { if (xb_ld(&(bar)[XB_TMO])) break; if (_sp > XB_SPIN_CAP) { atomicAdd(&(bar)[XB_TMO], 1u); break; } } } } while (0)

struct XcdBarrier { unsigned* bar; unsigned x; volatile LAS unsigned* st; int wave; };

__device__ __forceinline__ XcdBarrier xcd_barrier_post(unsigned* bar, volatile LAS unsigned* st) {
    XcdBarrier b; b.bar = bar; b.x = (unsigned)__builtin_amdgcn_readfirstlane((int)xb_xcc_id()); b.st = st;
    if (threadIdx.x == 0) (void)xb_add(&bar[XB_XCNT(b.x)], 1u);
    return b;
}
__device__ __forceinline__ void xcd_barrier_complete(unsigned* bar, unsigned x, unsigned& nloc, unsigned& nx) {
    const unsigned G = gridDim.x * gridDim.y * gridDim.z;
    unsigned sum, cnt, mine, sp = 0u;
    for (;;) {
        sum = 0u; cnt = 0u; mine = 0u;
#pragma unroll 1
        for (unsigned j = 0; j < 16; ++j) { const unsigned c = xb_ld(&bar[XB_XCNT(j)]); sum += c; cnt += (c > 0u) ? 1u : 0u; mine = (j == x) ? c : mine; }
        if (sum == G) break;
        __builtin_amdgcn_s_sleep(1);
        if ((++sp & 255u) == 0u) { if (xb_ld(&bar[XB_TMO])) break; if (sp > XB_SPIN_CAP) { atomicAdd(&bar[XB_TMO], 1u); break; } }
    }
    nloc = mine > 0u ? mine : 1u; nx = cnt > 0u ? cnt : 1u;
}
__device__ __forceinline__ void xcd_barrier(const XcdBarrier& b) {
    asm volatile("s_waitcnt vmcnt(0)" ::: "memory");
    __syncthreads();
    if (b.wave == 0 && lane_id() == 0) {
        unsigned* bar = b.bar;
        unsigned bx = b.x; asm volatile("" : "+s"(bx));
        __builtin_amdgcn_s_waitcnt(0);
        unsigned nloc = b.st[0], nx = b.st[1];
        const unsigned old = xb_add(&bar[XB_XSUB(bx)], 1u);
        const unsigned gen = old / nloc;
        if (old + 1u == (gen + 1u) * nloc) {
            __builtin_amdgcn_fence(__ATOMIC_RELEASE, "agent");
            asm volatile("s_waitcnt vmcnt(0)" ::: "memory");
            const unsigned og = xb_add(&bar[XB_TOP], 1u);
            const unsigned tg = og / nx;
            if (og + 1u == (tg + 1u) * nx) xb_add(&bar[XB_TOPGEN], 1u);
            else XB_SPIN(xb_ld(&bar[XB_TOPGEN]) == tg, bar);
            __builtin_amdgcn_fence(__ATOMIC_ACQUIRE, "agent");
            xb_add(&bar[XB_XGEN(bx)], 1u);
            asm volatile("s_waitcnt vmcnt(0)" ::: "memory");
        } else {
            XB_SPIN(xb_ld(&bar[XB_XGEN(bx)]) == gen, bar);
            __builtin_amdgcn_fence(__ATOMIC_ACQUIRE, "agent");
            asm volatile("s_waitcnt vmcnt(0)" ::: "memory");
        }
    }
    __syncthreads();
}

__device__ __forceinline__ void grp_barrier(unsigned* cnt, unsigned target, int wave) {
    asm volatile("s_waitcnt vmcnt(0)" ::: "memory");
    __syncthreads();
    if (wave == 0 && lane_id() == 0) {
        __builtin_amdgcn_fence(__ATOMIC_RELEASE, "agent"); asm volatile("s_waitcnt vmcnt(0)" ::: "memory");
        (void)xb_add(cnt, 1u);
        for (unsigned sp = 0u; xb_ld(cnt) < target && sp < 4000000u; ++sp) __builtin_amdgcn_s_sleep(1);
        __builtin_amdgcn_fence(__ATOMIC_ACQUIRE, "agent"); asm volatile("s_waitcnt vmcnt(0)" ::: "memory");
    }
    __syncthreads();
}

__device__ __forceinline__ void xswap16(float& a, float& b) { asm volatile("s_nop 1\n\tv_permlane16_swap_b32 %0, %1\n\ts_nop 1" : "+v"(a), "+v"(b)); }
__device__ __forceinline__ void xswap32(float& a, float& b) { asm volatile("s_nop 1\n\tv_permlane32_swap_b32 %0, %1\n\ts_nop 1" : "+v"(a), "+v"(b)); }
__device__ __forceinline__ float xmax16(float x) { float a = x, b = x; xswap16(a, b); return fmaxf(a, b); }
__device__ __forceinline__ float xmax32(float x) { float a = x, b = x; xswap32(a, b); return fmaxf(a, b); }
__device__ __forceinline__ float xsum16(float x) { float a = x, b = x; xswap16(a, b); return a + b; }
__device__ __forceinline__ float xsum32(float x) { float a = x, b = x; xswap32(a, b); return a + b; }

#define DPPF(x, ctrl) __builtin_bit_cast(float, __builtin_amdgcn_update_dpp(0, __builtin_bit_cast(int, (x)), (ctrl), 0xf, 0xf, true))
__device__ __forceinline__ float wmax_f(float x) {
    x = fmaxf(x, DPPF(x, 0xB1)); x = fmaxf(x, DPPF(x, 0x4E)); x = fmaxf(x, DPPF(x, 0x124)); x = fmaxf(x, DPPF(x, 0x128));
    x = xmax16(x); return xmax32(x);
}
__device__ __forceinline__ unsigned wprefix_u(unsigned x) {
    int v = (int)x;
    v += __builtin_amdgcn_update_dpp(0, v, 0x111, 0xf, 0xf, false);
    v += __builtin_amdgcn_update_dpp(0, v, 0x112, 0xf, 0xf, false);
    v += __builtin_amdgcn_update_dpp(0, v, 0x114, 0xf, 0xf, false);
    v += __builtin_amdgcn_update_dpp(0, v, 0x118, 0xf, 0xf, false);
    v += __builtin_amdgcn_update_dpp(0, v, 0x142, 0xa, 0xf, false);
    v += __builtin_amdgcn_update_dpp(0, v, 0x143, 0xc, 0xf, false);
    return (unsigned)v;
}

__device__ __forceinline__ float rowsum16(float x) { x += DPPF(x, 0xB1); x += DPPF(x, 0x4E); x += DPPF(x, 0x124); x += DPPF(x, 0x128); return x; }
__device__ __forceinline__ float wave_sum(float x) { x = rowsum16(x); x = xsum16(x); return xsum32(x); }
__device__ __forceinline__ float wave_max(float x) { return wmax_f(x); }
__device__ __forceinline__ int wave_sum_i(int v) { float f = wave_sum((float)v); return (int)(f + 0.5f); }
template <class Src>
__device__ __forceinline__ void cvt_load(const Src& src, int k0, int n0, int lane, float (&tv)[32]) {
#pragma unroll
    for (int j = 0; j < 8; ++j) { const f32x4 v = src(k0 + 8 * j + (lane >> 3), n0 + 4 * (lane & 7)); tv[4 * j] = v[0]; tv[4 * j + 1] = v[1]; tv[4 * j + 2] = v[2]; tv[4 * j + 3] = v[3]; }
}
__device__ __forceinline__ void cvt_store(const float (&tv)[32], bf16* WT, int K, int k0, int n0, LAS float* scr, int lane) {
#pragma unroll
    for (int j = 0; j < 8; ++j)
#pragma unroll
        for (int e = 0; e < 4; ++e) scr[(8 * j + (lane >> 3)) * 33 + 4 * (lane & 7) + e] = tv[4 * j + e];
    LDS_WAIT(); asm volatile("" ::: "memory");
    const int c = lane & 7;
#pragma unroll
    for (int j = 0; j < 4; ++j) { const int n = (lane >> 3) + 8 * j; const LAS float* s = scr + (8 * c) * 33 + n;
        v4u o; o.x = pk2(s[0 * 33], s[1 * 33]); o.y = pk2(s[2 * 33], s[3 * 33]); o.z = pk2(s[4 * 33], s[5 * 33]); o.w = pk2(s[6 * 33], s[7 * 33]);
        *(GAS v4u*)(WT + (size_t)(n0 + n) * K + k0 + 8 * c) = o; }
    LDS_WAIT(); asm volatile("" ::: "memory");
}

struct Args { const float* in[22]; float* out; unsigned char* ws; };

using pg8::Unit; using pg8::cvt_pk_bf16;
__device__ __forceinline__ void st_bf16x8(bf16* p, f32x4 v0, f32x4 v1) {
    v4u w; w.x = cvt_pk_bf16(v0[0], v0[1]); w.y = cvt_pk_bf16(v0[2], v0[3]); w.z = cvt_pk_bf16(v1[0], v1[1]); w.w = cvt_pk_bf16(v1[2], v1[3]);
    *(v4u*)p = w;
}
__device__ __forceinline__ void st_f32x8(float* p, f32x4 v0, f32x4 v1) { *(f32x4*)p = v0; *(f32x4*)(p + 4) = v1; }
__device__ __forceinline__ f32x4 sigm4(f32x4 v) { return (f32x4){sigm(v[0]), sigm(v[1]), sigm(v[2]), sigm(v[3])}; }
__device__ __forceinline__ f32x4 silu4(f32x4 v) { return (f32x4){v[0] * sigm(v[0]), v[1] * sigm(v[1]), v[2] * sigm(v[2]), v[3] * sigm(v[3])}; }
__device__ __forceinline__ f32x4 ldbf4(const bf16* p) { const v2u w = *(const v2u*)p; return (f32x4){bflo(w.x), bfhi(w.x), bflo(w.y), bfhi(w.y)}; }

#define EPI_LOOP(...) \
    _Pragma("unroll") for (int ai = 0; ai < 2; ++ai) _Pragma("unroll") for (int m = 0; m < 4; ++m) { const int row = row0 + ai * 128 + m * 16; \
        _Pragma("unroll") for (int bj = 0; bj < 2; ++bj) { const int col = colb + bj * 32; const f32x4 v0 = acc[ai][bj][m][0], v1 = acc[ai][bj][m][1]; __VA_ARGS__ } }

__device__ __forceinline__ unsigned q8x4(f32x4 g) { unsigned w = 0u;
#pragma unroll
    for (int e = 0; e < 4; ++e) { const float t = fmaxf(__builtin_fmaf(g[e], 255.f, 0.5f), 1.f); w |= ((unsigned)t) << (8 * e); } return w; }
__device__ __forceinline__ f32x4 ub4(unsigned w) { return (f32x4){(float)(w & 0xffu), (float)((w >> 8) & 0xffu), (float)((w >> 16) & 0xffu), (float)(w >> 24)}; }
struct EpiProj {
    bf16* QA; bf16* FA; bf16* IA; bf16* GA; bf16* LAT; bf16* GTA; bf16* GTB;
    __device__ __forceinline__ void operator()(const f32x4 (&acc)[2][2][4][2], const Unit& u, int wr, int wc, int fr, int fq) const {
        const int row0 = u.pm * 256 + wr * 64 + fr, pn = u.pn; const int colb = (pn & 3) * 256 + wc * 64 + 8 * fq;
        if (pn < 4)       { EPI_LOOP( st_bf16x8(QA + (size_t)row * 1024 + col, v0, v1); ) }
        else if (pn < 8)  { EPI_LOOP( st_bf16x8(FA + (size_t)row * 1024 + col, v0, v1); ) }
        else if (pn < 12) { EPI_LOOP( st_bf16x8(IA + (size_t)row * 1024 + col, v0, v1); ) }
        else if (pn < 16) { EPI_LOOP( st_bf16x8(GA + (size_t)row * 1024 + col, silu4(v0), silu4(v1)); ) }
        else if (pn < 20) { EPI_LOOP( st_bf16x8(LAT + (size_t)row * 1024 + col, v0, v1); ) }
        else { unsigned char* G8 = (unsigned char*)(pn < 28 ? GTA : GTB) + ((size_t)(u.pm * 8 + ((pn - 20) & 7)) * 8 + (wr * 4 + wc)) * 8192 + (fq * 16 + fr) * 16;
            _Pragma("unroll") for (int ai = 0; ai < 2; ++ai) _Pragma("unroll") for (int bj = 0; bj < 2; ++bj) _Pragma("unroll") for (int mp = 0; mp < 2; ++mp) { v4u w;
                w.x = q8x4(sigm4(acc[ai][bj][2 * mp][0])); w.y = q8x4(sigm4(acc[ai][bj][2 * mp][1])); w.z = q8x4(sigm4(acc[ai][bj][2 * mp + 1][0])); w.w = q8x4(sigm4(acc[ai][bj][2 * mp + 1][1]));
                *(v4u*)(G8 + (ai * 4 + bj * 2 + mp) * 1024) = w; } }
    }
};
struct EpiQ {
    bf16* QB; bf16* QIDX;
    __device__ __forceinline__ void operator()(const f32x4 (&acc)[2][2][4][2], const Unit& u, int wr, int wc, int fr, int fq) const {
        const int row0 = u.pm * 256 + wr * 64 + fr, pn = u.pn;
        if (pn < 16) { const int colb = pn * 256 + wc * 64 + 8 * fq; EPI_LOOP( st_bf16x8(QB + (size_t)row * 4096 + col, v0, v1); ) }
        else { const int colb = (pn - 16) * 256 + wc * 64 + 8 * fq; EPI_LOOP( st_bf16x8(QIDX + (size_t)row * 1024 + col, v0, v1); ) }
    }
};
struct EpiBf {
    bf16* O; int ldc; int coff;
    __device__ __forceinline__ void operator()(const f32x4 (&acc)[2][2][4][2], const Unit& u, int wr, int wc, int fr, int fq) const {
        const int row0 = u.pm * 256 + wr * 64 + fr; const int colb = coff + u.pn * 256 + wc * 64 + 8 * fq;
        EPI_LOOP( st_bf16x8(O + (size_t)row * ldc + col, v0, v1); )
    }
};
struct HookGate {
    static constexpr bool ON = true; const bf16* GA_; const bf16* GB_;
    __device__ __forceinline__ void mid(f32x4 (&acc)[2][2][4][2], const Unit& u, int wr, int wc, int fr, int fq) const {
        asm volatile("" : "+v"(fr), "+v"(fq));
        const size_t off = ((size_t)(u.pm * 8 + u.pn) * 8 + (wr * 4 + wc)) * 8192 + (fq * 16 + fr) * 16;
        const unsigned char* A8 = (const unsigned char*)GA_ + off; const unsigned char* B8 = (const unsigned char*)GB_ + off;
#pragma unroll
        for (int ai = 0; ai < 2; ++ai)
#pragma unroll
            for (int mp = 0; mp < 2; ++mp) {
#pragma unroll
                for (int bj = 0; bj < 2; ++bj) { const v4u a = *(const v4u*)(A8 + (ai * 4 + bj * 2 + mp) * 1024), b = *(const v4u*)(B8 + (ai * 4 + bj * 2 + mp) * 1024);
#pragma unroll
                    for (int mm = 0; mm < 2; ++mm)
#pragma unroll
                        for (int n = 0; n < 2; ++n) { const unsigned aw = a[mm * 2 + n], bw = b[mm * 2 + n]; const f32x4 fa = ub4(aw), fb = ub4(bw); f32x4 r;
#pragma unroll
                            for (int j = 0; j < 4; ++j) r[j] = fa[j] * __builtin_amdgcn_rcpf(fb[j]);
                            acc[ai][bj][2 * mp + mm][n] = acc[ai][bj][2 * mp + mm][n] * r; } }
                asm volatile("" : "+v"(acc[ai][0][2 * mp][0]), "+v"(acc[ai][0][2 * mp][1]), "+v"(acc[ai][1][2 * mp][0]), "+v"(acc[ai][1][2 * mp][1]));
                asm volatile("" : "+v"(acc[ai][0][2 * mp + 1][0]), "+v"(acc[ai][0][2 * mp + 1][1]), "+v"(acc[ai][1][2 * mp + 1][0]), "+v"(acc[ai][1][2 * mp + 1][1]));
                asm volatile("" ::: "memory"); }
    }
};
__device__ __forceinline__ f32x4 cvbf4(v2u w) { return (f32x4){bflo(w.x), bfhi(w.x), bflo(w.y), bfhi(w.y)}; }
struct EpiGateM {
    const bf16* GB_; bf16* MRG_;
    __device__ __forceinline__ void operator()(const f32x4 (&acc)[2][2][4][2], const Unit& u, int wr, int wc, int fr, int fq) const {
        const int row0 = u.pm * 256 + wr * 64 + fr; const int colb = u.pn * 256 + wc * 64 + 8 * fq;
        const unsigned char* B8 = (const unsigned char*)GB_ + ((size_t)(u.pm * 8 + u.pn) * 8 + (wr * 4 + wc)) * 8192 + (fq * 16 + fr) * 16;
#pragma unroll
        for (int ai = 0; ai < 2; ++ai) { v4u gr[2][2];
#pragma unroll
            for (int bj = 0; bj < 2; ++bj)
#pragma unroll
                for (int mp = 0; mp < 2; ++mp) gr[bj][mp] = *(const v4u*)(B8 + (ai * 4 + bj * 2 + mp) * 1024);
#pragma unroll
            for (int m = 0; m < 4; ++m)
#pragma unroll
                for (int bj = 0; bj < 2; ++bj) { const size_t o = (size_t)(row0 + ai * 128 + m * 16) * 2048 + colb + bj * 32;
                    const unsigned w0 = gr[bj][m >> 1][(m & 1) * 2], w1 = gr[bj][m >> 1][(m & 1) * 2 + 1];
                    st_bf16x8(MRG_ + o, acc[ai][bj][m][0] * (ub4(w0) * (1.f / 255.f)), acc[ai][bj][m][1] * (ub4(w1) * (1.f / 255.f))); } }
    }
};
struct EpiGateA {
    float* T1; const bf16* GT;
    __device__ __forceinline__ void operator()(const f32x4 (&acc)[2][2][4][2], const Unit& u, int wr, int wc, int fr, int fq) const {
        const int row0 = u.pm * 256 + wr * 64 + fr; const int colb = u.pn * 256 + wc * 64 + 8 * fq;
        EPI_LOOP( const size_t o = (size_t)row * 2048 + col; const f32x4 g0 = ldbf4(GT + o), g1 = ldbf4(GT + o + 4); st_f32x8(T1 + o, v0 * g0, v1 * g1); )
    }
};
struct EpiGateB {
    const float* T1; const bf16* GT; bf16* MRG;
    __device__ __forceinline__ void operator()(const f32x4 (&acc)[2][2][4][2], const Unit& u, int wr, int wc, int fr, int fq) const {
        const int row0 = u.pm * 256 + wr * 64 + fr; const int colb = u.pn * 256 + wc * 64 + 8 * fq;
        EPI_LOOP( const size_t o = (size_t)row * 2048 + col; const f32x4 g0 = ldbf4(GT + o), g1 = ldbf4(GT + o + 4); const f32x4 t0 = *(const f32x4*)(T1 + o), t1 = *(const f32x4*)(T1 + o + 4);
                  st_bf16x8(MRG + o, t0 + v0 * g0, t1 + v1 * g1); )
    }
};
struct EpiRes {
    const float* X; const bf16* Hh; bf16* R; const float* md; int osh, osc, ogt;
    __device__ __forceinline__ void operator()(const f32x4 (&acc)[2][2][4][2], const Unit& u, int wr, int wc, int fr, int fq) const {
        const int row0 = u.pm * 256 + wr * 64 + fr; const int colb = u.pn * 256 + wc * 64 + 8 * fq; const float* g = md + (size_t)(u.pm >> 4) * MODW;
        f32x4 gg[2][2];
#pragma unroll
        for (int bj = 0; bj < 2; ++bj) { gg[bj][0] = *(const f32x4*)(g + ogt + colb + bj * 32) + 1.f; gg[bj][1] = *(const f32x4*)(g + ogt + colb + bj * 32 + 4) + 1.f; }
        if (X) {
#pragma unroll
            for (int ai = 0; ai < 2; ++ai)
#pragma unroll
                for (int mh = 0; mh < 2; ++mh) { f32x4 xr[2][2][2];
#pragma unroll
                    for (int mm = 0; mm < 2; ++mm)
#pragma unroll
                        for (int bj = 0; bj < 2; ++bj) { const size_t o = (size_t)(row0 + ai * 128 + (2 * mh + mm) * 16) * 2048 + colb + bj * 32; xr[mm][bj][0] = *(const f32x4*)(X + o); xr[mm][bj][1] = *(const f32x4*)(X + o + 4); }
#pragma unroll
                    for (int mm = 0; mm < 2; ++mm)
#pragma unroll
                        for (int bj = 0; bj < 2; ++bj) { const int m = 2 * mh + mm; const size_t o = (size_t)(row0 + ai * 128 + m * 16) * 2048 + colb + bj * 32;
                            st_bf16x8(R + o, xr[mm][bj][0] * ALPHA + gg[bj][0] * acc[ai][bj][m][0], xr[mm][bj][1] * ALPHA + gg[bj][1] * acc[ai][bj][m][1]); } }
        } else {
            f32x4 ia[2][2], sb[2][2];
#pragma unroll
            for (int bj = 0; bj < 2; ++bj)
#pragma unroll
                for (int hh = 0; hh < 2; ++hh) { const f32x4 sc = *(const f32x4*)(g + osc + colb + bj * 32 + 4 * hh), sh = *(const f32x4*)(g + osh + colb + bj * 32 + 4 * hh);
#pragma unroll
                    for (int e = 0; e < 4; ++e) { ia[bj][hh][e] = ALPHA / (1.f + sc[e]); sb[bj][hh][e] = sh[e] * ia[bj][hh][e]; } }
#pragma unroll
            for (int ai = 0; ai < 2; ++ai) { v2u xr[4][2][2];
#pragma unroll
                for (int m = 0; m < 4; ++m)
#pragma unroll
                    for (int bj = 0; bj < 2; ++bj) { const size_t o = (size_t)(row0 + ai * 128 + m * 16) * 2048 + colb + bj * 32; xr[m][bj][0] = *(const v2u*)(Hh + o); xr[m][bj][1] = *(const v2u*)(Hh + o + 4); }
#pragma unroll
                for (int m = 0; m < 4; ++m)
#pragma unroll
                    for (int bj = 0; bj < 2; ++bj) { const size_t o = (size_t)(row0 + ai * 128 + m * 16) * 2048 + colb + bj * 32;
                        st_bf16x8(R + o, cvbf4(xr[m][bj][0]) * ia[bj][0] - sb[bj][0] + gg[bj][0] * acc[ai][bj][m][0], cvbf4(xr[m][bj][1]) * ia[bj][1] - sb[bj][1] + gg[bj][1] * acc[ai][bj][m][1]); } }
        }
    }
};
template <int which, bool FINAL>
struct EpiLn {
    unsigned char* ws; const float* X; float* Fo; const float* lng; const float* lnb; LAS unsigned char* lds; int l;
    __device__ __forceinline__ void operator()(f32x4 (&acc)[2][2][4][2], const Unit& u, int wr, int wc, int fr, int fq) const {
        { const int ln_ = lane_id(); fr = ln_ & 15; fq = ln_ >> 4; }
        int upm = u.pm, upn = u.pn; asm volatile("" : "+s"(upm), "+s"(upn));
        const float* MODb = (const float*)(ws + WS_MOD); bf16* Hh = (bf16*)(ws + WS_H);
        const float* g = MODb + ((size_t)l * NBATCH + (upm >> 4)) * MODW + (which ? 3 * DM : 0);
        const float* go = which ? MODb + ((size_t)(l + 1 < DEPTH ? l + 1 : l) * NBATCH + (upm >> 4)) * MODW : g + 3 * DM;
        LAS float* sl = (LAS float*)(lds + RING_BYTES);
        const int row0 = upm * 256 + wr * 64 + fr; const int colb = upn * 256 + wc * 64 + 8 * fq;
#pragma unroll
        for (int bj = 0; bj < 2; ++bj) { const int c0 = colb + bj * 32;
            const f32x4 gg0 = *(const f32x4*)(g + 2 * DM + c0) + 1.f, gg1 = *(const f32x4*)(g + 2 * DM + c0 + 4) + 1.f;
            if (which == 0 && X) {
#pragma unroll
                for (int ai = 0; ai < 2; ++ai) { f32x4 xr[4][2];
#pragma unroll
                    for (int m = 0; m < 4; ++m) { const size_t o = (size_t)(row0 + ai * 128 + m * 16) * 2048 + c0; xr[m][0] = *(const f32x4*)(X + o); xr[m][1] = *(const f32x4*)(X + o + 4); }
#pragma unroll
                    for (int m = 0; m < 4; ++m) { acc[ai][bj][m][0] = xr[m][0] * ALPHA + gg0 * acc[ai][bj][m][0]; acc[ai][bj][m][1] = xr[m][1] * ALPHA + gg1 * acc[ai][bj][m][1]; } }
            } else {
                f32x4 ia0, ia1, sb0, sb1;
                { const f32x4 sc0 = *(const f32x4*)(g + DM + c0), sc1 = *(const f32x4*)(g + DM + c0 + 4), sh0 = *(const f32x4*)(g + c0), sh1 = *(const f32x4*)(g + c0 + 4);
#pragma unroll
                  for (int e = 0; e < 4; ++e) { ia0[e] = ALPHA * __builtin_amdgcn_rcpf(1.f + sc0[e]); ia1[e] = ALPHA * __builtin_amdgcn_rcpf(1.f + sc1[e]); sb0[e] = sh0[e] * ia0[e]; sb1[e] = sh1[e] * ia1[e]; } }
#pragma unroll
                for (int ai = 0; ai < 2; ++ai) { v2u xr[4][2]; size_t o = (size_t)(row0 + ai * 128) * 2048 + c0;
#pragma unroll
                    for (int m = 0; m < 4; ++m) { xr[m][0] = *(const v2u*)(Hh + o); xr[m][1] = *(const v2u*)(Hh + o + 4); size_t st_ = 16 * 2048; asm volatile("" : "+s"(st_)); o += st_; }
#pragma unroll
                    for (int m = 0; m < 4; ++m) { acc[ai][bj][m][0] = cvbf4(xr[m][0]) * ia0 - sb0 + gg0 * acc[ai][bj][m][0]; acc[ai][bj][m][1] = cvbf4(xr[m][1]) * ia1 - sb1 + gg1 * acc[ai][bj][m][1]; }
                    asm volatile("" ::: "memory"); }
            }
            asm volatile("" ::: "memory"); }
        { const int ln_ = lane_id(); fr = ln_ & 15; fq = ln_ >> 4; }
#pragma unroll
        for (int ai = 0; ai < 2; ++ai)
#pragma unroll
            for (int m = 0; m < 4; ++m) { float s1 = 0.f, s2 = 0.f;
#pragma unroll
                for (int bj = 0; bj < 2; ++bj)
#pragma unroll
                    for (int hh = 0; hh < 2; ++hh) { const f32x4 v = acc[ai][bj][m][hh]; s1 += (v[0] + v[1]) + (v[2] + v[3]); s2 += (v[0] * v[0] + v[1] * v[1]) + (v[2] * v[2] + v[3] * v[3]); }
                s1 = xsum32(xsum16(s1)); s2 = xsum32(xsum16(s2));
                if (fq == 0) { const int rt = ai * 128 + wr * 64 + m * 16 + fr; sl[(wc * 256 + rt) * 2] = s1; sl[(wc * 256 + rt) * 2 + 1] = s2; } }
        __syncthreads();
        const int tid = (wr * 4 + wc) * 64 + lane_id();
        float* ex = (float*)(ws + WS_SEL) + (size_t)upm * 8 * 512;
        if (tid < 256) { const float S1 = (sl[tid * 2] + sl[(256 + tid) * 2]) + (sl[(512 + tid) * 2] + sl[(768 + tid) * 2]), S2 = (sl[tid * 2 + 1] + sl[(256 + tid) * 2 + 1]) + (sl[(512 + tid) * 2 + 1] + sl[(768 + tid) * 2 + 1]);
            __hip_atomic_store((unsigned*)(ex + (upn * 256 + tid) * 2), __builtin_bit_cast(unsigned, S1), __ATOMIC_RELAXED, __HIP_MEMORY_SCOPE_AGENT);
            __hip_atomic_store((unsigned*)(ex + (upn * 256 + tid) * 2 + 1), __builtin_bit_cast(unsigned, S2), __ATOMIC_RELAXED, __HIP_MEMORY_SCOPE_AGENT); }
        asm volatile("s_waitcnt vmcnt(0)" ::: "memory");
        __syncthreads();
        if (tid == 0) { unsigned* cp = (unsigned*)(ws + WS_CTL) + 256 + (l * 2 + which) * 64 + upm;
            __builtin_amdgcn_fence(__ATOMIC_RELEASE, "agent"); asm volatile("s_waitcnt vmcnt(0)" ::: "memory");
            (void)xb_add(cp, 1u);
            for (unsigned sp = 0u; xb_ld(cp) < 8u && sp < 400000u; ++sp) __builtin_amdgcn_s_sleep(1);
            __builtin_amdgcn_fence(__ATOMIC_ACQUIRE, "agent"); asm volatile("s_waitcnt vmcnt(0)" ::: "memory"); }
        __syncthreads();
        if (tid < 256) { float S1 = 0.f, S2 = 0.f;
#pragma unroll
            for (int p = 0; p < 8; ++p) { S1 += __builtin_bit_cast(float, __hip_atomic_load((unsigned*)(ex + (p * 256 + tid) * 2), __ATOMIC_RELAXED, __HIP_MEMORY_SCOPE_AGENT));
                S2 += __builtin_bit_cast(float, __hip_atomic_load((unsigned*)(ex + (p * 256 + tid) * 2 + 1), __ATOMIC_RELAXED, __HIP_MEMORY_SCOPE_AGENT)); }
            const float mean = S1 * (1.f / DM); const float var = fmaxf(S2 * (1.f / DM) - mean * mean, 0.f);
            sl[2048 + tid * 2] = mean; sl[2048 + tid * 2 + 1] = 1.0f / sqrtf(var + 1e-5f); }
        __syncthreads();
        { const int ln_ = lane_id(); fr = ln_ & 15; fq = ln_ >> 4; }
        const int row1 = upm * 256 + wr * 64 + fr; const int colc = upn * 256 + wc * 64 + 8 * fq;
#pragma unroll
        for (int bj = 0; bj < 2; ++bj) { const int c0 = colc + bj * 32;
            const f32x4 lg0 = *(const f32x4*)(lng + c0), lg1 = *(const f32x4*)(lng + c0 + 4), lb0 = *(const f32x4*)(lnb + c0), lb1 = *(const f32x4*)(lnb + c0 + 4);
            const f32x4 q0 = *(const f32x4*)(go + DM + c0) + 1.f, q1 = *(const f32x4*)(go + DM + c0 + 4) + 1.f, h0 = *(const f32x4*)(go + c0), h1 = *(const f32x4*)(go + c0 + 4);
#pragma unroll
            for (int ai = 0; ai < 2; ++ai) { size_t on = (size_t)(row1 + ai * 128) * 2048 + c0;
#pragma unroll
                for (int m = 0; m < 4; ++m) { const int rt = ai * 128 + wr * 64 + m * 16 + fr; const float mean = sl[2048 + rt * 2], rstd = sl[2048 + rt * 2 + 1];
                    const size_t o = on; { size_t st_ = 16 * 2048; asm volatile("" : "+s"(st_)); on += st_; }
                    const f32x4 y0 = (acc[ai][bj][m][0] - mean) * rstd * lg0 + lb0, y1 = (acc[ai][bj][m][1] - mean) * rstd * lg1 + lb1;
                    if constexpr (FINAL) { *(f32x4*)(Fo + o) = y0; *(f32x4*)(Fo + o + 4) = y1; }
                    else st_bf16x8(Hh + o, y0 * q0 + h0, y1 * q1 + h1); } }
            asm volatile("" ::: "memory"); }
    }
};
struct EpiSwiglu {
    bf16* ACT;
    __device__ __forceinline__ void operator()(const f32x4 (&acc)[2][2][4][2], const Unit& u, int wr, int wc, int fr, int fq) const {
        const int row0 = u.pm * 256 + wr * 64 + fr; const int col = u.pn * 128 + wc * 32 + 8 * fq;
#pragma unroll
        for (int ai = 0; ai < 2; ++ai)
#pragma unroll
            for (int m = 0; m < 4; ++m) { const int row = row0 + ai * 128 + m * 16;
                st_bf16x8(ACT + (size_t)row * DFF + col, silu4(acc[ai][0][m][0]) * acc[ai][1][m][0], silu4(acc[ai][0][m][1]) * acc[ai][1][m][1]); }
    }
};

__global__ void __launch_bounds__(NTHR, 2) fwd_kernel(Args args) {
    extern __shared__ __attribute__((aligned(16))) unsigned char lds_raw[];
    LAS unsigned char* lds = (LAS unsigned char*)lds_raw;
    const int G = gridDim.x, blk = blockIdx.x;
    const int NGW = G * NWAVES, NT = G * NTHR;
    unsigned char* const ws_base = args.ws;
    gu32* ctl = (gu32*)(ws_base + WS_CTL);
    for (int u = threadIdx.x; u < (LDS_BYTES - LDSCTL_OFF) / 4; u += NTHR) ((LAS unsigned*)(lds + LDSCTL_OFF))[u] = 0u;
    __syncthreads();
    volatile LAS unsigned* MISC = (volatile LAS unsigned*)(lds + MISC_OFF);
    const int wave_s = __builtin_amdgcn_readfirstlane((int)(threadIdx.x >> 6));
    XcdBarrier bar = xcd_barrier_post((unsigned*)(ctl + CW_BAR), MISC + 8); bar.wave = wave_s;
    if (threadIdx.x == 0) { unsigned nloc_ = 0u, nx_ = 0u; xcd_barrier_complete(bar.bar, bar.x, nloc_, nx_); bar.st[0] = nloc_; bar.st[1] = nx_; }
    __syncthreads();
#define GRID_BAR() xcd_barrier(bar)
#define GRP_BAR(K_) grp_barrier((unsigned*)(ctl + 1024 + 64 * (blk & 7)), (unsigned)(G >> 3) * (unsigned)(4 * l + (K_) + 1), wave_s)

#define x_in ((const float*)(const GAS float*)args.in[0 + z_])
#define c_in ((const float*)(const GAS float*)args.in[1 + z_])
#define w_ada ((const float*)(const GAS float*)args.in[2 + z_])
#define b_ada ((const float*)(const GAS float*)args.in[3 + z_])
#define w_in ((const float*)(const GAS float*)args.in[4 + z_])
#define lb_logits ((const float*)(const GAS float*)args.in[5 + z_])
#define g_hg ((const float*)(const GAS float*)args.in[6 + z_])
#define w_pa ((const float*)(const GAS float*)args.in[7 + z_])
#define g_cq ((const float*)(const GAS float*)args.in[8 + z_])
#define g_ckv ((const float*)(const GAS float*)args.in[9 + z_])
#define w_uq ((const float*)(const GAS float*)args.in[10 + z_])
#define w_iq ((const float*)(const GAS float*)args.in[11 + z_])
#define w_uv ((const float*)(const GAS float*)args.in[12 + z_])
#define w_pb ((const float*)(const GAS float*)args.in[13 + z_])
#define w_out ((const float*)(const GAS float*)args.in[14 + z_])
#define ln1_g ((const float*)(const GAS float*)args.in[15 + z_])
#define ln1_b ((const float*)(const GAS float*)args.in[16 + z_])
#define w_gate ((const float*)(const GAS float*)args.in[17 + z_])
#define w_up ((const float*)(const GAS float*)args.in[18 + z_])
#define w_down ((const float*)(const GAS float*)args.in[19 + z_])
#define ln2_g ((const float*)(const GAS float*)args.in[20 + z_])
#define ln2_b ((const float*)(const GAS float*)args.in[21 + z_])
#define MOD  ((float*)(ws + WS_MOD))
#define LB   ((float*)(ws + WS_LB))
#define MODP ((float*)(ws + WS_MODP))
#define W1   ((bf16*)(ws + WS_W1))
#define W3   ((bf16*)(ws + WS_W3))
#define W6   ((bf16*)(ws + WS_W6))
#define W7   ((bf16*)(ws + WS_W7))
#define W8   ((bf16*)(ws + WS_W8))
#define W10  ((bf16*)(ws + WS_W10))
#define W11  ((bf16*)(ws + WS_W11))
#define XB   ((bf16*)(ws + WS_X))
#define RB   ((bf16*)(ws + WS_R))
#define HB   ((bf16*)(ws + WS_H))
#define QA   ((bf16*)(ws + WS_QA))
#define FA   ((bf16*)(ws + WS_FA))
#define IA   ((bf16*)(ws + WS_IA))
#define GA   ((bf16*)(ws + WS_GA))
#define LAT  ((bf16*)(ws + WS_LAT))
#define GTA  ((bf16*)(ws + WS_GTA))
#define GTB  ((bf16*)(ws + WS_GTB))
#define CQN  ((bf16*)(ws + WS_CQN))
#define CKV  ((bf16*)(ws + WS_CKV))
#define KIDX ((bf16*)(ws + WS_KIDX))
#define IDXW ((float*)(ws + WS_IDXW))
#define QB   ((bf16*)(ws + WS_QB))
#define QIDX ((bf16*)(ws + WS_QIDX))
#define SEL  ((unsigned short*)(ws + WS_SEL))
#define YAB  ((bf16*)(ws + WS_YAB))
#define MRG  ((bf16*)(ws + WS_MRG))
#define OB   ((bf16*)(ws + WS_OB))
#define ISC  ((_Float16*)(ws + WS_BIG))
#define OP   ((float*)(ws + WS_BIG))
#define ACT  ((bf16*)(ws + WS_BIG))
#define KK   LAT
#define modl (MOD + (size_t)l * NBATCH * MODW)
#define KSB  ((bf16*)(ws + WS_KSB))
#define QSB  ((bf16*)(ws + WS_QSB))
#define KVT  ((bf16*)(ws + WS_BIG))
#define SPB  ((bf16*)(ws + WS_FA))
#define DEB  ((float*)(ws + WS_DEB))
#define PHASE_BEGIN { unsigned om_ = ~0u; asm volatile("" : "+s"(om_)); int tid = wave_s * 64 + (int)__builtin_amdgcn_mbcnt_hi(om_, __builtin_amdgcn_mbcnt_lo(om_, 0u)); asm volatile("" : "+v"(tid)); int z_ = 0; asm volatile("" : "+s"(z_)); (void)z_; GAS unsigned char* wsg_ = (GAS unsigned char*)ws_base; asm volatile("" : "+s"(wsg_)); unsigned char* ws = (unsigned char*)wsg_; const int lane = tid & 63, wave = __builtin_amdgcn_readfirstlane(tid >> 6); \
        const int gw = blk * NWAVES + wave, gtid = blk * NTHR + tid; LAS float* wscr = (LAS float*)(lds + wave * 16384); (void)lane; (void)gw; (void)gtid; (void)wscr;
#define PHASE_END }

#define CVT_DECODE(IT_, MID_, K0_, N0_) do { int r_ = (IT_); \
        if (r_ < I1) { MID_ = 0; K0_ = (r_ / (N1 / 32)) * 64; N0_ = (r_ % (N1 / 32)) * 32; } else { r_ -= I1; \
        if (r_ < I3) { MID_ = 1; K0_ = (r_ / (N3 / 32)) * 64; N0_ = (r_ % (N3 / 32)) * 32; } else { r_ -= I3; \
        if (r_ < I6) { MID_ = 2; K0_ = (r_ / 32) * 64; N0_ = (r_ % 32) * 32; } else { r_ -= I6; \
        if (r_ < I7) { MID_ = 3; K0_ = (r_ / (DM / 32)) * 64; N0_ = (r_ % (DM / 32)) * 32; } else { r_ -= I7; \
        if (r_ < I8) { MID_ = 4; K0_ = (r_ / (DM / 32)) * 64; N0_ = (r_ % (DM / 32)) * 32; } else { r_ -= I8; \
        if (r_ < I10) { MID_ = 5; K0_ = (r_ / (N10 / 32)) * 64; N0_ = (r_ % (N10 / 32)) * 32; } else { r_ -= I10; \
        MID_ = 6; K0_ = (r_ / (DM / 32)) * 64; N0_ = (r_ % (DM / 32)) * 32; } } } } } } } while (0)
#define CVT_LOAD(MID_, K0_, N0_, TV_) do { \
        if (MID_ == 0) cvt_load([=](int k, int n) -> f32x4 { const f32x4 v = *(const f32x4*)(s_in + (size_t)k * 9040 + (n < 4944 ? n : n - 176)); return (n >= 4944 && n < 5120) ? (f32x4){0.f, 0.f, 0.f, 0.f} : v; }, K0_, N0_, lane, TV_); \
        else if (MID_ == 1) cvt_load([=](int k, int n) -> f32x4 { const float* p = n < 4096 ? s_uq + (size_t)k * 4096 + n : s_iq + (size_t)k * 1024 + (n - 4096); return *(const f32x4*)p * (n < 4096 ? 0.0625f : 1.f); }, K0_, N0_, lane, TV_); \
        else if (MID_ == 2) cvt_load([=](int k, int n) -> f32x4 { const int h = n >> 6, v = n & 63, kk = k >> 8, c = k & 255; const f32x4 w = *(const f32x4*)(s_uv + ((size_t)h * 256 + c) * 64 + v); return kk == (h & 3) ? w : (f32x4){0.f, 0.f, 0.f, 0.f}; }, K0_, N0_, lane, TV_); \
        else if (MID_ == 3) cvt_load([=](int k, int n) -> f32x4 { const float* p = k < 1024 ? s_pa + (size_t)k * DM + n : s_pb + (size_t)(k - 1024) * DM + n; return *(const f32x4*)p; }, K0_, N0_, lane, TV_); \
        else if (MID_ == 4) cvt_load([=](int k, int n) -> f32x4 { return *(const f32x4*)(s_out + (size_t)k * DM + n); }, K0_, N0_, lane, TV_); \
        else if (MID_ == 5) cvt_load([=](int k, int n) -> f32x4 { const int pn = n >> 8, rr = n & 255, cc = pn * 128 + (rr >> 6) * 32 + (rr & 31); const float* p = ((rr & 32) ? s_u : s_g) + (size_t)k * DFF + cc; return *(const f32x4*)p; }, K0_, N0_, lane, TV_); \
        else cvt_load([=](int k, int n) -> f32x4 { return *(const f32x4*)(s_d + (size_t)k * DM + n); }, K0_, N0_, lane, TV_); } while (0)
#define CONVERT_LAYER(L) do { const int l_ = (L); \
        const float* s_in = w_in + (size_t)l_ * DM * 9040; const float* s_uq = w_uq + (size_t)l_ * SAR * 4096; const float* s_iq = w_iq + (size_t)l_ * SAR * 1024; \
        const float* s_uv = w_uv + (size_t)l_ * 16 * 256 * 64; const float* s_pa = w_pa + (size_t)l_ * 1024 * DM; const float* s_pb = w_pb + (size_t)l_ * 1024 * DM; \
        const float* s_out = w_out + (size_t)l_ * DM * DM; const float* s_g = w_gate + (size_t)l_ * DM * DFF; const float* s_u = w_up + (size_t)l_ * DM * DFF; const float* s_d = w_down + (size_t)l_ * DFF * DM; \
        constexpr int I1 = (DM / 64) * (N1 / 32), I3 = (SAR / 64) * (N3 / 32), I6 = (1024 / 64) * (1024 / 32), I7 = (DM / 64) * (DM / 32), I8 = I7, I10 = (DM / 64) * (N10 / 32), I11 = (DFF / 64) * (DM / 32); \
        constexpr int NIT = I1 + I3 + I6 + I7 + I8 + I10 + I11; \
        float tv_[32]; int mid_ = 0, k0_ = 0, n0_ = 0; \
        { CVT_DECODE(gw, mid_, k0_, n0_); CVT_LOAD(mid_, k0_, n0_, tv_); } \
        for (int it = gw; it < NIT; it += NGW) { \
            float tc_[32]; _Pragma("unroll") for (int i = 0; i < 32; ++i) tc_[i] = tv_[i]; \
            const int mc_ = mid_, kc_ = k0_, nc_ = n0_; \
            { const int itn_ = it + NGW < NIT ? it + NGW : it; CVT_DECODE(itn_, mid_, k0_, n0_); CVT_LOAD(mid_, k0_, n0_, tv_); }     \
            bf16* wt_ = mc_ == 0 ? W1 : mc_ == 1 ? W3 : mc_ == 2 ? W6 : mc_ == 3 ? W7 : mc_ == 4 ? W8 : mc_ == 5 ? W10 : W11; \
            const int kk_ = mc_ == 0 ? DM : mc_ == 1 ? SAR : mc_ == 2 ? 1024 : mc_ == 3 ? DM : mc_ == 4 ? DM : mc_ == 5 ? DM : DFF; \
            cvt_store(tc_, wt_, kk_, kc_, nc_, wscr, lane); \
        } } while (0)


#ifndef HGRN_NAIVE
#define HGRN_NAIVE 0
#endif
#ifndef IDX_NAIVE
#define IDX_NAIVE 0
#endif
#ifndef ATT_NAIVE
#define ATT_NAIVE 0
#endif
#ifndef TOPK_OLD
#define TOPK_OLD 0
#endif
#ifndef REP_HB
#define REP_HB 1
#endif
#ifndef REP_HC
#define REP_HC 1
#endif
#ifndef REP_P4A
#define REP_P4A 1
#endif
#ifndef REP_P5
#define REP_P5 1
#endif
#ifndef REP_P9
#define REP_P9 1
#endif
#ifndef REP_P12
#define REP_P12 1
#endif
#ifndef REP_TOPK
#define REP_TOPK 1
#endif
#ifndef REP_ATT
#define REP_ATT 1
#endif
#ifndef DRY_ATT
#define DRY_ATT 0
#endif
#ifndef REP_M1
#define REP_M1 1
#endif
#ifndef REP_M2
#define REP_M2 1
#endif
#ifndef REP_M3
#define REP_M3 1
#endif

    PHASE_BEGIN
    {
        LAS float* sc = (LAS float*)lds;
        for (int i = tid; i < NBATCH * DM; i += NTHR) { const float v = c_in[i]; sc[i] = v * sigm(v); }
        __syncthreads();
        for (int item = gtid; item < 8 * 12288; item += NT) {
            const int ks = item / 12288, cg = item % 12288, l = cg / 3072, n4 = (cg % 3072) * 4;
            const float* wp = w_ada + ((size_t)l * DM + ks * 256) * MODW + n4;
            f32x4 a0 = {0.f, 0.f, 0.f, 0.f}, a1 = a0, a2 = a0, a3 = a0;
#pragma unroll 8
            for (int k = 0; k < 256; ++k) { const f32x4 w = *(const f32x4*)(wp + (size_t)k * MODW); const int kk = ks * 256 + k;
                a0 += w * sc[kk]; a1 += w * sc[2048 + kk]; a2 += w * sc[4096 + kk]; a3 += w * sc[6144 + kk]; }
            float* o = MODP + ((size_t)(ks * 4 + l) * 4) * MODW + n4;
            *(f32x4*)(o) = a0; *(f32x4*)(o + MODW) = a1; *(f32x4*)(o + 2 * MODW) = a2; *(f32x4*)(o + 3 * MODW) = a3;
        }
        if (gtid < 1024) {
            const float a = lb_logits[gtid], b = lb_logits[1024 + gtid], c = lb_logits[2048 + gtid], d = lb_logits[3072 + gtid];
            const float mx = fmaxf(fmaxf(a, b), fmaxf(c, d)); const float ea = expf(a - mx), eb = expf(b - mx), ec = expf(c - mx), ed = expf(d - mx); const float inv = 1.f / (ea + eb + ec + ed);
            LB[gtid] = 0.f; LB[1024 + gtid] = eb * inv; LB[2048 + gtid] = (eb + ec) * inv; LB[3072 + gtid] = (eb + ec + ed) * inv;
        }
        __syncthreads();
        CONVERT_LAYER(0);
    }
    PHASE_END
    GRID_BAR();
    PHASE_BEGIN
    for (int i = gtid; i < DEPTH * NBATCH * MODW; i += NT) {
        const int l = i / (NBATCH * MODW), r = i % (NBATCH * MODW), b = r / MODW, n = r % MODW;
        float s = b_ada[l * MODW + n];
#pragma unroll
        for (int ks = 0; ks < 8; ++ks) s += MODP[((size_t)(ks * 4 + l) * 4 + b) * MODW + n];
        MOD[i] = s;
    }
    PHASE_END
    GRID_BAR();
    PHASE_BEGIN
    for (size_t i0 = gtid; i0 < (size_t)M * DM / 8; i0 += (size_t)NT * 4) {
        f32x4 xa[4], xb[4], sa[4], sb[4], ha[4], hb[4];
#pragma unroll
        for (int t = 0; t < 4; ++t) { size_t gi = i0 + (size_t)t * NT; gi = gi < (size_t)M * DM / 8 ? gi : (size_t)M * DM / 8 - 1; const size_t e = gi * 8; const int row = (int)(e / DM), col = (int)(e % DM), b = row / SEQ; const float* md = MOD + (size_t)b * MODW;
            xa[t] = *(const f32x4*)(x_in + e); xb[t] = *(const f32x4*)(x_in + e + 4); sa[t] = *(const f32x4*)(md + 2048 + col); sb[t] = *(const f32x4*)(md + 2048 + col + 4); ha[t] = *(const f32x4*)(md + col); hb[t] = *(const f32x4*)(md + col + 4); }
#pragma unroll
        for (int t = 0; t < 4; ++t) { size_t gi = i0 + (size_t)t * NT; gi = gi < (size_t)M * DM / 8 ? gi : (size_t)M * DM / 8 - 1; const size_t e = gi * 8; st_bf16x8(HB + e, xa[t] * (sa[t] + 1.f) + ha[t], xb[t] * (sb[t] + 1.f) + hb[t]); }
    }
    PHASE_END
    GRID_BAR();

    for (int l = 0; l < DEPTH; ++l) {
        PHASE_BEGIN
        { pg8::Gemm g{HB, W1, M, N1, DM, DM, DM, 0}; pg8::StaticOrder S; S.init(M, N1, G, blk);
          EpiProj E{QA, FA, IA, GA, LAT, GTA, GTB}; pg8::gemm_phase(lds, g, S, E, tid); }
        PHASE_END
        GRID_BAR();
        for (int rep_ = 0; rep_ < REP_M1; ++rep_) {
        PHASE_BEGIN
        v2u ra0, ra1, rkv; unsigned short rki, riw;
        const f32x4 g0 = *(const f32x4*)(g_cq + l * 512 + 4 * lane), g1 = *(const f32x4*)(g_cq + l * 512 + 256 + 4 * lane), gk = *(const f32x4*)(g_ckv + l * 256 + 4 * lane);
        { const bf16* lr = LAT + (size_t)gw * 1024; ra0 = *(const v2u*)(lr + 4 * lane); ra1 = *(const v2u*)(lr + 256 + 4 * lane); rkv = *(const v2u*)(lr + 512 + 4 * lane); rki = lr[768 + lane]; riw = lr[832 + (lane & 15)]; }
        for (int row = gw; row < M; row += NGW) {
            const f32x4 a0 = (f32x4){bflo(ra0.x), bfhi(ra0.x), bflo(ra0.y), bfhi(ra0.y)}, a1 = (f32x4){bflo(ra1.x), bfhi(ra1.x), bflo(ra1.y), bfhi(ra1.y)}, kv = (f32x4){bflo(rkv.x), bfhi(rkv.x), bflo(rkv.y), bfhi(rkv.y)};
            const float ki = bf2f(rki), iw = bf2f(riw);
            { const int rn = row + NGW < M ? row + NGW : row; const bf16* lr = LAT + (size_t)rn * 1024;
              ra0 = *(const v2u*)(lr + 4 * lane); ra1 = *(const v2u*)(lr + 256 + 4 * lane); rkv = *(const v2u*)(lr + 512 + 4 * lane); rki = lr[768 + lane]; riw = lr[832 + (lane & 15)]; }
            float sq = a0[0] * a0[0] + a0[1] * a0[1] + a0[2] * a0[2] + a0[3] * a0[3] + a1[0] * a1[0] + a1[1] * a1[1] + a1[2] * a1[2] + a1[3] * a1[3];
            float sk = kv[0] * kv[0] + kv[1] * kv[1] + kv[2] * kv[2] + kv[3] * kv[3];
            sq = wave_sum(sq); sk = wave_sum(sk);
            const float rq = 1.0f / sqrtf(sq * (1.f / 512.f) + 1e-6f), rk = 1.0f / sqrtf(sk * (1.f / 256.f) + 1e-6f);
            v2u o; f32x4 t = a0 * rq * g0; o.x = pk2(t[0], t[1]); o.y = pk2(t[2], t[3]); *(v2u*)(CQN + (size_t)row * 512 + 4 * lane) = o;
            t = a1 * rq * g1; o.x = pk2(t[0], t[1]); o.y = pk2(t[2], t[3]); *(v2u*)(CQN + (size_t)row * 512 + 256 + 4 * lane) = o;
            t = kv * rk * gk; o.x = pk2(t[0], t[1]); o.y = pk2(t[2], t[3]); *(v2u*)(CKV + (size_t)row * 256 + 4 * lane) = o;
            KIDX[(size_t)row * 64 + lane] = (bf16)f2bf(ki);
            if (lane < 16) IDXW[(size_t)row * 16 + lane] = iw * 0.03125f;
        }
        PHASE_END
        PHASE_BEGIN
        {
            const int cp = tid & 63, sg = tid >> 6;
            LAS unsigned char* KST = lds;
            LAS unsigned char* VTL = lds + 18432;
            LAS float* SEGT = (LAS float*)(lds + 36864);
            LAS float* G63 = (LAS float*)(lds + 40960);
            unsigned pfa[8], pq[8], pv[8]; float plb0, plb1;
#define HA_REQ(U_) do { int uu_ = (U_); asm volatile("" : "+s"(uu_)); const int bh_ = uu_ >> 6, c_ = uu_ & 63, b_ = bh_ >> 3, h_ = bh_ & 7; \
                const size_t rowb_ = (size_t)b_ * SEQ + c_ * 64 + sg * 8; const int col_ = h_ * 128 + 2 * cp; \
                _Pragma("unroll") for (int i = 0; i < 8; ++i) { pfa[i] = *(const unsigned*)(FA + (rowb_ + i) * 1024 + col_); pq[i] = *(const unsigned*)(QA + (rowb_ + i) * 1024 + col_); pv[i] = *(const unsigned*)(IA + (rowb_ + i) * 1024 + col_); } plb0 = LB[l * 1024 + col_]; plb1 = LB[l * 1024 + col_ + 1]; } while (0)
            HA_REQ(blk);
            for (int u = blk; u < 2048; u += G) {
                const int bh = u >> 6, c = u & 63, b = bh >> 3, h = bh & 7;
                const size_t rowb = (size_t)b * SEQ + c * 64 + sg * 8; const int col = h * 128 + 2 * cp;
                const float lb0 = plb0, lb1 = plb1;
                float lf0[8], lf1[8], kk0[8], kk1[8]; unsigned cq[8], cv[8];
#pragma unroll
                for (int i = 0; i < 8; ++i) { cq[i] = pq[i]; cv[i] = pv[i]; }
#pragma unroll
                for (int i = 0; i < 8; ++i) { const float2 fa = make_float2(bflo(pfa[i]), bfhi(pfa[i]));
                    const float f0 = fminf(fmaxf(lb0 + (1.f - lb0) * sigm(fa.x), 1e-6f), 1.f), f1 = fminf(fmaxf(lb1 + (1.f - lb1) * sigm(fa.y), 1e-6f), 1.f);
                    lf0[i] = __logf(f0); lf1[i] = __logf(f1); kk0[i] = (1.f - lb0) * sigm(-fa.x); kk1[i] = (1.f - lb1) * sigm(-fa.y); }
#pragma unroll
                for (int i = 1; i < 8; ++i) { lf0[i] += lf0[i - 1]; lf1[i] += lf1[i - 1]; }
                SEGT[sg * 128 + 2 * cp] = lf0[7]; SEGT[sg * 128 + 2 * cp + 1] = lf1[7];
                HA_REQ(u + G < 2048 ? u + G : u);
                __syncthreads();
                float pre0 = 0.f, pre1 = 0.f, r0 = 0.f, r1 = 0.f, t0 = 0.f, t1 = 0.f;
#pragma unroll
                for (int s2 = 0; s2 < 8; ++s2) { const float a0 = SEGT[s2 * 128 + 2 * cp], a1 = SEGT[s2 * 128 + 2 * cp + 1];
                    if (s2 < sg) { pre0 += a0; pre1 += a1; } if (s2 < 4) { r0 += a0; r1 += a1; } t0 += a0; t1 += a1; }
                unsigned ksw0[4], ksw1[4], vw0[4], vw1[4]; float ks0p = 0.f, ks1p = 0.f, v0p = 0.f, v1p = 0.f;
#pragma unroll
                for (int i = 0; i < 8; ++i) {
                    const float b0 = pre0 + lf0[i], b1 = pre1 + lf1[i];
                    const unsigned qw = cq[i]; const unsigned vw = cv[i];
                    const float qs0 = bflo(qw) * __expf(b0 - r0), qs1 = bfhi(qw) * __expf(b1 - r1);
                    const float ks0 = kk0[i] * __expf(r0 - b0), ks1 = kk1[i] * __expf(r1 - b1);
                    *(unsigned*)(QSB + (rowb + i) * 1024 + col) = pk2(qs0, qs1);
                    *(unsigned*)(KSB + (rowb + i) * 1024 + col) = pk2(ks0, ks1);
                    if (i & 1) { ksw0[i >> 1] = pk2(ks0p, ks0); ksw1[i >> 1] = pk2(ks1p, ks1); vw0[i >> 1] = pk2(v0p, bflo(vw)); vw1[i >> 1] = pk2(v1p, bfhi(vw)); }
                    else { ks0p = ks0; ks1p = ks1; v0p = bflo(vw); v1p = bfhi(vw); }
                }
                *(LAS v4u*)(KST + (2 * cp) * 144 + sg * 16) = (v4u){ksw0[0], ksw0[1], ksw0[2], ksw0[3]};
                *(LAS v4u*)(KST + (2 * cp + 1) * 144 + sg * 16) = (v4u){ksw1[0], ksw1[1], ksw1[2], ksw1[3]};
                *(LAS v4u*)(VTL + (2 * cp) * 144 + sg * 16) = (v4u){vw0[0], vw0[1], vw0[2], vw0[3]};
                *(LAS v4u*)(VTL + (2 * cp + 1) * 144 + sg * 16) = (v4u){vw1[0], vw1[1], vw1[2], vw1[3]};
                if (sg == 7) { float* de = DEB + (size_t)u * 256; *(float2*)(de + 2 * cp) = make_float2(__expf(r0), __expf(r1)); *(float2*)(de + 128 + 2 * cp) = make_float2(__expf(t0), __expf(t1));
                    G63[2 * cp] = __expf(t0 - r0); G63[2 * cp + 1] = __expf(t1 - r1); }
                __syncthreads();
                { const int kt = wave >> 1, vt0 = (wave & 1) * 2, lr = lane & 31, lh = lane >> 5;
                  f32x16 acc0, acc1;
#pragma unroll
                  for (int r = 0; r < 16; ++r) { acc0[r] = 0.f; acc1[r] = 0.f; }
#pragma unroll
                  for (int s4 = 0; s4 < 4; ++s4) {
                      const bf16x8 kb = *(const LAS bf16x8*)(KST + (kt * 32 + lr) * 144 + (s4 * 16 + 8 * lh) * 2);
                      const bf16x8 a0 = *(const LAS bf16x8*)(VTL + (vt0 * 32 + lr) * 144 + (s4 * 16 + 8 * lh) * 2);
                      const bf16x8 a1 = *(const LAS bf16x8*)(VTL + ((vt0 + 1) * 32 + lr) * 144 + (s4 * 16 + 8 * lh) * 2);
                      acc0 = __builtin_amdgcn_mfma_f32_32x32x16_bf16(a0, kb, acc0, 0, 0, 0); acc1 = __builtin_amdgcn_mfma_f32_32x32x16_bf16(a1, kb, acc1, 0, 0, 0); }
                  bf16* kvt = KVT + (size_t)u * 16384 + kt * 32 + lr; const float g = G63[kt * 32 + lr];
#pragma unroll
                  for (int r = 0; r < 16; ++r) { const int vv = 8 * (r >> 2) + 4 * lh + (r & 3);
                      kvt[(size_t)(vt0 * 32 + vv) * 128] = (bf16)(pk2(acc0[r] * g, 0.f) & 0xffffu); kvt[(size_t)((vt0 + 1) * 32 + vv) * 128] = (bf16)(pk2(acc1[r] * g, 0.f) & 0xffffu); } }
                __syncthreads();
            }
        }
#undef HA_REQ
        PHASE_END
        GRID_BAR();
        }
        for (int rep_ = 0; rep_ < REP_M2; ++rep_) {
        PHASE_BEGIN
        for (int item = gtid; item < 32 * 4096; item += NT) {
            const int bh = item >> 12, v = (item >> 5) & 127, k4 = (item & 31) * 4;
            f32x4 S = {0.f, 0.f, 0.f, 0.f};
            for (int c0 = 0; c0 < 64; c0 += 8) {
                f32x4 kv[8], dd[8], ee[8];
#pragma unroll
                for (int j = 0; j < 8; ++j) { const size_t u = (size_t)bh * 64 + c0 + j; kv[j] = ldbf4(KVT + u * 16384 + v * 128 + k4); ee[j] = *(const f32x4*)(DEB + u * 256 + k4); dd[j] = *(const f32x4*)(DEB + u * 256 + 128 + k4); }
#pragma unroll
                for (int j = 0; j < 8; ++j) { const size_t u = (size_t)bh * 64 + c0 + j; const f32x4 sp = S * ee[j]; v2u w; w.x = pk2(sp[0], sp[1]); w.y = pk2(sp[2], sp[3]);
                    *(v2u*)(SPB + u * 16384 + v * 128 + k4) = w; S = S * dd[j] + kv[j]; }
            }
        }
        PHASE_END
        PHASE_BEGIN
        { pg8::Gemm g{CQN, W3, M, N3, SAR, SAR, SAR, 0}; pg8::StaticOrder S; S.init(M, N3, G, blk);
          EpiQ E{QB, QIDX}; pg8::gemm_phase(lds, g, S, E, tid); }
        PHASE_END
        GRID_BAR();
        }
        for (int st_ = 0; st_ < 2; ++st_) {
        if ((st_ == 0) == (((blk >> 3) & 1) == 0)) {
        PHASE_BEGIN
        {
            LAS unsigned char* QSL = lds;
            LAS unsigned char* KSL = lds + 17408;
            LAS unsigned char* VTL = lds + 34816;
            LAS unsigned char* SPL = lds + 53248;
            LAS unsigned char* AL = lds + 88064;
            LAS float* SSQ = (LAS float*)(lds + 97280);
            const int cp = tid & 63, sg = tid >> 6, lr = lane & 31, lh = lane >> 5;
            v4u rq[2], rk[2], rs[4]; unsigned rv[8]; unsigned short rg[16];
#define HC_REQ(U_) do { int uu_ = (U_); asm volatile("" : "+s"(uu_));   const int bh_ = uu_ >> 6, c_ = uu_ & 63, b_ = bh_ >> 3, h_ = bh_ & 7; const size_t row0_ = (size_t)b_ * SEQ + c_ * 64; const int col0_ = h_ * 128; \
                _Pragma("unroll") for (int j = 0; j < 2; ++j) { const int q = tid + 512 * j, rr = q >> 4, cc = q & 15; \
                    rq[j] = *(const v4u*)(QSB + (row0_ + rr) * 1024 + col0_ + cc * 8); rk[j] = *(const v4u*)(KSB + (row0_ + rr) * 1024 + col0_ + cc * 8); } \
                _Pragma("unroll") for (int j = 0; j < 4; ++j) { const int q = tid + 512 * j, rr = q >> 4, cc = q & 15; rs[j] = *(const v4u*)(SPB + (size_t)uu_ * 16384 + rr * 128 + cc * 8); } \
                _Pragma("unroll") for (int i = 0; i < 8; ++i) rv[i] = *(const unsigned*)(IA + (row0_ + sg * 8 + i) * 1024 + col0_ + 2 * cp); \
                { const int it_ = wave >> 2, vt_ = wave & 3; const int colg_ = col0_ + vt_ * 32 + lr; \
                  _Pragma("unroll") for (int r = 0; r < 16; ++r) { const int ii = it_ * 32 + 8 * (r >> 2) + 4 * lh + (r & 3); rg[r] = GA[(row0_ + ii) * 1024 + colg_]; } } } while (0)
            HC_REQ(blk);
            for (int u = blk; u < 2048; u += G) {
                const int bh = u >> 6, c = u & 63, b = bh >> 3, h = bh & 7;
                const size_t row0 = (size_t)b * SEQ + c * 64; const int col0 = h * 128;
#pragma unroll
                for (int j = 0; j < 2; ++j) { const int q = tid + 512 * j, rr = q >> 4, cc = q & 15;
                    *(LAS v4u*)(QSL + rr * 272 + cc * 16) = rq[j]; *(LAS v4u*)(KSL + rr * 272 + cc * 16) = rk[j]; }
#pragma unroll
                for (int j = 0; j < 4; ++j) { const int q = tid + 512 * j, rr = q >> 4, cc = q & 15; *(LAS v4u*)(SPL + rr * 272 + cc * 16) = rs[j]; }
                { unsigned vw0[4], vw1[4]; float v0p = 0.f, v1p = 0.f;
#pragma unroll
                  for (int i = 0; i < 8; ++i) { const unsigned vw = rv[i];
                      if (i & 1) { vw0[i >> 1] = pk2(v0p, bflo(vw)); vw1[i >> 1] = pk2(v1p, bfhi(vw)); } else { v0p = bflo(vw); v1p = bfhi(vw); } }
                  *(LAS v4u*)(VTL + (2 * cp) * 144 + sg * 16) = (v4u){vw0[0], vw0[1], vw0[2], vw0[3]};
                  *(LAS v4u*)(VTL + (2 * cp + 1) * 144 + sg * 16) = (v4u){vw1[0], vw1[1], vw1[2], vw1[3]}; }
                float gav[16];
#pragma unroll
                for (int r = 0; r < 16; ++r) gav[r] = bf2f(rg[r]);
                const float gg = g_hg[l * 1024 + col0 + (wave & 3) * 32 + lr];
                HC_REQ(u + G < 2048 ? u + G : u);
                __syncthreads();
                if (wave < 4) {
                    const int it = wave >> 1, jt = wave & 1;
                    f32x16 acc;
#pragma unroll
                    for (int r = 0; r < 16; ++r) acc[r] = 0.f;
                    if (!(it == 0 && jt == 1)) {
#pragma unroll
                        for (int s8 = 0; s8 < 8; ++s8) {
                            const bf16x8 a = *(const LAS bf16x8*)(QSL + (it * 32 + lr) * 272 + (s8 * 16 + 8 * lh) * 2);
                            const bf16x8 bb = *(const LAS bf16x8*)(KSL + (jt * 32 + lr) * 272 + (s8 * 16 + 8 * lh) * 2);
                            acc = __builtin_amdgcn_mfma_f32_32x32x16_bf16(a, bb, acc, 0, 0, 0); } }
                    const int jj = jt * 32 + lr;
#pragma unroll
                    for (int r = 0; r < 16; ++r) { const int ii = it * 32 + 8 * (r >> 2) + 4 * lh + (r & 3); const float x = (jj <= ii) ? acc[r] : 0.f;
                        *(LAS unsigned short*)(AL + ii * 144 + jj * 2) = (unsigned short)(pk2(x, 0.f) & 0xffffu); }
                }
                __syncthreads();
                { const int it = wave >> 2, vt = wave & 3;
                  f32x16 acc;
#pragma unroll
                  for (int r = 0; r < 16; ++r) acc[r] = 0.f;
#pragma unroll
                  for (int s4 = 0; s4 < 4; ++s4) {
                      const bf16x8 a = *(const LAS bf16x8*)(AL + (it * 32 + lr) * 144 + (s4 * 16 + 8 * lh) * 2);
                      const bf16x8 bb = *(const LAS bf16x8*)(VTL + (vt * 32 + lr) * 144 + (s4 * 16 + 8 * lh) * 2);
                      acc = __builtin_amdgcn_mfma_f32_32x32x16_bf16(a, bb, acc, 0, 0, 0); }
#pragma unroll
                  for (int s8 = 0; s8 < 8; ++s8) {
                      const bf16x8 a = *(const LAS bf16x8*)(QSL + (it * 32 + lr) * 272 + (s8 * 16 + 8 * lh) * 2);
                      const bf16x8 bb = *(const LAS bf16x8*)(SPL + (vt * 32 + lr) * 272 + (s8 * 16 + 8 * lh) * 2);
                      acc = __builtin_amdgcn_mfma_f32_32x32x16_bf16(a, bb, acc, 0, 0, 0); }
#pragma unroll
                  for (int r = 0; r < 16; ++r) { float q2 = acc[r] * acc[r];
                      q2 = xsum16(rowsum16(q2));
                      if (lr == 0) SSQ[vt * 64 + it * 32 + 8 * (r >> 2) + 4 * lh + (r & 3)] = q2; }
                  __syncthreads();
                  const int colg = col0 + vt * 32 + lr;
#pragma unroll
                  for (int r = 0; r < 16; ++r) { const int ii = it * 32 + 8 * (r >> 2) + 4 * lh + (r & 3);
                      const float ss = SSQ[ii] + SSQ[64 + ii] + SSQ[128 + ii] + SSQ[192 + ii]; const float rn = 1.0f / sqrtf(ss * (1.f / 128.f) + 1e-6f);
                      YAB[(row0 + ii) * 2048 + colg] = (bf16)(pk2(acc[r] * rn * gg * gav[r], 0.f) & 0xffffu); }
                }
                __syncthreads();
            }
        }
#undef HC_REQ
        PHASE_END
        } else {
        PHASE_BEGIN
        for (int ub = blk * NWAVES; ub < 2048; ub += NGW) {
            const int unit = ub + wave;
            const int b = ub >> 9, j = unit & 511, lr = lane & 31, lh = lane >> 5;
            const int qsel = (lr >> 2) & 1, head = (lr >> 3) * 4 + (lr & 3);
            const int qlo = 4 * j, qhi = 4 * (1023 - j);
            const int nlo = ((qlo >> 6) + 1) * 64, nhi = ((qhi >> 6) + 1) * 64;
            const int nlo8 = (nlo + 511) & ~511, nhi8 = (nhi + 511) & ~511;
            const int nmax8 = (((((4 * (1023 - (ub & 511))) >> 6) + 1) * 64) + 511) & ~511;
            bf16x8 A[4][4]; float W[4][16]; typedef float f32x2_t __attribute__((ext_vector_type(2)));
#pragma unroll
            for (int p = 0; p < 4; ++p) { const size_t qb = (size_t)b * SEQ + (p < 2 ? qlo + 2 * p : qhi + 2 * (p - 2));
#pragma unroll
                for (int ks = 0; ks < 4; ++ks) A[p][ks] = *(const bf16x8*)(QIDX + (qb + qsel) * 1024 + head * 64 + ks * 16 + lh * 8);
#pragma unroll
                for (int r4 = 0; r4 < 4; ++r4) { const f32x4 w = *(const f32x4*)(IDXW + (qb + lh) * 16 + r4 * 4); W[p][r4 * 4] = w[0]; W[p][r4 * 4 + 1] = w[1]; W[p][r4 * 4 + 2] = w[2]; W[p][r4 * 4 + 3] = w[3]; } }
            const bf16* kb = KIDX + (size_t)b * SEQ * 64;
            const int srow = 8 * wave + (lane >> 3), spc = ((lane & 7) ^ ((srow >> 1) & 7)) * 8;
#define P4_STAGE(C0_, BUF_) do { _Pragma("unroll") for (int i = 0; i < 4; ++i) \
                __builtin_amdgcn_global_load_lds((const unsigned*)(kb + (size_t)((C0_) + 64 * i + srow) * 64 + spc), (LAS unsigned*)(lds + (BUF_) * 32768 + (i * 8 + wave) * 1024), 16, 0, 0); } while (0)
            P4_STAGE(0, 0);
            asm volatile("s_waitcnt vmcnt(0)" ::: "memory");
            __syncthreads();
            for (int c0 = 0; c0 < nmax8; c0 += 256) {
                const int cb = (c0 >> 8) & 1; const bool more = c0 + 256 < nmax8;
                if (more) P4_STAGE(c0 + 256, cb ^ 1);
                LAS unsigned char* kbuf = lds + cb * 32768;
#pragma unroll 1
                for (int tl = 0; tl < 8; ++tl) {
                    const int s0 = c0 + tl * 32;
                    if (s0 >= nhi8) break;
#pragma unroll
                    for (int p = 0; p < 4; ++p) { const int np = p < 2 ? nlo : nhi, np8 = p < 2 ? nlo8 : nhi8;
                        if (s0 >= np && s0 < np8) { const size_t q = (size_t)b * SEQ + (p < 2 ? qlo + 2 * p : qhi + 2 * (p - 2)) + lh; ISC[q * 4096 + s0 + lr] = (_Float16)(-60000.0f); } }
                    if (s0 >= nhi) continue;
                    bf16x8 B[4];
#pragma unroll
                    for (int ks = 0; ks < 4; ++ks) B[ks] = *(const LAS bf16x8*)(kbuf + (tl * 32 + lr) * 128 + (((2 * ks + lh) ^ ((lr >> 1) & 7)) * 16));
#define IDX_FINISH(P_, ACC_) do { f32x2_t s2_ = {0.f, 0.f};     \
                        _Pragma("unroll") for (int r = 0; r < 16; r += 2) { const float a0_ = ACC_[r], a1_ = ACC_[r + 1]; const int i0_ = __builtin_bit_cast(int, a0_), i1_ = __builtin_bit_cast(int, a1_); \
                            const f32x2_t rl_ = {__builtin_bit_cast(float, i0_ > 0 ? i0_ : 0), __builtin_bit_cast(float, i1_ > 0 ? i1_ : 0)}; const f32x2_t w_ = {W[P_][r], W[P_][r + 1]}; \
                            s2_ = __builtin_elementwise_fma(rl_, w_, s2_); } \
                        const float sc_ = s2_[0] + s2_[1]; \
                        const size_t q_ = (size_t)b * SEQ + ((P_) < 2 ? qlo + 2 * (P_) : qhi + 2 * ((P_) - 2)) + lh; ISC[q_ * 4096 + s0 + lr] = (_Float16)sc_; } while (0)
                    if (s0 < nlo) {
                        f32x16 c0_, c1_, c2_, c3_;
#pragma unroll
                        for (int r = 0; r < 16; ++r) { c0_[r] = 0.f; c1_[r] = 0.f; c2_[r] = 0.f; c3_[r] = 0.f; }
#pragma unroll
                        for (int ks = 0; ks < 4; ++ks) { c0_ = __builtin_amdgcn_mfma_f32_32x32x16_bf16(A[0][ks], B[ks], c0_, 0, 0, 0); c1_ = __builtin_amdgcn_mfma_f32_32x32x16_bf16(A[1][ks], B[ks], c1_, 0, 0, 0);
                            c2_ = __builtin_amdgcn_mfma_f32_32x32x16_bf16(A[2][ks], B[ks], c2_, 0, 0, 0); c3_ = __builtin_amdgcn_mfma_f32_32x32x16_bf16(A[3][ks], B[ks], c3_, 0, 0, 0); }
                        IDX_FINISH(0, c0_); IDX_FINISH(1, c1_); IDX_FINISH(2, c2_); IDX_FINISH(3, c3_);
                    } else {
                        f32x16 c2_, c3_;
#pragma unroll
                        for (int r = 0; r < 16; ++r) { c2_[r] = 0.f; c3_[r] = 0.f; }
#pragma unroll
                        for (int ks = 0; ks < 4; ++ks) { c2_ = __builtin_amdgcn_mfma_f32_32x32x16_bf16(A[2][ks], B[ks], c2_, 0, 0, 0); c3_ = __builtin_amdgcn_mfma_f32_32x32x16_bf16(A[3][ks], B[ks], c3_, 0, 0, 0); }
                        IDX_FINISH(2, c2_); IDX_FINISH(3, c3_);
                    }
#undef IDX_FINISH
                }
                asm volatile("s_waitcnt vmcnt(0)" ::: "memory");
                __syncthreads();
            }
        }
#undef P4_STAGE
        PHASE_END
        }
        __syncthreads();
        }
        GRID_BAR();
        for (int rep_ = 0; rep_ < REP_P5; ++rep_) {
        PHASE_BEGIN
        {
            LAS unsigned char* VB = lds + wave * 18432;
            LAS unsigned short* SELW = (LAS unsigned short*)(VB + 17408);
            const int hd = lane & 15, g = lane >> 4, qq = hd >> 2, pp = hd & 3;
            const float slope = exp2f(-0.5f * (float)(hd + 1));
            for (int q = gw; q < M; q += NGW) {
                const int b = q / SEQ, pos = q % SEQ, qc = pos >> 6; const int nsel = qc < 4 ? (qc + 1) * 64 : 256;
                for (int rtk_ = 0; rtk_ < REP_TOPK; ++rtk_) {
                int lane_t = lane; asm volatile("" : "+v"(lane_t));
                if (qc < 4) { const unsigned e0 = 4 * lane_t; const bool ok = 4 * lane_t < nsel; v2u z; z.x = ok ? (e0 | ((e0 + 1) << 16)) : 0u; z.y = ok ? ((e0 + 2) | ((e0 + 3) << 16)) : 0u; *(LAS v2u*)(SELW + 4 * lane_t) = z; }
                else {
                    LAS unsigned* HIST = (LAS unsigned*)VB;
                    const int nb8 = (qc + 8) >> 3;
                    float v[64];
                    { unsigned pk[32]; const int i2max = 4 * nb8 - 1; const _Float16* irow = ISC + (size_t)q * 4096 + 2 * lane_t; typedef _Float16 h2_t __attribute__((ext_vector_type(2)));
#pragma unroll
                      for (int i2 = 0; i2 < 32; ++i2) { const int ic = i2 < i2max ? i2 : i2max; pk[i2] = *(const unsigned*)(irow + ic * 128); }
#pragma unroll
                      for (int i2 = 0; i2 < 32; ++i2) { const float lim = (i2 >> 2) < nb8 ? 3.0e38f : -1.0e30f; const h2_t h = __builtin_bit_cast(h2_t, pk[i2]);
                          const float f0 = (float)h[0], f1 = (float)h[1]; v[2 * i2] = fminf(f0, lim); v[2 * i2 + 1] = fminf(f1, lim); } }
                    float vmx = v[0], vmn = fminf(fminf(v[0], v[1]), fminf(v[2], v[3]));
#pragma unroll
                    for (int i = 1; i < 64; ++i) vmx = fmaxf(vmx, v[i]);
                    vmx = wmax_f(vmx); vmn = -wmax_f(-vmn);
                    const float rng = vmx - vmn; const float s20 = rng > 0.f ? 1048574.0f / rng : 0.f;
#define ZERO_HIST() do { *(LAS v4u*)(HIST + 16 * lane) = (v4u){0u, 0u, 0u, 0u}; *(LAS v4u*)(HIST + 16 * lane + 4) = (v4u){0u, 0u, 0u, 0u}; *(LAS v4u*)(HIST + 16 * lane + 8) = (v4u){0u, 0u, 0u, 0u}; \
                        *(LAS v4u*)(HIST + 16 * lane + 12) = (v4u){0u, 0u, 0u, 0u}; HIST[1024 + lane] = 0u; } while (0)
#define SCAN_HIST(R_, BIN_, AB_) do { unsigned hh_[16]; const int hb_ = 1008 - 16 * lane; \
                        { const v4u h0 = *(const LAS v4u*)(HIST + hb_), h1 = *(const LAS v4u*)(HIST + hb_ + 4), h2 = *(const LAS v4u*)(HIST + hb_ + 8), h3 = *(const LAS v4u*)(HIST + hb_ + 12); \
                          hh_[0] = h0.x; hh_[1] = h0.y; hh_[2] = h0.z; hh_[3] = h0.w; hh_[4] = h1.x; hh_[5] = h1.y; hh_[6] = h1.z; hh_[7] = h1.w; hh_[8] = h2.x; hh_[9] = h2.y; hh_[10] = h2.z; hh_[11] = h2.w; hh_[12] = h3.x; hh_[13] = h3.y; hh_[14] = h3.z; hh_[15] = h3.w; } \
                        unsigned tot_ = 0u; _Pragma("unroll") for (int k = 0; k < 16; ++k) tot_ += hh_[k]; \
                        unsigned run_ = wprefix_u(tot_) - tot_; int fb_ = -1; unsigned fa_ = 0u; \
                        _Pragma("unroll") for (int k = 15; k >= 0; --k) { if (run_ < (R_) && run_ + hh_[k] >= (R_)) { fb_ = hb_ + k; fa_ = run_; } run_ += hh_[k]; } \
                        const unsigned long long bm_ = __ballot(fb_ >= 0); const int L_ = (int)__builtin_ctzll(bm_); \
                        BIN_ = (unsigned)__builtin_amdgcn_readlane(fb_, L_); AB_ = (unsigned)__builtin_amdgcn_readlane((int)fa_, L_); } while (0)
                    ZERO_HIST();
#pragma unroll
                    for (int i = 0; i < 64; ++i) v[i] = __builtin_bit_cast(float, (unsigned)((v[i] - vmn) * s20));
#define cd(i_) __builtin_bit_cast(unsigned, v[i_])
#pragma unroll
                    for (int g8 = 0; g8 < 8; ++g8) { if (g8 < nb8) {
#pragma unroll
                        for (int j = 0; j < 8; ++j) __hip_atomic_fetch_add(HIST + (cd(g8 * 8 + j) >> 10), 1u, __ATOMIC_RELAXED, __HIP_MEMORY_SCOPE_WORKGROUP); } }
                    LDS_WAIT(); asm volatile("" ::: "memory");
                    unsigned tb, above; SCAN_HIST(256u, tb, above);
                    ZERO_HIST();
                    LDS_WAIT(); asm volatile("" ::: "memory");
#pragma unroll
                    for (int g8 = 0; g8 < 8; ++g8) { if (g8 < nb8) {
#pragma unroll
                        for (int j = 0; j < 8; ++j) { const unsigned c = cd(g8 * 8 + j); const unsigned a = (c >> 10) == tb ? (c & 1023u) : 1024u + lane; __hip_atomic_fetch_add(HIST + a, 1u, __ATOMIC_RELAXED, __HIP_MEMORY_SCOPE_WORKGROUP); } } }
                    LDS_WAIT(); asm volatile("" ::: "memory");
                    unsigned tb2, ab2; { const unsigned R2 = 256u - above; SCAN_HIST(R2, tb2, ab2); }
                    const unsigned T = (tb << 10) | tb2; above += ab2;
                    unsigned baseg = 0u, basee = above;
#pragma unroll
                    for (int g8 = 0; g8 < 8; ++g8) { if (g8 < nb8) {
#pragma unroll
                        for (int j = 0; j < 8; ++j) { const int i = g8 * 8 + j;
                            const bool gt = cd(i) > T; const unsigned long long bg = __ballot(gt);
                            const unsigned pgp = baseg + __builtin_amdgcn_mbcnt_hi((unsigned)(bg >> 32), __builtin_amdgcn_mbcnt_lo((unsigned)bg, 0u));
                            if (gt) SELW[pgp] = (unsigned short)((i >> 1) * 128 + (i & 1) + 2 * lane);
                            baseg += (unsigned)__popcll(bg);
                            const bool eq = cd(i) == T; const unsigned long long be = __ballot(eq);
                            if (be) { const unsigned pep = basee + __builtin_amdgcn_mbcnt_hi((unsigned)(be >> 32), __builtin_amdgcn_mbcnt_lo((unsigned)be, 0u));
                                if (eq && pep < 256u) SELW[pep] = (unsigned short)((i >> 1) * 128 + (i & 1) + 2 * lane);
                                basee += (unsigned)__popcll(be); } } } }
#undef cd
#undef ZERO_HIST
#undef SCAN_HIST
                }
                LDS_WAIT(); asm volatile("" ::: "memory");
                }
                for (int rat_ = 0; rat_ < REP_ATT; ++rat_) {
                bf16* qrow = QB + (size_t)q * 4096;
                bf16x8 Bq[8];
#pragma unroll
                for (int ks = 0; ks < 8; ++ks) Bq[ks] = *(const bf16x8*)(qrow + hd * 256 + ks * 32 + g * 8);
                const bf16* kvb = CKV + (size_t)b * SEQ * 256;
                f32x4 O[16];
#pragma unroll
                for (int ct = 0; ct < 16; ++ct) O[ct] = (f32x4){0.f, 0.f, 0.f, 0.f};
                float mrun = -1.0e30f, lsum = 0.f;
                LDS_WAIT(); asm volatile("" ::: "memory");
                const int nks = nsel >> 5;
                const int lrow = lane >> 5, lcp = lane & 31, lsh = 16 * lrow;
                v4u KR[16];
#define ATT_IDX(KST_) v4u iw_[4]; _Pragma("unroll") for (int c = 0; c < 4; ++c) iw_[c] = *(const LAS v4u*)(SELW + 32 * (KST_) + 8 * c)
#define ATT_LOADROWS(KST_) do { ATT_IDX(KST_); _Pragma("unroll") for (int i = 0; i < 16; ++i) { const int rr_ = 2 * i + lrow; const unsigned w_ = iw_[i >> 2][i & 3]; const int ix_ = (int)((w_ >> lsh) & 0xffffu); \
                    KR[i] = *(const v4u*)(kvb + (size_t)ix_ * 256 + ((lcp ^ (rr_ & 7)) * 8)); } } while (0)
                ATT_LOADROWS(0);
                const int rlA = hd & 7;
                const int rlT = (4 * g + qq) & 7;
                const int trb = (4 * g + qq) * 512 + 8 * (pp & 1), trm = 16 * ((pp >> 1) ^ rlT);
                for (int kst = 0; kst < nks; ++kst) {
                    int rlA_ = rlA, trm_ = trm; asm volatile("" : "+v"(rlA_), "+v"(trm_));
                    if (kst + 1 < nks) {
                        ATT_IDX(kst + 1);
#pragma unroll
                        for (int i = 0; i < 16; ++i) { *(LAS v4u*)(VB + i * 1024 + lane * 16) = KR[i];
                            const int rr_ = 2 * i + lrow; const unsigned w_ = iw_[i >> 2][i & 3]; const int ix_ = (int)((w_ >> lsh) & 0xffffu); KR[i] = *(const v4u*)(kvb + (size_t)ix_ * 256 + ((lcp ^ (rr_ & 7)) * 8)); }
                    } else {
#pragma unroll
                        for (int i = 0; i < 16; ++i) *(LAS v4u*)(VB + i * 1024 + lane * 16) = KR[i]; }
                    LDS_WAIT(); asm volatile("" ::: "memory");
                    f32x4 S0 = {0.f, 0.f, 0.f, 0.f}, S1 = {0.f, 0.f, 0.f, 0.f};
#pragma unroll
                    for (int k4 = 0; k4 < 4; ++k4) {
                        bf16x8 a0[2], a1[2];
#pragma unroll
                        for (int j = 0; j < 2; ++j) { const int ks = k4 * 2 + j; const int cpos = (4 * ks + g) ^ rlA_;
                            a0[j] = *(const LAS bf16x8*)(VB + hd * 512 + cpos * 16); a1[j] = *(const LAS bf16x8*)(VB + (16 + hd) * 512 + cpos * 16); }
#pragma unroll
                        for (int j = 0; j < 2; ++j) { const int ks = k4 * 2 + j;
                            S0 = __builtin_amdgcn_mfma_f32_16x16x32_bf16(a0[j], Bq[ks], S0, 0, 0, 0); S1 = __builtin_amdgcn_mfma_f32_16x16x32_bf16(a1[j], Bq[ks], S1, 0, 0, 0); }
                    }
                    const v2u pa = *(const LAS v2u*)(SELW + 32 * kst + 4 * g), pb = *(const LAS v2u*)(SELW + 32 * kst + 16 + 4 * g);
                    const float fp = (float)pos;
                    float s0[4], s1[4];
                    s0[0] = S0[0] - slope * fabsf(fp - (float)(pa.x & 0xffffu)); s0[1] = S0[1] - slope * fabsf(fp - (float)(pa.x >> 16));
                    s0[2] = S0[2] - slope * fabsf(fp - (float)(pa.y & 0xffffu)); s0[3] = S0[3] - slope * fabsf(fp - (float)(pa.y >> 16));
                    s1[0] = S1[0] - slope * fabsf(fp - (float)(pb.x & 0xffffu)); s1[1] = S1[1] - slope * fabsf(fp - (float)(pb.x >> 16));
                    s1[2] = S1[2] - slope * fabsf(fp - (float)(pb.y & 0xffffu)); s1[3] = S1[3] - slope * fabsf(fp - (float)(pb.y >> 16));
                    float ml = fmaxf(fmaxf(fmaxf(s0[0], s0[1]), fmaxf(s0[2], s0[3])), fmaxf(fmaxf(s1[0], s1[1]), fmaxf(s1[2], s1[3])));
                    ml = xmax16(ml); ml = xmax32(ml);
                    const float mnew = fmaxf(mrun, ml), alpha = __expf(mrun - mnew); mrun = mnew;
                    float p0[4], p1[4];
#pragma unroll
                    for (int r = 0; r < 4; ++r) { p0[r] = __expf(s0[r] - mnew); p1[r] = __expf(s1[r] - mnew); }
                    lsum = lsum * alpha + ((p0[0] + p0[1]) + (p0[2] + p0[3])) + ((p1[0] + p1[1]) + (p1[2] + p1[3]));
                    v4u pw; pw.x = pk2(p0[0], p0[1]); pw.y = pk2(p0[2], p0[3]); pw.z = pk2(p1[0], p1[1]); pw.w = pk2(p1[2], p1[3]);
                    const bf16x8 Pf = __builtin_bit_cast(bf16x8, pw);
#pragma unroll
                    for (int ct = 0; ct < 16; ++ct) O[ct] = O[ct] * alpha;
#pragma unroll
                    for (int c8 = 0; c8 < 4; ++c8) {
                        v4s lo[4], hi[4];
#pragma unroll
                        for (int j = 0; j < 4; ++j) { const int ct = c8 * 4 + j; const int off = trb + ((32 * ct) ^ trm_);
                            lo[j] = __builtin_amdgcn_ds_read_tr16_b64_v4i16((LAS v4s*)(VB + off));
                            hi[j] = __builtin_amdgcn_ds_read_tr16_b64_v4i16((LAS v4s*)(VB + 16 * 512 + off)); }
#pragma unroll
                        for (int j = 0; j < 4; ++j) { const int ct = c8 * 4 + j;
                            const bf16x8 Af = {lo[j][0], lo[j][1], lo[j][2], lo[j][3], hi[j][0], hi[j][1], hi[j][2], hi[j][3]};
                            O[ct] = __builtin_amdgcn_mfma_f32_16x16x32_bf16(Af, Pf, O[ct], 0, 0, 0); }
                    }
                    LDS_WAIT(); asm volatile("" ::: "memory");
                }
#undef ATT_LOADROWS
#undef ATT_IDX
                lsum = xsum16(lsum); lsum = xsum32(lsum);
                const float inv = 1.0f / lsum;
#pragma unroll
                for (int ct = 0; ct < 16; ++ct) { const f32x4 o = O[ct] * inv; v2u w; w.x = pk2(o[0], o[1]); w.y = pk2(o[2], o[3]); *(v2u*)(OB + (size_t)q * 4096 + hd * 256 + 16 * ct + 4 * g) = w; }
                }
            }
        }
        PHASE_END
        GRID_BAR();
        }
        PHASE_BEGIN
        { pg8::Gemm g{OB, W6, M, 1024, 1024, 4096, 1024, 1024}; pg8::StaticOrder S; S.init(M, 1024, G, blk);
          EpiBf E{YAB, 2048, 1024}; pg8::gemm_phase(lds, g, S, E, tid); }
        PHASE_END
        GRP_BAR(0);
        PHASE_BEGIN
        { pg8::Gemm g{YAB, W7, M, DM, DM, DM, DM, 0}; pg8::StaticOrder S; S.init(M, DM, G, blk);
          EpiGateM E{GTB, MRG}; HookGate Hk{GTA, GTB}; pg8::gemm_phase(lds, g, S, E, tid, Hk); }
        PHASE_END
        GRP_BAR(1);
        PHASE_BEGIN
        { pg8::Gemm g{MRG, W8, M, DM, DM, DM, DM, 0}; pg8::StaticOrder S; S.init(M, DM, G, blk);
          S.mode = 1;
          EpiLn<0, false> E{ws, (l == 0) ? x_in : (const float*)nullptr, (float*)nullptr, ln1_g + l * DM, ln1_b + l * DM, lds, l};
          pg8::gemm_phase(lds, g, S, E, tid); }
        PHASE_END
        GRP_BAR(2);
        PHASE_BEGIN
        { pg8::Gemm g{HB, W10, M, N10, DM, DM, DM, 0}; pg8::StaticOrder S; S.init(M, N10, G, blk);
          EpiSwiglu E{ACT}; pg8::gemm_phase(lds, g, S, E, tid); }
        PHASE_END
        GRP_BAR(3);
        if (l == DEPTH - 1) {
        PHASE_BEGIN
        { pg8::Gemm g{ACT, W11, M, DM, DFF, DFF, DFF, 0, 1}; pg8::StaticOrder S; S.init(M, DM, G, blk); S.mode = 1;
          EpiLn<1, true> E{ws, (const float*)nullptr, args.out, ln2_g + l * DM, ln2_b + l * DM, lds, l}; pg8::gemm_phase(lds, g, S, E, tid); }
        PHASE_END
        } else {
        PHASE_BEGIN
        { pg8::Gemm g{ACT, W11, M, DM, DFF, DFF, DFF, 0, 1}; pg8::StaticOrder S; S.init(M, DM, G, blk); S.mode = 1;
          EpiLn<1, false> E{ws, (const float*)nullptr, (float*)nullptr, ln2_g + l * DM, ln2_b + l * DM, lds, l}; pg8::gemm_phase(lds, g, S, E, tid); }
        PHASE_END
        }
        if (l + 1 < DEPTH) {
            GRID_BAR();
            PHASE_BEGIN
            { CONVERT_LAYER(l + 1); }
            PHASE_END
            GRID_BAR();
        }
    }
}

extern "C" void kernel_launch(void* const* d_in, const int* in_sizes, int n_in, void* d_out, int out_size, void* d_ws, size_t ws_size, hipStream_t stream) {
    static int grid = 0;
    if (grid == 0) {
        if (n_in != 22 || out_size != M * DM || ws_size < WS_END) { fprintf(stderr, "kernel_launch: unexpected shapes (n_in %d, out %d, ws %zu < %zu)\n", n_in, out_size, ws_size, (size_t)WS_END); grid = -1; return; }
        int dev = 0, cus = 0, per_cu = 0;
        if (hipGetDevice(&dev) != hipSuccess || hipDeviceGetAttribute(&cus, hipDeviceAttributeMultiprocessorCount, dev) != hipSuccess) { grid = -1; return; }
        if (hipFuncSetAttribute((const void*)fwd_kernel, hipFuncAttributeMaxDynamicSharedMemorySize, LDS_BYTES) != hipSuccess) { fprintf(stderr, "kernel_launch: hipFuncSetAttribute failed\n"); grid = -1; return; }
        if (hipOccupancyMaxActiveBlocksPerMultiprocessor(&per_cu, (const void*)fwd_kernel, NTHR, LDS_BYTES) != hipSuccess || per_cu < 1) { fprintf(stderr, "kernel_launch: occupancy query says %d\n", per_cu); }
        (void)hipGetLastError();
        if (cus % 64 != 0) { fprintf(stderr, "kernel_launch: %d CUs: the fused-LayerNorm unit order needs a multiple of 64 workgroups\n", cus); grid = -1; return; }
        grid = cus;
    }
    if (grid < 0) return;
    if (hipMemsetAsync((char*)d_ws + WS_CTL, 0, CTL_ZERO_BYTES, stream) != hipSuccess) return;
    Args a{};
    for (int i = 0; i < 22; ++i) a.in[i] = (const float*)d_in[i];
    a.out = (float*)d_out; a.ws = (unsigned char*)d_ws;
    hipLaunchKernelGGL(fwd_kernel, dim3(grid), dim3(NTHR), LDS_BYTES, stream, a);
}
```

```cpp
#include <hip/hip_runtime.h>
#include <cstdio>
#include <cstdint>

namespace pg8 {
#define PG8_LAS __attribute__((address_space(3)))
typedef unsigned short bf16_t;
typedef short bf16x8 __attribute__((ext_vector_type(8)));
typedef float f32x4 __attribute__((ext_vector_type(4)));
typedef unsigned u32x4 __attribute__((ext_vector_type(4)));
constexpr int BM = 256, BK = 64, HALF = 128, HTB = HALF * BK * 2, STAGE_BYTES = 8 * HTB, NXCD = 8, WGM = 8;

__host__ __device__ __forceinline__ int lds_byte(int r, int c) { const int st = (r >> 4) * 2 + (c >> 5), rr = r & 15, cc = c & 31, ob = rr * 64 + cc * 2; return st * 1024 + (ob ^ (((ob >> 9) & 1) << 5)); }
__host__ __device__ __forceinline__ void stage_rc(int b, int& R, int& C) { const int st = b / 1024, sb = b % 1024, swz = sb ^ (((sb >> 9) & 1) << 5); R = (st >> 1) * 16 + swz / 64; C = (st & 1) * 32 + (swz % 64) / 2; }
__host__ __device__ __forceinline__ int perm32(int rho) { const int n = rho >> 4, i = rho & 15; return 8 * (i >> 2) + 4 * n + (i & 3); }

struct Unit { int pm, pn; };
struct Gemm { const bf16_t* A; const bf16_t* Bt; int M, N, K, lda, ldb, a_pn_stride; int krev = 0; };

struct StaticOrder {
    int nM, nN, nwg, G, c, mode;
    __host__ __device__ void init(int M, int N, int G_, int c_) { nM = M / BM; nN = N / BM; nwg = nM * nN; G = G_; c = c_; mode = 0; }
    __host__ __device__ bool next(int i, Unit& u) const {
        if (mode == 1) {
            const int PR = G >> 3, x = c & 7, j = c >> 3, pq = PR >> 3, nx = nM >> 3; if (i * pq + (j >> 3) >= nx) return false; u.pm = x * nx + i * pq + (j >> 3); u.pn = j & 7; return true; }
        const long L = (long)i * G + c; if (L >= nwg) return false;
        int wgid = (int)L; { const int q = nwg / NXCD, r = nwg % NXCD, xcd = wgid % NXCD, off = wgid / NXCD; wgid = (xcd < r ? xcd * (q + 1) : r * (q + 1) + (xcd - r) * q) + off; }
        const int nig = WGM * nN, gid = wgid / nig, fm = gid * WGM, gsz = (nM - fm) < WGM ? (nM - fm) : WGM;
        u.pm = fm + ((wgid % nig) % gsz); u.pn = (wgid % nig) / gsz; return true;
    }
};

typedef float f32x2_t __attribute__((ext_vector_type(2))); typedef __bf16 bf16x2_t __attribute__((ext_vector_type(2)));
__device__ __forceinline__ unsigned cvt_pk_bf16(float lo, float hi) { f32x2_t v = {lo, hi}; bf16x2_t b = __builtin_convertvector(v, bf16x2_t); return __builtin_bit_cast(unsigned, b); }

struct NoHook { static constexpr bool ON = false; template <class A> __device__ __forceinline__ void mid(A&, const Unit&, int, int, int, int) const {} };
template <class Epi, class Hook = NoHook>
__device__ __forceinline__ void gemm_phase(PG8_LAS unsigned char* lds, const Gemm g, const StaticOrder& S, const Epi& E, const int tid, const Hook H = Hook()) {
    const int wid = __builtin_amdgcn_readfirstlane(tid >> 6), lane = tid & 63, wr = wid >> 2, wc = wid & 3, fr = lane & 15, fq = lane >> 4;
    const int K = g.K, nt = K / BK;
    unsigned voffA[2], voffB[2];
#pragma unroll
    for (int i = 0; i < 2; ++i) { int R, C; stage_rc(tid * 16 + i * 8192, R, C); const int Rb = 64 * (R >> 5) + perm32(R & 31);
        voffA[i] = (unsigned)(R * g.lda + C) * 2u; voffB[i] = (unsigned)(Rb * g.ldb + C) * 2u; }
    const long kstep = g.krev ? -(long)(BK * 2) : (long)(BK * 2); const size_t kbase = g.krev ? (size_t)(nt - 1) * (BK * 2) : 0;
    const size_t hstepA = (size_t)HALF * g.lda * 2, hstepB = (size_t)32 * g.ldb * 2;
    const size_t tstepA = 2 * hstepA, tstepB = (size_t)BM * g.ldb * 2;
    const unsigned ldsw = (unsigned)wid * 1024u;
    const int aoff = lds_byte(wr * 64 + fr, fq * 8), boff = lds_byte(wc * 32 + fr, fq * 8);
#define PG8_SA(b, h) (((b) * 2 + (h)) * HTB)
#define PG8_SB(b, h) ((4 + (b) * 2 + (h)) * HTB)
#define PG8_STAGE(bufoff, gbase, voff) do { _Pragma("unroll") for (int _i = 0; _i < 2; ++_i) \
        __builtin_amdgcn_global_load_lds((const unsigned*)((const char*)(gbase) + (voff)[_i]), (PG8_LAS unsigned*)(lds + (bufoff) + ldsw + _i * 8192), 16, 0, 0); } while (0)
#define PG8_LDA(dst, b, h) do { _Pragma("unroll") for (int m = 0; m < 4; ++m) _Pragma("unroll") for (int k = 0; k < 2; ++k) dst[m][k] = *(const PG8_LAS bf16x8*)(lds + PG8_SA(b, h) + aoff + m * 2048 + k * 1024); } while (0)
#define PG8_LDB(dst, b, h) do { _Pragma("unroll") for (int n = 0; n < 2; ++n) _Pragma("unroll") for (int k = 0; k < 2; ++k) dst[n][k] = *(const PG8_LAS bf16x8*)(lds + PG8_SB(b, h) + boff + n * 2048 + k * 1024); } while (0)
#define PG8_MMA(ai, bj, At, Bt) do { __builtin_amdgcn_s_setprio(1); _Pragma("unroll") for (int m = 0; m < 4; ++m) _Pragma("unroll") for (int n = 0; n < 2; ++n) _Pragma("unroll") for (int k = 0; k < 2; ++k) \
        acc[ai][bj][m][n] = __builtin_amdgcn_mfma_f32_16x16x32_bf16(Bt[n][k], At[m][k], acc[ai][bj][m][n], 0, 0, 0); __builtin_amdgcn_s_setprio(0); } while (0)
#define PG8_WAIT_V(n) asm volatile("s_waitcnt vmcnt(" #n ")" ::: "memory")
#define PG8_WAIT_L(n) asm volatile("s_waitcnt lgkmcnt(" #n ")" ::: "memory")
#define PG8_BAR __builtin_amdgcn_s_barrier()
#define PG8_SCHED __builtin_amdgcn_sched_barrier(0)
    Unit cur, nxt; int ui = 0;
    if (!S.next(0, cur)) return;
    f32x4 acc[2][2][4][2];
#pragma unroll
    for (int a = 0; a < 2; ++a)
#pragma unroll
        for (int b = 0; b < 2; ++b)
#pragma unroll
            for (int m = 0; m < 4; ++m)
#pragma unroll
                for (int n = 0; n < 2; ++n) acc[a][b][m][n] = (f32x4){0.f, 0.f, 0.f, 0.f};
    bf16x8 At[4][2], B0[2][2], B1[2][2];
    const char* cA = (const char*)g.A + (size_t)cur.pm * tstepA + (size_t)cur.pn * g.a_pn_stride * 2 + kbase; const char* cB = (const char*)g.Bt + (size_t)cur.pn * tstepB + kbase;
    PG8_STAGE(PG8_SB(0, 0), cB, voffB); PG8_STAGE(PG8_SB(0, 1), cB + hstepB, voffB); PG8_STAGE(PG8_SA(0, 0), cA, voffA); PG8_STAGE(PG8_SA(0, 1), cA + hstepA, voffA);
    if (wr == 1) PG8_BAR;
    PG8_WAIT_V(2); PG8_BAR;
    PG8_STAGE(PG8_SB(1, 0), cB + kstep, voffB); PG8_STAGE(PG8_SA(1, 0), cA + kstep, voffA); PG8_STAGE(PG8_SB(1, 1), cB + hstepB + kstep, voffB);
    PG8_WAIT_V(6); PG8_BAR;
    for (;;) {
        const bool has_next = S.next(ui + 1, nxt);
        const char* nA = has_next ? (const char*)g.A + (size_t)nxt.pm * tstepA + (size_t)nxt.pn * g.a_pn_stride * 2 + kbase : cA; const char* nB = has_next ? (const char*)g.Bt + (size_t)nxt.pn * tstepB + kbase : cB;
        for (int t = 0; t < nt; t += 2) {
            const bool last = (t == nt - 2);
            const char* a1 = cA + (long)(t + 1) * kstep;
            const char* a2 = last ? nA : cA + (long)(t + 2) * kstep; const char* b2 = last ? nB : cB + (long)(t + 2) * kstep;
            const char* a3 = a2 + kstep; const char* b3 = b2 + kstep;
            if constexpr (Hook::ON) { if (t == (nt >> 1)) H.mid(acc, cur, wr, wc, fr, fq); }
            PG8_LDB(B0, 0, 0); PG8_LDB(B1, 0, 1); PG8_SCHED; PG8_LDA(At, 0, 0); PG8_STAGE(PG8_SA(1, 1), a1 + hstepA, voffA);
            PG8_WAIT_V(8); PG8_WAIT_L(0); PG8_BAR; PG8_MMA(0, 0, At, B0); PG8_MMA(0, 1, At, B1); PG8_BAR; PG8_SCHED;
            PG8_LDA(At, 0, 1); PG8_STAGE(PG8_SB(0, 0), b2, voffB); PG8_STAGE(PG8_SB(0, 1), b2 + hstepB, voffB); PG8_STAGE(PG8_SA(0, 0), a2, voffA);
            PG8_WAIT_V(8); PG8_WAIT_L(0); PG8_BAR; PG8_MMA(1, 0, At, B0); PG8_MMA(1, 1, At, B1); PG8_BAR; PG8_SCHED;
            PG8_LDB(B0, 1, 0); PG8_LDB(B1, 1, 1); PG8_SCHED; PG8_LDA(At, 1, 0); PG8_STAGE(PG8_SA(0, 1), a2 + hstepA, voffA);
            PG8_WAIT_V(8); PG8_WAIT_L(0); PG8_BAR; PG8_MMA(0, 0, At, B0); PG8_MMA(0, 1, At, B1); PG8_BAR; PG8_SCHED;
            PG8_LDA(At, 1, 1); PG8_STAGE(PG8_SB(1, 0), b3, voffB); PG8_STAGE(PG8_SB(1, 1), b3 + hstepB, voffB); PG8_STAGE(PG8_SA(1, 0), a3, voffA);
            PG8_WAIT_V(8); PG8_WAIT_L(0); PG8_BAR; PG8_MMA(1, 0, At, B0); PG8_MMA(1, 1, At, B1); PG8_BAR; PG8_SCHED;
        }
        if (wr == 0) PG8_BAR;
        E(acc, cur, wr, wc, fr, fq);
        if (!has_next) break;
#pragma unroll
        for (int a = 0; a < 2; ++a)
#pragma unroll
            for (int b = 0; b < 2; ++b)
#pragma unroll
                for (int m = 0; m < 4; ++m)
#pragma unroll
                    for (int n = 0; n < 2; ++n) acc[a][b][m][n] = (f32x4){0.f, 0.f, 0.f, 0.f};
        cur = nxt; cA = nA; cB = nB; ++ui;
        if (wr == 1) PG8_BAR;
    }
    PG8_WAIT_V(0);
    PG8_BAR;
#undef PG8_SA
#undef PG8_SB
#undef PG8_STAGE
#undef PG8_LDA
#undef PG8_LDB
#undef PG8_MMA
#undef PG8_WAIT_V
#undef PG8_WAIT_L
#undef PG8_BAR
#undef PG8_SCHED
}
}

constexpr int NWAVES = 8, NTHR = NWAVES * 64;
constexpr int DM = 2048, NBATCH = 4, SEQ = 4096, DEPTH = 4, M = NBATCH * SEQ;
constexpr int HGW = 1024;
constexpr int SAH = 16, SAC = 256, SAR = 512;
constexpr int DFF = 5632;
constexpr int N1 = 9216, N3 = 5120, N10 = 2 * DFF;
constexpr float ALPHA = 1.6817928305074292f;
constexpr int MODW = 6 * DM;

constexpr size_t MiB = 1u << 20;
constexpr size_t WS_CTL = 0, CTL_ZERO_BYTES = 32768;
constexpr size_t WS_MOD = 1 * MiB;
constexpr size_t WS_LB = 2 * MiB;
constexpr size_t WS_MODP = 3 * MiB;
constexpr size_t WS_W1 = 9 * MiB;
constexpr size_t WS_W3 = WS_W1 + 36 * MiB;
constexpr size_t WS_W6 = WS_W3 + 5 * MiB;
constexpr size_t WS_W7 = WS_W6 + 2 * MiB;
constexpr size_t WS_W8 = WS_W7 + 8 * MiB;
constexpr size_t WS_W10 = WS_W8 + 8 * MiB;
constexpr size_t WS_W11 = WS_W10 + 44 * MiB;
constexpr size_t WS_X = WS_W11 + 22 * MiB;
constexpr size_t WS_R = WS_X + 128 * MiB;
constexpr size_t WS_H = WS_R + 128 * MiB;
constexpr size_t WS_QA = WS_H + 64 * MiB;
constexpr size_t WS_FA = WS_QA + 32 * MiB;
constexpr size_t WS_IA = WS_FA + 64 * MiB;
constexpr size_t WS_GA = WS_IA + 32 * MiB;
constexpr size_t WS_LAT = WS_GA + 32 * MiB;
constexpr size_t WS_GTA = WS_LAT + 64 * MiB;
constexpr size_t WS_GTB = WS_GTA + 64 * MiB;
constexpr size_t WS_CQN = WS_GTB + 64 * MiB;
constexpr size_t WS_CKV = WS_CQN + 16 * MiB;
constexpr size_t WS_KIDX = WS_CKV + 8 * MiB;
constexpr size_t WS_IDXW = WS_KIDX + 2 * MiB;
constexpr size_t WS_QB = WS_IDXW + 1 * MiB;
constexpr size_t WS_QIDX = WS_QB + 128 * MiB;
constexpr size_t WS_SEL = WS_QIDX + 32 * MiB;
constexpr size_t WS_YAB = WS_SEL + 8 * MiB;
constexpr size_t WS_MRG = WS_FA;
constexpr size_t WS_OB = WS_YAB + 64 * MiB;
constexpr size_t WS_BIG = WS_OB + 128 * MiB;
constexpr size_t WS_KSB = WS_BIG + 256 * MiB;
constexpr size_t WS_DEB = WS_KSB + 32 * MiB;
constexpr size_t WS_QSB = WS_DEB + 2 * MiB;
constexpr size_t WS_END = WS_QSB + 32 * MiB;

constexpr int CW_BAR = 4096;

constexpr int RING_BYTES = 131072;
constexpr int LDS_BYTES = 163840;
constexpr int LDSCTL_OFF = LDS_BYTES - 1024, MISC_OFF = LDSCTL_OFF + 320, SELL_OFF = 147456;

#define GAS __attribute__((address_space(1)))
#define LAS __attribute__((address_space(3)))
typedef unsigned short bf16;
typedef unsigned v4u __attribute__((ext_vector_type(4)));
typedef unsigned v2u __attribute__((ext_vector_type(2)));
typedef float f32x4 __attribute__((ext_vector_type(4)));
typedef float f32x16 __attribute__((ext_vector_type(16)));
typedef short bf16x8 __attribute__((ext_vector_type(8)));
typedef short v4s __attribute__((ext_vector_type(4)));
typedef GAS unsigned gu32;
#define LDS_WAIT() asm volatile("s_waitcnt lgkmcnt(0)" ::: "memory")
__device__ __forceinline__ unsigned f2bf(float f) { unsigned u = __builtin_bit_cast(unsigned, f); return (u + 0x7fffu + ((u >> 16) & 1u)) >> 16; }
__device__ __forceinline__ unsigned pk2(float lo, float hi) { return pg8::cvt_pk_bf16(lo, hi); }
__device__ __forceinline__ float bf2f(unsigned short b) { return __builtin_bit_cast(float, ((unsigned)b) << 16); }
__device__ __forceinline__ float bflo(unsigned w) { return __builtin_bit_cast(float, w << 16); }
__device__ __forceinline__ float bfhi(unsigned w) { return __builtin_bit_cast(float, w & 0xffff0000u); }
__device__ __forceinline__ float sigm(float x) { return __builtin_amdgcn_rcpf(1.f + __expf(-x)); }

__device__ __forceinline__ int lane_id() { unsigned m = ~0u; asm volatile("" : "+s"(m)); return (int)__builtin_amdgcn_mbcnt_hi(m, __builtin_amdgcn_mbcnt_lo(m, 0u)); }
#define XB_TMO      128
#define XB_XCNT(j)  (256  + 64 * (j))
#define XB_XSUB(j)  (1280 + 64 * (j))
#define XB_XGEN(j)  (2304 + 64 * (j))
#define XB_TOP      3328
#define XB_TOPGEN   3392
#define XCD_BAR_WORDS 3456
#define XB_SPIN_CAP (1u << 22)

__device__ __forceinline__ unsigned xb_ld(unsigned* p)              { return __hip_atomic_load(p, __ATOMIC_RELAXED, __HIP_MEMORY_SCOPE_AGENT); }
__device__ __forceinline__ unsigned xb_add(unsigned* p, unsigned v) { return __hip_atomic_fetch_add(p, v, __ATOMIC_RELAXED, __HIP_MEMORY_SCOPE_AGENT); }
__device__ __forceinline__ unsigned xb_xcc_id() { return (unsigned)__builtin_amdgcn_s_getreg((3 << 11) | 20) & 0xFu; }
#define XB_SPIN(cond, bar) do { unsigned _sp = 0; while (cond) { __builtin_amdgcn_s_sleep(1); \
    if ((++_sp & 255u) == 0u) { if (xb_ld(&(bar)[XB_TMO])) break; if (_sp > XB_SPIN_CAP) { atomicAdd(&(bar)[XB_TMO], 1u); break; } } } } while (0)

struct XcdBarrier { unsigned* bar; unsigned x; volatile LAS unsigned* st; int wave; };

__device__ __forceinline__ XcdBarrier xcd_barrier_post(unsigned* bar, volatile LAS unsigned* st) {
    XcdBarrier b; b.bar = bar; b.x = (unsigned)__builtin_amdgcn_readfirstlane((int)xb_xcc_id()); b.st = st;
    if (threadIdx.x == 0) (void)xb_add(&bar[XB_XCNT(b.x)], 1u);
    return b;
}
__device__ __forceinline__ void xcd_barrier_complete(unsigned* bar, unsigned x, unsigned& nloc, unsigned& nx) {
    const unsigned G = gridDim.x * gridDim.y * gridDim.z;
    unsigned sum, cnt, mine, sp = 0u;
    for (;;) {
        sum = 0u; cnt = 0u; mine = 0u;
#pragma unroll 1
        for (unsigned j = 0; j < 16; ++j) { const unsigned c = xb_ld(&bar[XB_XCNT(j)]); sum += c; cnt += (c > 0u) ? 1u : 0u; mine = (j == x) ? c : mine; }
        if (sum == G) break;
        __builtin_amdgcn_s_sleep(1);
        if ((++sp & 255u) == 0u) { if (xb_ld(&bar[XB_TMO])) break; if (sp > XB_SPIN_CAP) { atomicAdd(&bar[XB_TMO], 1u); break; } }
    }
    nloc = mine > 0u ? mine : 1u; nx = cnt > 0u ? cnt : 1u;
}
__device__ __forceinline__ void xcd_barrier(const XcdBarrier& b) {
    asm volatile("s_waitcnt vmcnt(0)" ::: "memory");
    __syncthreads();
    if (b.wave == 0 && lane_id() == 0) {
        unsigned* bar = b.bar;
        unsigned bx = b.x; asm volatile("" : "+s"(bx));
        __builtin_amdgcn_s_waitcnt(0);
        unsigned nloc = b.st[0], nx = b.st[1];
        const unsigned old = xb_add(&bar[XB_XSUB(bx)], 1u);
        const unsigned gen = old / nloc;
        if (old + 1u == (gen + 1u) * nloc) {
            __builtin_amdgcn_fence(__ATOMIC_RELEASE, "agent");
            asm volatile("s_waitcnt vmcnt(0)" ::: "memory");
            const unsigned og = xb_add(&bar[XB_TOP], 1u);
            const unsigned tg = og / nx;
            if (og + 1u == (tg + 1u) * nx) xb_add(&bar[XB_TOPGEN], 1u);
            else XB_SPIN(xb_ld(&bar[XB_TOPGEN]) == tg, bar);
            __builtin_amdgcn_fence(__ATOMIC_ACQUIRE, "agent");
            xb_add(&bar[XB_XGEN(bx)], 1u);
            asm volatile("s_waitcnt vmcnt(0)" ::: "memory");
        } else {
            XB_SPIN(xb_ld(&bar[XB_XGEN(bx)]) == gen, bar);
            __builtin_amdgcn_fence(__ATOMIC_ACQUIRE, "agent");
            asm volatile("s_waitcnt vmcnt(0)" ::: "memory");
        }
    }
    __syncthreads();
}

__device__ __forceinline__ void xswap16(float& a, float& b) { asm volatile("s_nop 1\n\tv_permlane16_swap_b32 %0, %1\n\ts_nop 1" : "+v"(a), "+v"(b)); }
__device__ __forceinline__ void xswap32(float& a, float& b) { asm volatile("s_nop 1\n\tv_permlane32_swap_b32 %0, %1\n\ts_nop 1" : "+v"(a), "+v"(b)); }
__device__ __forceinline__ float xmax16(float x) { float a = x, b = x; xswap16(a, b); return fmaxf(a, b); }
__device__ __forceinline__ float xmax32(float x) { float a = x, b = x; xswap32(a, b); return fmaxf(a, b); }
__device__ __forceinline__ float xsum16(float x) { float a = x, b = x; xswap16(a, b); return a + b; }
__device__ __forceinline__ float xsum32(float x) { float a = x, b = x; xswap32(a, b); return a + b; }

#define DPPF(x, ctrl) __builtin_bit_cast(float, __builtin_amdgcn_update_dpp(0, __builtin_bit_cast(int, (x)), (ctrl), 0xf, 0xf, true))
__device__ __forceinline__ float wmax_f(float x) {
    x = fmaxf(x, DPPF(x, 0xB1)); x = fmaxf(x, DPPF(x, 0x4E)); x = fmaxf(x, DPPF(x, 0x124)); x = fmaxf(x, DPPF(x, 0x128));
    x = xmax16(x); return xmax32(x);
}
__device__ __forceinline__ unsigned wprefix_u(unsigned x) {
    int v = (int)x;
    v += __builtin_amdgcn_update_dpp(0, v, 0x111, 0xf, 0xf, false);
    v += __builtin_amdgcn_update_dpp(0, v, 0x112, 0xf, 0xf, false);
    v += __builtin_amdgcn_update_dpp(0, v, 0x114, 0xf, 0xf, false);
    v += __builtin_amdgcn_update_dpp(0, v, 0x118, 0xf, 0xf, false);
    v += __builtin_amdgcn_update_dpp(0, v, 0x142, 0xa, 0xf, false);
    v += __builtin_amdgcn_update_dpp(0, v, 0x143, 0xc, 0xf, false);
    return (unsigned)v;
}

__device__ __forceinline__ float rowsum16(float x) { x += DPPF(x, 0xB1); x += DPPF(x, 0x4E); x += DPPF(x, 0x124); x += DPPF(x, 0x128); return x; }
__device__ __forceinline__ float wave_sum(float x) { x = rowsum16(x); x = xsum16(x); return xsum32(x); }
__device__ __forceinline__ float wave_max(float x) { return wmax_f(x); }
__device__ __forceinline__ int wave_sum_i(int v) { float f = wave_sum((float)v); return (int)(f + 0.5f); }
template <class Src>
__device__ __forceinline__ void cvt_load(const Src& src, int k0, int n0, int lane, float (&tv)[32]) {
#pragma unroll
    for (int j = 0; j < 8; ++j) { const f32x4 v = src(k0 + 8 * j + (lane >> 3), n0 + 4 * (lane & 7)); tv[4 * j] = v[0]; tv[4 * j + 1] = v[1]; tv[4 * j + 2] = v[2]; tv[4 * j + 3] = v[3]; }
}
__device__ __forceinline__ void cvt_store(const float (&tv)[32], bf16* WT, int K, int k0, int n0, LAS float* scr, int lane) {
#pragma unroll
    for (int j = 0; j < 8; ++j)
#pragma unroll
        for (int e = 0; e < 4; ++e) scr[(8 * j + (lane >> 3)) * 33 + 4 * (lane & 7) + e] = tv[4 * j + e];
    LDS_WAIT(); asm volatile("" ::: "memory");
    const int c = lane & 7;
#pragma unroll
    for (int j = 0; j < 4; ++j) { const int n = (lane >> 3) + 8 * j; const LAS float* s = scr + (8 * c) * 33 + n;
        v4u o; o.x = pk2(s[0 * 33], s[1 * 33]); o.y = pk2(s[2 * 33], s[3 * 33]); o.z = pk2(s[4 * 33], s[5 * 33]); o.w = pk2(s[6 * 33], s[7 * 33]);
        *(GAS v4u*)(WT + (size_t)(n0 + n) * K + k0 + 8 * c) = o; }
    LDS_WAIT(); asm volatile("" ::: "memory");
}

struct Args { const float* in[22]; float* out; unsigned char* ws; };

using pg8::Unit; using pg8::cvt_pk_bf16;
__device__ __forceinline__ void st_bf16x8(bf16* p, f32x4 v0, f32x4 v1) {
    v4u w; w.x = cvt_pk_bf16(v0[0], v0[1]); w.y = cvt_pk_bf16(v0[2], v0[3]); w.z = cvt_pk_bf16(v1[0], v1[1]); w.w = cvt_pk_bf16(v1[2], v1[3]);
    *(v4u*)p = w;
}
__device__ __forceinline__ void st_f32x8(float* p, f32x4 v0, f32x4 v1) { *(f32x4*)p = v0; *(f32x4*)(p + 4) = v1; }
__device__ __forceinline__ f32x4 sigm4(f32x4 v) { return (f32x4){sigm(v[0]), sigm(v[1]), sigm(v[2]), sigm(v[3])}; }
__device__ __forceinline__ f32x4 silu4(f32x4 v) { return (f32x4){v[0] * sigm(v[0]), v[1] * sigm(v[1]), v[2] * sigm(v[2]), v[3] * sigm(v[3])}; }
__device__ __forceinline__ f32x4 ldbf4(const bf16* p) { const v2u w = *(const v2u*)p; return (f32x4){bflo(w.x), bfhi(w.x), bflo(w.y), bfhi(w.y)}; }

#define EPI_LOOP(...) \
    _Pragma("unroll") for (int ai = 0; ai < 2; ++ai) _Pragma("unroll") for (int m = 0; m < 4; ++m) { const int row = row0 + ai * 128 + m * 16; \
        _Pragma("unroll") for (int bj = 0; bj < 2; ++bj) { const int col = colb + bj * 32; const f32x4 v0 = acc[ai][bj][m][0], v1 = acc[ai][bj][m][1]; __VA_ARGS__ } }

__device__ __forceinline__ unsigned q8x4(f32x4 g) { unsigned w = 0u;
#pragma unroll
    for (int e = 0; e < 4; ++e) { const float t = fmaxf(__builtin_fmaf(g[e], 255.f, 0.5f), 1.f); w |= ((unsigned)t) << (8 * e); } return w; }
__device__ __forceinline__ f32x4 ub4(unsigned w) { return (f32x4){(float)(w & 0xffu), (float)((w >> 8) & 0xffu), (float)((w >> 16) & 0xffu), (float)(w >> 24)}; }
struct EpiProj {
    bf16* QA; bf16* FA; bf16* IA; bf16* GA; bf16* LAT; bf16* GTA; bf16* GTB;
    __device__ __forceinline__ void operator()(const f32x4 (&acc)[2][2][4][2], const Unit& u, int wr, int wc, int fr, int fq) const {
        const int row0 = u.pm * 256 + wr * 64 + fr, pn = u.pn; const int colb = (pn & 3) * 256 + wc * 64 + 8 * fq;
        if (pn < 4)       { EPI_LOOP( st_bf16x8(QA + (size_t)row * 1024 + col, v0, v1); ) }
        else if (pn < 8)  { EPI_LOOP( st_bf16x8(FA + (size_t)row * 1024 + col, v0, v1); ) }
        else if (pn < 12) { EPI_LOOP( st_bf16x8(IA + (size_t)row * 1024 + col, v0, v1); ) }
        else if (pn < 16) { EPI_LOOP( st_bf16x8(GA + (size_t)row * 1024 + col, silu4(v0), silu4(v1)); ) }
        else if (pn < 20) { EPI_LOOP( st_bf16x8(LAT + (size_t)row * 1024 + col, v0, v1); ) }
        else { unsigned char* G8 = (unsigned char*)(pn < 28 ? GTA : GTB) + ((size_t)(u.pm * 8 + ((pn - 20) & 7)) * 8 + (wr * 4 + wc)) * 8192 + (fq * 16 + fr) * 16;
            _Pragma("unroll") for (int ai = 0; ai < 2; ++ai) _Pragma("unroll") for (int bj = 0; bj < 2; ++bj) _Pragma("unroll") for (int mp = 0; mp < 2; ++mp) { v4u w;
                w.x = q8x4(sigm4(acc[ai][bj][2 * mp][0])); w.y = q8x4(sigm4(acc[ai][bj][2 * mp][1])); w.z = q8x4(sigm4(acc[ai][bj][2 * mp + 1][0])); w.w = q8x4(sigm4(acc[ai][bj][2 * mp + 1][1]));
                *(v4u*)(G8 + (ai * 4 + bj * 2 + mp) * 1024) = w; } }
    }
};
struct EpiQ {
    bf16* QB; bf16* QIDX;
    __device__ __forceinline__ void operator()(const f32x4 (&acc)[2][2][4][2], const Unit& u, int wr, int wc, int fr, int fq) const {
        const int row0 = u.pm * 256 + wr * 64 + fr, pn = u.pn;
        if (pn < 16) { const int colb = pn * 256 + wc * 64 + 8 * fq; EPI_LOOP( st_bf16x8(QB + (size_t)row * 4096 + col, v0, v1); ) }
        else { const int colb = (pn - 16) * 256 + wc * 64 + 8 * fq; EPI_LOOP( st_bf16x8(QIDX + (size_t)row * 1024 + col, v0, v1); ) }
    }
};
struct EpiBf {
    bf16* O; int ldc; int coff;
    __device__ __forceinline__ void operator()(const f32x4 (&acc)[2][2][4][2], const Unit& u, int wr, int wc, int fr, int fq) const {
        const int row0 = u.pm * 256 + wr * 64 + fr; const int colb = coff + u.pn * 256 + wc * 64 + 8 * fq;
        EPI_LOOP( st_bf16x8(O + (size_t)row * ldc + col, v0, v1); )
    }
};
struct HookGate {
    static constexpr bool ON = true; const bf16* GA_; const bf16* GB_;
    __device__ __forceinline__ void mid(f32x4 (&acc)[2][2][4][2], const Unit& u, int wr, int wc, int fr, int fq) const {
        asm volatile("" : "+v"(fr), "+v"(fq));
        const size_t off = ((size_t)(u.pm * 8 + u.pn) * 8 + (wr * 4 + wc)) * 8192 + (fq * 16 + fr) * 16;
        const unsigned char* A8 = (const unsigned char*)GA_ + off; const unsigned char* B8 = (const unsigned char*)GB_ + off;
#pragma unroll
        for (int ai = 0; ai < 2; ++ai)
#pragma unroll
            for (int mp = 0; mp < 2; ++mp) {
#pragma unroll
                for (int bj = 0; bj < 2; ++bj) { const v4u a = *(const v4u*)(A8 + (ai * 4 + bj * 2 + mp) * 1024), b = *(const v4u*)(B8 + (ai * 4 + bj * 2 + mp) * 1024);
#pragma unroll
                    for (int mm = 0; mm < 2; ++mm)
#pragma unroll
                        for (int n = 0; n < 2; ++n) { const unsigned aw = a[mm * 2 + n], bw = b[mm * 2 + n]; const f32x4 fa = ub4(aw), fb = ub4(bw); f32x4 r;
#pragma unroll
                            for (int j = 0; j < 4; ++j) r[j] = fa[j] * __builtin_amdgcn_rcpf(fb[j]);
                            acc[ai][bj][2 * mp + mm][n] = acc[ai][bj][2 * mp + mm][n] * r; } }
                asm volatile("" : "+v"(acc[ai][0][2 * mp][0]), "+v"(acc[ai][0][2 * mp][1]), "+v"(acc[ai][1][2 * mp][0]), "+v"(acc[ai][1][2 * mp][1]));
                asm volatile("" : "+v"(acc[ai][0][2 * mp + 1][0]), "+v"(acc[ai][0][2 * mp + 1][1]), "+v"(acc[ai][1][2 * mp + 1][0]), "+v"(acc[ai][1][2 * mp + 1][1]));
                asm volatile("" ::: "memory"); }
    }
};
__device__ __forceinline__ f32x4 cvbf4(v2u w) { return (f32x4){bflo(w.x), bfhi(w.x), bflo(w.y), bfhi(w.y)}; }
struct EpiGateM {
    const bf16* GB_; bf16* MRG_;
    __device__ __forceinline__ void operator()(const f32x4 (&acc)[2][2][4][2], const Unit& u, int wr, int wc, int fr, int fq) const {
        const int row0 = u.pm * 256 + wr * 64 + fr; const int colb = u.pn * 256 + wc * 64 + 8 * fq;
        const unsigned char* B8 = (const unsigned char*)GB_ + ((size_t)(u.pm * 8 + u.pn) * 8 + (wr * 4 + wc)) * 8192 + (fq * 16 + fr) * 16;
#pragma unroll
        for (int ai = 0; ai < 2; ++ai) { v4u gr[2][2];
#pragma unroll
            for (int bj = 0; bj < 2; ++bj)
#pragma unroll
                for (int mp = 0; mp < 2; ++mp) gr[bj][mp] = *(const v4u*)(B8 + (ai * 4 + bj * 2 + mp) * 1024);
#pragma unroll
            for (int m = 0; m < 4; ++m)
#pragma unroll
                for (int bj = 0; bj < 2; ++bj) { const size_t o = (size_t)(row0 + ai * 128 + m * 16) * 2048 + colb + bj * 32;
                    const unsigned w0 = gr[bj][m >> 1][(m & 1) * 2], w1 = gr[bj][m >> 1][(m & 1) * 2 + 1];
                    st_bf16x8(MRG_ + o, acc[ai][bj][m][0] * (ub4(w0) * (1.f / 255.f)), acc[ai][bj][m][1] * (ub4(w1) * (1.f / 255.f))); } }
    }
};
struct EpiGateA {
    float* T1; const bf16* GT;
    __device__ __forceinline__ void operator()(const f32x4 (&acc)[2][2][4][2], const Unit& u, int wr, int wc, int fr, int fq) const {
        const int row0 = u.pm * 256 + wr * 64 + fr; const int colb = u.pn * 256 + wc * 64 + 8 * fq;
        EPI_LOOP( const size_t o = (size_t)row * 2048 + col; const f32x4 g0 = ldbf4(GT + o), g1 = ldbf4(GT + o + 4); st_f32x8(T1 + o, v0 * g0, v1 * g1); )
    }
};
struct EpiGateB {
    const float* T1; const bf16* GT; bf16* MRG;
    __device__ __forceinline__ void operator()(const f32x4 (&acc)[2][2][4][2], const Unit& u, int wr, int wc, int fr, int fq) const {
        const int row0 = u.pm * 256 + wr * 64 + fr; const int colb = u.pn * 256 + wc * 64 + 8 * fq;
        EPI_LOOP( const size_t o = (size_t)row * 2048 + col; const f32x4 g0 = ldbf4(GT + o), g1 = ldbf4(GT + o + 4); const f32x4 t0 = *(const f32x4*)(T1 + o), t1 = *(const f32x4*)(T1 + o + 4);
                  st_bf16x8(MRG + o, t0 + v0 * g0, t1 + v1 * g1); )
    }
};
struct EpiRes {
    const float* X; const bf16* Hh; bf16* R; const float* md; int osh, osc, ogt;
    __device__ __forceinline__ void operator()(const f32x4 (&acc)[2][2][4][2], const Unit& u, int wr, int wc, int fr, int fq) const {
        const int row0 = u.pm * 256 + wr * 64 + fr; const int colb = u.pn * 256 + wc * 64 + 8 * fq; const float* g = md + (size_t)(u.pm >> 4) * MODW;
        f32x4 gg[2][2];
#pragma unroll
        for (int bj = 0; bj < 2; ++bj) { gg[bj][0] = *(const f32x4*)(g + ogt + colb + bj * 32) + 1.f; gg[bj][1] = *(const f32x4*)(g + ogt + colb + bj * 32 + 4) + 1.f; }
        if (X) {
#pragma unroll
            for (int ai = 0; ai < 2; ++ai)
#pragma unroll
                for (int mh = 0; mh < 2; ++mh) { f32x4 xr[2][2][2];
#pragma unroll
                    for (int mm = 0; mm < 2; ++mm)
#pragma unroll
                        for (int bj = 0; bj < 2; ++bj) { const size_t o = (size_t)(row0 + ai * 128 + (2 * mh + mm) * 16) * 2048 + colb + bj * 32; xr[mm][bj][0] = *(const f32x4*)(X + o); xr[mm][bj][1] = *(const f32x4*)(X + o + 4); }
#pragma unroll
                    for (int mm = 0; mm < 2; ++mm)
#pragma unroll
                        for (int bj = 0; bj < 2; ++bj) { const int m = 2 * mh + mm; const size_t o = (size_t)(row0 + ai * 128 + m * 16) * 2048 + colb + bj * 32;
                            st_bf16x8(R + o, xr[mm][bj][0] * ALPHA + gg[bj][0] * acc[ai][bj][m][0], xr[mm][bj][1] * ALPHA + gg[bj][1] * acc[ai][bj][m][1]); } }
        } else {
            f32x4 ia[2][2], sb[2][2];
#pragma unroll
            for (int bj = 0; bj < 2; ++bj)
#pragma unroll
                for (int hh = 0; hh < 2; ++hh) { const f32x4 sc = *(const f32x4*)(g + osc + colb + bj * 32 + 4 * hh), sh = *(const f32x4*)(g + osh + colb + bj * 32 + 4 * hh);
#pragma unroll
                    for (int e = 0; e < 4; ++e) { ia[bj][hh][e] = ALPHA / (1.f + sc[e]); sb[bj][hh][e] = sh[e] * ia[bj][hh][e]; } }
#pragma unroll
            for (int ai = 0; ai < 2; ++ai) { v2u xr[4][2][2];
#pragma unroll
                for (int m = 0; m < 4; ++m)
#pragma unroll
                    for (int bj = 0; bj < 2; ++bj) { const size_t o = (size_t)(row0 + ai * 128 + m * 16) * 2048 + colb + bj * 32; xr[m][bj][0] = *(const v2u*)(Hh + o); xr[m][bj][1] = *(const v2u*)(Hh + o + 4); }
#pragma unroll
                for (int m = 0; m < 4; ++m)
#pragma unroll
                    for (int bj = 0; bj < 2; ++bj) { const size_t o = (size_t)(row0 + ai * 128 + m * 16) * 2048 + colb + bj * 32;
                        st_bf16x8(R + o, cvbf4(xr[m][bj][0]) * ia[bj][0] - sb[bj][0] + gg[bj][0] * acc[ai][bj][m][0], cvbf4(xr[m][bj][1]) * ia[bj][1] - sb[bj][1] + gg[bj][1] * acc[ai][bj][m][1]); } }
        }
    }
};
template <int which, bool FINAL>
struct EpiLn {
    unsigned char* ws; const float* X; float* Fo; const float* lng; const float* lnb; LAS unsigned char* lds; int l;
    __device__ __forceinline__ void operator()(f32x4 (&acc)[2][2][4][2], const Unit& u, int wr, int wc, int fr, int fq) const {
        { const int ln_ = lane_id(); fr = ln_ & 15; fq = ln_ >> 4; }
        int upm = u.pm, upn = u.pn; asm volatile("" : "+s"(upm), "+s"(upn));
        const float* MODb = (const float*)(ws + WS_MOD); bf16* Hh = (bf16*)(ws + WS_H);
        const float* g = MODb + ((size_t)l * NBATCH + (upm >> 4)) * MODW + (which ? 3 * DM : 0);
        const float* go = which ? MODb + ((size_t)(l + 1 < DEPTH ? l + 1 : l) * NBATCH + (upm >> 4)) * MODW : g + 3 * DM;
        LAS float* sl = (LAS float*)(lds + RING_BYTES);
        const int row0 = upm * 256 + wr * 64 + fr; const int colb = upn * 256 + wc * 64 + 8 * fq;
#pragma unroll
        for (int bj = 0; bj < 2; ++bj) { const int c0 = colb + bj * 32;
            const f32x4 gg0 = *(const f32x4*)(g + 2 * DM + c0) + 1.f, gg1 = *(const f32x4*)(g + 2 * DM + c0 + 4) + 1.f;
            if (which == 0 && X) {
#pragma unroll
                for (int ai = 0; ai < 2; ++ai) { f32x4 xr[4][2];
#pragma unroll
                    for (int m = 0; m < 4; ++m) { const size_t o = (size_t)(row0 + ai * 128 + m * 16) * 2048 + c0; xr[m][0] = *(const f32x4*)(X + o); xr[m][1] = *(const f32x4*)(X + o + 4); }
#pragma unroll
                    for (int m = 0; m < 4; ++m) { acc[ai][bj][m][0] = xr[m][0] * ALPHA + gg0 * acc[ai][bj][m][0]; acc[ai][bj][m][1] = xr[m][1] * ALPHA + gg1 * acc[ai][bj][m][1]; } }
            } else {
                f32x4 ia0, ia1, sb0, sb1;
                { const f32x4 sc0 = *(const f32x4*)(g + DM + c0), sc1 = *(const f32x4*)(g + DM + c0 + 4), sh0 = *(const f32x4*)(g + c0), sh1 = *(const f32x4*)(g + c0 + 4);
#pragma unroll
                  for (int e = 0; e < 4; ++e) { ia0[e] = ALPHA * __builtin_amdgcn_rcpf(1.f + sc0[e]); ia1[e] = ALPHA * __builtin_amdgcn_rcpf(1.f + sc1[e]); sb0[e] = sh0[e] * ia0[e]; sb1[e] = sh1[e] * ia1[e]; } }
#pragma unroll
                for (int ai = 0; ai < 2; ++ai) { v2u xr[4][2]; size_t o = (size_t)(row0 + ai * 128) * 2048 + c0;
#pragma unroll
                    for (int m = 0; m < 4; ++m) { xr[m][0] = *(const v2u*)(Hh + o); xr[m][1] = *(const v2u*)(Hh + o + 4); size_t st_ = 16 * 2048; asm volatile("" : "+s"(st_)); o += st_; }
#pragma unroll
                    for (int m = 0; m < 4; ++m) { acc[ai][bj][m][0] = cvbf4(xr[m][0]) * ia0 - sb0 + gg0 * acc[ai][bj][m][0]; acc[ai][bj][m][1] = cvbf4(xr[m][1]) * ia1 - sb1 + gg1 * acc[ai][bj][m][1]; }
                    asm volatile("" ::: "memory"); }
            }
            asm volatile("" ::: "memory"); }
        { const int ln_ = lane_id(); fr = ln_ & 15; fq = ln_ >> 4; }
#pragma unroll
        for (int ai = 0; ai < 2; ++ai)
#pragma unroll
            for (int m = 0; m < 4; ++m) { float s1 = 0.f, s2 = 0.f;
#pragma unroll
                for (int bj = 0; bj < 2; ++bj)
#pragma unroll
                    for (int hh = 0; hh < 2; ++hh) { const f32x4 v = acc[ai][bj][m][hh]; s1 += (v[0] + v[1]) + (v[2] + v[3]); s2 += (v[0] * v[0] + v[1] * v[1]) + (v[2] * v[2] + v[3] * v[3]); }
                s1 = xsum32(xsum16(s1)); s2 = xsum32(xsum16(s2));
                if (fq == 0) { const int rt = ai * 128 + wr * 64 + m * 16 + fr; sl[(wc * 256 + rt) * 2] = s1; sl[(wc * 256 + rt) * 2 + 1] = s2; } }
        __syncthreads();
        const int tid = (wr * 4 + wc) * 64 + lane_id();
        float* ex = (float*)(ws + WS_SEL) + (size_t)upm * 8 * 512;
        if (tid < 256) { const float S1 = (sl[tid * 2] + sl[(256 + tid) * 2]) + (sl[(512 + tid) * 2] + sl[(768 + tid) * 2]), S2 = (sl[tid * 2 + 1] + sl[(256 + tid) * 2 + 1]) + (sl[(512 + tid) * 2 + 1] + sl[(768 + tid) * 2 + 1]);
            __hip_atomic_store((unsigned*)(ex + (upn * 256 + tid) * 2), __builtin_bit_cast(unsigned, S1), __ATOMIC_RELAXED, __HIP_MEMORY_SCOPE_AGENT);
            __hip_atomic_store((unsigned*)(ex + (upn * 256 + tid) * 2 + 1), __builtin_bit_cast(unsigned, S2), __ATOMIC_RELAXED, __HIP_MEMORY_SCOPE_AGENT); }
        asm volatile("s_waitcnt vmcnt(0)" ::: "memory");
        __syncthreads();
        if (tid == 0) { unsigned* cp = (unsigned*)(ws + WS_CTL) + 256 + (l * 2 + which) * 64 + upm;
            __builtin_amdgcn_fence(__ATOMIC_RELEASE, "agent"); asm volatile("s_waitcnt vmcnt(0)" ::: "memory");
            (void)xb_add(cp, 1u);
            for (unsigned sp = 0u; xb_ld(cp) < 8u && sp < 400000u; ++sp) __builtin_amdgcn_s_sleep(1);
            __builtin_amdgcn_fence(__ATOMIC_ACQUIRE, "agent"); asm volatile("s_waitcnt vmcnt(0)" ::: "memory"); }
        __syncthreads();
        if (tid < 256) { float S1 = 0.f, S2 = 0.f;
#pragma unroll
            for (int p = 0; p < 8; ++p) { S1 += __builtin_bit_cast(float, __hip_atomic_load((unsigned*)(ex + (p * 256 + tid) * 2), __ATOMIC_RELAXED, __HIP_MEMORY_SCOPE_AGENT));
                S2 += __builtin_bit_cast(float, __hip_atomic_load((unsigned*)(ex + (p * 256 + tid) * 2 + 1), __ATOMIC_RELAXED, __HIP_MEMORY_SCOPE_AGENT)); }
            const float mean = S1 * (1.f / DM); const float var = fmaxf(S2 * (1.f / DM) - mean * mean, 0.f);
            sl[2048 + tid * 2] = mean; sl[2048 + tid * 2 + 1] = 1.0f / sqrtf(var + 1e-5f); }
        __syncthreads();
        { const int ln_ = lane_id(); fr = ln_ & 15; fq = ln_ >> 4; }
        const int row1 = upm * 256 + wr * 64 + fr; const int colc = upn * 256 + wc * 64 + 8 * fq;
#pragma unroll
        for (int bj = 0; bj < 2; ++bj) { const int c0 = colc + bj * 32;
            const f32x4 lg0 = *(const f32x4*)(lng + c0), lg1 = *(const f32x4*)(lng + c0 + 4), lb0 = *(const f32x4*)(lnb + c0), lb1 = *(const f32x4*)(lnb + c0 + 4);
            const f32x4 q0 = *(const f32x4*)(go + DM + c0) + 1.f, q1 = *(const f32x4*)(go + DM + c0 + 4) + 1.f, h0 = *(const f32x4*)(go + c0), h1 = *(const f32x4*)(go + c0 + 4);
#pragma unroll
            for (int ai = 0; ai < 2; ++ai) { size_t on = (size_t)(row1 + ai * 128) * 2048 + c0;
#pragma unroll
                for (int m = 0; m < 4; ++m) { const int rt = ai * 128 + wr * 64 + m * 16 + fr; const float mean = sl[2048 + rt * 2], rstd = sl[2048 + rt * 2 + 1];
                    const size_t o = on; { size_t st_ = 16 * 2048; asm volatile("" : "+s"(st_)); on += st_; }
                    const f32x4 y0 = (acc[ai][bj][m][0] - mean) * rstd * lg0 + lb0, y1 = (acc[ai][bj][m][1] - mean) * rstd * lg1 + lb1;
                    if constexpr (FINAL) { *(f32x4*)(Fo + o) = y0; *(f32x4*)(Fo + o + 4) = y1; }
                    else st_bf16x8(Hh + o, y0 * q0 + h0, y1 * q1 + h1); } }
            asm volatile("" ::: "memory"); }
    }
};
struct EpiSwiglu {
    bf16* ACT;
    __device__ __forceinline__ void operator()(const f32x4 (&acc)[2][2][4][2], const Unit& u, int wr, int wc, int fr, int fq) const {
        const int row0 = u.pm * 256 + wr * 64 + fr; const int col = u.pn * 128 + wc * 32 + 8 * fq;
#pragma unroll
        for (int ai = 0; ai < 2; ++ai)
#pragma unroll
            for (int m = 0; m < 4; ++m) { const int row = row0 + ai * 128 + m * 16;
                st_bf16x8(ACT + (size_t)row * DFF + col, silu4(acc[ai][0][m][0]) * acc[ai][1][m][0], silu4(acc[ai][0][m][1]) * acc[ai][1][m][1]); }
    }
};

__global__ void __launch_bounds__(NTHR, 2) fwd_kernel(Args args) {
    extern __shared__ __attribute__((aligned(16))) unsigned char lds_raw[];
    LAS unsigned char* lds = (LAS unsigned char*)lds_raw;
    const int G = gridDim.x, blk = blockIdx.x;
    const int NGW = G * NWAVES, NT = G * NTHR;
    unsigned char* const ws_base = args.ws;
    gu32* ctl = (gu32*)(ws_base + WS_CTL);
    for (int u = threadIdx.x; u < (LDS_BYTES - LDSCTL_OFF) / 4; u += NTHR) ((LAS unsigned*)(lds + LDSCTL_OFF))[u] = 0u;
    __syncthreads();
    volatile LAS unsigned* MISC = (volatile LAS unsigned*)(lds + MISC_OFF);
    const int wave_s = __builtin_amdgcn_readfirstlane((int)(threadIdx.x >> 6));
    XcdBarrier bar = xcd_barrier_post((unsigned*)(ctl + CW_BAR), MISC + 8); bar.wave = wave_s;
    if (threadIdx.x == 0) { unsigned nloc_ = 0u, nx_ = 0u; xcd_barrier_complete(bar.bar, bar.x, nloc_, nx_); bar.st[0] = nloc_; bar.st[1] = nx_; }
    __syncthreads();
#define GRID_BAR() xcd_barrier(bar)

#define x_in ((const float*)(const GAS float*)args.in[0 + z_])
#define c_in ((const float*)(const GAS float*)args.in[1 + z_])
#define w_ada ((const float*)(const GAS float*)args.in[2 + z_])
#define b_ada ((const float*)(const GAS float*)args.in[3 + z_])
#define w_in ((const float*)(const GAS float*)args.in[4 + z_])
#define lb_logits ((const float*)(const GAS float*)args.in[5 + z_])
#define g_hg ((const float*)(const GAS float*)args.in[6 + z_])
#define w_pa ((const float*)(const GAS float*)args.in[7 + z_])
#define g_cq ((const float*)(const GAS float*)args.in[8 + z_])
#define g_ckv ((const float*)(const GAS float*)args.in[9 + z_])
#define w_uq ((const float*)(const GAS float*)args.in[10 + z_])
#define w_iq ((const float*)(const GAS float*)args.in[11 + z_])
#define w_uv ((const float*)(const GAS float*)args.in[12 + z_])
#define w_pb ((const float*)(const GAS float*)args.in[13 + z_])
#define w_out ((const float*)(const GAS float*)args.in[14 + z_])
#define ln1_g ((const float*)(const GAS float*)args.in[15 + z_])
#define ln1_b ((const float*)(const GAS float*)args.in[16 + z_])
#define w_gate ((const float*)(const GAS float*)args.in[17 + z_])
#define w_up ((const float*)(const GAS float*)args.in[18 + z_])
#define w_down ((const float*)(const GAS float*)args.in[19 + z_])
#define ln2_g ((const float*)(const GAS float*)args.in[20 + z_])
#define ln2_b ((const float*)(const GAS float*)args.in[21 + z_])
#define MOD  ((float*)(ws + WS_MOD))
#define LB   ((float*)(ws + WS_LB))
#define MODP ((float*)(ws + WS_MODP))
#define W1   ((bf16*)(ws + WS_W1))
#define W3   ((bf16*)(ws + WS_W3))
#define W6   ((bf16*)(ws + WS_W6))
#define W7   ((bf16*)(ws + WS_W7))
#define W8   ((bf16*)(ws + WS_W8))
#define W10  ((bf16*)(ws + WS_W10))
#define W11  ((bf16*)(ws + WS_W11))
#define XB   ((bf16*)(ws + WS_X))
#define RB   ((bf16*)(ws + WS_R))
#define HB   ((bf16*)(ws + WS_H))
#define QA   ((bf16*)(ws + WS_QA))
#define FA   ((bf16*)(ws + WS_FA))
#define IA   ((bf16*)(ws + WS_IA))
#define GA   ((bf16*)(ws + WS_GA))
#define LAT  ((bf16*)(ws + WS_LAT))
#define GTA  ((bf16*)(ws + WS_GTA))
#define GTB  ((bf16*)(ws + WS_GTB))
#define CQN  ((bf16*)(ws + WS_CQN))
#define CKV  ((bf16*)(ws + WS_CKV))
#define KIDX ((bf16*)(ws + WS_KIDX))
#define IDXW ((float*)(ws + WS_IDXW))
#define QB   ((bf16*)(ws + WS_QB))
#define QIDX ((bf16*)(ws + WS_QIDX))
#define SEL  ((unsigned short*)(ws + WS_SEL))
#define YAB  ((bf16*)(ws + WS_YAB))
#define MRG  ((bf16*)(ws + WS_MRG))
#define OB   ((bf16*)(ws + WS_OB))
#define ISC  ((_Float16*)(ws + WS_BIG))
#define OP   ((float*)(ws + WS_BIG))
#define ACT  ((bf16*)(ws + WS_BIG))
#define KK   LAT
#define modl (MOD + (size_t)l * NBATCH * MODW)
#define KSB  ((bf16*)(ws + WS_KSB))
#define QSB  ((bf16*)(ws + WS_QSB))
#define KVT  ((bf16*)(ws + WS_BIG))
#define SPB  ((bf16*)(ws + WS_FA))
#define DEB  ((float*)(ws + WS_DEB))
#define PHASE_BEGIN { unsigned om_ = ~0u; asm volatile("" : "+s"(om_)); int tid = wave_s * 64 + (int)__builtin_amdgcn_mbcnt_hi(om_, __builtin_amdgcn_mbcnt_lo(om_, 0u)); asm volatile("" : "+v"(tid)); int z_ = 0; asm volatile("" : "+s"(z_)); (void)z_; GAS unsigned char* wsg_ = (GAS unsigned char*)ws_base; asm volatile("" : "+s"(wsg_)); unsigned char* ws = (unsigned char*)wsg_; const int lane = tid & 63, wave = __builtin_amdgcn_readfirstlane(tid >> 6); \
        const int gw = blk * NWAVES + wave, gtid = blk * NTHR + tid; LAS float* wscr = (LAS float*)(lds + wave * 16384); (void)lane; (void)gw; (void)gtid; (void)wscr;
#define PHASE_END }

#define CVT_DECODE(IT_, MID_, K0_, N0_) do { int r_ = (IT_); \
        if (r_ < I1) { MID_ = 0; K0_ = (r_ / (N1 / 32)) * 64; N0_ = (r_ % (N1 / 32)) * 32; } else { r_ -= I1; \
        if (r_ < I3) { MID_ = 1; K0_ = (r_ / (N3 / 32)) * 64; N0_ = (r_ % (N3 / 32)) * 32; } else { r_ -= I3; \
        if (r_ < I6) { MID_ = 2; K0_ = (r_ / 32) * 64; N0_ = (r_ % 32) * 32; } else { r_ -= I6; \
        if (r_ < I7) { MID_ = 3; K0_ = (r_ / (DM / 32)) * 64; N0_ = (r_ % (DM / 32)) * 32; } else { r_ -= I7; \
        if (r_ < I8) { MID_ = 4; K0_ = (r_ / (DM / 32)) * 64; N0_ = (r_ % (DM / 32)) * 32; } else { r_ -= I8; \
        if (r_ < I10) { MID_ = 5; K0_ = (r_ / (N10 / 32)) * 64; N0_ = (r_ % (N10 / 32)) * 32; } else { r_ -= I10; \
        MID_ = 6; K0_ = (r_ / (DM / 32)) * 64; N0_ = (r_ % (DM / 32)) * 32; } } } } } } } while (0)
#define CVT_LOAD(MID_, K0_, N0_, TV_) do { \
        if (MID_ == 0) cvt_load([=](int k, int n) -> f32x4 { const f32x4 v = *(const f32x4*)(s_in + (size_t)k * 9040 + (n < 4944 ? n : n - 176)); return (n >= 4944 && n < 5120) ? (f32x4){0.f, 0.f, 0.f, 0.f} : v; }, K0_, N0_, lane, TV_); \
        else if (MID_ == 1) cvt_load([=](int k, int n) -> f32x4 { const float* p = n < 4096 ? s_uq + (size_t)k * 4096 + n : s_iq + (size_t)k * 1024 + (n - 4096); return *(const f32x4*)p * (n < 4096 ? 0.0625f : 1.f); }, K0_, N0_, lane, TV_); \
        else if (MID_ == 2) cvt_load([=](int k, int n) -> f32x4 { const int h = n >> 6, v = n & 63, kk = k >> 8, c = k & 255; const f32x4 w = *(const f32x4*)(s_uv + ((size_t)h * 256 + c) * 64 + v); return kk == (h & 3) ? w : (f32x4){0.f, 0.f, 0.f, 0.f}; }, K0_, N0_, lane, TV_); \
        else if (MID_ == 3) cvt_load([=](int k, int n) -> f32x4 { const float* p = k < 1024 ? s_pa + (size_t)k * DM + n : s_pb + (size_t)(k - 1024) * DM + n; return *(const f32x4*)p; }, K0_, N0_, lane, TV_); \
        else if (MID_ == 4) cvt_load([=](int k, int n) -> f32x4 { return *(const f32x4*)(s_out + (size_t)k * DM + n); }, K0_, N0_, lane, TV_); \
        else if (MID_ == 5) cvt_load([=](int k, int n) -> f32x4 { const int pn = n >> 8, rr = n & 255, cc = pn * 128 + (rr >> 6) * 32 + (rr & 31); const float* p = ((rr & 32) ? s_u : s_g) + (size_t)k * DFF + cc; return *(const f32x4*)p; }, K0_, N0_, lane, TV_); \
        else cvt_load([=](int k, int n) -> f32x4 { return *(const f32x4*)(s_d + (size_t)k * DM + n); }, K0_, N0_, lane, TV_); } while (0)
#define CONVERT_LAYER(L) do { const int l_ = (L); \
        const float* s_in = w_in + (size_t)l_ * DM * 9040; const float* s_uq = w_uq + (size_t)l_ * SAR * 4096; const float* s_iq = w_iq + (size_t)l_ * SAR * 1024; \
        const float* s_uv = w_uv + (size_t)l_ * 16 * 256 * 64; const float* s_pa = w_pa + (size_t)l_ * 1024 * DM; const float* s_pb = w_pb + (size_t)l_ * 1024 * DM; \
        const float* s_out = w_out + (size_t)l_ * DM * DM; const float* s_g = w_gate + (size_t)l_ * DM * DFF; const float* s_u = w_up + (size_t)l_ * DM * DFF; const float* s_d = w_down + (size_t)l_ * DFF * DM; \
        constexpr int I1 = (DM / 64) * (N1 / 32), I3 = (SAR / 64) * (N3 / 32), I6 = (1024 / 64) * (1024 / 32), I7 = (DM / 64) * (DM / 32), I8 = I7, I10 = (DM / 64) * (N10 / 32), I11 = (DFF / 64) * (DM / 32); \
        constexpr int NIT = I1 + I3 + I6 + I7 + I8 + I10 + I11; \
        float tv_[32]; int mid_ = 0, k0_ = 0, n0_ = 0; \
        { CVT_DECODE(gw, mid_, k0_, n0_); CVT_LOAD(mid_, k0_, n0_, tv_); } \
        for (int it = gw; it < NIT; it += NGW) { \
            float tc_[32]; _Pragma("unroll") for (int i = 0; i < 32; ++i) tc_[i] = tv_[i]; \
            const int mc_ = mid_, kc_ = k0_, nc_ = n0_; \
            { const int itn_ = it + NGW < NIT ? it + NGW : it; CVT_DECODE(itn_, mid_, k0_, n0_); CVT_LOAD(mid_, k0_, n0_, tv_); }     \
            bf16* wt_ = mc_ == 0 ? W1 : mc_ == 1 ? W3 : mc_ == 2 ? W6 : mc_ == 3 ? W7 : mc_ == 4 ? W8 : mc_ == 5 ? W10 : W11; \
            const int kk_ = mc_ == 0 ? DM : mc_ == 1 ? SAR : mc_ == 2 ? 1024 : mc_ == 3 ? DM : mc_ == 4 ? DM : mc_ == 5 ? DM : DFF; \
            cvt_store(tc_, wt_, kk_, kc_, nc_, wscr, lane); \
        } } while (0)


#ifndef HGRN_NAIVE
#define HGRN_NAIVE 0
#endif
#ifndef IDX_NAIVE
#define IDX_NAIVE 0
#endif
#ifndef ATT_NAIVE
#define ATT_NAIVE 0
#endif
#ifndef TOPK_OLD
#define TOPK_OLD 0
#endif
#ifndef REP_HB
#define REP_HB 1
#endif
#ifndef REP_HC
#define REP_HC 1
#endif
#ifndef REP_P4A
#define REP_P4A 1
#endif
#ifndef REP_P5
#define REP_P5 1
#endif
#ifndef REP_P9
#define REP_P9 1
#endif
#ifndef REP_P12
#define REP_P12 1
#endif
#ifndef REP_TOPK
#define REP_TOPK 1
#endif
#ifndef REP_ATT
#define REP_ATT 1
#endif
#ifndef DRY_ATT
#define DRY_ATT 0
#endif
#ifndef REP_M1
#define REP_M1 1
#endif
#ifndef REP_M2
#define REP_M2 1
#endif
#ifndef REP_M3
#define REP_M3 1
#endif

    PHASE_BEGIN
    {
        LAS float* sc = (LAS float*)lds;
        for (int i = tid; i < NBATCH * DM; i += NTHR) { const float v = c_in[i]; sc[i] = v * sigm(v); }
        __syncthreads();
        for (int item = gtid; item < 8 * 12288; item += NT) {
            const int ks = item / 12288, cg = item % 12288, l = cg / 3072, n4 = (cg % 3072) * 4;
            const float* wp = w_ada + ((size_t)l * DM + ks * 256) * MODW + n4;
            f32x4 a0 = {0.f, 0.f, 0.f, 0.f}, a1 = a0, a2 = a0, a3 = a0;
#pragma unroll 8
            for (int k = 0; k < 256; ++k) { const f32x4 w = *(const f32x4*)(wp + (size_t)k * MODW); const int kk = ks * 256 + k;
                a0 += w * sc[kk]; a1 += w * sc[2048 + kk]; a2 += w * sc[4096 + kk]; a3 += w * sc[6144 + kk]; }
            float* o = MODP + ((size_t)(ks * 4 + l) * 4) * MODW + n4;
            *(f32x4*)(o) = a0; *(f32x4*)(o + MODW) = a1; *(f32x4*)(o + 2 * MODW) = a2; *(f32x4*)(o + 3 * MODW) = a3;
        }
        if (gtid < 1024) {
            const float a = lb_logits[gtid], b = lb_logits[1024 + gtid], c = lb_logits[2048 + gtid], d = lb_logits[3072 + gtid];
            const float mx = fmaxf(fmaxf(a, b), fmaxf(c, d)); const float ea = expf(a - mx), eb = expf(b - mx), ec = expf(c - mx), ed = expf(d - mx); const float inv = 1.f / (ea + eb + ec + ed);
            LB[gtid] = 0.f; LB[1024 + gtid] = eb * inv; LB[2048 + gtid] = (eb + ec) * inv; LB[3072 + gtid] = (eb + ec + ed) * inv;
        }
        __syncthreads();
        CONVERT_LAYER(0);
    }
    PHASE_END
    GRID_BAR();
    PHASE_BEGIN
    for (int i = gtid; i < DEPTH * NBATCH * MODW; i += NT) {
        const int l = i / (NBATCH * MODW), r = i % (NBATCH * MODW), b = r / MODW, n = r % MODW;
        float s = b_ada[l * MODW + n];
#pragma unroll
        for (int ks = 0; ks < 8; ++ks) s += MODP[((size_t)(ks * 4 + l) * 4 + b) * MODW + n];
        MOD[i] = s;
    }
    PHASE_END
    GRID_BAR();
    PHASE_BEGIN
    for (size_t i0 = gtid; i0 < (size_t)M * DM / 8; i0 += (size_t)NT * 4) {
        f32x4 xa[4], xb[4], sa[4], sb[4], ha[4], hb[4];
#pragma unroll
        for (int t = 0; t < 4; ++t) { size_t gi = i0 + (size_t)t * NT; gi = gi < (size_t)M * DM / 8 ? gi : (size_t)M * DM / 8 - 1; const size_t e = gi * 8; const int row = (int)(e / DM), col = (int)(e % DM), b = row / SEQ; const float* md = MOD + (size_t)b * MODW;
            xa[t] = *(const f32x4*)(x_in + e); xb[t] = *(const f32x4*)(x_in + e + 4); sa[t] = *(const f32x4*)(md + 2048 + col); sb[t] = *(const f32x4*)(md + 2048 + col + 4); ha[t] = *(const f32x4*)(md + col); hb[t] = *(const f32x4*)(md + col + 4); }
#pragma unroll
        for (int t = 0; t < 4; ++t) { size_t gi = i0 + (size_t)t * NT; gi = gi < (size_t)M * DM / 8 ? gi : (size_t)M * DM / 8 - 1; const size_t e = gi * 8; st_bf16x8(HB + e, xa[t] * (sa[t] + 1.f) + ha[t], xb[t] * (sb[t] + 1.f) + hb[t]); }
    }
    PHASE_END
    GRID_BAR();

    for (int l = 0; l < DEPTH; ++l) {
        PHASE_BEGIN
        { pg8::Gemm g{HB, W1, M, N1, DM, DM, DM, 0}; pg8::StaticOrder S; S.init(M, N1, G, blk);
          EpiProj E{QA, FA, IA, GA, LAT, GTA, GTB}; pg8::gemm_phase(lds, g, S, E, tid); }
        PHASE_END
        GRID_BAR();
        for (int rep_ = 0; rep_ < REP_M1; ++rep_) {
        PHASE_BEGIN
        v2u ra0, ra1, rkv; unsigned short rki, riw;
        const f32x4 g0 = *(const f32x4*)(g_cq + l * 512 + 4 * lane), g1 = *(const f32x4*)(g_cq + l * 512 + 256 + 4 * lane), gk = *(const f32x4*)(g_ckv + l * 256 + 4 * lane);
        { const bf16* lr = LAT + (size_t)gw * 1024; ra0 = *(const v2u*)(lr + 4 * lane); ra1 = *(const v2u*)(lr + 256 + 4 * lane); rkv = *(const v2u*)(lr + 512 + 4 * lane); rki = lr[768 + lane]; riw = lr[832 + (lane & 15)]; }
        for (int row = gw; row < M; row += NGW) {
            const f32x4 a0 = (f32x4){bflo(ra0.x), bfhi(ra0.x), bflo(ra0.y), bfhi(ra0.y)}, a1 = (f32x4){bflo(ra1.x), bfhi(ra1.x), bflo(ra1.y), bfhi(ra1.y)}, kv = (f32x4){bflo(rkv.x), bfhi(rkv.x), bflo(rkv.y), bfhi(rkv.y)};
            const float ki = bf2f(rki), iw = bf2f(riw);
            { const int rn = row + NGW < M ? row + NGW : row; const bf16* lr = LAT + (size_t)rn * 1024;
              ra0 = *(const v2u*)(lr + 4 * lane); ra1 = *(const v2u*)(lr + 256 + 4 * lane); rkv = *(const v2u*)(lr + 512 + 4 * lane); rki = lr[768 + lane]; riw = lr[832 + (lane & 15)]; }
            float sq = a0[0] * a0[0] + a0[1] * a0[1] + a0[2] * a0[2] + a0[3] * a0[3] + a1[0] * a1[0] + a1[1] * a1[1] + a1[2] * a1[2] + a1[3] * a1[3];
            float sk = kv[0] * kv[0] + kv[1] * kv[1] + kv[2] * kv[2] + kv[3] * kv[3];
            sq = wave_sum(sq); sk = wave_sum(sk);
            const float rq = 1.0f / sqrtf(sq * (1.f / 512.f) + 1e-6f), rk = 1.0f / sqrtf(sk * (1.f / 256.f) + 1e-6f);
            v2u o; f32x4 t = a0 * rq * g0; o.x = pk2(t[0], t[1]); o.y = pk2(t[2], t[3]); *(v2u*)(CQN + (size_t)row * 512 + 4 * lane) = o;
            t = a1 * rq * g1; o.x = pk2(t[0], t[1]); o.y = pk2(t[2], t[3]); *(v2u*)(CQN + (size_t)row * 512 + 256 + 4 * lane) = o;
            t = kv * rk * gk; o.x = pk2(t[0], t[1]); o.y = pk2(t[2], t[3]); *(v2u*)(CKV + (size_t)row * 256 + 4 * lane) = o;
            KIDX[(size_t)row * 64 + lane] = (bf16)f2bf(ki);
            if (lane < 16) IDXW[(size_t)row * 16 + lane] = iw * 0.03125f;
        }
        PHASE_END
        PHASE_BEGIN
        {
            const int cp = tid & 63, sg = tid >> 6;
            LAS unsigned char* KST = lds;
            LAS unsigned char* VTL = lds + 18432;
            LAS float* SEGT = (LAS float*)(lds + 36864);
            LAS float* G63 = (LAS float*)(lds + 40960);
            unsigned pfa[8], pq[8], pv[8]; float plb0, plb1;
#define HA_REQ(U_) do { int uu_ = (U_); asm volatile("" : "+s"(uu_)); const int bh_ = uu_ >> 6, c_ = uu_ & 63, b_ = bh_ >> 3, h_ = bh_ & 7; \
                const size_t rowb_ = (size_t)b_ * SEQ + c_ * 64 + sg * 8; const int col_ = h_ * 128 + 2 * cp; \
                _Pragma("unroll") for (int i = 0; i < 8; ++i) { pfa[i] = *(const unsigned*)(FA + (rowb_ + i) * 1024 + col_); pq[i] = *(const unsigned*)(QA + (rowb_ + i) * 1024 + col_); pv[i] = *(const unsigned*)(IA + (rowb_ + i) * 1024 + col_); } plb0 = LB[l * 1024 + col_]; plb1 = LB[l * 1024 + col_ + 1]; } while (0)
            HA_REQ(blk);
            for (int u = blk; u < 2048; u += G) {
                const int bh = u >> 6, c = u & 63, b = bh >> 3, h = bh & 7;
                const size_t rowb = (size_t)b * SEQ + c * 64 + sg * 8; const int col = h * 128 + 2 * cp;
                const float lb0 = plb0, lb1 = plb1;
                float lf0[8], lf1[8], kk0[8], kk1[8]; unsigned cq[8], cv[8];
#pragma unroll
                for (int i = 0; i < 8; ++i) { cq[i] = pq[i]; cv[i] = pv[i]; }
#pragma unroll
                for (int i = 0; i < 8; ++i) { const float2 fa = make_float2(bflo(pfa[i]), bfhi(pfa[i]));
                    const float f0 = fminf(fmaxf(lb0 + (1.f - lb0) * sigm(fa.x), 1e-6f), 1.f), f1 = fminf(fmaxf(lb1 + (1.f - lb1) * sigm(fa.y), 1e-6f), 1.f);
                    lf0[i] = __logf(f0); lf1[i] = __logf(f1); kk0[i] = (1.f - lb0) * sigm(-fa.x); kk1[i] = (1.f - lb1) * sigm(-fa.y); }
#pragma unroll
                for (int i = 1; i < 8; ++i) { lf0[i] += lf0[i - 1]; lf1[i] += lf1[i - 1]; }
                SEGT[sg * 128 + 2 * cp] = lf0[7]; SEGT[sg * 128 + 2 * cp + 1] = lf1[7];
                HA_REQ(u + G < 2048 ? u + G : u);
                __syncthreads();
                float pre0 = 0.f, pre1 = 0.f, r0 = 0.f, r1 = 0.f, t0 = 0.f, t1 = 0.f;
#pragma unroll
                for (int s2 = 0; s2 < 8; ++s2) { const float a0 = SEGT[s2 * 128 + 2 * cp], a1 = SEGT[s2 * 128 + 2 * cp + 1];
                    if (s2 < sg) { pre0 += a0; pre1 += a1; } if (s2 < 4) { r0 += a0; r1 += a1; } t0 += a0; t1 += a1; }
                unsigned ksw0[4], ksw1[4], vw0[4], vw1[4]; float ks0p = 0.f, ks1p = 0.f, v0p = 0.f, v1p = 0.f;
#pragma unroll
                for (int i = 0; i < 8; ++i) {
                    const float b0 = pre0 + lf0[i], b1 = pre1 + lf1[i];
                    const unsigned qw = cq[i]; const unsigned vw = cv[i];
                    const float qs0 = bflo(qw) * __expf(b0 - r0), qs1 = bfhi(qw) * __expf(b1 - r1);
                    const float ks0 = kk0[i] * __expf(r0 - b0), ks1 = kk1[i] * __expf(r1 - b1);
                    *(unsigned*)(QSB + (rowb + i) * 1024 + col) = pk2(qs0, qs1);
                    *(unsigned*)(KSB + (rowb + i) * 1024 + col) = pk2(ks0, ks1);
                    if (i & 1) { ksw0[i >> 1] = pk2(ks0p, ks0); ksw1[i >> 1] = pk2(ks1p, ks1); vw0[i >> 1] = pk2(v0p, bflo(vw)); vw1[i >> 1] = pk2(v1p, bfhi(vw)); }
                    else { ks0p = ks0; ks1p = ks1; v0p = bflo(vw); v1p = bfhi(vw); }
                }
                *(LAS v4u*)(KST + (2 * cp) * 144 + sg * 16) = (v4u){ksw0[0], ksw0[1], ksw0[2], ksw0[3]};
                *(LAS v4u*)(KST + (2 * cp + 1) * 144 + sg * 16) = (v4u){ksw1[0], ksw1[1], ksw1[2], ksw1[3]};
                *(LAS v4u*)(VTL + (2 * cp) * 144 + sg * 16) = (v4u){vw0[0], vw0[1], vw0[2], vw0[3]};
                *(LAS v4u*)(VTL + (2 * cp + 1) * 144 + sg * 16) = (v4u){vw1[0], vw1[1], vw1[2], vw1[3]};
                if (sg == 7) { float* de = DEB + (size_t)u * 256; *(float2*)(de + 2 * cp) = make_float2(__expf(r0), __expf(r1)); *(float2*)(de + 128 + 2 * cp) = make_float2(__expf(t0), __expf(t1));
                    G63[2 * cp] = __expf(t0 - r0); G63[2 * cp + 1] = __expf(t1 - r1); }
                __syncthreads();
                { const int kt = wave >> 1, vt0 = (wave & 1) * 2, lr = lane & 31, lh = lane >> 5;
                  f32x16 acc0, acc1;
#pragma unroll
                  for (int r = 0; r < 16; ++r) { acc0[r] = 0.f; acc1[r] = 0.f; }
#pragma unroll
                  for (int s4 = 0; s4 < 4; ++s4) {
                      const bf16x8 kb = *(const LAS bf16x8*)(KST + (kt * 32 + lr) * 144 + (s4 * 16 + 8 * lh) * 2);
                      const bf16x8 a0 = *(const LAS bf16x8*)(VTL + (vt0 * 32 + lr) * 144 + (s4 * 16 + 8 * lh) * 2);
                      const bf16x8 a1 = *(const LAS bf16x8*)(VTL + ((vt0 + 1) * 32 + lr) * 144 + (s4 * 16 + 8 * lh) * 2);
                      acc0 = __builtin_amdgcn_mfma_f32_32x32x16_bf16(a0, kb, acc0, 0, 0, 0); acc1 = __builtin_amdgcn_mfma_f32_32x32x16_bf16(a1, kb, acc1, 0, 0, 0); }
                  bf16* kvt = KVT + (size_t)u * 16384 + kt * 32 + lr; const float g = G63[kt * 32 + lr];
#pragma unroll
                  for (int r = 0; r < 16; ++r) { const int vv = 8 * (r >> 2) + 4 * lh + (r & 3);
                      kvt[(size_t)(vt0 * 32 + vv) * 128] = (bf16)(pk2(acc0[r] * g, 0.f) & 0xffffu); kvt[(size_t)((vt0 + 1) * 32 + vv) * 128] = (bf16)(pk2(acc1[r] * g, 0.f) & 0xffffu); } }
                __syncthreads();
            }
        }
#undef HA_REQ
        PHASE_END
        GRID_BAR();
        }
        for (int rep_ = 0; rep_ < REP_M2; ++rep_) {
        PHASE_BEGIN
        for (int item = gtid; item < 32 * 4096; item += NT) {
            const int bh = item >> 12, v = (item >> 5) & 127, k4 = (item & 31) * 4;
            f32x4 S = {0.f, 0.f, 0.f, 0.f};
            for (int c0 = 0; c0 < 64; c0 += 8) {
                f32x4 kv[8], dd[8], ee[8];
#pragma unroll
                for (int j = 0; j < 8; ++j) { const size_t u = (size_t)bh * 64 + c0 + j; kv[j] = ldbf4(KVT + u * 16384 + v * 128 + k4); ee[j] = *(const f32x4*)(DEB + u * 256 + k4); dd[j] = *(const f32x4*)(DEB + u * 256 + 128 + k4); }
#pragma unroll
                for (int j = 0; j < 8; ++j) { const size_t u = (size_t)bh * 64 + c0 + j; const f32x4 sp = S * ee[j]; v2u w; w.x = pk2(sp[0], sp[1]); w.y = pk2(sp[2], sp[3]);
                    *(v2u*)(SPB + u * 16384 + v * 128 + k4) = w; S = S * dd[j] + kv[j]; }
            }
        }
        PHASE_END
        PHASE_BEGIN
        { pg8::Gemm g{CQN, W3, M, N3, SAR, SAR, SAR, 0}; pg8::StaticOrder S; S.init(M, N3, G, blk);
          EpiQ E{QB, QIDX}; pg8::gemm_phase(lds, g, S, E, tid); }
        PHASE_END
        GRID_BAR();
        }
        for (int st_ = 0; st_ < 2; ++st_) {
        if ((st_ == 0) == (((blk >> 3) & 1) == 0)) {
        PHASE_BEGIN
        {
            LAS unsigned char* QSL = lds;
            LAS unsigned char* KSL = lds + 17408;
            LAS unsigned char* VTL = lds + 34816;
            LAS unsigned char* SPL = lds + 53248;
            LAS unsigned char* AL = lds + 88064;
            LAS float* SSQ = (LAS float*)(lds + 97280);
            const int cp = tid & 63, sg = tid >> 6, lr = lane & 31, lh = lane >> 5;
            v4u rq[2], rk[2], rs[4]; unsigned rv[8]; unsigned short rg[16];
#define HC_REQ(U_) do { int uu_ = (U_); asm volatile("" : "+s"(uu_));   const int bh_ = uu_ >> 6, c_ = uu_ & 63, b_ = bh_ >> 3, h_ = bh_ & 7; const size_t row0_ = (size_t)b_ * SEQ + c_ * 64; const int col0_ = h_ * 128; \
                _Pragma("unroll") for (int j = 0; j < 2; ++j) { const int q = tid + 512 * j, rr = q >> 4, cc = q & 15; \
                    rq[j] = *(const v4u*)(QSB + (row0_ + rr) * 1024 + col0_ + cc * 8); rk[j] = *(const v4u*)(KSB + (row0_ + rr) * 1024 + col0_ + cc * 8); } \
                _Pragma("unroll") for (int j = 0; j < 4; ++j) { const int q = tid + 512 * j, rr = q >> 4, cc = q & 15; rs[j] = *(const v4u*)(SPB + (size_t)uu_ * 16384 + rr * 128 + cc * 8); } \
                _Pragma("unroll") for (int i = 0; i < 8; ++i) rv[i] = *(const unsigned*)(IA + (row0_ + sg * 8 + i) * 1024 + col0_ + 2 * cp); \
                { const int it_ = wave >> 2, vt_ = wave & 3; const int colg_ = col0_ + vt_ * 32 + lr; \
                  _Pragma("unroll") for (int r = 0; r < 16; ++r) { const int ii = it_ * 32 + 8 * (r >> 2) + 4 * lh + (r & 3); rg[r] = GA[(row0_ + ii) * 1024 + colg_]; } } } while (0)
            HC_REQ(blk);
            for (int u = blk; u < 2048; u += G) {
                const int bh = u >> 6, c = u & 63, b = bh >> 3, h = bh & 7;
                const size_t row0 = (size_t)b * SEQ + c * 64; const int col0 = h * 128;
#pragma unroll
                for (int j = 0; j < 2; ++j) { const int q = tid + 512 * j, rr = q >> 4, cc = q & 15;
                    *(LAS v4u*)(QSL + rr * 272 + cc * 16) = rq[j]; *(LAS v4u*)(KSL + rr * 272 + cc * 16) = rk[j]; }
#pragma unroll
                for (int j = 0; j < 4; ++j) { const int q = tid + 512 * j, rr = q >> 4, cc = q & 15; *(LAS v4u*)(SPL + rr * 272 + cc * 16) = rs[j]; }
                { unsigned vw0[4], vw1[4]; float v0p = 0.f, v1p = 0.f;
#pragma unroll
                  for (int i = 0; i < 8; ++i) { const unsigned vw = rv[i];
                      if (i & 1) { vw0[i >> 1] = pk2(v0p, bflo(vw)); vw1[i >> 1] = pk2(v1p, bfhi(vw)); } else { v0p = bflo(vw); v1p = bfhi(vw); } }
                  *(LAS v4u*)(VTL + (2 * cp) * 144 + sg * 16) = (v4u){vw0[0], vw0[1], vw0[2], vw0[3]};
                  *(LAS v4u*)(VTL + (2 * cp + 1) * 144 + sg * 16) = (v4u){vw1[0], vw1[1], vw1[2], vw1[3]}; }
                float gav[16];
#pragma unroll
                for (int r = 0; r < 16; ++r) gav[r] = bf2f(rg[r]);
                const float gg = g_hg[l * 1024 + col0 + (wave & 3) * 32 + lr];
                HC_REQ(u + G < 2048 ? u + G : u);
                __syncthreads();
                if (wave < 4) {
                    const int it = wave >> 1, jt = wave & 1;
                    f32x16 acc;
#pragma unroll
                    for (int r = 0; r < 16; ++r) acc[r] = 0.f;
                    if (!(it == 0 && jt == 1)) {
#pragma unroll
                        for (int s8 = 0; s8 < 8; ++s8) {
                            const bf16x8 a = *(const LAS bf16x8*)(QSL + (it * 32 + lr) * 272 + (s8 * 16 + 8 * lh) * 2);
                            const bf16x8 bb = *(const LAS bf16x8*)(KSL + (jt * 32 + lr) * 272 + (s8 * 16 + 8 * lh) * 2);
                            acc = __builtin_amdgcn_mfma_f32_32x32x16_bf16(a, bb, acc, 0, 0, 0); } }
                    const int jj = jt * 32 + lr;
#pragma unroll
                    for (int r = 0; r < 16; ++r) { const int ii = it * 32 + 8 * (r >> 2) + 4 * lh + (r & 3); const float x = (jj <= ii) ? acc[r] : 0.f;
                        *(LAS unsigned short*)(AL + ii * 144 + jj * 2) = (unsigned short)(pk2(x, 0.f) & 0xffffu); }
                }
                __syncthreads();
                { const int it = wave >> 2, vt = wave & 3;
                  f32x16 acc;
#pragma unroll
                  for (int r = 0; r < 16; ++r) acc[r] = 0.f;
#pragma unroll
                  for (int s4 = 0; s4 < 4; ++s4) {
                      const bf16x8 a = *(const LAS bf16x8*)(AL + (it * 32 + lr) * 144 + (s4 * 16 + 8 * lh) * 2);
                      const bf16x8 bb = *(const LAS bf16x8*)(VTL + (vt * 32 + lr) * 144 + (s4 * 16 + 8 * lh) * 2);
                      acc = __builtin_amdgcn_mfma_f32_32x32x16_bf16(a, bb, acc, 0, 0, 0); }
#pragma unroll
                  for (int s8 = 0; s8 < 8; ++s8) {
                      const bf16x8 a = *(const LAS bf16x8*)(QSL + (it * 32 + lr) * 272 + (s8 * 16 + 8 * lh) * 2);
                      const bf16x8 bb = *(const LAS bf16x8*)(SPL + (vt * 32 + lr) * 272 + (s8 * 16 + 8 * lh) * 2);
                      acc = __builtin_amdgcn_mfma_f32_32x32x16_bf16(a, bb, acc, 0, 0, 0); }
#pragma unroll
                  for (int r = 0; r < 16; ++r) { float q2 = acc[r] * acc[r];
                      q2 = xsum16(rowsum16(q2));
                      if (lr == 0) SSQ[vt * 64 + it * 32 + 8 * (r >> 2) + 4 * lh + (r & 3)] = q2; }
                  __syncthreads();
                  const int colg = col0 + vt * 32 + lr;
#pragma unroll
                  for (int r = 0; r < 16; ++r) { const int ii = it * 32 + 8 * (r >> 2) + 4 * lh + (r & 3);
                      const float ss = SSQ[ii] + SSQ[64 + ii] + SSQ[128 + ii] + SSQ[192 + ii]; const float rn = 1.0f / sqrtf(ss * (1.f / 128.f) + 1e-6f);
                      YAB[(row0 + ii) * 2048 + colg] = (bf16)(pk2(acc[r] * rn * gg * gav[r], 0.f) & 0xffffu); }
                }
                __syncthreads();
            }
        }
#undef HC_REQ
        PHASE_END
        } else {
        PHASE_BEGIN
        for (int ub = blk * NWAVES; ub < 2048; ub += NGW) {
            const int unit = ub + wave;
            const int b = ub >> 9, j = unit & 511, lr = lane & 31, lh = lane >> 5;
            const int qsel = (lr >> 2) & 1, head = (lr >> 3) * 4 + (lr & 3);
            const int qlo = 4 * j, qhi = 4 * (1023 - j);
            const int nlo = ((qlo >> 6) + 1) * 64, nhi = ((qhi >> 6) + 1) * 64;
            const int nlo8 = (nlo + 511) & ~511, nhi8 = (nhi + 511) & ~511;
            const int nmax8 = (((((4 * (1023 - (ub & 511))) >> 6) + 1) * 64) + 511) & ~511;
            bf16x8 A[4][4]; float W[4][16]; typedef float f32x2_t __attribute__((ext_vector_type(2)));
#pragma unroll
            for (int p = 0; p < 4; ++p) { const size_t qb = (size_t)b * SEQ + (p < 2 ? qlo + 2 * p : qhi + 2 * (p - 2));
#pragma unroll
                for (int ks = 0; ks < 4; ++ks) A[p][ks] = *(const bf16x8*)(QIDX + (qb + qsel) * 1024 + head * 64 + ks * 16 + lh * 8);
#pragma unroll
                for (int r4 = 0; r4 < 4; ++r4) { const f32x4 w = *(const f32x4*)(IDXW + (qb + lh) * 16 + r4 * 4); W[p][r4 * 4] = w[0]; W[p][r4 * 4 + 1] = w[1]; W[p][r4 * 4 + 2] = w[2]; W[p][r4 * 4 + 3] = w[3]; } }
            const bf16* kb = KIDX + (size_t)b * SEQ * 64;
            const int srow = 8 * wave + (lane >> 3), spc = ((lane & 7) ^ ((srow >> 1) & 7)) * 8;
#define P4_STAGE(C0_, BUF_) do { _Pragma("unroll") for (int i = 0; i < 4; ++i) \
                __builtin_amdgcn_global_load_lds((const unsigned*)(kb + (size_t)((C0_) + 64 * i + srow) * 64 + spc), (LAS unsigned*)(lds + (BUF_) * 32768 + (i * 8 + wave) * 1024), 16, 0, 0); } while (0)
            P4_STAGE(0, 0);
            asm volatile("s_waitcnt vmcnt(0)" ::: "memory");
            __syncthreads();
            for (int c0 = 0; c0 < nmax8; c0 += 256) {
                const int cb = (c0 >> 8) & 1; const bool more = c0 + 256 < nmax8;
                if (more) P4_STAGE(c0 + 256, cb ^ 1);
                LAS unsigned char* kbuf = lds + cb * 32768;
#pragma unroll 1
                for (int tl = 0; tl < 8; ++tl) {
                    const int s0 = c0 + tl * 32;
                    if (s0 >= nhi8) break;
#pragma unroll
                    for (int p = 0; p < 4; ++p) { const int np = p < 2 ? nlo : nhi, np8 = p < 2 ? nlo8 : nhi8;
                        if (s0 >= np && s0 < np8) { const size_t q = (size_t)b * SEQ + (p < 2 ? qlo + 2 * p : qhi + 2 * (p - 2)) + lh; ISC[q * 4096 + s0 + lr] = (_Float16)(-60000.0f); } }
                    if (s0 >= nhi) continue;
                    bf16x8 B[4];
#pragma unroll
                    for (int ks = 0; ks < 4; ++ks) B[ks] = *(const LAS bf16x8*)(kbuf + (tl * 32 + lr) * 128 + (((2 * ks + lh) ^ ((lr >> 1) & 7)) * 16));
#define IDX_FINISH(P_, ACC_) do { f32x2_t s2_ = {0.f, 0.f};     \
                        _Pragma("unroll") for (int r = 0; r < 16; r += 2) { const float a0_ = ACC_[r], a1_ = ACC_[r + 1]; const int i0_ = __builtin_bit_cast(int, a0_), i1_ = __builtin_bit_cast(int, a1_); \
                            const f32x2_t rl_ = {__builtin_bit_cast(float, i0_ > 0 ? i0_ : 0), __builtin_bit_cast(float, i1_ > 0 ? i1_ : 0)}; const f32x2_t w_ = {W[P_][r], W[P_][r + 1]}; \
                            s2_ = __builtin_elementwise_fma(rl_, w_, s2_); } \
                        const float sc_ = s2_[0] + s2_[1]; \
                        const size_t q_ = (size_t)b * SEQ + ((P_) < 2 ? qlo + 2 * (P_) : qhi + 2 * ((P_) - 2)) + lh; ISC[q_ * 4096 + s0 + lr] = (_Float16)sc_; } while (0)
                    if (s0 < nlo) {
                        f32x16 c0_, c1_, c2_, c3_;
#pragma unroll
                        for (int r = 0; r < 16; ++r) { c0_[r] = 0.f; c1_[r] = 0.f; c2_[r] = 0.f; c3_[r] = 0.f; }
#pragma unroll
                        for (int ks = 0; ks < 4; ++ks) { c0_ = __builtin_amdgcn_mfma_f32_32x32x16_bf16(A[0][ks], B[ks], c0_, 0, 0, 0); c1_ = __builtin_amdgcn_mfma_f32_32x32x16_bf16(A[1][ks], B[ks], c1_, 0, 0, 0);
                            c2_ = __builtin_amdgcn_mfma_f32_32x32x16_bf16(A[2][ks], B[ks], c2_, 0, 0, 0); c3_ = __builtin_amdgcn_mfma_f32_32x32x16_bf16(A[3][ks], B[ks], c3_, 0, 0, 0); }
                        IDX_FINISH(0, c0_); IDX_FINISH(1, c1_); IDX_FINISH(2, c2_); IDX_FINISH(3, c3_);
                    } else {
                        f32x16 c2_, c3_;
#pragma unroll
                        for (int r = 0; r < 16; ++r) { c2_[r] = 0.f; c3_[r] = 0.f; }
#pragma unroll
                        for (int ks = 0; ks < 4; ++ks) { c2_ = __builtin_amdgcn_mfma_f32_32x32x16_bf16(A[2][ks], B[ks], c2_, 0, 0, 0); c3_ = __builtin_amdgcn_mfma_f32_32x32x16_bf16(A[3][ks], B[ks], c3_, 0, 0, 0); }
                        IDX_FINISH(2, c2_); IDX_FINISH(3, c3_);
                    }
#undef IDX_FINISH
                }
                asm volatile("s_waitcnt vmcnt(0)" ::: "memory");
                __syncthreads();
            }
        }
#undef P4_STAGE
        PHASE_END
        }
        __syncthreads();
        }
        GRID_BAR();
        for (int rep_ = 0; rep_ < REP_P5; ++rep_) {
        PHASE_BEGIN
        {
            LAS unsigned char* VB = lds + wave * 18432;
            LAS unsigned short* SELW = (LAS unsigned short*)(VB + 17408);
            const int hd = lane & 15, g = lane >> 4, qq = hd >> 2, pp = hd & 3;
            const float slope = exp2f(-0.5f * (float)(hd + 1));
            for (int q = gw; q < M; q += NGW) {
                const int b = q / SEQ, pos = q % SEQ, qc = pos >> 6; const int nsel = qc < 4 ? (qc + 1) * 64 : 256;
                for (int rtk_ = 0; rtk_ < REP_TOPK; ++rtk_) {
                int lane_t = lane; asm volatile("" : "+v"(lane_t));
                if (qc < 4) { const unsigned e0 = 4 * lane_t; const bool ok = 4 * lane_t < nsel; v2u z; z.x = ok ? (e0 | ((e0 + 1) << 16)) : 0u; z.y = ok ? ((e0 + 2) | ((e0 + 3) << 16)) : 0u; *(LAS v2u*)(SELW + 4 * lane_t) = z; }
                else {
                    LAS unsigned* HIST = (LAS unsigned*)VB;
                    const int nb8 = (qc + 8) >> 3;
                    float v[64];
                    { unsigned pk[32]; const int i2max = 4 * nb8 - 1; const _Float16* irow = ISC + (size_t)q * 4096 + 2 * lane_t; typedef _Float16 h2_t __attribute__((ext_vector_type(2)));
#pragma unroll
                      for (int i2 = 0; i2 < 32; ++i2) { const int ic = i2 < i2max ? i2 : i2max; pk[i2] = *(const unsigned*)(irow + ic * 128); }
#pragma unroll
                      for (int i2 = 0; i2 < 32; ++i2) { const float lim = (i2 >> 2) < nb8 ? 3.0e38f : -1.0e30f; const h2_t h = __builtin_bit_cast(h2_t, pk[i2]);
                          const float f0 = (float)h[0], f1 = (float)h[1]; v[2 * i2] = fminf(f0, lim); v[2 * i2 + 1] = fminf(f1, lim); } }
                    float vmx = v[0], vmn = fminf(fminf(v[0], v[1]), fminf(v[2], v[3]));
#pragma unroll
                    for (int i = 1; i < 64; ++i) vmx = fmaxf(vmx, v[i]);
                    vmx = wmax_f(vmx); vmn = -wmax_f(-vmn);
                    const float rng = vmx - vmn; const float s20 = rng > 0.f ? 1048574.0f / rng : 0.f;
#define ZERO_HIST() do { *(LAS v4u*)(HIST + 16 * lane) = (v4u){0u, 0u, 0u, 0u}; *(LAS v4u*)(HIST + 16 * lane + 4) = (v4u){0u, 0u, 0u, 0u}; *(LAS v4u*)(HIST + 16 * lane + 8) = (v4u){0u, 0u, 0u, 0u}; \
                        *(LAS v4u*)(HIST + 16 * lane + 12) = (v4u){0u, 0u, 0u, 0u}; HIST[1024 + lane] = 0u; } while (0)
#define SCAN_HIST(R_, BIN_, AB_) do { unsigned hh_[16]; const int hb_ = 1008 - 16 * lane; \
                        { const v4u h0 = *(const LAS v4u*)(HIST + hb_), h1 = *(const LAS v4u*)(HIST + hb_ + 4), h2 = *(const LAS v4u*)(HIST + hb_ + 8), h3 = *(const LAS v4u*)(HIST + hb_ + 12); \
                          hh_[0] = h0.x; hh_[1] = h0.y; hh_[2] = h0.z; hh_[3] = h0.w; hh_[4] = h1.x; hh_[5] = h1.y; hh_[6] = h1.z; hh_[7] = h1.w; hh_[8] = h2.x; hh_[9] = h2.y; hh_[10] = h2.z; hh_[11] = h2.w; hh_[12] = h3.x; hh_[13] = h3.y; hh_[14] = h3.z; hh_[15] = h3.w; } \
                        unsigned tot_ = 0u; _Pragma("unroll") for (int k = 0; k < 16; ++k) tot_ += hh_[k]; \
                        unsigned run_ = wprefix_u(tot_) - tot_; int fb_ = -1; unsigned fa_ = 0u; \
                        _Pragma("unroll") for (int k = 15; k >= 0; --k) { if (run_ < (R_) && run_ + hh_[k] >= (R_)) { fb_ = hb_ + k; fa_ = run_; } run_ += hh_[k]; } \
                        const unsigned long long bm_ = __ballot(fb_ >= 0); const int L_ = (int)__builtin_ctzll(bm_); \
                        BIN_ = (unsigned)__builtin_amdgcn_readlane(fb_, L_); AB_ = (unsigned)__builtin_amdgcn_readlane((int)fa_, L_); } while (0)
                    ZERO_HIST();
#pragma unroll
                    for (int i = 0; i < 64; ++i) v[i] = __builtin_bit_cast(float, (unsigned)((v[i] - vmn) * s20));
#define cd(i_) __builtin_bit_cast(unsigned, v[i_])
#pragma unroll
                    for (int g8 = 0; g8 < 8; ++g8) { if (g8 < nb8) {
#pragma unroll
                        for (int j = 0; j < 8; ++j) __hip_atomic_fetch_add(HIST + (cd(g8 * 8 + j) >> 10), 1u, __ATOMIC_RELAXED, __HIP_MEMORY_SCOPE_WORKGROUP); } }
                    LDS_WAIT(); asm volatile("" ::: "memory");
                    unsigned tb, above; SCAN_HIST(256u, tb, above);
                    ZERO_HIST();
                    LDS_WAIT(); asm volatile("" ::: "memory");
#pragma unroll
                    for (int g8 = 0; g8 < 8; ++g8) { if (g8 < nb8) {
#pragma unroll
                        for (int j = 0; j < 8; ++j) { const unsigned c = cd(g8 * 8 + j); const unsigned a = (c >> 10) == tb ? (c & 1023u) : 1024u + lane; __hip_atomic_fetch_add(HIST + a, 1u, __ATOMIC_RELAXED, __HIP_MEMORY_SCOPE_WORKGROUP); } } }
                    LDS_WAIT(); asm volatile("" ::: "memory");
                    unsigned tb2, ab2; { const unsigned R2 = 256u - above; SCAN_HIST(R2, tb2, ab2); }
                    const unsigned T = (tb << 10) | tb2; above += ab2;
                    unsigned baseg = 0u, basee = above;
#pragma unroll
                    for (int g8 = 0; g8 < 8; ++g8) { if (g8 < nb8) {
#pragma unroll
                        for (int j = 0; j < 8; ++j) { const int i = g8 * 8 + j;
                            const bool gt = cd(i) > T; const unsigned long long bg = __ballot(gt);
                            const unsigned pgp = baseg + __builtin_amdgcn_mbcnt_hi((unsigned)(bg >> 32), __builtin_amdgcn_mbcnt_lo((unsigned)bg, 0u));
                            if (gt) SELW[pgp] = (unsigned short)((i >> 1) * 128 + (i & 1) + 2 * lane);
                            baseg += (unsigned)__popcll(bg);
                            const bool eq = cd(i) == T; const unsigned long long be = __ballot(eq);
                            if (be) { const unsigned pep = basee + __builtin_amdgcn_mbcnt_hi((unsigned)(be >> 32), __builtin_amdgcn_mbcnt_lo((unsigned)be, 0u));
                                if (eq && pep < 256u) SELW[pep] = (unsigned short)((i >> 1) * 128 + (i & 1) + 2 * lane);
                                basee += (unsigned)__popcll(be); } } } }
#undef cd
#undef ZERO_HIST
#undef SCAN_HIST
                }
                LDS_WAIT(); asm volatile("" ::: "memory");
                }
                for (int rat_ = 0; rat_ < REP_ATT; ++rat_) {
                bf16* qrow = QB + (size_t)q * 4096;
                bf16x8 Bq[8];
#pragma unroll
                for (int ks = 0; ks < 8; ++ks) Bq[ks] = *(const bf16x8*)(qrow + hd * 256 + ks * 32 + g * 8);
                const bf16* kvb = CKV + (size_t)b * SEQ * 256;
                f32x4 O[16];
#pragma unroll
                for (int ct = 0; ct < 16; ++ct) O[ct] = (f32x4){0.f, 0.f, 0.f, 0.f};
                float mrun = -1.0e30f, lsum = 0.f;
                LDS_WAIT(); asm volatile("" ::: "memory");
                const int nks = nsel >> 5;
                const int lrow = lane >> 5, lcp = lane & 31, lsh = 16 * lrow;
                v4u KR[16];
#define ATT_IDX(KST_) v4u iw_[4]; _Pragma("unroll") for (int c = 0; c < 4; ++c) iw_[c] = *(const LAS v4u*)(SELW + 32 * (KST_) + 8 * c)
#define ATT_LOADROWS(KST_) do { ATT_IDX(KST_); _Pragma("unroll") for (int i = 0; i < 16; ++i) { const int rr_ = 2 * i + lrow; const unsigned w_ = iw_[i >> 2][i & 3]; const int ix_ = (int)((w_ >> lsh) & 0xffffu); \
                    KR[i] = *(const v4u*)(kvb + (size_t)ix_ * 256 + ((lcp ^ (rr_ & 7)) * 8)); } } while (0)
                ATT_LOADROWS(0);
                const int rlA = hd & 7;
                const int rlT = (4 * g + qq) & 7;
                const int trb = (4 * g + qq) * 512 + 8 * (pp & 1), trm = 16 * ((pp >> 1) ^ rlT);
                for (int kst = 0; kst < nks; ++kst) {
                    int rlA_ = rlA, trm_ = trm; asm volatile("" : "+v"(rlA_), "+v"(trm_));
                    if (kst + 1 < nks) {
                        ATT_IDX(kst + 1);
#pragma unroll
                        for (int i = 0; i < 16; ++i) { *(LAS v4u*)(VB + i * 1024 + lane * 16) = KR[i];
                            const int rr_ = 2 * i + lrow; const unsigned w_ = iw_[i >> 2][i & 3]; const int ix_ = (int)((w_ >> lsh) & 0xffffu); KR[i] = *(const v4u*)(kvb + (size_t)ix_ * 256 + ((lcp ^ (rr_ & 7)) * 8)); }
                    } else {
#pragma unroll
                        for (int i = 0; i < 16; ++i) *(LAS v4u*)(VB + i * 1024 + lane * 16) = KR[i]; }
                    LDS_WAIT(); asm volatile("" ::: "memory");
                    f32x4 S0 = {0.f, 0.f, 0.f, 0.f}, S1 = {0.f, 0.f, 0.f, 0.f};
#pragma unroll
                    for (int k4 = 0; k4 < 4; ++k4) {
                        bf16x8 a0[2], a1[2];
#pragma unroll
                        for (int j = 0; j < 2; ++j) { const int ks = k4 * 2 + j; const int cpos = (4 * ks + g) ^ rlA_;
                            a0[j] = *(const LAS bf16x8*)(VB + hd * 512 + cpos * 16); a1[j] = *(const LAS bf16x8*)(VB + (16 + hd) * 512 + cpos * 16); }
#pragma unroll
                        for (int j = 0; j < 2; ++j) { const int ks = k4 * 2 + j;
                            S0 = __builtin_amdgcn_mfma_f32_16x16x32_bf16(a0[j], Bq[ks], S0, 0, 0, 0); S1 = __builtin_amdgcn_mfma_f32_16x16x32_bf16(a1[j], Bq[ks], S1, 0, 0, 0); }
                    }
                    const v2u pa = *(const LAS v2u*)(SELW + 32 * kst + 4 * g), pb = *(const LAS v2u*)(SELW + 32 * kst + 16 + 4 * g);
                    const float fp = (float)pos;
                    float s0[4], s1[4];
                    s0[0] = S0[0] - slope * fabsf(fp - (float)(pa.x & 0xffffu)); s0[1] = S0[1] - slope * fabsf(fp - (float)(pa.x >> 16));
                    s0[2] = S0[2] - slope * fabsf(fp - (float)(pa.y & 0xffffu)); s0[3] = S0[3] - slope * fabsf(fp - (float)(pa.y >> 16));
                    s1[0] = S1[0] - slope * fabsf(fp - (float)(pb.x & 0xffffu)); s1[1] = S1[1] - slope * fabsf(fp - (float)(pb.x >> 16));
                    s1[2] = S1[2] - slope * fabsf(fp - (float)(pb.y & 0xffffu)); s1[3] = S1[3] - slope * fabsf(fp - (float)(pb.y >> 16));
                    float ml = fmaxf(fmaxf(fmaxf(s0[0], s0[1]), fmaxf(s0[2], s0[3])), fmaxf(fmaxf(s1[0], s1[1]), fmaxf(s1[2], s1[3])));
                    ml = xmax16(ml); ml = xmax32(ml);
                    const float mnew = fmaxf(mrun, ml), alpha = __expf(mrun - mnew); mrun = mnew;
                    float p0[4], p1[4];
#pragma unroll
                    for (int r = 0; r < 4; ++r) { p0[r] = __expf(s0[r] - mnew); p1[r] = __expf(s1[r] - mnew); }
                    lsum = lsum * alpha + ((p0[0] + p0[1]) + (p0[2] + p0[3])) + ((p1[0] + p1[1]) + (p1[2] + p1[3]));
                    v4u pw; pw.x = pk2(p0[0], p0[1]); pw.y = pk2(p0[2], p0[3]); pw.z = pk2(p1[0], p1[1]); pw.w = pk2(p1[2], p1[3]);
                    const bf16x8 Pf = __builtin_bit_cast(bf16x8, pw);
#pragma unroll
                    for (int ct = 0; ct < 16; ++ct) O[ct] = O[ct] * alpha;
#pragma unroll
                    for (int c8 = 0; c8 < 4; ++c8) {
                        v4s lo[4], hi[4];
#pragma unroll
                        for (int j = 0; j < 4; ++j) { const int ct = c8 * 4 + j; const int off = trb + ((32 * ct) ^ trm_);
                            lo[j] = __builtin_amdgcn_ds_read_tr16_b64_v4i16((LAS v4s*)(VB + off));
                            hi[j] = __builtin_amdgcn_ds_read_tr16_b64_v4i16((LAS v4s*)(VB + 16 * 512 + off)); }
#pragma unroll
                        for (int j = 0; j < 4; ++j) { const int ct = c8 * 4 + j;
                            const bf16x8 Af = {lo[j][0], lo[j][1], lo[j][2], lo[j][3], hi[j][0], hi[j][1], hi[j][2], hi[j][3]};
                            O[ct] = __builtin_amdgcn_mfma_f32_16x16x32_bf16(Af, Pf, O[ct], 0, 0, 0); }
                    }
                    LDS_WAIT(); asm volatile("" ::: "memory");
                }
#undef ATT_LOADROWS
#undef ATT_IDX
                lsum = xsum16(lsum); lsum = xsum32(lsum);
                const float inv = 1.0f / lsum;
#pragma unroll
                for (int ct = 0; ct < 16; ++ct) { const f32x4 o = O[ct] * inv; v2u w; w.x = pk2(o[0], o[1]); w.y = pk2(o[2], o[3]); *(v2u*)(OB + (size_t)q * 4096 + hd * 256 + 16 * ct + 4 * g) = w; }
                }
            }
        }
        PHASE_END
        GRID_BAR();
        }
        PHASE_BEGIN
        { pg8::Gemm g{OB, W6, M, 1024, 1024, 4096, 1024, 1024}; pg8::StaticOrder S; S.init(M, 1024, G, blk);
          EpiBf E{YAB, 2048, 1024}; pg8::gemm_phase(lds, g, S, E, tid); }
        PHASE_END
        GRID_BAR();
        PHASE_BEGIN
        { pg8::Gemm g{YAB, W7, M, DM, DM, DM, DM, 0}; pg8::StaticOrder S; S.init(M, DM, G, blk);
          EpiGateM E{GTB, MRG}; HookGate Hk{GTA, GTB}; pg8::gemm_phase(lds, g, S, E, tid, Hk); }
        PHASE_END
        GRID_BAR();
        PHASE_BEGIN
        { pg8::Gemm g{MRG, W8, M, DM, DM, DM, DM, 0}; pg8::StaticOrder S; S.init(M, DM, G, blk);
          S.mode = 1;
          EpiLn<0, false> E{ws, (l == 0) ? x_in : (const float*)nullptr, (float*)nullptr, ln1_g + l * DM, ln1_b + l * DM, lds, l};
          pg8::gemm_phase(lds, g, S, E, tid); }
        PHASE_END
        GRID_BAR();
        PHASE_BEGIN
        { pg8::Gemm g{HB, W10, M, N10, DM, DM, DM, 0}; pg8::StaticOrder S; S.init(M, N10, G, blk);
          EpiSwiglu E{ACT}; pg8::gemm_phase(lds, g, S, E, tid); }
        PHASE_END
        GRID_BAR();
        if (l == DEPTH - 1) {
        PHASE_BEGIN
        { pg8::Gemm g{ACT, W11, M, DM, DFF, DFF, DFF, 0, 0}; pg8::StaticOrder S; S.init(M, DM, G, blk); S.mode = 1;
          EpiLn<1, true> E{ws, (const float*)nullptr, args.out, ln2_g + l * DM, ln2_b + l * DM, lds, l}; pg8::gemm_phase(lds, g, S, E, tid); }
        PHASE_END
        } else {
        PHASE_BEGIN
        { pg8::Gemm g{ACT, W11, M, DM, DFF, DFF, DFF, 0, 0}; pg8::StaticOrder S; S.init(M, DM, G, blk); S.mode = 1;
          EpiLn<1, false> E{ws, (const float*)nullptr, (float*)nullptr, ln2_g + l * DM, ln2_b + l * DM, lds, l}; pg8::gemm_phase(lds, g, S, E, tid); }
        PHASE_END
        }
        if (l + 1 < DEPTH) {
            GRID_BAR();
            PHASE_BEGIN
            { CONVERT_LAYER(l + 1); }
            PHASE_END
            GRID_BAR();
        }
    }
}

extern "C" void kernel_launch(void* const* d_in, const int* in_sizes, int n_in, void* d_out, int out_size, void* d_ws, size_t ws_size, hipStream_t stream) {
    static int grid = 0;
    if (grid == 0) {
        if (n_in != 22 || out_size != M * DM || ws_size < WS_END) { fprintf(stderr, "kernel_launch: unexpected shapes (n_in %d, out %d, ws %zu < %zu)\n", n_in, out_size, ws_size, (size_t)WS_END); grid = -1; return; }
        int dev = 0, cus = 0, per_cu = 0;
        if (hipGetDevice(&dev) != hipSuccess || hipDeviceGetAttribute(&cus, hipDeviceAttributeMultiprocessorCount, dev) != hipSuccess) { grid = -1; return; }
        if (hipFuncSetAttribute((const void*)fwd_kernel, hipFuncAttributeMaxDynamicSharedMemorySize, LDS_BYTES) != hipSuccess) { fprintf(stderr, "kernel_launch: hipFuncSetAttribute failed\n"); grid = -1; return; }
        if (hipOccupancyMaxActiveBlocksPerMultiprocessor(&per_cu, (const void*)fwd_kernel, NTHR, LDS_BYTES) != hipSuccess || per_cu < 1) { fprintf(stderr, "kernel_launch: occupancy query says %d\n", per_cu); }
        (void)hipGetLastError();
        if (cus % 64 != 0) { fprintf(stderr, "kernel_launch: %d CUs: the fused-LayerNorm unit order needs a multiple of 64 workgroups\n", cus); grid = -1; return; }
        grid = cus;
    }
    if (grid < 0) return;
    if (hipMemsetAsync((char*)d_ws + WS_CTL, 0, CTL_ZERO_BYTES, stream) != hipSuccess) return;
    Args a{};
    for (int i = 0; i < 22; ++i) a.in[i] = (const float*)d_in[i];
    a.out = (float*)d_out; a.ws = (unsigned char*)d_ws;
    hipLaunchKernelGGL(fwd_kernel, dim3(grid), dim3(NTHR), LDS_BYTES, stream, a);
}
```

```cpp
#include <hip/hip_runtime.h>
#include <cstdio>
#include <cstdint>

namespace pg8 {
#define PG8_LAS __attribute__((address_space(3)))
typedef unsigned short bf16_t;
typedef short bf16x8 __attribute__((ext_vector_type(8)));
typedef float f32x4 __attribute__((ext_vector_type(4)));
typedef unsigned u32x4 __attribute__((ext_vector_type(4)));
constexpr int BM = 256, BK = 64, HALF = 128, HTB = HALF * BK * 2, STAGE_BYTES = 8 * HTB, NXCD = 8, WGM = 8;

__host__ __device__ __forceinline__ int lds_byte(int r, int c) { const int st = (r >> 4) * 2 + (c >> 5), rr = r & 15, cc = c & 31, ob = rr * 64 + cc * 2; return st * 1024 + (ob ^ (((ob >> 9) & 1) << 5)); }
__host__ __device__ __forceinline__ void stage_rc(int b, int& R, int& C) { const int st = b / 1024, sb = b % 1024, swz = sb ^ (((sb >> 9) & 1) << 5); R = (st >> 1) * 16 + swz / 64; C = (st & 1) * 32 + (swz % 64) / 2; }
__host__ __device__ __forceinline__ int perm32(int rho) { const int n = rho >> 4, i = rho & 15; return 8 * (i >> 2) + 4 * n + (i & 3); }

struct Unit { int pm, pn; };
struct Gemm { const bf16_t* A; const bf16_t* Bt; int M, N, K, lda, ldb, a_pn_stride; int krev = 0; };

struct StaticOrder {
    int nM, nN, nwg, G, c, mode;
    __host__ __device__ void init(int M, int N, int G_, int c_) { nM = M / BM; nN = N / BM; nwg = nM * nN; G = G_; c = c_; mode = 0; }
    __host__ __device__ bool next(int i, Unit& u) const {
        if (mode == 1) {
            const int PR = G >> 3, x = c & 7, j = c >> 3, pq = PR >> 3, nx = nM >> 3; if (i * pq + (j >> 3) >= nx) return false; u.pm = x * nx + i * pq + (j >> 3); u.pn = j & 7; return true; }
        const long L = (long)i * G + c; if (L >= nwg) return false;
        int wgid = (int)L; { const int q = nwg / NXCD, r = nwg % NXCD, xcd = wgid % NXCD, off = wgid / NXCD; wgid = (xcd < r ? xcd * (q + 1) : r * (q + 1) + (xcd - r) * q) + off; }
        const int nig = WGM * nN, gid = wgid / nig, fm = gid * WGM, gsz = (nM - fm) < WGM ? (nM - fm) : WGM;
        u.pm = fm + ((wgid % nig) % gsz); u.pn = (wgid % nig) / gsz; return true;
    }
};

typedef float f32x2_t __attribute__((ext_vector_type(2))); typedef __bf16 bf16x2_t __attribute__((ext_vector_type(2)));
__device__ __forceinline__ unsigned cvt_pk_bf16(float lo, float hi) { f32x2_t v = {lo, hi}; bf16x2_t b = __builtin_convertvector(v, bf16x2_t); return __builtin_bit_cast(unsigned, b); }

struct NoHook { static constexpr bool ON = false; template <class A> __device__ __forceinline__ void mid(A&, const Unit&, int, int, int, int) const {} };
template <class Epi, class Hook = NoHook>
__device__ __forceinline__ void gemm_phase(PG8_LAS unsigned char* lds, const Gemm g, const StaticOrder& S, const Epi& E, const int tid, const Hook H = Hook()) {
    const int wid = __builtin_amdgcn_readfirstlane(tid >> 6), lane = tid & 63, wr = wid >> 2, wc = wid & 3, fr = lane & 15, fq = lane >> 4;
    const int K = g.K, nt = K / BK;
    unsigned voffA[2], voffB[2];
#pragma unroll
    for (int i = 0; i < 2; ++i) { int R, C; stage_rc(tid * 16 + i * 8192, R, C); const int Rb = 64 * (R >> 5) + perm32(R & 31);
        voffA[i] = (unsigned)(R * g.lda + C) * 2u; voffB[i] = (unsigned)(Rb * g.ldb + C) * 2u; }
    const long kstep = g.krev ? -(long)(BK * 2) : (long)(BK * 2); const size_t kbase = g.krev ? (size_t)(nt - 1) * (BK * 2) : 0;
    const size_t hstepA = (size_t)HALF * g.lda * 2, hstepB = (size_t)32 * g.ldb * 2;
    const size_t tstepA = 2 * hstepA, tstepB = (size_t)BM * g.ldb * 2;
    const unsigned ldsw = (unsigned)wid * 1024u;
    const int aoff = lds_byte(wr * 64 + fr, fq * 8), boff = lds_byte(wc * 32 + fr, fq * 8);
#define PG8_SA(b, h) (((b) * 2 + (h)) * HTB)
#define PG8_SB(b, h) ((4 + (b) * 2 + (h)) * HTB)
#define PG8_STAGE(bufoff, gbase, voff) do { _Pragma("unroll") for (int _i = 0; _i < 2; ++_i) \
        __builtin_amdgcn_global_load_lds((const unsigned*)((const char*)(gbase) + (voff)[_i]), (PG8_LAS unsigned*)(lds + (bufoff) + ldsw + _i * 8192), 16, 0, 0); } while (0)
#define PG8_LDA(dst, b, h) do { _Pragma("unroll") for (int m = 0; m < 4; ++m) _Pragma("unroll") for (int k = 0; k < 2; ++k) dst[m][k] = *(const PG8_LAS bf16x8*)(lds + PG8_SA(b, h) + aoff + m * 2048 + k * 1024); } while (0)
#define PG8_LDB(dst, b, h) do { _Pragma("unroll") for (int n = 0; n < 2; ++n) _Pragma("unroll") for (int k = 0; k < 2; ++k) dst[n][k] = *(const PG8_LAS bf16x8*)(lds + PG8_SB(b, h) + boff + n * 2048 + k * 1024); } while (0)
#define PG8_MMA(ai, bj, At, Bt) do { __builtin_amdgcn_s_setprio(1); _Pragma("unroll") for (int m = 0; m < 4; ++m) _Pragma("unroll") for (int n = 0; n < 2; ++n) _Pragma("unroll") for (int k = 0; k < 2; ++k) \
        acc[ai][bj][m][n] = __builtin_amdgcn_mfma_f32_16x16x32_bf16(Bt[n][k], At[m][k], acc[ai][bj][m][n], 0, 0, 0); __builtin_amdgcn_s_setprio(0); } while (0)
#define PG8_WAIT_V(n) asm volatile("s_waitcnt vmcnt(" #n ")" ::: "memory")
#define PG8_WAIT_L(n) asm volatile("s_waitcnt lgkmcnt(" #n ")" ::: "memory")
#define PG8_BAR __builtin_amdgcn_s_barrier()
#define PG8_SCHED __builtin_amdgcn_sched_barrier(0)
    Unit cur, nxt; int ui = 0;
    if (!S.next(0, cur)) return;
    f32x4 acc[2][2][4][2];
#pragma unroll
    for (int a = 0; a < 2; ++a)
#pragma unroll
        for (int b = 0; b < 2; ++b)
#pragma unroll
            for (int m = 0; m < 4; ++m)
#pragma unroll
                for (int n = 0; n < 2; ++n) acc[a][b][m][n] = (f32x4){0.f, 0.f, 0.f, 0.f};
    bf16x8 At[4][2], B0[2][2], B1[2][2];
    const char* cA = (const char*)g.A + (size_t)cur.pm * tstepA + (size_t)cur.pn * g.a_pn_stride * 2 + kbase; const char* cB = (const char*)g.Bt + (size_t)cur.pn * tstepB + kbase;
    PG8_STAGE(PG8_SB(0, 0), cB, voffB); PG8_STAGE(PG8_SB(0, 1), cB + hstepB, voffB); PG8_STAGE(PG8_SA(0, 0), cA, voffA); PG8_STAGE(PG8_SA(0, 1), cA + hstepA, voffA);
    if (wr == 1) PG8_BAR;
    PG8_WAIT_V(2); PG8_BAR;
    PG8_STAGE(PG8_SB(1, 0), cB + kstep, voffB); PG8_STAGE(PG8_SA(1, 0), cA + kstep, voffA); PG8_STAGE(PG8_SB(1, 1), cB + hstepB + kstep, voffB);
    PG8_WAIT_V(6); PG8_BAR;
    for (;;) {
        const bool has_next = S.next(ui + 1, nxt);
        const char* nA = has_next ? (const char*)g.A + (size_t)nxt.pm * tstepA + (size_t)nxt.pn * g.a_pn_stride * 2 + kbase : cA; const char* nB = has_next ? (const char*)g.Bt + (size_t)nxt.pn * tstepB + kbase : cB;
        for (int t = 0; t < nt; t += 2) {
            const bool last = (t == nt - 2);
            const char* a1 = cA + (long)(t + 1) * kstep;
            const char* a2 = last ? nA : cA + (long)(t + 2) * kstep; const char* b2 = last ? nB : cB + (long)(t + 2) * kstep;
            const char* a3 = a2 + kstep; const char* b3 = b2 + kstep;
            if constexpr (Hook::ON) { if (t == (nt >> 1)) H.mid(acc, cur, wr, wc, fr, fq); }
            PG8_LDB(B0, 0, 0); PG8_LDB(B1, 0, 1); PG8_SCHED; PG8_LDA(At, 0, 0); PG8_STAGE(PG8_SA(1, 1), a1 + hstepA, voffA);
            PG8_WAIT_V(8); PG8_WAIT_L(0); PG8_BAR; PG8_MMA(0, 0, At, B0); PG8_MMA(0, 1, At, B1); PG8_BAR; PG8_SCHED;
            PG8_LDA(At, 0, 1); PG8_STAGE(PG8_SB(0, 0), b2, voffB); PG8_STAGE(PG8_SB(0, 1), b2 + hstepB, voffB); PG8_STAGE(PG8_SA(0, 0), a2, voffA);
            PG8_WAIT_V(8); PG8_WAIT_L(0); PG8_BAR; PG8_MMA(1, 0, At, B0); PG8_MMA(1, 1, At, B1); PG8_BAR; PG8_SCHED;
            PG8_LDB(B0, 1, 0); PG8_LDB(B1, 1, 1); PG8_SCHED; PG8_LDA(At, 1, 0); PG8_STAGE(PG8_SA(0, 1), a2 + hstepA, voffA);
            PG8_WAIT_V(8); PG8_WAIT_L(0); PG8_BAR; PG8_MMA(0, 0, At, B0); PG8_MMA(0, 1, At, B1); PG8_BAR; PG8_SCHED;
            PG8_LDA(At, 1, 1); PG8_STAGE(PG8_SB(1, 0), b3, voffB); PG8_STAGE(PG8_SB(1, 1), b3 + hstepB, voffB); PG8_STAGE(PG8_SA(1, 0), a3, voffA);
            PG8_WAIT_V(8); PG8_WAIT_L(0); PG8_BAR; PG8_MMA(1, 0, At, B0); PG8_MMA(1, 1, At, B1); PG8_BAR; PG8_SCHED;
        }
        if (wr == 0) PG8_BAR;
        E(acc, cur, wr, wc, fr, fq);
        if (!has_next) break;
#pragma unroll
        for (int a = 0; a < 2; ++a)
#pragma unroll
            for (int b = 0; b < 2; ++b)
#pragma unroll
                for (int m = 0; m < 4; ++m)
#pragma unroll
                    for (int n = 0; n < 2; ++n) acc[a][b][m][n] = (f32x4){0.f, 0.f, 0.f, 0.f};
        cur = nxt; cA = nA; cB = nB; ++ui;
        if (wr == 1) PG8_BAR;
    }
    PG8_WAIT_V(0);
    PG8_BAR;
#undef PG8_SA
#undef PG8_SB
#undef PG8_STAGE
#undef PG8_LDA
#undef PG8_LDB
#undef PG8_MMA
#undef PG8_WAIT_V
#undef PG8_WAIT_L
#undef PG8_BAR
#undef PG8_SCHED
}
}

constexpr int NWAVES = 8, NTHR = NWAVES * 64;
constexpr int DM = 2048, NBATCH = 4, SEQ = 4096, DEPTH = 4, M = NBATCH * SEQ;
constexpr int HGW = 1024;
constexpr int SAH = 16, SAC = 256, SAR = 512;
constexpr int DFF = 5632;
constexpr int N1 = 9216, N3 = 5120, N10 = 2 * DFF;
constexpr float ALPHA = 1.6817928305074292f;
constexpr int MODW = 6 * DM;

constexpr size_t MiB = 1u << 20;
constexpr size_t WS_CTL = 0, CTL_ZERO_BYTES = 32768;
constexpr size_t WS_MOD = 1 * MiB;
constexpr size_t WS_LB = 2 * MiB;
constexpr size_t WS_MODP = 3 * MiB;
constexpr size_t WS_W1 = 9 * MiB;
constexpr size_t WS_W3 = WS_W1 + 36 * MiB;
constexpr size_t WS_W6 = WS_W3 + 5 * MiB;
constexpr size_t WS_W7 = WS_W6 + 2 * MiB;
constexpr size_t WS_W8 = WS_W7 + 8 * MiB;
constexpr size_t WS_W10 = WS_W8 + 8 * MiB;
constexpr size_t WS_W11 = WS_W10 + 44 * MiB;
constexpr size_t WS_X = WS_W11 + 22 * MiB;
constexpr size_t WS_R = WS_X + 128 * MiB;
constexpr size_t WS_H = WS_R + 128 * MiB;
constexpr size_t WS_QA = WS_H + 64 * MiB;
constexpr size_t WS_FA = WS_QA + 32 * MiB;
constexpr size_t WS_IA = WS_FA + 64 * MiB;
constexpr size_t WS_GA = WS_IA + 32 * MiB;
constexpr size_t WS_LAT = WS_GA + 32 * MiB;
constexpr size_t WS_GTA = WS_LAT + 64 * MiB;
constexpr size_t WS_GTB = WS_GTA + 64 * MiB;
constexpr size_t WS_CQN = WS_GTB + 64 * MiB;
constexpr size_t WS_CKV = WS_CQN + 16 * MiB;
constexpr size_t WS_KIDX = WS_CKV + 8 * MiB;
constexpr size_t WS_IDXW = WS_KIDX + 2 * MiB;
constexpr size_t WS_QB = WS_IDXW + 1 * MiB;
constexpr size_t WS_QIDX = WS_QB + 128 * MiB;
constexpr size_t WS_SEL = WS_QIDX + 32 * MiB;
constexpr size_t WS_YAB = WS_SEL + 8 * MiB;
constexpr size_t WS_MRG = WS_FA;
constexpr size_t WS_OB = WS_YAB + 64 * MiB;
constexpr size_t WS_BIG = WS_OB + 128 * MiB;
constexpr size_t WS_KSB = WS_BIG + 256 * MiB;
constexpr size_t WS_DEB = WS_KSB + 32 * MiB;
constexpr size_t WS_QSB = WS_DEB + 2 * MiB;
constexpr size_t WS_END = WS_QSB + 32 * MiB;

constexpr int CW_BAR = 4096;

constexpr int RING_BYTES = 131072;
constexpr int LDS_BYTES = 163840;
constexpr int LDSCTL_OFF = LDS_BYTES - 1024, MISC_OFF = LDSCTL_OFF + 320, SELL_OFF = 147456;

#define GAS __attribute__((address_space(1)))
#define LAS __attribute__((address_space(3)))
typedef unsigned short bf16;
typedef unsigned v4u __attribute__((ext_vector_type(4)));
typedef unsigned v2u __attribute__((ext_vector_type(2)));
typedef float f32x4 __attribute__((ext_vector_type(4)));
typedef float f32x16 __attribute__((ext_vector_type(16)));
typedef short bf16x8 __attribute__((ext_vector_type(8)));
typedef short v4s __attribute__((ext_vector_type(4)));
typedef GAS unsigned gu32;
#define LDS_WAIT() asm volatile("s_waitcnt lgkmcnt(0)" ::: "memory")
__device__ __forceinline__ unsigned f2bf(float f) { unsigned u = __builtin_bit_cast(unsigned, f); return (u + 0x7fffu + ((u >> 16) & 1u)) >> 16; }
__device__ __forceinline__ unsigned pk2(float lo, float hi) { return pg8::cvt_pk_bf16(lo, hi); }
__device__ __forceinline__ float bf2f(unsigned short b) { return __builtin_bit_cast(float, ((unsigned)b) << 16); }
__device__ __forceinline__ float bflo(unsigned w) { return __builtin_bit_cast(float, w << 16); }
__device__ __forceinline__ float bfhi(unsigned w) { return __builtin_bit_cast(float, w & 0xffff0000u); }
__device__ __forceinline__ float sigm(float x) { return __builtin_amdgcn_rcpf(1.f + __expf(-x)); }

__device__ __forceinline__ int lane_id() { unsigned m = ~0u; asm volatile("" : "+s"(m)); return (int)__builtin_amdgcn_mbcnt_hi(m, __builtin_amdgcn_mbcnt_lo(m, 0u)); }
#define XB_TMO      128
#define XB_XCNT(j)  (256  + 64 * (j))
#define XB_XSUB(j)  (1280 + 64 * (j))
#define XB_XGEN(j)  (2304 + 64 * (j))
#define XB_TOP      3328
#define XB_TOPGEN   3392
#define XCD_BAR_WORDS 3456
#define XB_SPIN_CAP (1u << 22)

__device__ __forceinline__ unsigned xb_ld(unsigned* p)              { return __hip_atomic_load(p, __ATOMIC_RELAXED, __HIP_MEMORY_SCOPE_AGENT); }
__device__ __forceinline__ unsigned xb_add(unsigned* p, unsigned v) { return __hip_atomic_fetch_add(p, v, __ATOMIC_RELAXED, __HIP_MEMORY_SCOPE_AGENT); }
__device__ __forceinline__ unsigned xb_xcc_id() { return (unsigned)__builtin_amdgcn_s_getreg((3 << 11) | 20) & 0xFu; }
#define XB_SPIN(cond, bar) do { unsigned _sp = 0; while (cond) { __builtin_amdgcn_s_sleep(1); \
    if ((++_sp & 255u) == 0u) { if (xb_ld(&(bar)[XB_TMO])) break; if (_sp > XB_SPIN_CAP) { atomicAdd(&(bar)[XB_TMO], 1u); break; } } } } while (0)

struct XcdBarrier { unsigned* bar; unsigned x; volatile LAS unsigned* st; int wave; };

__device__ __forceinline__ XcdBarrier xcd_barrier_post(unsigned* bar, volatile LAS unsigned* st) {
    XcdBarrier b; b.bar = bar; b.x = (unsigned)__builtin_amdgcn_readfirstlane((int)xb_xcc_id()); b.st = st;
    if (threadIdx.x == 0) (void)xb_add(&bar[XB_XCNT(b.x)], 1u);
    return b;
}
__device__ __forceinline__ void xcd_barrier_complete(unsigned* bar, unsigned x, unsigned& nloc, unsigned& nx) {
    const unsigned G = gridDim.x * gridDim.y * gridDim.z;
    unsigned sum, cnt, mine, sp = 0u;
    for (;;) {
        sum = 0u; cnt = 0u; mine = 0u;
#pragma unroll 1
        for (unsigned j = 0; j < 16; ++j) { const unsigned c = xb_ld(&bar[XB_XCNT(j)]); sum += c; cnt += (c > 0u) ? 1u : 0u; mine = (j == x) ? c : mine; }
        if (sum == G) break;
        __builtin_amdgcn_s_sleep(1);
        if ((++sp & 255u) == 0u) { if (xb_ld(&bar[XB_TMO])) break; if (sp > XB_SPIN_CAP) { atomicAdd(&bar[XB_TMO], 1u); break; } }
    }
    nloc = mine > 0u ? mine : 1u; nx = cnt > 0u ? cnt : 1u;
}
__device__ __forceinline__ void xcd_barrier(const XcdBarrier& b) {
    asm volatile("s_waitcnt vmcnt(0)" ::: "memory");
    __syncthreads();
    if (b.wave == 0 && lane_id() == 0) {
        unsigned* bar = b.bar;
        unsigned bx = b.x; asm volatile("" : "+s"(bx));
        __builtin_amdgcn_s_waitcnt(0);
        unsigned nloc = b.st[0], nx = b.st[1];
        const unsigned old = xb_add(&bar[XB_XSUB(bx)], 1u);
        const unsigned gen = old / nloc;
        if (old + 1u == (gen + 1u) * nloc) {
            __builtin_amdgcn_fence(__ATOMIC_RELEASE, "agent");
            asm volatile("s_waitcnt vmcnt(0)" ::: "memory");
            const unsigned og = xb_add(&bar[XB_TOP], 1u);
            const unsigned tg = og / nx;
            if (og + 1u == (tg + 1u) * nx) xb_add(&bar[XB_TOPGEN], 1u);
            else XB_SPIN(xb_ld(&bar[XB_TOPGEN]) == tg, bar);
            __builtin_amdgcn_fence(__ATOMIC_ACQUIRE, "agent");
            xb_add(&bar[XB_XGEN(bx)], 1u);
            asm volatile("s_waitcnt vmcnt(0)" ::: "memory");
        } else {
            XB_SPIN(xb_ld(&bar[XB_XGEN(bx)]) == gen, bar);
            __builtin_amdgcn_fence(__ATOMIC_ACQUIRE, "agent");
            asm volatile("s_waitcnt vmcnt(0)" ::: "memory");
        }
    }
    __syncthreads();
}

__device__ __forceinline__ void xswap16(float& a, float& b) { asm volatile("s_nop 1\n\tv_permlane16_swap_b32 %0, %1\n\ts_nop 1" : "+v"(a), "+v"(b)); }
__device__ __forceinline__ void xswap32(float& a, float& b) { asm volatile("s_nop 1\n\tv_permlane32_swap_b32 %0, %1\n\ts_nop 1" : "+v"(a), "+v"(b)); }
__device__ __forceinline__ float xmax16(float x) { float a = x, b = x; xswap16(a, b); return fmaxf(a, b); }
__device__ __forceinline__ float xmax32(float x) { float a = x, b = x; xswap32(a, b); return fmaxf(a, b); }
__device__ __forceinline__ float xsum16(float x) { float a = x, b = x; xswap16(a, b); return a + b; }
__device__ __forceinline__ float xsum32(float x) { float a = x, b = x; xswap32(a, b); return a + b; }

#define DPPF(x, ctrl) __builtin_bit_cast(float, __builtin_amdgcn_update_dpp(0, __builtin_bit_cast(int, (x)), (ctrl), 0xf, 0xf, true))
__device__ __forceinline__ float wmax_f(float x) {
    x = fmaxf(x, DPPF(x, 0xB1)); x = fmaxf(x, DPPF(x, 0x4E)); x = fmaxf(x, DPPF(x, 0x124)); x = fmaxf(x, DPPF(x, 0x128));
    x = xmax16(x); return xmax32(x);
}
__device__ __forceinline__ unsigned wprefix_u(unsigned x) {
    int v = (int)x;
    v += __builtin_amdgcn_update_dpp(0, v, 0x111, 0xf, 0xf, false);
    v += __builtin_amdgcn_update_dpp(0, v, 0x112, 0xf, 0xf, false);
    v += __builtin_amdgcn_update_dpp(0, v, 0x114, 0xf, 0xf, false);
    v += __builtin_amdgcn_update_dpp(0, v, 0x118, 0xf, 0xf, false);
    v += __builtin_amdgcn_update_dpp(0, v, 0x142, 0xa, 0xf, false);
    v += __builtin_amdgcn_update_dpp(0, v, 0x143, 0xc, 0xf, false);
    return (unsigned)v;
}

__device__ __forceinline__ float rowsum16(float x) { x += DPPF(x, 0xB1); x += DPPF(x, 0x4E); x += DPPF(x, 0x124); x += DPPF(x, 0x128); return x; }
__device__ __forceinline__ float wave_sum(float x) { x = rowsum16(x); x = xsum16(x); return xsum32(x); }
__device__ __forceinline__ float wave_max(float x) { return wmax_f(x); }
__device__ __forceinline__ int wave_sum_i(int v) { float f = wave_sum((float)v); return (int)(f + 0.5f); }
template <class Src>
__device__ __forceinline__ void cvt_load(const Src& src, int k0, int n0, int lane, float (&tv)[32]) {
#pragma unroll
    for (int j = 0; j < 8; ++j) { const f32x4 v = src(k0 + 8 * j + (lane >> 3), n0 + 4 * (lane & 7)); tv[4 * j] = v[0]; tv[4 * j + 1] = v[1]; tv[4 * j + 2] = v[2]; tv[4 * j + 3] = v[3]; }
}
__device__ __forceinline__ void cvt_store(const float (&tv)[32], bf16* WT, int K, int k0, int n0, LAS float* scr, int lane) {
#pragma unroll
    for (int j = 0; j < 8; ++j)
#pragma unroll
        for (int e = 0; e < 4; ++e) scr[(8 * j + (lane >> 3)) * 33 + 4 * (lane & 7) + e] = tv[4 * j + e];
    LDS_WAIT(); asm volatile("" ::: "memory");
    const int c = lane & 7;
#pragma unroll
    for (int j = 0; j < 4; ++j) { const int n = (lane >> 3) + 8 * j; const LAS float* s = scr + (8 * c) * 33 + n;
        v4u o; o.x = pk2(s[0 * 33], s[1 * 33]); o.y = pk2(s[2 * 33], s[3 * 33]); o.z = pk2(s[4 * 33], s[5 * 33]); o.w = pk2(s[6 * 33], s[7 * 33]);
        *(GAS v4u*)(WT + (size_t)(n0 + n) * K + k0 + 8 * c) = o; }
    LDS_WAIT(); asm volatile("" ::: "memory");
}

struct Args { const float* in[22]; float* out; unsigned char* ws; };

using pg8::Unit; using pg8::cvt_pk_bf16;
__device__ __forceinline__ void st_bf16x8(bf16* p, f32x4 v0, f32x4 v1) {
    v4u w; w.x = cvt_pk_bf16(v0[0], v0[1]); w.y = cvt_pk_bf16(v0[2], v0[3]); w.z = cvt_pk_bf16(v1[0], v1[1]); w.w = cvt_pk_bf16(v1[2], v1[3]);
    *(v4u*)p = w;
}
__device__ __forceinline__ void st_f32x8(float* p, f32x4 v0, f32x4 v1) { *(f32x4*)p = v0; *(f32x4*)(p + 4) = v1; }
__device__ __forceinline__ f32x4 sigm4(f32x4 v) { return (f32x4){sigm(v[0]), sigm(v[1]), sigm(v[2]), sigm(v[3])}; }
__device__ __forceinline__ f32x4 silu4(f32x4 v) { return (f32x4){v[0] * sigm(v[0]), v[1] * sigm(v[1]), v[2] * sigm(v[2]), v[3] * sigm(v[3])}; }
__device__ __forceinline__ f32x4 ldbf4(const bf16* p) { const v2u w = *(const v2u*)p; return (f32x4){bflo(w.x), bfhi(w.x), bflo(w.y), bfhi(w.y)}; }

#define EPI_LOOP(...) \
    _Pragma("unroll") for (int ai = 0; ai < 2; ++ai) _Pragma("unroll") for (int m = 0; m < 4; ++m) { const int row = row0 + ai * 128 + m * 16; \
        _Pragma("unroll") for (int bj = 0; bj < 2; ++bj) { const int col = colb + bj * 32; const f32x4 v0 = acc[ai][bj][m][0], v1 = acc[ai][bj][m][1]; __VA_ARGS__ } }

__device__ __forceinline__ unsigned q8x4(f32x4 g) { unsigned w = 0u;
#pragma unroll
    for (int e = 0; e < 4; ++e) { const float t = fmaxf(__builtin_fmaf(g[e], 255.f, 0.5f), 1.f); w |= ((unsigned)t) << (8 * e); } return w; }
__device__ __forceinline__ f32x4 ub4(unsigned w) { return (f32x4){(float)(w & 0xffu), (float)((w >> 8) & 0xffu), (float)((w >> 16) & 0xffu), (float)(w >> 24)}; }
struct EpiProj {
    bf16* QA; bf16* FA; bf16* IA; bf16* GA; bf16* LAT; bf16* GTA; bf16* GTB;
    __device__ __forceinline__ void operator()(const f32x4 (&acc)[2][2][4][2], const Unit& u, int wr, int wc, int fr, int fq) const {
        const int row0 = u.pm * 256 + wr * 64 + fr, pn = u.pn; const int colb = (pn & 3) * 256 + wc * 64 + 8 * fq;
        if (pn < 4)       { EPI_LOOP( st_bf16x8(QA + (size_t)row * 1024 + col, v0, v1); ) }
        else if (pn < 8)  { EPI_LOOP( st_bf16x8(FA + (size_t)row * 1024 + col, v0, v1); ) }
        else if (pn < 12) { EPI_LOOP( st_bf16x8(IA + (size_t)row * 1024 + col, v0, v1); ) }
        else if (pn < 16) { EPI_LOOP( st_bf16x8(GA + (size_t)row * 1024 + col, silu4(v0), silu4(v1)); ) }
        else if (pn < 20) { EPI_LOOP( st_bf16x8(LAT + (size_t)row * 1024 + col, v0, v1); ) }
        else { unsigned char* G8 = (unsigned char*)(pn < 28 ? GTA : GTB) + ((size_t)(u.pm * 8 + ((pn - 20) & 7)) * 8 + (wr * 4 + wc)) * 8192 + (fq * 16 + fr) * 16;
            _Pragma("unroll") for (int ai = 0; ai < 2; ++ai) _Pragma("unroll") for (int bj = 0; bj < 2; ++bj) _Pragma("unroll") for (int mp = 0; mp < 2; ++mp) { v4u w;
                w.x = q8x4(sigm4(acc[ai][bj][2 * mp][0])); w.y = q8x4(sigm4(acc[ai][bj][2 * mp][1])); w.z = q8x4(sigm4(acc[ai][bj][2 * mp + 1][0])); w.w = q8x4(sigm4(acc[ai][bj][2 * mp + 1][1]));
                *(v4u*)(G8 + (ai * 4 + bj * 2 + mp) * 1024) = w; } }
    }
};
struct EpiQ {
    bf16* QB; bf16* QIDX;
    __device__ __forceinline__ void operator()(const f32x4 (&acc)[2][2][4][2], const Unit& u, int wr, int wc, int fr, int fq) const {
        const int row0 = u.pm * 256 + wr * 64 + fr, pn = u.pn;
        if (pn < 16) { const int colb = pn * 256 + wc * 64 + 8 * fq; EPI_LOOP( st_bf16x8(QB + (size_t)row * 4096 + col, v0, v1); ) }
        else { const int colb = (pn - 16) * 256 + wc * 64 + 8 * fq; EPI_LOOP( st_bf16x8(QIDX + (size_t)row * 1024 + col, v0, v1); ) }
    }
};
struct EpiBf {
    bf16* O; int ldc; int coff;
    __device__ __forceinline__ void operator()(const f32x4 (&acc)[2][2][4][2], const Unit& u, int wr, int wc, int fr, int fq) const {
        const int row0 = u.pm * 256 + wr * 64 + fr; const int colb = coff + u.pn * 256 + wc * 64 + 8 * fq;
        EPI_LOOP( st_bf16x8(O + (size_t)row * ldc + col, v0, v1); )
    }
};
struct HookGate {
    static constexpr bool ON = true; const bf16* GA_; const bf16* GB_;
    __device__ __forceinline__ void mid(f32x4 (&acc)[2][2][4][2], const Unit& u, int wr, int wc, int fr, int fq) const {
        asm volatile("" : "+v"(fr), "+v"(fq));
        const size_t off = ((size_t)(u.pm * 8 + u.pn) * 8 + (wr * 4 + wc)) * 8192 + (fq * 16 + fr) * 16;
        const unsigned char* A8 = (const unsigned char*)GA_ + off; const unsigned char* B8 = (const unsigned char*)GB_ + off;
#pragma unroll
        for (int ai = 0; ai < 2; ++ai)
#pragma unroll
            for (int mp = 0; mp < 2; ++mp) {
#pragma unroll
                for (int bj = 0; bj < 2; ++bj) { const v4u a = *(const v4u*)(A8 + (ai * 4 + bj * 2 + mp) * 1024), b = *(const v4u*)(B8 + (ai * 4 + bj * 2 + mp) * 1024);
#pragma unroll
                    for (int mm = 0; mm < 2; ++mm)
#pragma unroll
                        for (int n = 0; n < 2; ++n) { const unsigned aw = a[mm * 2 + n], bw = b[mm * 2 + n]; const f32x4 fa = ub4(aw), fb = ub4(bw); f32x4 r;
#pragma unroll
                            for (int j = 0; j < 4; ++j) r[j] = fa[j] * __builtin_amdgcn_rcpf(fb[j]);
                            acc[ai][bj][2 * mp + mm][n] = acc[ai][bj][2 * mp + mm][n] * r; } }
                asm volatile("" : "+v"(acc[ai][0][2 * mp][0]), "+v"(acc[ai][0][2 * mp][1]), "+v"(acc[ai][1][2 * mp][0]), "+v"(acc[ai][1][2 * mp][1]));
                asm volatile("" : "+v"(acc[ai][0][2 * mp + 1][0]), "+v"(acc[ai][0][2 * mp + 1][1]), "+v"(acc[ai][1][2 * mp + 1][0]), "+v"(acc[ai][1][2 * mp + 1][1]));
                asm volatile("" ::: "memory"); }
    }
};
__device__ __forceinline__ f32x4 cvbf4(v2u w) { return (f32x4){bflo(w.x), bfhi(w.x), bflo(w.y), bfhi(w.y)}; }
struct EpiGateM {
    const bf16* GB_; bf16* MRG_;
    __device__ __forceinline__ void operator()(const f32x4 (&acc)[2][2][4][2], const Unit& u, int wr, int wc, int fr, int fq) const {
        const int row0 = u.pm * 256 + wr * 64 + fr; const int colb = u.pn * 256 + wc * 64 + 8 * fq;
        const unsigned char* B8 = (const unsigned char*)GB_ + ((size_t)(u.pm * 8 + u.pn) * 8 + (wr * 4 + wc)) * 8192 + (fq * 16 + fr) * 16;
#pragma unroll
        for (int ai = 0; ai < 2; ++ai) { v4u gr[2][2];
#pragma unroll
            for (int bj = 0; bj < 2; ++bj)
#pragma unroll
                for (int mp = 0; mp < 2; ++mp) gr[bj][mp] = *(const v4u*)(B8 + (ai * 4 + bj * 2 + mp) * 1024);
#pragma unroll
            for (int m = 0; m < 4; ++m)
#pragma unroll
                for (int bj = 0; bj < 2; ++bj) { const size_t o = (size_t)(row0 + ai * 128 + m * 16) * 2048 + colb + bj * 32;
                    const unsigned w0 = gr[bj][m >> 1][(m & 1) * 2], w1 = gr[bj][m >> 1][(m & 1) * 2 + 1];
                    st_bf16x8(MRG_ + o, acc[ai][bj][m][0] * (ub4(w0) * (1.f / 255.f)), acc[ai][bj][m][1] * (ub4(w1) * (1.f / 255.f))); } }
    }
};
struct EpiGateA {
    float* T1; const bf16* GT;
    __device__ __forceinline__ void operator()(const f32x4 (&acc)[2][2][4][2], const Unit& u, int wr, int wc, int fr, int fq) const {
        const int row0 = u.pm * 256 + wr * 64 + fr; const int colb = u.pn * 256 + wc * 64 + 8 * fq;
        EPI_LOOP( const size_t o = (size_t)row * 2048 + col; const f32x4 g0 = ldbf4(GT + o), g1 = ldbf4(GT + o + 4); st_f32x8(T1 + o, v0 * g0, v1 * g1); )
    }
};
struct EpiGateB {
    const float* T1; const bf16* GT; bf16* MRG;
    __device__ __forceinline__ void operator()(const f32x4 (&acc)[2][2][4][2], const Unit& u, int wr, int wc, int fr, int fq) const {
        const int row0 = u.pm * 256 + wr * 64 + fr; const int colb = u.pn * 256 + wc * 64 + 8 * fq;
        EPI_LOOP( const size_t o = (size_t)row * 2048 + col; const f32x4 g0 = ldbf4(GT + o), g1 = ldbf4(GT + o + 4); const f32x4 t0 = *(const f32x4*)(T1 + o), t1 = *(const f32x4*)(T1 + o + 4);
                  st_bf16x8(MRG + o, t0 + v0 * g0, t1 + v1 * g1); )
    }
};
struct EpiRes {
    const float* X; const bf16* Hh; bf16* R; const float* md; int osh, osc, ogt;
    __device__ __forceinline__ void operator()(const f32x4 (&acc)[2][2][4][2], const Unit& u, int wr, int wc, int fr, int fq) const {
        const int row0 = u.pm * 256 + wr * 64 + fr; const int colb = u.pn * 256 + wc * 64 + 8 * fq; const float* g = md + (size_t)(u.pm >> 4) * MODW;
        f32x4 gg[2][2];
#pragma unroll
        for (int bj = 0; bj < 2; ++bj) { gg[bj][0] = *(const f32x4*)(g + ogt + colb + bj * 32) + 1.f; gg[bj][1] = *(const f32x4*)(g + ogt + colb + bj * 32 + 4) + 1.f; }
        if (X) {
#pragma unroll
            for (int ai = 0; ai < 2; ++ai)
#pragma unroll
                for (int mh = 0; mh < 2; ++mh) { f32x4 xr[2][2][2];
#pragma unroll
                    for (int mm = 0; mm < 2; ++mm)
#pragma unroll
                        for (int bj = 0; bj < 2; ++bj) { const size_t o = (size_t)(row0 + ai * 128 + (2 * mh + mm) * 16) * 2048 + colb + bj * 32; xr[mm][bj][0] = *(const f32x4*)(X + o); xr[mm][bj][1] = *(const f32x4*)(X + o + 4); }
#pragma unroll
                    for (int mm = 0; mm < 2; ++mm)
#pragma unroll
                        for (int bj = 0; bj < 2; ++bj) { const int m = 2 * mh + mm; const size_t o = (size_t)(row0 + ai * 128 + m * 16) * 2048 + colb + bj * 32;
                            st_bf16x8(R + o, xr[mm][bj][0] * ALPHA + gg[bj][0] * acc[ai][bj][m][0], xr[mm][bj][1] * ALPHA + gg[bj][1] * acc[ai][bj][m][1]); } }
        } else {
            f32x4 ia[2][2], sb[2][2];
#pragma unroll
            for (int bj = 0; bj < 2; ++bj)
#pragma unroll
                for (int hh = 0; hh < 2; ++hh) { const f32x4 sc = *(const f32x4*)(g + osc + colb + bj * 32 + 4 * hh), sh = *(const f32x4*)(g + osh + colb + bj * 32 + 4 * hh);
#pragma unroll
                    for (int e = 0; e < 4; ++e) { ia[bj][hh][e] = ALPHA / (1.f + sc[e]); sb[bj][hh][e] = sh[e] * ia[bj][hh][e]; } }
#pragma unroll
            for (int ai = 0; ai < 2; ++ai) { v2u xr[4][2][2];
#pragma unroll
                for (int m = 0; m < 4; ++m)
#pragma unroll
                    for (int bj = 0; bj < 2; ++bj) { const size_t o = (size_t)(row0 + ai * 128 + m * 16) * 2048 + colb + bj * 32; xr[m][bj][0] = *(const v2u*)(Hh + o); xr[m][bj][1] = *(const v2u*)(Hh + o + 4); }
#pragma unroll
                for (int m = 0; m < 4; ++m)
#pragma unroll
                    for (int bj = 0; bj < 2; ++bj) { const size_t o = (size_t)(row0 + ai * 128 + m * 16) * 2048 + colb + bj * 32;
                        st_bf16x8(R + o, cvbf4(xr[m][bj][0]) * ia[bj][0] - sb[bj][0] + gg[bj][0] * acc[ai][bj][m][0], cvbf4(xr[m][bj][1]) * ia[bj][1] - sb[bj][1] + gg[bj][1] * acc[ai][bj][m][1]); } }
        }
    }
};
template <int which, bool FINAL>
struct EpiLn {
    unsigned char* ws; const float* X; float* Fo; const float* lng; const float* lnb; LAS unsigned char* lds; int l;
    __device__ __forceinline__ void operator()(f32x4 (&acc)[2][2][4][2], const Unit& u, int wr, int wc, int fr, int fq) const {
        { const int ln_ = lane_id(); fr = ln_ & 15; fq = ln_ >> 4; }
        int upm = u.pm, upn = u.pn; asm volatile("" : "+s"(upm), "+s"(upn));
        const float* MODb = (const float*)(ws + WS_MOD); bf16* Hh = (bf16*)(ws + WS_H);
        const float* g = MODb + ((size_t)l * NBATCH + (upm >> 4)) * MODW + (which ? 3 * DM : 0);
        const float* go = which ? MODb + ((size_t)(l + 1 < DEPTH ? l + 1 : l) * NBATCH + (upm >> 4)) * MODW : g + 3 * DM;
        LAS float* sl = (LAS float*)(lds + RING_BYTES);
        const int row0 = upm * 256 + wr * 64 + fr; const int colb = upn * 256 + wc * 64 + 8 * fq;
#pragma unroll
        for (int bj = 0; bj < 2; ++bj) { const int c0 = colb + bj * 32;
            const f32x4 gg0 = *(const f32x4*)(g + 2 * DM + c0) + 1.f, gg1 = *(const f32x4*)(g + 2 * DM + c0 + 4) + 1.f;
            if (which == 0 && X) {
#pragma unroll
                for (int ai = 0; ai < 2; ++ai) { f32x4 xr[4][2];
#pragma unroll
                    for (int m = 0; m < 4; ++m) { const size_t o = (size_t)(row0 + ai * 128 + m * 16) * 2048 + c0; xr[m][0] = *(const f32x4*)(X + o); xr[m][1] = *(const f32x4*)(X + o + 4); }
#pragma unroll
                    for (int m = 0; m < 4; ++m) { acc[ai][bj][m][0] = xr[m][0] * ALPHA + gg0 * acc[ai][bj][m][0]; acc[ai][bj][m][1] = xr[m][1] * ALPHA + gg1 * acc[ai][bj][m][1]; } }
            } else {
                f32x4 ia0, ia1, sb0, sb1;
                { const f32x4 sc0 = *(const f32x4*)(g + DM + c0), sc1 = *(const f32x4*)(g + DM + c0 + 4), sh0 = *(const f32x4*)(g + c0), sh1 = *(const f32x4*)(g + c0 + 4);
#pragma unroll
                  for (int e = 0; e < 4; ++e) { ia0[e] = ALPHA * __builtin_amdgcn_rcpf(1.f + sc0[e]); ia1[e] = ALPHA * __builtin_amdgcn_rcpf(1.f + sc1[e]); sb0[e] = sh0[e] * ia0[e]; sb1[e] = sh1[e] * ia1[e]; } }
#pragma unroll
                for (int ai = 0; ai < 2; ++ai) { v2u xr[4][2]; size_t o = (size_t)(row0 + ai * 128) * 2048 + c0;
#pragma unroll
                    for (int m = 0; m < 4; ++m) { xr[m][0] = *(const v2u*)(Hh + o); xr[m][1] = *(const v2u*)(Hh + o + 4); size_t st_ = 16 * 2048; asm volatile("" : "+s"(st_)); o += st_; }
#pragma unroll
                    for (int m = 0; m < 4; ++m) { acc[ai][bj][m][0] = cvbf4(xr[m][0]) * ia0 - sb0 + gg0 * acc[ai][bj][m][0]; acc[ai][bj][m][1] = cvbf4(xr[m][1]) * ia1 - sb1 + gg1 * acc[ai][bj][m][1]; }
                    asm volatile("" ::: "memory"); }
            }
            asm volatile("" ::: "memory"); }
        { const int ln_ = lane_id(); fr = ln_ & 15; fq = ln_ >> 4; }
#pragma unroll
        for (int ai = 0; ai < 2; ++ai)
#pragma unroll
            for (int m = 0; m < 4; ++m) { float s1 = 0.f, s2 = 0.f;
#pragma unroll
                for (int bj = 0; bj < 2; ++bj)
#pragma unroll
                    for (int hh = 0; hh < 2; ++hh) { const f32x4 v = acc[ai][bj][m][hh]; s1 += (v[0] + v[1]) + (v[2] + v[3]); s2 += (v[0] * v[0] + v[1] * v[1]) + (v[2] * v[2] + v[3] * v[3]); }
                s1 = xsum32(xsum16(s1)); s2 = xsum32(xsum16(s2));
                if (fq == 0) { const int rt = ai * 128 + wr * 64 + m * 16 + fr; sl[(wc * 256 + rt) * 2] = s1; sl[(wc * 256 + rt) * 2 + 1] = s2; } }
        __syncthreads();
        const int tid = (wr * 4 + wc) * 64 + lane_id();
        float* ex = (float*)(ws + WS_SEL) + (size_t)upm * 8 * 512;
        if (tid < 256) { const float S1 = (sl[tid * 2] + sl[(256 + tid) * 2]) + (sl[(512 + tid) * 2] + sl[(768 + tid) * 2]), S2 = (sl[tid * 2 + 1] + sl[(256 + tid) * 2 + 1]) + (sl[(512 + tid) * 2 + 1] + sl[(768 + tid) * 2 + 1]);
            __hip_atomic_store((unsigned*)(ex + (upn * 256 + tid) * 2), __builtin_bit_cast(unsigned, S1), __ATOMIC_RELAXED, __HIP_MEMORY_SCOPE_AGENT);
            __hip_atomic_store((unsigned*)(ex + (upn * 256 + tid) * 2 + 1), __builtin_bit_cast(unsigned, S2), __ATOMIC_RELAXED, __HIP_MEMORY_SCOPE_AGENT); }
        asm volatile("s_waitcnt vmcnt(0)" ::: "memory");
        __syncthreads();
        if (tid == 0) { unsigned* cp = (unsigned*)(ws + WS_CTL) + 256 + (l * 2 + which) * 64 + upm;
            __builtin_amdgcn_fence(__ATOMIC_RELEASE, "agent"); asm volatile("s_waitcnt vmcnt(0)" ::: "memory");
            (void)xb_add(cp, 1u);
            for (unsigned sp = 0u; xb_ld(cp) < 8u && sp < 400000u; ++sp) __builtin_amdgcn_s_sleep(1);
            __builtin_amdgcn_fence(__ATOMIC_ACQUIRE, "agent"); asm volatile("s_waitcnt vmcnt(0)" ::: "memory"); }
        __syncthreads();
        if (tid < 256) { float S1 = 0.f, S2 = 0.f;
#pragma unroll
            for (int p = 0; p < 8; ++p) { S1 += __builtin_bit_cast(float, __hip_atomic_load((unsigned*)(ex + (p * 256 + tid) * 2), __ATOMIC_RELAXED, __HIP_MEMORY_SCOPE_AGENT));
                S2 += __builtin_bit_cast(float, __hip_atomic_load((unsigned*)(ex + (p * 256 + tid) * 2 + 1), __ATOMIC_RELAXED, __HIP_MEMORY_SCOPE_AGENT)); }
            const float mean = S1 * (1.f / DM); const float var = fmaxf(S2 * (1.f / DM) - mean * mean, 0.f);
            sl[2048 + tid * 2] = mean; sl[2048 + tid * 2 + 1] = 1.0f / sqrtf(var + 1e-5f); }
        __syncthreads();
        { const int ln_ = lane_id(); fr = ln_ & 15; fq = ln_ >> 4; }
        const int row1 = upm * 256 + wr * 64 + fr; const int colc = upn * 256 + wc * 64 + 8 * fq;
#pragma unroll
        for (int bj = 0; bj < 2; ++bj) { const int c0 = colc + bj * 32;
            const f32x4 lg0 = *(const f32x4*)(lng + c0), lg1 = *(const f32x4*)(lng + c0 + 4), lb0 = *(const f32x4*)(lnb + c0), lb1 = *(const f32x4*)(lnb + c0 + 4);
            const f32x4 q0 = *(const f32x4*)(go + DM + c0) + 1.f, q1 = *(const f32x4*)(go + DM + c0 + 4) + 1.f, h0 = *(const f32x4*)(go + c0), h1 = *(const f32x4*)(go + c0 + 4);
#pragma unroll
            for (int ai = 0; ai < 2; ++ai) { size_t on = (size_t)(row1 + ai * 128) * 2048 + c0;
#pragma unroll
                for (int m = 0; m < 4; ++m) { const int rt = ai * 128 + wr * 64 + m * 16 + fr; const float mean = sl[2048 + rt * 2], rstd = sl[2048 + rt * 2 + 1];
                    const size_t o = on; { size_t st_ = 16 * 2048; asm volatile("" : "+s"(st_)); on += st_; }
                    const f32x4 y0 = (acc[ai][bj][m][0] - mean) * rstd * lg0 + lb0, y1 = (acc[ai][bj][m][1] - mean) * rstd * lg1 + lb1;
                    if constexpr (FINAL) { *(f32x4*)(Fo + o) = y0; *(f32x4*)(Fo + o + 4) = y1; }
                    else st_bf16x8(Hh + o, y0 * q0 + h0, y1 * q1 + h1); } }
            asm volatile("" ::: "memory"); }
    }
};
struct EpiSwiglu {
    bf16* ACT;
    __device__ __forceinline__ void operator()(const f32x4 (&acc)[2][2][4][2], const Unit& u, int wr, int wc, int fr, int fq) const {
        const int row0 = u.pm * 256 + wr * 64 + fr; const int col = u.pn * 128 + wc * 32 + 8 * fq;
#pragma unroll
        for (int ai = 0; ai < 2; ++ai)
#pragma unroll
            for (int m = 0; m < 4; ++m) { const int row = row0 + ai * 128 + m * 16;
                st_bf16x8(ACT + (size_t)row * DFF + col, silu4(acc[ai][0][m][0]) * acc[ai][1][m][0], silu4(acc[ai][0][m][1]) * acc[ai][1][m][1]); }
    }
};

__global__ void __launch_bounds__(NTHR, 2) fwd_kernel(Args args) {
    extern __shared__ __attribute__((aligned(16))) unsigned char lds_raw[];
    LAS unsigned char* lds = (LAS unsigned char*)lds_raw;
    const int G = gridDim.x, blk = blockIdx.x;
    const int NGW = G * NWAVES, NT = G * NTHR;
    unsigned char* const ws_base = args.ws;
    gu32* ctl = (gu32*)(ws_base + WS_CTL);
    for (int u = threadIdx.x; u < (LDS_BYTES - LDSCTL_OFF) / 4; u += NTHR) ((LAS unsigned*)(lds + LDSCTL_OFF))[u] = 0u;
    __syncthreads();
    volatile LAS unsigned* MISC = (volatile LAS unsigned*)(lds + MISC_OFF);
    const int wave_s = __builtin_amdgcn_readfirstlane((int)(threadIdx.x >> 6));
    XcdBarrier bar = xcd_barrier_post((unsigned*)(ctl + CW_BAR), MISC + 8); bar.wave = wave_s;
    if (threadIdx.x == 0) { unsigned nloc_ = 0u, nx_ = 0u; xcd_barrier_complete(bar.bar, bar.x, nloc_, nx_); bar.st[0] = nloc_; bar.st[1] = nx_; }
    __syncthreads();
#define GRID_BAR() xcd_barrier(bar)

#define x_in ((const float*)(const GAS float*)args.in[0 + z_])
#define c_in ((const float*)(const GAS float*)args.in[1 + z_])
#define w_ada ((const float*)(const GAS float*)args.in[2 + z_])
#define b_ada ((const float*)(const GAS float*)args.in[3 + z_])
#define w_in ((const float*)(const GAS float*)args.in[4 + z_])
#define lb_logits ((const float*)(const GAS float*)args.in[5 + z_])
#define g_hg ((const float*)(const GAS float*)args.in[6 + z_])
#define w_pa ((const float*)(const GAS float*)args.in[7 + z_])
#define g_cq ((const float*)(const GAS float*)args.in[8 + z_])
#define g_ckv ((const float*)(const GAS float*)args.in[9 + z_])
#define w_uq ((const float*)(const GAS float*)args.in[10 + z_])
#define w_iq ((const float*)(const GAS float*)args.in[11 + z_])
#define w_uv ((const float*)(const GAS float*)args.in[12 + z_])
#define w_pb ((const float*)(const GAS float*)args.in[13 + z_])
#define w_out ((const float*)(const GAS float*)args.in[14 + z_])
#define ln1_g ((const float*)(const GAS float*)args.in[15 + z_])
#define ln1_b ((const float*)(const GAS float*)args.in[16 + z_])
#define w_gate ((const float*)(const GAS float*)args.in[17 + z_])
#define w_up ((const float*)(const GAS float*)args.in[18 + z_])
#define w_down ((const float*)(const GAS float*)args.in[19 + z_])
#define ln2_g ((const float*)(const GAS float*)args.in[20 + z_])
#define ln2_b ((const float*)(const GAS float*)args.in[21 + z_])
#define MOD  ((float*)(ws + WS_MOD))
#define LB   ((float*)(ws + WS_LB))
#define MODP ((float*)(ws + WS_MODP))
#define WSET(L_) ((size_t)(((L_) & 1) ? (WS_X - WS_W1) : 0))
#define WL_(OFF_, L_) ((bf16*)(ws + (OFF_) + WSET(L_)))
#define W1   WL_(WS_W1, l)
#define W3   WL_(WS_W3, l)
#define W6   WL_(WS_W6, l)
#define W7   WL_(WS_W7, l)
#define W8   WL_(WS_W8, l)
#define W10  WL_(WS_W10, l)
#define W11  WL_(WS_W11, l)
#define XB   ((bf16*)(ws + WS_X))
#define RB   ((bf16*)(ws + WS_R))
#define HB   ((bf16*)(ws + WS_H))
#define QA   ((bf16*)(ws + WS_QA))
#define FA   ((bf16*)(ws + WS_FA))
#define IA   ((bf16*)(ws + WS_IA))
#define GA   ((bf16*)(ws + WS_GA))
#define LAT  ((bf16*)(ws + WS_LAT))
#define GTA  ((bf16*)(ws + WS_GTA))
#define GTB  ((bf16*)(ws + WS_GTB))
#define CQN  ((bf16*)(ws + WS_CQN))
#define CKV  ((bf16*)(ws + WS_CKV))
#define KIDX ((bf16*)(ws + WS_KIDX))
#define IDXW ((float*)(ws + WS_IDXW))
#define QB   ((bf16*)(ws + WS_QB))
#define QIDX ((bf16*)(ws + WS_QIDX))
#define SEL  ((unsigned short*)(ws + WS_SEL))
#define YAB  ((bf16*)(ws + WS_YAB))
#define MRG  ((bf16*)(ws + WS_MRG))
#define OB   ((bf16*)(ws + WS_OB))
#define ISC  ((_Float16*)(ws + WS_BIG))
#define OP   ((float*)(ws + WS_BIG))
#define ACT  ((bf16*)(ws + WS_BIG))
#define KK   LAT
#define modl (MOD + (size_t)l * NBATCH * MODW)
#define KSB  ((bf16*)(ws + WS_KSB))
#define QSB  ((bf16*)(ws + WS_QSB))
#define KVT  ((bf16*)(ws + WS_BIG))
#define SPB  ((bf16*)(ws + WS_FA))
#define DEB  ((float*)(ws + WS_DEB))
#define PHASE_BEGIN { unsigned om_ = ~0u; asm volatile("" : "+s"(om_)); int tid = wave_s * 64 + (int)__builtin_amdgcn_mbcnt_hi(om_, __builtin_amdgcn_mbcnt_lo(om_, 0u)); asm volatile("" : "+v"(tid)); int z_ = 0; asm volatile("" : "+s"(z_)); (void)z_; GAS unsigned char* wsg_ = (GAS unsigned char*)ws_base; asm volatile("" : "+s"(wsg_)); unsigned char* ws = (unsigned char*)wsg_; const int lane = tid & 63, wave = __builtin_amdgcn_readfirstlane(tid >> 6); \
        const int gw = blk * NWAVES + wave, gtid = blk * NTHR + tid; LAS float* wscr = (LAS float*)(lds + wave * 16384); (void)lane; (void)gw; (void)gtid; (void)wscr;
#define PHASE_END }

#define CVT_DECODE(IT_, MID_, K0_, N0_) do { int r_ = (IT_); \
        if (r_ < I1) { MID_ = 0; K0_ = (r_ / (N1 / 32)) * 64; N0_ = (r_ % (N1 / 32)) * 32; } else { r_ -= I1; \
        if (r_ < I3) { MID_ = 1; K0_ = (r_ / (N3 / 32)) * 64; N0_ = (r_ % (N3 / 32)) * 32; } else { r_ -= I3; \
        if (r_ < I6) { MID_ = 2; K0_ = (r_ / 32) * 64; N0_ = (r_ % 32) * 32; } else { r_ -= I6; \
        if (r_ < I7) { MID_ = 3; K0_ = (r_ / (DM / 32)) * 64; N0_ = (r_ % (DM / 32)) * 32; } else { r_ -= I7; \
        if (r_ < I8) { MID_ = 4; K0_ = (r_ / (DM / 32)) * 64; N0_ = (r_ % (DM / 32)) * 32; } else { r_ -= I8; \
        if (r_ < I10) { MID_ = 5; K0_ = (r_ / (N10 / 32)) * 64; N0_ = (r_ % (N10 / 32)) * 32; } else { r_ -= I10; \
        MID_ = 6; K0_ = (r_ / (DM / 32)) * 64; N0_ = (r_ % (DM / 32)) * 32; } } } } } } } while (0)
#define CVT_LOAD(MID_, K0_, N0_, TV_) do { \
        if (MID_ == 0) cvt_load([=](int k, int n) -> f32x4 { const f32x4 v = *(const f32x4*)(s_in + (size_t)k * 9040 + (n < 4944 ? n : n - 176)); return (n >= 4944 && n < 5120) ? (f32x4){0.f, 0.f, 0.f, 0.f} : v; }, K0_, N0_, lane, TV_); \
        else if (MID_ == 1) cvt_load([=](int k, int n) -> f32x4 { const float* p = n < 4096 ? s_uq + (size_t)k * 4096 + n : s_iq + (size_t)k * 1024 + (n - 4096); return *(const f32x4*)p * (n < 4096 ? 0.0625f : 1.f); }, K0_, N0_, lane, TV_); \
        else if (MID_ == 2) cvt_load([=](int k, int n) -> f32x4 { const int h = n >> 6, v = n & 63, kk = k >> 8, c = k & 255; const f32x4 w = *(const f32x4*)(s_uv + ((size_t)h * 256 + c) * 64 + v); return kk == (h & 3) ? w : (f32x4){0.f, 0.f, 0.f, 0.f}; }, K0_, N0_, lane, TV_); \
        else if (MID_ == 3) cvt_load([=](int k, int n) -> f32x4 { const float* p = k < 1024 ? s_pa + (size_t)k * DM + n : s_pb + (size_t)(k - 1024) * DM + n; return *(const f32x4*)p; }, K0_, N0_, lane, TV_); \
        else if (MID_ == 4) cvt_load([=](int k, int n) -> f32x4 { return *(const f32x4*)(s_out + (size_t)k * DM + n); }, K0_, N0_, lane, TV_); \
        else if (MID_ == 5) cvt_load([=](int k, int n) -> f32x4 { const int pn = n >> 8, rr = n & 255, cc = pn * 128 + (rr >> 6) * 32 + (rr & 31); const float* p = ((rr & 32) ? s_u : s_g) + (size_t)k * DFF + cc; return *(const f32x4*)p; }, K0_, N0_, lane, TV_); \
        else cvt_load([=](int k, int n) -> f32x4 { return *(const f32x4*)(s_d + (size_t)k * DM + n); }, K0_, N0_, lane, TV_); } while (0)
#define CONVERT_PREP(L) const int l_ = (L); \
        const float* s_in = w_in + (size_t)l_ * DM * 9040; const float* s_uq = w_uq + (size_t)l_ * SAR * 4096; const float* s_iq = w_iq + (size_t)l_ * SAR * 1024; \
        const float* s_uv = w_uv + (size_t)l_ * 16 * 256 * 64; const float* s_pa = w_pa + (size_t)l_ * 1024 * DM; const float* s_pb = w_pb + (size_t)l_ * 1024 * DM; \
        const float* s_out = w_out + (size_t)l_ * DM * DM; const float* s_g = w_gate + (size_t)l_ * DM * DFF; const float* s_u = w_up + (size_t)l_ * DM * DFF; const float* s_d = w_down + (size_t)l_ * DFF * DM; \
        constexpr int I1 = (DM / 64) * (N1 / 32), I3 = (SAR / 64) * (N3 / 32), I6 = (1024 / 64) * (1024 / 32), I7 = (DM / 64) * (DM / 32), I8 = I7, I10 = (DM / 64) * (N10 / 32), I11 = (DFF / 64) * (DM / 32); \
        constexpr int NIT = I1 + I3 + I6 + I7 + I8 + I10 + I11; (void)I11; (void)s_in; (void)s_uq; (void)s_iq; (void)s_uv; (void)s_pa; (void)s_pb; (void)s_out; (void)s_g; (void)s_u; (void)s_d
#define CVT_WT(MC_, L_) ((MC_) == 0 ? WL_(WS_W1, L_) : (MC_) == 1 ? WL_(WS_W3, L_) : (MC_) == 2 ? WL_(WS_W6, L_) : (MC_) == 3 ? WL_(WS_W7, L_) : (MC_) == 4 ? WL_(WS_W8, L_) : (MC_) == 5 ? WL_(WS_W10, L_) : WL_(WS_W11, L_))
#define CVT_KK(MC_) ((MC_) == 0 ? DM : (MC_) == 1 ? SAR : (MC_) == 2 ? 1024 : (MC_) == 3 ? DM : (MC_) == 4 ? DM : (MC_) == 5 ? DM : DFF)
#define CONVERT_LAYER(L) do { CONVERT_PREP(L); \
        float tv_[32]; int mid_ = 0, k0_ = 0, n0_ = 0; \
        { CVT_DECODE(gw, mid_, k0_, n0_); CVT_LOAD(mid_, k0_, n0_, tv_); } \
        for (int it = gw; it < NIT; it += NGW) { \
            float tc_[32]; _Pragma("unroll") for (int i = 0; i < 32; ++i) tc_[i] = tv_[i]; \
            const int mc_ = mid_, kc_ = k0_, nc_ = n0_; \
            { const int itn_ = it + NGW < NIT ? it + NGW : it; CVT_DECODE(itn_, mid_, k0_, n0_); CVT_LOAD(mid_, k0_, n0_, tv_); }     \
            cvt_store(tc_, CVT_WT(mc_, l_), CVT_KK(mc_), kc_, nc_, wscr, lane); \
        } } while (0)


#ifndef HGRN_NAIVE
#define HGRN_NAIVE 0
#endif
#ifndef IDX_NAIVE
#define IDX_NAIVE 0
#endif
#ifndef ATT_NAIVE
#define ATT_NAIVE 0
#endif
#ifndef TOPK_OLD
#define TOPK_OLD 0
#endif
#ifndef REP_HB
#define REP_HB 1
#endif
#ifndef REP_HC
#define REP_HC 1
#endif
#ifndef REP_P4A
#define REP_P4A 1
#endif
#ifndef REP_P5
#define REP_P5 1
#endif
#ifndef REP_P9
#define REP_P9 1
#endif
#ifndef REP_P12
#define REP_P12 1
#endif
#ifndef REP_TOPK
#define REP_TOPK 1
#endif
#ifndef REP_ATT
#define REP_ATT 1
#endif
#ifndef DRY_ATT
#define DRY_ATT 0
#endif
#ifndef REP_M1
#define REP_M1 1
#endif
#ifndef REP_M2
#define REP_M2 1
#endif
#ifndef REP_M3
#define REP_M3 1
#endif

    PHASE_BEGIN
    {
        LAS float* sc = (LAS float*)lds;
        for (int i = tid; i < NBATCH * DM; i += NTHR) { const float v = c_in[i]; sc[i] = v * sigm(v); }
        __syncthreads();
        for (int item = gtid; item < 8 * 12288; item += NT) {
            const int ks = item / 12288, cg = item % 12288, l = cg / 3072, n4 = (cg % 3072) * 4;
            const float* wp = w_ada + ((size_t)l * DM + ks * 256) * MODW + n4;
            f32x4 a0 = {0.f, 0.f, 0.f, 0.f}, a1 = a0, a2 = a0, a3 = a0;
#pragma unroll 8
            for (int k = 0; k < 256; ++k) { const f32x4 w = *(const f32x4*)(wp + (size_t)k * MODW); const int kk = ks * 256 + k;
                a0 += w * sc[kk]; a1 += w * sc[2048 + kk]; a2 += w * sc[4096 + kk]; a3 += w * sc[6144 + kk]; }
            float* o = MODP + ((size_t)(ks * 4 + l) * 4) * MODW + n4;
            *(f32x4*)(o) = a0; *(f32x4*)(o + MODW) = a1; *(f32x4*)(o + 2 * MODW) = a2; *(f32x4*)(o + 3 * MODW) = a3;
        }
        if (gtid < 1024) {
            const float a = lb_logits[gtid], b = lb_logits[1024 + gtid], c = lb_logits[2048 + gtid], d = lb_logits[3072 + gtid];
            const float mx = fmaxf(fmaxf(a, b), fmaxf(c, d)); const float ea = expf(a - mx), eb = expf(b - mx), ec = expf(c - mx), ed = expf(d - mx); const float inv = 1.f / (ea + eb + ec + ed);
            LB[gtid] = 0.f; LB[1024 + gtid] = eb * inv; LB[2048 + gtid] = (eb + ec) * inv; LB[3072 + gtid] = (eb + ec + ed) * inv;
        }
        __syncthreads();
        CONVERT_LAYER(0);
    }
    PHASE_END
    GRID_BAR();
    PHASE_BEGIN
    for (int i = gtid; i < DEPTH * NBATCH * MODW; i += NT) {
        const int l = i / (NBATCH * MODW), r = i % (NBATCH * MODW), b = r / MODW, n = r % MODW;
        float s = b_ada[l * MODW + n];
#pragma unroll
        for (int ks = 0; ks < 8; ++ks) s += MODP[((size_t)(ks * 4 + l) * 4 + b) * MODW + n];
        MOD[i] = s;
    }
    PHASE_END
    GRID_BAR();
    PHASE_BEGIN
    for (size_t i0 = gtid; i0 < (size_t)M * DM / 8; i0 += (size_t)NT * 4) {
        f32x4 xa[4], xb[4], sa[4], sb[4], ha[4], hb[4];
#pragma unroll
        for (int t = 0; t < 4; ++t) { size_t gi = i0 + (size_t)t * NT; gi = gi < (size_t)M * DM / 8 ? gi : (size_t)M * DM / 8 - 1; const size_t e = gi * 8; const int row = (int)(e / DM), col = (int)(e % DM), b = row / SEQ; const float* md = MOD + (size_t)b * MODW;
            xa[t] = *(const f32x4*)(x_in + e); xb[t] = *(const f32x4*)(x_in + e + 4); sa[t] = *(const f32x4*)(md + 2048 + col); sb[t] = *(const f32x4*)(md + 2048 + col + 4); ha[t] = *(const f32x4*)(md + col); hb[t] = *(const f32x4*)(md + col + 4); }
#pragma unroll
        for (int t = 0; t < 4; ++t) { size_t gi = i0 + (size_t)t * NT; gi = gi < (size_t)M * DM / 8 ? gi : (size_t)M * DM / 8 - 1; const size_t e = gi * 8; st_bf16x8(HB + e, xa[t] * (sa[t] + 1.f) + ha[t], xb[t] * (sb[t] + 1.f) + hb[t]); }
    }
    PHASE_END
    GRID_BAR();

    for (int l = 0; l < DEPTH; ++l) {
        PHASE_BEGIN
        { pg8::Gemm g{HB, W1, M, N1, DM, DM, DM, 0}; pg8::StaticOrder S; S.init(M, N1, G, blk);
          EpiProj E{QA, FA, IA, GA, LAT, GTA, GTB}; pg8::gemm_phase(lds, g, S, E, tid); }
        PHASE_END
        GRID_BAR();
        for (int rep_ = 0; rep_ < REP_M1; ++rep_) {
        PHASE_BEGIN
        v2u ra0, ra1, rkv; unsigned short rki, riw;
        const f32x4 g0 = *(const f32x4*)(g_cq + l * 512 + 4 * lane), g1 = *(const f32x4*)(g_cq + l * 512 + 256 + 4 * lane), gk = *(const f32x4*)(g_ckv + l * 256 + 4 * lane);
        { const bf16* lr = LAT + (size_t)gw * 1024; ra0 = *(const v2u*)(lr + 4 * lane); ra1 = *(const v2u*)(lr + 256 + 4 * lane); rkv = *(const v2u*)(lr + 512 + 4 * lane); rki = lr[768 + lane]; riw = lr[832 + (lane & 15)]; }
        for (int row = gw; row < M; row += NGW) {
            const f32x4 a0 = (f32x4){bflo(ra0.x), bfhi(ra0.x), bflo(ra0.y), bfhi(ra0.y)}, a1 = (f32x4){bflo(ra1.x), bfhi(ra1.x), bflo(ra1.y), bfhi(ra1.y)}, kv = (f32x4){bflo(rkv.x), bfhi(rkv.x), bflo(rkv.y), bfhi(rkv.y)};
            const float ki = bf2f(rki), iw = bf2f(riw);
            { const int rn = row + NGW < M ? row + NGW : row; const bf16* lr = LAT + (size_t)rn * 1024;
              ra0 = *(const v2u*)(lr + 4 * lane); ra1 = *(const v2u*)(lr + 256 + 4 * lane); rkv = *(const v2u*)(lr + 512 + 4 * lane); rki = lr[768 + lane]; riw = lr[832 + (lane & 15)]; }
            float sq = a0[0] * a0[0] + a0[1] * a0[1] + a0[2] * a0[2] + a0[3] * a0[3] + a1[0] * a1[0] + a1[1] * a1[1] + a1[2] * a1[2] + a1[3] * a1[3];
            float sk = kv[0] * kv[0] + kv[1] * kv[1] + kv[2] * kv[2] + kv[3] * kv[3];
            sq = wave_sum(sq); sk = wave_sum(sk);
            const float rq = 1.0f / sqrtf(sq * (1.f / 512.f) + 1e-6f), rk = 1.0f / sqrtf(sk * (1.f / 256.f) + 1e-6f);
            v2u o; f32x4 t = a0 * rq * g0; o.x = pk2(t[0], t[1]); o.y = pk2(t[2], t[3]); *(v2u*)(CQN + (size_t)row * 512 + 4 * lane) = o;
            t = a1 * rq * g1; o.x = pk2(t[0], t[1]); o.y = pk2(t[2], t[3]); *(v2u*)(CQN + (size_t)row * 512 + 256 + 4 * lane) = o;
            t = kv * rk * gk; o.x = pk2(t[0], t[1]); o.y = pk2(t[2], t[3]); *(v2u*)(CKV + (size_t)row * 256 + 4 * lane) = o;
            KIDX[(size_t)row * 64 + lane] = (bf16)f2bf(ki);
            if (lane < 16) IDXW[(size_t)row * 16 + lane] = iw * 0.03125f;
        }
        PHASE_END
        PHASE_BEGIN
        {
            const int cp = tid & 63, sg = tid >> 6;
            LAS unsigned char* KST = lds;
            LAS unsigned char* VTL = lds + 18432;
            LAS float* SEGT = (LAS float*)(lds + 36864);
            LAS float* G63 = (LAS float*)(lds + 40960);
            unsigned pfa[8], pq[8], pv[8]; float plb0, plb1;
#define HA_REQ(U_) do { int uu_ = (U_); asm volatile("" : "+s"(uu_)); const int bh_ = uu_ >> 6, c_ = uu_ & 63, b_ = bh_ >> 3, h_ = bh_ & 7; \
                const size_t rowb_ = (size_t)b_ * SEQ + c_ * 64 + sg * 8; const int col_ = h_ * 128 + 2 * cp; \
                _Pragma("unroll") for (int i = 0; i < 8; ++i) { pfa[i] = *(const unsigned*)(FA + (rowb_ + i) * 1024 + col_); pq[i] = *(const unsigned*)(QA + (rowb_ + i) * 1024 + col_); pv[i] = *(const unsigned*)(IA + (rowb_ + i) * 1024 + col_); } plb0 = LB[l * 1024 + col_]; plb1 = LB[l * 1024 + col_ + 1]; } while (0)
            HA_REQ(blk);
            for (int u = blk; u < 2048; u += G) {
                const int bh = u >> 6, c = u & 63, b = bh >> 3, h = bh & 7;
                const size_t rowb = (size_t)b * SEQ + c * 64 + sg * 8; const int col = h * 128 + 2 * cp;
                const float lb0 = plb0, lb1 = plb1;
                float lf0[8], lf1[8], kk0[8], kk1[8]; unsigned cq[8], cv[8];
#pragma unroll
                for (int i = 0; i < 8; ++i) { cq[i] = pq[i]; cv[i] = pv[i]; }
#pragma unroll
                for (int i = 0; i < 8; ++i) { const float2 fa = make_float2(bflo(pfa[i]), bfhi(pfa[i]));
                    const float f0 = fminf(fmaxf(lb0 + (1.f - lb0) * sigm(fa.x), 1e-6f), 1.f), f1 = fminf(fmaxf(lb1 + (1.f - lb1) * sigm(fa.y), 1e-6f), 1.f);
                    lf0[i] = __logf(f0); lf1[i] = __logf(f1); kk0[i] = (1.f - lb0) * sigm(-fa.x); kk1[i] = (1.f - lb1) * sigm(-fa.y); }
#pragma unroll
                for (int i = 1; i < 8; ++i) { lf0[i] += lf0[i - 1]; lf1[i] += lf1[i - 1]; }
                SEGT[sg * 128 + 2 * cp] = lf0[7]; SEGT[sg * 128 + 2 * cp + 1] = lf1[7];
                HA_REQ(u + G < 2048 ? u + G : u);
                __syncthreads();
                float pre0 = 0.f, pre1 = 0.f, r0 = 0.f, r1 = 0.f, t0 = 0.f, t1 = 0.f;
#pragma unroll
                for (int s2 = 0; s2 < 8; ++s2) { const float a0 = SEGT[s2 * 128 + 2 * cp], a1 = SEGT[s2 * 128 + 2 * cp + 1];
                    if (s2 < sg) { pre0 += a0; pre1 += a1; } if (s2 < 4) { r0 += a0; r1 += a1; } t0 += a0; t1 += a1; }
                unsigned ksw0[4], ksw1[4], vw0[4], vw1[4]; float ks0p = 0.f, ks1p = 0.f, v0p = 0.f, v1p = 0.f;
#pragma unroll
                for (int i = 0; i < 8; ++i) {
                    const float b0 = pre0 + lf0[i], b1 = pre1 + lf1[i];
                    const unsigned qw = cq[i]; const unsigned vw = cv[i];
                    const float qs0 = bflo(qw) * __expf(b0 - r0), qs1 = bfhi(qw) * __expf(b1 - r1);
                    const float ks0 = kk0[i] * __expf(r0 - b0), ks1 = kk1[i] * __expf(r1 - b1);
                    *(unsigned*)(QSB + (rowb + i) * 1024 + col) = pk2(qs0, qs1);
                    *(unsigned*)(KSB + (rowb + i) * 1024 + col) = pk2(ks0, ks1);
                    if (i & 1) { ksw0[i >> 1] = pk2(ks0p, ks0); ksw1[i >> 1] = pk2(ks1p, ks1); vw0[i >> 1] = pk2(v0p, bflo(vw)); vw1[i >> 1] = pk2(v1p, bfhi(vw)); }
                    else { ks0p = ks0; ks1p = ks1; v0p = bflo(vw); v1p = bfhi(vw); }
                }
                *(LAS v4u*)(KST + (2 * cp) * 144 + sg * 16) = (v4u){ksw0[0], ksw0[1], ksw0[2], ksw0[3]};
                *(LAS v4u*)(KST + (2 * cp + 1) * 144 + sg * 16) = (v4u){ksw1[0], ksw1[1], ksw1[2], ksw1[3]};
                *(LAS v4u*)(VTL + (2 * cp) * 144 + sg * 16) = (v4u){vw0[0], vw0[1], vw0[2], vw0[3]};
                *(LAS v4u*)(VTL + (2 * cp + 1) * 144 + sg * 16) = (v4u){vw1[0], vw1[1], vw1[2], vw1[3]};
                if (sg == 7) { float* de = DEB + (size_t)u * 256; *(float2*)(de + 2 * cp) = make_float2(__expf(r0), __expf(r1)); *(float2*)(de + 128 + 2 * cp) = make_float2(__expf(t0), __expf(t1));
                    G63[2 * cp] = __expf(t0 - r0); G63[2 * cp + 1] = __expf(t1 - r1); }
                __syncthreads();
                { const int kt = wave >> 1, vt0 = (wave & 1) * 2, lr = lane & 31, lh = lane >> 5;
                  f32x16 acc0, acc1;
#pragma unroll
                  for (int r = 0; r < 16; ++r) { acc0[r] = 0.f; acc1[r] = 0.f; }
#pragma unroll
                  for (int s4 = 0; s4 < 4; ++s4) {
                      const bf16x8 kb = *(const LAS bf16x8*)(KST + (kt * 32 + lr) * 144 + (s4 * 16 + 8 * lh) * 2);
                      const bf16x8 a0 = *(const LAS bf16x8*)(VTL + (vt0 * 32 + lr) * 144 + (s4 * 16 + 8 * lh) * 2);
                      const bf16x8 a1 = *(const LAS bf16x8*)(VTL + ((vt0 + 1) * 32 + lr) * 144 + (s4 * 16 + 8 * lh) * 2);
                      acc0 = __builtin_amdgcn_mfma_f32_32x32x16_bf16(a0, kb, acc0, 0, 0, 0); acc1 = __builtin_amdgcn_mfma_f32_32x32x16_bf16(a1, kb, acc1, 0, 0, 0); }
                  bf16* kvt = KVT + (size_t)u * 16384 + kt * 32 + lr; const float g = G63[kt * 32 + lr];
#pragma unroll
                  for (int r = 0; r < 16; ++r) { const int vv = 8 * (r >> 2) + 4 * lh + (r & 3);
                      kvt[(size_t)(vt0 * 32 + vv) * 128] = (bf16)(pk2(acc0[r] * g, 0.f) & 0xffffu); kvt[(size_t)((vt0 + 1) * 32 + vv) * 128] = (bf16)(pk2(acc1[r] * g, 0.f) & 0xffffu); } }
                __syncthreads();
            }
        }
#undef HA_REQ
        PHASE_END
        GRID_BAR();
        }
        for (int rep_ = 0; rep_ < REP_M2; ++rep_) {
        PHASE_BEGIN
        for (int item = gtid; item < 32 * 4096; item += NT) {
            const int bh = item >> 12, v = (item >> 5) & 127, k4 = (item & 31) * 4;
            f32x4 S = {0.f, 0.f, 0.f, 0.f};
            for (int c0 = 0; c0 < 64; c0 += 8) {
                f32x4 kv[8], dd[8], ee[8];
#pragma unroll
                for (int j = 0; j < 8; ++j) { const size_t u = (size_t)bh * 64 + c0 + j; kv[j] = ldbf4(KVT + u * 16384 + v * 128 + k4); ee[j] = *(const f32x4*)(DEB + u * 256 + k4); dd[j] = *(const f32x4*)(DEB + u * 256 + 128 + k4); }
#pragma unroll
                for (int j = 0; j < 8; ++j) { const size_t u = (size_t)bh * 64 + c0 + j; const f32x4 sp = S * ee[j]; v2u w; w.x = pk2(sp[0], sp[1]); w.y = pk2(sp[2], sp[3]);
                    *(v2u*)(SPB + u * 16384 + v * 128 + k4) = w; S = S * dd[j] + kv[j]; }
            }
        }
        PHASE_END
        PHASE_BEGIN
        { pg8::Gemm g{CQN, W3, M, N3, SAR, SAR, SAR, 0}; pg8::StaticOrder S; S.init(M, N3, G, blk);
          EpiQ E{QB, QIDX}; pg8::gemm_phase(lds, g, S, E, tid); }
        PHASE_END
        GRID_BAR();
        }
        for (int st_ = 0; st_ < 2; ++st_) {
        if ((st_ == 0) == (((blk >> 3) & 1) == 0)) {
        PHASE_BEGIN
        {
            LAS unsigned char* QSL = lds;
            LAS unsigned char* KSL = lds + 17408;
            LAS unsigned char* VTL = lds + 34816;
            LAS unsigned char* SPL = lds + 53248;
            LAS unsigned char* AL = lds + 88064;
            LAS float* SSQ = (LAS float*)(lds + 97280);
            const int cp = tid & 63, sg = tid >> 6, lr = lane & 31, lh = lane >> 5;
            v4u rq[2], rk[2], rs[4]; unsigned rv[8]; unsigned short rg[16];
#define HC_REQ(U_) do { int uu_ = (U_); asm volatile("" : "+s"(uu_));   const int bh_ = uu_ >> 6, c_ = uu_ & 63, b_ = bh_ >> 3, h_ = bh_ & 7; const size_t row0_ = (size_t)b_ * SEQ + c_ * 64; const int col0_ = h_ * 128; \
                _Pragma("unroll") for (int j = 0; j < 2; ++j) { const int q = tid + 512 * j, rr = q >> 4, cc = q & 15; \
                    rq[j] = *(const v4u*)(QSB + (row0_ + rr) * 1024 + col0_ + cc * 8); rk[j] = *(const v4u*)(KSB + (row0_ + rr) * 1024 + col0_ + cc * 8); } \
                _Pragma("unroll") for (int j = 0; j < 4; ++j) { const int q = tid + 512 * j, rr = q >> 4, cc = q & 15; rs[j] = *(const v4u*)(SPB + (size_t)uu_ * 16384 + rr * 128 + cc * 8); } \
                _Pragma("unroll") for (int i = 0; i < 8; ++i) rv[i] = *(const unsigned*)(IA + (row0_ + sg * 8 + i) * 1024 + col0_ + 2 * cp); \
                { const int it_ = wave >> 2, vt_ = wave & 3; const int colg_ = col0_ + vt_ * 32 + lr; \
                  _Pragma("unroll") for (int r = 0; r < 16; ++r) { const int ii = it_ * 32 + 8 * (r >> 2) + 4 * lh + (r & 3); rg[r] = GA[(row0_ + ii) * 1024 + colg_]; } } } while (0)
            HC_REQ(blk);
            for (int u = blk; u < 2048; u += G) {
                const int bh = u >> 6, c = u & 63, b = bh >> 3, h = bh & 7;
                const size_t row0 = (size_t)b * SEQ + c * 64; const int col0 = h * 128;
#pragma unroll
                for (int j = 0; j < 2; ++j) { const int q = tid + 512 * j, rr = q >> 4, cc = q & 15;
                    *(LAS v4u*)(QSL + rr * 272 + cc * 16) = rq[j]; *(LAS v4u*)(KSL + rr * 272 + cc * 16) = rk[j]; }
#pragma unroll
                for (int j = 0; j < 4; ++j) { const int q = tid + 512 * j, rr = q >> 4, cc = q & 15; *(LAS v4u*)(SPL + rr * 272 + cc * 16) = rs[j]; }
                { unsigned vw0[4], vw1[4]; float v0p = 0.f, v1p = 0.f;
#pragma unroll
                  for (int i = 0; i < 8; ++i) { const unsigned vw = rv[i];
                      if (i & 1) { vw0[i >> 1] = pk2(v0p, bflo(vw)); vw1[i >> 1] = pk2(v1p, bfhi(vw)); } else { v0p = bflo(vw); v1p = bfhi(vw); } }
                  *(LAS v4u*)(VTL + (2 * cp) * 144 + sg * 16) = (v4u){vw0[0], vw0[1], vw0[2], vw0[3]};
                  *(LAS v4u*)(VTL + (2 * cp + 1) * 144 + sg * 16) = (v4u){vw1[0], vw1[1], vw1[2], vw1[3]}; }
                float gav[16];
#pragma unroll
                for (int r = 0; r < 16; ++r) gav[r] = bf2f(rg[r]);
                const float gg = g_hg[l * 1024 + col0 + (wave & 3) * 32 + lr];
                HC_REQ(u + G < 2048 ? u + G : u);
                __syncthreads();
                if (wave < 4) {
                    const int it = wave >> 1, jt = wave & 1;
                    f32x16 acc;
#pragma unroll
                    for (int r = 0; r < 16; ++r) acc[r] = 0.f;
                    if (!(it == 0 && jt == 1)) {
#pragma unroll
                        for (int s8 = 0; s8 < 8; ++s8) {
                            const bf16x8 a = *(const LAS bf16x8*)(QSL + (it * 32 + lr) * 272 + (s8 * 16 + 8 * lh) * 2);
                            const bf16x8 bb = *(const LAS bf16x8*)(KSL + (jt * 32 + lr) * 272 + (s8 * 16 + 8 * lh) * 2);
                            acc = __builtin_amdgcn_mfma_f32_32x32x16_bf16(a, bb, acc, 0, 0, 0); } }
                    const int jj = jt * 32 + lr;
#pragma unroll
                    for (int r = 0; r < 16; ++r) { const int ii = it * 32 + 8 * (r >> 2) + 4 * lh + (r & 3); const float x = (jj <= ii) ? acc[r] : 0.f;
                        *(LAS unsigned short*)(AL + ii * 144 + jj * 2) = (unsigned short)(pk2(x, 0.f) & 0xffffu); }
                }
                __syncthreads();
                { const int it = wave >> 2, vt = wave & 3;
                  f32x16 acc;
#pragma unroll
                  for (int r = 0; r < 16; ++r) acc[r] = 0.f;
#pragma unroll
                  for (int s4 = 0; s4 < 4; ++s4) {
                      const bf16x8 a = *(const LAS bf16x8*)(AL + (it * 32 + lr) * 144 + (s4 * 16 + 8 * lh) * 2);
                      const bf16x8 bb = *(const LAS bf16x8*)(VTL + (vt * 32 + lr) * 144 + (s4 * 16 + 8 * lh) * 2);
                      acc = __builtin_amdgcn_mfma_f32_32x32x16_bf16(a, bb, acc, 0, 0, 0); }
#pragma unroll
                  for (int s8 = 0; s8 < 8; ++s8) {
                      const bf16x8 a = *(const LAS bf16x8*)(QSL + (it * 32 + lr) * 272 + (s8 * 16 + 8 * lh) * 2);
                      const bf16x8 bb = *(const LAS bf16x8*)(SPL + (vt * 32 + lr) * 272 + (s8 * 16 + 8 * lh) * 2);
                      acc = __builtin_amdgcn_mfma_f32_32x32x16_bf16(a, bb, acc, 0, 0, 0); }
#pragma unroll
                  for (int r = 0; r < 16; ++r) { float q2 = acc[r] * acc[r];
                      q2 = xsum16(rowsum16(q2));
                      if (lr == 0) SSQ[vt * 64 + it * 32 + 8 * (r >> 2) + 4 * lh + (r & 3)] = q2; }
                  __syncthreads();
                  const int colg = col0 + vt * 32 + lr;
#pragma unroll
                  for (int r = 0; r < 16; ++r) { const int ii = it * 32 + 8 * (r >> 2) + 4 * lh + (r & 3);
                      const float ss = SSQ[ii] + SSQ[64 + ii] + SSQ[128 + ii] + SSQ[192 + ii]; const float rn = 1.0f / sqrtf(ss * (1.f / 128.f) + 1e-6f);
                      YAB[(row0 + ii) * 2048 + colg] = (bf16)(pk2(acc[r] * rn * gg * gav[r], 0.f) & 0xffffu); }
                }
                __syncthreads();
            }
        }
#undef HC_REQ
        PHASE_END
        } else {
        PHASE_BEGIN
        for (int ub = blk * NWAVES; ub < 2048; ub += NGW) {
            const int unit = ub + wave;
            const int b = ub >> 9, j = unit & 511, lr = lane & 31, lh = lane >> 5;
            const int qsel = (lr >> 2) & 1, head = (lr >> 3) * 4 + (lr & 3);
            const int qlo = 4 * j, qhi = 4 * (1023 - j);
            const int nlo = ((qlo >> 6) + 1) * 64, nhi = ((qhi >> 6) + 1) * 64;
            const int nlo8 = (nlo + 511) & ~511, nhi8 = (nhi + 511) & ~511;
            const int nmax8 = (((((4 * (1023 - (ub & 511))) >> 6) + 1) * 64) + 511) & ~511;
            bf16x8 A[4][4]; float W[4][16]; typedef float f32x2_t __attribute__((ext_vector_type(2)));
#pragma unroll
            for (int p = 0; p < 4; ++p) { const size_t qb = (size_t)b * SEQ + (p < 2 ? qlo + 2 * p : qhi + 2 * (p - 2));
#pragma unroll
                for (int ks = 0; ks < 4; ++ks) A[p][ks] = *(const bf16x8*)(QIDX + (qb + qsel) * 1024 + head * 64 + ks * 16 + lh * 8);
#pragma unroll
                for (int r4 = 0; r4 < 4; ++r4) { const f32x4 w = *(const f32x4*)(IDXW + (qb + lh) * 16 + r4 * 4); W[p][r4 * 4] = w[0]; W[p][r4 * 4 + 1] = w[1]; W[p][r4 * 4 + 2] = w[2]; W[p][r4 * 4 + 3] = w[3]; } }
            const bf16* kb = KIDX + (size_t)b * SEQ * 64;
            const int srow = 8 * wave + (lane >> 3), spc = ((lane & 7) ^ ((srow >> 1) & 7)) * 8;
#define P4_STAGE(C0_, BUF_) do { _Pragma("unroll") for (int i = 0; i < 4; ++i) \
                __builtin_amdgcn_global_load_lds((const unsigned*)(kb + (size_t)((C0_) + 64 * i + srow) * 64 + spc), (LAS unsigned*)(lds + (BUF_) * 32768 + (i * 8 + wave) * 1024), 16, 0, 0); } while (0)
            P4_STAGE(0, 0);
            asm volatile("s_waitcnt vmcnt(0)" ::: "memory");
            __syncthreads();
            for (int c0 = 0; c0 < nmax8; c0 += 256) {
                const int cb = (c0 >> 8) & 1; const bool more = c0 + 256 < nmax8;
                if (more) P4_STAGE(c0 + 256, cb ^ 1);
                LAS unsigned char* kbuf = lds + cb * 32768;
#pragma unroll 1
                for (int tl = 0; tl < 8; ++tl) {
                    const int s0 = c0 + tl * 32;
                    if (s0 >= nhi8) break;
#pragma unroll
                    for (int p = 0; p < 4; ++p) { const int np = p < 2 ? nlo : nhi, np8 = p < 2 ? nlo8 : nhi8;
                        if (s0 >= np && s0 < np8) { const size_t q = (size_t)b * SEQ + (p < 2 ? qlo + 2 * p : qhi + 2 * (p - 2)) + lh; ISC[q * 4096 + s0 + lr] = (_Float16)(-60000.0f); } }
                    if (s0 >= nhi) continue;
                    bf16x8 B[4];
#pragma unroll
                    for (int ks = 0; ks < 4; ++ks) B[ks] = *(const LAS bf16x8*)(kbuf + (tl * 32 + lr) * 128 + (((2 * ks + lh) ^ ((lr >> 1) & 7)) * 16));
#define IDX_FINISH(P_, ACC_) do { f32x2_t s2_ = {0.f, 0.f};     \
                        _Pragma("unroll") for (int r = 0; r < 16; r += 2) { const float a0_ = ACC_[r], a1_ = ACC_[r + 1]; const int i0_ = __builtin_bit_cast(int, a0_), i1_ = __builtin_bit_cast(int, a1_); \
                            const f32x2_t rl_ = {__builtin_bit_cast(float, i0_ > 0 ? i0_ : 0), __builtin_bit_cast(float, i1_ > 0 ? i1_ : 0)}; const f32x2_t w_ = {W[P_][r], W[P_][r + 1]}; \
                            s2_ = __builtin_elementwise_fma(rl_, w_, s2_); } \
                        const float sc_ = s2_[0] + s2_[1]; \
                        const size_t q_ = (size_t)b * SEQ + ((P_) < 2 ? qlo + 2 * (P_) : qhi + 2 * ((P_) - 2)) + lh; ISC[q_ * 4096 + s0 + lr] = (_Float16)sc_; } while (0)
                    if (s0 < nlo) {
                        f32x16 c0_, c1_, c2_, c3_;
#pragma unroll
                        for (int r = 0; r < 16; ++r) { c0_[r] = 0.f; c1_[r] = 0.f; c2_[r] = 0.f; c3_[r] = 0.f; }
#pragma unroll
                        for (int ks = 0; ks < 4; ++ks) { c0_ = __builtin_amdgcn_mfma_f32_32x32x16_bf16(A[0][ks], B[ks], c0_, 0, 0, 0); c1_ = __builtin_amdgcn_mfma_f32_32x32x16_bf16(A[1][ks], B[ks], c1_, 0, 0, 0);
                            c2_ = __builtin_amdgcn_mfma_f32_32x32x16_bf16(A[2][ks], B[ks], c2_, 0, 0, 0); c3_ = __builtin_amdgcn_mfma_f32_32x32x16_bf16(A[3][ks], B[ks], c3_, 0, 0, 0); }
                        IDX_FINISH(0, c0_); IDX_FINISH(1, c1_); IDX_FINISH(2, c2_); IDX_FINISH(3, c3_);
                    } else {
                        f32x16 c2_, c3_;
#pragma unroll
                        for (int r = 0; r < 16; ++r) { c2_[r] = 0.f; c3_[r] = 0.f; }
#pragma unroll
                        for (int ks = 0; ks < 4; ++ks) { c2_ = __builtin_amdgcn_mfma_f32_32x32x16_bf16(A[2][ks], B[ks], c2_, 0, 0, 0); c3_ = __builtin_amdgcn_mfma_f32_32x32x16_bf16(A[3][ks], B[ks], c3_, 0, 0, 0); }
                        IDX_FINISH(2, c2_); IDX_FINISH(3, c3_);
                    }
#undef IDX_FINISH
                }
                asm volatile("s_waitcnt vmcnt(0)" ::: "memory");
                __syncthreads();
            }
        }
#undef P4_STAGE
        PHASE_END
        }
        __syncthreads();
        }
        GRID_BAR();
        for (int rep_ = 0; rep_ < REP_P5; ++rep_) {
        PHASE_BEGIN
        {
            LAS unsigned char* VB = lds + wave * 18432;
            LAS unsigned short* SELW = (LAS unsigned short*)(VB + 17408);
            const int hd = lane & 15, g = lane >> 4, qq = hd >> 2, pp = hd & 3;
            const float slope = exp2f(-0.5f * (float)(hd + 1));
            for (int q = gw; q < M; q += NGW) {
                const int b = q / SEQ, pos = q % SEQ, qc = pos >> 6; const int nsel = qc < 4 ? (qc + 1) * 64 : 256;
                const bool cvl = (l + 1 < DEPTH);
                const int lcv = cvl ? l + 1 : l;
                float cta[32]; int cma = 0, cka = 0, cna = 0;
                { CONVERT_PREP(lcv); int ita_ = gw + NGW * (2 * (q / NGW)); ita_ = ita_ < NIT ? ita_ : NIT - 1;
                    CVT_DECODE(ita_, cma, cka, cna); CVT_LOAD(cma, cka, cna, cta); }
                for (int rtk_ = 0; rtk_ < REP_TOPK; ++rtk_) {
                int lane_t = lane; asm volatile("" : "+v"(lane_t));
                if (qc < 4) { const unsigned e0 = 4 * lane_t; const bool ok = 4 * lane_t < nsel; v2u z; z.x = ok ? (e0 | ((e0 + 1) << 16)) : 0u; z.y = ok ? ((e0 + 2) | ((e0 + 3) << 16)) : 0u; *(LAS v2u*)(SELW + 4 * lane_t) = z; }
                else {
                    LAS unsigned* HIST = (LAS unsigned*)VB;
                    const int nb8 = (qc + 8) >> 3;
                    float v[64];
                    { unsigned pk[32]; const int i2max = 4 * nb8 - 1; const _Float16* irow = ISC + (size_t)q * 4096 + 2 * lane_t; typedef _Float16 h2_t __attribute__((ext_vector_type(2)));
#pragma unroll
                      for (int i2 = 0; i2 < 32; ++i2) { const int ic = i2 < i2max ? i2 : i2max; pk[i2] = *(const unsigned*)(irow + ic * 128); }
#pragma unroll
                      for (int i2 = 0; i2 < 32; ++i2) { const float lim = (i2 >> 2) < nb8 ? 3.0e38f : -1.0e30f; const h2_t h = __builtin_bit_cast(h2_t, pk[i2]);
                          const float f0 = (float)h[0], f1 = (float)h[1]; v[2 * i2] = fminf(f0, lim); v[2 * i2 + 1] = fminf(f1, lim); } }
                    float vmx = v[0], vmn = fminf(fminf(v[0], v[1]), fminf(v[2], v[3]));
#pragma unroll
                    for (int i = 1; i < 64; ++i) vmx = fmaxf(vmx, v[i]);
                    vmx = wmax_f(vmx); vmn = -wmax_f(-vmn);
                    const float rng = vmx - vmn; const float s20 = rng > 0.f ? 1048574.0f / rng : 0.f;
#define ZERO_HIST() do { *(LAS v4u*)(HIST + 16 * lane) = (v4u){0u, 0u, 0u, 0u}; *(LAS v4u*)(HIST + 16 * lane + 4) = (v4u){0u, 0u, 0u, 0u}; *(LAS v4u*)(HIST + 16 * lane + 8) = (v4u){0u, 0u, 0u, 0u}; \
                        *(LAS v4u*)(HIST + 16 * lane + 12) = (v4u){0u, 0u, 0u, 0u}; HIST[1024 + lane] = 0u; } while (0)
#define SCAN_HIST(R_, BIN_, AB_) do { unsigned hh_[16]; const int hb_ = 1008 - 16 * lane; \
                        { const v4u h0 = *(const LAS v4u*)(HIST + hb_), h1 = *(const LAS v4u*)(HIST + hb_ + 4), h2 = *(const LAS v4u*)(HIST + hb_ + 8), h3 = *(const LAS v4u*)(HIST + hb_ + 12); \
                          hh_[0] = h0.x; hh_[1] = h0.y; hh_[2] = h0.z; hh_[3] = h0.w; hh_[4] = h1.x; hh_[5] = h1.y; hh_[6] = h1.z; hh_[7] = h1.w; hh_[8] = h2.x; hh_[9] = h2.y; hh_[10] = h2.z; hh_[11] = h2.w; hh_[12] = h3.x; hh_[13] = h3.y; hh_[14] = h3.z; hh_[15] = h3.w; } \
                        unsigned tot_ = 0u; _Pragma("unroll") for (int k = 0; k < 16; ++k) tot_ += hh_[k]; \
                        unsigned run_ = wprefix_u(tot_) - tot_; int fb_ = -1; unsigned fa_ = 0u; \
                        _Pragma("unroll") for (int k = 15; k >= 0; --k) { if (run_ < (R_) && run_ + hh_[k] >= (R_)) { fb_ = hb_ + k; fa_ = run_; } run_ += hh_[k]; } \
                        const unsigned long long bm_ = __ballot(fb_ >= 0); const int L_ = (int)__builtin_ctzll(bm_); \
                        BIN_ = (unsigned)__builtin_amdgcn_readlane(fb_, L_); AB_ = (unsigned)__builtin_amdgcn_readlane((int)fa_, L_); } while (0)
                    ZERO_HIST();
#pragma unroll
                    for (int i = 0; i < 64; ++i) v[i] = __builtin_bit_cast(float, (unsigned)((v[i] - vmn) * s20));
#define cd(i_) __builtin_bit_cast(unsigned, v[i_])
#pragma unroll
                    for (int g8 = 0; g8 < 8; ++g8) { if (g8 < nb8) {
#pragma unroll
                        for (int j = 0; j < 8; ++j) __hip_atomic_fetch_add(HIST + (cd(g8 * 8 + j) >> 10), 1u, __ATOMIC_RELAXED, __HIP_MEMORY_SCOPE_WORKGROUP); } }
                    LDS_WAIT(); asm volatile("" ::: "memory");
                    unsigned tb, above; SCAN_HIST(256u, tb, above);
                    ZERO_HIST();
                    LDS_WAIT(); asm volatile("" ::: "memory");
#pragma unroll
                    for (int g8 = 0; g8 < 8; ++g8) { if (g8 < nb8) {
#pragma unroll
                        for (int j = 0; j < 8; ++j) { const unsigned c = cd(g8 * 8 + j); const unsigned a = (c >> 10) == tb ? (c & 1023u) : 1024u + lane; __hip_atomic_fetch_add(HIST + a, 1u, __ATOMIC_RELAXED, __HIP_MEMORY_SCOPE_WORKGROUP); } } }
                    LDS_WAIT(); asm volatile("" ::: "memory");
                    unsigned tb2, ab2; { const unsigned R2 = 256u - above; SCAN_HIST(R2, tb2, ab2); }
                    const unsigned T = (tb << 10) | tb2; above += ab2;
                    unsigned baseg = 0u, basee = above;
#pragma unroll
                    for (int g8 = 0; g8 < 8; ++g8) { if (g8 < nb8) {
#pragma unroll
                        for (int j = 0; j < 8; ++j) { const int i = g8 * 8 + j;
                            const bool gt = cd(i) > T; const unsigned long long bg = __ballot(gt);
                            const unsigned pgp = baseg + __builtin_amdgcn_mbcnt_hi((unsigned)(bg >> 32), __builtin_amdgcn_mbcnt_lo((unsigned)bg, 0u));
                            if (gt) SELW[pgp] = (unsigned short)((i >> 1) * 128 + (i & 1) + 2 * lane);
                            baseg += (unsigned)__popcll(bg);
                            const bool eq = cd(i) == T; const unsigned long long be = __ballot(eq);
                            if (be) { const unsigned pep = basee + __builtin_amdgcn_mbcnt_hi((unsigned)(be >> 32), __builtin_amdgcn_mbcnt_lo((unsigned)be, 0u));
                                if (eq && pep < 256u) SELW[pep] = (unsigned short)((i >> 1) * 128 + (i & 1) + 2 * lane);
                                basee += (unsigned)__popcll(be); } } } }
#undef cd
#undef ZERO_HIST
#undef SCAN_HIST
                }
                LDS_WAIT(); asm volatile("" ::: "memory");
                }
                { LAS float* cscr = (LAS float*)(VB + 4608); CONVERT_PREP(lcv);
                    float ctb[32]; int cmb = 0, ckb = 0, cnb = 0; int itb_ = gw + NGW * (2 * (q / NGW) + 1); itb_ = itb_ < NIT ? itb_ : NIT - 1;
                    CVT_DECODE(itb_, cmb, ckb, cnb); CVT_LOAD(cmb, ckb, cnb, ctb);
                    if (cvl) { cvt_store(cta, CVT_WT(cma, l + 1), CVT_KK(cma), cka, cna, cscr, lane); cvt_store(ctb, CVT_WT(cmb, l + 1), CVT_KK(cmb), ckb, cnb, cscr, lane); } }
                for (int rat_ = 0; rat_ < REP_ATT; ++rat_) {
                bf16* qrow = QB + (size_t)q * 4096;
                bf16x8 Bq[8];
#pragma unroll
                for (int ks = 0; ks < 8; ++ks) Bq[ks] = *(const bf16x8*)(qrow + hd * 256 + ks * 32 + g * 8);
                const bf16* kvb = CKV + (size_t)b * SEQ * 256;
                f32x4 O[16];
#pragma unroll
                for (int ct = 0; ct < 16; ++ct) O[ct] = (f32x4){0.f, 0.f, 0.f, 0.f};
                float mrun = -1.0e30f, lsum = 0.f;
                LDS_WAIT(); asm volatile("" ::: "memory");
                const int nks = nsel >> 5;
                const int lrow = lane >> 5, lcp = lane & 31, lsh = 16 * lrow;
                v4u KR[16];
#define ATT_IDX(KST_) v4u iw_[4]; _Pragma("unroll") for (int c = 0; c < 4; ++c) iw_[c] = *(const LAS v4u*)(SELW + 32 * (KST_) + 8 * c)
#define ATT_LOADROWS(KST_) do { ATT_IDX(KST_); _Pragma("unroll") for (int i = 0; i < 16; ++i) { const int rr_ = 2 * i + lrow; const unsigned w_ = iw_[i >> 2][i & 3]; const int ix_ = (int)((w_ >> lsh) & 0xffffu); \
                    KR[i] = *(const v4u*)(kvb + (size_t)ix_ * 256 + ((lcp ^ (rr_ & 7)) * 8)); } } while (0)
                ATT_LOADROWS(0);
                const int rlA = hd & 7;
                const int rlT = (4 * g + qq) & 7;
                const int trb = (4 * g + qq) * 512 + 8 * (pp & 1), trm = 16 * ((pp >> 1) ^ rlT);
                for (int kst = 0; kst < nks; ++kst) {
                    int rlA_ = rlA, trm_ = trm; asm volatile("" : "+v"(rlA_), "+v"(trm_));
                    if (kst + 1 < nks) {
                        ATT_IDX(kst + 1);
#pragma unroll
                        for (int i = 0; i < 16; ++i) { *(LAS v4u*)(VB + i * 1024 + lane * 16) = KR[i];
                            const int rr_ = 2 * i + lrow; const unsigned w_ = iw_[i >> 2][i & 3]; const int ix_ = (int)((w_ >> lsh) & 0xffffu); KR[i] = *(const v4u*)(kvb + (size_t)ix_ * 256 + ((lcp ^ (rr_ & 7)) * 8)); }
                    } else {
#pragma unroll
                        for (int i = 0; i < 16; ++i) *(LAS v4u*)(VB + i * 1024 + lane * 16) = KR[i]; }
                    LDS_WAIT(); asm volatile("" ::: "memory");
                    f32x4 S0 = {0.f, 0.f, 0.f, 0.f}, S1 = {0.f, 0.f, 0.f, 0.f};
#pragma unroll
                    for (int k4 = 0; k4 < 4; ++k4) {
                        bf16x8 a0[2], a1[2];
#pragma unroll
                        for (int j = 0; j < 2; ++j) { const int ks = k4 * 2 + j; const int cpos = (4 * ks + g) ^ rlA_;
                            a0[j] = *(const LAS bf16x8*)(VB + hd * 512 + cpos * 16); a1[j] = *(const LAS bf16x8*)(VB + (16 + hd) * 512 + cpos * 16); }
#pragma unroll
                        for (int j = 0; j < 2; ++j) { const int ks = k4 * 2 + j;
                            S0 = __builtin_amdgcn_mfma_f32_16x16x32_bf16(a0[j], Bq[ks], S0, 0, 0, 0); S1 = __builtin_amdgcn_mfma_f32_16x16x32_bf16(a1[j], Bq[ks], S1, 0, 0, 0); }
                    }
                    const v2u pa = *(const LAS v2u*)(SELW + 32 * kst + 4 * g), pb = *(const LAS v2u*)(SELW + 32 * kst + 16 + 4 * g);
                    const float fp = (float)pos;
                    float s0[4], s1[4];
                    s0[0] = S0[0] - slope * fabsf(fp - (float)(pa.x & 0xffffu)); s0[1] = S0[1] - slope * fabsf(fp - (float)(pa.x >> 16));
                    s0[2] = S0[2] - slope * fabsf(fp - (float)(pa.y & 0xffffu)); s0[3] = S0[3] - slope * fabsf(fp - (float)(pa.y >> 16));
                    s1[0] = S1[0] - slope * fabsf(fp - (float)(pb.x & 0xffffu)); s1[1] = S1[1] - slope * fabsf(fp - (float)(pb.x >> 16));
                    s1[2] = S1[2] - slope * fabsf(fp - (float)(pb.y & 0xffffu)); s1[3] = S1[3] - slope * fabsf(fp - (float)(pb.y >> 16));
                    float ml = fmaxf(fmaxf(fmaxf(s0[0], s0[1]), fmaxf(s0[2], s0[3])), fmaxf(fmaxf(s1[0], s1[1]), fmaxf(s1[2], s1[3])));
                    ml = xmax16(ml); ml = xmax32(ml);
                    const float mnew = fmaxf(mrun, ml), alpha = __expf(mrun - mnew); mrun = mnew;
                    float p0[4], p1[4];
#pragma unroll
                    for (int r = 0; r < 4; ++r) { p0[r] = __expf(s0[r] - mnew); p1[r] = __expf(s1[r] - mnew); }
                    lsum = lsum * alpha + ((p0[0] + p0[1]) + (p0[2] + p0[3])) + ((p1[0] + p1[1]) + (p1[2] + p1[3]));
                    v4u pw; pw.x = pk2(p0[0], p0[1]); pw.y = pk2(p0[2], p0[3]); pw.z = pk2(p1[0], p1[1]); pw.w = pk2(p1[2], p1[3]);
                    const bf16x8 Pf = __builtin_bit_cast(bf16x8, pw);
#pragma unroll
                    for (int ct = 0; ct < 16; ++ct) O[ct] = O[ct] * alpha;
#pragma unroll
                    for (int c8 = 0; c8 < 4; ++c8) {
                        v4s lo[4], hi[4];
#pragma unroll
                        for (int j = 0; j < 4; ++j) { const int ct = c8 * 4 + j; const int off = trb + ((32 * ct) ^ trm_);
                            lo[j] = __builtin_amdgcn_ds_read_tr16_b64_v4i16((LAS v4s*)(VB + off));
                            hi[j] = __builtin_amdgcn_ds_read_tr16_b64_v4i16((LAS v4s*)(VB + 16 * 512 + off)); }
#pragma unroll
                        for (int j = 0; j < 4; ++j) { const int ct = c8 * 4 + j;
                            const bf16x8 Af = {lo[j][0], lo[j][1], lo[j][2], lo[j][3], hi[j][0], hi[j][1], hi[j][2], hi[j][3]};
                            O[ct] = __builtin_amdgcn_mfma_f32_16x16x32_bf16(Af, Pf, O[ct], 0, 0, 0); }
                    }
                    LDS_WAIT(); asm volatile("" ::: "memory");
                }
#undef ATT_LOADROWS
#undef ATT_IDX
                lsum = xsum16(lsum); lsum = xsum32(lsum);
                const float inv = 1.0f / lsum;
#pragma unroll
                for (int ct = 0; ct < 16; ++ct) { const f32x4 o = O[ct] * inv; v2u w; w.x = pk2(o[0], o[1]); w.y = pk2(o[2], o[3]); *(v2u*)(OB + (size_t)q * 4096 + hd * 256 + 16 * ct + 4 * g) = w; }
                }
            }
        }
        PHASE_END
        GRID_BAR();
        }
        PHASE_BEGIN
        { pg8::Gemm g{OB, W6, M, 1024, 1024, 4096, 1024, 1024}; pg8::StaticOrder S; S.init(M, 1024, G, blk);
          EpiBf E{YAB, 2048, 1024}; pg8::gemm_phase(lds, g, S, E, tid); }
        PHASE_END
        GRID_BAR();
        PHASE_BEGIN
        { pg8::Gemm g{YAB, W7, M, DM, DM, DM, DM, 0}; pg8::StaticOrder S; S.init(M, DM, G, blk);
          EpiGateM E{GTB, MRG}; HookGate Hk{GTA, GTB}; pg8::gemm_phase(lds, g, S, E, tid, Hk); }
        PHASE_END
        GRID_BAR();
        PHASE_BEGIN
        { pg8::Gemm g{MRG, W8, M, DM, DM, DM, DM, 0}; pg8::StaticOrder S; S.init(M, DM, G, blk);
          S.mode = 1;
          EpiLn<0, false> E{ws, (l == 0) ? x_in : (const float*)nullptr, (float*)nullptr, ln1_g + l * DM, ln1_b + l * DM, lds, l};
          pg8::gemm_phase(lds, g, S, E, tid); }
        PHASE_END
        GRID_BAR();
        PHASE_BEGIN
        { pg8::Gemm g{HB, W10, M, N10, DM, DM, DM, 0}; pg8::StaticOrder S; S.init(M, N10, G, blk);
          EpiSwiglu E{ACT}; pg8::gemm_phase(lds, g, S, E, tid); }
        PHASE_END
        GRID_BAR();
        if (l == DEPTH - 1) {
        PHASE_BEGIN
        { pg8::Gemm g{ACT, W11, M, DM, DFF, DFF, DFF, 0, 1}; pg8::StaticOrder S; S.init(M, DM, G, blk); S.mode = 1;
          EpiLn<1, true> E{ws, (const float*)nullptr, args.out, ln2_g + l * DM, ln2_b + l * DM, lds, l}; pg8::gemm_phase(lds, g, S, E, tid); }
        PHASE_END
        } else {
        PHASE_BEGIN
        { pg8::Gemm g{ACT, W11, M, DM, DFF, DFF, DFF, 0, 1}; pg8::StaticOrder S; S.init(M, DM, G, blk); S.mode = 1;
          EpiLn<1, false> E{ws, (const float*)nullptr, (float*)nullptr, ln2_g + l * DM, ln2_b + l * DM, lds, l}; pg8::gemm_phase(lds, g, S, E, tid); }
        PHASE_END
        }
        if (l + 1 < DEPTH) GRID_BAR();
    }
}

extern "C" void kernel_launch(void* const* d_in, const int* in_sizes, int n_in, void* d_out, int out_size, void* d_ws, size_t ws_size, hipStream_t stream) {
    static int grid = 0;
    if (grid == 0) {
        if (n_in != 22 || out_size != M * DM || ws_size < WS_END) { fprintf(stderr, "kernel_launch: unexpected shapes (n_in %d, out %d, ws %zu < %zu)\n", n_in, out_size, ws_size, (size_t)WS_END); grid = -1; return; }
        int dev = 0, cus = 0, per_cu = 0;
        if (hipGetDevice(&dev) != hipSuccess || hipDeviceGetAttribute(&cus, hipDeviceAttributeMultiprocessorCount, dev) != hipSuccess) { grid = -1; return; }
        if (hipFuncSetAttribute((const void*)fwd_kernel, hipFuncAttributeMaxDynamicSharedMemorySize, LDS_BYTES) != hipSuccess) { fprintf(stderr, "kernel_launch: hipFuncSetAttribute failed\n"); grid = -1; return; }
        if (hipOccupancyMaxActiveBlocksPerMultiprocessor(&per_cu, (const void*)fwd_kernel, NTHR, LDS_BYTES) != hipSuccess || per_cu < 1) { fprintf(stderr, "kernel_launch: occupancy query says %d\n", per_cu); }
        (void)hipGetLastError();
        if (cus % 64 != 0) { fprintf(stderr, "kernel_launch: %d CUs: the fused-LayerNorm unit order needs a multiple of 64 workgroups\n", cus); grid = -1; return; }
        grid = cus;
    }
    if (grid < 0) return;
    if (hipMemsetAsync((char*)d_ws + WS_CTL, 0, CTL_ZERO_BYTES, stream) != hipSuccess) return;
    Args a{};
    for (int i = 0; i < 22; ++i) a.in[i] = (const float*)d_in[i];
    a.out = (float*)d_out; a.ws = (unsigned char*)d_ws;
    hipLaunchKernelGGL(fwd_kernel, dim3(grid), dim3(NTHR), LDS_BYTES, stream, a);
}
```

```cpp
#include <hip/hip_runtime.h>
#include <cstdio>
#include <cstdint>

namespace pg8 {
#define PG8_LAS __attribute__((address_space(3)))
typedef unsigned short bf16_t;
typedef short bf16x8 __attribute__((ext_vector_type(8)));
typedef float f32x4 __attribute__((ext_vector_type(4)));
typedef unsigned u32x4 __attribute__((ext_vector_type(4)));
constexpr int BM = 256, BK = 64, HALF = 128, HTB = HALF * BK * 2, STAGE_BYTES = 8 * HTB, NXCD = 8, WGM = 8;

__host__ __device__ __forceinline__ int lds_byte(int r, int c) { const int st = (r >> 4) * 2 + (c >> 5), rr = r & 15, cc = c & 31, ob = rr * 64 + cc * 2; return st * 1024 + (ob ^ (((ob >> 9) & 1) << 5)); }
__host__ __device__ __forceinline__ void stage_rc(int b, int& R, int& C) { const int st = b / 1024, sb = b % 1024, swz = sb ^ (((sb >> 9) & 1) << 5); R = (st >> 1) * 16 + swz / 64; C = (st & 1) * 32 + (swz % 64) / 2; }
__host__ __device__ __forceinline__ int perm32(int rho) { const int n = rho >> 4, i = rho & 15; return 8 * (i >> 2) + 4 * n + (i & 3); }

struct Unit { int pm, pn; };
struct Gemm { const bf16_t* A; const bf16_t* Bt; int M, N, K, lda, ldb, a_pn_stride; int krev = 0; };

struct StaticOrder {
    int nM, nN, nwg, G, c, mode;
    __host__ __device__ void init(int M, int N, int G_, int c_) { nM = M / BM; nN = N / BM; nwg = nM * nN; G = G_; c = c_; mode = 0; }
    __host__ __device__ bool next(int i, Unit& u) const {
        if (mode == 1) {
            const int PR = G >> 3, x = c & 7, j = c >> 3, pq = PR >> 3, nx = nM >> 3; if (i * pq + (j >> 3) >= nx) return false; u.pm = x * nx + i * pq + (j >> 3); u.pn = j & 7; return true; }
        const long L = (long)i * G + c; if (L >= nwg) return false;
        int wgid = (int)L; { const int q = nwg / NXCD, r = nwg % NXCD, xcd = wgid % NXCD, off = wgid / NXCD; wgid = (xcd < r ? xcd * (q + 1) : r * (q + 1) + (xcd - r) * q) + off; }
        const int nig = WGM * nN, gid = wgid / nig, fm = gid * WGM, gsz = (nM - fm) < WGM ? (nM - fm) : WGM;
        u.pm = fm + ((wgid % nig) % gsz); u.pn = (wgid % nig) / gsz; return true;
    }
};

typedef float f32x2_t __attribute__((ext_vector_type(2))); typedef __bf16 bf16x2_t __attribute__((ext_vector_type(2)));
__device__ __forceinline__ unsigned cvt_pk_bf16(float lo, float hi) { f32x2_t v = {lo, hi}; bf16x2_t b = __builtin_convertvector(v, bf16x2_t); return __builtin_bit_cast(unsigned, b); }

struct NoHook { static constexpr bool ON = false; template <class A> __device__ __forceinline__ void mid(A&, const Unit&, int, int, int, int) const {} };
template <class Epi, class Hook = NoHook>
__device__ __forceinline__ void gemm_phase(PG8_LAS unsigned char* lds, const Gemm g, const StaticOrder& S, const Epi& E, const int tid, const Hook H = Hook()) {
    const int wid = __builtin_amdgcn_readfirstlane(tid >> 6), lane = tid & 63, wr = wid >> 2, wc = wid & 3, fr = lane & 15, fq = lane >> 4;
    const int K = g.K, nt = K / BK;
    unsigned voffA[2], voffB[2];
#pragma unroll
    for (int i = 0; i < 2; ++i) { int R, C; stage_rc(tid * 16 + i * 8192, R, C); const int Rb = 64 * (R >> 5) + perm32(R & 31);
        voffA[i] = (unsigned)(R * g.lda + C) * 2u; voffB[i] = (unsigned)(Rb * g.ldb + C) * 2u; }
    const long kstep = g.krev ? -(long)(BK * 2) : (long)(BK * 2); const size_t kbase = g.krev ? (size_t)(nt - 1) * (BK * 2) : 0;
    const size_t hstepA = (size_t)HALF * g.lda * 2, hstepB = (size_t)32 * g.ldb * 2;
    const size_t tstepA = 2 * hstepA, tstepB = (size_t)BM * g.ldb * 2;
    const unsigned ldsw = (unsigned)wid * 1024u;
    const int aoff = lds_byte(wr * 64 + fr, fq * 8), boff = lds_byte(wc * 32 + fr, fq * 8);
#define PG8_SA(b, h) (((b) * 2 + (h)) * HTB)
#define PG8_SB(b, h) ((4 + (b) * 2 + (h)) * HTB)
#define PG8_STAGE(bufoff, gbase, voff) do { _Pragma("unroll") for (int _i = 0; _i < 2; ++_i) \
        __builtin_amdgcn_global_load_lds((const unsigned*)((const char*)(gbase) + (voff)[_i]), (PG8_LAS unsigned*)(lds + (bufoff) + ldsw + _i * 8192), 16, 0, 0); } while (0)
#define PG8_LDA(dst, b, h) do { _Pragma("unroll") for (int m = 0; m < 4; ++m) _Pragma("unroll") for (int k = 0; k < 2; ++k) dst[m][k] = *(const PG8_LAS bf16x8*)(lds + PG8_SA(b, h) + aoff + m * 2048 + k * 1024); } while (0)
#define PG8_LDB(dst, b, h) do { _Pragma("unroll") for (int n = 0; n < 2; ++n) _Pragma("unroll") for (int k = 0; k < 2; ++k) dst[n][k] = *(const PG8_LAS bf16x8*)(lds + PG8_SB(b, h) + boff + n * 2048 + k * 1024); } while (0)
#define PG8_MMA(ai, bj, At, Bt) do { __builtin_amdgcn_s_setprio(1); _Pragma("unroll") for (int m = 0; m < 4; ++m) _Pragma("unroll") for (int n = 0; n < 2; ++n) _Pragma("unroll") for (int k = 0; k < 2; ++k) \
        acc[ai][bj][m][n] = __builtin_amdgcn_mfma_f32_16x16x32_bf16(Bt[n][k], At[m][k], acc[ai][bj][m][n], 0, 0, 0); __builtin_amdgcn_s_setprio(0); } while (0)
#define PG8_WAIT_V(n) asm volatile("s_waitcnt vmcnt(" #n ")" ::: "memory")
#define PG8_WAIT_L(n) asm volatile("s_waitcnt lgkmcnt(" #n ")" ::: "memory")
#define PG8_BAR __builtin_amdgcn_s_barrier()
#define PG8_SCHED __builtin_amdgcn_sched_barrier(0)
    Unit cur, nxt; int ui = 0;
    if (!S.next(0, cur)) return;
    f32x4 acc[2][2][4][2];
#pragma unroll
    for (int a = 0; a < 2; ++a)
#pragma unroll
        for (int b = 0; b < 2; ++b)
#pragma unroll
            for (int m = 0; m < 4; ++m)
#pragma unroll
                for (int n = 0; n < 2; ++n) acc[a][b][m][n] = (f32x4){0.f, 0.f, 0.f, 0.f};
    bf16x8 At[4][2], B0[2][2], B1[2][2];
    const char* cA = (const char*)g.A + (size_t)cur.pm * tstepA + (size_t)cur.pn * g.a_pn_stride * 2 + kbase; const char* cB = (const char*)g.Bt + (size_t)cur.pn * tstepB + kbase;
    PG8_STAGE(PG8_SB(0, 0), cB, voffB); PG8_STAGE(PG8_SB(0, 1), cB + hstepB, voffB); PG8_STAGE(PG8_SA(0, 0), cA, voffA); PG8_STAGE(PG8_SA(0, 1), cA + hstepA, voffA);
    if (wr == 1) PG8_BAR;
    PG8_WAIT_V(2); PG8_BAR;
    PG8_STAGE(PG8_SB(1, 0), cB + kstep, voffB); PG8_STAGE(PG8_SA(1, 0), cA + kstep, voffA); PG8_STAGE(PG8_SB(1, 1), cB + hstepB + kstep, voffB);
    PG8_WAIT_V(6); PG8_BAR;
    for (;;) {
        const bool has_next = S.next(ui + 1, nxt);
        const char* nA = has_next ? (const char*)g.A + (size_t)nxt.pm * tstepA + (size_t)nxt.pn * g.a_pn_stride * 2 + kbase : cA; const char* nB = has_next ? (const char*)g.Bt + (size_t)nxt.pn * tstepB + kbase : cB;
        for (int t = 0; t < nt; t += 2) {
            const bool last = (t == nt - 2);
            const char* a1 = cA + (long)(t + 1) * kstep;
            const char* a2 = last ? nA : cA + (long)(t + 2) * kstep; const char* b2 = last ? nB : cB + (long)(t + 2) * kstep;
            const char* a3 = a2 + kstep; const char* b3 = b2 + kstep;
            if constexpr (Hook::ON) { if (t == (nt >> 1)) H.mid(acc, cur, wr, wc, fr, fq); }
            PG8_LDB(B0, 0, 0); PG8_LDB(B1, 0, 1); PG8_SCHED; PG8_LDA(At, 0, 0); PG8_STAGE(PG8_SA(1, 1), a1 + hstepA, voffA);
            PG8_WAIT_V(8); PG8_WAIT_L(0); PG8_BAR; PG8_MMA(0, 0, At, B0); PG8_MMA(0, 1, At, B1); PG8_BAR; PG8_SCHED;
            PG8_LDA(At, 0, 1); PG8_STAGE(PG8_SB(0, 0), b2, voffB); PG8_STAGE(PG8_SB(0, 1), b2 + hstepB, voffB); PG8_STAGE(PG8_SA(0, 0), a2, voffA);
            PG8_WAIT_V(8); PG8_WAIT_L(0); PG8_BAR; PG8_MMA(1, 0, At, B0); PG8_MMA(1, 1, At, B1); PG8_BAR; PG8_SCHED;
            PG8_LDB(B0, 1, 0); PG8_LDB(B1, 1, 1); PG8_SCHED; PG8_LDA(At, 1, 0); PG8_STAGE(PG8_SA(0, 1), a2 + hstepA, voffA);
            PG8_WAIT_V(8); PG8_WAIT_L(0); PG8_BAR; PG8_MMA(0, 0, At, B0); PG8_MMA(0, 1, At, B1); PG8_BAR; PG8_SCHED;
            PG8_LDA(At, 1, 1); PG8_STAGE(PG8_SB(1, 0), b3, voffB); PG8_STAGE(PG8_SB(1, 1), b3 + hstepB, voffB); PG8_STAGE(PG8_SA(1, 0), a3, voffA);
            PG8_WAIT_V(8); PG8_WAIT_L(0); PG8_BAR; PG8_MMA(1, 0, At, B0); PG8_MMA(1, 1, At, B1); PG8_BAR; PG8_SCHED;
        }
        if (wr == 0) PG8_BAR;
        E(acc, cur, wr, wc, fr, fq);
        if (!has_next) break;
#pragma unroll
        for (int a = 0; a < 2; ++a)
#pragma unroll
            for (int b = 0; b < 2; ++b)
#pragma unroll
                for (int m = 0; m < 4; ++m)
#pragma unroll
                    for (int n = 0; n < 2; ++n) acc[a][b][m][n] = (f32x4){0.f, 0.f, 0.f, 0.f};
        cur = nxt; cA = nA; cB = nB; ++ui;
        if (wr == 1) PG8_BAR;
    }
    PG8_WAIT_V(0);
    PG8_BAR;
#undef PG8_SA
#undef PG8_SB
#undef PG8_STAGE
#undef PG8_LDA
#undef PG8_LDB
#undef PG8_MMA
#undef PG8_WAIT_V
#undef PG8_WAIT_L
#undef PG8_BAR
#undef PG8_SCHED
}
}

constexpr int NWAVES = 8, NTHR = NWAVES * 64;
constexpr int DM = 2048, NBATCH = 4, SEQ = 4096, DEPTH = 4, M = NBATCH * SEQ;
constexpr int HGW = 1024;
constexpr int SAH = 16, SAC = 256, SAR = 512;
constexpr int DFF = 5632;
constexpr int N1 = 9216, N3 = 5120, N10 = 2 * DFF;
constexpr float ALPHA = 1.6817928305074292f;
constexpr int MODW = 6 * DM;

constexpr size_t MiB = 1u << 20;
constexpr size_t WS_CTL = 0, CTL_ZERO_BYTES = 32768;
constexpr size_t WS_MOD = 1 * MiB;
constexpr size_t WS_LB = 2 * MiB;
constexpr size_t WS_MODP = 3 * MiB;
constexpr size_t WS_W1 = 9 * MiB;
constexpr size_t WS_W3 = WS_W1 + 36 * MiB;
constexpr size_t WS_W6 = WS_W3 + 5 * MiB;
constexpr size_t WS_W7 = WS_W6 + 2 * MiB;
constexpr size_t WS_W8 = WS_W7 + 8 * MiB;
constexpr size_t WS_W10 = WS_W8 + 8 * MiB;
constexpr size_t WS_W11 = WS_W10 + 44 * MiB;
constexpr size_t WS_X = WS_W11 + 22 * MiB;
constexpr size_t WS_R = WS_X + 128 * MiB;
constexpr size_t WS_H = WS_R + 128 * MiB;
constexpr size_t WS_QA = WS_H + 64 * MiB;
constexpr size_t WS_FA = WS_QA + 32 * MiB;
constexpr size_t WS_IA = WS_FA + 64 * MiB;
constexpr size_t WS_GA = WS_IA + 32 * MiB;
constexpr size_t WS_LAT = WS_GA + 32 * MiB;
constexpr size_t WS_GTA = WS_LAT + 64 * MiB;
constexpr size_t WS_GTB = WS_GTA + 64 * MiB;
constexpr size_t WS_CQN = WS_GTB + 64 * MiB;
constexpr size_t WS_CKV = WS_CQN + 16 * MiB;
constexpr size_t WS_KIDX = WS_CKV + 8 * MiB;
constexpr size_t WS_IDXW = WS_KIDX + 2 * MiB;
constexpr size_t WS_QB = WS_IDXW + 1 * MiB;
constexpr size_t WS_QIDX = WS_QB + 128 * MiB;
constexpr size_t WS_SEL = WS_QIDX + 32 * MiB;
constexpr size_t WS_YAB = WS_SEL + 8 * MiB;
constexpr size_t WS_MRG = WS_FA;
constexpr size_t WS_OB = WS_YAB + 64 * MiB;
constexpr size_t WS_BIG = WS_OB + 128 * MiB;
constexpr size_t WS_KSB = WS_BIG + 256 * MiB;
constexpr size_t WS_DEB = WS_KSB + 32 * MiB;
constexpr size_t WS_QSB = WS_DEB + 2 * MiB;
constexpr size_t WS_END = WS_QSB + 32 * MiB;

constexpr int CW_BAR = 4096;

constexpr int RING_BYTES = 131072;
constexpr int LDS_BYTES = 163840;
constexpr int LDSCTL_OFF = LDS_BYTES - 1024, MISC_OFF = LDSCTL_OFF + 320, SELL_OFF = 147456;

#define GAS __attribute__((address_space(1)))
#define LAS __attribute__((address_space(3)))
typedef unsigned short bf16;
typedef unsigned v4u __attribute__((ext_vector_type(4)));
typedef unsigned v2u __attribute__((ext_vector_type(2)));
typedef float f32x4 __attribute__((ext_vector_type(4)));
typedef float f32x16 __attribute__((ext_vector_type(16)));
typedef short bf16x8 __attribute__((ext_vector_type(8)));
typedef short v4s __attribute__((ext_vector_type(4)));
typedef GAS unsigned gu32;
#define LDS_WAIT() asm volatile("s_waitcnt lgkmcnt(0)" ::: "memory")
__device__ __forceinline__ unsigned f2bf(float f) { unsigned u = __builtin_bit_cast(unsigned, f); return (u + 0x7fffu + ((u >> 16) & 1u)) >> 16; }
__device__ __forceinline__ unsigned pk2(float lo, float hi) { return pg8::cvt_pk_bf16(lo, hi); }
__device__ __forceinline__ float bf2f(unsigned short b) { return __builtin_bit_cast(float, ((unsigned)b) << 16); }
__device__ __forceinline__ float bflo(unsigned w) { return __builtin_bit_cast(float, w << 16); }
__device__ __forceinline__ float bfhi(unsigned w) { return __builtin_bit_cast(float, w & 0xffff0000u); }
__device__ __forceinline__ float sigm(float x) { return __builtin_amdgcn_rcpf(1.f + __expf(-x)); }

__device__ __forceinline__ int lane_id() { unsigned m = ~0u; asm volatile("" : "+s"(m)); return (int)__builtin_amdgcn_mbcnt_hi(m, __builtin_amdgcn_mbcnt_lo(m, 0u)); }
#define XB_TMO      128
#define XB_XCNT(j)  (256  + 64 * (j))
#define XB_XSUB(j)  (1280 + 64 * (j))
#define XB_XGEN(j)  (2304 + 64 * (j))
#define XB_TOP      3328
#define XB_TOPGEN   3392
#define XCD_BAR_WORDS 3456
#define XB_SPIN_CAP (1u << 22)

__device__ __forceinline__ unsigned xb_ld(unsigned* p)              { return __hip_atomic_load(p, __ATOMIC_RELAXED, __HIP_MEMORY_SCOPE_AGENT); }
__device__ __forceinline__ unsigned xb_add(unsigned* p, unsigned v) { return __hip_atomic_fetch_add(p, v, __ATOMIC_RELAXED, __HIP_MEMORY_SCOPE_AGENT); }
__device__ __forceinline__ unsigned xb_xcc_id() { return (unsigned)__builtin_amdgcn_s_getreg((3 << 11) | 20) & 0xFu; }
#define XB_SPIN(cond, bar) do { unsigned _sp = 0; while (cond) { __builtin_amdgcn_s_sleep(1); \
    if ((++_sp & 255u) == 0u) { if (xb_ld(&(bar)[XB_TMO])) break; if (_sp > XB_SPIN_CAP) { atomicAdd(&(bar)[XB_TMO], 1u); break; } } } } while (0)

struct XcdBarrier { unsigned* bar; unsigned x; volatile LAS unsigned* st; int wave; };

__device__ __forceinline__ XcdBarrier xcd_barrier_post(unsigned* bar, volatile LAS unsigned* st) {
    XcdBarrier b; b.bar = bar; b.x = (unsigned)__builtin_amdgcn_readfirstlane((int)xb_xcc_id()); b.st = st;
    if (threadIdx.x == 0) (void)xb_add(&bar[XB_XCNT(b.x)], 1u);
    return b;
}
__device__ __forceinline__ void xcd_barrier_complete(unsigned* bar, unsigned x, unsigned& nloc, unsigned& nx) {
    const unsigned G = gridDim.x * gridDim.y * gridDim.z;
    unsigned sum, cnt, mine, sp = 0u;
    for (;;) {
        sum = 0u; cnt = 0u; mine = 0u;
#pragma unroll 1
        for (unsigned j = 0; j < 16; ++j) { const unsigned c = xb_ld(&bar[XB_XCNT(j)]); sum += c; cnt += (c > 0u) ? 1u : 0u; mine = (j == x) ? c : mine; }
        if (sum == G) break;
        __builtin_amdgcn_s_sleep(1);
        if ((++sp & 255u) == 0u) { if (xb_ld(&bar[XB_TMO])) break; if (sp > XB_SPIN_CAP) { atomicAdd(&bar[XB_TMO], 1u); break; } }
    }
    nloc = mine > 0u ? mine : 1u; nx = cnt > 0u ? cnt : 1u;
}
__device__ __forceinline__ void xcd_barrier(const XcdBarrier& b) {
    asm volatile("s_waitcnt vmcnt(0)" ::: "memory");
    __syncthreads();
    if (b.wave == 0 && lane_id() == 0) {
        unsigned* bar = b.bar;
        unsigned bx = b.x; asm volatile("" : "+s"(bx));
        __builtin_amdgcn_s_waitcnt(0);
        unsigned nloc = b.st[0], nx = b.st[1];
        const unsigned old = xb_add(&bar[XB_XSUB(bx)], 1u);
        const unsigned gen = old / nloc;
        if (old + 1u == (gen + 1u) * nloc) {
            __builtin_amdgcn_fence(__ATOMIC_RELEASE, "agent");
            asm volatile("s_waitcnt vmcnt(0)" ::: "memory");
            const unsigned og = xb_add(&bar[XB_TOP], 1u);
            const unsigned tg = og / nx;
            if (og + 1u == (tg + 1u) * nx) xb_add(&bar[XB_TOPGEN], 1u);
            else XB_SPIN(xb_ld(&bar[XB_TOPGEN]) == tg, bar);
            __builtin_amdgcn_fence(__ATOMIC_ACQUIRE, "agent");
            xb_add(&bar[XB_XGEN(bx)], 1u);
            asm volatile("s_waitcnt vmcnt(0)" ::: "memory");
        } else {
            XB_SPIN(xb_ld(&bar[XB_XGEN(bx)]) == gen, bar);
            __builtin_amdgcn_fence(__ATOMIC_ACQUIRE, "agent");
            asm volatile("s_waitcnt vmcnt(0)" ::: "memory");
        }
    }
    __syncthreads();
}

__device__ __forceinline__ void xswap16(float& a, float& b) { asm volatile("s_nop 1\n\tv_permlane16_swap_b32 %0, %1\n\ts_nop 1" : "+v"(a), "+v"(b)); }
__device__ __forceinline__ void xswap32(float& a, float& b) { asm volatile("s_nop 1\n\tv_permlane32_swap_b32 %0, %1\n\ts_nop 1" : "+v"(a), "+v"(b)); }
__device__ __forceinline__ float xmax16(float x) { float a = x, b = x; xswap16(a, b); return fmaxf(a, b); }
__device__ __forceinline__ float xmax32(float x) { float a = x, b = x; xswap32(a, b); return fmaxf(a, b); }
__device__ __forceinline__ float xsum16(float x) { float a = x, b = x; xswap16(a, b); return a + b; }
__device__ __forceinline__ float xsum32(float x) { float a = x, b = x; xswap32(a, b); return a + b; }

#define DPPF(x, ctrl) __builtin_bit_cast(float, __builtin_amdgcn_update_dpp(0, __builtin_bit_cast(int, (x)), (ctrl), 0xf, 0xf, true))
__device__ __forceinline__ float wmax_f(float x) {
    x = fmaxf(x, DPPF(x, 0xB1)); x = fmaxf(x, DPPF(x, 0x4E)); x = fmaxf(x, DPPF(x, 0x124)); x = fmaxf(x, DPPF(x, 0x128));
    x = xmax16(x); return xmax32(x);
}
__device__ __forceinline__ unsigned wprefix_u(unsigned x) {
    int v = (int)x;
    v += __builtin_amdgcn_update_dpp(0, v, 0x111, 0xf, 0xf, false);
    v += __builtin_amdgcn_update_dpp(0, v, 0x112, 0xf, 0xf, false);
    v += __builtin_amdgcn_update_dpp(0, v, 0x114, 0xf, 0xf, false);
    v += __builtin_amdgcn_update_dpp(0, v, 0x118, 0xf, 0xf, false);
    v += __builtin_amdgcn_update_dpp(0, v, 0x142, 0xa, 0xf, false);
    v += __builtin_amdgcn_update_dpp(0, v, 0x143, 0xc, 0xf, false);
    return (unsigned)v;
}

__device__ __forceinline__ float rowsum16(float x) { x += DPPF(x, 0xB1); x += DPPF(x, 0x4E); x += DPPF(x, 0x124); x += DPPF(x, 0x128); return x; }
__device__ __forceinline__ float wave_sum(float x) { x = rowsum16(x); x = xsum16(x); return xsum32(x); }
__device__ __forceinline__ float wave_max(float x) { return wmax_f(x); }
__device__ __forceinline__ int wave_sum_i(int v) { float f = wave_sum((float)v); return (int)(f + 0.5f); }
template <class Src>
__device__ __forceinline__ void cvt_load(const Src& src, int k0, int n0, int lane, float (&tv)[32]) {
#pragma unroll
    for (int j = 0; j < 8; ++j) { const f32x4 v = src(k0 + 8 * j + (lane >> 3), n0 + 4 * (lane & 7)); tv[4 * j] = v[0]; tv[4 * j + 1] = v[1]; tv[4 * j + 2] = v[2]; tv[4 * j + 3] = v[3]; }
}
__device__ __forceinline__ void cvt_store(const float (&tv)[32], bf16* WT, int K, int k0, int n0, LAS float* scr, int lane) {
#pragma unroll
    for (int j = 0; j < 8; ++j)
#pragma unroll
        for (int e = 0; e < 4; ++e) scr[(8 * j + (lane >> 3)) * 33 + 4 * (lane & 7) + e] = tv[4 * j + e];
    LDS_WAIT(); asm volatile("" ::: "memory");
    const int c = lane & 7;
#pragma unroll
    for (int j = 0; j < 4; ++j) { const int n = (lane >> 3) + 8 * j; const LAS float* s = scr + (8 * c) * 33 + n;
        v4u o; o.x = pk2(s[0 * 33], s[1 * 33]); o.y = pk2(s[2 * 33], s[3 * 33]); o.z = pk2(s[4 * 33], s[5 * 33]); o.w = pk2(s[6 * 33], s[7 * 33]);
        *(GAS v4u*)(WT + (size_t)(n0 + n) * K + k0 + 8 * c) = o; }
    LDS_WAIT(); asm volatile("" ::: "memory");
}

struct Args { const float* in[22]; float* out; unsigned char* ws; };

using pg8::Unit; using pg8::cvt_pk_bf16;
__device__ __forceinline__ void st_bf16x8(bf16* p, f32x4 v0, f32x4 v1) {
    v4u w; w.x = cvt_pk_bf16(v0[0], v0[1]); w.y = cvt_pk_bf16(v0[2], v0[3]); w.z = cvt_pk_bf16(v1[0], v1[1]); w.w = cvt_pk_bf16(v1[2], v1[3]);
    *(v4u*)p = w;
}
__device__ __forceinline__ void st_f32x8(float* p, f32x4 v0, f32x4 v1) { *(f32x4*)p = v0; *(f32x4*)(p + 4) = v1; }
__device__ __forceinline__ f32x4 sigm4(f32x4 v) { return (f32x4){sigm(v[0]), sigm(v[1]), sigm(v[2]), sigm(v[3])}; }
__device__ __forceinline__ f32x4 silu4(f32x4 v) { return (f32x4){v[0] * sigm(v[0]), v[1] * sigm(v[1]), v[2] * sigm(v[2]), v[3] * sigm(v[3])}; }
__device__ __forceinline__ f32x4 ldbf4(const bf16* p) { const v2u w = *(const v2u*)p; return (f32x4){bflo(w.x), bfhi(w.x), bflo(w.y), bfhi(w.y)}; }

#define EPI_LOOP(...) \
    _Pragma("unroll") for (int ai = 0; ai < 2; ++ai) _Pragma("unroll") for (int m = 0; m < 4; ++m) { const int row = row0 + ai * 128 + m * 16; \
        _Pragma("unroll") for (int bj = 0; bj < 2; ++bj) { const int col = colb + bj * 32; const f32x4 v0 = acc[ai][bj][m][0], v1 = acc[ai][bj][m][1]; __VA_ARGS__ } }

__device__ __forceinline__ unsigned q8x4(f32x4 g) { unsigned w = 0u;
#pragma unroll
    for (int e = 0; e < 4; ++e) { const float t = fmaxf(__builtin_fmaf(g[e], 255.f, 0.5f), 1.f); w |= ((unsigned)t) << (8 * e); } return w; }
__device__ __forceinline__ f32x4 ub4(unsigned w) { return (f32x4){(float)(w & 0xffu), (float)((w >> 8) & 0xffu), (float)((w >> 16) & 0xffu), (float)(w >> 24)}; }
struct EpiProj {
    bf16* QA; bf16* FA; bf16* IA; bf16* GA; bf16* LAT; bf16* GTA; bf16* GTB;
    __device__ __forceinline__ void operator()(const f32x4 (&acc)[2][2][4][2], const Unit& u, int wr, int wc, int fr, int fq) const {
        const int row0 = u.pm * 256 + wr * 64 + fr, pn = u.pn; const int colb = (pn & 3) * 256 + wc * 64 + 8 * fq;
        if (pn < 4)       { EPI_LOOP( st_bf16x8(QA + (size_t)row * 1024 + col, v0, v1); ) }
        else if (pn < 8)  { EPI_LOOP( st_bf16x8(FA + (size_t)row * 1024 + col, v0, v1); ) }
        else if (pn < 12) { EPI_LOOP( st_bf16x8(IA + (size_t)row * 1024 + col, v0, v1); ) }
        else if (pn < 16) { EPI_LOOP( st_bf16x8(GA + (size_t)row * 1024 + col, silu4(v0), silu4(v1)); ) }
        else if (pn < 20) { EPI_LOOP( st_bf16x8(LAT + (size_t)row * 1024 + col, v0, v1); ) }
        else { unsigned char* G8 = (unsigned char*)(pn < 28 ? GTA : GTB) + ((size_t)(u.pm * 8 + ((pn - 20) & 7)) * 8 + (wr * 4 + wc)) * 8192 + (fq * 16 + fr) * 16;
            _Pragma("unroll") for (int ai = 0; ai < 2; ++ai) _Pragma("unroll") for (int bj = 0; bj < 2; ++bj) _Pragma("unroll") for (int mp = 0; mp < 2; ++mp) { v4u w;
                w.x = q8x4(sigm4(acc[ai][bj][2 * mp][0])); w.y = q8x4(sigm4(acc[ai][bj][2 * mp][1])); w.z = q8x4(sigm4(acc[ai][bj][2 * mp + 1][0])); w.w = q8x4(sigm4(acc[ai][bj][2 * mp + 1][1]));
                *(v4u*)(G8 + (ai * 4 + bj * 2 + mp) * 1024) = w; } }
    }
};
struct EpiQ {
    bf16* QB; bf16* QIDX;
    __device__ __forceinline__ void operator()(const f32x4 (&acc)[2][2][4][2], const Unit& u, int wr, int wc, int fr, int fq) const {
        const int row0 = u.pm * 256 + wr * 64 + fr, pn = u.pn;
        if (pn < 16) { const int colb = pn * 256 + wc * 64 + 8 * fq; EPI_LOOP( st_bf16x8(QB + (size_t)row * 4096 + col, v0, v1); ) }
        else { const int colb = (pn - 16) * 256 + wc * 64 + 8 * fq; EPI_LOOP( st_bf16x8(QIDX + (size_t)row * 1024 + col, v0, v1); ) }
    }
};
struct EpiBf {
    bf16* O; int ldc; int coff;
    __device__ __forceinline__ void operator()(const f32x4 (&acc)[2][2][4][2], const Unit& u, int wr, int wc, int fr, int fq) const {
        const int row0 = u.pm * 256 + wr * 64 + fr; const int colb = coff + u.pn * 256 + wc * 64 + 8 * fq;
        EPI_LOOP( st_bf16x8(O + (size_t)row * ldc + col, v0, v1); )
    }
};
struct HookGate {
    static constexpr bool ON = true; const bf16* GA_; const bf16* GB_;
    __device__ __forceinline__ void mid(f32x4 (&acc)[2][2][4][2], const Unit& u, int wr, int wc, int fr, int fq) const {
        asm volatile("" : "+v"(fr), "+v"(fq));
        const size_t off = ((size_t)(u.pm * 8 + u.pn) * 8 + (wr * 4 + wc)) * 8192 + (fq * 16 + fr) * 16;
        const unsigned char* A8 = (const unsigned char*)GA_ + off; const unsigned char* B8 = (const unsigned char*)GB_ + off;
#pragma unroll
        for (int ai = 0; ai < 2; ++ai)
#pragma unroll
            for (int mp = 0; mp < 2; ++mp) {
#pragma unroll
                for (int bj = 0; bj < 2; ++bj) { const v4u a = *(const v4u*)(A8 + (ai * 4 + bj * 2 + mp) * 1024), b = *(const v4u*)(B8 + (ai * 4 + bj * 2 + mp) * 1024);
#pragma unroll
                    for (int mm = 0; mm < 2; ++mm)
#pragma unroll
                        for (int n = 0; n < 2; ++n) { const unsigned aw = a[mm * 2 + n], bw = b[mm * 2 + n]; const f32x4 fa = ub4(aw), fb = ub4(bw); f32x4 r;
#pragma unroll
                            for (int j = 0; j < 4; ++j) r[j] = fa[j] * __builtin_amdgcn_rcpf(fb[j]);
                            acc[ai][bj][2 * mp + mm][n] = acc[ai][bj][2 * mp + mm][n] * r; } }
                asm volatile("" : "+v"(acc[ai][0][2 * mp][0]), "+v"(acc[ai][0][2 * mp][1]), "+v"(acc[ai][1][2 * mp][0]), "+v"(acc[ai][1][2 * mp][1]));
                asm volatile("" : "+v"(acc[ai][0][2 * mp + 1][0]), "+v"(acc[ai][0][2 * mp + 1][1]), "+v"(acc[ai][1][2 * mp + 1][0]), "+v"(acc[ai][1][2 * mp + 1][1]));
                asm volatile("" ::: "memory"); }
    }
};
__device__ __forceinline__ f32x4 cvbf4(v2u w) { return (f32x4){bflo(w.x), bfhi(w.x), bflo(w.y), bfhi(w.y)}; }
struct EpiGateM {
    const bf16* GB_; bf16* MRG_;
    __device__ __forceinline__ void operator()(const f32x4 (&acc)[2][2][4][2], const Unit& u, int wr, int wc, int fr, int fq) const {
        const int row0 = u.pm * 256 + wr * 64 + fr; const int colb = u.pn * 256 + wc * 64 + 8 * fq;
        const unsigned char* B8 = (const unsigned char*)GB_ + ((size_t)(u.pm * 8 + u.pn) * 8 + (wr * 4 + wc)) * 8192 + (fq * 16 + fr) * 16;
#pragma unroll
        for (int ai = 0; ai < 2; ++ai) { v4u gr[2][2];
#pragma unroll
            for (int bj = 0; bj < 2; ++bj)
#pragma unroll
                for (int mp = 0; mp < 2; ++mp) gr[bj][mp] = *(const v4u*)(B8 + (ai * 4 + bj * 2 + mp) * 1024);
#pragma unroll
            for (int m = 0; m < 4; ++m)
#pragma unroll
                for (int bj = 0; bj < 2; ++bj) { const size_t o = (size_t)(row0 + ai * 128 + m * 16) * 2048 + colb + bj * 32;
                    const unsigned w0 = gr[bj][m >> 1][(m & 1) * 2], w1 = gr[bj][m >> 1][(m & 1) * 2 + 1];
                    st_bf16x8(MRG_ + o, acc[ai][bj][m][0] * (ub4(w0) * (1.f / 255.f)), acc[ai][bj][m][1] * (ub4(w1) * (1.f / 255.f))); } }
    }
};
struct EpiGateA {
    float* T1; const bf16* GT;
    __device__ __forceinline__ void operator()(const f32x4 (&acc)[2][2][4][2], const Unit& u, int wr, int wc, int fr, int fq) const {
        const int row0 = u.pm * 256 + wr * 64 + fr; const int colb = u.pn * 256 + wc * 64 + 8 * fq;
        EPI_LOOP( const size_t o = (size_t)row * 2048 + col; const f32x4 g0 = ldbf4(GT + o), g1 = ldbf4(GT + o + 4); st_f32x8(T1 + o, v0 * g0, v1 * g1); )
    }
};
struct EpiGateB {
    const float* T1; const bf16* GT; bf16* MRG;
    __device__ __forceinline__ void operator()(const f32x4 (&acc)[2][2][4][2], const Unit& u, int wr, int wc, int fr, int fq) const {
        const int row0 = u.pm * 256 + wr * 64 + fr; const int colb = u.pn * 256 + wc * 64 + 8 * fq;
        EPI_LOOP( const size_t o = (size_t)row * 2048 + col; const f32x4 g0 = ldbf4(GT + o), g1 = ldbf4(GT + o + 4); const f32x4 t0 = *(const f32x4*)(T1 + o), t1 = *(const f32x4*)(T1 + o + 4);
                  st_bf16x8(MRG + o, t0 + v0 * g0, t1 + v1 * g1); )
    }
};
struct EpiRes {
    const float* X; const bf16* Hh; bf16* R; const float* md; int osh, osc, ogt;
    __device__ __forceinline__ void operator()(const f32x4 (&acc)[2][2][4][2], const Unit& u, int wr, int wc, int fr, int fq) const {
        const int row0 = u.pm * 256 + wr * 64 + fr; const int colb = u.pn * 256 + wc * 64 + 8 * fq; const float* g = md + (size_t)(u.pm >> 4) * MODW;
        f32x4 gg[2][2];
#pragma unroll
        for (int bj = 0; bj < 2; ++bj) { gg[bj][0] = *(const f32x4*)(g + ogt + colb + bj * 32) + 1.f; gg[bj][1] = *(const f32x4*)(g + ogt + colb + bj * 32 + 4) + 1.f; }
        if (X) {
#pragma unroll
            for (int ai = 0; ai < 2; ++ai)
#pragma unroll
                for (int mh = 0; mh < 2; ++mh) { f32x4 xr[2][2][2];
#pragma unroll
                    for (int mm = 0; mm < 2; ++mm)
#pragma unroll
                        for (int bj = 0; bj < 2; ++bj) { const size_t o = (size_t)(row0 + ai * 128 + (2 * mh + mm) * 16) * 2048 + colb + bj * 32; xr[mm][bj][0] = *(const f32x4*)(X + o); xr[mm][bj][1] = *(const f32x4*)(X + o + 4); }
#pragma unroll
                    for (int mm = 0; mm < 2; ++mm)
#pragma unroll
                        for (int bj = 0; bj < 2; ++bj) { const int m = 2 * mh + mm; const size_t o = (size_t)(row0 + ai * 128 + m * 16) * 2048 + colb + bj * 32;
                            st_bf16x8(R + o, xr[mm][bj][0] * ALPHA + gg[bj][0] * acc[ai][bj][m][0], xr[mm][bj][1] * ALPHA + gg[bj][1] * acc[ai][bj][m][1]); } }
        } else {
            f32x4 ia[2][2], sb[2][2];
#pragma unroll
            for (int bj = 0; bj < 2; ++bj)
#pragma unroll
                for (int hh = 0; hh < 2; ++hh) { const f32x4 sc = *(const f32x4*)(g + osc + colb + bj * 32 + 4 * hh), sh = *(const f32x4*)(g + osh + colb + bj * 32 + 4 * hh);
#pragma unroll
                    for (int e = 0; e < 4; ++e) { ia[bj][hh][e] = ALPHA / (1.f + sc[e]); sb[bj][hh][e] = sh[e] * ia[bj][hh][e]; } }
#pragma unroll
            for (int ai = 0; ai < 2; ++ai) { v2u xr[4][2][2];
#pragma unroll
                for (int m = 0; m < 4; ++m)
#pragma unroll
                    for (int bj = 0; bj < 2; ++bj) { const size_t o = (size_t)(row0 + ai * 128 + m * 16) * 2048 + colb + bj * 32; xr[m][bj][0] = *(const v2u*)(Hh + o); xr[m][bj][1] = *(const v2u*)(Hh + o + 4); }
#pragma unroll
                for (int m = 0; m < 4; ++m)
#pragma unroll
                    for (int bj = 0; bj < 2; ++bj) { const size_t o = (size_t)(row0 + ai * 128 + m * 16) * 2048 + colb + bj * 32;
                        st_bf16x8(R + o, cvbf4(xr[m][bj][0]) * ia[bj][0] - sb[bj][0] + gg[bj][0] * acc[ai][bj][m][0], cvbf4(xr[m][bj][1]) * ia[bj][1] - sb[bj][1] + gg[bj][1] * acc[ai][bj][m][1]); } }
        }
    }
};
template <int which, bool FINAL>
struct EpiLn {
    unsigned char* ws; const float* X; float* Fo; const float* lng; const float* lnb; LAS unsigned char* lds; int l;
    __device__ __forceinline__ void operator()(f32x4 (&acc)[2][2][4][2], const Unit& u, int wr, int wc, int fr, int fq) const {
        { const int ln_ = lane_id(); fr = ln_ & 15; fq = ln_ >> 4; }
        int upm = u.pm, upn = u.pn; asm volatile("" : "+s"(upm), "+s"(upn));
        const float* MODb = (const float*)(ws + WS_MOD); bf16* Hh = (bf16*)(ws + WS_H);
        const float* g = MODb + ((size_t)l * NBATCH + (upm >> 4)) * MODW + (which ? 3 * DM : 0);
        const float* go = which ? MODb + ((size_t)(l + 1 < DEPTH ? l + 1 : l) * NBATCH + (upm >> 4)) * MODW : g + 3 * DM;
        LAS float* sl = (LAS float*)(lds + RING_BYTES);
        const int row0 = upm * 256 + wr * 64 + fr; const int colb = upn * 256 + wc * 64 + 8 * fq;
#pragma unroll
        for (int bj = 0; bj < 2; ++bj) { const int c0 = colb + bj * 32;
            const f32x4 gg0 = *(const f32x4*)(g + 2 * DM + c0) + 1.f, gg1 = *(const f32x4*)(g + 2 * DM + c0 + 4) + 1.f;
            if (which == 0 && X) {
#pragma unroll
                for (int ai = 0; ai < 2; ++ai) { f32x4 xr[4][2];
#pragma unroll
                    for (int m = 0; m < 4; ++m) { const size_t o = (size_t)(row0 + ai * 128 + m * 16) * 2048 + c0; xr[m][0] = *(const f32x4*)(X + o); xr[m][1] = *(const f32x4*)(X + o + 4); }
#pragma unroll
                    for (int m = 0; m < 4; ++m) { acc[ai][bj][m][0] = xr[m][0] * ALPHA + gg0 * acc[ai][bj][m][0]; acc[ai][bj][m][1] = xr[m][1] * ALPHA + gg1 * acc[ai][bj][m][1]; } }
            } else {
                f32x4 ia0, ia1, sb0, sb1;
                { const f32x4 sc0 = *(const f32x4*)(g + DM + c0), sc1 = *(const f32x4*)(g + DM + c0 + 4), sh0 = *(const f32x4*)(g + c0), sh1 = *(const f32x4*)(g + c0 + 4);
#pragma unroll
                  for (int e = 0; e < 4; ++e) { ia0[e] = ALPHA * __builtin_amdgcn_rcpf(1.f + sc0[e]); ia1[e] = ALPHA * __builtin_amdgcn_rcpf(1.f + sc1[e]); sb0[e] = sh0[e] * ia0[e]; sb1[e] = sh1[e] * ia1[e]; } }
#pragma unroll
                for (int ai = 0; ai < 2; ++ai) { v2u xr[4][2]; size_t o = (size_t)(row0 + ai * 128) * 2048 + c0;
#pragma unroll
                    for (int m = 0; m < 4; ++m) { xr[m][0] = *(const v2u*)(Hh + o); xr[m][1] = *(const v2u*)(Hh + o + 4); size_t st_ = 16 * 2048; asm volatile("" : "+s"(st_)); o += st_; }
#pragma unroll
                    for (int m = 0; m < 4; ++m) { acc[ai][bj][m][0] = cvbf4(xr[m][0]) * ia0 - sb0 + gg0 * acc[ai][bj][m][0]; acc[ai][bj][m][1] = cvbf4(xr[m][1]) * ia1 - sb1 + gg1 * acc[ai][bj][m][1]; }
                    asm volatile("" ::: "memory"); }
            }
            asm volatile("" ::: "memory"); }
        { const int ln_ = lane_id(); fr = ln_ & 15; fq = ln_ >> 4; }
#pragma unroll
        for (int ai = 0; ai < 2; ++ai)
#pragma unroll
            for (int m = 0; m < 4; ++m) { float s1 = 0.f, s2 = 0.f;
#pragma unroll
                for (int bj = 0; bj < 2; ++bj)
#pragma unroll
                    for (int hh = 0; hh < 2; ++hh) { const f32x4 v = acc[ai][bj][m][hh]; s1 += (v[0] + v[1]) + (v[2] + v[3]); s2 += (v[0] * v[0] + v[1] * v[1]) + (v[2] * v[2] + v[3] * v[3]); }
                s1 = xsum32(xsum16(s1)); s2 = xsum32(xsum16(s2));
                if (fq == 0) { const int rt = ai * 128 + wr * 64 + m * 16 + fr; sl[(wc * 256 + rt) * 2] = s1; sl[(wc * 256 + rt) * 2 + 1] = s2; } }
        __syncthreads();
        const int tid = (wr * 4 + wc) * 64 + lane_id();
        float* ex = (float*)(ws + WS_SEL) + (size_t)upm * 8 * 512;
        if (tid < 256) { const float S1 = (sl[tid * 2] + sl[(256 + tid) * 2]) + (sl[(512 + tid) * 2] + sl[(768 + tid) * 2]), S2 = (sl[tid * 2 + 1] + sl[(256 + tid) * 2 + 1]) + (sl[(512 + tid) * 2 + 1] + sl[(768 + tid) * 2 + 1]);
            __hip_atomic_store((unsigned*)(ex + (upn * 256 + tid) * 2), __builtin_bit_cast(unsigned, S1), __ATOMIC_RELAXED, __HIP_MEMORY_SCOPE_AGENT);
            __hip_atomic_store((unsigned*)(ex + (upn * 256 + tid) * 2 + 1), __builtin_bit_cast(unsigned, S2), __ATOMIC_RELAXED, __HIP_MEMORY_SCOPE_AGENT); }
        asm volatile("s_waitcnt vmcnt(0)" ::: "memory");
        __syncthreads();
        if (tid == 0) { unsigned* cp = (unsigned*)(ws + WS_CTL) + 256 + (l * 2 + which) * 64 + upm;
            __builtin_amdgcn_fence(__ATOMIC_RELEASE, "agent"); asm volatile("s_waitcnt vmcnt(0)" ::: "memory");
            (void)xb_add(cp, 1u);
            for (unsigned sp = 0u; xb_ld(cp) < 8u && sp < 400000u; ++sp) __builtin_amdgcn_s_sleep(1);
            __builtin_amdgcn_fence(__ATOMIC_ACQUIRE, "agent"); asm volatile("s_waitcnt vmcnt(0)" ::: "memory"); }
        __syncthreads();
        if (tid < 256) { float S1 = 0.f, S2 = 0.f;
#pragma unroll
            for (int p = 0; p < 8; ++p) { S1 += __builtin_bit_cast(float, __hip_atomic_load((unsigned*)(ex + (p * 256 + tid) * 2), __ATOMIC_RELAXED, __HIP_MEMORY_SCOPE_AGENT));
                S2 += __builtin_bit_cast(float, __hip_atomic_load((unsigned*)(ex + (p * 256 + tid) * 2 + 1), __ATOMIC_RELAXED, __HIP_MEMORY_SCOPE_AGENT)); }
            const float mean = S1 * (1.f / DM); const float var = fmaxf(S2 * (1.f / DM) - mean * mean, 0.f);
            sl[2048 + tid * 2] = mean; sl[2048 + tid * 2 + 1] = 1.0f / sqrtf(var + 1e-5f); }
        __syncthreads();
        { const int ln_ = lane_id(); fr = ln_ & 15; fq = ln_ >> 4; }
        const int row1 = upm * 256 + wr * 64 + fr; const int colc = upn * 256 + wc * 64 + 8 * fq;
#pragma unroll
        for (int bj = 0; bj < 2; ++bj) { const int c0 = colc + bj * 32;
            const f32x4 lg0 = *(const f32x4*)(lng + c0), lg1 = *(const f32x4*)(lng + c0 + 4), lb0 = *(const f32x4*)(lnb + c0), lb1 = *(const f32x4*)(lnb + c0 + 4);
            const f32x4 q0 = *(const f32x4*)(go + DM + c0) + 1.f, q1 = *(const f32x4*)(go + DM + c0 + 4) + 1.f, h0 = *(const f32x4*)(go + c0), h1 = *(const f32x4*)(go + c0 + 4);
#pragma unroll
            for (int ai = 0; ai < 2; ++ai) { size_t on = (size_t)(row1 + ai * 128) * 2048 + c0;
#pragma unroll
                for (int m = 0; m < 4; ++m) { const int rt = ai * 128 + wr * 64 + m * 16 + fr; const float mean = sl[2048 + rt * 2], rstd = sl[2048 + rt * 2 + 1];
                    const size_t o = on; { size_t st_ = 16 * 2048; asm volatile("" : "+s"(st_)); on += st_; }
                    const f32x4 y0 = (acc[ai][bj][m][0] - mean) * rstd * lg0 + lb0, y1 = (acc[ai][bj][m][1] - mean) * rstd * lg1 + lb1;
                    if constexpr (FINAL) { *(f32x4*)(Fo + o) = y0; *(f32x4*)(Fo + o + 4) = y1; }
                    else st_bf16x8(Hh + o, y0 * q0 + h0, y1 * q1 + h1); } }
            asm volatile("" ::: "memory"); }
    }
};
struct EpiSwiglu {
    bf16* ACT;
    __device__ __forceinline__ void operator()(const f32x4 (&acc)[2][2][4][2], const Unit& u, int wr, int wc, int fr, int fq) const {
        const int row0 = u.pm * 256 + wr * 64 + fr; const int col = u.pn * 128 + wc * 32 + 8 * fq;
#pragma unroll
        for (int ai = 0; ai < 2; ++ai)
#pragma unroll
            for (int m = 0; m < 4; ++m) { const int row = row0 + ai * 128 + m * 16;
                st_bf16x8(ACT + (size_t)row * DFF + col, silu4(acc[ai][0][m][0]) * acc[ai][1][m][0], silu4(acc[ai][0][m][1]) * acc[ai][1][m][1]); }
    }
};

__global__ void __launch_bounds__(NTHR, 2) fwd_kernel(Args args) {
    extern __shared__ __attribute__((aligned(16))) unsigned char lds_raw[];
    LAS unsigned char* lds = (LAS unsigned char*)lds_raw;
    const int G = gridDim.x, blk = blockIdx.x;
    const int NGW = G * NWAVES, NT = G * NTHR;
    unsigned char* const ws_base = args.ws;
    gu32* ctl = (gu32*)(ws_base + WS_CTL);
    for (int u = threadIdx.x; u < (LDS_BYTES - LDSCTL_OFF) / 4; u += NTHR) ((LAS unsigned*)(lds + LDSCTL_OFF))[u] = 0u;
    __syncthreads();
    volatile LAS unsigned* MISC = (volatile LAS unsigned*)(lds + MISC_OFF);
    const int wave_s = __builtin_amdgcn_readfirstlane((int)(threadIdx.x >> 6));
    XcdBarrier bar = xcd_barrier_post((unsigned*)(ctl + CW_BAR), MISC + 8); bar.wave = wave_s;
    if (threadIdx.x == 0) { unsigned nloc_ = 0u, nx_ = 0u; xcd_barrier_complete(bar.bar, bar.x, nloc_, nx_); bar.st[0] = nloc_; bar.st[1] = nx_; }
    __syncthreads();
#define GRID_BAR() xcd_barrier(bar)

#define x_in ((const float*)(const GAS float*)args.in[0 + z_])
#define c_in ((const float*)(const GAS float*)args.in[1 + z_])
#define w_ada ((const float*)(const GAS float*)args.in[2 + z_])
#define b_ada ((const float*)(const GAS float*)args.in[3 + z_])
#define w_in ((const float*)(const GAS float*)args.in[4 + z_])
#define lb_logits ((const float*)(const GAS float*)args.in[5 + z_])
#define g_hg ((const float*)(const GAS float*)args.in[6 + z_])
#define w_pa ((const float*)(const GAS float*)args.in[7 + z_])
#define g_cq ((const float*)(const GAS float*)args.in[8 + z_])
#define g_ckv ((const float*)(const GAS float*)args.in[9 + z_])
#define w_uq ((const float*)(const GAS float*)args.in[10 + z_])
#define w_iq ((const float*)(const GAS float*)args.in[11 + z_])
#define w_uv ((const float*)(const GAS float*)args.in[12 + z_])
#define w_pb ((const float*)(const GAS float*)args.in[13 + z_])
#define w_out ((const float*)(const GAS float*)args.in[14 + z_])
#define ln1_g ((const float*)(const GAS float*)args.in[15 + z_])
#define ln1_b ((const float*)(const GAS float*)args.in[16 + z_])
#define w_gate ((const float*)(const GAS float*)args.in[17 + z_])
#define w_up ((const float*)(const GAS float*)args.in[18 + z_])
#define w_down ((const float*)(const GAS float*)args.in[19 + z_])
#define ln2_g ((const float*)(const GAS float*)args.in[20 + z_])
#define ln2_b ((const float*)(const GAS float*)args.in[21 + z_])
#define MOD  ((float*)(ws + WS_MOD))
#define LB   ((float*)(ws + WS_LB))
#define MODP ((float*)(ws + WS_MODP))
#define WSET(L_) ((size_t)(((L_) & 1) ? (WS_X - WS_W1) : 0))
#define WL_(OFF_, L_) ((bf16*)(ws + (OFF_) + WSET(L_)))
#define W1   WL_(WS_W1, l)
#define W3   WL_(WS_W3, l)
#define W6   WL_(WS_W6, l)
#define W7   WL_(WS_W7, l)
#define W8   WL_(WS_W8, l)
#define W10  WL_(WS_W10, l)
#define W11  WL_(WS_W11, l)
#define XB   ((bf16*)(ws + WS_X))
#define RB   ((bf16*)(ws + WS_R))
#define HB   ((bf16*)(ws + WS_H))
#define QA   ((bf16*)(ws + WS_QA))
#define FA   ((bf16*)(ws + WS_FA))
#define IA   ((bf16*)(ws + WS_IA))
#define GA   ((bf16*)(ws + WS_GA))
#define LAT  ((bf16*)(ws + WS_LAT))
#define GTA  ((bf16*)(ws + WS_GTA))
#define GTB  ((bf16*)(ws + WS_GTB))
#define CQN  ((bf16*)(ws + WS_CQN))
#define CKV  ((bf16*)(ws + WS_CKV))
#define KIDX ((bf16*)(ws + WS_KIDX))
#define IDXW ((float*)(ws + WS_IDXW))
#define QB   ((bf16*)(ws + WS_QB))
#define QIDX ((bf16*)(ws + WS_QIDX))
#define SEL  ((unsigned short*)(ws + WS_SEL))
#define YAB  ((bf16*)(ws + WS_YAB))
#define MRG  ((bf16*)(ws + WS_MRG))
#define OB   ((bf16*)(ws + WS_OB))
#define ISC  ((_Float16*)(ws + WS_BIG))
#define OP   ((float*)(ws + WS_BIG))
#define ACT  ((bf16*)(ws + WS_BIG))
#define KK   LAT
#define modl (MOD + (size_t)l * NBATCH * MODW)
#define KSB  ((bf16*)(ws + WS_KSB))
#define QSB  ((bf16*)(ws + WS_QSB))
#define KVT  ((bf16*)(ws + WS_BIG))
#define SPB  ((bf16*)(ws + WS_FA))
#define DEB  ((float*)(ws + WS_DEB))
#define PHASE_BEGIN { unsigned om_ = ~0u; asm volatile("" : "+s"(om_)); int tid = wave_s * 64 + (int)__builtin_amdgcn_mbcnt_hi(om_, __builtin_amdgcn_mbcnt_lo(om_, 0u)); asm volatile("" : "+v"(tid)); int z_ = 0; asm volatile("" : "+s"(z_)); (void)z_; GAS unsigned char* wsg_ = (GAS unsigned char*)ws_base; asm volatile("" : "+s"(wsg_)); unsigned char* ws = (unsigned char*)wsg_; const int lane = tid & 63, wave = __builtin_amdgcn_readfirstlane(tid >> 6); \
        const int gw = blk * NWAVES + wave, gtid = blk * NTHR + tid; LAS float* wscr = (LAS float*)(lds + wave * 16384); (void)lane; (void)gw; (void)gtid; (void)wscr;
#define PHASE_END }

#define CVT_DECODE(IT_, MID_, K0_, N0_) do { int r_ = (IT_); \
        if (r_ < I1) { MID_ = 0; K0_ = (r_ / (N1 / 32)) * 64; N0_ = (r_ % (N1 / 32)) * 32; } else { r_ -= I1; \
        if (r_ < I3) { MID_ = 1; K0_ = (r_ / (N3 / 32)) * 64; N0_ = (r_ % (N3 / 32)) * 32; } else { r_ -= I3; \
        if (r_ < I6) { MID_ = 2; K0_ = (r_ / 32) * 64; N0_ = (r_ % 32) * 32; } else { r_ -= I6; \
        if (r_ < I7) { MID_ = 3; K0_ = (r_ / (DM / 32)) * 64; N0_ = (r_ % (DM / 32)) * 32; } else { r_ -= I7; \
        if (r_ < I8) { MID_ = 4; K0_ = (r_ / (DM / 32)) * 64; N0_ = (r_ % (DM / 32)) * 32; } else { r_ -= I8; \
        if (r_ < I10) { MID_ = 5; K0_ = (r_ / (N10 / 32)) * 64; N0_ = (r_ % (N10 / 32)) * 32; } else { r_ -= I10; \
        MID_ = 6; K0_ = (r_ / (DM / 32)) * 64; N0_ = (r_ % (DM / 32)) * 32; } } } } } } } while (0)
#define CVT_LOAD(MID_, K0_, N0_, TV_) do { \
        if (MID_ == 0) cvt_load([=](int k, int n) -> f32x4 { const f32x4 v = *(const f32x4*)(s_in + (size_t)k * 9040 + (n < 4944 ? n : n - 176)); return (n >= 4944 && n < 5120) ? (f32x4){0.f, 0.f, 0.f, 0.f} : v; }, K0_, N0_, lane, TV_); \
        else if (MID_ == 1) cvt_load([=](int k, int n) -> f32x4 { const float* p = n < 4096 ? s_uq + (size_t)k * 4096 + n : s_iq + (size_t)k * 1024 + (n - 4096); return *(const f32x4*)p * (n < 4096 ? 0.0625f : 1.f); }, K0_, N0_, lane, TV_); \
        else if (MID_ == 2) cvt_load([=](int k, int n) -> f32x4 { const int h = n >> 6, v = n & 63, kk = k >> 8, c = k & 255; const f32x4 w = *(const f32x4*)(s_uv + ((size_t)h * 256 + c) * 64 + v); return kk == (h & 3) ? w : (f32x4){0.f, 0.f, 0.f, 0.f}; }, K0_, N0_, lane, TV_); \
        else if (MID_ == 3) cvt_load([=](int k, int n) -> f32x4 { const float* p = k < 1024 ? s_pa + (size_t)k * DM + n : s_pb + (size_t)(k - 1024) * DM + n; return *(const f32x4*)p; }, K0_, N0_, lane, TV_); \
        else if (MID_ == 4) cvt_load([=](int k, int n) -> f32x4 { return *(const f32x4*)(s_out + (size_t)k * DM + n); }, K0_, N0_, lane, TV_); \
        else if (MID_ == 5) cvt_load([=](int k, int n) -> f32x4 { const int pn = n >> 8, rr = n & 255, cc = pn * 128 + (rr >> 6) * 32 + (rr & 31); const float* p = ((rr & 32) ? s_u : s_g) + (size_t)k * DFF + cc; return *(const f32x4*)p; }, K0_, N0_, lane, TV_); \
        else cvt_load([=](int k, int n) -> f32x4 { return *(const f32x4*)(s_d + (size_t)k * DM + n); }, K0_, N0_, lane, TV_); } while (0)
#define CONVERT_PREP(L) const int l_ = (L); \
        const float* s_in = w_in + (size_t)l_ * DM * 9040; const float* s_uq = w_uq + (size_t)l_ * SAR * 4096; const float* s_iq = w_iq + (size_t)l_ * SAR * 1024; \
        const float* s_uv = w_uv + (size_t)l_ * 16 * 256 * 64; const float* s_pa = w_pa + (size_t)l_ * 1024 * DM; const float* s_pb = w_pb + (size_t)l_ * 1024 * DM; \
        const float* s_out = w_out + (size_t)l_ * DM * DM; const float* s_g = w_gate + (size_t)l_ * DM * DFF; const float* s_u = w_up + (size_t)l_ * DM * DFF; const float* s_d = w_down + (size_t)l_ * DFF * DM; \
        constexpr int I1 = (DM / 64) * (N1 / 32), I3 = (SAR / 64) * (N3 / 32), I6 = (1024 / 64) * (1024 / 32), I7 = (DM / 64) * (DM / 32), I8 = I7, I10 = (DM / 64) * (N10 / 32), I11 = (DFF / 64) * (DM / 32); \
        constexpr int NIT = I1 + I3 + I6 + I7 + I8 + I10 + I11; (void)I11; (void)s_in; (void)s_uq; (void)s_iq; (void)s_uv; (void)s_pa; (void)s_pb; (void)s_out; (void)s_g; (void)s_u; (void)s_d
#define CVT_WT(MC_, L_) ((MC_) == 0 ? WL_(WS_W1, L_) : (MC_) == 1 ? WL_(WS_W3, L_) : (MC_) == 2 ? WL_(WS_W6, L_) : (MC_) == 3 ? WL_(WS_W7, L_) : (MC_) == 4 ? WL_(WS_W8, L_) : (MC_) == 5 ? WL_(WS_W10, L_) : WL_(WS_W11, L_))
#define CVT_KK(MC_) ((MC_) == 0 ? DM : (MC_) == 1 ? SAR : (MC_) == 2 ? 1024 : (MC_) == 3 ? DM : (MC_) == 4 ? DM : (MC_) == 5 ? DM : DFF)
#define CONVERT_LAYER(L) do { CONVERT_PREP(L); \
        float tv_[32]; int mid_ = 0, k0_ = 0, n0_ = 0; \
        { CVT_DECODE(gw, mid_, k0_, n0_); CVT_LOAD(mid_, k0_, n0_, tv_); } \
        for (int it = gw; it < NIT; it += NGW) { \
            float tc_[32]; _Pragma("unroll") for (int i = 0; i < 32; ++i) tc_[i] = tv_[i]; \
            const int mc_ = mid_, kc_ = k0_, nc_ = n0_; \
            { const int itn_ = it + NGW < NIT ? it + NGW : it; CVT_DECODE(itn_, mid_, k0_, n0_); CVT_LOAD(mid_, k0_, n0_, tv_); }     \
            cvt_store(tc_, CVT_WT(mc_, l_), CVT_KK(mc_), kc_, nc_, wscr, lane); \
        } } while (0)


#ifndef HGRN_NAIVE
#define HGRN_NAIVE 0
#endif
#ifndef IDX_NAIVE
#define IDX_NAIVE 0
#endif
#ifndef ATT_NAIVE
#define ATT_NAIVE 0
#endif
#ifndef TOPK_OLD
#define TOPK_OLD 0
#endif
#ifndef REP_HB
#define REP_HB 1
#endif
#ifndef REP_HC
#define REP_HC 1
#endif
#ifndef REP_P4A
#define REP_P4A 1
#endif
#ifndef REP_P5
#define REP_P5 1
#endif
#ifndef REP_P9
#define REP_P9 1
#endif
#ifndef REP_P12
#define REP_P12 1
#endif
#ifndef REP_TOPK
#define REP_TOPK 1
#endif
#ifndef REP_ATT
#define REP_ATT 1
#endif
#ifndef DRY_ATT
#define DRY_ATT 0
#endif
#ifndef REP_M1
#define REP_M1 1
#endif
#ifndef REP_M2
#define REP_M2 1
#endif
#ifndef REP_M3
#define REP_M3 1
#endif

    PHASE_BEGIN
    {
        LAS float* sc = (LAS float*)lds;
        for (int i = tid; i < NBATCH * DM; i += NTHR) { const float v = c_in[i]; sc[i] = v * sigm(v); }
        __syncthreads();
        for (int item = gtid; item < 8 * 12288; item += NT) {
            const int ks = item / 12288, cg = item % 12288, l = cg / 3072, n4 = (cg % 3072) * 4;
            const float* wp = w_ada + ((size_t)l * DM + ks * 256) * MODW + n4;
            f32x4 a0 = {0.f, 0.f, 0.f, 0.f}, a1 = a0, a2 = a0, a3 = a0;
#pragma unroll 8
            for (int k = 0; k < 256; ++k) { const f32x4 w = *(const f32x4*)(wp + (size_t)k * MODW); const int kk = ks * 256 + k;
                a0 += w * sc[kk]; a1 += w * sc[2048 + kk]; a2 += w * sc[4096 + kk]; a3 += w * sc[6144 + kk]; }
            float* o = MODP + ((size_t)(ks * 4 + l) * 4) * MODW + n4;
            *(f32x4*)(o) = a0; *(f32x4*)(o + MODW) = a1; *(f32x4*)(o + 2 * MODW) = a2; *(f32x4*)(o + 3 * MODW) = a3;
        }
        if (gtid < 1024) {
            const float a = lb_logits[gtid], b = lb_logits[1024 + gtid], c = lb_logits[2048 + gtid], d = lb_logits[3072 + gtid];
            const float mx = fmaxf(fmaxf(a, b), fmaxf(c, d)); const float ea = expf(a - mx), eb = expf(b - mx), ec = expf(c - mx), ed = expf(d - mx); const float inv = 1.f / (ea + eb + ec + ed);
            LB[gtid] = 0.f; LB[1024 + gtid] = eb * inv; LB[2048 + gtid] = (eb + ec) * inv; LB[3072 + gtid] = (eb + ec + ed) * inv;
        }
        __syncthreads();
        CONVERT_LAYER(0);
    }
    PHASE_END
    GRID_BAR();
    PHASE_BEGIN
    for (int i = gtid; i < DEPTH * NBATCH * MODW; i += NT) {
        const int l = i / (NBATCH * MODW), r = i % (NBATCH * MODW), b = r / MODW, n = r % MODW;
        float s = b_ada[l * MODW + n];
#pragma unroll
        for (int ks = 0; ks < 8; ++ks) s += MODP[((size_t)(ks * 4 + l) * 4 + b) * MODW + n];
        MOD[i] = s;
    }
    PHASE_END
    GRID_BAR();
    PHASE_BEGIN
    for (size_t i0 = gtid; i0 < (size_t)M * DM / 8; i0 += (size_t)NT * 4) {
        f32x4 xa[4], xb[4], sa[4], sb[4], ha[4], hb[4];
#pragma unroll
        for (int t = 0; t < 4; ++t) { size_t gi = i0 + (size_t)t * NT; gi = gi < (size_t)M * DM / 8 ? gi : (size_t)M * DM / 8 - 1; const size_t e = gi * 8; const int row = (int)(e / DM), col = (int)(e % DM), b = row / SEQ; const float* md = MOD + (size_t)b * MODW;
            xa[t] = *(const f32x4*)(x_in + e); xb[t] = *(const f32x4*)(x_in + e + 4); sa[t] = *(const f32x4*)(md + 2048 + col); sb[t] = *(const f32x4*)(md + 2048 + col + 4); ha[t] = *(const f32x4*)(md + col); hb[t] = *(const f32x4*)(md + col + 4); }
#pragma unroll
        for (int t = 0; t < 4; ++t) { size_t gi = i0 + (size_t)t * NT; gi = gi < (size_t)M * DM / 8 ? gi : (size_t)M * DM / 8 - 1; const size_t e = gi * 8; st_bf16x8(HB + e, xa[t] * (sa[t] + 1.f) + ha[t], xb[t] * (sb[t] + 1.f) + hb[t]); }
    }
    PHASE_END
    GRID_BAR();

    for (int l = 0; l < DEPTH; ++l) {
        PHASE_BEGIN
        { pg8::Gemm g{HB, W1, M, N1, DM, DM, DM, 0}; pg8::StaticOrder S; S.init(M, N1, G, blk);
          EpiProj E{QA, FA, IA, GA, LAT, GTA, GTB}; pg8::gemm_phase(lds, g, S, E, tid); }
        PHASE_END
        GRID_BAR();
        for (int rep_ = 0; rep_ < REP_M1; ++rep_) {
        PHASE_BEGIN
        v2u ra0, ra1, rkv; unsigned short rki, riw;
        const f32x4 g0 = *(const f32x4*)(g_cq + l * 512 + 4 * lane), g1 = *(const f32x4*)(g_cq + l * 512 + 256 + 4 * lane), gk = *(const f32x4*)(g_ckv + l * 256 + 4 * lane);
        { const bf16* lr = LAT + (size_t)gw * 1024; ra0 = *(const v2u*)(lr + 4 * lane); ra1 = *(const v2u*)(lr + 256 + 4 * lane); rkv = *(const v2u*)(lr + 512 + 4 * lane); rki = lr[768 + lane]; riw = lr[832 + (lane & 15)]; }
        for (int row = gw; row < M; row += NGW) {
            const f32x4 a0 = (f32x4){bflo(ra0.x), bfhi(ra0.x), bflo(ra0.y), bfhi(ra0.y)}, a1 = (f32x4){bflo(ra1.x), bfhi(ra1.x), bflo(ra1.y), bfhi(ra1.y)}, kv = (f32x4){bflo(rkv.x), bfhi(rkv.x), bflo(rkv.y), bfhi(rkv.y)};
            const float ki = bf2f(rki), iw = bf2f(riw);
            { const int rn = row + NGW < M ? row + NGW : row; const bf16* lr = LAT + (size_t)rn * 1024;
              ra0 = *(const v2u*)(lr + 4 * lane); ra1 = *(const v2u*)(lr + 256 + 4 * lane); rkv = *(const v2u*)(lr + 512 + 4 * lane); rki = lr[768 + lane]; riw = lr[832 + (lane & 15)]; }
            float sq = a0[0] * a0[0] + a0[1] * a0[1] + a0[2] * a0[2] + a0[3] * a0[3] + a1[0] * a1[0] + a1[1] * a1[1] + a1[2] * a1[2] + a1[3] * a1[3];
            float sk = kv[0] * kv[0] + kv[1] * kv[1] + kv[2] * kv[2] + kv[3] * kv[3];
            sq = wave_sum(sq); sk = wave_sum(sk);
            const float rq = 1.0f / sqrtf(sq * (1.f / 512.f) + 1e-6f), rk = 1.0f / sqrtf(sk * (1.f / 256.f) + 1e-6f);
            v2u o; f32x4 t = a0 * rq * g0; o.x = pk2(t[0], t[1]); o.y = pk2(t[2], t[3]); *(v2u*)(CQN + (size_t)row * 512 + 4 * lane) = o;
            t = a1 * rq * g1; o.x = pk2(t[0], t[1]); o.y = pk2(t[2], t[3]); *(v2u*)(CQN + (size_t)row * 512 + 256 + 4 * lane) = o;
            t = kv * rk * gk; o.x = pk2(t[0], t[1]); o.y = pk2(t[2], t[3]); *(v2u*)(CKV + (size_t)row * 256 + 4 * lane) = o;
            KIDX[(size_t)row * 64 + lane] = (bf16)f2bf(ki);
            if (lane < 16) IDXW[(size_t)row * 16 + lane] = iw * 0.03125f;
        }
        PHASE_END
        PHASE_BEGIN
        {
            const int cp = tid & 63, sg = tid >> 6;
            LAS unsigned char* KST = lds;
            LAS unsigned char* VTL = lds + 18432;
            LAS float* SEGT = (LAS float*)(lds + 36864);
            LAS float* G63 = (LAS float*)(lds + 40960);
            unsigned pfa[8], pq[8], pv[8]; float plb0, plb1;
#define HA_REQ(U_) do { int uu_ = (U_); asm volatile("" : "+s"(uu_)); const int bh_ = uu_ >> 6, c_ = uu_ & 63, b_ = bh_ >> 3, h_ = bh_ & 7; \
                const size_t rowb_ = (size_t)b_ * SEQ + c_ * 64 + sg * 8; const int col_ = h_ * 128 + 2 * cp; \
                _Pragma("unroll") for (int i = 0; i < 8; ++i) { pfa[i] = *(const unsigned*)(FA + (rowb_ + i) * 1024 + col_); pq[i] = *(const unsigned*)(QA + (rowb_ + i) * 1024 + col_); pv[i] = *(const unsigned*)(IA + (rowb_ + i) * 1024 + col_); } plb0 = LB[l * 1024 + col_]; plb1 = LB[l * 1024 + col_ + 1]; } while (0)
            HA_REQ(blk);
            for (int u = blk; u < 2048; u += G) {
                const int bh = u >> 6, c = u & 63, b = bh >> 3, h = bh & 7;
                const size_t rowb = (size_t)b * SEQ + c * 64 + sg * 8; const int col = h * 128 + 2 * cp;
                const float lb0 = plb0, lb1 = plb1;
                float lf0[8], lf1[8], kk0[8], kk1[8]; unsigned cq[8], cv[8];
#pragma unroll
                for (int i = 0; i < 8; ++i) { cq[i] = pq[i]; cv[i] = pv[i]; }
#pragma unroll
                for (int i = 0; i < 8; ++i) { const float2 fa = make_float2(bflo(pfa[i]), bfhi(pfa[i]));
                    const float f0 = fminf(fmaxf(lb0 + (1.f - lb0) * sigm(fa.x), 1e-6f), 1.f), f1 = fminf(fmaxf(lb1 + (1.f - lb1) * sigm(fa.y), 1e-6f), 1.f);
                    lf0[i] = __logf(f0); lf1[i] = __logf(f1); kk0[i] = (1.f - lb0) * sigm(-fa.x); kk1[i] = (1.f - lb1) * sigm(-fa.y); }
#pragma unroll
                for (int i = 1; i < 8; ++i) { lf0[i] += lf0[i - 1]; lf1[i] += lf1[i - 1]; }
                SEGT[sg * 128 + 2 * cp] = lf0[7]; SEGT[sg * 128 + 2 * cp + 1] = lf1[7];
                HA_REQ(u + G < 2048 ? u + G : u);
                __syncthreads();
                float pre0 = 0.f, pre1 = 0.f, r0 = 0.f, r1 = 0.f, t0 = 0.f, t1 = 0.f;
#pragma unroll
                for (int s2 = 0; s2 < 8; ++s2) { const float a0 = SEGT[s2 * 128 + 2 * cp], a1 = SEGT[s2 * 128 + 2 * cp + 1];
                    if (s2 < sg) { pre0 += a0; pre1 += a1; } if (s2 < 4) { r0 += a0; r1 += a1; } t0 += a0; t1 += a1; }
                unsigned ksw0[4], ksw1[4], vw0[4], vw1[4]; float ks0p = 0.f, ks1p = 0.f, v0p = 0.f, v1p = 0.f;
#pragma unroll
                for (int i = 0; i < 8; ++i) {
                    const float b0 = pre0 + lf0[i], b1 = pre1 + lf1[i];
                    const unsigned qw = cq[i]; const unsigned vw = cv[i];
                    const float qs0 = bflo(qw) * __expf(b0 - r0), qs1 = bfhi(qw) * __expf(b1 - r1);
                    const float ks0 = kk0[i] * __expf(r0 - b0), ks1 = kk1[i] * __expf(r1 - b1);
                    *(unsigned*)(QSB + (rowb + i) * 1024 + col) = pk2(qs0, qs1);
                    *(unsigned*)(KSB + (rowb + i) * 1024 + col) = pk2(ks0, ks1);
                    if (i & 1) { ksw0[i >> 1] = pk2(ks0p, ks0); ksw1[i >> 1] = pk2(ks1p, ks1); vw0[i >> 1] = pk2(v0p, bflo(vw)); vw1[i >> 1] = pk2(v1p, bfhi(vw)); }
                    else { ks0p = ks0; ks1p = ks1; v0p = bflo(vw); v1p = bfhi(vw); }
                }
                *(LAS v4u*)(KST + (2 * cp) * 144 + sg * 16) = (v4u){ksw0[0], ksw0[1], ksw0[2], ksw0[3]};
                *(LAS v4u*)(KST + (2 * cp + 1) * 144 + sg * 16) = (v4u){ksw1[0], ksw1[1], ksw1[2], ksw1[3]};
                *(LAS v4u*)(VTL + (2 * cp) * 144 + sg * 16) = (v4u){vw0[0], vw0[1], vw0[2], vw0[3]};
                *(LAS v4u*)(VTL + (2 * cp + 1) * 144 + sg * 16) = (v4u){vw1[0], vw1[1], vw1[2], vw1[3]};
                if (sg == 7) { float* de = DEB + (size_t)u * 256; *(float2*)(de + 2 * cp) = make_float2(__expf(r0), __expf(r1)); *(float2*)(de + 128 + 2 * cp) = make_float2(__expf(t0), __expf(t1));
                    G63[2 * cp] = __expf(t0 - r0); G63[2 * cp + 1] = __expf(t1 - r1); }
                __syncthreads();
                { const int kt = wave >> 1, vt0 = (wave & 1) * 2, lr = lane & 31, lh = lane >> 5;
                  f32x16 acc0, acc1;
#pragma unroll
                  for (int r = 0; r < 16; ++r) { acc0[r] = 0.f; acc1[r] = 0.f; }
#pragma unroll
                  for (int s4 = 0; s4 < 4; ++s4) {
                      const bf16x8 kb = *(const LAS bf16x8*)(KST + (kt * 32 + lr) * 144 + (s4 * 16 + 8 * lh) * 2);
                      const bf16x8 a0 = *(const LAS bf16x8*)(VTL + (vt0 * 32 + lr) * 144 + (s4 * 16 + 8 * lh) * 2);
                      const bf16x8 a1 = *(const LAS bf16x8*)(VTL + ((vt0 + 1) * 32 + lr) * 144 + (s4 * 16 + 8 * lh) * 2);
                      acc0 = __builtin_amdgcn_mfma_f32_32x32x16_bf16(a0, kb, acc0, 0, 0, 0); acc1 = __builtin_amdgcn_mfma_f32_32x32x16_bf16(a1, kb, acc1, 0, 0, 0); }
                  bf16* kvt = KVT + (size_t)u * 16384 + kt * 32 + lr; const float g = G63[kt * 32 + lr];
#pragma unroll
                  for (int r = 0; r < 16; ++r) { const int vv = 8 * (r >> 2) + 4 * lh + (r & 3);
                      kvt[(size_t)(vt0 * 32 + vv) * 128] = (bf16)(pk2(acc0[r] * g, 0.f) & 0xffffu); kvt[(size_t)((vt0 + 1) * 32 + vv) * 128] = (bf16)(pk2(acc1[r] * g, 0.f) & 0xffffu); } }
                __syncthreads();
            }
        }
#undef HA_REQ
        PHASE_END
        GRID_BAR();
        }
        for (int rep_ = 0; rep_ < REP_M2; ++rep_) {
        PHASE_BEGIN
        for (int item = gtid; item < 32 * 4096; item += NT) {
            const int bh = item >> 12, v = (item >> 5) & 127, k4 = (item & 31) * 4;
            f32x4 S = {0.f, 0.f, 0.f, 0.f};
            for (int c0 = 0; c0 < 64; c0 += 8) {
                f32x4 kv[8], dd[8], ee[8];
#pragma unroll
                for (int j = 0; j < 8; ++j) { const size_t u = (size_t)bh * 64 + c0 + j; kv[j] = ldbf4(KVT + u * 16384 + v * 128 + k4); ee[j] = *(const f32x4*)(DEB + u * 256 + k4); dd[j] = *(const f32x4*)(DEB + u * 256 + 128 + k4); }
#pragma unroll
                for (int j = 0; j < 8; ++j) { const size_t u = (size_t)bh * 64 + c0 + j; const f32x4 sp = S * ee[j]; v2u w; w.x = pk2(sp[0], sp[1]); w.y = pk2(sp[2], sp[3]);
                    *(v2u*)(SPB + u * 16384 + v * 128 + k4) = w; S = S * dd[j] + kv[j]; }
            }
        }
        PHASE_END
        PHASE_BEGIN
        { pg8::Gemm g{CQN, W3, M, N3, SAR, SAR, SAR, 0}; pg8::StaticOrder S; S.init(M, N3, G, blk);
          EpiQ E{QB, QIDX}; pg8::gemm_phase(lds, g, S, E, tid); }
        PHASE_END
        GRID_BAR();
        }
        for (int st_ = 0; st_ < 2; ++st_) {
        if ((st_ == 0) == (((blk >> 3) & 1) == 0)) {
        PHASE_BEGIN
        {
            LAS unsigned char* QSL = lds;
            LAS unsigned char* KSL = lds + 17408;
            LAS unsigned char* VTL = lds + 34816;
            LAS unsigned char* SPL = lds + 53248;
            LAS unsigned char* AL = lds + 88064;
            LAS float* SSQ = (LAS float*)(lds + 97280);
            const int cp = tid & 63, sg = tid >> 6, lr = lane & 31, lh = lane >> 5;
            v4u rq[2], rk[2], rs[4]; unsigned rv[8]; unsigned short rg[16];
#define HC_REQ(U_) do { int uu_ = (U_); asm volatile("" : "+s"(uu_));   const int bh_ = uu_ >> 6, c_ = uu_ & 63, b_ = bh_ >> 3, h_ = bh_ & 7; const size_t row0_ = (size_t)b_ * SEQ + c_ * 64; const int col0_ = h_ * 128; \
                _Pragma("unroll") for (int j = 0; j < 2; ++j) { const int q = tid + 512 * j, rr = q >> 4, cc = q & 15; \
                    rq[j] = *(const v4u*)(QSB + (row0_ + rr) * 1024 + col0_ + cc * 8); rk[j] = *(const v4u*)(KSB + (row0_ + rr) * 1024 + col0_ + cc * 8); } \
                _Pragma("unroll") for (int j = 0; j < 4; ++j) { const int q = tid + 512 * j, rr = q >> 4, cc = q & 15; rs[j] = *(const v4u*)(SPB + (size_t)uu_ * 16384 + rr * 128 + cc * 8); } \
                _Pragma("unroll") for (int i = 0; i < 8; ++i) rv[i] = *(const unsigned*)(IA + (row0_ + sg * 8 + i) * 1024 + col0_ + 2 * cp); \
                { const int it_ = wave >> 2, vt_ = wave & 3; const int colg_ = col0_ + vt_ * 32 + lr; \
                  _Pragma("unroll") for (int r = 0; r < 16; ++r) { const int ii = it_ * 32 + 8 * (r >> 2) + 4 * lh + (r & 3); rg[r] = GA[(row0_ + ii) * 1024 + colg_]; } } } while (0)
            HC_REQ(blk);
            for (int u = blk; u < 2048; u += G) {
                const int bh = u >> 6, c = u & 63, b = bh >> 3, h = bh & 7;
                const size_t row0 = (size_t)b * SEQ + c * 64; const int col0 = h * 128;
#pragma unroll
                for (int j = 0; j < 2; ++j) { const int q = tid + 512 * j, rr = q >> 4, cc = q & 15;
                    *(LAS v4u*)(QSL + rr * 272 + cc * 16) = rq[j]; *(LAS v4u*)(KSL + rr * 272 + cc * 16) = rk[j]; }
#pragma unroll
                for (int j = 0; j < 4; ++j) { const int q = tid + 512 * j, rr = q >> 4, cc = q & 15; *(LAS v4u*)(SPL + rr * 272 + cc * 16) = rs[j]; }
                { unsigned vw0[4], vw1[4]; float v0p = 0.f, v1p = 0.f;
#pragma unroll
                  for (int i = 0; i < 8; ++i) { const unsigned vw = rv[i];
                      if (i & 1) { vw0[i >> 1] = pk2(v0p, bflo(vw)); vw1[i >> 1] = pk2(v1p, bfhi(vw)); } else { v0p = bflo(vw); v1p = bfhi(vw); } }
                  *(LAS v4u*)(VTL + (2 * cp) * 144 + sg * 16) = (v4u){vw0[0], vw0[1], vw0[2], vw0[3]};
                  *(LAS v4u*)(VTL + (2 * cp + 1) * 144 + sg * 16) = (v4u){vw1[0], vw1[1], vw1[2], vw1[3]}; }
                float gav[16];
#pragma unroll
                for (int r = 0; r < 16; ++r) gav[r] = bf2f(rg[r]);
                const float gg = g_hg[l * 1024 + col0 + (wave & 3) * 32 + lr];
                HC_REQ(u + G < 2048 ? u + G : u);
                __syncthreads();
                if (wave < 4) {
                    const int it = wave >> 1, jt = wave & 1;
                    f32x16 acc;
#pragma unroll
                    for (int r = 0; r < 16; ++r) acc[r] = 0.f;
                    if (!(it == 0 && jt == 1)) {
#pragma unroll
                        for (int s8 = 0; s8 < 8; ++s8) {
                            const bf16x8 a = *(const LAS bf16x8*)(QSL + (it * 32 + lr) * 272 + (s8 * 16 + 8 * lh) * 2);
                            const bf16x8 bb = *(const LAS bf16x8*)(KSL + (jt * 32 + lr) * 272 + (s8 * 16 + 8 * lh) * 2);
                            acc = __builtin_amdgcn_mfma_f32_32x32x16_bf16(a, bb, acc, 0, 0, 0); } }
                    const int jj = jt * 32 + lr;
#pragma unroll
                    for (int r = 0; r < 16; ++r) { const int ii = it * 32 + 8 * (r >> 2) + 4 * lh + (r & 3); const float x = (jj <= ii) ? acc[r] : 0.f;
                        *(LAS unsigned short*)(AL + ii * 144 + jj * 2) = (unsigned short)(pk2(x, 0.f) & 0xffffu); }
                }
                __syncthreads();
                { const int it = wave >> 2, vt = wave & 3;
                  f32x16 acc;
#pragma unroll
                  for (int r = 0; r < 16; ++r) acc[r] = 0.f;
#pragma unroll
                  for (int s4 = 0; s4 < 4; ++s4) {
                      const bf16x8 a = *(const LAS bf16x8*)(AL + (it * 32 + lr) * 144 + (s4 * 16 + 8 * lh) * 2);
                      const bf16x8 bb = *(const LAS bf16x8*)(VTL + (vt * 32 + lr) * 144 + (s4 * 16 + 8 * lh) * 2);
                      acc = __builtin_amdgcn_mfma_f32_32x32x16_bf16(a, bb, acc, 0, 0, 0); }
#pragma unroll
                  for (int s8 = 0; s8 < 8; ++s8) {
                      const bf16x8 a = *(const LAS bf16x8*)(QSL + (it * 32 + lr) * 272 + (s8 * 16 + 8 * lh) * 2);
                      const bf16x8 bb = *(const LAS bf16x8*)(SPL + (vt * 32 + lr) * 272 + (s8 * 16 + 8 * lh) * 2);
                      acc = __builtin_amdgcn_mfma_f32_32x32x16_bf16(a, bb, acc, 0, 0, 0); }
#pragma unroll
                  for (int r = 0; r < 16; ++r) { float q2 = acc[r] * acc[r];
                      q2 = xsum16(rowsum16(q2));
                      if (lr == 0) SSQ[vt * 64 + it * 32 + 8 * (r >> 2) + 4 * lh + (r & 3)] = q2; }
                  __syncthreads();
                  const int colg = col0 + vt * 32 + lr;
#pragma unroll
                  for (int r = 0; r < 16; ++r) { const int ii = it * 32 + 8 * (r >> 2) + 4 * lh + (r & 3);
                      const float ss = SSQ[ii] + SSQ[64 + ii] + SSQ[128 + ii] + SSQ[192 + ii]; const float rn = 1.0f / sqrtf(ss * (1.f / 128.f) + 1e-6f);
                      YAB[(row0 + ii) * 2048 + colg] = (bf16)(pk2(acc[r] * rn * gg * gav[r], 0.f) & 0xffffu); }
                }
                __syncthreads();
            }
        }
#undef HC_REQ
        PHASE_END
        } else {
        PHASE_BEGIN
        for (int ub = blk * NWAVES; ub < 2048; ub += NGW) {
            const int unit = ub + wave;
            const int b = ub >> 9, j = unit & 511, lr = lane & 31, lh = lane >> 5;
            const int qsel = (lr >> 2) & 1, head = (lr >> 3) * 4 + (lr & 3);
            const int qlo = 4 * j, qhi = 4 * (1023 - j);
            const int nlo = ((qlo >> 6) + 1) * 64, nhi = ((qhi >> 6) + 1) * 64;
            const int nlo8 = (nlo + 511) & ~511, nhi8 = (nhi + 511) & ~511;
            const int nmax8 = (((((4 * (1023 - (ub & 511))) >> 6) + 1) * 64) + 511) & ~511;
            bf16x8 A[4][4]; float W[4][16]; typedef float f32x2_t __attribute__((ext_vector_type(2)));
#pragma unroll
            for (int p = 0; p < 4; ++p) { const size_t qb = (size_t)b * SEQ + (p < 2 ? qlo + 2 * p : qhi + 2 * (p - 2));
#pragma unroll
                for (int ks = 0; ks < 4; ++ks) A[p][ks] = *(const bf16x8*)(QIDX + (qb + qsel) * 1024 + head * 64 + ks * 16 + lh * 8);
#pragma unroll
                for (int r4 = 0; r4 < 4; ++r4) { const f32x4 w = *(const f32x4*)(IDXW + (qb + lh) * 16 + r4 * 4); W[p][r4 * 4] = w[0]; W[p][r4 * 4 + 1] = w[1]; W[p][r4 * 4 + 2] = w[2]; W[p][r4 * 4 + 3] = w[3]; } }
            const bf16* kb = KIDX + (size_t)b * SEQ * 64;
            const int srow = 8 * wave + (lane >> 3), spc = ((lane & 7) ^ ((srow >> 1) & 7)) * 8;
#define P4_STAGE(C0_, BUF_) do { _Pragma("unroll") for (int i = 0; i < 4; ++i) \
                __builtin_amdgcn_global_load_lds((const unsigned*)(kb + (size_t)((C0_) + 64 * i + srow) * 64 + spc), (LAS unsigned*)(lds + (BUF_) * 32768 + (i * 8 + wave) * 1024), 16, 0, 0); } while (0)
            P4_STAGE(0, 0);
            asm volatile("s_waitcnt vmcnt(0)" ::: "memory");
            __syncthreads();
            for (int c0 = 0; c0 < nmax8; c0 += 256) {
                const int cb = (c0 >> 8) & 1; const bool more = c0 + 256 < nmax8;
                if (more) P4_STAGE(c0 + 256, cb ^ 1);
                LAS unsigned char* kbuf = lds + cb * 32768;
#pragma unroll 1
                for (int tl = 0; tl < 8; ++tl) {
                    const int s0 = c0 + tl * 32;
                    if (s0 >= nhi8) break;
#pragma unroll
                    for (int p = 0; p < 4; ++p) { const int np = p < 2 ? nlo : nhi, np8 = p < 2 ? nlo8 : nhi8;
                        if (s0 >= np && s0 < np8) { const size_t q = (size_t)b * SEQ + (p < 2 ? qlo + 2 * p : qhi + 2 * (p - 2)) + lh; ISC[q * 4096 + s0 + lr] = (_Float16)(-60000.0f); } }
                    if (s0 >= nhi) continue;
                    bf16x8 B[4];
#pragma unroll
                    for (int ks = 0; ks < 4; ++ks) B[ks] = *(const LAS bf16x8*)(kbuf + (tl * 32 + lr) * 128 + (((2 * ks + lh) ^ ((lr >> 1) & 7)) * 16));
#define IDX_FINISH(P_, ACC_) do { f32x2_t s2_ = {0.f, 0.f};     \
                        _Pragma("unroll") for (int r = 0; r < 16; r += 2) { const float a0_ = ACC_[r], a1_ = ACC_[r + 1]; const int i0_ = __builtin_bit_cast(int, a0_), i1_ = __builtin_bit_cast(int, a1_); \
                            const f32x2_t rl_ = {__builtin_bit_cast(float, i0_ > 0 ? i0_ : 0), __builtin_bit_cast(float, i1_ > 0 ? i1_ : 0)}; const f32x2_t w_ = {W[P_][r], W[P_][r + 1]}; \
                            s2_ = __builtin_elementwise_fma(rl_, w_, s2_); } \
                        const float sc_ = s2_[0] + s2_[1]; \
                        const size_t q_ = (size_t)b * SEQ + ((P_) < 2 ? qlo + 2 * (P_) : qhi + 2 * ((P_) - 2)) + lh; ISC[q_ * 4096 + s0 + lr] = (_Float16)sc_; } while (0)
                    if (s0 < nlo) {
                        f32x16 c0_, c1_, c2_, c3_;
#pragma unroll
                        for (int r = 0; r < 16; ++r) { c0_[r] = 0.f; c1_[r] = 0.f; c2_[r] = 0.f; c3_[r] = 0.f; }
#pragma unroll
                        for (int ks = 0; ks < 4; ++ks) { c0_ = __builtin_amdgcn_mfma_f32_32x32x16_bf16(A[0][ks], B[ks], c0_, 0, 0, 0); c1_ = __builtin_amdgcn_mfma_f32_32x32x16_bf16(A[1][ks], B[ks], c1_, 0, 0, 0);
                            c2_ = __builtin_amdgcn_mfma_f32_32x32x16_bf16(A[2][ks], B[ks], c2_, 0, 0, 0); c3_ = __builtin_amdgcn_mfma_f32_32x32x16_bf16(A[3][ks], B[ks], c3_, 0, 0, 0); }
                        IDX_FINISH(0, c0_); IDX_FINISH(1, c1_); IDX_FINISH(2, c2_); IDX_FINISH(3, c3_);
                    } else {
                        f32x16 c2_, c3_;
#pragma unroll
                        for (int r = 0; r < 16; ++r) { c2_[r] = 0.f; c3_[r] = 0.f; }
#pragma unroll
                        for (int ks = 0; ks < 4; ++ks) { c2_ = __builtin_amdgcn_mfma_f32_32x32x16_bf16(A[2][ks], B[ks], c2_, 0, 0, 0); c3_ = __builtin_amdgcn_mfma_f32_32x32x16_bf16(A[3][ks], B[ks], c3_, 0, 0, 0); }
                        IDX_FINISH(2, c2_); IDX_FINISH(3, c3_);
                    }
#undef IDX_FINISH
                }
                asm volatile("s_waitcnt vmcnt(0)" ::: "memory");
                __syncthreads();
            }
        }
#undef P4_STAGE
        PHASE_END
        }
        __syncthreads();
        }
        GRID_BAR();
        for (int rep_ = 0; rep_ < REP_P5; ++rep_) {
        PHASE_BEGIN
        {
            LAS unsigned char* VB = lds + wave * 18432;
            LAS unsigned short* SELW = (LAS unsigned short*)(VB + 17408);
            const int hd = lane & 15, g = lane >> 4, qq = hd >> 2, pp = hd & 3;
            const float slope = exp2f(-0.5f * (float)(hd + 1));
            for (int q = gw; q < M; q += NGW) {
                const int b = q / SEQ, pos = q % SEQ, qc = pos >> 6; const int nsel = qc < 4 ? (qc + 1) * 64 : 256;
                const bool cvl = (l + 1 < DEPTH);
                const int lcv = cvl ? l + 1 : l;
                float cta[32], ctb[32]; int cma = 0, cka = 0, cna = 0, cmb = 0, ckb = 0, cnb = 0;
                { CONVERT_PREP(lcv); int ita_ = gw + NGW * (2 * (q / NGW)), itb_ = ita_ + NGW; ita_ = ita_ < NIT ? ita_ : NIT - 1; itb_ = itb_ < NIT ? itb_ : NIT - 1;
                    if (!cvl) { ita_ = 0; itb_ = 0; }
                    CVT_DECODE(ita_, cma, cka, cna); CVT_LOAD(cma, cka, cna, cta); CVT_DECODE(itb_, cmb, ckb, cnb); CVT_LOAD(cmb, ckb, cnb, ctb); }
                for (int rtk_ = 0; rtk_ < REP_TOPK; ++rtk_) {
                int lane_t = lane; asm volatile("" : "+v"(lane_t));
                if (qc < 4) { const unsigned e0 = 4 * lane_t; const bool ok = 4 * lane_t < nsel; v2u z; z.x = ok ? (e0 | ((e0 + 1) << 16)) : 0u; z.y = ok ? ((e0 + 2) | ((e0 + 3) << 16)) : 0u; *(LAS v2u*)(SELW + 4 * lane_t) = z; }
                else {
                    LAS unsigned* HIST = (LAS unsigned*)VB;
                    const int nb8 = (qc + 8) >> 3;
                    float v[64];
                    { unsigned pk[32]; const int i2max = 4 * nb8 - 1; const _Float16* irow = ISC + (size_t)q * 4096 + 2 * lane_t; typedef _Float16 h2_t __attribute__((ext_vector_type(2)));
#pragma unroll
                      for (int i2 = 0; i2 < 32; ++i2) { const int ic = i2 < i2max ? i2 : i2max; pk[i2] = *(const unsigned*)(irow + ic * 128); }
#pragma unroll
                      for (int i2 = 0; i2 < 32; ++i2) { const float lim = (i2 >> 2) < nb8 ? 3.0e38f : -1.0e30f; const h2_t h = __builtin_bit_cast(h2_t, pk[i2]);
                          const float f0 = (float)h[0], f1 = (float)h[1]; v[2 * i2] = fminf(f0, lim); v[2 * i2 + 1] = fminf(f1, lim); } }
                    float vmx = v[0], vmn = fminf(fminf(v[0], v[1]), fminf(v[2], v[3]));
#pragma unroll
                    for (int i = 1; i < 64; ++i) vmx = fmaxf(vmx, v[i]);
                    vmx = wmax_f(vmx); vmn = -wmax_f(-vmn);
                    const float rng = vmx - vmn; const float s20 = rng > 0.f ? 1048574.0f / rng : 0.f;
#define ZERO_HIST() do { *(LAS v4u*)(HIST + 16 * lane) = (v4u){0u, 0u, 0u, 0u}; *(LAS v4u*)(HIST + 16 * lane + 4) = (v4u){0u, 0u, 0u, 0u}; *(LAS v4u*)(HIST + 16 * lane + 8) = (v4u){0u, 0u, 0u, 0u}; \
                        *(LAS v4u*)(HIST + 16 * lane + 12) = (v4u){0u, 0u, 0u, 0u}; HIST[1024 + lane] = 0u; } while (0)
#define SCAN_HIST(R_, BIN_, AB_) do { unsigned hh_[16]; const int hb_ = 1008 - 16 * lane; \
                        { const v4u h0 = *(const LAS v4u*)(HIST + hb_), h1 = *(const LAS v4u*)(HIST + hb_ + 4), h2 = *(const LAS v4u*)(HIST + hb_ + 8), h3 = *(const LAS v4u*)(HIST + hb_ + 12); \
                          hh_[0] = h0.x; hh_[1] = h0.y; hh_[2] = h0.z; hh_[3] = h0.w; hh_[4] = h1.x; hh_[5] = h1.y; hh_[6] = h1.z; hh_[7] = h1.w; hh_[8] = h2.x; hh_[9] = h2.y; hh_[10] = h2.z; hh_[11] = h2.w; hh_[12] = h3.x; hh_[13] = h3.y; hh_[14] = h3.z; hh_[15] = h3.w; } \
                        unsigned tot_ = 0u; _Pragma("unroll") for (int k = 0; k < 16; ++k) tot_ += hh_[k]; \
                        unsigned run_ = wprefix_u(tot_) - tot_; int fb_ = -1; unsigned fa_ = 0u; \
                        _Pragma("unroll") for (int k = 15; k >= 0; --k) { if (run_ < (R_) && run_ + hh_[k] >= (R_)) { fb_ = hb_ + k; fa_ = run_; } run_ += hh_[k]; } \
                        const unsigned long long bm_ = __ballot(fb_ >= 0); const int L_ = (int)__builtin_ctzll(bm_); \
                        BIN_ = (unsigned)__builtin_amdgcn_readlane(fb_, L_); AB_ = (unsigned)__builtin_amdgcn_readlane((int)fa_, L_); } while (0)
                    ZERO_HIST();
#pragma unroll
                    for (int i = 0; i < 64; ++i) v[i] = __builtin_bit_cast(float, (unsigned)((v[i] - vmn) * s20));
#define cd(i_) __builtin_bit_cast(unsigned, v[i_])
#pragma unroll
                    for (int g8 = 0; g8 < 8; ++g8) { if (g8 < nb8) {
#pragma unroll
                        for (int j = 0; j < 8; ++j) __hip_atomic_fetch_add(HIST + (cd(g8 * 8 + j) >> 10), 1u, __ATOMIC_RELAXED, __HIP_MEMORY_SCOPE_WORKGROUP); } }
                    LDS_WAIT(); asm volatile("" ::: "memory");
                    unsigned tb, above; SCAN_HIST(256u, tb, above);
                    ZERO_HIST();
                    LDS_WAIT(); asm volatile("" ::: "memory");
#pragma unroll
                    for (int g8 = 0; g8 < 8; ++g8) { if (g8 < nb8) {
#pragma unroll
                        for (int j = 0; j < 8; ++j) { const unsigned c = cd(g8 * 8 + j); const unsigned a = (c >> 10) == tb ? (c & 1023u) : 1024u + lane; __hip_atomic_fetch_add(HIST + a, 1u, __ATOMIC_RELAXED, __HIP_MEMORY_SCOPE_WORKGROUP); } } }
                    LDS_WAIT(); asm volatile("" ::: "memory");
                    unsigned tb2, ab2; { const unsigned R2 = 256u - above; SCAN_HIST(R2, tb2, ab2); }
                    const unsigned T = (tb << 10) | tb2; above += ab2;
                    unsigned baseg = 0u, basee = above;
#pragma unroll
                    for (int g8 = 0; g8 < 8; ++g8) { if (g8 < nb8) {
#pragma unroll
                        for (int j = 0; j < 8; ++j) { const int i = g8 * 8 + j;
                            const bool gt = cd(i) > T; const unsigned long long bg = __ballot(gt);
                            const unsigned pgp = baseg + __builtin_amdgcn_mbcnt_hi((unsigned)(bg >> 32), __builtin_amdgcn_mbcnt_lo((unsigned)bg, 0u));
                            if (gt) SELW[pgp] = (unsigned short)((i >> 1) * 128 + (i & 1) + 2 * lane);
                            baseg += (unsigned)__popcll(bg);
                            const bool eq = cd(i) == T; const unsigned long long be = __ballot(eq);
                            if (be) { const unsigned pep = basee + __builtin_amdgcn_mbcnt_hi((unsigned)(be >> 32), __builtin_amdgcn_mbcnt_lo((unsigned)be, 0u));
                                if (eq && pep < 256u) SELW[pep] = (unsigned short)((i >> 1) * 128 + (i & 1) + 2 * lane);
                                basee += (unsigned)__popcll(be); } } } }
#undef cd
#undef ZERO_HIST
#undef SCAN_HIST
                }
                LDS_WAIT(); asm volatile("" ::: "memory");
                }
                { LAS float* cscr = (LAS float*)(VB + 4608);
                    if (cvl) { cvt_store(cta, CVT_WT(cma, l + 1), CVT_KK(cma), cka, cna, cscr, lane); cvt_store(ctb, CVT_WT(cmb, l + 1), CVT_KK(cmb), ckb, cnb, cscr, lane); }
                    else { asm volatile("" :: "v"(cta[0]), "v"(ctb[0])); } }
                for (int rat_ = 0; rat_ < REP_ATT; ++rat_) {
                bf16* qrow = QB + (size_t)q * 4096;
                bf16x8 Bq[8];
#pragma unroll
                for (int ks = 0; ks < 8; ++ks) Bq[ks] = *(const bf16x8*)(qrow + hd * 256 + ks * 32 + g * 8);
                const bf16* kvb = CKV + (size_t)b * SEQ * 256;
                f32x4 O[16];
#pragma unroll
                for (int ct = 0; ct < 16; ++ct) O[ct] = (f32x4){0.f, 0.f, 0.f, 0.f};
                float mrun = -1.0e30f, lsum = 0.f;
                LDS_WAIT(); asm volatile("" ::: "memory");
                const int nks = nsel >> 5;
                const int lrow = lane >> 5, lcp = lane & 31, lsh = 16 * lrow;
                v4u KR[16];
#define ATT_IDX(KST_) v4u iw_[4]; _Pragma("unroll") for (int c = 0; c < 4; ++c) iw_[c] = *(const LAS v4u*)(SELW + 32 * (KST_) + 8 * c)
#define ATT_LOADROWS(KST_) do { ATT_IDX(KST_); _Pragma("unroll") for (int i = 0; i < 16; ++i) { const int rr_ = 2 * i + lrow; const unsigned w_ = iw_[i >> 2][i & 3]; const int ix_ = (int)((w_ >> lsh) & 0xffffu); \
                    KR[i] = *(const v4u*)(kvb + (size_t)ix_ * 256 + ((lcp ^ (rr_ & 7)) * 8)); } } while (0)
                ATT_LOADROWS(0);
                const int rlA = hd & 7;
                const int rlT = (4 * g + qq) & 7;
                const int trb = (4 * g + qq) * 512 + 8 * (pp & 1), trm = 16 * ((pp >> 1) ^ rlT);
                for (int kst = 0; kst < nks; ++kst) {
                    int rlA_ = rlA, trm_ = trm; asm volatile("" : "+v"(rlA_), "+v"(trm_));
                    if (kst + 1 < nks) {
                        ATT_IDX(kst + 1);
#pragma unroll
                        for (int i = 0; i < 16; ++i) { *(LAS v4u*)(VB + i * 1024 + lane * 16) = KR[i];
                            const int rr_ = 2 * i + lrow; const unsigned w_ = iw_[i >> 2][i & 3]; const int ix_ = (int)((w_ >> lsh) & 0xffffu); KR[i] = *(const v4u*)(kvb + (size_t)ix_ * 256 + ((lcp ^ (rr_ & 7)) * 8)); }
                    } else {
#pragma unroll
                        for (int i = 0; i < 16; ++i) *(LAS v4u*)(VB + i * 1024 + lane * 16) = KR[i]; }
                    LDS_WAIT(); asm volatile("" ::: "memory");
                    f32x4 S0 = {0.f, 0.f, 0.f, 0.f}, S1 = {0.f, 0.f, 0.f, 0.f};
#pragma unroll
                    for (int k4 = 0; k4 < 4; ++k4) {
                        bf16x8 a0[2], a1[2];
#pragma unroll
                        for (int j = 0; j < 2; ++j) { const int ks = k4 * 2 + j; const int cpos = (4 * ks + g) ^ rlA_;
                            a0[j] = *(const LAS bf16x8*)(VB + hd * 512 + cpos * 16); a1[j] = *(const LAS bf16x8*)(VB + (16 + hd) * 512 + cpos * 16); }
#pragma unroll
                        for (int j = 0; j < 2; ++j) { const int ks = k4 * 2 + j;
                            S0 = __builtin_amdgcn_mfma_f32_16x16x32_bf16(a0[j], Bq[ks], S0, 0, 0, 0); S1 = __builtin_amdgcn_mfma_f32_16x16x32_bf16(a1[j], Bq[ks], S1, 0, 0, 0); }
                    }
                    const v2u pa = *(const LAS v2u*)(SELW + 32 * kst + 4 * g), pb = *(const LAS v2u*)(SELW + 32 * kst + 16 + 4 * g);
                    const float fp = (float)pos;
                    float s0[4], s1[4];
                    s0[0] = S0[0] - slope * fabsf(fp - (float)(pa.x & 0xffffu)); s0[1] = S0[1] - slope * fabsf(fp - (float)(pa.x >> 16));
                    s0[2] = S0[2] - slope * fabsf(fp - (float)(pa.y & 0xffffu)); s0[3] = S0[3] - slope * fabsf(fp - (float)(pa.y >> 16));
                    s1[0] = S1[0] - slope * fabsf(fp - (float)(pb.x & 0xffffu)); s1[1] = S1[1] - slope * fabsf(fp - (float)(pb.x >> 16));
                    s1[2] = S1[2] - slope * fabsf(fp - (float)(pb.y & 0xffffu)); s1[3] = S1[3] - slope * fabsf(fp - (float)(pb.y >> 16));
                    float ml = fmaxf(fmaxf(fmaxf(s0[0], s0[1]), fmaxf(s0[2], s0[3])), fmaxf(fmaxf(s1[0], s1[1]), fmaxf(s1[2], s1[3])));
                    ml = xmax16(ml); ml = xmax32(ml);
                    const float mnew = fmaxf(mrun, ml), alpha = __expf(mrun - mnew); mrun = mnew;
                    float p0[4], p1[4];
#pragma unroll
                    for (int r = 0; r < 4; ++r) { p0[r] = __expf(s0[r] - mnew); p1[r] = __expf(s1[r] - mnew); }
                    lsum = lsum * alpha + ((p0[0] + p0[1]) + (p0[2] + p0[3])) + ((p1[0] + p1[1]) + (p1[2] + p1[3]));
                    v4u pw; pw.x = pk2(p0[0], p0[1]); pw.y = pk2(p0[2], p0[3]); pw.z = pk2(p1[0], p1[1]); pw.w = pk2(p1[2], p1[3]);
                    const bf16x8 Pf = __builtin_bit_cast(bf16x8, pw);
#pragma unroll
                    for (int ct = 0; ct < 16; ++ct) O[ct] = O[ct] * alpha;
#pragma unroll
                    for (int c8 = 0; c8 < 4; ++c8) {
                        v4s lo[4], hi[4];
#pragma unroll
                        for (int j = 0; j < 4; ++j) { const int ct = c8 * 4 + j; const int off = trb + ((32 * ct) ^ trm_);
                            lo[j] = __builtin_amdgcn_ds_read_tr16_b64_v4i16((LAS v4s*)(VB + off));
                            hi[j] = __builtin_amdgcn_ds_read_tr16_b64_v4i16((LAS v4s*)(VB + 16 * 512 + off)); }
#pragma unroll
                        for (int j = 0; j < 4; ++j) { const int ct = c8 * 4 + j;
                            const bf16x8 Af = {lo[j][0], lo[j][1], lo[j][2], lo[j][3], hi[j][0], hi[j][1], hi[j][2], hi[j][3]};
                            O[ct] = __builtin_amdgcn_mfma_f32_16x16x32_bf16(Af, Pf, O[ct], 0, 0, 0); }
                    }
                    LDS_WAIT(); asm volatile("" ::: "memory");
                }
#undef ATT_LOADROWS
#undef ATT_IDX
                lsum = xsum16(lsum); lsum = xsum32(lsum);
                const float inv = 1.0f / lsum;
#pragma unroll
                for (int ct = 0; ct < 16; ++ct) { const f32x4 o = O[ct] * inv; v2u w; w.x = pk2(o[0], o[1]); w.y = pk2(o[2], o[3]); *(v2u*)(OB + (size_t)q * 4096 + hd * 256 + 16 * ct + 4 * g) = w; }
                }
            }
        }
        PHASE_END
        GRID_BAR();
        }
        PHASE_BEGIN
        { pg8::Gemm g{OB, W6, M, 1024, 1024, 4096, 1024, 1024}; pg8::StaticOrder S; S.init(M, 1024, G, blk);
          EpiBf E{YAB, 2048, 1024}; pg8::gemm_phase(lds, g, S, E, tid); }
        PHASE_END
        GRID_BAR();
        PHASE_BEGIN
        { pg8::Gemm g{YAB, W7, M, DM, DM, DM, DM, 0}; pg8::StaticOrder S; S.init(M, DM, G, blk);
          EpiGateM E{GTB, MRG}; HookGate Hk{GTA, GTB}; pg8::gemm_phase(lds, g, S, E, tid, Hk); }
        PHASE_END
        GRID_BAR();
        PHASE_BEGIN
        { pg8::Gemm g{MRG, W8, M, DM, DM, DM, DM, 0}; pg8::StaticOrder S; S.init(M, DM, G, blk);
          S.mode = 1;
          EpiLn<0, false> E{ws, (l == 0) ? x_in : (const float*)nullptr, (float*)nullptr, ln1_g + l * DM, ln1_b + l * DM, lds, l};
          pg8::gemm_phase(lds, g, S, E, tid); }
        PHASE_END
        GRID_BAR();
        PHASE_BEGIN
        { pg8::Gemm g{HB, W10, M, N10, DM, DM, DM, 0}; pg8::StaticOrder S; S.init(M, N10, G, blk);
          EpiSwiglu E{ACT}; pg8::gemm_phase(lds, g, S, E, tid); }
        PHASE_END
        GRID_BAR();
        if (l == DEPTH - 1) {
        PHASE_BEGIN
        { pg8::Gemm g{ACT, W11, M, DM, DFF, DFF, DFF, 0, 1}; pg8::StaticOrder S; S.init(M, DM, G, blk); S.mode = 1;
          EpiLn<1, true> E{ws, (const float*)nullptr, args.out, ln2_g + l * DM, ln2_b + l * DM, lds, l}; pg8::gemm_phase(lds, g, S, E, tid); }
        PHASE_END
        } else {
        PHASE_BEGIN
        { pg8::Gemm g{ACT, W11, M, DM, DFF, DFF, DFF, 0, 1}; pg8::StaticOrder S; S.init(M, DM, G, blk); S.mode = 1;
          EpiLn<1, false> E{ws, (const float*)nullptr, (float*)nullptr, ln2_g + l * DM, ln2_b + l * DM, lds, l}; pg8::gemm_phase(lds, g, S, E, tid); }
        PHASE_END
        }
        if (l + 1 < DEPTH) GRID_BAR();
    }
}

extern "C" void kernel_launch(void* const* d_in, const int* in_sizes, int n_in, void* d_out, int out_size, void* d_ws, size_t ws_size, hipStream_t stream) {
    static int grid = 0;
    if (grid == 0) {
        if (n_in != 22 || out_size != M * DM || ws_size < WS_END) { fprintf(stderr, "kernel_launch: unexpected shapes (n_in %d, out %d, ws %zu < %zu)\n", n_in, out_size, ws_size, (size_t)WS_END); grid = -1; return; }
        int dev = 0, cus = 0, per_cu = 0;
        if (hipGetDevice(&dev) != hipSuccess || hipDeviceGetAttribute(&cus, hipDeviceAttributeMultiprocessorCount, dev) != hipSuccess) { grid = -1; return; }
        if (hipFuncSetAttribute((const void*)fwd_kernel, hipFuncAttributeMaxDynamicSharedMemorySize, LDS_BYTES) != hipSuccess) { fprintf(stderr, "kernel_launch: hipFuncSetAttribute failed\n"); grid = -1; return; }
        if (hipOccupancyMaxActiveBlocksPerMultiprocessor(&per_cu, (const void*)fwd_kernel, NTHR, LDS_BYTES) != hipSuccess || per_cu < 1) { fprintf(stderr, "kernel_launch: occupancy query says %d\n", per_cu); }
        (void)hipGetLastError();
        if (cus % 64 != 0) { fprintf(stderr, "kernel_launch: %d CUs: the fused-LayerNorm unit order needs a multiple of 64 workgroups\n", cus); grid = -1; return; }
        grid = cus;
    }
    if (grid < 0) return;
    if (hipMemsetAsync((char*)d_ws + WS_CTL, 0, CTL_ZERO_BYTES, stream) != hipSuccess) return;
    Args a{};
    for (int i = 0; i < 22; ++i) a.in[i] = (const float*)d_in[i];
    a.out = (float*)d_out; a.ws = (unsigned char*)d_ws;
    hipLaunchKernelGGL(fwd_kernel, dim3(grid), dim3(NTHR), LDS_BYTES, stream, a);
}
```
